# Optimizing an MI355X kernel written in HIP

```python
import jax, jax.numpy as jnp
from jax import lax
import numpy as np

D_MODEL = 1024
BATCH = 4
SEQ = 4096
DEPTH = 1

HGRN_HEADS = 4
HGRN_KEY_DIM = 128
HGRN_VAL_DIM = (D_MODEL // 2) // HGRN_HEADS
HGRN_KEY_WIDTH = HGRN_HEADS * HGRN_KEY_DIM
HGRN_WIDTH = HGRN_HEADS * HGRN_VAL_DIM
CHUNK = 64
POOL_WINDOWS = (2, 4, 8, 16)
POOL_GROUPS = len(POOL_WINDOWS)
POOL_WIDTH = D_MODEL - HGRN_WIDTH
POOL_GROUP_DIM = POOL_WIDTH // POOL_GROUPS
POOL_MAX_W = max(POOL_WINDOWS)
MIX_WIDTH = HGRN_WIDTH + POOL_WIDTH
IN_WIDTH = 2 * HGRN_KEY_WIDTH + 2 * HGRN_WIDTH + POOL_WIDTH
MEM_LEN = 256
XATTN_HEADS = 4
XATTN_HEAD_DIM = D_MODEL // XATTN_HEADS
D_FF = 4 * D_MODEL
EPS = 1e-6

kernel_name = "hymba_style_hgrn2_pool_hybrid"


def rmsnorm(x, g):
    xf = x.astype(jnp.float32)
    y = xf * lax.rsqrt(jnp.mean(xf * xf, axis=-1, keepdims=True) + EPS)
    return (y * g.astype(jnp.float32)).astype(x.dtype)


def hgrn2_chunkwise(q, k, v, log_f):
    B, S, H, DK = q.shape
    DV = v.shape[-1]
    n = S // CHUNK

    def to_chunks(a):
        return a.reshape(B, n, CHUNK, H, a.shape[-1]).transpose(1, 0, 3, 2, 4)

    qc, kc, vc, fc = to_chunks(q), to_chunks(k), to_chunks(v), to_chunks(log_f)
    causal = jnp.tril(jnp.ones((CHUNK, CHUNK), dtype=bool))

    def step(state, inp):
        q_, k_, v_, lf = inp
        b = jnp.cumsum(lf, axis=2)
        diff = b[:, :, :, None, :] - b[:, :, None, :, :]
        decay = jnp.exp(jnp.where(causal[None, None, :, :, None], diff, -jnp.inf))
        scores = jnp.einsum('bhtk,bhsk,bhtsk->bhts', q_, k_, decay)
        o_intra = jnp.einsum('bhts,bhsv->bhtv', scores, v_)
        o_inter = jnp.einsum('bhtk,bhkv->bhtv', q_ * jnp.exp(b), state)
        b_last = b[:, :, -1:, :]
        k_dec = k_ * jnp.exp(b_last - b)
        state = jnp.exp(b_last[:, :, 0, :])[..., None] * state + jnp.einsum('bhsk,bhsv->bhkv', k_dec, v_)
        return state, o_intra + o_inter

    s0 = jnp.zeros((B, H, DK, DV), jnp.float32)
    _, o = lax.scan(step, s0, (qc, kc, vc, fc))
    return o.transpose(1, 0, 3, 2, 4).reshape(B, S, H, DV)


def multiscale_pool(p, w_pool, pool_scale):
    B, S, _ = p.shape
    pg = p.astype(jnp.float32).reshape(B, S, POOL_GROUPS, POOL_GROUP_DIM)
    cs = jnp.cumsum(pg, axis=1)
    cs = jnp.pad(cs, ((0, 0), (POOL_MAX_W, 0), (0, 0), (0, 0)))
    pos = (jnp.arange(S) + 1)
    outs = []
    for gi, w in enumerate(POOL_WINDOWS):
        win = cs[:, POOL_MAX_W:, gi] - cs[:, POOL_MAX_W - w:POOL_MAX_W - w + S, gi]
        cnt = jnp.minimum(pos, w).astype(jnp.float32)[None, :, None]
        outs.append(win / cnt - pg[:, :, gi])
    pooled = jnp.stack(outs, axis=2)
    y = jnp.einsum('bsgc,gcd->bsgd', pooled, w_pool.astype(jnp.float32))
    return y.reshape(B, S, POOL_WIDTH) * pool_scale.astype(jnp.float32)


def setup_inputs(seed: int = 0) -> dict:
    key = jax.random.key(seed)
    ks = jax.random.split(key, 24)
    f32 = jnp.float32

    def dense(k, shape, fan_in):
        return jax.random.normal(k, shape, f32) * (fan_in ** -0.5)

    def gain(k, shape):
        return 1.0 + 0.02 * jax.random.normal(k, shape, f32)

    return {
        "x": jax.random.normal(ks[0], (BATCH, SEQ, D_MODEL), f32),
        "mem": jax.random.normal(ks[1], (BATCH, MEM_LEN, D_MODEL), f32),
        "norm_mix_g": gain(ks[2], (DEPTH, D_MODEL)),
        "w_in": dense(ks[3], (DEPTH, D_MODEL, IN_WIDTH), D_MODEL),
        "lb_logits": 0.5 * jax.random.normal(ks[4], (DEPTH + 1, HGRN_KEY_WIDTH), f32),
        "hgrn_norm_g": gain(ks[5], (DEPTH, HGRN_HEADS, HGRN_VAL_DIM)),
        "w_pool": dense(ks[6], (DEPTH, POOL_GROUPS, POOL_GROUP_DIM, POOL_GROUP_DIM), POOL_GROUP_DIM),
        "pool_scale": gain(ks[7], (DEPTH, POOL_WIDTH)),
        "w_out": dense(ks[8], (DEPTH, MIX_WIDTH, D_MODEL), MIX_WIDTH),
        "norm_x_g": gain(ks[9], (DEPTH, D_MODEL)),
        "norm_mem_g": gain(ks[10], (DEPTH, D_MODEL)),
        "w_xq": dense(ks[11], (DEPTH, D_MODEL, XATTN_HEADS, XATTN_HEAD_DIM), D_MODEL),
        "w_xk": dense(ks[12], (DEPTH, D_MODEL, XATTN_HEADS, XATTN_HEAD_DIM), D_MODEL),
        "w_xv": dense(ks[13], (DEPTH, D_MODEL, XATTN_HEADS, XATTN_HEAD_DIM), D_MODEL),
        "w_xo": dense(ks[14], (DEPTH, XATTN_HEADS, XATTN_HEAD_DIM, D_MODEL), D_MODEL),
        "norm_ffn_g": gain(ks[15], (DEPTH, D_MODEL)),
        "w_ff1": dense(ks[16], (DEPTH, D_MODEL, D_FF), D_MODEL),
        "w_ff2": dense(ks[17], (DEPTH, D_FF, D_MODEL), D_FF),
        "final_norm_g": gain(ks[18], (D_MODEL,)),
    }


def reference(x, mem, norm_mix_g, w_in, lb_logits, hgrn_norm_g, w_pool, pool_scale, w_out,
              norm_x_g, norm_mem_g, w_xq, w_xk, w_xv, w_xo, norm_ffn_g, w_ff1, w_ff2, final_norm_g):
    B, S, _ = x.shape
    f32 = jnp.float32
    lower_bounds = jnp.cumsum(jax.nn.softmax(lb_logits.astype(f32), axis=0), axis=0)
    split_at = [HGRN_KEY_WIDTH, 2 * HGRN_KEY_WIDTH,
                2 * HGRN_KEY_WIDTH + HGRN_WIDTH, 2 * HGRN_KEY_WIDTH + 2 * HGRN_WIDTH]
    for l in range(DEPTH):
        h = rmsnorm(x, norm_mix_g[l])
        z = jnp.einsum('bsd,de->bse', h, w_in[l])
        q_pre, f_pre, i_pre, g_pre, p = jnp.split(z, split_at, axis=-1)

        lb = lower_bounds[l]
        f = lb + (1.0 - lb) * jax.nn.sigmoid(f_pre.astype(f32))
        log_f = jnp.log(f)
        k = 1.0 - f
        q = jax.nn.silu(q_pre.astype(f32))
        hs = lambda a, d: a.reshape(B, S, HGRN_HEADS, d)
        o = hgrn2_chunkwise(hs(q, HGRN_KEY_DIM), hs(k, HGRN_KEY_DIM),
                            hs(i_pre.astype(f32), HGRN_VAL_DIM), hs(log_f, HGRN_KEY_DIM))
        o = o * lax.rsqrt(jnp.mean(o * o, axis=-1, keepdims=True) + EPS) * hgrn_norm_g[l].astype(f32)
        o_a = o.reshape(B, S, HGRN_WIDTH) * jax.nn.silu(g_pre.astype(f32))

        o_b = multiscale_pool(p, w_pool[l], pool_scale[l])

        mixed = jnp.concatenate([o_a, o_b], axis=-1).astype(x.dtype)
        x = x + jnp.einsum('bse,ed->bsd', mixed, w_out[l])

        hq = rmsnorm(x, norm_x_g[l])
        hm = rmsnorm(mem, norm_mem_g[l])
        xq = jnp.einsum('bsd,dhe->bshe', hq, w_xq[l])
        xk = jnp.einsum('bmd,dhe->bmhe', hm, w_xk[l])
        xv = jnp.einsum('bmd,dhe->bmhe', hm, w_xv[l])
        scores = jnp.einsum('bshe,bmhe->bhsm', xq, xk).astype(f32) * (XATTN_HEAD_DIM ** -0.5)
        probs = jax.nn.softmax(scores, axis=-1).astype(x.dtype)
        att = jnp.einsum('bhsm,bmhe->bshe', probs, xv)
        x = x + jnp.einsum('bshe,hed->bsd', att, w_xo[l])

        hf = rmsnorm(x, norm_ffn_g[l])
        u = jnp.square(jax.nn.relu(jnp.einsum('bsd,df->bsf', hf, w_ff1[l])))
        x = x + jnp.einsum('bsf,fd->bsd', u, w_ff2[l])
    return rmsnorm(x, final_norm_g)
```

```cpp
#include <hip/hip_runtime.h>
#include <hip/hip_cooperative_groups.h>
#include <cstdio>
namespace cg = cooperative_groups;

#ifndef N_LAUNCH_MODE
#define N_LAUNCH_MODE 1
#endif

typedef unsigned short bf16_t;
typedef short bf16x8 __attribute__((ext_vector_type(8)));
typedef float f32x2 __attribute__((ext_vector_type(2)));
typedef float f32x4 __attribute__((ext_vector_type(4)));
typedef float f32x16 __attribute__((ext_vector_type(16)));
typedef unsigned u32x2 __attribute__((ext_vector_type(2)));
typedef unsigned u32x4 __attribute__((ext_vector_type(4)));
#define LAS __attribute__((address_space(3)))

constexpr int MROWS = 16384, DM = 1024, SEQ = 4096, NIN = 2560, DFF = 4096, MEMROWS = 1024;
constexpr float EPS = 1e-6f;
constexpr int NTHREADS = 512;
constexpr int LDS_BYTES = 135168;

constexpr size_t MiB = 1u << 20;
constexpr size_t WS_WT_IN = 0, WS_WT_K = 5 * MiB, WS_WT_V = 7 * MiB, WS_WT_OUT = 9 * MiB, WS_WT_Q = 11 * MiB, WS_WT_O = 13 * MiB,
                 WS_WT_FF1 = 15 * MiB, WS_WT_FF2 = 23 * MiB, WS_MEMB = 31 * MiB, WS_KX = 33 * MiB, WS_VT = 35 * MiB, WS_SSQ = 37 * MiB,
                 WS_RSTD0 = 38 * MiB, WS_RSTDM = 38 * MiB + 65536, WS_DEC = 38 * MiB + 131072,
                 WS_XB = 40 * MiB  , WS_QH = 72 * MiB, WS_KH = 88 * MiB, WS_VH = 104 * MiB, WS_GH = 120 * MiB, WS_PH = 136 * MiB,
                 WS_LF = 152 * MiB, WS_ST = 184 * MiB, WS_MIXED = 216 * MiB,
                 WS_X1 = 72 * MiB, WS_XQ = 136 * MiB, WS_ATT = 168 * MiB, WS_U = 72 * MiB, WS_END = 256 * MiB;

typedef __bf16 bf16x2n __attribute__((ext_vector_type(2)));
__device__ __forceinline__ unsigned cvt_pk_bf16(float lo, float hi) { f32x2 v = {lo, hi}; return __builtin_bit_cast(unsigned, __builtin_convertvector(v, bf16x2n)); }
__device__ __forceinline__ bf16_t f2bf(float f) { return (bf16_t)(cvt_pk_bf16(f, 0.f) & 0xffffu); }
__device__ __forceinline__ float bf2f(bf16_t b) { return __uint_as_float(((unsigned)b) << 16); }
__device__ __forceinline__ float bflo(unsigned u) { return __uint_as_float(u << 16); }
__device__ __forceinline__ float bfhi(unsigned u) { return __uint_as_float(u & 0xffff0000u); }
__device__ __forceinline__ f32x4 mfma16(bf16x8 a, bf16x8 b, f32x4 c) { return __builtin_amdgcn_mfma_f32_16x16x32_bf16(a, b, c, 0, 0, 0); }
__device__ __forceinline__ f32x16 mfma32(bf16x8 a, bf16x8 b, f32x16 c) { return __builtin_amdgcn_mfma_f32_32x32x16_bf16(a, b, c, 0, 0, 0); }
__device__ __forceinline__ bf16x8 mk8(u32x2 lo, u32x2 hi) { u32x4 t; t.x = lo.x; t.y = lo.y; t.z = hi.x; t.w = hi.y; return __builtin_bit_cast(bf16x8, t); }
__device__ __forceinline__ bf16x8 mk8u(unsigned a, unsigned b, unsigned c, unsigned d) { u32x4 t; t.x = a; t.y = b; t.z = c; t.w = d; return __builtin_bit_cast(bf16x8, t); }
__device__ __forceinline__ float sigmoidf_(float z) { return 1.0f / (1.0f + __expf(-z)); }

namespace pg8 {
constexpr int BM = 256, BK = 64, HALF = 128, HTB = HALF * BK * 2, STAGE_BYTES = 8 * HTB, NXCD = 8, WGM = 8;
__device__ __forceinline__ int lds_byte(int r, int c) { const int st = (r >> 4) * 2 + (c >> 5), rr = r & 15, cc = c & 31, ob = rr * 64 + cc * 2; return st * 1024 + (ob ^ (((ob >> 9) & 1) << 5)); }
__device__ __forceinline__ void stage_rc(int b, int& R, int& C) { const int st = b / 1024, sb = b % 1024, swz = sb ^ (((sb >> 9) & 1) << 5); R = (st >> 1) * 16 + swz / 64; C = (st & 1) * 32 + (swz % 64) / 2; }
__device__ __forceinline__ int perm32(int rho) { const int n = rho >> 4, i = rho & 15; return 8 * (i >> 2) + 4 * n + (i & 3); }
struct Unit { int pm, pn; };
struct Gemm { const bf16_t* A; const bf16_t* Bt; int M, N, K; };
struct StaticOrder {
    int nM, nN, nwg, G, c;
    __device__ void init(int M, int N, int G_, int c_) { nM = M / BM; nN = N / BM; nwg = nM * nN; G = G_; c = c_; }
    __device__ bool next(int i, Unit& u) const {
        const long L = (long)i * G + c; if (L >= nwg) return false;
        int wgid = (int)L; { const int q = nwg / NXCD, r = nwg % NXCD, xcd = wgid % NXCD, off = wgid / NXCD; wgid = (xcd < r ? xcd * (q + 1) : r * (q + 1) + (xcd - r) * q) + off; }
        const int nig = WGM * nN, gid = wgid / nig, fm = gid * WGM, gsz = (nM - fm) < WGM ? (nM - fm) : WGM;
        u.pm = fm + ((wgid % nig) % gsz); u.pn = (wgid % nig) / gsz; return true;
    }
};

struct Epi {
    static constexpr bool PERM = true;
    int mode;
    unsigned char* ws; const float* x; float* out; const float* lbl;
    __device__ __forceinline__ void store8(bf16_t* p, const f32x4& v0, const f32x4& v1) const {
        u32x4 w; w.x = cvt_pk_bf16(v0[0], v0[1]); w.y = cvt_pk_bf16(v0[2], v0[3]); w.z = cvt_pk_bf16(v1[0], v1[1]); w.w = cvt_pk_bf16(v1[2], v1[3]); *(u32x4*)p = w; }
    __device__ __forceinline__ void operator()(const f32x4 (&acc)[2][2][4][2], const Unit& u, int wr, int wc, int fr, int fq) const {
        const int row0 = u.pm * BM + wr * 64 + fr;
        const int colL = wc * 32 + 8 * fq;
        if (mode == 0) {
            const float* rs = (const float*)(ws + WS_RSTD0);
            float* lf = (float*)(ws + WS_LF); bf16_t* kh = (bf16_t*)(ws + WS_KH);
            const int sub = u.pn >> 1; const int cb = (u.pn & 1) * 256 + colL;
            if (sub == 1) {
                float oml[2][8];
#pragma unroll
                for (int bj = 0; bj < 2; ++bj)
#pragma unroll
                    for (int j = 0; j < 8; ++j) { const int c = cb + bj * HALF + j; const float l0 = lbl[c], l1 = lbl[512 + c]; const float lb = 1.0f / (1.0f + __expf(l1 - l0)); oml[bj][j] = 1.0f - lb; }
#pragma unroll
                for (int ai = 0; ai < 2; ++ai)
#pragma unroll
                    for (int m = 0; m < 4; ++m) { const int row = row0 + ai * HALF + m * 16; const float r = rs[row];
#pragma unroll
                        for (int bj = 0; bj < 2; ++bj) { f32x4 lf0, lf1, k0, k1;
#pragma unroll
                            for (int j = 0; j < 4; ++j) {
                                const float za = acc[ai][bj][m][0][j] * r, zb = acc[ai][bj][m][1][j] * r;
                                const float ka = oml[bj][j] * (1.0f - sigmoidf_(za)), kb = oml[bj][4 + j] * (1.0f - sigmoidf_(zb));
                                k0[j] = ka; k1[j] = kb; lf0[j] = __logf(1.0f - ka); lf1[j] = __logf(1.0f - kb); }
                            const size_t o = (size_t)row * 512 + cb + bj * HALF;
                            *(f32x4*)(lf + o) = lf0; *(f32x4*)(lf + o + 4) = lf1; store8(kh + o, k0, k1); } }
            } else {
                bf16_t* dst = (bf16_t*)(ws + (sub == 0 ? WS_QH : (sub == 2 ? WS_VH : (sub == 3 ? WS_GH : WS_PH))));
                const bool act = (sub == 0) || (sub == 3);
#pragma unroll
                for (int ai = 0; ai < 2; ++ai)
#pragma unroll
                    for (int m = 0; m < 4; ++m) { const int row = row0 + ai * HALF + m * 16; const float r = rs[row];
#pragma unroll
                        for (int bj = 0; bj < 2; ++bj) { f32x4 v0 = acc[ai][bj][m][0] * r, v1 = acc[ai][bj][m][1] * r;
                            if (act) {
#pragma unroll
                                for (int j = 0; j < 4; ++j) { v0[j] = v0[j] * sigmoidf_(v0[j]); v1[j] = v1[j] * sigmoidf_(v1[j]); } }
                            store8(dst + (size_t)row * 512 + cb + bj * HALF, v0, v1); } }
            }
        } else if (mode == 3 || mode == 6 || mode == 7) {
            const int col0 = u.pn * BM + colL;
            const float* resid = mode == 3 ? x : (mode == 6 ? (const float*)(ws + WS_X1) : (const float*)out);
            float* of = mode == 3 ? (float*)(ws + WS_X1) : out;
            bf16_t* ob = mode == 7 ? nullptr : (bf16_t*)(ws + WS_XB);
            float* ssq = mode == 7 ? nullptr : (float*)(ws + WS_SSQ);
#pragma unroll
            for (int ai = 0; ai < 2; ++ai)
#pragma unroll
                for (int m = 0; m < 4; ++m) { const int row = row0 + ai * HALF + m * 16; float ss = 0.f;
#pragma unroll
                    for (int bj = 0; bj < 2; ++bj) { const size_t o = (size_t)row * DM + col0 + bj * HALF;
                        const f32x4 v0 = acc[ai][bj][m][0] + *(const f32x4*)(resid + o), v1 = acc[ai][bj][m][1] + *(const f32x4*)(resid + o + 4);
                        *(f32x4*)(of + o) = v0; *(f32x4*)(of + o + 4) = v1;
                        if (ob) store8(ob + o, v0, v1);
                        ss += (v0[0] * v0[0] + v0[1] * v0[1]) + (v0[2] * v0[2] + v0[3] * v0[3]) + (v1[0] * v1[0] + v1[1] * v1[1]) + (v1[2] * v1[2] + v1[3] * v1[3]); }
                    ss += __shfl_xor(ss, 16); ss += __shfl_xor(ss, 32);
                    if (ssq && fq == 0) ssq[(size_t)row * 16 + u.pn * 4 + wc] = ss; }
        } else if (mode == 2) {
            const int col0 = u.pn * BM + colL;
            const float* rs = (const float*)(ws + WS_RSTDM); bf16_t* ob = (bf16_t*)(ws + WS_VT); const int ldo = 1024;
            f32x4 c0[2], c1[2];
#pragma unroll
            for (int bj = 0; bj < 2; ++bj) { c0[bj] = *(const f32x4*)(rs + col0 + bj * HALF); c1[bj] = *(const f32x4*)(rs + col0 + bj * HALF + 4); }
#pragma unroll
            for (int ai = 0; ai < 2; ++ai)
#pragma unroll
                for (int m = 0; m < 4; ++m) { const int row = row0 + ai * HALF + m * 16;
#pragma unroll
                    for (int bj = 0; bj < 2; ++bj) store8(ob + (size_t)row * ldo + col0 + bj * HALF, acc[ai][bj][m][0] * c0[bj], acc[ai][bj][m][1] * c1[bj]); }
        } else {
            const int col0 = u.pn * BM + colL;
            const float* rs = mode == 1 ? (const float*)(ws + WS_RSTDM) : (const float*)(ws + WS_SSQ);
            bf16_t* ob = (bf16_t*)(ws + (mode == 1 ? WS_KX : (mode == 4 ? WS_XQ : WS_U))); const int ldo = mode == 5 ? DFF : 1024;
            const float cs = mode == 4 ? 0.0625f : 1.0f;
#pragma unroll
            for (int ai = 0; ai < 2; ++ai)
#pragma unroll
                for (int m = 0; m < 4; ++m) { const int row = row0 + ai * HALF + m * 16; float r;
                    if (mode == 1) r = rs[row];
                    else { const f32x4* p = (const f32x4*)(rs + (size_t)row * 16); const f32x4 a = p[0], b = p[1], c = p[2], d = p[3];
                        const float t = ((a[0] + a[1]) + (a[2] + a[3])) + ((b[0] + b[1]) + (b[2] + b[3])) + ((c[0] + c[1]) + (c[2] + c[3])) + ((d[0] + d[1]) + (d[2] + d[3]));
                        r = rsqrtf(t * (1.0f / 1024.0f) + EPS) * cs; }
#pragma unroll
                    for (int bj = 0; bj < 2; ++bj) { f32x4 v0 = acc[ai][bj][m][0] * r, v1 = acc[ai][bj][m][1] * r;
                        if (mode == 5) {
#pragma unroll
                            for (int j = 0; j < 4; ++j) { const float a = fmaxf(v0[j], 0.f), b = fmaxf(v1[j], 0.f); v0[j] = a * a; v1[j] = b * b; } }
                        store8(ob + (size_t)row * ldo + col0 + bj * HALF, v0, v1); } }
        }
    }
};

template <class EpiT, class Sched>
__device__ __forceinline__ void gemm_phase(LAS unsigned char* lds, const Gemm g, const Sched S, const EpiT E) {
    const int tid = threadIdx.x, wid = __builtin_amdgcn_readfirstlane(tid >> 6), lane = tid & 63, wr = wid >> 2, wc = wid & 3, fr = lane & 15, fq = lane >> 4;
    const int K = g.K, nt = K / BK;
    unsigned voffA[2], voffB[2];
#pragma unroll
    for (int i = 0; i < 2; ++i) { int R, C; stage_rc(tid * 16 + i * 8192, R, C); const int Rb = EpiT::PERM ? ((R & ~31) + perm32(R & 31)) : R;
        voffA[i] = (unsigned)(R * K + C) * 2u; voffB[i] = (unsigned)(Rb * K + C) * 2u; }
    const size_t kstep = (size_t)(BK * 2);
    const size_t hstep = (size_t)HALF * K * 2;
    const size_t tstep = 2 * hstep;
    const unsigned ldsw = (unsigned)wid * 1024u;
    const int aoff = lds_byte(wr * 64 + fr, fq * 8), boff = lds_byte(wc * 32 + fr, fq * 8);
#define PG8_SA(b, h) (((b) * 2 + (h)) * HTB)
#define PG8_SB(b, h) ((4 + (b) * 2 + (h)) * HTB)
#define PG8_STAGE(bufoff, gbase, voff) do { _Pragma("unroll") for (int _i = 0; _i < 2; ++_i) \
        __builtin_amdgcn_global_load_lds((const unsigned*)((const char*)(gbase) + (voff)[_i]), (LAS unsigned*)(lds + (bufoff) + ldsw + _i * 8192), 16, 0, 0); } while (0)
#define PG8_LDA(dst, b, h) do { _Pragma("unroll") for (int m = 0; m < 4; ++m) _Pragma("unroll") for (int k = 0; k < 2; ++k) dst[m][k] = *(const LAS bf16x8*)(lds + PG8_SA(b, h) + aoff + m * 2048 + k * 1024); } while (0)
#define PG8_LDB(dst, b, h) do { _Pragma("unroll") for (int n = 0; n < 2; ++n) _Pragma("unroll") for (int k = 0; k < 2; ++k) dst[n][k] = *(const LAS bf16x8*)(lds + PG8_SB(b, h) + boff + n * 2048 + k * 1024); } while (0)
#define PG8_MMA(ai, bj, At, Bt) do { __builtin_amdgcn_s_setprio(1); _Pragma("unroll") for (int m = 0; m < 4; ++m) _Pragma("unroll") for (int n = 0; n < 2; ++n) _Pragma("unroll") for (int k = 0; k < 2; ++k) \
        acc[ai][bj][m][n] = __builtin_amdgcn_mfma_f32_16x16x32_bf16(Bt[n][k], At[m][k], acc[ai][bj][m][n], 0, 0, 0); __builtin_amdgcn_s_setprio(0); } while (0)
#define PG8_WAIT_V(n) asm volatile("s_waitcnt vmcnt(" #n ")" ::: "memory")
#define PG8_WAIT_L(n) asm volatile("s_waitcnt lgkmcnt(" #n ")" ::: "memory")
#define PG8_BAR __builtin_amdgcn_s_barrier()
#define PG8_SCHED __builtin_amdgcn_sched_barrier(0)
    Unit cur, nxt; int ui = 0;
    if (!S.next(0, cur)) return;
    f32x4 acc[2][2][4][2];
#pragma unroll
    for (int a = 0; a < 2; ++a)
#pragma unroll
        for (int b = 0; b < 2; ++b)
#pragma unroll
            for (int m = 0; m < 4; ++m)
#pragma unroll
                for (int n = 0; n < 2; ++n) acc[a][b][m][n] = (f32x4){0.f, 0.f, 0.f, 0.f};
    bf16x8 At[4][2], B0[2][2], B1[2][2];
    const char* cA = (const char*)g.A + (size_t)cur.pm * tstep; const char* cB = (const char*)g.Bt + (size_t)cur.pn * tstep;
    PG8_STAGE(PG8_SB(0, 0), cB, voffB); PG8_STAGE(PG8_SA(0, 0), cA, voffA); PG8_STAGE(PG8_SB(0, 1), cB + hstep, voffB); PG8_STAGE(PG8_SA(0, 1), cA + hstep, voffA);
    if (wr == 1) PG8_BAR;
    PG8_WAIT_V(4); PG8_BAR;
    PG8_STAGE(PG8_SB(1, 0), cB + kstep, voffB); PG8_STAGE(PG8_SA(1, 0), cA + kstep, voffA); PG8_STAGE(PG8_SB(1, 1), cB + hstep + kstep, voffB);
    PG8_WAIT_V(6); PG8_BAR;
    for (;;) {
        const bool has_next = S.next(ui + 1, nxt);
        const char* nA = has_next ? (const char*)g.A + (size_t)nxt.pm * tstep : cA; const char* nB = has_next ? (const char*)g.Bt + (size_t)nxt.pn * tstep : cB;
        for (int t = 0; t < nt; t += 2) {
            const bool last = (t == nt - 2);
            const char* a1 = cA + (size_t)(t + 1) * kstep;
            const char* a2 = last ? nA : cA + (size_t)(t + 2) * kstep; const char* b2 = last ? nB : cB + (size_t)(t + 2) * kstep;
            const char* a3 = a2 + kstep; const char* b3 = b2 + kstep;
            PG8_LDB(B0, 0, 0); PG8_SCHED; PG8_LDA(At, 0, 0); PG8_STAGE(PG8_SA(1, 1), a1 + hstep, voffA);
            PG8_WAIT_L(8); PG8_BAR; PG8_WAIT_L(0); PG8_MMA(0, 0, At, B0); PG8_BAR; PG8_SCHED;
            PG8_LDB(B1, 0, 1); PG8_STAGE(PG8_SB(0, 0), b2, voffB);
            PG8_BAR; PG8_WAIT_L(0); PG8_MMA(0, 1, At, B1); PG8_BAR;
            PG8_LDA(At, 0, 1); PG8_STAGE(PG8_SA(0, 0), a2, voffA);
            PG8_BAR; PG8_WAIT_L(0); PG8_MMA(1, 0, At, B0); PG8_BAR; PG8_SCHED;
            PG8_STAGE(PG8_SB(0, 1), b2 + hstep, voffB);
            PG8_WAIT_V(6); PG8_BAR; PG8_MMA(1, 1, At, B1); PG8_BAR;
            PG8_LDB(B0, 1, 0); PG8_SCHED; PG8_LDA(At, 1, 0); PG8_STAGE(PG8_SA(0, 1), a2 + hstep, voffA);
            PG8_WAIT_L(8); PG8_BAR; PG8_WAIT_L(0); PG8_MMA(0, 0, At, B0); PG8_BAR; PG8_SCHED;
            PG8_LDB(B1, 1, 1); PG8_STAGE(PG8_SB(1, 0), b3, voffB);
            PG8_BAR; PG8_WAIT_L(0); PG8_MMA(0, 1, At, B1); PG8_BAR;
            PG8_LDA(At, 1, 1); PG8_STAGE(PG8_SA(1, 0), a3, voffA);
            PG8_BAR; PG8_WAIT_L(0); PG8_MMA(1, 0, At, B0); PG8_BAR; PG8_SCHED;
            PG8_STAGE(PG8_SB(1, 1), b3 + hstep, voffB);
            PG8_WAIT_V(6); PG8_BAR; PG8_MMA(1, 1, At, B1); PG8_BAR;
        }
        E(acc, cur, wr, wc, fr, fq);
        if (!has_next) break;
#pragma unroll
        for (int a = 0; a < 2; ++a)
#pragma unroll
            for (int b = 0; b < 2; ++b)
#pragma unroll
                for (int m = 0; m < 4; ++m)
#pragma unroll
                    for (int n = 0; n < 2; ++n) acc[a][b][m][n] = (f32x4){0.f, 0.f, 0.f, 0.f};
        cur = nxt; cA = nA; cB = nB; ++ui;
    }
    PG8_WAIT_V(0);
    if (wr == 0) PG8_BAR;
    PG8_BAR;
#undef PG8_SA
#undef PG8_SB
#undef PG8_STAGE
#undef PG8_LDA
#undef PG8_LDB
#undef PG8_MMA
#undef PG8_WAIT_V
#undef PG8_WAIT_L
#undef PG8_BAR
#undef PG8_SCHED
}
}

struct Params {
    const float *x, *mem, *norm_mix_g, *w_in, *lb_logits, *hgrn_norm_g, *w_pool, *pool_scale, *w_out, *norm_x_g, *norm_mem_g, *w_xq, *w_xk, *w_xv, *w_xo, *norm_ffn_g, *w_ff1, *w_ff2, *final_norm_g;
    float* out; unsigned char* ws;
    int ph_lo, ph_hi;
};

__device__ __forceinline__ void prep_transpose_tile(const float* __restrict__ W, int N, const float* __restrict__ g, bf16_t* __restrict__ out, int ldo, int kt, int nt, unsigned char* lds) {
    bf16_t* T = (bf16_t*)lds;
    const int tid = threadIdx.x, r = tid >> 4, c4 = tid & 15;
#pragma unroll
    for (int i = 0; i < 4; ++i) {
        const int kl = r + 32 * i, k = 128 * kt + kl;
        const f32x4 v = *(const f32x4*)(W + (size_t)k * N + 64 * nt + 4 * c4);
        const float s = g ? g[k] : 1.0f;
        T[(4 * c4 + 0) * 136 + kl] = f2bf(v[0] * s); T[(4 * c4 + 1) * 136 + kl] = f2bf(v[1] * s);
        T[(4 * c4 + 2) * 136 + kl] = f2bf(v[2] * s); T[(4 * c4 + 3) * 136 + kl] = f2bf(v[3] * s);
    }
    __syncthreads();
    const int n = tid >> 3, ks = tid & 7;
    const u32x4* src = (const u32x4*)(T + n * 136 + 16 * ks);
    const u32x4 a = src[0], b = src[1];
    u32x4* dst = (u32x4*)(out + (size_t)(64 * nt + n) * ldo + 128 * kt + 16 * ks);
    dst[0] = a; dst[1] = b;
    __syncthreads();
}

__device__ __forceinline__ void phase_prep(const Params p, unsigned char* lds) {
    unsigned char* ws = p.ws;
    const int G = gridDim.x;
    for (int t = blockIdx.x; t < 1920; t += G) {
        if (t < 320)       { prep_transpose_tile(p.w_in, NIN, p.norm_mix_g, (bf16_t*)(ws + WS_WT_IN), 1024, t / 40, t % 40, lds); }
        else if (t < 448)  { const int u = t - 320;  prep_transpose_tile(p.w_xk, 1024, p.norm_mem_g, (bf16_t*)(ws + WS_WT_K), 1024, u / 16, u % 16, lds); }
        else if (t < 576)  { const int u = t - 448;  prep_transpose_tile(p.w_xv, 1024, p.norm_mem_g, (bf16_t*)(ws + WS_WT_V), 1024, u / 16, u % 16, lds); }
        else if (t < 704)  { const int u = t - 576;  prep_transpose_tile(p.w_xq, 1024, p.norm_x_g, (bf16_t*)(ws + WS_WT_Q), 1024, u / 16, u % 16, lds); }
        else if (t < 832)  { const int u = t - 704;  prep_transpose_tile(p.w_xo, 1024, nullptr, (bf16_t*)(ws + WS_WT_O), 1024, u / 16, u % 16, lds); }
        else if (t < 896)  { const int u = t - 832;  prep_transpose_tile(p.w_out, 1024, nullptr, (bf16_t*)(ws + WS_WT_OUT), 1024, u / 16, u % 16, lds); }
        else if (t < 1408) { const int u = t - 896;  prep_transpose_tile(p.w_ff1, DFF, p.norm_ffn_g, (bf16_t*)(ws + WS_WT_FF1), 1024, u / 64, u % 64, lds); }
        else               { const int u = t - 1408; prep_transpose_tile(p.w_ff2, 1024, nullptr, (bf16_t*)(ws + WS_WT_FF2), 4096, u / 16, u % 16, lds); }
    }
    {
        bf16_t* wto = (bf16_t*)(ws + WS_WT_OUT);
        for (int item = blockIdx.x * NTHREADS + threadIdx.x; item < 65536; item += G * NTHREADS) {
            const int n = item & 1023, cgp = item >> 10, gi = cgp >> 4, c0 = (cgp & 15) * 8;
            float a[8];
#pragma unroll
            for (int j = 0; j < 8; ++j) a[j] = 0.f;
            const float* wp = p.w_pool + (size_t)(gi * 128 + c0) * 128;
            for (int d = 0; d < 128; ++d) {
                const float wo = p.w_out[(size_t)(512 + gi * 128 + d) * 1024 + n] * p.pool_scale[gi * 128 + d];
#pragma unroll
                for (int j = 0; j < 8; ++j) a[j] += wp[j * 128 + d] * wo;
            }
            u32x4 w; w.x = cvt_pk_bf16(a[0], a[1]); w.y = cvt_pk_bf16(a[2], a[3]); w.z = cvt_pk_bf16(a[4], a[5]); w.w = cvt_pk_bf16(a[6], a[7]);
            *(u32x4*)(wto + (size_t)n * 1024 + 512 + gi * 128 + c0) = w;
        }
    }
    {
        const int lane = threadIdx.x & 63, gw = blockIdx.x * (NTHREADS / 64) + (threadIdx.x >> 6), nw = G * (NTHREADS / 64);
        for (int r = gw; r < MROWS + MEMROWS; r += nw) {
            const bool isx = r < MROWS;
            const float* src = isx ? p.x + (size_t)r * DM : p.mem + (size_t)(r - MROWS) * DM;
            bf16_t* dst = isx ? (bf16_t*)(ws + WS_XB) + (size_t)r * DM : (bf16_t*)(ws + WS_MEMB) + (size_t)(r - MROWS) * DM;
            f32x4 v[4]; float ss = 0.f;
#pragma unroll
            for (int i = 0; i < 4; ++i) { v[i] = ((const f32x4*)src)[lane + 64 * i]; ss += (v[i][0] * v[i][0] + v[i][1] * v[i][1]) + (v[i][2] * v[i][2] + v[i][3] * v[i][3]); }
#pragma unroll
            for (int o = 1; o < 64; o <<= 1) ss += __shfl_xor(ss, o);
#pragma unroll
            for (int i = 0; i < 4; ++i) { u32x2 w; w.x = cvt_pk_bf16(v[i][0], v[i][1]); w.y = cvt_pk_bf16(v[i][2], v[i][3]); ((u32x2*)dst)[lane + 64 * i] = w; }
            if (lane == 0) { const float rstd = rsqrtf(ss * (1.0f / 1024.0f) + EPS); if (isx) ((float*)(ws + WS_RSTD0))[r] = rstd; else ((float*)(ws + WS_RSTDM))[r - MROWS] = rstd; }
        }
    }
}

__device__ void hgrn_passA_unit(const bf16_t* __restrict__ KH, const float* __restrict__ LF, const bf16_t* __restrict__ VH, bf16_t* __restrict__ LT, float* __restrict__ DEC, int unit, unsigned char* lds) {
    const int tid = threadIdx.x, ch = tid & 127, seg = tid >> 7;
    const int b = unit >> 8, c = (unit >> 2) & 63, h = unit & 3;
    const int row0 = b * SEQ + c * 64, bh = b * 4 + h;
    float* segtot = (float*)lds;
    unsigned char* KdT = lds + 2048;
    unsigned char* VTl = lds + 2048 + 18432;
    const size_t g0 = (size_t)(row0 + seg * 16) * 512 + h * 128 + ch;
    float lf[16], kk[16], vv[16];
#pragma unroll
    for (int i = 0; i < 16; ++i) { lf[i] = LF[g0 + (size_t)i * 512]; kk[i] = bf2f(KH[g0 + (size_t)i * 512]); vv[i] = bf2f(VH[g0 + (size_t)i * 512]); }
#pragma unroll
    for (int i = 1; i < 16; ++i) lf[i] += lf[i - 1];
    segtot[seg * 128 + ch] = lf[15];
    __syncthreads();
    float after = 0.f;
#pragma unroll
    for (int s2 = 1; s2 < 4; ++s2) if (s2 > seg) after += segtot[s2 * 128 + ch];
    const float tot = after + lf[15];
    if (seg == 0) DEC[(size_t)(bh * 64 + c) * 128 + ch] = __expf(tot);
    unsigned kd[8], vp[8];
#pragma unroll
    for (int i = 0; i < 8; ++i) {
        kd[i] = cvt_pk_bf16(kk[2 * i] * __expf(tot - lf[2 * i]), kk[2 * i + 1] * __expf(tot - lf[2 * i + 1]));
        vp[i] = cvt_pk_bf16(vv[2 * i], vv[2 * i + 1]);
    }
    { u32x4* d = (u32x4*)(KdT + ch * 144 + seg * 32); d[0] = (u32x4){kd[0], kd[1], kd[2], kd[3]}; d[1] = (u32x4){kd[4], kd[5], kd[6], kd[7]}; }
    { u32x4* d = (u32x4*)(VTl + ch * 144 + seg * 32); d[0] = (u32x4){vp[0], vp[1], vp[2], vp[3]}; d[1] = (u32x4){vp[4], vp[5], vp[6], vp[7]}; }
    __syncthreads();
    const int w = tid >> 6, lane = tid & 63, fr = lane & 15, q = lane >> 4;
    bf16x8 a[2];
#pragma unroll
    for (int ks = 0; ks < 2; ++ks) a[ks] = *(const bf16x8*)(KdT + (16 * w + fr) * 144 + (32 * ks + 8 * q) * 2);
    bf16_t* ltp = LT + (size_t)(bh * 64 + c) * 16384;
#pragma unroll
    for (int vb = 0; vb < 8; ++vb) {
        f32x4 acc = (f32x4){0.f, 0.f, 0.f, 0.f};
#pragma unroll
        for (int ks = 0; ks < 2; ++ks) { const bf16x8 bfr = *(const bf16x8*)(VTl + (16 * vb + fr) * 144 + (32 * ks + 8 * q) * 2); acc = mfma16(a[ks], bfr, acc); }
        u32x2 pk; pk.x = cvt_pk_bf16(acc[0], acc[1]); pk.y = cvt_pk_bf16(acc[2], acc[3]);
        *(u32x2*)(ltp + (size_t)(16 * vb + fr) * 128 + 16 * w + 4 * q) = pk;
    }
    __syncthreads();
}

__device__ void pool_tile(const bf16_t* __restrict__ PH, bf16_t* __restrict__ MIXED, int tile) {
    const int tid = threadIdx.x, cp = tid & 255, th = tid >> 8, c0 = 2 * cp, gi = c0 >> 7, w = 2 << gi;
    const int r0 = tile * 64 + th * 32, s0 = r0 & (SEQ - 1);
    float sx = 0.f, sy = 0.f;
    for (int j = 1; j < w; ++j) if (s0 - j >= 0) { const unsigned u = *(const unsigned*)(PH + (size_t)(r0 - j) * 512 + c0); sx += bflo(u); sy += bfhi(u); }
    for (int tt = 0; tt < 32; ++tt) {
        const int r = r0 + tt, s = s0 + tt;
        const unsigned u = *(const unsigned*)(PH + (size_t)r * 512 + c0);
        const float px = bflo(u), py = bfhi(u);
        sx += px; sy += py;
        const int cnt = (s + 1) < w ? (s + 1) : w;
        const float inv = 1.0f / (float)cnt;
        *(unsigned*)(MIXED + (size_t)r * 1024 + 512 + c0) = cvt_pk_bf16(sx * inv - px, sy * inv - py);
        if (s - (w - 1) >= 0) { const unsigned u2 = *(const unsigned*)(PH + (size_t)(r - (w - 1)) * 512 + c0); sx -= bflo(u2); sy -= bfhi(u2); }
    }
}

__device__ void phase_scan(const bf16_t* __restrict__ LT, const float* __restrict__ DEC, bf16_t* __restrict__ ST) {
    for (int e2 = blockIdx.x * NTHREADS + threadIdx.x; e2 < 131072; e2 += gridDim.x * NTHREADS) {
        const int bh = e2 >> 13, v = (e2 >> 6) & 127, kp = e2 & 63;
        float sx = 0.f, sy = 0.f;
        const size_t base = (size_t)bh * 64 * 16384 + (size_t)v * 128 + 2 * kp;
        const float* dp = DEC + (size_t)bh * 64 * 128 + 2 * kp;
        for (int c0 = 0; c0 < 64; c0 += 8) {
            unsigned l[8]; f32x2 d[8];
#pragma unroll
            for (int j = 0; j < 8; ++j) { l[j] = *(const unsigned*)(LT + base + (size_t)(c0 + j) * 16384); d[j] = *(const f32x2*)(dp + (c0 + j) * 128); }
#pragma unroll
            for (int j = 0; j < 8; ++j) {
                *(unsigned*)(ST + base + (size_t)(c0 + j) * 16384) = cvt_pk_bf16(sx, sy);
                sx = d[j][0] * sx + bflo(l[j]); sy = d[j][1] * sy + bfhi(l[j]);
            }
        }
    }
}

__device__ void hgrn_passC_unit(const bf16_t* __restrict__ QH, const bf16_t* __restrict__ KH, const float* __restrict__ LF, const bf16_t* __restrict__ VH, const bf16_t* __restrict__ GH,
                                const bf16_t* __restrict__ ST, const float* __restrict__ hg, bf16_t* __restrict__ MIXED, int unit, unsigned char* lds) {
    const int tid = threadIdx.x, ch = tid & 127, seg = tid >> 7;
    const int b = unit >> 8, c = (unit >> 2) & 63, h = unit & 3;
    const int row0 = b * SEQ + c * 64, bh = b * 4 + h;
    float* segtot = (float*)lds;
    float* rmsp = (float*)(lds + 2048);
    bf16_t* QC = (bf16_t*)(lds + 4096);
    bf16_t* QT = (bf16_t*)(lds + 21504);
    constexpr int KT0 = 38912;
    unsigned char* VTl = lds + 82432;
    const size_t g0 = (size_t)(row0 + seg * 16) * 512 + h * 128 + ch;
    float lf[16];
#pragma unroll
    for (int i = 0; i < 16; ++i) lf[i] = LF[g0 + (size_t)i * 512];
#pragma unroll
    for (int i = 1; i < 16; ++i) lf[i] += lf[i - 1];
    segtot[seg * 128 + ch] = lf[15];
    {
        unsigned vp[8];
#pragma unroll
        for (int i = 0; i < 8; ++i) vp[i] = (unsigned)VH[g0 + (size_t)(2 * i) * 512] | ((unsigned)VH[g0 + (size_t)(2 * i + 1) * 512] << 16);
        u32x4* d = (u32x4*)(VTl + ch * 144 + seg * 32); d[0] = (u32x4){vp[0], vp[1], vp[2], vp[3]}; d[1] = (u32x4){vp[4], vp[5], vp[6], vp[7]};
    }
    __syncthreads();
    const float t0 = segtot[ch], t1 = segtot[128 + ch], t2 = segtot[256 + ch];
    const float P = (seg > 0 ? t0 : 0.f) + (seg > 1 ? t1 : 0.f) + (seg > 2 ? t2 : 0.f);
    {
#pragma unroll
        for (int i = 0; i < 16; ++i) {
            const float qv = bf2f(QH[g0 + (size_t)i * 512]);
            const float el = __expf(lf[i]);
            QT[(seg * 16 + i) * 136 + ch] = f2bf(qv * el);
            QC[(seg * 16 + i) * 136 + ch] = f2bf(qv * el * __expf(P));
        }
        float kk[16];
#pragma unroll
        for (int i = 0; i < 16; ++i) kk[i] = bf2f(KH[g0 + (size_t)i * 512]);
        float E = 0.f;
#pragma unroll
        for (int i = 0; i < 4; ++i) {
            if (i >= seg) {
                bf16_t* KT = (bf16_t*)(lds + KT0 + 4352 * ((i * (i + 1)) / 2));
#pragma unroll
                for (int j = 0; j < 16; ++j) KT[(seg * 16 + j) * 136 + ch] = f2bf(kk[j] * __expf(E - lf[j]));
                E += (i == 0 ? t0 : (i == 1 ? t1 : t2));
            }
        }
    }
    __syncthreads();
    const int w = tid >> 6, lane = tid & 63, fr = lane & 15, q = lane >> 4;
    const int i = w & 3, vh = w >> 2;
    f32x4 sT[4];
#pragma unroll
    for (int j = 0; j < 4; ++j) sT[j] = (f32x4){0.f, 0.f, 0.f, 0.f};
    {
        bf16x8 qfr[4];
#pragma unroll
        for (int ks = 0; ks < 4; ++ks) qfr[ks] = *(const bf16x8*)((const unsigned char*)QT + (16 * i + fr) * 272 + (32 * ks + 8 * q) * 2);
        const unsigned char* KT = lds + KT0 + 4352 * ((i * (i + 1)) / 2);
#pragma unroll
        for (int j = 0; j < 4; ++j) if (j <= i) {
#pragma unroll
            for (int ks = 0; ks < 4; ++ks) { const bf16x8 a = *(const bf16x8*)(KT + (16 * j + fr) * 272 + (32 * ks + 8 * q) * 2); sT[j] = mfma16(a, qfr[ks], sT[j]); }
            if (j == i) {
#pragma unroll
                for (int rg = 0; rg < 4; ++rg) if (4 * q + rg > fr) sT[j][rg] = 0.f;
            }
        }
    }
    f32x4 oacc[4];
#pragma unroll
    for (int vbl = 0; vbl < 4; ++vbl) oacc[vbl] = (f32x4){0.f, 0.f, 0.f, 0.f};
#pragma unroll
    for (int m = 0; m < 2; ++m) if (2 * m <= i) {
        const bf16x8 bfrag = mk8u(cvt_pk_bf16(sT[2 * m][0], sT[2 * m][1]), cvt_pk_bf16(sT[2 * m][2], sT[2 * m][3]), cvt_pk_bf16(sT[2 * m + 1][0], sT[2 * m + 1][1]), cvt_pk_bf16(sT[2 * m + 1][2], sT[2 * m + 1][3]));
#pragma unroll
        for (int vbl = 0; vbl < 4; ++vbl) {
            const unsigned char* base = VTl + (16 * (vh * 4 + vbl) + fr) * 144 + (32 * m + 4 * q) * 2;
            const bf16x8 a = mk8(*(const u32x2*)base, *(const u32x2*)(base + 32));
            oacc[vbl] = mfma16(a, bfrag, oacc[vbl]);
        }
    }
    {
        const bf16_t* stp = ST + (size_t)(bh * 64 + c) * 16384;
#pragma unroll
        for (int ks = 0; ks < 4; ++ks) {
            const bf16x8 bfr = *(const bf16x8*)((const unsigned char*)QC + (16 * i + fr) * 272 + (32 * ks + 8 * q) * 2);
#pragma unroll
            for (int vbl = 0; vbl < 4; ++vbl) { const bf16x8 a = *(const bf16x8*)(stp + (size_t)(16 * (vh * 4 + vbl) + fr) * 128 + 32 * ks + 8 * q); oacc[vbl] = mfma16(a, bfr, oacc[vbl]); }
        }
    }
    float ss = 0.f;
#pragma unroll
    for (int vbl = 0; vbl < 4; ++vbl) ss += (oacc[vbl][0] * oacc[vbl][0] + oacc[vbl][1] * oacc[vbl][1]) + (oacc[vbl][2] * oacc[vbl][2] + oacc[vbl][3] * oacc[vbl][3]);
    ss += __shfl_xor(ss, 16); ss += __shfl_xor(ss, 32);
    if (q == 0) rmsp[vh * 64 + 16 * i + fr] = ss;
    __syncthreads();
    const float rstd = rsqrtf((rmsp[16 * i + fr] + rmsp[64 + 16 * i + fr]) * (1.0f / 128.0f) + EPS);
    const size_t row = (size_t)(row0 + 16 * i + fr);
#pragma unroll
    for (int vbl = 0; vbl < 4; ++vbl) {
        const int v0 = 16 * (vh * 4 + vbl) + 4 * q;
        const u32x2 gt = *(const u32x2*)(GH + row * 512 + h * 128 + v0);
        const f32x4 gg = *(const f32x4*)(hg + h * 128 + v0);
        u32x2 o;
        o.x = cvt_pk_bf16(oacc[vbl][0] * rstd * gg[0] * bflo(gt.x), oacc[vbl][1] * rstd * gg[1] * bfhi(gt.x));
        o.y = cvt_pk_bf16(oacc[vbl][2] * rstd * gg[2] * bflo(gt.y), oacc[vbl][3] * rstd * gg[3] * bfhi(gt.y));
        *(u32x2*)(MIXED + row * 1024 + h * 128 + v0) = o;
    }
    __syncthreads();
}

__device__ void attn_unit(const bf16_t* __restrict__ XQ, const bf16_t* __restrict__ KX, const bf16_t* __restrict__ VT, bf16_t* __restrict__ ATT, int unit, unsigned char* lds) {
    const int tid = threadIdx.x, w = tid >> 6, lane = tid & 63, r = lane & 31, hh = lane >> 5;
    const int b = unit >> 6, st = (unit >> 2) & 15, h = unit & 3;
    const int row0 = b * SEQ + st * 256;
    const bf16_t* qp = XQ + (size_t)(row0 + 32 * w + r) * 1024 + h * 256 + 8 * hh;
    {
        const bf16_t* kp = KX + (size_t)(b * 256) * 1024 + h * 256;
#pragma unroll
        for (int it = 0; it < 16; ++it) { const int idx = tid + 512 * it, m = idx >> 5, cc = idx & 31;
            const u32x4 v = *(const u32x4*)(kp + (size_t)m * 1024 + cc * 8); *(u32x4*)(lds + m * 528 + cc * 16) = v; }
    }
    __syncthreads();
    f32x16 sacc[8];
#pragma unroll
    for (int mb = 0; mb < 8; ++mb)
#pragma unroll
        for (int e = 0; e < 16; ++e) sacc[mb][e] = 0.f;
    for (int kg = 0; kg < 4; ++kg) {
        bf16x8 qf[4];
#pragma unroll
        for (int k4 = 0; k4 < 4; ++k4) qf[k4] = *(const bf16x8*)(qp + 16 * (4 * kg + k4));
#pragma unroll
        for (int k4 = 0; k4 < 4; ++k4)
#pragma unroll
            for (int mb = 0; mb < 8; ++mb) { const bf16x8 a = *(const bf16x8*)(lds + (32 * mb + r) * 528 + (16 * (4 * kg + k4) + 8 * hh) * 2); sacc[mb] = mfma32(a, qf[k4], sacc[mb]); }
    }
    float mx = -3.0e38f;
#pragma unroll
    for (int mb = 0; mb < 8; ++mb)
#pragma unroll
        for (int e = 0; e < 16; ++e) mx = fmaxf(mx, sacc[mb][e]);
    mx = fmaxf(mx, __shfl_xor(mx, 32));
    float sum = 0.f;
    bf16x8 pf[8][2];
#pragma unroll
    for (int mb = 0; mb < 8; ++mb) {
        float pv[16];
#pragma unroll
        for (int e = 0; e < 16; ++e) { pv[e] = __expf(sacc[mb][e] - mx); sum += pv[e]; }
#pragma unroll
        for (int s = 0; s < 2; ++s) pf[mb][s] = mk8u(cvt_pk_bf16(pv[8 * s + 0], pv[8 * s + 1]), cvt_pk_bf16(pv[8 * s + 2], pv[8 * s + 3]), cvt_pk_bf16(pv[8 * s + 4], pv[8 * s + 5]), cvt_pk_bf16(pv[8 * s + 6], pv[8 * s + 7]));
    }
    sum += __shfl_xor(sum, 32);
    const float inv = 1.0f / sum;
    __syncthreads();
    {
        const bf16_t* vp = VT + (size_t)(h * 256) * 1024 + b * 256;
#pragma unroll
        for (int it = 0; it < 16; ++it) { const int idx = tid + 512 * it, e = idx >> 5, cc = idx & 31;
            const u32x4 v = *(const u32x4*)(vp + (size_t)e * 1024 + cc * 8);
            u32x2* d = (u32x2*)(lds + e * 520 + cc * 16); d[0] = (u32x2){v.x, v.y}; d[1] = (u32x2){v.z, v.w}; }
    }
    __syncthreads();
    bf16_t* op = ATT + (size_t)(row0 + 32 * w + r) * 1024 + h * 256 + 4 * hh;
#pragma unroll
    for (int half = 0; half < 2; ++half) {
        f32x16 oacc[4];
#pragma unroll
        for (int d = 0; d < 4; ++d)
#pragma unroll
            for (int e = 0; e < 16; ++e) oacc[d][e] = 0.f;
#pragma unroll
        for (int mb = 0; mb < 8; ++mb)
#pragma unroll
            for (int s = 0; s < 2; ++s)
#pragma unroll
                for (int d = 0; d < 4; ++d) {
                    const unsigned char* base = lds + (32 * (half * 4 + d) + r) * 520 + (32 * mb + 16 * s + 4 * hh) * 2;
                    const bf16x8 a = mk8(*(const u32x2*)base, *(const u32x2*)(base + 16));
                    oacc[d] = mfma32(a, pf[mb][s], oacc[d]);
                }
#pragma unroll
        for (int d = 0; d < 4; ++d)
#pragma unroll
            for (int g = 0; g < 4; ++g) {
                u32x2 o; o.x = cvt_pk_bf16(oacc[d][4 * g] * inv, oacc[d][4 * g + 1] * inv); o.y = cvt_pk_bf16(oacc[d][4 * g + 2] * inv, oacc[d][4 * g + 3] * inv);
                *(u32x2*)(op + 32 * (half * 4 + d) + 8 * g) = o;
            }
    }
    __syncthreads();
}

__device__ void phase_final(float* __restrict__ out, const float* __restrict__ g) {
    const int lane = threadIdx.x & 63, gw = blockIdx.x * (NTHREADS / 64) + (threadIdx.x >> 6), nw = gridDim.x * (NTHREADS / 64);
    f32x4 gv[4];
#pragma unroll
    for (int i = 0; i < 4; ++i) gv[i] = ((const f32x4*)g)[lane + 64 * i];
    for (int r = gw; r < MROWS; r += nw) {
        f32x4* row = (f32x4*)(out + (size_t)r * DM);
        f32x4 v[4]; float ss = 0.f;
#pragma unroll
        for (int i = 0; i < 4; ++i) { v[i] = row[lane + 64 * i]; ss += (v[i][0] * v[i][0] + v[i][1] * v[i][1]) + (v[i][2] * v[i][2] + v[i][3] * v[i][3]); }
#pragma unroll
        for (int o = 1; o < 64; o <<= 1) ss += __shfl_xor(ss, o);
        const float rstd = rsqrtf(ss * (1.0f / 1024.0f) + EPS);
#pragma unroll
        for (int i = 0; i < 4; ++i) row[lane + 64 * i] = v[i] * rstd * gv[i];
    }
}

constexpr int N_PHASES = 12;
__global__ void __launch_bounds__(NTHREADS, 2) mega(Params p) {
    extern __shared__ __attribute__((aligned(16))) unsigned char lds[];
    LAS unsigned char* ldsl = (LAS unsigned char*)lds;
    unsigned char* ws = p.ws;
    const int G = gridDim.x, bid = blockIdx.x;
    const int lo = p.ph_lo, hi = p.ph_hi;

#ifndef DBG_LAST
#define DBG_LAST -1
#endif
#ifndef PHASE_MASK
#define PHASE_MASK 0xfff
#endif
#define IN(k) (((PHASE_MASK >> (k)) & 1) && lo <= (k) && (k) < hi)
#define SEAM(k) do { if (IN(k) && IN((k) + 1)) { cg::this_grid().sync(); } } while (0)
    bf16_t* XB = (bf16_t*)(ws + WS_XB); bf16_t* LT = (bf16_t*)(ws + WS_XB);
    bf16_t* QH = (bf16_t*)(ws + WS_QH); bf16_t* KH = (bf16_t*)(ws + WS_KH); bf16_t* VH = (bf16_t*)(ws + WS_VH); bf16_t* GH = (bf16_t*)(ws + WS_GH); bf16_t* PH = (bf16_t*)(ws + WS_PH);
    float* LF = (float*)(ws + WS_LF); bf16_t* ST = (bf16_t*)(ws + WS_ST); bf16_t* MIXED = (bf16_t*)(ws + WS_MIXED);
    float* X1 = (float*)(ws + WS_X1); bf16_t* XQ = (bf16_t*)(ws + WS_XQ); bf16_t* ATT = (bf16_t*)(ws + WS_ATT); bf16_t* U = (bf16_t*)(ws + WS_U);
    float* SSQ = (float*)(ws + WS_SSQ); float* DEC = (float*)(ws + WS_DEC);
    bf16_t* MEMB = (bf16_t*)(ws + WS_MEMB); bf16_t* KX = (bf16_t*)(ws + WS_KX); bf16_t* VT = (bf16_t*)(ws + WS_VT);

    if (IN(0)) { phase_prep(p, lds); }
    SEAM(0);
    if (IN(1)) {
        const pg8::Epi E{0, ws, p.x, p.out, p.lb_logits};
        { pg8::Gemm g{XB, (const bf16_t*)(ws + WS_WT_IN), MROWS, NIN, DM}; pg8::StaticOrder S; S.init(MROWS, NIN, G, bid); pg8::gemm_phase(ldsl, g, S, E); }
        const pg8::Epi E1{1, ws, p.x, p.out, p.lb_logits};
        { pg8::Gemm g{MEMB, (const bf16_t*)(ws + WS_WT_K), MEMROWS, 1024, DM}; pg8::StaticOrder S; S.init(MEMROWS, 1024, G, (bid + 128) % G); pg8::gemm_phase(ldsl, g, S, E1); }
        const pg8::Epi E2{2, ws, p.x, p.out, p.lb_logits};
        { pg8::Gemm g{(const bf16_t*)(ws + WS_WT_V), MEMB, 1024, MEMROWS, DM}; pg8::StaticOrder S; S.init(1024, MEMROWS, G, (bid + 112) % G); pg8::gemm_phase(ldsl, g, S, E2); }
    }
    SEAM(1);
    if (IN(2)) {
#ifndef DBG_NO_PASSA
        for (int u = bid; u < 1024; u += G) hgrn_passA_unit(KH, LF, VH, LT, DEC, u, lds);
#endif
#ifndef DBG_NO_POOL
        for (int t = bid; t < 256; t += G) pool_tile(PH, MIXED, t);
#endif
    }
    SEAM(2);
    if (IN(3)) { phase_scan(LT, DEC, ST); }
    SEAM(3);
    if (IN(4)) { for (int u = bid; u < 1024; u += G) hgrn_passC_unit(QH, KH, LF, VH, GH, ST, p.hgrn_norm_g, MIXED, u, lds); }
    SEAM(4);
    if (IN(5)) {
        const pg8::Epi E{3, ws, p.x, p.out, p.lb_logits};
        pg8::Gemm g{MIXED, (const bf16_t*)(ws + WS_WT_OUT), MROWS, DM, DM}; pg8::StaticOrder S; S.init(MROWS, DM, G, bid); pg8::gemm_phase(ldsl, g, S, E);
    }
    SEAM(5);
    if (IN(6)) {
        const pg8::Epi E{4, ws, p.x, p.out, p.lb_logits};
        pg8::Gemm g{XB, (const bf16_t*)(ws + WS_WT_Q), MROWS, DM, DM}; pg8::StaticOrder S; S.init(MROWS, DM, G, bid); pg8::gemm_phase(ldsl, g, S, E);
    }
    SEAM(6);
    if (IN(7)) { for (int u = bid; u < 256; u += G) attn_unit(XQ, KX, VT, ATT, u, lds); }
    SEAM(7);
    if (IN(8)) {
        const pg8::Epi E{6, ws, p.x, p.out, p.lb_logits};
        pg8::Gemm g{ATT, (const bf16_t*)(ws + WS_WT_O), MROWS, DM, DM}; pg8::StaticOrder S; S.init(MROWS, DM, G, bid); pg8::gemm_phase(ldsl, g, S, E);
    }
    SEAM(8);
    if (IN(9)) {
        const pg8::Epi E{5, ws, p.x, p.out, p.lb_logits};
        pg8::Gemm g{XB, (const bf16_t*)(ws + WS_WT_FF1), MROWS, DFF, DM}; pg8::StaticOrder S; S.init(MROWS, DFF, G, bid); pg8::gemm_phase(ldsl, g, S, E);
    }
    SEAM(9);
    if (IN(10)) {
        const pg8::Epi E{7, ws, p.x, p.out, p.lb_logits};
        pg8::Gemm g{U, (const bf16_t*)(ws + WS_WT_FF2), MROWS, DM, DFF}; pg8::StaticOrder S; S.init(MROWS, DM, G, bid); pg8::gemm_phase(ldsl, g, S, E);
    }
    SEAM(10);
    if (IN(11)) { phase_final(p.out, p.final_norm_g); }
#if DBG_LAST >= 0
    cg::this_grid().sync();
    {
        const unsigned* w32 = (const unsigned*)ws;
        for (size_t i = (size_t)bid * NTHREADS + threadIdx.x; i < (size_t)MROWS * DM; i += (size_t)G * NTHREADS) {
            float a = 0.f;
            for (int j = 0; j < 4; ++j) { const unsigned v = w32[i + (size_t)j * MROWS * DM]; a += (float)(v & 0xffffu) + (float)(v >> 16); }
            p.out[i] = a;
        }
    }
#endif
#undef IN
#undef SEAM
}

extern "C" void kernel_launch(void* const* d_in, const int* in_sizes, int n_in, void* d_out, int out_size, void* d_ws, size_t ws_size, hipStream_t stream) {
    static int grid = 0;
    if (grid == 0) {
        if (n_in != 19 || in_sizes[0] != MROWS * DM || out_size != MROWS * DM || ws_size < WS_END) { fprintf(stderr, "kernel_launch: unexpected shapes (n_in %d, ws %zu)\n", n_in, ws_size); grid = -1; return; }
        int dev = 0, cus = 0, per_cu = 0;
        hipGetDevice(&dev); hipDeviceGetAttribute(&cus, hipDeviceAttributeMultiprocessorCount, dev);
        if (hipFuncSetAttribute((const void*)mega, hipFuncAttributeMaxDynamicSharedMemorySize, LDS_BYTES) != hipSuccess) { fprintf(stderr, "kernel_launch: hipFuncSetAttribute failed\n"); grid = -1; return; }
        if (hipOccupancyMaxActiveBlocksPerMultiprocessor(&per_cu, (const void*)mega, NTHREADS, LDS_BYTES) != hipSuccess || per_cu < 1) { fprintf(stderr, "kernel_launch: occupancy query says %d\n", per_cu); per_cu = 1; }
        (void)hipGetLastError();
        grid = cus * 1;
        if (grid > cus * per_cu) grid = cus * per_cu;
    }
    if (grid < 0) return;
    Params p{};
    const float** f = (const float**)&p;
    for (int i = 0; i < 19; ++i) f[i] = (const float*)d_in[i];
    p.out = (float*)d_out; p.ws = (unsigned char*)d_ws;
#if N_LAUNCH_MODE == 1
    p.ph_lo = 0; p.ph_hi = (DBG_LAST >= 0) ? DBG_LAST + 1 : N_PHASES;
    void* args[] = {&p};
    hipError_t e = hipLaunchCooperativeKernel((const void*)mega, dim3(grid), dim3(NTHREADS), args, LDS_BYTES, stream);
    if (e != hipSuccess) fprintf(stderr, "kernel_launch: cooperative launch failed: %s (grid %d)\n", hipGetErrorString(e), grid);
#else
    for (int k = 0; k < N_PHASES; ++k) { p.ph_lo = k; p.ph_hi = k + 1; hipLaunchKernelGGL(mega, dim3(grid), dim3(NTHREADS), LDS_BYTES, stream, p); }
#endif
}
```

```cpp
#include <hip/hip_runtime.h>
#include <hip/hip_cooperative_groups.h>
#include <cstdio>
namespace cg = cooperative_groups;

#ifndef N_LAUNCH_MODE
#define N_LAUNCH_MODE 1
#endif

typedef unsigned short bf16_t;
typedef short bf16x8 __attribute__((ext_vector_type(8)));
typedef float f32x2 __attribute__((ext_vector_type(2)));
typedef float f32x4 __attribute__((ext_vector_type(4)));
typedef float f32x16 __attribute__((ext_vector_type(16)));
typedef unsigned u32x2 __attribute__((ext_vector_type(2)));
typedef unsigned u32x4 __attribute__((ext_vector_type(4)));
#define LAS __attribute__((address_space(3)))

constexpr int MROWS = 16384, DM = 1024, SEQ = 4096, NIN = 2560, DFF = 4096, MEMROWS = 1024;
constexpr float EPS = 1e-6f;
constexpr int NTHREADS = 512;
constexpr int LDS_MAIN = 135168;
constexpr int LDS_BYTES = LDS_MAIN + 16;

constexpr size_t MiB = 1u << 20;
constexpr size_t WS_WT_IN = 0, WS_WT_K = 5 * MiB, WS_WT_V = 7 * MiB, WS_WT_OUT = 9 * MiB, WS_WT_Q = 11 * MiB, WS_WT_O = 13 * MiB,
                 WS_WT_FF1 = 15 * MiB, WS_WT_FF2 = 23 * MiB, WS_MEMB = 31 * MiB, WS_KX = 33 * MiB, WS_VT = 35 * MiB, WS_SSQ = 37 * MiB,
                 WS_BAR = 39 * MiB, WS_RSTD0 = 38 * MiB, WS_RSTDM = 38 * MiB + 65536, WS_DEC = 38 * MiB + 131072,
                 WS_XB = 40 * MiB  , WS_QH = 72 * MiB, WS_KH = 88 * MiB, WS_VH = 104 * MiB, WS_GH = 120 * MiB, WS_PH = 136 * MiB,
                 WS_LF = 152 * MiB, WS_ST = 184 * MiB, WS_MIXED = 216 * MiB,
                 WS_X1 = 72 * MiB, WS_XQ = 136 * MiB, WS_ATT = 168 * MiB, WS_U = 72 * MiB, WS_END = 256 * MiB;

typedef __bf16 bf16x2n __attribute__((ext_vector_type(2)));
__device__ __forceinline__ unsigned cvt_pk_bf16(float lo, float hi) { f32x2 v = {lo, hi}; return __builtin_bit_cast(unsigned, __builtin_convertvector(v, bf16x2n)); }
__device__ __forceinline__ bf16_t f2bf(float f) { return (bf16_t)(cvt_pk_bf16(f, 0.f) & 0xffffu); }
__device__ __forceinline__ float bf2f(bf16_t b) { return __uint_as_float(((unsigned)b) << 16); }
__device__ __forceinline__ float bflo(unsigned u) { return __uint_as_float(u << 16); }
__device__ __forceinline__ float bfhi(unsigned u) { return __uint_as_float(u & 0xffff0000u); }
__device__ __forceinline__ f32x4 mfma16(bf16x8 a, bf16x8 b, f32x4 c) { return __builtin_amdgcn_mfma_f32_16x16x32_bf16(a, b, c, 0, 0, 0); }
__device__ __forceinline__ f32x16 mfma32(bf16x8 a, bf16x8 b, f32x16 c) { return __builtin_amdgcn_mfma_f32_32x32x16_bf16(a, b, c, 0, 0, 0); }
__device__ __forceinline__ bf16x8 mk8(u32x2 lo, u32x2 hi) { u32x4 t; t.x = lo.x; t.y = lo.y; t.z = hi.x; t.w = hi.y; return __builtin_bit_cast(bf16x8, t); }
__device__ __forceinline__ bf16x8 mk8u(unsigned a, unsigned b, unsigned c, unsigned d) { u32x4 t; t.x = a; t.y = b; t.z = c; t.w = d; return __builtin_bit_cast(bf16x8, t); }
__device__ __forceinline__ float sigmoidf_(float z) { return 1.0f / (1.0f + __expf(-z)); }

namespace pg8 {
constexpr int BM = 256, BK = 64, HALF = 128, HTB = HALF * BK * 2, STAGE_BYTES = 8 * HTB, NXCD = 8, WGM = 8;
__device__ __forceinline__ int lds_byte(int r, int c) { const int st = (r >> 4) * 2 + (c >> 5), rr = r & 15, cc = c & 31, ob = rr * 64 + cc * 2; return st * 1024 + (ob ^ (((ob >> 9) & 1) << 5)); }
__device__ __forceinline__ void stage_rc(int b, int& R, int& C) { const int st = b / 1024, sb = b % 1024, swz = sb ^ (((sb >> 9) & 1) << 5); R = (st >> 1) * 16 + swz / 64; C = (st & 1) * 32 + (swz % 64) / 2; }
__device__ __forceinline__ int perm32(int rho) { const int n = rho >> 4, i = rho & 15; return 8 * (i >> 2) + 4 * n + (i & 3); }
struct Unit { int pm, pn; };
struct Gemm { const bf16_t* A; const bf16_t* Bt; int M, N, K; };
struct StaticOrder {
    int nM, nN, nwg, G, c;
    __device__ void init(int M, int N, int G_, int c_) { nM = M / BM; nN = N / BM; nwg = nM * nN; G = G_; c = c_; }
    __device__ bool next(int i, Unit& u) const {
        const long L = (long)i * G + c; if (L >= nwg) return false;
        int wgid = (int)L; { const int q = nwg / NXCD, r = nwg % NXCD, xcd = wgid % NXCD, off = wgid / NXCD; wgid = (xcd < r ? xcd * (q + 1) : r * (q + 1) + (xcd - r) * q) + off; }
        const int nig = WGM * nN, gid = wgid / nig, fm = gid * WGM, gsz = (nM - fm) < WGM ? (nM - fm) : WGM;
        u.pm = fm + ((wgid % nig) % gsz); u.pn = (wgid % nig) / gsz; return true;
    }
};

struct Epi {
    static constexpr bool PERM = true;
    int mode;
    unsigned char* ws; const float* x; float* out; const float* lbl;
    __device__ __forceinline__ void store8(bf16_t* p, const f32x4& v0, const f32x4& v1) const {
        u32x4 w; w.x = cvt_pk_bf16(v0[0], v0[1]); w.y = cvt_pk_bf16(v0[2], v0[3]); w.z = cvt_pk_bf16(v1[0], v1[1]); w.w = cvt_pk_bf16(v1[2], v1[3]); *(u32x4*)p = w; }
    __device__ __forceinline__ void operator()(const f32x4 (&acc)[2][2][4][2], const Unit& u, int wr, int wc, int fr, int fq) const {
        const int row0 = u.pm * BM + wr * 64 + fr;
        const int colL = wc * 32 + 8 * fq;
        if (mode == 0) {
            const float* rs = (const float*)(ws + WS_RSTD0);
            float* lf = (float*)(ws + WS_LF); bf16_t* kh = (bf16_t*)(ws + WS_KH);
            const int sub = u.pn >> 1; const int cb = (u.pn & 1) * 256 + colL;
            if (sub == 1) {
                float oml[2][8];
#pragma unroll
                for (int bj = 0; bj < 2; ++bj)
#pragma unroll
                    for (int j = 0; j < 8; ++j) { const int c = cb + bj * HALF + j; const float l0 = lbl[c], l1 = lbl[512 + c]; const float lb = 1.0f / (1.0f + __expf(l1 - l0)); oml[bj][j] = 1.0f - lb; }
#pragma unroll
                for (int ai = 0; ai < 2; ++ai)
#pragma unroll
                    for (int m = 0; m < 4; ++m) { const int row = row0 + ai * HALF + m * 16; const float r = rs[row];
#pragma unroll
                        for (int bj = 0; bj < 2; ++bj) { f32x4 lf0, lf1, k0, k1;
#pragma unroll
                            for (int j = 0; j < 4; ++j) {
                                const float za = acc[ai][bj][m][0][j] * r, zb = acc[ai][bj][m][1][j] * r;
                                const float ka = oml[bj][j] * (1.0f - sigmoidf_(za)), kb = oml[bj][4 + j] * (1.0f - sigmoidf_(zb));
                                k0[j] = ka; k1[j] = kb; lf0[j] = __logf(1.0f - ka); lf1[j] = __logf(1.0f - kb); }
                            const size_t o = (size_t)row * 512 + cb + bj * HALF;
                            *(f32x4*)(lf + o) = lf0; *(f32x4*)(lf + o + 4) = lf1; store8(kh + o, k0, k1); } }
            } else {
                bf16_t* dst = (bf16_t*)(ws + (sub == 0 ? WS_QH : (sub == 2 ? WS_VH : (sub == 3 ? WS_GH : WS_PH))));
                const bool act = (sub == 0) || (sub == 3);
#pragma unroll
                for (int ai = 0; ai < 2; ++ai)
#pragma unroll
                    for (int m = 0; m < 4; ++m) { const int row = row0 + ai * HALF + m * 16; const float r = rs[row];
#pragma unroll
                        for (int bj = 0; bj < 2; ++bj) { f32x4 v0 = acc[ai][bj][m][0] * r, v1 = acc[ai][bj][m][1] * r;
                            if (act) {
#pragma unroll
                                for (int j = 0; j < 4; ++j) { v0[j] = v0[j] * sigmoidf_(v0[j]); v1[j] = v1[j] * sigmoidf_(v1[j]); } }
                            store8(dst + (size_t)row * 512 + cb + bj * HALF, v0, v1); } }
            }
        } else if (mode == 3 || mode == 6 || mode == 7) {
            const int col0 = u.pn * BM + colL;
            const float* resid = mode == 3 ? x : (mode == 6 ? (const float*)(ws + WS_X1) : (const float*)out);
            float* of = mode == 3 ? (float*)(ws + WS_X1) : out;
            bf16_t* ob = mode == 7 ? nullptr : (bf16_t*)(ws + WS_XB);
            float* ssq = mode == 7 ? nullptr : (float*)(ws + WS_SSQ);
#pragma unroll
            for (int ai = 0; ai < 2; ++ai)
#pragma unroll
                for (int m = 0; m < 4; ++m) { const int row = row0 + ai * HALF + m * 16; float ss = 0.f;
#pragma unroll
                    for (int bj = 0; bj < 2; ++bj) { const size_t o = (size_t)row * DM + col0 + bj * HALF;
                        const f32x4 v0 = acc[ai][bj][m][0] + *(const f32x4*)(resid + o), v1 = acc[ai][bj][m][1] + *(const f32x4*)(resid + o + 4);
                        *(f32x4*)(of + o) = v0; *(f32x4*)(of + o + 4) = v1;
                        if (ob) store8(ob + o, v0, v1);
                        ss += (v0[0] * v0[0] + v0[1] * v0[1]) + (v0[2] * v0[2] + v0[3] * v0[3]) + (v1[0] * v1[0] + v1[1] * v1[1]) + (v1[2] * v1[2] + v1[3] * v1[3]); }
                    ss += __shfl_xor(ss, 16); ss += __shfl_xor(ss, 32);
                    if (ssq && fq == 0) ssq[(size_t)row * 16 + u.pn * 4 + wc] = ss; }
        } else if (mode == 2) {
            const int col0 = u.pn * BM + colL;
            const float* rs = (const float*)(ws + WS_RSTDM); bf16_t* ob = (bf16_t*)(ws + WS_VT); const int ldo = 1024;
            f32x4 c0[2], c1[2];
#pragma unroll
            for (int bj = 0; bj < 2; ++bj) { c0[bj] = *(const f32x4*)(rs + col0 + bj * HALF); c1[bj] = *(const f32x4*)(rs + col0 + bj * HALF + 4); }
#pragma unroll
            for (int ai = 0; ai < 2; ++ai)
#pragma unroll
                for (int m = 0; m < 4; ++m) { const int row = row0 + ai * HALF + m * 16;
#pragma unroll
                    for (int bj = 0; bj < 2; ++bj) store8(ob + (size_t)row * ldo + col0 + bj * HALF, acc[ai][bj][m][0] * c0[bj], acc[ai][bj][m][1] * c1[bj]); }
        } else {
            const int col0 = u.pn * BM + colL;
            const float* rs = mode == 1 ? (const float*)(ws + WS_RSTDM) : (const float*)(ws + WS_SSQ);
            bf16_t* ob = (bf16_t*)(ws + (mode == 1 ? WS_KX : (mode == 4 ? WS_XQ : WS_U))); const int ldo = mode == 5 ? DFF : 1024;
            const float cs = mode == 4 ? 0.0625f : 1.0f;
#pragma unroll
            for (int ai = 0; ai < 2; ++ai)
#pragma unroll
                for (int m = 0; m < 4; ++m) { const int row = row0 + ai * HALF + m * 16; float r;
                    if (mode == 1) r = rs[row];
                    else { const f32x4* p = (const f32x4*)(rs + (size_t)row * 16); const f32x4 a = p[0], b = p[1], c = p[2], d = p[3];
                        const float t = ((a[0] + a[1]) + (a[2] + a[3])) + ((b[0] + b[1]) + (b[2] + b[3])) + ((c[0] + c[1]) + (c[2] + c[3])) + ((d[0] + d[1]) + (d[2] + d[3]));
                        r = rsqrtf(t * (1.0f / 1024.0f) + EPS) * cs; }
#pragma unroll
                    for (int bj = 0; bj < 2; ++bj) { f32x4 v0 = acc[ai][bj][m][0] * r, v1 = acc[ai][bj][m][1] * r;
                        if (mode == 5) {
#pragma unroll
                            for (int j = 0; j < 4; ++j) { const float a = fmaxf(v0[j], 0.f), b = fmaxf(v1[j], 0.f); v0[j] = a * a; v1[j] = b * b; } }
                        store8(ob + (size_t)row * ldo + col0 + bj * HALF, v0, v1); } }
        }
    }
};

template <class EpiT, class Sched>
__device__ __forceinline__ void gemm_phase(LAS unsigned char* lds, const Gemm g, const Sched S, const EpiT E) {
    const int tid = threadIdx.x, wid = __builtin_amdgcn_readfirstlane(tid >> 6), lane = tid & 63, wr = wid >> 2, wc = wid & 3, fr = lane & 15, fq = lane >> 4;
    const int K = g.K, nt = K / BK;
    unsigned voffA[2], voffB[2];
#pragma unroll
    for (int i = 0; i < 2; ++i) { int R, C; stage_rc(tid * 16 + i * 8192, R, C); const int Rb = EpiT::PERM ? ((R & ~31) + perm32(R & 31)) : R;
        voffA[i] = (unsigned)(R * K + C) * 2u; voffB[i] = (unsigned)(Rb * K + C) * 2u; }
    const size_t kstep = (size_t)(BK * 2);
    const size_t hstep = (size_t)HALF * K * 2;
    const size_t tstep = 2 * hstep;
    const unsigned ldsw = (unsigned)wid * 1024u;
    const int aoff = lds_byte(wr * 64 + fr, fq * 8), boff = lds_byte(wc * 32 + fr, fq * 8);
#define PG8_SA(b, h) (((b) * 2 + (h)) * HTB)
#define PG8_SB(b, h) ((4 + (b) * 2 + (h)) * HTB)
#define PG8_STAGE(bufoff, gbase, voff) do { _Pragma("unroll") for (int _i = 0; _i < 2; ++_i) \
        __builtin_amdgcn_global_load_lds((const unsigned*)((const char*)(gbase) + (voff)[_i]), (LAS unsigned*)(lds + (bufoff) + ldsw + _i * 8192), 16, 0, 0); } while (0)
#define PG8_LDA(dst, b, h) do { _Pragma("unroll") for (int m = 0; m < 4; ++m) _Pragma("unroll") for (int k = 0; k < 2; ++k) dst[m][k] = *(const LAS bf16x8*)(lds + PG8_SA(b, h) + aoff + m * 2048 + k * 1024); } while (0)
#define PG8_LDB(dst, b, h) do { _Pragma("unroll") for (int n = 0; n < 2; ++n) _Pragma("unroll") for (int k = 0; k < 2; ++k) dst[n][k] = *(const LAS bf16x8*)(lds + PG8_SB(b, h) + boff + n * 2048 + k * 1024); } while (0)
#define PG8_MMA(ai, bj, At, Bt) do { __builtin_amdgcn_s_setprio(1); _Pragma("unroll") for (int m = 0; m < 4; ++m) _Pragma("unroll") for (int n = 0; n < 2; ++n) _Pragma("unroll") for (int k = 0; k < 2; ++k) \
        acc[ai][bj][m][n] = __builtin_amdgcn_mfma_f32_16x16x32_bf16(Bt[n][k], At[m][k], acc[ai][bj][m][n], 0, 0, 0); __builtin_amdgcn_s_setprio(0); } while (0)
#define PG8_WAIT_V(n) asm volatile("s_waitcnt vmcnt(" #n ")" ::: "memory")
#define PG8_WAIT_L(n) asm volatile("s_waitcnt lgkmcnt(" #n ")" ::: "memory")
#define PG8_BAR __builtin_amdgcn_s_barrier()
#define PG8_SCHED __builtin_amdgcn_sched_barrier(0)
    Unit cur, nxt; int ui = 0;
    if (!S.next(0, cur)) return;
    f32x4 acc[2][2][4][2];
#pragma unroll
    for (int a = 0; a < 2; ++a)
#pragma unroll
        for (int b = 0; b < 2; ++b)
#pragma unroll
            for (int m = 0; m < 4; ++m)
#pragma unroll
                for (int n = 0; n < 2; ++n) acc[a][b][m][n] = (f32x4){0.f, 0.f, 0.f, 0.f};
    bf16x8 At[4][2], B0[2][2], B1[2][2];
    const char* cA = (const char*)g.A + (size_t)cur.pm * tstep; const char* cB = (const char*)g.Bt + (size_t)cur.pn * tstep;
    PG8_STAGE(PG8_SB(0, 0), cB, voffB); PG8_STAGE(PG8_SA(0, 0), cA, voffA); PG8_STAGE(PG8_SB(0, 1), cB + hstep, voffB); PG8_STAGE(PG8_SA(0, 1), cA + hstep, voffA);
    if (wr == 1) PG8_BAR;
    PG8_WAIT_V(4); PG8_BAR;
    PG8_STAGE(PG8_SB(1, 0), cB + kstep, voffB); PG8_STAGE(PG8_SA(1, 0), cA + kstep, voffA); PG8_STAGE(PG8_SB(1, 1), cB + hstep + kstep, voffB);
    PG8_WAIT_V(6); PG8_BAR;
    for (;;) {
        const bool has_next = S.next(ui + 1, nxt);
        const char* nA = has_next ? (const char*)g.A + (size_t)nxt.pm * tstep : cA; const char* nB = has_next ? (const char*)g.Bt + (size_t)nxt.pn * tstep : cB;
        for (int t = 0; t < nt; t += 2) {
            const bool last = (t == nt - 2);
            const char* a1 = cA + (size_t)(t + 1) * kstep;
            const char* a2 = last ? nA : cA + (size_t)(t + 2) * kstep; const char* b2 = last ? nB : cB + (size_t)(t + 2) * kstep;
            const char* a3 = a2 + kstep; const char* b3 = b2 + kstep;
            PG8_LDB(B0, 0, 0); PG8_SCHED; PG8_LDA(At, 0, 0); PG8_STAGE(PG8_SA(1, 1), a1 + hstep, voffA);
            PG8_WAIT_L(8); PG8_BAR; PG8_WAIT_L(0); PG8_MMA(0, 0, At, B0); PG8_BAR; PG8_SCHED;
            PG8_LDB(B1, 0, 1); PG8_STAGE(PG8_SB(0, 0), b2, voffB);
            PG8_BAR; PG8_WAIT_L(0); PG8_MMA(0, 1, At, B1); PG8_BAR;
            PG8_LDA(At, 0, 1); PG8_STAGE(PG8_SA(0, 0), a2, voffA);
            PG8_BAR; PG8_WAIT_L(0); PG8_MMA(1, 0, At, B0); PG8_BAR; PG8_SCHED;
            PG8_STAGE(PG8_SB(0, 1), b2 + hstep, voffB);
            PG8_WAIT_V(6); PG8_BAR; PG8_MMA(1, 1, At, B1); PG8_BAR;
            PG8_LDB(B0, 1, 0); PG8_SCHED; PG8_LDA(At, 1, 0); PG8_STAGE(PG8_SA(0, 1), a2 + hstep, voffA);
            PG8_WAIT_L(8); PG8_BAR; PG8_WAIT_L(0); PG8_MMA(0, 0, At, B0); PG8_BAR; PG8_SCHED;
            PG8_LDB(B1, 1, 1); PG8_STAGE(PG8_SB(1, 0), b3, voffB);
            PG8_BAR; PG8_WAIT_L(0); PG8_MMA(0, 1, At, B1); PG8_BAR;
            PG8_LDA(At, 1, 1); PG8_STAGE(PG8_SA(1, 0), a3, voffA);
            PG8_BAR; PG8_WAIT_L(0); PG8_MMA(1, 0, At, B0); PG8_BAR; PG8_SCHED;
            PG8_STAGE(PG8_SB(1, 1), b3 + hstep, voffB);
            PG8_WAIT_V(6); PG8_BAR; PG8_MMA(1, 1, At, B1); PG8_BAR;
        }
        E(acc, cur, wr, wc, fr, fq);
        if (!has_next) break;
#pragma unroll
        for (int a = 0; a < 2; ++a)
#pragma unroll
            for (int b = 0; b < 2; ++b)
#pragma unroll
                for (int m = 0; m < 4; ++m)
#pragma unroll
                    for (int n = 0; n < 2; ++n) acc[a][b][m][n] = (f32x4){0.f, 0.f, 0.f, 0.f};
        cur = nxt; cA = nA; cB = nB; ++ui;
    }
    PG8_WAIT_V(0);
    if (wr == 0) PG8_BAR;
    PG8_BAR;
#undef PG8_SA
#undef PG8_SB
#undef PG8_STAGE
#undef PG8_LDA
#undef PG8_LDB
#undef PG8_MMA
#undef PG8_WAIT_V
#undef PG8_WAIT_L
#undef PG8_BAR
#undef PG8_SCHED
}
}

struct Params {
    const float *x, *mem, *norm_mix_g, *w_in, *lb_logits, *hgrn_norm_g, *w_pool, *pool_scale, *w_out, *norm_x_g, *norm_mem_g, *w_xq, *w_xk, *w_xv, *w_xo, *norm_ffn_g, *w_ff1, *w_ff2, *final_norm_g;
    float* out; unsigned char* ws;
    int ph_lo, ph_hi;
};

__device__ __forceinline__ void prep_transpose_tile(const float* __restrict__ W, int N, const float* __restrict__ g, bf16_t* __restrict__ out, int ldo, int kt, int nt, unsigned char* lds) {
    bf16_t* T = (bf16_t*)lds;
    const int tid = threadIdx.x, r = tid >> 4, c4 = tid & 15;
#pragma unroll
    for (int i = 0; i < 4; ++i) {
        const int kl = r + 32 * i, k = 128 * kt + kl;
        const f32x4 v = *(const f32x4*)(W + (size_t)k * N + 64 * nt + 4 * c4);
        const float s = g ? g[k] : 1.0f;
        T[(4 * c4 + 0) * 136 + kl] = f2bf(v[0] * s); T[(4 * c4 + 1) * 136 + kl] = f2bf(v[1] * s);
        T[(4 * c4 + 2) * 136 + kl] = f2bf(v[2] * s); T[(4 * c4 + 3) * 136 + kl] = f2bf(v[3] * s);
    }
    __syncthreads();
    const int n = tid >> 3, ks = tid & 7;
    const u32x4* src = (const u32x4*)(T + n * 136 + 16 * ks);
    const u32x4 a = src[0], b = src[1];
    u32x4* dst = (u32x4*)(out + (size_t)(64 * nt + n) * ldo + 128 * kt + 16 * ks);
    dst[0] = a; dst[1] = b;
    __syncthreads();
}

__device__ __forceinline__ void phase_prep(const Params p, unsigned char* lds) {
    unsigned char* ws = p.ws;
    const int G = gridDim.x;
    for (int t = blockIdx.x; t < 1920; t += G) {
        if (t < 320)       { prep_transpose_tile(p.w_in, NIN, p.norm_mix_g, (bf16_t*)(ws + WS_WT_IN), 1024, t / 40, t % 40, lds); }
        else if (t < 448)  { const int u = t - 320;  prep_transpose_tile(p.w_xk, 1024, p.norm_mem_g, (bf16_t*)(ws + WS_WT_K), 1024, u / 16, u % 16, lds); }
        else if (t < 576)  { const int u = t - 448;  prep_transpose_tile(p.w_xv, 1024, p.norm_mem_g, (bf16_t*)(ws + WS_WT_V), 1024, u / 16, u % 16, lds); }
        else if (t < 704)  { const int u = t - 576;  prep_transpose_tile(p.w_xq, 1024, p.norm_x_g, (bf16_t*)(ws + WS_WT_Q), 1024, u / 16, u % 16, lds); }
        else if (t < 832)  { const int u = t - 704;  prep_transpose_tile(p.w_xo, 1024, nullptr, (bf16_t*)(ws + WS_WT_O), 1024, u / 16, u % 16, lds); }
        else if (t < 896)  { const int u = t - 832;  prep_transpose_tile(p.w_out, 1024, nullptr, (bf16_t*)(ws + WS_WT_OUT), 1024, u / 16, u % 16, lds); }
        else if (t < 1408) { const int u = t - 896;  prep_transpose_tile(p.w_ff1, DFF, p.norm_ffn_g, (bf16_t*)(ws + WS_WT_FF1), 1024, u / 64, u % 64, lds); }
        else               { const int u = t - 1408; prep_transpose_tile(p.w_ff2, 1024, nullptr, (bf16_t*)(ws + WS_WT_FF2), 4096, u / 16, u % 16, lds); }
    }
    {
        bf16_t* wto = (bf16_t*)(ws + WS_WT_OUT);
        for (int item = blockIdx.x * NTHREADS + threadIdx.x; item < 65536; item += G * NTHREADS) {
            const int n = item & 1023, cgp = item >> 10, gi = cgp >> 4, c0 = (cgp & 15) * 8;
            float a[8];
#pragma unroll
            for (int j = 0; j < 8; ++j) a[j] = 0.f;
            const float* wp = p.w_pool + (size_t)(gi * 128 + c0) * 128;
            for (int d = 0; d < 128; ++d) {
                const float wo = p.w_out[(size_t)(512 + gi * 128 + d) * 1024 + n] * p.pool_scale[gi * 128 + d];
#pragma unroll
                for (int j = 0; j < 8; ++j) a[j] += wp[j * 128 + d] * wo;
            }
            u32x4 w; w.x = cvt_pk_bf16(a[0], a[1]); w.y = cvt_pk_bf16(a[2], a[3]); w.z = cvt_pk_bf16(a[4], a[5]); w.w = cvt_pk_bf16(a[6], a[7]);
            *(u32x4*)(wto + (size_t)n * 1024 + 512 + gi * 128 + c0) = w;
        }
    }
    {
        const int lane = threadIdx.x & 63, gw = blockIdx.x * (NTHREADS / 64) + (threadIdx.x >> 6), nw = G * (NTHREADS / 64);
        for (int r = gw; r < MROWS + MEMROWS; r += nw) {
            const bool isx = r < MROWS;
            const float* src = isx ? p.x + (size_t)r * DM : p.mem + (size_t)(r - MROWS) * DM;
            bf16_t* dst = isx ? (bf16_t*)(ws + WS_XB) + (size_t)r * DM : (bf16_t*)(ws + WS_MEMB) + (size_t)(r - MROWS) * DM;
            f32x4 v[4]; float ss = 0.f;
#pragma unroll
            for (int i = 0; i < 4; ++i) { v[i] = ((const f32x4*)src)[lane + 64 * i]; ss += (v[i][0] * v[i][0] + v[i][1] * v[i][1]) + (v[i][2] * v[i][2] + v[i][3] * v[i][3]); }
#pragma unroll
            for (int o = 1; o < 64; o <<= 1) ss += __shfl_xor(ss, o);
#pragma unroll
            for (int i = 0; i < 4; ++i) { u32x2 w; w.x = cvt_pk_bf16(v[i][0], v[i][1]); w.y = cvt_pk_bf16(v[i][2], v[i][3]); ((u32x2*)dst)[lane + 64 * i] = w; }
            if (lane == 0) { const float rstd = rsqrtf(ss * (1.0f / 1024.0f) + EPS); if (isx) ((float*)(ws + WS_RSTD0))[r] = rstd; else ((float*)(ws + WS_RSTDM))[r - MROWS] = rstd; }
        }
    }
}

__device__ void hgrn_passA_unit(const bf16_t* __restrict__ KH, const float* __restrict__ LF, const bf16_t* __restrict__ VH, bf16_t* __restrict__ LT, float* __restrict__ DEC, int unit, unsigned char* lds) {
    const int tid = threadIdx.x, ch = tid & 127, seg = tid >> 7;
    const int b = unit >> 8, c = (unit >> 2) & 63, h = unit & 3;
    const int row0 = b * SEQ + c * 64, bh = b * 4 + h;
    float* segtot = (float*)lds;
    unsigned char* KdT = lds + 2048;
    unsigned char* VTl = lds + 2048 + 18432;
    const size_t g0 = (size_t)(row0 + seg * 16) * 512 + h * 128 + ch;
    float lf[16], kk[16], vv[16];
#pragma unroll
    for (int i = 0; i < 16; ++i) { lf[i] = LF[g0 + (size_t)i * 512]; kk[i] = bf2f(KH[g0 + (size_t)i * 512]); vv[i] = bf2f(VH[g0 + (size_t)i * 512]); }
#pragma unroll
    for (int i = 1; i < 16; ++i) lf[i] += lf[i - 1];
    segtot[seg * 128 + ch] = lf[15];
    __syncthreads();
    float after = 0.f;
#pragma unroll
    for (int s2 = 1; s2 < 4; ++s2) if (s2 > seg) after += segtot[s2 * 128 + ch];
    const float tot = after + lf[15];
    if (seg == 0) DEC[(size_t)(bh * 64 + c) * 128 + ch] = __expf(tot);
    unsigned kd[8], vp[8];
#pragma unroll
    for (int i = 0; i < 8; ++i) {
        kd[i] = cvt_pk_bf16(kk[2 * i] * __expf(tot - lf[2 * i]), kk[2 * i + 1] * __expf(tot - lf[2 * i + 1]));
        vp[i] = cvt_pk_bf16(vv[2 * i], vv[2 * i + 1]);
    }
    { u32x4* d = (u32x4*)(KdT + ch * 144 + seg * 32); d[0] = (u32x4){kd[0], kd[1], kd[2], kd[3]}; d[1] = (u32x4){kd[4], kd[5], kd[6], kd[7]}; }
    { u32x4* d = (u32x4*)(VTl + ch * 144 + seg * 32); d[0] = (u32x4){vp[0], vp[1], vp[2], vp[3]}; d[1] = (u32x4){vp[4], vp[5], vp[6], vp[7]}; }
    __syncthreads();
    const int w = tid >> 6, lane = tid & 63, fr = lane & 15, q = lane >> 4;
    bf16x8 a[2];
#pragma unroll
    for (int ks = 0; ks < 2; ++ks) a[ks] = *(const bf16x8*)(KdT + (16 * w + fr) * 144 + (32 * ks + 8 * q) * 2);
    bf16_t* ltp = LT + (size_t)(bh * 64 + c) * 16384;
#pragma unroll
    for (int vb = 0; vb < 8; ++vb) {
        f32x4 acc = (f32x4){0.f, 0.f, 0.f, 0.f};
#pragma unroll
        for (int ks = 0; ks < 2; ++ks) { const bf16x8 bfr = *(const bf16x8*)(VTl + (16 * vb + fr) * 144 + (32 * ks + 8 * q) * 2); acc = mfma16(a[ks], bfr, acc); }
        u32x2 pk; pk.x = cvt_pk_bf16(acc[0], acc[1]); pk.y = cvt_pk_bf16(acc[2], acc[3]);
        *(u32x2*)(ltp + (size_t)(16 * vb + fr) * 128 + 16 * w + 4 * q) = pk;
    }
    __syncthreads();
}

__device__ void pool_tile(const bf16_t* __restrict__ PH, bf16_t* __restrict__ MIXED, int tile) {
    const int tid = threadIdx.x, cp = tid & 255, th = tid >> 8, c0 = 2 * cp, gi = c0 >> 7, w = 2 << gi;
    const int r0 = tile * 64 + th * 32, s0 = r0 & (SEQ - 1);
    float sx = 0.f, sy = 0.f;
    for (int j = 1; j < w; ++j) if (s0 - j >= 0) { const unsigned u = *(const unsigned*)(PH + (size_t)(r0 - j) * 512 + c0); sx += bflo(u); sy += bfhi(u); }
    for (int tt = 0; tt < 32; ++tt) {
        const int r = r0 + tt, s = s0 + tt;
        const unsigned u = *(const unsigned*)(PH + (size_t)r * 512 + c0);
        const float px = bflo(u), py = bfhi(u);
        sx += px; sy += py;
        const int cnt = (s + 1) < w ? (s + 1) : w;
        const float inv = 1.0f / (float)cnt;
        *(unsigned*)(MIXED + (size_t)r * 1024 + 512 + c0) = cvt_pk_bf16(sx * inv - px, sy * inv - py);
        if (s - (w - 1) >= 0) { const unsigned u2 = *(const unsigned*)(PH + (size_t)(r - (w - 1)) * 512 + c0); sx -= bflo(u2); sy -= bfhi(u2); }
    }
}

__device__ void phase_scan(const bf16_t* __restrict__ LT, const float* __restrict__ DEC, bf16_t* __restrict__ ST) {
    for (int e2 = blockIdx.x * NTHREADS + threadIdx.x; e2 < 131072; e2 += gridDim.x * NTHREADS) {
        const int bh = e2 >> 13, v = (e2 >> 6) & 127, kp = e2 & 63;
        float sx = 0.f, sy = 0.f;
        const size_t base = (size_t)bh * 64 * 16384 + (size_t)v * 128 + 2 * kp;
        const float* dp = DEC + (size_t)bh * 64 * 128 + 2 * kp;
        for (int c0 = 0; c0 < 64; c0 += 8) {
            unsigned l[8]; f32x2 d[8];
#pragma unroll
            for (int j = 0; j < 8; ++j) { l[j] = *(const unsigned*)(LT + base + (size_t)(c0 + j) * 16384); d[j] = *(const f32x2*)(dp + (c0 + j) * 128); }
#pragma unroll
            for (int j = 0; j < 8; ++j) {
                *(unsigned*)(ST + base + (size_t)(c0 + j) * 16384) = cvt_pk_bf16(sx, sy);
                sx = d[j][0] * sx + bflo(l[j]); sy = d[j][1] * sy + bfhi(l[j]);
            }
        }
    }
}

__device__ void hgrn_passC_unit(const bf16_t* __restrict__ QH, const bf16_t* __restrict__ KH, const float* __restrict__ LF, const bf16_t* __restrict__ VH, const bf16_t* __restrict__ GH,
                                const bf16_t* __restrict__ ST, const float* __restrict__ hg, bf16_t* __restrict__ MIXED, int unit, unsigned char* lds) {
    const int tid = threadIdx.x, ch = tid & 127, seg = tid >> 7;
    const int b = unit >> 8, c = (unit >> 2) & 63, h = unit & 3;
    const int row0 = b * SEQ + c * 64, bh = b * 4 + h;
    float* segtot = (float*)lds;
    float* rmsp = (float*)(lds + 2048);
    bf16_t* QC = (bf16_t*)(lds + 4096);
    bf16_t* QT = (bf16_t*)(lds + 21504);
    constexpr int KT0 = 38912;
    unsigned char* VTl = lds + 82432;
    const size_t g0 = (size_t)(row0 + seg * 16) * 512 + h * 128 + ch;
    float lf[16];
#pragma unroll
    for (int i = 0; i < 16; ++i) lf[i] = LF[g0 + (size_t)i * 512];
#pragma unroll
    for (int i = 1; i < 16; ++i) lf[i] += lf[i - 1];
    segtot[seg * 128 + ch] = lf[15];
    {
        unsigned vp[8];
#pragma unroll
        for (int i = 0; i < 8; ++i) vp[i] = (unsigned)VH[g0 + (size_t)(2 * i) * 512] | ((unsigned)VH[g0 + (size_t)(2 * i + 1) * 512] << 16);
        u32x4* d = (u32x4*)(VTl + ch * 144 + seg * 32); d[0] = (u32x4){vp[0], vp[1], vp[2], vp[3]}; d[1] = (u32x4){vp[4], vp[5], vp[6], vp[7]};
    }
    __syncthreads();
    const float t0 = segtot[ch], t1 = segtot[128 + ch], t2 = segtot[256 + ch];
    const float P = (seg > 0 ? t0 : 0.f) + (seg > 1 ? t1 : 0.f) + (seg > 2 ? t2 : 0.f);
    {
#pragma unroll
        for (int i = 0; i < 16; ++i) {
            const float qv = bf2f(QH[g0 + (size_t)i * 512]);
            const float el = __expf(lf[i]);
            QT[(seg * 16 + i) * 136 + ch] = f2bf(qv * el);
            QC[(seg * 16 + i) * 136 + ch] = f2bf(qv * el * __expf(P));
        }
        float kk[16];
#pragma unroll
        for (int i = 0; i < 16; ++i) kk[i] = bf2f(KH[g0 + (size_t)i * 512]);
        float E = 0.f;
#pragma unroll
        for (int i = 0; i < 4; ++i) {
            if (i >= seg) {
                bf16_t* KT = (bf16_t*)(lds + KT0 + 4352 * ((i * (i + 1)) / 2));
#pragma unroll
                for (int j = 0; j < 16; ++j) KT[(seg * 16 + j) * 136 + ch] = f2bf(kk[j] * __expf(E - lf[j]));
                E += (i == 0 ? t0 : (i == 1 ? t1 : t2));
            }
        }
    }
    __syncthreads();
    const int w = tid >> 6, lane = tid & 63, fr = lane & 15, q = lane >> 4;
    const int i = w & 3, vh = w >> 2;
    f32x4 sT[4];
#pragma unroll
    for (int j = 0; j < 4; ++j) sT[j] = (f32x4){0.f, 0.f, 0.f, 0.f};
    {
        bf16x8 qfr[4];
#pragma unroll
        for (int ks = 0; ks < 4; ++ks) qfr[ks] = *(const bf16x8*)((const unsigned char*)QT + (16 * i + fr) * 272 + (32 * ks + 8 * q) * 2);
        const unsigned char* KT = lds + KT0 + 4352 * ((i * (i + 1)) / 2);
#pragma unroll
        for (int j = 0; j < 4; ++j) if (j <= i) {
#pragma unroll
            for (int ks = 0; ks < 4; ++ks) { const bf16x8 a = *(const bf16x8*)(KT + (16 * j + fr) * 272 + (32 * ks + 8 * q) * 2); sT[j] = mfma16(a, qfr[ks], sT[j]); }
            if (j == i) {
#pragma unroll
                for (int rg = 0; rg < 4; ++rg) if (4 * q + rg > fr) sT[j][rg] = 0.f;
            }
        }
    }
    f32x4 oacc[4];
#pragma unroll
    for (int vbl = 0; vbl < 4; ++vbl) oacc[vbl] = (f32x4){0.f, 0.f, 0.f, 0.f};
#pragma unroll
    for (int m = 0; m < 2; ++m) if (2 * m <= i) {
        const bf16x8 bfrag = mk8u(cvt_pk_bf16(sT[2 * m][0], sT[2 * m][1]), cvt_pk_bf16(sT[2 * m][2], sT[2 * m][3]), cvt_pk_bf16(sT[2 * m + 1][0], sT[2 * m + 1][1]), cvt_pk_bf16(sT[2 * m + 1][2], sT[2 * m + 1][3]));
#pragma unroll
        for (int vbl = 0; vbl < 4; ++vbl) {
            const unsigned char* base = VTl + (16 * (vh * 4 + vbl) + fr) * 144 + (32 * m + 4 * q) * 2;
            const bf16x8 a = mk8(*(const u32x2*)base, *(const u32x2*)(base + 32));
            oacc[vbl] = mfma16(a, bfrag, oacc[vbl]);
        }
    }
    {
        const bf16_t* stp = ST + (size_t)(bh * 64 + c) * 16384;
#pragma unroll
        for (int ks = 0; ks < 4; ++ks) {
            const bf16x8 bfr = *(const bf16x8*)((const unsigned char*)QC + (16 * i + fr) * 272 + (32 * ks + 8 * q) * 2);
#pragma unroll
            for (int vbl = 0; vbl < 4; ++vbl) { const bf16x8 a = *(const bf16x8*)(stp + (size_t)(16 * (vh * 4 + vbl) + fr) * 128 + 32 * ks + 8 * q); oacc[vbl] = mfma16(a, bfr, oacc[vbl]); }
        }
    }
    float ss = 0.f;
#pragma unroll
    for (int vbl = 0; vbl < 4; ++vbl) ss += (oacc[vbl][0] * oacc[vbl][0] + oacc[vbl][1] * oacc[vbl][1]) + (oacc[vbl][2] * oacc[vbl][2] + oacc[vbl][3] * oacc[vbl][3]);
    ss += __shfl_xor(ss, 16); ss += __shfl_xor(ss, 32);
    if (q == 0) rmsp[vh * 64 + 16 * i + fr] = ss;
    __syncthreads();
    const float rstd = rsqrtf((rmsp[16 * i + fr] + rmsp[64 + 16 * i + fr]) * (1.0f / 128.0f) + EPS);
    const size_t row = (size_t)(row0 + 16 * i + fr);
#pragma unroll
    for (int vbl = 0; vbl < 4; ++vbl) {
        const int v0 = 16 * (vh * 4 + vbl) + 4 * q;
        const u32x2 gt = *(const u32x2*)(GH + row * 512 + h * 128 + v0);
        const f32x4 gg = *(const f32x4*)(hg + h * 128 + v0);
        u32x2 o;
        o.x = cvt_pk_bf16(oacc[vbl][0] * rstd * gg[0] * bflo(gt.x), oacc[vbl][1] * rstd * gg[1] * bfhi(gt.x));
        o.y = cvt_pk_bf16(oacc[vbl][2] * rstd * gg[2] * bflo(gt.y), oacc[vbl][3] * rstd * gg[3] * bfhi(gt.y));
        *(u32x2*)(MIXED + row * 1024 + h * 128 + v0) = o;
    }
    __syncthreads();
}

__device__ void attn_unit(const bf16_t* __restrict__ XQ, const bf16_t* __restrict__ KX, const bf16_t* __restrict__ VT, bf16_t* __restrict__ ATT, int unit, unsigned char* lds) {
    const int tid = threadIdx.x, w = tid >> 6, lane = tid & 63, r = lane & 31, hh = lane >> 5;
    const int b = unit >> 6, st = (unit >> 2) & 15, h = unit & 3;
    const int row0 = b * SEQ + st * 256;
    const bf16_t* qp = XQ + (size_t)(row0 + 32 * w + r) * 1024 + h * 256 + 8 * hh;
    {
        const bf16_t* kp = KX + (size_t)(b * 256) * 1024 + h * 256;
#pragma unroll
        for (int it = 0; it < 16; ++it) { const int idx = tid + 512 * it, m = idx >> 5, cc = idx & 31;
            const u32x4 v = *(const u32x4*)(kp + (size_t)m * 1024 + cc * 8); *(u32x4*)(lds + m * 528 + cc * 16) = v; }
    }
    __syncthreads();
    f32x16 sacc[8];
#pragma unroll
    for (int mb = 0; mb < 8; ++mb)
#pragma unroll
        for (int e = 0; e < 16; ++e) sacc[mb][e] = 0.f;
    for (int kg = 0; kg < 4; ++kg) {
        bf16x8 qf[4];
#pragma unroll
        for (int k4 = 0; k4 < 4; ++k4) qf[k4] = *(const bf16x8*)(qp + 16 * (4 * kg + k4));
#pragma unroll
        for (int k4 = 0; k4 < 4; ++k4)
#pragma unroll
            for (int mb = 0; mb < 8; ++mb) { const bf16x8 a = *(const bf16x8*)(lds + (32 * mb + r) * 528 + (16 * (4 * kg + k4) + 8 * hh) * 2); sacc[mb] = mfma32(a, qf[k4], sacc[mb]); }
    }
    float mx = -3.0e38f;
#pragma unroll
    for (int mb = 0; mb < 8; ++mb)
#pragma unroll
        for (int e = 0; e < 16; ++e) mx = fmaxf(mx, sacc[mb][e]);
    mx = fmaxf(mx, __shfl_xor(mx, 32));
    float sum = 0.f;
    bf16x8 pf[8][2];
#pragma unroll
    for (int mb = 0; mb < 8; ++mb) {
        float pv[16];
#pragma unroll
        for (int e = 0; e < 16; ++e) { pv[e] = __expf(sacc[mb][e] - mx); sum += pv[e]; }
#pragma unroll
        for (int s = 0; s < 2; ++s) pf[mb][s] = mk8u(cvt_pk_bf16(pv[8 * s + 0], pv[8 * s + 1]), cvt_pk_bf16(pv[8 * s + 2], pv[8 * s + 3]), cvt_pk_bf16(pv[8 * s + 4], pv[8 * s + 5]), cvt_pk_bf16(pv[8 * s + 6], pv[8 * s + 7]));
    }
    sum += __shfl_xor(sum, 32);
    const float inv = 1.0f / sum;
    __syncthreads();
    {
        const bf16_t* vp = VT + (size_t)(h * 256) * 1024 + b * 256;
#pragma unroll
        for (int it = 0; it < 16; ++it) { const int idx = tid + 512 * it, e = idx >> 5, cc = idx & 31;
            const u32x4 v = *(const u32x4*)(vp + (size_t)e * 1024 + cc * 8);
            u32x2* d = (u32x2*)(lds + e * 520 + cc * 16); d[0] = (u32x2){v.x, v.y}; d[1] = (u32x2){v.z, v.w}; }
    }
    __syncthreads();
    bf16_t* op = ATT + (size_t)(row0 + 32 * w + r) * 1024 + h * 256 + 4 * hh;
#pragma unroll
    for (int half = 0; half < 2; ++half) {
        f32x16 oacc[4];
#pragma unroll
        for (int d = 0; d < 4; ++d)
#pragma unroll
            for (int e = 0; e < 16; ++e) oacc[d][e] = 0.f;
#pragma unroll
        for (int mb = 0; mb < 8; ++mb)
#pragma unroll
            for (int s = 0; s < 2; ++s)
#pragma unroll
                for (int d = 0; d < 4; ++d) {
                    const unsigned char* base = lds + (32 * (half * 4 + d) + r) * 520 + (32 * mb + 16 * s + 4 * hh) * 2;
                    const bf16x8 a = mk8(*(const u32x2*)base, *(const u32x2*)(base + 16));
                    oacc[d] = mfma32(a, pf[mb][s], oacc[d]);
                }
#pragma unroll
        for (int d = 0; d < 4; ++d)
#pragma unroll
            for (int g = 0; g < 4; ++g) {
                u32x2 o; o.x = cvt_pk_bf16(oacc[d][4 * g] * inv, oacc[d][4 * g + 1] * inv); o.y = cvt_pk_bf16(oacc[d][4 * g + 2] * inv, oacc[d][4 * g + 3] * inv);
                *(u32x2*)(op + 32 * (half * 4 + d) + 8 * g) = o;
            }
    }
    __syncthreads();
}

__device__ void phase_final(float* __restrict__ out, const float* __restrict__ g) {
    const int lane = threadIdx.x & 63, gw = blockIdx.x * (NTHREADS / 64) + (threadIdx.x >> 6), nw = gridDim.x * (NTHREADS / 64);
    f32x4 gv[4];
#pragma unroll
    for (int i = 0; i < 4; ++i) gv[i] = ((const f32x4*)g)[lane + 64 * i];
    for (int r = gw; r < MROWS; r += nw) {
        f32x4* row = (f32x4*)(out + (size_t)r * DM);
        f32x4 v[4]; float ss = 0.f;
#pragma unroll
        for (int i = 0; i < 4; ++i) { v[i] = row[lane + 64 * i]; ss += (v[i][0] * v[i][0] + v[i][1] * v[i][1]) + (v[i][2] * v[i][2] + v[i][3] * v[i][3]); }
#pragma unroll
        for (int o = 1; o < 64; o <<= 1) ss += __shfl_xor(ss, o);
        const float rstd = rsqrtf(ss * (1.0f / 1024.0f) + EPS);
#pragma unroll
        for (int i = 0; i < 4; ++i) row[lane + 64 * i] = v[i] * rstd * gv[i];
    }
}

#define XB_TMO      128
#define XB_XCNT(j)  (256  + 64 * (j))
#define XB_XSUB(j)  (1280 + 64 * (j))
#define XB_XGEN(j)  (2304 + 64 * (j))
#define XB_TOP      3328
#define XB_TOPGEN   3392
#define XCD_BAR_WORDS 3456
#define XB_SPIN_CAP (1u << 22)
__device__ __forceinline__ unsigned xb_ld(unsigned* p)              { return __hip_atomic_load(p, __ATOMIC_RELAXED, __HIP_MEMORY_SCOPE_AGENT); }
__device__ __forceinline__ unsigned xb_add(unsigned* p, unsigned v) { return __hip_atomic_fetch_add(p, v, __ATOMIC_RELAXED, __HIP_MEMORY_SCOPE_AGENT); }
__device__ __forceinline__ unsigned xb_xcc_id() { return (unsigned)__builtin_amdgcn_s_getreg((3 << 11) | 20) & 0xFu; }
#define XB_SPIN(cond, bar) do { unsigned _sp = 0; while (cond) { __builtin_amdgcn_s_sleep(1); \
    if ((++_sp & 255u) == 0u) { if (xb_ld(&(bar)[XB_TMO])) break; if (_sp > XB_SPIN_CAP) { atomicAdd(&(bar)[XB_TMO], 1u); break; } } } } while (0)
struct XcdBarrier { unsigned* bar; unsigned x; volatile LAS unsigned* st; };
__device__ __forceinline__ XcdBarrier xcd_barrier_post(unsigned* bar, volatile LAS unsigned* st) {
    XcdBarrier b; b.bar = bar; b.x = xb_xcc_id(); b.st = st;
    if (threadIdx.x == 0) (void)xb_add(&bar[XB_XCNT(b.x)], 1u);
    return b;
}
__device__ __forceinline__ void xcd_barrier_complete(unsigned* bar, unsigned x, unsigned& nloc, unsigned& nx) {
    const unsigned G = gridDim.x * gridDim.y * gridDim.z;
    unsigned sum, cnt, mine, sp = 0u;
    for (;;) {
        sum = 0u; cnt = 0u; mine = 0u;
#pragma unroll
        for (unsigned j = 0; j < 16; ++j) { const unsigned c = xb_ld(&bar[XB_XCNT(j)]); sum += c; cnt += (c > 0u) ? 1u : 0u; mine = (j == x) ? c : mine; }
        if (sum == G) break;
        __builtin_amdgcn_s_sleep(1);
        if ((++sp & 255u) == 0u) { if (xb_ld(&bar[XB_TMO])) break; if (sp > XB_SPIN_CAP) { atomicAdd(&bar[XB_TMO], 1u); break; } }
    }
    nloc = mine > 0u ? mine : 1u; nx = cnt > 0u ? cnt : 1u;
}
__device__ __forceinline__ void xcd_barrier(const XcdBarrier& b) {
    asm volatile("s_waitcnt vmcnt(0)" ::: "memory");
    __syncthreads();
    if (threadIdx.x == 0) {
        unsigned* bar = b.bar;
        __builtin_amdgcn_s_waitcnt(0);
        unsigned nloc = b.st[0], nx = b.st[1];
        if (nloc == 0u) { xcd_barrier_complete(bar, b.x, nloc, nx); b.st[0] = nloc; b.st[1] = nx; }
        const unsigned old = xb_add(&bar[XB_XSUB(b.x)], 1u);
        const unsigned gen = old / nloc;
        if (old + 1u == (gen + 1u) * nloc) {
            __builtin_amdgcn_fence(__ATOMIC_RELEASE, "agent");
            asm volatile("s_waitcnt vmcnt(0)" ::: "memory");
            const unsigned og = xb_add(&bar[XB_TOP], 1u);
            const unsigned tg = og / nx;
            if (og + 1u == (tg + 1u) * nx) xb_add(&bar[XB_TOPGEN], 1u);
            else XB_SPIN(xb_ld(&bar[XB_TOPGEN]) == tg, bar);
            __builtin_amdgcn_fence(__ATOMIC_ACQUIRE, "agent");
            xb_add(&bar[XB_XGEN(b.x)], 1u);
            asm volatile("s_waitcnt vmcnt(0)" ::: "memory");
        } else {
            XB_SPIN(xb_ld(&bar[XB_XGEN(b.x)]) == gen, bar);
            __builtin_amdgcn_fence(__ATOMIC_ACQUIRE, "agent");
            asm volatile("s_waitcnt vmcnt(0)" ::: "memory");
        }
    }
    __syncthreads();
}

constexpr int N_PHASES = 12;
__global__ void __launch_bounds__(NTHREADS, 2) mega(Params p) {
    extern __shared__ __attribute__((aligned(16))) unsigned char lds[];
    LAS unsigned char* ldsl = (LAS unsigned char*)lds;
    unsigned char* ws = p.ws;
    const int G = gridDim.x, bid = blockIdx.x;
    const int lo = p.ph_lo, hi = p.ph_hi;

#ifndef DBG_LAST
#define DBG_LAST -1
#endif
#ifndef PHASE_MASK
#define PHASE_MASK 0xfff
#endif
#define IN(k) (((PHASE_MASK >> (k)) & 1) && lo <= (k) && (k) < hi)
    if (threadIdx.x == 0) { ((volatile LAS unsigned*)(ldsl + LDS_MAIN))[0] = 0u; ((volatile LAS unsigned*)(ldsl + LDS_MAIN))[1] = 0u; }
    __syncthreads();
    XcdBarrier xbar; xbar.bar = (unsigned*)(ws + WS_BAR); xbar.x = 0; xbar.st = nullptr;
    if (hi - lo > 1) xbar = xcd_barrier_post((unsigned*)(ws + WS_BAR), (volatile LAS unsigned*)(ldsl + LDS_MAIN));
#define SEAM(k) do { if (IN(k) && IN((k) + 1)) { if ((k) == 0) cg::this_grid().sync(); else xcd_barrier(xbar); } } while (0)
    bf16_t* XB = (bf16_t*)(ws + WS_XB); bf16_t* LT = (bf16_t*)(ws + WS_XB);
    bf16_t* QH = (bf16_t*)(ws + WS_QH); bf16_t* KH = (bf16_t*)(ws + WS_KH); bf16_t* VH = (bf16_t*)(ws + WS_VH); bf16_t* GH = (bf16_t*)(ws + WS_GH); bf16_t* PH = (bf16_t*)(ws + WS_PH);
    float* LF = (float*)(ws + WS_LF); bf16_t* ST = (bf16_t*)(ws + WS_ST); bf16_t* MIXED = (bf16_t*)(ws + WS_MIXED);
    float* X1 = (float*)(ws + WS_X1); bf16_t* XQ = (bf16_t*)(ws + WS_XQ); bf16_t* ATT = (bf16_t*)(ws + WS_ATT); bf16_t* U = (bf16_t*)(ws + WS_U);
    float* SSQ = (float*)(ws + WS_SSQ); float* DEC = (float*)(ws + WS_DEC);
    bf16_t* MEMB = (bf16_t*)(ws + WS_MEMB); bf16_t* KX = (bf16_t*)(ws + WS_KX); bf16_t* VT = (bf16_t*)(ws + WS_VT);

    if (IN(0)) { phase_prep(p, lds); }
    SEAM(0);
    if (IN(1)) {
        const pg8::Epi E{0, ws, p.x, p.out, p.lb_logits};
        { pg8::Gemm g{XB, (const bf16_t*)(ws + WS_WT_IN), MROWS, NIN, DM}; pg8::StaticOrder S; S.init(MROWS, NIN, G, bid); pg8::gemm_phase(ldsl, g, S, E); }
        const pg8::Epi E1{1, ws, p.x, p.out, p.lb_logits};
        { pg8::Gemm g{MEMB, (const bf16_t*)(ws + WS_WT_K), MEMROWS, 1024, DM}; pg8::StaticOrder S; S.init(MEMROWS, 1024, G, (bid + 128) % G); pg8::gemm_phase(ldsl, g, S, E1); }
        const pg8::Epi E2{2, ws, p.x, p.out, p.lb_logits};
        { pg8::Gemm g{(const bf16_t*)(ws + WS_WT_V), MEMB, 1024, MEMROWS, DM}; pg8::StaticOrder S; S.init(1024, MEMROWS, G, (bid + 112) % G); pg8::gemm_phase(ldsl, g, S, E2); }
    }
    SEAM(1);
    if (IN(2)) {
#ifndef DBG_NO_PASSA
        for (int u = bid; u < 1024; u += G) hgrn_passA_unit(KH, LF, VH, LT, DEC, u, lds);
#endif
#ifndef DBG_NO_POOL
        for (int t = bid; t < 256; t += G) pool_tile(PH, MIXED, t);
#endif
    }
    SEAM(2);
    if (IN(3)) { phase_scan(LT, DEC, ST); }
    SEAM(3);
    if (IN(4)) { for (int u = bid; u < 1024; u += G) hgrn_passC_unit(QH, KH, LF, VH, GH, ST, p.hgrn_norm_g, MIXED, u, lds); }
    SEAM(4);
    if (IN(5)) {
        const pg8::Epi E{3, ws, p.x, p.out, p.lb_logits};
        pg8::Gemm g{MIXED, (const bf16_t*)(ws + WS_WT_OUT), MROWS, DM, DM}; pg8::StaticOrder S; S.init(MROWS, DM, G, bid); pg8::gemm_phase(ldsl, g, S, E);
    }
    SEAM(5);
    if (IN(6)) {
        const pg8::Epi E{4, ws, p.x, p.out, p.lb_logits};
        pg8::Gemm g{XB, (const bf16_t*)(ws + WS_WT_Q), MROWS, DM, DM}; pg8::StaticOrder S; S.init(MROWS, DM, G, bid); pg8::gemm_phase(ldsl, g, S, E);
    }
    SEAM(6);
    if (IN(7)) { for (int u = bid; u < 256; u += G) attn_unit(XQ, KX, VT, ATT, u, lds); }
    SEAM(7);
    if (IN(8)) {
        const pg8::Epi E{6, ws, p.x, p.out, p.lb_logits};
        pg8::Gemm g{ATT, (const bf16_t*)(ws + WS_WT_O), MROWS, DM, DM}; pg8::StaticOrder S; S.init(MROWS, DM, G, bid); pg8::gemm_phase(ldsl, g, S, E);
    }
    SEAM(8);
    if (IN(9)) {
        const pg8::Epi E{5, ws, p.x, p.out, p.lb_logits};
        pg8::Gemm g{XB, (const bf16_t*)(ws + WS_WT_FF1), MROWS, DFF, DM}; pg8::StaticOrder S; S.init(MROWS, DFF, G, bid); pg8::gemm_phase(ldsl, g, S, E);
    }
    SEAM(9);
    if (IN(10)) {
        const pg8::Epi E{7, ws, p.x, p.out, p.lb_logits};
        pg8::Gemm g{U, (const bf16_t*)(ws + WS_WT_FF2), MROWS, DM, DFF}; pg8::StaticOrder S; S.init(MROWS, DM, G, bid); pg8::gemm_phase(ldsl, g, S, E);
    }
    SEAM(10);
    if (IN(11)) { phase_final(p.out, p.final_norm_g); }
#if DBG_LAST >= 0
    cg::this_grid().sync();
    {
        const unsigned* w32 = (const unsigned*)ws;
        for (size_t i = (size_t)bid * NTHREADS + threadIdx.x; i < (size_t)MROWS * DM; i += (size_t)G * NTHREADS) {
            float a = 0.f;
            for (int j = 0; j < 4; ++j) { const unsigned v = w32[i + (size_t)j * MROWS * DM]; a += (float)(v & 0xffffu) + (float)(v >> 16); }
            p.out[i] = a;
        }
    }
#endif
#undef IN
#undef SEAM
}

extern "C" void kernel_launch(void* const* d_in, const int* in_sizes, int n_in, void* d_out, int out_size, void* d_ws, size_t ws_size, hipStream_t stream) {
    static int grid = 0;
    if (grid == 0) {
        if (n_in != 19 || in_sizes[0] != MROWS * DM || out_size != MROWS * DM || ws_size < WS_END) { fprintf(stderr, "kernel_launch: unexpected shapes (n_in %d, ws %zu)\n", n_in, ws_size); grid = -1; return; }
        int dev = 0, cus = 0, per_cu = 0;
        hipGetDevice(&dev); hipDeviceGetAttribute(&cus, hipDeviceAttributeMultiprocessorCount, dev);
        if (hipFuncSetAttribute((const void*)mega, hipFuncAttributeMaxDynamicSharedMemorySize, LDS_BYTES) != hipSuccess) { fprintf(stderr, "kernel_launch: hipFuncSetAttribute failed\n"); grid = -1; return; }
        if (hipOccupancyMaxActiveBlocksPerMultiprocessor(&per_cu, (const void*)mega, NTHREADS, LDS_BYTES) != hipSuccess || per_cu < 1) { fprintf(stderr, "kernel_launch: occupancy query says %d\n", per_cu); per_cu = 1; }
        (void)hipGetLastError();
        grid = cus * 1;
        if (grid > cus * per_cu) grid = cus * per_cu;
    }
    if (grid < 0) return;
    if (hipMemsetAsync((char*)d_ws + WS_BAR, 0, XCD_BAR_WORDS * 4, stream) != hipSuccess) { fprintf(stderr, "kernel_launch: memset of barrier words failed\n"); return; }
    Params p{};
    const float** f = (const float**)&p;
    for (int i = 0; i < 19; ++i) f[i] = (const float*)d_in[i];
    p.out = (float*)d_out; p.ws = (unsigned char*)d_ws;
#if N_LAUNCH_MODE == 1
    p.ph_lo = 0; p.ph_hi = (DBG_LAST >= 0) ? DBG_LAST + 1 : N_PHASES;
    void* args[] = {&p};
    hipError_t e = hipLaunchCooperativeKernel((const void*)mega, dim3(grid), dim3(NTHREADS), args, LDS_BYTES, stream);
    if (e != hipSuccess) fprintf(stderr, "kernel_launch: cooperative launch failed: %s (grid %d)\n", hipGetErrorString(e), grid);
#else
    for (int k = 0; k < N_PHASES; ++k) { p.ph_lo = k; p.ph_hi = k + 1; hipLaunchKernelGGL(mega, dim3(grid), dim3(NTHREADS), LDS_BYTES, stream, p); }
#endif
}
```

```cpp
#include <hip/hip_runtime.h>
#include <hip/hip_cooperative_groups.h>
#include <cstdio>
namespace cg = cooperative_groups;

#ifndef N_LAUNCH_MODE
#define N_LAUNCH_MODE 1
#endif

typedef unsigned short bf16_t;
typedef short bf16x8 __attribute__((ext_vector_type(8)));
typedef float f32x2 __attribute__((ext_vector_type(2)));
typedef float f32x4 __attribute__((ext_vector_type(4)));
typedef float f32x16 __attribute__((ext_vector_type(16)));
typedef unsigned u32x2 __attribute__((ext_vector_type(2)));
typedef unsigned u32x4 __attribute__((ext_vector_type(4)));
#define LAS __attribute__((address_space(3)))

constexpr int MROWS = 16384, DM = 1024, SEQ = 4096, NIN = 2560, DFF = 4096, MEMROWS = 1024;
constexpr float EPS = 1e-6f;
constexpr int NTHREADS = 512;
constexpr int LDS_MAIN = 135168;
constexpr int LDS_BYTES = LDS_MAIN + 16;

constexpr size_t MiB = 1u << 20;
constexpr size_t WS_WT_IN = 0, WS_WT_K = 5 * MiB, WS_WT_V = 7 * MiB, WS_WT_OUT = 9 * MiB, WS_WT_Q = 11 * MiB, WS_WT_O = 13 * MiB,
                 WS_WT_FF1 = 15 * MiB, WS_WT_FF2 = 23 * MiB, WS_MEMB = 31 * MiB, WS_KX = 33 * MiB, WS_VT = 35 * MiB, WS_SSQ = 37 * MiB,
                 WS_BAR = 39 * MiB, WS_RSTD0 = 38 * MiB, WS_RSTDM = 38 * MiB + 65536, WS_DEC = 38 * MiB + 131072,
                 WS_XB = 40 * MiB  , WS_QH = 72 * MiB, WS_KH = 88 * MiB, WS_VH = 104 * MiB, WS_GH = 120 * MiB, WS_PH = 136 * MiB,
                 WS_LF = 152 * MiB, WS_ST = 184 * MiB, WS_MIXED = 216 * MiB,
                 WS_X1 = 72 * MiB, WS_XQ = 136 * MiB, WS_ATT = 168 * MiB, WS_U = 72 * MiB, WS_END = 256 * MiB;

typedef __bf16 bf16x2n __attribute__((ext_vector_type(2)));
__device__ __forceinline__ unsigned cvt_pk_bf16(float lo, float hi) { f32x2 v = {lo, hi}; return __builtin_bit_cast(unsigned, __builtin_convertvector(v, bf16x2n)); }
__device__ __forceinline__ bf16_t f2bf(float f) { return (bf16_t)(cvt_pk_bf16(f, 0.f) & 0xffffu); }
__device__ __forceinline__ float bf2f(bf16_t b) { return __uint_as_float(((unsigned)b) << 16); }
__device__ __forceinline__ float bflo(unsigned u) { return __uint_as_float(u << 16); }
__device__ __forceinline__ float bfhi(unsigned u) { return __uint_as_float(u & 0xffff0000u); }
__device__ __forceinline__ f32x4 mfma16(bf16x8 a, bf16x8 b, f32x4 c) { return __builtin_amdgcn_mfma_f32_16x16x32_bf16(a, b, c, 0, 0, 0); }
__device__ __forceinline__ f32x16 mfma32(bf16x8 a, bf16x8 b, f32x16 c) { return __builtin_amdgcn_mfma_f32_32x32x16_bf16(a, b, c, 0, 0, 0); }
__device__ __forceinline__ bf16x8 mk8(u32x2 lo, u32x2 hi) { u32x4 t; t.x = lo.x; t.y = lo.y; t.z = hi.x; t.w = hi.y; return __builtin_bit_cast(bf16x8, t); }
__device__ __forceinline__ bf16x8 mk8u(unsigned a, unsigned b, unsigned c, unsigned d) { u32x4 t; t.x = a; t.y = b; t.z = c; t.w = d; return __builtin_bit_cast(bf16x8, t); }
__device__ __forceinline__ float sigmoidf_(float z) { return 1.0f / (1.0f + __expf(-z)); }

namespace pg8 {
constexpr int BM = 256, BK = 64, HALF = 128, HTB = HALF * BK * 2, STAGE_BYTES = 8 * HTB, NXCD = 8, WGM = 8;
__device__ __forceinline__ int lds_byte(int r, int c) { const int st = (r >> 4) * 2 + (c >> 5), rr = r & 15, cc = c & 31, ob = rr * 64 + cc * 2; return st * 1024 + (ob ^ (((ob >> 9) & 1) << 5)); }
__device__ __forceinline__ void stage_rc(int b, int& R, int& C) { const int st = b / 1024, sb = b % 1024, swz = sb ^ (((sb >> 9) & 1) << 5); R = (st >> 1) * 16 + swz / 64; C = (st & 1) * 32 + (swz % 64) / 2; }
__device__ __forceinline__ int perm32(int rho) { const int n = rho >> 4, i = rho & 15; return 8 * (i >> 2) + 4 * n + (i & 3); }
struct Unit { int pm, pn; };
struct Gemm { const bf16_t* A; const bf16_t* Bt; int M, N, K; };
struct StaticOrder {
    int nM, nN, nwg, G, c;
    __device__ void init(int M, int N, int G_, int c_) { nM = M / BM; nN = N / BM; nwg = nM * nN; G = G_; c = c_; }
    __device__ bool next(int i, Unit& u) const {
        const long L = (long)i * G + c; if (L >= nwg) return false;
        int wgid = (int)L; { const int q = nwg / NXCD, r = nwg % NXCD, xcd = wgid % NXCD, off = wgid / NXCD; wgid = (xcd < r ? xcd * (q + 1) : r * (q + 1) + (xcd - r) * q) + off; }
        const int nig = WGM * nN, gid = wgid / nig, fm = gid * WGM, gsz = (nM - fm) < WGM ? (nM - fm) : WGM;
        u.pm = fm + ((wgid % nig) % gsz); u.pn = (wgid % nig) / gsz; return true;
    }
};

struct Epi {
    static constexpr bool PERM = true;
    int mode;
    unsigned char* ws; const float* x; float* out; const float* lbl;
    __device__ __forceinline__ void store8(bf16_t* p, const f32x4& v0, const f32x4& v1) const {
        u32x4 w; w.x = cvt_pk_bf16(v0[0], v0[1]); w.y = cvt_pk_bf16(v0[2], v0[3]); w.z = cvt_pk_bf16(v1[0], v1[1]); w.w = cvt_pk_bf16(v1[2], v1[3]); *(u32x4*)p = w; }
    __device__ __forceinline__ void operator()(const f32x4 (&acc)[2][2][4][2], const Unit& u, int wr, int wc, int fr, int fq) const {
        const int row0 = u.pm * BM + wr * 64 + fr;
        const int colL = wc * 32 + 8 * fq;
        if (mode == 3 || mode == 6 || mode == 7) {
            const int col0 = u.pn * BM + colL;
            const float* resid = mode == 3 ? x : (mode == 6 ? (const float*)(ws + WS_X1) : (const float*)out);
            float* of = mode == 3 ? (float*)(ws + WS_X1) : out;
            bf16_t* ob = mode == 7 ? nullptr : (bf16_t*)(ws + WS_XB);
            float* ssq = mode == 7 ? nullptr : (float*)(ws + WS_SSQ);
            f32x4 rc[4], rn[4];
            { const size_t o = (size_t)row0 * DM + col0; rc[0] = *(const f32x4*)(resid + o); rc[1] = *(const f32x4*)(resid + o + 4); rc[2] = *(const f32x4*)(resid + o + HALF); rc[3] = *(const f32x4*)(resid + o + HALF + 4); }
#pragma unroll
            for (int gidx = 0; gidx < 8; ++gidx) { const int ai = gidx >> 2, m = gidx & 3; const int row = row0 + ai * HALF + m * 16;
                if (gidx < 7) { const int g2 = gidx + 1; const size_t o2 = (size_t)(row0 + (g2 >> 2) * HALF + (g2 & 3) * 16) * DM + col0;
                    rn[0] = *(const f32x4*)(resid + o2); rn[1] = *(const f32x4*)(resid + o2 + 4); rn[2] = *(const f32x4*)(resid + o2 + HALF); rn[3] = *(const f32x4*)(resid + o2 + HALF + 4); }
                float ss = 0.f;
#pragma unroll
                for (int bj = 0; bj < 2; ++bj) { const size_t o = (size_t)row * DM + col0 + bj * HALF;
                    const f32x4 v0 = acc[ai][bj][m][0] + rc[2 * bj], v1 = acc[ai][bj][m][1] + rc[2 * bj + 1];
                    *(f32x4*)(of + o) = v0; *(f32x4*)(of + o + 4) = v1;
                    if (ob) store8(ob + o, v0, v1);
                    ss += (v0[0] * v0[0] + v0[1] * v0[1]) + (v0[2] * v0[2] + v0[3] * v0[3]) + (v1[0] * v1[0] + v1[1] * v1[1]) + (v1[2] * v1[2] + v1[3] * v1[3]); }
                ss += __shfl_xor(ss, 16); ss += __shfl_xor(ss, 32);
                if (ssq && fq == 0) ssq[(size_t)row * 16 + u.pn * 4 + wc] = ss;
#pragma unroll
                for (int k = 0; k < 4; ++k) rc[k] = rn[k]; }
            return;
        }
        if (mode == 2) {
            const int col0 = u.pn * BM + colL;
            const float* rs = (const float*)(ws + WS_RSTDM); bf16_t* ob = (bf16_t*)(ws + WS_VT); const int ldo = 1024;
            f32x4 c0[2], c1[2];
#pragma unroll
            for (int bj = 0; bj < 2; ++bj) { c0[bj] = *(const f32x4*)(rs + col0 + bj * HALF); c1[bj] = *(const f32x4*)(rs + col0 + bj * HALF + 4); }
#pragma unroll
            for (int ai = 0; ai < 2; ++ai)
#pragma unroll
                for (int m = 0; m < 4; ++m) { const int row = row0 + ai * HALF + m * 16;
#pragma unroll
                    for (int bj = 0; bj < 2; ++bj) store8(ob + (size_t)row * ldo + col0 + bj * HALF, acc[ai][bj][m][0] * c0[bj], acc[ai][bj][m][1] * c1[bj]); }
            return;
        }
        float rsc[8];
        if (mode == 4 || mode == 5) {
            const float* sq = (const float*)(ws + WS_SSQ);
            f32x4 pv[8];
#pragma unroll
            for (int gidx = 0; gidx < 8; ++gidx) pv[gidx] = *(const f32x4*)(sq + (size_t)(row0 + (gidx >> 2) * HALF + (gidx & 3) * 16) * 16 + 4 * fq);
            const float cs = mode == 4 ? 0.0625f : 1.0f;
#pragma unroll
            for (int gidx = 0; gidx < 8; ++gidx) { float t = (pv[gidx][0] + pv[gidx][1]) + (pv[gidx][2] + pv[gidx][3]); t += __shfl_xor(t, 16); t += __shfl_xor(t, 32); rsc[gidx] = rsqrtf(t * (1.0f / 1024.0f) + EPS) * cs; }
        } else {
            const float* rs = (const float*)(ws + (mode == 0 ? WS_RSTD0 : WS_RSTDM));
#pragma unroll
            for (int gidx = 0; gidx < 8; ++gidx) rsc[gidx] = rs[row0 + (gidx >> 2) * HALF + (gidx & 3) * 16];
        }
        if (mode == 0) {
            float* lf = (float*)(ws + WS_LF); bf16_t* kh = (bf16_t*)(ws + WS_KH);
            const int sub = u.pn >> 1; const int cb = (u.pn & 1) * 256 + colL;
            if (sub == 1) {
                float oml[2][8];
#pragma unroll
                for (int bj = 0; bj < 2; ++bj)
#pragma unroll
                    for (int j = 0; j < 8; ++j) { const int c = cb + bj * HALF + j; const float l0 = lbl[c], l1 = lbl[512 + c]; const float lb = 1.0f / (1.0f + __expf(l1 - l0)); oml[bj][j] = 1.0f - lb; }
#pragma unroll
                for (int ai = 0; ai < 2; ++ai)
#pragma unroll
                    for (int m = 0; m < 4; ++m) { const int row = row0 + ai * HALF + m * 16; const float r = rsc[ai * 4 + m];
#pragma unroll
                        for (int bj = 0; bj < 2; ++bj) { f32x4 lf0, lf1, k0, k1;
#pragma unroll
                            for (int j = 0; j < 4; ++j) {
                                const float za = acc[ai][bj][m][0][j] * r, zb = acc[ai][bj][m][1][j] * r;
                                const float ka = oml[bj][j] * (1.0f - sigmoidf_(za)), kb = oml[bj][4 + j] * (1.0f - sigmoidf_(zb));
                                k0[j] = ka; k1[j] = kb; lf0[j] = __logf(1.0f - ka); lf1[j] = __logf(1.0f - kb); }
                            const size_t o = (size_t)row * 512 + cb + bj * HALF;
                            *(f32x4*)(lf + o) = lf0; *(f32x4*)(lf + o + 4) = lf1; store8(kh + o, k0, k1); } }
            } else {
                bf16_t* dst = (bf16_t*)(ws + (sub == 0 ? WS_QH : (sub == 2 ? WS_VH : (sub == 3 ? WS_GH : WS_PH))));
                const bool act = (sub == 0) || (sub == 3);
#pragma unroll
                for (int ai = 0; ai < 2; ++ai)
#pragma unroll
                    for (int m = 0; m < 4; ++m) { const int row = row0 + ai * HALF + m * 16; const float r = rsc[ai * 4 + m];
#pragma unroll
                        for (int bj = 0; bj < 2; ++bj) { f32x4 v0 = acc[ai][bj][m][0] * r, v1 = acc[ai][bj][m][1] * r;
                            if (act) {
#pragma unroll
                                for (int j = 0; j < 4; ++j) { v0[j] = v0[j] * sigmoidf_(v0[j]); v1[j] = v1[j] * sigmoidf_(v1[j]); } }
                            store8(dst + (size_t)row * 512 + cb + bj * HALF, v0, v1); } }
            }
        } else {
            const int col0 = u.pn * BM + colL;
            bf16_t* ob = (bf16_t*)(ws + (mode == 1 ? WS_KX : (mode == 4 ? WS_XQ : WS_U))); const int ldo = mode == 5 ? DFF : 1024;
#pragma unroll
            for (int ai = 0; ai < 2; ++ai)
#pragma unroll
                for (int m = 0; m < 4; ++m) { const int row = row0 + ai * HALF + m * 16; const float r = rsc[ai * 4 + m];
#pragma unroll
                    for (int bj = 0; bj < 2; ++bj) { f32x4 v0 = acc[ai][bj][m][0] * r, v1 = acc[ai][bj][m][1] * r;
                        if (mode == 5) {
#pragma unroll
                            for (int j = 0; j < 4; ++j) { const float a = fmaxf(v0[j], 0.f), b = fmaxf(v1[j], 0.f); v0[j] = a * a; v1[j] = b * b; } }
                        store8(ob + (size_t)row * ldo + col0 + bj * HALF, v0, v1); } }
        }
    }
};

template <class EpiT, class Sched>
__device__ __forceinline__ void gemm_phase(LAS unsigned char* lds, const Gemm g, const Sched S, const EpiT E) {
    const int tid = threadIdx.x, wid = __builtin_amdgcn_readfirstlane(tid >> 6), lane = tid & 63, wr = wid >> 2, wc = wid & 3, fr = lane & 15, fq = lane >> 4;
    const int K = g.K, nt = K / BK;
    unsigned voffA[2], voffB[2];
#pragma unroll
    for (int i = 0; i < 2; ++i) { int R, C; stage_rc(tid * 16 + i * 8192, R, C); const int Rb = EpiT::PERM ? ((R & ~31) + perm32(R & 31)) : R;
        voffA[i] = (unsigned)(R * K + C) * 2u; voffB[i] = (unsigned)(Rb * K + C) * 2u; }
    const size_t kstep = (size_t)(BK * 2);
    const size_t hstep = (size_t)HALF * K * 2;
    const size_t tstep = 2 * hstep;
    const unsigned ldsw = (unsigned)wid * 1024u;
    const int aoff = lds_byte(wr * 64 + fr, fq * 8), boff = lds_byte(wc * 32 + fr, fq * 8);
#define PG8_SA(b, h) (((b) * 2 + (h)) * HTB)
#define PG8_SB(b, h) ((4 + (b) * 2 + (h)) * HTB)
#define PG8_STAGE(bufoff, gbase, voff) do { _Pragma("unroll") for (int _i = 0; _i < 2; ++_i) \
        __builtin_amdgcn_global_load_lds((const unsigned*)((const char*)(gbase) + (voff)[_i]), (LAS unsigned*)(lds + (bufoff) + ldsw + _i * 8192), 16, 0, 0); } while (0)
#define PG8_LDA(dst, b, h) do { _Pragma("unroll") for (int m = 0; m < 4; ++m) _Pragma("unroll") for (int k = 0; k < 2; ++k) dst[m][k] = *(const LAS bf16x8*)(lds + PG8_SA(b, h) + aoff + m * 2048 + k * 1024); } while (0)
#define PG8_LDB(dst, b, h) do { _Pragma("unroll") for (int n = 0; n < 2; ++n) _Pragma("unroll") for (int k = 0; k < 2; ++k) dst[n][k] = *(const LAS bf16x8*)(lds + PG8_SB(b, h) + boff + n * 2048 + k * 1024); } while (0)
#define PG8_MMA(ai, bj, At, Bt) do { __builtin_amdgcn_s_setprio(1); _Pragma("unroll") for (int m = 0; m < 4; ++m) _Pragma("unroll") for (int n = 0; n < 2; ++n) _Pragma("unroll") for (int k = 0; k < 2; ++k) \
        acc[ai][bj][m][n] = __builtin_amdgcn_mfma_f32_16x16x32_bf16(Bt[n][k], At[m][k], acc[ai][bj][m][n], 0, 0, 0); __builtin_amdgcn_s_setprio(0); } while (0)
#define PG8_WAIT_V(n) asm volatile("s_waitcnt vmcnt(" #n ")" ::: "memory")
#define PG8_WAIT_L(n) asm volatile("s_waitcnt lgkmcnt(" #n ")" ::: "memory")
#define PG8_BAR __builtin_amdgcn_s_barrier()
#define PG8_SCHED __builtin_amdgcn_sched_barrier(0)
    Unit cur, nxt; int ui = 0;
    if (!S.next(0, cur)) return;
    f32x4 acc[2][2][4][2];
#pragma unroll
    for (int a = 0; a < 2; ++a)
#pragma unroll
        for (int b = 0; b < 2; ++b)
#pragma unroll
            for (int m = 0; m < 4; ++m)
#pragma unroll
                for (int n = 0; n < 2; ++n) acc[a][b][m][n] = (f32x4){0.f, 0.f, 0.f, 0.f};
    bf16x8 At[4][2], B0[2][2], B1[2][2];
    const char* cA = (const char*)g.A + (size_t)cur.pm * tstep; const char* cB = (const char*)g.Bt + (size_t)cur.pn * tstep;
    PG8_STAGE(PG8_SB(0, 0), cB, voffB); PG8_STAGE(PG8_SA(0, 0), cA, voffA); PG8_STAGE(PG8_SB(0, 1), cB + hstep, voffB); PG8_STAGE(PG8_SA(0, 1), cA + hstep, voffA);
    if (wr == 1) PG8_BAR;
    PG8_WAIT_V(4); PG8_BAR;
    PG8_STAGE(PG8_SB(1, 0), cB + kstep, voffB); PG8_STAGE(PG8_SA(1, 0), cA + kstep, voffA); PG8_STAGE(PG8_SB(1, 1), cB + hstep + kstep, voffB);
    PG8_WAIT_V(6); PG8_BAR;
    for (;;) {
        const bool has_next = S.next(ui + 1, nxt);
        const char* nA = has_next ? (const char*)g.A + (size_t)nxt.pm * tstep : cA; const char* nB = has_next ? (const char*)g.Bt + (size_t)nxt.pn * tstep : cB;
        for (int t = 0; t < nt; t += 2) {
            const bool last = (t == nt - 2);
            const char* a1 = cA + (size_t)(t + 1) * kstep;
            const char* a2 = last ? nA : cA + (size_t)(t + 2) * kstep; const char* b2 = last ? nB : cB + (size_t)(t + 2) * kstep;
            const char* a3 = a2 + kstep; const char* b3 = b2 + kstep;
            PG8_LDB(B0, 0, 0); PG8_SCHED; PG8_LDA(At, 0, 0); PG8_STAGE(PG8_SA(1, 1), a1 + hstep, voffA);
            PG8_WAIT_L(8); PG8_BAR; PG8_WAIT_L(0); PG8_MMA(0, 0, At, B0); PG8_BAR; PG8_SCHED;
            PG8_LDB(B1, 0, 1); PG8_STAGE(PG8_SB(0, 0), b2, voffB);
            PG8_BAR; PG8_WAIT_L(0); PG8_MMA(0, 1, At, B1); PG8_BAR;
            PG8_LDA(At, 0, 1); PG8_STAGE(PG8_SA(0, 0), a2, voffA);
            PG8_BAR; PG8_WAIT_L(0); PG8_MMA(1, 0, At, B0); PG8_BAR; PG8_SCHED;
            PG8_STAGE(PG8_SB(0, 1), b2 + hstep, voffB);
            PG8_WAIT_V(6); PG8_BAR; PG8_MMA(1, 1, At, B1); PG8_BAR;
            PG8_LDB(B0, 1, 0); PG8_SCHED; PG8_LDA(At, 1, 0); PG8_STAGE(PG8_SA(0, 1), a2 + hstep, voffA);
            PG8_WAIT_L(8); PG8_BAR; PG8_WAIT_L(0); PG8_MMA(0, 0, At, B0); PG8_BAR; PG8_SCHED;
            PG8_LDB(B1, 1, 1); PG8_STAGE(PG8_SB(1, 0), b3, voffB);
            PG8_BAR; PG8_WAIT_L(0); PG8_MMA(0, 1, At, B1); PG8_BAR;
            PG8_LDA(At, 1, 1); PG8_STAGE(PG8_SA(1, 0), a3, voffA);
            PG8_BAR; PG8_WAIT_L(0); PG8_MMA(1, 0, At, B0); PG8_BAR; PG8_SCHED;
            PG8_STAGE(PG8_SB(1, 1), b3 + hstep, voffB);
            PG8_WAIT_V(6); PG8_BAR; PG8_MMA(1, 1, At, B1); PG8_BAR;
        }
        E(acc, cur, wr, wc, fr, fq);
        if (!has_next) break;
#pragma unroll
        for (int a = 0; a < 2; ++a)
#pragma unroll
            for (int b = 0; b < 2; ++b)
#pragma unroll
                for (int m = 0; m < 4; ++m)
#pragma unroll
                    for (int n = 0; n < 2; ++n) acc[a][b][m][n] = (f32x4){0.f, 0.f, 0.f, 0.f};
        cur = nxt; cA = nA; cB = nB; ++ui;
    }
    PG8_WAIT_V(0);
    if (wr == 0) PG8_BAR;
    PG8_BAR;
#undef PG8_SA
#undef PG8_SB
#undef PG8_STAGE
#undef PG8_LDA
#undef PG8_LDB
#undef PG8_MMA
#undef PG8_WAIT_V
#undef PG8_WAIT_L
#undef PG8_BAR
#undef PG8_SCHED
}
}

struct Params {
    const float *x, *mem, *norm_mix_g, *w_in, *lb_logits, *hgrn_norm_g, *w_pool, *pool_scale, *w_out, *norm_x_g, *norm_mem_g, *w_xq, *w_xk, *w_xv, *w_xo, *norm_ffn_g, *w_ff1, *w_ff2, *final_norm_g;
    float* out; unsigned char* ws;
    int ph_lo, ph_hi;
};

__device__ __forceinline__ void prep_transpose_tile(const float* __restrict__ W, int N, const float* __restrict__ g, bf16_t* __restrict__ out, int ldo, int kt, int nt, unsigned char* lds) {
    bf16_t* T = (bf16_t*)lds;
    const int tid = threadIdx.x, r = tid >> 4, c4 = tid & 15;
#pragma unroll
    for (int i = 0; i < 4; ++i) {
        const int kl = r + 32 * i, k = 128 * kt + kl;
        const f32x4 v = *(const f32x4*)(W + (size_t)k * N + 64 * nt + 4 * c4);
        const float s = g ? g[k] : 1.0f;
        T[(4 * c4 + 0) * 136 + kl] = f2bf(v[0] * s); T[(4 * c4 + 1) * 136 + kl] = f2bf(v[1] * s);
        T[(4 * c4 + 2) * 136 + kl] = f2bf(v[2] * s); T[(4 * c4 + 3) * 136 + kl] = f2bf(v[3] * s);
    }
    __syncthreads();
    const int n = tid >> 3, ks = tid & 7;
    const u32x4* src = (const u32x4*)(T + n * 136 + 16 * ks);
    const u32x4 a = src[0], b = src[1];
    u32x4* dst = (u32x4*)(out + (size_t)(64 * nt + n) * ldo + 128 * kt + 16 * ks);
    dst[0] = a; dst[1] = b;
    __syncthreads();
}

__device__ __forceinline__ void phase_prep(const Params p, unsigned char* lds) {
    unsigned char* ws = p.ws;
    const int G = gridDim.x;
    for (int t = blockIdx.x; t < 1920; t += G) {
        if (t < 320)       { prep_transpose_tile(p.w_in, NIN, p.norm_mix_g, (bf16_t*)(ws + WS_WT_IN), 1024, t / 40, t % 40, lds); }
        else if (t < 448)  { const int u = t - 320;  prep_transpose_tile(p.w_xk, 1024, p.norm_mem_g, (bf16_t*)(ws + WS_WT_K), 1024, u / 16, u % 16, lds); }
        else if (t < 576)  { const int u = t - 448;  prep_transpose_tile(p.w_xv, 1024, p.norm_mem_g, (bf16_t*)(ws + WS_WT_V), 1024, u / 16, u % 16, lds); }
        else if (t < 704)  { const int u = t - 576;  prep_transpose_tile(p.w_xq, 1024, p.norm_x_g, (bf16_t*)(ws + WS_WT_Q), 1024, u / 16, u % 16, lds); }
        else if (t < 832)  { const int u = t - 704;  prep_transpose_tile(p.w_xo, 1024, nullptr, (bf16_t*)(ws + WS_WT_O), 1024, u / 16, u % 16, lds); }
        else if (t < 896)  { const int u = t - 832;  prep_transpose_tile(p.w_out, 1024, nullptr, (bf16_t*)(ws + WS_WT_OUT), 1024, u / 16, u % 16, lds); }
        else if (t < 1408) { const int u = t - 896;  prep_transpose_tile(p.w_ff1, DFF, p.norm_ffn_g, (bf16_t*)(ws + WS_WT_FF1), 1024, u / 64, u % 64, lds); }
        else               { const int u = t - 1408; prep_transpose_tile(p.w_ff2, 1024, nullptr, (bf16_t*)(ws + WS_WT_FF2), 4096, u / 16, u % 16, lds); }
    }
    {
        bf16_t* wto = (bf16_t*)(ws + WS_WT_OUT);
        for (int item = blockIdx.x * NTHREADS + threadIdx.x; item < 65536; item += G * NTHREADS) {
            const int n = item & 1023, cgp = item >> 10, gi = cgp >> 4, c0 = (cgp & 15) * 8;
            float a[8];
#pragma unroll
            for (int j = 0; j < 8; ++j) a[j] = 0.f;
            const float* wp = p.w_pool + (size_t)(gi * 128 + c0) * 128;
            for (int d = 0; d < 128; ++d) {
                const float wo = p.w_out[(size_t)(512 + gi * 128 + d) * 1024 + n] * p.pool_scale[gi * 128 + d];
#pragma unroll
                for (int j = 0; j < 8; ++j) a[j] += wp[j * 128 + d] * wo;
            }
            u32x4 w; w.x = cvt_pk_bf16(a[0], a[1]); w.y = cvt_pk_bf16(a[2], a[3]); w.z = cvt_pk_bf16(a[4], a[5]); w.w = cvt_pk_bf16(a[6], a[7]);
            *(u32x4*)(wto + (size_t)n * 1024 + 512 + gi * 128 + c0) = w;
        }
    }
    {
        const int lane = threadIdx.x & 63, gw = blockIdx.x * (NTHREADS / 64) + (threadIdx.x >> 6), nw = G * (NTHREADS / 64);
        for (int r = gw; r < MROWS + MEMROWS; r += nw) {
            const bool isx = r < MROWS;
            const float* src = isx ? p.x + (size_t)r * DM : p.mem + (size_t)(r - MROWS) * DM;
            bf16_t* dst = isx ? (bf16_t*)(ws + WS_XB) + (size_t)r * DM : (bf16_t*)(ws + WS_MEMB) + (size_t)(r - MROWS) * DM;
            f32x4 v[4]; float ss = 0.f;
#pragma unroll
            for (int i = 0; i < 4; ++i) { v[i] = ((const f32x4*)src)[lane + 64 * i]; ss += (v[i][0] * v[i][0] + v[i][1] * v[i][1]) + (v[i][2] * v[i][2] + v[i][3] * v[i][3]); }
#pragma unroll
            for (int o = 1; o < 64; o <<= 1) ss += __shfl_xor(ss, o);
#pragma unroll
            for (int i = 0; i < 4; ++i) { u32x2 w; w.x = cvt_pk_bf16(v[i][0], v[i][1]); w.y = cvt_pk_bf16(v[i][2], v[i][3]); ((u32x2*)dst)[lane + 64 * i] = w; }
            if (lane == 0) { const float rstd = rsqrtf(ss * (1.0f / 1024.0f) + EPS); if (isx) ((float*)(ws + WS_RSTD0))[r] = rstd; else ((float*)(ws + WS_RSTDM))[r - MROWS] = rstd; }
        }
    }
}

__device__ void hgrn_passA_unit(const bf16_t* __restrict__ KH, const float* __restrict__ LF, const bf16_t* __restrict__ VH, bf16_t* __restrict__ LT, float* __restrict__ DEC, int unit, unsigned char* lds) {
    const int tid = threadIdx.x, ch = tid & 127, seg = tid >> 7;
    const int b = unit >> 8, c = (unit >> 2) & 63, h = unit & 3;
    const int row0 = b * SEQ + c * 64, bh = b * 4 + h;
    float* segtot = (float*)lds;
    unsigned char* KdT = lds + 2048;
    unsigned char* VTl = lds + 2048 + 18432;
    const size_t g0 = (size_t)(row0 + seg * 16) * 512 + h * 128 + ch;
    float lf[16], kk[16], vv[16];
#pragma unroll
    for (int i = 0; i < 16; ++i) { lf[i] = LF[g0 + (size_t)i * 512]; kk[i] = bf2f(KH[g0 + (size_t)i * 512]); vv[i] = bf2f(VH[g0 + (size_t)i * 512]); }
#pragma unroll
    for (int i = 1; i < 16; ++i) lf[i] += lf[i - 1];
    segtot[seg * 128 + ch] = lf[15];
    __syncthreads();
    float after = 0.f;
#pragma unroll
    for (int s2 = 1; s2 < 4; ++s2) if (s2 > seg) after += segtot[s2 * 128 + ch];
    const float tot = after + lf[15];
    if (seg == 0) DEC[(size_t)(bh * 64 + c) * 128 + ch] = __expf(tot);
    unsigned kd[8], vp[8];
#pragma unroll
    for (int i = 0; i < 8; ++i) {
        kd[i] = cvt_pk_bf16(kk[2 * i] * __expf(tot - lf[2 * i]), kk[2 * i + 1] * __expf(tot - lf[2 * i + 1]));
        vp[i] = cvt_pk_bf16(vv[2 * i], vv[2 * i + 1]);
    }
    { u32x4* d = (u32x4*)(KdT + ch * 144 + seg * 32); d[0] = (u32x4){kd[0], kd[1], kd[2], kd[3]}; d[1] = (u32x4){kd[4], kd[5], kd[6], kd[7]}; }
    { u32x4* d = (u32x4*)(VTl + ch * 144 + seg * 32); d[0] = (u32x4){vp[0], vp[1], vp[2], vp[3]}; d[1] = (u32x4){vp[4], vp[5], vp[6], vp[7]}; }
    __syncthreads();
    const int w = tid >> 6, lane = tid & 63, fr = lane & 15, q = lane >> 4;
    bf16x8 a[2];
#pragma unroll
    for (int ks = 0; ks < 2; ++ks) a[ks] = *(const bf16x8*)(KdT + (16 * w + fr) * 144 + (32 * ks + 8 * q) * 2);
    bf16_t* ltp = LT + (size_t)(bh * 64 + c) * 16384;
#pragma unroll
    for (int vb = 0; vb < 8; ++vb) {
        f32x4 acc = (f32x4){0.f, 0.f, 0.f, 0.f};
#pragma unroll
        for (int ks = 0; ks < 2; ++ks) { const bf16x8 bfr = *(const bf16x8*)(VTl + (16 * vb + fr) * 144 + (32 * ks + 8 * q) * 2); acc = mfma16(a[ks], bfr, acc); }
        u32x2 pk; pk.x = cvt_pk_bf16(acc[0], acc[1]); pk.y = cvt_pk_bf16(acc[2], acc[3]);
        *(u32x2*)(ltp + (size_t)(16 * vb + fr) * 128 + 16 * w + 4 * q) = pk;
    }
    __syncthreads();
}

__device__ void pool_tile(const bf16_t* __restrict__ PH, bf16_t* __restrict__ MIXED, int tile) {
    const int tid = threadIdx.x, cp = tid & 255, th = tid >> 8, c0 = 2 * cp, gi = c0 >> 7, w = 2 << gi;
    const int r0 = tile * 64 + th * 32, s0 = r0 & (SEQ - 1);
    float sx = 0.f, sy = 0.f;
    for (int j = 1; j < w; ++j) if (s0 - j >= 0) { const unsigned u = *(const unsigned*)(PH + (size_t)(r0 - j) * 512 + c0); sx += bflo(u); sy += bfhi(u); }
    for (int tt = 0; tt < 32; ++tt) {
        const int r = r0 + tt, s = s0 + tt;
        const unsigned u = *(const unsigned*)(PH + (size_t)r * 512 + c0);
        const float px = bflo(u), py = bfhi(u);
        sx += px; sy += py;
        const int cnt = (s + 1) < w ? (s + 1) : w;
        const float inv = 1.0f / (float)cnt;
        *(unsigned*)(MIXED + (size_t)r * 1024 + 512 + c0) = cvt_pk_bf16(sx * inv - px, sy * inv - py);
        if (s - (w - 1) >= 0) { const unsigned u2 = *(const unsigned*)(PH + (size_t)(r - (w - 1)) * 512 + c0); sx -= bflo(u2); sy -= bfhi(u2); }
    }
}

__device__ void phase_scan(const bf16_t* __restrict__ LT, const float* __restrict__ DEC, bf16_t* __restrict__ ST) {
    for (int e2 = blockIdx.x * NTHREADS + threadIdx.x; e2 < 131072; e2 += gridDim.x * NTHREADS) {
        const int bh = e2 >> 13, v = (e2 >> 6) & 127, kp = e2 & 63;
        float sx = 0.f, sy = 0.f;
        const size_t base = (size_t)bh * 64 * 16384 + (size_t)v * 128 + 2 * kp;
        const float* dp = DEC + (size_t)bh * 64 * 128 + 2 * kp;
        for (int c0 = 0; c0 < 64; c0 += 8) {
            unsigned l[8]; f32x2 d[8];
#pragma unroll
            for (int j = 0; j < 8; ++j) { l[j] = *(const unsigned*)(LT + base + (size_t)(c0 + j) * 16384); d[j] = *(const f32x2*)(dp + (c0 + j) * 128); }
#pragma unroll
            for (int j = 0; j < 8; ++j) {
                *(unsigned*)(ST + base + (size_t)(c0 + j) * 16384) = cvt_pk_bf16(sx, sy);
                sx = d[j][0] * sx + bflo(l[j]); sy = d[j][1] * sy + bfhi(l[j]);
            }
        }
    }
}

__device__ void hgrn_passC_unit(const bf16_t* __restrict__ QH, const bf16_t* __restrict__ KH, const float* __restrict__ LF, const bf16_t* __restrict__ VH, const bf16_t* __restrict__ GH,
                                const bf16_t* __restrict__ ST, const float* __restrict__ hg, bf16_t* __restrict__ MIXED, int unit, unsigned char* lds) {
    const int tid = threadIdx.x, ch = tid & 127, seg = tid >> 7;
    const int b = unit >> 8, c = (unit >> 2) & 63, h = unit & 3;
    const int row0 = b * SEQ + c * 64, bh = b * 4 + h;
    float* segtot = (float*)lds;
    float* rmsp = (float*)(lds + 2048);
    bf16_t* QC = (bf16_t*)(lds + 4096);
    bf16_t* QT = (bf16_t*)(lds + 21504);
    constexpr int KT0 = 38912;
    unsigned char* VTl = lds + 82432;
    const size_t g0 = (size_t)(row0 + seg * 16) * 512 + h * 128 + ch;
    float lf[16];
#pragma unroll
    for (int i = 0; i < 16; ++i) lf[i] = LF[g0 + (size_t)i * 512];
#pragma unroll
    for (int i = 1; i < 16; ++i) lf[i] += lf[i - 1];
    segtot[seg * 128 + ch] = lf[15];
    {
        unsigned vp[8];
#pragma unroll
        for (int i = 0; i < 8; ++i) vp[i] = (unsigned)VH[g0 + (size_t)(2 * i) * 512] | ((unsigned)VH[g0 + (size_t)(2 * i + 1) * 512] << 16);
        u32x4* d = (u32x4*)(VTl + ch * 144 + seg * 32); d[0] = (u32x4){vp[0], vp[1], vp[2], vp[3]}; d[1] = (u32x4){vp[4], vp[5], vp[6], vp[7]};
    }
    __syncthreads();
    const float t0 = segtot[ch], t1 = segtot[128 + ch], t2 = segtot[256 + ch];
    const float P = (seg > 0 ? t0 : 0.f) + (seg > 1 ? t1 : 0.f) + (seg > 2 ? t2 : 0.f);
    {
#pragma unroll
        for (int i = 0; i < 16; ++i) {
            const float qv = bf2f(QH[g0 + (size_t)i * 512]);
            const float el = __expf(lf[i]);
            QT[(seg * 16 + i) * 136 + ch] = f2bf(qv * el);
            QC[(seg * 16 + i) * 136 + ch] = f2bf(qv * el * __expf(P));
        }
        float kk[16];
#pragma unroll
        for (int i = 0; i < 16; ++i) kk[i] = bf2f(KH[g0 + (size_t)i * 512]);
        float E = 0.f;
#pragma unroll
        for (int i = 0; i < 4; ++i) {
            if (i >= seg) {
                bf16_t* KT = (bf16_t*)(lds + KT0 + 4352 * ((i * (i + 1)) / 2));
#pragma unroll
                for (int j = 0; j < 16; ++j) KT[(seg * 16 + j) * 136 + ch] = f2bf(kk[j] * __expf(E - lf[j]));
                E += (i == 0 ? t0 : (i == 1 ? t1 : t2));
            }
        }
    }
    __syncthreads();
    const int w = tid >> 6, lane = tid & 63, fr = lane & 15, q = lane >> 4;
    const int i = w & 3, vh = w >> 2;
    f32x4 sT[4];
#pragma unroll
    for (int j = 0; j < 4; ++j) sT[j] = (f32x4){0.f, 0.f, 0.f, 0.f};
    {
        bf16x8 qfr[4];
#pragma unroll
        for (int ks = 0; ks < 4; ++ks) qfr[ks] = *(const bf16x8*)((const unsigned char*)QT + (16 * i + fr) * 272 + (32 * ks + 8 * q) * 2);
        const unsigned char* KT = lds + KT0 + 4352 * ((i * (i + 1)) / 2);
#pragma unroll
        for (int j = 0; j < 4; ++j) if (j <= i) {
#pragma unroll
            for (int ks = 0; ks < 4; ++ks) { const bf16x8 a = *(const bf16x8*)(KT + (16 * j + fr) * 272 + (32 * ks + 8 * q) * 2); sT[j] = mfma16(a, qfr[ks], sT[j]); }
            if (j == i) {
#pragma unroll
                for (int rg = 0; rg < 4; ++rg) if (4 * q + rg > fr) sT[j][rg] = 0.f;
            }
        }
    }
    f32x4 oacc[4];
#pragma unroll
    for (int vbl = 0; vbl < 4; ++vbl) oacc[vbl] = (f32x4){0.f, 0.f, 0.f, 0.f};
#pragma unroll
    for (int m = 0; m < 2; ++m) if (2 * m <= i) {
        const bf16x8 bfrag = mk8u(cvt_pk_bf16(sT[2 * m][0], sT[2 * m][1]), cvt_pk_bf16(sT[2 * m][2], sT[2 * m][3]), cvt_pk_bf16(sT[2 * m + 1][0], sT[2 * m + 1][1]), cvt_pk_bf16(sT[2 * m + 1][2], sT[2 * m + 1][3]));
#pragma unroll
        for (int vbl = 0; vbl < 4; ++vbl) {
            const unsigned char* base = VTl + (16 * (vh * 4 + vbl) + fr) * 144 + (32 * m + 4 * q) * 2;
            const bf16x8 a = mk8(*(const u32x2*)base, *(const u32x2*)(base + 32));
            oacc[vbl] = mfma16(a, bfrag, oacc[vbl]);
        }
    }
    {
        const bf16_t* stp = ST + (size_t)(bh * 64 + c) * 16384;
#pragma unroll
        for (int ks = 0; ks < 4; ++ks) {
            const bf16x8 bfr = *(const bf16x8*)((const unsigned char*)QC + (16 * i + fr) * 272 + (32 * ks + 8 * q) * 2);
#pragma unroll
            for (int vbl = 0; vbl < 4; ++vbl) { const bf16x8 a = *(const bf16x8*)(stp + (size_t)(16 * (vh * 4 + vbl) + fr) * 128 + 32 * ks + 8 * q); oacc[vbl] = mfma16(a, bfr, oacc[vbl]); }
        }
    }
    float ss = 0.f;
#pragma unroll
    for (int vbl = 0; vbl < 4; ++vbl) ss += (oacc[vbl][0] * oacc[vbl][0] + oacc[vbl][1] * oacc[vbl][1]) + (oacc[vbl][2] * oacc[vbl][2] + oacc[vbl][3] * oacc[vbl][3]);
    ss += __shfl_xor(ss, 16); ss += __shfl_xor(ss, 32);
    if (q == 0) rmsp[vh * 64 + 16 * i + fr] = ss;
    __syncthreads();
    const float rstd = rsqrtf((rmsp[16 * i + fr] + rmsp[64 + 16 * i + fr]) * (1.0f / 128.0f) + EPS);
    const size_t row = (size_t)(row0 + 16 * i + fr);
#pragma unroll
    for (int vbl = 0; vbl < 4; ++vbl) {
        const int v0 = 16 * (vh * 4 + vbl) + 4 * q;
        const u32x2 gt = *(const u32x2*)(GH + row * 512 + h * 128 + v0);
        const f32x4 gg = *(const f32x4*)(hg + h * 128 + v0);
        u32x2 o;
        o.x = cvt_pk_bf16(oacc[vbl][0] * rstd * gg[0] * bflo(gt.x), oacc[vbl][1] * rstd * gg[1] * bfhi(gt.x));
        o.y = cvt_pk_bf16(oacc[vbl][2] * rstd * gg[2] * bflo(gt.y), oacc[vbl][3] * rstd * gg[3] * bfhi(gt.y));
        *(u32x2*)(MIXED + row * 1024 + h * 128 + v0) = o;
    }
    __syncthreads();
}

__device__ void attn_unit(const bf16_t* __restrict__ XQ, const bf16_t* __restrict__ KX, const bf16_t* __restrict__ VT, bf16_t* __restrict__ ATT, int unit, unsigned char* lds) {
    const int tid = threadIdx.x, w = tid >> 6, lane = tid & 63, r = lane & 31, hh = lane >> 5;
    const int b = unit >> 6, st = (unit >> 2) & 15, h = unit & 3;
    const int row0 = b * SEQ + st * 256;
    const bf16_t* qp = XQ + (size_t)(row0 + 32 * w + r) * 1024 + h * 256 + 8 * hh;
    {
        const bf16_t* kp = KX + (size_t)(b * 256) * 1024 + h * 256;
#pragma unroll
        for (int it = 0; it < 16; ++it) { const int idx = tid + 512 * it, m = idx >> 5, cc = idx & 31;
            const u32x4 v = *(const u32x4*)(kp + (size_t)m * 1024 + cc * 8); *(u32x4*)(lds + m * 528 + cc * 16) = v; }
    }
    __syncthreads();
    f32x16 sacc[8];
#pragma unroll
    for (int mb = 0; mb < 8; ++mb)
#pragma unroll
        for (int e = 0; e < 16; ++e) sacc[mb][e] = 0.f;
    for (int kg = 0; kg < 4; ++kg) {
        bf16x8 qf[4];
#pragma unroll
        for (int k4 = 0; k4 < 4; ++k4) qf[k4] = *(const bf16x8*)(qp + 16 * (4 * kg + k4));
#pragma unroll
        for (int k4 = 0; k4 < 4; ++k4)
#pragma unroll
            for (int mb = 0; mb < 8; ++mb) { const bf16x8 a = *(const bf16x8*)(lds + (32 * mb + r) * 528 + (16 * (4 * kg + k4) + 8 * hh) * 2); sacc[mb] = mfma32(a, qf[k4], sacc[mb]); }
    }
    float mx = -3.0e38f;
#pragma unroll
    for (int mb = 0; mb < 8; ++mb)
#pragma unroll
        for (int e = 0; e < 16; ++e) mx = fmaxf(mx, sacc[mb][e]);
    mx = fmaxf(mx, __shfl_xor(mx, 32));
    float sum = 0.f;
    bf16x8 pf[8][2];
#pragma unroll
    for (int mb = 0; mb < 8; ++mb) {
        float pv[16];
#pragma unroll
        for (int e = 0; e < 16; ++e) { pv[e] = __expf(sacc[mb][e] - mx); sum += pv[e]; }
#pragma unroll
        for (int s = 0; s < 2; ++s) pf[mb][s] = mk8u(cvt_pk_bf16(pv[8 * s + 0], pv[8 * s + 1]), cvt_pk_bf16(pv[8 * s + 2], pv[8 * s + 3]), cvt_pk_bf16(pv[8 * s + 4], pv[8 * s + 5]), cvt_pk_bf16(pv[8 * s + 6], pv[8 * s + 7]));
    }
    sum += __shfl_xor(sum, 32);
    const float inv = 1.0f / sum;
    __syncthreads();
    {
        const bf16_t* vp = VT + (size_t)(h * 256) * 1024 + b * 256;
#pragma unroll
        for (int it = 0; it < 16; ++it) { const int idx = tid + 512 * it, e = idx >> 5, cc = idx & 31;
            const u32x4 v = *(const u32x4*)(vp + (size_t)e * 1024 + cc * 8);
            u32x2* d = (u32x2*)(lds + e * 520 + cc * 16); d[0] = (u32x2){v.x, v.y}; d[1] = (u32x2){v.z, v.w}; }
    }
    __syncthreads();
    bf16_t* op = ATT + (size_t)(row0 + 32 * w + r) * 1024 + h * 256 + 4 * hh;
#pragma unroll
    for (int half = 0; half < 2; ++half) {
        f32x16 oacc[4];
#pragma unroll
        for (int d = 0; d < 4; ++d)
#pragma unroll
            for (int e = 0; e < 16; ++e) oacc[d][e] = 0.f;
#pragma unroll
        for (int mb = 0; mb < 8; ++mb)
#pragma unroll
            for (int s = 0; s < 2; ++s)
#pragma unroll
                for (int d = 0; d < 4; ++d) {
                    const unsigned char* base = lds + (32 * (half * 4 + d) + r) * 520 + (32 * mb + 16 * s + 4 * hh) * 2;
                    const bf16x8 a = mk8(*(const u32x2*)base, *(const u32x2*)(base + 16));
                    oacc[d] = mfma32(a, pf[mb][s], oacc[d]);
                }
#pragma unroll
        for (int d = 0; d < 4; ++d)
#pragma unroll
            for (int g = 0; g < 4; ++g) {
                u32x2 o; o.x = cvt_pk_bf16(oacc[d][4 * g] * inv, oacc[d][4 * g + 1] * inv); o.y = cvt_pk_bf16(oacc[d][4 * g + 2] * inv, oacc[d][4 * g + 3] * inv);
                *(u32x2*)(op + 32 * (half * 4 + d) + 8 * g) = o;
            }
    }
    __syncthreads();
}

__device__ void phase_final(float* __restrict__ out, const float* __restrict__ g) {
    const int lane = threadIdx.x & 63, gw = blockIdx.x * (NTHREADS / 64) + (threadIdx.x >> 6), nw = gridDim.x * (NTHREADS / 64);
    f32x4 gv[4];
#pragma unroll
    for (int i = 0; i < 4; ++i) gv[i] = ((const f32x4*)g)[lane + 64 * i];
    for (int r = gw; r < MROWS; r += nw) {
        f32x4* row = (f32x4*)(out + (size_t)r * DM);
        f32x4 v[4]; float ss = 0.f;
#pragma unroll
        for (int i = 0; i < 4; ++i) { v[i] = row[lane + 64 * i]; ss += (v[i][0] * v[i][0] + v[i][1] * v[i][1]) + (v[i][2] * v[i][2] + v[i][3] * v[i][3]); }
#pragma unroll
        for (int o = 1; o < 64; o <<= 1) ss += __shfl_xor(ss, o);
        const float rstd = rsqrtf(ss * (1.0f / 1024.0f) + EPS);
#pragma unroll
        for (int i = 0; i < 4; ++i) row[lane + 64 * i] = v[i] * rstd * gv[i];
    }
}

#define XB_TMO      128
#define XB_XCNT(j)  (256  + 64 * (j))
#define XB_XSUB(j)  (1280 + 64 * (j))
#define XB_XGEN(j)  (2304 + 64 * (j))
#define XB_TOP      3328
#define XB_TOPGEN   3392
#define XCD_BAR_WORDS 3456
#define XB_SPIN_CAP (1u << 22)
__device__ __forceinline__ unsigned xb_ld(unsigned* p)              { return __hip_atomic_load(p, __ATOMIC_RELAXED, __HIP_MEMORY_SCOPE_AGENT); }
__device__ __forceinline__ unsigned xb_add(unsigned* p, unsigned v) { return __hip_atomic_fetch_add(p, v, __ATOMIC_RELAXED, __HIP_MEMORY_SCOPE_AGENT); }
__device__ __forceinline__ unsigned xb_xcc_id() { return (unsigned)__builtin_amdgcn_s_getreg((3 << 11) | 20) & 0xFu; }
#define XB_SPIN(cond, bar) do { unsigned _sp = 0; while (cond) { __builtin_amdgcn_s_sleep(1); \
    if ((++_sp & 255u) == 0u) { if (xb_ld(&(bar)[XB_TMO])) break; if (_sp > XB_SPIN_CAP) { atomicAdd(&(bar)[XB_TMO], 1u); break; } } } } while (0)
struct XcdBarrier { unsigned* bar; unsigned x; volatile LAS unsigned* st; };
__device__ __forceinline__ XcdBarrier xcd_barrier_post(unsigned* bar, volatile LAS unsigned* st) {
    XcdBarrier b; b.bar = bar; b.x = xb_xcc_id(); b.st = st;
    if (threadIdx.x == 0) (void)xb_add(&bar[XB_XCNT(b.x)], 1u);
    return b;
}
__device__ __forceinline__ void xcd_barrier_complete(unsigned* bar, unsigned x, unsigned& nloc, unsigned& nx) {
    const unsigned G = gridDim.x * gridDim.y * gridDim.z;
    unsigned sum, cnt, mine, sp = 0u;
    for (;;) {
        sum = 0u; cnt = 0u; mine = 0u;
#pragma unroll
        for (unsigned j = 0; j < 16; ++j) { const unsigned c = xb_ld(&bar[XB_XCNT(j)]); sum += c; cnt += (c > 0u) ? 1u : 0u; mine = (j == x) ? c : mine; }
        if (sum == G) break;
        __builtin_amdgcn_s_sleep(1);
        if ((++sp & 255u) == 0u) { if (xb_ld(&bar[XB_TMO])) break; if (sp > XB_SPIN_CAP) { atomicAdd(&bar[XB_TMO], 1u); break; } }
    }
    nloc = mine > 0u ? mine : 1u; nx = cnt > 0u ? cnt : 1u;
}
__device__ __forceinline__ void xcd_barrier(const XcdBarrier& b) {
    asm volatile("s_waitcnt vmcnt(0)" ::: "memory");
    __syncthreads();
    if (threadIdx.x == 0) {
        unsigned* bar = b.bar;
        __builtin_amdgcn_s_waitcnt(0);
        unsigned nloc = b.st[0], nx = b.st[1];
        if (nloc == 0u) { xcd_barrier_complete(bar, b.x, nloc, nx); b.st[0] = nloc; b.st[1] = nx; }
        const unsigned old = xb_add(&bar[XB_XSUB(b.x)], 1u);
        const unsigned gen = old / nloc;
        if (old + 1u == (gen + 1u) * nloc) {
            __builtin_amdgcn_fence(__ATOMIC_RELEASE, "agent");
            asm volatile("s_waitcnt vmcnt(0)" ::: "memory");
            const unsigned og = xb_add(&bar[XB_TOP], 1u);
            const unsigned tg = og / nx;
            if (og + 1u == (tg + 1u) * nx) xb_add(&bar[XB_TOPGEN], 1u);
            else XB_SPIN(xb_ld(&bar[XB_TOPGEN]) == tg, bar);
            __builtin_amdgcn_fence(__ATOMIC_ACQUIRE, "agent");
            xb_add(&bar[XB_XGEN(b.x)], 1u);
            asm volatile("s_waitcnt vmcnt(0)" ::: "memory");
        } else {
            XB_SPIN(xb_ld(&bar[XB_XGEN(b.x)]) == gen, bar);
            __builtin_amdgcn_fence(__ATOMIC_ACQUIRE, "agent");
            asm volatile("s_waitcnt vmcnt(0)" ::: "memory");
        }
    }
    __syncthreads();
}

constexpr int N_PHASES = 12;
__global__ void __launch_bounds__(NTHREADS, 2) mega(Params p) {
    extern __shared__ __attribute__((aligned(16))) unsigned char lds[];
    LAS unsigned char* ldsl = (LAS unsigned char*)lds;
    unsigned char* ws = p.ws;
    const int G = gridDim.x, bid = blockIdx.x;
    const int lo = p.ph_lo, hi = p.ph_hi;

#ifndef DBG_LAST
#define DBG_LAST -1
#endif
#ifndef PHASE_MASK
#define PHASE_MASK 0xfff
#endif
#define IN(k) (((PHASE_MASK >> (k)) & 1) && lo <= (k) && (k) < hi)
    if (threadIdx.x == 0) { ((volatile LAS unsigned*)(ldsl + LDS_MAIN))[0] = 0u; ((volatile LAS unsigned*)(ldsl + LDS_MAIN))[1] = 0u; }
    __syncthreads();
    XcdBarrier xbar; xbar.bar = (unsigned*)(ws + WS_BAR); xbar.x = 0; xbar.st = nullptr;
    if (hi - lo > 1) xbar = xcd_barrier_post((unsigned*)(ws + WS_BAR), (volatile LAS unsigned*)(ldsl + LDS_MAIN));
    if (lo > hi) cg::this_grid().sync();
#define SEAM(k) do { if (IN(k) && IN((k) + 1)) { xcd_barrier(xbar); } } while (0)
    bf16_t* XB = (bf16_t*)(ws + WS_XB); bf16_t* LT = (bf16_t*)(ws + WS_XB);
    bf16_t* QH = (bf16_t*)(ws + WS_QH); bf16_t* KH = (bf16_t*)(ws + WS_KH); bf16_t* VH = (bf16_t*)(ws + WS_VH); bf16_t* GH = (bf16_t*)(ws + WS_GH); bf16_t* PH = (bf16_t*)(ws + WS_PH);
    float* LF = (float*)(ws + WS_LF); bf16_t* ST = (bf16_t*)(ws + WS_ST); bf16_t* MIXED = (bf16_t*)(ws + WS_MIXED);
    float* X1 = (float*)(ws + WS_X1); bf16_t* XQ = (bf16_t*)(ws + WS_XQ); bf16_t* ATT = (bf16_t*)(ws + WS_ATT); bf16_t* U = (bf16_t*)(ws + WS_U);
    float* SSQ = (float*)(ws + WS_SSQ); float* DEC = (float*)(ws + WS_DEC);
    bf16_t* MEMB = (bf16_t*)(ws + WS_MEMB); bf16_t* KX = (bf16_t*)(ws + WS_KX); bf16_t* VT = (bf16_t*)(ws + WS_VT);

    if (IN(0)) { phase_prep(p, lds); }
    SEAM(0);
    if (IN(1)) {
        const pg8::Epi E{0, ws, p.x, p.out, p.lb_logits};
        { pg8::Gemm g{XB, (const bf16_t*)(ws + WS_WT_IN), MROWS, NIN, DM}; pg8::StaticOrder S; S.init(MROWS, NIN, G, bid); pg8::gemm_phase(ldsl, g, S, E); }
        const pg8::Epi E1{1, ws, p.x, p.out, p.lb_logits};
        { pg8::Gemm g{MEMB, (const bf16_t*)(ws + WS_WT_K), MEMROWS, 1024, DM}; pg8::StaticOrder S; S.init(MEMROWS, 1024, G, (bid + 128) % G); pg8::gemm_phase(ldsl, g, S, E1); }
        const pg8::Epi E2{2, ws, p.x, p.out, p.lb_logits};
        { pg8::Gemm g{(const bf16_t*)(ws + WS_WT_V), MEMB, 1024, MEMROWS, DM}; pg8::StaticOrder S; S.init(1024, MEMROWS, G, (bid + 112) % G); pg8::gemm_phase(ldsl, g, S, E2); }
    }
    SEAM(1);
    if (IN(2)) {
#ifndef DBG_NO_PASSA
        for (int u = bid; u < 1024; u += G) hgrn_passA_unit(KH, LF, VH, LT, DEC, u, lds);
#endif
#ifndef DBG_NO_POOL
        for (int t = bid; t < 256; t += G) pool_tile(PH, MIXED, t);
#endif
    }
    SEAM(2);
    if (IN(3)) { phase_scan(LT, DEC, ST); }
    SEAM(3);
    if (IN(4)) { for (int u = bid; u < 1024; u += G) hgrn_passC_unit(QH, KH, LF, VH, GH, ST, p.hgrn_norm_g, MIXED, u, lds); }
    SEAM(4);
    if (IN(5)) {
        const pg8::Epi E{3, ws, p.x, p.out, p.lb_logits};
        pg8::Gemm g{MIXED, (const bf16_t*)(ws + WS_WT_OUT), MROWS, DM, DM}; pg8::StaticOrder S; S.init(MROWS, DM, G, bid); pg8::gemm_phase(ldsl, g, S, E);
    }
    SEAM(5);
    if (IN(6)) {
        const pg8::Epi E{4, ws, p.x, p.out, p.lb_logits};
        pg8::Gemm g{XB, (const bf16_t*)(ws + WS_WT_Q), MROWS, DM, DM}; pg8::StaticOrder S; S.init(MROWS, DM, G, bid); pg8::gemm_phase(ldsl, g, S, E);
    }
    SEAM(6);
    if (IN(7)) { for (int u = bid; u < 256; u += G) attn_unit(XQ, KX, VT, ATT, u, lds); }
    SEAM(7);
    if (IN(8)) {
        const pg8::Epi E{6, ws, p.x, p.out, p.lb_logits};
        pg8::Gemm g{ATT, (const bf16_t*)(ws + WS_WT_O), MROWS, DM, DM}; pg8::StaticOrder S; S.init(MROWS, DM, G, bid); pg8::gemm_phase(ldsl, g, S, E);
    }
    SEAM(8);
    if (IN(9)) {
        const pg8::Epi E{5, ws, p.x, p.out, p.lb_logits};
        pg8::Gemm g{XB, (const bf16_t*)(ws + WS_WT_FF1), MROWS, DFF, DM}; pg8::StaticOrder S; S.init(MROWS, DFF, G, bid); pg8::gemm_phase(ldsl, g, S, E);
    }
    SEAM(9);
    if (IN(10)) {
        const pg8::Epi E{7, ws, p.x, p.out, p.lb_logits};
        pg8::Gemm g{U, (const bf16_t*)(ws + WS_WT_FF2), MROWS, DM, DFF}; pg8::StaticOrder S; S.init(MROWS, DM, G, bid); pg8::gemm_phase(ldsl, g, S, E);
    }
    SEAM(10);
    if (IN(11)) { phase_final(p.out, p.final_norm_g); }
#if DBG_LAST >= 0
    cg::this_grid().sync();
    {
        const unsigned* w32 = (const unsigned*)ws;
        for (size_t i = (size_t)bid * NTHREADS + threadIdx.x; i < (size_t)MROWS * DM; i += (size_t)G * NTHREADS) {
            float a = 0.f;
            for (int j = 0; j < 4; ++j) { const unsigned v = w32[i + (size_t)j * MROWS * DM]; a += (float)(v & 0xffffu) + (float)(v >> 16); }
            p.out[i] = a;
        }
    }
#endif
#undef IN
#undef SEAM
}

extern "C" void kernel_launch(void* const* d_in, const int* in_sizes, int n_in, void* d_out, int out_size, void* d_ws, size_t ws_size, hipStream_t stream) {
    static int grid = 0;
    if (grid == 0) {
        if (n_in != 19 || in_sizes[0] != MROWS * DM || out_size != MROWS * DM || ws_size < WS_END) { fprintf(stderr, "kernel_launch: unexpected shapes (n_in %d, ws %zu)\n", n_in, ws_size); grid = -1; return; }
        int dev = 0, cus = 0, per_cu = 0;
        hipGetDevice(&dev); hipDeviceGetAttribute(&cus, hipDeviceAttributeMultiprocessorCount, dev);
        if (hipFuncSetAttribute((const void*)mega, hipFuncAttributeMaxDynamicSharedMemorySize, LDS_BYTES) != hipSuccess) { fprintf(stderr, "kernel_launch: hipFuncSetAttribute failed\n"); grid = -1; return; }
        if (hipOccupancyMaxActiveBlocksPerMultiprocessor(&per_cu, (const void*)mega, NTHREADS, LDS_BYTES) != hipSuccess || per_cu < 1) { fprintf(stderr, "kernel_launch: occupancy query says %d\n", per_cu); per_cu = 1; }
        (void)hipGetLastError();
        grid = cus * 1;
        if (grid > cus * per_cu) grid = cus * per_cu;
    }
    if (grid < 0) return;
    if (hipMemsetAsync((char*)d_ws + WS_BAR, 0, XCD_BAR_WORDS * 4, stream) != hipSuccess) { fprintf(stderr, "kernel_launch: memset of barrier words failed\n"); return; }
    Params p{};
    const float** f = (const float**)&p;
    for (int i = 0; i < 19; ++i) f[i] = (const float*)d_in[i];
    p.out = (float*)d_out; p.ws = (unsigned char*)d_ws;
#if N_LAUNCH_MODE == 1
    p.ph_lo = 0; p.ph_hi = (DBG_LAST >= 0) ? DBG_LAST + 1 : N_PHASES;
    void* args[] = {&p};
    hipError_t e = hipLaunchCooperativeKernel((const void*)mega, dim3(grid), dim3(NTHREADS), args, LDS_BYTES, stream);
    if (e != hipSuccess) fprintf(stderr, "kernel_launch: cooperative launch failed: %s (grid %d)\n", hipGetErrorString(e), grid);
#else
    for (int k = 0; k < N_PHASES; ++k) { p.ph_lo = k; p.ph_hi = k + 1; hipLaunchKernelGGL(mega, dim3(grid), dim3(NTHREADS), LDS_BYTES, stream, p); }
#endif
}
```

```cpp
#include <hip/hip_runtime.h>
#include <hip/hip_cooperative_groups.h>
#include <cstdio>
namespace cg = cooperative_groups;

#ifndef N_LAUNCH_MODE
#define N_LAUNCH_MODE 1
#endif

typedef unsigned short bf16_t;
typedef short bf16x8 __attribute__((ext_vector_type(8)));
typedef float f32x2 __attribute__((ext_vector_type(2)));
typedef float f32x4 __attribute__((ext_vector_type(4)));
typedef float f32x16 __attribute__((ext_vector_type(16)));
typedef unsigned u32x2 __attribute__((ext_vector_type(2)));
typedef unsigned u32x4 __attribute__((ext_vector_type(4)));
#define LAS __attribute__((address_space(3)))

constexpr int MROWS = 16384, DM = 1024, SEQ = 4096, NIN = 2560, DFF = 4096, MEMROWS = 1024;
constexpr float EPS = 1e-6f;
constexpr int NTHREADS = 512;
constexpr int LDS_MAIN = 135168;
constexpr int LDS_BYTES = LDS_MAIN + 16;

constexpr size_t MiB = 1u << 20;
constexpr size_t WS_WT_IN = 0, WS_WT_K = 5 * MiB, WS_WT_V = 7 * MiB, WS_WT_OUT = 9 * MiB, WS_WT_Q = 11 * MiB, WS_WT_O = 13 * MiB,
                 WS_WT_FF1 = 15 * MiB, WS_WT_FF2 = 23 * MiB, WS_MEMB = 31 * MiB, WS_KX = 33 * MiB, WS_VT = 35 * MiB, WS_SSQ = 37 * MiB,
                 WS_BAR = 39 * MiB, WS_RSTD0 = 38 * MiB, WS_RSTDM = 38 * MiB + 65536, WS_DEC = 38 * MiB + 131072,
                 WS_XB = 40 * MiB  , WS_QH = 72 * MiB, WS_KH = 88 * MiB, WS_VH = 104 * MiB, WS_GH = 120 * MiB, WS_PH = 136 * MiB,
                 WS_LF = 152 * MiB, WS_ST = 184 * MiB, WS_MIXED = 216 * MiB,
                 WS_X1 = 72 * MiB, WS_XQ = 136 * MiB, WS_ATT = 168 * MiB, WS_U = 72 * MiB, WS_END = 256 * MiB;

typedef __bf16 bf16x2n __attribute__((ext_vector_type(2)));
__device__ __forceinline__ unsigned cvt_pk_bf16(float lo, float hi) { f32x2 v = {lo, hi}; return __builtin_bit_cast(unsigned, __builtin_convertvector(v, bf16x2n)); }
__device__ __forceinline__ bf16_t f2bf(float f) { return (bf16_t)(cvt_pk_bf16(f, 0.f) & 0xffffu); }
__device__ __forceinline__ float bf2f(bf16_t b) { return __uint_as_float(((unsigned)b) << 16); }
__device__ __forceinline__ float bflo(unsigned u) { return __uint_as_float(u << 16); }
__device__ __forceinline__ float bfhi(unsigned u) { return __uint_as_float(u & 0xffff0000u); }
__device__ __forceinline__ f32x4 mfma16(bf16x8 a, bf16x8 b, f32x4 c) { return __builtin_amdgcn_mfma_f32_16x16x32_bf16(a, b, c, 0, 0, 0); }
__device__ __forceinline__ f32x16 mfma32(bf16x8 a, bf16x8 b, f32x16 c) { return __builtin_amdgcn_mfma_f32_32x32x16_bf16(a, b, c, 0, 0, 0); }
__device__ __forceinline__ bf16x8 mk8(u32x2 lo, u32x2 hi) { u32x4 t; t.x = lo.x; t.y = lo.y; t.z = hi.x; t.w = hi.y; return __builtin_bit_cast(bf16x8, t); }
__device__ __forceinline__ bf16x8 mk8u(unsigned a, unsigned b, unsigned c, unsigned d) { u32x4 t; t.x = a; t.y = b; t.z = c; t.w = d; return __builtin_bit_cast(bf16x8, t); }
__device__ __forceinline__ float sigmoidf_(float z) { return 1.0f / (1.0f + __expf(-z)); }

namespace pg8 {
constexpr int BM = 256, BK = 64, HALF = 128, HTB = HALF * BK * 2, STAGE_BYTES = 8 * HTB, NXCD = 8, WGM = 8;
__device__ __forceinline__ int lds_byte(int r, int c) { const int st = (r >> 4) * 2 + (c >> 5), rr = r & 15, cc = c & 31, ob = rr * 64 + cc * 2; return st * 1024 + (ob ^ (((ob >> 9) & 1) << 5)); }
__device__ __forceinline__ void stage_rc(int b, int& R, int& C) { const int st = b / 1024, sb = b % 1024, swz = sb ^ (((sb >> 9) & 1) << 5); R = (st >> 1) * 16 + swz / 64; C = (st & 1) * 32 + (swz % 64) / 2; }
__device__ __forceinline__ int perm32(int rho) { const int n = rho >> 4, i = rho & 15; return 8 * (i >> 2) + 4 * n + (i & 3); }
struct Unit { int pm, pn; };
struct Gemm { const bf16_t* A; const bf16_t* Bt; int M, N, K; };
struct StaticOrder {
    int nM, nN, nwg, G, c;
    __device__ void init(int M, int N, int G_, int c_) { nM = M / BM; nN = N / BM; nwg = nM * nN; G = G_; c = c_; }
    __device__ bool next(int i, Unit& u) const {
        const long L = (long)i * G + c; if (L >= nwg) return false;
        int wgid = (int)L; { const int q = nwg / NXCD, r = nwg % NXCD, xcd = wgid % NXCD, off = wgid / NXCD; wgid = (xcd < r ? xcd * (q + 1) : r * (q + 1) + (xcd - r) * q) + off; }
        const int nig = WGM * nN, gid = wgid / nig, fm = gid * WGM, gsz = (nM - fm) < WGM ? (nM - fm) : WGM;
        u.pm = fm + ((wgid % nig) % gsz); u.pn = (wgid % nig) / gsz; return true;
    }
};

struct Epi {
    static constexpr bool PERM = true;
    int mode;
    unsigned char* ws; const float* x; float* out; const float* lbl;
    __device__ __forceinline__ void store8(bf16_t* p, const f32x4& v0, const f32x4& v1) const {
        u32x4 w; w.x = cvt_pk_bf16(v0[0], v0[1]); w.y = cvt_pk_bf16(v0[2], v0[3]); w.z = cvt_pk_bf16(v1[0], v1[1]); w.w = cvt_pk_bf16(v1[2], v1[3]); *(u32x4*)p = w; }
    __device__ __forceinline__ void operator()(const f32x4 (&acc)[2][2][4][2], const Unit& u, int wr, int wc, int fr, int fq) const {
        const int row0 = u.pm * BM + wr * 64 + fr;
        const int colL = wc * 32 + 8 * fq;
        if (mode == 3 || mode == 6 || mode == 7) {
            const int col0 = u.pn * BM + colL;
            bf16_t* xb = (bf16_t*)(ws + WS_XB);
            float* ssq = (float*)(ws + WS_SSQ);
            f32x4 rc[4], rn[4];
            u32x4 bc[2], bn[2];
            if (mode == 3) { const size_t o = (size_t)row0 * DM + col0; rc[0] = *(const f32x4*)(x + o); rc[1] = *(const f32x4*)(x + o + 4); rc[2] = *(const f32x4*)(x + o + HALF); rc[3] = *(const f32x4*)(x + o + HALF + 4); }
            else { const size_t o = (size_t)row0 * DM + col0; bc[0] = *(const u32x4*)(xb + o); bc[1] = *(const u32x4*)(xb + o + HALF); }
#pragma unroll
            for (int gidx = 0; gidx < 8; ++gidx) { const int ai = gidx >> 2, m = gidx & 3; const int row = row0 + ai * HALF + m * 16;
                if (gidx < 7) { const int g2 = gidx + 1; const size_t o2 = (size_t)(row0 + (g2 >> 2) * HALF + (g2 & 3) * 16) * DM + col0;
                    if (mode == 3) { rn[0] = *(const f32x4*)(x + o2); rn[1] = *(const f32x4*)(x + o2 + 4); rn[2] = *(const f32x4*)(x + o2 + HALF); rn[3] = *(const f32x4*)(x + o2 + HALF + 4); }
                    else { bn[0] = *(const u32x4*)(xb + o2); bn[1] = *(const u32x4*)(xb + o2 + HALF); } }
                if (mode != 3) {
#pragma unroll
                    for (int bj = 0; bj < 2; ++bj) { rc[2 * bj] = (f32x4){bflo(bc[bj].x), bfhi(bc[bj].x), bflo(bc[bj].y), bfhi(bc[bj].y)}; rc[2 * bj + 1] = (f32x4){bflo(bc[bj].z), bfhi(bc[bj].z), bflo(bc[bj].w), bfhi(bc[bj].w)}; } }
                float ss = 0.f;
#pragma unroll
                for (int bj = 0; bj < 2; ++bj) { const size_t o = (size_t)row * DM + col0 + bj * HALF;
                    const f32x4 v0 = acc[ai][bj][m][0] + rc[2 * bj], v1 = acc[ai][bj][m][1] + rc[2 * bj + 1];
                    if (mode == 7) { *(f32x4*)(out + o) = v0; *(f32x4*)(out + o + 4) = v1; }
                    else store8(xb + o, v0, v1);
                    ss += (v0[0] * v0[0] + v0[1] * v0[1]) + (v0[2] * v0[2] + v0[3] * v0[3]) + (v1[0] * v1[0] + v1[1] * v1[1]) + (v1[2] * v1[2] + v1[3] * v1[3]); }
                if (mode != 7) { ss += __shfl_xor(ss, 16); ss += __shfl_xor(ss, 32);
                    if (fq == 0) ssq[(size_t)row * 16 + u.pn * 4 + wc] = ss; }
#pragma unroll
                for (int k = 0; k < 4; ++k) rc[k] = rn[k];
                bc[0] = bn[0]; bc[1] = bn[1]; }
            return;
        }
        if (mode == 2) {
            const int col0 = u.pn * BM + colL;
            const float* rs = (const float*)(ws + WS_RSTDM); bf16_t* ob = (bf16_t*)(ws + WS_VT); const int ldo = 1024;
            f32x4 c0[2], c1[2];
#pragma unroll
            for (int bj = 0; bj < 2; ++bj) { c0[bj] = *(const f32x4*)(rs + col0 + bj * HALF); c1[bj] = *(const f32x4*)(rs + col0 + bj * HALF + 4); }
#pragma unroll
            for (int ai = 0; ai < 2; ++ai)
#pragma unroll
                for (int m = 0; m < 4; ++m) { const int row = row0 + ai * HALF + m * 16;
#pragma unroll
                    for (int bj = 0; bj < 2; ++bj) store8(ob + (size_t)row * ldo + col0 + bj * HALF, acc[ai][bj][m][0] * c0[bj], acc[ai][bj][m][1] * c1[bj]); }
            return;
        }
        float rsc[8];
        if (mode == 4 || mode == 5) {
            const float* sq = (const float*)(ws + WS_SSQ);
            f32x4 pv[8];
#pragma unroll
            for (int gidx = 0; gidx < 8; ++gidx) pv[gidx] = *(const f32x4*)(sq + (size_t)(row0 + (gidx >> 2) * HALF + (gidx & 3) * 16) * 16 + 4 * fq);
            const float cs = mode == 4 ? 0.0625f : 1.0f;
#pragma unroll
            for (int gidx = 0; gidx < 8; ++gidx) { float t = (pv[gidx][0] + pv[gidx][1]) + (pv[gidx][2] + pv[gidx][3]); t += __shfl_xor(t, 16); t += __shfl_xor(t, 32); rsc[gidx] = rsqrtf(t * (1.0f / 1024.0f) + EPS) * cs; }
        } else {
            const float* rs = (const float*)(ws + (mode == 0 ? WS_RSTD0 : WS_RSTDM));
#pragma unroll
            for (int gidx = 0; gidx < 8; ++gidx) rsc[gidx] = rs[row0 + (gidx >> 2) * HALF + (gidx & 3) * 16];
        }
        if (mode == 0) {
            float* lf = (float*)(ws + WS_LF); bf16_t* kh = (bf16_t*)(ws + WS_KH);
            const int sub = u.pn >> 1; const int cb = (u.pn & 1) * 256 + colL;
            if (sub == 1) {
                float oml[2][8];
#pragma unroll
                for (int bj = 0; bj < 2; ++bj)
#pragma unroll
                    for (int j = 0; j < 8; ++j) { const int c = cb + bj * HALF + j; const float l0 = lbl[c], l1 = lbl[512 + c]; const float lb = 1.0f / (1.0f + __expf(l1 - l0)); oml[bj][j] = 1.0f - lb; }
#pragma unroll
                for (int ai = 0; ai < 2; ++ai)
#pragma unroll
                    for (int m = 0; m < 4; ++m) { const int row = row0 + ai * HALF + m * 16; const float r = rsc[ai * 4 + m];
#pragma unroll
                        for (int bj = 0; bj < 2; ++bj) { f32x4 lf0, lf1, k0, k1;
#pragma unroll
                            for (int j = 0; j < 4; ++j) {
                                const float za = acc[ai][bj][m][0][j] * r, zb = acc[ai][bj][m][1][j] * r;
                                const float ka = oml[bj][j] * (1.0f - sigmoidf_(za)), kb = oml[bj][4 + j] * (1.0f - sigmoidf_(zb));
                                k0[j] = ka; k1[j] = kb; lf0[j] = __logf(1.0f - ka); lf1[j] = __logf(1.0f - kb); }
                            const size_t o = (size_t)row * 512 + cb + bj * HALF;
                            *(f32x4*)(lf + o) = lf0; *(f32x4*)(lf + o + 4) = lf1; store8(kh + o, k0, k1); } }
            } else {
                bf16_t* dst = (bf16_t*)(ws + (sub == 0 ? WS_QH : (sub == 2 ? WS_VH : (sub == 3 ? WS_GH : WS_PH))));
                const bool act = (sub == 0) || (sub == 3);
#pragma unroll
                for (int ai = 0; ai < 2; ++ai)
#pragma unroll
                    for (int m = 0; m < 4; ++m) { const int row = row0 + ai * HALF + m * 16; const float r = rsc[ai * 4 + m];
#pragma unroll
                        for (int bj = 0; bj < 2; ++bj) { f32x4 v0 = acc[ai][bj][m][0] * r, v1 = acc[ai][bj][m][1] * r;
                            if (act) {
#pragma unroll
                                for (int j = 0; j < 4; ++j) { v0[j] = v0[j] * sigmoidf_(v0[j]); v1[j] = v1[j] * sigmoidf_(v1[j]); } }
                            store8(dst + (size_t)row * 512 + cb + bj * HALF, v0, v1); } }
            }
        } else {
            const int col0 = u.pn * BM + colL;
            bf16_t* ob = (bf16_t*)(ws + (mode == 1 ? WS_KX : (mode == 4 ? WS_XQ : WS_U))); const int ldo = mode == 5 ? DFF : 1024;
#pragma unroll
            for (int ai = 0; ai < 2; ++ai)
#pragma unroll
                for (int m = 0; m < 4; ++m) { const int row = row0 + ai * HALF + m * 16; const float r = rsc[ai * 4 + m];
#pragma unroll
                    for (int bj = 0; bj < 2; ++bj) { f32x4 v0 = acc[ai][bj][m][0] * r, v1 = acc[ai][bj][m][1] * r;
                        if (mode == 5) {
#pragma unroll
                            for (int j = 0; j < 4; ++j) { const float a = fmaxf(v0[j], 0.f), b = fmaxf(v1[j], 0.f); v0[j] = a * a; v1[j] = b * b; } }
                        store8(ob + (size_t)row * ldo + col0 + bj * HALF, v0, v1); } }
        }
    }
};

template <class EpiT, class Sched>
__device__ __forceinline__ void gemm_phase(LAS unsigned char* lds, const Gemm g, const Sched S, const EpiT E) {
    const int tid = threadIdx.x, wid = __builtin_amdgcn_readfirstlane(tid >> 6), lane = tid & 63, wr = wid >> 2, wc = wid & 3, fr = lane & 15, fq = lane >> 4;
    const int K = g.K, nt = K / BK;
    unsigned voffA[2], voffB[2];
#pragma unroll
    for (int i = 0; i < 2; ++i) { int R, C; stage_rc(tid * 16 + i * 8192, R, C); const int Rb = EpiT::PERM ? ((R & ~31) + perm32(R & 31)) : R;
        voffA[i] = (unsigned)(R * K + C) * 2u; voffB[i] = (unsigned)(Rb * K + C) * 2u; }
    const size_t kstep = (size_t)(BK * 2);
    const size_t hstep = (size_t)HALF * K * 2;
    const size_t tstep = 2 * hstep;
    const unsigned ldsw = (unsigned)wid * 1024u;
    const int aoff = lds_byte(wr * 64 + fr, fq * 8), boff = lds_byte(wc * 32 + fr, fq * 8);
#define PG8_SA(b, h) (((b) * 2 + (h)) * HTB)
#define PG8_SB(b, h) ((4 + (b) * 2 + (h)) * HTB)
#define PG8_STAGE(bufoff, gbase, voff) do { _Pragma("unroll") for (int _i = 0; _i < 2; ++_i) \
        __builtin_amdgcn_global_load_lds((const unsigned*)((const char*)(gbase) + (voff)[_i]), (LAS unsigned*)(lds + (bufoff) + ldsw + _i * 8192), 16, 0, 0); } while (0)
#define PG8_LDA(dst, b, h) do { _Pragma("unroll") for (int m = 0; m < 4; ++m) _Pragma("unroll") for (int k = 0; k < 2; ++k) dst[m][k] = *(const LAS bf16x8*)(lds + PG8_SA(b, h) + aoff + m * 2048 + k * 1024); } while (0)
#define PG8_LDB(dst, b, h) do { _Pragma("unroll") for (int n = 0; n < 2; ++n) _Pragma("unroll") for (int k = 0; k < 2; ++k) dst[n][k] = *(const LAS bf16x8*)(lds + PG8_SB(b, h) + boff + n * 2048 + k * 1024); } while (0)
#define PG8_MMA(ai, bj, At, Bt) do { __builtin_amdgcn_s_setprio(1); _Pragma("unroll") for (int m = 0; m < 4; ++m) _Pragma("unroll") for (int n = 0; n < 2; ++n) _Pragma("unroll") for (int k = 0; k < 2; ++k) \
        acc[ai][bj][m][n] = __builtin_amdgcn_mfma_f32_16x16x32_bf16(Bt[n][k], At[m][k], acc[ai][bj][m][n], 0, 0, 0); __builtin_amdgcn_s_setprio(0); } while (0)
#define PG8_WAIT_V(n) asm volatile("s_waitcnt vmcnt(" #n ")" ::: "memory")
#define PG8_WAIT_L(n) asm volatile("s_waitcnt lgkmcnt(" #n ")" ::: "memory")
#define PG8_BAR __builtin_amdgcn_s_barrier()
#define PG8_SCHED __builtin_amdgcn_sched_barrier(0)
    Unit cur, nxt; int ui = 0;
    if (!S.next(0, cur)) return;
    f32x4 acc[2][2][4][2];
#pragma unroll
    for (int a = 0; a < 2; ++a)
#pragma unroll
        for (int b = 0; b < 2; ++b)
#pragma unroll
            for (int m = 0; m < 4; ++m)
#pragma unroll
                for (int n = 0; n < 2; ++n) acc[a][b][m][n] = (f32x4){0.f, 0.f, 0.f, 0.f};
    bf16x8 At[4][2], B0[2][2], B1[2][2];
    const char* cA = (const char*)g.A + (size_t)cur.pm * tstep; const char* cB = (const char*)g.Bt + (size_t)cur.pn * tstep;
    PG8_STAGE(PG8_SB(0, 0), cB, voffB); PG8_STAGE(PG8_SA(0, 0), cA, voffA); PG8_STAGE(PG8_SB(0, 1), cB + hstep, voffB); PG8_STAGE(PG8_SA(0, 1), cA + hstep, voffA);
    if (wr == 1) PG8_BAR;
    PG8_WAIT_V(4); PG8_BAR;
    PG8_STAGE(PG8_SB(1, 0), cB + kstep, voffB); PG8_STAGE(PG8_SA(1, 0), cA + kstep, voffA); PG8_STAGE(PG8_SB(1, 1), cB + hstep + kstep, voffB);
    PG8_WAIT_V(6); PG8_BAR;
    for (;;) {
        const bool has_next = S.next(ui + 1, nxt);
        const char* nA = has_next ? (const char*)g.A + (size_t)nxt.pm * tstep : cA; const char* nB = has_next ? (const char*)g.Bt + (size_t)nxt.pn * tstep : cB;
        for (int t = 0; t < nt; t += 2) {
            const bool last = (t == nt - 2);
            const char* a1 = cA + (size_t)(t + 1) * kstep;
            const char* a2 = last ? nA : cA + (size_t)(t + 2) * kstep; const char* b2 = last ? nB : cB + (size_t)(t + 2) * kstep;
            const char* a3 = a2 + kstep; const char* b3 = b2 + kstep;
            PG8_LDB(B0, 0, 0); PG8_SCHED; PG8_LDA(At, 0, 0); PG8_STAGE(PG8_SA(1, 1), a1 + hstep, voffA);
            PG8_WAIT_L(8); PG8_BAR; PG8_WAIT_L(0); PG8_MMA(0, 0, At, B0); PG8_BAR; PG8_SCHED;
            PG8_LDB(B1, 0, 1); PG8_STAGE(PG8_SB(0, 0), b2, voffB);
            PG8_BAR; PG8_WAIT_L(0); PG8_MMA(0, 1, At, B1); PG8_BAR;
            PG8_LDA(At, 0, 1); PG8_STAGE(PG8_SA(0, 0), a2, voffA);
            PG8_BAR; PG8_WAIT_L(0); PG8_MMA(1, 0, At, B0); PG8_BAR; PG8_SCHED;
            PG8_STAGE(PG8_SB(0, 1), b2 + hstep, voffB);
            PG8_WAIT_V(6); PG8_BAR; PG8_MMA(1, 1, At, B1); PG8_BAR;
            PG8_LDB(B0, 1, 0); PG8_SCHED; PG8_LDA(At, 1, 0); PG8_STAGE(PG8_SA(0, 1), a2 + hstep, voffA);
            PG8_WAIT_L(8); PG8_BAR; PG8_WAIT_L(0); PG8_MMA(0, 0, At, B0); PG8_BAR; PG8_SCHED;
            PG8_LDB(B1, 1, 1); PG8_STAGE(PG8_SB(1, 0), b3, voffB);
            PG8_BAR; PG8_WAIT_L(0); PG8_MMA(0, 1, At, B1); PG8_BAR;
            PG8_LDA(At, 1, 1); PG8_STAGE(PG8_SA(1, 0), a3, voffA);
            PG8_BAR; PG8_WAIT_L(0); PG8_MMA(1, 0, At, B0); PG8_BAR; PG8_SCHED;
            PG8_STAGE(PG8_SB(1, 1), b3 + hstep, voffB);
            PG8_WAIT_V(6); PG8_BAR; PG8_MMA(1, 1, At, B1); PG8_BAR;
        }
        E(acc, cur, wr, wc, fr, fq);
        if (!has_next) break;
#pragma unroll
        for (int a = 0; a < 2; ++a)
#pragma unroll
            for (int b = 0; b < 2; ++b)
#pragma unroll
                for (int m = 0; m < 4; ++m)
#pragma unroll
                    for (int n = 0; n < 2; ++n) acc[a][b][m][n] = (f32x4){0.f, 0.f, 0.f, 0.f};
        cur = nxt; cA = nA; cB = nB; ++ui;
    }
    PG8_WAIT_V(0);
    if (wr == 0) PG8_BAR;
    PG8_BAR;
#undef PG8_SA
#undef PG8_SB
#undef PG8_STAGE
#undef PG8_LDA
#undef PG8_LDB
#undef PG8_MMA
#undef PG8_WAIT_V
#undef PG8_WAIT_L
#undef PG8_BAR
#undef PG8_SCHED
}
}

struct Params {
    const float *x, *mem, *norm_mix_g, *w_in, *lb_logits, *hgrn_norm_g, *w_pool, *pool_scale, *w_out, *norm_x_g, *norm_mem_g, *w_xq, *w_xk, *w_xv, *w_xo, *norm_ffn_g, *w_ff1, *w_ff2, *final_norm_g;
    float* out; unsigned char* ws;
    int ph_lo, ph_hi;
};

__device__ __forceinline__ void prep_transpose_tile(const float* __restrict__ W, int N, const float* __restrict__ g, bf16_t* __restrict__ out, int ldo, int kt, int nt, unsigned char* lds) {
    bf16_t* T = (bf16_t*)lds;
    const int tid = threadIdx.x, r = tid >> 4, c4 = tid & 15;
#pragma unroll
    for (int i = 0; i < 4; ++i) {
        const int kl = r + 32 * i, k = 128 * kt + kl;
        const f32x4 v = *(const f32x4*)(W + (size_t)k * N + 64 * nt + 4 * c4);
        const float s = g ? g[k] : 1.0f;
        T[(4 * c4 + 0) * 136 + kl] = f2bf(v[0] * s); T[(4 * c4 + 1) * 136 + kl] = f2bf(v[1] * s);
        T[(4 * c4 + 2) * 136 + kl] = f2bf(v[2] * s); T[(4 * c4 + 3) * 136 + kl] = f2bf(v[3] * s);
    }
    __syncthreads();
    const int n = tid >> 3, ks = tid & 7;
    const u32x4* src = (const u32x4*)(T + n * 136 + 16 * ks);
    const u32x4 a = src[0], b = src[1];
    u32x4* dst = (u32x4*)(out + (size_t)(64 * nt + n) * ldo + 128 * kt + 16 * ks);
    dst[0] = a; dst[1] = b;
    __syncthreads();
}

__device__ __forceinline__ void phase_prep(const Params p, unsigned char* lds) {
    unsigned char* ws = p.ws;
    const int G = gridDim.x;
    for (int t = blockIdx.x; t < 1920; t += G) {
        if (t < 320)       { prep_transpose_tile(p.w_in, NIN, p.norm_mix_g, (bf16_t*)(ws + WS_WT_IN), 1024, t / 40, t % 40, lds); }
        else if (t < 448)  { const int u = t - 320;  prep_transpose_tile(p.w_xk, 1024, p.norm_mem_g, (bf16_t*)(ws + WS_WT_K), 1024, u / 16, u % 16, lds); }
        else if (t < 576)  { const int u = t - 448;  prep_transpose_tile(p.w_xv, 1024, p.norm_mem_g, (bf16_t*)(ws + WS_WT_V), 1024, u / 16, u % 16, lds); }
        else if (t < 704)  { const int u = t - 576;  prep_transpose_tile(p.w_xq, 1024, p.norm_x_g, (bf16_t*)(ws + WS_WT_Q), 1024, u / 16, u % 16, lds); }
        else if (t < 832)  { const int u = t - 704;  prep_transpose_tile(p.w_xo, 1024, nullptr, (bf16_t*)(ws + WS_WT_O), 1024, u / 16, u % 16, lds); }
        else if (t < 896)  { const int u = t - 832;  prep_transpose_tile(p.w_out, 1024, nullptr, (bf16_t*)(ws + WS_WT_OUT), 1024, u / 16, u % 16, lds); }
        else if (t < 1408) { const int u = t - 896;  prep_transpose_tile(p.w_ff1, DFF, p.norm_ffn_g, (bf16_t*)(ws + WS_WT_FF1), 1024, u / 64, u % 64, lds); }
        else               { const int u = t - 1408; prep_transpose_tile(p.w_ff2, 1024, nullptr, (bf16_t*)(ws + WS_WT_FF2), 4096, u / 16, u % 16, lds); }
    }
    {
        bf16_t* wto = (bf16_t*)(ws + WS_WT_OUT);
        for (int item = blockIdx.x * NTHREADS + threadIdx.x; item < 65536; item += G * NTHREADS) {
            const int n = item & 1023, cgp = item >> 10, gi = cgp >> 4, c0 = (cgp & 15) * 8;
            float a[8];
#pragma unroll
            for (int j = 0; j < 8; ++j) a[j] = 0.f;
            const float* wp = p.w_pool + (size_t)(gi * 128 + c0) * 128;
            for (int d = 0; d < 128; ++d) {
                const float wo = p.w_out[(size_t)(512 + gi * 128 + d) * 1024 + n] * p.pool_scale[gi * 128 + d];
#pragma unroll
                for (int j = 0; j < 8; ++j) a[j] += wp[j * 128 + d] * wo;
            }
            u32x4 w; w.x = cvt_pk_bf16(a[0], a[1]); w.y = cvt_pk_bf16(a[2], a[3]); w.z = cvt_pk_bf16(a[4], a[5]); w.w = cvt_pk_bf16(a[6], a[7]);
            *(u32x4*)(wto + (size_t)n * 1024 + 512 + gi * 128 + c0) = w;
        }
    }
    {
        const int lane = threadIdx.x & 63, gw = blockIdx.x * (NTHREADS / 64) + (threadIdx.x >> 6), nw = G * (NTHREADS / 64);
        for (int r = gw; r < MROWS + MEMROWS; r += nw) {
            const bool isx = r < MROWS;
            const float* src = isx ? p.x + (size_t)r * DM : p.mem + (size_t)(r - MROWS) * DM;
            bf16_t* dst = isx ? (bf16_t*)(ws + WS_XB) + (size_t)r * DM : (bf16_t*)(ws + WS_MEMB) + (size_t)(r - MROWS) * DM;
            f32x4 v[4]; float ss = 0.f;
#pragma unroll
            for (int i = 0; i < 4; ++i) { v[i] = ((const f32x4*)src)[lane + 64 * i]; ss += (v[i][0] * v[i][0] + v[i][1] * v[i][1]) + (v[i][2] * v[i][2] + v[i][3] * v[i][3]); }
#pragma unroll
            for (int o = 1; o < 64; o <<= 1) ss += __shfl_xor(ss, o);
#pragma unroll
            for (int i = 0; i < 4; ++i) { u32x2 w; w.x = cvt_pk_bf16(v[i][0], v[i][1]); w.y = cvt_pk_bf16(v[i][2], v[i][3]); ((u32x2*)dst)[lane + 64 * i] = w; }
            if (lane == 0) { const float rstd = rsqrtf(ss * (1.0f / 1024.0f) + EPS); if (isx) ((float*)(ws + WS_RSTD0))[r] = rstd; else ((float*)(ws + WS_RSTDM))[r - MROWS] = rstd; }
        }
    }
}

__device__ void hgrn_passA_unit(const bf16_t* __restrict__ KH, const float* __restrict__ LF, const bf16_t* __restrict__ VH, bf16_t* __restrict__ LT, float* __restrict__ DEC, int unit, unsigned char* lds) {
    const int tid = threadIdx.x, ch = tid & 127, seg = tid >> 7;
    const int b = unit >> 8, c = (unit >> 2) & 63, h = unit & 3;
    const int row0 = b * SEQ + c * 64, bh = b * 4 + h;
    float* segtot = (float*)lds;
    unsigned char* KdT = lds + 2048;
    unsigned char* VTl = lds + 2048 + 18432;
    const size_t g0 = (size_t)(row0 + seg * 16) * 512 + h * 128 + ch;
    float lf[16], kk[16], vv[16];
#pragma unroll
    for (int i = 0; i < 16; ++i) { lf[i] = LF[g0 + (size_t)i * 512]; kk[i] = bf2f(KH[g0 + (size_t)i * 512]); vv[i] = bf2f(VH[g0 + (size_t)i * 512]); }
#pragma unroll
    for (int i = 1; i < 16; ++i) lf[i] += lf[i - 1];
    segtot[seg * 128 + ch] = lf[15];
    __syncthreads();
    float after = 0.f;
#pragma unroll
    for (int s2 = 1; s2 < 4; ++s2) if (s2 > seg) after += segtot[s2 * 128 + ch];
    const float tot = after + lf[15];
    if (seg == 0) DEC[(size_t)(bh * 64 + c) * 128 + ch] = __expf(tot);
    unsigned kd[8], vp[8];
#pragma unroll
    for (int i = 0; i < 8; ++i) {
        kd[i] = cvt_pk_bf16(kk[2 * i] * __expf(tot - lf[2 * i]), kk[2 * i + 1] * __expf(tot - lf[2 * i + 1]));
        vp[i] = cvt_pk_bf16(vv[2 * i], vv[2 * i + 1]);
    }
    { u32x4* d = (u32x4*)(KdT + ch * 144 + seg * 32); d[0] = (u32x4){kd[0], kd[1], kd[2], kd[3]}; d[1] = (u32x4){kd[4], kd[5], kd[6], kd[7]}; }
    { u32x4* d = (u32x4*)(VTl + ch * 144 + seg * 32); d[0] = (u32x4){vp[0], vp[1], vp[2], vp[3]}; d[1] = (u32x4){vp[4], vp[5], vp[6], vp[7]}; }
    __syncthreads();
    const int w = tid >> 6, lane = tid & 63, fr = lane & 15, q = lane >> 4;
    bf16x8 a[2];
#pragma unroll
    for (int ks = 0; ks < 2; ++ks) a[ks] = *(const bf16x8*)(KdT + (16 * w + fr) * 144 + (32 * ks + 8 * q) * 2);
    bf16_t* ltp = LT + (size_t)(bh * 64 + c) * 16384;
#pragma unroll
    for (int vb = 0; vb < 8; ++vb) {
        f32x4 acc = (f32x4){0.f, 0.f, 0.f, 0.f};
#pragma unroll
        for (int ks = 0; ks < 2; ++ks) { const bf16x8 bfr = *(const bf16x8*)(VTl + (16 * vb + fr) * 144 + (32 * ks + 8 * q) * 2); acc = mfma16(a[ks], bfr, acc); }
        u32x2 pk; pk.x = cvt_pk_bf16(acc[0], acc[1]); pk.y = cvt_pk_bf16(acc[2], acc[3]);
        *(u32x2*)(ltp + (size_t)(16 * vb + fr) * 128 + 16 * w + 4 * q) = pk;
    }
    __syncthreads();
}

__device__ void pool_tile(const bf16_t* __restrict__ PH, bf16_t* __restrict__ MIXED, int tile) {
    const int tid = threadIdx.x, cp = tid & 255, th = tid >> 8, c0 = 2 * cp, gi = c0 >> 7, w = 2 << gi;
    const int r0 = tile * 64 + th * 32, s0 = r0 & (SEQ - 1);
    float sx = 0.f, sy = 0.f;
    for (int j = 1; j < w; ++j) if (s0 - j >= 0) { const unsigned u = *(const unsigned*)(PH + (size_t)(r0 - j) * 512 + c0); sx += bflo(u); sy += bfhi(u); }
    for (int tt = 0; tt < 32; ++tt) {
        const int r = r0 + tt, s = s0 + tt;
        const unsigned u = *(const unsigned*)(PH + (size_t)r * 512 + c0);
        const float px = bflo(u), py = bfhi(u);
        sx += px; sy += py;
        const int cnt = (s + 1) < w ? (s + 1) : w;
        const float inv = 1.0f / (float)cnt;
        *(unsigned*)(MIXED + (size_t)r * 1024 + 512 + c0) = cvt_pk_bf16(sx * inv - px, sy * inv - py);
        if (s - (w - 1) >= 0) { const unsigned u2 = *(const unsigned*)(PH + (size_t)(r - (w - 1)) * 512 + c0); sx -= bflo(u2); sy -= bfhi(u2); }
    }
}

__device__ void phase_scan(const bf16_t* __restrict__ LT, const float* __restrict__ DEC, bf16_t* __restrict__ ST) {
    for (int e2 = blockIdx.x * NTHREADS + threadIdx.x; e2 < 131072; e2 += gridDim.x * NTHREADS) {
        const int bh = e2 >> 13, v = (e2 >> 6) & 127, kp = e2 & 63;
        float sx = 0.f, sy = 0.f;
        const size_t base = (size_t)bh * 64 * 16384 + (size_t)v * 128 + 2 * kp;
        const float* dp = DEC + (size_t)bh * 64 * 128 + 2 * kp;
        for (int c0 = 0; c0 < 64; c0 += 8) {
            unsigned l[8]; f32x2 d[8];
#pragma unroll
            for (int j = 0; j < 8; ++j) { l[j] = *(const unsigned*)(LT + base + (size_t)(c0 + j) * 16384); d[j] = *(const f32x2*)(dp + (c0 + j) * 128); }
#pragma unroll
            for (int j = 0; j < 8; ++j) {
                *(unsigned*)(ST + base + (size_t)(c0 + j) * 16384) = cvt_pk_bf16(sx, sy);
                sx = d[j][0] * sx + bflo(l[j]); sy = d[j][1] * sy + bfhi(l[j]);
            }
        }
    }
}

__device__ void hgrn_passC_unit(const bf16_t* __restrict__ QH, const bf16_t* __restrict__ KH, const float* __restrict__ LF, const bf16_t* __restrict__ VH, const bf16_t* __restrict__ GH,
                                const bf16_t* __restrict__ ST, const float* __restrict__ hg, bf16_t* __restrict__ MIXED, int unit, unsigned char* lds) {
    const int tid = threadIdx.x, ch = tid & 127, seg = tid >> 7;
    const int b = unit >> 8, c = (unit >> 2) & 63, h = unit & 3;
    const int row0 = b * SEQ + c * 64, bh = b * 4 + h;
    float* segtot = (float*)lds;
    float* rmsp = (float*)(lds + 2048);
    bf16_t* QC = (bf16_t*)(lds + 4096);
    bf16_t* QT = (bf16_t*)(lds + 21504);
    constexpr int KT0 = 38912;
    unsigned char* VTl = lds + 82432;
    const size_t g0 = (size_t)(row0 + seg * 16) * 512 + h * 128 + ch;
    float lf[16];
#pragma unroll
    for (int i = 0; i < 16; ++i) lf[i] = LF[g0 + (size_t)i * 512];
#pragma unroll
    for (int i = 1; i < 16; ++i) lf[i] += lf[i - 1];
    segtot[seg * 128 + ch] = lf[15];
    {
        unsigned vp[8];
#pragma unroll
        for (int i = 0; i < 8; ++i) vp[i] = (unsigned)VH[g0 + (size_t)(2 * i) * 512] | ((unsigned)VH[g0 + (size_t)(2 * i + 1) * 512] << 16);
        u32x4* d = (u32x4*)(VTl + ch * 144 + seg * 32); d[0] = (u32x4){vp[0], vp[1], vp[2], vp[3]}; d[1] = (u32x4){vp[4], vp[5], vp[6], vp[7]};
    }
    __syncthreads();
    const float t0 = segtot[ch], t1 = segtot[128 + ch], t2 = segtot[256 + ch];
    const float P = (seg > 0 ? t0 : 0.f) + (seg > 1 ? t1 : 0.f) + (seg > 2 ? t2 : 0.f);
    {
#pragma unroll
        for (int i = 0; i < 16; ++i) {
            const float qv = bf2f(QH[g0 + (size_t)i * 512]);
            const float el = __expf(lf[i]);
            QT[(seg * 16 + i) * 136 + ch] = f2bf(qv * el);
            QC[(seg * 16 + i) * 136 + ch] = f2bf(qv * el * __expf(P));
        }
        float kk[16];
#pragma unroll
        for (int i = 0; i < 16; ++i) kk[i] = bf2f(KH[g0 + (size_t)i * 512]);
        float E = 0.f;
#pragma unroll
        for (int i = 0; i < 4; ++i) {
            if (i >= seg) {
                bf16_t* KT = (bf16_t*)(lds + KT0 + 4352 * ((i * (i + 1)) / 2));
#pragma unroll
                for (int j = 0; j < 16; ++j) KT[(seg * 16 + j) * 136 + ch] = f2bf(kk[j] * __expf(E - lf[j]));
                E += (i == 0 ? t0 : (i == 1 ? t1 : t2));
            }
        }
    }
    __syncthreads();
    const int w = tid >> 6, lane = tid & 63, fr = lane & 15, q = lane >> 4;
    const int i = w & 3, vh = w >> 2;
    f32x4 sT[4];
#pragma unroll
    for (int j = 0; j < 4; ++j) sT[j] = (f32x4){0.f, 0.f, 0.f, 0.f};
    {
        bf16x8 qfr[4];
#pragma unroll
        for (int ks = 0; ks < 4; ++ks) qfr[ks] = *(const bf16x8*)((const unsigned char*)QT + (16 * i + fr) * 272 + (32 * ks + 8 * q) * 2);
        const unsigned char* KT = lds + KT0 + 4352 * ((i * (i + 1)) / 2);
#pragma unroll
        for (int j = 0; j < 4; ++j) if (j <= i) {
#pragma unroll
            for (int ks = 0; ks < 4; ++ks) { const bf16x8 a = *(const bf16x8*)(KT + (16 * j + fr) * 272 + (32 * ks + 8 * q) * 2); sT[j] = mfma16(a, qfr[ks], sT[j]); }
            if (j == i) {
#pragma unroll
                for (int rg = 0; rg < 4; ++rg) if (4 * q + rg > fr) sT[j][rg] = 0.f;
            }
        }
    }
    f32x4 oacc[4];
#pragma unroll
    for (int vbl = 0; vbl < 4; ++vbl) oacc[vbl] = (f32x4){0.f, 0.f, 0.f, 0.f};
#pragma unroll
    for (int m = 0; m < 2; ++m) if (2 * m <= i) {
        const bf16x8 bfrag = mk8u(cvt_pk_bf16(sT[2 * m][0], sT[2 * m][1]), cvt_pk_bf16(sT[2 * m][2], sT[2 * m][3]), cvt_pk_bf16(sT[2 * m + 1][0], sT[2 * m + 1][1]), cvt_pk_bf16(sT[2 * m + 1][2], sT[2 * m + 1][3]));
#pragma unroll
        for (int vbl = 0; vbl < 4; ++vbl) {
            const unsigned char* base = VTl + (16 * (vh * 4 + vbl) + fr) * 144 + (32 * m + 4 * q) * 2;
            const bf16x8 a = mk8(*(const u32x2*)base, *(const u32x2*)(base + 32));
            oacc[vbl] = mfma16(a, bfrag, oacc[vbl]);
        }
    }
    {
        const bf16_t* stp = ST + (size_t)(bh * 64 + c) * 16384;
#pragma unroll
        for (int ks = 0; ks < 4; ++ks) {
            const bf16x8 bfr = *(const bf16x8*)((const unsigned char*)QC + (16 * i + fr) * 272 + (32 * ks + 8 * q) * 2);
#pragma unroll
            for (int vbl = 0; vbl < 4; ++vbl) { const bf16x8 a = *(const bf16x8*)(stp + (size_t)(16 * (vh * 4 + vbl) + fr) * 128 + 32 * ks + 8 * q); oacc[vbl] = mfma16(a, bfr, oacc[vbl]); }
        }
    }
    float ss = 0.f;
#pragma unroll
    for (int vbl = 0; vbl < 4; ++vbl) ss += (oacc[vbl][0] * oacc[vbl][0] + oacc[vbl][1] * oacc[vbl][1]) + (oacc[vbl][2] * oacc[vbl][2] + oacc[vbl][3] * oacc[vbl][3]);
    ss += __shfl_xor(ss, 16); ss += __shfl_xor(ss, 32);
    if (q == 0) rmsp[vh * 64 + 16 * i + fr] = ss;
    __syncthreads();
    const float rstd = rsqrtf((rmsp[16 * i + fr] + rmsp[64 + 16 * i + fr]) * (1.0f / 128.0f) + EPS);
    const size_t row = (size_t)(row0 + 16 * i + fr);
#pragma unroll
    for (int vbl = 0; vbl < 4; ++vbl) {
        const int v0 = 16 * (vh * 4 + vbl) + 4 * q;
        const u32x2 gt = *(const u32x2*)(GH + row * 512 + h * 128 + v0);
        const f32x4 gg = *(const f32x4*)(hg + h * 128 + v0);
        u32x2 o;
        o.x = cvt_pk_bf16(oacc[vbl][0] * rstd * gg[0] * bflo(gt.x), oacc[vbl][1] * rstd * gg[1] * bfhi(gt.x));
        o.y = cvt_pk_bf16(oacc[vbl][2] * rstd * gg[2] * bflo(gt.y), oacc[vbl][3] * rstd * gg[3] * bfhi(gt.y));
        *(u32x2*)(MIXED + row * 1024 + h * 128 + v0) = o;
    }
    __syncthreads();
}

__device__ void attn_unit(const bf16_t* __restrict__ XQ, const bf16_t* __restrict__ KX, const bf16_t* __restrict__ VT, bf16_t* __restrict__ ATT, int unit, unsigned char* lds) {
    const int tid = threadIdx.x, w = tid >> 6, lane = tid & 63, r = lane & 31, hh = lane >> 5;
    const int b = unit >> 6, st = (unit >> 2) & 15, h = unit & 3;
    const int row0 = b * SEQ + st * 256;
    const bf16_t* qp = XQ + (size_t)(row0 + 32 * w + r) * 1024 + h * 256 + 8 * hh;
    {
        const bf16_t* kp = KX + (size_t)(b * 256) * 1024 + h * 256;
#pragma unroll
        for (int it = 0; it < 16; ++it) { const int idx = tid + 512 * it, m = idx >> 5, cc = idx & 31;
            const u32x4 v = *(const u32x4*)(kp + (size_t)m * 1024 + cc * 8); *(u32x4*)(lds + m * 528 + cc * 16) = v; }
    }
    __syncthreads();
    f32x16 sacc[8];
#pragma unroll
    for (int mb = 0; mb < 8; ++mb)
#pragma unroll
        for (int e = 0; e < 16; ++e) sacc[mb][e] = 0.f;
    for (int kg = 0; kg < 4; ++kg) {
        bf16x8 qf[4];
#pragma unroll
        for (int k4 = 0; k4 < 4; ++k4) qf[k4] = *(const bf16x8*)(qp + 16 * (4 * kg + k4));
#pragma unroll
        for (int k4 = 0; k4 < 4; ++k4)
#pragma unroll
            for (int mb = 0; mb < 8; ++mb) { const bf16x8 a = *(const bf16x8*)(lds + (32 * mb + r) * 528 + (16 * (4 * kg + k4) + 8 * hh) * 2); sacc[mb] = mfma32(a, qf[k4], sacc[mb]); }
    }
    float mx = -3.0e38f;
#pragma unroll
    for (int mb = 0; mb < 8; ++mb)
#pragma unroll
        for (int e = 0; e < 16; ++e) mx = fmaxf(mx, sacc[mb][e]);
    mx = fmaxf(mx, __shfl_xor(mx, 32));
    float sum = 0.f;
    bf16x8 pf[8][2];
#pragma unroll
    for (int mb = 0; mb < 8; ++mb) {
        float pv[16];
#pragma unroll
        for (int e = 0; e < 16; ++e) { pv[e] = __expf(sacc[mb][e] - mx); sum += pv[e]; }
#pragma unroll
        for (int s = 0; s < 2; ++s) pf[mb][s] = mk8u(cvt_pk_bf16(pv[8 * s + 0], pv[8 * s + 1]), cvt_pk_bf16(pv[8 * s + 2], pv[8 * s + 3]), cvt_pk_bf16(pv[8 * s + 4], pv[8 * s + 5]), cvt_pk_bf16(pv[8 * s + 6], pv[8 * s + 7]));
    }
    sum += __shfl_xor(sum, 32);
    const float inv = 1.0f / sum;
    __syncthreads();
    {
        const bf16_t* vp = VT + (size_t)(h * 256) * 1024 + b * 256;
#pragma unroll
        for (int it = 0; it < 16; ++it) { const int idx = tid + 512 * it, e = idx >> 5, cc = idx & 31;
            const u32x4 v = *(const u32x4*)(vp + (size_t)e * 1024 + cc * 8);
            u32x2* d = (u32x2*)(lds + e * 520 + cc * 16); d[0] = (u32x2){v.x, v.y}; d[1] = (u32x2){v.z, v.w}; }
    }
    __syncthreads();
    bf16_t* op = ATT + (size_t)(row0 + 32 * w + r) * 1024 + h * 256 + 4 * hh;
#pragma unroll
    for (int half = 0; half < 2; ++half) {
        f32x16 oacc[4];
#pragma unroll
        for (int d = 0; d < 4; ++d)
#pragma unroll
            for (int e = 0; e < 16; ++e) oacc[d][e] = 0.f;
#pragma unroll
        for (int mb = 0; mb < 8; ++mb)
#pragma unroll
            for (int s = 0; s < 2; ++s)
#pragma unroll
                for (int d = 0; d < 4; ++d) {
                    const unsigned char* base = lds + (32 * (half * 4 + d) + r) * 520 + (32 * mb + 16 * s + 4 * hh) * 2;
                    const bf16x8 a = mk8(*(const u32x2*)base, *(const u32x2*)(base + 16));
                    oacc[d] = mfma32(a, pf[mb][s], oacc[d]);
                }
#pragma unroll
        for (int d = 0; d < 4; ++d)
#pragma unroll
            for (int g = 0; g < 4; ++g) {
                u32x2 o; o.x = cvt_pk_bf16(oacc[d][4 * g] * inv, oacc[d][4 * g + 1] * inv); o.y = cvt_pk_bf16(oacc[d][4 * g + 2] * inv, oacc[d][4 * g + 3] * inv);
                *(u32x2*)(op + 32 * (half * 4 + d) + 8 * g) = o;
            }
    }
    __syncthreads();
}

__device__ void phase_final(float* __restrict__ out, const float* __restrict__ g) {
    const int lane = threadIdx.x & 63, gw = blockIdx.x * (NTHREADS / 64) + (threadIdx.x >> 6), nw = gridDim.x * (NTHREADS / 64);
    f32x4 gv[4];
#pragma unroll
    for (int i = 0; i < 4; ++i) gv[i] = ((const f32x4*)g)[lane + 64 * i];
    for (int r = gw; r < MROWS; r += nw) {
        f32x4* row = (f32x4*)(out + (size_t)r * DM);
        f32x4 v[4]; float ss = 0.f;
#pragma unroll
        for (int i = 0; i < 4; ++i) { v[i] = row[lane + 64 * i]; ss += (v[i][0] * v[i][0] + v[i][1] * v[i][1]) + (v[i][2] * v[i][2] + v[i][3] * v[i][3]); }
#pragma unroll
        for (int o = 1; o < 64; o <<= 1) ss += __shfl_xor(ss, o);
        const float rstd = rsqrtf(ss * (1.0f / 1024.0f) + EPS);
#pragma unroll
        for (int i = 0; i < 4; ++i) row[lane + 64 * i] = v[i] * rstd * gv[i];
    }
}

#define XB_TMO      128
#define XB_XCNT(j)  (256  + 64 * (j))
#define XB_XSUB(j)  (1280 + 64 * (j))
#define XB_XGEN(j)  (2304 + 64 * (j))
#define XB_TOP      3328
#define XB_TOPGEN   3392
#define XCD_BAR_WORDS 3456
#define XB_SPIN_CAP (1u << 22)
__device__ __forceinline__ unsigned xb_ld(unsigned* p)              { return __hip_atomic_load(p, __ATOMIC_RELAXED, __HIP_MEMORY_SCOPE_AGENT); }
__device__ __forceinline__ unsigned xb_add(unsigned* p, unsigned v) { return __hip_atomic_fetch_add(p, v, __ATOMIC_RELAXED, __HIP_MEMORY_SCOPE_AGENT); }
__device__ __forceinline__ unsigned xb_xcc_id() { return (unsigned)__builtin_amdgcn_s_getreg((3 << 11) | 20) & 0xFu; }
#define XB_SPIN(cond, bar) do { unsigned _sp = 0; while (cond) { __builtin_amdgcn_s_sleep(1); \
    if ((++_sp & 255u) == 0u) { if (xb_ld(&(bar)[XB_TMO])) break; if (_sp > XB_SPIN_CAP) { atomicAdd(&(bar)[XB_TMO], 1u); break; } } } } while (0)
struct XcdBarrier { unsigned* bar; unsigned x; volatile LAS unsigned* st; };
__device__ __forceinline__ XcdBarrier xcd_barrier_post(unsigned* bar, volatile LAS unsigned* st) {
    XcdBarrier b; b.bar = bar; b.x = xb_xcc_id(); b.st = st;
    if (threadIdx.x == 0) (void)xb_add(&bar[XB_XCNT(b.x)], 1u);
    return b;
}
__device__ __forceinline__ void xcd_barrier_complete(unsigned* bar, unsigned x, unsigned& nloc, unsigned& nx) {
    const unsigned G = gridDim.x * gridDim.y * gridDim.z;
    unsigned sum, cnt, mine, sp = 0u;
    for (;;) {
        sum = 0u; cnt = 0u; mine = 0u;
#pragma unroll
        for (unsigned j = 0; j < 16; ++j) { const unsigned c = xb_ld(&bar[XB_XCNT(j)]); sum += c; cnt += (c > 0u) ? 1u : 0u; mine = (j == x) ? c : mine; }
        if (sum == G) break;
        __builtin_amdgcn_s_sleep(1);
        if ((++sp & 255u) == 0u) { if (xb_ld(&bar[XB_TMO])) break; if (sp > XB_SPIN_CAP) { atomicAdd(&bar[XB_TMO], 1u); break; } }
    }
    nloc = mine > 0u ? mine : 1u; nx = cnt > 0u ? cnt : 1u;
}
__device__ __forceinline__ void xcd_barrier(const XcdBarrier& b) {
    asm volatile("s_waitcnt vmcnt(0)" ::: "memory");
    __syncthreads();
    if (threadIdx.x == 0) {
        unsigned* bar = b.bar;
        __builtin_amdgcn_s_waitcnt(0);
        unsigned nloc = b.st[0], nx = b.st[1];
        if (nloc == 0u) { xcd_barrier_complete(bar, b.x, nloc, nx); b.st[0] = nloc; b.st[1] = nx; }
        const unsigned old = xb_add(&bar[XB_XSUB(b.x)], 1u);
        const unsigned gen = old / nloc;
        if (old + 1u == (gen + 1u) * nloc) {
            __builtin_amdgcn_fence(__ATOMIC_RELEASE, "agent");
            asm volatile("s_waitcnt vmcnt(0)" ::: "memory");
            const unsigned og = xb_add(&bar[XB_TOP], 1u);
            const unsigned tg = og / nx;
            if (og + 1u == (tg + 1u) * nx) xb_add(&bar[XB_TOPGEN], 1u);
            else XB_SPIN(xb_ld(&bar[XB_TOPGEN]) == tg, bar);
            __builtin_amdgcn_fence(__ATOMIC_ACQUIRE, "agent");
            xb_add(&bar[XB_XGEN(b.x)], 1u);
            asm volatile("s_waitcnt vmcnt(0)" ::: "memory");
        } else {
            XB_SPIN(xb_ld(&bar[XB_XGEN(b.x)]) == gen, bar);
            __builtin_amdgcn_fence(__ATOMIC_ACQUIRE, "agent");
            asm volatile("s_waitcnt vmcnt(0)" ::: "memory");
        }
    }
    __syncthreads();
}

constexpr int N_PHASES = 12;
__global__ void __launch_bounds__(NTHREADS, 2) mega(Params p) {
    extern __shared__ __attribute__((aligned(16))) unsigned char lds[];
    LAS unsigned char* ldsl = (LAS unsigned char*)lds;
    unsigned char* ws = p.ws;
    const int G = gridDim.x, bid = blockIdx.x;
    const int lo = p.ph_lo, hi = p.ph_hi;

#ifndef DBG_LAST
#define DBG_LAST -1
#endif
#ifndef PHASE_MASK
#define PHASE_MASK 0xfff
#endif
#define IN(k) (((PHASE_MASK >> (k)) & 1) && lo <= (k) && (k) < hi)
    if (threadIdx.x == 0) { ((volatile LAS unsigned*)(ldsl + LDS_MAIN))[0] = 0u; ((volatile LAS unsigned*)(ldsl + LDS_MAIN))[1] = 0u; }
    __syncthreads();
    XcdBarrier xbar; xbar.bar = (unsigned*)(ws + WS_BAR); xbar.x = 0; xbar.st = nullptr;
    if (hi - lo > 1) xbar = xcd_barrier_post((unsigned*)(ws + WS_BAR), (volatile LAS unsigned*)(ldsl + LDS_MAIN));
    if (lo > hi) cg::this_grid().sync();
#define SEAM(k) do { if (IN(k) && IN((k) + 1)) { xcd_barrier(xbar); } } while (0)
    bf16_t* XB = (bf16_t*)(ws + WS_XB); bf16_t* LT = (bf16_t*)(ws + WS_XB);
    bf16_t* QH = (bf16_t*)(ws + WS_QH); bf16_t* KH = (bf16_t*)(ws + WS_KH); bf16_t* VH = (bf16_t*)(ws + WS_VH); bf16_t* GH = (bf16_t*)(ws + WS_GH); bf16_t* PH = (bf16_t*)(ws + WS_PH);
    float* LF = (float*)(ws + WS_LF); bf16_t* ST = (bf16_t*)(ws + WS_ST); bf16_t* MIXED = (bf16_t*)(ws + WS_MIXED);
    float* X1 = (float*)(ws + WS_X1); bf16_t* XQ = (bf16_t*)(ws + WS_XQ); bf16_t* ATT = (bf16_t*)(ws + WS_ATT); bf16_t* U = (bf16_t*)(ws + WS_U);
    float* SSQ = (float*)(ws + WS_SSQ); float* DEC = (float*)(ws + WS_DEC);
    bf16_t* MEMB = (bf16_t*)(ws + WS_MEMB); bf16_t* KX = (bf16_t*)(ws + WS_KX); bf16_t* VT = (bf16_t*)(ws + WS_VT);

    if (IN(0)) { phase_prep(p, lds); }
    SEAM(0);
    if (IN(1)) {
        const pg8::Epi E{0, ws, p.x, p.out, p.lb_logits};
        { pg8::Gemm g{XB, (const bf16_t*)(ws + WS_WT_IN), MROWS, NIN, DM}; pg8::StaticOrder S; S.init(MROWS, NIN, G, bid); pg8::gemm_phase(ldsl, g, S, E); }
        const pg8::Epi E1{1, ws, p.x, p.out, p.lb_logits};
        { pg8::Gemm g{MEMB, (const bf16_t*)(ws + WS_WT_K), MEMROWS, 1024, DM}; pg8::StaticOrder S; S.init(MEMROWS, 1024, G, (bid + 128) % G); pg8::gemm_phase(ldsl, g, S, E1); }
        const pg8::Epi E2{2, ws, p.x, p.out, p.lb_logits};
        { pg8::Gemm g{(const bf16_t*)(ws + WS_WT_V), MEMB, 1024, MEMROWS, DM}; pg8::StaticOrder S; S.init(1024, MEMROWS, G, (bid + 112) % G); pg8::gemm_phase(ldsl, g, S, E2); }
    }
    SEAM(1);
    if (IN(2)) {
#ifndef DBG_NO_PASSA
        for (int u = bid; u < 1024; u += G) hgrn_passA_unit(KH, LF, VH, LT, DEC, u, lds);
#endif
#ifndef DBG_NO_POOL
        for (int t = bid; t < 256; t += G) pool_tile(PH, MIXED, t);
#endif
    }
    SEAM(2);
    if (IN(3)) { phase_scan(LT, DEC, ST); }
    SEAM(3);
    if (IN(4)) { for (int u = bid; u < 1024; u += G) hgrn_passC_unit(QH, KH, LF, VH, GH, ST, p.hgrn_norm_g, MIXED, u, lds); }
    SEAM(4);
    if (IN(5)) {
        const pg8::Epi E{3, ws, p.x, p.out, p.lb_logits};
        pg8::Gemm g{MIXED, (const bf16_t*)(ws + WS_WT_OUT), MROWS, DM, DM}; pg8::StaticOrder S; S.init(MROWS, DM, G, bid); pg8::gemm_phase(ldsl, g, S, E);
    }
    SEAM(5);
    if (IN(6)) {
        const pg8::Epi E{4, ws, p.x, p.out, p.lb_logits};
        pg8::Gemm g{XB, (const bf16_t*)(ws + WS_WT_Q), MROWS, DM, DM}; pg8::StaticOrder S; S.init(MROWS, DM, G, bid); pg8::gemm_phase(ldsl, g, S, E);
    }
    SEAM(6);
    if (IN(7)) { for (int u = bid; u < 256; u += G) attn_unit(XQ, KX, VT, ATT, u, lds); }
    SEAM(7);
    if (IN(8)) {
        const pg8::Epi E{6, ws, p.x, p.out, p.lb_logits};
        pg8::Gemm g{ATT, (const bf16_t*)(ws + WS_WT_O), MROWS, DM, DM}; pg8::StaticOrder S; S.init(MROWS, DM, G, bid); pg8::gemm_phase(ldsl, g, S, E);
    }
    SEAM(8);
    if (IN(9)) {
        const pg8::Epi E{5, ws, p.x, p.out, p.lb_logits};
        pg8::Gemm g{XB, (const bf16_t*)(ws + WS_WT_FF1), MROWS, DFF, DM}; pg8::StaticOrder S; S.init(MROWS, DFF, G, bid); pg8::gemm_phase(ldsl, g, S, E);
    }
    SEAM(9);
    if (IN(10)) {
        const pg8::Epi E{7, ws, p.x, p.out, p.lb_logits};
        pg8::Gemm g{U, (const bf16_t*)(ws + WS_WT_FF2), MROWS, DM, DFF}; pg8::StaticOrder S; S.init(MROWS, DM, G, bid); pg8::gemm_phase(ldsl, g, S, E);
    }
    SEAM(10);
    if (IN(11)) { phase_final(p.out, p.final_norm_g); }
#if DBG_LAST >= 0
    cg::this_grid().sync();
    {
        const unsigned* w32 = (const unsigned*)ws;
        for (size_t i = (size_t)bid * NTHREADS + threadIdx.x; i < (size_t)MROWS * DM; i += (size_t)G * NTHREADS) {
            float a = 0.f;
            for (int j = 0; j < 4; ++j) { const unsigned v = w32[i + (size_t)j * MROWS * DM]; a += (float)(v & 0xffffu) + (float)(v >> 16); }
            p.out[i] = a;
        }
    }
#endif
#undef IN
#undef SEAM
}

extern "C" void kernel_launch(void* const* d_in, const int* in_sizes, int n_in, void* d_out, int out_size, void* d_ws, size_t ws_size, hipStream_t stream) {
    static int grid = 0;
    if (grid == 0) {
        if (n_in != 19 || in_sizes[0] != MROWS * DM || out_size != MROWS * DM || ws_size < WS_END) { fprintf(stderr, "kernel_launch: unexpected shapes (n_in %d, ws %zu)\n", n_in, ws_size); grid = -1; return; }
        int dev = 0, cus = 0, per_cu = 0;
        hipGetDevice(&dev); hipDeviceGetAttribute(&cus, hipDeviceAttributeMultiprocessorCount, dev);
        if (hipFuncSetAttribute((const void*)mega, hipFuncAttributeMaxDynamicSharedMemorySize, LDS_BYTES) != hipSuccess) { fprintf(stderr, "kernel_launch: hipFuncSetAttribute failed\n"); grid = -1; return; }
        if (hipOccupancyMaxActiveBlocksPerMultiprocessor(&per_cu, (const void*)mega, NTHREADS, LDS_BYTES) != hipSuccess || per_cu < 1) { fprintf(stderr, "kernel_launch: occupancy query says %d\n", per_cu); per_cu = 1; }
        (void)hipGetLastError();
        grid = cus * 1;
        if (grid > cus * per_cu) grid = cus * per_cu;
    }
    if (grid < 0) return;
    if (hipMemsetAsync((char*)d_ws + WS_BAR, 0, XCD_BAR_WORDS * 4, stream) != hipSuccess) { fprintf(stderr, "kernel_launch: memset of barrier words failed\n"); return; }
    Params p{};
    const float** f = (const float**)&p;
    for (int i = 0; i < 19; ++i) f[i] = (const float*)d_in[i];
    p.out = (float*)d_out; p.ws = (unsigned char*)d_ws;
#if N_LAUNCH_MODE == 1
    p.ph_lo = 0; p.ph_hi = (DBG_LAST >= 0) ? DBG_LAST + 1 : N_PHASES;
    void* args[] = {&p};
    hipError_t e = hipLaunchCooperativeKernel((const void*)mega, dim3(grid), dim3(NTHREADS), args, LDS_BYTES, stream);
    if (e != hipSuccess) fprintf(stderr, "kernel_launch: cooperative launch failed: %s (grid %d)\n", hipGetErrorString(e), grid);
#else
    for (int k = 0; k < N_PHASES; ++k) { p.ph_lo = k; p.ph_hi = k + 1; hipLaunchKernelGGL(mega, dim3(grid), dim3(NTHREADS), LDS_BYTES, stream, p); }
#endif
}
```

```cpp
#include <hip/hip_runtime.h>
#include <hip/hip_cooperative_groups.h>
#include <cstdio>
namespace cg = cooperative_groups;

#ifndef N_LAUNCH_MODE
#define N_LAUNCH_MODE 1
#endif

typedef unsigned short bf16_t;
typedef short bf16x8 __attribute__((ext_vector_type(8)));
typedef float f32x2 __attribute__((ext_vector_type(2)));
typedef float f32x4 __attribute__((ext_vector_type(4)));
typedef float f32x16 __attribute__((ext_vector_type(16)));
typedef unsigned u32x2 __attribute__((ext_vector_type(2)));
typedef unsigned u32x4 __attribute__((ext_vector_type(4)));
#define LAS __attribute__((address_space(3)))

constexpr int MROWS = 16384, DM = 1024, SEQ = 4096, NIN = 2560, DFF = 4096, MEMROWS = 1024;
constexpr float EPS = 1e-6f;
constexpr int NTHREADS = 512;
constexpr int LDS_MAIN = 135168;
constexpr int LDS_BYTES = LDS_MAIN + 16;

constexpr size_t MiB = 1u << 20;
constexpr size_t WS_WT_IN = 0, WS_WT_K = 5 * MiB, WS_WT_V = 7 * MiB, WS_WT_OUT = 9 * MiB, WS_WT_Q = 11 * MiB, WS_WT_O = 13 * MiB,
                 WS_WT_FF1 = 15 * MiB, WS_WT_FF2 = 23 * MiB, WS_MEMB = 31 * MiB, WS_KX = 33 * MiB, WS_VT = 35 * MiB, WS_SSQ = 37 * MiB,
                 WS_BAR = 39 * MiB, WS_CNT = 39 * MiB + 16384, WS_RSTD0 = 38 * MiB, WS_RSTDM = 38 * MiB + 65536, WS_DEC = 38 * MiB + 131072,
                 WS_XB = 40 * MiB  , WS_QH = 72 * MiB, WS_KH = 88 * MiB, WS_VH = 104 * MiB, WS_GH = 120 * MiB, WS_PH = 136 * MiB,
                 WS_LF = 152 * MiB, WS_ST = 184 * MiB, WS_MIXED = 216 * MiB,
                 WS_X1 = 72 * MiB, WS_XQ = 136 * MiB, WS_ATT = 168 * MiB, WS_U = 72 * MiB, WS_END = 256 * MiB;

typedef __bf16 bf16x2n __attribute__((ext_vector_type(2)));
__device__ __forceinline__ unsigned cvt_pk_bf16(float lo, float hi) { f32x2 v = {lo, hi}; return __builtin_bit_cast(unsigned, __builtin_convertvector(v, bf16x2n)); }
__device__ __forceinline__ bf16_t f2bf(float f) { return (bf16_t)(cvt_pk_bf16(f, 0.f) & 0xffffu); }
__device__ __forceinline__ float bf2f(bf16_t b) { return __uint_as_float(((unsigned)b) << 16); }
__device__ __forceinline__ float bflo(unsigned u) { return __uint_as_float(u << 16); }
__device__ __forceinline__ float bfhi(unsigned u) { return __uint_as_float(u & 0xffff0000u); }
__device__ __forceinline__ f32x4 mfma16(bf16x8 a, bf16x8 b, f32x4 c) { return __builtin_amdgcn_mfma_f32_16x16x32_bf16(a, b, c, 0, 0, 0); }
__device__ __forceinline__ f32x16 mfma32(bf16x8 a, bf16x8 b, f32x16 c) { return __builtin_amdgcn_mfma_f32_32x32x16_bf16(a, b, c, 0, 0, 0); }
__device__ __forceinline__ bf16x8 mk8(u32x2 lo, u32x2 hi) { u32x4 t; t.x = lo.x; t.y = lo.y; t.z = hi.x; t.w = hi.y; return __builtin_bit_cast(bf16x8, t); }
__device__ __forceinline__ bf16x8 mk8u(unsigned a, unsigned b, unsigned c, unsigned d) { u32x4 t; t.x = a; t.y = b; t.z = c; t.w = d; return __builtin_bit_cast(bf16x8, t); }
__device__ __forceinline__ float sigmoidf_(float z) { return 1.0f / (1.0f + __expf(-z)); }

namespace pg8 {
constexpr int BM = 256, BK = 64, HALF = 128, HTB = HALF * BK * 2, STAGE_BYTES = 8 * HTB, NXCD = 8, WGM = 8;
__device__ __forceinline__ int lds_byte(int r, int c) { const int st = (r >> 4) * 2 + (c >> 5), rr = r & 15, cc = c & 31, ob = rr * 64 + cc * 2; return st * 1024 + (ob ^ (((ob >> 9) & 1) << 5)); }
__device__ __forceinline__ void stage_rc(int b, int& R, int& C) { const int st = b / 1024, sb = b % 1024, swz = sb ^ (((sb >> 9) & 1) << 5); R = (st >> 1) * 16 + swz / 64; C = (st & 1) * 32 + (swz % 64) / 2; }
__device__ __forceinline__ int perm32(int rho) { const int n = rho >> 4, i = rho & 15; return 8 * (i >> 2) + 4 * n + (i & 3); }
struct Unit { int pm, pn; };
struct Gemm { const bf16_t* A; const bf16_t* Bt; int M, N, K; };
struct StaticOrder {
    int nM, nN, nwg, G, c;
    __device__ void init(int M, int N, int G_, int c_) { nM = M / BM; nN = N / BM; nwg = nM * nN; G = G_; c = c_; }
    __device__ bool next(int i, Unit& u) const {
        const long L = (long)i * G + c; if (L >= nwg) return false;
        int wgid = (int)L; { const int q = nwg / NXCD, r = nwg % NXCD, xcd = wgid % NXCD, off = wgid / NXCD; wgid = (xcd < r ? xcd * (q + 1) : r * (q + 1) + (xcd - r) * q) + off; }
        const int nig = WGM * nN, gid = wgid / nig, fm = gid * WGM, gsz = (nM - fm) < WGM ? (nM - fm) : WGM;
        u.pm = fm + ((wgid % nig) % gsz); u.pn = (wgid % nig) / gsz; return true;
    }
};

struct Epi {
    static constexpr bool PERM = true;
    int mode;
    unsigned char* ws; const float* x; float* out; const float* lbl; const float* gfin;
    __device__ __forceinline__ void store8(bf16_t* p, const f32x4& v0, const f32x4& v1) const {
        u32x4 w; w.x = cvt_pk_bf16(v0[0], v0[1]); w.y = cvt_pk_bf16(v0[2], v0[3]); w.z = cvt_pk_bf16(v1[0], v1[1]); w.w = cvt_pk_bf16(v1[2], v1[3]); *(u32x4*)p = w; }
    __device__ __forceinline__ void fused(f32x4 (&acc)[2][2][4][2], const Unit& u, int wr, int wc, int fr, int fq) const {
        const int row0 = u.pm * BM + wr * 64 + fr;
        const int col0 = u.pn * BM + wc * 32 + 8 * fq;
        const bf16_t* xb = (const bf16_t*)(ws + WS_XB);
        unsigned* sq = (unsigned*)(ws + WS_SSQ);
        unsigned* cnt = (unsigned*)(ws + WS_CNT) + 64 * u.pm;
        u32x4 bc[2], bn[2];
        { const size_t o = (size_t)row0 * DM + col0; bc[0] = *(const u32x4*)(xb + o); bc[1] = *(const u32x4*)(xb + o + HALF); }
#pragma unroll
        for (int gidx = 0; gidx < 8; ++gidx) { const int ai = gidx >> 2, m = gidx & 3; const int row = row0 + ai * HALF + m * 16;
            if (gidx < 7) { const int g2 = gidx + 1; const size_t o2 = (size_t)(row0 + (g2 >> 2) * HALF + (g2 & 3) * 16) * DM + col0; bn[0] = *(const u32x4*)(xb + o2); bn[1] = *(const u32x4*)(xb + o2 + HALF); }
            float ss = 0.f;
#pragma unroll
            for (int bj = 0; bj < 2; ++bj) { const u32x4 bb = bc[bj];
                const f32x4 v0 = acc[ai][bj][m][0] + (f32x4){bflo(bb.x), bfhi(bb.x), bflo(bb.y), bfhi(bb.y)}, v1 = acc[ai][bj][m][1] + (f32x4){bflo(bb.z), bfhi(bb.z), bflo(bb.w), bfhi(bb.w)};
                acc[ai][bj][m][0] = v0; acc[ai][bj][m][1] = v1;
                ss += (v0[0] * v0[0] + v0[1] * v0[1]) + (v0[2] * v0[2] + v0[3] * v0[3]) + (v1[0] * v1[0] + v1[1] * v1[1]) + (v1[2] * v1[2] + v1[3] * v1[3]); }
            ss += __shfl_xor(ss, 16); ss += __shfl_xor(ss, 32);
            if (fq == 0) __hip_atomic_store(sq + (size_t)row * 16 + u.pn * 4 + wc, __float_as_uint(ss), __ATOMIC_RELAXED, __HIP_MEMORY_SCOPE_AGENT);
            bc[0] = bn[0]; bc[1] = bn[1]; }
        asm volatile("s_waitcnt vmcnt(0)" ::: "memory");
        if ((threadIdx.x & 63) == 0) __hip_atomic_fetch_add(cnt, 1u, __ATOMIC_RELAXED, __HIP_MEMORY_SCOPE_AGENT);
        f32x4 gv[2][2];
#pragma unroll
        for (int bj = 0; bj < 2; ++bj) { gv[bj][0] = *(const f32x4*)(gfin + col0 + bj * HALF); gv[bj][1] = *(const f32x4*)(gfin + col0 + bj * HALF + 4); }
        { unsigned spins = 0; while ((unsigned)__builtin_amdgcn_readfirstlane(__hip_atomic_load(cnt, __ATOMIC_RELAXED, __HIP_MEMORY_SCOPE_AGENT)) < 32u) { __builtin_amdgcn_s_sleep(1); if (++spins > (1u << 22)) break; } }
        __builtin_amdgcn_fence(__ATOMIC_ACQUIRE, "agent");
        asm volatile("s_waitcnt vmcnt(0)" ::: "memory");
        f32x4 pv[8];
#pragma unroll
        for (int gidx = 0; gidx < 8; ++gidx) pv[gidx] = *(const f32x4*)((const float*)sq + (size_t)(row0 + (gidx >> 2) * HALF + (gidx & 3) * 16) * 16 + 4 * fq);
#pragma unroll
        for (int gidx = 0; gidx < 8; ++gidx) { const int ai = gidx >> 2, m = gidx & 3; const int row = row0 + ai * HALF + m * 16;
            float t = (pv[gidx][0] + pv[gidx][1]) + (pv[gidx][2] + pv[gidx][3]); t += __shfl_xor(t, 16); t += __shfl_xor(t, 32);
            const float rstd = rsqrtf(t * (1.0f / 1024.0f) + EPS);
            const size_t o = (size_t)row * DM + col0;
#pragma unroll
            for (int bj = 0; bj < 2; ++bj) { *(f32x4*)(out + o + bj * HALF) = acc[ai][bj][m][0] * rstd * gv[bj][0]; *(f32x4*)(out + o + bj * HALF + 4) = acc[ai][bj][m][1] * rstd * gv[bj][1]; } }
    }
    __device__ __forceinline__ void operator()(const f32x4 (&acc)[2][2][4][2], const Unit& u, int wr, int wc, int fr, int fq) const {
        const int row0 = u.pm * BM + wr * 64 + fr;
        const int colL = wc * 32 + 8 * fq;
        if (mode == 3 || mode == 6 || mode == 7) {
            const int col0 = u.pn * BM + colL;
            bf16_t* xb = (bf16_t*)(ws + WS_XB);
            float* ssq = (float*)(ws + WS_SSQ);
            f32x4 rc[4], rn[4];
            u32x4 bc[2], bn[2];
            if (mode == 3) { const size_t o = (size_t)row0 * DM + col0; rc[0] = *(const f32x4*)(x + o); rc[1] = *(const f32x4*)(x + o + 4); rc[2] = *(const f32x4*)(x + o + HALF); rc[3] = *(const f32x4*)(x + o + HALF + 4); }
            else { const size_t o = (size_t)row0 * DM + col0; bc[0] = *(const u32x4*)(xb + o); bc[1] = *(const u32x4*)(xb + o + HALF); }
#pragma unroll
            for (int gidx = 0; gidx < 8; ++gidx) { const int ai = gidx >> 2, m = gidx & 3; const int row = row0 + ai * HALF + m * 16;
                if (gidx < 7) { const int g2 = gidx + 1; const size_t o2 = (size_t)(row0 + (g2 >> 2) * HALF + (g2 & 3) * 16) * DM + col0;
                    if (mode == 3) { rn[0] = *(const f32x4*)(x + o2); rn[1] = *(const f32x4*)(x + o2 + 4); rn[2] = *(const f32x4*)(x + o2 + HALF); rn[3] = *(const f32x4*)(x + o2 + HALF + 4); }
                    else { bn[0] = *(const u32x4*)(xb + o2); bn[1] = *(const u32x4*)(xb + o2 + HALF); } }
                if (mode != 3) {
#pragma unroll
                    for (int bj = 0; bj < 2; ++bj) { rc[2 * bj] = (f32x4){bflo(bc[bj].x), bfhi(bc[bj].x), bflo(bc[bj].y), bfhi(bc[bj].y)}; rc[2 * bj + 1] = (f32x4){bflo(bc[bj].z), bfhi(bc[bj].z), bflo(bc[bj].w), bfhi(bc[bj].w)}; } }
                float ss = 0.f;
#pragma unroll
                for (int bj = 0; bj < 2; ++bj) { const size_t o = (size_t)row * DM + col0 + bj * HALF;
                    const f32x4 v0 = acc[ai][bj][m][0] + rc[2 * bj], v1 = acc[ai][bj][m][1] + rc[2 * bj + 1];
                    if (mode == 7) { *(f32x4*)(out + o) = v0; *(f32x4*)(out + o + 4) = v1; }
                    else store8(xb + o, v0, v1);
                    ss += (v0[0] * v0[0] + v0[1] * v0[1]) + (v0[2] * v0[2] + v0[3] * v0[3]) + (v1[0] * v1[0] + v1[1] * v1[1]) + (v1[2] * v1[2] + v1[3] * v1[3]); }
                if (mode != 7) { ss += __shfl_xor(ss, 16); ss += __shfl_xor(ss, 32);
                    if (fq == 0) ssq[(size_t)row * 16 + u.pn * 4 + wc] = ss; }
#pragma unroll
                for (int k = 0; k < 4; ++k) rc[k] = rn[k];
                bc[0] = bn[0]; bc[1] = bn[1]; }
            return;
        }
        if (mode == 2) {
            const int col0 = u.pn * BM + colL;
            const float* rs = (const float*)(ws + WS_RSTDM); bf16_t* ob = (bf16_t*)(ws + WS_VT); const int ldo = 1024;
            f32x4 c0[2], c1[2];
#pragma unroll
            for (int bj = 0; bj < 2; ++bj) { c0[bj] = *(const f32x4*)(rs + col0 + bj * HALF); c1[bj] = *(const f32x4*)(rs + col0 + bj * HALF + 4); }
#pragma unroll
            for (int ai = 0; ai < 2; ++ai)
#pragma unroll
                for (int m = 0; m < 4; ++m) { const int row = row0 + ai * HALF + m * 16;
#pragma unroll
                    for (int bj = 0; bj < 2; ++bj) store8(ob + (size_t)row * ldo + col0 + bj * HALF, acc[ai][bj][m][0] * c0[bj], acc[ai][bj][m][1] * c1[bj]); }
            return;
        }
        float rsc[8];
        if (mode == 4 || mode == 5) {
            const float* sq = (const float*)(ws + WS_SSQ);
            f32x4 pv[8];
#pragma unroll
            for (int gidx = 0; gidx < 8; ++gidx) pv[gidx] = *(const f32x4*)(sq + (size_t)(row0 + (gidx >> 2) * HALF + (gidx & 3) * 16) * 16 + 4 * fq);
            const float cs = mode == 4 ? 0.0625f : 1.0f;
#pragma unroll
            for (int gidx = 0; gidx < 8; ++gidx) { float t = (pv[gidx][0] + pv[gidx][1]) + (pv[gidx][2] + pv[gidx][3]); t += __shfl_xor(t, 16); t += __shfl_xor(t, 32); rsc[gidx] = rsqrtf(t * (1.0f / 1024.0f) + EPS) * cs; }
        } else {
            const float* rs = (const float*)(ws + (mode == 0 ? WS_RSTD0 : WS_RSTDM));
#pragma unroll
            for (int gidx = 0; gidx < 8; ++gidx) rsc[gidx] = rs[row0 + (gidx >> 2) * HALF + (gidx & 3) * 16];
        }
        if (mode == 0) {
            float* lf = (float*)(ws + WS_LF); bf16_t* kh = (bf16_t*)(ws + WS_KH);
            const int sub = u.pn >> 1; const int cb = (u.pn & 1) * 256 + colL;
            if (sub == 1) {
                float oml[2][8];
#pragma unroll
                for (int bj = 0; bj < 2; ++bj)
#pragma unroll
                    for (int j = 0; j < 8; ++j) { const int c = cb + bj * HALF + j; const float l0 = lbl[c], l1 = lbl[512 + c]; const float lb = 1.0f / (1.0f + __expf(l1 - l0)); oml[bj][j] = 1.0f - lb; }
#pragma unroll
                for (int ai = 0; ai < 2; ++ai)
#pragma unroll
                    for (int m = 0; m < 4; ++m) { const int row = row0 + ai * HALF + m * 16; const float r = rsc[ai * 4 + m];
#pragma unroll
                        for (int bj = 0; bj < 2; ++bj) { f32x4 lf0, lf1, k0, k1;
#pragma unroll
                            for (int j = 0; j < 4; ++j) {
                                const float za = acc[ai][bj][m][0][j] * r, zb = acc[ai][bj][m][1][j] * r;
                                const float ka = oml[bj][j] * (1.0f - sigmoidf_(za)), kb = oml[bj][4 + j] * (1.0f - sigmoidf_(zb));
                                k0[j] = ka; k1[j] = kb; lf0[j] = __logf(1.0f - ka); lf1[j] = __logf(1.0f - kb); }
                            const size_t o = (size_t)row * 512 + cb + bj * HALF;
                            *(f32x4*)(lf + o) = lf0; *(f32x4*)(lf + o + 4) = lf1; store8(kh + o, k0, k1); } }
            } else {
                bf16_t* dst = (bf16_t*)(ws + (sub == 0 ? WS_QH : (sub == 2 ? WS_VH : (sub == 3 ? WS_GH : WS_PH))));
                const bool act = (sub == 0) || (sub == 3);
#pragma unroll
                for (int ai = 0; ai < 2; ++ai)
#pragma unroll
                    for (int m = 0; m < 4; ++m) { const int row = row0 + ai * HALF + m * 16; const float r = rsc[ai * 4 + m];
#pragma unroll
                        for (int bj = 0; bj < 2; ++bj) { f32x4 v0 = acc[ai][bj][m][0] * r, v1 = acc[ai][bj][m][1] * r;
                            if (act) {
#pragma unroll
                                for (int j = 0; j < 4; ++j) { v0[j] = v0[j] * sigmoidf_(v0[j]); v1[j] = v1[j] * sigmoidf_(v1[j]); } }
                            store8(dst + (size_t)row * 512 + cb + bj * HALF, v0, v1); } }
            }
        } else {
            const int col0 = u.pn * BM + colL;
            bf16_t* ob = (bf16_t*)(ws + (mode == 1 ? WS_KX : (mode == 4 ? WS_XQ : WS_U))); const int ldo = mode == 5 ? DFF : 1024;
#pragma unroll
            for (int ai = 0; ai < 2; ++ai)
#pragma unroll
                for (int m = 0; m < 4; ++m) { const int row = row0 + ai * HALF + m * 16; const float r = rsc[ai * 4 + m];
#pragma unroll
                    for (int bj = 0; bj < 2; ++bj) { f32x4 v0 = acc[ai][bj][m][0] * r, v1 = acc[ai][bj][m][1] * r;
                        if (mode == 5) {
#pragma unroll
                            for (int j = 0; j < 4; ++j) { const float a = fmaxf(v0[j], 0.f), b = fmaxf(v1[j], 0.f); v0[j] = a * a; v1[j] = b * b; } }
                        store8(ob + (size_t)row * ldo + col0 + bj * HALF, v0, v1); } }
        }
    }
};

template <class EpiT, class Sched>
__device__ __forceinline__ void gemm_phase(LAS unsigned char* lds, const Gemm g, const Sched S, const EpiT E) {
    const int tid = threadIdx.x, wid = __builtin_amdgcn_readfirstlane(tid >> 6), lane = tid & 63, wr = wid >> 2, wc = wid & 3, fr = lane & 15, fq = lane >> 4;
    const int K = g.K, nt = K / BK;
    unsigned voffA[2], voffB[2];
#pragma unroll
    for (int i = 0; i < 2; ++i) { int R, C; stage_rc(tid * 16 + i * 8192, R, C); const int Rb = EpiT::PERM ? ((R & ~31) + perm32(R & 31)) : R;
        voffA[i] = (unsigned)(R * K + C) * 2u; voffB[i] = (unsigned)(Rb * K + C) * 2u; }
    const size_t kstep = (size_t)(BK * 2);
    const size_t hstep = (size_t)HALF * K * 2;
    const size_t tstep = 2 * hstep;
    const unsigned ldsw = (unsigned)wid * 1024u;
    const int aoff = lds_byte(wr * 64 + fr, fq * 8), boff = lds_byte(wc * 32 + fr, fq * 8);
#define PG8_SA(b, h) (((b) * 2 + (h)) * HTB)
#define PG8_SB(b, h) ((4 + (b) * 2 + (h)) * HTB)
#define PG8_STAGE(bufoff, gbase, voff) do { _Pragma("unroll") for (int _i = 0; _i < 2; ++_i) \
        __builtin_amdgcn_global_load_lds((const unsigned*)((const char*)(gbase) + (voff)[_i]), (LAS unsigned*)(lds + (bufoff) + ldsw + _i * 8192), 16, 0, 0); } while (0)
#define PG8_LDA(dst, b, h) do { _Pragma("unroll") for (int m = 0; m < 4; ++m) _Pragma("unroll") for (int k = 0; k < 2; ++k) dst[m][k] = *(const LAS bf16x8*)(lds + PG8_SA(b, h) + aoff + m * 2048 + k * 1024); } while (0)
#define PG8_LDB(dst, b, h) do { _Pragma("unroll") for (int n = 0; n < 2; ++n) _Pragma("unroll") for (int k = 0; k < 2; ++k) dst[n][k] = *(const LAS bf16x8*)(lds + PG8_SB(b, h) + boff + n * 2048 + k * 1024); } while (0)
#define PG8_MMA(ai, bj, At, Bt) do { __builtin_amdgcn_s_setprio(1); _Pragma("unroll") for (int m = 0; m < 4; ++m) _Pragma("unroll") for (int n = 0; n < 2; ++n) _Pragma("unroll") for (int k = 0; k < 2; ++k) \
        acc[ai][bj][m][n] = __builtin_amdgcn_mfma_f32_16x16x32_bf16(Bt[n][k], At[m][k], acc[ai][bj][m][n], 0, 0, 0); __builtin_amdgcn_s_setprio(0); } while (0)
#define PG8_WAIT_V(n) asm volatile("s_waitcnt vmcnt(" #n ")" ::: "memory")
#define PG8_WAIT_L(n) asm volatile("s_waitcnt lgkmcnt(" #n ")" ::: "memory")
#define PG8_BAR __builtin_amdgcn_s_barrier()
#define PG8_SCHED __builtin_amdgcn_sched_barrier(0)
    Unit cur, nxt; int ui = 0;
    if (!S.next(0, cur)) return;
    f32x4 acc[2][2][4][2];
#pragma unroll
    for (int a = 0; a < 2; ++a)
#pragma unroll
        for (int b = 0; b < 2; ++b)
#pragma unroll
            for (int m = 0; m < 4; ++m)
#pragma unroll
                for (int n = 0; n < 2; ++n) acc[a][b][m][n] = (f32x4){0.f, 0.f, 0.f, 0.f};
    bf16x8 At[4][2], B0[2][2], B1[2][2];
    const char* cA = (const char*)g.A + (size_t)cur.pm * tstep; const char* cB = (const char*)g.Bt + (size_t)cur.pn * tstep;
    PG8_STAGE(PG8_SB(0, 0), cB, voffB); PG8_STAGE(PG8_SA(0, 0), cA, voffA); PG8_STAGE(PG8_SB(0, 1), cB + hstep, voffB); PG8_STAGE(PG8_SA(0, 1), cA + hstep, voffA);
    if (wr == 1) PG8_BAR;
    PG8_WAIT_V(4); PG8_BAR;
    PG8_STAGE(PG8_SB(1, 0), cB + kstep, voffB); PG8_STAGE(PG8_SA(1, 0), cA + kstep, voffA); PG8_STAGE(PG8_SB(1, 1), cB + hstep + kstep, voffB);
    PG8_WAIT_V(6); PG8_BAR;
    for (;;) {
        const bool has_next = S.next(ui + 1, nxt);
        const char* nA = has_next ? (const char*)g.A + (size_t)nxt.pm * tstep : cA; const char* nB = has_next ? (const char*)g.Bt + (size_t)nxt.pn * tstep : cB;
        for (int t = 0; t < nt; t += 2) {
            const bool last = (t == nt - 2);
            const char* a1 = cA + (size_t)(t + 1) * kstep;
            const char* a2 = last ? nA : cA + (size_t)(t + 2) * kstep; const char* b2 = last ? nB : cB + (size_t)(t + 2) * kstep;
            const char* a3 = a2 + kstep; const char* b3 = b2 + kstep;
            PG8_LDB(B0, 0, 0); PG8_SCHED; PG8_LDA(At, 0, 0); PG8_STAGE(PG8_SA(1, 1), a1 + hstep, voffA);
            PG8_WAIT_L(8); PG8_BAR; PG8_WAIT_L(0); PG8_MMA(0, 0, At, B0); PG8_BAR; PG8_SCHED;
            PG8_LDB(B1, 0, 1); PG8_STAGE(PG8_SB(0, 0), b2, voffB);
            PG8_BAR; PG8_WAIT_L(0); PG8_MMA(0, 1, At, B1); PG8_BAR;
            PG8_LDA(At, 0, 1); PG8_STAGE(PG8_SA(0, 0), a2, voffA);
            PG8_BAR; PG8_WAIT_L(0); PG8_MMA(1, 0, At, B0); PG8_BAR; PG8_SCHED;
            PG8_STAGE(PG8_SB(0, 1), b2 + hstep, voffB);
            PG8_WAIT_V(6); PG8_BAR; PG8_MMA(1, 1, At, B1); PG8_BAR;
            PG8_LDB(B0, 1, 0); PG8_SCHED; PG8_LDA(At, 1, 0); PG8_STAGE(PG8_SA(0, 1), a2 + hstep, voffA);
            PG8_WAIT_L(8); PG8_BAR; PG8_WAIT_L(0); PG8_MMA(0, 0, At, B0); PG8_BAR; PG8_SCHED;
            PG8_LDB(B1, 1, 1); PG8_STAGE(PG8_SB(1, 0), b3, voffB);
            PG8_BAR; PG8_WAIT_L(0); PG8_MMA(0, 1, At, B1); PG8_BAR;
            PG8_LDA(At, 1, 1); PG8_STAGE(PG8_SA(1, 0), a3, voffA);
            PG8_BAR; PG8_WAIT_L(0); PG8_MMA(1, 0, At, B0); PG8_BAR; PG8_SCHED;
            PG8_STAGE(PG8_SB(1, 1), b3 + hstep, voffB);
            PG8_WAIT_V(6); PG8_BAR; PG8_MMA(1, 1, At, B1); PG8_BAR;
        }
        if (E.mode != 8) E(acc, cur, wr, wc, fr, fq);
        if (!has_next) break;
#pragma unroll
        for (int a = 0; a < 2; ++a)
#pragma unroll
            for (int b = 0; b < 2; ++b)
#pragma unroll
                for (int m = 0; m < 4; ++m)
#pragma unroll
                    for (int n = 0; n < 2; ++n) acc[a][b][m][n] = (f32x4){0.f, 0.f, 0.f, 0.f};
        cur = nxt; cA = nA; cB = nB; ++ui;
    }
    PG8_WAIT_V(0);
    if (wr == 0) PG8_BAR;
    PG8_BAR;
    if (E.mode == 8) E.fused(acc, cur, wr, wc, fr, fq);
#undef PG8_SA
#undef PG8_SB
#undef PG8_STAGE
#undef PG8_LDA
#undef PG8_LDB
#undef PG8_MMA
#undef PG8_WAIT_V
#undef PG8_WAIT_L
#undef PG8_BAR
#undef PG8_SCHED
}
}

struct Params {
    const float *x, *mem, *norm_mix_g, *w_in, *lb_logits, *hgrn_norm_g, *w_pool, *pool_scale, *w_out, *norm_x_g, *norm_mem_g, *w_xq, *w_xk, *w_xv, *w_xo, *norm_ffn_g, *w_ff1, *w_ff2, *final_norm_g;
    float* out; unsigned char* ws;
    int ph_lo, ph_hi;
};

__device__ __forceinline__ void prep_transpose_tile(const float* __restrict__ W, int N, const float* __restrict__ g, bf16_t* __restrict__ out, int ldo, int kt, int nt, unsigned char* lds) {
    bf16_t* T = (bf16_t*)lds;
    const int tid = threadIdx.x, r = tid >> 4, c4 = tid & 15;
#pragma unroll
    for (int i = 0; i < 4; ++i) {
        const int kl = r + 32 * i, k = 128 * kt + kl;
        const f32x4 v = *(const f32x4*)(W + (size_t)k * N + 64 * nt + 4 * c4);
        const float s = g ? g[k] : 1.0f;
        T[(4 * c4 + 0) * 136 + kl] = f2bf(v[0] * s); T[(4 * c4 + 1) * 136 + kl] = f2bf(v[1] * s);
        T[(4 * c4 + 2) * 136 + kl] = f2bf(v[2] * s); T[(4 * c4 + 3) * 136 + kl] = f2bf(v[3] * s);
    }
    __syncthreads();
    const int n = tid >> 3, ks = tid & 7;
    const u32x4* src = (const u32x4*)(T + n * 136 + 16 * ks);
    const u32x4 a = src[0], b = src[1];
    u32x4* dst = (u32x4*)(out + (size_t)(64 * nt + n) * ldo + 128 * kt + 16 * ks);
    dst[0] = a; dst[1] = b;
    __syncthreads();
}

__device__ __forceinline__ void phase_prep(const Params p, unsigned char* lds) {
    unsigned char* ws = p.ws;
    const int G = gridDim.x;
    for (int t = blockIdx.x; t < 1920; t += G) {
        if (t < 320)       { prep_transpose_tile(p.w_in, NIN, p.norm_mix_g, (bf16_t*)(ws + WS_WT_IN), 1024, t / 40, t % 40, lds); }
        else if (t < 448)  { const int u = t - 320;  prep_transpose_tile(p.w_xk, 1024, p.norm_mem_g, (bf16_t*)(ws + WS_WT_K), 1024, u / 16, u % 16, lds); }
        else if (t < 576)  { const int u = t - 448;  prep_transpose_tile(p.w_xv, 1024, p.norm_mem_g, (bf16_t*)(ws + WS_WT_V), 1024, u / 16, u % 16, lds); }
        else if (t < 704)  { const int u = t - 576;  prep_transpose_tile(p.w_xq, 1024, p.norm_x_g, (bf16_t*)(ws + WS_WT_Q), 1024, u / 16, u % 16, lds); }
        else if (t < 832)  { const int u = t - 704;  prep_transpose_tile(p.w_xo, 1024, nullptr, (bf16_t*)(ws + WS_WT_O), 1024, u / 16, u % 16, lds); }
        else if (t < 896)  { const int u = t - 832;  prep_transpose_tile(p.w_out, 1024, nullptr, (bf16_t*)(ws + WS_WT_OUT), 1024, u / 16, u % 16, lds); }
        else if (t < 1408) { const int u = t - 896;  prep_transpose_tile(p.w_ff1, DFF, p.norm_ffn_g, (bf16_t*)(ws + WS_WT_FF1), 1024, u / 64, u % 64, lds); }
        else               { const int u = t - 1408; prep_transpose_tile(p.w_ff2, 1024, nullptr, (bf16_t*)(ws + WS_WT_FF2), 4096, u / 16, u % 16, lds); }
    }
    {
        bf16_t* wto = (bf16_t*)(ws + WS_WT_OUT);
        for (int item = blockIdx.x * NTHREADS + threadIdx.x; item < 65536; item += G * NTHREADS) {
            const int n = item & 1023, cgp = item >> 10, gi = cgp >> 4, c0 = (cgp & 15) * 8;
            float a[8];
#pragma unroll
            for (int j = 0; j < 8; ++j) a[j] = 0.f;
            const float* wp = p.w_pool + (size_t)(gi * 128 + c0) * 128;
            for (int d = 0; d < 128; ++d) {
                const float wo = p.w_out[(size_t)(512 + gi * 128 + d) * 1024 + n] * p.pool_scale[gi * 128 + d];
#pragma unroll
                for (int j = 0; j < 8; ++j) a[j] += wp[j * 128 + d] * wo;
            }
            u32x4 w; w.x = cvt_pk_bf16(a[0], a[1]); w.y = cvt_pk_bf16(a[2], a[3]); w.z = cvt_pk_bf16(a[4], a[5]); w.w = cvt_pk_bf16(a[6], a[7]);
            *(u32x4*)(wto + (size_t)n * 1024 + 512 + gi * 128 + c0) = w;
        }
    }
    {
        const int lane = threadIdx.x & 63, gw = blockIdx.x * (NTHREADS / 64) + (threadIdx.x >> 6), nw = G * (NTHREADS / 64);
        for (int r = gw; r < MROWS + MEMROWS; r += nw) {
            const bool isx = r < MROWS;
            const float* src = isx ? p.x + (size_t)r * DM : p.mem + (size_t)(r - MROWS) * DM;
            bf16_t* dst = isx ? (bf16_t*)(ws + WS_XB) + (size_t)r * DM : (bf16_t*)(ws + WS_MEMB) + (size_t)(r - MROWS) * DM;
            f32x4 v[4]; float ss = 0.f;
#pragma unroll
            for (int i = 0; i < 4; ++i) { v[i] = ((const f32x4*)src)[lane + 64 * i]; ss += (v[i][0] * v[i][0] + v[i][1] * v[i][1]) + (v[i][2] * v[i][2] + v[i][3] * v[i][3]); }
#pragma unroll
            for (int o = 1; o < 64; o <<= 1) ss += __shfl_xor(ss, o);
#pragma unroll
            for (int i = 0; i < 4; ++i) { u32x2 w; w.x = cvt_pk_bf16(v[i][0], v[i][1]); w.y = cvt_pk_bf16(v[i][2], v[i][3]); ((u32x2*)dst)[lane + 64 * i] = w; }
            if (lane == 0) { const float rstd = rsqrtf(ss * (1.0f / 1024.0f) + EPS); if (isx) ((float*)(ws + WS_RSTD0))[r] = rstd; else ((float*)(ws + WS_RSTDM))[r - MROWS] = rstd; }
        }
    }
}

__device__ void hgrn_passA_unit(const bf16_t* __restrict__ KH, const float* __restrict__ LF, const bf16_t* __restrict__ VH, bf16_t* __restrict__ LT, float* __restrict__ DEC, int unit, unsigned char* lds) {
    const int tid = threadIdx.x, ch = tid & 127, seg = tid >> 7;
    const int b = unit >> 8, c = (unit >> 2) & 63, h = unit & 3;
    const int row0 = b * SEQ + c * 64, bh = b * 4 + h;
    float* segtot = (float*)lds;
    unsigned char* KdT = lds + 2048;
    unsigned char* VTl = lds + 2048 + 18432;
    const size_t g0 = (size_t)(row0 + seg * 16) * 512 + h * 128 + ch;
    float lf[16], kk[16], vv[16];
#pragma unroll
    for (int i = 0; i < 16; ++i) { lf[i] = LF[g0 + (size_t)i * 512]; kk[i] = bf2f(KH[g0 + (size_t)i * 512]); vv[i] = bf2f(VH[g0 + (size_t)i * 512]); }
#pragma unroll
    for (int i = 1; i < 16; ++i) lf[i] += lf[i - 1];
    segtot[seg * 128 + ch] = lf[15];
    __syncthreads();
    float after = 0.f;
#pragma unroll
    for (int s2 = 1; s2 < 4; ++s2) if (s2 > seg) after += segtot[s2 * 128 + ch];
    const float tot = after + lf[15];
    if (seg == 0) DEC[(size_t)(bh * 64 + c) * 128 + ch] = __expf(tot);
    unsigned kd[8], vp[8];
#pragma unroll
    for (int i = 0; i < 8; ++i) {
        kd[i] = cvt_pk_bf16(kk[2 * i] * __expf(tot - lf[2 * i]), kk[2 * i + 1] * __expf(tot - lf[2 * i + 1]));
        vp[i] = cvt_pk_bf16(vv[2 * i], vv[2 * i + 1]);
    }
    { u32x4* d = (u32x4*)(KdT + ch * 144 + seg * 32); d[0] = (u32x4){kd[0], kd[1], kd[2], kd[3]}; d[1] = (u32x4){kd[4], kd[5], kd[6], kd[7]}; }
    { u32x4* d = (u32x4*)(VTl + ch * 144 + seg * 32); d[0] = (u32x4){vp[0], vp[1], vp[2], vp[3]}; d[1] = (u32x4){vp[4], vp[5], vp[6], vp[7]}; }
    __syncthreads();
    const int w = tid >> 6, lane = tid & 63, fr = lane & 15, q = lane >> 4;
    bf16x8 a[2];
#pragma unroll
    for (int ks = 0; ks < 2; ++ks) a[ks] = *(const bf16x8*)(KdT + (16 * w + fr) * 144 + (32 * ks + 8 * q) * 2);
    bf16_t* ltp = LT + (size_t)(bh * 64 + c) * 16384;
#pragma unroll
    for (int vb = 0; vb < 8; ++vb) {
        f32x4 acc = (f32x4){0.f, 0.f, 0.f, 0.f};
#pragma unroll
        for (int ks = 0; ks < 2; ++ks) { const bf16x8 bfr = *(const bf16x8*)(VTl + (16 * vb + fr) * 144 + (32 * ks + 8 * q) * 2); acc = mfma16(a[ks], bfr, acc); }
        u32x2 pk; pk.x = cvt_pk_bf16(acc[0], acc[1]); pk.y = cvt_pk_bf16(acc[2], acc[3]);
        *(u32x2*)(ltp + (size_t)(16 * vb + fr) * 128 + 16 * w + 4 * q) = pk;
    }
    __syncthreads();
}

__device__ void pool_tile(const bf16_t* __restrict__ PH, bf16_t* __restrict__ MIXED, int tile) {
    const int tid = threadIdx.x, cp = tid & 255, th = tid >> 8, c0 = 2 * cp, gi = c0 >> 7, w = 2 << gi;
    const int r0 = tile * 64 + th * 32, s0 = r0 & (SEQ - 1);
    float sx = 0.f, sy = 0.f;
    for (int j = 1; j < w; ++j) if (s0 - j >= 0) { const unsigned u = *(const unsigned*)(PH + (size_t)(r0 - j) * 512 + c0); sx += bflo(u); sy += bfhi(u); }
    for (int tt = 0; tt < 32; ++tt) {
        const int r = r0 + tt, s = s0 + tt;
        const unsigned u = *(const unsigned*)(PH + (size_t)r * 512 + c0);
        const float px = bflo(u), py = bfhi(u);
        sx += px; sy += py;
        const int cnt = (s + 1) < w ? (s + 1) : w;
        const float inv = 1.0f / (float)cnt;
        *(unsigned*)(MIXED + (size_t)r * 1024 + 512 + c0) = cvt_pk_bf16(sx * inv - px, sy * inv - py);
        if (s - (w - 1) >= 0) { const unsigned u2 = *(const unsigned*)(PH + (size_t)(r - (w - 1)) * 512 + c0); sx -= bflo(u2); sy -= bfhi(u2); }
    }
}

__device__ void phase_scan(const bf16_t* __restrict__ LT, const float* __restrict__ DEC, bf16_t* __restrict__ ST) {
    for (int e2 = blockIdx.x * NTHREADS + threadIdx.x; e2 < 131072; e2 += gridDim.x * NTHREADS) {
        const int bh = e2 >> 13, v = (e2 >> 6) & 127, kp = e2 & 63;
        float sx = 0.f, sy = 0.f;
        const size_t base = (size_t)bh * 64 * 16384 + (size_t)v * 128 + 2 * kp;
        const float* dp = DEC + (size_t)bh * 64 * 128 + 2 * kp;
        for (int c0 = 0; c0 < 64; c0 += 8) {
            unsigned l[8]; f32x2 d[8];
#pragma unroll
            for (int j = 0; j < 8; ++j) { l[j] = *(const unsigned*)(LT + base + (size_t)(c0 + j) * 16384); d[j] = *(const f32x2*)(dp + (c0 + j) * 128); }
#pragma unroll
            for (int j = 0; j < 8; ++j) {
                *(unsigned*)(ST + base + (size_t)(c0 + j) * 16384) = cvt_pk_bf16(sx, sy);
                sx = d[j][0] * sx + bflo(l[j]); sy = d[j][1] * sy + bfhi(l[j]);
            }
        }
    }
}

__device__ void hgrn_passC_unit(const bf16_t* __restrict__ QH, const bf16_t* __restrict__ KH, const float* __restrict__ LF, const bf16_t* __restrict__ VH, const bf16_t* __restrict__ GH,
                                const bf16_t* __restrict__ ST, const float* __restrict__ hg, bf16_t* __restrict__ MIXED, int unit, unsigned char* lds) {
    const int tid = threadIdx.x, ch = tid & 127, seg = tid >> 7;
    const int b = unit >> 8, c = (unit >> 2) & 63, h = unit & 3;
    const int row0 = b * SEQ + c * 64, bh = b * 4 + h;
    float* segtot = (float*)lds;
    float* rmsp = (float*)(lds + 2048);
    bf16_t* QC = (bf16_t*)(lds + 4096);
    bf16_t* QT = (bf16_t*)(lds + 21504);
    constexpr int KT0 = 38912;
    unsigned char* VTl = lds + 82432;
    const size_t g0 = (size_t)(row0 + seg * 16) * 512 + h * 128 + ch;
    float lf[16];
#pragma unroll
    for (int i = 0; i < 16; ++i) lf[i] = LF[g0 + (size_t)i * 512];
#pragma unroll
    for (int i = 1; i < 16; ++i) lf[i] += lf[i - 1];
    segtot[seg * 128 + ch] = lf[15];
    {
        unsigned vp[8];
#pragma unroll
        for (int i = 0; i < 8; ++i) vp[i] = (unsigned)VH[g0 + (size_t)(2 * i) * 512] | ((unsigned)VH[g0 + (size_t)(2 * i + 1) * 512] << 16);
        u32x4* d = (u32x4*)(VTl + ch * 144 + seg * 32); d[0] = (u32x4){vp[0], vp[1], vp[2], vp[3]}; d[1] = (u32x4){vp[4], vp[5], vp[6], vp[7]};
    }
    __syncthreads();
    const float t0 = segtot[ch], t1 = segtot[128 + ch], t2 = segtot[256 + ch];
    const float P = (seg > 0 ? t0 : 0.f) + (seg > 1 ? t1 : 0.f) + (seg > 2 ? t2 : 0.f);
    {
#pragma unroll
        for (int i = 0; i < 16; ++i) {
            const float qv = bf2f(QH[g0 + (size_t)i * 512]);
            const float el = __expf(lf[i]);
            QT[(seg * 16 + i) * 136 + ch] = f2bf(qv * el);
            QC[(seg * 16 + i) * 136 + ch] = f2bf(qv * el * __expf(P));
        }
        float kk[16];
#pragma unroll
        for (int i = 0; i < 16; ++i) kk[i] = bf2f(KH[g0 + (size_t)i * 512]);
        float E = 0.f;
#pragma unroll
        for (int i = 0; i < 4; ++i) {
            if (i >= seg) {
                bf16_t* KT = (bf16_t*)(lds + KT0 + 4352 * ((i * (i + 1)) / 2));
#pragma unroll
                for (int j = 0; j < 16; ++j) KT[(seg * 16 + j) * 136 + ch] = f2bf(kk[j] * __expf(E - lf[j]));
                E += (i == 0 ? t0 : (i == 1 ? t1 : t2));
            }
        }
    }
    __syncthreads();
    const int w = tid >> 6, lane = tid & 63, fr = lane & 15, q = lane >> 4;
    const int i = w & 3, vh = w >> 2;
    f32x4 sT[4];
#pragma unroll
    for (int j = 0; j < 4; ++j) sT[j] = (f32x4){0.f, 0.f, 0.f, 0.f};
    {
        bf16x8 qfr[4];
#pragma unroll
        for (int ks = 0; ks < 4; ++ks) qfr[ks] = *(const bf16x8*)((const unsigned char*)QT + (16 * i + fr) * 272 + (32 * ks + 8 * q) * 2);
        const unsigned char* KT = lds + KT0 + 4352 * ((i * (i + 1)) / 2);
#pragma unroll
        for (int j = 0; j < 4; ++j) if (j <= i) {
#pragma unroll
            for (int ks = 0; ks < 4; ++ks) { const bf16x8 a = *(const bf16x8*)(KT + (16 * j + fr) * 272 + (32 * ks + 8 * q) * 2); sT[j] = mfma16(a, qfr[ks], sT[j]); }
            if (j == i) {
#pragma unroll
                for (int rg = 0; rg < 4; ++rg) if (4 * q + rg > fr) sT[j][rg] = 0.f;
            }
        }
    }
    f32x4 oacc[4];
#pragma unroll
    for (int vbl = 0; vbl < 4; ++vbl) oacc[vbl] = (f32x4){0.f, 0.f, 0.f, 0.f};
#pragma unroll
    for (int m = 0; m < 2; ++m) if (2 * m <= i) {
        const bf16x8 bfrag = mk8u(cvt_pk_bf16(sT[2 * m][0], sT[2 * m][1]), cvt_pk_bf16(sT[2 * m][2], sT[2 * m][3]), cvt_pk_bf16(sT[2 * m + 1][0], sT[2 * m + 1][1]), cvt_pk_bf16(sT[2 * m + 1][2], sT[2 * m + 1][3]));
#pragma unroll
        for (int vbl = 0; vbl < 4; ++vbl) {
            const unsigned char* base = VTl + (16 * (vh * 4 + vbl) + fr) * 144 + (32 * m + 4 * q) * 2;
            const bf16x8 a = mk8(*(const u32x2*)base, *(const u32x2*)(base + 32));
            oacc[vbl] = mfma16(a, bfrag, oacc[vbl]);
        }
    }
    {
        const bf16_t* stp = ST + (size_t)(bh * 64 + c) * 16384;
#pragma unroll
        for (int ks = 0; ks < 4; ++ks) {
            const bf16x8 bfr = *(const bf16x8*)((const unsigned char*)QC + (16 * i + fr) * 272 + (32 * ks + 8 * q) * 2);
#pragma unroll
            for (int vbl = 0; vbl < 4; ++vbl) { const bf16x8 a = *(const bf16x8*)(stp + (size_t)(16 * (vh * 4 + vbl) + fr) * 128 + 32 * ks + 8 * q); oacc[vbl] = mfma16(a, bfr, oacc[vbl]); }
        }
    }
    float ss = 0.f;
#pragma unroll
    for (int vbl = 0; vbl < 4; ++vbl) ss += (oacc[vbl][0] * oacc[vbl][0] + oacc[vbl][1] * oacc[vbl][1]) + (oacc[vbl][2] * oacc[vbl][2] + oacc[vbl][3] * oacc[vbl][3]);
    ss += __shfl_xor(ss, 16); ss += __shfl_xor(ss, 32);
    if (q == 0) rmsp[vh * 64 + 16 * i + fr] = ss;
    __syncthreads();
    const float rstd = rsqrtf((rmsp[16 * i + fr] + rmsp[64 + 16 * i + fr]) * (1.0f / 128.0f) + EPS);
    const size_t row = (size_t)(row0 + 16 * i + fr);
#pragma unroll
    for (int vbl = 0; vbl < 4; ++vbl) {
        const int v0 = 16 * (vh * 4 + vbl) + 4 * q;
        const u32x2 gt = *(const u32x2*)(GH + row * 512 + h * 128 + v0);
        const f32x4 gg = *(const f32x4*)(hg + h * 128 + v0);
        u32x2 o;
        o.x = cvt_pk_bf16(oacc[vbl][0] * rstd * gg[0] * bflo(gt.x), oacc[vbl][1] * rstd * gg[1] * bfhi(gt.x));
        o.y = cvt_pk_bf16(oacc[vbl][2] * rstd * gg[2] * bflo(gt.y), oacc[vbl][3] * rstd * gg[3] * bfhi(gt.y));
        *(u32x2*)(MIXED + row * 1024 + h * 128 + v0) = o;
    }
    __syncthreads();
}

__device__ void attn_unit(const bf16_t* __restrict__ XQ, const bf16_t* __restrict__ KX, const bf16_t* __restrict__ VT, bf16_t* __restrict__ ATT, int unit, unsigned char* lds) {
    const int tid = threadIdx.x, w = tid >> 6, lane = tid & 63, r = lane & 31, hh = lane >> 5;
    const int b = unit >> 6, st = (unit >> 2) & 15, h = unit & 3;
    const int row0 = b * SEQ + st * 256;
    const bf16_t* qp = XQ + (size_t)(row0 + 32 * w + r) * 1024 + h * 256 + 8 * hh;
    {
        const bf16_t* kp = KX + (size_t)(b * 256) * 1024 + h * 256;
#pragma unroll
        for (int it = 0; it < 16; ++it) { const int idx = tid + 512 * it, m = idx >> 5, cc = idx & 31;
            const u32x4 v = *(const u32x4*)(kp + (size_t)m * 1024 + cc * 8); *(u32x4*)(lds + m * 528 + cc * 16) = v; }
    }
    __syncthreads();
    f32x16 sacc[8];
#pragma unroll
    for (int mb = 0; mb < 8; ++mb)
#pragma unroll
        for (int e = 0; e < 16; ++e) sacc[mb][e] = 0.f;
    for (int kg = 0; kg < 4; ++kg) {
        bf16x8 qf[4];
#pragma unroll
        for (int k4 = 0; k4 < 4; ++k4) qf[k4] = *(const bf16x8*)(qp + 16 * (4 * kg + k4));
#pragma unroll
        for (int k4 = 0; k4 < 4; ++k4)
#pragma unroll
            for (int mb = 0; mb < 8; ++mb) { const bf16x8 a = *(const bf16x8*)(lds + (32 * mb + r) * 528 + (16 * (4 * kg + k4) + 8 * hh) * 2); sacc[mb] = mfma32(a, qf[k4], sacc[mb]); }
    }
    float mx = -3.0e38f;
#pragma unroll
    for (int mb = 0; mb < 8; ++mb)
#pragma unroll
        for (int e = 0; e < 16; ++e) mx = fmaxf(mx, sacc[mb][e]);
    mx = fmaxf(mx, __shfl_xor(mx, 32));
    float sum = 0.f;
    bf16x8 pf[8][2];
#pragma unroll
    for (int mb = 0; mb < 8; ++mb) {
        float pv[16];
#pragma unroll
        for (int e = 0; e < 16; ++e) { pv[e] = __expf(sacc[mb][e] - mx); sum += pv[e]; }
#pragma unroll
        for (int s = 0; s < 2; ++s) pf[mb][s] = mk8u(cvt_pk_bf16(pv[8 * s + 0], pv[8 * s + 1]), cvt_pk_bf16(pv[8 * s + 2], pv[8 * s + 3]), cvt_pk_bf16(pv[8 * s + 4], pv[8 * s + 5]), cvt_pk_bf16(pv[8 * s + 6], pv[8 * s + 7]));
    }
    sum += __shfl_xor(sum, 32);
    const float inv = 1.0f / sum;
    __syncthreads();
    {
        const bf16_t* vp = VT + (size_t)(h * 256) * 1024 + b * 256;
#pragma unroll
        for (int it = 0; it < 16; ++it) { const int idx = tid + 512 * it, e = idx >> 5, cc = idx & 31;
            const u32x4 v = *(const u32x4*)(vp + (size_t)e * 1024 + cc * 8);
            u32x2* d = (u32x2*)(lds + e * 520 + cc * 16); d[0] = (u32x2){v.x, v.y}; d[1] = (u32x2){v.z, v.w}; }
    }
    __syncthreads();
    bf16_t* op = ATT + (size_t)(row0 + 32 * w + r) * 1024 + h * 256 + 4 * hh;
#pragma unroll
    for (int half = 0; half < 2; ++half) {
        f32x16 oacc[4];
#pragma unroll
        for (int d = 0; d < 4; ++d)
#pragma unroll
            for (int e = 0; e < 16; ++e) oacc[d][e] = 0.f;
#pragma unroll
        for (int mb = 0; mb < 8; ++mb)
#pragma unroll
            for (int s = 0; s < 2; ++s)
#pragma unroll
                for (int d = 0; d < 4; ++d) {
                    const unsigned char* base = lds + (32 * (half * 4 + d) + r) * 520 + (32 * mb + 16 * s + 4 * hh) * 2;
                    const bf16x8 a = mk8(*(const u32x2*)base, *(const u32x2*)(base + 16));
                    oacc[d] = mfma32(a, pf[mb][s], oacc[d]);
                }
#pragma unroll
        for (int d = 0; d < 4; ++d)
#pragma unroll
            for (int g = 0; g < 4; ++g) {
                u32x2 o; o.x = cvt_pk_bf16(oacc[d][4 * g] * inv, oacc[d][4 * g + 1] * inv); o.y = cvt_pk_bf16(oacc[d][4 * g + 2] * inv, oacc[d][4 * g + 3] * inv);
                *(u32x2*)(op + 32 * (half * 4 + d) + 8 * g) = o;
            }
    }
    __syncthreads();
}

__device__ void phase_final(float* __restrict__ out, const float* __restrict__ g) {
    const int lane = threadIdx.x & 63, gw = blockIdx.x * (NTHREADS / 64) + (threadIdx.x >> 6), nw = gridDim.x * (NTHREADS / 64);
    f32x4 gv[4];
#pragma unroll
    for (int i = 0; i < 4; ++i) gv[i] = ((const f32x4*)g)[lane + 64 * i];
    for (int r = gw; r < MROWS; r += nw) {
        f32x4* row = (f32x4*)(out + (size_t)r * DM);
        f32x4 v[4]; float ss = 0.f;
#pragma unroll
        for (int i = 0; i < 4; ++i) { v[i] = row[lane + 64 * i]; ss += (v[i][0] * v[i][0] + v[i][1] * v[i][1]) + (v[i][2] * v[i][2] + v[i][3] * v[i][3]); }
#pragma unroll
        for (int o = 1; o < 64; o <<= 1) ss += __shfl_xor(ss, o);
        const float rstd = rsqrtf(ss * (1.0f / 1024.0f) + EPS);
#pragma unroll
        for (int i = 0; i < 4; ++i) row[lane + 64 * i] = v[i] * rstd * gv[i];
    }
}

#define XB_TMO      128
#define XB_XCNT(j)  (256  + 64 * (j))
#define XB_XSUB(j)  (1280 + 64 * (j))
#define XB_XGEN(j)  (2304 + 64 * (j))
#define XB_TOP      3328
#define XB_TOPGEN   3392
#define XCD_BAR_WORDS 3456
#define XB_SPIN_CAP (1u << 22)
__device__ __forceinline__ unsigned xb_ld(unsigned* p)              { return __hip_atomic_load(p, __ATOMIC_RELAXED, __HIP_MEMORY_SCOPE_AGENT); }
__device__ __forceinline__ unsigned xb_add(unsigned* p, unsigned v) { return __hip_atomic_fetch_add(p, v, __ATOMIC_RELAXED, __HIP_MEMORY_SCOPE_AGENT); }
__device__ __forceinline__ unsigned xb_xcc_id() { return (unsigned)__builtin_amdgcn_s_getreg((3 << 11) | 20) & 0xFu; }
#define XB_SPIN(cond, bar) do { unsigned _sp = 0; while (cond) { __builtin_amdgcn_s_sleep(1); \
    if ((++_sp & 255u) == 0u) { if (xb_ld(&(bar)[XB_TMO])) break; if (_sp > XB_SPIN_CAP) { atomicAdd(&(bar)[XB_TMO], 1u); break; } } } } while (0)
struct XcdBarrier { unsigned* bar; unsigned x; volatile LAS unsigned* st; };
__device__ __forceinline__ XcdBarrier xcd_barrier_post(unsigned* bar, volatile LAS unsigned* st) {
    XcdBarrier b; b.bar = bar; b.x = xb_xcc_id(); b.st = st;
    if (threadIdx.x == 0) (void)xb_add(&bar[XB_XCNT(b.x)], 1u);
    return b;
}
__device__ __forceinline__ void xcd_barrier_complete(unsigned* bar, unsigned x, unsigned& nloc, unsigned& nx) {
    const unsigned G = gridDim.x * gridDim.y * gridDim.z;
    unsigned sum, cnt, mine, sp = 0u;
    for (;;) {
        sum = 0u; cnt = 0u; mine = 0u;
#pragma unroll
        for (unsigned j = 0; j < 16; ++j) { const unsigned c = xb_ld(&bar[XB_XCNT(j)]); sum += c; cnt += (c > 0u) ? 1u : 0u; mine = (j == x) ? c : mine; }
        if (sum == G) break;
        __builtin_amdgcn_s_sleep(1);
        if ((++sp & 255u) == 0u) { if (xb_ld(&bar[XB_TMO])) break; if (sp > XB_SPIN_CAP) { atomicAdd(&bar[XB_TMO], 1u); break; } }
    }
    nloc = mine > 0u ? mine : 1u; nx = cnt > 0u ? cnt : 1u;
}
__device__ __forceinline__ void xcd_barrier(const XcdBarrier& b) {
    asm volatile("s_waitcnt vmcnt(0)" ::: "memory");
    __syncthreads();
    if (threadIdx.x == 0) {
        unsigned* bar = b.bar;
        __builtin_amdgcn_s_waitcnt(0);
        unsigned nloc = b.st[0], nx = b.st[1];
        if (nloc == 0u) { xcd_barrier_complete(bar, b.x, nloc, nx); b.st[0] = nloc; b.st[1] = nx; }
        const unsigned old = xb_add(&bar[XB_XSUB(b.x)], 1u);
        const unsigned gen = old / nloc;
        if (old + 1u == (gen + 1u) * nloc) {
            __builtin_amdgcn_fence(__ATOMIC_RELEASE, "agent");
            asm volatile("s_waitcnt vmcnt(0)" ::: "memory");
            const unsigned og = xb_add(&bar[XB_TOP], 1u);
            const unsigned tg = og / nx;
            if (og + 1u == (tg + 1u) * nx) xb_add(&bar[XB_TOPGEN], 1u);
            else XB_SPIN(xb_ld(&bar[XB_TOPGEN]) == tg, bar);
            __builtin_amdgcn_fence(__ATOMIC_ACQUIRE, "agent");
            xb_add(&bar[XB_XGEN(b.x)], 1u);
            asm volatile("s_waitcnt vmcnt(0)" ::: "memory");
        } else {
            XB_SPIN(xb_ld(&bar[XB_XGEN(b.x)]) == gen, bar);
            __builtin_amdgcn_fence(__ATOMIC_ACQUIRE, "agent");
            asm volatile("s_waitcnt vmcnt(0)" ::: "memory");
        }
    }
    __syncthreads();
}

constexpr int N_PHASES = 12;
__global__ void __launch_bounds__(NTHREADS, 2) mega(Params p) {
    extern __shared__ __attribute__((aligned(16))) unsigned char lds[];
    LAS unsigned char* ldsl = (LAS unsigned char*)lds;
    unsigned char* ws = p.ws;
    const int G = gridDim.x, bid = blockIdx.x;
    const int lo = p.ph_lo, hi = p.ph_hi;

#ifndef DBG_LAST
#define DBG_LAST -1
#endif
#ifndef PHASE_MASK
#define PHASE_MASK 0xfff
#endif
#define IN(k) (((PHASE_MASK >> (k)) & 1) && lo <= (k) && (k) < hi)
    if (threadIdx.x == 0) { ((volatile LAS unsigned*)(ldsl + LDS_MAIN))[0] = 0u; ((volatile LAS unsigned*)(ldsl + LDS_MAIN))[1] = 0u; }
    __syncthreads();
    XcdBarrier xbar; xbar.bar = (unsigned*)(ws + WS_BAR); xbar.x = 0; xbar.st = nullptr;
    if (hi - lo > 1) xbar = xcd_barrier_post((unsigned*)(ws + WS_BAR), (volatile LAS unsigned*)(ldsl + LDS_MAIN));
    if (lo > hi) cg::this_grid().sync();
#define SEAM(k) do { if (IN(k) && IN((k) + 1)) { xcd_barrier(xbar); } } while (0)
    bf16_t* XB = (bf16_t*)(ws + WS_XB); bf16_t* LT = (bf16_t*)(ws + WS_XB);
    bf16_t* QH = (bf16_t*)(ws + WS_QH); bf16_t* KH = (bf16_t*)(ws + WS_KH); bf16_t* VH = (bf16_t*)(ws + WS_VH); bf16_t* GH = (bf16_t*)(ws + WS_GH); bf16_t* PH = (bf16_t*)(ws + WS_PH);
    float* LF = (float*)(ws + WS_LF); bf16_t* ST = (bf16_t*)(ws + WS_ST); bf16_t* MIXED = (bf16_t*)(ws + WS_MIXED);
    float* X1 = (float*)(ws + WS_X1); bf16_t* XQ = (bf16_t*)(ws + WS_XQ); bf16_t* ATT = (bf16_t*)(ws + WS_ATT); bf16_t* U = (bf16_t*)(ws + WS_U);
    float* SSQ = (float*)(ws + WS_SSQ); float* DEC = (float*)(ws + WS_DEC);
    bf16_t* MEMB = (bf16_t*)(ws + WS_MEMB); bf16_t* KX = (bf16_t*)(ws + WS_KX); bf16_t* VT = (bf16_t*)(ws + WS_VT);

    const bool fuse_final = (G == 256) && IN(10) && (hi - lo > 1);
    if (IN(0)) { phase_prep(p, lds); }
    SEAM(0);
    if (IN(1)) {
        const pg8::Epi E{0, ws, p.x, p.out, p.lb_logits, p.final_norm_g};
        { pg8::Gemm g{XB, (const bf16_t*)(ws + WS_WT_IN), MROWS, NIN, DM}; pg8::StaticOrder S; S.init(MROWS, NIN, G, bid); pg8::gemm_phase(ldsl, g, S, E); }
        const pg8::Epi E1{1, ws, p.x, p.out, p.lb_logits, p.final_norm_g};
        { pg8::Gemm g{MEMB, (const bf16_t*)(ws + WS_WT_K), MEMROWS, 1024, DM}; pg8::StaticOrder S; S.init(MEMROWS, 1024, G, (bid + 128) % G); pg8::gemm_phase(ldsl, g, S, E1); }
        const pg8::Epi E2{2, ws, p.x, p.out, p.lb_logits, p.final_norm_g};
        { pg8::Gemm g{(const bf16_t*)(ws + WS_WT_V), MEMB, 1024, MEMROWS, DM}; pg8::StaticOrder S; S.init(1024, MEMROWS, G, (bid + 112) % G); pg8::gemm_phase(ldsl, g, S, E2); }
    }
    SEAM(1);
    if (IN(2)) {
#ifndef DBG_NO_PASSA
        for (int u = bid; u < 1024; u += G) hgrn_passA_unit(KH, LF, VH, LT, DEC, u, lds);
#endif
#ifndef DBG_NO_POOL
        for (int t = bid; t < 256; t += G) pool_tile(PH, MIXED, t);
#endif
    }
    SEAM(2);
    if (IN(3)) { phase_scan(LT, DEC, ST); }
    SEAM(3);
    if (IN(4)) { for (int u = bid; u < 1024; u += G) hgrn_passC_unit(QH, KH, LF, VH, GH, ST, p.hgrn_norm_g, MIXED, u, lds); }
    SEAM(4);
    if (IN(5)) {
        const pg8::Epi E{3, ws, p.x, p.out, p.lb_logits, p.final_norm_g};
        pg8::Gemm g{MIXED, (const bf16_t*)(ws + WS_WT_OUT), MROWS, DM, DM}; pg8::StaticOrder S; S.init(MROWS, DM, G, bid); pg8::gemm_phase(ldsl, g, S, E);
    }
    SEAM(5);
    if (IN(6)) {
        const pg8::Epi E{4, ws, p.x, p.out, p.lb_logits, p.final_norm_g};
        pg8::Gemm g{XB, (const bf16_t*)(ws + WS_WT_Q), MROWS, DM, DM}; pg8::StaticOrder S; S.init(MROWS, DM, G, bid); pg8::gemm_phase(ldsl, g, S, E);
    }
    SEAM(6);
    if (IN(7)) { for (int u = bid; u < 256; u += G) attn_unit(XQ, KX, VT, ATT, u, lds); }
    SEAM(7);
    if (IN(8)) {
        const pg8::Epi E{6, ws, p.x, p.out, p.lb_logits, p.final_norm_g};
        pg8::Gemm g{ATT, (const bf16_t*)(ws + WS_WT_O), MROWS, DM, DM}; pg8::StaticOrder S; S.init(MROWS, DM, G, bid); pg8::gemm_phase(ldsl, g, S, E);
    }
    SEAM(8);
    if (IN(9)) {
        const pg8::Epi E{5, ws, p.x, p.out, p.lb_logits, p.final_norm_g};
        pg8::Gemm g{XB, (const bf16_t*)(ws + WS_WT_FF1), MROWS, DFF, DM}; pg8::StaticOrder S; S.init(MROWS, DFF, G, bid); pg8::gemm_phase(ldsl, g, S, E);
    }
    SEAM(9);
    if (IN(10)) {
        const pg8::Epi E{fuse_final ? 8 : 7, ws, p.x, p.out, p.lb_logits, p.final_norm_g};
        pg8::Gemm g{U, (const bf16_t*)(ws + WS_WT_FF2), MROWS, DM, DFF}; pg8::StaticOrder S; S.init(MROWS, DM, G, bid); pg8::gemm_phase(ldsl, g, S, E);
    }
    if (!fuse_final) {
        SEAM(10);
        if (IN(11)) { phase_final(p.out, p.final_norm_g); }
    }
#if DBG_LAST >= 0
    cg::this_grid().sync();
    {
        const unsigned* w32 = (const unsigned*)ws;
        for (size_t i = (size_t)bid * NTHREADS + threadIdx.x; i < (size_t)MROWS * DM; i += (size_t)G * NTHREADS) {
            float a = 0.f;
            for (int j = 0; j < 4; ++j) { const unsigned v = w32[i + (size_t)j * MROWS * DM]; a += (float)(v & 0xffffu) + (float)(v >> 16); }
            p.out[i] = a;
        }
    }
#endif
#undef IN
#undef SEAM
}

extern "C" void kernel_launch(void* const* d_in, const int* in_sizes, int n_in, void* d_out, int out_size, void* d_ws, size_t ws_size, hipStream_t stream) {
    static int grid = 0;
    if (grid == 0) {
        if (n_in != 19 || in_sizes[0] != MROWS * DM || out_size != MROWS * DM || ws_size < WS_END) { fprintf(stderr, "kernel_launch: unexpected shapes (n_in %d, ws %zu)\n", n_in, ws_size); grid = -1; return; }
        int dev = 0, cus = 0, per_cu = 0;
        hipGetDevice(&dev); hipDeviceGetAttribute(&cus, hipDeviceAttributeMultiprocessorCount, dev);
        if (hipFuncSetAttribute((const void*)mega, hipFuncAttributeMaxDynamicSharedMemorySize, LDS_BYTES) != hipSuccess) { fprintf(stderr, "kernel_launch: hipFuncSetAttribute failed\n"); grid = -1; return; }
        if (hipOccupancyMaxActiveBlocksPerMultiprocessor(&per_cu, (const void*)mega, NTHREADS, LDS_BYTES) != hipSuccess || per_cu < 1) { fprintf(stderr, "kernel_launch: occupancy query says %d\n", per_cu); per_cu = 1; }
        (void)hipGetLastError();
        grid = cus * 1;
        if (grid > cus * per_cu) grid = cus * per_cu;
    }
    if (grid < 0) return;
    if (hipMemsetAsync((char*)d_ws + WS_BAR, 0, 32768, stream) != hipSuccess) { fprintf(stderr, "kernel_launch: memset of barrier words failed\n"); return; }
    Params p{};
    const float** f = (const float**)&p;
    for (int i = 0; i < 19; ++i) f[i] = (const float*)d_in[i];
    p.out = (float*)d_out; p.ws = (unsigned char*)d_ws;
#if N_LAUNCH_MODE == 1
    p.ph_lo = 0; p.ph_hi = (DBG_LAST >= 0) ? DBG_LAST + 1 : N_PHASES;
    void* args[] = {&p};
    hipError_t e = hipLaunchCooperativeKernel((const void*)mega, dim3(grid), dim3(NTHREADS), args, LDS_BYTES, stream);
    if (e != hipSuccess) fprintf(stderr, "kernel_launch: cooperative launch failed: %s (grid %d)\n", hipGetErrorString(e), grid);
#else
    for (int k = 0; k < N_PHASES; ++k) { p.ph_lo = k; p.ph_hi = k + 1; hipLaunchKernelGGL(mega, dim3(grid), dim3(NTHREADS), LDS_BYTES, stream, p); }
#endif
}
```

```cpp
#include <hip/hip_runtime.h>
#include <hip/hip_cooperative_groups.h>
#include <cstdio>
namespace cg = cooperative_groups;

#ifndef N_LAUNCH_MODE
#define N_LAUNCH_MODE 1
#endif

typedef unsigned short bf16_t;
typedef short bf16x8 __attribute__((ext_vector_type(8)));
typedef float f32x2 __attribute__((ext_vector_type(2)));
typedef float f32x4 __attribute__((ext_vector_type(4)));
typedef float f32x16 __attribute__((ext_vector_type(16)));
typedef unsigned u32x2 __attribute__((ext_vector_type(2)));
typedef unsigned u32x4 __attribute__((ext_vector_type(4)));
#define LAS __attribute__((address_space(3)))

constexpr int MROWS = 16384, DM = 1024, SEQ = 4096, NIN = 2560, DFF = 4096, MEMROWS = 1024;
constexpr float EPS = 1e-6f;
constexpr int NTHREADS = 512;
constexpr int LDS_MAIN = 135168;
constexpr int LDS_BYTES = LDS_MAIN + 16;

constexpr size_t MiB = 1u << 20;
constexpr size_t WS_WT_IN = 0, WS_WT_K = 5 * MiB, WS_WT_V = 7 * MiB, WS_WT_OUT = 9 * MiB, WS_WT_Q = 11 * MiB, WS_WT_O = 13 * MiB,
                 WS_WT_FF1 = 15 * MiB, WS_WT_FF2 = 23 * MiB, WS_MEMB = 31 * MiB, WS_KX = 33 * MiB, WS_VT = 35 * MiB, WS_SSQ = 37 * MiB,
                 WS_BAR = 39 * MiB, WS_CNT = 39 * MiB + 16384, WS_RSTD0 = 38 * MiB, WS_RSTDM = 38 * MiB + 65536, WS_DEC = 38 * MiB + 131072,
                 WS_XB = 40 * MiB  , WS_QH = 72 * MiB, WS_KH = 88 * MiB, WS_VH = 104 * MiB, WS_GH = 120 * MiB, WS_PH = 136 * MiB,
                 WS_LF = 152 * MiB, WS_ST = 184 * MiB, WS_MIXED = 216 * MiB,
                 WS_X1 = 72 * MiB, WS_XQ = 136 * MiB, WS_ATT = 168 * MiB, WS_U = 72 * MiB, WS_END = 256 * MiB;

typedef __bf16 bf16x2n __attribute__((ext_vector_type(2)));
__device__ __forceinline__ unsigned cvt_pk_bf16(float lo, float hi) { f32x2 v = {lo, hi}; return __builtin_bit_cast(unsigned, __builtin_convertvector(v, bf16x2n)); }
__device__ __forceinline__ bf16_t f2bf(float f) { return (bf16_t)(cvt_pk_bf16(f, 0.f) & 0xffffu); }
__device__ __forceinline__ float bf2f(bf16_t b) { return __uint_as_float(((unsigned)b) << 16); }
__device__ __forceinline__ float bflo(unsigned u) { return __uint_as_float(u << 16); }
__device__ __forceinline__ float bfhi(unsigned u) { return __uint_as_float(u & 0xffff0000u); }
__device__ __forceinline__ f32x4 mfma16(bf16x8 a, bf16x8 b, f32x4 c) { return __builtin_amdgcn_mfma_f32_16x16x32_bf16(a, b, c, 0, 0, 0); }
__device__ __forceinline__ f32x16 mfma32(bf16x8 a, bf16x8 b, f32x16 c) { return __builtin_amdgcn_mfma_f32_32x32x16_bf16(a, b, c, 0, 0, 0); }
__device__ __forceinline__ bf16x8 mk8(u32x2 lo, u32x2 hi) { u32x4 t; t.x = lo.x; t.y = lo.y; t.z = hi.x; t.w = hi.y; return __builtin_bit_cast(bf16x8, t); }
__device__ __forceinline__ bf16x8 mk8u(unsigned a, unsigned b, unsigned c, unsigned d) { u32x4 t; t.x = a; t.y = b; t.z = c; t.w = d; return __builtin_bit_cast(bf16x8, t); }
__device__ __forceinline__ float sigmoidf_(float z) { return 1.0f / (1.0f + __expf(-z)); }

namespace pg8 {
constexpr int BM = 256, BK = 64, HALF = 128, HTB = HALF * BK * 2, STAGE_BYTES = 8 * HTB, NXCD = 8, WGM = 8;
__device__ __forceinline__ int lds_byte(int r, int c) { const int st = (r >> 4) * 2 + (c >> 5), rr = r & 15, cc = c & 31, ob = rr * 64 + cc * 2; return st * 1024 + (ob ^ (((ob >> 9) & 1) << 5)); }
__device__ __forceinline__ void stage_rc(int b, int& R, int& C) { const int st = b / 1024, sb = b % 1024, swz = sb ^ (((sb >> 9) & 1) << 5); R = (st >> 1) * 16 + swz / 64; C = (st & 1) * 32 + (swz % 64) / 2; }
__device__ __forceinline__ int perm32(int rho) { const int n = rho >> 4, i = rho & 15; return 8 * (i >> 2) + 4 * n + (i & 3); }
struct Unit { int pm, pn; };
struct Gemm { const bf16_t* A; const bf16_t* Bt; int M, N, K; };
struct StaticOrder {
    int nM, nN, nwg, G, c;
    __device__ void init(int M, int N, int G_, int c_) { nM = M / BM; nN = N / BM; nwg = nM * nN; G = G_; c = c_; }
    __device__ bool next(int i, Unit& u) const {
        const long L = (long)i * G + c; if (L >= nwg) return false;
        int wgid = (int)L; { const int q = nwg / NXCD, r = nwg % NXCD, xcd = wgid % NXCD, off = wgid / NXCD; wgid = (xcd < r ? xcd * (q + 1) : r * (q + 1) + (xcd - r) * q) + off; }
        const int nig = WGM * nN, gid = wgid / nig, fm = gid * WGM, gsz = (nM - fm) < WGM ? (nM - fm) : WGM;
        u.pm = fm + ((wgid % nig) % gsz); u.pn = (wgid % nig) / gsz; return true;
    }
};

struct Epi {
    static constexpr bool PERM = true;
    int mode;
    unsigned char* ws; const float* x; float* out; const float* lbl; const float* gfin;
    __device__ __forceinline__ void store8(bf16_t* p, const f32x4& v0, const f32x4& v1) const {
        u32x4 w; w.x = cvt_pk_bf16(v0[0], v0[1]); w.y = cvt_pk_bf16(v0[2], v0[3]); w.z = cvt_pk_bf16(v1[0], v1[1]); w.w = cvt_pk_bf16(v1[2], v1[3]); *(u32x4*)p = w; }
    __device__ __forceinline__ void fused(f32x4 (&acc)[2][2][4][2], const Unit& u, int wr, int wc, int fr, int fq) const {
        const int row0 = u.pm * BM + wr * 64 + fr;
        const int col0 = u.pn * BM + wc * 32 + 8 * fq;
        const bf16_t* xb = (const bf16_t*)(ws + WS_XB);
        unsigned* sq = (unsigned*)(ws + WS_SSQ);
        unsigned* cnt = (unsigned*)(ws + WS_CNT) + 64 * u.pm;
        u32x4 bc[2], bn[2];
        { const size_t o = (size_t)row0 * DM + col0; bc[0] = *(const u32x4*)(xb + o); bc[1] = *(const u32x4*)(xb + o + HALF); }
#pragma unroll
        for (int gidx = 0; gidx < 8; ++gidx) { const int ai = gidx >> 2, m = gidx & 3; const int row = row0 + ai * HALF + m * 16;
            if (gidx < 7) { const int g2 = gidx + 1; const size_t o2 = (size_t)(row0 + (g2 >> 2) * HALF + (g2 & 3) * 16) * DM + col0; bn[0] = *(const u32x4*)(xb + o2); bn[1] = *(const u32x4*)(xb + o2 + HALF); }
            float ss = 0.f;
#pragma unroll
            for (int bj = 0; bj < 2; ++bj) { const u32x4 bb = bc[bj];
                const f32x4 v0 = acc[ai][bj][m][0] + (f32x4){bflo(bb.x), bfhi(bb.x), bflo(bb.y), bfhi(bb.y)}, v1 = acc[ai][bj][m][1] + (f32x4){bflo(bb.z), bfhi(bb.z), bflo(bb.w), bfhi(bb.w)};
                acc[ai][bj][m][0] = v0; acc[ai][bj][m][1] = v1;
                ss += (v0[0] * v0[0] + v0[1] * v0[1]) + (v0[2] * v0[2] + v0[3] * v0[3]) + (v1[0] * v1[0] + v1[1] * v1[1]) + (v1[2] * v1[2] + v1[3] * v1[3]); }
            ss += __shfl_xor(ss, 16); ss += __shfl_xor(ss, 32);
            if (fq == 0) __hip_atomic_store(sq + (size_t)row * 16 + u.pn * 4 + wc, __float_as_uint(ss), __ATOMIC_RELAXED, __HIP_MEMORY_SCOPE_AGENT);
            bc[0] = bn[0]; bc[1] = bn[1]; }
        asm volatile("s_waitcnt vmcnt(0)" ::: "memory");
        if ((threadIdx.x & 63) == 0) __hip_atomic_fetch_add(cnt, 1u, __ATOMIC_RELAXED, __HIP_MEMORY_SCOPE_AGENT);
        f32x4 gv[2][2];
#pragma unroll
        for (int bj = 0; bj < 2; ++bj) { gv[bj][0] = *(const f32x4*)(gfin + col0 + bj * HALF); gv[bj][1] = *(const f32x4*)(gfin + col0 + bj * HALF + 4); }
        { unsigned spins = 0; while ((unsigned)__builtin_amdgcn_readfirstlane(__hip_atomic_load(cnt, __ATOMIC_RELAXED, __HIP_MEMORY_SCOPE_AGENT)) < 32u) { __builtin_amdgcn_s_sleep(1); if (++spins > (1u << 22)) break; } }
        __builtin_amdgcn_fence(__ATOMIC_ACQUIRE, "agent");
        asm volatile("s_waitcnt vmcnt(0)" ::: "memory");
        f32x4 pv[8];
#pragma unroll
        for (int gidx = 0; gidx < 8; ++gidx) pv[gidx] = *(const f32x4*)((const float*)sq + (size_t)(row0 + (gidx >> 2) * HALF + (gidx & 3) * 16) * 16 + 4 * fq);
#pragma unroll
        for (int gidx = 0; gidx < 8; ++gidx) { const int ai = gidx >> 2, m = gidx & 3; const int row = row0 + ai * HALF + m * 16;
            float t = (pv[gidx][0] + pv[gidx][1]) + (pv[gidx][2] + pv[gidx][3]); t += __shfl_xor(t, 16); t += __shfl_xor(t, 32);
            const float rstd = rsqrtf(t * (1.0f / 1024.0f) + EPS);
            const size_t o = (size_t)row * DM + col0;
#pragma unroll
            for (int bj = 0; bj < 2; ++bj) { *(f32x4*)(out + o + bj * HALF) = acc[ai][bj][m][0] * rstd * gv[bj][0]; *(f32x4*)(out + o + bj * HALF + 4) = acc[ai][bj][m][1] * rstd * gv[bj][1]; } }
    }
    __device__ __forceinline__ void operator()(const f32x4 (&acc)[2][2][4][2], const Unit& u, int wr, int wc, int fr, int fq) const {
        const int row0 = u.pm * BM + wr * 64 + fr;
        const int colL = wc * 32 + 8 * fq;
        if (mode == 3 || mode == 6 || mode == 7) {
            const int col0 = u.pn * BM + colL;
            bf16_t* xb = (bf16_t*)(ws + WS_XB);
            float* ssq = (float*)(ws + WS_SSQ);
            f32x4 rc[4], rn[4];
            u32x4 bc[2], bn[2];
            if (mode == 3) { const size_t o = (size_t)row0 * DM + col0; rc[0] = *(const f32x4*)(x + o); rc[1] = *(const f32x4*)(x + o + 4); rc[2] = *(const f32x4*)(x + o + HALF); rc[3] = *(const f32x4*)(x + o + HALF + 4); }
            else { const size_t o = (size_t)row0 * DM + col0; bc[0] = *(const u32x4*)(xb + o); bc[1] = *(const u32x4*)(xb + o + HALF); }
#pragma unroll
            for (int gidx = 0; gidx < 8; ++gidx) { const int ai = gidx >> 2, m = gidx & 3; const int row = row0 + ai * HALF + m * 16;
                if (gidx < 7) { const int g2 = gidx + 1; const size_t o2 = (size_t)(row0 + (g2 >> 2) * HALF + (g2 & 3) * 16) * DM + col0;
                    if (mode == 3) { rn[0] = *(const f32x4*)(x + o2); rn[1] = *(const f32x4*)(x + o2 + 4); rn[2] = *(const f32x4*)(x + o2 + HALF); rn[3] = *(const f32x4*)(x + o2 + HALF + 4); }
                    else { bn[0] = *(const u32x4*)(xb + o2); bn[1] = *(const u32x4*)(xb + o2 + HALF); } }
                if (mode != 3) {
#pragma unroll
                    for (int bj = 0; bj < 2; ++bj) { rc[2 * bj] = (f32x4){bflo(bc[bj].x), bfhi(bc[bj].x), bflo(bc[bj].y), bfhi(bc[bj].y)}; rc[2 * bj + 1] = (f32x4){bflo(bc[bj].z), bfhi(bc[bj].z), bflo(bc[bj].w), bfhi(bc[bj].w)}; } }
                float ss = 0.f;
#pragma unroll
                for (int bj = 0; bj < 2; ++bj) { const size_t o = (size_t)row * DM + col0 + bj * HALF;
                    const f32x4 v0 = acc[ai][bj][m][0] + rc[2 * bj], v1 = acc[ai][bj][m][1] + rc[2 * bj + 1];
                    if (mode == 7) { *(f32x4*)(out + o) = v0; *(f32x4*)(out + o + 4) = v1; }
                    else store8(xb + o, v0, v1);
                    ss += (v0[0] * v0[0] + v0[1] * v0[1]) + (v0[2] * v0[2] + v0[3] * v0[3]) + (v1[0] * v1[0] + v1[1] * v1[1]) + (v1[2] * v1[2] + v1[3] * v1[3]); }
                if (mode != 7) { ss += __shfl_xor(ss, 16); ss += __shfl_xor(ss, 32);
                    if (fq == 0) ssq[(size_t)row * 16 + u.pn * 4 + wc] = ss; }
#pragma unroll
                for (int k = 0; k < 4; ++k) rc[k] = rn[k];
                bc[0] = bn[0]; bc[1] = bn[1]; }
            return;
        }
        if (mode == 2) {
            const int col0 = u.pn * BM + colL;
            const float* rs = (const float*)(ws + WS_RSTDM); bf16_t* ob = (bf16_t*)(ws + WS_VT); const int ldo = 1024;
            f32x4 c0[2], c1[2];
#pragma unroll
            for (int bj = 0; bj < 2; ++bj) { c0[bj] = *(const f32x4*)(rs + col0 + bj * HALF); c1[bj] = *(const f32x4*)(rs + col0 + bj * HALF + 4); }
#pragma unroll
            for (int ai = 0; ai < 2; ++ai)
#pragma unroll
                for (int m = 0; m < 4; ++m) { const int row = row0 + ai * HALF + m * 16;
#pragma unroll
                    for (int bj = 0; bj < 2; ++bj) store8(ob + (size_t)row * ldo + col0 + bj * HALF, acc[ai][bj][m][0] * c0[bj], acc[ai][bj][m][1] * c1[bj]); }
            return;
        }
        float rsc[8];
        if (mode == 4 || mode == 5) {
            const float* sq = (const float*)(ws + WS_SSQ);
            f32x4 pv[8];
#pragma unroll
            for (int gidx = 0; gidx < 8; ++gidx) pv[gidx] = *(const f32x4*)(sq + (size_t)(row0 + (gidx >> 2) * HALF + (gidx & 3) * 16) * 16 + 4 * fq);
            const float cs = mode == 4 ? 0.0625f : 1.0f;
#pragma unroll
            for (int gidx = 0; gidx < 8; ++gidx) { float t = (pv[gidx][0] + pv[gidx][1]) + (pv[gidx][2] + pv[gidx][3]); t += __shfl_xor(t, 16); t += __shfl_xor(t, 32); rsc[gidx] = rsqrtf(t * (1.0f / 1024.0f) + EPS) * cs; }
        } else {
            const float* rs = (const float*)(ws + (mode == 0 ? WS_RSTD0 : WS_RSTDM));
#pragma unroll
            for (int gidx = 0; gidx < 8; ++gidx) rsc[gidx] = rs[row0 + (gidx >> 2) * HALF + (gidx & 3) * 16];
        }
        if (mode == 0) {
            float* lf = (float*)(ws + WS_LF); bf16_t* kh = (bf16_t*)(ws + WS_KH);
            const int sub = u.pn >> 1; const int cb = (u.pn & 1) * 256 + colL;
            if (sub == 1) {
                float oml[2][8];
#pragma unroll
                for (int bj = 0; bj < 2; ++bj)
#pragma unroll
                    for (int j = 0; j < 8; ++j) { const int c = cb + bj * HALF + j; const float l0 = lbl[c], l1 = lbl[512 + c]; const float lb = 1.0f / (1.0f + __expf(l1 - l0)); oml[bj][j] = 1.0f - lb; }
#pragma unroll
                for (int ai = 0; ai < 2; ++ai)
#pragma unroll
                    for (int m = 0; m < 4; ++m) { const int row = row0 + ai * HALF + m * 16; const float r = rsc[ai * 4 + m];
#pragma unroll
                        for (int bj = 0; bj < 2; ++bj) { f32x4 lf0, lf1, k0, k1;
#pragma unroll
                            for (int j = 0; j < 4; ++j) {
                                const float za = acc[ai][bj][m][0][j] * r, zb = acc[ai][bj][m][1][j] * r;
                                const float ka = oml[bj][j] * (1.0f - sigmoidf_(za)), kb = oml[bj][4 + j] * (1.0f - sigmoidf_(zb));
                                k0[j] = ka; k1[j] = kb; lf0[j] = __logf(1.0f - ka); lf1[j] = __logf(1.0f - kb); }
                            const size_t o = (size_t)row * 512 + cb + bj * HALF;
                            *(f32x4*)(lf + o) = lf0; *(f32x4*)(lf + o + 4) = lf1; store8(kh + o, k0, k1); } }
            } else {
                bf16_t* dst = (bf16_t*)(ws + (sub == 0 ? WS_QH : (sub == 2 ? WS_VH : (sub == 3 ? WS_GH : WS_PH))));
                const bool act = (sub == 0) || (sub == 3);
#pragma unroll
                for (int ai = 0; ai < 2; ++ai)
#pragma unroll
                    for (int m = 0; m < 4; ++m) { const int row = row0 + ai * HALF + m * 16; const float r = rsc[ai * 4 + m];
#pragma unroll
                        for (int bj = 0; bj < 2; ++bj) { f32x4 v0 = acc[ai][bj][m][0] * r, v1 = acc[ai][bj][m][1] * r;
                            if (act) {
#pragma unroll
                                for (int j = 0; j < 4; ++j) { v0[j] = v0[j] * sigmoidf_(v0[j]); v1[j] = v1[j] * sigmoidf_(v1[j]); } }
                            store8(dst + (size_t)row * 512 + cb + bj * HALF, v0, v1); } }
            }
        } else {
            const int col0 = u.pn * BM + colL;
            bf16_t* ob = (bf16_t*)(ws + (mode == 1 ? WS_KX : (mode == 4 ? WS_XQ : WS_U))); const int ldo = mode == 5 ? DFF : 1024;
#pragma unroll
            for (int ai = 0; ai < 2; ++ai)
#pragma unroll
                for (int m = 0; m < 4; ++m) { const int row = row0 + ai * HALF + m * 16; const float r = rsc[ai * 4 + m];
#pragma unroll
                    for (int bj = 0; bj < 2; ++bj) { f32x4 v0 = acc[ai][bj][m][0] * r, v1 = acc[ai][bj][m][1] * r;
                        if (mode == 5) {
#pragma unroll
                            for (int j = 0; j < 4; ++j) { const float a = fmaxf(v0[j], 0.f), b = fmaxf(v1[j], 0.f); v0[j] = a * a; v1[j] = b * b; } }
                        store8(ob + (size_t)row * ldo + col0 + bj * HALF, v0, v1); } }
        }
    }
};

template <class EpiT, class Sched>
__device__ __forceinline__ void gemm_phase(LAS unsigned char* lds, const Gemm g, const Sched S, const EpiT E) {
    const int tid = threadIdx.x, wid = __builtin_amdgcn_readfirstlane(tid >> 6), lane = tid & 63, wr = wid >> 2, wc = wid & 3, fr = lane & 15, fq = lane >> 4;
    const int K = g.K, nt = K / BK;
    unsigned voffA[2], voffB[2];
#pragma unroll
    for (int i = 0; i < 2; ++i) { int R, C; stage_rc(tid * 16 + i * 8192, R, C); const int Rb = EpiT::PERM ? ((R & ~31) + perm32(R & 31)) : R;
        voffA[i] = (unsigned)(R * K + C) * 2u; voffB[i] = (unsigned)(Rb * K + C) * 2u; }
    const size_t kstep = (size_t)(BK * 2);
    const size_t hstep = (size_t)HALF * K * 2;
    const size_t tstep = 2 * hstep;
    const unsigned ldsw = (unsigned)wid * 1024u;
    const int aoff = lds_byte(wr * 64 + fr, fq * 8), boff = lds_byte(wc * 32 + fr, fq * 8);
#define PG8_SA(b, h) (((b) * 2 + (h)) * HTB)
#define PG8_SB(b, h) ((4 + (b) * 2 + (h)) * HTB)
#define PG8_STAGE(bufoff, gbase, voff) do { _Pragma("unroll") for (int _i = 0; _i < 2; ++_i) \
        __builtin_amdgcn_global_load_lds((const unsigned*)((const char*)(gbase) + (voff)[_i]), (LAS unsigned*)(lds + (bufoff) + ldsw + _i * 8192), 16, 0, 0); } while (0)
#define PG8_LDA(dst, b, h) do { _Pragma("unroll") for (int m = 0; m < 4; ++m) _Pragma("unroll") for (int k = 0; k < 2; ++k) dst[m][k] = *(const LAS bf16x8*)(lds + PG8_SA(b, h) + aoff + m * 2048 + k * 1024); } while (0)
#define PG8_LDB(dst, b, h) do { _Pragma("unroll") for (int n = 0; n < 2; ++n) _Pragma("unroll") for (int k = 0; k < 2; ++k) dst[n][k] = *(const LAS bf16x8*)(lds + PG8_SB(b, h) + boff + n * 2048 + k * 1024); } while (0)
#define PG8_MMA(ai, bj, At, Bt) do { __builtin_amdgcn_s_setprio(1); _Pragma("unroll") for (int m = 0; m < 4; ++m) _Pragma("unroll") for (int n = 0; n < 2; ++n) _Pragma("unroll") for (int k = 0; k < 2; ++k) \
        acc[ai][bj][m][n] = __builtin_amdgcn_mfma_f32_16x16x32_bf16(Bt[n][k], At[m][k], acc[ai][bj][m][n], 0, 0, 0); __builtin_amdgcn_s_setprio(0); } while (0)
#define PG8_WAIT_V(n) asm volatile("s_waitcnt vmcnt(" #n ")" ::: "memory")
#define PG8_WAIT_L(n) asm volatile("s_waitcnt lgkmcnt(" #n ")" ::: "memory")
#define PG8_BAR __builtin_amdgcn_s_barrier()
#define PG8_SCHED __builtin_amdgcn_sched_barrier(0)
    Unit cur, nxt; int ui = 0;
    if (!S.next(0, cur)) return;
    f32x4 acc[2][2][4][2];
#pragma unroll
    for (int a = 0; a < 2; ++a)
#pragma unroll
        for (int b = 0; b < 2; ++b)
#pragma unroll
            for (int m = 0; m < 4; ++m)
#pragma unroll
                for (int n = 0; n < 2; ++n) acc[a][b][m][n] = (f32x4){0.f, 0.f, 0.f, 0.f};
    bf16x8 At[4][2], B0[2][2], B1[2][2];
    const char* cA = (const char*)g.A + (size_t)cur.pm * tstep; const char* cB = (const char*)g.Bt + (size_t)cur.pn * tstep;
    PG8_STAGE(PG8_SB(0, 0), cB, voffB); PG8_STAGE(PG8_SA(0, 0), cA, voffA); PG8_STAGE(PG8_SB(0, 1), cB + hstep, voffB); PG8_STAGE(PG8_SA(0, 1), cA + hstep, voffA);
    if (wr == 1) PG8_BAR;
    PG8_WAIT_V(4); PG8_BAR;
    PG8_STAGE(PG8_SB(1, 0), cB + kstep, voffB); PG8_STAGE(PG8_SA(1, 0), cA + kstep, voffA); PG8_STAGE(PG8_SB(1, 1), cB + hstep + kstep, voffB);
    PG8_WAIT_V(6); PG8_BAR;
    for (;;) {
        const bool has_next = S.next(ui + 1, nxt);
        const char* nA = has_next ? (const char*)g.A + (size_t)nxt.pm * tstep : cA; const char* nB = has_next ? (const char*)g.Bt + (size_t)nxt.pn * tstep : cB;
        for (int t = 0; t < nt; t += 2) {
            const bool last = (t == nt - 2);
            const char* a1 = cA + (size_t)(t + 1) * kstep;
            const char* a2 = last ? nA : cA + (size_t)(t + 2) * kstep; const char* b2 = last ? nB : cB + (size_t)(t + 2) * kstep;
            const char* a3 = a2 + kstep; const char* b3 = b2 + kstep;
            PG8_LDB(B0, 0, 0); PG8_SCHED; PG8_LDA(At, 0, 0); PG8_STAGE(PG8_SA(1, 1), a1 + hstep, voffA);
            PG8_WAIT_L(8); PG8_BAR; PG8_WAIT_L(0); PG8_MMA(0, 0, At, B0); PG8_BAR; PG8_SCHED;
            PG8_LDB(B1, 0, 1); PG8_STAGE(PG8_SB(0, 0), b2, voffB);
            PG8_BAR; PG8_WAIT_L(0); PG8_MMA(0, 1, At, B1); PG8_BAR;
            PG8_LDA(At, 0, 1); PG8_STAGE(PG8_SA(0, 0), a2, voffA);
            PG8_BAR; PG8_WAIT_L(0); PG8_MMA(1, 0, At, B0); PG8_BAR; PG8_SCHED;
            PG8_STAGE(PG8_SB(0, 1), b2 + hstep, voffB);
            PG8_WAIT_V(6); PG8_BAR; PG8_MMA(1, 1, At, B1); PG8_BAR;
            PG8_LDB(B0, 1, 0); PG8_SCHED; PG8_LDA(At, 1, 0); PG8_STAGE(PG8_SA(0, 1), a2 + hstep, voffA);
            PG8_WAIT_L(8); PG8_BAR; PG8_WAIT_L(0); PG8_MMA(0, 0, At, B0); PG8_BAR; PG8_SCHED;
            PG8_LDB(B1, 1, 1); PG8_STAGE(PG8_SB(1, 0), b3, voffB);
            PG8_BAR; PG8_WAIT_L(0); PG8_MMA(0, 1, At, B1); PG8_BAR;
            PG8_LDA(At, 1, 1); PG8_STAGE(PG8_SA(1, 0), a3, voffA);
            PG8_BAR; PG8_WAIT_L(0); PG8_MMA(1, 0, At, B0); PG8_BAR; PG8_SCHED;
            PG8_STAGE(PG8_SB(1, 1), b3 + hstep, voffB);
            PG8_WAIT_V(6); PG8_BAR; PG8_MMA(1, 1, At, B1); PG8_BAR;
        }
        if (E.mode != 8) E(acc, cur, wr, wc, fr, fq);
        if (!has_next) break;
#pragma unroll
        for (int a = 0; a < 2; ++a)
#pragma unroll
            for (int b = 0; b < 2; ++b)
#pragma unroll
                for (int m = 0; m < 4; ++m)
#pragma unroll
                    for (int n = 0; n < 2; ++n) acc[a][b][m][n] = (f32x4){0.f, 0.f, 0.f, 0.f};
        cur = nxt; cA = nA; cB = nB; ++ui;
    }
    PG8_WAIT_V(0);
    if (wr == 0) PG8_BAR;
    PG8_BAR;
    if (E.mode == 8) E.fused(acc, cur, wr, wc, fr, fq);
#undef PG8_SA
#undef PG8_SB
#undef PG8_STAGE
#undef PG8_LDA
#undef PG8_LDB
#undef PG8_MMA
#undef PG8_WAIT_V
#undef PG8_WAIT_L
#undef PG8_BAR
#undef PG8_SCHED
}
}

struct Params {
    const float *x, *mem, *norm_mix_g, *w_in, *lb_logits, *hgrn_norm_g, *w_pool, *pool_scale, *w_out, *norm_x_g, *norm_mem_g, *w_xq, *w_xk, *w_xv, *w_xo, *norm_ffn_g, *w_ff1, *w_ff2, *final_norm_g;
    float* out; unsigned char* ws;
    int ph_lo, ph_hi;
};

__device__ __forceinline__ void prep_transpose_tile(const float* __restrict__ W, int N, const float* __restrict__ g, bf16_t* __restrict__ out, int ldo, int kt, int nt, unsigned char* lds) {
    bf16_t* T = (bf16_t*)lds;
    const int tid = threadIdx.x, r = tid >> 4, c4 = tid & 15;
#pragma unroll
    for (int i = 0; i < 4; ++i) {
        const int kl = r + 32 * i, k = 128 * kt + kl;
        const f32x4 v = *(const f32x4*)(W + (size_t)k * N + 64 * nt + 4 * c4);
        const float s = g ? g[k] : 1.0f;
        T[(4 * c4 + 0) * 136 + kl] = f2bf(v[0] * s); T[(4 * c4 + 1) * 136 + kl] = f2bf(v[1] * s);
        T[(4 * c4 + 2) * 136 + kl] = f2bf(v[2] * s); T[(4 * c4 + 3) * 136 + kl] = f2bf(v[3] * s);
    }
    __syncthreads();
    const int n = tid >> 3, ks = tid & 7;
    const u32x4* src = (const u32x4*)(T + n * 136 + 16 * ks);
    const u32x4 a = src[0], b = src[1];
    u32x4* dst = (u32x4*)(out + (size_t)(64 * nt + n) * ldo + 128 * kt + 16 * ks);
    dst[0] = a; dst[1] = b;
    __syncthreads();
}

__device__ __forceinline__ void phase_prep(const Params p, unsigned char* lds) {
    unsigned char* ws = p.ws;
    const int G = gridDim.x;
    for (int t = blockIdx.x; t < 1920; t += G) {
        if (t < 320)       { prep_transpose_tile(p.w_in, NIN, p.norm_mix_g, (bf16_t*)(ws + WS_WT_IN), 1024, t / 40, t % 40, lds); }
        else if (t < 448)  { const int u = t - 320;  prep_transpose_tile(p.w_xk, 1024, p.norm_mem_g, (bf16_t*)(ws + WS_WT_K), 1024, u / 16, u % 16, lds); }
        else if (t < 576)  { const int u = t - 448;  prep_transpose_tile(p.w_xv, 1024, p.norm_mem_g, (bf16_t*)(ws + WS_WT_V), 1024, u / 16, u % 16, lds); }
        else if (t < 704)  { const int u = t - 576;  prep_transpose_tile(p.w_xq, 1024, p.norm_x_g, (bf16_t*)(ws + WS_WT_Q), 1024, u / 16, u % 16, lds); }
        else if (t < 832)  { const int u = t - 704;  prep_transpose_tile(p.w_xo, 1024, nullptr, (bf16_t*)(ws + WS_WT_O), 1024, u / 16, u % 16, lds); }
        else if (t < 896)  { const int u = t - 832;  prep_transpose_tile(p.w_out, 1024, nullptr, (bf16_t*)(ws + WS_WT_OUT), 1024, u / 16, u % 16, lds); }
        else if (t < 1408) { const int u = t - 896;  prep_transpose_tile(p.w_ff1, DFF, p.norm_ffn_g, (bf16_t*)(ws + WS_WT_FF1), 1024, u / 64, u % 64, lds); }
        else               { const int u = t - 1408; prep_transpose_tile(p.w_ff2, 1024, nullptr, (bf16_t*)(ws + WS_WT_FF2), 4096, u / 16, u % 16, lds); }
    }
    {
        bf16_t* wto = (bf16_t*)(ws + WS_WT_OUT);
        for (int item = blockIdx.x * NTHREADS + threadIdx.x; item < 65536; item += G * NTHREADS) {
            const int n = item & 1023, cgp = item >> 10, gi = cgp >> 4, c0 = (cgp & 15) * 8;
            float a[8];
#pragma unroll
            for (int j = 0; j < 8; ++j) a[j] = 0.f;
            const float* wp = p.w_pool + (size_t)(gi * 128 + c0) * 128;
            for (int d = 0; d < 128; ++d) {
                const float wo = p.w_out[(size_t)(512 + gi * 128 + d) * 1024 + n] * p.pool_scale[gi * 128 + d];
#pragma unroll
                for (int j = 0; j < 8; ++j) a[j] += wp[j * 128 + d] * wo;
            }
            u32x4 w; w.x = cvt_pk_bf16(a[0], a[1]); w.y = cvt_pk_bf16(a[2], a[3]); w.z = cvt_pk_bf16(a[4], a[5]); w.w = cvt_pk_bf16(a[6], a[7]);
            *(u32x4*)(wto + (size_t)n * 1024 + 512 + gi * 128 + c0) = w;
        }
    }
    {
        const int lane = threadIdx.x & 63, gw = blockIdx.x * (NTHREADS / 64) + (threadIdx.x >> 6), nw = G * (NTHREADS / 64);
        for (int r = gw; r < MROWS + MEMROWS; r += nw) {
            const bool isx = r < MROWS;
            const float* src = isx ? p.x + (size_t)r * DM : p.mem + (size_t)(r - MROWS) * DM;
            bf16_t* dst = isx ? (bf16_t*)(ws + WS_XB) + (size_t)r * DM : (bf16_t*)(ws + WS_MEMB) + (size_t)(r - MROWS) * DM;
            f32x4 v[4]; float ss = 0.f;
#pragma unroll
            for (int i = 0; i < 4; ++i) { v[i] = ((const f32x4*)src)[lane + 64 * i]; ss += (v[i][0] * v[i][0] + v[i][1] * v[i][1]) + (v[i][2] * v[i][2] + v[i][3] * v[i][3]); }
#pragma unroll
            for (int o = 1; o < 64; o <<= 1) ss += __shfl_xor(ss, o);
#pragma unroll
            for (int i = 0; i < 4; ++i) { u32x2 w; w.x = cvt_pk_bf16(v[i][0], v[i][1]); w.y = cvt_pk_bf16(v[i][2], v[i][3]); ((u32x2*)dst)[lane + 64 * i] = w; }
            if (lane == 0) { const float rstd = rsqrtf(ss * (1.0f / 1024.0f) + EPS); if (isx) ((float*)(ws + WS_RSTD0))[r] = rstd; else ((float*)(ws + WS_RSTDM))[r - MROWS] = rstd; }
        }
    }
}

__device__ __forceinline__ void phase_passA(const bf16_t* __restrict__ KH, const float* __restrict__ LF, const bf16_t* __restrict__ VH, bf16_t* __restrict__ LT, float* __restrict__ DEC, unsigned char* lds) {
    const int tid = threadIdx.x, ch = tid & 127, seg = tid >> 7, G = gridDim.x;
    float* segtot = (float*)lds;
    unsigned char* KdT = lds + 2048;
    unsigned char* VTl = lds + 2048 + 18432;
    const int w = tid >> 6, lane = tid & 63, fr = lane & 15, q = lane >> 4;
    float lf[16]; unsigned kr[16], vr[16];
    int unit = blockIdx.x;
    if (unit < 1024) { const int b = unit >> 8, c = (unit >> 2) & 63, h = unit & 3; const size_t g0 = (size_t)(b * SEQ + c * 64 + seg * 16) * 512 + h * 128 + ch;
#pragma unroll
        for (int i = 0; i < 16; ++i) { lf[i] = LF[g0 + (size_t)i * 512]; kr[i] = KH[g0 + (size_t)i * 512]; vr[i] = VH[g0 + (size_t)i * 512]; } }
    for (; unit < 1024; unit += G) {
        const int b = unit >> 8, c = (unit >> 2) & 63, h = unit & 3, bh = b * 4 + h;
#pragma unroll
        for (int i = 1; i < 16; ++i) lf[i] += lf[i - 1];
        segtot[seg * 128 + ch] = lf[15];
        __syncthreads();
        float after = 0.f;
#pragma unroll
        for (int s2 = 1; s2 < 4; ++s2) if (s2 > seg) after += segtot[s2 * 128 + ch];
        const float tot = after + lf[15];
        if (seg == 0) DEC[(size_t)(bh * 64 + c) * 128 + ch] = __expf(tot);
        unsigned kd[8], vp[8];
#pragma unroll
        for (int i = 0; i < 8; ++i) {
            kd[i] = cvt_pk_bf16(bflo(kr[2 * i]) * __expf(tot - lf[2 * i]), bflo(kr[2 * i + 1]) * __expf(tot - lf[2 * i + 1]));
            vp[i] = vr[2 * i] | (vr[2 * i + 1] << 16);
        }
        { u32x4* d = (u32x4*)(KdT + ch * 144 + seg * 32); d[0] = (u32x4){kd[0], kd[1], kd[2], kd[3]}; d[1] = (u32x4){kd[4], kd[5], kd[6], kd[7]}; }
        { u32x4* d = (u32x4*)(VTl + ch * 144 + seg * 32); d[0] = (u32x4){vp[0], vp[1], vp[2], vp[3]}; d[1] = (u32x4){vp[4], vp[5], vp[6], vp[7]}; }
        __syncthreads();
        {
            const int un = unit + G;
            if (un < 1024) { const int b2 = un >> 8, c2 = (un >> 2) & 63, h2 = un & 3; const size_t g0 = (size_t)(b2 * SEQ + c2 * 64 + seg * 16) * 512 + h2 * 128 + ch;
#pragma unroll
                for (int i = 0; i < 16; ++i) { lf[i] = LF[g0 + (size_t)i * 512]; kr[i] = KH[g0 + (size_t)i * 512]; vr[i] = VH[g0 + (size_t)i * 512]; } }
        }
        bf16x8 a[2];
#pragma unroll
        for (int ks = 0; ks < 2; ++ks) a[ks] = *(const bf16x8*)(KdT + (16 * w + fr) * 144 + (32 * ks + 8 * q) * 2);
        bf16_t* ltp = LT + (size_t)(bh * 64 + c) * 16384;
#pragma unroll
        for (int vb = 0; vb < 8; ++vb) {
            f32x4 acc = (f32x4){0.f, 0.f, 0.f, 0.f};
#pragma unroll
            for (int ks = 0; ks < 2; ++ks) { const bf16x8 bfr = *(const bf16x8*)(VTl + (16 * vb + fr) * 144 + (32 * ks + 8 * q) * 2); acc = mfma16(a[ks], bfr, acc); }
            u32x2 pk; pk.x = cvt_pk_bf16(acc[0], acc[1]); pk.y = cvt_pk_bf16(acc[2], acc[3]);
            *(u32x2*)(ltp + (size_t)(16 * vb + fr) * 128 + 16 * w + 4 * q) = pk;
        }
        __syncthreads();
    }
}

template <int W>
__device__ __forceinline__ void pool_body(const bf16_t* __restrict__ PH, bf16_t* __restrict__ MIXED, int r0, int s0, int c0) {
    unsigned v[31 + W];
#pragma unroll
    for (int j = 1; j < W; ++j) v[W - 1 - j] = (s0 - j >= 0) ? *(const unsigned*)(PH + (size_t)(r0 - j) * 512 + c0) : 0u;
#pragma unroll
    for (int tt = 0; tt < 32; ++tt) v[W - 1 + tt] = *(const unsigned*)(PH + (size_t)(r0 + tt) * 512 + c0);
    float sx = 0.f, sy = 0.f;
#pragma unroll
    for (int j = 1; j < W; ++j) { sx += bflo(v[W - 1 - j]); sy += bfhi(v[W - 1 - j]); }
#pragma unroll
    for (int tt = 0; tt < 32; ++tt) {
        const int s = s0 + tt;
        const float px = bflo(v[W - 1 + tt]), py = bfhi(v[W - 1 + tt]);
        sx += px; sy += py;
        const int cnt = (s + 1) < W ? (s + 1) : W;
        const float inv = 1.0f / (float)cnt;
        *(unsigned*)(MIXED + (size_t)(r0 + tt) * 1024 + 512 + c0) = cvt_pk_bf16(sx * inv - px, sy * inv - py);
        sx -= bflo(v[tt]); sy -= bfhi(v[tt]);
    }
}
__device__ __forceinline__ void pool_tile(const bf16_t* __restrict__ PH, bf16_t* __restrict__ MIXED, int tile) {
    const int tid = threadIdx.x, cp = tid & 255, th = tid >> 8, c0 = 2 * cp, gi = c0 >> 7;
    const int r0 = tile * 64 + th * 32, s0 = r0 & (SEQ - 1);
    if (gi == 0) pool_body<2>(PH, MIXED, r0, s0, c0);
    else if (gi == 1) pool_body<4>(PH, MIXED, r0, s0, c0);
    else if (gi == 2) pool_body<8>(PH, MIXED, r0, s0, c0);
    else pool_body<16>(PH, MIXED, r0, s0, c0);
}

__device__ __forceinline__ void phase_scan(const bf16_t* __restrict__ LT, const float* __restrict__ DEC, bf16_t* __restrict__ ST) {
    for (int e2 = blockIdx.x * NTHREADS + threadIdx.x; e2 < 131072; e2 += gridDim.x * NTHREADS) {
        const int bh = e2 >> 13, v = (e2 >> 6) & 127, kp = e2 & 63;
        float sx = 0.f, sy = 0.f;
        const size_t base = (size_t)bh * 64 * 16384 + (size_t)v * 128 + 2 * kp;
        const float* dp = DEC + (size_t)bh * 64 * 128 + 2 * kp;
        for (int c0 = 0; c0 < 64; c0 += 16) {
            unsigned l[16]; f32x2 d[16];
#pragma unroll
            for (int j = 0; j < 16; ++j) { l[j] = *(const unsigned*)(LT + base + (size_t)(c0 + j) * 16384); d[j] = *(const f32x2*)(dp + (c0 + j) * 128); }
#pragma unroll
            for (int j = 0; j < 16; ++j) {
                *(unsigned*)(ST + base + (size_t)(c0 + j) * 16384) = cvt_pk_bf16(sx, sy);
                sx = d[j][0] * sx + bflo(l[j]); sy = d[j][1] * sy + bfhi(l[j]);
            }
        }
    }
}

__device__ __forceinline__ void hgrn_passC_unit(const bf16_t* __restrict__ QH, const bf16_t* __restrict__ KH, const float* __restrict__ LF, const bf16_t* __restrict__ VH, const bf16_t* __restrict__ GH,
                                const bf16_t* __restrict__ ST, const float* __restrict__ hg, bf16_t* __restrict__ MIXED, int unit, unsigned char* lds) {
    const int tid = threadIdx.x, ch = tid & 127, seg = tid >> 7;
    const int b = unit >> 8, c = (unit >> 2) & 63, h = unit & 3;
    const int row0 = b * SEQ + c * 64, bh = b * 4 + h;
    float* segtot = (float*)lds;
    float* rmsp = (float*)(lds + 2048);
    bf16_t* QC = (bf16_t*)(lds + 4096);
    bf16_t* QT = (bf16_t*)(lds + 21504);
    constexpr int KT0 = 38912;
    unsigned char* VTl = lds + 82432;
    const size_t g0 = (size_t)(row0 + seg * 16) * 512 + h * 128 + ch;
    float lf[16]; unsigned qr[16], kr[16], vr[16];
#pragma unroll
    for (int i = 0; i < 16; ++i) { lf[i] = LF[g0 + (size_t)i * 512]; vr[i] = VH[g0 + (size_t)i * 512]; qr[i] = QH[g0 + (size_t)i * 512]; kr[i] = KH[g0 + (size_t)i * 512]; }
    const int w = tid >> 6, lane = tid & 63, fr = lane & 15, q = lane >> 4;
    const int i = w & 3, vh = w >> 2;
    const size_t row = (size_t)(row0 + 16 * i + fr);
    u32x2 gt[4]; f32x4 gg[4]; bf16x8 stf[4][4];
    {
        const bf16_t* stp = ST + (size_t)(bh * 64 + c) * 16384;
#pragma unroll
        for (int vbl = 0; vbl < 4; ++vbl) { const int v0 = 16 * (vh * 4 + vbl) + 4 * q; gt[vbl] = *(const u32x2*)(GH + row * 512 + h * 128 + v0); gg[vbl] = *(const f32x4*)(hg + h * 128 + v0);
#pragma unroll
            for (int ks = 0; ks < 4; ++ks) stf[ks][vbl] = *(const bf16x8*)(stp + (size_t)(16 * (vh * 4 + vbl) + fr) * 128 + 32 * ks + 8 * q); }
    }
#pragma unroll
    for (int i2 = 1; i2 < 16; ++i2) lf[i2] += lf[i2 - 1];
    segtot[seg * 128 + ch] = lf[15];
    {
        unsigned vp[8];
#pragma unroll
        for (int i2 = 0; i2 < 8; ++i2) vp[i2] = vr[2 * i2] | (vr[2 * i2 + 1] << 16);
        u32x4* d = (u32x4*)(VTl + ch * 144 + seg * 32); d[0] = (u32x4){vp[0], vp[1], vp[2], vp[3]}; d[1] = (u32x4){vp[4], vp[5], vp[6], vp[7]};
    }
    __syncthreads();
    const float t0 = segtot[ch], t1 = segtot[128 + ch], t2 = segtot[256 + ch];
    const float P = (seg > 0 ? t0 : 0.f) + (seg > 1 ? t1 : 0.f) + (seg > 2 ? t2 : 0.f);
    {
        const float eP = __expf(P);
#pragma unroll
        for (int i2 = 0; i2 < 16; ++i2) {
            const float qv = bflo(qr[i2]);
            const float el = __expf(lf[i2]);
            QT[(seg * 16 + i2) * 136 + ch] = f2bf(qv * el);
            QC[(seg * 16 + i2) * 136 + ch] = f2bf(qv * el * eP);
        }
        float E = 0.f;
#pragma unroll
        for (int i2 = 0; i2 < 4; ++i2) {
            if (i2 >= seg) {
                bf16_t* KT = (bf16_t*)(lds + KT0 + 4352 * ((i2 * (i2 + 1)) / 2));
#pragma unroll
                for (int j = 0; j < 16; ++j) KT[(seg * 16 + j) * 136 + ch] = f2bf(bflo(kr[j]) * __expf(E - lf[j]));
                E += (i2 == 0 ? t0 : (i2 == 1 ? t1 : t2));
            }
        }
    }
    __syncthreads();
    f32x4 sT[4];
#pragma unroll
    for (int j = 0; j < 4; ++j) sT[j] = (f32x4){0.f, 0.f, 0.f, 0.f};
    {
        bf16x8 qfr[4];
#pragma unroll
        for (int ks = 0; ks < 4; ++ks) qfr[ks] = *(const bf16x8*)((const unsigned char*)QT + (16 * i + fr) * 272 + (32 * ks + 8 * q) * 2);
        const unsigned char* KT = lds + KT0 + 4352 * ((i * (i + 1)) / 2);
#pragma unroll
        for (int j = 0; j < 4; ++j) if (j <= i) {
#pragma unroll
            for (int ks = 0; ks < 4; ++ks) { const bf16x8 a = *(const bf16x8*)(KT + (16 * j + fr) * 272 + (32 * ks + 8 * q) * 2); sT[j] = mfma16(a, qfr[ks], sT[j]); }
            if (j == i) {
#pragma unroll
                for (int rg = 0; rg < 4; ++rg) if (4 * q + rg > fr) sT[j][rg] = 0.f;
            }
        }
    }
    f32x4 oacc[4];
#pragma unroll
    for (int vbl = 0; vbl < 4; ++vbl) oacc[vbl] = (f32x4){0.f, 0.f, 0.f, 0.f};
#pragma unroll
    for (int m = 0; m < 2; ++m) if (2 * m <= i) {
        const bf16x8 bfrag = mk8u(cvt_pk_bf16(sT[2 * m][0], sT[2 * m][1]), cvt_pk_bf16(sT[2 * m][2], sT[2 * m][3]), cvt_pk_bf16(sT[2 * m + 1][0], sT[2 * m + 1][1]), cvt_pk_bf16(sT[2 * m + 1][2], sT[2 * m + 1][3]));
#pragma unroll
        for (int vbl = 0; vbl < 4; ++vbl) {
            const unsigned char* base = VTl + (16 * (vh * 4 + vbl) + fr) * 144 + (32 * m + 4 * q) * 2;
            const bf16x8 a = mk8(*(const u32x2*)base, *(const u32x2*)(base + 32));
            oacc[vbl] = mfma16(a, bfrag, oacc[vbl]);
        }
    }
    {
#pragma unroll
        for (int ks = 0; ks < 4; ++ks) {
            const bf16x8 bfr = *(const bf16x8*)((const unsigned char*)QC + (16 * i + fr) * 272 + (32 * ks + 8 * q) * 2);
#pragma unroll
            for (int vbl = 0; vbl < 4; ++vbl) oacc[vbl] = mfma16(stf[ks][vbl], bfr, oacc[vbl]);
        }
    }
    float ss = 0.f;
#pragma unroll
    for (int vbl = 0; vbl < 4; ++vbl) ss += (oacc[vbl][0] * oacc[vbl][0] + oacc[vbl][1] * oacc[vbl][1]) + (oacc[vbl][2] * oacc[vbl][2] + oacc[vbl][3] * oacc[vbl][3]);
    ss += __shfl_xor(ss, 16); ss += __shfl_xor(ss, 32);
    if (q == 0) rmsp[vh * 64 + 16 * i + fr] = ss;
    __syncthreads();
    const float rstd = rsqrtf((rmsp[16 * i + fr] + rmsp[64 + 16 * i + fr]) * (1.0f / 128.0f) + EPS);
#pragma unroll
    for (int vbl = 0; vbl < 4; ++vbl) {
        const int v0 = 16 * (vh * 4 + vbl) + 4 * q;
        u32x2 o;
        o.x = cvt_pk_bf16(oacc[vbl][0] * rstd * gg[vbl][0] * bflo(gt[vbl].x), oacc[vbl][1] * rstd * gg[vbl][1] * bfhi(gt[vbl].x));
        o.y = cvt_pk_bf16(oacc[vbl][2] * rstd * gg[vbl][2] * bflo(gt[vbl].y), oacc[vbl][3] * rstd * gg[vbl][3] * bfhi(gt[vbl].y));
        *(u32x2*)(MIXED + row * 1024 + h * 128 + v0) = o;
    }
    __syncthreads();
}

__device__ __forceinline__ void attn_unit(const bf16_t* __restrict__ XQ, const bf16_t* __restrict__ KX, const bf16_t* __restrict__ VT, bf16_t* __restrict__ ATT, int unit, unsigned char* lds) {
    const int tid = threadIdx.x, w = tid >> 6, lane = tid & 63, r = lane & 31, hh = lane >> 5;
    const int b = unit >> 6, st = (unit >> 2) & 15, h = unit & 3;
    const int row0 = b * SEQ + st * 256;
    const bf16_t* qp = XQ + (size_t)(row0 + 32 * w + r) * 1024 + h * 256 + 8 * hh;
    {
        const bf16_t* kp = KX + (size_t)(b * 256) * 1024 + h * 256;
#pragma unroll
        for (int it = 0; it < 16; ++it) { const int idx = tid + 512 * it, m = idx >> 5, cc = idx & 31;
            const u32x4 v = *(const u32x4*)(kp + (size_t)m * 1024 + cc * 8); *(u32x4*)(lds + m * 528 + cc * 16) = v; }
    }
    __syncthreads();
    f32x16 sacc[8];
#pragma unroll
    for (int mb = 0; mb < 8; ++mb)
#pragma unroll
        for (int e = 0; e < 16; ++e) sacc[mb][e] = 0.f;
    for (int kg = 0; kg < 4; ++kg) {
        bf16x8 qf[4];
#pragma unroll
        for (int k4 = 0; k4 < 4; ++k4) qf[k4] = *(const bf16x8*)(qp + 16 * (4 * kg + k4));
#pragma unroll
        for (int k4 = 0; k4 < 4; ++k4)
#pragma unroll
            for (int mb = 0; mb < 8; ++mb) { const bf16x8 a = *(const bf16x8*)(lds + (32 * mb + r) * 528 + (16 * (4 * kg + k4) + 8 * hh) * 2); sacc[mb] = mfma32(a, qf[k4], sacc[mb]); }
    }
    float mx = -3.0e38f;
#pragma unroll
    for (int mb = 0; mb < 8; ++mb)
#pragma unroll
        for (int e = 0; e < 16; ++e) mx = fmaxf(mx, sacc[mb][e]);
    mx = fmaxf(mx, __shfl_xor(mx, 32));
    float sum = 0.f;
    bf16x8 pf[8][2];
#pragma unroll
    for (int mb = 0; mb < 8; ++mb) {
        float pv[16];
#pragma unroll
        for (int e = 0; e < 16; ++e) { pv[e] = __expf(sacc[mb][e] - mx); sum += pv[e]; }
#pragma unroll
        for (int s = 0; s < 2; ++s) pf[mb][s] = mk8u(cvt_pk_bf16(pv[8 * s + 0], pv[8 * s + 1]), cvt_pk_bf16(pv[8 * s + 2], pv[8 * s + 3]), cvt_pk_bf16(pv[8 * s + 4], pv[8 * s + 5]), cvt_pk_bf16(pv[8 * s + 6], pv[8 * s + 7]));
    }
    sum += __shfl_xor(sum, 32);
    const float inv = 1.0f / sum;
    __syncthreads();
    {
        const bf16_t* vp = VT + (size_t)(h * 256) * 1024 + b * 256;
#pragma unroll
        for (int it = 0; it < 16; ++it) { const int idx = tid + 512 * it, e = idx >> 5, cc = idx & 31;
            const u32x4 v = *(const u32x4*)(vp + (size_t)e * 1024 + cc * 8);
            u32x2* d = (u32x2*)(lds + e * 520 + cc * 16); d[0] = (u32x2){v.x, v.y}; d[1] = (u32x2){v.z, v.w}; }
    }
    __syncthreads();
    bf16_t* op = ATT + (size_t)(row0 + 32 * w + r) * 1024 + h * 256 + 4 * hh;
#pragma unroll
    for (int half = 0; half < 2; ++half) {
        f32x16 oacc[4];
#pragma unroll
        for (int d = 0; d < 4; ++d)
#pragma unroll
            for (int e = 0; e < 16; ++e) oacc[d][e] = 0.f;
#pragma unroll
        for (int mb = 0; mb < 8; ++mb)
#pragma unroll
            for (int s = 0; s < 2; ++s)
#pragma unroll
                for (int d = 0; d < 4; ++d) {
                    const unsigned char* base = lds + (32 * (half * 4 + d) + r) * 520 + (32 * mb + 16 * s + 4 * hh) * 2;
                    const bf16x8 a = mk8(*(const u32x2*)base, *(const u32x2*)(base + 16));
                    oacc[d] = mfma32(a, pf[mb][s], oacc[d]);
                }
#pragma unroll
        for (int d = 0; d < 4; ++d)
#pragma unroll
            for (int g = 0; g < 4; ++g) {
                u32x2 o; o.x = cvt_pk_bf16(oacc[d][4 * g] * inv, oacc[d][4 * g + 1] * inv); o.y = cvt_pk_bf16(oacc[d][4 * g + 2] * inv, oacc[d][4 * g + 3] * inv);
                *(u32x2*)(op + 32 * (half * 4 + d) + 8 * g) = o;
            }
    }
    __syncthreads();
}

__device__ __forceinline__ void phase_final(float* __restrict__ out, const float* __restrict__ g) {
    const int lane = threadIdx.x & 63, gw = blockIdx.x * (NTHREADS / 64) + (threadIdx.x >> 6), nw = gridDim.x * (NTHREADS / 64);
    f32x4 gv[4];
#pragma unroll
    for (int i = 0; i < 4; ++i) gv[i] = ((const f32x4*)g)[lane + 64 * i];
    for (int r = gw; r < MROWS; r += nw) {
        f32x4* row = (f32x4*)(out + (size_t)r * DM);
        f32x4 v[4]; float ss = 0.f;
#pragma unroll
        for (int i = 0; i < 4; ++i) { v[i] = row[lane + 64 * i]; ss += (v[i][0] * v[i][0] + v[i][1] * v[i][1]) + (v[i][2] * v[i][2] + v[i][3] * v[i][3]); }
#pragma unroll
        for (int o = 1; o < 64; o <<= 1) ss += __shfl_xor(ss, o);
        const float rstd = rsqrtf(ss * (1.0f / 1024.0f) + EPS);
#pragma unroll
        for (int i = 0; i < 4; ++i) row[lane + 64 * i] = v[i] * rstd * gv[i];
    }
}

#define XB_TMO      128
#define XB_XCNT(j)  (256  + 64 * (j))
#define XB_XSUB(j)  (1280 + 64 * (j))
#define XB_XGEN(j)  (2304 + 64 * (j))
#define XB_TOP      3328
#define XB_TOPGEN   3392
#define XCD_BAR_WORDS 3456
#define XB_SPIN_CAP (1u << 22)
__device__ __forceinline__ unsigned xb_ld(unsigned* p)              { return __hip_atomic_load(p, __ATOMIC_RELAXED, __HIP_MEMORY_SCOPE_AGENT); }
__device__ __forceinline__ unsigned xb_add(unsigned* p, unsigned v) { return __hip_atomic_fetch_add(p, v, __ATOMIC_RELAXED, __HIP_MEMORY_SCOPE_AGENT); }
__device__ __forceinline__ unsigned xb_xcc_id() { return (unsigned)__builtin_amdgcn_s_getreg((3 << 11) | 20) & 0xFu; }
#define XB_SPIN(cond, bar) do { unsigned _sp = 0; while (cond) { __builtin_amdgcn_s_sleep(1); \
    if ((++_sp & 255u) == 0u) { if (xb_ld(&(bar)[XB_TMO])) break; if (_sp > XB_SPIN_CAP) { atomicAdd(&(bar)[XB_TMO], 1u); break; } } } } while (0)
struct XcdBarrier { unsigned* bar; unsigned x; volatile LAS unsigned* st; };
__device__ __forceinline__ XcdBarrier xcd_barrier_post(unsigned* bar, volatile LAS unsigned* st) {
    XcdBarrier b; b.bar = bar; b.x = xb_xcc_id(); b.st = st;
    if (threadIdx.x == 0) (void)xb_add(&bar[XB_XCNT(b.x)], 1u);
    return b;
}
__device__ __forceinline__ void xcd_barrier_complete(unsigned* bar, unsigned x, unsigned& nloc, unsigned& nx) {
    const unsigned G = gridDim.x * gridDim.y * gridDim.z;
    unsigned sum, cnt, mine, sp = 0u;
    for (;;) {
        sum = 0u; cnt = 0u; mine = 0u;
#pragma unroll
        for (unsigned j = 0; j < 16; ++j) { const unsigned c = xb_ld(&bar[XB_XCNT(j)]); sum += c; cnt += (c > 0u) ? 1u : 0u; mine = (j == x) ? c : mine; }
        if (sum == G) break;
        __builtin_amdgcn_s_sleep(1);
        if ((++sp & 255u) == 0u) { if (xb_ld(&bar[XB_TMO])) break; if (sp > XB_SPIN_CAP) { atomicAdd(&bar[XB_TMO], 1u); break; } }
    }
    nloc = mine > 0u ? mine : 1u; nx = cnt > 0u ? cnt : 1u;
}
__device__ __forceinline__ void xcd_barrier(const XcdBarrier& b) {
    asm volatile("s_waitcnt vmcnt(0)" ::: "memory");
    __syncthreads();
    if (threadIdx.x == 0) {
        unsigned* bar = b.bar;
        __builtin_amdgcn_s_waitcnt(0);
        unsigned nloc = b.st[0], nx = b.st[1];
        if (nloc == 0u) { xcd_barrier_complete(bar, b.x, nloc, nx); b.st[0] = nloc; b.st[1] = nx; }
        const unsigned old = xb_add(&bar[XB_XSUB(b.x)], 1u);
        const unsigned gen = old / nloc;
        if (old + 1u == (gen + 1u) * nloc) {
            __builtin_amdgcn_fence(__ATOMIC_RELEASE, "agent");
            asm volatile("s_waitcnt vmcnt(0)" ::: "memory");
            const unsigned og = xb_add(&bar[XB_TOP], 1u);
            const unsigned tg = og / nx;
            if (og + 1u == (tg + 1u) * nx) xb_add(&bar[XB_TOPGEN], 1u);
            else XB_SPIN(xb_ld(&bar[XB_TOPGEN]) == tg, bar);
            __builtin_amdgcn_fence(__ATOMIC_ACQUIRE, "agent");
            xb_add(&bar[XB_XGEN(b.x)], 1u);
            asm volatile("s_waitcnt vmcnt(0)" ::: "memory");
        } else {
            XB_SPIN(xb_ld(&bar[XB_XGEN(b.x)]) == gen, bar);
            __builtin_amdgcn_fence(__ATOMIC_ACQUIRE, "agent");
            asm volatile("s_waitcnt vmcnt(0)" ::: "memory");
        }
    }
    __syncthreads();
}

constexpr int N_PHASES = 12;
__global__ void __launch_bounds__(NTHREADS, 2) mega(Params p) {
    extern __shared__ __attribute__((aligned(16))) unsigned char lds[];
    LAS unsigned char* ldsl = (LAS unsigned char*)lds;
    unsigned char* ws = p.ws;
    const int G = gridDim.x, bid = blockIdx.x;
    const int lo = p.ph_lo, hi = p.ph_hi;

#ifndef DBG_LAST
#define DBG_LAST -1
#endif
#ifndef PHASE_MASK
#define PHASE_MASK 0xfff
#endif
#define IN(k) (((PHASE_MASK >> (k)) & 1) && lo <= (k) && (k) < hi)
    if (threadIdx.x == 0) { ((volatile LAS unsigned*)(ldsl + LDS_MAIN))[0] = 0u; ((volatile LAS unsigned*)(ldsl + LDS_MAIN))[1] = 0u; }
    __syncthreads();
    XcdBarrier xbar; xbar.bar = (unsigned*)(ws + WS_BAR); xbar.x = 0; xbar.st = nullptr;
    if (hi - lo > 1) xbar = xcd_barrier_post((unsigned*)(ws + WS_BAR), (volatile LAS unsigned*)(ldsl + LDS_MAIN));
    if (lo > hi) cg::this_grid().sync();
#define SEAM(k) do { if (IN(k) && IN((k) + 1)) { xcd_barrier(xbar); } } while (0)
    bf16_t* XB = (bf16_t*)(ws + WS_XB); bf16_t* LT = (bf16_t*)(ws + WS_XB);
    bf16_t* QH = (bf16_t*)(ws + WS_QH); bf16_t* KH = (bf16_t*)(ws + WS_KH); bf16_t* VH = (bf16_t*)(ws + WS_VH); bf16_t* GH = (bf16_t*)(ws + WS_GH); bf16_t* PH = (bf16_t*)(ws + WS_PH);
    float* LF = (float*)(ws + WS_LF); bf16_t* ST = (bf16_t*)(ws + WS_ST); bf16_t* MIXED = (bf16_t*)(ws + WS_MIXED);
    float* X1 = (float*)(ws + WS_X1); bf16_t* XQ = (bf16_t*)(ws + WS_XQ); bf16_t* ATT = (bf16_t*)(ws + WS_ATT); bf16_t* U = (bf16_t*)(ws + WS_U);
    float* SSQ = (float*)(ws + WS_SSQ); float* DEC = (float*)(ws + WS_DEC);
    bf16_t* MEMB = (bf16_t*)(ws + WS_MEMB); bf16_t* KX = (bf16_t*)(ws + WS_KX); bf16_t* VT = (bf16_t*)(ws + WS_VT);

    const bool fuse_final = (G == 256) && IN(10) && (hi - lo > 1);
    if (IN(0)) { phase_prep(p, lds); }
    SEAM(0);
    if (IN(1)) {
        const pg8::Epi E{0, ws, p.x, p.out, p.lb_logits, p.final_norm_g};
        { pg8::Gemm g{XB, (const bf16_t*)(ws + WS_WT_IN), MROWS, NIN, DM}; pg8::StaticOrder S; S.init(MROWS, NIN, G, bid); pg8::gemm_phase(ldsl, g, S, E); }
        const pg8::Epi E1{1, ws, p.x, p.out, p.lb_logits, p.final_norm_g};
        { pg8::Gemm g{MEMB, (const bf16_t*)(ws + WS_WT_K), MEMROWS, 1024, DM}; pg8::StaticOrder S; S.init(MEMROWS, 1024, G, (bid + 128) % G); pg8::gemm_phase(ldsl, g, S, E1); }
        const pg8::Epi E2{2, ws, p.x, p.out, p.lb_logits, p.final_norm_g};
        { pg8::Gemm g{(const bf16_t*)(ws + WS_WT_V), MEMB, 1024, MEMROWS, DM}; pg8::StaticOrder S; S.init(1024, MEMROWS, G, (bid + 112) % G); pg8::gemm_phase(ldsl, g, S, E2); }
    }
    SEAM(1);
    if (IN(2)) {
#ifndef DBG_NO_PASSA
        phase_passA(KH, LF, VH, LT, DEC, lds);
#endif
#ifndef DBG_NO_POOL
        for (int t = bid; t < 256; t += G) pool_tile(PH, MIXED, t);
#endif
    }
    SEAM(2);
    if (IN(3)) { phase_scan(LT, DEC, ST); }
    SEAM(3);
    if (IN(4)) { for (int u = bid; u < 1024; u += G) hgrn_passC_unit(QH, KH, LF, VH, GH, ST, p.hgrn_norm_g, MIXED, u, lds); }
    SEAM(4);
    if (IN(5)) {
        const pg8::Epi E{3, ws, p.x, p.out, p.lb_logits, p.final_norm_g};
        pg8::Gemm g{MIXED, (const bf16_t*)(ws + WS_WT_OUT), MROWS, DM, DM}; pg8::StaticOrder S; S.init(MROWS, DM, G, bid); pg8::gemm_phase(ldsl, g, S, E);
    }
    SEAM(5);
    if (IN(6)) {
        const pg8::Epi E{4, ws, p.x, p.out, p.lb_logits, p.final_norm_g};
        pg8::Gemm g{XB, (const bf16_t*)(ws + WS_WT_Q), MROWS, DM, DM}; pg8::StaticOrder S; S.init(MROWS, DM, G, bid); pg8::gemm_phase(ldsl, g, S, E);
    }
    SEAM(6);
    if (IN(7)) { for (int u = bid; u < 256; u += G) attn_unit(XQ, KX, VT, ATT, u, lds); }
    SEAM(7);
    if (IN(8)) {
        const pg8::Epi E{6, ws, p.x, p.out, p.lb_logits, p.final_norm_g};
        pg8::Gemm g{ATT, (const bf16_t*)(ws + WS_WT_O), MROWS, DM, DM}; pg8::StaticOrder S; S.init(MROWS, DM, G, bid); pg8::gemm_phase(ldsl, g, S, E);
    }
    SEAM(8);
    if (IN(9)) {
        const pg8::Epi E{5, ws, p.x, p.out, p.lb_logits, p.final_norm_g};
        pg8::Gemm g{XB, (const bf16_t*)(ws + WS_WT_FF1), MROWS, DFF, DM}; pg8::StaticOrder S; S.init(MROWS, DFF, G, bid); pg8::gemm_phase(ldsl, g, S, E);
    }
    SEAM(9);
    if (IN(10)) {
        const pg8::Epi E{fuse_final ? 8 : 7, ws, p.x, p.out, p.lb_logits, p.final_norm_g};
        pg8::Gemm g{U, (const bf16_t*)(ws + WS_WT_FF2), MROWS, DM, DFF}; pg8::StaticOrder S; S.init(MROWS, DM, G, bid); pg8::gemm_phase(ldsl, g, S, E);
    }
    if (!fuse_final) {
        SEAM(10);
        if (IN(11)) { phase_final(p.out, p.final_norm_g); }
    }
#if DBG_LAST >= 0
    cg::this_grid().sync();
    {
        const unsigned* w32 = (const unsigned*)ws;
        for (size_t i = (size_t)bid * NTHREADS + threadIdx.x; i < (size_t)MROWS * DM; i += (size_t)G * NTHREADS) {
            float a = 0.f;
            for (int j = 0; j < 4; ++j) { const unsigned v = w32[i + (size_t)j * MROWS * DM]; a += (float)(v & 0xffffu) + (float)(v >> 16); }
            p.out[i] = a;
        }
    }
#endif
#undef IN
#undef SEAM
}

extern "C" void kernel_launch(void* const* d_in, const int* in_sizes, int n_in, void* d_out, int out_size, void* d_ws, size_t ws_size, hipStream_t stream) {
    static int grid = 0;
    if (grid == 0) {
        if (n_in != 19 || in_sizes[0] != MROWS * DM || out_size != MROWS * DM || ws_size < WS_END) { fprintf(stderr, "kernel_launch: unexpected shapes (n_in %d, ws %zu)\n", n_in, ws_size); grid = -1; return; }
        int dev = 0, cus = 0, per_cu = 0;
        hipGetDevice(&dev); hipDeviceGetAttribute(&cus, hipDeviceAttributeMultiprocessorCount, dev);
        if (hipFuncSetAttribute((const void*)mega, hipFuncAttributeMaxDynamicSharedMemorySize, LDS_BYTES) != hipSuccess) { fprintf(stderr, "kernel_launch: hipFuncSetAttribute failed\n"); grid = -1; return; }
        if (hipOccupancyMaxActiveBlocksPerMultiprocessor(&per_cu, (const void*)mega, NTHREADS, LDS_BYTES) != hipSuccess || per_cu < 1) { fprintf(stderr, "kernel_launch: occupancy query says %d\n", per_cu); per_cu = 1; }
        (void)hipGetLastError();
        grid = cus * 1;
        if (grid > cus * per_cu) grid = cus * per_cu;
    }
    if (grid < 0) return;
    if (hipMemsetAsync((char*)d_ws + WS_BAR, 0, 32768, stream) != hipSuccess) { fprintf(stderr, "kernel_launch: memset of barrier words failed\n"); return; }
    Params p{};
    const float** f = (const float**)&p;
    for (int i = 0; i < 19; ++i) f[i] = (const float*)d_in[i];
    p.out = (float*)d_out; p.ws = (unsigned char*)d_ws;
#if N_LAUNCH_MODE == 1
    p.ph_lo = 0; p.ph_hi = (DBG_LAST >= 0) ? DBG_LAST + 1 : N_PHASES;
    void* args[] = {&p};
    hipError_t e = hipLaunchCooperativeKernel((const void*)mega, dim3(grid), dim3(NTHREADS), args, LDS_BYTES, stream);
    if (e != hipSuccess) fprintf(stderr, "kernel_launch: cooperative launch failed: %s (grid %d)\n", hipGetErrorString(e), grid);
#else
    for (int k = 0; k < N_PHASES; ++k) { p.ph_lo = k; p.ph_hi = k + 1; hipLaunchKernelGGL(mega, dim3(grid), dim3(NTHREADS), LDS_BYTES, stream, p); }
#endif
}
```

```cpp
#include <hip/hip_runtime.h>
#include <hip/hip_cooperative_groups.h>
#include <cstdio>
namespace cg = cooperative_groups;

#ifndef N_LAUNCH_MODE
#define N_LAUNCH_MODE 1
#endif

typedef unsigned short bf16_t;
typedef short bf16x8 __attribute__((ext_vector_type(8)));
typedef float f32x2 __attribute__((ext_vector_type(2)));
typedef float f32x4 __attribute__((ext_vector_type(4)));
typedef float f32x16 __attribute__((ext_vector_type(16)));
typedef unsigned u32x2 __attribute__((ext_vector_type(2)));
typedef unsigned u32x4 __attribute__((ext_vector_type(4)));
#define LAS __attribute__((address_space(3)))

constexpr int MROWS = 16384, DM = 1024, SEQ = 4096, NIN = 2560, DFF = 4096, MEMROWS = 1024;
constexpr float EPS = 1e-6f;
constexpr int NTHREADS = 512;
constexpr int LDS_MAIN = 135168;
constexpr int LDS_BYTES = LDS_MAIN + 16;

constexpr size_t MiB = 1u << 20;
constexpr size_t WS_WT_IN = 0, WS_WT_K = 5 * MiB, WS_WT_V = 7 * MiB, WS_WT_OUT = 9 * MiB, WS_WT_Q = 11 * MiB, WS_WT_O = 13 * MiB,
                 WS_WT_FF1 = 15 * MiB, WS_WT_FF2 = 23 * MiB, WS_MEMB = 31 * MiB, WS_KX = 33 * MiB, WS_VT = 35 * MiB, WS_SSQ = 37 * MiB,
                 WS_BAR = 39 * MiB, WS_CNT = 39 * MiB + 16384, WS_RSTD0 = 38 * MiB, WS_RSTDM = 38 * MiB + 65536, WS_DEC = 38 * MiB + 131072,
                 WS_XB = 40 * MiB  , WS_QH = 72 * MiB, WS_KH = 88 * MiB, WS_VH = 104 * MiB, WS_GH = 120 * MiB, WS_PH = 136 * MiB,
                 WS_LF = 152 * MiB, WS_ST = 184 * MiB, WS_MIXED = 216 * MiB,
                 WS_X1 = 72 * MiB, WS_XQ = 136 * MiB, WS_ATT = 168 * MiB, WS_U = 72 * MiB, WS_END = 256 * MiB;

typedef __bf16 bf16x2n __attribute__((ext_vector_type(2)));
__device__ __forceinline__ unsigned cvt_pk_bf16(float lo, float hi) { f32x2 v = {lo, hi}; return __builtin_bit_cast(unsigned, __builtin_convertvector(v, bf16x2n)); }
__device__ __forceinline__ bf16_t f2bf(float f) { return (bf16_t)(cvt_pk_bf16(f, 0.f) & 0xffffu); }
__device__ __forceinline__ float bf2f(bf16_t b) { return __uint_as_float(((unsigned)b) << 16); }
__device__ __forceinline__ float bflo(unsigned u) { return __uint_as_float(u << 16); }
__device__ __forceinline__ float bfhi(unsigned u) { return __uint_as_float(u & 0xffff0000u); }
__device__ __forceinline__ f32x4 mfma16(bf16x8 a, bf16x8 b, f32x4 c) { return __builtin_amdgcn_mfma_f32_16x16x32_bf16(a, b, c, 0, 0, 0); }
__device__ __forceinline__ f32x16 mfma32(bf16x8 a, bf16x8 b, f32x16 c) { return __builtin_amdgcn_mfma_f32_32x32x16_bf16(a, b, c, 0, 0, 0); }
__device__ __forceinline__ bf16x8 mk8(u32x2 lo, u32x2 hi) { u32x4 t; t.x = lo.x; t.y = lo.y; t.z = hi.x; t.w = hi.y; return __builtin_bit_cast(bf16x8, t); }
__device__ __forceinline__ bf16x8 mk8u(unsigned a, unsigned b, unsigned c, unsigned d) { u32x4 t; t.x = a; t.y = b; t.z = c; t.w = d; return __builtin_bit_cast(bf16x8, t); }
__device__ __forceinline__ float sigmoidf_(float z) { return 1.0f / (1.0f + __expf(-z)); }

namespace pg8 {
constexpr int BM = 256, BK = 64, HALF = 128, HTB = HALF * BK * 2, STAGE_BYTES = 8 * HTB, NXCD = 8, WGM = 8;
__device__ __forceinline__ int lds_byte(int r, int c) { const int st = (r >> 4) * 2 + (c >> 5), rr = r & 15, cc = c & 31, ob = rr * 64 + cc * 2; return st * 1024 + (ob ^ (((ob >> 9) & 1) << 5)); }
__device__ __forceinline__ void stage_rc(int b, int& R, int& C) { const int st = b / 1024, sb = b % 1024, swz = sb ^ (((sb >> 9) & 1) << 5); R = (st >> 1) * 16 + swz / 64; C = (st & 1) * 32 + (swz % 64) / 2; }
__device__ __forceinline__ int perm32(int rho) { const int n = rho >> 4, i = rho & 15; return 8 * (i >> 2) + 4 * n + (i & 3); }
struct Unit { int pm, pn; };
struct Gemm { const bf16_t* A; const bf16_t* Bt; int M, N, K; };
struct StaticOrder {
    int nM, nN, nwg, G, c;
    __device__ __forceinline__ void init(int M, int N, int G_, int c_) { nM = M / BM; nN = N / BM; nwg = nM * nN; G = G_; c = c_; }
    __device__ __forceinline__ bool next(int i, Unit& u) const {
        const long L = (long)i * G + c; if (L >= nwg) return false;
        int wgid = (int)L; { const int q = nwg / NXCD, r = nwg % NXCD, xcd = wgid % NXCD, off = wgid / NXCD; wgid = (xcd < r ? xcd * (q + 1) : r * (q + 1) + (xcd - r) * q) + off; }
        const int nig = WGM * nN, gid = wgid / nig, fm = gid * WGM, gsz = (nM - fm) < WGM ? (nM - fm) : WGM;
        u.pm = fm + ((wgid % nig) % gsz); u.pn = (wgid % nig) / gsz; return true;
    }
};

struct Epi {
    static constexpr bool PERM = true;
    int mode;
    unsigned char* ws; const float* x; float* out; const float* lbl; const float* gfin;
    __device__ __forceinline__ void store8(bf16_t* p, const f32x4& v0, const f32x4& v1) const {
        u32x4 w; w.x = cvt_pk_bf16(v0[0], v0[1]); w.y = cvt_pk_bf16(v0[2], v0[3]); w.z = cvt_pk_bf16(v1[0], v1[1]); w.w = cvt_pk_bf16(v1[2], v1[3]); *(u32x4*)p = w; }
    __device__ __forceinline__ void fused(f32x4 (&acc)[2][2][4][2], const Unit& u, int wr, int wc, int fr, int fq) const {
        const int row0 = u.pm * BM + wr * 64 + fr;
        const int col0 = u.pn * BM + wc * 32 + 8 * fq;
        const bf16_t* xb = (const bf16_t*)(ws + WS_XB);
        unsigned* sq = (unsigned*)(ws + WS_SSQ);
        unsigned* cnt = (unsigned*)(ws + WS_CNT) + 64 * u.pm;
        u32x4 bc[2], bn[2];
        { const size_t o = (size_t)row0 * DM + col0; bc[0] = *(const u32x4*)(xb + o); bc[1] = *(const u32x4*)(xb + o + HALF); }
#pragma unroll
        for (int gidx = 0; gidx < 8; ++gidx) { const int ai = gidx >> 2, m = gidx & 3; const int row = row0 + ai * HALF + m * 16;
            if (gidx < 7) { const int g2 = gidx + 1; const size_t o2 = (size_t)(row0 + (g2 >> 2) * HALF + (g2 & 3) * 16) * DM + col0; bn[0] = *(const u32x4*)(xb + o2); bn[1] = *(const u32x4*)(xb + o2 + HALF); }
            float ss = 0.f;
#pragma unroll
            for (int bj = 0; bj < 2; ++bj) { const u32x4 bb = bc[bj];
                const f32x4 v0 = acc[ai][bj][m][0] + (f32x4){bflo(bb.x), bfhi(bb.x), bflo(bb.y), bfhi(bb.y)}, v1 = acc[ai][bj][m][1] + (f32x4){bflo(bb.z), bfhi(bb.z), bflo(bb.w), bfhi(bb.w)};
                acc[ai][bj][m][0] = v0; acc[ai][bj][m][1] = v1;
                ss += (v0[0] * v0[0] + v0[1] * v0[1]) + (v0[2] * v0[2] + v0[3] * v0[3]) + (v1[0] * v1[0] + v1[1] * v1[1]) + (v1[2] * v1[2] + v1[3] * v1[3]); }
            ss += __shfl_xor(ss, 16); ss += __shfl_xor(ss, 32);
            if (fq == 0) __hip_atomic_store(sq + (size_t)row * 16 + u.pn * 4 + wc, __float_as_uint(ss), __ATOMIC_RELAXED, __HIP_MEMORY_SCOPE_AGENT);
            bc[0] = bn[0]; bc[1] = bn[1]; }
        asm volatile("s_waitcnt vmcnt(0)" ::: "memory");
        if ((threadIdx.x & 63) == 0) __hip_atomic_fetch_add(cnt, 1u, __ATOMIC_RELAXED, __HIP_MEMORY_SCOPE_AGENT);
        f32x4 gv[2][2];
#pragma unroll
        for (int bj = 0; bj < 2; ++bj) { gv[bj][0] = *(const f32x4*)(gfin + col0 + bj * HALF); gv[bj][1] = *(const f32x4*)(gfin + col0 + bj * HALF + 4); }
        { unsigned spins = 0; while ((unsigned)__builtin_amdgcn_readfirstlane(__hip_atomic_load(cnt, __ATOMIC_RELAXED, __HIP_MEMORY_SCOPE_AGENT)) < 32u) { __builtin_amdgcn_s_sleep(1); if (++spins > (1u << 22)) break; } }
        __builtin_amdgcn_fence(__ATOMIC_ACQUIRE, "agent");
        asm volatile("s_waitcnt vmcnt(0)" ::: "memory");
        f32x4 pv[8];
#pragma unroll
        for (int gidx = 0; gidx < 8; ++gidx) pv[gidx] = *(const f32x4*)((const float*)sq + (size_t)(row0 + (gidx >> 2) * HALF + (gidx & 3) * 16) * 16 + 4 * fq);
#pragma unroll
        for (int gidx = 0; gidx < 8; ++gidx) { const int ai = gidx >> 2, m = gidx & 3; const int row = row0 + ai * HALF + m * 16;
            float t = (pv[gidx][0] + pv[gidx][1]) + (pv[gidx][2] + pv[gidx][3]); t += __shfl_xor(t, 16); t += __shfl_xor(t, 32);
            const float rstd = rsqrtf(t * (1.0f / 1024.0f) + EPS);
            const size_t o = (size_t)row * DM + col0;
#pragma unroll
            for (int bj = 0; bj < 2; ++bj) { *(f32x4*)(out + o + bj * HALF) = acc[ai][bj][m][0] * rstd * gv[bj][0]; *(f32x4*)(out + o + bj * HALF + 4) = acc[ai][bj][m][1] * rstd * gv[bj][1]; } }
    }
    template <class Sched>
    __device__ __forceinline__ bool prefill(LAS unsigned char* lds, const Sched& S) const {
        if (!(mode == 0 || mode == 1 || mode == 4 || mode == 5) || S.nwg > 4 * S.G) return false;
        const int tid = threadIdx.x, rr = tid & 255;
#pragma unroll
        for (int k = 0; k < 2; ++k) { const int ui = (tid >> 8) + 2 * k; Unit u;
            if (S.next(ui, u)) { const int row = u.pm * BM + rr; float r;
                if (mode == 4 || mode == 5) { const f32x4* pp = (const f32x4*)((const float*)(ws + WS_SSQ) + (size_t)row * 16); const f32x4 a = pp[0], b = pp[1], c = pp[2], d = pp[3];
                    const float t = ((a[0] + a[1]) + (a[2] + a[3])) + ((b[0] + b[1]) + (b[2] + b[3])) + ((c[0] + c[1]) + (c[2] + c[3])) + ((d[0] + d[1]) + (d[2] + d[3]));
                    r = rsqrtf(t * (1.0f / 1024.0f) + EPS) * (mode == 4 ? 0.0625f : 1.0f); }
                else r = ((const float*)(ws + (mode == 0 ? WS_RSTD0 : WS_RSTDM)))[row];
                *(LAS float*)(lds + STAGE_BYTES + (ui * 256 + rr) * 4) = r; } }
        return true;
    }
    __device__ __forceinline__ void operator()(const f32x4 (&acc)[2][2][4][2], const Unit& u, int ui, bool tab, LAS unsigned char* lds, int wr, int wc, int fr, int fq) const {
        const int row0 = u.pm * BM + wr * 64 + fr;
        const int colL = wc * 32 + 8 * fq;
        if (mode == 3 || mode == 6 || mode == 7) {
            const int col0 = u.pn * BM + colL;
            bf16_t* xb = (bf16_t*)(ws + WS_XB);
            float* ssq = (float*)(ws + WS_SSQ);
            f32x4 rc[4], rn[4];
            u32x4 bc[2], bn[2];
            if (mode == 3) { const size_t o = (size_t)row0 * DM + col0; rc[0] = *(const f32x4*)(x + o); rc[1] = *(const f32x4*)(x + o + 4); rc[2] = *(const f32x4*)(x + o + HALF); rc[3] = *(const f32x4*)(x + o + HALF + 4); }
            else { const size_t o = (size_t)row0 * DM + col0; bc[0] = *(const u32x4*)(xb + o); bc[1] = *(const u32x4*)(xb + o + HALF); }
#pragma unroll
            for (int gidx = 0; gidx < 8; ++gidx) { const int ai = gidx >> 2, m = gidx & 3; const int row = row0 + ai * HALF + m * 16;
                if (gidx < 7) { const int g2 = gidx + 1; const size_t o2 = (size_t)(row0 + (g2 >> 2) * HALF + (g2 & 3) * 16) * DM + col0;
                    if (mode == 3) { rn[0] = *(const f32x4*)(x + o2); rn[1] = *(const f32x4*)(x + o2 + 4); rn[2] = *(const f32x4*)(x + o2 + HALF); rn[3] = *(const f32x4*)(x + o2 + HALF + 4); }
                    else { bn[0] = *(const u32x4*)(xb + o2); bn[1] = *(const u32x4*)(xb + o2 + HALF); } }
                if (mode != 3) {
#pragma unroll
                    for (int bj = 0; bj < 2; ++bj) { rc[2 * bj] = (f32x4){bflo(bc[bj].x), bfhi(bc[bj].x), bflo(bc[bj].y), bfhi(bc[bj].y)}; rc[2 * bj + 1] = (f32x4){bflo(bc[bj].z), bfhi(bc[bj].z), bflo(bc[bj].w), bfhi(bc[bj].w)}; } }
                float ss = 0.f;
#pragma unroll
                for (int bj = 0; bj < 2; ++bj) { const size_t o = (size_t)row * DM + col0 + bj * HALF;
                    const f32x4 v0 = acc[ai][bj][m][0] + rc[2 * bj], v1 = acc[ai][bj][m][1] + rc[2 * bj + 1];
                    if (mode == 7) { *(f32x4*)(out + o) = v0; *(f32x4*)(out + o + 4) = v1; }
                    else store8(xb + o, v0, v1);
                    ss += (v0[0] * v0[0] + v0[1] * v0[1]) + (v0[2] * v0[2] + v0[3] * v0[3]) + (v1[0] * v1[0] + v1[1] * v1[1]) + (v1[2] * v1[2] + v1[3] * v1[3]); }
                if (mode != 7) { ss += __shfl_xor(ss, 16); ss += __shfl_xor(ss, 32);
                    if (fq == 0) ssq[(size_t)row * 16 + u.pn * 4 + wc] = ss; }
#pragma unroll
                for (int k = 0; k < 4; ++k) rc[k] = rn[k];
                bc[0] = bn[0]; bc[1] = bn[1]; }
            return;
        }
        if (mode == 2) {
            const int col0 = u.pn * BM + colL;
            const float* rs = (const float*)(ws + WS_RSTDM); bf16_t* ob = (bf16_t*)(ws + WS_VT); const int ldo = 1024;
            f32x4 c0[2], c1[2];
#pragma unroll
            for (int bj = 0; bj < 2; ++bj) { c0[bj] = *(const f32x4*)(rs + col0 + bj * HALF); c1[bj] = *(const f32x4*)(rs + col0 + bj * HALF + 4); }
#pragma unroll
            for (int ai = 0; ai < 2; ++ai)
#pragma unroll
                for (int m = 0; m < 4; ++m) { const int row = row0 + ai * HALF + m * 16;
#pragma unroll
                    for (int bj = 0; bj < 2; ++bj) store8(ob + (size_t)row * ldo + col0 + bj * HALF, acc[ai][bj][m][0] * c0[bj], acc[ai][bj][m][1] * c1[bj]); }
            return;
        }
        float rsc[8];
        if (tab) {
#pragma unroll
            for (int gidx = 0; gidx < 8; ++gidx) rsc[gidx] = *(const LAS float*)(lds + STAGE_BYTES + (ui * 256 + wr * 64 + fr + (gidx >> 2) * HALF + (gidx & 3) * 16) * 4);
        } else if (mode == 4 || mode == 5) {
            const float* sq = (const float*)(ws + WS_SSQ);
            f32x4 pv[8];
#pragma unroll
            for (int gidx = 0; gidx < 8; ++gidx) pv[gidx] = *(const f32x4*)(sq + (size_t)(row0 + (gidx >> 2) * HALF + (gidx & 3) * 16) * 16 + 4 * fq);
            const float cs = mode == 4 ? 0.0625f : 1.0f;
#pragma unroll
            for (int gidx = 0; gidx < 8; ++gidx) { float t = (pv[gidx][0] + pv[gidx][1]) + (pv[gidx][2] + pv[gidx][3]); t += __shfl_xor(t, 16); t += __shfl_xor(t, 32); rsc[gidx] = rsqrtf(t * (1.0f / 1024.0f) + EPS) * cs; }
        } else {
            const float* rs = (const float*)(ws + (mode == 0 ? WS_RSTD0 : WS_RSTDM));
#pragma unroll
            for (int gidx = 0; gidx < 8; ++gidx) rsc[gidx] = rs[row0 + (gidx >> 2) * HALF + (gidx & 3) * 16];
        }
        if (mode == 0) {
            float* lf = (float*)(ws + WS_LF); bf16_t* kh = (bf16_t*)(ws + WS_KH);
            const int sub = u.pn >> 1; const int cb = (u.pn & 1) * 256 + colL;
            if (sub == 1) {
                float oml[2][8];
#pragma unroll
                for (int bj = 0; bj < 2; ++bj)
#pragma unroll
                    for (int j = 0; j < 8; ++j) { const int c = cb + bj * HALF + j; const float l0 = lbl[c], l1 = lbl[512 + c]; const float lb = 1.0f / (1.0f + __expf(l1 - l0)); oml[bj][j] = 1.0f - lb; }
#pragma unroll
                for (int ai = 0; ai < 2; ++ai)
#pragma unroll
                    for (int m = 0; m < 4; ++m) { const int row = row0 + ai * HALF + m * 16; const float r = rsc[ai * 4 + m];
#pragma unroll
                        for (int bj = 0; bj < 2; ++bj) { f32x4 lf0, lf1, k0, k1;
#pragma unroll
                            for (int j = 0; j < 4; ++j) {
                                const float za = acc[ai][bj][m][0][j] * r, zb = acc[ai][bj][m][1][j] * r;
                                const float ka = oml[bj][j] * (1.0f - sigmoidf_(za)), kb = oml[bj][4 + j] * (1.0f - sigmoidf_(zb));
                                k0[j] = ka; k1[j] = kb; lf0[j] = __logf(1.0f - ka); lf1[j] = __logf(1.0f - kb); }
                            const size_t o = (size_t)row * 512 + cb + bj * HALF;
                            *(f32x4*)(lf + o) = lf0; *(f32x4*)(lf + o + 4) = lf1; store8(kh + o, k0, k1); } }
            } else {
                bf16_t* dst = (bf16_t*)(ws + (sub == 0 ? WS_QH : (sub == 2 ? WS_VH : (sub == 3 ? WS_GH : WS_PH))));
                const bool act = (sub == 0) || (sub == 3);
#pragma unroll
                for (int ai = 0; ai < 2; ++ai)
#pragma unroll
                    for (int m = 0; m < 4; ++m) { const int row = row0 + ai * HALF + m * 16; const float r = rsc[ai * 4 + m];
#pragma unroll
                        for (int bj = 0; bj < 2; ++bj) { f32x4 v0 = acc[ai][bj][m][0] * r, v1 = acc[ai][bj][m][1] * r;
                            if (act) {
#pragma unroll
                                for (int j = 0; j < 4; ++j) { v0[j] = v0[j] * sigmoidf_(v0[j]); v1[j] = v1[j] * sigmoidf_(v1[j]); } }
                            store8(dst + (size_t)row * 512 + cb + bj * HALF, v0, v1); } }
            }
        } else {
            const int col0 = u.pn * BM + colL;
            bf16_t* ob = (bf16_t*)(ws + (mode == 1 ? WS_KX : (mode == 4 ? WS_XQ : WS_U))); const int ldo = mode == 5 ? DFF : 1024;
#pragma unroll
            for (int ai = 0; ai < 2; ++ai)
#pragma unroll
                for (int m = 0; m < 4; ++m) { const int row = row0 + ai * HALF + m * 16; const float r = rsc[ai * 4 + m];
#pragma unroll
                    for (int bj = 0; bj < 2; ++bj) { f32x4 v0 = acc[ai][bj][m][0] * r, v1 = acc[ai][bj][m][1] * r;
                        if (mode == 5) {
#pragma unroll
                            for (int j = 0; j < 4; ++j) { const float a = fmaxf(v0[j], 0.f), b = fmaxf(v1[j], 0.f); v0[j] = a * a; v1[j] = b * b; } }
                        store8(ob + (size_t)row * ldo + col0 + bj * HALF, v0, v1); } }
        }
    }
};

template <class EpiT, class Sched>
__device__ __forceinline__ void gemm_phase(LAS unsigned char* lds, const Gemm g, const Sched S, const EpiT E) {
    const int tid = threadIdx.x, wid = __builtin_amdgcn_readfirstlane(tid >> 6), lane = tid & 63, wr = wid >> 2, wc = wid & 3, fr = lane & 15, fq = lane >> 4;
    const int K = g.K, nt = K / BK;
    unsigned voffA[2], voffB[2];
#pragma unroll
    for (int i = 0; i < 2; ++i) { int R, C; stage_rc(tid * 16 + i * 8192, R, C); const int Rb = EpiT::PERM ? ((R & ~31) + perm32(R & 31)) : R;
        voffA[i] = (unsigned)(R * K + C) * 2u; voffB[i] = (unsigned)(Rb * K + C) * 2u; }
    const size_t kstep = (size_t)(BK * 2);
    const size_t hstep = (size_t)HALF * K * 2;
    const size_t tstep = 2 * hstep;
    const unsigned ldsw = (unsigned)wid * 1024u;
    const int aoff = lds_byte(wr * 64 + fr, fq * 8), boff = lds_byte(wc * 32 + fr, fq * 8);
#define PG8_SA(b, h) (((b) * 2 + (h)) * HTB)
#define PG8_SB(b, h) ((4 + (b) * 2 + (h)) * HTB)
#define PG8_STAGE(bufoff, gbase, voff) do { _Pragma("unroll") for (int _i = 0; _i < 2; ++_i) \
        __builtin_amdgcn_global_load_lds((const unsigned*)((const char*)(gbase) + (voff)[_i]), (LAS unsigned*)(lds + (bufoff) + ldsw + _i * 8192), 16, 0, 0); } while (0)
#define PG8_LDA(dst, b, h) do { _Pragma("unroll") for (int m = 0; m < 4; ++m) _Pragma("unroll") for (int k = 0; k < 2; ++k) dst[m][k] = *(const LAS bf16x8*)(lds + PG8_SA(b, h) + aoff + m * 2048 + k * 1024); } while (0)
#define PG8_LDB(dst, b, h) do { _Pragma("unroll") for (int n = 0; n < 2; ++n) _Pragma("unroll") for (int k = 0; k < 2; ++k) dst[n][k] = *(const LAS bf16x8*)(lds + PG8_SB(b, h) + boff + n * 2048 + k * 1024); } while (0)
#define PG8_MMA(ai, bj, At, Bt) do { __builtin_amdgcn_s_setprio(1); _Pragma("unroll") for (int m = 0; m < 4; ++m) _Pragma("unroll") for (int n = 0; n < 2; ++n) _Pragma("unroll") for (int k = 0; k < 2; ++k) \
        acc[ai][bj][m][n] = __builtin_amdgcn_mfma_f32_16x16x32_bf16(Bt[n][k], At[m][k], acc[ai][bj][m][n], 0, 0, 0); __builtin_amdgcn_s_setprio(0); } while (0)
#define PG8_WAIT_V(n) asm volatile("s_waitcnt vmcnt(" #n ")" ::: "memory")
#define PG8_WAIT_L(n) asm volatile("s_waitcnt lgkmcnt(" #n ")" ::: "memory")
#define PG8_BAR __builtin_amdgcn_s_barrier()
#define PG8_SCHED __builtin_amdgcn_sched_barrier(0)
    Unit cur, nxt; int ui = 0;
    if (!S.next(0, cur)) return;
    const bool tab = E.prefill(lds, S);
    if (tab) __syncthreads();
    f32x4 acc[2][2][4][2];
#pragma unroll
    for (int a = 0; a < 2; ++a)
#pragma unroll
        for (int b = 0; b < 2; ++b)
#pragma unroll
            for (int m = 0; m < 4; ++m)
#pragma unroll
                for (int n = 0; n < 2; ++n) acc[a][b][m][n] = (f32x4){0.f, 0.f, 0.f, 0.f};
    bf16x8 At[4][2], B0[2][2], B1[2][2];
    const char* cA = (const char*)g.A + (size_t)cur.pm * tstep; const char* cB = (const char*)g.Bt + (size_t)cur.pn * tstep;
    PG8_STAGE(PG8_SB(0, 0), cB, voffB); PG8_STAGE(PG8_SA(0, 0), cA, voffA); PG8_STAGE(PG8_SB(0, 1), cB + hstep, voffB); PG8_STAGE(PG8_SA(0, 1), cA + hstep, voffA);
    if (wr == 1) PG8_BAR;
    PG8_WAIT_V(4); PG8_BAR;
    PG8_STAGE(PG8_SB(1, 0), cB + kstep, voffB); PG8_STAGE(PG8_SA(1, 0), cA + kstep, voffA); PG8_STAGE(PG8_SB(1, 1), cB + hstep + kstep, voffB);
    PG8_WAIT_V(6); PG8_BAR;
    for (;;) {
        const bool has_next = S.next(ui + 1, nxt);
        const char* nA = has_next ? (const char*)g.A + (size_t)nxt.pm * tstep : cA; const char* nB = has_next ? (const char*)g.Bt + (size_t)nxt.pn * tstep : cB;
        for (int t = 0; t < nt; t += 2) {
            const bool last = (t == nt - 2);
            const char* a1 = cA + (size_t)(t + 1) * kstep;
            const char* a2 = last ? nA : cA + (size_t)(t + 2) * kstep; const char* b2 = last ? nB : cB + (size_t)(t + 2) * kstep;
            const char* a3 = a2 + kstep; const char* b3 = b2 + kstep;
            PG8_LDB(B0, 0, 0); PG8_SCHED; PG8_LDA(At, 0, 0); PG8_STAGE(PG8_SA(1, 1), a1 + hstep, voffA);
            PG8_WAIT_L(8); PG8_BAR; PG8_WAIT_L(0); PG8_MMA(0, 0, At, B0); PG8_BAR; PG8_SCHED;
            PG8_LDB(B1, 0, 1); PG8_STAGE(PG8_SB(0, 0), b2, voffB);
            PG8_BAR; PG8_WAIT_L(0); PG8_MMA(0, 1, At, B1); PG8_BAR;
            PG8_LDA(At, 0, 1); PG8_STAGE(PG8_SA(0, 0), a2, voffA);
            PG8_BAR; PG8_WAIT_L(0); PG8_MMA(1, 0, At, B0); PG8_BAR; PG8_SCHED;
            PG8_STAGE(PG8_SB(0, 1), b2 + hstep, voffB);
            PG8_WAIT_V(6); PG8_BAR; PG8_MMA(1, 1, At, B1); PG8_BAR;
            PG8_LDB(B0, 1, 0); PG8_SCHED; PG8_LDA(At, 1, 0); PG8_STAGE(PG8_SA(0, 1), a2 + hstep, voffA);
            PG8_WAIT_L(8); PG8_BAR; PG8_WAIT_L(0); PG8_MMA(0, 0, At, B0); PG8_BAR; PG8_SCHED;
            PG8_LDB(B1, 1, 1); PG8_STAGE(PG8_SB(1, 0), b3, voffB);
            PG8_BAR; PG8_WAIT_L(0); PG8_MMA(0, 1, At, B1); PG8_BAR;
            PG8_LDA(At, 1, 1); PG8_STAGE(PG8_SA(1, 0), a3, voffA);
            PG8_BAR; PG8_WAIT_L(0); PG8_MMA(1, 0, At, B0); PG8_BAR; PG8_SCHED;
            PG8_STAGE(PG8_SB(1, 1), b3 + hstep, voffB);
            PG8_WAIT_V(6); PG8_BAR; PG8_MMA(1, 1, At, B1); PG8_BAR;
        }
        if (E.mode != 8) E(acc, cur, ui, tab, lds, wr, wc, fr, fq);
        if (!has_next) break;
#pragma unroll
        for (int a = 0; a < 2; ++a)
#pragma unroll
            for (int b = 0; b < 2; ++b)
#pragma unroll
                for (int m = 0; m < 4; ++m)
#pragma unroll
                    for (int n = 0; n < 2; ++n) acc[a][b][m][n] = (f32x4){0.f, 0.f, 0.f, 0.f};
        cur = nxt; cA = nA; cB = nB; ++ui;
    }
    PG8_WAIT_V(0);
    if (wr == 0) PG8_BAR;
    PG8_BAR;
    if (E.mode == 8) E.fused(acc, cur, wr, wc, fr, fq);
#undef PG8_SA
#undef PG8_SB
#undef PG8_STAGE
#undef PG8_LDA
#undef PG8_LDB
#undef PG8_MMA
#undef PG8_WAIT_V
#undef PG8_WAIT_L
#undef PG8_BAR
#undef PG8_SCHED
}
}

struct Params {
    const float *x, *mem, *norm_mix_g, *w_in, *lb_logits, *hgrn_norm_g, *w_pool, *pool_scale, *w_out, *norm_x_g, *norm_mem_g, *w_xq, *w_xk, *w_xv, *w_xo, *norm_ffn_g, *w_ff1, *w_ff2, *final_norm_g;
    float* out; unsigned char* ws;
    int ph_lo, ph_hi;
};

struct TD { const float* W; const float* g; bf16_t* out; int N, ldo, kt, nt; };
__device__ __forceinline__ TD tile_desc(const Params& p, int t) {
    unsigned char* ws = p.ws; TD d;
    if (t < 320)       { d.W = p.w_in;  d.g = p.norm_mix_g; d.out = (bf16_t*)(ws + WS_WT_IN);  d.N = NIN;  d.ldo = 1024; d.kt = t / 40; d.nt = t % 40; }
    else if (t < 448)  { const int u = t - 320;  d.W = p.w_xk;  d.g = p.norm_mem_g; d.out = (bf16_t*)(ws + WS_WT_K);   d.N = 1024; d.ldo = 1024; d.kt = u / 16; d.nt = u % 16; }
    else if (t < 576)  { const int u = t - 448;  d.W = p.w_xv;  d.g = p.norm_mem_g; d.out = (bf16_t*)(ws + WS_WT_V);   d.N = 1024; d.ldo = 1024; d.kt = u / 16; d.nt = u % 16; }
    else if (t < 704)  { const int u = t - 576;  d.W = p.w_xq;  d.g = p.norm_x_g;   d.out = (bf16_t*)(ws + WS_WT_Q);   d.N = 1024; d.ldo = 1024; d.kt = u / 16; d.nt = u % 16; }
    else if (t < 832)  { const int u = t - 704;  d.W = p.w_xo;  d.g = nullptr;      d.out = (bf16_t*)(ws + WS_WT_O);   d.N = 1024; d.ldo = 1024; d.kt = u / 16; d.nt = u % 16; }
    else if (t < 896)  { const int u = t - 832;  d.W = p.w_out; d.g = nullptr;      d.out = (bf16_t*)(ws + WS_WT_OUT); d.N = 1024; d.ldo = 1024; d.kt = u / 16; d.nt = u % 16; }
    else if (t < 1408) { const int u = t - 896;  d.W = p.w_ff1; d.g = p.norm_ffn_g; d.out = (bf16_t*)(ws + WS_WT_FF1); d.N = DFF;  d.ldo = 1024; d.kt = u / 64; d.nt = u % 64; }
    else               { const int u = t - 1408; d.W = p.w_ff2; d.g = nullptr;      d.out = (bf16_t*)(ws + WS_WT_FF2); d.N = 1024; d.ldo = 4096; d.kt = u / 16; d.nt = u % 16; }
    return d;
}
__device__ __forceinline__ void tile_load(const TD& d, f32x4 (&v)[4], float (&sc)[4]) {
    const int tid = threadIdx.x, r = tid >> 4, c4 = tid & 15;
#pragma unroll
    for (int i = 0; i < 4; ++i) { const int k = 128 * d.kt + r + 32 * i; v[i] = *(const f32x4*)(d.W + (size_t)k * d.N + 64 * d.nt + 4 * c4); sc[i] = d.g ? d.g[k] : 1.0f; }
}
__device__ __forceinline__ void transpose_range(const Params& p, unsigned char* lds, int t_begin, int t_end, int first, int stride) {
    bf16_t* T = (bf16_t*)lds;
    const int tid = threadIdx.x, r = tid >> 4, c4 = tid & 15, n = tid >> 3, ks = tid & 7;
    int t = t_begin + first;
    if (t >= t_end) return;
    TD d = tile_desc(p, t); f32x4 v[4]; float sc[4];
    tile_load(d, v, sc);
    for (;;) {
#pragma unroll
        for (int i = 0; i < 4; ++i) { const int kl = r + 32 * i;
            T[(4 * c4 + 0) * 136 + kl] = f2bf(v[i][0] * sc[i]); T[(4 * c4 + 1) * 136 + kl] = f2bf(v[i][1] * sc[i]);
            T[(4 * c4 + 2) * 136 + kl] = f2bf(v[i][2] * sc[i]); T[(4 * c4 + 3) * 136 + kl] = f2bf(v[i][3] * sc[i]); }
        __syncthreads();
        const int tn = t + stride; TD dn = d;
        if (tn < t_end) { dn = tile_desc(p, tn); tile_load(dn, v, sc); }
        const u32x4* src = (const u32x4*)(T + n * 136 + 16 * ks);
        const u32x4 a = src[0], b = src[1];
        u32x4* dst = (u32x4*)(d.out + (size_t)(64 * d.nt + n) * d.ldo + 128 * d.kt + 16 * ks);
        dst[0] = a; dst[1] = b;
        __syncthreads();
        if (tn >= t_end) break;
        t = tn; d = dn;
    }
}
__device__ __forceinline__ void fold_pool_weights(const Params& p, int first, int stride) {
    bf16_t* wto = (bf16_t*)(p.ws + WS_WT_OUT);
    for (int item = first; item < 131072; item += stride) {
        const int n = item & 1023, cgp = item >> 10, gi = cgp >> 5, c0 = (cgp & 31) * 4;
        float a[4];
#pragma unroll
        for (int j = 0; j < 4; ++j) a[j] = 0.f;
        const float* wp = p.w_pool + (size_t)(gi * 128 + c0) * 128;
        const float* wo_p = p.w_out + (size_t)(512 + gi * 128) * 1024 + n;
        const float* ps = p.pool_scale + gi * 128;
#pragma unroll 8
        for (int d = 0; d < 128; ++d) {
            const float wo = wo_p[(size_t)d * 1024] * ps[d];
#pragma unroll
            for (int j = 0; j < 4; ++j) a[j] += wp[j * 128 + d] * wo;
        }
        u32x2 w; w.x = cvt_pk_bf16(a[0], a[1]); w.y = cvt_pk_bf16(a[2], a[3]);
        *(u32x2*)(wto + (size_t)n * 1024 + 512 + gi * 128 + c0) = w;
    }
}

__device__ __forceinline__ void phase_prep(const Params p, unsigned char* lds) {
    unsigned char* ws = p.ws;
    const int G = gridDim.x;
    {
        const int lane = threadIdx.x & 63, gw = blockIdx.x * (NTHREADS / 64) + (threadIdx.x >> 6), nw = G * (NTHREADS / 64);
        int r = gw;
        f32x4 v[4], vn[4];
        if (r < MROWS + MEMROWS) { const float* src = r < MROWS ? p.x + (size_t)r * DM : p.mem + (size_t)(r - MROWS) * DM;
#pragma unroll
            for (int i = 0; i < 4; ++i) v[i] = ((const f32x4*)src)[lane + 64 * i]; }
        for (; r < MROWS + MEMROWS; r += nw) {
            const int rn = r + nw;
            if (rn < MROWS + MEMROWS) { const float* src = rn < MROWS ? p.x + (size_t)rn * DM : p.mem + (size_t)(rn - MROWS) * DM;
#pragma unroll
                for (int i = 0; i < 4; ++i) vn[i] = ((const f32x4*)src)[lane + 64 * i]; }
            const bool isx = r < MROWS;
            bf16_t* dst = isx ? (bf16_t*)(ws + WS_XB) + (size_t)r * DM : (bf16_t*)(ws + WS_MEMB) + (size_t)(r - MROWS) * DM;
            float ss = 0.f;
#pragma unroll
            for (int i = 0; i < 4; ++i) ss += (v[i][0] * v[i][0] + v[i][1] * v[i][1]) + (v[i][2] * v[i][2] + v[i][3] * v[i][3]);
#pragma unroll
            for (int o = 1; o < 64; o <<= 1) ss += __shfl_xor(ss, o);
#pragma unroll
            for (int i = 0; i < 4; ++i) { u32x2 w; w.x = cvt_pk_bf16(v[i][0], v[i][1]); w.y = cvt_pk_bf16(v[i][2], v[i][3]); ((u32x2*)dst)[lane + 64 * i] = w; }
            if (lane == 0) { const float rstd = rsqrtf(ss * (1.0f / 1024.0f) + EPS); if (isx) ((float*)(ws + WS_RSTD0))[r] = rstd; else ((float*)(ws + WS_RSTDM))[r - MROWS] = rstd; }
#pragma unroll
            for (int i = 0; i < 4; ++i) v[i] = vn[i];
        }
    }
    transpose_range(p, lds, 0, 576, blockIdx.x, G);
}
__device__ __forceinline__ void deferred_prep(const Params p, unsigned char* lds, int j, int nworkers) {
    transpose_range(p, lds, 576, 1920, j, nworkers);
    fold_pool_weights(p, j * NTHREADS + threadIdx.x, nworkers * NTHREADS);
}

__device__ __forceinline__ void phase_passA(const bf16_t* __restrict__ KH, const float* __restrict__ LF, const bf16_t* __restrict__ VH, bf16_t* __restrict__ LT, float* __restrict__ DEC, unsigned char* lds) {
    const int tid = threadIdx.x, ch = tid & 127, seg = tid >> 7, G = gridDim.x;
    float* segtot = (float*)lds;
    unsigned char* KdT = lds + 2048;
    unsigned char* VTl = lds + 2048 + 18432;
    const int w = tid >> 6, lane = tid & 63, fr = lane & 15, q = lane >> 4;
    float lf[16]; unsigned kr[16], vr[16];
    int unit = blockIdx.x;
    if (unit < 1024) { const int b = unit >> 8, c = (unit >> 2) & 63, h = unit & 3; const size_t g0 = (size_t)(b * SEQ + c * 64 + seg * 16) * 512 + h * 128 + ch;
#pragma unroll
        for (int i = 0; i < 16; ++i) { lf[i] = LF[g0 + (size_t)i * 512]; kr[i] = KH[g0 + (size_t)i * 512]; vr[i] = VH[g0 + (size_t)i * 512]; } }
    for (; unit < 1024; unit += G) {
        const int b = unit >> 8, c = (unit >> 2) & 63, h = unit & 3, bh = b * 4 + h;
#pragma unroll
        for (int i = 1; i < 16; ++i) lf[i] += lf[i - 1];
        segtot[seg * 128 + ch] = lf[15];
        __syncthreads();
        float after = 0.f;
#pragma unroll
        for (int s2 = 1; s2 < 4; ++s2) if (s2 > seg) after += segtot[s2 * 128 + ch];
        const float tot = after + lf[15];
        if (seg == 0) DEC[(size_t)(bh * 64 + c) * 128 + ch] = __expf(tot);
        unsigned kd[8], vp[8];
#pragma unroll
        for (int i = 0; i < 8; ++i) {
            kd[i] = cvt_pk_bf16(bflo(kr[2 * i]) * __expf(tot - lf[2 * i]), bflo(kr[2 * i + 1]) * __expf(tot - lf[2 * i + 1]));
            vp[i] = vr[2 * i] | (vr[2 * i + 1] << 16);
        }
        { u32x4* d = (u32x4*)(KdT + ch * 144 + seg * 32); d[0] = (u32x4){kd[0], kd[1], kd[2], kd[3]}; d[1] = (u32x4){kd[4], kd[5], kd[6], kd[7]}; }
        { u32x4* d = (u32x4*)(VTl + ch * 144 + seg * 32); d[0] = (u32x4){vp[0], vp[1], vp[2], vp[3]}; d[1] = (u32x4){vp[4], vp[5], vp[6], vp[7]}; }
        __syncthreads();
        {
            const int un = unit + G;
            if (un < 1024) { const int b2 = un >> 8, c2 = (un >> 2) & 63, h2 = un & 3; const size_t g0 = (size_t)(b2 * SEQ + c2 * 64 + seg * 16) * 512 + h2 * 128 + ch;
#pragma unroll
                for (int i = 0; i < 16; ++i) { lf[i] = LF[g0 + (size_t)i * 512]; kr[i] = KH[g0 + (size_t)i * 512]; vr[i] = VH[g0 + (size_t)i * 512]; } }
        }
        bf16x8 a[2];
#pragma unroll
        for (int ks = 0; ks < 2; ++ks) a[ks] = *(const bf16x8*)(KdT + (16 * w + fr) * 144 + (32 * ks + 8 * q) * 2);
        bf16_t* ltp = LT + (size_t)(bh * 64 + c) * 16384;
#pragma unroll
        for (int vb = 0; vb < 8; ++vb) {
            f32x4 acc = (f32x4){0.f, 0.f, 0.f, 0.f};
#pragma unroll
            for (int ks = 0; ks < 2; ++ks) { const bf16x8 bfr = *(const bf16x8*)(VTl + (16 * vb + fr) * 144 + (32 * ks + 8 * q) * 2); acc = mfma16(a[ks], bfr, acc); }
            u32x2 pk; pk.x = cvt_pk_bf16(acc[0], acc[1]); pk.y = cvt_pk_bf16(acc[2], acc[3]);
            *(u32x2*)(ltp + (size_t)(16 * vb + fr) * 128 + 16 * w + 4 * q) = pk;
        }
        __syncthreads();
    }
}

template <int W>
__device__ __forceinline__ void pool_body(const bf16_t* __restrict__ PH, bf16_t* __restrict__ MIXED, int r0, int s0, int c0) {
    unsigned v[31 + W];
#pragma unroll
    for (int j = 1; j < W; ++j) v[W - 1 - j] = (s0 - j >= 0) ? *(const unsigned*)(PH + (size_t)(r0 - j) * 512 + c0) : 0u;
#pragma unroll
    for (int tt = 0; tt < 32; ++tt) v[W - 1 + tt] = *(const unsigned*)(PH + (size_t)(r0 + tt) * 512 + c0);
    float sx = 0.f, sy = 0.f;
#pragma unroll
    for (int j = 1; j < W; ++j) { sx += bflo(v[W - 1 - j]); sy += bfhi(v[W - 1 - j]); }
#pragma unroll
    for (int tt = 0; tt < 32; ++tt) {
        const int s = s0 + tt;
        const float px = bflo(v[W - 1 + tt]), py = bfhi(v[W - 1 + tt]);
        sx += px; sy += py;
        const int cnt = (s + 1) < W ? (s + 1) : W;
        const float inv = 1.0f / (float)cnt;
        *(unsigned*)(MIXED + (size_t)(r0 + tt) * 1024 + 512 + c0) = cvt_pk_bf16(sx * inv - px, sy * inv - py);
        sx -= bflo(v[tt]); sy -= bfhi(v[tt]);
    }
}
__device__ __forceinline__ void pool_tile(const bf16_t* __restrict__ PH, bf16_t* __restrict__ MIXED, int tile) {
    const int tid = threadIdx.x, cp = tid & 255, th = tid >> 8, c0 = 2 * cp, gi = c0 >> 7;
    const int r0 = tile * 64 + th * 32, s0 = r0 & (SEQ - 1);
    if (gi == 0) pool_body<2>(PH, MIXED, r0, s0, c0);
    else if (gi == 1) pool_body<4>(PH, MIXED, r0, s0, c0);
    else if (gi == 2) pool_body<8>(PH, MIXED, r0, s0, c0);
    else pool_body<16>(PH, MIXED, r0, s0, c0);
}

__device__ __forceinline__ void phase_scan(const bf16_t* __restrict__ LT, const float* __restrict__ DEC, bf16_t* __restrict__ ST) {
    for (int e2 = blockIdx.x * NTHREADS + threadIdx.x; e2 < 131072; e2 += gridDim.x * NTHREADS) {
        const int bh = e2 >> 13, v = (e2 >> 6) & 127, kp = e2 & 63;
        float sx = 0.f, sy = 0.f;
        const size_t base = (size_t)bh * 64 * 16384 + (size_t)v * 128 + 2 * kp;
        const float* dp = DEC + (size_t)bh * 64 * 128 + 2 * kp;
        for (int c0 = 0; c0 < 64; c0 += 32) {
            unsigned l[32]; f32x2 d[32];
#pragma unroll
            for (int j = 0; j < 32; ++j) { l[j] = *(const unsigned*)(LT + base + (size_t)(c0 + j) * 16384); d[j] = *(const f32x2*)(dp + (c0 + j) * 128); }
#pragma unroll
            for (int j = 0; j < 32; ++j) {
                *(unsigned*)(ST + base + (size_t)(c0 + j) * 16384) = cvt_pk_bf16(sx, sy);
                sx = d[j][0] * sx + bflo(l[j]); sy = d[j][1] * sy + bfhi(l[j]);
            }
        }
    }
}

__device__ __forceinline__ void phase_passC(const bf16_t* __restrict__ QH, const bf16_t* __restrict__ KH, const float* __restrict__ LF, const bf16_t* __restrict__ VH, const bf16_t* __restrict__ GH,
                                const bf16_t* __restrict__ ST, const float* __restrict__ hg, bf16_t* __restrict__ MIXED, unsigned char* lds) {
    const int tid = threadIdx.x, ch = tid & 127, seg = tid >> 7, G = gridDim.x;
    float lf[16]; unsigned qr[16], kr[16], vr[16];
    int unit = blockIdx.x;
    if (unit < 1024) { const int b = unit >> 8, c = (unit >> 2) & 63, h = unit & 3; const size_t g0 = (size_t)(b * SEQ + c * 64 + seg * 16) * 512 + h * 128 + ch;
#pragma unroll
        for (int i = 0; i < 16; ++i) { lf[i] = LF[g0 + (size_t)i * 512]; vr[i] = VH[g0 + (size_t)i * 512]; qr[i] = QH[g0 + (size_t)i * 512]; kr[i] = KH[g0 + (size_t)i * 512]; } }
  for (; unit < 1024; unit += G) {
    const int b = unit >> 8, c = (unit >> 2) & 63, h = unit & 3;
    const int row0 = b * SEQ + c * 64, bh = b * 4 + h;
    float* segtot = (float*)lds;
    float* rmsp = (float*)(lds + 2048);
    bf16_t* QC = (bf16_t*)(lds + 4096);
    bf16_t* QT = (bf16_t*)(lds + 21504);
    constexpr int KT0 = 38912;
    unsigned char* VTl = lds + 82432;
    const int w = tid >> 6, lane = tid & 63, fr = lane & 15, q = lane >> 4;
    const int i = w & 3, vh = w >> 2;
    const size_t row = (size_t)(row0 + 16 * i + fr);
    u32x2 gt[4]; f32x4 gg[4]; bf16x8 stf[4][4];
    {
        const bf16_t* stp = ST + (size_t)(bh * 64 + c) * 16384;
#pragma unroll
        for (int vbl = 0; vbl < 4; ++vbl) { const int v0 = 16 * (vh * 4 + vbl) + 4 * q; gt[vbl] = *(const u32x2*)(GH + row * 512 + h * 128 + v0); gg[vbl] = *(const f32x4*)(hg + h * 128 + v0);
#pragma unroll
            for (int ks = 0; ks < 4; ++ks) stf[ks][vbl] = *(const bf16x8*)(stp + (size_t)(16 * (vh * 4 + vbl) + fr) * 128 + 32 * ks + 8 * q); }
    }
#pragma unroll
    for (int i2 = 1; i2 < 16; ++i2) lf[i2] += lf[i2 - 1];
    segtot[seg * 128 + ch] = lf[15];
    {
        unsigned vp[8];
#pragma unroll
        for (int i2 = 0; i2 < 8; ++i2) vp[i2] = vr[2 * i2] | (vr[2 * i2 + 1] << 16);
        u32x4* d = (u32x4*)(VTl + ch * 144 + seg * 32); d[0] = (u32x4){vp[0], vp[1], vp[2], vp[3]}; d[1] = (u32x4){vp[4], vp[5], vp[6], vp[7]};
    }
    __syncthreads();
    const float t0 = segtot[ch], t1 = segtot[128 + ch], t2 = segtot[256 + ch];
    const float P = (seg > 0 ? t0 : 0.f) + (seg > 1 ? t1 : 0.f) + (seg > 2 ? t2 : 0.f);
    {
        const float eP = __expf(P);
#pragma unroll
        for (int i2 = 0; i2 < 16; ++i2) {
            const float qv = bflo(qr[i2]);
            const float el = __expf(lf[i2]);
            QT[(seg * 16 + i2) * 136 + ch] = f2bf(qv * el);
            QC[(seg * 16 + i2) * 136 + ch] = f2bf(qv * el * eP);
        }
        float E = 0.f;
#pragma unroll
        for (int i2 = 0; i2 < 4; ++i2) {
            if (i2 >= seg) {
                bf16_t* KT = (bf16_t*)(lds + KT0 + 4352 * ((i2 * (i2 + 1)) / 2));
#pragma unroll
                for (int j = 0; j < 16; ++j) KT[(seg * 16 + j) * 136 + ch] = f2bf(bflo(kr[j]) * __expf(E - lf[j]));
                E += (i2 == 0 ? t0 : (i2 == 1 ? t1 : t2));
            }
        }
    }
    __syncthreads();
    {
        const int un = unit + G;
        if (un < 1024) { const int b2 = un >> 8, c2 = (un >> 2) & 63, h2 = un & 3; const size_t g2 = (size_t)(b2 * SEQ + c2 * 64 + seg * 16) * 512 + h2 * 128 + ch;
#pragma unroll
            for (int i2 = 0; i2 < 16; ++i2) { lf[i2] = LF[g2 + (size_t)i2 * 512]; vr[i2] = VH[g2 + (size_t)i2 * 512]; qr[i2] = QH[g2 + (size_t)i2 * 512]; kr[i2] = KH[g2 + (size_t)i2 * 512]; } }
    }
    f32x4 sT[4];
#pragma unroll
    for (int j = 0; j < 4; ++j) sT[j] = (f32x4){0.f, 0.f, 0.f, 0.f};
    {
        bf16x8 qfr[4];
#pragma unroll
        for (int ks = 0; ks < 4; ++ks) qfr[ks] = *(const bf16x8*)((const unsigned char*)QT + (16 * i + fr) * 272 + (32 * ks + 8 * q) * 2);
        const unsigned char* KT = lds + KT0 + 4352 * ((i * (i + 1)) / 2);
#pragma unroll
        for (int j = 0; j < 4; ++j) if (j <= i) {
#pragma unroll
            for (int ks = 0; ks < 4; ++ks) { const bf16x8 a = *(const bf16x8*)(KT + (16 * j + fr) * 272 + (32 * ks + 8 * q) * 2); sT[j] = mfma16(a, qfr[ks], sT[j]); }
            if (j == i) {
#pragma unroll
                for (int rg = 0; rg < 4; ++rg) if (4 * q + rg > fr) sT[j][rg] = 0.f;
            }
        }
    }
    f32x4 oacc[4];
#pragma unroll
    for (int vbl = 0; vbl < 4; ++vbl) oacc[vbl] = (f32x4){0.f, 0.f, 0.f, 0.f};
#pragma unroll
    for (int m = 0; m < 2; ++m) if (2 * m <= i) {
        const bf16x8 bfrag = mk8u(cvt_pk_bf16(sT[2 * m][0], sT[2 * m][1]), cvt_pk_bf16(sT[2 * m][2], sT[2 * m][3]), cvt_pk_bf16(sT[2 * m + 1][0], sT[2 * m + 1][1]), cvt_pk_bf16(sT[2 * m + 1][2], sT[2 * m + 1][3]));
#pragma unroll
        for (int vbl = 0; vbl < 4; ++vbl) {
            const unsigned char* base = VTl + (16 * (vh * 4 + vbl) + fr) * 144 + (32 * m + 4 * q) * 2;
            const bf16x8 a = mk8(*(const u32x2*)base, *(const u32x2*)(base + 32));
            oacc[vbl] = mfma16(a, bfrag, oacc[vbl]);
        }
    }
    {
#pragma unroll
        for (int ks = 0; ks < 4; ++ks) {
            const bf16x8 bfr = *(const bf16x8*)((const unsigned char*)QC + (16 * i + fr) * 272 + (32 * ks + 8 * q) * 2);
#pragma unroll
            for (int vbl = 0; vbl < 4; ++vbl) oacc[vbl] = mfma16(stf[ks][vbl], bfr, oacc[vbl]);
        }
    }
    float ss = 0.f;
#pragma unroll
    for (int vbl = 0; vbl < 4; ++vbl) ss += (oacc[vbl][0] * oacc[vbl][0] + oacc[vbl][1] * oacc[vbl][1]) + (oacc[vbl][2] * oacc[vbl][2] + oacc[vbl][3] * oacc[vbl][3]);
    ss += __shfl_xor(ss, 16); ss += __shfl_xor(ss, 32);
    if (q == 0) rmsp[vh * 64 + 16 * i + fr] = ss;
    __syncthreads();
    const float rstd = rsqrtf((rmsp[16 * i + fr] + rmsp[64 + 16 * i + fr]) * (1.0f / 128.0f) + EPS);
#pragma unroll
    for (int vbl = 0; vbl < 4; ++vbl) {
        const int v0 = 16 * (vh * 4 + vbl) + 4 * q;
        u32x2 o;
        o.x = cvt_pk_bf16(oacc[vbl][0] * rstd * gg[vbl][0] * bflo(gt[vbl].x), oacc[vbl][1] * rstd * gg[vbl][1] * bfhi(gt[vbl].x));
        o.y = cvt_pk_bf16(oacc[vbl][2] * rstd * gg[vbl][2] * bflo(gt[vbl].y), oacc[vbl][3] * rstd * gg[vbl][3] * bfhi(gt[vbl].y));
        *(u32x2*)(MIXED + row * 1024 + h * 128 + v0) = o;
    }
    __syncthreads();
  }
}

__device__ __forceinline__ void attn_unit(const bf16_t* __restrict__ XQ, const bf16_t* __restrict__ KX, const bf16_t* __restrict__ VT, bf16_t* __restrict__ ATT, int unit, unsigned char* lds) {
    const int tid = threadIdx.x, w = tid >> 6, lane = tid & 63, r = lane & 31, hh = lane >> 5;
    const int b = unit >> 6, st = (unit >> 2) & 15, h = unit & 3;
    const int row0 = b * SEQ + st * 256;
    const bf16_t* qp = XQ + (size_t)(row0 + 32 * w + r) * 1024 + h * 256 + 8 * hh;
    {
        const bf16_t* kp = KX + (size_t)(b * 256) * 1024 + h * 256;
#pragma unroll
        for (int it = 0; it < 16; ++it) { const int idx = tid + 512 * it, m = idx >> 5, cc = idx & 31;
            const u32x4 v = *(const u32x4*)(kp + (size_t)m * 1024 + cc * 8); *(u32x4*)(lds + m * 528 + cc * 16) = v; }
    }
    __syncthreads();
    f32x16 sacc[8];
#pragma unroll
    for (int mb = 0; mb < 8; ++mb)
#pragma unroll
        for (int e = 0; e < 16; ++e) sacc[mb][e] = 0.f;
    for (int kg = 0; kg < 4; ++kg) {
        bf16x8 qf[4];
#pragma unroll
        for (int k4 = 0; k4 < 4; ++k4) qf[k4] = *(const bf16x8*)(qp + 16 * (4 * kg + k4));
#pragma unroll
        for (int k4 = 0; k4 < 4; ++k4)
#pragma unroll
            for (int mb = 0; mb < 8; ++mb) { const bf16x8 a = *(const bf16x8*)(lds + (32 * mb + r) * 528 + (16 * (4 * kg + k4) + 8 * hh) * 2); sacc[mb] = mfma32(a, qf[k4], sacc[mb]); }
    }
    float mx = -3.0e38f;
#pragma unroll
    for (int mb = 0; mb < 8; ++mb)
#pragma unroll
        for (int e = 0; e < 16; ++e) mx = fmaxf(mx, sacc[mb][e]);
    mx = fmaxf(mx, __shfl_xor(mx, 32));
    float sum = 0.f;
    bf16x8 pf[8][2];
#pragma unroll
    for (int mb = 0; mb < 8; ++mb) {
        float pv[16];
#pragma unroll
        for (int e = 0; e < 16; ++e) { pv[e] = __expf(sacc[mb][e] - mx); sum += pv[e]; }
#pragma unroll
        for (int s = 0; s < 2; ++s) pf[mb][s] = mk8u(cvt_pk_bf16(pv[8 * s + 0], pv[8 * s + 1]), cvt_pk_bf16(pv[8 * s + 2], pv[8 * s + 3]), cvt_pk_bf16(pv[8 * s + 4], pv[8 * s + 5]), cvt_pk_bf16(pv[8 * s + 6], pv[8 * s + 7]));
    }
    sum += __shfl_xor(sum, 32);
    const float inv = 1.0f / sum;
    __syncthreads();
    {
        const bf16_t* vp = VT + (size_t)(h * 256) * 1024 + b * 256;
#pragma unroll
        for (int it = 0; it < 16; ++it) { const int idx = tid + 512 * it, e = idx >> 5, cc = idx & 31;
            const u32x4 v = *(const u32x4*)(vp + (size_t)e * 1024 + cc * 8);
            u32x2* d = (u32x2*)(lds + e * 520 + cc * 16); d[0] = (u32x2){v.x, v.y}; d[1] = (u32x2){v.z, v.w}; }
    }
    __syncthreads();
    bf16_t* op = ATT + (size_t)(row0 + 32 * w + r) * 1024 + h * 256 + 4 * hh;
#pragma unroll
    for (int half = 0; half < 2; ++half) {
        f32x16 oacc[4];
#pragma unroll
        for (int d = 0; d < 4; ++d)
#pragma unroll
            for (int e = 0; e < 16; ++e) oacc[d][e] = 0.f;
#pragma unroll
        for (int mb = 0; mb < 8; ++mb)
#pragma unroll
            for (int s = 0; s < 2; ++s)
#pragma unroll
                for (int d = 0; d < 4; ++d) {
                    const unsigned char* base = lds + (32 * (half * 4 + d) + r) * 520 + (32 * mb + 16 * s + 4 * hh) * 2;
                    const bf16x8 a = mk8(*(const u32x2*)base, *(const u32x2*)(base + 16));
                    oacc[d] = mfma32(a, pf[mb][s], oacc[d]);
                }
#pragma unroll
        for (int d = 0; d < 4; ++d)
#pragma unroll
            for (int g = 0; g < 4; ++g) {
                u32x2 o; o.x = cvt_pk_bf16(oacc[d][4 * g] * inv, oacc[d][4 * g + 1] * inv); o.y = cvt_pk_bf16(oacc[d][4 * g + 2] * inv, oacc[d][4 * g + 3] * inv);
                *(u32x2*)(op + 32 * (half * 4 + d) + 8 * g) = o;
            }
    }
    __syncthreads();
}

__device__ __forceinline__ void phase_final(float* __restrict__ out, const float* __restrict__ g) {
    const int lane = threadIdx.x & 63, gw = blockIdx.x * (NTHREADS / 64) + (threadIdx.x >> 6), nw = gridDim.x * (NTHREADS / 64);
    f32x4 gv[4];
#pragma unroll
    for (int i = 0; i < 4; ++i) gv[i] = ((const f32x4*)g)[lane + 64 * i];
    for (int r = gw; r < MROWS; r += nw) {
        f32x4* row = (f32x4*)(out + (size_t)r * DM);
        f32x4 v[4]; float ss = 0.f;
#pragma unroll
        for (int i = 0; i < 4; ++i) { v[i] = row[lane + 64 * i]; ss += (v[i][0] * v[i][0] + v[i][1] * v[i][1]) + (v[i][2] * v[i][2] + v[i][3] * v[i][3]); }
#pragma unroll
        for (int o = 1; o < 64; o <<= 1) ss += __shfl_xor(ss, o);
        const float rstd = rsqrtf(ss * (1.0f / 1024.0f) + EPS);
#pragma unroll
        for (int i = 0; i < 4; ++i) row[lane + 64 * i] = v[i] * rstd * gv[i];
    }
}

#define XB_TMO      128
#define XB_XCNT(j)  (256  + 64 * (j))
#define XB_XSUB(j)  (1280 + 64 * (j))
#define XB_XGEN(j)  (2304 + 64 * (j))
#define XB_TOP      3328
#define XB_TOPGEN   3392
#define XCD_BAR_WORDS 3456
#define XB_SPIN_CAP (1u << 22)
__device__ __forceinline__ unsigned xb_ld(unsigned* p)              { return __hip_atomic_load(p, __ATOMIC_RELAXED, __HIP_MEMORY_SCOPE_AGENT); }
__device__ __forceinline__ unsigned xb_add(unsigned* p, unsigned v) { return __hip_atomic_fetch_add(p, v, __ATOMIC_RELAXED, __HIP_MEMORY_SCOPE_AGENT); }
__device__ __forceinline__ unsigned xb_xcc_id() { return (unsigned)__builtin_amdgcn_s_getreg((3 << 11) | 20) & 0xFu; }
#define XB_SPIN(cond, bar) do { unsigned _sp = 0; while (cond) { __builtin_amdgcn_s_sleep(1); \
    if ((++_sp & 255u) == 0u) { if (xb_ld(&(bar)[XB_TMO])) break; if (_sp > XB_SPIN_CAP) { atomicAdd(&(bar)[XB_TMO], 1u); break; } } } } while (0)
struct XcdBarrier { unsigned* bar; unsigned x; volatile LAS unsigned* st; };
__device__ __forceinline__ XcdBarrier xcd_barrier_post(unsigned* bar, volatile LAS unsigned* st) {
    XcdBarrier b; b.bar = bar; b.x = xb_xcc_id(); b.st = st;
    if (threadIdx.x == 0) (void)xb_add(&bar[XB_XCNT(b.x)], 1u);
    return b;
}
__device__ __forceinline__ void xcd_barrier_complete(unsigned* bar, unsigned x, unsigned& nloc, unsigned& nx) {
    const unsigned G = gridDim.x * gridDim.y * gridDim.z;
    unsigned sum, cnt, mine, sp = 0u;
    for (;;) {
        sum = 0u; cnt = 0u; mine = 0u;
#pragma unroll
        for (unsigned j = 0; j < 16; ++j) { const unsigned c = xb_ld(&bar[XB_XCNT(j)]); sum += c; cnt += (c > 0u) ? 1u : 0u; mine = (j == x) ? c : mine; }
        if (sum == G) break;
        __builtin_amdgcn_s_sleep(1);
        if ((++sp & 255u) == 0u) { if (xb_ld(&bar[XB_TMO])) break; if (sp > XB_SPIN_CAP) { atomicAdd(&bar[XB_TMO], 1u); break; } }
    }
    nloc = mine > 0u ? mine : 1u; nx = cnt > 0u ? cnt : 1u;
}
__device__ __forceinline__ void xcd_barrier(const XcdBarrier& b) {
    asm volatile("s_waitcnt vmcnt(0)" ::: "memory");
    __syncthreads();
    if (threadIdx.x == 0) {
        unsigned* bar = b.bar;
        __builtin_amdgcn_s_waitcnt(0);
        unsigned nloc = b.st[0], nx = b.st[1];
        if (nloc == 0u) { xcd_barrier_complete(bar, b.x, nloc, nx); b.st[0] = nloc; b.st[1] = nx; }
        const unsigned old = xb_add(&bar[XB_XSUB(b.x)], 1u);
        const unsigned gen = old / nloc;
        if (old + 1u == (gen + 1u) * nloc) {
            __builtin_amdgcn_fence(__ATOMIC_RELEASE, "agent");
            asm volatile("s_waitcnt vmcnt(0)" ::: "memory");
            const unsigned og = xb_add(&bar[XB_TOP], 1u);
            const unsigned tg = og / nx;
            if (og + 1u == (tg + 1u) * nx) xb_add(&bar[XB_TOPGEN], 1u);
            else XB_SPIN(xb_ld(&bar[XB_TOPGEN]) == tg, bar);
            __builtin_amdgcn_fence(__ATOMIC_ACQUIRE, "agent");
            xb_add(&bar[XB_XGEN(b.x)], 1u);
            asm volatile("s_waitcnt vmcnt(0)" ::: "memory");
        } else {
            XB_SPIN(xb_ld(&bar[XB_XGEN(b.x)]) == gen, bar);
            __builtin_amdgcn_fence(__ATOMIC_ACQUIRE, "agent");
            asm volatile("s_waitcnt vmcnt(0)" ::: "memory");
        }
    }
    __syncthreads();
}

constexpr int N_PHASES = 12;
__global__ void __launch_bounds__(NTHREADS, 2) mega(Params p) {
    extern __shared__ __attribute__((aligned(16))) unsigned char lds[];
    LAS unsigned char* ldsl = (LAS unsigned char*)lds;
    unsigned char* ws = p.ws;
    const int G = gridDim.x, bid = blockIdx.x;
    const int lo = p.ph_lo, hi = p.ph_hi;

#ifndef DEFER_PREP
#define DEFER_PREP 0
#endif
#ifndef FUSE_FINAL
#define FUSE_FINAL 0
#endif
#ifndef DBG_LAST
#define DBG_LAST -1
#endif
#ifndef PHASE_MASK
#define PHASE_MASK 0xfff
#endif
#define IN(k) (((PHASE_MASK >> (k)) & 1) && lo <= (k) && (k) < hi)
    if (threadIdx.x == 0) { ((volatile LAS unsigned*)(ldsl + LDS_MAIN))[0] = 0u; ((volatile LAS unsigned*)(ldsl + LDS_MAIN))[1] = 0u; }
    __syncthreads();
    XcdBarrier xbar; xbar.bar = (unsigned*)(ws + WS_BAR); xbar.x = 0; xbar.st = nullptr;
    if (hi - lo > 1) xbar = xcd_barrier_post((unsigned*)(ws + WS_BAR), (volatile LAS unsigned*)(ldsl + LDS_MAIN));
    if (lo > hi) cg::this_grid().sync();
#define SEAM(k) do { if (IN(k) && IN((k) + 1)) { xcd_barrier(xbar); } } while (0)
    bf16_t* XB = (bf16_t*)(ws + WS_XB); bf16_t* LT = (bf16_t*)(ws + WS_XB);
    bf16_t* QH = (bf16_t*)(ws + WS_QH); bf16_t* KH = (bf16_t*)(ws + WS_KH); bf16_t* VH = (bf16_t*)(ws + WS_VH); bf16_t* GH = (bf16_t*)(ws + WS_GH); bf16_t* PH = (bf16_t*)(ws + WS_PH);
    float* LF = (float*)(ws + WS_LF); bf16_t* ST = (bf16_t*)(ws + WS_ST); bf16_t* MIXED = (bf16_t*)(ws + WS_MIXED);
    float* X1 = (float*)(ws + WS_X1); bf16_t* XQ = (bf16_t*)(ws + WS_XQ); bf16_t* ATT = (bf16_t*)(ws + WS_ATT); bf16_t* U = (bf16_t*)(ws + WS_U);
    float* SSQ = (float*)(ws + WS_SSQ); float* DEC = (float*)(ws + WS_DEC);
    bf16_t* MEMB = (bf16_t*)(ws + WS_MEMB); bf16_t* KX = (bf16_t*)(ws + WS_KX); bf16_t* VT = (bf16_t*)(ws + WS_VT);

    const bool fuse_final = FUSE_FINAL && (G == 256) && IN(10) && (hi - lo > 1);
    if (IN(0)) { phase_prep(p, lds);
#if !DEFER_PREP
        deferred_prep(p, lds, bid, G);
#endif
    }
    SEAM(0);
    if (IN(1)) {
        const pg8::Epi E{0, ws, p.x, p.out, p.lb_logits, p.final_norm_g};
        { pg8::Gemm g{XB, (const bf16_t*)(ws + WS_WT_IN), MROWS, NIN, DM}; pg8::StaticOrder S; S.init(MROWS, NIN, G, bid); pg8::gemm_phase(ldsl, g, S, E); }
        const pg8::Epi E1{1, ws, p.x, p.out, p.lb_logits, p.final_norm_g};
        { pg8::Gemm g{MEMB, (const bf16_t*)(ws + WS_WT_K), MEMROWS, 1024, DM}; pg8::StaticOrder S; S.init(MEMROWS, 1024, G, (bid + 128) % G); pg8::gemm_phase(ldsl, g, S, E1); }
        const pg8::Epi E2{2, ws, p.x, p.out, p.lb_logits, p.final_norm_g};
        { pg8::Gemm g{(const bf16_t*)(ws + WS_WT_V), MEMB, 1024, MEMROWS, DM}; pg8::StaticOrder S; S.init(1024, MEMROWS, G, (bid + 112) % G); pg8::gemm_phase(ldsl, g, S, E2); }
#if DEFER_PREP
        if (G == 256) { if (bid >= 160) deferred_prep(p, lds, bid - 160, 96); }
        else deferred_prep(p, lds, bid, G);
#endif
    }
    SEAM(1);
    if (IN(2)) {
#ifndef DBG_NO_PASSA
        phase_passA(KH, LF, VH, LT, DEC, lds);
#endif
#ifndef DBG_NO_POOL
        for (int t = bid; t < 256; t += G) pool_tile(PH, MIXED, t);
#endif
    }
    SEAM(2);
    if (IN(3)) { phase_scan(LT, DEC, ST); }
    SEAM(3);
    if (IN(4)) { phase_passC(QH, KH, LF, VH, GH, ST, p.hgrn_norm_g, MIXED, lds); }
    SEAM(4);
    if (IN(5)) {
        const pg8::Epi E{3, ws, p.x, p.out, p.lb_logits, p.final_norm_g};
        pg8::Gemm g{MIXED, (const bf16_t*)(ws + WS_WT_OUT), MROWS, DM, DM}; pg8::StaticOrder S; S.init(MROWS, DM, G, bid); pg8::gemm_phase(ldsl, g, S, E);
    }
    SEAM(5);
    const bool fuse_attn = (G == 256) && IN(6) && IN(7);
    if (IN(6)) {
        const pg8::Epi E{4, ws, p.x, p.out, p.lb_logits, p.final_norm_g};
        pg8::Gemm g{XB, (const bf16_t*)(ws + WS_WT_Q), MROWS, DM, DM}; pg8::StaticOrder S; S.init(MROWS, DM, G, bid); pg8::gemm_phase(ldsl, g, S, E);
        if (fuse_attn) {
            pg8::Unit u; S.next(0, u);
            asm volatile("s_waitcnt vmcnt(0)" ::: "memory"); __syncthreads();
            attn_unit(XQ, KX, VT, ATT, u.pm * 4 + u.pn, lds);
        }
    }
    if (!fuse_attn) {
        SEAM(6);
        if (IN(7)) { for (int u = bid; u < 256; u += G) attn_unit(XQ, KX, VT, ATT, u, lds); }
    }
    SEAM(7);
    if (IN(8)) {
        const pg8::Epi E{6, ws, p.x, p.out, p.lb_logits, p.final_norm_g};
        pg8::Gemm g{ATT, (const bf16_t*)(ws + WS_WT_O), MROWS, DM, DM}; pg8::StaticOrder S; S.init(MROWS, DM, G, bid); pg8::gemm_phase(ldsl, g, S, E);
    }
    SEAM(8);
    if (IN(9)) {
        const pg8::Epi E{5, ws, p.x, p.out, p.lb_logits, p.final_norm_g};
        pg8::Gemm g{XB, (const bf16_t*)(ws + WS_WT_FF1), MROWS, DFF, DM}; pg8::StaticOrder S; S.init(MROWS, DFF, G, bid); pg8::gemm_phase(ldsl, g, S, E);
    }
    SEAM(9);
    if (IN(10)) {
        const pg8::Epi E{fuse_final ? 8 : 7, ws, p.x, p.out, p.lb_logits, p.final_norm_g};
        pg8::Gemm g{U, (const bf16_t*)(ws + WS_WT_FF2), MROWS, DM, DFF}; pg8::StaticOrder S; S.init(MROWS, DM, G, bid); pg8::gemm_phase(ldsl, g, S, E);
    }
    if (!fuse_final) {
        SEAM(10);
        if (IN(11)) { phase_final(p.out, p.final_norm_g); }
    }
#if DBG_LAST >= 0
    cg::this_grid().sync();
    {
        const unsigned* w32 = (const unsigned*)ws;
        for (size_t i = (size_t)bid * NTHREADS + threadIdx.x; i < (size_t)MROWS * DM; i += (size_t)G * NTHREADS) {
            float a = 0.f;
            for (int j = 0; j < 4; ++j) { const unsigned v = w32[i + (size_t)j * MROWS * DM]; a += (float)(v & 0xffffu) + (float)(v >> 16); }
            p.out[i] = a;
        }
    }
#endif
#undef IN
#undef SEAM
}

extern "C" void kernel_launch(void* const* d_in, const int* in_sizes, int n_in, void* d_out, int out_size, void* d_ws, size_t ws_size, hipStream_t stream) {
    static int grid = 0;
    if (grid == 0) {
        if (n_in != 19 || in_sizes[0] != MROWS * DM || out_size != MROWS * DM || ws_size < WS_END) { fprintf(stderr, "kernel_launch: unexpected shapes (n_in %d, ws %zu)\n", n_in, ws_size); grid = -1; return; }
        int dev = 0, cus = 0, per_cu = 0;
        hipGetDevice(&dev); hipDeviceGetAttribute(&cus, hipDeviceAttributeMultiprocessorCount, dev);
        if (hipFuncSetAttribute((const void*)mega, hipFuncAttributeMaxDynamicSharedMemorySize, LDS_BYTES) != hipSuccess) { fprintf(stderr, "kernel_launch: hipFuncSetAttribute failed\n"); grid = -1; return; }
        if (hipOccupancyMaxActiveBlocksPerMultiprocessor(&per_cu, (const void*)mega, NTHREADS, LDS_BYTES) != hipSuccess || per_cu < 1) { fprintf(stderr, "kernel_launch: occupancy query says %d\n", per_cu); per_cu = 1; }
        (void)hipGetLastError();
        grid = cus * 1;
        if (grid > cus * per_cu) grid = cus * per_cu;
    }
    if (grid < 0) return;
    if (hipMemsetAsync((char*)d_ws + WS_BAR, 0, 32768, stream) != hipSuccess) { fprintf(stderr, "kernel_launch: memset of barrier words failed\n"); return; }
    Params p{};
    const float** f = (const float**)&p;
    for (int i = 0; i < 19; ++i) f[i] = (const float*)d_in[i];
    p.out = (float*)d_out; p.ws = (unsigned char*)d_ws;
#if N_LAUNCH_MODE == 1
    p.ph_lo = 0; p.ph_hi = (DBG_LAST >= 0) ? DBG_LAST + 1 : N_PHASES;
    void* args[] = {&p};
    hipError_t e = hipLaunchCooperativeKernel((const void*)mega, dim3(grid), dim3(NTHREADS), args, LDS_BYTES, stream);
    if (e != hipSuccess) fprintf(stderr, "kernel_launch: cooperative launch failed: %s (grid %d)\n", hipGetErrorString(e), grid);
#else
    for (int k = 0; k < N_PHASES; ++k) { p.ph_lo = k; p.ph_hi = k + 1; hipLaunchKernelGGL(mega, dim3(grid), dim3(NTHREADS), LDS_BYTES, stream, p); }
#endif
}
```

```cpp
#include <hip/hip_runtime.h>
#include <hip/hip_cooperative_groups.h>
#include <cstdio>
namespace cg = cooperative_groups;

#ifndef N_LAUNCH_MODE
#define N_LAUNCH_MODE 1
#endif

typedef unsigned short bf16_t;
typedef short bf16x8 __attribute__((ext_vector_type(8)));
typedef float f32x2 __attribute__((ext_vector_type(2)));
typedef float f32x4 __attribute__((ext_vector_type(4)));
typedef float f32x16 __attribute__((ext_vector_type(16)));
typedef unsigned u32x2 __attribute__((ext_vector_type(2)));
typedef unsigned u32x4 __attribute__((ext_vector_type(4)));
#define LAS __attribute__((address_space(3)))

constexpr int MROWS = 16384, DM = 1024, SEQ = 4096, NIN = 2560, DFF = 4096, MEMROWS = 1024;
constexpr float EPS = 1e-6f;
constexpr int NTHREADS = 512;
constexpr int LDS_MAIN = 135168;
constexpr int LDS_BYTES = LDS_MAIN + 16;

constexpr size_t MiB = 1u << 20;
constexpr size_t WS_WT_IN = 0, WS_WT_K = 5 * MiB, WS_WT_V = 7 * MiB, WS_WT_OUT = 9 * MiB, WS_WT_Q = 11 * MiB, WS_WT_O = 13 * MiB,
                 WS_WT_FF1 = 15 * MiB, WS_WT_FF2 = 23 * MiB, WS_MEMB = 31 * MiB, WS_KX = 33 * MiB, WS_VT = 35 * MiB, WS_SSQ = 37 * MiB,
                 WS_BAR = 39 * MiB, WS_CNT = 39 * MiB + 16384, WS_RSTD0 = 38 * MiB, WS_RSTDM = 38 * MiB + 65536, WS_DEC = 38 * MiB + 131072,
                 WS_XB = 40 * MiB  , WS_QH = 72 * MiB, WS_KH = 88 * MiB, WS_VH = 104 * MiB, WS_GH = 120 * MiB, WS_PH = 136 * MiB,
                 WS_LF = 152 * MiB, WS_ST = 184 * MiB, WS_MIXED = 216 * MiB,
                 WS_X1 = 72 * MiB, WS_XQ = 136 * MiB, WS_ATT = 168 * MiB, WS_U = 72 * MiB, WS_END = 256 * MiB;

typedef __bf16 bf16x2n __attribute__((ext_vector_type(2)));
__device__ __forceinline__ unsigned cvt_pk_bf16(float lo, float hi) { f32x2 v = {lo, hi}; return __builtin_bit_cast(unsigned, __builtin_convertvector(v, bf16x2n)); }
__device__ __forceinline__ bf16_t f2bf(float f) { return (bf16_t)(cvt_pk_bf16(f, 0.f) & 0xffffu); }
__device__ __forceinline__ float bf2f(bf16_t b) { return __uint_as_float(((unsigned)b) << 16); }
__device__ __forceinline__ float bflo(unsigned u) { return __uint_as_float(u << 16); }
__device__ __forceinline__ float bfhi(unsigned u) { return __uint_as_float(u & 0xffff0000u); }
__device__ __forceinline__ f32x4 mfma16(bf16x8 a, bf16x8 b, f32x4 c) { return __builtin_amdgcn_mfma_f32_16x16x32_bf16(a, b, c, 0, 0, 0); }
__device__ __forceinline__ f32x16 mfma32(bf16x8 a, bf16x8 b, f32x16 c) { return __builtin_amdgcn_mfma_f32_32x32x16_bf16(a, b, c, 0, 0, 0); }
__device__ __forceinline__ bf16x8 mk8(u32x2 lo, u32x2 hi) { u32x4 t; t.x = lo.x; t.y = lo.y; t.z = hi.x; t.w = hi.y; return __builtin_bit_cast(bf16x8, t); }
__device__ __forceinline__ bf16x8 mk8u(unsigned a, unsigned b, unsigned c, unsigned d) { u32x4 t; t.x = a; t.y = b; t.z = c; t.w = d; return __builtin_bit_cast(bf16x8, t); }
__device__ __forceinline__ float sigmoidf_(float z) { return 1.0f / (1.0f + __expf(-z)); }

namespace pg8 {
constexpr int BM = 256, BK = 64, HALF = 128, HTB = HALF * BK * 2, STAGE_BYTES = 8 * HTB, NXCD = 8, WGM = 8;
__device__ __forceinline__ int lds_byte(int r, int c) { const int st = (r >> 4) * 2 + (c >> 5), rr = r & 15, cc = c & 31, ob = rr * 64 + cc * 2; return st * 1024 + (ob ^ (((ob >> 9) & 1) << 5)); }
__device__ __forceinline__ void stage_rc(int b, int& R, int& C) { const int st = b / 1024, sb = b % 1024, swz = sb ^ (((sb >> 9) & 1) << 5); R = (st >> 1) * 16 + swz / 64; C = (st & 1) * 32 + (swz % 64) / 2; }
__device__ __forceinline__ int perm32(int rho) { const int n = rho >> 4, i = rho & 15; return 8 * (i >> 2) + 4 * n + (i & 3); }
struct Unit { int pm, pn; };
struct Gemm { const bf16_t* A; const bf16_t* Bt; int M, N, K; };
struct StaticOrder {
    int nM, nN, nwg, G, c;
    __device__ __forceinline__ void init(int M, int N, int G_, int c_) { nM = M / BM; nN = N / BM; nwg = nM * nN; G = G_; c = c_; }
    __device__ __forceinline__ bool next(int i, Unit& u) const {
        const long L = (long)i * G + c; if (L >= nwg) return false;
        int wgid = (int)L; { const int q = nwg / NXCD, r = nwg % NXCD, xcd = wgid % NXCD, off = wgid / NXCD; wgid = (xcd < r ? xcd * (q + 1) : r * (q + 1) + (xcd - r) * q) + off; }
        const int nig = WGM * nN, gid = wgid / nig, fm = gid * WGM, gsz = (nM - fm) < WGM ? (nM - fm) : WGM;
        u.pm = fm + ((wgid % nig) % gsz); u.pn = (wgid % nig) / gsz; return true;
    }
};

struct Epi {
    static constexpr bool PERM = true;
    int mode;
    unsigned char* ws; const float* x; float* out; const float* lbl; const float* gfin;
    __device__ __forceinline__ void store8(bf16_t* p, const f32x4& v0, const f32x4& v1) const {
        u32x4 w; w.x = cvt_pk_bf16(v0[0], v0[1]); w.y = cvt_pk_bf16(v0[2], v0[3]); w.z = cvt_pk_bf16(v1[0], v1[1]); w.w = cvt_pk_bf16(v1[2], v1[3]); *(u32x4*)p = w; }
    __device__ __forceinline__ void fused(f32x4 (&acc)[2][2][4][2], const Unit& u, int wr, int wc, int fr, int fq) const {
        const int row0 = u.pm * BM + wr * 64 + fr;
        const int col0 = u.pn * BM + wc * 32 + 8 * fq;
        const bf16_t* xb = (const bf16_t*)(ws + WS_XB);
        unsigned* sq = (unsigned*)(ws + WS_SSQ);
        unsigned* cnt = (unsigned*)(ws + WS_CNT) + 64 * u.pm;
        u32x4 bc[2], bn[2];
        { const size_t o = (size_t)row0 * DM + col0; bc[0] = *(const u32x4*)(xb + o); bc[1] = *(const u32x4*)(xb + o + HALF); }
#pragma unroll
        for (int gidx = 0; gidx < 8; ++gidx) { const int ai = gidx >> 2, m = gidx & 3; const int row = row0 + ai * HALF + m * 16;
            if (gidx < 7) { const int g2 = gidx + 1; const size_t o2 = (size_t)(row0 + (g2 >> 2) * HALF + (g2 & 3) * 16) * DM + col0; bn[0] = *(const u32x4*)(xb + o2); bn[1] = *(const u32x4*)(xb + o2 + HALF); }
            float ss = 0.f;
#pragma unroll
            for (int bj = 0; bj < 2; ++bj) { const u32x4 bb = bc[bj];
                const f32x4 v0 = acc[ai][bj][m][0] + (f32x4){bflo(bb.x), bfhi(bb.x), bflo(bb.y), bfhi(bb.y)}, v1 = acc[ai][bj][m][1] + (f32x4){bflo(bb.z), bfhi(bb.z), bflo(bb.w), bfhi(bb.w)};
                acc[ai][bj][m][0] = v0; acc[ai][bj][m][1] = v1;
                ss += (v0[0] * v0[0] + v0[1] * v0[1]) + (v0[2] * v0[2] + v0[3] * v0[3]) + (v1[0] * v1[0] + v1[1] * v1[1]) + (v1[2] * v1[2] + v1[3] * v1[3]); }
            ss += __shfl_xor(ss, 16); ss += __shfl_xor(ss, 32);
            if (fq == 0) __hip_atomic_store(sq + (size_t)row * 16 + u.pn * 4 + wc, __float_as_uint(ss), __ATOMIC_RELAXED, __HIP_MEMORY_SCOPE_AGENT);
            bc[0] = bn[0]; bc[1] = bn[1]; }
        asm volatile("s_waitcnt vmcnt(0)" ::: "memory");
        if ((threadIdx.x & 63) == 0) __hip_atomic_fetch_add(cnt, 1u, __ATOMIC_RELAXED, __HIP_MEMORY_SCOPE_AGENT);
        f32x4 gv[2][2];
#pragma unroll
        for (int bj = 0; bj < 2; ++bj) { gv[bj][0] = *(const f32x4*)(gfin + col0 + bj * HALF); gv[bj][1] = *(const f32x4*)(gfin + col0 + bj * HALF + 4); }
        { unsigned spins = 0; while ((unsigned)__builtin_amdgcn_readfirstlane(__hip_atomic_load(cnt, __ATOMIC_RELAXED, __HIP_MEMORY_SCOPE_AGENT)) < 32u) { __builtin_amdgcn_s_sleep(1); if (++spins > (1u << 22)) break; } }
        __builtin_amdgcn_fence(__ATOMIC_ACQUIRE, "agent");
        asm volatile("s_waitcnt vmcnt(0)" ::: "memory");
        f32x4 pv[8];
#pragma unroll
        for (int gidx = 0; gidx < 8; ++gidx) pv[gidx] = *(const f32x4*)((const float*)sq + (size_t)(row0 + (gidx >> 2) * HALF + (gidx & 3) * 16) * 16 + 4 * fq);
#pragma unroll
        for (int gidx = 0; gidx < 8; ++gidx) { const int ai = gidx >> 2, m = gidx & 3; const int row = row0 + ai * HALF + m * 16;
            float t = (pv[gidx][0] + pv[gidx][1]) + (pv[gidx][2] + pv[gidx][3]); t += __shfl_xor(t, 16); t += __shfl_xor(t, 32);
            const float rstd = rsqrtf(t * (1.0f / 1024.0f) + EPS);
            const size_t o = (size_t)row * DM + col0;
#pragma unroll
            for (int bj = 0; bj < 2; ++bj) { *(f32x4*)(out + o + bj * HALF) = acc[ai][bj][m][0] * rstd * gv[bj][0]; *(f32x4*)(out + o + bj * HALF + 4) = acc[ai][bj][m][1] * rstd * gv[bj][1]; } }
    }
    template <class Sched>
    __device__ __forceinline__ bool prefill(LAS unsigned char* lds, const Sched& S) const {
        if (!(mode == 0 || mode == 1 || mode == 4 || mode == 5) || S.nwg > 4 * S.G) return false;
        const int tid = threadIdx.x, rr = tid & 255;
#pragma unroll
        for (int k = 0; k < 2; ++k) { const int ui = (tid >> 8) + 2 * k; Unit u;
            if (S.next(ui, u)) { const int row = u.pm * BM + rr; float r;
                if (mode == 4 || mode == 5) { const f32x4* pp = (const f32x4*)((const float*)(ws + WS_SSQ) + (size_t)row * 16); const f32x4 a = pp[0], b = pp[1], c = pp[2], d = pp[3];
                    const float t = ((a[0] + a[1]) + (a[2] + a[3])) + ((b[0] + b[1]) + (b[2] + b[3])) + ((c[0] + c[1]) + (c[2] + c[3])) + ((d[0] + d[1]) + (d[2] + d[3]));
                    r = rsqrtf(t * (1.0f / 1024.0f) + EPS) * (mode == 4 ? 0.0625f : 1.0f); }
                else r = ((const float*)(ws + (mode == 0 ? WS_RSTD0 : WS_RSTDM)))[row];
                *(LAS float*)(lds + STAGE_BYTES + (ui * 256 + rr) * 4) = r; } }
        return true;
    }
    __device__ __forceinline__ void operator()(const f32x4 (&acc)[2][2][4][2], const Unit& u, int ui, bool tab, LAS unsigned char* lds, int wr, int wc, int fr, int fq) const {
        const int row0 = u.pm * BM + wr * 64 + fr;
        const int colL = wc * 32 + 8 * fq;
        if (mode == 3 || mode == 6 || mode == 7) {
            const int col0 = u.pn * BM + colL;
            bf16_t* xb = (bf16_t*)(ws + WS_XB);
            float* ssq = (float*)(ws + WS_SSQ);
            f32x4 rc[4], rn[4];
            u32x4 bc[2], bn[2];
            if (mode == 3) { const size_t o = (size_t)row0 * DM + col0; rc[0] = *(const f32x4*)(x + o); rc[1] = *(const f32x4*)(x + o + 4); rc[2] = *(const f32x4*)(x + o + HALF); rc[3] = *(const f32x4*)(x + o + HALF + 4); }
            else { const size_t o = (size_t)row0 * DM + col0; bc[0] = *(const u32x4*)(xb + o); bc[1] = *(const u32x4*)(xb + o + HALF); }
#pragma unroll
            for (int gidx = 0; gidx < 8; ++gidx) { const int ai = gidx >> 2, m = gidx & 3; const int row = row0 + ai * HALF + m * 16;
                if (gidx < 7) { const int g2 = gidx + 1; const size_t o2 = (size_t)(row0 + (g2 >> 2) * HALF + (g2 & 3) * 16) * DM + col0;
                    if (mode == 3) { rn[0] = *(const f32x4*)(x + o2); rn[1] = *(const f32x4*)(x + o2 + 4); rn[2] = *(const f32x4*)(x + o2 + HALF); rn[3] = *(const f32x4*)(x + o2 + HALF + 4); }
                    else { bn[0] = *(const u32x4*)(xb + o2); bn[1] = *(const u32x4*)(xb + o2 + HALF); } }
                if (mode != 3) {
#pragma unroll
                    for (int bj = 0; bj < 2; ++bj) { rc[2 * bj] = (f32x4){bflo(bc[bj].x), bfhi(bc[bj].x), bflo(bc[bj].y), bfhi(bc[bj].y)}; rc[2 * bj + 1] = (f32x4){bflo(bc[bj].z), bfhi(bc[bj].z), bflo(bc[bj].w), bfhi(bc[bj].w)}; } }
                float ss = 0.f;
#pragma unroll
                for (int bj = 0; bj < 2; ++bj) { const size_t o = (size_t)row * DM + col0 + bj * HALF;
                    const f32x4 v0 = acc[ai][bj][m][0] + rc[2 * bj], v1 = acc[ai][bj][m][1] + rc[2 * bj + 1];
                    store8(xb + o, v0, v1);
                    ss += (v0[0] * v0[0] + v0[1] * v0[1]) + (v0[2] * v0[2] + v0[3] * v0[3]) + (v1[0] * v1[0] + v1[1] * v1[1]) + (v1[2] * v1[2] + v1[3] * v1[3]); }
                ss += __shfl_xor(ss, 16); ss += __shfl_xor(ss, 32);
                if (fq == 0) ssq[(size_t)row * 16 + u.pn * 4 + wc] = ss;
#pragma unroll
                for (int k = 0; k < 4; ++k) rc[k] = rn[k];
                bc[0] = bn[0]; bc[1] = bn[1]; }
            return;
        }
        if (mode == 2) {
            const int col0 = u.pn * BM + colL;
            const float* rs = (const float*)(ws + WS_RSTDM); bf16_t* ob = (bf16_t*)(ws + WS_VT); const int ldo = 1024;
            f32x4 c0[2], c1[2];
#pragma unroll
            for (int bj = 0; bj < 2; ++bj) { c0[bj] = *(const f32x4*)(rs + col0 + bj * HALF); c1[bj] = *(const f32x4*)(rs + col0 + bj * HALF + 4); }
#pragma unroll
            for (int ai = 0; ai < 2; ++ai)
#pragma unroll
                for (int m = 0; m < 4; ++m) { const int row = row0 + ai * HALF + m * 16;
#pragma unroll
                    for (int bj = 0; bj < 2; ++bj) store8(ob + (size_t)row * ldo + col0 + bj * HALF, acc[ai][bj][m][0] * c0[bj], acc[ai][bj][m][1] * c1[bj]); }
            return;
        }
        float rsc[8];
        if (tab) {
#pragma unroll
            for (int gidx = 0; gidx < 8; ++gidx) rsc[gidx] = *(const LAS float*)(lds + STAGE_BYTES + (ui * 256 + wr * 64 + fr + (gidx >> 2) * HALF + (gidx & 3) * 16) * 4);
        } else if (mode == 4 || mode == 5) {
            const float* sq = (const float*)(ws + WS_SSQ);
            f32x4 pv[8];
#pragma unroll
            for (int gidx = 0; gidx < 8; ++gidx) pv[gidx] = *(const f32x4*)(sq + (size_t)(row0 + (gidx >> 2) * HALF + (gidx & 3) * 16) * 16 + 4 * fq);
            const float cs = mode == 4 ? 0.0625f : 1.0f;
#pragma unroll
            for (int gidx = 0; gidx < 8; ++gidx) { float t = (pv[gidx][0] + pv[gidx][1]) + (pv[gidx][2] + pv[gidx][3]); t += __shfl_xor(t, 16); t += __shfl_xor(t, 32); rsc[gidx] = rsqrtf(t * (1.0f / 1024.0f) + EPS) * cs; }
        } else {
            const float* rs = (const float*)(ws + (mode == 0 ? WS_RSTD0 : WS_RSTDM));
#pragma unroll
            for (int gidx = 0; gidx < 8; ++gidx) rsc[gidx] = rs[row0 + (gidx >> 2) * HALF + (gidx & 3) * 16];
        }
        if (mode == 0) {
            float* lf = (float*)(ws + WS_LF); bf16_t* kh = (bf16_t*)(ws + WS_KH);
            const int sub = u.pn >> 1; const int cb = (u.pn & 1) * 256 + colL;
            if (sub == 1) {
                float oml[2][8];
#pragma unroll
                for (int bj = 0; bj < 2; ++bj)
#pragma unroll
                    for (int j = 0; j < 8; ++j) { const int c = cb + bj * HALF + j; const float l0 = lbl[c], l1 = lbl[512 + c]; const float lb = 1.0f / (1.0f + __expf(l1 - l0)); oml[bj][j] = 1.0f - lb; }
#pragma unroll
                for (int ai = 0; ai < 2; ++ai)
#pragma unroll
                    for (int m = 0; m < 4; ++m) { const int row = row0 + ai * HALF + m * 16; const float r = rsc[ai * 4 + m];
#pragma unroll
                        for (int bj = 0; bj < 2; ++bj) { f32x4 lf0, lf1, k0, k1;
#pragma unroll
                            for (int j = 0; j < 4; ++j) {
                                const float za = acc[ai][bj][m][0][j] * r, zb = acc[ai][bj][m][1][j] * r;
                                const float ka = oml[bj][j] * (1.0f - sigmoidf_(za)), kb = oml[bj][4 + j] * (1.0f - sigmoidf_(zb));
                                k0[j] = ka; k1[j] = kb; lf0[j] = __logf(1.0f - ka); lf1[j] = __logf(1.0f - kb); }
                            const size_t o = (size_t)row * 512 + cb + bj * HALF;
                            *(f32x4*)(lf + o) = lf0; *(f32x4*)(lf + o + 4) = lf1; store8(kh + o, k0, k1); } }
            } else {
                bf16_t* dst = (bf16_t*)(ws + (sub == 0 ? WS_QH : (sub == 2 ? WS_VH : (sub == 3 ? WS_GH : WS_PH))));
                const bool act = (sub == 0) || (sub == 3);
#pragma unroll
                for (int ai = 0; ai < 2; ++ai)
#pragma unroll
                    for (int m = 0; m < 4; ++m) { const int row = row0 + ai * HALF + m * 16; const float r = rsc[ai * 4 + m];
#pragma unroll
                        for (int bj = 0; bj < 2; ++bj) { f32x4 v0 = acc[ai][bj][m][0] * r, v1 = acc[ai][bj][m][1] * r;
                            if (act) {
#pragma unroll
                                for (int j = 0; j < 4; ++j) { v0[j] = v0[j] * sigmoidf_(v0[j]); v1[j] = v1[j] * sigmoidf_(v1[j]); } }
                            store8(dst + (size_t)row * 512 + cb + bj * HALF, v0, v1); } }
            }
        } else {
            const int col0 = u.pn * BM + colL;
            bf16_t* ob = (bf16_t*)(ws + (mode == 1 ? WS_KX : (mode == 4 ? WS_XQ : WS_U))); const int ldo = mode == 5 ? DFF : 1024;
#pragma unroll
            for (int ai = 0; ai < 2; ++ai)
#pragma unroll
                for (int m = 0; m < 4; ++m) { const int row = row0 + ai * HALF + m * 16; const float r = rsc[ai * 4 + m];
#pragma unroll
                    for (int bj = 0; bj < 2; ++bj) { f32x4 v0 = acc[ai][bj][m][0] * r, v1 = acc[ai][bj][m][1] * r;
                        if (mode == 5) {
#pragma unroll
                            for (int j = 0; j < 4; ++j) { const float a = fmaxf(v0[j], 0.f), b = fmaxf(v1[j], 0.f); v0[j] = a * a; v1[j] = b * b; } }
                        store8(ob + (size_t)row * ldo + col0 + bj * HALF, v0, v1); } }
        }
    }
};

template <class EpiT, class Sched>
__device__ __forceinline__ void gemm_phase(LAS unsigned char* lds, const Gemm g, const Sched S, const EpiT E) {
    const int tid = threadIdx.x, wid = __builtin_amdgcn_readfirstlane(tid >> 6), lane = tid & 63, wr = wid >> 2, wc = wid & 3, fr = lane & 15, fq = lane >> 4;
    const int K = g.K, nt = K / BK;
    unsigned voffA[2], voffB[2];
#pragma unroll
    for (int i = 0; i < 2; ++i) { int R, C; stage_rc(tid * 16 + i * 8192, R, C); const int Rb = EpiT::PERM ? ((R & ~31) + perm32(R & 31)) : R;
        voffA[i] = (unsigned)(R * K + C) * 2u; voffB[i] = (unsigned)(Rb * K + C) * 2u; }
    const size_t kstep = (size_t)(BK * 2);
    const size_t hstep = (size_t)HALF * K * 2;
    const size_t tstep = 2 * hstep;
    const unsigned ldsw = (unsigned)wid * 1024u;
    const int aoff = lds_byte(wr * 64 + fr, fq * 8), boff = lds_byte(wc * 32 + fr, fq * 8);
#define PG8_SA(b, h) (((b) * 2 + (h)) * HTB)
#define PG8_SB(b, h) ((4 + (b) * 2 + (h)) * HTB)
#define PG8_STAGE(bufoff, gbase, voff) do { _Pragma("unroll") for (int _i = 0; _i < 2; ++_i) \
        __builtin_amdgcn_global_load_lds((const unsigned*)((const char*)(gbase) + (voff)[_i]), (LAS unsigned*)(lds + (bufoff) + ldsw + _i * 8192), 16, 0, 0); } while (0)
#define PG8_LDA(dst, b, h) do { _Pragma("unroll") for (int m = 0; m < 4; ++m) _Pragma("unroll") for (int k = 0; k < 2; ++k) dst[m][k] = *(const LAS bf16x8*)(lds + PG8_SA(b, h) + aoff + m * 2048 + k * 1024); } while (0)
#define PG8_LDB(dst, b, h) do { _Pragma("unroll") for (int n = 0; n < 2; ++n) _Pragma("unroll") for (int k = 0; k < 2; ++k) dst[n][k] = *(const LAS bf16x8*)(lds + PG8_SB(b, h) + boff + n * 2048 + k * 1024); } while (0)
#define PG8_MMA(ai, bj, At, Bt) do { __builtin_amdgcn_s_setprio(1); _Pragma("unroll") for (int m = 0; m < 4; ++m) _Pragma("unroll") for (int n = 0; n < 2; ++n) _Pragma("unroll") for (int k = 0; k < 2; ++k) \
        acc[ai][bj][m][n] = __builtin_amdgcn_mfma_f32_16x16x32_bf16(Bt[n][k], At[m][k], acc[ai][bj][m][n], 0, 0, 0); __builtin_amdgcn_s_setprio(0); } while (0)
#define PG8_WAIT_V(n) asm volatile("s_waitcnt vmcnt(" #n ")" ::: "memory")
#define PG8_WAIT_L(n) asm volatile("s_waitcnt lgkmcnt(" #n ")" ::: "memory")
#define PG8_BAR __builtin_amdgcn_s_barrier()
#define PG8_SCHED __builtin_amdgcn_sched_barrier(0)
    Unit cur, nxt; int ui = 0;
    if (!S.next(0, cur)) return;
    const bool tab = E.prefill(lds, S);
    if (tab) __syncthreads();
    f32x4 acc[2][2][4][2];
#pragma unroll
    for (int a = 0; a < 2; ++a)
#pragma unroll
        for (int b = 0; b < 2; ++b)
#pragma unroll
            for (int m = 0; m < 4; ++m)
#pragma unroll
                for (int n = 0; n < 2; ++n) acc[a][b][m][n] = (f32x4){0.f, 0.f, 0.f, 0.f};
    bf16x8 At[4][2], B0[2][2], B1[2][2];
    const char* cA = (const char*)g.A + (size_t)cur.pm * tstep; const char* cB = (const char*)g.Bt + (size_t)cur.pn * tstep;
    PG8_STAGE(PG8_SB(0, 0), cB, voffB); PG8_STAGE(PG8_SA(0, 0), cA, voffA); PG8_STAGE(PG8_SB(0, 1), cB + hstep, voffB); PG8_STAGE(PG8_SA(0, 1), cA + hstep, voffA);
    if (wr == 1) PG8_BAR;
    PG8_WAIT_V(4); PG8_BAR;
    PG8_STAGE(PG8_SB(1, 0), cB + kstep, voffB); PG8_STAGE(PG8_SA(1, 0), cA + kstep, voffA); PG8_STAGE(PG8_SB(1, 1), cB + hstep + kstep, voffB);
    PG8_WAIT_V(6); PG8_BAR;
    for (;;) {
        const bool has_next = S.next(ui + 1, nxt);
        const char* nA = has_next ? (const char*)g.A + (size_t)nxt.pm * tstep : cA; const char* nB = has_next ? (const char*)g.Bt + (size_t)nxt.pn * tstep : cB;
        for (int t = 0; t < nt; t += 2) {
            const bool last = (t == nt - 2);
            const char* a1 = cA + (size_t)(t + 1) * kstep;
            const char* a2 = last ? nA : cA + (size_t)(t + 2) * kstep; const char* b2 = last ? nB : cB + (size_t)(t + 2) * kstep;
            const char* a3 = a2 + kstep; const char* b3 = b2 + kstep;
            PG8_LDB(B0, 0, 0); PG8_SCHED; PG8_LDA(At, 0, 0); PG8_STAGE(PG8_SA(1, 1), a1 + hstep, voffA);
            PG8_WAIT_L(8); PG8_BAR; PG8_WAIT_L(0); PG8_MMA(0, 0, At, B0); PG8_BAR; PG8_SCHED;
            PG8_LDB(B1, 0, 1); PG8_STAGE(PG8_SB(0, 0), b2, voffB);
            PG8_BAR; PG8_WAIT_L(0); PG8_MMA(0, 1, At, B1); PG8_BAR;
            PG8_LDA(At, 0, 1); PG8_STAGE(PG8_SA(0, 0), a2, voffA);
            PG8_BAR; PG8_WAIT_L(0); PG8_MMA(1, 0, At, B0); PG8_BAR; PG8_SCHED;
            PG8_STAGE(PG8_SB(0, 1), b2 + hstep, voffB);
            PG8_WAIT_V(6); PG8_BAR; PG8_MMA(1, 1, At, B1); PG8_BAR;
            PG8_LDB(B0, 1, 0); PG8_SCHED; PG8_LDA(At, 1, 0); PG8_STAGE(PG8_SA(0, 1), a2 + hstep, voffA);
            PG8_WAIT_L(8); PG8_BAR; PG8_WAIT_L(0); PG8_MMA(0, 0, At, B0); PG8_BAR; PG8_SCHED;
            PG8_LDB(B1, 1, 1); PG8_STAGE(PG8_SB(1, 0), b3, voffB);
            PG8_BAR; PG8_WAIT_L(0); PG8_MMA(0, 1, At, B1); PG8_BAR;
            PG8_LDA(At, 1, 1); PG8_STAGE(PG8_SA(1, 0), a3, voffA);
            PG8_BAR; PG8_WAIT_L(0); PG8_MMA(1, 0, At, B0); PG8_BAR; PG8_SCHED;
            PG8_STAGE(PG8_SB(1, 1), b3 + hstep, voffB);
            PG8_WAIT_V(6); PG8_BAR; PG8_MMA(1, 1, At, B1); PG8_BAR;
        }
        if (E.mode != 8) E(acc, cur, ui, tab, lds, wr, wc, fr, fq);
        if (!has_next) break;
#pragma unroll
        for (int a = 0; a < 2; ++a)
#pragma unroll
            for (int b = 0; b < 2; ++b)
#pragma unroll
                for (int m = 0; m < 4; ++m)
#pragma unroll
                    for (int n = 0; n < 2; ++n) acc[a][b][m][n] = (f32x4){0.f, 0.f, 0.f, 0.f};
        cur = nxt; cA = nA; cB = nB; ++ui;
    }
    PG8_WAIT_V(0);
    if (wr == 0) PG8_BAR;
    PG8_BAR;
    if (E.mode == 8) E.fused(acc, cur, wr, wc, fr, fq);
#undef PG8_SA
#undef PG8_SB
#undef PG8_STAGE
#undef PG8_LDA
#undef PG8_LDB
#undef PG8_MMA
#undef PG8_WAIT_V
#undef PG8_WAIT_L
#undef PG8_BAR
#undef PG8_SCHED
}
}

struct Params {
    const float *x, *mem, *norm_mix_g, *w_in, *lb_logits, *hgrn_norm_g, *w_pool, *pool_scale, *w_out, *norm_x_g, *norm_mem_g, *w_xq, *w_xk, *w_xv, *w_xo, *norm_ffn_g, *w_ff1, *w_ff2, *final_norm_g;
    float* out; unsigned char* ws;
    int ph_lo, ph_hi;
};

struct TD { const float* W; const float* g; bf16_t* out; int N, ldo, kt, nt; };
__device__ __forceinline__ TD tile_desc(const Params& p, int t) {
    unsigned char* ws = p.ws; TD d;
    if (t < 320)       { d.W = p.w_in;  d.g = p.norm_mix_g; d.out = (bf16_t*)(ws + WS_WT_IN);  d.N = NIN;  d.ldo = 1024; d.kt = t / 40; d.nt = t % 40; }
    else if (t < 448)  { const int u = t - 320;  d.W = p.w_xk;  d.g = p.norm_mem_g; d.out = (bf16_t*)(ws + WS_WT_K);   d.N = 1024; d.ldo = 1024; d.kt = u / 16; d.nt = u % 16; }
    else if (t < 576)  { const int u = t - 448;  d.W = p.w_xv;  d.g = p.norm_mem_g; d.out = (bf16_t*)(ws + WS_WT_V);   d.N = 1024; d.ldo = 1024; d.kt = u / 16; d.nt = u % 16; }
    else if (t < 704)  { const int u = t - 576;  d.W = p.w_xq;  d.g = p.norm_x_g;   d.out = (bf16_t*)(ws + WS_WT_Q);   d.N = 1024; d.ldo = 1024; d.kt = u / 16; d.nt = u % 16; }
    else if (t < 832)  { const int u = t - 704;  d.W = p.w_xo;  d.g = nullptr;      d.out = (bf16_t*)(ws + WS_WT_O);   d.N = 1024; d.ldo = 1024; d.kt = u / 16; d.nt = u % 16; }
    else if (t < 896)  { const int u = t - 832;  d.W = p.w_out; d.g = nullptr;      d.out = (bf16_t*)(ws + WS_WT_OUT); d.N = 1024; d.ldo = 1024; d.kt = u / 16; d.nt = u % 16; }
    else if (t < 1408) { const int u = t - 896;  d.W = p.w_ff1; d.g = p.norm_ffn_g; d.out = (bf16_t*)(ws + WS_WT_FF1); d.N = DFF;  d.ldo = 1024; d.kt = u / 64; d.nt = u % 64; }
    else               { const int u = t - 1408; d.W = p.w_ff2; d.g = nullptr;      d.out = (bf16_t*)(ws + WS_WT_FF2); d.N = 1024; d.ldo = 4096; d.kt = u / 16; d.nt = u % 16; }
    return d;
}
__device__ __forceinline__ void tile_load(const TD& d, f32x4 (&v)[4], float (&sc)[4]) {
    const int tid = threadIdx.x, r = tid >> 4, c4 = tid & 15;
#pragma unroll
    for (int i = 0; i < 4; ++i) { const int k = 128 * d.kt + r + 32 * i; v[i] = *(const f32x4*)(d.W + (size_t)k * d.N + 64 * d.nt + 4 * c4); sc[i] = d.g ? d.g[k] : 1.0f; }
}
__device__ __forceinline__ void transpose_range(const Params& p, unsigned char* lds, int t_begin, int t_end, int first, int stride) {
    bf16_t* T = (bf16_t*)lds;
    const int tid = threadIdx.x, r = tid >> 4, c4 = tid & 15, n = tid >> 3, ks = tid & 7;
    int t = t_begin + first;
    if (t >= t_end) return;
    TD d = tile_desc(p, t); f32x4 v[4]; float sc[4];
    tile_load(d, v, sc);
    for (;;) {
#pragma unroll
        for (int i = 0; i < 4; ++i) { const int kl = r + 32 * i;
            T[(4 * c4 + 0) * 136 + kl] = f2bf(v[i][0] * sc[i]); T[(4 * c4 + 1) * 136 + kl] = f2bf(v[i][1] * sc[i]);
            T[(4 * c4 + 2) * 136 + kl] = f2bf(v[i][2] * sc[i]); T[(4 * c4 + 3) * 136 + kl] = f2bf(v[i][3] * sc[i]); }
        __syncthreads();
        const int tn = t + stride; TD dn = d;
        if (tn < t_end) { dn = tile_desc(p, tn); tile_load(dn, v, sc); }
        const u32x4* src = (const u32x4*)(T + n * 136 + 16 * ks);
        const u32x4 a = src[0], b = src[1];
        u32x4* dst = (u32x4*)(d.out + (size_t)(64 * d.nt + n) * d.ldo + 128 * d.kt + 16 * ks);
        dst[0] = a; dst[1] = b;
        __syncthreads();
        if (tn >= t_end) break;
        t = tn; d = dn;
    }
}
__device__ __forceinline__ void fold_pool_weights(const Params& p, int first, int stride) {
    bf16_t* wto = (bf16_t*)(p.ws + WS_WT_OUT);
    for (int item = first; item < 131072; item += stride) {
        const int n = item & 1023, cgp = item >> 10, gi = cgp >> 5, c0 = (cgp & 31) * 4;
        float a[4];
#pragma unroll
        for (int j = 0; j < 4; ++j) a[j] = 0.f;
        const float* wp = p.w_pool + (size_t)(gi * 128 + c0) * 128;
        const float* wo_p = p.w_out + (size_t)(512 + gi * 128) * 1024 + n;
        const float* ps = p.pool_scale + gi * 128;
#pragma unroll 8
        for (int d = 0; d < 128; ++d) {
            const float wo = wo_p[(size_t)d * 1024] * ps[d];
#pragma unroll
            for (int j = 0; j < 4; ++j) a[j] += wp[j * 128 + d] * wo;
        }
        u32x2 w; w.x = cvt_pk_bf16(a[0], a[1]); w.y = cvt_pk_bf16(a[2], a[3]);
        *(u32x2*)(wto + (size_t)n * 1024 + 512 + gi * 128 + c0) = w;
    }
}

__device__ __forceinline__ void phase_prep(const Params p, unsigned char* lds) {
    unsigned char* ws = p.ws;
    const int G = gridDim.x;
    {
        const int lane = threadIdx.x & 63, gw = blockIdx.x * (NTHREADS / 64) + (threadIdx.x >> 6), nw = G * (NTHREADS / 64);
        int r = gw;
        f32x4 v[4], vn[4];
        if (r < MROWS + MEMROWS) { const float* src = r < MROWS ? p.x + (size_t)r * DM : p.mem + (size_t)(r - MROWS) * DM;
#pragma unroll
            for (int i = 0; i < 4; ++i) v[i] = ((const f32x4*)src)[lane + 64 * i]; }
        for (; r < MROWS + MEMROWS; r += nw) {
            const int rn = r + nw;
            if (rn < MROWS + MEMROWS) { const float* src = rn < MROWS ? p.x + (size_t)rn * DM : p.mem + (size_t)(rn - MROWS) * DM;
#pragma unroll
                for (int i = 0; i < 4; ++i) vn[i] = ((const f32x4*)src)[lane + 64 * i]; }
            const bool isx = r < MROWS;
            bf16_t* dst = isx ? (bf16_t*)(ws + WS_XB) + (size_t)r * DM : (bf16_t*)(ws + WS_MEMB) + (size_t)(r - MROWS) * DM;
            float ss = 0.f;
#pragma unroll
            for (int i = 0; i < 4; ++i) ss += (v[i][0] * v[i][0] + v[i][1] * v[i][1]) + (v[i][2] * v[i][2] + v[i][3] * v[i][3]);
#pragma unroll
            for (int o = 1; o < 64; o <<= 1) ss += __shfl_xor(ss, o);
#pragma unroll
            for (int i = 0; i < 4; ++i) { u32x2 w; w.x = cvt_pk_bf16(v[i][0], v[i][1]); w.y = cvt_pk_bf16(v[i][2], v[i][3]); ((u32x2*)dst)[lane + 64 * i] = w; }
            if (lane == 0) { const float rstd = rsqrtf(ss * (1.0f / 1024.0f) + EPS); if (isx) ((float*)(ws + WS_RSTD0))[r] = rstd; else ((float*)(ws + WS_RSTDM))[r - MROWS] = rstd; }
#pragma unroll
            for (int i = 0; i < 4; ++i) v[i] = vn[i];
        }
    }
    transpose_range(p, lds, 0, 576, blockIdx.x, G);
}
__device__ __forceinline__ void deferred_prep(const Params p, unsigned char* lds, int j, int nworkers) {
    transpose_range(p, lds, 576, 1920, j, nworkers);
    fold_pool_weights(p, j * NTHREADS + threadIdx.x, nworkers * NTHREADS);
}

__device__ __forceinline__ void phase_passA(const bf16_t* __restrict__ KH, const float* __restrict__ LF, const bf16_t* __restrict__ VH, bf16_t* __restrict__ LT, float* __restrict__ DEC, unsigned char* lds) {
    const int tid = threadIdx.x, ch = tid & 127, seg = tid >> 7, G = gridDim.x;
    float* segtot = (float*)lds;
    unsigned char* KdT = lds + 2048;
    unsigned char* VTl = lds + 2048 + 18432;
    const int w = tid >> 6, lane = tid & 63, fr = lane & 15, q = lane >> 4;
    float lf[16]; unsigned kr[16], vr[16];
    int unit = blockIdx.x;
    if (unit < 1024) { const int b = unit >> 8, c = (unit >> 2) & 63, h = unit & 3; const size_t g0 = (size_t)(b * SEQ + c * 64 + seg * 16) * 512 + h * 128 + ch;
#pragma unroll
        for (int i = 0; i < 16; ++i) { lf[i] = LF[g0 + (size_t)i * 512]; kr[i] = KH[g0 + (size_t)i * 512]; vr[i] = VH[g0 + (size_t)i * 512]; } }
    for (; unit < 1024; unit += G) {
        const int b = unit >> 8, c = (unit >> 2) & 63, h = unit & 3, bh = b * 4 + h;
#pragma unroll
        for (int i = 1; i < 16; ++i) lf[i] += lf[i - 1];
        segtot[seg * 128 + ch] = lf[15];
        __syncthreads();
        float after = 0.f;
#pragma unroll
        for (int s2 = 1; s2 < 4; ++s2) if (s2 > seg) after += segtot[s2 * 128 + ch];
        const float tot = after + lf[15];
        if (seg == 0) DEC[(size_t)(bh * 64 + c) * 128 + ch] = __expf(tot);
        unsigned kd[8], vp[8];
#pragma unroll
        for (int i = 0; i < 8; ++i) {
            kd[i] = cvt_pk_bf16(bflo(kr[2 * i]) * __expf(tot - lf[2 * i]), bflo(kr[2 * i + 1]) * __expf(tot - lf[2 * i + 1]));
            vp[i] = vr[2 * i] | (vr[2 * i + 1] << 16);
        }
        { u32x4* d = (u32x4*)(KdT + ch * 144 + seg * 32); d[0] = (u32x4){kd[0], kd[1], kd[2], kd[3]}; d[1] = (u32x4){kd[4], kd[5], kd[6], kd[7]}; }
        { u32x4* d = (u32x4*)(VTl + ch * 144 + seg * 32); d[0] = (u32x4){vp[0], vp[1], vp[2], vp[3]}; d[1] = (u32x4){vp[4], vp[5], vp[6], vp[7]}; }
        __syncthreads();
        {
            const int un = unit + G;
            if (un < 1024) { const int b2 = un >> 8, c2 = (un >> 2) & 63, h2 = un & 3; const size_t g0 = (size_t)(b2 * SEQ + c2 * 64 + seg * 16) * 512 + h2 * 128 + ch;
#pragma unroll
                for (int i = 0; i < 16; ++i) { lf[i] = LF[g0 + (size_t)i * 512]; kr[i] = KH[g0 + (size_t)i * 512]; vr[i] = VH[g0 + (size_t)i * 512]; } }
        }
        bf16x8 a[2];
#pragma unroll
        for (int ks = 0; ks < 2; ++ks) a[ks] = *(const bf16x8*)(KdT + (16 * w + fr) * 144 + (32 * ks + 8 * q) * 2);
        bf16_t* ltp = LT + (size_t)(bh * 64 + c) * 16384;
#pragma unroll
        for (int vb = 0; vb < 8; ++vb) {
            f32x4 acc = (f32x4){0.f, 0.f, 0.f, 0.f};
#pragma unroll
            for (int ks = 0; ks < 2; ++ks) { const bf16x8 bfr = *(const bf16x8*)(VTl + (16 * vb + fr) * 144 + (32 * ks + 8 * q) * 2); acc = mfma16(a[ks], bfr, acc); }
            u32x2 pk; pk.x = cvt_pk_bf16(acc[0], acc[1]); pk.y = cvt_pk_bf16(acc[2], acc[3]);
            *(u32x2*)(ltp + (size_t)(16 * vb + fr) * 128 + 16 * w + 4 * q) = pk;
        }
        __syncthreads();
    }
}

template <int W>
__device__ __forceinline__ void pool_body(const bf16_t* __restrict__ PH, bf16_t* __restrict__ MIXED, int r0, int s0, int c0) {
    unsigned v[31 + W];
#pragma unroll
    for (int j = 1; j < W; ++j) v[W - 1 - j] = (s0 - j >= 0) ? *(const unsigned*)(PH + (size_t)(r0 - j) * 512 + c0) : 0u;
#pragma unroll
    for (int tt = 0; tt < 32; ++tt) v[W - 1 + tt] = *(const unsigned*)(PH + (size_t)(r0 + tt) * 512 + c0);
    float sx = 0.f, sy = 0.f;
#pragma unroll
    for (int j = 1; j < W; ++j) { sx += bflo(v[W - 1 - j]); sy += bfhi(v[W - 1 - j]); }
#pragma unroll
    for (int tt = 0; tt < 32; ++tt) {
        const int s = s0 + tt;
        const float px = bflo(v[W - 1 + tt]), py = bfhi(v[W - 1 + tt]);
        sx += px; sy += py;
        const int cnt = (s + 1) < W ? (s + 1) : W;
        const float inv = 1.0f / (float)cnt;
        *(unsigned*)(MIXED + (size_t)(r0 + tt) * 1024 + 512 + c0) = cvt_pk_bf16(sx * inv - px, sy * inv - py);
        sx -= bflo(v[tt]); sy -= bfhi(v[tt]);
    }
}
__device__ __forceinline__ void pool_tile(const bf16_t* __restrict__ PH, bf16_t* __restrict__ MIXED, int tile) {
    const int tid = threadIdx.x, cp = tid & 255, th = tid >> 8, c0 = 2 * cp, gi = c0 >> 7;
    const int r0 = tile * 64 + th * 32, s0 = r0 & (SEQ - 1);
    if (gi == 0) pool_body<2>(PH, MIXED, r0, s0, c0);
    else if (gi == 1) pool_body<4>(PH, MIXED, r0, s0, c0);
    else if (gi == 2) pool_body<8>(PH, MIXED, r0, s0, c0);
    else pool_body<16>(PH, MIXED, r0, s0, c0);
}

__device__ __forceinline__ void phase_scan(const bf16_t* LT, const float* __restrict__ DEC, bf16_t* ST) {
    for (int e2 = blockIdx.x * NTHREADS + threadIdx.x; e2 < 131072; e2 += gridDim.x * NTHREADS) {
        const int bh = e2 >> 13, v = (e2 >> 6) & 127, kp = e2 & 63;
        float sx = 0.f, sy = 0.f;
        const size_t base = (size_t)bh * 64 * 16384 + (size_t)v * 128 + 2 * kp;
        const float* dp = DEC + (size_t)bh * 64 * 128 + 2 * kp;
        for (int c0 = 0; c0 < 64; c0 += 32) {
            unsigned l[32]; f32x2 d[32];
#pragma unroll
            for (int j = 0; j < 32; ++j) { l[j] = *(const unsigned*)(LT + base + (size_t)(c0 + j) * 16384); d[j] = *(const f32x2*)(dp + (c0 + j) * 128); }
#pragma unroll
            for (int j = 0; j < 32; ++j) {
                *(unsigned*)(ST + base + (size_t)(c0 + j) * 16384) = cvt_pk_bf16(sx, sy);
                sx = d[j][0] * sx + bflo(l[j]); sy = d[j][1] * sy + bfhi(l[j]);
            }
        }
    }
}

__device__ __forceinline__ void phase_passC(const bf16_t* __restrict__ QH, const bf16_t* __restrict__ KH, const float* __restrict__ LF, const bf16_t* __restrict__ VH, const bf16_t* __restrict__ GH,
                                const bf16_t* __restrict__ ST, const float* __restrict__ hg, bf16_t* __restrict__ MIXED, unsigned char* lds) {
    const int tid = threadIdx.x, ch = tid & 127, seg = tid >> 7, G = gridDim.x;
    float lf[16]; unsigned qr[16], kr[16], vr[16];
    int unit = blockIdx.x;
    if (unit < 1024) { const int b = unit >> 8, c = (unit >> 2) & 63, h = unit & 3; const size_t g0 = (size_t)(b * SEQ + c * 64 + seg * 16) * 512 + h * 128 + ch;
#pragma unroll
        for (int i = 0; i < 16; ++i) { lf[i] = LF[g0 + (size_t)i * 512]; vr[i] = VH[g0 + (size_t)i * 512]; qr[i] = QH[g0 + (size_t)i * 512]; kr[i] = KH[g0 + (size_t)i * 512]; } }
  for (; unit < 1024; unit += G) {
    const int b = unit >> 8, c = (unit >> 2) & 63, h = unit & 3;
    const int row0 = b * SEQ + c * 64, bh = b * 4 + h;
    float* segtot = (float*)lds;
    float* rmsp = (float*)(lds + 2048);
    bf16_t* QC = (bf16_t*)(lds + 4096);
    bf16_t* QT = (bf16_t*)(lds + 21504);
    constexpr int KT0 = 38912;
    unsigned char* VTl = lds + 82432;
    const int w = tid >> 6, lane = tid & 63, fr = lane & 15, q = lane >> 4;
    const int i = w & 3, vh = w >> 2;
    const size_t row = (size_t)(row0 + 16 * i + fr);
    u32x2 gt[4]; f32x4 gg[4]; bf16x8 stf[4][4];
    {
        const bf16_t* stp = ST + (size_t)(bh * 64 + c) * 16384;
#pragma unroll
        for (int vbl = 0; vbl < 4; ++vbl) { const int v0 = 16 * (vh * 4 + vbl) + 4 * q; gt[vbl] = *(const u32x2*)(GH + row * 512 + h * 128 + v0); gg[vbl] = *(const f32x4*)(hg + h * 128 + v0);
#pragma unroll
            for (int ks = 0; ks < 4; ++ks) stf[ks][vbl] = *(const bf16x8*)(stp + (size_t)(16 * (vh * 4 + vbl) + fr) * 128 + 32 * ks + 8 * q); }
    }
#pragma unroll
    for (int i2 = 1; i2 < 16; ++i2) lf[i2] += lf[i2 - 1];
    segtot[seg * 128 + ch] = lf[15];
    {
        unsigned vp[8];
#pragma unroll
        for (int i2 = 0; i2 < 8; ++i2) vp[i2] = vr[2 * i2] | (vr[2 * i2 + 1] << 16);
        u32x4* d = (u32x4*)(VTl + ch * 144 + seg * 32); d[0] = (u32x4){vp[0], vp[1], vp[2], vp[3]}; d[1] = (u32x4){vp[4], vp[5], vp[6], vp[7]};
    }
    __syncthreads();
    const float t0 = segtot[ch], t1 = segtot[128 + ch], t2 = segtot[256 + ch];
    const float P = (seg > 0 ? t0 : 0.f) + (seg > 1 ? t1 : 0.f) + (seg > 2 ? t2 : 0.f);
    {
        const float eP = __expf(P);
#pragma unroll
        for (int i2 = 0; i2 < 16; ++i2) {
            const float qv = bflo(qr[i2]);
            const float el = __expf(lf[i2]);
            QT[(seg * 16 + i2) * 136 + ch] = f2bf(qv * el);
            QC[(seg * 16 + i2) * 136 + ch] = f2bf(qv * el * eP);
        }
        float E = 0.f;
#pragma unroll
        for (int i2 = 0; i2 < 4; ++i2) {
            if (i2 >= seg) {
                bf16_t* KT = (bf16_t*)(lds + KT0 + 4352 * ((i2 * (i2 + 1)) / 2));
#pragma unroll
                for (int j = 0; j < 16; ++j) KT[(seg * 16 + j) * 136 + ch] = f2bf(bflo(kr[j]) * __expf(E - lf[j]));
                E += (i2 == 0 ? t0 : (i2 == 1 ? t1 : t2));
            }
        }
    }
    __syncthreads();
    {
        const int un = unit + G;
        if (un < 1024) { const int b2 = un >> 8, c2 = (un >> 2) & 63, h2 = un & 3; const size_t g2 = (size_t)(b2 * SEQ + c2 * 64 + seg * 16) * 512 + h2 * 128 + ch;
#pragma unroll
            for (int i2 = 0; i2 < 16; ++i2) { lf[i2] = LF[g2 + (size_t)i2 * 512]; vr[i2] = VH[g2 + (size_t)i2 * 512]; qr[i2] = QH[g2 + (size_t)i2 * 512]; kr[i2] = KH[g2 + (size_t)i2 * 512]; } }
    }
    f32x4 sT[4];
#pragma unroll
    for (int j = 0; j < 4; ++j) sT[j] = (f32x4){0.f, 0.f, 0.f, 0.f};
    {
        bf16x8 qfr[4];
#pragma unroll
        for (int ks = 0; ks < 4; ++ks) qfr[ks] = *(const bf16x8*)((const unsigned char*)QT + (16 * i + fr) * 272 + (32 * ks + 8 * q) * 2);
        const unsigned char* KT = lds + KT0 + 4352 * ((i * (i + 1)) / 2);
#pragma unroll
        for (int j = 0; j < 4; ++j) if (j <= i) {
#pragma unroll
            for (int ks = 0; ks < 4; ++ks) { const bf16x8 a = *(const bf16x8*)(KT + (16 * j + fr) * 272 + (32 * ks + 8 * q) * 2); sT[j] = mfma16(a, qfr[ks], sT[j]); }
            if (j == i) {
#pragma unroll
                for (int rg = 0; rg < 4; ++rg) if (4 * q + rg > fr) sT[j][rg] = 0.f;
            }
        }
    }
    f32x4 oacc[4];
#pragma unroll
    for (int vbl = 0; vbl < 4; ++vbl) oacc[vbl] = (f32x4){0.f, 0.f, 0.f, 0.f};
#pragma unroll
    for (int m = 0; m < 2; ++m) if (2 * m <= i) {
        const bf16x8 bfrag = mk8u(cvt_pk_bf16(sT[2 * m][0], sT[2 * m][1]), cvt_pk_bf16(sT[2 * m][2], sT[2 * m][3]), cvt_pk_bf16(sT[2 * m + 1][0], sT[2 * m + 1][1]), cvt_pk_bf16(sT[2 * m + 1][2], sT[2 * m + 1][3]));
#pragma unroll
        for (int vbl = 0; vbl < 4; ++vbl) {
            const unsigned char* base = VTl + (16 * (vh * 4 + vbl) + fr) * 144 + (32 * m + 4 * q) * 2;
            const bf16x8 a = mk8(*(const u32x2*)base, *(const u32x2*)(base + 32));
            oacc[vbl] = mfma16(a, bfrag, oacc[vbl]);
        }
    }
    {
#pragma unroll
        for (int ks = 0; ks < 4; ++ks) {
            const bf16x8 bfr = *(const bf16x8*)((const unsigned char*)QC + (16 * i + fr) * 272 + (32 * ks + 8 * q) * 2);
#pragma unroll
            for (int vbl = 0; vbl < 4; ++vbl) oacc[vbl] = mfma16(stf[ks][vbl], bfr, oacc[vbl]);
        }
    }
    float ss = 0.f;
#pragma unroll
    for (int vbl = 0; vbl < 4; ++vbl) ss += (oacc[vbl][0] * oacc[vbl][0] + oacc[vbl][1] * oacc[vbl][1]) + (oacc[vbl][2] * oacc[vbl][2] + oacc[vbl][3] * oacc[vbl][3]);
    ss += __shfl_xor(ss, 16); ss += __shfl_xor(ss, 32);
    if (q == 0) rmsp[vh * 64 + 16 * i + fr] = ss;
    __syncthreads();
    const float rstd = rsqrtf((rmsp[16 * i + fr] + rmsp[64 + 16 * i + fr]) * (1.0f / 128.0f) + EPS);
#pragma unroll
    for (int vbl = 0; vbl < 4; ++vbl) {
        const int v0 = 16 * (vh * 4 + vbl) + 4 * q;
        u32x2 o;
        o.x = cvt_pk_bf16(oacc[vbl][0] * rstd * gg[vbl][0] * bflo(gt[vbl].x), oacc[vbl][1] * rstd * gg[vbl][1] * bfhi(gt[vbl].x));
        o.y = cvt_pk_bf16(oacc[vbl][2] * rstd * gg[vbl][2] * bflo(gt[vbl].y), oacc[vbl][3] * rstd * gg[vbl][3] * bfhi(gt[vbl].y));
        *(u32x2*)(MIXED + row * 1024 + h * 128 + v0) = o;
    }
    __syncthreads();
  }
}

__device__ __forceinline__ void attn_unit(const bf16_t* __restrict__ XQ, const bf16_t* __restrict__ KX, const bf16_t* __restrict__ VT, bf16_t* __restrict__ ATT, int unit, unsigned char* lds) {
    const int tid = threadIdx.x, w = tid >> 6, lane = tid & 63, r = lane & 31, hh = lane >> 5;
    const int b = unit >> 6, st = (unit >> 2) & 15, h = unit & 3;
    const int row0 = b * SEQ + st * 256;
    const bf16_t* qp = XQ + (size_t)(row0 + 32 * w + r) * 1024 + h * 256 + 8 * hh;
    {
        const bf16_t* kp = KX + (size_t)(b * 256) * 1024 + h * 256;
#pragma unroll
        for (int it = 0; it < 16; ++it) { const int idx = tid + 512 * it, m = idx >> 5, cc = idx & 31;
            const u32x4 v = *(const u32x4*)(kp + (size_t)m * 1024 + cc * 8); *(u32x4*)(lds + m * 528 + cc * 16) = v; }
    }
    __syncthreads();
    f32x16 sacc[8];
#pragma unroll
    for (int mb = 0; mb < 8; ++mb)
#pragma unroll
        for (int e = 0; e < 16; ++e) sacc[mb][e] = 0.f;
    for (int kg = 0; kg < 4; ++kg) {
        bf16x8 qf[4];
#pragma unroll
        for (int k4 = 0; k4 < 4; ++k4) qf[k4] = *(const bf16x8*)(qp + 16 * (4 * kg + k4));
#pragma unroll
        for (int k4 = 0; k4 < 4; ++k4)
#pragma unroll
            for (int mb = 0; mb < 8; ++mb) { const bf16x8 a = *(const bf16x8*)(lds + (32 * mb + r) * 528 + (16 * (4 * kg + k4) + 8 * hh) * 2); sacc[mb] = mfma32(a, qf[k4], sacc[mb]); }
    }
    float mx = -3.0e38f;
#pragma unroll
    for (int mb = 0; mb < 8; ++mb)
#pragma unroll
        for (int e = 0; e < 16; ++e) mx = fmaxf(mx, sacc[mb][e]);
    mx = fmaxf(mx, __shfl_xor(mx, 32));
    float sum = 0.f;
    bf16x8 pf[8][2];
#pragma unroll
    for (int mb = 0; mb < 8; ++mb) {
        float pv[16];
#pragma unroll
        for (int e = 0; e < 16; ++e) { pv[e] = __expf(sacc[mb][e] - mx); sum += pv[e]; }
#pragma unroll
        for (int s = 0; s < 2; ++s) pf[mb][s] = mk8u(cvt_pk_bf16(pv[8 * s + 0], pv[8 * s + 1]), cvt_pk_bf16(pv[8 * s + 2], pv[8 * s + 3]), cvt_pk_bf16(pv[8 * s + 4], pv[8 * s + 5]), cvt_pk_bf16(pv[8 * s + 6], pv[8 * s + 7]));
    }
    sum += __shfl_xor(sum, 32);
    const float inv = 1.0f / sum;
    __syncthreads();
    {
        const bf16_t* vp = VT + (size_t)(h * 256) * 1024 + b * 256;
#pragma unroll
        for (int it = 0; it < 16; ++it) { const int idx = tid + 512 * it, e = idx >> 5, cc = idx & 31;
            const u32x4 v = *(const u32x4*)(vp + (size_t)e * 1024 + cc * 8);
            u32x2* d = (u32x2*)(lds + e * 520 + cc * 16); d[0] = (u32x2){v.x, v.y}; d[1] = (u32x2){v.z, v.w}; }
    }
    __syncthreads();
    bf16_t* op = ATT + (size_t)(row0 + 32 * w + r) * 1024 + h * 256 + 4 * hh;
#pragma unroll
    for (int half = 0; half < 2; ++half) {
        f32x16 oacc[4];
#pragma unroll
        for (int d = 0; d < 4; ++d)
#pragma unroll
            for (int e = 0; e < 16; ++e) oacc[d][e] = 0.f;
#pragma unroll
        for (int mb = 0; mb < 8; ++mb)
#pragma unroll
            for (int s = 0; s < 2; ++s)
#pragma unroll
                for (int d = 0; d < 4; ++d) {
                    const unsigned char* base = lds + (32 * (half * 4 + d) + r) * 520 + (32 * mb + 16 * s + 4 * hh) * 2;
                    const bf16x8 a = mk8(*(const u32x2*)base, *(const u32x2*)(base + 16));
                    oacc[d] = mfma32(a, pf[mb][s], oacc[d]);
                }
#pragma unroll
        for (int d = 0; d < 4; ++d)
#pragma unroll
            for (int g = 0; g < 4; ++g) {
                u32x2 o; o.x = cvt_pk_bf16(oacc[d][4 * g] * inv, oacc[d][4 * g + 1] * inv); o.y = cvt_pk_bf16(oacc[d][4 * g + 2] * inv, oacc[d][4 * g + 3] * inv);
                *(u32x2*)(op + 32 * (half * 4 + d) + 8 * g) = o;
            }
    }
    __syncthreads();
}

__device__ __forceinline__ void phase_final(const bf16_t* __restrict__ xb, const float* __restrict__ ssq, float* __restrict__ out, const float* __restrict__ g) {
    const int tid = threadIdx.x, sub = tid >> 7, l = tid & 127;
    const f32x4 g0 = *(const f32x4*)(g + 8 * l), g1 = *(const f32x4*)(g + 8 * l + 4);
    for (int r = blockIdx.x * 4 + sub; r < MROWS; r += gridDim.x * 4) {
        const u32x4 v = *(const u32x4*)(xb + (size_t)r * DM + 8 * l);
        const f32x4* pp = (const f32x4*)(ssq + (size_t)r * 16); const f32x4 a = pp[0], b = pp[1], c = pp[2], d = pp[3];
        const float t = ((a[0] + a[1]) + (a[2] + a[3])) + ((b[0] + b[1]) + (b[2] + b[3])) + ((c[0] + c[1]) + (c[2] + c[3])) + ((d[0] + d[1]) + (d[2] + d[3]));
        const float rstd = rsqrtf(t * (1.0f / 1024.0f) + EPS);
        const f32x4 o0 = (f32x4){bflo(v.x), bfhi(v.x), bflo(v.y), bfhi(v.y)} * rstd * g0, o1 = (f32x4){bflo(v.z), bfhi(v.z), bflo(v.w), bfhi(v.w)} * rstd * g1;
        *(f32x4*)(out + (size_t)r * DM + 8 * l) = o0; *(f32x4*)(out + (size_t)r * DM + 8 * l + 4) = o1;
    }
}

#define XB_TMO      128
#define XB_XCNT(j)  (256  + 64 * (j))
#define XB_XSUB(j)  (1280 + 64 * (j))
#define XB_XGEN(j)  (2304 + 64 * (j))
#define XB_TOP      3328
#define XB_TOPGEN   3392
#define XCD_BAR_WORDS 3456
#define XB_SPIN_CAP (1u << 22)
__device__ __forceinline__ unsigned xb_ld(unsigned* p)              { return __hip_atomic_load(p, __ATOMIC_RELAXED, __HIP_MEMORY_SCOPE_AGENT); }
__device__ __forceinline__ unsigned xb_add(unsigned* p, unsigned v) { return __hip_atomic_fetch_add(p, v, __ATOMIC_RELAXED, __HIP_MEMORY_SCOPE_AGENT); }
__device__ __forceinline__ unsigned xb_xcc_id() { return (unsigned)__builtin_amdgcn_s_getreg((3 << 11) | 20) & 0xFu; }
#define XB_SPIN(cond, bar) do { unsigned _sp = 0; while (cond) { __builtin_amdgcn_s_sleep(1); \
    if ((++_sp & 255u) == 0u) { if (xb_ld(&(bar)[XB_TMO])) break; if (_sp > XB_SPIN_CAP) { atomicAdd(&(bar)[XB_TMO], 1u); break; } } } } while (0)
struct XcdBarrier { unsigned* bar; unsigned x; volatile LAS unsigned* st; };
__device__ __forceinline__ XcdBarrier xcd_barrier_post(unsigned* bar, volatile LAS unsigned* st) {
    XcdBarrier b; b.bar = bar; b.x = xb_xcc_id(); b.st = st;
    if (threadIdx.x == 0) (void)xb_add(&bar[XB_XCNT(b.x)], 1u);
    return b;
}
__device__ __forceinline__ void xcd_barrier_complete(unsigned* bar, unsigned x, unsigned& nloc, unsigned& nx) {
    const unsigned G = gridDim.x * gridDim.y * gridDim.z;
    unsigned sum, cnt, mine, sp = 0u;
    for (;;) {
        sum = 0u; cnt = 0u; mine = 0u;
#pragma unroll
        for (unsigned j = 0; j < 16; ++j) { const unsigned c = xb_ld(&bar[XB_XCNT(j)]); sum += c; cnt += (c > 0u) ? 1u : 0u; mine = (j == x) ? c : mine; }
        if (sum == G) break;
        __builtin_amdgcn_s_sleep(1);
        if ((++sp & 255u) == 0u) { if (xb_ld(&bar[XB_TMO])) break; if (sp > XB_SPIN_CAP) { atomicAdd(&bar[XB_TMO], 1u); break; } }
    }
    nloc = mine > 0u ? mine : 1u; nx = cnt > 0u ? cnt : 1u;
}
__device__ __forceinline__ void xcd_barrier(const XcdBarrier& b) {
    asm volatile("s_waitcnt vmcnt(0)" ::: "memory");
    __syncthreads();
    if (threadIdx.x == 0) {
        unsigned* bar = b.bar;
        __builtin_amdgcn_s_waitcnt(0);
        unsigned nloc = b.st[0], nx = b.st[1];
        if (nloc == 0u) { xcd_barrier_complete(bar, b.x, nloc, nx); b.st[0] = nloc; b.st[1] = nx; }
        const unsigned old = xb_add(&bar[XB_XSUB(b.x)], 1u);
        const unsigned gen = old / nloc;
        if (old + 1u == (gen + 1u) * nloc) {
            __builtin_amdgcn_fence(__ATOMIC_RELEASE, "agent");
            asm volatile("s_waitcnt vmcnt(0)" ::: "memory");
            const unsigned og = xb_add(&bar[XB_TOP], 1u);
            const unsigned tg = og / nx;
            if (og + 1u == (tg + 1u) * nx) xb_add(&bar[XB_TOPGEN], 1u);
            else XB_SPIN(xb_ld(&bar[XB_TOPGEN]) == tg, bar);
            __builtin_amdgcn_fence(__ATOMIC_ACQUIRE, "agent");
            xb_add(&bar[XB_XGEN(b.x)], 1u);
            asm volatile("s_waitcnt vmcnt(0)" ::: "memory");
        } else {
            XB_SPIN(xb_ld(&bar[XB_XGEN(b.x)]) == gen, bar);
            __builtin_amdgcn_fence(__ATOMIC_ACQUIRE, "agent");
            asm volatile("s_waitcnt vmcnt(0)" ::: "memory");
        }
    }
    __syncthreads();
}

constexpr int N_PHASES = 12;
__global__ void __launch_bounds__(NTHREADS, 2) mega(Params p) {
    extern __shared__ __attribute__((aligned(16))) unsigned char lds[];
    LAS unsigned char* ldsl = (LAS unsigned char*)lds;
    unsigned char* ws = p.ws;
    const int G = gridDim.x, bid = blockIdx.x;
    const int lo = p.ph_lo, hi = p.ph_hi;

#ifndef DEFER_PREP
#define DEFER_PREP 0
#endif
#ifndef FUSE_FINAL
#define FUSE_FINAL 0
#endif
#ifndef DBG_LAST
#define DBG_LAST -1
#endif
#ifndef PHASE_MASK
#define PHASE_MASK 0xfff
#endif
#define IN(k) (((PHASE_MASK >> (k)) & 1) && lo <= (k) && (k) < hi)
    if (threadIdx.x == 0) { ((volatile LAS unsigned*)(ldsl + LDS_MAIN))[0] = 0u; ((volatile LAS unsigned*)(ldsl + LDS_MAIN))[1] = 0u; }
    __syncthreads();
    XcdBarrier xbar; xbar.bar = (unsigned*)(ws + WS_BAR); xbar.x = 0; xbar.st = nullptr;
    if (hi - lo > 1) xbar = xcd_barrier_post((unsigned*)(ws + WS_BAR), (volatile LAS unsigned*)(ldsl + LDS_MAIN));
    if (lo > hi) cg::this_grid().sync();
#define SEAM(k) do { if (IN(k) && IN((k) + 1)) { xcd_barrier(xbar); } } while (0)
    bf16_t* XB = (bf16_t*)(ws + WS_XB); bf16_t* LT = (bf16_t*)(ws + WS_ST);
    bf16_t* QH = (bf16_t*)(ws + WS_QH); bf16_t* KH = (bf16_t*)(ws + WS_KH); bf16_t* VH = (bf16_t*)(ws + WS_VH); bf16_t* GH = (bf16_t*)(ws + WS_GH); bf16_t* PH = (bf16_t*)(ws + WS_PH);
    float* LF = (float*)(ws + WS_LF); bf16_t* ST = (bf16_t*)(ws + WS_ST); bf16_t* MIXED = (bf16_t*)(ws + WS_MIXED);
    float* X1 = (float*)(ws + WS_X1); bf16_t* XQ = (bf16_t*)(ws + WS_XQ); bf16_t* ATT = (bf16_t*)(ws + WS_ATT); bf16_t* U = (bf16_t*)(ws + WS_U);
    float* SSQ = (float*)(ws + WS_SSQ); float* DEC = (float*)(ws + WS_DEC);
    bf16_t* MEMB = (bf16_t*)(ws + WS_MEMB); bf16_t* KX = (bf16_t*)(ws + WS_KX); bf16_t* VT = (bf16_t*)(ws + WS_VT);

    const bool fuse_final = FUSE_FINAL && (G == 256) && IN(10) && (hi - lo > 1);
    if (IN(0)) { phase_prep(p, lds);
#if !DEFER_PREP
        deferred_prep(p, lds, bid, G);
#endif
    }
    SEAM(0);
    if (IN(1)) {
        const pg8::Epi E{0, ws, p.x, p.out, p.lb_logits, p.final_norm_g};
        { pg8::Gemm g{XB, (const bf16_t*)(ws + WS_WT_IN), MROWS, NIN, DM}; pg8::StaticOrder S; S.init(MROWS, NIN, G, bid); pg8::gemm_phase(ldsl, g, S, E); }
        const pg8::Epi E1{1, ws, p.x, p.out, p.lb_logits, p.final_norm_g};
        { pg8::Gemm g{MEMB, (const bf16_t*)(ws + WS_WT_K), MEMROWS, 1024, DM}; pg8::StaticOrder S; S.init(MEMROWS, 1024, G, (bid + 128) % G); pg8::gemm_phase(ldsl, g, S, E1); }
        const pg8::Epi E2{2, ws, p.x, p.out, p.lb_logits, p.final_norm_g};
        { pg8::Gemm g{(const bf16_t*)(ws + WS_WT_V), MEMB, 1024, MEMROWS, DM}; pg8::StaticOrder S; S.init(1024, MEMROWS, G, (bid + 112) % G); pg8::gemm_phase(ldsl, g, S, E2); }
#if DEFER_PREP
        if (G == 256) { if (bid >= 160) deferred_prep(p, lds, bid - 160, 96); }
        else deferred_prep(p, lds, bid, G);
#endif
    }
    SEAM(1);
    if (IN(2)) {
#ifndef DBG_NO_PASSA
        phase_passA(KH, LF, VH, LT, DEC, lds);
#endif
#ifndef DBG_NO_POOL
        for (int t = bid; t < 256; t += G) pool_tile(PH, MIXED, t);
#endif
    }
    SEAM(2);
    if (IN(3)) { phase_scan(LT, DEC, ST); }
    SEAM(3);
    if (IN(4)) { phase_passC(QH, KH, LF, VH, GH, ST, p.hgrn_norm_g, MIXED, lds); }
    SEAM(4);
    if (IN(5)) {
        const pg8::Epi E{6, ws, p.x, p.out, p.lb_logits, p.final_norm_g};
        pg8::Gemm g{MIXED, (const bf16_t*)(ws + WS_WT_OUT), MROWS, DM, DM}; pg8::StaticOrder S; S.init(MROWS, DM, G, bid); pg8::gemm_phase(ldsl, g, S, E);
    }
    SEAM(5);
    const bool fuse_attn = (G == 256) && IN(6) && IN(7);
    if (IN(6)) {
        const pg8::Epi E{4, ws, p.x, p.out, p.lb_logits, p.final_norm_g};
        pg8::Gemm g{XB, (const bf16_t*)(ws + WS_WT_Q), MROWS, DM, DM}; pg8::StaticOrder S; S.init(MROWS, DM, G, bid); pg8::gemm_phase(ldsl, g, S, E);
        if (fuse_attn) {
            pg8::Unit u; S.next(0, u);
            asm volatile("s_waitcnt vmcnt(0)" ::: "memory"); __syncthreads();
            attn_unit(XQ, KX, VT, ATT, u.pm * 4 + u.pn, lds);
        }
    }
    if (!fuse_attn) {
        SEAM(6);
        if (IN(7)) { for (int u = bid; u < 256; u += G) attn_unit(XQ, KX, VT, ATT, u, lds); }
    }
    SEAM(7);
    if (IN(8)) {
        const pg8::Epi E{6, ws, p.x, p.out, p.lb_logits, p.final_norm_g};
        pg8::Gemm g{ATT, (const bf16_t*)(ws + WS_WT_O), MROWS, DM, DM}; pg8::StaticOrder S; S.init(MROWS, DM, G, bid); pg8::gemm_phase(ldsl, g, S, E);
    }
    SEAM(8);
    if (IN(9)) {
        const pg8::Epi E{5, ws, p.x, p.out, p.lb_logits, p.final_norm_g};
        pg8::Gemm g{XB, (const bf16_t*)(ws + WS_WT_FF1), MROWS, DFF, DM}; pg8::StaticOrder S; S.init(MROWS, DFF, G, bid); pg8::gemm_phase(ldsl, g, S, E);
    }
    SEAM(9);
    if (IN(10)) {
        const pg8::Epi E{fuse_final ? 8 : 7, ws, p.x, p.out, p.lb_logits, p.final_norm_g};
        pg8::Gemm g{U, (const bf16_t*)(ws + WS_WT_FF2), MROWS, DM, DFF}; pg8::StaticOrder S; S.init(MROWS, DM, G, bid); pg8::gemm_phase(ldsl, g, S, E);
    }
    if (!fuse_final) {
        SEAM(10);
        if (IN(11)) { phase_final(XB, SSQ, p.out, p.final_norm_g); }
    }
#if DBG_LAST >= 0
    cg::this_grid().sync();
    {
        const unsigned* w32 = (const unsigned*)ws;
        for (size_t i = (size_t)bid * NTHREADS + threadIdx.x; i < (size_t)MROWS * DM; i += (size_t)G * NTHREADS) {
            float a = 0.f;
            for (int j = 0; j < 4; ++j) { const unsigned v = w32[i + (size_t)j * MROWS * DM]; a += (float)(v & 0xffffu) + (float)(v >> 16); }
            p.out[i] = a;
        }
    }
#endif
#undef IN
#undef SEAM
}

extern "C" void kernel_launch(void* const* d_in, const int* in_sizes, int n_in, void* d_out, int out_size, void* d_ws, size_t ws_size, hipStream_t stream) {
    static int grid = 0;
    if (grid == 0) {
        if (n_in != 19 || in_sizes[0] != MROWS * DM || out_size != MROWS * DM || ws_size < WS_END) { fprintf(stderr, "kernel_launch: unexpected shapes (n_in %d, ws %zu)\n", n_in, ws_size); grid = -1; return; }
        int dev = 0, cus = 0, per_cu = 0;
        hipGetDevice(&dev); hipDeviceGetAttribute(&cus, hipDeviceAttributeMultiprocessorCount, dev);
        if (hipFuncSetAttribute((const void*)mega, hipFuncAttributeMaxDynamicSharedMemorySize, LDS_BYTES) != hipSuccess) { fprintf(stderr, "kernel_launch: hipFuncSetAttribute failed\n"); grid = -1; return; }
        if (hipOccupancyMaxActiveBlocksPerMultiprocessor(&per_cu, (const void*)mega, NTHREADS, LDS_BYTES) != hipSuccess || per_cu < 1) { fprintf(stderr, "kernel_launch: occupancy query says %d\n", per_cu); per_cu = 1; }
        (void)hipGetLastError();
        grid = cus * 1;
        if (grid > cus * per_cu) grid = cus * per_cu;
    }
    if (grid < 0) return;
    if (hipMemsetAsync((char*)d_ws + WS_BAR, 0, 32768, stream) != hipSuccess) { fprintf(stderr, "kernel_launch: memset of barrier words failed\n"); return; }
    Params p{};
    const float** f = (const float**)&p;
    for (int i = 0; i < 19; ++i) f[i] = (const float*)d_in[i];
    p.out = (float*)d_out; p.ws = (unsigned char*)d_ws;
#if N_LAUNCH_MODE == 1
    p.ph_lo = 0; p.ph_hi = (DBG_LAST >= 0) ? DBG_LAST + 1 : N_PHASES;
    void* args[] = {&p};
    hipError_t e = hipLaunchCooperativeKernel((const void*)mega, dim3(grid), dim3(NTHREADS), args, LDS_BYTES, stream);
    if (e != hipSuccess) fprintf(stderr, "kernel_launch: cooperative launch failed: %s (grid %d)\n", hipGetErrorString(e), grid);
#else
    for (int k = 0; k < N_PHASES; ++k) { p.ph_lo = k; p.ph_hi = k + 1; hipLaunchKernelGGL(mega, dim3(grid), dim3(NTHREADS), LDS_BYTES, stream, p); }
#endif
}
```

```cpp
#include <hip/hip_runtime.h>
#include <hip/hip_cooperative_groups.h>
#include <cstdio>
namespace cg = cooperative_groups;

#ifndef N_LAUNCH_MODE
#define N_LAUNCH_MODE 1
#endif

typedef unsigned short bf16_t;
typedef short bf16x8 __attribute__((ext_vector_type(8)));
typedef float f32x2 __attribute__((ext_vector_type(2)));
typedef float f32x4 __attribute__((ext_vector_type(4)));
typedef float f32x16 __attribute__((ext_vector_type(16)));
typedef unsigned u32x2 __attribute__((ext_vector_type(2)));
typedef unsigned u32x4 __attribute__((ext_vector_type(4)));
#define LAS __attribute__((address_space(3)))

constexpr int MROWS = 16384, DM = 1024, SEQ = 4096, NIN = 2560, DFF = 4096, MEMROWS = 1024;
constexpr float EPS = 1e-6f;
constexpr int NTHREADS = 512;
constexpr int LDS_MAIN = 135168;
constexpr int LDS_BYTES = LDS_MAIN + 16;

constexpr size_t MiB = 1u << 20;
constexpr size_t WS_WT_IN = 0, WS_WT_K = 5 * MiB, WS_WT_V = 7 * MiB, WS_WT_OUT = 9 * MiB, WS_WT_Q = 11 * MiB, WS_WT_O = 13 * MiB,
                 WS_WT_FF1 = 15 * MiB, WS_WT_FF2 = 23 * MiB, WS_MEMB = 31 * MiB, WS_KX = 33 * MiB, WS_VT = 35 * MiB, WS_SSQ = 37 * MiB,
                 WS_BAR = 39 * MiB, WS_CNT = 39 * MiB + 16384, WS_RSTD0 = 38 * MiB, WS_RSTDM = 38 * MiB + 65536, WS_DEC = 38 * MiB + 131072,
                 WS_XB = 40 * MiB  , WS_QH = 72 * MiB, WS_KH = 88 * MiB, WS_VH = 104 * MiB, WS_GH = 120 * MiB, WS_PH = 136 * MiB,
                 WS_LF = 152 * MiB, WS_ST = 184 * MiB, WS_MIXED = 216 * MiB,
                 WS_X1 = 72 * MiB, WS_XQ = 136 * MiB, WS_ATT = 168 * MiB, WS_U = 72 * MiB, WS_END = 256 * MiB;

typedef __bf16 bf16x2n __attribute__((ext_vector_type(2)));
__device__ __forceinline__ unsigned cvt_pk_bf16(float lo, float hi) { f32x2 v = {lo, hi}; return __builtin_bit_cast(unsigned, __builtin_convertvector(v, bf16x2n)); }
__device__ __forceinline__ bf16_t f2bf(float f) { return (bf16_t)(cvt_pk_bf16(f, 0.f) & 0xffffu); }
__device__ __forceinline__ float bf2f(bf16_t b) { return __uint_as_float(((unsigned)b) << 16); }
__device__ __forceinline__ float bflo(unsigned u) { return __uint_as_float(u << 16); }
__device__ __forceinline__ float bfhi(unsigned u) { return __uint_as_float(u & 0xffff0000u); }
__device__ __forceinline__ f32x4 mfma16(bf16x8 a, bf16x8 b, f32x4 c) { return __builtin_amdgcn_mfma_f32_16x16x32_bf16(a, b, c, 0, 0, 0); }
__device__ __forceinline__ f32x16 mfma32(bf16x8 a, bf16x8 b, f32x16 c) { return __builtin_amdgcn_mfma_f32_32x32x16_bf16(a, b, c, 0, 0, 0); }
__device__ __forceinline__ bf16x8 mk8(u32x2 lo, u32x2 hi) { u32x4 t; t.x = lo.x; t.y = lo.y; t.z = hi.x; t.w = hi.y; return __builtin_bit_cast(bf16x8, t); }
__device__ __forceinline__ bf16x8 mk8u(unsigned a, unsigned b, unsigned c, unsigned d) { u32x4 t; t.x = a; t.y = b; t.z = c; t.w = d; return __builtin_bit_cast(bf16x8, t); }
__device__ __forceinline__ float sigmoidf_(float z) { return 1.0f / (1.0f + __expf(-z)); }

namespace pg8 {
constexpr int BM = 256, BK = 64, HALF = 128, HTB = HALF * BK * 2, STAGE_BYTES = 8 * HTB, NXCD = 8, WGM = 8;
__device__ __forceinline__ int lds_byte(int r, int c) { const int st = (r >> 4) * 2 + (c >> 5), rr = r & 15, cc = c & 31, ob = rr * 64 + cc * 2; return st * 1024 + (ob ^ (((ob >> 9) & 1) << 5)); }
__device__ __forceinline__ void stage_rc(int b, int& R, int& C) { const int st = b / 1024, sb = b % 1024, swz = sb ^ (((sb >> 9) & 1) << 5); R = (st >> 1) * 16 + swz / 64; C = (st & 1) * 32 + (swz % 64) / 2; }
__device__ __forceinline__ int perm32(int rho) { const int n = rho >> 4, i = rho & 15; return 8 * (i >> 2) + 4 * n + (i & 3); }
struct Unit { int pm, pn; };
struct Gemm { const bf16_t* A; const bf16_t* Bt; int M, N, K; };
struct StaticOrder {
    int nM, nN, nwg, G, c;
    __device__ __forceinline__ void init(int M, int N, int G_, int c_) { nM = M / BM; nN = N / BM; nwg = nM * nN; G = G_; c = c_; }
    __device__ __forceinline__ bool next(int i, Unit& u) const {
        const long L = (long)i * G + c; if (L >= nwg) return false;
        int wgid = (int)L; { const int q = nwg / NXCD, r = nwg % NXCD, xcd = wgid % NXCD, off = wgid / NXCD; wgid = (xcd < r ? xcd * (q + 1) : r * (q + 1) + (xcd - r) * q) + off; }
        const int nig = WGM * nN, gid = wgid / nig, fm = gid * WGM, gsz = (nM - fm) < WGM ? (nM - fm) : WGM;
        u.pm = fm + ((wgid % nig) % gsz); u.pn = (wgid % nig) / gsz; return true;
    }
};

struct Epi {
    static constexpr bool PERM = true;
    int mode;
    unsigned char* ws; const float* x; float* out; const float* lbl; const float* gfin;
    __device__ __forceinline__ void store8(bf16_t* p, const f32x4& v0, const f32x4& v1) const {
        u32x4 w; w.x = cvt_pk_bf16(v0[0], v0[1]); w.y = cvt_pk_bf16(v0[2], v0[3]); w.z = cvt_pk_bf16(v1[0], v1[1]); w.w = cvt_pk_bf16(v1[2], v1[3]); *(u32x4*)p = w; }
    __device__ __forceinline__ void fused(f32x4 (&acc)[2][2][4][2], const Unit& u, int wr, int wc, int fr, int fq) const {
        const int row0 = u.pm * BM + wr * 64 + fr;
        const int col0 = u.pn * BM + wc * 32 + 8 * fq;
        const bf16_t* xb = (const bf16_t*)(ws + WS_XB);
        unsigned* sq = (unsigned*)(ws + WS_SSQ);
        unsigned* cnt = (unsigned*)(ws + WS_CNT) + 64 * u.pm;
        u32x4 bc[2], bn[2];
        { const size_t o = (size_t)row0 * DM + col0; bc[0] = *(const u32x4*)(xb + o); bc[1] = *(const u32x4*)(xb + o + HALF); }
#pragma unroll
        for (int gidx = 0; gidx < 8; ++gidx) { const int ai = gidx >> 2, m = gidx & 3; const int row = row0 + ai * HALF + m * 16;
            if (gidx < 7) { const int g2 = gidx + 1; const size_t o2 = (size_t)(row0 + (g2 >> 2) * HALF + (g2 & 3) * 16) * DM + col0; bn[0] = *(const u32x4*)(xb + o2); bn[1] = *(const u32x4*)(xb + o2 + HALF); }
            float ss = 0.f;
#pragma unroll
            for (int bj = 0; bj < 2; ++bj) { const u32x4 bb = bc[bj];
                const f32x4 v0 = acc[ai][bj][m][0] + (f32x4){bflo(bb.x), bfhi(bb.x), bflo(bb.y), bfhi(bb.y)}, v1 = acc[ai][bj][m][1] + (f32x4){bflo(bb.z), bfhi(bb.z), bflo(bb.w), bfhi(bb.w)};
                acc[ai][bj][m][0] = v0; acc[ai][bj][m][1] = v1;
                ss += (v0[0] * v0[0] + v0[1] * v0[1]) + (v0[2] * v0[2] + v0[3] * v0[3]) + (v1[0] * v1[0] + v1[1] * v1[1]) + (v1[2] * v1[2] + v1[3] * v1[3]); }
            ss += __shfl_xor(ss, 16); ss += __shfl_xor(ss, 32);
            if (fq == 0) __hip_atomic_store(sq + (size_t)row * 16 + u.pn * 4 + wc, __float_as_uint(ss), __ATOMIC_RELAXED, __HIP_MEMORY_SCOPE_AGENT);
            bc[0] = bn[0]; bc[1] = bn[1]; }
        asm volatile("s_waitcnt vmcnt(0)" ::: "memory");
        if ((threadIdx.x & 63) == 0) __hip_atomic_fetch_add(cnt, 1u, __ATOMIC_RELAXED, __HIP_MEMORY_SCOPE_AGENT);
        f32x4 gv[2][2];
#pragma unroll
        for (int bj = 0; bj < 2; ++bj) { gv[bj][0] = *(const f32x4*)(gfin + col0 + bj * HALF); gv[bj][1] = *(const f32x4*)(gfin + col0 + bj * HALF + 4); }
        { unsigned spins = 0; while ((unsigned)__builtin_amdgcn_readfirstlane(__hip_atomic_load(cnt, __ATOMIC_RELAXED, __HIP_MEMORY_SCOPE_AGENT)) < 32u) { __builtin_amdgcn_s_sleep(1); if (++spins > (1u << 22)) break; } }
        __builtin_amdgcn_fence(__ATOMIC_ACQUIRE, "agent");
        asm volatile("s_waitcnt vmcnt(0)" ::: "memory");
        f32x4 pv[8];
#pragma unroll
        for (int gidx = 0; gidx < 8; ++gidx) pv[gidx] = *(const f32x4*)((const float*)sq + (size_t)(row0 + (gidx >> 2) * HALF + (gidx & 3) * 16) * 16 + 4 * fq);
#pragma unroll
        for (int gidx = 0; gidx < 8; ++gidx) { const int ai = gidx >> 2, m = gidx & 3; const int row = row0 + ai * HALF + m * 16;
            float t = (pv[gidx][0] + pv[gidx][1]) + (pv[gidx][2] + pv[gidx][3]); t += __shfl_xor(t, 16); t += __shfl_xor(t, 32);
            const float rstd = rsqrtf(t * (1.0f / 1024.0f) + EPS);
            const size_t o = (size_t)row * DM + col0;
#pragma unroll
            for (int bj = 0; bj < 2; ++bj) { *(f32x4*)(out + o + bj * HALF) = acc[ai][bj][m][0] * rstd * gv[bj][0]; *(f32x4*)(out + o + bj * HALF + 4) = acc[ai][bj][m][1] * rstd * gv[bj][1]; } }
    }
    template <class Sched>
    __device__ __forceinline__ bool prefill(LAS unsigned char* lds, const Sched& S) const {
        if (!(mode == 0 || mode == 1 || mode == 4 || mode == 5) || S.nwg > 4 * S.G) return false;
        const int tid = threadIdx.x, rr = tid & 255;
#pragma unroll
        for (int k = 0; k < 2; ++k) { const int ui = (tid >> 8) + 2 * k; Unit u;
            if (S.next(ui, u)) { const int row = u.pm * BM + rr; float r;
                if (mode == 4 || mode == 5) { const f32x4* pp = (const f32x4*)((const float*)(ws + WS_SSQ) + (size_t)row * 16); const f32x4 a = pp[0], b = pp[1], c = pp[2], d = pp[3];
                    const float t = ((a[0] + a[1]) + (a[2] + a[3])) + ((b[0] + b[1]) + (b[2] + b[3])) + ((c[0] + c[1]) + (c[2] + c[3])) + ((d[0] + d[1]) + (d[2] + d[3]));
                    r = rsqrtf(t * (1.0f / 1024.0f) + EPS) * (mode == 4 ? 0.0625f : 1.0f); }
                else r = ((const float*)(ws + (mode == 0 ? WS_RSTD0 : WS_RSTDM)))[row];
                *(LAS float*)(lds + STAGE_BYTES + (ui * 256 + rr) * 4) = r; } }
        return true;
    }
    __device__ __forceinline__ void operator()(const f32x4 (&acc)[2][2][4][2], const Unit& u, int ui, bool tab, LAS unsigned char* lds, int wr, int wc, int fr, int fq) const {
        const int row0 = u.pm * BM + wr * 64 + fr;
        const int colL = wc * 32 + 8 * fq;
        if (mode == 3 || mode == 6 || mode == 7) {
            const int col0 = u.pn * BM + colL;
            bf16_t* xb = (bf16_t*)(ws + WS_XB);
            float* ssq = (float*)(ws + WS_SSQ);
            f32x4 rc[4], rn[4];
            u32x4 bc[2], bn[2];
            if (mode == 3) { const size_t o = (size_t)row0 * DM + col0; rc[0] = *(const f32x4*)(x + o); rc[1] = *(const f32x4*)(x + o + 4); rc[2] = *(const f32x4*)(x + o + HALF); rc[3] = *(const f32x4*)(x + o + HALF + 4); }
            else { const size_t o = (size_t)row0 * DM + col0; bc[0] = *(const u32x4*)(xb + o); bc[1] = *(const u32x4*)(xb + o + HALF); }
#pragma unroll
            for (int gidx = 0; gidx < 8; ++gidx) { const int ai = gidx >> 2, m = gidx & 3; const int row = row0 + ai * HALF + m * 16;
                if (gidx < 7) { const int g2 = gidx + 1; const size_t o2 = (size_t)(row0 + (g2 >> 2) * HALF + (g2 & 3) * 16) * DM + col0;
                    if (mode == 3) { rn[0] = *(const f32x4*)(x + o2); rn[1] = *(const f32x4*)(x + o2 + 4); rn[2] = *(const f32x4*)(x + o2 + HALF); rn[3] = *(const f32x4*)(x + o2 + HALF + 4); }
                    else { bn[0] = *(const u32x4*)(xb + o2); bn[1] = *(const u32x4*)(xb + o2 + HALF); } }
                if (mode != 3) {
#pragma unroll
                    for (int bj = 0; bj < 2; ++bj) { rc[2 * bj] = (f32x4){bflo(bc[bj].x), bfhi(bc[bj].x), bflo(bc[bj].y), bfhi(bc[bj].y)}; rc[2 * bj + 1] = (f32x4){bflo(bc[bj].z), bfhi(bc[bj].z), bflo(bc[bj].w), bfhi(bc[bj].w)}; } }
                float ss = 0.f;
#pragma unroll
                for (int bj = 0; bj < 2; ++bj) { const size_t o = (size_t)row * DM + col0 + bj * HALF;
                    const f32x4 v0 = acc[ai][bj][m][0] + rc[2 * bj], v1 = acc[ai][bj][m][1] + rc[2 * bj + 1];
                    store8(xb + o, v0, v1);
                    ss += (v0[0] * v0[0] + v0[1] * v0[1]) + (v0[2] * v0[2] + v0[3] * v0[3]) + (v1[0] * v1[0] + v1[1] * v1[1]) + (v1[2] * v1[2] + v1[3] * v1[3]); }
                ss += __shfl_xor(ss, 16); ss += __shfl_xor(ss, 32);
                if (fq == 0) ssq[(size_t)row * 16 + u.pn * 4 + wc] = ss;
#pragma unroll
                for (int k = 0; k < 4; ++k) rc[k] = rn[k];
                bc[0] = bn[0]; bc[1] = bn[1]; }
            return;
        }
        if (mode == 2) {
            const int col0 = u.pn * BM + colL;
            const float* rs = (const float*)(ws + WS_RSTDM); bf16_t* ob = (bf16_t*)(ws + WS_VT); const int ldo = 1024;
            f32x4 c0[2], c1[2];
#pragma unroll
            for (int bj = 0; bj < 2; ++bj) { c0[bj] = *(const f32x4*)(rs + col0 + bj * HALF); c1[bj] = *(const f32x4*)(rs + col0 + bj * HALF + 4); }
#pragma unroll
            for (int ai = 0; ai < 2; ++ai)
#pragma unroll
                for (int m = 0; m < 4; ++m) { const int row = row0 + ai * HALF + m * 16;
#pragma unroll
                    for (int bj = 0; bj < 2; ++bj) store8(ob + (size_t)row * ldo + col0 + bj * HALF, acc[ai][bj][m][0] * c0[bj], acc[ai][bj][m][1] * c1[bj]); }
            return;
        }
        float rsc[8];
        if (tab) {
#pragma unroll
            for (int gidx = 0; gidx < 8; ++gidx) rsc[gidx] = *(const LAS float*)(lds + STAGE_BYTES + (ui * 256 + wr * 64 + fr + (gidx >> 2) * HALF + (gidx & 3) * 16) * 4);
        } else if (mode == 4 || mode == 5) {
            const float* sq = (const float*)(ws + WS_SSQ);
            f32x4 pv[8];
#pragma unroll
            for (int gidx = 0; gidx < 8; ++gidx) pv[gidx] = *(const f32x4*)(sq + (size_t)(row0 + (gidx >> 2) * HALF + (gidx & 3) * 16) * 16 + 4 * fq);
            const float cs = mode == 4 ? 0.0625f : 1.0f;
#pragma unroll
            for (int gidx = 0; gidx < 8; ++gidx) { float t = (pv[gidx][0] + pv[gidx][1]) + (pv[gidx][2] + pv[gidx][3]); t += __shfl_xor(t, 16); t += __shfl_xor(t, 32); rsc[gidx] = rsqrtf(t * (1.0f / 1024.0f) + EPS) * cs; }
        } else {
            const float* rs = (const float*)(ws + (mode == 0 ? WS_RSTD0 : WS_RSTDM));
#pragma unroll
            for (int gidx = 0; gidx < 8; ++gidx) rsc[gidx] = rs[row0 + (gidx >> 2) * HALF + (gidx & 3) * 16];
        }
        if (mode == 0) {
            float* lf = (float*)(ws + WS_LF);
            const int sub = u.pn >> 1; const int cb = (u.pn & 1) * 256 + colL;
            if (sub == 1) {
                float oml[2][8];
#pragma unroll
                for (int bj = 0; bj < 2; ++bj)
#pragma unroll
                    for (int j = 0; j < 8; ++j) { const int c = cb + bj * HALF + j; const float l0 = lbl[c], l1 = lbl[512 + c]; const float lb = 1.0f / (1.0f + __expf(l1 - l0)); oml[bj][j] = 1.0f - lb; }
#pragma unroll
                for (int ai = 0; ai < 2; ++ai)
#pragma unroll
                    for (int m = 0; m < 4; ++m) { const int row = row0 + ai * HALF + m * 16; const float r = rsc[ai * 4 + m];
#pragma unroll
                        for (int bj = 0; bj < 2; ++bj) { f32x4 lf0, lf1;
#pragma unroll
                            for (int j = 0; j < 4; ++j) {
                                const float za = acc[ai][bj][m][0][j] * r, zb = acc[ai][bj][m][1][j] * r;
                                const float ka = oml[bj][j] * (1.0f - sigmoidf_(za)), kb = oml[bj][4 + j] * (1.0f - sigmoidf_(zb));
                                lf0[j] = __logf(1.0f - ka); lf1[j] = __logf(1.0f - kb); }
                            const size_t o = (size_t)row * 512 + cb + bj * HALF;
                            *(f32x4*)(lf + o) = lf0; *(f32x4*)(lf + o + 4) = lf1; } }
            } else {
                bf16_t* dst = (bf16_t*)(ws + (sub == 0 ? WS_QH : (sub == 2 ? WS_VH : (sub == 3 ? WS_GH : WS_PH))));
                const bool act = (sub == 0) || (sub == 3);
#pragma unroll
                for (int ai = 0; ai < 2; ++ai)
#pragma unroll
                    for (int m = 0; m < 4; ++m) { const int row = row0 + ai * HALF + m * 16; const float r = rsc[ai * 4 + m];
#pragma unroll
                        for (int bj = 0; bj < 2; ++bj) { f32x4 v0 = acc[ai][bj][m][0] * r, v1 = acc[ai][bj][m][1] * r;
                            if (act) {
#pragma unroll
                                for (int j = 0; j < 4; ++j) { v0[j] = v0[j] * sigmoidf_(v0[j]); v1[j] = v1[j] * sigmoidf_(v1[j]); } }
                            store8(dst + (size_t)row * 512 + cb + bj * HALF, v0, v1); } }
            }
        } else {
            const int col0 = u.pn * BM + colL;
            bf16_t* ob = (bf16_t*)(ws + (mode == 1 ? WS_KX : (mode == 4 ? WS_XQ : WS_U))); const int ldo = mode == 5 ? DFF : 1024;
#pragma unroll
            for (int ai = 0; ai < 2; ++ai)
#pragma unroll
                for (int m = 0; m < 4; ++m) { const int row = row0 + ai * HALF + m * 16; const float r = rsc[ai * 4 + m];
#pragma unroll
                    for (int bj = 0; bj < 2; ++bj) { f32x4 v0 = acc[ai][bj][m][0] * r, v1 = acc[ai][bj][m][1] * r;
                        if (mode == 5) {
#pragma unroll
                            for (int j = 0; j < 4; ++j) { const float a = fmaxf(v0[j], 0.f), b = fmaxf(v1[j], 0.f); v0[j] = a * a; v1[j] = b * b; } }
                        store8(ob + (size_t)row * ldo + col0 + bj * HALF, v0, v1); } }
        }
    }
};

template <class EpiT, class Sched>
__device__ __forceinline__ void gemm_phase(LAS unsigned char* lds, const Gemm g, const Sched S, const EpiT E) {
    const int tid = threadIdx.x, wid = __builtin_amdgcn_readfirstlane(tid >> 6), lane = tid & 63, wr = wid >> 2, wc = wid & 3, fr = lane & 15, fq = lane >> 4;
    const int K = g.K, nt = K / BK;
    unsigned voffA[2], voffB[2];
#pragma unroll
    for (int i = 0; i < 2; ++i) { int R, C; stage_rc(tid * 16 + i * 8192, R, C); const int Rb = EpiT::PERM ? ((R & ~31) + perm32(R & 31)) : R;
        voffA[i] = (unsigned)(R * K + C) * 2u; voffB[i] = (unsigned)(Rb * K + C) * 2u; }
    const size_t kstep = (size_t)(BK * 2);
    const size_t hstep = (size_t)HALF * K * 2;
    const size_t tstep = 2 * hstep;
    const unsigned ldsw = (unsigned)wid * 1024u;
    const int aoff = lds_byte(wr * 64 + fr, fq * 8), boff = lds_byte(wc * 32 + fr, fq * 8);
#define PG8_SA(b, h) (((b) * 2 + (h)) * HTB)
#define PG8_SB(b, h) ((4 + (b) * 2 + (h)) * HTB)
#define PG8_STAGE(bufoff, gbase, voff) do { _Pragma("unroll") for (int _i = 0; _i < 2; ++_i) \
        __builtin_amdgcn_global_load_lds((const unsigned*)((const char*)(gbase) + (voff)[_i]), (LAS unsigned*)(lds + (bufoff) + ldsw + _i * 8192), 16, 0, 0); } while (0)
#define PG8_LDA(dst, b, h) do { _Pragma("unroll") for (int m = 0; m < 4; ++m) _Pragma("unroll") for (int k = 0; k < 2; ++k) dst[m][k] = *(const LAS bf16x8*)(lds + PG8_SA(b, h) + aoff + m * 2048 + k * 1024); } while (0)
#define PG8_LDB(dst, b, h) do { _Pragma("unroll") for (int n = 0; n < 2; ++n) _Pragma("unroll") for (int k = 0; k < 2; ++k) dst[n][k] = *(const LAS bf16x8*)(lds + PG8_SB(b, h) + boff + n * 2048 + k * 1024); } while (0)
#define PG8_MMA(ai, bj, At, Bt) do { __builtin_amdgcn_s_setprio(1); _Pragma("unroll") for (int m = 0; m < 4; ++m) _Pragma("unroll") for (int n = 0; n < 2; ++n) _Pragma("unroll") for (int k = 0; k < 2; ++k) \
        acc[ai][bj][m][n] = __builtin_amdgcn_mfma_f32_16x16x32_bf16(Bt[n][k], At[m][k], acc[ai][bj][m][n], 0, 0, 0); __builtin_amdgcn_s_setprio(0); } while (0)
#define PG8_WAIT_V(n) asm volatile("s_waitcnt vmcnt(" #n ")" ::: "memory")
#define PG8_WAIT_L(n) asm volatile("s_waitcnt lgkmcnt(" #n ")" ::: "memory")
#define PG8_BAR __builtin_amdgcn_s_barrier()
#define PG8_SCHED __builtin_amdgcn_sched_barrier(0)
    Unit cur, nxt; int ui = 0;
    if (!S.next(0, cur)) return;
    const bool tab = E.prefill(lds, S);
    if (tab) __syncthreads();
    f32x4 acc[2][2][4][2];
#pragma unroll
    for (int a = 0; a < 2; ++a)
#pragma unroll
        for (int b = 0; b < 2; ++b)
#pragma unroll
            for (int m = 0; m < 4; ++m)
#pragma unroll
                for (int n = 0; n < 2; ++n) acc[a][b][m][n] = (f32x4){0.f, 0.f, 0.f, 0.f};
    bf16x8 At[4][2], B0[2][2], B1[2][2];
    const char* cA = (const char*)g.A + (size_t)cur.pm * tstep; const char* cB = (const char*)g.Bt + (size_t)cur.pn * tstep;
    PG8_STAGE(PG8_SB(0, 0), cB, voffB); PG8_STAGE(PG8_SA(0, 0), cA, voffA); PG8_STAGE(PG8_SB(0, 1), cB + hstep, voffB); PG8_STAGE(PG8_SA(0, 1), cA + hstep, voffA);
    if (wr == 1) PG8_BAR;
    PG8_WAIT_V(4); PG8_BAR;
    PG8_STAGE(PG8_SB(1, 0), cB + kstep, voffB); PG8_STAGE(PG8_SA(1, 0), cA + kstep, voffA); PG8_STAGE(PG8_SB(1, 1), cB + hstep + kstep, voffB);
    PG8_WAIT_V(6); PG8_BAR;
    for (;;) {
        const bool has_next = S.next(ui + 1, nxt);
        const char* nA = has_next ? (const char*)g.A + (size_t)nxt.pm * tstep : cA; const char* nB = has_next ? (const char*)g.Bt + (size_t)nxt.pn * tstep : cB;
        for (int t = 0; t < nt; t += 2) {
            const bool last = (t == nt - 2);
            const char* a1 = cA + (size_t)(t + 1) * kstep;
            const char* a2 = last ? nA : cA + (size_t)(t + 2) * kstep; const char* b2 = last ? nB : cB + (size_t)(t + 2) * kstep;
            const char* a3 = a2 + kstep; const char* b3 = b2 + kstep;
            PG8_LDB(B0, 0, 0); PG8_SCHED; PG8_LDA(At, 0, 0); PG8_STAGE(PG8_SA(1, 1), a1 + hstep, voffA);
            PG8_WAIT_L(8); PG8_BAR; PG8_WAIT_L(0); PG8_MMA(0, 0, At, B0); PG8_BAR; PG8_SCHED;
            PG8_LDB(B1, 0, 1); PG8_STAGE(PG8_SB(0, 0), b2, voffB);
            PG8_BAR; PG8_WAIT_L(0); PG8_MMA(0, 1, At, B1); PG8_BAR;
            PG8_LDA(At, 0, 1); PG8_STAGE(PG8_SA(0, 0), a2, voffA);
            PG8_BAR; PG8_WAIT_L(0); PG8_MMA(1, 0, At, B0); PG8_BAR; PG8_SCHED;
            PG8_STAGE(PG8_SB(0, 1), b2 + hstep, voffB);
            PG8_WAIT_V(6); PG8_BAR; PG8_MMA(1, 1, At, B1); PG8_BAR;
            PG8_LDB(B0, 1, 0); PG8_SCHED; PG8_LDA(At, 1, 0); PG8_STAGE(PG8_SA(0, 1), a2 + hstep, voffA);
            PG8_WAIT_L(8); PG8_BAR; PG8_WAIT_L(0); PG8_MMA(0, 0, At, B0); PG8_BAR; PG8_SCHED;
            PG8_LDB(B1, 1, 1); PG8_STAGE(PG8_SB(1, 0), b3, voffB);
            PG8_BAR; PG8_WAIT_L(0); PG8_MMA(0, 1, At, B1); PG8_BAR;
            PG8_LDA(At, 1, 1); PG8_STAGE(PG8_SA(1, 0), a3, voffA);
            PG8_BAR; PG8_WAIT_L(0); PG8_MMA(1, 0, At, B0); PG8_BAR; PG8_SCHED;
            PG8_STAGE(PG8_SB(1, 1), b3 + hstep, voffB);
            PG8_WAIT_V(6); PG8_BAR; PG8_MMA(1, 1, At, B1); PG8_BAR;
        }
        if (E.mode != 8) E(acc, cur, ui, tab, lds, wr, wc, fr, fq);
        if (!has_next) break;
#pragma unroll
        for (int a = 0; a < 2; ++a)
#pragma unroll
            for (int b = 0; b < 2; ++b)
#pragma unroll
                for (int m = 0; m < 4; ++m)
#pragma unroll
                    for (int n = 0; n < 2; ++n) acc[a][b][m][n] = (f32x4){0.f, 0.f, 0.f, 0.f};
        cur = nxt; cA = nA; cB = nB; ++ui;
    }
    PG8_WAIT_V(0);
    if (wr == 0) PG8_BAR;
    PG8_BAR;
    if (E.mode == 8) E.fused(acc, cur, wr, wc, fr, fq);
#undef PG8_SA
#undef PG8_SB
#undef PG8_STAGE
#undef PG8_LDA
#undef PG8_LDB
#undef PG8_MMA
#undef PG8_WAIT_V
#undef PG8_WAIT_L
#undef PG8_BAR
#undef PG8_SCHED
}
}

struct Params {
    const float *x, *mem, *norm_mix_g, *w_in, *lb_logits, *hgrn_norm_g, *w_pool, *pool_scale, *w_out, *norm_x_g, *norm_mem_g, *w_xq, *w_xk, *w_xv, *w_xo, *norm_ffn_g, *w_ff1, *w_ff2, *final_norm_g;
    float* out; unsigned char* ws;
    int ph_lo, ph_hi;
};

struct TD { const float* W; const float* g; bf16_t* out; int N, ldo, kt, nt; };
__device__ __forceinline__ TD tile_desc(const Params& p, int t) {
    unsigned char* ws = p.ws; TD d;
    if (t < 320)       { d.W = p.w_in;  d.g = p.norm_mix_g; d.out = (bf16_t*)(ws + WS_WT_IN);  d.N = NIN;  d.ldo = 1024; d.kt = t / 40; d.nt = t % 40; }
    else if (t < 448)  { const int u = t - 320;  d.W = p.w_xk;  d.g = p.norm_mem_g; d.out = (bf16_t*)(ws + WS_WT_K);   d.N = 1024; d.ldo = 1024; d.kt = u / 16; d.nt = u % 16; }
    else if (t < 576)  { const int u = t - 448;  d.W = p.w_xv;  d.g = p.norm_mem_g; d.out = (bf16_t*)(ws + WS_WT_V);   d.N = 1024; d.ldo = 1024; d.kt = u / 16; d.nt = u % 16; }
    else if (t < 704)  { const int u = t - 576;  d.W = p.w_xq;  d.g = p.norm_x_g;   d.out = (bf16_t*)(ws + WS_WT_Q);   d.N = 1024; d.ldo = 1024; d.kt = u / 16; d.nt = u % 16; }
    else if (t < 832)  { const int u = t - 704;  d.W = p.w_xo;  d.g = nullptr;      d.out = (bf16_t*)(ws + WS_WT_O);   d.N = 1024; d.ldo = 1024; d.kt = u / 16; d.nt = u % 16; }
    else if (t < 960)  { const int u = t - 832;  d.W = p.w_out; d.g = nullptr;      d.out = (bf16_t*)(ws + WS_WT_OUT); d.N = 1024; d.ldo = 1024; d.kt = u / 16; d.nt = u % 16; }
    else if (t < 1472) { const int u = t - 960;  d.W = p.w_ff1; d.g = p.norm_ffn_g; d.out = (bf16_t*)(ws + WS_WT_FF1); d.N = DFF;  d.ldo = 1024; d.kt = u / 64; d.nt = u % 64; }
    else               { const int u = t - 1472; d.W = p.w_ff2; d.g = nullptr;      d.out = (bf16_t*)(ws + WS_WT_FF2); d.N = 1024; d.ldo = 4096; d.kt = u / 16; d.nt = u % 16; }
    return d;
}
__device__ __forceinline__ void tile_load(const TD& d, f32x4 (&v)[4], float (&sc)[4]) {
    const int tid = threadIdx.x, r = tid >> 4, c4 = tid & 15;
#pragma unroll
    for (int i = 0; i < 4; ++i) { const int k = 128 * d.kt + r + 32 * i; v[i] = *(const f32x4*)(d.W + (size_t)k * d.N + 64 * d.nt + 4 * c4); sc[i] = d.g ? d.g[k] : 1.0f; }
}
__device__ __forceinline__ void transpose_range(const Params& p, unsigned char* lds, int t_begin, int t_end, int first, int stride) {
    bf16_t* T0 = (bf16_t*)lds;
    bf16_t* T1 = (bf16_t*)(lds + 17408);
    const int tid = threadIdx.x, r = tid >> 4, c4 = tid & 15, n = tid >> 3, ks = tid & 7;
    int ta = t_begin + first;
    if (ta >= t_end) return;
    int tb = ta + stride; bool hb = tb < t_end;
    TD da = tile_desc(p, ta), db = da; f32x4 va[4], vb[4]; float sa[4], sb[4];
    tile_load(da, va, sa);
    if (hb) { db = tile_desc(p, tb); tile_load(db, vb, sb); }
    for (;;) {
#pragma unroll
        for (int i = 0; i < 4; ++i) { const int kl = r + 32 * i;
            T0[(4 * c4 + 0) * 136 + kl] = f2bf(va[i][0] * sa[i]); T0[(4 * c4 + 1) * 136 + kl] = f2bf(va[i][1] * sa[i]);
            T0[(4 * c4 + 2) * 136 + kl] = f2bf(va[i][2] * sa[i]); T0[(4 * c4 + 3) * 136 + kl] = f2bf(va[i][3] * sa[i]); }
        if (hb) {
#pragma unroll
            for (int i = 0; i < 4; ++i) { const int kl = r + 32 * i;
                T1[(4 * c4 + 0) * 136 + kl] = f2bf(vb[i][0] * sb[i]); T1[(4 * c4 + 1) * 136 + kl] = f2bf(vb[i][1] * sb[i]);
                T1[(4 * c4 + 2) * 136 + kl] = f2bf(vb[i][2] * sb[i]); T1[(4 * c4 + 3) * 136 + kl] = f2bf(vb[i][3] * sb[i]); } }
        __syncthreads();
        const int tna = ta + 2 * stride, tnb = tna + stride; const bool hna = tna < t_end, hnb = tnb < t_end;
        const TD ca = da, cb = db; const bool chb = hb;
        if (hna) { da = tile_desc(p, tna); tile_load(da, va, sa); }
        if (hnb) { db = tile_desc(p, tnb); tile_load(db, vb, sb); }
        { const u32x4* src = (const u32x4*)(T0 + n * 136 + 16 * ks); const u32x4 a = src[0], b = src[1];
          u32x4* dst = (u32x4*)(ca.out + (size_t)(64 * ca.nt + n) * ca.ldo + 128 * ca.kt + 16 * ks); dst[0] = a; dst[1] = b; }
        if (chb) { const u32x4* src = (const u32x4*)(T1 + n * 136 + 16 * ks); const u32x4 a = src[0], b = src[1];
          u32x4* dst = (u32x4*)(cb.out + (size_t)(64 * cb.nt + n) * cb.ldo + 128 * cb.kt + 16 * ks); dst[0] = a; dst[1] = b; }
        __syncthreads();
        if (!hna) break;
        ta = tna; hb = hnb;
    }
}
__device__ __forceinline__ void phase_prep(const Params p, unsigned char* lds) {
    unsigned char* ws = p.ws;
    const int G = gridDim.x;
    {
        const int lane = threadIdx.x & 63, gw = blockIdx.x * (NTHREADS / 64) + (threadIdx.x >> 6), nw = G * (NTHREADS / 64);
        int r = gw;
        f32x4 v[4], vn[4];
        if (r < MROWS + MEMROWS) { const float* src = r < MROWS ? p.x + (size_t)r * DM : p.mem + (size_t)(r - MROWS) * DM;
#pragma unroll
            for (int i = 0; i < 4; ++i) v[i] = ((const f32x4*)src)[lane + 64 * i]; }
        for (; r < MROWS + MEMROWS; r += nw) {
            const int rn = r + nw;
            if (rn < MROWS + MEMROWS) { const float* src = rn < MROWS ? p.x + (size_t)rn * DM : p.mem + (size_t)(rn - MROWS) * DM;
#pragma unroll
                for (int i = 0; i < 4; ++i) vn[i] = ((const f32x4*)src)[lane + 64 * i]; }
            const bool isx = r < MROWS;
            bf16_t* dst = isx ? (bf16_t*)(ws + WS_XB) + (size_t)r * DM : (bf16_t*)(ws + WS_MEMB) + (size_t)(r - MROWS) * DM;
            float ss = 0.f;
#pragma unroll
            for (int i = 0; i < 4; ++i) ss += (v[i][0] * v[i][0] + v[i][1] * v[i][1]) + (v[i][2] * v[i][2] + v[i][3] * v[i][3]);
#pragma unroll
            for (int o = 1; o < 64; o <<= 1) ss += __shfl_xor(ss, o);
#pragma unroll
            for (int i = 0; i < 4; ++i) { u32x2 w; w.x = cvt_pk_bf16(v[i][0], v[i][1]); w.y = cvt_pk_bf16(v[i][2], v[i][3]); ((u32x2*)dst)[lane + 64 * i] = w; }
            if (lane == 0) { const float rstd = rsqrtf(ss * (1.0f / 1024.0f) + EPS); if (isx) ((float*)(ws + WS_RSTD0))[r] = rstd; else ((float*)(ws + WS_RSTDM))[r - MROWS] = rstd; }
#pragma unroll
            for (int i = 0; i < 4; ++i) v[i] = vn[i];
        }
    }
    transpose_range(p, lds, 0, 576, blockIdx.x, G);
}
__device__ __forceinline__ void deferred_prep(const Params p, unsigned char* lds, int j, int nworkers) {
    transpose_range(p, lds, 576, 1984, j, nworkers);
}
__device__ __forceinline__ void fold_pool_weights_mfma(const Params& p) {
    bf16_t* wto = (bf16_t*)(p.ws + WS_WT_OUT);
    const int tid = threadIdx.x, w = tid >> 6, lane = tid & 63, fr = lane & 15, q = lane >> 4;
    for (int item = blockIdx.x; item < 256; item += gridDim.x) {
        const int gi = item >> 6, nb = item & 63;
        f32x4 acc = (f32x4){0.f, 0.f, 0.f, 0.f};
        const float* wp = p.w_pool + (size_t)(gi * 128 + 16 * w + fr) * 128;
        const float* ps = p.pool_scale + gi * 128;
        const bf16_t* arow = wto + (size_t)(16 * nb + fr) * 1024 + 512 + gi * 128;
#pragma unroll
        for (int ks = 0; ks < 4; ++ks) {
            const int d0 = 32 * ks + 8 * q;
            const f32x4 w0 = *(const f32x4*)(wp + d0), w1 = *(const f32x4*)(wp + d0 + 4), s0 = *(const f32x4*)(ps + d0), s1 = *(const f32x4*)(ps + d0 + 4);
            const bf16x8 cfr = mk8u(cvt_pk_bf16(w0[0] * s0[0], w0[1] * s0[1]), cvt_pk_bf16(w0[2] * s0[2], w0[3] * s0[3]), cvt_pk_bf16(w1[0] * s1[0], w1[1] * s1[1]), cvt_pk_bf16(w1[2] * s1[2], w1[3] * s1[3]));
            const bf16x8 nfr = *(const bf16x8*)(arow + d0);
            acc = mfma16(cfr, nfr, acc);
        }
        asm volatile("s_waitcnt vmcnt(0)" ::: "memory");
        __syncthreads();
        u32x2 o; o.x = cvt_pk_bf16(acc[0], acc[1]); o.y = cvt_pk_bf16(acc[2], acc[3]);
        *(u32x2*)(wto + (size_t)(16 * nb + fr) * 1024 + 512 + gi * 128 + 16 * w + 4 * q) = o;
        __syncthreads();
    }
}

__device__ __forceinline__ void phase_passA(const bf16_t* __restrict__ KH, const float* __restrict__ LF, const bf16_t* __restrict__ VH, bf16_t* __restrict__ LT, float* __restrict__ DEC, unsigned char* lds) {
    const int tid = threadIdx.x, ch = tid & 127, seg = tid >> 7, G = gridDim.x;
    float* segtot = (float*)lds;
    unsigned char* KdT = lds + 2048;
    unsigned char* VTl = lds + 2048 + 18432;
    const int w = tid >> 6, lane = tid & 63, fr = lane & 15, q = lane >> 4;
    float lf[16], kk[16]; unsigned vr[16];
    int unit = blockIdx.x;
    if (unit < 1024) { const int b = unit >> 8, c = (unit >> 2) & 63, h = unit & 3; const size_t g0 = (size_t)(b * SEQ + c * 64 + seg * 16) * 512 + h * 128 + ch;
#pragma unroll
        for (int i = 0; i < 16; ++i) { lf[i] = LF[g0 + (size_t)i * 512]; vr[i] = VH[g0 + (size_t)i * 512]; } }
    for (; unit < 1024; unit += G) {
        const int b = unit >> 8, c = (unit >> 2) & 63, h = unit & 3, bh = b * 4 + h;
#pragma unroll
        for (int i = 0; i < 16; ++i) kk[i] = 1.0f - __expf(lf[i]);
#pragma unroll
        for (int i = 1; i < 16; ++i) lf[i] += lf[i - 1];
        segtot[seg * 128 + ch] = lf[15];
        __syncthreads();
        float after = 0.f;
#pragma unroll
        for (int s2 = 1; s2 < 4; ++s2) if (s2 > seg) after += segtot[s2 * 128 + ch];
        const float tot = after + lf[15];
        if (seg == 0) DEC[(size_t)(bh * 64 + c) * 128 + ch] = __expf(tot);
        unsigned kd[8], vp[8];
#pragma unroll
        for (int i = 0; i < 8; ++i) {
            kd[i] = cvt_pk_bf16(kk[2 * i] * __expf(tot - lf[2 * i]), kk[2 * i + 1] * __expf(tot - lf[2 * i + 1]));
            vp[i] = vr[2 * i] | (vr[2 * i + 1] << 16);
        }
        { u32x4* d = (u32x4*)(KdT + ch * 144 + seg * 32); d[0] = (u32x4){kd[0], kd[1], kd[2], kd[3]}; d[1] = (u32x4){kd[4], kd[5], kd[6], kd[7]}; }
        { u32x4* d = (u32x4*)(VTl + ch * 144 + seg * 32); d[0] = (u32x4){vp[0], vp[1], vp[2], vp[3]}; d[1] = (u32x4){vp[4], vp[5], vp[6], vp[7]}; }
        __syncthreads();
        {
            const int un = unit + G;
            if (un < 1024) { const int b2 = un >> 8, c2 = (un >> 2) & 63, h2 = un & 3; const size_t g0 = (size_t)(b2 * SEQ + c2 * 64 + seg * 16) * 512 + h2 * 128 + ch;
#pragma unroll
                for (int i = 0; i < 16; ++i) { lf[i] = LF[g0 + (size_t)i * 512]; vr[i] = VH[g0 + (size_t)i * 512]; } }
        }
        bf16x8 a[2];
#pragma unroll
        for (int ks = 0; ks < 2; ++ks) a[ks] = *(const bf16x8*)(KdT + (16 * w + fr) * 144 + (32 * ks + 8 * q) * 2);
        bf16_t* ltp = LT + (size_t)(bh * 64 + c) * 16384;
#pragma unroll
        for (int vb = 0; vb < 8; ++vb) {
            f32x4 acc = (f32x4){0.f, 0.f, 0.f, 0.f};
#pragma unroll
            for (int ks = 0; ks < 2; ++ks) { const bf16x8 bfr = *(const bf16x8*)(VTl + (16 * vb + fr) * 144 + (32 * ks + 8 * q) * 2); acc = mfma16(a[ks], bfr, acc); }
            u32x2 pk; pk.x = cvt_pk_bf16(acc[0], acc[1]); pk.y = cvt_pk_bf16(acc[2], acc[3]);
            *(u32x2*)(ltp + (size_t)(16 * vb + fr) * 128 + 16 * w + 4 * q) = pk;
        }
        __syncthreads();
    }
}

template <int W>
__device__ __forceinline__ void pool_body(const bf16_t* __restrict__ PH, bf16_t* __restrict__ MIXED, int r0, int s0, int c0) {
    unsigned v[31 + W];
#pragma unroll
    for (int j = 1; j < W; ++j) v[W - 1 - j] = (s0 - j >= 0) ? *(const unsigned*)(PH + (size_t)(r0 - j) * 512 + c0) : 0u;
#pragma unroll
    for (int tt = 0; tt < 32; ++tt) v[W - 1 + tt] = *(const unsigned*)(PH + (size_t)(r0 + tt) * 512 + c0);
    float sx = 0.f, sy = 0.f;
#pragma unroll
    for (int j = 1; j < W; ++j) { sx += bflo(v[W - 1 - j]); sy += bfhi(v[W - 1 - j]); }
#pragma unroll
    for (int tt = 0; tt < 32; ++tt) {
        const int s = s0 + tt;
        const float px = bflo(v[W - 1 + tt]), py = bfhi(v[W - 1 + tt]);
        sx += px; sy += py;
        const int cnt = (s + 1) < W ? (s + 1) : W;
        const float inv = 1.0f / (float)cnt;
        *(unsigned*)(MIXED + (size_t)(r0 + tt) * 1024 + 512 + c0) = cvt_pk_bf16(sx * inv - px, sy * inv - py);
        sx -= bflo(v[tt]); sy -= bfhi(v[tt]);
    }
}
__device__ __forceinline__ void pool_tile(const bf16_t* __restrict__ PH, bf16_t* __restrict__ MIXED, int tile) {
    const int tid = threadIdx.x, cp = tid & 255, th = tid >> 8, c0 = 2 * cp, gi = c0 >> 7;
    const int r0 = tile * 64 + th * 32, s0 = r0 & (SEQ - 1);
    if (gi == 0) pool_body<2>(PH, MIXED, r0, s0, c0);
    else if (gi == 1) pool_body<4>(PH, MIXED, r0, s0, c0);
    else if (gi == 2) pool_body<8>(PH, MIXED, r0, s0, c0);
    else pool_body<16>(PH, MIXED, r0, s0, c0);
}

__device__ __forceinline__ void phase_scan(const bf16_t* LT, const float* __restrict__ DEC, bf16_t* ST) {
    for (int e2 = blockIdx.x * NTHREADS + threadIdx.x; e2 < 131072; e2 += gridDim.x * NTHREADS) {
        const int bh = e2 >> 13, v = (e2 >> 6) & 127, kp = e2 & 63;
        float sx = 0.f, sy = 0.f;
        const size_t base = (size_t)bh * 64 * 16384 + (size_t)v * 128 + 2 * kp;
        const float* dp = DEC + (size_t)bh * 64 * 128 + 2 * kp;
        for (int c0 = 0; c0 < 64; c0 += 32) {
            unsigned l[32]; f32x2 d[32];
#pragma unroll
            for (int j = 0; j < 32; ++j) { l[j] = *(const unsigned*)(LT + base + (size_t)(c0 + j) * 16384); d[j] = *(const f32x2*)(dp + (c0 + j) * 128); }
#pragma unroll
            for (int j = 0; j < 32; ++j) {
                *(unsigned*)(ST + base + (size_t)(c0 + j) * 16384) = cvt_pk_bf16(sx, sy);
                sx = d[j][0] * sx + bflo(l[j]); sy = d[j][1] * sy + bfhi(l[j]);
            }
        }
    }
}

__device__ __forceinline__ void phase_passC(const bf16_t* __restrict__ QH, const bf16_t* __restrict__ KH, const float* __restrict__ LF, const bf16_t* __restrict__ VH, const bf16_t* __restrict__ GH,
                                const bf16_t* __restrict__ ST, const float* __restrict__ hg, bf16_t* __restrict__ MIXED, unsigned char* lds) {
    const int tid = threadIdx.x, ch = tid & 127, seg = tid >> 7, G = gridDim.x;
    float lf[16], kk[16]; unsigned qr[16], vr[16];
    int unit = blockIdx.x;
    if (unit < 1024) { const int b = unit >> 8, c = (unit >> 2) & 63, h = unit & 3; const size_t g0 = (size_t)(b * SEQ + c * 64 + seg * 16) * 512 + h * 128 + ch;
#pragma unroll
        for (int i = 0; i < 16; ++i) { lf[i] = LF[g0 + (size_t)i * 512]; vr[i] = VH[g0 + (size_t)i * 512]; qr[i] = QH[g0 + (size_t)i * 512]; } }
  for (; unit < 1024; unit += G) {
    const int b = unit >> 8, c = (unit >> 2) & 63, h = unit & 3;
    const int row0 = b * SEQ + c * 64, bh = b * 4 + h;
    float* segtot = (float*)lds;
    float* rmsp = (float*)(lds + 2048);
    bf16_t* QC = (bf16_t*)(lds + 4096);
    bf16_t* QT = (bf16_t*)(lds + 21504);
    constexpr int KT0 = 38912;
    unsigned char* VTl = lds + 82432;
    const int w = tid >> 6, lane = tid & 63, fr = lane & 15, q = lane >> 4;
    const int i = w & 3, vh = w >> 2;
    const size_t row = (size_t)(row0 + 16 * i + fr);
    u32x2 gt[4]; f32x4 gg[4]; bf16x8 stf[4][4];
    {
        const bf16_t* stp = ST + (size_t)(bh * 64 + c) * 16384;
#pragma unroll
        for (int vbl = 0; vbl < 4; ++vbl) { const int v0 = 16 * (vh * 4 + vbl) + 4 * q; gt[vbl] = *(const u32x2*)(GH + row * 512 + h * 128 + v0); gg[vbl] = *(const f32x4*)(hg + h * 128 + v0);
#pragma unroll
            for (int ks = 0; ks < 4; ++ks) stf[ks][vbl] = *(const bf16x8*)(stp + (size_t)(16 * (vh * 4 + vbl) + fr) * 128 + 32 * ks + 8 * q); }
    }
#pragma unroll
    for (int i2 = 0; i2 < 16; ++i2) kk[i2] = 1.0f - __expf(lf[i2]);
#pragma unroll
    for (int i2 = 1; i2 < 16; ++i2) lf[i2] += lf[i2 - 1];
    segtot[seg * 128 + ch] = lf[15];
    {
        unsigned vp[8];
#pragma unroll
        for (int i2 = 0; i2 < 8; ++i2) vp[i2] = vr[2 * i2] | (vr[2 * i2 + 1] << 16);
        u32x4* d = (u32x4*)(VTl + ch * 144 + seg * 32); d[0] = (u32x4){vp[0], vp[1], vp[2], vp[3]}; d[1] = (u32x4){vp[4], vp[5], vp[6], vp[7]};
    }
    __syncthreads();
    const float t0 = segtot[ch], t1 = segtot[128 + ch], t2 = segtot[256 + ch];
    const float P = (seg > 0 ? t0 : 0.f) + (seg > 1 ? t1 : 0.f) + (seg > 2 ? t2 : 0.f);
    {
        const float eP = __expf(P);
#pragma unroll
        for (int i2 = 0; i2 < 16; ++i2) {
            const float qv = bflo(qr[i2]);
            const float el = __expf(lf[i2]);
            QT[(seg * 16 + i2) * 136 + ch] = f2bf(qv * el);
            QC[(seg * 16 + i2) * 136 + ch] = f2bf(qv * el * eP);
        }
        float E = 0.f;
#pragma unroll
        for (int i2 = 0; i2 < 4; ++i2) {
            if (i2 >= seg) {
                bf16_t* KT = (bf16_t*)(lds + KT0 + 4352 * ((i2 * (i2 + 1)) / 2));
#pragma unroll
                for (int j = 0; j < 16; ++j) KT[(seg * 16 + j) * 136 + ch] = f2bf(kk[j] * __expf(E - lf[j]));
                E += (i2 == 0 ? t0 : (i2 == 1 ? t1 : t2));
            }
        }
    }
    __syncthreads();
    {
        const int un = unit + G;
        if (un < 1024) { const int b2 = un >> 8, c2 = (un >> 2) & 63, h2 = un & 3; const size_t g2 = (size_t)(b2 * SEQ + c2 * 64 + seg * 16) * 512 + h2 * 128 + ch;
#pragma unroll
            for (int i2 = 0; i2 < 16; ++i2) { lf[i2] = LF[g2 + (size_t)i2 * 512]; vr[i2] = VH[g2 + (size_t)i2 * 512]; qr[i2] = QH[g2 + (size_t)i2 * 512]; } }
    }
    f32x4 sT[4];
#pragma unroll
    for (int j = 0; j < 4; ++j) sT[j] = (f32x4){0.f, 0.f, 0.f, 0.f};
    {
        bf16x8 qfr[4];
#pragma unroll
        for (int ks = 0; ks < 4; ++ks) qfr[ks] = *(const bf16x8*)((const unsigned char*)QT + (16 * i + fr) * 272 + (32 * ks + 8 * q) * 2);
        const unsigned char* KT = lds + KT0 + 4352 * ((i * (i + 1)) / 2);
#pragma unroll
        for (int j = 0; j < 4; ++j) if (j <= i) {
#pragma unroll
            for (int ks = 0; ks < 4; ++ks) { const bf16x8 a = *(const bf16x8*)(KT + (16 * j + fr) * 272 + (32 * ks + 8 * q) * 2); sT[j] = mfma16(a, qfr[ks], sT[j]); }
            if (j == i) {
#pragma unroll
                for (int rg = 0; rg < 4; ++rg) if (4 * q + rg > fr) sT[j][rg] = 0.f;
            }
        }
    }
    f32x4 oacc[4];
#pragma unroll
    for (int vbl = 0; vbl < 4; ++vbl) oacc[vbl] = (f32x4){0.f, 0.f, 0.f, 0.f};
#pragma unroll
    for (int m = 0; m < 2; ++m) if (2 * m <= i) {
        const bf16x8 bfrag = mk8u(cvt_pk_bf16(sT[2 * m][0], sT[2 * m][1]), cvt_pk_bf16(sT[2 * m][2], sT[2 * m][3]), cvt_pk_bf16(sT[2 * m + 1][0], sT[2 * m + 1][1]), cvt_pk_bf16(sT[2 * m + 1][2], sT[2 * m + 1][3]));
#pragma unroll
        for (int vbl = 0; vbl < 4; ++vbl) {
            const unsigned char* base = VTl + (16 * (vh * 4 + vbl) + fr) * 144 + (32 * m + 4 * q) * 2;
            const bf16x8 a = mk8(*(const u32x2*)base, *(const u32x2*)(base + 32));
            oacc[vbl] = mfma16(a, bfrag, oacc[vbl]);
        }
    }
    {
#pragma unroll
        for (int ks = 0; ks < 4; ++ks) {
            const bf16x8 bfr = *(const bf16x8*)((const unsigned char*)QC + (16 * i + fr) * 272 + (32 * ks + 8 * q) * 2);
#pragma unroll
            for (int vbl = 0; vbl < 4; ++vbl) oacc[vbl] = mfma16(stf[ks][vbl], bfr, oacc[vbl]);
        }
    }
    float ss = 0.f;
#pragma unroll
    for (int vbl = 0; vbl < 4; ++vbl) ss += (oacc[vbl][0] * oacc[vbl][0] + oacc[vbl][1] * oacc[vbl][1]) + (oacc[vbl][2] * oacc[vbl][2] + oacc[vbl][3] * oacc[vbl][3]);
    ss += __shfl_xor(ss, 16); ss += __shfl_xor(ss, 32);
    if (q == 0) rmsp[vh * 64 + 16 * i + fr] = ss;
    __syncthreads();
    const float rstd = rsqrtf((rmsp[16 * i + fr] + rmsp[64 + 16 * i + fr]) * (1.0f / 128.0f) + EPS);
#pragma unroll
    for (int vbl = 0; vbl < 4; ++vbl) {
        const int v0 = 16 * (vh * 4 + vbl) + 4 * q;
        u32x2 o;
        o.x = cvt_pk_bf16(oacc[vbl][0] * rstd * gg[vbl][0] * bflo(gt[vbl].x), oacc[vbl][1] * rstd * gg[vbl][1] * bfhi(gt[vbl].x));
        o.y = cvt_pk_bf16(oacc[vbl][2] * rstd * gg[vbl][2] * bflo(gt[vbl].y), oacc[vbl][3] * rstd * gg[vbl][3] * bfhi(gt[vbl].y));
        *(u32x2*)(MIXED + row * 1024 + h * 128 + v0) = o;
    }
    __syncthreads();
  }
}

__device__ __forceinline__ void attn_unit(const bf16_t* __restrict__ XQ, const bf16_t* __restrict__ KX, const bf16_t* __restrict__ VT, bf16_t* __restrict__ ATT, int unit, unsigned char* lds) {
    const int tid = threadIdx.x, w = tid >> 6, lane = tid & 63, r = lane & 31, hh = lane >> 5;
    const int b = unit >> 6, st = (unit >> 2) & 15, h = unit & 3;
    const int row0 = b * SEQ + st * 256;
    const bf16_t* qp = XQ + (size_t)(row0 + 32 * w + r) * 1024 + h * 256 + 8 * hh;
    {
        const bf16_t* kp = KX + (size_t)(b * 256) * 1024 + h * 256;
#pragma unroll
        for (int it = 0; it < 16; ++it) { const int idx = tid + 512 * it, m = idx >> 5, cc = idx & 31;
            const u32x4 v = *(const u32x4*)(kp + (size_t)m * 1024 + cc * 8); *(u32x4*)(lds + m * 528 + cc * 16) = v; }
    }
    __syncthreads();
    f32x16 sacc[8];
#pragma unroll
    for (int mb = 0; mb < 8; ++mb)
#pragma unroll
        for (int e = 0; e < 16; ++e) sacc[mb][e] = 0.f;
    for (int kg = 0; kg < 4; ++kg) {
        bf16x8 qf[4];
#pragma unroll
        for (int k4 = 0; k4 < 4; ++k4) qf[k4] = *(const bf16x8*)(qp + 16 * (4 * kg + k4));
#pragma unroll
        for (int k4 = 0; k4 < 4; ++k4)
#pragma unroll
            for (int mb = 0; mb < 8; ++mb) { const bf16x8 a = *(const bf16x8*)(lds + (32 * mb + r) * 528 + (16 * (4 * kg + k4) + 8 * hh) * 2); sacc[mb] = mfma32(a, qf[k4], sacc[mb]); }
    }
    float mx = -3.0e38f;
#pragma unroll
    for (int mb = 0; mb < 8; ++mb)
#pragma unroll
        for (int e = 0; e < 16; ++e) mx = fmaxf(mx, sacc[mb][e]);
    mx = fmaxf(mx, __shfl_xor(mx, 32));
    float sum = 0.f;
    bf16x8 pf[8][2];
#pragma unroll
    for (int mb = 0; mb < 8; ++mb) {
        float pv[16];
#pragma unroll
        for (int e = 0; e < 16; ++e) { pv[e] = __expf(sacc[mb][e] - mx); sum += pv[e]; }
#pragma unroll
        for (int s = 0; s < 2; ++s) pf[mb][s] = mk8u(cvt_pk_bf16(pv[8 * s + 0], pv[8 * s + 1]), cvt_pk_bf16(pv[8 * s + 2], pv[8 * s + 3]), cvt_pk_bf16(pv[8 * s + 4], pv[8 * s + 5]), cvt_pk_bf16(pv[8 * s + 6], pv[8 * s + 7]));
    }
    sum += __shfl_xor(sum, 32);
    const float inv = 1.0f / sum;
    __syncthreads();
    {
        const bf16_t* vp = VT + (size_t)(h * 256) * 1024 + b * 256;
#pragma unroll
        for (int it = 0; it < 16; ++it) { const int idx = tid + 512 * it, e = idx >> 5, cc = idx & 31;
            const u32x4 v = *(const u32x4*)(vp + (size_t)e * 1024 + cc * 8);
            u32x2* d = (u32x2*)(lds + e * 520 + cc * 16); d[0] = (u32x2){v.x, v.y}; d[1] = (u32x2){v.z, v.w}; }
    }
    __syncthreads();
    bf16_t* op = ATT + (size_t)(row0 + 32 * w + r) * 1024 + h * 256 + 4 * hh;
#pragma unroll
    for (int half = 0; half < 2; ++half) {
        f32x16 oacc[4];
#pragma unroll
        for (int d = 0; d < 4; ++d)
#pragma unroll
            for (int e = 0; e < 16; ++e) oacc[d][e] = 0.f;
#pragma unroll
        for (int mb = 0; mb < 8; ++mb)
#pragma unroll
            for (int s = 0; s < 2; ++s)
#pragma unroll
                for (int d = 0; d < 4; ++d) {
                    const unsigned char* base = lds + (32 * (half * 4 + d) + r) * 520 + (32 * mb + 16 * s + 4 * hh) * 2;
                    const bf16x8 a = mk8(*(const u32x2*)base, *(const u32x2*)(base + 16));
                    oacc[d] = mfma32(a, pf[mb][s], oacc[d]);
                }
#pragma unroll
        for (int d = 0; d < 4; ++d)
#pragma unroll
            for (int g = 0; g < 4; ++g) {
                u32x2 o; o.x = cvt_pk_bf16(oacc[d][4 * g] * inv, oacc[d][4 * g + 1] * inv); o.y = cvt_pk_bf16(oacc[d][4 * g + 2] * inv, oacc[d][4 * g + 3] * inv);
                *(u32x2*)(op + 32 * (half * 4 + d) + 8 * g) = o;
            }
    }
    __syncthreads();
}

__device__ __forceinline__ void phase_final(const bf16_t* __restrict__ xb, const float* __restrict__ ssq, float* __restrict__ out, const float* __restrict__ g) {
    const int tid = threadIdx.x, sub = tid >> 7, l = tid & 127;
    const f32x4 g0 = *(const f32x4*)(g + 8 * l), g1 = *(const f32x4*)(g + 8 * l + 4);
    for (int r = blockIdx.x * 4 + sub; r < MROWS; r += gridDim.x * 4) {
        const u32x4 v = *(const u32x4*)(xb + (size_t)r * DM + 8 * l);
        const f32x4* pp = (const f32x4*)(ssq + (size_t)r * 16); const f32x4 a = pp[0], b = pp[1], c = pp[2], d = pp[3];
        const float t = ((a[0] + a[1]) + (a[2] + a[3])) + ((b[0] + b[1]) + (b[2] + b[3])) + ((c[0] + c[1]) + (c[2] + c[3])) + ((d[0] + d[1]) + (d[2] + d[3]));
        const float rstd = rsqrtf(t * (1.0f / 1024.0f) + EPS);
        const f32x4 o0 = (f32x4){bflo(v.x), bfhi(v.x), bflo(v.y), bfhi(v.y)} * rstd * g0, o1 = (f32x4){bflo(v.z), bfhi(v.z), bflo(v.w), bfhi(v.w)} * rstd * g1;
        *(f32x4*)(out + (size_t)r * DM + 8 * l) = o0; *(f32x4*)(out + (size_t)r * DM + 8 * l + 4) = o1;
    }
}

#define XB_TMO      128
#define XB_XCNT(j)  (256  + 64 * (j))
#define XB_XSUB(j)  (1280 + 64 * (j))
#define XB_XGEN(j)  (2304 + 64 * (j))
#define XB_TOP      3328
#define XB_TOPGEN   3392
#define XCD_BAR_WORDS 3456
#define XB_SPIN_CAP (1u << 22)
__device__ __forceinline__ unsigned xb_ld(unsigned* p)              { return __hip_atomic_load(p, __ATOMIC_RELAXED, __HIP_MEMORY_SCOPE_AGENT); }
__device__ __forceinline__ unsigned xb_add(unsigned* p, unsigned v) { return __hip_atomic_fetch_add(p, v, __ATOMIC_RELAXED, __HIP_MEMORY_SCOPE_AGENT); }
__device__ __forceinline__ unsigned xb_xcc_id() { return (unsigned)__builtin_amdgcn_s_getreg((3 << 11) | 20) & 0xFu; }
#define XB_SPIN(cond, bar) do { unsigned _sp = 0; while (cond) { __builtin_amdgcn_s_sleep(1); \
    if ((++_sp & 255u) == 0u) { if (xb_ld(&(bar)[XB_TMO])) break; if (_sp > XB_SPIN_CAP) { atomicAdd(&(bar)[XB_TMO], 1u); break; } } } } while (0)
struct XcdBarrier { unsigned* bar; unsigned x; volatile LAS unsigned* st; };
__device__ __forceinline__ XcdBarrier xcd_barrier_post(unsigned* bar, volatile LAS unsigned* st) {
    XcdBarrier b; b.bar = bar; b.x = xb_xcc_id(); b.st = st;
    if (threadIdx.x == 0) (void)xb_add(&bar[XB_XCNT(b.x)], 1u);
    return b;
}
__device__ __forceinline__ void xcd_barrier_complete(unsigned* bar, unsigned x, unsigned& nloc, unsigned& nx) {
    const unsigned G = gridDim.x * gridDim.y * gridDim.z;
    unsigned sum, cnt, mine, sp = 0u;
    for (;;) {
        sum = 0u; cnt = 0u; mine = 0u;
#pragma unroll
        for (unsigned j = 0; j < 16; ++j) { const unsigned c = xb_ld(&bar[XB_XCNT(j)]); sum += c; cnt += (c > 0u) ? 1u : 0u; mine = (j == x) ? c : mine; }
        if (sum == G) break;
        __builtin_amdgcn_s_sleep(1);
        if ((++sp & 255u) == 0u) { if (xb_ld(&bar[XB_TMO])) break; if (sp > XB_SPIN_CAP) { atomicAdd(&bar[XB_TMO], 1u); break; } }
    }
    nloc = mine > 0u ? mine : 1u; nx = cnt > 0u ? cnt : 1u;
}
__device__ __forceinline__ void xcd_barrier(const XcdBarrier& b) {
    asm volatile("s_waitcnt vmcnt(0)" ::: "memory");
    __syncthreads();
    if (threadIdx.x == 0) {
        unsigned* bar = b.bar;
        __builtin_amdgcn_s_waitcnt(0);
        unsigned nloc = b.st[0], nx = b.st[1];
        if (nloc == 0u) { xcd_barrier_complete(bar, b.x, nloc, nx); b.st[0] = nloc; b.st[1] = nx; }
        const unsigned old = xb_add(&bar[XB_XSUB(b.x)], 1u);
        const unsigned gen = old / nloc;
        if (old + 1u == (gen + 1u) * nloc) {
            __builtin_amdgcn_fence(__ATOMIC_RELEASE, "agent");
            asm volatile("s_waitcnt vmcnt(0)" ::: "memory");
            const unsigned og = xb_add(&bar[XB_TOP], 1u);
            const unsigned tg = og / nx;
            if (og + 1u == (tg + 1u) * nx) xb_add(&bar[XB_TOPGEN], 1u);
            else XB_SPIN(xb_ld(&bar[XB_TOPGEN]) == tg, bar);
            __builtin_amdgcn_fence(__ATOMIC_ACQUIRE, "agent");
            xb_add(&bar[XB_XGEN(b.x)], 1u);
            asm volatile("s_waitcnt vmcnt(0)" ::: "memory");
        } else {
            XB_SPIN(xb_ld(&bar[XB_XGEN(b.x)]) == gen, bar);
            __builtin_amdgcn_fence(__ATOMIC_ACQUIRE, "agent");
            asm volatile("s_waitcnt vmcnt(0)" ::: "memory");
        }
    }
    __syncthreads();
}

constexpr int N_PHASES = 12;
__global__ void __launch_bounds__(NTHREADS, 2) mega(Params p) {
    extern __shared__ __attribute__((aligned(16))) unsigned char lds[];
    LAS unsigned char* ldsl = (LAS unsigned char*)lds;
    unsigned char* ws = p.ws;
    const int G = gridDim.x, bid = blockIdx.x;
    const int lo = p.ph_lo, hi = p.ph_hi;

#ifndef DEFER_PREP
#define DEFER_PREP 0
#endif
#ifndef FUSE_FINAL
#define FUSE_FINAL 0
#endif
#ifndef DBG_LAST
#define DBG_LAST -1
#endif
#ifndef PHASE_MASK
#define PHASE_MASK 0xfff
#endif
#define IN(k) (((PHASE_MASK >> (k)) & 1) && lo <= (k) && (k) < hi)
    if (threadIdx.x == 0) { ((volatile LAS unsigned*)(ldsl + LDS_MAIN))[0] = 0u; ((volatile LAS unsigned*)(ldsl + LDS_MAIN))[1] = 0u; }
    __syncthreads();
    XcdBarrier xbar; xbar.bar = (unsigned*)(ws + WS_BAR); xbar.x = 0; xbar.st = nullptr;
    if (hi - lo > 1) xbar = xcd_barrier_post((unsigned*)(ws + WS_BAR), (volatile LAS unsigned*)(ldsl + LDS_MAIN));
    if (lo > hi) cg::this_grid().sync();
#define SEAM(k) do { if (IN(k) && IN((k) + 1)) { xcd_barrier(xbar); } } while (0)
    bf16_t* XB = (bf16_t*)(ws + WS_XB); bf16_t* LT = (bf16_t*)(ws + WS_ST);
    bf16_t* QH = (bf16_t*)(ws + WS_QH); bf16_t* KH = (bf16_t*)(ws + WS_KH); bf16_t* VH = (bf16_t*)(ws + WS_VH); bf16_t* GH = (bf16_t*)(ws + WS_GH); bf16_t* PH = (bf16_t*)(ws + WS_PH);
    float* LF = (float*)(ws + WS_LF); bf16_t* ST = (bf16_t*)(ws + WS_ST); bf16_t* MIXED = (bf16_t*)(ws + WS_MIXED);
    float* X1 = (float*)(ws + WS_X1); bf16_t* XQ = (bf16_t*)(ws + WS_XQ); bf16_t* ATT = (bf16_t*)(ws + WS_ATT); bf16_t* U = (bf16_t*)(ws + WS_U);
    float* SSQ = (float*)(ws + WS_SSQ); float* DEC = (float*)(ws + WS_DEC);
    bf16_t* MEMB = (bf16_t*)(ws + WS_MEMB); bf16_t* KX = (bf16_t*)(ws + WS_KX); bf16_t* VT = (bf16_t*)(ws + WS_VT);

    const bool fuse_final = FUSE_FINAL && (G == 256) && IN(10) && (hi - lo > 1);
    if (IN(0)) { phase_prep(p, lds);
#if !DEFER_PREP
        deferred_prep(p, lds, bid, G);
#endif
    }
    SEAM(0);
    if (IN(1)) {
        const pg8::Epi E{0, ws, p.x, p.out, p.lb_logits, p.final_norm_g};
        { pg8::Gemm g{XB, (const bf16_t*)(ws + WS_WT_IN), MROWS, NIN, DM}; pg8::StaticOrder S; S.init(MROWS, NIN, G, bid); pg8::gemm_phase(ldsl, g, S, E); }
        const pg8::Epi E1{1, ws, p.x, p.out, p.lb_logits, p.final_norm_g};
        { pg8::Gemm g{MEMB, (const bf16_t*)(ws + WS_WT_K), MEMROWS, 1024, DM}; pg8::StaticOrder S; S.init(MEMROWS, 1024, G, (bid + 128) % G); pg8::gemm_phase(ldsl, g, S, E1); }
        const pg8::Epi E2{2, ws, p.x, p.out, p.lb_logits, p.final_norm_g};
        { pg8::Gemm g{(const bf16_t*)(ws + WS_WT_V), MEMB, 1024, MEMROWS, DM}; pg8::StaticOrder S; S.init(1024, MEMROWS, G, (bid + 112) % G); pg8::gemm_phase(ldsl, g, S, E2); }
#if DEFER_PREP
        if (G == 256) { if (bid >= 160) deferred_prep(p, lds, bid - 160, 96); }
        else deferred_prep(p, lds, bid, G);
#endif
    }
    SEAM(1);
    if (IN(2)) {
#ifndef DBG_NO_PASSA
        phase_passA(KH, LF, VH, LT, DEC, lds);
#endif
#ifndef DBG_NO_POOL
        for (int t = bid; t < 256; t += G) pool_tile(PH, MIXED, t);
#endif
        fold_pool_weights_mfma(p);
    }
    SEAM(2);
    if (IN(3)) { phase_scan(LT, DEC, ST); }
    SEAM(3);
    if (IN(4)) { phase_passC(QH, KH, LF, VH, GH, ST, p.hgrn_norm_g, MIXED, lds); }
    SEAM(4);
    if (IN(5)) {
        const pg8::Epi E{6, ws, p.x, p.out, p.lb_logits, p.final_norm_g};
        pg8::Gemm g{MIXED, (const bf16_t*)(ws + WS_WT_OUT), MROWS, DM, DM}; pg8::StaticOrder S; S.init(MROWS, DM, G, bid); pg8::gemm_phase(ldsl, g, S, E);
    }
    SEAM(5);
    const bool fuse_attn = (G == 256) && IN(6) && IN(7);
    if (IN(6)) {
        const pg8::Epi E{4, ws, p.x, p.out, p.lb_logits, p.final_norm_g};
        pg8::Gemm g{XB, (const bf16_t*)(ws + WS_WT_Q), MROWS, DM, DM}; pg8::StaticOrder S; S.init(MROWS, DM, G, bid); pg8::gemm_phase(ldsl, g, S, E);
        if (fuse_attn) {
            pg8::Unit u; S.next(0, u);
            asm volatile("s_waitcnt vmcnt(0)" ::: "memory"); __syncthreads();
            attn_unit(XQ, KX, VT, ATT, u.pm * 4 + u.pn, lds);
        }
    }
    if (!fuse_attn) {
        SEAM(6);
        if (IN(7)) { for (int u = bid; u < 256; u += G) attn_unit(XQ, KX, VT, ATT, u, lds); }
    }
    SEAM(7);
    if (IN(8)) {
        const pg8::Epi E{6, ws, p.x, p.out, p.lb_logits, p.final_norm_g};
        pg8::Gemm g{ATT, (const bf16_t*)(ws + WS_WT_O), MROWS, DM, DM}; pg8::StaticOrder S; S.init(MROWS, DM, G, bid); pg8::gemm_phase(ldsl, g, S, E);
    }
    SEAM(8);
    if (IN(9)) {
        const pg8::Epi E{5, ws, p.x, p.out, p.lb_logits, p.final_norm_g};
        pg8::Gemm g{XB, (const bf16_t*)(ws + WS_WT_FF1), MROWS, DFF, DM}; pg8::StaticOrder S; S.init(MROWS, DFF, G, bid); pg8::gemm_phase(ldsl, g, S, E);
    }
    SEAM(9);
    if (IN(10)) {
        const pg8::Epi E{fuse_final ? 8 : 7, ws, p.x, p.out, p.lb_logits, p.final_norm_g};
        pg8::Gemm g{U, (const bf16_t*)(ws + WS_WT_FF2), MROWS, DM, DFF}; pg8::StaticOrder S; S.init(MROWS, DM, G, bid); pg8::gemm_phase(ldsl, g, S, E);
    }
    if (!fuse_final) {
        SEAM(10);
        if (IN(11)) { phase_final(XB, SSQ, p.out, p.final_norm_g); }
    }
#if DBG_LAST >= 0
    cg::this_grid().sync();
    {
        const unsigned* w32 = (const unsigned*)ws;
        for (size_t i = (size_t)bid * NTHREADS + threadIdx.x; i < (size_t)MROWS * DM; i += (size_t)G * NTHREADS) {
            float a = 0.f;
            for (int j = 0; j < 4; ++j) { const unsigned v = w32[i + (size_t)j * MROWS * DM]; a += (float)(v & 0xffffu) + (float)(v >> 16); }
            p.out[i] = a;
        }
    }
#endif
#undef IN
#undef SEAM
}

extern "C" void kernel_launch(void* const* d_in, const int* in_sizes, int n_in, void* d_out, int out_size, void* d_ws, size_t ws_size, hipStream_t stream) {
    static int grid = 0;
    if (grid == 0) {
        if (n_in != 19 || in_sizes[0] != MROWS * DM || out_size != MROWS * DM || ws_size < WS_END) { fprintf(stderr, "kernel_launch: unexpected shapes (n_in %d, ws %zu)\n", n_in, ws_size); grid = -1; return; }
        int dev = 0, cus = 0, per_cu = 0;
        hipGetDevice(&dev); hipDeviceGetAttribute(&cus, hipDeviceAttributeMultiprocessorCount, dev);
        if (hipFuncSetAttribute((const void*)mega, hipFuncAttributeMaxDynamicSharedMemorySize, LDS_BYTES) != hipSuccess) { fprintf(stderr, "kernel_launch: hipFuncSetAttribute failed\n"); grid = -1; return; }
        if (hipOccupancyMaxActiveBlocksPerMultiprocessor(&per_cu, (const void*)mega, NTHREADS, LDS_BYTES) != hipSuccess || per_cu < 1) { fprintf(stderr, "kernel_launch: occupancy query says %d\n", per_cu); per_cu = 1; }
        (void)hipGetLastError();
        grid = cus * 1;
        if (grid > cus * per_cu) grid = cus * per_cu;
    }
    if (grid < 0) return;
    if (hipMemsetAsync((char*)d_ws + WS_BAR, 0, 32768, stream) != hipSuccess) { fprintf(stderr, "kernel_launch: memset of barrier words failed\n"); return; }
    Params p{};
    const float** f = (const float**)&p;
    for (int i = 0; i < 19; ++i) f[i] = (const float*)d_in[i];
    p.out = (float*)d_out; p.ws = (unsigned char*)d_ws;
#if N_LAUNCH_MODE == 1
    p.ph_lo = 0; p.ph_hi = (DBG_LAST >= 0) ? DBG_LAST + 1 : N_PHASES;
    void* args[] = {&p};
    hipError_t e = hipLaunchCooperativeKernel((const void*)mega, dim3(grid), dim3(NTHREADS), args, LDS_BYTES, stream);
    if (e != hipSuccess) fprintf(stderr, "kernel_launch: cooperative launch failed: %s (grid %d)\n", hipGetErrorString(e), grid);
#else
    for (int k = 0; k < N_PHASES; ++k) { p.ph_lo = k; p.ph_hi = k + 1; hipLaunchKernelGGL(mega, dim3(grid), dim3(NTHREADS), LDS_BYTES, stream, p); }
#endif
}
```

```cpp
#include <hip/hip_runtime.h>
#include <hip/hip_cooperative_groups.h>
#include <cstdio>
namespace cg = cooperative_groups;

#ifndef N_LAUNCH_MODE
#define N_LAUNCH_MODE 1
#endif

typedef unsigned short bf16_t;
typedef short bf16x8 __attribute__((ext_vector_type(8)));
typedef float f32x2 __attribute__((ext_vector_type(2)));
typedef float f32x4 __attribute__((ext_vector_type(4)));
typedef float f32x16 __attribute__((ext_vector_type(16)));
typedef unsigned u32x2 __attribute__((ext_vector_type(2)));
typedef unsigned u32x4 __attribute__((ext_vector_type(4)));
#define LAS __attribute__((address_space(3)))

constexpr int MROWS = 16384, DM = 1024, SEQ = 4096, NIN = 2560, DFF = 4096, MEMROWS = 1024;
constexpr float EPS = 1e-6f;
constexpr int NTHREADS = 512;
constexpr int LDS_MAIN = 135168;
constexpr int LDS_BYTES = LDS_MAIN + 16;

constexpr size_t MiB = 1u << 20;
constexpr size_t WS_WT_IN = 0, WS_WT_K = 5 * MiB, WS_WT_V = 7 * MiB, WS_WT_OUT = 9 * MiB, WS_WT_Q = 11 * MiB, WS_WT_O = 13 * MiB,
                 WS_WT_FF1 = 15 * MiB, WS_WT_FF2 = 23 * MiB, WS_MEMB = 31 * MiB, WS_KX = 33 * MiB, WS_VT = 35 * MiB, WS_SSQ = 37 * MiB,
                 WS_BAR = 39 * MiB, WS_CNT = 39 * MiB + 16384, WS_RSTD0 = 38 * MiB, WS_RSTDM = 38 * MiB + 65536, WS_DEC = 38 * MiB + 131072,
                 WS_XB = 40 * MiB  , WS_QH = 72 * MiB, WS_KH = 88 * MiB, WS_VH = 104 * MiB, WS_GH = 120 * MiB, WS_PH = 136 * MiB,
                 WS_LF = 152 * MiB, WS_ST = 184 * MiB, WS_MIXED = 216 * MiB,
                 WS_X1 = 72 * MiB, WS_XQ = 136 * MiB, WS_ATT = 168 * MiB, WS_U = 72 * MiB, WS_END = 256 * MiB;

typedef __bf16 bf16x2n __attribute__((ext_vector_type(2)));
__device__ __forceinline__ unsigned cvt_pk_bf16(float lo, float hi) { f32x2 v = {lo, hi}; return __builtin_bit_cast(unsigned, __builtin_convertvector(v, bf16x2n)); }
__device__ __forceinline__ bf16_t f2bf(float f) { return (bf16_t)(cvt_pk_bf16(f, 0.f) & 0xffffu); }
__device__ __forceinline__ float bf2f(bf16_t b) { return __uint_as_float(((unsigned)b) << 16); }
__device__ __forceinline__ float bflo(unsigned u) { return __uint_as_float(u << 16); }
__device__ __forceinline__ float bfhi(unsigned u) { return __uint_as_float(u & 0xffff0000u); }
__device__ __forceinline__ f32x4 mfma16(bf16x8 a, bf16x8 b, f32x4 c) { return __builtin_amdgcn_mfma_f32_16x16x32_bf16(a, b, c, 0, 0, 0); }
__device__ __forceinline__ f32x16 mfma32(bf16x8 a, bf16x8 b, f32x16 c) { return __builtin_amdgcn_mfma_f32_32x32x16_bf16(a, b, c, 0, 0, 0); }
__device__ __forceinline__ bf16x8 mk8(u32x2 lo, u32x2 hi) { u32x4 t; t.x = lo.x; t.y = lo.y; t.z = hi.x; t.w = hi.y; return __builtin_bit_cast(bf16x8, t); }
__device__ __forceinline__ bf16x8 mk8u(unsigned a, unsigned b, unsigned c, unsigned d) { u32x4 t; t.x = a; t.y = b; t.z = c; t.w = d; return __builtin_bit_cast(bf16x8, t); }
__device__ __forceinline__ float sigmoidf_(float z) { return 1.0f / (1.0f + __expf(-z)); }

namespace pg8 {
constexpr int BM = 256, BK = 64, HALF = 128, HTB = HALF * BK * 2, STAGE_BYTES = 8 * HTB, NXCD = 8, WGM = 8;
__device__ __forceinline__ int lds_byte(int r, int c) { const int st = (r >> 4) * 2 + (c >> 5), rr = r & 15, cc = c & 31, ob = rr * 64 + cc * 2; return st * 1024 + (ob ^ (((ob >> 9) & 1) << 5)); }
__device__ __forceinline__ void stage_rc(int b, int& R, int& C) { const int st = b / 1024, sb = b % 1024, swz = sb ^ (((sb >> 9) & 1) << 5); R = (st >> 1) * 16 + swz / 64; C = (st & 1) * 32 + (swz % 64) / 2; }
__device__ __forceinline__ int perm32(int rho) { const int n = rho >> 4, i = rho & 15; return 8 * (i >> 2) + 4 * n + (i & 3); }
struct Unit { int pm, pn; };
struct Gemm { const bf16_t* A; const bf16_t* Bt; int M, N, K; };
struct StaticOrder {
    int nM, nN, nwg, G, c;
    __device__ __forceinline__ void init(int M, int N, int G_, int c_) { nM = M / BM; nN = N / BM; nwg = nM * nN; G = G_; c = c_; }
    __device__ __forceinline__ bool next(int i, Unit& u) const {
        const long L = (long)i * G + c; if (L >= nwg) return false;
        int wgid = (int)L; { const int q = nwg / NXCD, r = nwg % NXCD, xcd = wgid % NXCD, off = wgid / NXCD; wgid = (xcd < r ? xcd * (q + 1) : r * (q + 1) + (xcd - r) * q) + off; }
        const int nig = WGM * nN, gid = wgid / nig, fm = gid * WGM, gsz = (nM - fm) < WGM ? (nM - fm) : WGM;
        u.pm = fm + ((wgid % nig) % gsz); u.pn = (wgid % nig) / gsz; return true;
    }
};

struct Epi {
    static constexpr bool PERM = true;
    int mode;
    unsigned char* ws; const float* x; float* out; const float* lbl; const float* gfin;
    __device__ __forceinline__ void store8(bf16_t* p, const f32x4& v0, const f32x4& v1) const {
        u32x4 w; w.x = cvt_pk_bf16(v0[0], v0[1]); w.y = cvt_pk_bf16(v0[2], v0[3]); w.z = cvt_pk_bf16(v1[0], v1[1]); w.w = cvt_pk_bf16(v1[2], v1[3]); *(u32x4*)p = w; }
    __device__ __forceinline__ void fused(f32x4 (&acc)[2][2][4][2], const Unit& u, int wr, int wc, int fr, int fq) const {
        const int row0 = u.pm * BM + wr * 64 + fr;
        const int col0 = u.pn * BM + wc * 32 + 8 * fq;
        const bf16_t* xb = (const bf16_t*)(ws + WS_XB);
        unsigned* sq = (unsigned*)(ws + WS_SSQ);
        unsigned* cnt = (unsigned*)(ws + WS_CNT) + 64 * u.pm;
        u32x4 bc[2], bn[2];
        { const size_t o = (size_t)row0 * DM + col0; bc[0] = *(const u32x4*)(xb + o); bc[1] = *(const u32x4*)(xb + o + HALF); }
#pragma unroll
        for (int gidx = 0; gidx < 8; ++gidx) { const int ai = gidx >> 2, m = gidx & 3; const int row = row0 + ai * HALF + m * 16;
            if (gidx < 7) { const int g2 = gidx + 1; const size_t o2 = (size_t)(row0 + (g2 >> 2) * HALF + (g2 & 3) * 16) * DM + col0; bn[0] = *(const u32x4*)(xb + o2); bn[1] = *(const u32x4*)(xb + o2 + HALF); }
            float ss = 0.f;
#pragma unroll
            for (int bj = 0; bj < 2; ++bj) { const u32x4 bb = bc[bj];
                const f32x4 v0 = acc[ai][bj][m][0] + (f32x4){bflo(bb.x), bfhi(bb.x), bflo(bb.y), bfhi(bb.y)}, v1 = acc[ai][bj][m][1] + (f32x4){bflo(bb.z), bfhi(bb.z), bflo(bb.w), bfhi(bb.w)};
                acc[ai][bj][m][0] = v0; acc[ai][bj][m][1] = v1;
                ss += (v0[0] * v0[0] + v0[1] * v0[1]) + (v0[2] * v0[2] + v0[3] * v0[3]) + (v1[0] * v1[0] + v1[1] * v1[1]) + (v1[2] * v1[2] + v1[3] * v1[3]); }
            ss += __shfl_xor(ss, 16); ss += __shfl_xor(ss, 32);
            if (fq == 0) __hip_atomic_store(sq + (size_t)row * 16 + u.pn * 4 + wc, __float_as_uint(ss), __ATOMIC_RELAXED, __HIP_MEMORY_SCOPE_AGENT);
            bc[0] = bn[0]; bc[1] = bn[1]; }
        asm volatile("s_waitcnt vmcnt(0)" ::: "memory");
        if ((threadIdx.x & 63) == 0) __hip_atomic_fetch_add(cnt, 1u, __ATOMIC_RELAXED, __HIP_MEMORY_SCOPE_AGENT);
        f32x4 gv[2][2];
#pragma unroll
        for (int bj = 0; bj < 2; ++bj) { gv[bj][0] = *(const f32x4*)(gfin + col0 + bj * HALF); gv[bj][1] = *(const f32x4*)(gfin + col0 + bj * HALF + 4); }
        { unsigned spins = 0; while ((unsigned)__builtin_amdgcn_readfirstlane(__hip_atomic_load(cnt, __ATOMIC_RELAXED, __HIP_MEMORY_SCOPE_AGENT)) < 32u) { __builtin_amdgcn_s_sleep(1); if (++spins > (1u << 22)) break; } }
        __builtin_amdgcn_fence(__ATOMIC_ACQUIRE, "agent");
        asm volatile("s_waitcnt vmcnt(0)" ::: "memory");
        f32x4 pv[8];
#pragma unroll
        for (int gidx = 0; gidx < 8; ++gidx) pv[gidx] = *(const f32x4*)((const float*)sq + (size_t)(row0 + (gidx >> 2) * HALF + (gidx & 3) * 16) * 16 + 4 * fq);
#pragma unroll
        for (int gidx = 0; gidx < 8; ++gidx) { const int ai = gidx >> 2, m = gidx & 3; const int row = row0 + ai * HALF + m * 16;
            float t = (pv[gidx][0] + pv[gidx][1]) + (pv[gidx][2] + pv[gidx][3]); t += __shfl_xor(t, 16); t += __shfl_xor(t, 32);
            const float rstd = rsqrtf(t * (1.0f / 1024.0f) + EPS);
            const size_t o = (size_t)row * DM + col0;
#pragma unroll
            for (int bj = 0; bj < 2; ++bj) { *(f32x4*)(out + o + bj * HALF) = acc[ai][bj][m][0] * rstd * gv[bj][0]; *(f32x4*)(out + o + bj * HALF + 4) = acc[ai][bj][m][1] * rstd * gv[bj][1]; } }
    }
    template <class Sched>
    __device__ __forceinline__ bool prefill(LAS unsigned char* lds, const Sched& S) const {
        if (!(mode == 0 || mode == 1 || mode == 4 || mode == 5) || S.nwg > 4 * S.G) return false;
        const int tid = threadIdx.x, rr = tid & 255;
#pragma unroll
        for (int k = 0; k < 2; ++k) { const int ui = (tid >> 8) + 2 * k; Unit u;
            if (S.next(ui, u)) { const int row = u.pm * BM + rr; float r;
                if (mode == 4 || mode == 5) { const f32x4* pp = (const f32x4*)((const float*)(ws + WS_SSQ) + (size_t)row * 16); const f32x4 a = pp[0], b = pp[1], c = pp[2], d = pp[3];
                    const float t = ((a[0] + a[1]) + (a[2] + a[3])) + ((b[0] + b[1]) + (b[2] + b[3])) + ((c[0] + c[1]) + (c[2] + c[3])) + ((d[0] + d[1]) + (d[2] + d[3]));
                    r = rsqrtf(t * (1.0f / 1024.0f) + EPS) * (mode == 4 ? 0.0625f : 1.0f); }
                else r = ((const float*)(ws + (mode == 0 ? WS_RSTD0 : WS_RSTDM)))[row];
                *(LAS float*)(lds + STAGE_BYTES + (ui * 256 + rr) * 4) = r; } }
        return true;
    }
    __device__ __forceinline__ void operator()(const f32x4 (&acc)[2][2][4][2], const Unit& u, int ui, bool tab, LAS unsigned char* lds, int wr, int wc, int fr, int fq) const {
        const int row0 = u.pm * BM + wr * 64 + fr;
        const int colL = wc * 32 + 8 * fq;
        if (mode == 3 || mode == 6 || mode == 7) {
            const int col0 = u.pn * BM + colL;
            bf16_t* xb = (bf16_t*)(ws + WS_XB);
            float* ssq = (float*)(ws + WS_SSQ);
            f32x4 rc[4], rn[4];
            u32x4 bc[2], bn[2];
            if (mode == 3) { const size_t o = (size_t)row0 * DM + col0; rc[0] = *(const f32x4*)(x + o); rc[1] = *(const f32x4*)(x + o + 4); rc[2] = *(const f32x4*)(x + o + HALF); rc[3] = *(const f32x4*)(x + o + HALF + 4); }
            else { const size_t o = (size_t)row0 * DM + col0; bc[0] = *(const u32x4*)(xb + o); bc[1] = *(const u32x4*)(xb + o + HALF); }
#pragma unroll
            for (int gidx = 0; gidx < 8; ++gidx) { const int ai = gidx >> 2, m = gidx & 3; const int row = row0 + ai * HALF + m * 16;
                if (gidx < 7) { const int g2 = gidx + 1; const size_t o2 = (size_t)(row0 + (g2 >> 2) * HALF + (g2 & 3) * 16) * DM + col0;
                    if (mode == 3) { rn[0] = *(const f32x4*)(x + o2); rn[1] = *(const f32x4*)(x + o2 + 4); rn[2] = *(const f32x4*)(x + o2 + HALF); rn[3] = *(const f32x4*)(x + o2 + HALF + 4); }
                    else { bn[0] = *(const u32x4*)(xb + o2); bn[1] = *(const u32x4*)(xb + o2 + HALF); } }
                if (mode != 3) {
#pragma unroll
                    for (int bj = 0; bj < 2; ++bj) { rc[2 * bj] = (f32x4){bflo(bc[bj].x), bfhi(bc[bj].x), bflo(bc[bj].y), bfhi(bc[bj].y)}; rc[2 * bj + 1] = (f32x4){bflo(bc[bj].z), bfhi(bc[bj].z), bflo(bc[bj].w), bfhi(bc[bj].w)}; } }
                float ss = 0.f;
#pragma unroll
                for (int bj = 0; bj < 2; ++bj) { const size_t o = (size_t)row * DM + col0 + bj * HALF;
                    const f32x4 v0 = acc[ai][bj][m][0] + rc[2 * bj], v1 = acc[ai][bj][m][1] + rc[2 * bj + 1];
                    store8(xb + o, v0, v1);
                    ss += (v0[0] * v0[0] + v0[1] * v0[1]) + (v0[2] * v0[2] + v0[3] * v0[3]) + (v1[0] * v1[0] + v1[1] * v1[1]) + (v1[2] * v1[2] + v1[3] * v1[3]); }
                ss += __shfl_xor(ss, 16); ss += __shfl_xor(ss, 32);
                if (fq == 0) ssq[(size_t)row * 16 + u.pn * 4 + wc] = ss;
#pragma unroll
                for (int k = 0; k < 4; ++k) rc[k] = rn[k];
                bc[0] = bn[0]; bc[1] = bn[1]; }
            return;
        }
        if (mode == 2) {
            const int col0 = u.pn * BM + colL;
            const float* rs = (const float*)(ws + WS_RSTDM); bf16_t* ob = (bf16_t*)(ws + WS_VT); const int ldo = 1024;
            f32x4 c0[2], c1[2];
#pragma unroll
            for (int bj = 0; bj < 2; ++bj) { c0[bj] = *(const f32x4*)(rs + col0 + bj * HALF); c1[bj] = *(const f32x4*)(rs + col0 + bj * HALF + 4); }
#pragma unroll
            for (int ai = 0; ai < 2; ++ai)
#pragma unroll
                for (int m = 0; m < 4; ++m) { const int row = row0 + ai * HALF + m * 16;
#pragma unroll
                    for (int bj = 0; bj < 2; ++bj) store8(ob + (size_t)row * ldo + col0 + bj * HALF, acc[ai][bj][m][0] * c0[bj], acc[ai][bj][m][1] * c1[bj]); }
            return;
        }
        float rsc[8];
        if (tab) {
#pragma unroll
            for (int gidx = 0; gidx < 8; ++gidx) rsc[gidx] = *(const LAS float*)(lds + STAGE_BYTES + (ui * 256 + wr * 64 + fr + (gidx >> 2) * HALF + (gidx & 3) * 16) * 4);
        } else if (mode == 4 || mode == 5) {
            const float* sq = (const float*)(ws + WS_SSQ);
            f32x4 pv[8];
#pragma unroll
            for (int gidx = 0; gidx < 8; ++gidx) pv[gidx] = *(const f32x4*)(sq + (size_t)(row0 + (gidx >> 2) * HALF + (gidx & 3) * 16) * 16 + 4 * fq);
            const float cs = mode == 4 ? 0.0625f : 1.0f;
#pragma unroll
            for (int gidx = 0; gidx < 8; ++gidx) { float t = (pv[gidx][0] + pv[gidx][1]) + (pv[gidx][2] + pv[gidx][3]); t += __shfl_xor(t, 16); t += __shfl_xor(t, 32); rsc[gidx] = rsqrtf(t * (1.0f / 1024.0f) + EPS) * cs; }
        } else {
            const float* rs = (const float*)(ws + (mode == 0 ? WS_RSTD0 : WS_RSTDM));
#pragma unroll
            for (int gidx = 0; gidx < 8; ++gidx) rsc[gidx] = rs[row0 + (gidx >> 2) * HALF + (gidx & 3) * 16];
        }
        if (mode == 0) {
            float* lf = (float*)(ws + WS_LF);
            const int sub = u.pn >> 1; const int cb = (u.pn & 1) * 256 + colL;
            if (sub == 1) {
                float oml[2][8];
#pragma unroll
                for (int bj = 0; bj < 2; ++bj)
#pragma unroll
                    for (int j = 0; j < 8; ++j) { const int c = cb + bj * HALF + j; const float l0 = lbl[c], l1 = lbl[512 + c]; const float lb = 1.0f / (1.0f + __expf(l1 - l0)); oml[bj][j] = 1.0f - lb; }
#pragma unroll
                for (int ai = 0; ai < 2; ++ai)
#pragma unroll
                    for (int m = 0; m < 4; ++m) { const int row = row0 + ai * HALF + m * 16; const float r = rsc[ai * 4 + m];
#pragma unroll
                        for (int bj = 0; bj < 2; ++bj) { f32x4 lf0, lf1;
#pragma unroll
                            for (int j = 0; j < 4; ++j) {
                                const float za = acc[ai][bj][m][0][j] * r, zb = acc[ai][bj][m][1][j] * r;
                                const float ka = oml[bj][j] * (1.0f - sigmoidf_(za)), kb = oml[bj][4 + j] * (1.0f - sigmoidf_(zb));
                                lf0[j] = __logf(1.0f - ka); lf1[j] = __logf(1.0f - kb); }
                            const size_t o = (size_t)row * 512 + cb + bj * HALF;
                            *(f32x4*)(lf + o) = lf0; *(f32x4*)(lf + o + 4) = lf1; } }
            } else {
                bf16_t* dst = (bf16_t*)(ws + (sub == 0 ? WS_QH : (sub == 2 ? WS_VH : (sub == 3 ? WS_GH : WS_PH))));
                const bool act = (sub == 0) || (sub == 3);
#pragma unroll
                for (int ai = 0; ai < 2; ++ai)
#pragma unroll
                    for (int m = 0; m < 4; ++m) { const int row = row0 + ai * HALF + m * 16; const float r = rsc[ai * 4 + m];
#pragma unroll
                        for (int bj = 0; bj < 2; ++bj) { f32x4 v0 = acc[ai][bj][m][0] * r, v1 = acc[ai][bj][m][1] * r;
                            if (act) {
#pragma unroll
                                for (int j = 0; j < 4; ++j) { v0[j] = v0[j] * sigmoidf_(v0[j]); v1[j] = v1[j] * sigmoidf_(v1[j]); } }
                            store8(dst + (size_t)row * 512 + cb + bj * HALF, v0, v1); } }
            }
        } else {
            const int col0 = u.pn * BM + colL;
            bf16_t* ob = (bf16_t*)(ws + (mode == 1 ? WS_KX : (mode == 4 ? WS_XQ : WS_U))); const int ldo = mode == 5 ? DFF : 1024;
#pragma unroll
            for (int ai = 0; ai < 2; ++ai)
#pragma unroll
                for (int m = 0; m < 4; ++m) { const int row = row0 + ai * HALF + m * 16; const float r = rsc[ai * 4 + m];
#pragma unroll
                    for (int bj = 0; bj < 2; ++bj) { f32x4 v0 = acc[ai][bj][m][0] * r, v1 = acc[ai][bj][m][1] * r;
                        if (mode == 5) {
#pragma unroll
                            for (int j = 0; j < 4; ++j) { const float a = fmaxf(v0[j], 0.f), b = fmaxf(v1[j], 0.f); v0[j] = a * a; v1[j] = b * b; } }
                        store8(ob + (size_t)row * ldo + col0 + bj * HALF, v0, v1); } }
        }
    }
};

template <class EpiT, class Sched>
__device__ __forceinline__ void gemm_phase(LAS unsigned char* lds, const Gemm g, const Sched S, const EpiT E) {
    const int tid = threadIdx.x, wid = __builtin_amdgcn_readfirstlane(tid >> 6), lane = tid & 63, wr = wid >> 2, wc = wid & 3, fr = lane & 15, fq = lane >> 4;
    const int K = g.K, nt = K / BK;
    unsigned voffA[2], voffB[2];
#pragma unroll
    for (int i = 0; i < 2; ++i) { int R, C; stage_rc(tid * 16 + i * 8192, R, C); const int Rb = EpiT::PERM ? ((R & ~31) + perm32(R & 31)) : R;
        voffA[i] = (unsigned)(R * K + C) * 2u; voffB[i] = (unsigned)(Rb * K + C) * 2u; }
    const size_t kstep = (size_t)(BK * 2);
    const size_t hstep = (size_t)HALF * K * 2;
    const size_t tstep = 2 * hstep;
    const unsigned ldsw = (unsigned)wid * 1024u;
    const int aoff = lds_byte(wr * 64 + fr, fq * 8), boff = lds_byte(wc * 32 + fr, fq * 8);
#define PG8_SA(b, h) (((b) * 2 + (h)) * HTB)
#define PG8_SB(b, h) ((4 + (b) * 2 + (h)) * HTB)
#define PG8_STAGE(bufoff, gbase, voff) do { _Pragma("unroll") for (int _i = 0; _i < 2; ++_i) \
        __builtin_amdgcn_global_load_lds((const unsigned*)((const char*)(gbase) + (voff)[_i]), (LAS unsigned*)(lds + (bufoff) + ldsw + _i * 8192), 16, 0, 0); } while (0)
#define PG8_LDA(dst, b, h) do { _Pragma("unroll") for (int m = 0; m < 4; ++m) _Pragma("unroll") for (int k = 0; k < 2; ++k) dst[m][k] = *(const LAS bf16x8*)(lds + PG8_SA(b, h) + aoff + m * 2048 + k * 1024); } while (0)
#define PG8_LDB(dst, b, h) do { _Pragma("unroll") for (int n = 0; n < 2; ++n) _Pragma("unroll") for (int k = 0; k < 2; ++k) dst[n][k] = *(const LAS bf16x8*)(lds + PG8_SB(b, h) + boff + n * 2048 + k * 1024); } while (0)
#define PG8_MMA(ai, bj, At, Bt) do { __builtin_amdgcn_s_setprio(1); _Pragma("unroll") for (int m = 0; m < 4; ++m) _Pragma("unroll") for (int n = 0; n < 2; ++n) _Pragma("unroll") for (int k = 0; k < 2; ++k) \
        acc[ai][bj][m][n] = __builtin_amdgcn_mfma_f32_16x16x32_bf16(Bt[n][k], At[m][k], acc[ai][bj][m][n], 0, 0, 0); __builtin_amdgcn_s_setprio(0); } while (0)
#define PG8_WAIT_V(n) asm volatile("s_waitcnt vmcnt(" #n ")" ::: "memory")
#define PG8_WAIT_L(n) asm volatile("s_waitcnt lgkmcnt(" #n ")" ::: "memory")
#define PG8_BAR __builtin_amdgcn_s_barrier()
#define PG8_SCHED __builtin_amdgcn_sched_barrier(0)
    Unit cur, nxt; int ui = 0;
    if (!S.next(0, cur)) return;
    const bool tab = E.prefill(lds, S);
    if (tab) __syncthreads();
    f32x4 acc[2][2][4][2];
#pragma unroll
    for (int a = 0; a < 2; ++a)
#pragma unroll
        for (int b = 0; b < 2; ++b)
#pragma unroll
            for (int m = 0; m < 4; ++m)
#pragma unroll
                for (int n = 0; n < 2; ++n) acc[a][b][m][n] = (f32x4){0.f, 0.f, 0.f, 0.f};
    bf16x8 At[4][2], B0[2][2], B1[2][2];
    const char* cA = (const char*)g.A + (size_t)cur.pm * tstep; const char* cB = (const char*)g.Bt + (size_t)cur.pn * tstep;
    PG8_STAGE(PG8_SB(0, 0), cB, voffB); PG8_STAGE(PG8_SA(0, 0), cA, voffA); PG8_STAGE(PG8_SB(0, 1), cB + hstep, voffB); PG8_STAGE(PG8_SA(0, 1), cA + hstep, voffA);
    if (wr == 1) PG8_BAR;
    PG8_WAIT_V(4); PG8_BAR;
    PG8_STAGE(PG8_SB(1, 0), cB + kstep, voffB); PG8_STAGE(PG8_SA(1, 0), cA + kstep, voffA); PG8_STAGE(PG8_SB(1, 1), cB + hstep + kstep, voffB);
    PG8_WAIT_V(6); PG8_BAR;
    for (;;) {
        const bool has_next = S.next(ui + 1, nxt);
        const char* nA = has_next ? (const char*)g.A + (size_t)nxt.pm * tstep : cA; const char* nB = has_next ? (const char*)g.Bt + (size_t)nxt.pn * tstep : cB;
        for (int t = 0; t < nt; t += 2) {
            const bool last = (t == nt - 2);
            const char* a1 = cA + (size_t)(t + 1) * kstep;
            const char* a2 = last ? nA : cA + (size_t)(t + 2) * kstep; const char* b2 = last ? nB : cB + (size_t)(t + 2) * kstep;
            const char* a3 = a2 + kstep; const char* b3 = b2 + kstep;
            PG8_LDB(B0, 0, 0); PG8_SCHED; PG8_LDA(At, 0, 0); PG8_STAGE(PG8_SA(1, 1), a1 + hstep, voffA);
            PG8_WAIT_L(8); PG8_BAR; PG8_WAIT_L(0); PG8_MMA(0, 0, At, B0); PG8_BAR; PG8_SCHED;
            PG8_LDB(B1, 0, 1); PG8_STAGE(PG8_SB(0, 0), b2, voffB);
            PG8_BAR; PG8_WAIT_L(0); PG8_MMA(0, 1, At, B1); PG8_BAR;
            PG8_LDA(At, 0, 1); PG8_STAGE(PG8_SA(0, 0), a2, voffA);
            PG8_BAR; PG8_WAIT_L(0); PG8_MMA(1, 0, At, B0); PG8_BAR; PG8_SCHED;
            PG8_STAGE(PG8_SB(0, 1), b2 + hstep, voffB);
            PG8_WAIT_V(6); PG8_BAR; PG8_MMA(1, 1, At, B1); PG8_BAR;
            PG8_LDB(B0, 1, 0); PG8_SCHED; PG8_LDA(At, 1, 0); PG8_STAGE(PG8_SA(0, 1), a2 + hstep, voffA);
            PG8_WAIT_L(8); PG8_BAR; PG8_WAIT_L(0); PG8_MMA(0, 0, At, B0); PG8_BAR; PG8_SCHED;
            PG8_LDB(B1, 1, 1); PG8_STAGE(PG8_SB(1, 0), b3, voffB);
            PG8_BAR; PG8_WAIT_L(0); PG8_MMA(0, 1, At, B1); PG8_BAR;
            PG8_LDA(At, 1, 1); PG8_STAGE(PG8_SA(1, 0), a3, voffA);
            PG8_BAR; PG8_WAIT_L(0); PG8_MMA(1, 0, At, B0); PG8_BAR; PG8_SCHED;
            PG8_STAGE(PG8_SB(1, 1), b3 + hstep, voffB);
            PG8_WAIT_V(6); PG8_BAR; PG8_MMA(1, 1, At, B1); PG8_BAR;
        }
        if (E.mode != 8) E(acc, cur, ui, tab, lds, wr, wc, fr, fq);
        if (!has_next) break;
#pragma unroll
        for (int a = 0; a < 2; ++a)
#pragma unroll
            for (int b = 0; b < 2; ++b)
#pragma unroll
                for (int m = 0; m < 4; ++m)
#pragma unroll
                    for (int n = 0; n < 2; ++n) acc[a][b][m][n] = (f32x4){0.f, 0.f, 0.f, 0.f};
        cur = nxt; cA = nA; cB = nB; ++ui;
    }
    PG8_WAIT_V(0);
    if (wr == 0) PG8_BAR;
    PG8_BAR;
    if (E.mode == 8) E.fused(acc, cur, wr, wc, fr, fq);
#undef PG8_SA
#undef PG8_SB
#undef PG8_STAGE
#undef PG8_LDA
#undef PG8_LDB
#undef PG8_MMA
#undef PG8_WAIT_V
#undef PG8_WAIT_L
#undef PG8_BAR
#undef PG8_SCHED
}
}

struct Params {
    const float *x, *mem, *norm_mix_g, *w_in, *lb_logits, *hgrn_norm_g, *w_pool, *pool_scale, *w_out, *norm_x_g, *norm_mem_g, *w_xq, *w_xk, *w_xv, *w_xo, *norm_ffn_g, *w_ff1, *w_ff2, *final_norm_g;
    float* out; unsigned char* ws;
    int ph_lo, ph_hi;
};

struct TD { const float* W; const float* g; bf16_t* out; int N, ldo, kt, nt; };
__device__ __forceinline__ TD tile_desc(const Params& p, int t) {
    unsigned char* ws = p.ws; TD d;
    if (t < 320)       { d.W = p.w_in;  d.g = p.norm_mix_g; d.out = (bf16_t*)(ws + WS_WT_IN);  d.N = NIN;  d.ldo = 1024; d.kt = t / 40; d.nt = t % 40; }
    else if (t < 448)  { const int u = t - 320;  d.W = p.w_xk;  d.g = p.norm_mem_g; d.out = (bf16_t*)(ws + WS_WT_K);   d.N = 1024; d.ldo = 1024; d.kt = u / 16; d.nt = u % 16; }
    else if (t < 576)  { const int u = t - 448;  d.W = p.w_xv;  d.g = p.norm_mem_g; d.out = (bf16_t*)(ws + WS_WT_V);   d.N = 1024; d.ldo = 1024; d.kt = u / 16; d.nt = u % 16; }
    else if (t < 704)  { const int u = t - 576;  d.W = p.w_xq;  d.g = p.norm_x_g;   d.out = (bf16_t*)(ws + WS_WT_Q);   d.N = 1024; d.ldo = 1024; d.kt = u / 16; d.nt = u % 16; }
    else if (t < 832)  { const int u = t - 704;  d.W = p.w_xo;  d.g = nullptr;      d.out = (bf16_t*)(ws + WS_WT_O);   d.N = 1024; d.ldo = 1024; d.kt = u / 16; d.nt = u % 16; }
    else if (t < 960)  { const int u = t - 832;  d.W = p.w_out; d.g = nullptr;      d.out = (bf16_t*)(ws + WS_WT_OUT); d.N = 1024; d.ldo = 1024; d.kt = u / 16; d.nt = u % 16; }
    else if (t < 1472) { const int u = t - 960;  d.W = p.w_ff1; d.g = p.norm_ffn_g; d.out = (bf16_t*)(ws + WS_WT_FF1); d.N = DFF;  d.ldo = 1024; d.kt = u / 64; d.nt = u % 64; }
    else               { const int u = t - 1472; d.W = p.w_ff2; d.g = nullptr;      d.out = (bf16_t*)(ws + WS_WT_FF2); d.N = 1024; d.ldo = 4096; d.kt = u / 16; d.nt = u % 16; }
    return d;
}
__device__ __forceinline__ void tile_load(const TD& d, f32x4 (&v)[4], float (&sc)[4]) {
    const int tid = threadIdx.x, r = tid >> 4, c4 = tid & 15;
#pragma unroll
    for (int i = 0; i < 4; ++i) { const int k = 128 * d.kt + r + 32 * i; v[i] = *(const f32x4*)(d.W + (size_t)k * d.N + 64 * d.nt + 4 * c4); sc[i] = d.g ? d.g[k] : 1.0f; }
}
__device__ __forceinline__ void transpose_range(const Params& p, unsigned char* lds, int t_begin, int t_end, int first, int stride) {
    bf16_t* T0 = (bf16_t*)lds;
    bf16_t* T1 = (bf16_t*)(lds + 17408);
    const int tid = threadIdx.x, r = tid >> 4, c4 = tid & 15, n = tid >> 3, ks = tid & 7;
    int ta = t_begin + first;
    if (ta >= t_end) return;
    int tb = ta + stride; bool hb = tb < t_end;
    TD da = tile_desc(p, ta), db = da; f32x4 va[4], vb[4]; float sa[4], sb[4];
    tile_load(da, va, sa);
    if (hb) { db = tile_desc(p, tb); tile_load(db, vb, sb); }
    for (;;) {
#pragma unroll
        for (int i = 0; i < 4; ++i) { const int kl = r + 32 * i;
            T0[(4 * c4 + 0) * 136 + kl] = f2bf(va[i][0] * sa[i]); T0[(4 * c4 + 1) * 136 + kl] = f2bf(va[i][1] * sa[i]);
            T0[(4 * c4 + 2) * 136 + kl] = f2bf(va[i][2] * sa[i]); T0[(4 * c4 + 3) * 136 + kl] = f2bf(va[i][3] * sa[i]); }
        if (hb) {
#pragma unroll
            for (int i = 0; i < 4; ++i) { const int kl = r + 32 * i;
                T1[(4 * c4 + 0) * 136 + kl] = f2bf(vb[i][0] * sb[i]); T1[(4 * c4 + 1) * 136 + kl] = f2bf(vb[i][1] * sb[i]);
                T1[(4 * c4 + 2) * 136 + kl] = f2bf(vb[i][2] * sb[i]); T1[(4 * c4 + 3) * 136 + kl] = f2bf(vb[i][3] * sb[i]); } }
        __syncthreads();
        const int tna = ta + 2 * stride, tnb = tna + stride; const bool hna = tna < t_end, hnb = tnb < t_end;
        const TD ca = da, cb = db; const bool chb = hb;
        if (hna) { da = tile_desc(p, tna); tile_load(da, va, sa); }
        if (hnb) { db = tile_desc(p, tnb); tile_load(db, vb, sb); }
        { const u32x4* src = (const u32x4*)(T0 + n * 136 + 16 * ks); const u32x4 a = src[0], b = src[1];
          u32x4* dst = (u32x4*)(ca.out + (size_t)(64 * ca.nt + n) * ca.ldo + 128 * ca.kt + 16 * ks); dst[0] = a; dst[1] = b; }
        if (chb) { const u32x4* src = (const u32x4*)(T1 + n * 136 + 16 * ks); const u32x4 a = src[0], b = src[1];
          u32x4* dst = (u32x4*)(cb.out + (size_t)(64 * cb.nt + n) * cb.ldo + 128 * cb.kt + 16 * ks); dst[0] = a; dst[1] = b; }
        __syncthreads();
        if (!hna) break;
        ta = tna; hb = hnb;
    }
}
__device__ __forceinline__ void phase_prep(const Params p, unsigned char* lds) {
    unsigned char* ws = p.ws;
    const int G = gridDim.x;
    {
        const int lane = threadIdx.x & 63, gw = blockIdx.x * (NTHREADS / 64) + (threadIdx.x >> 6), nw = G * (NTHREADS / 64);
        int r = gw;
        f32x4 v[4], vn[4];
        if (r < MROWS + MEMROWS) { const float* src = r < MROWS ? p.x + (size_t)r * DM : p.mem + (size_t)(r - MROWS) * DM;
#pragma unroll
            for (int i = 0; i < 4; ++i) v[i] = ((const f32x4*)src)[lane + 64 * i]; }
        for (; r < MROWS + MEMROWS; r += nw) {
            const int rn = r + nw;
            if (rn < MROWS + MEMROWS) { const float* src = rn < MROWS ? p.x + (size_t)rn * DM : p.mem + (size_t)(rn - MROWS) * DM;
#pragma unroll
                for (int i = 0; i < 4; ++i) vn[i] = ((const f32x4*)src)[lane + 64 * i]; }
            const bool isx = r < MROWS;
            bf16_t* dst = isx ? (bf16_t*)(ws + WS_XB) + (size_t)r * DM : (bf16_t*)(ws + WS_MEMB) + (size_t)(r - MROWS) * DM;
            float ss = 0.f;
#pragma unroll
            for (int i = 0; i < 4; ++i) ss += (v[i][0] * v[i][0] + v[i][1] * v[i][1]) + (v[i][2] * v[i][2] + v[i][3] * v[i][3]);
#pragma unroll
            for (int o = 1; o < 64; o <<= 1) ss += __shfl_xor(ss, o);
#pragma unroll
            for (int i = 0; i < 4; ++i) { u32x2 w; w.x = cvt_pk_bf16(v[i][0], v[i][1]); w.y = cvt_pk_bf16(v[i][2], v[i][3]); ((u32x2*)dst)[lane + 64 * i] = w; }
            if (lane == 0) { const float rstd = rsqrtf(ss * (1.0f / 1024.0f) + EPS); if (isx) ((float*)(ws + WS_RSTD0))[r] = rstd; else ((float*)(ws + WS_RSTDM))[r - MROWS] = rstd; }
#pragma unroll
            for (int i = 0; i < 4; ++i) v[i] = vn[i];
        }
    }
    transpose_range(p, lds, 0, 576, blockIdx.x, G);
}
__device__ __forceinline__ void deferred_prep(const Params p, unsigned char* lds, int j, int nworkers) {
    transpose_range(p, lds, 576, 1984, j, nworkers);
}
__device__ __forceinline__ void fold_pool_weights_mfma(const Params& p) {
    bf16_t* wto = (bf16_t*)(p.ws + WS_WT_OUT);
    const int tid = threadIdx.x, w = tid >> 6, lane = tid & 63, fr = lane & 15, q = lane >> 4;
    for (int item = blockIdx.x; item < 256; item += gridDim.x) {
        const int gi = item >> 6, nb = item & 63;
        f32x4 acc = (f32x4){0.f, 0.f, 0.f, 0.f};
        const float* wp = p.w_pool + (size_t)(gi * 128 + 16 * w + fr) * 128;
        const float* ps = p.pool_scale + gi * 128;
        const bf16_t* arow = wto + (size_t)(16 * nb + fr) * 1024 + 512 + gi * 128;
#pragma unroll
        for (int ks = 0; ks < 4; ++ks) {
            const int d0 = 32 * ks + 8 * q;
            const f32x4 w0 = *(const f32x4*)(wp + d0), w1 = *(const f32x4*)(wp + d0 + 4), s0 = *(const f32x4*)(ps + d0), s1 = *(const f32x4*)(ps + d0 + 4);
            const bf16x8 cfr = mk8u(cvt_pk_bf16(w0[0] * s0[0], w0[1] * s0[1]), cvt_pk_bf16(w0[2] * s0[2], w0[3] * s0[3]), cvt_pk_bf16(w1[0] * s1[0], w1[1] * s1[1]), cvt_pk_bf16(w1[2] * s1[2], w1[3] * s1[3]));
            const bf16x8 nfr = *(const bf16x8*)(arow + d0);
            acc = mfma16(cfr, nfr, acc);
        }
        asm volatile("s_waitcnt vmcnt(0)" ::: "memory");
        __syncthreads();
        u32x2 o; o.x = cvt_pk_bf16(acc[0], acc[1]); o.y = cvt_pk_bf16(acc[2], acc[3]);
        *(u32x2*)(wto + (size_t)(16 * nb + fr) * 1024 + 512 + gi * 128 + 16 * w + 4 * q) = o;
        __syncthreads();
    }
}

__device__ __forceinline__ void phase_passA(const bf16_t* __restrict__ KH, const float* __restrict__ LF, const bf16_t* __restrict__ VH, bf16_t* __restrict__ LT, float* __restrict__ DEC, unsigned char* lds) {
    const int tid = threadIdx.x, ch = tid & 127, seg = tid >> 7, G = gridDim.x;
    float* segtot = (float*)lds;
    unsigned char* KdT = lds + 2048;
    unsigned char* VTl = lds + 2048 + 18432;
    const int w = tid >> 6, lane = tid & 63, fr = lane & 15, q = lane >> 4;
    float lf[16], kk[16]; unsigned vr[16];
    int unit = blockIdx.x;
    if (unit < 1024) { const int b = unit >> 8, c = (unit >> 2) & 63, h = unit & 3; const size_t g0 = (size_t)(b * SEQ + c * 64 + seg * 16) * 512 + h * 128 + ch;
#pragma unroll
        for (int i = 0; i < 16; ++i) { lf[i] = LF[g0 + (size_t)i * 512]; vr[i] = VH[g0 + (size_t)i * 512]; } }
    for (; unit < 1024; unit += G) {
        const int b = unit >> 8, c = (unit >> 2) & 63, h = unit & 3, bh = b * 4 + h;
#pragma unroll
        for (int i = 0; i < 16; ++i) kk[i] = 1.0f - __expf(lf[i]);
#pragma unroll
        for (int i = 1; i < 16; ++i) lf[i] += lf[i - 1];
        segtot[seg * 128 + ch] = lf[15];
        __syncthreads();
        float after = 0.f;
#pragma unroll
        for (int s2 = 1; s2 < 4; ++s2) if (s2 > seg) after += segtot[s2 * 128 + ch];
        const float tot = after + lf[15];
        if (seg == 0) DEC[(size_t)(bh * 64 + c) * 128 + ch] = __expf(tot);
        unsigned kd[8], vp[8];
#pragma unroll
        for (int i = 0; i < 8; ++i) {
            kd[i] = cvt_pk_bf16(kk[2 * i] * __expf(tot - lf[2 * i]), kk[2 * i + 1] * __expf(tot - lf[2 * i + 1]));
            vp[i] = vr[2 * i] | (vr[2 * i + 1] << 16);
        }
        { u32x4* d = (u32x4*)(KdT + ch * 144 + seg * 32); d[0] = (u32x4){kd[0], kd[1], kd[2], kd[3]}; d[1] = (u32x4){kd[4], kd[5], kd[6], kd[7]}; }
        { u32x4* d = (u32x4*)(VTl + ch * 144 + seg * 32); d[0] = (u32x4){vp[0], vp[1], vp[2], vp[3]}; d[1] = (u32x4){vp[4], vp[5], vp[6], vp[7]}; }
        __syncthreads();
        {
            const int un = unit + G;
            if (un < 1024) { const int b2 = un >> 8, c2 = (un >> 2) & 63, h2 = un & 3; const size_t g0 = (size_t)(b2 * SEQ + c2 * 64 + seg * 16) * 512 + h2 * 128 + ch;
#pragma unroll
                for (int i = 0; i < 16; ++i) { lf[i] = LF[g0 + (size_t)i * 512]; vr[i] = VH[g0 + (size_t)i * 512]; } }
        }
        bf16x8 a[2];
#pragma unroll
        for (int ks = 0; ks < 2; ++ks) a[ks] = *(const bf16x8*)(KdT + (16 * w + fr) * 144 + (32 * ks + 8 * q) * 2);
        bf16_t* ltp = LT + (size_t)(bh * 64 + c) * 16384;
#pragma unroll
        for (int vb = 0; vb < 8; ++vb) {
            f32x4 acc = (f32x4){0.f, 0.f, 0.f, 0.f};
#pragma unroll
            for (int ks = 0; ks < 2; ++ks) { const bf16x8 bfr = *(const bf16x8*)(VTl + (16 * vb + fr) * 144 + (32 * ks + 8 * q) * 2); acc = mfma16(a[ks], bfr, acc); }
            u32x2 pk; pk.x = cvt_pk_bf16(acc[0], acc[1]); pk.y = cvt_pk_bf16(acc[2], acc[3]);
            *(u32x2*)(ltp + (size_t)(16 * vb + fr) * 128 + 16 * w + 4 * q) = pk;
        }
        __syncthreads();
    }
}

template <int W>
__device__ __forceinline__ void pool_body(const bf16_t* __restrict__ PH, bf16_t* __restrict__ MIXED, int r0, int s0, int c0) {
    unsigned v[31 + W];
#pragma unroll
    for (int j = 1; j < W; ++j) v[W - 1 - j] = (s0 - j >= 0) ? *(const unsigned*)(PH + (size_t)(r0 - j) * 512 + c0) : 0u;
#pragma unroll
    for (int tt = 0; tt < 32; ++tt) v[W - 1 + tt] = *(const unsigned*)(PH + (size_t)(r0 + tt) * 512 + c0);
    float sx = 0.f, sy = 0.f;
#pragma unroll
    for (int j = 1; j < W; ++j) { sx += bflo(v[W - 1 - j]); sy += bfhi(v[W - 1 - j]); }
#pragma unroll
    for (int tt = 0; tt < 32; ++tt) {
        const int s = s0 + tt;
        const float px = bflo(v[W - 1 + tt]), py = bfhi(v[W - 1 + tt]);
        sx += px; sy += py;
        const int cnt = (s + 1) < W ? (s + 1) : W;
        const float inv = 1.0f / (float)cnt;
        *(unsigned*)(MIXED + (size_t)(r0 + tt) * 1024 + 512 + c0) = cvt_pk_bf16(sx * inv - px, sy * inv - py);
        sx -= bflo(v[tt]); sy -= bfhi(v[tt]);
    }
}
__device__ __forceinline__ void pool_tile(const bf16_t* __restrict__ PH, bf16_t* __restrict__ MIXED, int tile) {
    const int tid = threadIdx.x, cp = tid & 255, th = tid >> 8, c0 = 2 * cp, gi = c0 >> 7;
    const int r0 = tile * 64 + th * 32, s0 = r0 & (SEQ - 1);
    if (gi == 0) pool_body<2>(PH, MIXED, r0, s0, c0);
    else if (gi == 1) pool_body<4>(PH, MIXED, r0, s0, c0);
    else if (gi == 2) pool_body<8>(PH, MIXED, r0, s0, c0);
    else pool_body<16>(PH, MIXED, r0, s0, c0);
}

__device__ __forceinline__ void phase_scan(const bf16_t* LT, const float* __restrict__ DEC, bf16_t* ST) {
    for (int e2 = blockIdx.x * NTHREADS + threadIdx.x; e2 < 131072; e2 += gridDim.x * NTHREADS) {
        const int bh = e2 >> 13, v = (e2 >> 6) & 127, kp = e2 & 63;
        float sx = 0.f, sy = 0.f;
        const size_t base = (size_t)bh * 64 * 16384 + (size_t)v * 128 + 2 * kp;
        const float* dp = DEC + (size_t)bh * 64 * 128 + 2 * kp;
        for (int c0 = 0; c0 < 64; c0 += 32) {
            unsigned l[32]; f32x2 d[32];
#pragma unroll
            for (int j = 0; j < 32; ++j) { l[j] = *(const unsigned*)(LT + base + (size_t)(c0 + j) * 16384); d[j] = *(const f32x2*)(dp + (c0 + j) * 128); }
#pragma unroll
            for (int j = 0; j < 32; ++j) {
                *(unsigned*)(ST + base + (size_t)(c0 + j) * 16384) = cvt_pk_bf16(sx, sy);
                sx = d[j][0] * sx + bflo(l[j]); sy = d[j][1] * sy + bfhi(l[j]);
            }
        }
    }
}

__device__ __forceinline__ void phase_passC(const bf16_t* __restrict__ QH, const bf16_t* __restrict__ KH, const float* __restrict__ LF, const bf16_t* __restrict__ VH, const bf16_t* __restrict__ GH,
                                const bf16_t* __restrict__ ST, const float* __restrict__ hg, bf16_t* __restrict__ MIXED, unsigned char* lds) {
    const int tid = threadIdx.x, ch = tid & 127, seg = tid >> 7, G = gridDim.x;
    float lf[16], kk[16]; unsigned qr[16], vr[16];
    int unit = blockIdx.x;
    if (unit < 1024) { const int b = unit >> 8, c = (unit >> 2) & 63, h = unit & 3; const size_t g0 = (size_t)(b * SEQ + c * 64 + seg * 16) * 512 + h * 128 + ch;
#pragma unroll
        for (int i = 0; i < 16; ++i) { lf[i] = LF[g0 + (size_t)i * 512]; vr[i] = VH[g0 + (size_t)i * 512]; qr[i] = QH[g0 + (size_t)i * 512]; } }
  for (; unit < 1024; unit += G) {
    const int b = unit >> 8, c = (unit >> 2) & 63, h = unit & 3;
    const int row0 = b * SEQ + c * 64, bh = b * 4 + h;
    float* segtot = (float*)lds;
    float* rmsp = (float*)(lds + 2048);
    bf16_t* QC = (bf16_t*)(lds + 4096);
    bf16_t* QT = (bf16_t*)(lds + 21504);
    constexpr int KT0 = 38912;
    unsigned char* VTl = lds + 82432;
    const int w = tid >> 6, lane = tid & 63, fr = lane & 15, q = lane >> 4;
    const int i = w & 3, vh = w >> 2;
    const size_t row = (size_t)(row0 + 16 * i + fr);
    u32x2 gt[4]; f32x4 gg[4]; bf16x8 stf[4][4];
    {
        const bf16_t* stp = ST + (size_t)(bh * 64 + c) * 16384;
#pragma unroll
        for (int vbl = 0; vbl < 4; ++vbl) { const int v0 = 16 * (vh * 4 + vbl) + 4 * q; gt[vbl] = *(const u32x2*)(GH + row * 512 + h * 128 + v0); gg[vbl] = *(const f32x4*)(hg + h * 128 + v0);
#pragma unroll
            for (int ks = 0; ks < 4; ++ks) stf[ks][vbl] = *(const bf16x8*)(stp + (size_t)(16 * (vh * 4 + vbl) + fr) * 128 + 32 * ks + 8 * q); }
    }
#pragma unroll
    for (int i2 = 0; i2 < 16; ++i2) kk[i2] = 1.0f - __expf(lf[i2]);
#pragma unroll
    for (int i2 = 1; i2 < 16; ++i2) lf[i2] += lf[i2 - 1];
    segtot[seg * 128 + ch] = lf[15];
    {
        unsigned vp[8];
#pragma unroll
        for (int i2 = 0; i2 < 8; ++i2) vp[i2] = vr[2 * i2] | (vr[2 * i2 + 1] << 16);
        u32x4* d = (u32x4*)(VTl + ch * 144 + seg * 32); d[0] = (u32x4){vp[0], vp[1], vp[2], vp[3]}; d[1] = (u32x4){vp[4], vp[5], vp[6], vp[7]};
    }
    __syncthreads();
    const float t0 = segtot[ch], t1 = segtot[128 + ch], t2 = segtot[256 + ch];
    const float P = (seg > 0 ? t0 : 0.f) + (seg > 1 ? t1 : 0.f) + (seg > 2 ? t2 : 0.f);
    {
        const float eP = __expf(P);
#pragma unroll
        for (int i2 = 0; i2 < 16; ++i2) {
            const float qv = bflo(qr[i2]);
            const float el = __expf(lf[i2]);
            QT[(seg * 16 + i2) * 136 + ch] = f2bf(qv * el);
            QC[(seg * 16 + i2) * 136 + ch] = f2bf(qv * el * eP);
        }
        float E = 0.f;
#pragma unroll
        for (int i2 = 0; i2 < 4; ++i2) {
            if (i2 >= seg) {
                bf16_t* KT = (bf16_t*)(lds + KT0 + 4352 * ((i2 * (i2 + 1)) / 2));
#pragma unroll
                for (int j = 0; j < 16; ++j) KT[(seg * 16 + j) * 136 + ch] = f2bf(kk[j] * __expf(E - lf[j]));
                E += (i2 == 0 ? t0 : (i2 == 1 ? t1 : t2));
            }
        }
    }
    __syncthreads();
    {
        const int un = unit + G;
        if (un < 1024) { const int b2 = un >> 8, c2 = (un >> 2) & 63, h2 = un & 3; const size_t g2 = (size_t)(b2 * SEQ + c2 * 64 + seg * 16) * 512 + h2 * 128 + ch;
#pragma unroll
            for (int i2 = 0; i2 < 16; ++i2) { lf[i2] = LF[g2 + (size_t)i2 * 512]; vr[i2] = VH[g2 + (size_t)i2 * 512]; qr[i2] = QH[g2 + (size_t)i2 * 512]; } }
    }
    f32x4 sT[4];
#pragma unroll
    for (int j = 0; j < 4; ++j) sT[j] = (f32x4){0.f, 0.f, 0.f, 0.f};
    {
        bf16x8 qfr[4];
#pragma unroll
        for (int ks = 0; ks < 4; ++ks) qfr[ks] = *(const bf16x8*)((const unsigned char*)QT + (16 * i + fr) * 272 + (32 * ks + 8 * q) * 2);
        const unsigned char* KT = lds + KT0 + 4352 * ((i * (i + 1)) / 2);
#pragma unroll
        for (int j = 0; j < 4; ++j) if (j <= i) {
#pragma unroll
            for (int ks = 0; ks < 4; ++ks) { const bf16x8 a = *(const bf16x8*)(KT + (16 * j + fr) * 272 + (32 * ks + 8 * q) * 2); sT[j] = mfma16(a, qfr[ks], sT[j]); }
            if (j == i) {
#pragma unroll
                for (int rg = 0; rg < 4; ++rg) if (4 * q + rg > fr) sT[j][rg] = 0.f;
            }
        }
    }
    f32x4 oacc[4];
#pragma unroll
    for (int vbl = 0; vbl < 4; ++vbl) oacc[vbl] = (f32x4){0.f, 0.f, 0.f, 0.f};
#pragma unroll
    for (int m = 0; m < 2; ++m) if (2 * m <= i) {
        const bf16x8 bfrag = mk8u(cvt_pk_bf16(sT[2 * m][0], sT[2 * m][1]), cvt_pk_bf16(sT[2 * m][2], sT[2 * m][3]), cvt_pk_bf16(sT[2 * m + 1][0], sT[2 * m + 1][1]), cvt_pk_bf16(sT[2 * m + 1][2], sT[2 * m + 1][3]));
#pragma unroll
        for (int vbl = 0; vbl < 4; ++vbl) {
            const unsigned char* base = VTl + (16 * (vh * 4 + vbl) + fr) * 144 + (32 * m + 4 * q) * 2;
            const bf16x8 a = mk8(*(const u32x2*)base, *(const u32x2*)(base + 32));
            oacc[vbl] = mfma16(a, bfrag, oacc[vbl]);
        }
    }
    {
#pragma unroll
        for (int ks = 0; ks < 4; ++ks) {
            const bf16x8 bfr = *(const bf16x8*)((const unsigned char*)QC + (16 * i + fr) * 272 + (32 * ks + 8 * q) * 2);
#pragma unroll
            for (int vbl = 0; vbl < 4; ++vbl) oacc[vbl] = mfma16(stf[ks][vbl], bfr, oacc[vbl]);
        }
    }
    float ss = 0.f;
#pragma unroll
    for (int vbl = 0; vbl < 4; ++vbl) ss += (oacc[vbl][0] * oacc[vbl][0] + oacc[vbl][1] * oacc[vbl][1]) + (oacc[vbl][2] * oacc[vbl][2] + oacc[vbl][3] * oacc[vbl][3]);
    ss += __shfl_xor(ss, 16); ss += __shfl_xor(ss, 32);
    if (q == 0) rmsp[vh * 64 + 16 * i + fr] = ss;
    __syncthreads();
    const float rstd = rsqrtf((rmsp[16 * i + fr] + rmsp[64 + 16 * i + fr]) * (1.0f / 128.0f) + EPS);
#pragma unroll
    for (int vbl = 0; vbl < 4; ++vbl) {
        const int v0 = 16 * (vh * 4 + vbl) + 4 * q;
        u32x2 o;
        o.x = cvt_pk_bf16(oacc[vbl][0] * rstd * gg[vbl][0] * bflo(gt[vbl].x), oacc[vbl][1] * rstd * gg[vbl][1] * bfhi(gt[vbl].x));
        o.y = cvt_pk_bf16(oacc[vbl][2] * rstd * gg[vbl][2] * bflo(gt[vbl].y), oacc[vbl][3] * rstd * gg[vbl][3] * bfhi(gt[vbl].y));
        *(u32x2*)(MIXED + row * 1024 + h * 128 + v0) = o;
    }
    __syncthreads();
  }
}

__device__ __forceinline__ void attn_unit(const bf16_t* __restrict__ XQ, const bf16_t* __restrict__ KX, const bf16_t* __restrict__ VT, bf16_t* __restrict__ ATT, int unit, unsigned char* lds) {
    const int tid = threadIdx.x, w = tid >> 6, lane = tid & 63, r = lane & 31, hh = lane >> 5;
    const int b = unit >> 6, st = (unit >> 2) & 15, h = unit & 3;
    const int row0 = b * SEQ + st * 256;
    const bf16_t* qp = XQ + (size_t)(row0 + 32 * w + r) * 1024 + h * 256 + 8 * hh;
    {
        const bf16_t* kp = KX + (size_t)(b * 256) * 1024 + h * 256;
#pragma unroll
        for (int it = 0; it < 16; ++it) { const int idx = tid + 512 * it, m = idx >> 5, cc = idx & 31;
            const u32x4 v = *(const u32x4*)(kp + (size_t)m * 1024 + cc * 8); *(u32x4*)(lds + m * 528 + cc * 16) = v; }
    }
    __syncthreads();
    f32x16 sacc[8];
#pragma unroll
    for (int mb = 0; mb < 8; ++mb)
#pragma unroll
        for (int e = 0; e < 16; ++e) sacc[mb][e] = 0.f;
    {
        bf16x8 qf[4], qn[4];
#pragma unroll
        for (int k4 = 0; k4 < 4; ++k4) qf[k4] = *(const bf16x8*)(qp + 16 * k4);
#pragma unroll
        for (int kg = 0; kg < 4; ++kg) {
            if (kg < 3) {
#pragma unroll
                for (int k4 = 0; k4 < 4; ++k4) qn[k4] = *(const bf16x8*)(qp + 16 * (4 * (kg + 1) + k4)); }
#pragma unroll
            for (int k4 = 0; k4 < 4; ++k4)
#pragma unroll
                for (int mb = 0; mb < 8; ++mb) { const bf16x8 a = *(const bf16x8*)(lds + (32 * mb + r) * 528 + (16 * (4 * kg + k4) + 8 * hh) * 2); sacc[mb] = mfma32(a, qf[k4], sacc[mb]); }
#pragma unroll
            for (int k4 = 0; k4 < 4; ++k4) qf[k4] = qn[k4];
        }
    }
    float mx = -3.0e38f;
#pragma unroll
    for (int mb = 0; mb < 8; ++mb)
#pragma unroll
        for (int e = 0; e < 16; ++e) mx = fmaxf(mx, sacc[mb][e]);
    mx = fmaxf(mx, __shfl_xor(mx, 32));
    float sum = 0.f;
    bf16x8 pf[8][2];
#pragma unroll
    for (int mb = 0; mb < 8; ++mb) {
        float pv[16];
#pragma unroll
        for (int e = 0; e < 16; ++e) { pv[e] = __expf(sacc[mb][e] - mx); sum += pv[e]; }
#pragma unroll
        for (int s = 0; s < 2; ++s) pf[mb][s] = mk8u(cvt_pk_bf16(pv[8 * s + 0], pv[8 * s + 1]), cvt_pk_bf16(pv[8 * s + 2], pv[8 * s + 3]), cvt_pk_bf16(pv[8 * s + 4], pv[8 * s + 5]), cvt_pk_bf16(pv[8 * s + 6], pv[8 * s + 7]));
    }
    sum += __shfl_xor(sum, 32);
    const float inv = 1.0f / sum;
    __syncthreads();
    {
        const bf16_t* vp = VT + (size_t)(h * 256) * 1024 + b * 256;
#pragma unroll
        for (int it = 0; it < 16; ++it) { const int idx = tid + 512 * it, e = idx >> 5, cc = idx & 31;
            const u32x4 v = *(const u32x4*)(vp + (size_t)e * 1024 + cc * 8);
            u32x2* d = (u32x2*)(lds + e * 520 + cc * 16); d[0] = (u32x2){v.x, v.y}; d[1] = (u32x2){v.z, v.w}; }
    }
    __syncthreads();
    bf16_t* op = ATT + (size_t)(row0 + 32 * w + r) * 1024 + h * 256 + 4 * hh;
#pragma unroll
    for (int half = 0; half < 2; ++half) {
        f32x16 oacc[4];
#pragma unroll
        for (int d = 0; d < 4; ++d)
#pragma unroll
            for (int e = 0; e < 16; ++e) oacc[d][e] = 0.f;
#pragma unroll
        for (int mb = 0; mb < 8; ++mb)
#pragma unroll
            for (int s = 0; s < 2; ++s)
#pragma unroll
                for (int d = 0; d < 4; ++d) {
                    const unsigned char* base = lds + (32 * (half * 4 + d) + r) * 520 + (32 * mb + 16 * s + 4 * hh) * 2;
                    const bf16x8 a = mk8(*(const u32x2*)base, *(const u32x2*)(base + 16));
                    oacc[d] = mfma32(a, pf[mb][s], oacc[d]);
                }
#pragma unroll
        for (int d = 0; d < 4; ++d)
#pragma unroll
            for (int g = 0; g < 4; ++g) {
                u32x2 o; o.x = cvt_pk_bf16(oacc[d][4 * g] * inv, oacc[d][4 * g + 1] * inv); o.y = cvt_pk_bf16(oacc[d][4 * g + 2] * inv, oacc[d][4 * g + 3] * inv);
                *(u32x2*)(op + 32 * (half * 4 + d) + 8 * g) = o;
            }
    }
    __syncthreads();
}

__device__ __forceinline__ void phase_final(const bf16_t* __restrict__ xb, const float* __restrict__ ssq, float* __restrict__ out, const float* __restrict__ g) {
    const int tid = threadIdx.x, sub = tid >> 7, l = tid & 127;
    const f32x4 g0 = *(const f32x4*)(g + 8 * l), g1 = *(const f32x4*)(g + 8 * l + 4);
    for (int r = blockIdx.x * 4 + sub; r < MROWS; r += gridDim.x * 4) {
        const u32x4 v = *(const u32x4*)(xb + (size_t)r * DM + 8 * l);
        const f32x4* pp = (const f32x4*)(ssq + (size_t)r * 16); const f32x4 a = pp[0], b = pp[1], c = pp[2], d = pp[3];
        const float t = ((a[0] + a[1]) + (a[2] + a[3])) + ((b[0] + b[1]) + (b[2] + b[3])) + ((c[0] + c[1]) + (c[2] + c[3])) + ((d[0] + d[1]) + (d[2] + d[3]));
        const float rstd = rsqrtf(t * (1.0f / 1024.0f) + EPS);
        const f32x4 o0 = (f32x4){bflo(v.x), bfhi(v.x), bflo(v.y), bfhi(v.y)} * rstd * g0, o1 = (f32x4){bflo(v.z), bfhi(v.z), bflo(v.w), bfhi(v.w)} * rstd * g1;
        *(f32x4*)(out + (size_t)r * DM + 8 * l) = o0; *(f32x4*)(out + (size_t)r * DM + 8 * l + 4) = o1;
    }
}

#define XB_TMO      128
#define XB_XCNT(j)  (256  + 64 * (j))
#define XB_XSUB(j)  (1280 + 64 * (j))
#define XB_XGEN(j)  (2304 + 64 * (j))
#define XB_TOP      3328
#define XB_TOPGEN   3392
#define XCD_BAR_WORDS 3456
#define XB_SPIN_CAP (1u << 22)
__device__ __forceinline__ unsigned xb_ld(unsigned* p)              { return __hip_atomic_load(p, __ATOMIC_RELAXED, __HIP_MEMORY_SCOPE_AGENT); }
__device__ __forceinline__ unsigned xb_add(unsigned* p, unsigned v) { return __hip_atomic_fetch_add(p, v, __ATOMIC_RELAXED, __HIP_MEMORY_SCOPE_AGENT); }
__device__ __forceinline__ unsigned xb_xcc_id() { return (unsigned)__builtin_amdgcn_s_getreg((3 << 11) | 20) & 0xFu; }
#define XB_SPIN(cond, bar) do { unsigned _sp = 0; while (cond) { __builtin_amdgcn_s_sleep(1); \
    if ((++_sp & 255u) == 0u) { if (xb_ld(&(bar)[XB_TMO])) break; if (_sp > XB_SPIN_CAP) { atomicAdd(&(bar)[XB_TMO], 1u); break; } } } } while (0)
struct XcdBarrier { unsigned* bar; unsigned x; volatile LAS unsigned* st; };
__device__ __forceinline__ XcdBarrier xcd_barrier_post(unsigned* bar, volatile LAS unsigned* st) {
    XcdBarrier b; b.bar = bar; b.x = xb_xcc_id(); b.st = st;
    if (threadIdx.x == 0) (void)xb_add(&bar[XB_XCNT(b.x)], 1u);
    return b;
}
__device__ __forceinline__ void xcd_barrier_complete(unsigned* bar, unsigned x, unsigned& nloc, unsigned& nx) {
    const unsigned G = gridDim.x * gridDim.y * gridDim.z;
    unsigned sum, cnt, mine, sp = 0u;
    for (;;) {
        sum = 0u; cnt = 0u; mine = 0u;
#pragma unroll
        for (unsigned j = 0; j < 16; ++j) { const unsigned c = xb_ld(&bar[XB_XCNT(j)]); sum += c; cnt += (c > 0u) ? 1u : 0u; mine = (j == x) ? c : mine; }
        if (sum == G) break;
        __builtin_amdgcn_s_sleep(1);
        if ((++sp & 255u) == 0u) { if (xb_ld(&bar[XB_TMO])) break; if (sp > XB_SPIN_CAP) { atomicAdd(&bar[XB_TMO], 1u); break; } }
    }
    nloc = mine > 0u ? mine : 1u; nx = cnt > 0u ? cnt : 1u;
}
__device__ __forceinline__ void xcd_barrier(const XcdBarrier& b) {
    asm volatile("s_waitcnt vmcnt(0)" ::: "memory");
    __syncthreads();
    if (threadIdx.x == 0) {
        unsigned* bar = b.bar;
        __builtin_amdgcn_s_waitcnt(0);
        unsigned nloc = b.st[0], nx = b.st[1];
        if (nloc == 0u) { xcd_barrier_complete(bar, b.x, nloc, nx); b.st[0] = nloc; b.st[1] = nx; }
        const unsigned old = xb_add(&bar[XB_XSUB(b.x)], 1u);
        const unsigned gen = old / nloc;
        if (old + 1u == (gen + 1u) * nloc) {
            __builtin_amdgcn_fence(__ATOMIC_RELEASE, "agent");
            asm volatile("s_waitcnt vmcnt(0)" ::: "memory");
            const unsigned og = xb_add(&bar[XB_TOP], 1u);
            const unsigned tg = og / nx;
            if (og + 1u == (tg + 1u) * nx) xb_add(&bar[XB_TOPGEN], 1u);
            else XB_SPIN(xb_ld(&bar[XB_TOPGEN]) == tg, bar);
            __builtin_amdgcn_fence(__ATOMIC_ACQUIRE, "agent");
            xb_add(&bar[XB_XGEN(b.x)], 1u);
            asm volatile("s_waitcnt vmcnt(0)" ::: "memory");
        } else {
            XB_SPIN(xb_ld(&bar[XB_XGEN(b.x)]) == gen, bar);
            __builtin_amdgcn_fence(__ATOMIC_ACQUIRE, "agent");
            asm volatile("s_waitcnt vmcnt(0)" ::: "memory");
        }
    }
    __syncthreads();
}

constexpr int N_PHASES = 12;
__global__ void __launch_bounds__(NTHREADS, 2) mega(Params p) {
    extern __shared__ __attribute__((aligned(16))) unsigned char lds[];
    LAS unsigned char* ldsl = (LAS unsigned char*)lds;
    unsigned char* ws = p.ws;
    const int G = gridDim.x, bid = blockIdx.x;
    const int lo = p.ph_lo, hi = p.ph_hi;

#ifndef DEFER_PREP
#define DEFER_PREP 0
#endif
#ifndef FUSE_FINAL
#define FUSE_FINAL 0
#endif
#ifndef DBG_LAST
#define DBG_LAST -1
#endif
#ifndef PHASE_MASK
#define PHASE_MASK 0xfff
#endif
#define IN(k) (((PHASE_MASK >> (k)) & 1) && lo <= (k) && (k) < hi)
    if (threadIdx.x == 0) { ((volatile LAS unsigned*)(ldsl + LDS_MAIN))[0] = 0u; ((volatile LAS unsigned*)(ldsl + LDS_MAIN))[1] = 0u; }
    __syncthreads();
    XcdBarrier xbar; xbar.bar = (unsigned*)(ws + WS_BAR); xbar.x = 0; xbar.st = nullptr;
    if (hi - lo > 1) xbar = xcd_barrier_post((unsigned*)(ws + WS_BAR), (volatile LAS unsigned*)(ldsl + LDS_MAIN));
    if (lo > hi) cg::this_grid().sync();
#define SEAM(k) do { if (IN(k) && IN((k) + 1)) { xcd_barrier(xbar); } } while (0)
    bf16_t* XB = (bf16_t*)(ws + WS_XB); bf16_t* LT = (bf16_t*)(ws + WS_ST);
    bf16_t* QH = (bf16_t*)(ws + WS_QH); bf16_t* KH = (bf16_t*)(ws + WS_KH); bf16_t* VH = (bf16_t*)(ws + WS_VH); bf16_t* GH = (bf16_t*)(ws + WS_GH); bf16_t* PH = (bf16_t*)(ws + WS_PH);
    float* LF = (float*)(ws + WS_LF); bf16_t* ST = (bf16_t*)(ws + WS_ST); bf16_t* MIXED = (bf16_t*)(ws + WS_MIXED);
    float* X1 = (float*)(ws + WS_X1); bf16_t* XQ = (bf16_t*)(ws + WS_XQ); bf16_t* ATT = (bf16_t*)(ws + WS_ATT); bf16_t* U = (bf16_t*)(ws + WS_U);
    float* SSQ = (float*)(ws + WS_SSQ); float* DEC = (float*)(ws + WS_DEC);
    bf16_t* MEMB = (bf16_t*)(ws + WS_MEMB); bf16_t* KX = (bf16_t*)(ws + WS_KX); bf16_t* VT = (bf16_t*)(ws + WS_VT);

    const bool fuse_final = FUSE_FINAL && (G == 256) && IN(10) && (hi - lo > 1);
    if (IN(0)) { phase_prep(p, lds);
#if !DEFER_PREP
        deferred_prep(p, lds, bid, G);
#endif
    }
    SEAM(0);
    if (IN(1)) {
        const pg8::Epi E{0, ws, p.x, p.out, p.lb_logits, p.final_norm_g};
        { pg8::Gemm g{XB, (const bf16_t*)(ws + WS_WT_IN), MROWS, NIN, DM}; pg8::StaticOrder S; S.init(MROWS, NIN, G, bid); pg8::gemm_phase(ldsl, g, S, E); }
        const pg8::Epi E1{1, ws, p.x, p.out, p.lb_logits, p.final_norm_g};
        { pg8::Gemm g{MEMB, (const bf16_t*)(ws + WS_WT_K), MEMROWS, 1024, DM}; pg8::StaticOrder S; S.init(MEMROWS, 1024, G, (bid + 128) % G); pg8::gemm_phase(ldsl, g, S, E1); }
        const pg8::Epi E2{2, ws, p.x, p.out, p.lb_logits, p.final_norm_g};
        { pg8::Gemm g{(const bf16_t*)(ws + WS_WT_V), MEMB, 1024, MEMROWS, DM}; pg8::StaticOrder S; S.init(1024, MEMROWS, G, (bid + 112) % G); pg8::gemm_phase(ldsl, g, S, E2); }
#if DEFER_PREP
        if (G == 256) { if (bid >= 160) deferred_prep(p, lds, bid - 160, 96); }
        else deferred_prep(p, lds, bid, G);
#endif
    }
    SEAM(1);
    if (IN(2)) {
#ifndef DBG_NO_PASSA
        phase_passA(KH, LF, VH, LT, DEC, lds);
#endif
#ifndef DBG_NO_POOL
        for (int t = bid; t < 256; t += G) pool_tile(PH, MIXED, t);
#endif
        fold_pool_weights_mfma(p);
    }
    SEAM(2);
    if (IN(3)) { phase_scan(LT, DEC, ST); }
    SEAM(3);
    if (IN(4)) { phase_passC(QH, KH, LF, VH, GH, ST, p.hgrn_norm_g, MIXED, lds); }
    SEAM(4);
    if (IN(5)) {
        const pg8::Epi E{6, ws, p.x, p.out, p.lb_logits, p.final_norm_g};
        pg8::Gemm g{MIXED, (const bf16_t*)(ws + WS_WT_OUT), MROWS, DM, DM}; pg8::StaticOrder S; S.init(MROWS, DM, G, bid); pg8::gemm_phase(ldsl, g, S, E);
    }
    SEAM(5);
    const bool fuse_attn = (G == 256) && IN(6) && IN(7);
    if (IN(6)) {
        const pg8::Epi E{4, ws, p.x, p.out, p.lb_logits, p.final_norm_g};
        pg8::Gemm g{XB, (const bf16_t*)(ws + WS_WT_Q), MROWS, DM, DM}; pg8::StaticOrder S; S.init(MROWS, DM, G, bid); pg8::gemm_phase(ldsl, g, S, E);
        if (fuse_attn) {
            pg8::Unit u; S.next(0, u);
            asm volatile("s_waitcnt vmcnt(0)" ::: "memory"); __syncthreads();
            attn_unit(XQ, KX, VT, ATT, u.pm * 4 + u.pn, lds);
        }
    }
    if (!fuse_attn) {
        SEAM(6);
        if (IN(7)) { for (int u = bid; u < 256; u += G) attn_unit(XQ, KX, VT, ATT, u, lds); }
    }
    SEAM(7);
    if (IN(8)) {
        const pg8::Epi E{6, ws, p.x, p.out, p.lb_logits, p.final_norm_g};
        pg8::Gemm g{ATT, (const bf16_t*)(ws + WS_WT_O), MROWS, DM, DM}; pg8::StaticOrder S; S.init(MROWS, DM, G, bid); pg8::gemm_phase(ldsl, g, S, E);
    }
    SEAM(8);
    if (IN(9)) {
        const pg8::Epi E{5, ws, p.x, p.out, p.lb_logits, p.final_norm_g};
        pg8::Gemm g{XB, (const bf16_t*)(ws + WS_WT_FF1), MROWS, DFF, DM}; pg8::StaticOrder S; S.init(MROWS, DFF, G, bid); pg8::gemm_phase(ldsl, g, S, E);
    }
    SEAM(9);
    if (IN(10)) {
        const pg8::Epi E{fuse_final ? 8 : 7, ws, p.x, p.out, p.lb_logits, p.final_norm_g};
        pg8::Gemm g{U, (const bf16_t*)(ws + WS_WT_FF2), MROWS, DM, DFF}; pg8::StaticOrder S; S.init(MROWS, DM, G, bid); pg8::gemm_phase(ldsl, g, S, E);
    }
    if (!fuse_final) {
        SEAM(10);
        if (IN(11)) { phase_final(XB, SSQ, p.out, p.final_norm_g); }
    }
#if DBG_LAST >= 0
    cg::this_grid().sync();
    {
        const unsigned* w32 = (const unsigned*)ws;
        for (size_t i = (size_t)bid * NTHREADS + threadIdx.x; i < (size_t)MROWS * DM; i += (size_t)G * NTHREADS) {
            float a = 0.f;
            for (int j = 0; j < 4; ++j) { const unsigned v = w32[i + (size_t)j * MROWS * DM]; a += (float)(v & 0xffffu) + (float)(v >> 16); }
            p.out[i] = a;
        }
    }
#endif
#undef IN
#undef SEAM
}

extern "C" void kernel_launch(void* const* d_in, const int* in_sizes, int n_in, void* d_out, int out_size, void* d_ws, size_t ws_size, hipStream_t stream) {
    static int grid = 0;
    if (grid == 0) {
        if (n_in != 19 || in_sizes[0] != MROWS * DM || out_size != MROWS * DM || ws_size < WS_END) { fprintf(stderr, "kernel_launch: unexpected shapes (n_in %d, ws %zu)\n", n_in, ws_size); grid = -1; return; }
        int dev = 0, cus = 0, per_cu = 0;
        hipGetDevice(&dev); hipDeviceGetAttribute(&cus, hipDeviceAttributeMultiprocessorCount, dev);
        if (hipFuncSetAttribute((const void*)mega, hipFuncAttributeMaxDynamicSharedMemorySize, LDS_BYTES) != hipSuccess) { fprintf(stderr, "kernel_launch: hipFuncSetAttribute failed\n"); grid = -1; return; }
        if (hipOccupancyMaxActiveBlocksPerMultiprocessor(&per_cu, (const void*)mega, NTHREADS, LDS_BYTES) != hipSuccess || per_cu < 1) { fprintf(stderr, "kernel_launch: occupancy query says %d\n", per_cu); per_cu = 1; }
        (void)hipGetLastError();
        grid = cus * 1;
        if (grid > cus * per_cu) grid = cus * per_cu;
    }
    if (grid < 0) return;
    if (hipMemsetAsync((char*)d_ws + WS_BAR, 0, 32768, stream) != hipSuccess) { fprintf(stderr, "kernel_launch: memset of barrier words failed\n"); return; }
    Params p{};
    const float** f = (const float**)&p;
    for (int i = 0; i < 19; ++i) f[i] = (const float*)d_in[i];
    p.out = (float*)d_out; p.ws = (unsigned char*)d_ws;
#if N_LAUNCH_MODE == 1
    p.ph_lo = 0; p.ph_hi = (DBG_LAST >= 0) ? DBG_LAST + 1 : N_PHASES;
    void* args[] = {&p};
    hipError_t e = hipLaunchCooperativeKernel((const void*)mega, dim3(grid), dim3(NTHREADS), args, LDS_BYTES, stream);
    if (e != hipSuccess) fprintf(stderr, "kernel_launch: cooperative launch failed: %s (grid %d)\n", hipGetErrorString(e), grid);
#else
    for (int k = 0; k < N_PHASES; ++k) { p.ph_lo = k; p.ph_hi = k + 1; hipLaunchKernelGGL(mega, dim3(grid), dim3(NTHREADS), LDS_BYTES, stream, p); }
#endif
}
```

```cpp
#include <hip/hip_runtime.h>
#include <hip/hip_cooperative_groups.h>
#include <cstdio>
namespace cg = cooperative_groups;

#ifndef N_LAUNCH_MODE
#define N_LAUNCH_MODE 1
#endif

typedef unsigned short bf16_t;
typedef short bf16x8 __attribute__((ext_vector_type(8)));
typedef float f32x2 __attribute__((ext_vector_type(2)));
typedef float f32x4 __attribute__((ext_vector_type(4)));
typedef float f32x16 __attribute__((ext_vector_type(16)));
typedef unsigned u32x2 __attribute__((ext_vector_type(2)));
typedef unsigned u32x4 __attribute__((ext_vector_type(4)));
#define LAS __attribute__((address_space(3)))

constexpr int MROWS = 16384, DM = 1024, SEQ = 4096, NIN = 2560, DFF = 4096, MEMROWS = 1024;
constexpr float EPS = 1e-6f;
constexpr int NTHREADS = 512;
constexpr int LDS_MAIN = 135168;
constexpr int LDS_BYTES = LDS_MAIN + 16;

constexpr size_t MiB = 1u << 20;
constexpr size_t WS_WT_IN = 0, WS_WT_K = 5 * MiB, WS_WT_V = 7 * MiB, WS_WT_OUT = 9 * MiB, WS_WT_Q = 11 * MiB, WS_WT_O = 13 * MiB,
                 WS_WT_FF1 = 15 * MiB, WS_WT_FF2 = 23 * MiB, WS_MEMB = 31 * MiB, WS_KX = 33 * MiB, WS_VT = 35 * MiB, WS_SSQ = 37 * MiB,
                 WS_BAR = 39 * MiB, WS_CNT = 39 * MiB + 16384, WS_RSTD0 = 38 * MiB, WS_RSTDM = 38 * MiB + 65536, WS_DEC = 38 * MiB + 131072,
                 WS_XB = 40 * MiB  , WS_QH = 72 * MiB, WS_KH = 88 * MiB, WS_VH = 104 * MiB, WS_GH = 120 * MiB, WS_PH = 136 * MiB,
                 WS_LF = 152 * MiB, WS_ST = 184 * MiB, WS_MIXED = 216 * MiB,
                 WS_X1 = 72 * MiB, WS_XQ = 136 * MiB, WS_ATT = 168 * MiB, WS_U = 72 * MiB, WS_END = 256 * MiB;

typedef __bf16 bf16x2n __attribute__((ext_vector_type(2)));
__device__ __forceinline__ unsigned cvt_pk_bf16(float lo, float hi) { f32x2 v = {lo, hi}; return __builtin_bit_cast(unsigned, __builtin_convertvector(v, bf16x2n)); }
__device__ __forceinline__ bf16_t f2bf(float f) { return (bf16_t)(cvt_pk_bf16(f, 0.f) & 0xffffu); }
__device__ __forceinline__ float bf2f(bf16_t b) { return __uint_as_float(((unsigned)b) << 16); }
__device__ __forceinline__ float bflo(unsigned u) { return __uint_as_float(u << 16); }
__device__ __forceinline__ float bfhi(unsigned u) { return __uint_as_float(u & 0xffff0000u); }
__device__ __forceinline__ f32x4 mfma16(bf16x8 a, bf16x8 b, f32x4 c) { return __builtin_amdgcn_mfma_f32_16x16x32_bf16(a, b, c, 0, 0, 0); }
__device__ __forceinline__ f32x16 mfma32(bf16x8 a, bf16x8 b, f32x16 c) { return __builtin_amdgcn_mfma_f32_32x32x16_bf16(a, b, c, 0, 0, 0); }
__device__ __forceinline__ bf16x8 mk8(u32x2 lo, u32x2 hi) { u32x4 t; t.x = lo.x; t.y = lo.y; t.z = hi.x; t.w = hi.y; return __builtin_bit_cast(bf16x8, t); }
__device__ __forceinline__ bf16x8 mk8u(unsigned a, unsigned b, unsigned c, unsigned d) { u32x4 t; t.x = a; t.y = b; t.z = c; t.w = d; return __builtin_bit_cast(bf16x8, t); }
__device__ __forceinline__ float sigmoidf_(float z) { return 1.0f / (1.0f + __expf(-z)); }

namespace pg8 {
constexpr int BM = 256, BK = 64, HALF = 128, HTB = HALF * BK * 2, STAGE_BYTES = 8 * HTB, NXCD = 8, WGM = 8;
__device__ __forceinline__ int lds_byte(int r, int c) { const int st = (r >> 4) * 2 + (c >> 5), rr = r & 15, cc = c & 31, ob = rr * 64 + cc * 2; return st * 1024 + (ob ^ (((ob >> 9) & 1) << 5)); }
__device__ __forceinline__ void stage_rc(int b, int& R, int& C) { const int st = b / 1024, sb = b % 1024, swz = sb ^ (((sb >> 9) & 1) << 5); R = (st >> 1) * 16 + swz / 64; C = (st & 1) * 32 + (swz % 64) / 2; }
__device__ __forceinline__ int perm32(int rho) { const int n = rho >> 4, i = rho & 15; return 8 * (i >> 2) + 4 * n + (i & 3); }
struct Unit { int pm, pn; };
struct Gemm { const bf16_t* A; const bf16_t* Bt; int M, N, K; };
struct StaticOrder {
    int nM, nN, nwg, G, c;
    __device__ __forceinline__ void init(int M, int N, int G_, int c_) { nM = M / BM; nN = N / BM; nwg = nM * nN; G = G_; c = c_; }
    __device__ __forceinline__ bool next(int i, Unit& u) const {
        const long L = (long)i * G + c; if (L >= nwg) return false;
        int wgid = (int)L; { const int q = nwg / NXCD, r = nwg % NXCD, xcd = wgid % NXCD, off = wgid / NXCD; wgid = (xcd < r ? xcd * (q + 1) : r * (q + 1) + (xcd - r) * q) + off; }
        const int nig = WGM * nN, gid = wgid / nig, fm = gid * WGM, gsz = (nM - fm) < WGM ? (nM - fm) : WGM;
        u.pm = fm + ((wgid % nig) % gsz); u.pn = (wgid % nig) / gsz; return true;
    }
};

struct Epi {
    static constexpr bool PERM = true;
    int mode;
    unsigned char* ws; const float* x; float* out; const float* lbl; const float* gfin;
    __device__ __forceinline__ void store8(bf16_t* p, const f32x4& v0, const f32x4& v1) const {
        u32x4 w; w.x = cvt_pk_bf16(v0[0], v0[1]); w.y = cvt_pk_bf16(v0[2], v0[3]); w.z = cvt_pk_bf16(v1[0], v1[1]); w.w = cvt_pk_bf16(v1[2], v1[3]); *(u32x4*)p = w; }
    __device__ __forceinline__ void fused(f32x4 (&acc)[2][2][4][2], const Unit& u, int wr, int wc, int fr, int fq) const {
        const int row0 = u.pm * BM + wr * 64 + fr;
        const int col0 = u.pn * BM + wc * 32 + 8 * fq;
        const bf16_t* xb = (const bf16_t*)(ws + WS_XB);
        unsigned* sq = (unsigned*)(ws + WS_SSQ);
        unsigned* cnt = (unsigned*)(ws + WS_CNT) + 64 * u.pm;
        u32x4 bc[2], bn[2];
        { const size_t o = (size_t)row0 * DM + col0; bc[0] = *(const u32x4*)(xb + o); bc[1] = *(const u32x4*)(xb + o + HALF); }
#pragma unroll
        for (int gidx = 0; gidx < 8; ++gidx) { const int ai = gidx >> 2, m = gidx & 3; const int row = row0 + ai * HALF + m * 16;
            if (gidx < 7) { const int g2 = gidx + 1; const size_t o2 = (size_t)(row0 + (g2 >> 2) * HALF + (g2 & 3) * 16) * DM + col0; bn[0] = *(const u32x4*)(xb + o2); bn[1] = *(const u32x4*)(xb + o2 + HALF); }
            float ss = 0.f;
#pragma unroll
            for (int bj = 0; bj < 2; ++bj) { const u32x4 bb = bc[bj];
                const f32x4 v0 = acc[ai][bj][m][0] + (f32x4){bflo(bb.x), bfhi(bb.x), bflo(bb.y), bfhi(bb.y)}, v1 = acc[ai][bj][m][1] + (f32x4){bflo(bb.z), bfhi(bb.z), bflo(bb.w), bfhi(bb.w)};
                acc[ai][bj][m][0] = v0; acc[ai][bj][m][1] = v1;
                ss += (v0[0] * v0[0] + v0[1] * v0[1]) + (v0[2] * v0[2] + v0[3] * v0[3]) + (v1[0] * v1[0] + v1[1] * v1[1]) + (v1[2] * v1[2] + v1[3] * v1[3]); }
            ss += __shfl_xor(ss, 16); ss += __shfl_xor(ss, 32);
            if (fq == 0) __hip_atomic_store(sq + (size_t)row * 16 + u.pn * 4 + wc, __float_as_uint(ss), __ATOMIC_RELAXED, __HIP_MEMORY_SCOPE_AGENT);
            bc[0] = bn[0]; bc[1] = bn[1]; }
        asm volatile("s_waitcnt vmcnt(0)" ::: "memory");
        if ((threadIdx.x & 63) == 0) __hip_atomic_fetch_add(cnt, 1u, __ATOMIC_RELAXED, __HIP_MEMORY_SCOPE_AGENT);
        f32x4 gv[2][2];
#pragma unroll
        for (int bj = 0; bj < 2; ++bj) { gv[bj][0] = *(const f32x4*)(gfin + col0 + bj * HALF); gv[bj][1] = *(const f32x4*)(gfin + col0 + bj * HALF + 4); }
        { unsigned spins = 0; while ((unsigned)__builtin_amdgcn_readfirstlane(__hip_atomic_load(cnt, __ATOMIC_RELAXED, __HIP_MEMORY_SCOPE_AGENT)) < 32u) { __builtin_amdgcn_s_sleep(1); if (++spins > (1u << 22)) break; } }
        __builtin_amdgcn_fence(__ATOMIC_ACQUIRE, "agent");
        asm volatile("s_waitcnt vmcnt(0)" ::: "memory");
        f32x4 pv[8];
#pragma unroll
        for (int gidx = 0; gidx < 8; ++gidx) pv[gidx] = *(const f32x4*)((const float*)sq + (size_t)(row0 + (gidx >> 2) * HALF + (gidx & 3) * 16) * 16 + 4 * fq);
#pragma unroll
        for (int gidx = 0; gidx < 8; ++gidx) { const int ai = gidx >> 2, m = gidx & 3; const int row = row0 + ai * HALF + m * 16;
            float t = (pv[gidx][0] + pv[gidx][1]) + (pv[gidx][2] + pv[gidx][3]); t += __shfl_xor(t, 16); t += __shfl_xor(t, 32);
            const float rstd = rsqrtf(t * (1.0f / 1024.0f) + EPS);
            const size_t o = (size_t)row * DM + col0;
#pragma unroll
            for (int bj = 0; bj < 2; ++bj) { *(f32x4*)(out + o + bj * HALF) = acc[ai][bj][m][0] * rstd * gv[bj][0]; *(f32x4*)(out + o + bj * HALF + 4) = acc[ai][bj][m][1] * rstd * gv[bj][1]; } }
    }
    template <class Sched>
    __device__ __forceinline__ bool prefill(LAS unsigned char* lds, const Sched& S) const {
        if (!(mode == 0 || mode == 1 || mode == 4 || mode == 5) || S.nwg > 4 * S.G) return false;
        const int tid = threadIdx.x, rr = tid & 255;
#pragma unroll
        for (int k = 0; k < 2; ++k) { const int ui = (tid >> 8) + 2 * k; Unit u;
            if (S.next(ui, u)) { const int row = u.pm * BM + rr; float r;
                if (mode == 4 || mode == 5) { const f32x4* pp = (const f32x4*)((const float*)(ws + WS_SSQ) + (size_t)row * 16); const f32x4 a = pp[0], b = pp[1], c = pp[2], d = pp[3];
                    const float t = ((a[0] + a[1]) + (a[2] + a[3])) + ((b[0] + b[1]) + (b[2] + b[3])) + ((c[0] + c[1]) + (c[2] + c[3])) + ((d[0] + d[1]) + (d[2] + d[3]));
                    r = rsqrtf(t * (1.0f / 1024.0f) + EPS) * (mode == 4 ? 0.0625f : 1.0f); }
                else r = ((const float*)(ws + (mode == 0 ? WS_RSTD0 : WS_RSTDM)))[row];
                *(LAS float*)(lds + STAGE_BYTES + (ui * 256 + rr) * 4) = r; } }
        return true;
    }
    __device__ __forceinline__ void operator()(const f32x4 (&acc)[2][2][4][2], const Unit& u, int ui, bool tab, LAS unsigned char* lds, int wr, int wc, int fr, int fq) const {
        const int row0 = u.pm * BM + wr * 64 + fr;
        const int colL = wc * 32 + 8 * fq;
        if (mode == 3 || mode == 6 || mode == 7) {
            const int col0 = u.pn * BM + colL;
            bf16_t* xb = (bf16_t*)(ws + WS_XB);
            float* ssq = (float*)(ws + WS_SSQ);
            f32x4 rc[4], rn[4];
            u32x4 bc[2], bn[2];
            if (mode == 3) { const size_t o = (size_t)row0 * DM + col0; rc[0] = *(const f32x4*)(x + o); rc[1] = *(const f32x4*)(x + o + 4); rc[2] = *(const f32x4*)(x + o + HALF); rc[3] = *(const f32x4*)(x + o + HALF + 4); }
            else { const size_t o = (size_t)row0 * DM + col0; bc[0] = *(const u32x4*)(xb + o); bc[1] = *(const u32x4*)(xb + o + HALF); }
#pragma unroll
            for (int gidx = 0; gidx < 8; ++gidx) { const int ai = gidx >> 2, m = gidx & 3; const int row = row0 + ai * HALF + m * 16;
                if (gidx < 7) { const int g2 = gidx + 1; const size_t o2 = (size_t)(row0 + (g2 >> 2) * HALF + (g2 & 3) * 16) * DM + col0;
                    if (mode == 3) { rn[0] = *(const f32x4*)(x + o2); rn[1] = *(const f32x4*)(x + o2 + 4); rn[2] = *(const f32x4*)(x + o2 + HALF); rn[3] = *(const f32x4*)(x + o2 + HALF + 4); }
                    else { bn[0] = *(const u32x4*)(xb + o2); bn[1] = *(const u32x4*)(xb + o2 + HALF); } }
                if (mode != 3) {
#pragma unroll
                    for (int bj = 0; bj < 2; ++bj) { rc[2 * bj] = (f32x4){bflo(bc[bj].x), bfhi(bc[bj].x), bflo(bc[bj].y), bfhi(bc[bj].y)}; rc[2 * bj + 1] = (f32x4){bflo(bc[bj].z), bfhi(bc[bj].z), bflo(bc[bj].w), bfhi(bc[bj].w)}; } }
                float ss = 0.f;
#pragma unroll
                for (int bj = 0; bj < 2; ++bj) { const size_t o = (size_t)row * DM + col0 + bj * HALF;
                    const f32x4 v0 = acc[ai][bj][m][0] + rc[2 * bj], v1 = acc[ai][bj][m][1] + rc[2 * bj + 1];
                    store8(xb + o, v0, v1);
                    ss += (v0[0] * v0[0] + v0[1] * v0[1]) + (v0[2] * v0[2] + v0[3] * v0[3]) + (v1[0] * v1[0] + v1[1] * v1[1]) + (v1[2] * v1[2] + v1[3] * v1[3]); }
                ss += __shfl_xor(ss, 16); ss += __shfl_xor(ss, 32);
                if (fq == 0) ssq[(size_t)row * 16 + u.pn * 4 + wc] = ss;
#pragma unroll
                for (int k = 0; k < 4; ++k) rc[k] = rn[k];
                bc[0] = bn[0]; bc[1] = bn[1]; }
            return;
        }
        if (mode == 2) {
            const int col0 = u.pn * BM + colL;
            const float* rs = (const float*)(ws + WS_RSTDM); bf16_t* ob = (bf16_t*)(ws + WS_VT); const int ldo = 1024;
            f32x4 c0[2], c1[2];
#pragma unroll
            for (int bj = 0; bj < 2; ++bj) { c0[bj] = *(const f32x4*)(rs + col0 + bj * HALF); c1[bj] = *(const f32x4*)(rs + col0 + bj * HALF + 4); }
#pragma unroll
            for (int ai = 0; ai < 2; ++ai)
#pragma unroll
                for (int m = 0; m < 4; ++m) { const int row = row0 + ai * HALF + m * 16;
#pragma unroll
                    for (int bj = 0; bj < 2; ++bj) store8(ob + (size_t)row * ldo + col0 + bj * HALF, acc[ai][bj][m][0] * c0[bj], acc[ai][bj][m][1] * c1[bj]); }
            return;
        }
        float rsc[8];
        if (tab) {
#pragma unroll
            for (int gidx = 0; gidx < 8; ++gidx) rsc[gidx] = *(const LAS float*)(lds + STAGE_BYTES + (ui * 256 + wr * 64 + fr + (gidx >> 2) * HALF + (gidx & 3) * 16) * 4);
        } else if (mode == 4 || mode == 5) {
            const float* sq = (const float*)(ws + WS_SSQ);
            f32x4 pv[8];
#pragma unroll
            for (int gidx = 0; gidx < 8; ++gidx) pv[gidx] = *(const f32x4*)(sq + (size_t)(row0 + (gidx >> 2) * HALF + (gidx & 3) * 16) * 16 + 4 * fq);
            const float cs = mode == 4 ? 0.0625f : 1.0f;
#pragma unroll
            for (int gidx = 0; gidx < 8; ++gidx) { float t = (pv[gidx][0] + pv[gidx][1]) + (pv[gidx][2] + pv[gidx][3]); t += __shfl_xor(t, 16); t += __shfl_xor(t, 32); rsc[gidx] = rsqrtf(t * (1.0f / 1024.0f) + EPS) * cs; }
        } else {
            const float* rs = (const float*)(ws + (mode == 0 ? WS_RSTD0 : WS_RSTDM));
#pragma unroll
            for (int gidx = 0; gidx < 8; ++gidx) rsc[gidx] = rs[row0 + (gidx >> 2) * HALF + (gidx & 3) * 16];
        }
        if (mode == 0) {
            float* lf = (float*)(ws + WS_LF);
            const int sub = u.pn >> 1; const int cb = (u.pn & 1) * 256 + colL;
            if (sub == 1) {
                float oml[2][8];
#pragma unroll
                for (int bj = 0; bj < 2; ++bj)
#pragma unroll
                    for (int j = 0; j < 8; ++j) { const int c = cb + bj * HALF + j; const float l0 = lbl[c], l1 = lbl[512 + c]; const float lb = 1.0f / (1.0f + __expf(l1 - l0)); oml[bj][j] = 1.0f - lb; }
#pragma unroll
                for (int ai = 0; ai < 2; ++ai)
#pragma unroll
                    for (int m = 0; m < 4; ++m) { const int row = row0 + ai * HALF + m * 16; const float r = rsc[ai * 4 + m];
#pragma unroll
                        for (int bj = 0; bj < 2; ++bj) { f32x4 lf0, lf1;
#pragma unroll
                            for (int j = 0; j < 4; ++j) {
                                const float za = acc[ai][bj][m][0][j] * r, zb = acc[ai][bj][m][1][j] * r;
                                const float ka = oml[bj][j] * (1.0f - sigmoidf_(za)), kb = oml[bj][4 + j] * (1.0f - sigmoidf_(zb));
                                lf0[j] = __logf(1.0f - ka); lf1[j] = __logf(1.0f - kb); }
                            const size_t o = (size_t)row * 512 + cb + bj * HALF;
                            *(f32x4*)(lf + o) = lf0; *(f32x4*)(lf + o + 4) = lf1; } }
            } else {
                bf16_t* dst = (bf16_t*)(ws + (sub == 0 ? WS_QH : (sub == 2 ? WS_VH : (sub == 3 ? WS_GH : WS_PH))));
                const bool act = (sub == 0) || (sub == 3);
#pragma unroll
                for (int ai = 0; ai < 2; ++ai)
#pragma unroll
                    for (int m = 0; m < 4; ++m) { const int row = row0 + ai * HALF + m * 16; const float r = rsc[ai * 4 + m];
#pragma unroll
                        for (int bj = 0; bj < 2; ++bj) { f32x4 v0 = acc[ai][bj][m][0] * r, v1 = acc[ai][bj][m][1] * r;
                            if (act) {
#pragma unroll
                                for (int j = 0; j < 4; ++j) { v0[j] = v0[j] * sigmoidf_(v0[j]); v1[j] = v1[j] * sigmoidf_(v1[j]); } }
                            store8(dst + (size_t)row * 512 + cb + bj * HALF, v0, v1); } }
            }
        } else {
            const int col0 = u.pn * BM + colL;
            bf16_t* ob = (bf16_t*)(ws + (mode == 1 ? WS_KX : (mode == 4 ? WS_XQ : WS_U))); const int ldo = mode == 5 ? DFF : 1024;
#pragma unroll
            for (int ai = 0; ai < 2; ++ai)
#pragma unroll
                for (int m = 0; m < 4; ++m) { const int row = row0 + ai * HALF + m * 16; const float r = rsc[ai * 4 + m];
#pragma unroll
                    for (int bj = 0; bj < 2; ++bj) { f32x4 v0 = acc[ai][bj][m][0] * r, v1 = acc[ai][bj][m][1] * r;
                        if (mode == 5) {
#pragma unroll
                            for (int j = 0; j < 4; ++j) { const float a = fmaxf(v0[j], 0.f), b = fmaxf(v1[j], 0.f); v0[j] = a * a; v1[j] = b * b; } }
                        store8(ob + (size_t)row * ldo + col0 + bj * HALF, v0, v1); } }
        }
    }
};

template <class EpiT, class Sched>
__device__ __forceinline__ void gemm_phase(LAS unsigned char* lds, const Gemm g, const Sched S, const EpiT E) {
    const int tid = threadIdx.x, wid = __builtin_amdgcn_readfirstlane(tid >> 6), lane = tid & 63, wr = wid >> 2, wc = wid & 3, fr = lane & 15, fq = lane >> 4;
    const int K = g.K, nt = K / BK;
    unsigned voffA[2], voffB[2];
#pragma unroll
    for (int i = 0; i < 2; ++i) { int R, C; stage_rc(tid * 16 + i * 8192, R, C); const int Rb = EpiT::PERM ? ((R & ~31) + perm32(R & 31)) : R;
        voffA[i] = (unsigned)(R * K + C) * 2u; voffB[i] = (unsigned)(Rb * K + C) * 2u; }
    const size_t kstep = (size_t)(BK * 2);
    const size_t hstep = (size_t)HALF * K * 2;
    const size_t tstep = 2 * hstep;
    const unsigned ldsw = (unsigned)wid * 1024u;
    const int aoff = lds_byte(wr * 64 + fr, fq * 8), boff = lds_byte(wc * 32 + fr, fq * 8);
#define PG8_SA(b, h) (((b) * 2 + (h)) * HTB)
#define PG8_SB(b, h) ((4 + (b) * 2 + (h)) * HTB)
#define PG8_STAGE(bufoff, gbase, voff) do { _Pragma("unroll") for (int _i = 0; _i < 2; ++_i) \
        __builtin_amdgcn_global_load_lds((const unsigned*)((const char*)(gbase) + (voff)[_i]), (LAS unsigned*)(lds + (bufoff) + ldsw + _i * 8192), 16, 0, 0); } while (0)
#define PG8_LDA(dst, b, h) do { _Pragma("unroll") for (int m = 0; m < 4; ++m) _Pragma("unroll") for (int k = 0; k < 2; ++k) dst[m][k] = *(const LAS bf16x8*)(lds + PG8_SA(b, h) + aoff + m * 2048 + k * 1024); } while (0)
#define PG8_LDB(dst, b, h) do { _Pragma("unroll") for (int n = 0; n < 2; ++n) _Pragma("unroll") for (int k = 0; k < 2; ++k) dst[n][k] = *(const LAS bf16x8*)(lds + PG8_SB(b, h) + boff + n * 2048 + k * 1024); } while (0)
#define PG8_MMA(ai, bj, At, Bt) do { __builtin_amdgcn_s_setprio(1); _Pragma("unroll") for (int m = 0; m < 4; ++m) _Pragma("unroll") for (int n = 0; n < 2; ++n) _Pragma("unroll") for (int k = 0; k < 2; ++k) \
        acc[ai][bj][m][n] = __builtin_amdgcn_mfma_f32_16x16x32_bf16(Bt[n][k], At[m][k], acc[ai][bj][m][n], 0, 0, 0); __builtin_amdgcn_s_setprio(0); } while (0)
#define PG8_WAIT_V(n) asm volatile("s_waitcnt vmcnt(" #n ")" ::: "memory")
#define PG8_WAIT_L(n) asm volatile("s_waitcnt lgkmcnt(" #n ")" ::: "memory")
#define PG8_BAR __builtin_amdgcn_s_barrier()
#define PG8_SCHED __builtin_amdgcn_sched_barrier(0)
    Unit cur, nxt; int ui = 0;
    if (!S.next(0, cur)) return;
    const bool tab = E.prefill(lds, S);
    if (tab) __syncthreads();
    f32x4 acc[2][2][4][2];
#pragma unroll
    for (int a = 0; a < 2; ++a)
#pragma unroll
        for (int b = 0; b < 2; ++b)
#pragma unroll
            for (int m = 0; m < 4; ++m)
#pragma unroll
                for (int n = 0; n < 2; ++n) acc[a][b][m][n] = (f32x4){0.f, 0.f, 0.f, 0.f};
    bf16x8 At[4][2], B0[2][2], B1[2][2];
    const char* cA = (const char*)g.A + (size_t)cur.pm * tstep; const char* cB = (const char*)g.Bt + (size_t)cur.pn * tstep;
    PG8_STAGE(PG8_SB(0, 0), cB, voffB); PG8_STAGE(PG8_SA(0, 0), cA, voffA); PG8_STAGE(PG8_SB(0, 1), cB + hstep, voffB); PG8_STAGE(PG8_SA(0, 1), cA + hstep, voffA);
    if (wr == 1) PG8_BAR;
    PG8_WAIT_V(4); PG8_BAR;
    PG8_STAGE(PG8_SB(1, 0), cB + kstep, voffB); PG8_STAGE(PG8_SA(1, 0), cA + kstep, voffA); PG8_STAGE(PG8_SB(1, 1), cB + hstep + kstep, voffB);
    PG8_WAIT_V(6); PG8_BAR;
    for (;;) {
        const bool has_next = S.next(ui + 1, nxt);
        const char* nA = has_next ? (const char*)g.A + (size_t)nxt.pm * tstep : cA; const char* nB = has_next ? (const char*)g.Bt + (size_t)nxt.pn * tstep : cB;
        for (int t = 0; t < nt; t += 2) {
            const bool last = (t == nt - 2);
            const char* a1 = cA + (size_t)(t + 1) * kstep;
            const char* a2 = last ? nA : cA + (size_t)(t + 2) * kstep; const char* b2 = last ? nB : cB + (size_t)(t + 2) * kstep;
            const char* a3 = a2 + kstep; const char* b3 = b2 + kstep;
            PG8_LDB(B0, 0, 0); PG8_SCHED; PG8_LDA(At, 0, 0); PG8_STAGE(PG8_SA(1, 1), a1 + hstep, voffA);
            PG8_WAIT_L(8); PG8_BAR; PG8_WAIT_L(0); PG8_MMA(0, 0, At, B0); PG8_BAR; PG8_SCHED;
            PG8_LDB(B1, 0, 1); PG8_STAGE(PG8_SB(0, 0), b2, voffB);
            PG8_BAR; PG8_WAIT_L(0); PG8_MMA(0, 1, At, B1); PG8_BAR;
            PG8_LDA(At, 0, 1); PG8_STAGE(PG8_SA(0, 0), a2, voffA);
            PG8_BAR; PG8_WAIT_L(0); PG8_MMA(1, 0, At, B0); PG8_BAR; PG8_SCHED;
            PG8_STAGE(PG8_SB(0, 1), b2 + hstep, voffB);
            PG8_WAIT_V(6); PG8_BAR; PG8_MMA(1, 1, At, B1); PG8_BAR;
            PG8_LDB(B0, 1, 0); PG8_SCHED; PG8_LDA(At, 1, 0); PG8_STAGE(PG8_SA(0, 1), a2 + hstep, voffA);
            PG8_WAIT_L(8); PG8_BAR; PG8_WAIT_L(0); PG8_MMA(0, 0, At, B0); PG8_BAR; PG8_SCHED;
            PG8_LDB(B1, 1, 1); PG8_STAGE(PG8_SB(1, 0), b3, voffB);
            PG8_BAR; PG8_WAIT_L(0); PG8_MMA(0, 1, At, B1); PG8_BAR;
            PG8_LDA(At, 1, 1); PG8_STAGE(PG8_SA(1, 0), a3, voffA);
            PG8_BAR; PG8_WAIT_L(0); PG8_MMA(1, 0, At, B0); PG8_BAR; PG8_SCHED;
            PG8_STAGE(PG8_SB(1, 1), b3 + hstep, voffB);
            PG8_WAIT_V(6); PG8_BAR; PG8_MMA(1, 1, At, B1); PG8_BAR;
        }
        if (E.mode != 8) E(acc, cur, ui, tab, lds, wr, wc, fr, fq);
        if (!has_next) break;
#pragma unroll
        for (int a = 0; a < 2; ++a)
#pragma unroll
            for (int b = 0; b < 2; ++b)
#pragma unroll
                for (int m = 0; m < 4; ++m)
#pragma unroll
                    for (int n = 0; n < 2; ++n) acc[a][b][m][n] = (f32x4){0.f, 0.f, 0.f, 0.f};
        cur = nxt; cA = nA; cB = nB; ++ui;
    }
    PG8_WAIT_V(0);
    if (wr == 0) PG8_BAR;
    PG8_BAR;
    if (E.mode == 8) E.fused(acc, cur, wr, wc, fr, fq);
#undef PG8_SA
#undef PG8_SB
#undef PG8_STAGE
#undef PG8_LDA
#undef PG8_LDB
#undef PG8_MMA
#undef PG8_WAIT_V
#undef PG8_WAIT_L
#undef PG8_BAR
#undef PG8_SCHED
}
}

struct Params {
    const float *x, *mem, *norm_mix_g, *w_in, *lb_logits, *hgrn_norm_g, *w_pool, *pool_scale, *w_out, *norm_x_g, *norm_mem_g, *w_xq, *w_xk, *w_xv, *w_xo, *norm_ffn_g, *w_ff1, *w_ff2, *final_norm_g;
    float* out; unsigned char* ws;
    int ph_lo, ph_hi;
};

struct TD { const float* W; const float* g; bf16_t* out; int N, ldo, kt, nt; };
__device__ __forceinline__ TD tile_desc(const Params& p, int t) {
    unsigned char* ws = p.ws; TD d;
    if (t < 320)       { d.W = p.w_in;  d.g = p.norm_mix_g; d.out = (bf16_t*)(ws + WS_WT_IN);  d.N = NIN;  d.ldo = 1024; d.kt = t / 40; d.nt = t % 40; }
    else if (t < 448)  { const int u = t - 320;  d.W = p.w_xk;  d.g = p.norm_mem_g; d.out = (bf16_t*)(ws + WS_WT_K);   d.N = 1024; d.ldo = 1024; d.kt = u / 16; d.nt = u % 16; }
    else if (t < 576)  { const int u = t - 448;  d.W = p.w_xv;  d.g = p.norm_mem_g; d.out = (bf16_t*)(ws + WS_WT_V);   d.N = 1024; d.ldo = 1024; d.kt = u / 16; d.nt = u % 16; }
    else if (t < 704)  { const int u = t - 576;  d.W = p.w_xq;  d.g = p.norm_x_g;   d.out = (bf16_t*)(ws + WS_WT_Q);   d.N = 1024; d.ldo = 1024; d.kt = u / 16; d.nt = u % 16; }
    else if (t < 832)  { const int u = t - 704;  d.W = p.w_xo;  d.g = nullptr;      d.out = (bf16_t*)(ws + WS_WT_O);   d.N = 1024; d.ldo = 1024; d.kt = u / 16; d.nt = u % 16; }
    else if (t < 960)  { const int u = t - 832;  d.W = p.w_out; d.g = nullptr;      d.out = (bf16_t*)(ws + WS_WT_OUT); d.N = 1024; d.ldo = 1024; d.kt = u / 16; d.nt = u % 16; }
    else if (t < 1472) { const int u = t - 960;  d.W = p.w_ff1; d.g = p.norm_ffn_g; d.out = (bf16_t*)(ws + WS_WT_FF1); d.N = DFF;  d.ldo = 1024; d.kt = u / 64; d.nt = u % 64; }
    else               { const int u = t - 1472; d.W = p.w_ff2; d.g = nullptr;      d.out = (bf16_t*)(ws + WS_WT_FF2); d.N = 1024; d.ldo = 4096; d.kt = u / 16; d.nt = u % 16; }
    return d;
}
__device__ __forceinline__ void tile_load(const TD& d, f32x4 (&v)[4], float (&sc)[4]) {
    const int tid = threadIdx.x, r = tid >> 4, c4 = tid & 15;
#pragma unroll
    for (int i = 0; i < 4; ++i) { const int k = 128 * d.kt + r + 32 * i; v[i] = __builtin_nontemporal_load((const f32x4*)(d.W + (size_t)k * d.N + 64 * d.nt + 4 * c4)); sc[i] = d.g ? d.g[k] : 1.0f; }
}
__device__ __forceinline__ void transpose_range(const Params& p, unsigned char* lds, int t_begin, int t_end, int first, int stride) {
    bf16_t* T0 = (bf16_t*)lds;
    bf16_t* T1 = (bf16_t*)(lds + 17408);
    const int tid = threadIdx.x, r = tid >> 4, c4 = tid & 15, n = tid >> 3, ks = tid & 7;
    int ta = t_begin + first;
    if (ta >= t_end) return;
    int tb = ta + stride; bool hb = tb < t_end;
    TD da = tile_desc(p, ta), db = da; f32x4 va[4], vb[4]; float sa[4], sb[4];
    tile_load(da, va, sa);
    if (hb) { db = tile_desc(p, tb); tile_load(db, vb, sb); }
    for (;;) {
#pragma unroll
        for (int i = 0; i < 4; ++i) { const int kl = r + 32 * i;
            T0[(4 * c4 + 0) * 136 + kl] = f2bf(va[i][0] * sa[i]); T0[(4 * c4 + 1) * 136 + kl] = f2bf(va[i][1] * sa[i]);
            T0[(4 * c4 + 2) * 136 + kl] = f2bf(va[i][2] * sa[i]); T0[(4 * c4 + 3) * 136 + kl] = f2bf(va[i][3] * sa[i]); }
        if (hb) {
#pragma unroll
            for (int i = 0; i < 4; ++i) { const int kl = r + 32 * i;
                T1[(4 * c4 + 0) * 136 + kl] = f2bf(vb[i][0] * sb[i]); T1[(4 * c4 + 1) * 136 + kl] = f2bf(vb[i][1] * sb[i]);
                T1[(4 * c4 + 2) * 136 + kl] = f2bf(vb[i][2] * sb[i]); T1[(4 * c4 + 3) * 136 + kl] = f2bf(vb[i][3] * sb[i]); } }
        __syncthreads();
        const int tna = ta + 2 * stride, tnb = tna + stride; const bool hna = tna < t_end, hnb = tnb < t_end;
        const TD ca = da, cb = db; const bool chb = hb;
        if (hna) { da = tile_desc(p, tna); tile_load(da, va, sa); }
        if (hnb) { db = tile_desc(p, tnb); tile_load(db, vb, sb); }
        { const u32x4* src = (const u32x4*)(T0 + n * 136 + 16 * ks); const u32x4 a = src[0], b = src[1];
          u32x4* dst = (u32x4*)(ca.out + (size_t)(64 * ca.nt + n) * ca.ldo + 128 * ca.kt + 16 * ks); dst[0] = a; dst[1] = b; }
        if (chb) { const u32x4* src = (const u32x4*)(T1 + n * 136 + 16 * ks); const u32x4 a = src[0], b = src[1];
          u32x4* dst = (u32x4*)(cb.out + (size_t)(64 * cb.nt + n) * cb.ldo + 128 * cb.kt + 16 * ks); dst[0] = a; dst[1] = b; }
        __syncthreads();
        if (!hna) break;
        ta = tna; hb = hnb;
    }
}
__device__ __forceinline__ void phase_prep(const Params p, unsigned char* lds) {
    unsigned char* ws = p.ws;
    const int G = gridDim.x;
    {
        const int lane = threadIdx.x & 63, gw = blockIdx.x * (NTHREADS / 64) + (threadIdx.x >> 6), nw = G * (NTHREADS / 64);
        int r = gw;
        f32x4 v[4], vn[4];
        if (r < MROWS + MEMROWS) { const float* src = r < MROWS ? p.x + (size_t)r * DM : p.mem + (size_t)(r - MROWS) * DM;
#pragma unroll
            for (int i = 0; i < 4; ++i) v[i] = __builtin_nontemporal_load((const f32x4*)src + lane + 64 * i); }
        for (; r < MROWS + MEMROWS; r += nw) {
            const int rn = r + nw;
            if (rn < MROWS + MEMROWS) { const float* src = rn < MROWS ? p.x + (size_t)rn * DM : p.mem + (size_t)(rn - MROWS) * DM;
#pragma unroll
                for (int i = 0; i < 4; ++i) vn[i] = __builtin_nontemporal_load((const f32x4*)src + lane + 64 * i); }
            const bool isx = r < MROWS;
            bf16_t* dst = isx ? (bf16_t*)(ws + WS_XB) + (size_t)r * DM : (bf16_t*)(ws + WS_MEMB) + (size_t)(r - MROWS) * DM;
            float ss = 0.f;
#pragma unroll
            for (int i = 0; i < 4; ++i) ss += (v[i][0] * v[i][0] + v[i][1] * v[i][1]) + (v[i][2] * v[i][2] + v[i][3] * v[i][3]);
#pragma unroll
            for (int o = 1; o < 64; o <<= 1) ss += __shfl_xor(ss, o);
#pragma unroll
            for (int i = 0; i < 4; ++i) { u32x2 w; w.x = cvt_pk_bf16(v[i][0], v[i][1]); w.y = cvt_pk_bf16(v[i][2], v[i][3]); ((u32x2*)dst)[lane + 64 * i] = w; }
            if (lane == 0) { const float rstd = rsqrtf(ss * (1.0f / 1024.0f) + EPS); if (isx) ((float*)(ws + WS_RSTD0))[r] = rstd; else ((float*)(ws + WS_RSTDM))[r - MROWS] = rstd; }
#pragma unroll
            for (int i = 0; i < 4; ++i) v[i] = vn[i];
        }
    }
    transpose_range(p, lds, 0, 576, blockIdx.x, G);
}
__device__ __forceinline__ void deferred_prep(const Params p, unsigned char* lds, int j, int nworkers) {
    transpose_range(p, lds, 576, 1984, j, nworkers);
}
__device__ __forceinline__ void fold_pool_weights_mfma(const Params& p) {
    bf16_t* wto = (bf16_t*)(p.ws + WS_WT_OUT);
    const int tid = threadIdx.x, w = tid >> 6, lane = tid & 63, fr = lane & 15, q = lane >> 4;
    for (int item = blockIdx.x; item < 256; item += gridDim.x) {
        const int gi = item >> 6, nb = item & 63;
        f32x4 acc = (f32x4){0.f, 0.f, 0.f, 0.f};
        const float* wp = p.w_pool + (size_t)(gi * 128 + 16 * w + fr) * 128;
        const float* ps = p.pool_scale + gi * 128;
        const bf16_t* arow = wto + (size_t)(16 * nb + fr) * 1024 + 512 + gi * 128;
#pragma unroll
        for (int ks = 0; ks < 4; ++ks) {
            const int d0 = 32 * ks + 8 * q;
            const f32x4 w0 = *(const f32x4*)(wp + d0), w1 = *(const f32x4*)(wp + d0 + 4), s0 = *(const f32x4*)(ps + d0), s1 = *(const f32x4*)(ps + d0 + 4);
            const bf16x8 cfr = mk8u(cvt_pk_bf16(w0[0] * s0[0], w0[1] * s0[1]), cvt_pk_bf16(w0[2] * s0[2], w0[3] * s0[3]), cvt_pk_bf16(w1[0] * s1[0], w1[1] * s1[1]), cvt_pk_bf16(w1[2] * s1[2], w1[3] * s1[3]));
            const bf16x8 nfr = *(const bf16x8*)(arow + d0);
            acc = mfma16(cfr, nfr, acc);
        }
        asm volatile("s_waitcnt vmcnt(0)" ::: "memory");
        __syncthreads();
        u32x2 o; o.x = cvt_pk_bf16(acc[0], acc[1]); o.y = cvt_pk_bf16(acc[2], acc[3]);
        *(u32x2*)(wto + (size_t)(16 * nb + fr) * 1024 + 512 + gi * 128 + 16 * w + 4 * q) = o;
        __syncthreads();
    }
}

__device__ __forceinline__ void phase_passA(const bf16_t* __restrict__ KH, const float* __restrict__ LF, const bf16_t* __restrict__ VH, bf16_t* __restrict__ LT, float* __restrict__ DEC, unsigned char* lds) {
    const int tid = threadIdx.x, ch = tid & 127, seg = tid >> 7, G = gridDim.x;
    float* segtot = (float*)lds;
    unsigned char* KdT = lds + 2048;
    unsigned char* VTl = lds + 2048 + 18432;
    const int w = tid >> 6, lane = tid & 63, fr = lane & 15, q = lane >> 4;
    float lf[16], kk[16]; unsigned vr[16];
    int unit = blockIdx.x;
    if (unit < 1024) { const int b = unit >> 8, c = (unit >> 2) & 63, h = unit & 3; const size_t g0 = (size_t)(b * SEQ + c * 64 + seg * 16) * 512 + h * 128 + ch;
#pragma unroll
        for (int i = 0; i < 16; ++i) { lf[i] = LF[g0 + (size_t)i * 512]; vr[i] = VH[g0 + (size_t)i * 512]; } }
    for (; unit < 1024; unit += G) {
        const int b = unit >> 8, c = (unit >> 2) & 63, h = unit & 3, bh = b * 4 + h;
#pragma unroll
        for (int i = 0; i < 16; ++i) kk[i] = 1.0f - __expf(lf[i]);
#pragma unroll
        for (int i = 1; i < 16; ++i) lf[i] += lf[i - 1];
        segtot[seg * 128 + ch] = lf[15];
        __syncthreads();
        float after = 0.f;
#pragma unroll
        for (int s2 = 1; s2 < 4; ++s2) if (s2 > seg) after += segtot[s2 * 128 + ch];
        const float tot = after + lf[15];
        if (seg == 0) DEC[(size_t)(bh * 64 + c) * 128 + ch] = __expf(tot);
        unsigned kd[8], vp[8];
#pragma unroll
        for (int i = 0; i < 8; ++i) {
            kd[i] = cvt_pk_bf16(kk[2 * i] * __expf(tot - lf[2 * i]), kk[2 * i + 1] * __expf(tot - lf[2 * i + 1]));
            vp[i] = vr[2 * i] | (vr[2 * i + 1] << 16);
        }
        { u32x4* d = (u32x4*)(KdT + ch * 144 + seg * 32); d[0] = (u32x4){kd[0], kd[1], kd[2], kd[3]}; d[1] = (u32x4){kd[4], kd[5], kd[6], kd[7]}; }
        { u32x4* d = (u32x4*)(VTl + ch * 144 + seg * 32); d[0] = (u32x4){vp[0], vp[1], vp[2], vp[3]}; d[1] = (u32x4){vp[4], vp[5], vp[6], vp[7]}; }
        __syncthreads();
        {
            const int un = unit + G;
            if (un < 1024) { const int b2 = un >> 8, c2 = (un >> 2) & 63, h2 = un & 3; const size_t g0 = (size_t)(b2 * SEQ + c2 * 64 + seg * 16) * 512 + h2 * 128 + ch;
#pragma unroll
                for (int i = 0; i < 16; ++i) { lf[i] = LF[g0 + (size_t)i * 512]; vr[i] = VH[g0 + (size_t)i * 512]; } }
        }
        bf16x8 a[2];
#pragma unroll
        for (int ks = 0; ks < 2; ++ks) a[ks] = *(const bf16x8*)(KdT + (16 * w + fr) * 144 + (32 * ks + 8 * q) * 2);
        bf16_t* ltp = LT + (size_t)(bh * 64 + c) * 16384;
#pragma unroll
        for (int vb = 0; vb < 8; ++vb) {
            f32x4 acc = (f32x4){0.f, 0.f, 0.f, 0.f};
#pragma unroll
            for (int ks = 0; ks < 2; ++ks) { const bf16x8 bfr = *(const bf16x8*)(VTl + (16 * vb + fr) * 144 + (32 * ks + 8 * q) * 2); acc = mfma16(a[ks], bfr, acc); }
            u32x2 pk; pk.x = cvt_pk_bf16(acc[0], acc[1]); pk.y = cvt_pk_bf16(acc[2], acc[3]);
            *(u32x2*)(ltp + (size_t)(16 * vb + fr) * 128 + 16 * w + 4 * q) = pk;
        }
        __syncthreads();
    }
}

template <int W>
__device__ __forceinline__ void pool_body(const bf16_t* __restrict__ PH, bf16_t* __restrict__ MIXED, int r0, int s0, int c0) {
    unsigned v[31 + W];
#pragma unroll
    for (int j = 1; j < W; ++j) v[W - 1 - j] = (s0 - j >= 0) ? *(const unsigned*)(PH + (size_t)(r0 - j) * 512 + c0) : 0u;
#pragma unroll
    for (int tt = 0; tt < 32; ++tt) v[W - 1 + tt] = *(const unsigned*)(PH + (size_t)(r0 + tt) * 512 + c0);
    float sx = 0.f, sy = 0.f;
#pragma unroll
    for (int j = 1; j < W; ++j) { sx += bflo(v[W - 1 - j]); sy += bfhi(v[W - 1 - j]); }
#pragma unroll
    for (int tt = 0; tt < 32; ++tt) {
        const int s = s0 + tt;
        const float px = bflo(v[W - 1 + tt]), py = bfhi(v[W - 1 + tt]);
        sx += px; sy += py;
        const int cnt = (s + 1) < W ? (s + 1) : W;
        const float inv = 1.0f / (float)cnt;
        *(unsigned*)(MIXED + (size_t)(r0 + tt) * 1024 + 512 + c0) = cvt_pk_bf16(sx * inv - px, sy * inv - py);
        sx -= bflo(v[tt]); sy -= bfhi(v[tt]);
    }
}
__device__ __forceinline__ void pool_tile(const bf16_t* __restrict__ PH, bf16_t* __restrict__ MIXED, int tile) {
    const int tid = threadIdx.x, cp = tid & 255, th = tid >> 8, c0 = 2 * cp, gi = c0 >> 7;
    const int r0 = tile * 64 + th * 32, s0 = r0 & (SEQ - 1);
    if (gi == 0) pool_body<2>(PH, MIXED, r0, s0, c0);
    else if (gi == 1) pool_body<4>(PH, MIXED, r0, s0, c0);
    else if (gi == 2) pool_body<8>(PH, MIXED, r0, s0, c0);
    else pool_body<16>(PH, MIXED, r0, s0, c0);
}

__device__ __forceinline__ void phase_scan(const bf16_t* LT, const float* __restrict__ DEC, bf16_t* ST) {
    for (int e2 = blockIdx.x * NTHREADS + threadIdx.x; e2 < 131072; e2 += gridDim.x * NTHREADS) {
        const int bh = e2 >> 13, v = (e2 >> 6) & 127, kp = e2 & 63;
        float sx = 0.f, sy = 0.f;
        const size_t base = (size_t)bh * 64 * 16384 + (size_t)v * 128 + 2 * kp;
        const float* dp = DEC + (size_t)bh * 64 * 128 + 2 * kp;
        for (int c0 = 0; c0 < 64; c0 += 32) {
            unsigned l[32]; f32x2 d[32];
#pragma unroll
            for (int j = 0; j < 32; ++j) { l[j] = *(const unsigned*)(LT + base + (size_t)(c0 + j) * 16384); d[j] = *(const f32x2*)(dp + (c0 + j) * 128); }
#pragma unroll
            for (int j = 0; j < 32; ++j) {
                *(unsigned*)(ST + base + (size_t)(c0 + j) * 16384) = cvt_pk_bf16(sx, sy);
                sx = d[j][0] * sx + bflo(l[j]); sy = d[j][1] * sy + bfhi(l[j]);
            }
        }
    }
}

__device__ __forceinline__ void phase_passC(const bf16_t* __restrict__ QH, const bf16_t* __restrict__ KH, const float* __restrict__ LF, const bf16_t* __restrict__ VH, const bf16_t* __restrict__ GH,
                                const bf16_t* __restrict__ ST, const float* __restrict__ hg, bf16_t* __restrict__ MIXED, unsigned char* lds) {
    const int tid = threadIdx.x, ch = tid & 127, seg = tid >> 7, G = gridDim.x;
    float lf[16], kk[16]; unsigned qr[16], vr[16];
    int unit = blockIdx.x;
    if (unit < 1024) { const int b = unit >> 8, c = (unit >> 2) & 63, h = unit & 3; const size_t g0 = (size_t)(b * SEQ + c * 64 + seg * 16) * 512 + h * 128 + ch;
#pragma unroll
        for (int i = 0; i < 16; ++i) { lf[i] = LF[g0 + (size_t)i * 512]; vr[i] = VH[g0 + (size_t)i * 512]; qr[i] = QH[g0 + (size_t)i * 512]; } }
  for (; unit < 1024; unit += G) {
    const int b = unit >> 8, c = (unit >> 2) & 63, h = unit & 3;
    const int row0 = b * SEQ + c * 64, bh = b * 4 + h;
    float* segtot = (float*)lds;
    float* rmsp = (float*)(lds + 2048);
    bf16_t* QC = (bf16_t*)(lds + 4096);
    bf16_t* QT = (bf16_t*)(lds + 21504);
    constexpr int KT0 = 38912;
    unsigned char* VTl = lds + 82432;
    const int w = tid >> 6, lane = tid & 63, fr = lane & 15, q = lane >> 4;
    const int i = w & 3, vh = w >> 2;
    const size_t row = (size_t)(row0 + 16 * i + fr);
    u32x2 gt[4]; f32x4 gg[4]; bf16x8 stf[4][4];
    {
        const bf16_t* stp = ST + (size_t)(bh * 64 + c) * 16384;
#pragma unroll
        for (int vbl = 0; vbl < 4; ++vbl) { const int v0 = 16 * (vh * 4 + vbl) + 4 * q; gt[vbl] = *(const u32x2*)(GH + row * 512 + h * 128 + v0); gg[vbl] = *(const f32x4*)(hg + h * 128 + v0);
#pragma unroll
            for (int ks = 0; ks < 4; ++ks) stf[ks][vbl] = *(const bf16x8*)(stp + (size_t)(16 * (vh * 4 + vbl) + fr) * 128 + 32 * ks + 8 * q); }
    }
#pragma unroll
    for (int i2 = 0; i2 < 16; ++i2) kk[i2] = 1.0f - __expf(lf[i2]);
#pragma unroll
    for (int i2 = 1; i2 < 16; ++i2) lf[i2] += lf[i2 - 1];
    segtot[seg * 128 + ch] = lf[15];
    {
        unsigned vp[8];
#pragma unroll
        for (int i2 = 0; i2 < 8; ++i2) vp[i2] = vr[2 * i2] | (vr[2 * i2 + 1] << 16);
        u32x4* d = (u32x4*)(VTl + ch * 144 + seg * 32); d[0] = (u32x4){vp[0], vp[1], vp[2], vp[3]}; d[1] = (u32x4){vp[4], vp[5], vp[6], vp[7]};
    }
    __syncthreads();
    const float t0 = segtot[ch], t1 = segtot[128 + ch], t2 = segtot[256 + ch];
    const float P = (seg > 0 ? t0 : 0.f) + (seg > 1 ? t1 : 0.f) + (seg > 2 ? t2 : 0.f);
    {
        const float eP = __expf(P);
#pragma unroll
        for (int i2 = 0; i2 < 16; ++i2) {
            const float qv = bflo(qr[i2]);
            const float el = __expf(lf[i2]);
            QT[(seg * 16 + i2) * 136 + ch] = f2bf(qv * el);
            QC[(seg * 16 + i2) * 136 + ch] = f2bf(qv * el * eP);
        }
        float E = 0.f;
#pragma unroll
        for (int i2 = 0; i2 < 4; ++i2) {
            if (i2 >= seg) {
                bf16_t* KT = (bf16_t*)(lds + KT0 + 4352 * ((i2 * (i2 + 1)) / 2));
#pragma unroll
                for (int j = 0; j < 16; ++j) KT[(seg * 16 + j) * 136 + ch] = f2bf(kk[j] * __expf(E - lf[j]));
                E += (i2 == 0 ? t0 : (i2 == 1 ? t1 : t2));
            }
        }
    }
    __syncthreads();
    {
        const int un = unit + G;
        if (un < 1024) { const int b2 = un >> 8, c2 = (un >> 2) & 63, h2 = un & 3; const size_t g2 = (size_t)(b2 * SEQ + c2 * 64 + seg * 16) * 512 + h2 * 128 + ch;
#pragma unroll
            for (int i2 = 0; i2 < 16; ++i2) { lf[i2] = LF[g2 + (size_t)i2 * 512]; vr[i2] = VH[g2 + (size_t)i2 * 512]; qr[i2] = QH[g2 + (size_t)i2 * 512]; } }
    }
    f32x4 sT[4];
#pragma unroll
    for (int j = 0; j < 4; ++j) sT[j] = (f32x4){0.f, 0.f, 0.f, 0.f};
    {
        bf16x8 qfr[4];
#pragma unroll
        for (int ks = 0; ks < 4; ++ks) qfr[ks] = *(const bf16x8*)((const unsigned char*)QT + (16 * i + fr) * 272 + (32 * ks + 8 * q) * 2);
        const unsigned char* KT = lds + KT0 + 4352 * ((i * (i + 1)) / 2);
#pragma unroll
        for (int j = 0; j < 4; ++j) if (j <= i) {
#pragma unroll
            for (int ks = 0; ks < 4; ++ks) { const bf16x8 a = *(const bf16x8*)(KT + (16 * j + fr) * 272 + (32 * ks + 8 * q) * 2); sT[j] = mfma16(a, qfr[ks], sT[j]); }
            if (j == i) {
#pragma unroll
                for (int rg = 0; rg < 4; ++rg) if (4 * q + rg > fr) sT[j][rg] = 0.f;
            }
        }
    }
    f32x4 oacc[4];
#pragma unroll
    for (int vbl = 0; vbl < 4; ++vbl) oacc[vbl] = (f32x4){0.f, 0.f, 0.f, 0.f};
#pragma unroll
    for (int m = 0; m < 2; ++m) if (2 * m <= i) {
        const bf16x8 bfrag = mk8u(cvt_pk_bf16(sT[2 * m][0], sT[2 * m][1]), cvt_pk_bf16(sT[2 * m][2], sT[2 * m][3]), cvt_pk_bf16(sT[2 * m + 1][0], sT[2 * m + 1][1]), cvt_pk_bf16(sT[2 * m + 1][2], sT[2 * m + 1][3]));
#pragma unroll
        for (int vbl = 0; vbl < 4; ++vbl) {
            const unsigned char* base = VTl + (16 * (vh * 4 + vbl) + fr) * 144 + (32 * m + 4 * q) * 2;
            const bf16x8 a = mk8(*(const u32x2*)base, *(const u32x2*)(base + 32));
            oacc[vbl] = mfma16(a, bfrag, oacc[vbl]);
        }
    }
    {
#pragma unroll
        for (int ks = 0; ks < 4; ++ks) {
            const bf16x8 bfr = *(const bf16x8*)((const unsigned char*)QC + (16 * i + fr) * 272 + (32 * ks + 8 * q) * 2);
#pragma unroll
            for (int vbl = 0; vbl < 4; ++vbl) oacc[vbl] = mfma16(stf[ks][vbl], bfr, oacc[vbl]);
        }
    }
    float ss = 0.f;
#pragma unroll
    for (int vbl = 0; vbl < 4; ++vbl) ss += (oacc[vbl][0] * oacc[vbl][0] + oacc[vbl][1] * oacc[vbl][1]) + (oacc[vbl][2] * oacc[vbl][2] + oacc[vbl][3] * oacc[vbl][3]);
    ss += __shfl_xor(ss, 16); ss += __shfl_xor(ss, 32);
    if (q == 0) rmsp[vh * 64 + 16 * i + fr] = ss;
    __syncthreads();
    const float rstd = rsqrtf((rmsp[16 * i + fr] + rmsp[64 + 16 * i + fr]) * (1.0f / 128.0f) + EPS);
#pragma unroll
    for (int vbl = 0; vbl < 4; ++vbl) {
        const int v0 = 16 * (vh * 4 + vbl) + 4 * q;
        u32x2 o;
        o.x = cvt_pk_bf16(oacc[vbl][0] * rstd * gg[vbl][0] * bflo(gt[vbl].x), oacc[vbl][1] * rstd * gg[vbl][1] * bfhi(gt[vbl].x));
        o.y = cvt_pk_bf16(oacc[vbl][2] * rstd * gg[vbl][2] * bflo(gt[vbl].y), oacc[vbl][3] * rstd * gg[vbl][3] * bfhi(gt[vbl].y));
        *(u32x2*)(MIXED + row * 1024 + h * 128 + v0) = o;
    }
    __syncthreads();
  }
}

__device__ __forceinline__ void attn_unit(const bf16_t* __restrict__ XQ, const bf16_t* __restrict__ KX, const bf16_t* __restrict__ VT, bf16_t* __restrict__ ATT, int unit, unsigned char* lds) {
    const int tid = threadIdx.x, w = tid >> 6, lane = tid & 63, r = lane & 31, hh = lane >> 5;
    const int b = unit >> 6, st = (unit >> 2) & 15, h = unit & 3;
    const int row0 = b * SEQ + st * 256;
    const bf16_t* qp = XQ + (size_t)(row0 + 32 * w + r) * 1024 + h * 256 + 8 * hh;
    {
        const bf16_t* kp = KX + (size_t)(b * 256) * 1024 + h * 256;
#pragma unroll
        for (int it = 0; it < 16; ++it) { const int idx = tid + 512 * it, m = idx >> 5, cc = idx & 31;
            const u32x4 v = *(const u32x4*)(kp + (size_t)m * 1024 + cc * 8); *(u32x4*)(lds + m * 528 + cc * 16) = v; }
    }
    __syncthreads();
    f32x16 sacc[8];
#pragma unroll
    for (int mb = 0; mb < 8; ++mb)
#pragma unroll
        for (int e = 0; e < 16; ++e) sacc[mb][e] = 0.f;
    {
        bf16x8 qf[4], qn[4];
#pragma unroll
        for (int k4 = 0; k4 < 4; ++k4) qf[k4] = *(const bf16x8*)(qp + 16 * k4);
#pragma unroll
        for (int kg = 0; kg < 4; ++kg) {
            if (kg < 3) {
#pragma unroll
                for (int k4 = 0; k4 < 4; ++k4) qn[k4] = *(const bf16x8*)(qp + 16 * (4 * (kg + 1) + k4)); }
#pragma unroll
            for (int k4 = 0; k4 < 4; ++k4)
#pragma unroll
                for (int mb = 0; mb < 8; ++mb) { const bf16x8 a = *(const bf16x8*)(lds + (32 * mb + r) * 528 + (16 * (4 * kg + k4) + 8 * hh) * 2); sacc[mb] = mfma32(a, qf[k4], sacc[mb]); }
#pragma unroll
            for (int k4 = 0; k4 < 4; ++k4) qf[k4] = qn[k4];
        }
    }
    float mx = -3.0e38f;
#pragma unroll
    for (int mb = 0; mb < 8; ++mb)
#pragma unroll
        for (int e = 0; e < 16; ++e) mx = fmaxf(mx, sacc[mb][e]);
    mx = fmaxf(mx, __shfl_xor(mx, 32));
    float sum = 0.f;
    bf16x8 pf[8][2];
#pragma unroll
    for (int mb = 0; mb < 8; ++mb) {
        float pv[16];
#pragma unroll
        for (int e = 0; e < 16; ++e) { pv[e] = __expf(sacc[mb][e] - mx); sum += pv[e]; }
#pragma unroll
        for (int s = 0; s < 2; ++s) pf[mb][s] = mk8u(cvt_pk_bf16(pv[8 * s + 0], pv[8 * s + 1]), cvt_pk_bf16(pv[8 * s + 2], pv[8 * s + 3]), cvt_pk_bf16(pv[8 * s + 4], pv[8 * s + 5]), cvt_pk_bf16(pv[8 * s + 6], pv[8 * s + 7]));
    }
    sum += __shfl_xor(sum, 32);
    const float inv = 1.0f / sum;
    __syncthreads();
    {
        const bf16_t* vp = VT + (size_t)(h * 256) * 1024 + b * 256;
#pragma unroll
        for (int it = 0; it < 16; ++it) { const int idx = tid + 512 * it, e = idx >> 5, cc = idx & 31;
            const u32x4 v = *(const u32x4*)(vp + (size_t)e * 1024 + cc * 8);
            u32x2* d = (u32x2*)(lds + e * 520 + cc * 16); d[0] = (u32x2){v.x, v.y}; d[1] = (u32x2){v.z, v.w}; }
    }
    __syncthreads();
    bf16_t* op = ATT + (size_t)(row0 + 32 * w + r) * 1024 + h * 256 + 4 * hh;
#pragma unroll
    for (int half = 0; half < 2; ++half) {
        f32x16 oacc[4];
#pragma unroll
        for (int d = 0; d < 4; ++d)
#pragma unroll
            for (int e = 0; e < 16; ++e) oacc[d][e] = 0.f;
#pragma unroll
        for (int mb = 0; mb < 8; ++mb)
#pragma unroll
            for (int s = 0; s < 2; ++s)
#pragma unroll
                for (int d = 0; d < 4; ++d) {
                    const unsigned char* base = lds + (32 * (half * 4 + d) + r) * 520 + (32 * mb + 16 * s + 4 * hh) * 2;
                    const bf16x8 a = mk8(*(const u32x2*)base, *(const u32x2*)(base + 16));
                    oacc[d] = mfma32(a, pf[mb][s], oacc[d]);
                }
#pragma unroll
        for (int d = 0; d < 4; ++d)
#pragma unroll
            for (int g = 0; g < 4; ++g) {
                u32x2 o; o.x = cvt_pk_bf16(oacc[d][4 * g] * inv, oacc[d][4 * g + 1] * inv); o.y = cvt_pk_bf16(oacc[d][4 * g + 2] * inv, oacc[d][4 * g + 3] * inv);
                *(u32x2*)(op + 32 * (half * 4 + d) + 8 * g) = o;
            }
    }
    __syncthreads();
}

__device__ __forceinline__ void phase_final(const bf16_t* __restrict__ xb, const float* __restrict__ ssq, float* __restrict__ out, const float* __restrict__ g) {
    const int tid = threadIdx.x, sub = tid >> 7, l = tid & 127;
    const f32x4 g0 = *(const f32x4*)(g + 8 * l), g1 = *(const f32x4*)(g + 8 * l + 4);
    for (int r = blockIdx.x * 4 + sub; r < MROWS; r += gridDim.x * 4) {
        const u32x4 v = *(const u32x4*)(xb + (size_t)r * DM + 8 * l);
        const f32x4* pp = (const f32x4*)(ssq + (size_t)r * 16); const f32x4 a = pp[0], b = pp[1], c = pp[2], d = pp[3];
        const float t = ((a[0] + a[1]) + (a[2] + a[3])) + ((b[0] + b[1]) + (b[2] + b[3])) + ((c[0] + c[1]) + (c[2] + c[3])) + ((d[0] + d[1]) + (d[2] + d[3]));
        const float rstd = rsqrtf(t * (1.0f / 1024.0f) + EPS);
        const f32x4 o0 = (f32x4){bflo(v.x), bfhi(v.x), bflo(v.y), bfhi(v.y)} * rstd * g0, o1 = (f32x4){bflo(v.z), bfhi(v.z), bflo(v.w), bfhi(v.w)} * rstd * g1;
        *(f32x4*)(out + (size_t)r * DM + 8 * l) = o0; *(f32x4*)(out + (size_t)r * DM + 8 * l + 4) = o1;
    }
}

#define XB_TMO      128
#define XB_XCNT(j)  (256  + 64 * (j))
#define XB_XSUB(j)  (1280 + 64 * (j))
#define XB_XGEN(j)  (2304 + 64 * (j))
#define XB_TOP      3328
#define XB_TOPGEN   3392
#define XCD_BAR_WORDS 3456
#define XB_SPIN_CAP (1u << 22)
__device__ __forceinline__ unsigned xb_ld(unsigned* p)              { return __hip_atomic_load(p, __ATOMIC_RELAXED, __HIP_MEMORY_SCOPE_AGENT); }
__device__ __forceinline__ unsigned xb_add(unsigned* p, unsigned v) { return __hip_atomic_fetch_add(p, v, __ATOMIC_RELAXED, __HIP_MEMORY_SCOPE_AGENT); }
__device__ __forceinline__ unsigned xb_xcc_id() { return (unsigned)__builtin_amdgcn_s_getreg((3 << 11) | 20) & 0xFu; }
#define XB_SPIN(cond, bar) do { unsigned _sp = 0; while (cond) { __builtin_amdgcn_s_sleep(1); \
    if ((++_sp & 255u) == 0u) { if (xb_ld(&(bar)[XB_TMO])) break; if (_sp > XB_SPIN_CAP) { atomicAdd(&(bar)[XB_TMO], 1u); break; } } } } while (0)
struct XcdBarrier { unsigned* bar; unsigned x; volatile LAS unsigned* st; };
__device__ __forceinline__ XcdBarrier xcd_barrier_post(unsigned* bar, volatile LAS unsigned* st) {
    XcdBarrier b; b.bar = bar; b.x = xb_xcc_id(); b.st = st;
    if (threadIdx.x == 0) (void)xb_add(&bar[XB_XCNT(b.x)], 1u);
    return b;
}
__device__ __forceinline__ void xcd_barrier_complete(unsigned* bar, unsigned x, unsigned& nloc, unsigned& nx) {
    const unsigned G = gridDim.x * gridDim.y * gridDim.z;
    unsigned sum, cnt, mine, sp = 0u;
    for (;;) {
        sum = 0u; cnt = 0u; mine = 0u;
#pragma unroll
        for (unsigned j = 0; j < 16; ++j) { const unsigned c = xb_ld(&bar[XB_XCNT(j)]); sum += c; cnt += (c > 0u) ? 1u : 0u; mine = (j == x) ? c : mine; }
        if (sum == G) break;
        __builtin_amdgcn_s_sleep(1);
        if ((++sp & 255u) == 0u) { if (xb_ld(&bar[XB_TMO])) break; if (sp > XB_SPIN_CAP) { atomicAdd(&bar[XB_TMO], 1u); break; } }
    }
    nloc = mine > 0u ? mine : 1u; nx = cnt > 0u ? cnt : 1u;
}
__device__ __forceinline__ void xcd_barrier(const XcdBarrier& b) {
    asm volatile("s_waitcnt vmcnt(0)" ::: "memory");
    __syncthreads();
    if (threadIdx.x == 0) {
        unsigned* bar = b.bar;
        __builtin_amdgcn_s_waitcnt(0);
        unsigned nloc = b.st[0], nx = b.st[1];
        if (nloc == 0u) { xcd_barrier_complete(bar, b.x, nloc, nx); b.st[0] = nloc; b.st[1] = nx; }
        const unsigned old = xb_add(&bar[XB_XSUB(b.x)], 1u);
        const unsigned gen = old / nloc;
        if (old + 1u == (gen + 1u) * nloc) {
            __builtin_amdgcn_fence(__ATOMIC_RELEASE, "agent");
            asm volatile("s_waitcnt vmcnt(0)" ::: "memory");
            const unsigned og = xb_add(&bar[XB_TOP], 1u);
            const unsigned tg = og / nx;
            if (og + 1u == (tg + 1u) * nx) xb_add(&bar[XB_TOPGEN], 1u);
            else XB_SPIN(xb_ld(&bar[XB_TOPGEN]) == tg, bar);
            __builtin_amdgcn_fence(__ATOMIC_ACQUIRE, "agent");
            xb_add(&bar[XB_XGEN(b.x)], 1u);
            asm volatile("s_waitcnt vmcnt(0)" ::: "memory");
        } else {
            XB_SPIN(xb_ld(&bar[XB_XGEN(b.x)]) == gen, bar);
            __builtin_amdgcn_fence(__ATOMIC_ACQUIRE, "agent");
            asm volatile("s_waitcnt vmcnt(0)" ::: "memory");
        }
    }
    __syncthreads();
}

constexpr int N_PHASES = 12;
__global__ void __launch_bounds__(NTHREADS, 2) mega(Params p) {
    extern __shared__ __attribute__((aligned(16))) unsigned char lds[];
    LAS unsigned char* ldsl = (LAS unsigned char*)lds;
    unsigned char* ws = p.ws;
    const int G = gridDim.x, bid = blockIdx.x;
    const int lo = p.ph_lo, hi = p.ph_hi;

#ifndef DEFER_PREP
#define DEFER_PREP 0
#endif
#ifndef FUSE_FINAL
#define FUSE_FINAL 0
#endif
#ifndef DBG_LAST
#define DBG_LAST -1
#endif
#ifndef PHASE_MASK
#define PHASE_MASK 0xfff
#endif
#define IN(k) (((PHASE_MASK >> (k)) & 1) && lo <= (k) && (k) < hi)
    if (threadIdx.x == 0) { ((volatile LAS unsigned*)(ldsl + LDS_MAIN))[0] = 0u; ((volatile LAS unsigned*)(ldsl + LDS_MAIN))[1] = 0u; }
    __syncthreads();
    XcdBarrier xbar; xbar.bar = (unsigned*)(ws + WS_BAR); xbar.x = 0; xbar.st = nullptr;
    if (hi - lo > 1) xbar = xcd_barrier_post((unsigned*)(ws + WS_BAR), (volatile LAS unsigned*)(ldsl + LDS_MAIN));
    if (lo > hi) cg::this_grid().sync();
#define SEAM(k) do { if (IN(k) && IN((k) + 1)) { xcd_barrier(xbar); } } while (0)
    bf16_t* XB = (bf16_t*)(ws + WS_XB); bf16_t* LT = (bf16_t*)(ws + WS_ST);
    bf16_t* QH = (bf16_t*)(ws + WS_QH); bf16_t* KH = (bf16_t*)(ws + WS_KH); bf16_t* VH = (bf16_t*)(ws + WS_VH); bf16_t* GH = (bf16_t*)(ws + WS_GH); bf16_t* PH = (bf16_t*)(ws + WS_PH);
    float* LF = (float*)(ws + WS_LF); bf16_t* ST = (bf16_t*)(ws + WS_ST); bf16_t* MIXED = (bf16_t*)(ws + WS_MIXED);
    float* X1 = (float*)(ws + WS_X1); bf16_t* XQ = (bf16_t*)(ws + WS_XQ); bf16_t* ATT = (bf16_t*)(ws + WS_ATT); bf16_t* U = (bf16_t*)(ws + WS_U);
    float* SSQ = (float*)(ws + WS_SSQ); float* DEC = (float*)(ws + WS_DEC);
    bf16_t* MEMB = (bf16_t*)(ws + WS_MEMB); bf16_t* KX = (bf16_t*)(ws + WS_KX); bf16_t* VT = (bf16_t*)(ws + WS_VT);

    const bool fuse_final = FUSE_FINAL && (G == 256) && IN(10) && (hi - lo > 1);
    if (IN(0)) { phase_prep(p, lds);
#if !DEFER_PREP
        deferred_prep(p, lds, bid, G);
#endif
    }
    SEAM(0);
    if (IN(1)) {
        const pg8::Epi E{0, ws, p.x, p.out, p.lb_logits, p.final_norm_g};
        { pg8::Gemm g{XB, (const bf16_t*)(ws + WS_WT_IN), MROWS, NIN, DM}; pg8::StaticOrder S; S.init(MROWS, NIN, G, bid); pg8::gemm_phase(ldsl, g, S, E); }
        const pg8::Epi E1{1, ws, p.x, p.out, p.lb_logits, p.final_norm_g};
        { pg8::Gemm g{MEMB, (const bf16_t*)(ws + WS_WT_K), MEMROWS, 1024, DM}; pg8::StaticOrder S; S.init(MEMROWS, 1024, G, (bid + 128) % G); pg8::gemm_phase(ldsl, g, S, E1); }
        const pg8::Epi E2{2, ws, p.x, p.out, p.lb_logits, p.final_norm_g};
        { pg8::Gemm g{(const bf16_t*)(ws + WS_WT_V), MEMB, 1024, MEMROWS, DM}; pg8::StaticOrder S; S.init(1024, MEMROWS, G, (bid + 112) % G); pg8::gemm_phase(ldsl, g, S, E2); }
#if DEFER_PREP
        if (G == 256) { if (bid >= 160) deferred_prep(p, lds, bid - 160, 96); }
        else deferred_prep(p, lds, bid, G);
#endif
    }
    SEAM(1);
    if (IN(2)) {
#ifndef DBG_NO_PASSA
        phase_passA(KH, LF, VH, LT, DEC, lds);
#endif
#ifndef DBG_NO_POOL
        for (int t = bid; t < 256; t += G) pool_tile(PH, MIXED, t);
#endif
        fold_pool_weights_mfma(p);
    }
    SEAM(2);
    if (IN(3)) { phase_scan(LT, DEC, ST); }
    SEAM(3);
    if (IN(4)) { phase_passC(QH, KH, LF, VH, GH, ST, p.hgrn_norm_g, MIXED, lds); }
    SEAM(4);
    if (IN(5)) {
        const pg8::Epi E{6, ws, p.x, p.out, p.lb_logits, p.final_norm_g};
        pg8::Gemm g{MIXED, (const bf16_t*)(ws + WS_WT_OUT), MROWS, DM, DM}; pg8::StaticOrder S; S.init(MROWS, DM, G, bid); pg8::gemm_phase(ldsl, g, S, E);
    }
    SEAM(5);
    const bool fuse_attn = (G == 256) && IN(6) && IN(7);
    if (IN(6)) {
        const pg8::Epi E{4, ws, p.x, p.out, p.lb_logits, p.final_norm_g};
        pg8::Gemm g{XB, (const bf16_t*)(ws + WS_WT_Q), MROWS, DM, DM}; pg8::StaticOrder S; S.init(MROWS, DM, G, bid); pg8::gemm_phase(ldsl, g, S, E);
        if (fuse_attn) {
            pg8::Unit u; S.next(0, u);
            asm volatile("s_waitcnt vmcnt(0)" ::: "memory"); __syncthreads();
            attn_unit(XQ, KX, VT, ATT, u.pm * 4 + u.pn, lds);
        }
    }
    if (!fuse_attn) {
        SEAM(6);
        if (IN(7)) { for (int u = bid; u < 256; u += G) attn_unit(XQ, KX, VT, ATT, u, lds); }
    }
    SEAM(7);
    if (IN(8)) {
        const pg8::Epi E{6, ws, p.x, p.out, p.lb_logits, p.final_norm_g};
        pg8::Gemm g{ATT, (const bf16_t*)(ws + WS_WT_O), MROWS, DM, DM}; pg8::StaticOrder S; S.init(MROWS, DM, G, bid); pg8::gemm_phase(ldsl, g, S, E);
    }
    SEAM(8);
    if (IN(9)) {
        const pg8::Epi E{5, ws, p.x, p.out, p.lb_logits, p.final_norm_g};
        pg8::Gemm g{XB, (const bf16_t*)(ws + WS_WT_FF1), MROWS, DFF, DM}; pg8::StaticOrder S; S.init(MROWS, DFF, G, bid); pg8::gemm_phase(ldsl, g, S, E);
    }
    SEAM(9);
    if (IN(10)) {
        const pg8::Epi E{fuse_final ? 8 : 7, ws, p.x, p.out, p.lb_logits, p.final_norm_g};
        pg8::Gemm g{U, (const bf16_t*)(ws + WS_WT_FF2), MROWS, DM, DFF}; pg8::StaticOrder S; S.init(MROWS, DM, G, bid); pg8::gemm_phase(ldsl, g, S, E);
    }
    if (!fuse_final) {
        SEAM(10);
        if (IN(11)) { phase_final(XB, SSQ, p.out, p.final_norm_g); }
    }
#if DBG_LAST >= 0
    cg::this_grid().sync();
    {
        const unsigned* w32 = (const unsigned*)ws;
        for (size_t i = (size_t)bid * NTHREADS + threadIdx.x; i < (size_t)MROWS * DM; i += (size_t)G * NTHREADS) {
            float a = 0.f;
            for (int j = 0; j < 4; ++j) { const unsigned v = w32[i + (size_t)j * MROWS * DM]; a += (float)(v & 0xffffu) + (float)(v >> 16); }
            p.out[i] = a;
        }
    }
#endif
#undef IN
#undef SEAM
}

extern "C" void kernel_launch(void* const* d_in, const int* in_sizes, int n_in, void* d_out, int out_size, void* d_ws, size_t ws_size, hipStream_t stream) {
    static int grid = 0;
    if (grid == 0) {
        if (n_in != 19 || in_sizes[0] != MROWS * DM || out_size != MROWS * DM || ws_size < WS_END) { fprintf(stderr, "kernel_launch: unexpected shapes (n_in %d, ws %zu)\n", n_in, ws_size); grid = -1; return; }
        int dev = 0, cus = 0, per_cu = 0;
        hipGetDevice(&dev); hipDeviceGetAttribute(&cus, hipDeviceAttributeMultiprocessorCount, dev);
        if (hipFuncSetAttribute((const void*)mega, hipFuncAttributeMaxDynamicSharedMemorySize, LDS_BYTES) != hipSuccess) { fprintf(stderr, "kernel_launch: hipFuncSetAttribute failed\n"); grid = -1; return; }
        if (hipOccupancyMaxActiveBlocksPerMultiprocessor(&per_cu, (const void*)mega, NTHREADS, LDS_BYTES) != hipSuccess || per_cu < 1) { fprintf(stderr, "kernel_launch: occupancy query says %d\n", per_cu); per_cu = 1; }
        (void)hipGetLastError();
        grid = cus * 1;
        if (grid > cus * per_cu) grid = cus * per_cu;
    }
    if (grid < 0) return;
    if (hipMemsetAsync((char*)d_ws + WS_BAR, 0, 32768, stream) != hipSuccess) { fprintf(stderr, "kernel_launch: memset of barrier words failed\n"); return; }
    Params p{};
    const float** f = (const float**)&p;
    for (int i = 0; i < 19; ++i) f[i] = (const float*)d_in[i];
    p.out = (float*)d_out; p.ws = (unsigned char*)d_ws;
#if N_LAUNCH_MODE == 1
    p.ph_lo = 0; p.ph_hi = (DBG_LAST >= 0) ? DBG_LAST + 1 : N_PHASES;
    void* args[] = {&p};
    hipError_t e = hipLaunchCooperativeKernel((const void*)mega, dim3(grid), dim3(NTHREADS), args, LDS_BYTES, stream);
    if (e != hipSuccess) fprintf(stderr, "kernel_launch: cooperative launch failed: %s (grid %d)\n", hipGetErrorString(e), grid);
#else
    for (int k = 0; k < N_PHASES; ++k) { p.ph_lo = k; p.ph_hi = k + 1; hipLaunchKernelGGL(mega, dim3(grid), dim3(NTHREADS), LDS_BYTES, stream, p); }
#endif
}
```

```cpp
#include <hip/hip_runtime.h>
#include <hip/hip_cooperative_groups.h>
#include <cstdio>
namespace cg = cooperative_groups;

#ifndef N_LAUNCH_MODE
#define N_LAUNCH_MODE 1
#endif

typedef unsigned short bf16_t;
typedef short bf16x8 __attribute__((ext_vector_type(8)));
typedef float f32x2 __attribute__((ext_vector_type(2)));
typedef float f32x4 __attribute__((ext_vector_type(4)));
typedef float f32x16 __attribute__((ext_vector_type(16)));
typedef unsigned u32x2 __attribute__((ext_vector_type(2)));
typedef unsigned u32x4 __attribute__((ext_vector_type(4)));
#define LAS __attribute__((address_space(3)))

constexpr int MROWS = 16384, DM = 1024, SEQ = 4096, NIN = 2560, DFF = 4096, MEMROWS = 1024;
constexpr float EPS = 1e-6f;
constexpr int NTHREADS = 512;
constexpr int LDS_MAIN = 135168;
constexpr int LDS_BYTES = LDS_MAIN + 16;

constexpr size_t MiB = 1u << 20;
constexpr size_t WS_WT_IN = 0, WS_WT_K = 5 * MiB, WS_WT_V = 7 * MiB, WS_WT_OUT = 9 * MiB, WS_WT_Q = 11 * MiB, WS_WT_O = 13 * MiB,
                 WS_WT_FF1 = 15 * MiB, WS_WT_FF2 = 23 * MiB, WS_MEMB = 31 * MiB, WS_KX = 33 * MiB, WS_VT = 35 * MiB, WS_SSQ = 37 * MiB,
                 WS_BAR = 39 * MiB, WS_CNT = 39 * MiB + 16384, WS_RSTD0 = 38 * MiB, WS_RSTDM = 38 * MiB + 65536, WS_DEC = 38 * MiB + 131072,
                 WS_XB = 40 * MiB  , WS_QH = 72 * MiB, WS_KH = 88 * MiB, WS_VH = 104 * MiB, WS_GH = 120 * MiB, WS_PH = 136 * MiB,
                 WS_LF = 152 * MiB, WS_ST = 184 * MiB, WS_MIXED = 216 * MiB,
                 WS_X1 = 72 * MiB, WS_XQ = 136 * MiB, WS_ATT = 168 * MiB, WS_U = 72 * MiB, WS_END = 256 * MiB;

typedef __bf16 bf16x2n __attribute__((ext_vector_type(2)));
__device__ __forceinline__ unsigned cvt_pk_bf16(float lo, float hi) { f32x2 v = {lo, hi}; return __builtin_bit_cast(unsigned, __builtin_convertvector(v, bf16x2n)); }
__device__ __forceinline__ bf16_t f2bf(float f) { return (bf16_t)(cvt_pk_bf16(f, 0.f) & 0xffffu); }
__device__ __forceinline__ float bf2f(bf16_t b) { return __uint_as_float(((unsigned)b) << 16); }
__device__ __forceinline__ float bflo(unsigned u) { return __uint_as_float(u << 16); }
__device__ __forceinline__ float bfhi(unsigned u) { return __uint_as_float(u & 0xffff0000u); }
__device__ __forceinline__ f32x4 mfma16(bf16x8 a, bf16x8 b, f32x4 c) { return __builtin_amdgcn_mfma_f32_16x16x32_bf16(a, b, c, 0, 0, 0); }
__device__ __forceinline__ f32x16 mfma32(bf16x8 a, bf16x8 b, f32x16 c) { return __builtin_amdgcn_mfma_f32_32x32x16_bf16(a, b, c, 0, 0, 0); }
__device__ __forceinline__ bf16x8 mk8(u32x2 lo, u32x2 hi) { u32x4 t; t.x = lo.x; t.y = lo.y; t.z = hi.x; t.w = hi.y; return __builtin_bit_cast(bf16x8, t); }
__device__ __forceinline__ bf16x8 mk8u(unsigned a, unsigned b, unsigned c, unsigned d) { u32x4 t; t.x = a; t.y = b; t.z = c; t.w = d; return __builtin_bit_cast(bf16x8, t); }
__device__ __forceinline__ float sigmoidf_(float z) { return 1.0f / (1.0f + __expf(-z)); }

namespace pg8 {
constexpr int BM = 256, BK = 64, HALF = 128, HTB = HALF * BK * 2, STAGE_BYTES = 8 * HTB, NXCD = 8, WGM = 8;
__device__ __forceinline__ int lds_byte(int r, int c) { const int st = (r >> 4) * 2 + (c >> 5), rr = r & 15, cc = c & 31, ob = rr * 64 + cc * 2; return st * 1024 + (ob ^ (((ob >> 9) & 1) << 5)); }
__device__ __forceinline__ void stage_rc(int b, int& R, int& C) { const int st = b / 1024, sb = b % 1024, swz = sb ^ (((sb >> 9) & 1) << 5); R = (st >> 1) * 16 + swz / 64; C = (st & 1) * 32 + (swz % 64) / 2; }
__device__ __forceinline__ int perm32(int rho) { const int n = rho >> 4, i = rho & 15; return 8 * (i >> 2) + 4 * n + (i & 3); }
struct Unit { int pm, pn; };
struct Gemm { const bf16_t* A; const bf16_t* Bt; int M, N, K; };
struct StaticOrder {
    int nM, nN, nwg, G, c;
    __device__ __forceinline__ void init(int M, int N, int G_, int c_) { nM = M / BM; nN = N / BM; nwg = nM * nN; G = G_; c = c_; }
    __device__ __forceinline__ bool next(int i, Unit& u) const {
        const long L = (long)i * G + c; if (L >= nwg) return false;
        int wgid = (int)L; { const int q = nwg / NXCD, r = nwg % NXCD, xcd = wgid % NXCD, off = wgid / NXCD; wgid = (xcd < r ? xcd * (q + 1) : r * (q + 1) + (xcd - r) * q) + off; }
        const int nig = WGM * nN, gid = wgid / nig, fm = gid * WGM, gsz = (nM - fm) < WGM ? (nM - fm) : WGM;
        u.pm = fm + ((wgid % nig) % gsz); u.pn = (wgid % nig) / gsz; return true;
    }
};

struct Epi {
    static constexpr bool PERM = true;
    int mode;
    unsigned char* ws; const float* x; float* out; const float* lbl; const float* gfin;
    __device__ __forceinline__ void store8(bf16_t* p, const f32x4& v0, const f32x4& v1) const {
        u32x4 w; w.x = cvt_pk_bf16(v0[0], v0[1]); w.y = cvt_pk_bf16(v0[2], v0[3]); w.z = cvt_pk_bf16(v1[0], v1[1]); w.w = cvt_pk_bf16(v1[2], v1[3]); *(u32x4*)p = w; }
    __device__ __forceinline__ void fused(f32x4 (&acc)[2][2][4][2], const Unit& u, int wr, int wc, int fr, int fq) const {
        const int row0 = u.pm * BM + wr * 64 + fr;
        const int col0 = u.pn * BM + wc * 32 + 8 * fq;
        const bf16_t* xb = (const bf16_t*)(ws + WS_XB);
        unsigned* sq = (unsigned*)(ws + WS_SSQ);
        unsigned* cnt = (unsigned*)(ws + WS_CNT) + 64 * u.pm;
        u32x4 bc[2], bn[2];
        { const size_t o = (size_t)row0 * DM + col0; bc[0] = *(const u32x4*)(xb + o); bc[1] = *(const u32x4*)(xb + o + HALF); }
#pragma unroll
        for (int gidx = 0; gidx < 8; ++gidx) { const int ai = gidx >> 2, m = gidx & 3; const int row = row0 + ai * HALF + m * 16;
            if (gidx < 7) { const int g2 = gidx + 1; const size_t o2 = (size_t)(row0 + (g2 >> 2) * HALF + (g2 & 3) * 16) * DM + col0; bn[0] = *(const u32x4*)(xb + o2); bn[1] = *(const u32x4*)(xb + o2 + HALF); }
            float ss = 0.f;
#pragma unroll
            for (int bj = 0; bj < 2; ++bj) { const u32x4 bb = bc[bj];
                const f32x4 v0 = acc[ai][bj][m][0] + (f32x4){bflo(bb.x), bfhi(bb.x), bflo(bb.y), bfhi(bb.y)}, v1 = acc[ai][bj][m][1] + (f32x4){bflo(bb.z), bfhi(bb.z), bflo(bb.w), bfhi(bb.w)};
                acc[ai][bj][m][0] = v0; acc[ai][bj][m][1] = v1;
                ss += (v0[0] * v0[0] + v0[1] * v0[1]) + (v0[2] * v0[2] + v0[3] * v0[3]) + (v1[0] * v1[0] + v1[1] * v1[1]) + (v1[2] * v1[2] + v1[3] * v1[3]); }
            ss += __shfl_xor(ss, 16); ss += __shfl_xor(ss, 32);
            if (fq == 0) __hip_atomic_store(sq + (size_t)row * 16 + u.pn * 4 + wc, __float_as_uint(ss), __ATOMIC_RELAXED, __HIP_MEMORY_SCOPE_AGENT);
            bc[0] = bn[0]; bc[1] = bn[1]; }
        asm volatile("s_waitcnt vmcnt(0)" ::: "memory");
        if ((threadIdx.x & 63) == 0) __hip_atomic_fetch_add(cnt, 1u, __ATOMIC_RELAXED, __HIP_MEMORY_SCOPE_AGENT);
        f32x4 gv[2][2];
#pragma unroll
        for (int bj = 0; bj < 2; ++bj) { gv[bj][0] = *(const f32x4*)(gfin + col0 + bj * HALF); gv[bj][1] = *(const f32x4*)(gfin + col0 + bj * HALF + 4); }
        { unsigned spins = 0; while ((unsigned)__builtin_amdgcn_readfirstlane(__hip_atomic_load(cnt, __ATOMIC_RELAXED, __HIP_MEMORY_SCOPE_AGENT)) < 32u) { __builtin_amdgcn_s_sleep(1); if (++spins > (1u << 22)) break; } }
        __builtin_amdgcn_fence(__ATOMIC_ACQUIRE, "agent");
        asm volatile("s_waitcnt vmcnt(0)" ::: "memory");
        f32x4 pv[8];
#pragma unroll
        for (int gidx = 0; gidx < 8; ++gidx) pv[gidx] = *(const f32x4*)((const float*)sq + (size_t)(row0 + (gidx >> 2) * HALF + (gidx & 3) * 16) * 16 + 4 * fq);
#pragma unroll
        for (int gidx = 0; gidx < 8; ++gidx) { const int ai = gidx >> 2, m = gidx & 3; const int row = row0 + ai * HALF + m * 16;
            float t = (pv[gidx][0] + pv[gidx][1]) + (pv[gidx][2] + pv[gidx][3]); t += __shfl_xor(t, 16); t += __shfl_xor(t, 32);
            const float rstd = rsqrtf(t * (1.0f / 1024.0f) + EPS);
            const size_t o = (size_t)row * DM + col0;
#pragma unroll
            for (int bj = 0; bj < 2; ++bj) { *(f32x4*)(out + o + bj * HALF) = acc[ai][bj][m][0] * rstd * gv[bj][0]; *(f32x4*)(out + o + bj * HALF + 4) = acc[ai][bj][m][1] * rstd * gv[bj][1]; } }
    }
    template <class Sched>
    __device__ __forceinline__ bool prefill(LAS unsigned char* lds, const Sched& S) const {
        if (!(mode == 0 || mode == 1 || mode == 4 || mode == 5) || S.nwg > 4 * S.G) return false;
        const int tid = threadIdx.x, rr = tid & 255;
#pragma unroll
        for (int k = 0; k < 2; ++k) { const int ui = (tid >> 8) + 2 * k; Unit u;
            if (S.next(ui, u)) { const int row = u.pm * BM + rr; float r;
                if (mode == 4 || mode == 5) { const f32x4* pp = (const f32x4*)((const float*)(ws + WS_SSQ) + (size_t)row * 16); const f32x4 a = pp[0], b = pp[1], c = pp[2], d = pp[3];
                    const float t = ((a[0] + a[1]) + (a[2] + a[3])) + ((b[0] + b[1]) + (b[2] + b[3])) + ((c[0] + c[1]) + (c[2] + c[3])) + ((d[0] + d[1]) + (d[2] + d[3]));
                    r = rsqrtf(t * (1.0f / 1024.0f) + EPS) * (mode == 4 ? 0.0625f : 1.0f); }
                else r = ((const float*)(ws + (mode == 0 ? WS_RSTD0 : WS_RSTDM)))[row];
                *(LAS float*)(lds + STAGE_BYTES + (ui * 256 + rr) * 4) = r; } }
        return true;
    }
    __device__ __forceinline__ void operator()(const f32x4 (&acc)[2][2][4][2], const Unit& u, int ui, bool tab, LAS unsigned char* lds, int wr, int wc, int fr, int fq) const {
        const int row0 = u.pm * BM + wr * 64 + fr;
        const int colL = wc * 32 + 8 * fq;
        if (mode == 3 || mode == 6 || mode == 7) {
            const int col0 = u.pn * BM + colL;
            bf16_t* xb = (bf16_t*)(ws + WS_XB);
            float* ssq = (float*)(ws + WS_SSQ);
            f32x4 rc[4], rn[4];
            u32x4 bc[2], bn[2];
            if (mode == 3) { const size_t o = (size_t)row0 * DM + col0; rc[0] = *(const f32x4*)(x + o); rc[1] = *(const f32x4*)(x + o + 4); rc[2] = *(const f32x4*)(x + o + HALF); rc[3] = *(const f32x4*)(x + o + HALF + 4); }
            else { const size_t o = (size_t)row0 * DM + col0; bc[0] = *(const u32x4*)(xb + o); bc[1] = *(const u32x4*)(xb + o + HALF); }
#pragma unroll
            for (int gidx = 0; gidx < 8; ++gidx) { const int ai = gidx >> 2, m = gidx & 3; const int row = row0 + ai * HALF + m * 16;
                if (gidx < 7) { const int g2 = gidx + 1; const size_t o2 = (size_t)(row0 + (g2 >> 2) * HALF + (g2 & 3) * 16) * DM + col0;
                    if (mode == 3) { rn[0] = *(const f32x4*)(x + o2); rn[1] = *(const f32x4*)(x + o2 + 4); rn[2] = *(const f32x4*)(x + o2 + HALF); rn[3] = *(const f32x4*)(x + o2 + HALF + 4); }
                    else { bn[0] = *(const u32x4*)(xb + o2); bn[1] = *(const u32x4*)(xb + o2 + HALF); } }
                if (mode != 3) {
#pragma unroll
                    for (int bj = 0; bj < 2; ++bj) { rc[2 * bj] = (f32x4){bflo(bc[bj].x), bfhi(bc[bj].x), bflo(bc[bj].y), bfhi(bc[bj].y)}; rc[2 * bj + 1] = (f32x4){bflo(bc[bj].z), bfhi(bc[bj].z), bflo(bc[bj].w), bfhi(bc[bj].w)}; } }
                float ss = 0.f;
#pragma unroll
                for (int bj = 0; bj < 2; ++bj) { const size_t o = (size_t)row * DM + col0 + bj * HALF;
                    const f32x4 v0 = acc[ai][bj][m][0] + rc[2 * bj], v1 = acc[ai][bj][m][1] + rc[2 * bj + 1];
                    store8(xb + o, v0, v1);
                    ss += (v0[0] * v0[0] + v0[1] * v0[1]) + (v0[2] * v0[2] + v0[3] * v0[3]) + (v1[0] * v1[0] + v1[1] * v1[1]) + (v1[2] * v1[2] + v1[3] * v1[3]); }
                ss += __shfl_xor(ss, 16); ss += __shfl_xor(ss, 32);
                if (fq == 0) ssq[(size_t)row * 16 + u.pn * 4 + wc] = ss;
#pragma unroll
                for (int k = 0; k < 4; ++k) rc[k] = rn[k];
                bc[0] = bn[0]; bc[1] = bn[1]; }
            return;
        }
        if (mode == 2) {
            const int col0 = u.pn * BM + colL;
            const float* rs = (const float*)(ws + WS_RSTDM); bf16_t* ob = (bf16_t*)(ws + WS_VT); const int ldo = 1024;
            f32x4 c0[2], c1[2];
#pragma unroll
            for (int bj = 0; bj < 2; ++bj) { c0[bj] = *(const f32x4*)(rs + col0 + bj * HALF); c1[bj] = *(const f32x4*)(rs + col0 + bj * HALF + 4); }
#pragma unroll
            for (int ai = 0; ai < 2; ++ai)
#pragma unroll
                for (int m = 0; m < 4; ++m) { const int row = row0 + ai * HALF + m * 16;
#pragma unroll
                    for (int bj = 0; bj < 2; ++bj) store8(ob + (size_t)row * ldo + col0 + bj * HALF, acc[ai][bj][m][0] * c0[bj], acc[ai][bj][m][1] * c1[bj]); }
            return;
        }
        float rsc[8];
        if (tab) {
#pragma unroll
            for (int gidx = 0; gidx < 8; ++gidx) rsc[gidx] = *(const LAS float*)(lds + STAGE_BYTES + (ui * 256 + wr * 64 + fr + (gidx >> 2) * HALF + (gidx & 3) * 16) * 4);
        } else if (mode == 4 || mode == 5) {
            const float* sq = (const float*)(ws + WS_SSQ);
            f32x4 pv[8];
#pragma unroll
            for (int gidx = 0; gidx < 8; ++gidx) pv[gidx] = *(const f32x4*)(sq + (size_t)(row0 + (gidx >> 2) * HALF + (gidx & 3) * 16) * 16 + 4 * fq);
            const float cs = mode == 4 ? 0.0625f : 1.0f;
#pragma unroll
            for (int gidx = 0; gidx < 8; ++gidx) { float t = (pv[gidx][0] + pv[gidx][1]) + (pv[gidx][2] + pv[gidx][3]); t += __shfl_xor(t, 16); t += __shfl_xor(t, 32); rsc[gidx] = rsqrtf(t * (1.0f / 1024.0f) + EPS) * cs; }
        } else {
            const float* rs = (const float*)(ws + (mode == 0 ? WS_RSTD0 : WS_RSTDM));
#pragma unroll
            for (int gidx = 0; gidx < 8; ++gidx) rsc[gidx] = rs[row0 + (gidx >> 2) * HALF + (gidx & 3) * 16];
        }
        if (mode == 0) {
            float* lf = (float*)(ws + WS_LF);
            const int sub = u.pn >> 1; const int cb = (u.pn & 1) * 256 + colL;
            if (sub == 1) {
                float oml[2][8];
#pragma unroll
                for (int bj = 0; bj < 2; ++bj)
#pragma unroll
                    for (int j = 0; j < 8; ++j) { const int c = cb + bj * HALF + j; const float l0 = lbl[c], l1 = lbl[512 + c]; const float lb = 1.0f / (1.0f + __expf(l1 - l0)); oml[bj][j] = 1.0f - lb; }
#pragma unroll
                for (int ai = 0; ai < 2; ++ai)
#pragma unroll
                    for (int m = 0; m < 4; ++m) { const int row = row0 + ai * HALF + m * 16; const float r = rsc[ai * 4 + m];
#pragma unroll
                        for (int bj = 0; bj < 2; ++bj) { f32x4 lf0, lf1;
#pragma unroll
                            for (int j = 0; j < 4; ++j) {
                                const float za = acc[ai][bj][m][0][j] * r, zb = acc[ai][bj][m][1][j] * r;
                                const float ka = oml[bj][j] * (1.0f - sigmoidf_(za)), kb = oml[bj][4 + j] * (1.0f - sigmoidf_(zb));
                                lf0[j] = __logf(1.0f - ka); lf1[j] = __logf(1.0f - kb); }
                            const size_t o = (size_t)row * 512 + cb + bj * HALF;
                            *(f32x4*)(lf + o) = lf0; *(f32x4*)(lf + o + 4) = lf1; } }
            } else {
                bf16_t* dst = (bf16_t*)(ws + (sub == 0 ? WS_QH : (sub == 2 ? WS_VH : (sub == 3 ? WS_GH : WS_PH))));
                const bool act = (sub == 0) || (sub == 3);
#pragma unroll
                for (int ai = 0; ai < 2; ++ai)
#pragma unroll
                    for (int m = 0; m < 4; ++m) { const int row = row0 + ai * HALF + m * 16; const float r = rsc[ai * 4 + m];
#pragma unroll
                        for (int bj = 0; bj < 2; ++bj) { f32x4 v0 = acc[ai][bj][m][0] * r, v1 = acc[ai][bj][m][1] * r;
                            if (act) {
#pragma unroll
                                for (int j = 0; j < 4; ++j) { v0[j] = v0[j] * sigmoidf_(v0[j]); v1[j] = v1[j] * sigmoidf_(v1[j]); } }
                            store8(dst + (size_t)row * 512 + cb + bj * HALF, v0, v1); } }
            }
        } else {
            const int col0 = u.pn * BM + colL;
            bf16_t* ob = (bf16_t*)(ws + (mode == 1 ? WS_KX : (mode == 4 ? WS_XQ : WS_U))); const int ldo = mode == 5 ? DFF : 1024;
#pragma unroll
            for (int ai = 0; ai < 2; ++ai)
#pragma unroll
                for (int m = 0; m < 4; ++m) { const int row = row0 + ai * HALF + m * 16; const float r = rsc[ai * 4 + m];
#pragma unroll
                    for (int bj = 0; bj < 2; ++bj) { f32x4 v0 = acc[ai][bj][m][0] * r, v1 = acc[ai][bj][m][1] * r;
                        if (mode == 5) {
#pragma unroll
                            for (int j = 0; j < 4; ++j) { const float a = fmaxf(v0[j], 0.f), b = fmaxf(v1[j], 0.f); v0[j] = a * a; v1[j] = b * b; } }
                        store8(ob + (size_t)row * ldo + col0 + bj * HALF, v0, v1); } }
        }
    }
};

template <class EpiT, class Sched>
__device__ __forceinline__ void gemm_phase(LAS unsigned char* lds, const Gemm g, const Sched S, const EpiT E) {
    const int tid = threadIdx.x, wid = __builtin_amdgcn_readfirstlane(tid >> 6), lane = tid & 63, wr = wid >> 2, wc = wid & 3, fr = lane & 15, fq = lane >> 4;
    const int K = g.K, nt = K / BK;
    unsigned voffA[2], voffB[2];
#pragma unroll
    for (int i = 0; i < 2; ++i) { int R, C; stage_rc(tid * 16 + i * 8192, R, C); const int Rb = EpiT::PERM ? ((R & ~31) + perm32(R & 31)) : R;
        voffA[i] = (unsigned)(R * K + C) * 2u; voffB[i] = (unsigned)(Rb * K + C) * 2u; }
    const size_t kstep = (size_t)(BK * 2);
    const size_t hstep = (size_t)HALF * K * 2;
    const size_t tstep = 2 * hstep;
    const unsigned ldsw = (unsigned)wid * 1024u;
    const int aoff = lds_byte(wr * 64 + fr, fq * 8), boff = lds_byte(wc * 32 + fr, fq * 8);
#define PG8_SA(b, h) (((b) * 2 + (h)) * HTB)
#define PG8_SB(b, h) ((4 + (b) * 2 + (h)) * HTB)
#define PG8_STAGE(bufoff, gbase, voff) do { _Pragma("unroll") for (int _i = 0; _i < 2; ++_i) \
        __builtin_amdgcn_global_load_lds((const unsigned*)((const char*)(gbase) + (voff)[_i]), (LAS unsigned*)(lds + (bufoff) + ldsw + _i * 8192), 16, 0, 0); } while (0)
#define PG8_LDA(dst, b, h) do { _Pragma("unroll") for (int m = 0; m < 4; ++m) _Pragma("unroll") for (int k = 0; k < 2; ++k) dst[m][k] = *(const LAS bf16x8*)(lds + PG8_SA(b, h) + aoff + m * 2048 + k * 1024); } while (0)
#define PG8_LDB(dst, b, h) do { _Pragma("unroll") for (int n = 0; n < 2; ++n) _Pragma("unroll") for (int k = 0; k < 2; ++k) dst[n][k] = *(const LAS bf16x8*)(lds + PG8_SB(b, h) + boff + n * 2048 + k * 1024); } while (0)
#define PG8_MMA(ai, bj, At, Bt) do { __builtin_amdgcn_s_setprio(1); _Pragma("unroll") for (int m = 0; m < 4; ++m) _Pragma("unroll") for (int n = 0; n < 2; ++n) _Pragma("unroll") for (int k = 0; k < 2; ++k) \
        acc[ai][bj][m][n] = __builtin_amdgcn_mfma_f32_16x16x32_bf16(Bt[n][k], At[m][k], acc[ai][bj][m][n], 0, 0, 0); __builtin_amdgcn_s_setprio(0); } while (0)
#define PG8_WAIT_V(n) asm volatile("s_waitcnt vmcnt(" #n ")" ::: "memory")
#define PG8_WAIT_L(n) asm volatile("s_waitcnt lgkmcnt(" #n ")" ::: "memory")
#define PG8_BAR __builtin_amdgcn_s_barrier()
#define PG8_SCHED __builtin_amdgcn_sched_barrier(0)
    Unit cur, nxt; int ui = 0;
    if (!S.next(0, cur)) return;
    const bool tab = E.prefill(lds, S);
    if (tab) __syncthreads();
    f32x4 acc[2][2][4][2];
#pragma unroll
    for (int a = 0; a < 2; ++a)
#pragma unroll
        for (int b = 0; b < 2; ++b)
#pragma unroll
            for (int m = 0; m < 4; ++m)
#pragma unroll
                for (int n = 0; n < 2; ++n) acc[a][b][m][n] = (f32x4){0.f, 0.f, 0.f, 0.f};
    bf16x8 At[4][2], B0[2][2], B1[2][2];
    const char* cA = (const char*)g.A + (size_t)cur.pm * tstep; const char* cB = (const char*)g.Bt + (size_t)cur.pn * tstep;
    PG8_STAGE(PG8_SB(0, 0), cB, voffB); PG8_STAGE(PG8_SA(0, 0), cA, voffA); PG8_STAGE(PG8_SB(0, 1), cB + hstep, voffB); PG8_STAGE(PG8_SA(0, 1), cA + hstep, voffA);
    if (wr == 1) PG8_BAR;
    PG8_WAIT_V(4); PG8_BAR;
    PG8_STAGE(PG8_SB(1, 0), cB + kstep, voffB); PG8_STAGE(PG8_SA(1, 0), cA + kstep, voffA); PG8_STAGE(PG8_SB(1, 1), cB + hstep + kstep, voffB);
    PG8_WAIT_V(6); PG8_BAR;
    for (;;) {
        const bool has_next = S.next(ui + 1, nxt);
        const char* nA = has_next ? (const char*)g.A + (size_t)nxt.pm * tstep : cA; const char* nB = has_next ? (const char*)g.Bt + (size_t)nxt.pn * tstep : cB;
        for (int t = 0; t < nt; t += 2) {
            const bool last = (t == nt - 2);
            const char* a1 = cA + (size_t)(t + 1) * kstep;
            const char* a2 = last ? nA : cA + (size_t)(t + 2) * kstep; const char* b2 = last ? nB : cB + (size_t)(t + 2) * kstep;
            const char* a3 = a2 + kstep; const char* b3 = b2 + kstep;
            PG8_LDB(B0, 0, 0); PG8_SCHED; PG8_LDA(At, 0, 0); PG8_STAGE(PG8_SA(1, 1), a1 + hstep, voffA);
            PG8_WAIT_L(8); PG8_BAR; PG8_WAIT_L(0); PG8_MMA(0, 0, At, B0); PG8_BAR; PG8_SCHED;
            PG8_LDB(B1, 0, 1); PG8_STAGE(PG8_SB(0, 0), b2, voffB);
            PG8_BAR; PG8_WAIT_L(0); PG8_MMA(0, 1, At, B1); PG8_BAR;
            PG8_LDA(At, 0, 1); PG8_STAGE(PG8_SA(0, 0), a2, voffA);
            PG8_BAR; PG8_WAIT_L(0); PG8_MMA(1, 0, At, B0); PG8_BAR; PG8_SCHED;
            PG8_STAGE(PG8_SB(0, 1), b2 + hstep, voffB);
            PG8_WAIT_V(6); PG8_BAR; PG8_MMA(1, 1, At, B1); PG8_BAR;
            PG8_LDB(B0, 1, 0); PG8_SCHED; PG8_LDA(At, 1, 0); PG8_STAGE(PG8_SA(0, 1), a2 + hstep, voffA);
            PG8_WAIT_L(8); PG8_BAR; PG8_WAIT_L(0); PG8_MMA(0, 0, At, B0); PG8_BAR; PG8_SCHED;
            PG8_LDB(B1, 1, 1); PG8_STAGE(PG8_SB(1, 0), b3, voffB);
            PG8_BAR; PG8_WAIT_L(0); PG8_MMA(0, 1, At, B1); PG8_BAR;
            PG8_LDA(At, 1, 1); PG8_STAGE(PG8_SA(1, 0), a3, voffA);
            PG8_BAR; PG8_WAIT_L(0); PG8_MMA(1, 0, At, B0); PG8_BAR; PG8_SCHED;
            PG8_STAGE(PG8_SB(1, 1), b3 + hstep, voffB);
            PG8_WAIT_V(6); PG8_BAR; PG8_MMA(1, 1, At, B1); PG8_BAR;
        }
        if (E.mode != 8) E(acc, cur, ui, tab, lds, wr, wc, fr, fq);
        if (!has_next) break;
#pragma unroll
        for (int a = 0; a < 2; ++a)
#pragma unroll
            for (int b = 0; b < 2; ++b)
#pragma unroll
                for (int m = 0; m < 4; ++m)
#pragma unroll
                    for (int n = 0; n < 2; ++n) acc[a][b][m][n] = (f32x4){0.f, 0.f, 0.f, 0.f};
        cur = nxt; cA = nA; cB = nB; ++ui;
    }
    PG8_WAIT_V(0);
    if (wr == 0) PG8_BAR;
    PG8_BAR;
    if (E.mode == 8) E.fused(acc, cur, wr, wc, fr, fq);
#undef PG8_SA
#undef PG8_SB
#undef PG8_STAGE
#undef PG8_LDA
#undef PG8_LDB
#undef PG8_MMA
#undef PG8_WAIT_V
#undef PG8_WAIT_L
#undef PG8_BAR
#undef PG8_SCHED
}
}

struct Params {
    const float *x, *mem, *norm_mix_g, *w_in, *lb_logits, *hgrn_norm_g, *w_pool, *pool_scale, *w_out, *norm_x_g, *norm_mem_g, *w_xq, *w_xk, *w_xv, *w_xo, *norm_ffn_g, *w_ff1, *w_ff2, *final_norm_g;
    float* out; unsigned char* ws;
    int ph_lo, ph_hi;
};

struct TD { const float* W; const float* g; bf16_t* out; int N, ldo, kt, nt; };
__device__ __forceinline__ TD tile_desc(const Params& p, int t) {
    unsigned char* ws = p.ws; TD d;
    if (t < 320)       { d.W = p.w_in;  d.g = p.norm_mix_g; d.out = (bf16_t*)(ws + WS_WT_IN);  d.N = NIN;  d.ldo = 1024; d.kt = t / 40; d.nt = t % 40; }
    else if (t < 448)  { const int u = t - 320;  d.W = p.w_xk;  d.g = p.norm_mem_g; d.out = (bf16_t*)(ws + WS_WT_K);   d.N = 1024; d.ldo = 1024; d.kt = u / 16; d.nt = u % 16; }
    else if (t < 576)  { const int u = t - 448;  d.W = p.w_xv;  d.g = p.norm_mem_g; d.out = (bf16_t*)(ws + WS_WT_V);   d.N = 1024; d.ldo = 1024; d.kt = u / 16; d.nt = u % 16; }
    else if (t < 704)  { const int u = t - 576;  d.W = p.w_xq;  d.g = p.norm_x_g;   d.out = (bf16_t*)(ws + WS_WT_Q);   d.N = 1024; d.ldo = 1024; d.kt = u / 16; d.nt = u % 16; }
    else if (t < 832)  { const int u = t - 704;  d.W = p.w_xo;  d.g = nullptr;      d.out = (bf16_t*)(ws + WS_WT_O);   d.N = 1024; d.ldo = 1024; d.kt = u / 16; d.nt = u % 16; }
    else if (t < 960)  { const int u = t - 832;  d.W = p.w_out; d.g = nullptr;      d.out = (bf16_t*)(ws + WS_WT_OUT); d.N = 1024; d.ldo = 1024; d.kt = u / 16; d.nt = u % 16; }
    else if (t < 1472) { const int u = t - 960;  d.W = p.w_ff1; d.g = p.norm_ffn_g; d.out = (bf16_t*)(ws + WS_WT_FF1); d.N = DFF;  d.ldo = 1024; d.kt = u / 64; d.nt = u % 64; }
    else               { const int u = t - 1472; d.W = p.w_ff2; d.g = nullptr;      d.out = (bf16_t*)(ws + WS_WT_FF2); d.N = 1024; d.ldo = 4096; d.kt = u / 16; d.nt = u % 16; }
    return d;
}
__device__ __forceinline__ void tile_load(const TD& d, f32x4 (&v)[4], float (&sc)[4]) {
    const int tid = threadIdx.x, r = tid >> 4, c4 = tid & 15;
#pragma unroll
    for (int i = 0; i < 4; ++i) { const int k = 128 * d.kt + r + 32 * i; v[i] = __builtin_nontemporal_load((const f32x4*)(d.W + (size_t)k * d.N + 64 * d.nt + 4 * c4)); sc[i] = d.g ? d.g[k] : 1.0f; }
}
__device__ __forceinline__ void transpose_range(const Params& p, unsigned char* lds, int t_begin, int t_end, int first, int stride) {
    bf16_t* T0 = (bf16_t*)lds;
    bf16_t* T1 = (bf16_t*)(lds + 17408);
    const int tid = threadIdx.x, r = tid >> 4, c4 = tid & 15, n = tid >> 3, ks = tid & 7;
    int ta = t_begin + first;
    if (ta >= t_end) return;
    int tb = ta + stride; bool hb = tb < t_end;
    TD da = tile_desc(p, ta), db = da; f32x4 va[4], vb[4]; float sa[4], sb[4];
    tile_load(da, va, sa);
    if (hb) { db = tile_desc(p, tb); tile_load(db, vb, sb); }
    for (;;) {
#pragma unroll
        for (int i = 0; i < 4; ++i) { const int kl = r + 32 * i;
            T0[(4 * c4 + 0) * 136 + kl] = f2bf(va[i][0] * sa[i]); T0[(4 * c4 + 1) * 136 + kl] = f2bf(va[i][1] * sa[i]);
            T0[(4 * c4 + 2) * 136 + kl] = f2bf(va[i][2] * sa[i]); T0[(4 * c4 + 3) * 136 + kl] = f2bf(va[i][3] * sa[i]); }
        if (hb) {
#pragma unroll
            for (int i = 0; i < 4; ++i) { const int kl = r + 32 * i;
                T1[(4 * c4 + 0) * 136 + kl] = f2bf(vb[i][0] * sb[i]); T1[(4 * c4 + 1) * 136 + kl] = f2bf(vb[i][1] * sb[i]);
                T1[(4 * c4 + 2) * 136 + kl] = f2bf(vb[i][2] * sb[i]); T1[(4 * c4 + 3) * 136 + kl] = f2bf(vb[i][3] * sb[i]); } }
        __syncthreads();
        const int tna = ta + 2 * stride, tnb = tna + stride; const bool hna = tna < t_end, hnb = tnb < t_end;
        const TD ca = da, cb = db; const bool chb = hb;
        if (hna) { da = tile_desc(p, tna); tile_load(da, va, sa); }
        if (hnb) { db = tile_desc(p, tnb); tile_load(db, vb, sb); }
        { const u32x4* src = (const u32x4*)(T0 + n * 136 + 16 * ks); const u32x4 a = src[0], b = src[1];
          u32x4* dst = (u32x4*)(ca.out + (size_t)(64 * ca.nt + n) * ca.ldo + 128 * ca.kt + 16 * ks); dst[0] = a; dst[1] = b; }
        if (chb) { const u32x4* src = (const u32x4*)(T1 + n * 136 + 16 * ks); const u32x4 a = src[0], b = src[1];
          u32x4* dst = (u32x4*)(cb.out + (size_t)(64 * cb.nt + n) * cb.ldo + 128 * cb.kt + 16 * ks); dst[0] = a; dst[1] = b; }
        __syncthreads();
        if (!hna) break;
        ta = tna; hb = hnb;
    }
}
__device__ __forceinline__ void phase_prep(const Params p, unsigned char* lds) {
    unsigned char* ws = p.ws;
    const int G = gridDim.x;
    {
        const int lane = threadIdx.x & 63, gw = blockIdx.x * (NTHREADS / 64) + (threadIdx.x >> 6), nw = G * (NTHREADS / 64);
        int r = gw;
        f32x4 v[4], vn[4];
        if (r < MROWS + MEMROWS) { const float* src = r < MROWS ? p.x + (size_t)r * DM : p.mem + (size_t)(r - MROWS) * DM;
#pragma unroll
            for (int i = 0; i < 4; ++i) v[i] = __builtin_nontemporal_load((const f32x4*)src + lane + 64 * i); }
        for (; r < MROWS + MEMROWS; r += nw) {
            const int rn = r + nw;
            if (rn < MROWS + MEMROWS) { const float* src = rn < MROWS ? p.x + (size_t)rn * DM : p.mem + (size_t)(rn - MROWS) * DM;
#pragma unroll
                for (int i = 0; i < 4; ++i) vn[i] = __builtin_nontemporal_load((const f32x4*)src + lane + 64 * i); }
            const bool isx = r < MROWS;
            bf16_t* dst = isx ? (bf16_t*)(ws + WS_XB) + (size_t)r * DM : (bf16_t*)(ws + WS_MEMB) + (size_t)(r - MROWS) * DM;
            float ss = 0.f;
#pragma unroll
            for (int i = 0; i < 4; ++i) ss += (v[i][0] * v[i][0] + v[i][1] * v[i][1]) + (v[i][2] * v[i][2] + v[i][3] * v[i][3]);
#pragma unroll
            for (int o = 1; o < 64; o <<= 1) ss += __shfl_xor(ss, o);
#pragma unroll
            for (int i = 0; i < 4; ++i) { u32x2 w; w.x = cvt_pk_bf16(v[i][0], v[i][1]); w.y = cvt_pk_bf16(v[i][2], v[i][3]); ((u32x2*)dst)[lane + 64 * i] = w; }
            if (lane == 0) { const float rstd = rsqrtf(ss * (1.0f / 1024.0f) + EPS); if (isx) ((float*)(ws + WS_RSTD0))[r] = rstd; else ((float*)(ws + WS_RSTDM))[r - MROWS] = rstd; }
#pragma unroll
            for (int i = 0; i < 4; ++i) v[i] = vn[i];
        }
    }
    transpose_range(p, lds, 0, 576, blockIdx.x, G);
}
__device__ __forceinline__ void deferred_prep(const Params p, unsigned char* lds, int j, int nworkers) {
    transpose_range(p, lds, 576, 1984, j, nworkers);
}
__device__ __forceinline__ void fold_pool_weights_mfma(const Params& p) {
    bf16_t* wto = (bf16_t*)(p.ws + WS_WT_OUT);
    const int tid = threadIdx.x, w = tid >> 6, lane = tid & 63, fr = lane & 15, q = lane >> 4;
    for (int item = blockIdx.x; item < 256; item += gridDim.x) {
        const int gi = item >> 6, nb = item & 63;
        f32x4 acc = (f32x4){0.f, 0.f, 0.f, 0.f};
        const float* wp = p.w_pool + (size_t)(gi * 128 + 16 * w + fr) * 128;
        const float* ps = p.pool_scale + gi * 128;
        const bf16_t* arow = wto + (size_t)(16 * nb + fr) * 1024 + 512 + gi * 128;
#pragma unroll
        for (int ks = 0; ks < 4; ++ks) {
            const int d0 = 32 * ks + 8 * q;
            const f32x4 w0 = *(const f32x4*)(wp + d0), w1 = *(const f32x4*)(wp + d0 + 4), s0 = *(const f32x4*)(ps + d0), s1 = *(const f32x4*)(ps + d0 + 4);
            const bf16x8 cfr = mk8u(cvt_pk_bf16(w0[0] * s0[0], w0[1] * s0[1]), cvt_pk_bf16(w0[2] * s0[2], w0[3] * s0[3]), cvt_pk_bf16(w1[0] * s1[0], w1[1] * s1[1]), cvt_pk_bf16(w1[2] * s1[2], w1[3] * s1[3]));
            const bf16x8 nfr = *(const bf16x8*)(arow + d0);
            acc = mfma16(cfr, nfr, acc);
        }
        asm volatile("s_waitcnt vmcnt(0)" ::: "memory");
        __syncthreads();
        u32x2 o; o.x = cvt_pk_bf16(acc[0], acc[1]); o.y = cvt_pk_bf16(acc[2], acc[3]);
        *(u32x2*)(wto + (size_t)(16 * nb + fr) * 1024 + 512 + gi * 128 + 16 * w + 4 * q) = o;
        __syncthreads();
    }
}

__device__ __forceinline__ void phase_passA(const bf16_t* __restrict__ KH, const float* __restrict__ LF, const bf16_t* __restrict__ VH, bf16_t* __restrict__ LT, float* __restrict__ DEC, unsigned char* lds) {
    const int tid = threadIdx.x, ch = tid & 127, seg = tid >> 7, G = gridDim.x;
    float* segtot = (float*)lds;
    unsigned char* KdT = lds + 2048;
    unsigned char* VTl = lds + 2048 + 18432;
    const int w = tid >> 6, lane = tid & 63, fr = lane & 15, q = lane >> 4;
    float lf[16], kk[16]; unsigned vr[16];
    int unit = blockIdx.x;
    if (unit < 1024) { const int b = unit >> 8, c = (unit >> 2) & 63, h = unit & 3; const size_t g0 = (size_t)(b * SEQ + c * 64 + seg * 16) * 512 + h * 128 + ch;
#pragma unroll
        for (int i = 0; i < 16; ++i) { lf[i] = LF[g0 + (size_t)i * 512]; vr[i] = VH[g0 + (size_t)i * 512]; } }
    for (; unit < 1024; unit += G) {
        const int b = unit >> 8, c = (unit >> 2) & 63, h = unit & 3, bh = b * 4 + h;
#pragma unroll
        for (int i = 0; i < 16; ++i) kk[i] = 1.0f - __expf(lf[i]);
#pragma unroll
        for (int i = 1; i < 16; ++i) lf[i] += lf[i - 1];
        segtot[seg * 128 + ch] = lf[15];
        __syncthreads();
        float after = 0.f;
#pragma unroll
        for (int s2 = 1; s2 < 4; ++s2) if (s2 > seg) after += segtot[s2 * 128 + ch];
        const float tot = after + lf[15];
        if (seg == 0) DEC[(size_t)(bh * 64 + c) * 128 + ch] = __expf(tot);
        unsigned kd[8], vp[8];
#pragma unroll
        for (int i = 0; i < 8; ++i) {
            kd[i] = cvt_pk_bf16(kk[2 * i] * __expf(tot - lf[2 * i]), kk[2 * i + 1] * __expf(tot - lf[2 * i + 1]));
            vp[i] = vr[2 * i] | (vr[2 * i + 1] << 16);
        }
        { u32x4* d = (u32x4*)(KdT + ch * 144 + seg * 32); d[0] = (u32x4){kd[0], kd[1], kd[2], kd[3]}; d[1] = (u32x4){kd[4], kd[5], kd[6], kd[7]}; }
        { u32x4* d = (u32x4*)(VTl + ch * 144 + seg * 32); d[0] = (u32x4){vp[0], vp[1], vp[2], vp[3]}; d[1] = (u32x4){vp[4], vp[5], vp[6], vp[7]}; }
        __syncthreads();
        {
            const int un = unit + G;
            if (un < 1024) { const int b2 = un >> 8, c2 = (un >> 2) & 63, h2 = un & 3; const size_t g0 = (size_t)(b2 * SEQ + c2 * 64 + seg * 16) * 512 + h2 * 128 + ch;
#pragma unroll
                for (int i = 0; i < 16; ++i) { lf[i] = LF[g0 + (size_t)i * 512]; vr[i] = VH[g0 + (size_t)i * 512]; } }
        }
        bf16x8 a[2];
#pragma unroll
        for (int ks = 0; ks < 2; ++ks) a[ks] = *(const bf16x8*)(KdT + (16 * w + fr) * 144 + (32 * ks + 8 * q) * 2);
        bf16_t* ltp = LT + (size_t)(bh * 64 + c) * 16384;
#pragma unroll
        for (int vb = 0; vb < 8; ++vb) {
            f32x4 acc = (f32x4){0.f, 0.f, 0.f, 0.f};
#pragma unroll
            for (int ks = 0; ks < 2; ++ks) { const bf16x8 bfr = *(const bf16x8*)(VTl + (16 * vb + fr) * 144 + (32 * ks + 8 * q) * 2); acc = mfma16(a[ks], bfr, acc); }
            u32x2 pk; pk.x = cvt_pk_bf16(acc[0], acc[1]); pk.y = cvt_pk_bf16(acc[2], acc[3]);
            *(u32x2*)(ltp + (size_t)(16 * vb + fr) * 128 + 16 * w + 4 * q) = pk;
        }
        __syncthreads();
    }
}

template <int W>
__device__ __forceinline__ void pool_body(const bf16_t* __restrict__ PH, bf16_t* __restrict__ MIXED, int r0, int s0, int c0) {
    unsigned v[31 + W];
#pragma unroll
    for (int j = 1; j < W; ++j) v[W - 1 - j] = (s0 - j >= 0) ? *(const unsigned*)(PH + (size_t)(r0 - j) * 512 + c0) : 0u;
#pragma unroll
    for (int tt = 0; tt < 32; ++tt) v[W - 1 + tt] = *(const unsigned*)(PH + (size_t)(r0 + tt) * 512 + c0);
    float sx = 0.f, sy = 0.f;
#pragma unroll
    for (int j = 1; j < W; ++j) { sx += bflo(v[W - 1 - j]); sy += bfhi(v[W - 1 - j]); }
#pragma unroll
    for (int tt = 0; tt < 32; ++tt) {
        const int s = s0 + tt;
        const float px = bflo(v[W - 1 + tt]), py = bfhi(v[W - 1 + tt]);
        sx += px; sy += py;
        const int cnt = (s + 1) < W ? (s + 1) : W;
        const float inv = 1.0f / (float)cnt;
        *(unsigned*)(MIXED + (size_t)(r0 + tt) * 1024 + 512 + c0) = cvt_pk_bf16(sx * inv - px, sy * inv - py);
        sx -= bflo(v[tt]); sy -= bfhi(v[tt]);
    }
}
__device__ __forceinline__ void pool_tile(const bf16_t* __restrict__ PH, bf16_t* __restrict__ MIXED, int tile) {
    const int tid = threadIdx.x, cp = tid & 255, th = tid >> 8, c0 = 2 * cp, gi = c0 >> 7;
    const int r0 = tile * 64 + th * 32, s0 = r0 & (SEQ - 1);
    if (gi == 0) pool_body<2>(PH, MIXED, r0, s0, c0);
    else if (gi == 1) pool_body<4>(PH, MIXED, r0, s0, c0);
    else if (gi == 2) pool_body<8>(PH, MIXED, r0, s0, c0);
    else pool_body<16>(PH, MIXED, r0, s0, c0);
}

__device__ __forceinline__ void phase_scan(const bf16_t* LT, const float* __restrict__ DEC, bf16_t* ST) {
    for (int e2 = blockIdx.x * NTHREADS + threadIdx.x; e2 < 131072; e2 += gridDim.x * NTHREADS) {
        const int bh = e2 >> 13, v = (e2 >> 6) & 127, kp = e2 & 63;
        float sx = 0.f, sy = 0.f;
        const size_t base = (size_t)bh * 64 * 16384 + (size_t)v * 128 + 2 * kp;
        const float* dp = DEC + (size_t)bh * 64 * 128 + 2 * kp;
        for (int c0 = 0; c0 < 64; c0 += 32) {
            unsigned l[32]; f32x2 d[32];
#pragma unroll
            for (int j = 0; j < 32; ++j) { l[j] = *(const unsigned*)(LT + base + (size_t)(c0 + j) * 16384); d[j] = *(const f32x2*)(dp + (c0 + j) * 128); }
#pragma unroll
            for (int j = 0; j < 32; ++j) {
                *(unsigned*)(ST + base + (size_t)(c0 + j) * 16384) = cvt_pk_bf16(sx, sy);
                sx = d[j][0] * sx + bflo(l[j]); sy = d[j][1] * sy + bfhi(l[j]);
            }
        }
    }
}

__device__ __forceinline__ void phase_passC(const bf16_t* __restrict__ QH, const bf16_t* __restrict__ KH, const float* __restrict__ LF, const bf16_t* __restrict__ VH, const bf16_t* __restrict__ GH,
                                const bf16_t* __restrict__ ST, const float* __restrict__ hg, bf16_t* __restrict__ MIXED, unsigned char* lds) {
    const int tid = threadIdx.x, ch = tid & 127, seg = tid >> 7, G = gridDim.x;
    float lf[16], kk[16]; unsigned qr[16], vr[16];
    int unit = blockIdx.x;
    if (unit < 1024) { const int b = unit >> 8, c = (unit >> 2) & 63, h = unit & 3; const size_t g0 = (size_t)(b * SEQ + c * 64 + seg * 16) * 512 + h * 128 + ch;
#pragma unroll
        for (int i = 0; i < 16; ++i) { lf[i] = LF[g0 + (size_t)i * 512]; vr[i] = VH[g0 + (size_t)i * 512]; qr[i] = QH[g0 + (size_t)i * 512]; } }
  for (; unit < 1024; unit += G) {
    const int b = unit >> 8, c = (unit >> 2) & 63, h = unit & 3;
    const int row0 = b * SEQ + c * 64, bh = b * 4 + h;
    float* segtot = (float*)lds;
    float* rmsp = (float*)(lds + 2048);
    bf16_t* QC = (bf16_t*)(lds + 4096);
    bf16_t* QT = (bf16_t*)(lds + 21504);
    constexpr int KT0 = 38912;
    unsigned char* VTl = lds + 82432;
    const int w = tid >> 6, lane = tid & 63, fr = lane & 15, q = lane >> 4;
    const int i = w & 3, vh = w >> 2;
    const size_t row = (size_t)(row0 + 16 * i + fr);
    u32x2 gt[4]; f32x4 gg[4]; bf16x8 stf[4][4];
    {
        const bf16_t* stp = ST + (size_t)(bh * 64 + c) * 16384;
#pragma unroll
        for (int vbl = 0; vbl < 4; ++vbl) { const int v0 = 16 * (vh * 4 + vbl) + 4 * q; gt[vbl] = *(const u32x2*)(GH + row * 512 + h * 128 + v0); gg[vbl] = *(const f32x4*)(hg + h * 128 + v0);
#pragma unroll
            for (int ks = 0; ks < 4; ++ks) stf[ks][vbl] = *(const bf16x8*)(stp + (size_t)(16 * (vh * 4 + vbl) + fr) * 128 + 32 * ks + 8 * q); }
    }
#pragma unroll
    for (int i2 = 0; i2 < 16; ++i2) kk[i2] = 1.0f - __expf(lf[i2]);
#pragma unroll
    for (int i2 = 1; i2 < 16; ++i2) lf[i2] += lf[i2 - 1];
    segtot[seg * 128 + ch] = lf[15];
    {
        unsigned vp[8];
#pragma unroll
        for (int i2 = 0; i2 < 8; ++i2) vp[i2] = vr[2 * i2] | (vr[2 * i2 + 1] << 16);
        u32x4* d = (u32x4*)(VTl + ch * 144 + seg * 32); d[0] = (u32x4){vp[0], vp[1], vp[2], vp[3]}; d[1] = (u32x4){vp[4], vp[5], vp[6], vp[7]};
    }
    __syncthreads();
    const float t0 = segtot[ch], t1 = segtot[128 + ch], t2 = segtot[256 + ch];
    const float P = (seg > 0 ? t0 : 0.f) + (seg > 1 ? t1 : 0.f) + (seg > 2 ? t2 : 0.f);
    {
        const float eP = __expf(P);
#pragma unroll
        for (int i2 = 0; i2 < 16; ++i2) {
            const float qv = bflo(qr[i2]);
            const float el = __expf(lf[i2]);
            QT[(seg * 16 + i2) * 136 + ch] = f2bf(qv * el);
            QC[(seg * 16 + i2) * 136 + ch] = f2bf(qv * el * eP);
        }
        float E = 0.f;
#pragma unroll
        for (int i2 = 0; i2 < 4; ++i2) {
            if (i2 >= seg) {
                bf16_t* KT = (bf16_t*)(lds + KT0 + 4352 * ((i2 * (i2 + 1)) / 2));
#pragma unroll
                for (int j = 0; j < 16; ++j) KT[(seg * 16 + j) * 136 + ch] = f2bf(kk[j] * __expf(E - lf[j]));
                E += (i2 == 0 ? t0 : (i2 == 1 ? t1 : t2));
            }
        }
    }
    __syncthreads();
    {
        const int un = unit + G;
        if (un < 1024) { const int b2 = un >> 8, c2 = (un >> 2) & 63, h2 = un & 3; const size_t g2 = (size_t)(b2 * SEQ + c2 * 64 + seg * 16) * 512 + h2 * 128 + ch;
#pragma unroll
            for (int i2 = 0; i2 < 16; ++i2) { lf[i2] = LF[g2 + (size_t)i2 * 512]; vr[i2] = VH[g2 + (size_t)i2 * 512]; qr[i2] = QH[g2 + (size_t)i2 * 512]; } }
    }
    f32x4 sT[4];
#pragma unroll
    for (int j = 0; j < 4; ++j) sT[j] = (f32x4){0.f, 0.f, 0.f, 0.f};
    {
        bf16x8 qfr[4];
#pragma unroll
        for (int ks = 0; ks < 4; ++ks) qfr[ks] = *(const bf16x8*)((const unsigned char*)QT + (16 * i + fr) * 272 + (32 * ks + 8 * q) * 2);
        const unsigned char* KT = lds + KT0 + 4352 * ((i * (i + 1)) / 2);
#pragma unroll
        for (int j = 0; j < 4; ++j) if (j <= i) {
#pragma unroll
            for (int ks = 0; ks < 4; ++ks) { const bf16x8 a = *(const bf16x8*)(KT + (16 * j + fr) * 272 + (32 * ks + 8 * q) * 2); sT[j] = mfma16(a, qfr[ks], sT[j]); }
            if (j == i) {
#pragma unroll
                for (int rg = 0; rg < 4; ++rg) if (4 * q + rg > fr) sT[j][rg] = 0.f;
            }
        }
    }
    f32x4 oacc[4];
#pragma unroll
    for (int vbl = 0; vbl < 4; ++vbl) oacc[vbl] = (f32x4){0.f, 0.f, 0.f, 0.f};
#pragma unroll
    for (int m = 0; m < 2; ++m) if (2 * m <= i) {
        const bf16x8 bfrag = mk8u(cvt_pk_bf16(sT[2 * m][0], sT[2 * m][1]), cvt_pk_bf16(sT[2 * m][2], sT[2 * m][3]), cvt_pk_bf16(sT[2 * m + 1][0], sT[2 * m + 1][1]), cvt_pk_bf16(sT[2 * m + 1][2], sT[2 * m + 1][3]));
#pragma unroll
        for (int vbl = 0; vbl < 4; ++vbl) {
            const unsigned char* base = VTl + (16 * (vh * 4 + vbl) + fr) * 144 + (32 * m + 4 * q) * 2;
            const bf16x8 a = mk8(*(const u32x2*)base, *(const u32x2*)(base + 32));
            oacc[vbl] = mfma16(a, bfrag, oacc[vbl]);
        }
    }
    {
#pragma unroll
        for (int ks = 0; ks < 4; ++ks) {
            const bf16x8 bfr = *(const bf16x8*)((const unsigned char*)QC + (16 * i + fr) * 272 + (32 * ks + 8 * q) * 2);
#pragma unroll
            for (int vbl = 0; vbl < 4; ++vbl) oacc[vbl] = mfma16(stf[ks][vbl], bfr, oacc[vbl]);
        }
    }
    float ss = 0.f;
#pragma unroll
    for (int vbl = 0; vbl < 4; ++vbl) ss += (oacc[vbl][0] * oacc[vbl][0] + oacc[vbl][1] * oacc[vbl][1]) + (oacc[vbl][2] * oacc[vbl][2] + oacc[vbl][3] * oacc[vbl][3]);
    ss += __shfl_xor(ss, 16); ss += __shfl_xor(ss, 32);
    if (q == 0) rmsp[vh * 64 + 16 * i + fr] = ss;
    __syncthreads();
    const float rstd = rsqrtf((rmsp[16 * i + fr] + rmsp[64 + 16 * i + fr]) * (1.0f / 128.0f) + EPS);
#pragma unroll
    for (int vbl = 0; vbl < 4; ++vbl) {
        const int v0 = 16 * (vh * 4 + vbl) + 4 * q;
        u32x2 o;
        o.x = cvt_pk_bf16(oacc[vbl][0] * rstd * gg[vbl][0] * bflo(gt[vbl].x), oacc[vbl][1] * rstd * gg[vbl][1] * bfhi(gt[vbl].x));
        o.y = cvt_pk_bf16(oacc[vbl][2] * rstd * gg[vbl][2] * bflo(gt[vbl].y), oacc[vbl][3] * rstd * gg[vbl][3] * bfhi(gt[vbl].y));
        *(u32x2*)(MIXED + row * 1024 + h * 128 + v0) = o;
    }
    __syncthreads();
  }
}

__device__ __forceinline__ void attn_unit(const bf16_t* __restrict__ XQ, const bf16_t* __restrict__ KX, const bf16_t* __restrict__ VT, bf16_t* __restrict__ ATT, int unit, unsigned char* lds) {
    const int tid = threadIdx.x, w = tid >> 6, lane = tid & 63, r = lane & 31, hh = lane >> 5;
    const int b = unit >> 6, st = (unit >> 2) & 15, h = unit & 3;
    const int row0 = b * SEQ + st * 256;
    const bf16_t* qp = XQ + (size_t)(row0 + 32 * w + r) * 1024 + h * 256 + 8 * hh;
    {
        const bf16_t* kp = KX + (size_t)(b * 256) * 1024 + h * 256;
#pragma unroll
        for (int it = 0; it < 16; ++it) { const int idx = tid + 512 * it, m = idx >> 5, cc = idx & 31;
            const u32x4 v = *(const u32x4*)(kp + (size_t)m * 1024 + cc * 8); *(u32x4*)(lds + m * 528 + cc * 16) = v; }
    }
    __syncthreads();
    f32x16 sacc[8];
#pragma unroll
    for (int mb = 0; mb < 8; ++mb)
#pragma unroll
        for (int e = 0; e < 16; ++e) sacc[mb][e] = 0.f;
    {
        bf16x8 qf[4], qn[4];
#pragma unroll
        for (int k4 = 0; k4 < 4; ++k4) qf[k4] = *(const bf16x8*)(qp + 16 * k4);
#pragma unroll
        for (int kg = 0; kg < 4; ++kg) {
            if (kg < 3) {
#pragma unroll
                for (int k4 = 0; k4 < 4; ++k4) qn[k4] = *(const bf16x8*)(qp + 16 * (4 * (kg + 1) + k4)); }
#pragma unroll
            for (int k4 = 0; k4 < 4; ++k4)
#pragma unroll
                for (int mb = 0; mb < 8; ++mb) { const bf16x8 a = *(const bf16x8*)(lds + (32 * mb + r) * 528 + (16 * (4 * kg + k4) + 8 * hh) * 2); sacc[mb] = mfma32(a, qf[k4], sacc[mb]); }
#pragma unroll
            for (int k4 = 0; k4 < 4; ++k4) qf[k4] = qn[k4];
        }
    }
    float mx = -3.0e38f;
#pragma unroll
    for (int mb = 0; mb < 8; ++mb)
#pragma unroll
        for (int e = 0; e < 16; ++e) mx = fmaxf(mx, sacc[mb][e]);
    mx = fmaxf(mx, __shfl_xor(mx, 32));
    float sum = 0.f;
    bf16x8 pf[8][2];
#pragma unroll
    for (int mb = 0; mb < 8; ++mb) {
        float pv[16];
#pragma unroll
        for (int e = 0; e < 16; ++e) { pv[e] = __expf(sacc[mb][e] - mx); sum += pv[e]; }
#pragma unroll
        for (int s = 0; s < 2; ++s) pf[mb][s] = mk8u(cvt_pk_bf16(pv[8 * s + 0], pv[8 * s + 1]), cvt_pk_bf16(pv[8 * s + 2], pv[8 * s + 3]), cvt_pk_bf16(pv[8 * s + 4], pv[8 * s + 5]), cvt_pk_bf16(pv[8 * s + 6], pv[8 * s + 7]));
    }
    sum += __shfl_xor(sum, 32);
    const float inv = 1.0f / sum;
    __syncthreads();
    {
        const bf16_t* vp = VT + (size_t)(h * 256) * 1024 + b * 256;
#pragma unroll
        for (int it = 0; it < 16; ++it) { const int idx = tid + 512 * it, e = idx >> 5, cc = idx & 31;
            const u32x4 v = *(const u32x4*)(vp + (size_t)e * 1024 + cc * 8);
            u32x2* d = (u32x2*)(lds + e * 520 + cc * 16); d[0] = (u32x2){v.x, v.y}; d[1] = (u32x2){v.z, v.w}; }
    }
    __syncthreads();
    bf16_t* op = ATT + (size_t)(row0 + 32 * w + r) * 1024 + h * 256 + 4 * hh;
#pragma unroll
    for (int half = 0; half < 2; ++half) {
        f32x16 oacc[4];
#pragma unroll
        for (int d = 0; d < 4; ++d)
#pragma unroll
            for (int e = 0; e < 16; ++e) oacc[d][e] = 0.f;
#pragma unroll
        for (int mb = 0; mb < 8; ++mb)
#pragma unroll
            for (int s = 0; s < 2; ++s)
#pragma unroll
                for (int d = 0; d < 4; ++d) {
                    const unsigned char* base = lds + (32 * (half * 4 + d) + r) * 520 + (32 * mb + 16 * s + 4 * hh) * 2;
                    const bf16x8 a = mk8(*(const u32x2*)base, *(const u32x2*)(base + 16));
                    oacc[d] = mfma32(a, pf[mb][s], oacc[d]);
                }
#pragma unroll
        for (int d = 0; d < 4; ++d)
#pragma unroll
            for (int g = 0; g < 4; ++g) {
                u32x2 o; o.x = cvt_pk_bf16(oacc[d][4 * g] * inv, oacc[d][4 * g + 1] * inv); o.y = cvt_pk_bf16(oacc[d][4 * g + 2] * inv, oacc[d][4 * g + 3] * inv);
                *(u32x2*)(op + 32 * (half * 4 + d) + 8 * g) = o;
            }
    }
    __syncthreads();
}

__device__ __forceinline__ void phase_final(const bf16_t* __restrict__ xb, const float* __restrict__ ssq, float* __restrict__ out, const float* __restrict__ g) {
    const int tid = threadIdx.x, sub = tid >> 7, l = tid & 127;
    const f32x4 g0 = *(const f32x4*)(g + 8 * l), g1 = *(const f32x4*)(g + 8 * l + 4);
    for (int r = blockIdx.x * 4 + sub; r < MROWS; r += gridDim.x * 4) {
        const u32x4 v = *(const u32x4*)(xb + (size_t)r * DM + 8 * l);
        const f32x4* pp = (const f32x4*)(ssq + (size_t)r * 16); const f32x4 a = pp[0], b = pp[1], c = pp[2], d = pp[3];
        const float t = ((a[0] + a[1]) + (a[2] + a[3])) + ((b[0] + b[1]) + (b[2] + b[3])) + ((c[0] + c[1]) + (c[2] + c[3])) + ((d[0] + d[1]) + (d[2] + d[3]));
        const float rstd = rsqrtf(t * (1.0f / 1024.0f) + EPS);
        const f32x4 o0 = (f32x4){bflo(v.x), bfhi(v.x), bflo(v.y), bfhi(v.y)} * rstd * g0, o1 = (f32x4){bflo(v.z), bfhi(v.z), bflo(v.w), bfhi(v.w)} * rstd * g1;
        *(f32x4*)(out + (size_t)r * DM + 8 * l) = o0; *(f32x4*)(out + (size_t)r * DM + 8 * l + 4) = o1;
    }
}

#define XB_TMO      128
#define XB_XCNT(j)  (256  + 64 * (j))
#define XB_XSUB(j)  (1280 + 64 * (j))
#define XB_XGEN(j)  (2304 + 64 * (j))
#define XB_TOP      3328
#define XB_TOPGEN   3392
#define XCD_BAR_WORDS 3456
#define XB_SPIN_CAP (1u << 22)
__device__ __forceinline__ unsigned xb_ld(unsigned* p)              { return __hip_atomic_load(p, __ATOMIC_RELAXED, __HIP_MEMORY_SCOPE_AGENT); }
__device__ __forceinline__ unsigned xb_add(unsigned* p, unsigned v) { return __hip_atomic_fetch_add(p, v, __ATOMIC_RELAXED, __HIP_MEMORY_SCOPE_AGENT); }
__device__ __forceinline__ unsigned xb_xcc_id() { return (unsigned)__builtin_amdgcn_s_getreg((3 << 11) | 20) & 0xFu; }
#define XB_SPIN(cond, bar) do { unsigned _sp = 0; while (cond) { __builtin_amdgcn_s_sleep(1); \
    if ((++_sp & 255u) == 0u) { if (xb_ld(&(bar)[XB_TMO])) break; if (_sp > XB_SPIN_CAP) { atomicAdd(&(bar)[XB_TMO], 1u); break; } } } } while (0)
struct XcdBarrier { unsigned* bar; unsigned x; volatile LAS unsigned* st; };
__device__ __forceinline__ XcdBarrier xcd_barrier_post(unsigned* bar, volatile LAS unsigned* st) {
    XcdBarrier b; b.bar = bar; b.x = xb_xcc_id(); b.st = st;
    if (threadIdx.x == 0) (void)xb_add(&bar[XB_XCNT(b.x)], 1u);
    return b;
}
__device__ __forceinline__ void xcd_barrier_complete(unsigned* bar, unsigned x, unsigned& nloc, unsigned& nx) {
    const unsigned G = gridDim.x * gridDim.y * gridDim.z;
    unsigned sum, cnt, mine, sp = 0u;
    for (;;) {
        sum = 0u; cnt = 0u; mine = 0u;
#pragma unroll
        for (unsigned j = 0; j < 16; ++j) { const unsigned c = xb_ld(&bar[XB_XCNT(j)]); sum += c; cnt += (c > 0u) ? 1u : 0u; mine = (j == x) ? c : mine; }
        if (sum == G) break;
        __builtin_amdgcn_s_sleep(1);
        if ((++sp & 255u) == 0u) { if (xb_ld(&bar[XB_TMO])) break; if (sp > XB_SPIN_CAP) { atomicAdd(&bar[XB_TMO], 1u); break; } }
    }
    nloc = mine > 0u ? mine : 1u; nx = cnt > 0u ? cnt : 1u;
}
__device__ __forceinline__ void xcd_barrier(const XcdBarrier& b) {
    asm volatile("s_waitcnt vmcnt(0)" ::: "memory");
    __syncthreads();
    if (threadIdx.x == 0) {
        unsigned* bar = b.bar;
        __builtin_amdgcn_s_waitcnt(0);
        unsigned nloc = b.st[0], nx = b.st[1];
        if (nloc == 0u) { xcd_barrier_complete(bar, b.x, nloc, nx); b.st[0] = nloc; b.st[1] = nx; }
        const unsigned old = xb_add(&bar[XB_XSUB(b.x)], 1u);
        const unsigned gen = old / nloc;
        if (old + 1u == (gen + 1u) * nloc) {
            __builtin_amdgcn_fence(__ATOMIC_RELEASE, "agent");
            asm volatile("s_waitcnt vmcnt(0)" ::: "memory");
            const unsigned og = xb_add(&bar[XB_TOP], 1u);
            const unsigned tg = og / nx;
            if (og + 1u == (tg + 1u) * nx) xb_add(&bar[XB_TOPGEN], 1u);
            else XB_SPIN(xb_ld(&bar[XB_TOPGEN]) == tg, bar);
            __builtin_amdgcn_fence(__ATOMIC_ACQUIRE, "agent");
            asm volatile("s_waitcnt vmcnt(0)" ::: "memory");
        } else {
            XB_SPIN(xb_ld(&bar[XB_TOPGEN]) == gen, bar);
            __builtin_amdgcn_fence(__ATOMIC_ACQUIRE, "agent");
            asm volatile("s_waitcnt vmcnt(0)" ::: "memory");
        }
    }
    __syncthreads();
}

constexpr int N_PHASES = 12;
__global__ void __launch_bounds__(NTHREADS, 2) mega(Params p) {
    extern __shared__ __attribute__((aligned(16))) unsigned char lds[];
    LAS unsigned char* ldsl = (LAS unsigned char*)lds;
    unsigned char* ws = p.ws;
    const int G = gridDim.x, bid = blockIdx.x;
    const int lo = p.ph_lo, hi = p.ph_hi;

#ifndef DEFER_PREP
#define DEFER_PREP 0
#endif
#ifndef FUSE_FINAL
#define FUSE_FINAL 0
#endif
#ifndef DBG_LAST
#define DBG_LAST -1
#endif
#ifndef PHASE_MASK
#define PHASE_MASK 0xfff
#endif
#define IN(k) (((PHASE_MASK >> (k)) & 1) && lo <= (k) && (k) < hi)
    if (threadIdx.x == 0) { ((volatile LAS unsigned*)(ldsl + LDS_MAIN))[0] = 0u; ((volatile LAS unsigned*)(ldsl + LDS_MAIN))[1] = 0u; }
    __syncthreads();
    XcdBarrier xbar; xbar.bar = (unsigned*)(ws + WS_BAR); xbar.x = 0; xbar.st = nullptr;
    if (hi - lo > 1) xbar = xcd_barrier_post((unsigned*)(ws + WS_BAR), (volatile LAS unsigned*)(ldsl + LDS_MAIN));
    if (lo > hi) cg::this_grid().sync();
#define SEAM(k) do { if (IN(k) && IN((k) + 1)) { xcd_barrier(xbar); } } while (0)
    bf16_t* XB = (bf16_t*)(ws + WS_XB); bf16_t* LT = (bf16_t*)(ws + WS_ST);
    bf16_t* QH = (bf16_t*)(ws + WS_QH); bf16_t* KH = (bf16_t*)(ws + WS_KH); bf16_t* VH = (bf16_t*)(ws + WS_VH); bf16_t* GH = (bf16_t*)(ws + WS_GH); bf16_t* PH = (bf16_t*)(ws + WS_PH);
    float* LF = (float*)(ws + WS_LF); bf16_t* ST = (bf16_t*)(ws + WS_ST); bf16_t* MIXED = (bf16_t*)(ws + WS_MIXED);
    float* X1 = (float*)(ws + WS_X1); bf16_t* XQ = (bf16_t*)(ws + WS_XQ); bf16_t* ATT = (bf16_t*)(ws + WS_ATT); bf16_t* U = (bf16_t*)(ws + WS_U);
    float* SSQ = (float*)(ws + WS_SSQ); float* DEC = (float*)(ws + WS_DEC);
    bf16_t* MEMB = (bf16_t*)(ws + WS_MEMB); bf16_t* KX = (bf16_t*)(ws + WS_KX); bf16_t* VT = (bf16_t*)(ws + WS_VT);

    const bool fuse_final = FUSE_FINAL && (G == 256) && IN(10) && (hi - lo > 1);
    if (IN(0)) { phase_prep(p, lds);
#if !DEFER_PREP
        deferred_prep(p, lds, bid, G);
#endif
    }
    SEAM(0);
    if (IN(1)) {
        const pg8::Epi E{0, ws, p.x, p.out, p.lb_logits, p.final_norm_g};
        { pg8::Gemm g{XB, (const bf16_t*)(ws + WS_WT_IN), MROWS, NIN, DM}; pg8::StaticOrder S; S.init(MROWS, NIN, G, bid); pg8::gemm_phase(ldsl, g, S, E); }
        const pg8::Epi E1{1, ws, p.x, p.out, p.lb_logits, p.final_norm_g};
        { pg8::Gemm g{MEMB, (const bf16_t*)(ws + WS_WT_K), MEMROWS, 1024, DM}; pg8::StaticOrder S; S.init(MEMROWS, 1024, G, (bid + 128) % G); pg8::gemm_phase(ldsl, g, S, E1); }
        const pg8::Epi E2{2, ws, p.x, p.out, p.lb_logits, p.final_norm_g};
        { pg8::Gemm g{(const bf16_t*)(ws + WS_WT_V), MEMB, 1024, MEMROWS, DM}; pg8::StaticOrder S; S.init(1024, MEMROWS, G, (bid + 112) % G); pg8::gemm_phase(ldsl, g, S, E2); }
#if DEFER_PREP
        if (G == 256) { if (bid >= 160) deferred_prep(p, lds, bid - 160, 96); }
        else deferred_prep(p, lds, bid, G);
#endif
    }
    SEAM(1);
    if (IN(2)) {
#ifndef DBG_NO_PASSA
        phase_passA(KH, LF, VH, LT, DEC, lds);
#endif
#ifndef DBG_NO_POOL
        for (int t = bid; t < 256; t += G) pool_tile(PH, MIXED, t);
#endif
        fold_pool_weights_mfma(p);
    }
    SEAM(2);
    if (IN(3)) { phase_scan(LT, DEC, ST); }
    SEAM(3);
    if (IN(4)) { phase_passC(QH, KH, LF, VH, GH, ST, p.hgrn_norm_g, MIXED, lds); }
    SEAM(4);
    if (IN(5)) {
        const pg8::Epi E{6, ws, p.x, p.out, p.lb_logits, p.final_norm_g};
        pg8::Gemm g{MIXED, (const bf16_t*)(ws + WS_WT_OUT), MROWS, DM, DM}; pg8::StaticOrder S; S.init(MROWS, DM, G, bid); pg8::gemm_phase(ldsl, g, S, E);
    }
    SEAM(5);
    const bool fuse_attn = (G == 256) && IN(6) && IN(7);
    if (IN(6)) {
        const pg8::Epi E{4, ws, p.x, p.out, p.lb_logits, p.final_norm_g};
        pg8::Gemm g{XB, (const bf16_t*)(ws + WS_WT_Q), MROWS, DM, DM}; pg8::StaticOrder S; S.init(MROWS, DM, G, bid); pg8::gemm_phase(ldsl, g, S, E);
        if (fuse_attn) {
            pg8::Unit u; S.next(0, u);
            asm volatile("s_waitcnt vmcnt(0)" ::: "memory"); __syncthreads();
            attn_unit(XQ, KX, VT, ATT, u.pm * 4 + u.pn, lds);
        }
    }
    if (!fuse_attn) {
        SEAM(6);
        if (IN(7)) { for (int u = bid; u < 256; u += G) attn_unit(XQ, KX, VT, ATT, u, lds); }
    }
    SEAM(7);
    if (IN(8)) {
        const pg8::Epi E{6, ws, p.x, p.out, p.lb_logits, p.final_norm_g};
        pg8::Gemm g{ATT, (const bf16_t*)(ws + WS_WT_O), MROWS, DM, DM}; pg8::StaticOrder S; S.init(MROWS, DM, G, bid); pg8::gemm_phase(ldsl, g, S, E);
    }
    SEAM(8);
    if (IN(9)) {
        const pg8::Epi E{5, ws, p.x, p.out, p.lb_logits, p.final_norm_g};
        pg8::Gemm g{XB, (const bf16_t*)(ws + WS_WT_FF1), MROWS, DFF, DM}; pg8::StaticOrder S; S.init(MROWS, DFF, G, bid); pg8::gemm_phase(ldsl, g, S, E);
    }
    SEAM(9);
    if (IN(10)) {
        const pg8::Epi E{fuse_final ? 8 : 7, ws, p.x, p.out, p.lb_logits, p.final_norm_g};
        pg8::Gemm g{U, (const bf16_t*)(ws + WS_WT_FF2), MROWS, DM, DFF}; pg8::StaticOrder S; S.init(MROWS, DM, G, bid); pg8::gemm_phase(ldsl, g, S, E);
    }
    if (!fuse_final) {
        SEAM(10);
        if (IN(11)) { phase_final(XB, SSQ, p.out, p.final_norm_g); }
    }
#if DBG_LAST >= 0
    cg::this_grid().sync();
    {
        const unsigned* w32 = (const unsigned*)ws;
        for (size_t i = (size_t)bid * NTHREADS + threadIdx.x; i < (size_t)MROWS * DM; i += (size_t)G * NTHREADS) {
            float a = 0.f;
            for (int j = 0; j < 4; ++j) { const unsigned v = w32[i + (size_t)j * MROWS * DM]; a += (float)(v & 0xffffu) + (float)(v >> 16); }
            p.out[i] = a;
        }
    }
#endif
#undef IN
#undef SEAM
}

extern "C" void kernel_launch(void* const* d_in, const int* in_sizes, int n_in, void* d_out, int out_size, void* d_ws, size_t ws_size, hipStream_t stream) {
    static int grid = 0;
    if (grid == 0) {
        if (n_in != 19 || in_sizes[0] != MROWS * DM || out_size != MROWS * DM || ws_size < WS_END) { fprintf(stderr, "kernel_launch: unexpected shapes (n_in %d, ws %zu)\n", n_in, ws_size); grid = -1; return; }
        int dev = 0, cus = 0, per_cu = 0;
        hipGetDevice(&dev); hipDeviceGetAttribute(&cus, hipDeviceAttributeMultiprocessorCount, dev);
        if (hipFuncSetAttribute((const void*)mega, hipFuncAttributeMaxDynamicSharedMemorySize, LDS_BYTES) != hipSuccess) { fprintf(stderr, "kernel_launch: hipFuncSetAttribute failed\n"); grid = -1; return; }
        if (hipOccupancyMaxActiveBlocksPerMultiprocessor(&per_cu, (const void*)mega, NTHREADS, LDS_BYTES) != hipSuccess || per_cu < 1) { fprintf(stderr, "kernel_launch: occupancy query says %d\n", per_cu); per_cu = 1; }
        (void)hipGetLastError();
        grid = cus * 1;
        if (grid > cus * per_cu) grid = cus * per_cu;
    }
    if (grid < 0) return;
    if (hipMemsetAsync((char*)d_ws + WS_BAR, 0, 32768, stream) != hipSuccess) { fprintf(stderr, "kernel_launch: memset of barrier words failed\n"); return; }
    Params p{};
    const float** f = (const float**)&p;
    for (int i = 0; i < 19; ++i) f[i] = (const float*)d_in[i];
    p.out = (float*)d_out; p.ws = (unsigned char*)d_ws;
#if N_LAUNCH_MODE == 1
    p.ph_lo = 0; p.ph_hi = (DBG_LAST >= 0) ? DBG_LAST + 1 : N_PHASES;
    void* args[] = {&p};
    hipError_t e = hipLaunchCooperativeKernel((const void*)mega, dim3(grid), dim3(NTHREADS), args, LDS_BYTES, stream);
    if (e != hipSuccess) fprintf(stderr, "kernel_launch: cooperative launch failed: %s (grid %d)\n", hipGetErrorString(e), grid);
#else
    for (int k = 0; k < N_PHASES; ++k) { p.ph_lo = k; p.ph_hi = k + 1; hipLaunchKernelGGL(mega, dim3(grid), dim3(NTHREADS), LDS_BYTES, stream, p); }
#endif
}
```

```cpp
#include <hip/hip_runtime.h>
#include <hip/hip_cooperative_groups.h>
#include <cstdio>
namespace cg = cooperative_groups;

#ifndef N_LAUNCH_MODE
#define N_LAUNCH_MODE 1
#endif

typedef unsigned short bf16_t;
typedef short bf16x8 __attribute__((ext_vector_type(8)));
typedef float f32x2 __attribute__((ext_vector_type(2)));
typedef float f32x4 __attribute__((ext_vector_type(4)));
typedef float f32x16 __attribute__((ext_vector_type(16)));
typedef unsigned u32x2 __attribute__((ext_vector_type(2)));
typedef unsigned u32x4 __attribute__((ext_vector_type(4)));
#define LAS __attribute__((address_space(3)))

constexpr int MROWS = 16384, DM = 1024, SEQ = 4096, NIN = 2560, DFF = 4096, MEMROWS = 1024;
constexpr float EPS = 1e-6f;
constexpr int NTHREADS = 512;
constexpr int LDS_MAIN = 135168;
constexpr int LDS_BYTES = LDS_MAIN + 16;

constexpr size_t MiB = 1u << 20;
constexpr size_t WS_WT_IN = 0, WS_WT_K = 5 * MiB, WS_WT_V = 7 * MiB, WS_WT_OUT = 9 * MiB, WS_WT_Q = 11 * MiB, WS_WT_O = 13 * MiB,
                 WS_WT_FF1 = 15 * MiB, WS_WT_FF2 = 23 * MiB, WS_MEMB = 31 * MiB, WS_KX = 33 * MiB, WS_VT = 35 * MiB, WS_SSQ = 37 * MiB,
                 WS_BAR = 39 * MiB, WS_CNT = 39 * MiB + 16384, WS_RSTD0 = 38 * MiB, WS_RSTDM = 38 * MiB + 65536, WS_DEC = 38 * MiB + 131072,
                 WS_XB = 40 * MiB  , WS_QH = 72 * MiB, WS_KH = 88 * MiB, WS_VH = 104 * MiB, WS_GH = 120 * MiB, WS_PH = 136 * MiB,
                 WS_LF = 152 * MiB, WS_ST = 184 * MiB, WS_MIXED = 216 * MiB,
                 WS_X1 = 72 * MiB, WS_XQ = 136 * MiB, WS_ATT = 168 * MiB, WS_U = 72 * MiB, WS_END = 256 * MiB;

typedef __bf16 bf16x2n __attribute__((ext_vector_type(2)));
__device__ __forceinline__ unsigned cvt_pk_bf16(float lo, float hi) { f32x2 v = {lo, hi}; return __builtin_bit_cast(unsigned, __builtin_convertvector(v, bf16x2n)); }
__device__ __forceinline__ bf16_t f2bf(float f) { return (bf16_t)(cvt_pk_bf16(f, 0.f) & 0xffffu); }
__device__ __forceinline__ float bf2f(bf16_t b) { return __uint_as_float(((unsigned)b) << 16); }
__device__ __forceinline__ float bflo(unsigned u) { return __uint_as_float(u << 16); }
__device__ __forceinline__ float bfhi(unsigned u) { return __uint_as_float(u & 0xffff0000u); }
__device__ __forceinline__ f32x4 mfma16(bf16x8 a, bf16x8 b, f32x4 c) { return __builtin_amdgcn_mfma_f32_16x16x32_bf16(a, b, c, 0, 0, 0); }
__device__ __forceinline__ f32x16 mfma32(bf16x8 a, bf16x8 b, f32x16 c) { return __builtin_amdgcn_mfma_f32_32x32x16_bf16(a, b, c, 0, 0, 0); }
__device__ __forceinline__ bf16x8 mk8(u32x2 lo, u32x2 hi) { u32x4 t; t.x = lo.x; t.y = lo.y; t.z = hi.x; t.w = hi.y; return __builtin_bit_cast(bf16x8, t); }
__device__ __forceinline__ bf16x8 mk8u(unsigned a, unsigned b, unsigned c, unsigned d) { u32x4 t; t.x = a; t.y = b; t.z = c; t.w = d; return __builtin_bit_cast(bf16x8, t); }
__device__ __forceinline__ float sigmoidf_(float z) { return __builtin_amdgcn_rcpf(1.0f + __expf(-z)); }

namespace pg8 {
constexpr int BM = 256, BK = 64, HALF = 128, HTB = HALF * BK * 2, STAGE_BYTES = 8 * HTB, NXCD = 8, WGM = 8;
__device__ __forceinline__ int lds_byte(int r, int c) { const int st = (r >> 4) * 2 + (c >> 5), rr = r & 15, cc = c & 31, ob = rr * 64 + cc * 2; return st * 1024 + (ob ^ (((ob >> 9) & 1) << 5)); }
__device__ __forceinline__ void stage_rc(int b, int& R, int& C) { const int st = b / 1024, sb = b % 1024, swz = sb ^ (((sb >> 9) & 1) << 5); R = (st >> 1) * 16 + swz / 64; C = (st & 1) * 32 + (swz % 64) / 2; }
__device__ __forceinline__ int perm32(int rho) { const int n = rho >> 4, i = rho & 15; return 8 * (i >> 2) + 4 * n + (i & 3); }
struct Unit { int pm, pn; };
struct Gemm { const bf16_t* A; const bf16_t* Bt; int M, N, K; };
struct StaticOrder {
    int nM, nN, nwg, G, c;
    __device__ __forceinline__ void init(int M, int N, int G_, int c_) { nM = M / BM; nN = N / BM; nwg = nM * nN; G = G_; c = c_; }
    __device__ __forceinline__ bool next(int i, Unit& u) const {
        const long L = (long)i * G + c; if (L >= nwg) return false;
        int wgid = (int)L; { const int q = nwg / NXCD, r = nwg % NXCD, xcd = wgid % NXCD, off = wgid / NXCD; wgid = (xcd < r ? xcd * (q + 1) : r * (q + 1) + (xcd - r) * q) + off; }
        const int nig = WGM * nN, gid = wgid / nig, fm = gid * WGM, gsz = (nM - fm) < WGM ? (nM - fm) : WGM;
        u.pm = fm + ((wgid % nig) % gsz); u.pn = (wgid % nig) / gsz; return true;
    }
};

struct Epi {
    static constexpr bool PERM = true;
    int mode;
    unsigned char* ws; const float* x; float* out; const float* lbl; const float* gfin;
    __device__ __forceinline__ void store8(bf16_t* p, const f32x4& v0, const f32x4& v1) const {
        u32x4 w; w.x = cvt_pk_bf16(v0[0], v0[1]); w.y = cvt_pk_bf16(v0[2], v0[3]); w.z = cvt_pk_bf16(v1[0], v1[1]); w.w = cvt_pk_bf16(v1[2], v1[3]); *(u32x4*)p = w; }
    __device__ __forceinline__ void fused(f32x4 (&acc)[2][2][4][2], const Unit& u, int wr, int wc, int fr, int fq) const {
        const int row0 = u.pm * BM + wr * 64 + fr;
        const int col0 = u.pn * BM + wc * 32 + 8 * fq;
        const bf16_t* xb = (const bf16_t*)(ws + WS_XB);
        unsigned* sq = (unsigned*)(ws + WS_SSQ);
        unsigned* cnt = (unsigned*)(ws + WS_CNT) + 64 * u.pm;
        u32x4 bc[2], bn[2];
        { const size_t o = (size_t)row0 * DM + col0; bc[0] = *(const u32x4*)(xb + o); bc[1] = *(const u32x4*)(xb + o + HALF); }
#pragma unroll
        for (int gidx = 0; gidx < 8; ++gidx) { const int ai = gidx >> 2, m = gidx & 3; const int row = row0 + ai * HALF + m * 16;
            if (gidx < 7) { const int g2 = gidx + 1; const size_t o2 = (size_t)(row0 + (g2 >> 2) * HALF + (g2 & 3) * 16) * DM + col0; bn[0] = *(const u32x4*)(xb + o2); bn[1] = *(const u32x4*)(xb + o2 + HALF); }
            float ss = 0.f;
#pragma unroll
            for (int bj = 0; bj < 2; ++bj) { const u32x4 bb = bc[bj];
                const f32x4 v0 = acc[ai][bj][m][0] + (f32x4){bflo(bb.x), bfhi(bb.x), bflo(bb.y), bfhi(bb.y)}, v1 = acc[ai][bj][m][1] + (f32x4){bflo(bb.z), bfhi(bb.z), bflo(bb.w), bfhi(bb.w)};
                acc[ai][bj][m][0] = v0; acc[ai][bj][m][1] = v1;
                ss += (v0[0] * v0[0] + v0[1] * v0[1]) + (v0[2] * v0[2] + v0[3] * v0[3]) + (v1[0] * v1[0] + v1[1] * v1[1]) + (v1[2] * v1[2] + v1[3] * v1[3]); }
            ss += __shfl_xor(ss, 16); ss += __shfl_xor(ss, 32);
            if (fq == 0) __hip_atomic_store(sq + (size_t)row * 16 + u.pn * 4 + wc, __float_as_uint(ss), __ATOMIC_RELAXED, __HIP_MEMORY_SCOPE_AGENT);
            bc[0] = bn[0]; bc[1] = bn[1]; }
        asm volatile("s_waitcnt vmcnt(0)" ::: "memory");
        if ((threadIdx.x & 63) == 0) __hip_atomic_fetch_add(cnt, 1u, __ATOMIC_RELAXED, __HIP_MEMORY_SCOPE_AGENT);
        f32x4 gv[2][2];
#pragma unroll
        for (int bj = 0; bj < 2; ++bj) { gv[bj][0] = *(const f32x4*)(gfin + col0 + bj * HALF); gv[bj][1] = *(const f32x4*)(gfin + col0 + bj * HALF + 4); }
        { unsigned spins = 0; while ((unsigned)__builtin_amdgcn_readfirstlane(__hip_atomic_load(cnt, __ATOMIC_RELAXED, __HIP_MEMORY_SCOPE_AGENT)) < 32u) { __builtin_amdgcn_s_sleep(1); if (++spins > (1u << 22)) break; } }
        __builtin_amdgcn_fence(__ATOMIC_ACQUIRE, "agent");
        asm volatile("s_waitcnt vmcnt(0)" ::: "memory");
        f32x4 pv[8];
#pragma unroll
        for (int gidx = 0; gidx < 8; ++gidx) pv[gidx] = *(const f32x4*)((const float*)sq + (size_t)(row0 + (gidx >> 2) * HALF + (gidx & 3) * 16) * 16 + 4 * fq);
#pragma unroll
        for (int gidx = 0; gidx < 8; ++gidx) { const int ai = gidx >> 2, m = gidx & 3; const int row = row0 + ai * HALF + m * 16;
            float t = (pv[gidx][0] + pv[gidx][1]) + (pv[gidx][2] + pv[gidx][3]); t += __shfl_xor(t, 16); t += __shfl_xor(t, 32);
            const float rstd = rsqrtf(t * (1.0f / 1024.0f) + EPS);
            const size_t o = (size_t)row * DM + col0;
#pragma unroll
            for (int bj = 0; bj < 2; ++bj) { *(f32x4*)(out + o + bj * HALF) = acc[ai][bj][m][0] * rstd * gv[bj][0]; *(f32x4*)(out + o + bj * HALF + 4) = acc[ai][bj][m][1] * rstd * gv[bj][1]; } }
    }
    template <class Sched>
    __device__ __forceinline__ bool prefill(LAS unsigned char* lds, const Sched& S) const {
        if (!(mode == 0 || mode == 1 || mode == 4 || mode == 5) || S.nwg > 4 * S.G) return false;
        const int tid = threadIdx.x, rr = tid & 255;
#pragma unroll
        for (int k = 0; k < 2; ++k) { const int ui = (tid >> 8) + 2 * k; Unit u;
            if (S.next(ui, u)) { const int row = u.pm * BM + rr; float r;
                if (mode == 4 || mode == 5) { const f32x4* pp = (const f32x4*)((const float*)(ws + WS_SSQ) + (size_t)row * 16); const f32x4 a = pp[0], b = pp[1], c = pp[2], d = pp[3];
                    const float t = ((a[0] + a[1]) + (a[2] + a[3])) + ((b[0] + b[1]) + (b[2] + b[3])) + ((c[0] + c[1]) + (c[2] + c[3])) + ((d[0] + d[1]) + (d[2] + d[3]));
                    r = rsqrtf(t * (1.0f / 1024.0f) + EPS) * (mode == 4 ? 0.0625f : 1.0f); }
                else r = ((const float*)(ws + (mode == 0 ? WS_RSTD0 : WS_RSTDM)))[row];
                *(LAS float*)(lds + STAGE_BYTES + (ui * 256 + rr) * 4) = r; } }
        return true;
    }
    __device__ __forceinline__ void operator()(const f32x4 (&acc)[2][2][4][2], const Unit& u, int ui, bool tab, LAS unsigned char* lds, int wr, int wc, int fr, int fq) const {
        const int row0 = u.pm * BM + wr * 64 + fr;
        const int colL = wc * 32 + 8 * fq;
        if (mode == 3 || mode == 6 || mode == 7) {
            const int col0 = u.pn * BM + colL;
            bf16_t* xb = (bf16_t*)(ws + WS_XB);
            float* ssq = (float*)(ws + WS_SSQ);
            f32x4 rc[4], rn[4];
            u32x4 bc[2], bn[2];
            if (mode == 3) { const size_t o = (size_t)row0 * DM + col0; rc[0] = *(const f32x4*)(x + o); rc[1] = *(const f32x4*)(x + o + 4); rc[2] = *(const f32x4*)(x + o + HALF); rc[3] = *(const f32x4*)(x + o + HALF + 4); }
            else { const size_t o = (size_t)row0 * DM + col0; bc[0] = *(const u32x4*)(xb + o); bc[1] = *(const u32x4*)(xb + o + HALF); }
#pragma unroll
            for (int gidx = 0; gidx < 8; ++gidx) { const int ai = gidx >> 2, m = gidx & 3; const int row = row0 + ai * HALF + m * 16;
                if (gidx < 7) { const int g2 = gidx + 1; const size_t o2 = (size_t)(row0 + (g2 >> 2) * HALF + (g2 & 3) * 16) * DM + col0;
                    if (mode == 3) { rn[0] = *(const f32x4*)(x + o2); rn[1] = *(const f32x4*)(x + o2 + 4); rn[2] = *(const f32x4*)(x + o2 + HALF); rn[3] = *(const f32x4*)(x + o2 + HALF + 4); }
                    else { bn[0] = *(const u32x4*)(xb + o2); bn[1] = *(const u32x4*)(xb + o2 + HALF); } }
                if (mode != 3) {
#pragma unroll
                    for (int bj = 0; bj < 2; ++bj) { rc[2 * bj] = (f32x4){bflo(bc[bj].x), bfhi(bc[bj].x), bflo(bc[bj].y), bfhi(bc[bj].y)}; rc[2 * bj + 1] = (f32x4){bflo(bc[bj].z), bfhi(bc[bj].z), bflo(bc[bj].w), bfhi(bc[bj].w)}; } }
                float ss = 0.f;
#pragma unroll
                for (int bj = 0; bj < 2; ++bj) { const size_t o = (size_t)row * DM + col0 + bj * HALF;
                    const f32x4 v0 = acc[ai][bj][m][0] + rc[2 * bj], v1 = acc[ai][bj][m][1] + rc[2 * bj + 1];
                    store8(xb + o, v0, v1);
                    ss += (v0[0] * v0[0] + v0[1] * v0[1]) + (v0[2] * v0[2] + v0[3] * v0[3]) + (v1[0] * v1[0] + v1[1] * v1[1]) + (v1[2] * v1[2] + v1[3] * v1[3]); }
                ss += __shfl_xor(ss, 16); ss += __shfl_xor(ss, 32);
                if (fq == 0) ssq[(size_t)row * 16 + u.pn * 4 + wc] = ss;
#pragma unroll
                for (int k = 0; k < 4; ++k) rc[k] = rn[k];
                bc[0] = bn[0]; bc[1] = bn[1]; }
            return;
        }
        if (mode == 2) {
            const int col0 = u.pn * BM + colL;
            const float* rs = (const float*)(ws + WS_RSTDM); bf16_t* ob = (bf16_t*)(ws + WS_VT); const int ldo = 1024;
            f32x4 c0[2], c1[2];
#pragma unroll
            for (int bj = 0; bj < 2; ++bj) { c0[bj] = *(const f32x4*)(rs + col0 + bj * HALF); c1[bj] = *(const f32x4*)(rs + col0 + bj * HALF + 4); }
#pragma unroll
            for (int ai = 0; ai < 2; ++ai)
#pragma unroll
                for (int m = 0; m < 4; ++m) { const int row = row0 + ai * HALF + m * 16;
#pragma unroll
                    for (int bj = 0; bj < 2; ++bj) store8(ob + (size_t)row * ldo + col0 + bj * HALF, acc[ai][bj][m][0] * c0[bj], acc[ai][bj][m][1] * c1[bj]); }
            return;
        }
        float rsc[8];
        if (tab) {
#pragma unroll
            for (int gidx = 0; gidx < 8; ++gidx) rsc[gidx] = *(const LAS float*)(lds + STAGE_BYTES + (ui * 256 + wr * 64 + fr + (gidx >> 2) * HALF + (gidx & 3) * 16) * 4);
        } else if (mode == 4 || mode == 5) {
            const float* sq = (const float*)(ws + WS_SSQ);
            f32x4 pv[8];
#pragma unroll
            for (int gidx = 0; gidx < 8; ++gidx) pv[gidx] = *(const f32x4*)(sq + (size_t)(row0 + (gidx >> 2) * HALF + (gidx & 3) * 16) * 16 + 4 * fq);
            const float cs = mode == 4 ? 0.0625f : 1.0f;
#pragma unroll
            for (int gidx = 0; gidx < 8; ++gidx) { float t = (pv[gidx][0] + pv[gidx][1]) + (pv[gidx][2] + pv[gidx][3]); t += __shfl_xor(t, 16); t += __shfl_xor(t, 32); rsc[gidx] = rsqrtf(t * (1.0f / 1024.0f) + EPS) * cs; }
        } else {
            const float* rs = (const float*)(ws + (mode == 0 ? WS_RSTD0 : WS_RSTDM));
#pragma unroll
            for (int gidx = 0; gidx < 8; ++gidx) rsc[gidx] = rs[row0 + (gidx >> 2) * HALF + (gidx & 3) * 16];
        }
        if (mode == 0) {
            float* lf = (float*)(ws + WS_LF);
            const int sub = u.pn >> 1; const int cb = (u.pn & 1) * 256 + colL;
            if (sub == 1) {
                float oml[2][8];
#pragma unroll
                for (int bj = 0; bj < 2; ++bj)
#pragma unroll
                    for (int j = 0; j < 8; ++j) { const int c = cb + bj * HALF + j; const float l0 = lbl[c], l1 = lbl[512 + c]; const float lb = 1.0f / (1.0f + __expf(l1 - l0)); oml[bj][j] = 1.0f - lb; }
#pragma unroll
                for (int ai = 0; ai < 2; ++ai)
#pragma unroll
                    for (int m = 0; m < 4; ++m) { const int row = row0 + ai * HALF + m * 16; const float r = rsc[ai * 4 + m];
#pragma unroll
                        for (int bj = 0; bj < 2; ++bj) { f32x4 lf0, lf1;
#pragma unroll
                            for (int j = 0; j < 4; ++j) {
                                const float za = acc[ai][bj][m][0][j] * r, zb = acc[ai][bj][m][1][j] * r;
                                const float ka = oml[bj][j] * (1.0f - sigmoidf_(za)), kb = oml[bj][4 + j] * (1.0f - sigmoidf_(zb));
                                lf0[j] = __logf(1.0f - ka); lf1[j] = __logf(1.0f - kb); }
                            const size_t o = (size_t)row * 512 + cb + bj * HALF;
                            *(f32x4*)(lf + o) = lf0; *(f32x4*)(lf + o + 4) = lf1; } }
            } else {
                bf16_t* dst = (bf16_t*)(ws + (sub == 0 ? WS_QH : (sub == 2 ? WS_VH : (sub == 3 ? WS_GH : WS_PH))));
                const bool act = (sub == 0) || (sub == 3);
#pragma unroll
                for (int ai = 0; ai < 2; ++ai)
#pragma unroll
                    for (int m = 0; m < 4; ++m) { const int row = row0 + ai * HALF + m * 16; const float r = rsc[ai * 4 + m];
#pragma unroll
                        for (int bj = 0; bj < 2; ++bj) { f32x4 v0 = acc[ai][bj][m][0] * r, v1 = acc[ai][bj][m][1] * r;
                            if (act) {
#pragma unroll
                                for (int j = 0; j < 4; ++j) { v0[j] = v0[j] * sigmoidf_(v0[j]); v1[j] = v1[j] * sigmoidf_(v1[j]); } }
                            store8(dst + (size_t)row * 512 + cb + bj * HALF, v0, v1); } }
            }
        } else {
            const int col0 = u.pn * BM + colL;
            bf16_t* ob = (bf16_t*)(ws + (mode == 1 ? WS_KX : (mode == 4 ? WS_XQ : WS_U))); const int ldo = mode == 5 ? DFF : 1024;
#pragma unroll
            for (int ai = 0; ai < 2; ++ai)
#pragma unroll
                for (int m = 0; m < 4; ++m) { const int row = row0 + ai * HALF + m * 16; const float r = rsc[ai * 4 + m];
#pragma unroll
                    for (int bj = 0; bj < 2; ++bj) { f32x4 v0 = acc[ai][bj][m][0] * r, v1 = acc[ai][bj][m][1] * r;
                        if (mode == 5) {
#pragma unroll
                            for (int j = 0; j < 4; ++j) { const float a = fmaxf(v0[j], 0.f), b = fmaxf(v1[j], 0.f); v0[j] = a * a; v1[j] = b * b; } }
                        store8(ob + (size_t)row * ldo + col0 + bj * HALF, v0, v1); } }
        }
    }
};

template <class EpiT, class Sched>
__device__ __forceinline__ void gemm_phase(LAS unsigned char* lds, const Gemm g, const Sched S, const EpiT E) {
    const int tid = threadIdx.x, wid = __builtin_amdgcn_readfirstlane(tid >> 6), lane = tid & 63, wr = wid >> 2, wc = wid & 3, fr = lane & 15, fq = lane >> 4;
    const int K = g.K, nt = K / BK;
    unsigned voffA[2], voffB[2];
#pragma unroll
    for (int i = 0; i < 2; ++i) { int R, C; stage_rc(tid * 16 + i * 8192, R, C); const int Rb = EpiT::PERM ? ((R & ~31) + perm32(R & 31)) : R;
        voffA[i] = (unsigned)(R * K + C) * 2u; voffB[i] = (unsigned)(Rb * K + C) * 2u; }
    const size_t kstep = (size_t)(BK * 2);
    const size_t hstep = (size_t)HALF * K * 2;
    const size_t tstep = 2 * hstep;
    const unsigned ldsw = (unsigned)wid * 1024u;
    const int aoff = lds_byte(wr * 64 + fr, fq * 8), boff = lds_byte(wc * 32 + fr, fq * 8);
#define PG8_SA(b, h) (((b) * 2 + (h)) * HTB)
#define PG8_SB(b, h) ((4 + (b) * 2 + (h)) * HTB)
#define PG8_STAGE(bufoff, gbase, voff) do { _Pragma("unroll") for (int _i = 0; _i < 2; ++_i) \
        __builtin_amdgcn_global_load_lds((const unsigned*)((const char*)(gbase) + (voff)[_i]), (LAS unsigned*)(lds + (bufoff) + ldsw + _i * 8192), 16, 0, 0); } while (0)
#define PG8_LDA(dst, b, h) do { _Pragma("unroll") for (int m = 0; m < 4; ++m) _Pragma("unroll") for (int k = 0; k < 2; ++k) dst[m][k] = *(const LAS bf16x8*)(lds + PG8_SA(b, h) + aoff + m * 2048 + k * 1024); } while (0)
#define PG8_LDB(dst, b, h) do { _Pragma("unroll") for (int n = 0; n < 2; ++n) _Pragma("unroll") for (int k = 0; k < 2; ++k) dst[n][k] = *(const LAS bf16x8*)(lds + PG8_SB(b, h) + boff + n * 2048 + k * 1024); } while (0)
#define PG8_MMA(ai, bj, At, Bt) do { __builtin_amdgcn_s_setprio(1); _Pragma("unroll") for (int m = 0; m < 4; ++m) _Pragma("unroll") for (int n = 0; n < 2; ++n) _Pragma("unroll") for (int k = 0; k < 2; ++k) \
        acc[ai][bj][m][n] = __builtin_amdgcn_mfma_f32_16x16x32_bf16(Bt[n][k], At[m][k], acc[ai][bj][m][n], 0, 0, 0); __builtin_amdgcn_s_setprio(0); } while (0)
#define PG8_WAIT_V(n) asm volatile("s_waitcnt vmcnt(" #n ")" ::: "memory")
#define PG8_WAIT_L(n) asm volatile("s_waitcnt lgkmcnt(" #n ")" ::: "memory")
#define PG8_BAR __builtin_amdgcn_s_barrier()
#define PG8_SCHED __builtin_amdgcn_sched_barrier(0)
    Unit cur, nxt; int ui = 0;
    if (!S.next(0, cur)) return;
    const bool tab = E.prefill(lds, S);
    if (tab) __syncthreads();
    f32x4 acc[2][2][4][2];
#pragma unroll
    for (int a = 0; a < 2; ++a)
#pragma unroll
        for (int b = 0; b < 2; ++b)
#pragma unroll
            for (int m = 0; m < 4; ++m)
#pragma unroll
                for (int n = 0; n < 2; ++n) acc[a][b][m][n] = (f32x4){0.f, 0.f, 0.f, 0.f};
    bf16x8 At[4][2], B0[2][2], B1[2][2];
    const char* cA = (const char*)g.A + (size_t)cur.pm * tstep; const char* cB = (const char*)g.Bt + (size_t)cur.pn * tstep;
    PG8_STAGE(PG8_SB(0, 0), cB, voffB); PG8_STAGE(PG8_SA(0, 0), cA, voffA); PG8_STAGE(PG8_SB(0, 1), cB + hstep, voffB); PG8_STAGE(PG8_SA(0, 1), cA + hstep, voffA);
    if (wr == 1) PG8_BAR;
    PG8_WAIT_V(4); PG8_BAR;
    PG8_STAGE(PG8_SB(1, 0), cB + kstep, voffB); PG8_STAGE(PG8_SA(1, 0), cA + kstep, voffA); PG8_STAGE(PG8_SB(1, 1), cB + hstep + kstep, voffB);
    PG8_WAIT_V(6); PG8_BAR;
    for (;;) {
        const bool has_next = S.next(ui + 1, nxt);
        const char* nA = has_next ? (const char*)g.A + (size_t)nxt.pm * tstep : cA; const char* nB = has_next ? (const char*)g.Bt + (size_t)nxt.pn * tstep : cB;
        for (int t = 0; t < nt; t += 2) {
            const bool last = (t == nt - 2);
            const char* a1 = cA + (size_t)(t + 1) * kstep;
            const char* a2 = last ? nA : cA + (size_t)(t + 2) * kstep; const char* b2 = last ? nB : cB + (size_t)(t + 2) * kstep;
            const char* a3 = a2 + kstep; const char* b3 = b2 + kstep;
            PG8_LDB(B0, 0, 0); PG8_SCHED; PG8_LDA(At, 0, 0); PG8_STAGE(PG8_SA(1, 1), a1 + hstep, voffA);
            PG8_WAIT_L(8); PG8_BAR; PG8_WAIT_L(0); PG8_MMA(0, 0, At, B0); PG8_BAR; PG8_SCHED;
            PG8_LDB(B1, 0, 1); PG8_STAGE(PG8_SB(0, 0), b2, voffB);
            PG8_BAR; PG8_WAIT_L(0); PG8_MMA(0, 1, At, B1); PG8_BAR;
            PG8_LDA(At, 0, 1); PG8_STAGE(PG8_SA(0, 0), a2, voffA);
            PG8_BAR; PG8_WAIT_L(0); PG8_MMA(1, 0, At, B0); PG8_BAR; PG8_SCHED;
            PG8_STAGE(PG8_SB(0, 1), b2 + hstep, voffB);
            PG8_WAIT_V(6); PG8_BAR; PG8_MMA(1, 1, At, B1); PG8_BAR;
            PG8_LDB(B0, 1, 0); PG8_SCHED; PG8_LDA(At, 1, 0); PG8_STAGE(PG8_SA(0, 1), a2 + hstep, voffA);
            PG8_WAIT_L(8); PG8_BAR; PG8_WAIT_L(0); PG8_MMA(0, 0, At, B0); PG8_BAR; PG8_SCHED;
            PG8_LDB(B1, 1, 1); PG8_STAGE(PG8_SB(1, 0), b3, voffB);
            PG8_BAR; PG8_WAIT_L(0); PG8_MMA(0, 1, At, B1); PG8_BAR;
            PG8_LDA(At, 1, 1); PG8_STAGE(PG8_SA(1, 0), a3, voffA);
            PG8_BAR; PG8_WAIT_L(0); PG8_MMA(1, 0, At, B0); PG8_BAR; PG8_SCHED;
            PG8_STAGE(PG8_SB(1, 1), b3 + hstep, voffB);
            PG8_WAIT_V(6); PG8_BAR; PG8_MMA(1, 1, At, B1); PG8_BAR;
        }
        if (E.mode != 8) E(acc, cur, ui, tab, lds, wr, wc, fr, fq);
        if (!has_next) break;
#pragma unroll
        for (int a = 0; a < 2; ++a)
#pragma unroll
            for (int b = 0; b < 2; ++b)
#pragma unroll
                for (int m = 0; m < 4; ++m)
#pragma unroll
                    for (int n = 0; n < 2; ++n) acc[a][b][m][n] = (f32x4){0.f, 0.f, 0.f, 0.f};
        cur = nxt; cA = nA; cB = nB; ++ui;
    }
    PG8_WAIT_V(0);
    if (wr == 0) PG8_BAR;
    PG8_BAR;
    if (E.mode == 8) E.fused(acc, cur, wr, wc, fr, fq);
#undef PG8_SA
#undef PG8_SB
#undef PG8_STAGE
#undef PG8_LDA
#undef PG8_LDB
#undef PG8_MMA
#undef PG8_WAIT_V
#undef PG8_WAIT_L
#undef PG8_BAR
#undef PG8_SCHED
}
}

struct Params {
    const float *x, *mem, *norm_mix_g, *w_in, *lb_logits, *hgrn_norm_g, *w_pool, *pool_scale, *w_out, *norm_x_g, *norm_mem_g, *w_xq, *w_xk, *w_xv, *w_xo, *norm_ffn_g, *w_ff1, *w_ff2, *final_norm_g;
    float* out; unsigned char* ws;
    int ph_lo, ph_hi;
};

struct TD { const float* W; const float* g; bf16_t* out; int N, ldo, kt, nt; };
__device__ __forceinline__ TD tile_desc(const Params& p, int t) {
    unsigned char* ws = p.ws; TD d;
    if (t < 320)       { d.W = p.w_in;  d.g = p.norm_mix_g; d.out = (bf16_t*)(ws + WS_WT_IN);  d.N = NIN;  d.ldo = 1024; d.kt = t / 40; d.nt = t % 40; }
    else if (t < 448)  { const int u = t - 320;  d.W = p.w_xk;  d.g = p.norm_mem_g; d.out = (bf16_t*)(ws + WS_WT_K);   d.N = 1024; d.ldo = 1024; d.kt = u / 16; d.nt = u % 16; }
    else if (t < 576)  { const int u = t - 448;  d.W = p.w_xv;  d.g = p.norm_mem_g; d.out = (bf16_t*)(ws + WS_WT_V);   d.N = 1024; d.ldo = 1024; d.kt = u / 16; d.nt = u % 16; }
    else if (t < 704)  { const int u = t - 576;  d.W = p.w_xq;  d.g = p.norm_x_g;   d.out = (bf16_t*)(ws + WS_WT_Q);   d.N = 1024; d.ldo = 1024; d.kt = u / 16; d.nt = u % 16; }
    else if (t < 832)  { const int u = t - 704;  d.W = p.w_xo;  d.g = nullptr;      d.out = (bf16_t*)(ws + WS_WT_O);   d.N = 1024; d.ldo = 1024; d.kt = u / 16; d.nt = u % 16; }
    else if (t < 960)  { const int u = t - 832;  d.W = p.w_out; d.g = nullptr;      d.out = (bf16_t*)(ws + WS_WT_OUT); d.N = 1024; d.ldo = 1024; d.kt = u / 16; d.nt = u % 16; }
    else if (t < 1472) { const int u = t - 960;  d.W = p.w_ff1; d.g = p.norm_ffn_g; d.out = (bf16_t*)(ws + WS_WT_FF1); d.N = DFF;  d.ldo = 1024; d.kt = u / 64; d.nt = u % 64; }
    else               { const int u = t - 1472; d.W = p.w_ff2; d.g = nullptr;      d.out = (bf16_t*)(ws + WS_WT_FF2); d.N = 1024; d.ldo = 4096; d.kt = u / 16; d.nt = u % 16; }
    return d;
}
__device__ __forceinline__ void tile_load(const TD& d, f32x4 (&v)[4], float (&sc)[4]) {
    const int tid = threadIdx.x, r = tid >> 4, c4 = tid & 15;
#pragma unroll
    for (int i = 0; i < 4; ++i) { const int k = 128 * d.kt + r + 32 * i; v[i] = __builtin_nontemporal_load((const f32x4*)(d.W + (size_t)k * d.N + 64 * d.nt + 4 * c4)); sc[i] = d.g ? d.g[k] : 1.0f; }
}
__device__ __forceinline__ void transpose_range(const Params& p, unsigned char* lds, int t_begin, int t_end, int first, int stride) {
    bf16_t* T0 = (bf16_t*)lds;
    bf16_t* T1 = (bf16_t*)(lds + 17408);
    const int tid = threadIdx.x, r = tid >> 4, c4 = tid & 15, n = tid >> 3, ks = tid & 7;
    int ta = t_begin + first;
    if (ta >= t_end) return;
    int tb = ta + stride; bool hb = tb < t_end;
    TD da = tile_desc(p, ta), db = da; f32x4 va[4], vb[4]; float sa[4], sb[4];
    tile_load(da, va, sa);
    if (hb) { db = tile_desc(p, tb); tile_load(db, vb, sb); }
    for (;;) {
#pragma unroll
        for (int i = 0; i < 4; ++i) { const int kl = r + 32 * i;
            T0[(4 * c4 + 0) * 136 + kl] = f2bf(va[i][0] * sa[i]); T0[(4 * c4 + 1) * 136 + kl] = f2bf(va[i][1] * sa[i]);
            T0[(4 * c4 + 2) * 136 + kl] = f2bf(va[i][2] * sa[i]); T0[(4 * c4 + 3) * 136 + kl] = f2bf(va[i][3] * sa[i]); }
        if (hb) {
#pragma unroll
            for (int i = 0; i < 4; ++i) { const int kl = r + 32 * i;
                T1[(4 * c4 + 0) * 136 + kl] = f2bf(vb[i][0] * sb[i]); T1[(4 * c4 + 1) * 136 + kl] = f2bf(vb[i][1] * sb[i]);
                T1[(4 * c4 + 2) * 136 + kl] = f2bf(vb[i][2] * sb[i]); T1[(4 * c4 + 3) * 136 + kl] = f2bf(vb[i][3] * sb[i]); } }
        __syncthreads();
        const int tna = ta + 2 * stride, tnb = tna + stride; const bool hna = tna < t_end, hnb = tnb < t_end;
        const TD ca = da, cb = db; const bool chb = hb;
        if (hna) { da = tile_desc(p, tna); tile_load(da, va, sa); }
        if (hnb) { db = tile_desc(p, tnb); tile_load(db, vb, sb); }
        { const u32x4* src = (const u32x4*)(T0 + n * 136 + 16 * ks); const u32x4 a = src[0], b = src[1];
          u32x4* dst = (u32x4*)(ca.out + (size_t)(64 * ca.nt + n) * ca.ldo + 128 * ca.kt + 16 * ks); dst[0] = a; dst[1] = b; }
        if (chb) { const u32x4* src = (const u32x4*)(T1 + n * 136 + 16 * ks); const u32x4 a = src[0], b = src[1];
          u32x4* dst = (u32x4*)(cb.out + (size_t)(64 * cb.nt + n) * cb.ldo + 128 * cb.kt + 16 * ks); dst[0] = a; dst[1] = b; }
        __syncthreads();
        if (!hna) break;
        ta = tna; hb = hnb;
    }
}
__device__ __forceinline__ void phase_prep(const Params p, unsigned char* lds) {
    unsigned char* ws = p.ws;
    const int G = gridDim.x;
    {
        const int lane = threadIdx.x & 63, gw = blockIdx.x * (NTHREADS / 64) + (threadIdx.x >> 6), nw = G * (NTHREADS / 64);
        int r = gw;
        f32x4 v[4], vn[4];
        if (r < MROWS + MEMROWS) { const float* src = r < MROWS ? p.x + (size_t)r * DM : p.mem + (size_t)(r - MROWS) * DM;
#pragma unroll
            for (int i = 0; i < 4; ++i) v[i] = __builtin_nontemporal_load((const f32x4*)src + lane + 64 * i); }
        for (; r < MROWS + MEMROWS; r += nw) {
            const int rn = r + nw;
            if (rn < MROWS + MEMROWS) { const float* src = rn < MROWS ? p.x + (size_t)rn * DM : p.mem + (size_t)(rn - MROWS) * DM;
#pragma unroll
                for (int i = 0; i < 4; ++i) vn[i] = __builtin_nontemporal_load((const f32x4*)src + lane + 64 * i); }
            const bool isx = r < MROWS;
            bf16_t* dst = isx ? (bf16_t*)(ws + WS_XB) + (size_t)r * DM : (bf16_t*)(ws + WS_MEMB) + (size_t)(r - MROWS) * DM;
            float ss = 0.f;
#pragma unroll
            for (int i = 0; i < 4; ++i) ss += (v[i][0] * v[i][0] + v[i][1] * v[i][1]) + (v[i][2] * v[i][2] + v[i][3] * v[i][3]);
#pragma unroll
            for (int o = 1; o < 64; o <<= 1) ss += __shfl_xor(ss, o);
#pragma unroll
            for (int i = 0; i < 4; ++i) { u32x2 w; w.x = cvt_pk_bf16(v[i][0], v[i][1]); w.y = cvt_pk_bf16(v[i][2], v[i][3]); ((u32x2*)dst)[lane + 64 * i] = w; }
            if (lane == 0) { const float rstd = rsqrtf(ss * (1.0f / 1024.0f) + EPS); if (isx) ((float*)(ws + WS_RSTD0))[r] = rstd; else ((float*)(ws + WS_RSTDM))[r - MROWS] = rstd; }
#pragma unroll
            for (int i = 0; i < 4; ++i) v[i] = vn[i];
        }
    }
    transpose_range(p, lds, 0, 576, blockIdx.x, G);
}
__device__ __forceinline__ void deferred_prep(const Params p, unsigned char* lds, int j, int nworkers) {
    transpose_range(p, lds, 576, 1984, j, nworkers);
}
__device__ __forceinline__ void fold_pool_weights_mfma(const Params& p) {
    bf16_t* wto = (bf16_t*)(p.ws + WS_WT_OUT);
    const int tid = threadIdx.x, w = tid >> 6, lane = tid & 63, fr = lane & 15, q = lane >> 4;
    for (int item = blockIdx.x; item < 256; item += gridDim.x) {
        const int gi = item >> 6, nb = item & 63;
        f32x4 acc = (f32x4){0.f, 0.f, 0.f, 0.f};
        const float* wp = p.w_pool + (size_t)(gi * 128 + 16 * w + fr) * 128;
        const float* ps = p.pool_scale + gi * 128;
        const bf16_t* arow = wto + (size_t)(16 * nb + fr) * 1024 + 512 + gi * 128;
#pragma unroll
        for (int ks = 0; ks < 4; ++ks) {
            const int d0 = 32 * ks + 8 * q;
            const f32x4 w0 = *(const f32x4*)(wp + d0), w1 = *(const f32x4*)(wp + d0 + 4), s0 = *(const f32x4*)(ps + d0), s1 = *(const f32x4*)(ps + d0 + 4);
            const bf16x8 cfr = mk8u(cvt_pk_bf16(w0[0] * s0[0], w0[1] * s0[1]), cvt_pk_bf16(w0[2] * s0[2], w0[3] * s0[3]), cvt_pk_bf16(w1[0] * s1[0], w1[1] * s1[1]), cvt_pk_bf16(w1[2] * s1[2], w1[3] * s1[3]));
            const bf16x8 nfr = *(const bf16x8*)(arow + d0);
            acc = mfma16(cfr, nfr, acc);
        }
        asm volatile("s_waitcnt vmcnt(0)" ::: "memory");
        __syncthreads();
        u32x2 o; o.x = cvt_pk_bf16(acc[0], acc[1]); o.y = cvt_pk_bf16(acc[2], acc[3]);
        *(u32x2*)(wto + (size_t)(16 * nb + fr) * 1024 + 512 + gi * 128 + 16 * w + 4 * q) = o;
        __syncthreads();
    }
}

__device__ __forceinline__ void phase_passA(const bf16_t* __restrict__ KH, const float* __restrict__ LF, const bf16_t* __restrict__ VH, bf16_t* __restrict__ LT, float* __restrict__ DEC, unsigned char* lds) {
    const int tid = threadIdx.x, ch = tid & 127, seg = tid >> 7, G = gridDim.x;
    float* segtot = (float*)lds;
    unsigned char* KdT = lds + 2048;
    unsigned char* VTl = lds + 2048 + 18432;
    const int w = tid >> 6, lane = tid & 63, fr = lane & 15, q = lane >> 4;
    float lf[16], kk[16]; unsigned vr[16];
    int unit = blockIdx.x;
    if (unit < 1024) { const int b = unit >> 8, c = (unit >> 2) & 63, h = unit & 3; const size_t g0 = (size_t)(b * SEQ + c * 64 + seg * 16) * 512 + h * 128 + ch;
#pragma unroll
        for (int i = 0; i < 16; ++i) { lf[i] = LF[g0 + (size_t)i * 512]; vr[i] = VH[g0 + (size_t)i * 512]; } }
    for (; unit < 1024; unit += G) {
        const int b = unit >> 8, c = (unit >> 2) & 63, h = unit & 3, bh = b * 4 + h;
#pragma unroll
        for (int i = 0; i < 16; ++i) kk[i] = 1.0f - __expf(lf[i]);
#pragma unroll
        for (int i = 1; i < 16; ++i) lf[i] += lf[i - 1];
        segtot[seg * 128 + ch] = lf[15];
        __syncthreads();
        float after = 0.f;
#pragma unroll
        for (int s2 = 1; s2 < 4; ++s2) if (s2 > seg) after += segtot[s2 * 128 + ch];
        const float tot = after + lf[15];
        if (seg == 0) DEC[(size_t)(bh * 64 + c) * 128 + ch] = __expf(tot);
        unsigned kd[8], vp[8];
#pragma unroll
        for (int i = 0; i < 8; ++i) {
            kd[i] = cvt_pk_bf16(kk[2 * i] * __expf(tot - lf[2 * i]), kk[2 * i + 1] * __expf(tot - lf[2 * i + 1]));
            vp[i] = vr[2 * i] | (vr[2 * i + 1] << 16);
        }
        { u32x4* d = (u32x4*)(KdT + ch * 144 + seg * 32); d[0] = (u32x4){kd[0], kd[1], kd[2], kd[3]}; d[1] = (u32x4){kd[4], kd[5], kd[6], kd[7]}; }
        { u32x4* d = (u32x4*)(VTl + ch * 144 + seg * 32); d[0] = (u32x4){vp[0], vp[1], vp[2], vp[3]}; d[1] = (u32x4){vp[4], vp[5], vp[6], vp[7]}; }
        __syncthreads();
        {
            const int un = unit + G;
            if (un < 1024) { const int b2 = un >> 8, c2 = (un >> 2) & 63, h2 = un & 3; const size_t g0 = (size_t)(b2 * SEQ + c2 * 64 + seg * 16) * 512 + h2 * 128 + ch;
#pragma unroll
                for (int i = 0; i < 16; ++i) { lf[i] = LF[g0 + (size_t)i * 512]; vr[i] = VH[g0 + (size_t)i * 512]; } }
        }
        bf16x8 a[2];
#pragma unroll
        for (int ks = 0; ks < 2; ++ks) a[ks] = *(const bf16x8*)(KdT + (16 * w + fr) * 144 + (32 * ks + 8 * q) * 2);
        bf16_t* ltp = LT + (size_t)(bh * 64 + c) * 16384;
#pragma unroll
        for (int vb = 0; vb < 8; ++vb) {
            f32x4 acc = (f32x4){0.f, 0.f, 0.f, 0.f};
#pragma unroll
            for (int ks = 0; ks < 2; ++ks) { const bf16x8 bfr = *(const bf16x8*)(VTl + (16 * vb + fr) * 144 + (32 * ks + 8 * q) * 2); acc = mfma16(a[ks], bfr, acc); }
            u32x2 pk; pk.x = cvt_pk_bf16(acc[0], acc[1]); pk.y = cvt_pk_bf16(acc[2], acc[3]);
            *(u32x2*)(ltp + (size_t)(16 * vb + fr) * 128 + 16 * w + 4 * q) = pk;
        }
        __syncthreads();
    }
}

template <int W>
__device__ __forceinline__ void pool_body(const bf16_t* __restrict__ PH, bf16_t* __restrict__ MIXED, int r0, int s0, int c0) {
    unsigned v[31 + W];
#pragma unroll
    for (int j = 1; j < W; ++j) v[W - 1 - j] = (s0 - j >= 0) ? *(const unsigned*)(PH + (size_t)(r0 - j) * 512 + c0) : 0u;
#pragma unroll
    for (int tt = 0; tt < 32; ++tt) v[W - 1 + tt] = *(const unsigned*)(PH + (size_t)(r0 + tt) * 512 + c0);
    float sx = 0.f, sy = 0.f;
#pragma unroll
    for (int j = 1; j < W; ++j) { sx += bflo(v[W - 1 - j]); sy += bfhi(v[W - 1 - j]); }
#pragma unroll
    for (int tt = 0; tt < 32; ++tt) {
        const int s = s0 + tt;
        const float px = bflo(v[W - 1 + tt]), py = bfhi(v[W - 1 + tt]);
        sx += px; sy += py;
        const int cnt = (s + 1) < W ? (s + 1) : W;
        const float inv = __builtin_amdgcn_rcpf((float)cnt);
        *(unsigned*)(MIXED + (size_t)(r0 + tt) * 1024 + 512 + c0) = cvt_pk_bf16(sx * inv - px, sy * inv - py);
        sx -= bflo(v[tt]); sy -= bfhi(v[tt]);
    }
}
__device__ __forceinline__ void pool_tile(const bf16_t* __restrict__ PH, bf16_t* __restrict__ MIXED, int tile) {
    const int tid = threadIdx.x, cp = tid & 255, th = tid >> 8, c0 = 2 * cp, gi = c0 >> 7;
    const int r0 = tile * 64 + th * 32, s0 = r0 & (SEQ - 1);
    if (gi == 0) pool_body<2>(PH, MIXED, r0, s0, c0);
    else if (gi == 1) pool_body<4>(PH, MIXED, r0, s0, c0);
    else if (gi == 2) pool_body<8>(PH, MIXED, r0, s0, c0);
    else pool_body<16>(PH, MIXED, r0, s0, c0);
}

__device__ __forceinline__ void phase_scan(const bf16_t* LT, const float* __restrict__ DEC, bf16_t* ST) {
    for (int e2 = blockIdx.x * NTHREADS + threadIdx.x; e2 < 131072; e2 += gridDim.x * NTHREADS) {
        const int bh = e2 >> 13, v = (e2 >> 6) & 127, kp = e2 & 63;
        float sx = 0.f, sy = 0.f;
        const size_t base = (size_t)bh * 64 * 16384 + (size_t)v * 128 + 2 * kp;
        const float* dp = DEC + (size_t)bh * 64 * 128 + 2 * kp;
        for (int c0 = 0; c0 < 64; c0 += 32) {
            unsigned l[32]; f32x2 d[32];
#pragma unroll
            for (int j = 0; j < 32; ++j) { l[j] = *(const unsigned*)(LT + base + (size_t)(c0 + j) * 16384); d[j] = *(const f32x2*)(dp + (c0 + j) * 128); }
#pragma unroll
            for (int j = 0; j < 32; ++j) {
                *(unsigned*)(ST + base + (size_t)(c0 + j) * 16384) = cvt_pk_bf16(sx, sy);
                sx = d[j][0] * sx + bflo(l[j]); sy = d[j][1] * sy + bfhi(l[j]);
            }
        }
    }
}

__device__ __forceinline__ void phase_passC(const bf16_t* __restrict__ QH, const bf16_t* __restrict__ KH, const float* __restrict__ LF, const bf16_t* __restrict__ VH, const bf16_t* __restrict__ GH,
                                const bf16_t* __restrict__ ST, const float* __restrict__ hg, bf16_t* __restrict__ MIXED, unsigned char* lds) {
    const int tid = threadIdx.x, ch = tid & 127, seg = tid >> 7, G = gridDim.x;
    float lf[16], kk[16]; unsigned qr[16], vr[16];
    int unit = blockIdx.x;
    if (unit < 1024) { const int b = unit >> 8, c = (unit >> 2) & 63, h = unit & 3; const size_t g0 = (size_t)(b * SEQ + c * 64 + seg * 16) * 512 + h * 128 + ch;
#pragma unroll
        for (int i = 0; i < 16; ++i) { lf[i] = LF[g0 + (size_t)i * 512]; vr[i] = VH[g0 + (size_t)i * 512]; qr[i] = QH[g0 + (size_t)i * 512]; } }
  for (; unit < 1024; unit += G) {
    const int b = unit >> 8, c = (unit >> 2) & 63, h = unit & 3;
    const int row0 = b * SEQ + c * 64, bh = b * 4 + h;
    float* segtot = (float*)lds;
    float* rmsp = (float*)(lds + 2048);
    bf16_t* QC = (bf16_t*)(lds + 4096);
    bf16_t* QT = (bf16_t*)(lds + 21504);
    constexpr int KT0 = 38912;
    unsigned char* VTl = lds + 82432;
    const int w = tid >> 6, lane = tid & 63, fr = lane & 15, q = lane >> 4;
    const int i = w & 3, vh = w >> 2;
    const size_t row = (size_t)(row0 + 16 * i + fr);
    u32x2 gt[4]; f32x4 gg[4]; bf16x8 stf[4][4];
    {
        const bf16_t* stp = ST + (size_t)(bh * 64 + c) * 16384;
#pragma unroll
        for (int vbl = 0; vbl < 4; ++vbl) { const int v0 = 16 * (vh * 4 + vbl) + 4 * q; gt[vbl] = *(const u32x2*)(GH + row * 512 + h * 128 + v0); gg[vbl] = *(const f32x4*)(hg + h * 128 + v0);
#pragma unroll
            for (int ks = 0; ks < 4; ++ks) stf[ks][vbl] = *(const bf16x8*)(stp + (size_t)(16 * (vh * 4 + vbl) + fr) * 128 + 32 * ks + 8 * q); }
    }
#pragma unroll
    for (int i2 = 0; i2 < 16; ++i2) kk[i2] = 1.0f - __expf(lf[i2]);
#pragma unroll
    for (int i2 = 1; i2 < 16; ++i2) lf[i2] += lf[i2 - 1];
    segtot[seg * 128 + ch] = lf[15];
    {
        unsigned vp[8];
#pragma unroll
        for (int i2 = 0; i2 < 8; ++i2) vp[i2] = vr[2 * i2] | (vr[2 * i2 + 1] << 16);
        u32x4* d = (u32x4*)(VTl + ch * 144 + seg * 32); d[0] = (u32x4){vp[0], vp[1], vp[2], vp[3]}; d[1] = (u32x4){vp[4], vp[5], vp[6], vp[7]};
    }
    __syncthreads();
    const float t0 = segtot[ch], t1 = segtot[128 + ch], t2 = segtot[256 + ch];
    const float P = (seg > 0 ? t0 : 0.f) + (seg > 1 ? t1 : 0.f) + (seg > 2 ? t2 : 0.f);
    {
        const float eP = __expf(P);
#pragma unroll
        for (int i2 = 0; i2 < 16; ++i2) {
            const float qv = bflo(qr[i2]);
            const float el = __expf(lf[i2]);
            QT[(seg * 16 + i2) * 136 + ch] = f2bf(qv * el);
            QC[(seg * 16 + i2) * 136 + ch] = f2bf(qv * el * eP);
        }
        float E = 0.f;
#pragma unroll
        for (int i2 = 0; i2 < 4; ++i2) {
            if (i2 >= seg) {
                bf16_t* KT = (bf16_t*)(lds + KT0 + 4352 * ((i2 * (i2 + 1)) / 2));
#pragma unroll
                for (int j = 0; j < 16; ++j) KT[(seg * 16 + j) * 136 + ch] = f2bf(kk[j] * __expf(E - lf[j]));
                E += (i2 == 0 ? t0 : (i2 == 1 ? t1 : t2));
            }
        }
    }
    __syncthreads();
    {
        const int un = unit + G;
        if (un < 1024) { const int b2 = un >> 8, c2 = (un >> 2) & 63, h2 = un & 3; const size_t g2 = (size_t)(b2 * SEQ + c2 * 64 + seg * 16) * 512 + h2 * 128 + ch;
#pragma unroll
            for (int i2 = 0; i2 < 16; ++i2) { lf[i2] = LF[g2 + (size_t)i2 * 512]; vr[i2] = VH[g2 + (size_t)i2 * 512]; qr[i2] = QH[g2 + (size_t)i2 * 512]; } }
    }
    f32x4 sT[4];
#pragma unroll
    for (int j = 0; j < 4; ++j) sT[j] = (f32x4){0.f, 0.f, 0.f, 0.f};
    {
        bf16x8 qfr[4];
#pragma unroll
        for (int ks = 0; ks < 4; ++ks) qfr[ks] = *(const bf16x8*)((const unsigned char*)QT + (16 * i + fr) * 272 + (32 * ks + 8 * q) * 2);
        const unsigned char* KT = lds + KT0 + 4352 * ((i * (i + 1)) / 2);
#pragma unroll
        for (int j = 0; j < 4; ++j) if (j <= i) {
#pragma unroll
            for (int ks = 0; ks < 4; ++ks) { const bf16x8 a = *(const bf16x8*)(KT + (16 * j + fr) * 272 + (32 * ks + 8 * q) * 2); sT[j] = mfma16(a, qfr[ks], sT[j]); }
            if (j == i) {
#pragma unroll
                for (int rg = 0; rg < 4; ++rg) if (4 * q + rg > fr) sT[j][rg] = 0.f;
            }
        }
    }
    f32x4 oacc[4];
#pragma unroll
    for (int vbl = 0; vbl < 4; ++vbl) oacc[vbl] = (f32x4){0.f, 0.f, 0.f, 0.f};
#pragma unroll
    for (int m = 0; m < 2; ++m) if (2 * m <= i) {
        const bf16x8 bfrag = mk8u(cvt_pk_bf16(sT[2 * m][0], sT[2 * m][1]), cvt_pk_bf16(sT[2 * m][2], sT[2 * m][3]), cvt_pk_bf16(sT[2 * m + 1][0], sT[2 * m + 1][1]), cvt_pk_bf16(sT[2 * m + 1][2], sT[2 * m + 1][3]));
#pragma unroll
        for (int vbl = 0; vbl < 4; ++vbl) {
            const unsigned char* base = VTl + (16 * (vh * 4 + vbl) + fr) * 144 + (32 * m + 4 * q) * 2;
            const bf16x8 a = mk8(*(const u32x2*)base, *(const u32x2*)(base + 32));
            oacc[vbl] = mfma16(a, bfrag, oacc[vbl]);
        }
    }
    {
#pragma unroll
        for (int ks = 0; ks < 4; ++ks) {
            const bf16x8 bfr = *(const bf16x8*)((const unsigned char*)QC + (16 * i + fr) * 272 + (32 * ks + 8 * q) * 2);
#pragma unroll
            for (int vbl = 0; vbl < 4; ++vbl) oacc[vbl] = mfma16(stf[ks][vbl], bfr, oacc[vbl]);
        }
    }
    float ss = 0.f;
#pragma unroll
    for (int vbl = 0; vbl < 4; ++vbl) ss += (oacc[vbl][0] * oacc[vbl][0] + oacc[vbl][1] * oacc[vbl][1]) + (oacc[vbl][2] * oacc[vbl][2] + oacc[vbl][3] * oacc[vbl][3]);
    ss += __shfl_xor(ss, 16); ss += __shfl_xor(ss, 32);
    if (q == 0) rmsp[vh * 64 + 16 * i + fr] = ss;
    __syncthreads();
    const float rstd = rsqrtf((rmsp[16 * i + fr] + rmsp[64 + 16 * i + fr]) * (1.0f / 128.0f) + EPS);
#pragma unroll
    for (int vbl = 0; vbl < 4; ++vbl) {
        const int v0 = 16 * (vh * 4 + vbl) + 4 * q;
        u32x2 o;
        o.x = cvt_pk_bf16(oacc[vbl][0] * rstd * gg[vbl][0] * bflo(gt[vbl].x), oacc[vbl][1] * rstd * gg[vbl][1] * bfhi(gt[vbl].x));
        o.y = cvt_pk_bf16(oacc[vbl][2] * rstd * gg[vbl][2] * bflo(gt[vbl].y), oacc[vbl][3] * rstd * gg[vbl][3] * bfhi(gt[vbl].y));
        *(u32x2*)(MIXED + row * 1024 + h * 128 + v0) = o;
    }
    __syncthreads();
  }
}

__device__ __forceinline__ void attn_unit(const bf16_t* __restrict__ XQ, const bf16_t* __restrict__ KX, const bf16_t* __restrict__ VT, bf16_t* __restrict__ ATT, int unit, unsigned char* lds) {
    const int tid = threadIdx.x, w = tid >> 6, lane = tid & 63, r = lane & 31, hh = lane >> 5;
    const int b = unit >> 6, st = (unit >> 2) & 15, h = unit & 3;
    const int row0 = b * SEQ + st * 256;
    const bf16_t* qp = XQ + (size_t)(row0 + 32 * w + r) * 1024 + h * 256 + 8 * hh;
    {
        const bf16_t* kp = KX + (size_t)(b * 256) * 1024 + h * 256;
#pragma unroll
        for (int it = 0; it < 16; ++it) { const int idx = tid + 512 * it, m = idx >> 5, cc = idx & 31;
            const u32x4 v = *(const u32x4*)(kp + (size_t)m * 1024 + cc * 8); *(u32x4*)(lds + m * 528 + cc * 16) = v; }
    }
    __syncthreads();
    f32x16 sacc[8];
#pragma unroll
    for (int mb = 0; mb < 8; ++mb)
#pragma unroll
        for (int e = 0; e < 16; ++e) sacc[mb][e] = 0.f;
    {
        bf16x8 qf[4], qn[4];
#pragma unroll
        for (int k4 = 0; k4 < 4; ++k4) qf[k4] = *(const bf16x8*)(qp + 16 * k4);
#pragma unroll
        for (int kg = 0; kg < 4; ++kg) {
            if (kg < 3) {
#pragma unroll
                for (int k4 = 0; k4 < 4; ++k4) qn[k4] = *(const bf16x8*)(qp + 16 * (4 * (kg + 1) + k4)); }
#pragma unroll
            for (int k4 = 0; k4 < 4; ++k4)
#pragma unroll
                for (int mb = 0; mb < 8; ++mb) { const bf16x8 a = *(const bf16x8*)(lds + (32 * mb + r) * 528 + (16 * (4 * kg + k4) + 8 * hh) * 2); sacc[mb] = mfma32(a, qf[k4], sacc[mb]); }
#pragma unroll
            for (int k4 = 0; k4 < 4; ++k4) qf[k4] = qn[k4];
        }
    }
    float mx = -3.0e38f;
#pragma unroll
    for (int mb = 0; mb < 8; ++mb)
#pragma unroll
        for (int e = 0; e < 16; ++e) mx = fmaxf(mx, sacc[mb][e]);
    mx = fmaxf(mx, __shfl_xor(mx, 32));
    float sum = 0.f;
    bf16x8 pf[8][2];
#pragma unroll
    for (int mb = 0; mb < 8; ++mb) {
        float pv[16];
#pragma unroll
        for (int e = 0; e < 16; ++e) { pv[e] = __expf(sacc[mb][e] - mx); sum += pv[e]; }
#pragma unroll
        for (int s = 0; s < 2; ++s) pf[mb][s] = mk8u(cvt_pk_bf16(pv[8 * s + 0], pv[8 * s + 1]), cvt_pk_bf16(pv[8 * s + 2], pv[8 * s + 3]), cvt_pk_bf16(pv[8 * s + 4], pv[8 * s + 5]), cvt_pk_bf16(pv[8 * s + 6], pv[8 * s + 7]));
    }
    sum += __shfl_xor(sum, 32);
    const float inv = 1.0f / sum;
    __syncthreads();
    {
        const bf16_t* vp = VT + (size_t)(h * 256) * 1024 + b * 256;
#pragma unroll
        for (int it = 0; it < 16; ++it) { const int idx = tid + 512 * it, e = idx >> 5, cc = idx & 31;
            const u32x4 v = *(const u32x4*)(vp + (size_t)e * 1024 + cc * 8);
            u32x2* d = (u32x2*)(lds + e * 520 + cc * 16); d[0] = (u32x2){v.x, v.y}; d[1] = (u32x2){v.z, v.w}; }
    }
    __syncthreads();
    bf16_t* op = ATT + (size_t)(row0 + 32 * w + r) * 1024 + h * 256 + 4 * hh;
#pragma unroll
    for (int half = 0; half < 2; ++half) {
        f32x16 oacc[4];
#pragma unroll
        for (int d = 0; d < 4; ++d)
#pragma unroll
            for (int e = 0; e < 16; ++e) oacc[d][e] = 0.f;
#pragma unroll
        for (int mb = 0; mb < 8; ++mb)
#pragma unroll
            for (int s = 0; s < 2; ++s)
#pragma unroll
                for (int d = 0; d < 4; ++d) {
                    const unsigned char* base = lds + (32 * (half * 4 + d) + r) * 520 + (32 * mb + 16 * s + 4 * hh) * 2;
                    const bf16x8 a = mk8(*(const u32x2*)base, *(const u32x2*)(base + 16));
                    oacc[d] = mfma32(a, pf[mb][s], oacc[d]);
                }
#pragma unroll
        for (int d = 0; d < 4; ++d)
#pragma unroll
            for (int g = 0; g < 4; ++g) {
                u32x2 o; o.x = cvt_pk_bf16(oacc[d][4 * g] * inv, oacc[d][4 * g + 1] * inv); o.y = cvt_pk_bf16(oacc[d][4 * g + 2] * inv, oacc[d][4 * g + 3] * inv);
                *(u32x2*)(op + 32 * (half * 4 + d) + 8 * g) = o;
            }
    }
    __syncthreads();
}

__device__ __forceinline__ void phase_final(const bf16_t* __restrict__ xb, const float* __restrict__ ssq, float* __restrict__ out, const float* __restrict__ g) {
    const int tid = threadIdx.x, sub = tid >> 7, l = tid & 127;
    const f32x4 g0 = *(const f32x4*)(g + 8 * l), g1 = *(const f32x4*)(g + 8 * l + 4);
    for (int r = blockIdx.x * 4 + sub; r < MROWS; r += gridDim.x * 4) {
        const u32x4 v = *(const u32x4*)(xb + (size_t)r * DM + 8 * l);
        const f32x4* pp = (const f32x4*)(ssq + (size_t)r * 16); const f32x4 a = pp[0], b = pp[1], c = pp[2], d = pp[3];
        const float t = ((a[0] + a[1]) + (a[2] + a[3])) + ((b[0] + b[1]) + (b[2] + b[3])) + ((c[0] + c[1]) + (c[2] + c[3])) + ((d[0] + d[1]) + (d[2] + d[3]));
        const float rstd = rsqrtf(t * (1.0f / 1024.0f) + EPS);
        const f32x4 o0 = (f32x4){bflo(v.x), bfhi(v.x), bflo(v.y), bfhi(v.y)} * rstd * g0, o1 = (f32x4){bflo(v.z), bfhi(v.z), bflo(v.w), bfhi(v.w)} * rstd * g1;
        *(f32x4*)(out + (size_t)r * DM + 8 * l) = o0; *(f32x4*)(out + (size_t)r * DM + 8 * l + 4) = o1;
    }
}

#define XB_TMO      128
#define XB_XCNT(j)  (256  + 64 * (j))
#define XB_XSUB(j)  (1280 + 64 * (j))
#define XB_XGEN(j)  (2304 + 64 * (j))
#define XB_TOP      3328
#define XB_TOPGEN   3392
#define XCD_BAR_WORDS 3456
#define XB_SPIN_CAP (1u << 22)
__device__ __forceinline__ unsigned xb_ld(unsigned* p)              { return __hip_atomic_load(p, __ATOMIC_RELAXED, __HIP_MEMORY_SCOPE_AGENT); }
__device__ __forceinline__ unsigned xb_add(unsigned* p, unsigned v) { return __hip_atomic_fetch_add(p, v, __ATOMIC_RELAXED, __HIP_MEMORY_SCOPE_AGENT); }
__device__ __forceinline__ unsigned xb_xcc_id() { return (unsigned)__builtin_amdgcn_s_getreg((3 << 11) | 20) & 0xFu; }
#define XB_SPIN(cond, bar) do { unsigned _sp = 0; while (cond) { __builtin_amdgcn_s_sleep(1); \
    if ((++_sp & 255u) == 0u) { if (xb_ld(&(bar)[XB_TMO])) break; if (_sp > XB_SPIN_CAP) { atomicAdd(&(bar)[XB_TMO], 1u); break; } } } } while (0)
struct XcdBarrier { unsigned* bar; unsigned x; volatile LAS unsigned* st; };
__device__ __forceinline__ XcdBarrier xcd_barrier_post(unsigned* bar, volatile LAS unsigned* st) {
    XcdBarrier b; b.bar = bar; b.x = xb_xcc_id(); b.st = st;
    if (threadIdx.x == 0) (void)xb_add(&bar[XB_XCNT(b.x)], 1u);
    return b;
}
__device__ __forceinline__ void xcd_barrier_complete(unsigned* bar, unsigned x, unsigned& nloc, unsigned& nx) {
    const unsigned G = gridDim.x * gridDim.y * gridDim.z;
    unsigned sum, cnt, mine, sp = 0u;
    for (;;) {
        sum = 0u; cnt = 0u; mine = 0u;
#pragma unroll
        for (unsigned j = 0; j < 16; ++j) { const unsigned c = xb_ld(&bar[XB_XCNT(j)]); sum += c; cnt += (c > 0u) ? 1u : 0u; mine = (j == x) ? c : mine; }
        if (sum == G) break;
        __builtin_amdgcn_s_sleep(1);
        if ((++sp & 255u) == 0u) { if (xb_ld(&bar[XB_TMO])) break; if (sp > XB_SPIN_CAP) { atomicAdd(&bar[XB_TMO], 1u); break; } }
    }
    nloc = mine > 0u ? mine : 1u; nx = cnt > 0u ? cnt : 1u;
}
__device__ __forceinline__ void xcd_barrier(const XcdBarrier& b) {
    asm volatile("s_waitcnt vmcnt(0)" ::: "memory");
    __syncthreads();
    if (threadIdx.x == 0) {
        unsigned* bar = b.bar;
        __builtin_amdgcn_s_waitcnt(0);
        unsigned nloc = b.st[0], nx = b.st[1];
        if (nloc == 0u) { xcd_barrier_complete(bar, b.x, nloc, nx); b.st[0] = nloc; b.st[1] = nx; }
        const unsigned old = xb_add(&bar[XB_XSUB(b.x)], 1u);
        const unsigned gen = old / nloc;
        if (old + 1u == (gen + 1u) * nloc) {
            __builtin_amdgcn_fence(__ATOMIC_RELEASE, "agent");
            asm volatile("s_waitcnt vmcnt(0)" ::: "memory");
            const unsigned og = xb_add(&bar[XB_TOP], 1u);
            const unsigned tg = og / nx;
            if (og + 1u == (tg + 1u) * nx) xb_add(&bar[XB_TOPGEN], 1u);
            else XB_SPIN(xb_ld(&bar[XB_TOPGEN]) == tg, bar);
            __builtin_amdgcn_fence(__ATOMIC_ACQUIRE, "agent");
            asm volatile("s_waitcnt vmcnt(0)" ::: "memory");
        } else {
            XB_SPIN(xb_ld(&bar[XB_TOPGEN]) == gen, bar);
            __builtin_amdgcn_fence(__ATOMIC_ACQUIRE, "agent");
            asm volatile("s_waitcnt vmcnt(0)" ::: "memory");
        }
    }
    __syncthreads();
}

constexpr int N_PHASES = 12;
__global__ void __launch_bounds__(NTHREADS, 2) mega(Params p) {
    extern __shared__ __attribute__((aligned(16))) unsigned char lds[];
    LAS unsigned char* ldsl = (LAS unsigned char*)lds;
    unsigned char* ws = p.ws;
    const int G = gridDim.x, bid = blockIdx.x;
    const int lo = p.ph_lo, hi = p.ph_hi;

#ifndef DEFER_PREP
#define DEFER_PREP 0
#endif
#ifndef FUSE_FINAL
#define FUSE_FINAL 0
#endif
#ifndef DBG_LAST
#define DBG_LAST -1
#endif
#ifndef PHASE_MASK
#define PHASE_MASK 0xfff
#endif
#define IN(k) (((PHASE_MASK >> (k)) & 1) && lo <= (k) && (k) < hi)
    if (threadIdx.x == 0) { ((volatile LAS unsigned*)(ldsl + LDS_MAIN))[0] = 0u; ((volatile LAS unsigned*)(ldsl + LDS_MAIN))[1] = 0u; }
    __syncthreads();
    XcdBarrier xbar; xbar.bar = (unsigned*)(ws + WS_BAR); xbar.x = 0; xbar.st = nullptr;
    if (hi - lo > 1) xbar = xcd_barrier_post((unsigned*)(ws + WS_BAR), (volatile LAS unsigned*)(ldsl + LDS_MAIN));
    if (lo > hi) cg::this_grid().sync();
#define SEAM(k) do { if (IN(k) && IN((k) + 1)) { xcd_barrier(xbar); } } while (0)
    bf16_t* XB = (bf16_t*)(ws + WS_XB); bf16_t* LT = (bf16_t*)(ws + WS_ST);
    bf16_t* QH = (bf16_t*)(ws + WS_QH); bf16_t* KH = (bf16_t*)(ws + WS_KH); bf16_t* VH = (bf16_t*)(ws + WS_VH); bf16_t* GH = (bf16_t*)(ws + WS_GH); bf16_t* PH = (bf16_t*)(ws + WS_PH);
    float* LF = (float*)(ws + WS_LF); bf16_t* ST = (bf16_t*)(ws + WS_ST); bf16_t* MIXED = (bf16_t*)(ws + WS_MIXED);
    float* X1 = (float*)(ws + WS_X1); bf16_t* XQ = (bf16_t*)(ws + WS_XQ); bf16_t* ATT = (bf16_t*)(ws + WS_ATT); bf16_t* U = (bf16_t*)(ws + WS_U);
    float* SSQ = (float*)(ws + WS_SSQ); float* DEC = (float*)(ws + WS_DEC);
    bf16_t* MEMB = (bf16_t*)(ws + WS_MEMB); bf16_t* KX = (bf16_t*)(ws + WS_KX); bf16_t* VT = (bf16_t*)(ws + WS_VT);

    const bool fuse_final = FUSE_FINAL && (G == 256) && IN(10) && (hi - lo > 1);
    if (IN(0)) { phase_prep(p, lds);
#if !DEFER_PREP
        deferred_prep(p, lds, bid, G);
#endif
    }
    SEAM(0);
    if (IN(1)) {
        const pg8::Epi E{0, ws, p.x, p.out, p.lb_logits, p.final_norm_g};
        { pg8::Gemm g{XB, (const bf16_t*)(ws + WS_WT_IN), MROWS, NIN, DM}; pg8::StaticOrder S; S.init(MROWS, NIN, G, bid); pg8::gemm_phase(ldsl, g, S, E); }
        const pg8::Epi E1{1, ws, p.x, p.out, p.lb_logits, p.final_norm_g};
        { pg8::Gemm g{MEMB, (const bf16_t*)(ws + WS_WT_K), MEMROWS, 1024, DM}; pg8::StaticOrder S; S.init(MEMROWS, 1024, G, (bid + 128) % G); pg8::gemm_phase(ldsl, g, S, E1); }
        const pg8::Epi E2{2, ws, p.x, p.out, p.lb_logits, p.final_norm_g};
        { pg8::Gemm g{(const bf16_t*)(ws + WS_WT_V), MEMB, 1024, MEMROWS, DM}; pg8::StaticOrder S; S.init(1024, MEMROWS, G, (bid + 112) % G); pg8::gemm_phase(ldsl, g, S, E2); }
#if DEFER_PREP
        if (G == 256) { if (bid >= 160) deferred_prep(p, lds, bid - 160, 96); }
        else deferred_prep(p, lds, bid, G);
#endif
    }
    SEAM(1);
    if (IN(2)) {
#ifndef DBG_NO_PASSA
        phase_passA(KH, LF, VH, LT, DEC, lds);
#endif
#ifndef DBG_NO_POOL
        for (int t = bid; t < 256; t += G) pool_tile(PH, MIXED, t);
#endif
        fold_pool_weights_mfma(p);
    }
    SEAM(2);
    if (IN(3)) { phase_scan(LT, DEC, ST); }
    SEAM(3);
    if (IN(4)) { phase_passC(QH, KH, LF, VH, GH, ST, p.hgrn_norm_g, MIXED, lds); }
    SEAM(4);
    if (IN(5)) {
        const pg8::Epi E{6, ws, p.x, p.out, p.lb_logits, p.final_norm_g};
        pg8::Gemm g{MIXED, (const bf16_t*)(ws + WS_WT_OUT), MROWS, DM, DM}; pg8::StaticOrder S; S.init(MROWS, DM, G, bid); pg8::gemm_phase(ldsl, g, S, E);
    }
    SEAM(5);
    const bool fuse_attn = (G == 256) && IN(6) && IN(7);
    if (IN(6)) {
        const pg8::Epi E{4, ws, p.x, p.out, p.lb_logits, p.final_norm_g};
        pg8::Gemm g{XB, (const bf16_t*)(ws + WS_WT_Q), MROWS, DM, DM}; pg8::StaticOrder S; S.init(MROWS, DM, G, bid); pg8::gemm_phase(ldsl, g, S, E);
        if (fuse_attn) {
            pg8::Unit u; S.next(0, u);
            asm volatile("s_waitcnt vmcnt(0)" ::: "memory"); __syncthreads();
            attn_unit(XQ, KX, VT, ATT, u.pm * 4 + u.pn, lds);
        }
    }
    if (!fuse_attn) {
        SEAM(6);
        if (IN(7)) { for (int u = bid; u < 256; u += G) attn_unit(XQ, KX, VT, ATT, u, lds); }
    }
    SEAM(7);
    if (IN(8)) {
        const pg8::Epi E{6, ws, p.x, p.out, p.lb_logits, p.final_norm_g};
        pg8::Gemm g{ATT, (const bf16_t*)(ws + WS_WT_O), MROWS, DM, DM}; pg8::StaticOrder S; S.init(MROWS, DM, G, bid); pg8::gemm_phase(ldsl, g, S, E);
    }
    SEAM(8);
    if (IN(9)) {
        const pg8::Epi E{5, ws, p.x, p.out, p.lb_logits, p.final_norm_g};
        pg8::Gemm g{XB, (const bf16_t*)(ws + WS_WT_FF1), MROWS, DFF, DM}; pg8::StaticOrder S; S.init(MROWS, DFF, G, bid); pg8::gemm_phase(ldsl, g, S, E);
    }
    SEAM(9);
    if (IN(10)) {
        const pg8::Epi E{fuse_final ? 8 : 7, ws, p.x, p.out, p.lb_logits, p.final_norm_g};
        pg8::Gemm g{U, (const bf16_t*)(ws + WS_WT_FF2), MROWS, DM, DFF}; pg8::StaticOrder S; S.init(MROWS, DM, G, bid); pg8::gemm_phase(ldsl, g, S, E);
    }
    if (!fuse_final) {
        SEAM(10);
        if (IN(11)) { phase_final(XB, SSQ, p.out, p.final_norm_g); }
    }
#if DBG_LAST >= 0
    cg::this_grid().sync();
    {
        const unsigned* w32 = (const unsigned*)ws;
        for (size_t i = (size_t)bid * NTHREADS + threadIdx.x; i < (size_t)MROWS * DM; i += (size_t)G * NTHREADS) {
            float a = 0.f;
            for (int j = 0; j < 4; ++j) { const unsigned v = w32[i + (size_t)j * MROWS * DM]; a += (float)(v & 0xffffu) + (float)(v >> 16); }
            p.out[i] = a;
        }
    }
#endif
#undef IN
#undef SEAM
}

extern "C" void kernel_launch(void* const* d_in, const int* in_sizes, int n_in, void* d_out, int out_size, void* d_ws, size_t ws_size, hipStream_t stream) {
    static int grid = 0;
    if (grid == 0) {
        if (n_in != 19 || in_sizes[0] != MROWS * DM || out_size != MROWS * DM || ws_size < WS_END) { fprintf(stderr, "kernel_launch: unexpected shapes (n_in %d, ws %zu)\n", n_in, ws_size); grid = -1; return; }
        int dev = 0, cus = 0, per_cu = 0;
        hipGetDevice(&dev); hipDeviceGetAttribute(&cus, hipDeviceAttributeMultiprocessorCount, dev);
        if (hipFuncSetAttribute((const void*)mega, hipFuncAttributeMaxDynamicSharedMemorySize, LDS_BYTES) != hipSuccess) { fprintf(stderr, "kernel_launch: hipFuncSetAttribute failed\n"); grid = -1; return; }
        if (hipOccupancyMaxActiveBlocksPerMultiprocessor(&per_cu, (const void*)mega, NTHREADS, LDS_BYTES) != hipSuccess || per_cu < 1) { fprintf(stderr, "kernel_launch: occupancy query says %d\n", per_cu); per_cu = 1; }
        (void)hipGetLastError();
        grid = cus * 1;
        if (grid > cus * per_cu) grid = cus * per_cu;
    }
    if (grid < 0) return;
    if (hipMemsetAsync((char*)d_ws + WS_BAR, 0, 32768, stream) != hipSuccess) { fprintf(stderr, "kernel_launch: memset of barrier words failed\n"); return; }
    Params p{};
    const float** f = (const float**)&p;
    for (int i = 0; i < 19; ++i) f[i] = (const float*)d_in[i];
    p.out = (float*)d_out; p.ws = (unsigned char*)d_ws;
#if N_LAUNCH_MODE == 1
    p.ph_lo = 0; p.ph_hi = (DBG_LAST >= 0) ? DBG_LAST + 1 : N_PHASES;
    void* args[] = {&p};
    hipError_t e = hipLaunchCooperativeKernel((const void*)mega, dim3(grid), dim3(NTHREADS), args, LDS_BYTES, stream);
    if (e != hipSuccess) fprintf(stderr, "kernel_launch: cooperative launch failed: %s (grid %d)\n", hipGetErrorString(e), grid);
#else
    for (int k = 0; k < N_PHASES; ++k) { p.ph_lo = k; p.ph_hi = k + 1; hipLaunchKernelGGL(mega, dim3(grid), dim3(NTHREADS), LDS_BYTES, stream, p); }
#endif
}
```

```cpp
#include <hip/hip_runtime.h>
#include <hip/hip_cooperative_groups.h>
#include <cstdio>
namespace cg = cooperative_groups;

#ifndef N_LAUNCH_MODE
#define N_LAUNCH_MODE 1
#endif

typedef unsigned short bf16_t;
typedef short bf16x8 __attribute__((ext_vector_type(8)));
typedef float f32x2 __attribute__((ext_vector_type(2)));
typedef float f32x4 __attribute__((ext_vector_type(4)));
typedef float f32x16 __attribute__((ext_vector_type(16)));
typedef unsigned u32x2 __attribute__((ext_vector_type(2)));
typedef unsigned u32x4 __attribute__((ext_vector_type(4)));
#define LAS __attribute__((address_space(3)))

constexpr int MROWS = 16384, DM = 1024, SEQ = 4096, NIN = 2560, DFF = 4096, MEMROWS = 1024;
constexpr float EPS = 1e-6f;
constexpr int NTHREADS = 512;
constexpr int LDS_MAIN = 135168;
constexpr int LDS_BYTES = LDS_MAIN + 16;

constexpr size_t MiB = 1u << 20;
constexpr size_t WS_WT_IN = 0, WS_WT_K = 5 * MiB, WS_WT_V = 7 * MiB, WS_WT_OUT = 9 * MiB, WS_WT_Q = 11 * MiB, WS_WT_O = 13 * MiB,
                 WS_WT_FF1 = 15 * MiB, WS_WT_FF2 = 23 * MiB, WS_MEMB = 31 * MiB, WS_KX = 33 * MiB, WS_VT = 35 * MiB, WS_SSQ = 37 * MiB,
                 WS_BAR = 39 * MiB, WS_CNT = 39 * MiB + 16384, WS_RSTD0 = 38 * MiB, WS_RSTDM = 38 * MiB + 65536, WS_DEC = 38 * MiB + 131072,
                 WS_XB = 40 * MiB  , WS_QH = 72 * MiB, WS_KH = 88 * MiB, WS_VH = 104 * MiB, WS_GH = 120 * MiB, WS_PH = 136 * MiB,
                 WS_LF = 152 * MiB, WS_ST = 184 * MiB, WS_MIXED = 216 * MiB,
                 WS_X1 = 72 * MiB, WS_XQ = 136 * MiB, WS_ATT = 168 * MiB, WS_U = 72 * MiB, WS_END = 256 * MiB;

typedef __bf16 bf16x2n __attribute__((ext_vector_type(2)));
__device__ __forceinline__ unsigned cvt_pk_bf16(float lo, float hi) { f32x2 v = {lo, hi}; return __builtin_bit_cast(unsigned, __builtin_convertvector(v, bf16x2n)); }
__device__ __forceinline__ bf16_t f2bf(float f) { return (bf16_t)(cvt_pk_bf16(f, 0.f) & 0xffffu); }
__device__ __forceinline__ float bf2f(bf16_t b) { return __uint_as_float(((unsigned)b) << 16); }
__device__ __forceinline__ float bflo(unsigned u) { return __uint_as_float(u << 16); }
__device__ __forceinline__ float bfhi(unsigned u) { return __uint_as_float(u & 0xffff0000u); }
__device__ __forceinline__ f32x4 mfma16(bf16x8 a, bf16x8 b, f32x4 c) { return __builtin_amdgcn_mfma_f32_16x16x32_bf16(a, b, c, 0, 0, 0); }
__device__ __forceinline__ f32x16 mfma32(bf16x8 a, bf16x8 b, f32x16 c) { return __builtin_amdgcn_mfma_f32_32x32x16_bf16(a, b, c, 0, 0, 0); }
__device__ __forceinline__ bf16x8 mk8(u32x2 lo, u32x2 hi) { u32x4 t; t.x = lo.x; t.y = lo.y; t.z = hi.x; t.w = hi.y; return __builtin_bit_cast(bf16x8, t); }
__device__ __forceinline__ bf16x8 mk8u(unsigned a, unsigned b, unsigned c, unsigned d) { u32x4 t; t.x = a; t.y = b; t.z = c; t.w = d; return __builtin_bit_cast(bf16x8, t); }
__device__ __forceinline__ float sigmoidf_(float z) { return __builtin_amdgcn_rcpf(1.0f + __expf(-z)); }

namespace pg8 {
constexpr int BM = 256, BK = 64, HALF = 128, HTB = HALF * BK * 2, STAGE_BYTES = 8 * HTB, NXCD = 8, WGM = 8;
__device__ __forceinline__ int lds_byte(int r, int c) { const int st = (r >> 4) * 2 + (c >> 5), rr = r & 15, cc = c & 31, ob = rr * 64 + cc * 2; return st * 1024 + (ob ^ (((ob >> 9) & 1) << 5)); }
__device__ __forceinline__ void stage_rc(int b, int& R, int& C) { const int st = b / 1024, sb = b % 1024, swz = sb ^ (((sb >> 9) & 1) << 5); R = (st >> 1) * 16 + swz / 64; C = (st & 1) * 32 + (swz % 64) / 2; }
__device__ __forceinline__ int perm32(int rho) { const int n = rho >> 4, i = rho & 15; return 8 * (i >> 2) + 4 * n + (i & 3); }
struct Unit { int pm, pn; };
struct Gemm { const bf16_t* A; const bf16_t* Bt; int M, N, K; };
struct StaticOrder {
    int nM, nN, nwg, G, c;
    __device__ __forceinline__ void init(int M, int N, int G_, int c_) { nM = M / BM; nN = N / BM; nwg = nM * nN; G = G_; c = c_; }
    __device__ __forceinline__ bool next(int i, Unit& u) const {
        const long L = (long)i * G + c; if (L >= nwg) return false;
        int wgid = (int)L; { const int q = nwg / NXCD, r = nwg % NXCD, xcd = wgid % NXCD, off = wgid / NXCD; wgid = (xcd < r ? xcd * (q + 1) : r * (q + 1) + (xcd - r) * q) + off; }
        const int nig = WGM * nN, gid = wgid / nig, fm = gid * WGM, gsz = (nM - fm) < WGM ? (nM - fm) : WGM;
        u.pm = fm + ((wgid % nig) % gsz); u.pn = (wgid % nig) / gsz; return true;
    }
};

struct Epi {
    static constexpr bool PERM = true;
    int mode;
    unsigned char* ws; const float* x; float* out; const float* lbl; const float* gfin;
    __device__ __forceinline__ void store8(bf16_t* p, const f32x4& v0, const f32x4& v1) const {
        u32x4 w; w.x = cvt_pk_bf16(v0[0], v0[1]); w.y = cvt_pk_bf16(v0[2], v0[3]); w.z = cvt_pk_bf16(v1[0], v1[1]); w.w = cvt_pk_bf16(v1[2], v1[3]); *(u32x4*)p = w; }
    __device__ __forceinline__ void fused(f32x4 (&acc)[2][2][4][2], const Unit& u, int wr, int wc, int fr, int fq) const {
        const int row0 = u.pm * BM + wr * 64 + fr;
        const int col0 = u.pn * BM + wc * 32 + 8 * fq;
        const bf16_t* xb = (const bf16_t*)(ws + WS_XB);
        unsigned* sq = (unsigned*)(ws + WS_SSQ);
        unsigned* cnt = (unsigned*)(ws + WS_CNT) + 64 * u.pm;
        u32x4 bc[2], bn[2];
        { const size_t o = (size_t)row0 * DM + col0; bc[0] = *(const u32x4*)(xb + o); bc[1] = *(const u32x4*)(xb + o + HALF); }
#pragma unroll
        for (int gidx = 0; gidx < 8; ++gidx) { const int ai = gidx >> 2, m = gidx & 3; const int row = row0 + ai * HALF + m * 16;
            if (gidx < 7) { const int g2 = gidx + 1; const size_t o2 = (size_t)(row0 + (g2 >> 2) * HALF + (g2 & 3) * 16) * DM + col0; bn[0] = *(const u32x4*)(xb + o2); bn[1] = *(const u32x4*)(xb + o2 + HALF); }
            float ss = 0.f;
#pragma unroll
            for (int bj = 0; bj < 2; ++bj) { const u32x4 bb = bc[bj];
                const f32x4 v0 = acc[ai][bj][m][0] + (f32x4){bflo(bb.x), bfhi(bb.x), bflo(bb.y), bfhi(bb.y)}, v1 = acc[ai][bj][m][1] + (f32x4){bflo(bb.z), bfhi(bb.z), bflo(bb.w), bfhi(bb.w)};
                acc[ai][bj][m][0] = v0; acc[ai][bj][m][1] = v1;
                ss += (v0[0] * v0[0] + v0[1] * v0[1]) + (v0[2] * v0[2] + v0[3] * v0[3]) + (v1[0] * v1[0] + v1[1] * v1[1]) + (v1[2] * v1[2] + v1[3] * v1[3]); }
            ss += __shfl_xor(ss, 16); ss += __shfl_xor(ss, 32);
            if (fq == 0) __hip_atomic_store(sq + (size_t)row * 16 + u.pn * 4 + wc, __float_as_uint(ss), __ATOMIC_RELAXED, __HIP_MEMORY_SCOPE_AGENT);
            bc[0] = bn[0]; bc[1] = bn[1]; }
        asm volatile("s_waitcnt vmcnt(0)" ::: "memory");
        if ((threadIdx.x & 63) == 0) __hip_atomic_fetch_add(cnt, 1u, __ATOMIC_RELAXED, __HIP_MEMORY_SCOPE_AGENT);
        f32x4 gv[2][2];
#pragma unroll
        for (int bj = 0; bj < 2; ++bj) { gv[bj][0] = *(const f32x4*)(gfin + col0 + bj * HALF); gv[bj][1] = *(const f32x4*)(gfin + col0 + bj * HALF + 4); }
        { unsigned spins = 0; while ((unsigned)__builtin_amdgcn_readfirstlane(__hip_atomic_load(cnt, __ATOMIC_RELAXED, __HIP_MEMORY_SCOPE_AGENT)) < 32u) { __builtin_amdgcn_s_sleep(1); if (++spins > (1u << 22)) break; } }
        __builtin_amdgcn_fence(__ATOMIC_ACQUIRE, "agent");
        asm volatile("s_waitcnt vmcnt(0)" ::: "memory");
        f32x4 pv[8];
#pragma unroll
        for (int gidx = 0; gidx < 8; ++gidx) pv[gidx] = *(const f32x4*)((const float*)sq + (size_t)(row0 + (gidx >> 2) * HALF + (gidx & 3) * 16) * 16 + 4 * fq);
#pragma unroll
        for (int gidx = 0; gidx < 8; ++gidx) { const int ai = gidx >> 2, m = gidx & 3; const int row = row0 + ai * HALF + m * 16;
            float t = (pv[gidx][0] + pv[gidx][1]) + (pv[gidx][2] + pv[gidx][3]); t += __shfl_xor(t, 16); t += __shfl_xor(t, 32);
            const float rstd = rsqrtf(t * (1.0f / 1024.0f) + EPS);
            const size_t o = (size_t)row * DM + col0;
#pragma unroll
            for (int bj = 0; bj < 2; ++bj) { *(f32x4*)(out + o + bj * HALF) = acc[ai][bj][m][0] * rstd * gv[bj][0]; *(f32x4*)(out + o + bj * HALF + 4) = acc[ai][bj][m][1] * rstd * gv[bj][1]; } }
    }
    template <class Sched>
    __device__ __forceinline__ bool prefill(LAS unsigned char* lds, const Sched& S) const {
        if (!(mode == 0 || mode == 1 || mode == 4 || mode == 5) || S.nwg > 4 * S.G) return false;
        const int tid = threadIdx.x, rr = tid & 255;
#pragma unroll
        for (int k = 0; k < 2; ++k) { const int ui = (tid >> 8) + 2 * k; Unit u;
            if (S.next(ui, u)) { const int row = u.pm * BM + rr; float r;
                if (mode == 4 || mode == 5) { const f32x4* pp = (const f32x4*)((const float*)(ws + WS_SSQ) + (size_t)row * 16); const f32x4 a = pp[0], b = pp[1], c = pp[2], d = pp[3];
                    const float t = ((a[0] + a[1]) + (a[2] + a[3])) + ((b[0] + b[1]) + (b[2] + b[3])) + ((c[0] + c[1]) + (c[2] + c[3])) + ((d[0] + d[1]) + (d[2] + d[3]));
                    r = rsqrtf(t * (1.0f / 1024.0f) + EPS) * (mode == 4 ? 0.0625f : 1.0f); }
                else r = ((const float*)(ws + (mode == 0 ? WS_RSTD0 : WS_RSTDM)))[row];
                *(LAS float*)(lds + STAGE_BYTES + (ui * 256 + rr) * 4) = r; } }
        return true;
    }
    __device__ __forceinline__ void operator()(const f32x4 (&acc)[2][2][4][2], const Unit& u, int ui, bool tab, LAS unsigned char* lds, int wr, int wc, int fr, int fq) const {
        const int row0 = u.pm * BM + wr * 64 + fr;
        const int colL = wc * 32 + 8 * fq;
        if (mode == 3 || mode == 6 || mode == 7) {
            const int col0 = u.pn * BM + colL;
            bf16_t* xb = (bf16_t*)(ws + WS_XB);
            float* ssq = (float*)(ws + WS_SSQ);
            f32x4 rc[4], rn[4];
            u32x4 bc[2], bn[2];
            if (mode == 3) { const size_t o = (size_t)row0 * DM + col0; rc[0] = *(const f32x4*)(x + o); rc[1] = *(const f32x4*)(x + o + 4); rc[2] = *(const f32x4*)(x + o + HALF); rc[3] = *(const f32x4*)(x + o + HALF + 4); }
            else { const size_t o = (size_t)row0 * DM + col0; bc[0] = *(const u32x4*)(xb + o); bc[1] = *(const u32x4*)(xb + o + HALF); }
#pragma unroll
            for (int gidx = 0; gidx < 8; ++gidx) { const int ai = gidx >> 2, m = gidx & 3; const int row = row0 + ai * HALF + m * 16;
                if (gidx < 7) { const int g2 = gidx + 1; const size_t o2 = (size_t)(row0 + (g2 >> 2) * HALF + (g2 & 3) * 16) * DM + col0;
                    if (mode == 3) { rn[0] = *(const f32x4*)(x + o2); rn[1] = *(const f32x4*)(x + o2 + 4); rn[2] = *(const f32x4*)(x + o2 + HALF); rn[3] = *(const f32x4*)(x + o2 + HALF + 4); }
                    else { bn[0] = *(const u32x4*)(xb + o2); bn[1] = *(const u32x4*)(xb + o2 + HALF); } }
                if (mode != 3) {
#pragma unroll
                    for (int bj = 0; bj < 2; ++bj) { rc[2 * bj] = (f32x4){bflo(bc[bj].x), bfhi(bc[bj].x), bflo(bc[bj].y), bfhi(bc[bj].y)}; rc[2 * bj + 1] = (f32x4){bflo(bc[bj].z), bfhi(bc[bj].z), bflo(bc[bj].w), bfhi(bc[bj].w)}; } }
                float ss = 0.f;
#pragma unroll
                for (int bj = 0; bj < 2; ++bj) { const size_t o = (size_t)row * DM + col0 + bj * HALF;
                    const f32x4 v0 = acc[ai][bj][m][0] + rc[2 * bj], v1 = acc[ai][bj][m][1] + rc[2 * bj + 1];
                    store8(xb + o, v0, v1);
                    ss += (v0[0] * v0[0] + v0[1] * v0[1]) + (v0[2] * v0[2] + v0[3] * v0[3]) + (v1[0] * v1[0] + v1[1] * v1[1]) + (v1[2] * v1[2] + v1[3] * v1[3]); }
                ss += __shfl_xor(ss, 16); ss += __shfl_xor(ss, 32);
                if (fq == 0) ssq[(size_t)row * 16 + u.pn * 4 + wc] = ss;
#pragma unroll
                for (int k = 0; k < 4; ++k) rc[k] = rn[k];
                bc[0] = bn[0]; bc[1] = bn[1]; }
            return;
        }
        if (mode == 2) {
            const int col0 = u.pn * BM + colL;
            const float* rs = (const float*)(ws + WS_RSTDM); bf16_t* ob = (bf16_t*)(ws + WS_VT); const int ldo = 1024;
            f32x4 c0[2], c1[2];
#pragma unroll
            for (int bj = 0; bj < 2; ++bj) { c0[bj] = *(const f32x4*)(rs + col0 + bj * HALF); c1[bj] = *(const f32x4*)(rs + col0 + bj * HALF + 4); }
#pragma unroll
            for (int ai = 0; ai < 2; ++ai)
#pragma unroll
                for (int m = 0; m < 4; ++m) { const int row = row0 + ai * HALF + m * 16;
#pragma unroll
                    for (int bj = 0; bj < 2; ++bj) store8(ob + (size_t)row * ldo + col0 + bj * HALF, acc[ai][bj][m][0] * c0[bj], acc[ai][bj][m][1] * c1[bj]); }
            return;
        }
        float rsc[8];
        if (tab) {
#pragma unroll
            for (int gidx = 0; gidx < 8; ++gidx) rsc[gidx] = *(const LAS float*)(lds + STAGE_BYTES + (ui * 256 + wr * 64 + fr + (gidx >> 2) * HALF + (gidx & 3) * 16) * 4);
        } else if (mode == 4 || mode == 5) {
            const float* sq = (const float*)(ws + WS_SSQ);
            f32x4 pv[8];
#pragma unroll
            for (int gidx = 0; gidx < 8; ++gidx) pv[gidx] = *(const f32x4*)(sq + (size_t)(row0 + (gidx >> 2) * HALF + (gidx & 3) * 16) * 16 + 4 * fq);
            const float cs = mode == 4 ? 0.0625f : 1.0f;
#pragma unroll
            for (int gidx = 0; gidx < 8; ++gidx) { float t = (pv[gidx][0] + pv[gidx][1]) + (pv[gidx][2] + pv[gidx][3]); t += __shfl_xor(t, 16); t += __shfl_xor(t, 32); rsc[gidx] = rsqrtf(t * (1.0f / 1024.0f) + EPS) * cs; }
        } else {
            const float* rs = (const float*)(ws + (mode == 0 ? WS_RSTD0 : WS_RSTDM));
#pragma unroll
            for (int gidx = 0; gidx < 8; ++gidx) rsc[gidx] = rs[row0 + (gidx >> 2) * HALF + (gidx & 3) * 16];
        }
        if (mode == 0) {
            float* lf = (float*)(ws + WS_LF);
            const int sub = u.pn >> 1; const int cb = (u.pn & 1) * 256 + colL;
            if (sub == 1) {
                float oml[2][8];
#pragma unroll
                for (int bj = 0; bj < 2; ++bj)
#pragma unroll
                    for (int j = 0; j < 8; ++j) { const int c = cb + bj * HALF + j; const float l0 = lbl[c], l1 = lbl[512 + c]; const float lb = 1.0f / (1.0f + __expf(l1 - l0)); oml[bj][j] = 1.0f - lb; }
#pragma unroll
                for (int ai = 0; ai < 2; ++ai)
#pragma unroll
                    for (int m = 0; m < 4; ++m) { const int row = row0 + ai * HALF + m * 16; const float r = rsc[ai * 4 + m];
#pragma unroll
                        for (int bj = 0; bj < 2; ++bj) { f32x4 lf0, lf1;
#pragma unroll
                            for (int j = 0; j < 4; ++j) {
                                const float za = acc[ai][bj][m][0][j] * r, zb = acc[ai][bj][m][1][j] * r;
                                const float ka = oml[bj][j] * (1.0f - sigmoidf_(za)), kb = oml[bj][4 + j] * (1.0f - sigmoidf_(zb));
                                lf0[j] = __logf(1.0f - ka); lf1[j] = __logf(1.0f - kb); }
                            const size_t o = (size_t)row * 512 + cb + bj * HALF;
                            *(f32x4*)(lf + o) = lf0; *(f32x4*)(lf + o + 4) = lf1; } }
            } else {
                bf16_t* dst = (bf16_t*)(ws + (sub == 0 ? WS_QH : (sub == 2 ? WS_VH : (sub == 3 ? WS_GH : WS_PH))));
                const bool act = (sub == 0) || (sub == 3);
#pragma unroll
                for (int ai = 0; ai < 2; ++ai)
#pragma unroll
                    for (int m = 0; m < 4; ++m) { const int row = row0 + ai * HALF + m * 16; const float r = rsc[ai * 4 + m];
#pragma unroll
                        for (int bj = 0; bj < 2; ++bj) { f32x4 v0 = acc[ai][bj][m][0] * r, v1 = acc[ai][bj][m][1] * r;
                            if (act) {
#pragma unroll
                                for (int j = 0; j < 4; ++j) { v0[j] = v0[j] * sigmoidf_(v0[j]); v1[j] = v1[j] * sigmoidf_(v1[j]); } }
                            store8(dst + (size_t)row * 512 + cb + bj * HALF, v0, v1); } }
            }
        } else {
            const int col0 = u.pn * BM + colL;
            bf16_t* ob = (bf16_t*)(ws + (mode == 1 ? WS_KX : (mode == 4 ? WS_XQ : WS_U))); const int ldo = mode == 5 ? DFF : 1024;
#pragma unroll
            for (int ai = 0; ai < 2; ++ai)
#pragma unroll
                for (int m = 0; m < 4; ++m) { const int row = row0 + ai * HALF + m * 16; const float r = rsc[ai * 4 + m];
#pragma unroll
                    for (int bj = 0; bj < 2; ++bj) { f32x4 v0 = acc[ai][bj][m][0] * r, v1 = acc[ai][bj][m][1] * r;
                        if (mode == 5) {
#pragma unroll
                            for (int j = 0; j < 4; ++j) { const float a = fmaxf(v0[j], 0.f), b = fmaxf(v1[j], 0.f); v0[j] = a * a; v1[j] = b * b; } }
                        store8(ob + (size_t)row * ldo + col0 + bj * HALF, v0, v1); } }
        }
    }
};

template <class EpiT, class Sched>
__device__ __forceinline__ void gemm_phase(LAS unsigned char* lds, const Gemm g, const Sched S, const EpiT E) {
    const int tid = threadIdx.x, wid = __builtin_amdgcn_readfirstlane(tid >> 6), lane = tid & 63, wr = wid >> 2, wc = wid & 3, fr = lane & 15, fq = lane >> 4;
    const int K = g.K, nt = K / BK;
    unsigned voffA[2], voffB[2];
#pragma unroll
    for (int i = 0; i < 2; ++i) { int R, C; stage_rc(tid * 16 + i * 8192, R, C); const int Rb = EpiT::PERM ? ((R & ~31) + perm32(R & 31)) : R;
        voffA[i] = (unsigned)(R * K + C) * 2u; voffB[i] = (unsigned)(Rb * K + C) * 2u; }
    const size_t kstep = (size_t)(BK * 2);
    const size_t hstep = (size_t)HALF * K * 2;
    const size_t tstep = 2 * hstep;
    const unsigned ldsw = (unsigned)wid * 1024u;
    const int aoff = lds_byte(wr * 64 + fr, fq * 8), boff = lds_byte(wc * 32 + fr, fq * 8);
#define PG8_SA(b, h) (((b) * 2 + (h)) * HTB)
#define PG8_SB(b, h) ((4 + (b) * 2 + (h)) * HTB)
#define PG8_STAGE(bufoff, gbase, voff) do { _Pragma("unroll") for (int _i = 0; _i < 2; ++_i) \
        __builtin_amdgcn_global_load_lds((const unsigned*)((const char*)(gbase) + (voff)[_i]), (LAS unsigned*)(lds + (bufoff) + ldsw + _i * 8192), 16, 0, 0); } while (0)
#define PG8_LDA(dst, b, h) do { _Pragma("unroll") for (int m = 0; m < 4; ++m) _Pragma("unroll") for (int k = 0; k < 2; ++k) dst[m][k] = *(const LAS bf16x8*)(lds + PG8_SA(b, h) + aoff + m * 2048 + k * 1024); } while (0)
#define PG8_LDB(dst, b, h) do { _Pragma("unroll") for (int n = 0; n < 2; ++n) _Pragma("unroll") for (int k = 0; k < 2; ++k) dst[n][k] = *(const LAS bf16x8*)(lds + PG8_SB(b, h) + boff + n * 2048 + k * 1024); } while (0)
#define PG8_MMA(ai, bj, At, Bt) do { __builtin_amdgcn_s_setprio(1); _Pragma("unroll") for (int m = 0; m < 4; ++m) _Pragma("unroll") for (int n = 0; n < 2; ++n) _Pragma("unroll") for (int k = 0; k < 2; ++k) \
        acc[ai][bj][m][n] = __builtin_amdgcn_mfma_f32_16x16x32_bf16(Bt[n][k], At[m][k], acc[ai][bj][m][n], 0, 0, 0); __builtin_amdgcn_s_setprio(0); } while (0)
#define PG8_WAIT_V(n) asm volatile("s_waitcnt vmcnt(" #n ")" ::: "memory")
#define PG8_WAIT_L(n) asm volatile("s_waitcnt lgkmcnt(" #n ")" ::: "memory")
#define PG8_BAR __builtin_amdgcn_s_barrier()
#define PG8_SCHED __builtin_amdgcn_sched_barrier(0)
    Unit cur, nxt; int ui = 0;
    if (!S.next(0, cur)) return;
    const bool tab = E.prefill(lds, S);
    if (tab) __syncthreads();
    f32x4 acc[2][2][4][2];
#pragma unroll
    for (int a = 0; a < 2; ++a)
#pragma unroll
        for (int b = 0; b < 2; ++b)
#pragma unroll
            for (int m = 0; m < 4; ++m)
#pragma unroll
                for (int n = 0; n < 2; ++n) acc[a][b][m][n] = (f32x4){0.f, 0.f, 0.f, 0.f};
    bf16x8 At[4][2], B0[2][2], B1[2][2];
    const char* cA = (const char*)g.A + (size_t)cur.pm * tstep; const char* cB = (const char*)g.Bt + (size_t)cur.pn * tstep;
    PG8_STAGE(PG8_SB(0, 0), cB, voffB); PG8_STAGE(PG8_SA(0, 0), cA, voffA); PG8_STAGE(PG8_SB(0, 1), cB + hstep, voffB); PG8_STAGE(PG8_SA(0, 1), cA + hstep, voffA);
    if (wr == 1) PG8_BAR;
    PG8_WAIT_V(4); PG8_BAR;
    PG8_STAGE(PG8_SB(1, 0), cB + kstep, voffB); PG8_STAGE(PG8_SA(1, 0), cA + kstep, voffA); PG8_STAGE(PG8_SB(1, 1), cB + hstep + kstep, voffB);
    PG8_WAIT_V(6); PG8_BAR;
    for (;;) {
        const bool has_next = S.next(ui + 1, nxt);
        const char* nA = has_next ? (const char*)g.A + (size_t)nxt.pm * tstep : cA; const char* nB = has_next ? (const char*)g.Bt + (size_t)nxt.pn * tstep : cB;
        for (int t = 0; t < nt; t += 2) {
            const bool last = (t == nt - 2);
            const char* a1 = cA + (size_t)(t + 1) * kstep;
            const char* a2 = last ? nA : cA + (size_t)(t + 2) * kstep; const char* b2 = last ? nB : cB + (size_t)(t + 2) * kstep;
            const char* a3 = a2 + kstep; const char* b3 = b2 + kstep;
            PG8_LDB(B0, 0, 0); PG8_SCHED; PG8_LDA(At, 0, 0); PG8_STAGE(PG8_SA(1, 1), a1 + hstep, voffA);
            PG8_WAIT_L(8); PG8_BAR; PG8_WAIT_L(0); PG8_MMA(0, 0, At, B0); PG8_BAR; PG8_SCHED;
            PG8_LDB(B1, 0, 1); PG8_STAGE(PG8_SB(0, 0), b2, voffB);
            PG8_BAR; PG8_WAIT_L(0); PG8_MMA(0, 1, At, B1); PG8_BAR;
            PG8_LDA(At, 0, 1); PG8_STAGE(PG8_SA(0, 0), a2, voffA);
            PG8_BAR; PG8_WAIT_L(0); PG8_MMA(1, 0, At, B0); PG8_BAR; PG8_SCHED;
            PG8_STAGE(PG8_SB(0, 1), b2 + hstep, voffB);
            PG8_WAIT_V(6); PG8_BAR; PG8_MMA(1, 1, At, B1); PG8_BAR;
            PG8_LDB(B0, 1, 0); PG8_SCHED; PG8_LDA(At, 1, 0); PG8_STAGE(PG8_SA(0, 1), a2 + hstep, voffA);
            PG8_WAIT_L(8); PG8_BAR; PG8_WAIT_L(0); PG8_MMA(0, 0, At, B0); PG8_BAR; PG8_SCHED;
            PG8_LDB(B1, 1, 1); PG8_STAGE(PG8_SB(1, 0), b3, voffB);
            PG8_BAR; PG8_WAIT_L(0); PG8_MMA(0, 1, At, B1); PG8_BAR;
            PG8_LDA(At, 1, 1); PG8_STAGE(PG8_SA(1, 0), a3, voffA);
            PG8_BAR; PG8_WAIT_L(0); PG8_MMA(1, 0, At, B0); PG8_BAR; PG8_SCHED;
            PG8_STAGE(PG8_SB(1, 1), b3 + hstep, voffB);
            PG8_WAIT_V(6); PG8_BAR; PG8_MMA(1, 1, At, B1); PG8_BAR;
        }
        if (E.mode != 8) E(acc, cur, ui, tab, lds, wr, wc, fr, fq);
        __builtin_amdgcn_s_waitcnt(0x0F70);
        if (!has_next) break;
#pragma unroll
        for (int a = 0; a < 2; ++a)
#pragma unroll
            for (int b = 0; b < 2; ++b)
#pragma unroll
                for (int m = 0; m < 4; ++m)
#pragma unroll
                    for (int n = 0; n < 2; ++n) acc[a][b][m][n] = (f32x4){0.f, 0.f, 0.f, 0.f};
        cur = nxt; cA = nA; cB = nB; ++ui;
    }
    PG8_WAIT_V(0);
    if (wr == 0) PG8_BAR;
    PG8_BAR;
    if (E.mode == 8) E.fused(acc, cur, wr, wc, fr, fq);
#undef PG8_SA
#undef PG8_SB
#undef PG8_STAGE
#undef PG8_LDA
#undef PG8_LDB
#undef PG8_MMA
#undef PG8_WAIT_V
#undef PG8_WAIT_L
#undef PG8_BAR
#undef PG8_SCHED
}
}

struct Params {
    const float *x, *mem, *norm_mix_g, *w_in, *lb_logits, *hgrn_norm_g, *w_pool, *pool_scale, *w_out, *norm_x_g, *norm_mem_g, *w_xq, *w_xk, *w_xv, *w_xo, *norm_ffn_g, *w_ff1, *w_ff2, *final_norm_g;
    float* out; unsigned char* ws;
    int ph_lo, ph_hi;
};

struct TD { const float* W; const float* g; bf16_t* out; int N, ldo, kt, nt; };
__device__ __forceinline__ TD tile_desc(const Params& p, int t) {
    unsigned char* ws = p.ws; TD d;
    if (t < 320)       { d.W = p.w_in;  d.g = p.norm_mix_g; d.out = (bf16_t*)(ws + WS_WT_IN);  d.N = NIN;  d.ldo = 1024; d.kt = t / 40; d.nt = t % 40; }
    else if (t < 448)  { const int u = t - 320;  d.W = p.w_xk;  d.g = p.norm_mem_g; d.out = (bf16_t*)(ws + WS_WT_K);   d.N = 1024; d.ldo = 1024; d.kt = u / 16; d.nt = u % 16; }
    else if (t < 576)  { const int u = t - 448;  d.W = p.w_xv;  d.g = p.norm_mem_g; d.out = (bf16_t*)(ws + WS_WT_V);   d.N = 1024; d.ldo = 1024; d.kt = u / 16; d.nt = u % 16; }
    else if (t < 704)  { const int u = t - 576;  d.W = p.w_xq;  d.g = p.norm_x_g;   d.out = (bf16_t*)(ws + WS_WT_Q);   d.N = 1024; d.ldo = 1024; d.kt = u / 16; d.nt = u % 16; }
    else if (t < 832)  { const int u = t - 704;  d.W = p.w_xo;  d.g = nullptr;      d.out = (bf16_t*)(ws + WS_WT_O);   d.N = 1024; d.ldo = 1024; d.kt = u / 16; d.nt = u % 16; }
    else if (t < 960)  { const int u = t - 832;  d.W = p.w_out; d.g = nullptr;      d.out = (bf16_t*)(ws + WS_WT_OUT); d.N = 1024; d.ldo = 1024; d.kt = u / 16; d.nt = u % 16; }
    else if (t < 1472) { const int u = t - 960;  d.W = p.w_ff1; d.g = p.norm_ffn_g; d.out = (bf16_t*)(ws + WS_WT_FF1); d.N = DFF;  d.ldo = 1024; d.kt = u / 64; d.nt = u % 64; }
    else               { const int u = t - 1472; d.W = p.w_ff2; d.g = nullptr;      d.out = (bf16_t*)(ws + WS_WT_FF2); d.N = 1024; d.ldo = 4096; d.kt = u / 16; d.nt = u % 16; }
    return d;
}
__device__ __forceinline__ void tile_load(const TD& d, f32x4 (&v)[4], float (&sc)[4]) {
    const int tid = threadIdx.x, r = tid >> 4, c4 = tid & 15;
#pragma unroll
    for (int i = 0; i < 4; ++i) { const int k = 128 * d.kt + r + 32 * i; v[i] = __builtin_nontemporal_load((const f32x4*)(d.W + (size_t)k * d.N + 64 * d.nt + 4 * c4)); sc[i] = d.g ? d.g[k] : 1.0f; }
}
__device__ __forceinline__ void transpose_range(const Params& p, unsigned char* lds, int t_begin, int t_end, int first, int stride) {
    bf16_t* T0 = (bf16_t*)lds;
    bf16_t* T1 = (bf16_t*)(lds + 17408);
    const int tid = threadIdx.x, r = tid >> 4, c4 = tid & 15, n = tid >> 3, ks = tid & 7;
    int ta = t_begin + first;
    if (ta >= t_end) return;
    int tb = ta + stride; bool hb = tb < t_end;
    TD da = tile_desc(p, ta), db = da; f32x4 va[4], vb[4]; float sa[4], sb[4];
    tile_load(da, va, sa);
    if (hb) { db = tile_desc(p, tb); tile_load(db, vb, sb); }
    for (;;) {
#pragma unroll
        for (int i = 0; i < 4; ++i) { const int kl = r + 32 * i;
            T0[(4 * c4 + 0) * 136 + kl] = f2bf(va[i][0] * sa[i]); T0[(4 * c4 + 1) * 136 + kl] = f2bf(va[i][1] * sa[i]);
            T0[(4 * c4 + 2) * 136 + kl] = f2bf(va[i][2] * sa[i]); T0[(4 * c4 + 3) * 136 + kl] = f2bf(va[i][3] * sa[i]); }
        if (hb) {
#pragma unroll
            for (int i = 0; i < 4; ++i) { const int kl = r + 32 * i;
                T1[(4 * c4 + 0) * 136 + kl] = f2bf(vb[i][0] * sb[i]); T1[(4 * c4 + 1) * 136 + kl] = f2bf(vb[i][1] * sb[i]);
                T1[(4 * c4 + 2) * 136 + kl] = f2bf(vb[i][2] * sb[i]); T1[(4 * c4 + 3) * 136 + kl] = f2bf(vb[i][3] * sb[i]); } }
        __syncthreads();
        const int tna = ta + 2 * stride, tnb = tna + stride; const bool hna = tna < t_end, hnb = tnb < t_end;
        const TD ca = da, cb = db; const bool chb = hb;
        if (hna) { da = tile_desc(p, tna); tile_load(da, va, sa); }
        if (hnb) { db = tile_desc(p, tnb); tile_load(db, vb, sb); }
        { const u32x4* src = (const u32x4*)(T0 + n * 136 + 16 * ks); const u32x4 a = src[0], b = src[1];
          u32x4* dst = (u32x4*)(ca.out + (size_t)(64 * ca.nt + n) * ca.ldo + 128 * ca.kt + 16 * ks); dst[0] = a; dst[1] = b; }
        if (chb) { const u32x4* src = (const u32x4*)(T1 + n * 136 + 16 * ks); const u32x4 a = src[0], b = src[1];
          u32x4* dst = (u32x4*)(cb.out + (size_t)(64 * cb.nt + n) * cb.ldo + 128 * cb.kt + 16 * ks); dst[0] = a; dst[1] = b; }
        __syncthreads();
        if (!hna) break;
        ta = tna; hb = hnb;
    }
}
__device__ __forceinline__ void phase_prep(const Params p, unsigned char* lds) {
    unsigned char* ws = p.ws;
    const int G = gridDim.x;
    {
        const int lane = threadIdx.x & 63, gw = blockIdx.x * (NTHREADS / 64) + (threadIdx.x >> 6), nw = G * (NTHREADS / 64);
        int r = gw;
        f32x4 v[4], vn[4];
        if (r < MROWS + MEMROWS) { const float* src = r < MROWS ? p.x + (size_t)r * DM : p.mem + (size_t)(r - MROWS) * DM;
#pragma unroll
            for (int i = 0; i < 4; ++i) v[i] = __builtin_nontemporal_load((const f32x4*)src + lane + 64 * i); }
        for (; r < MROWS + MEMROWS; r += nw) {
            const int rn = r + nw;
            if (rn < MROWS + MEMROWS) { const float* src = rn < MROWS ? p.x + (size_t)rn * DM : p.mem + (size_t)(rn - MROWS) * DM;
#pragma unroll
                for (int i = 0; i < 4; ++i) vn[i] = __builtin_nontemporal_load((const f32x4*)src + lane + 64 * i); }
            const bool isx = r < MROWS;
            bf16_t* dst = isx ? (bf16_t*)(ws + WS_XB) + (size_t)r * DM : (bf16_t*)(ws + WS_MEMB) + (size_t)(r - MROWS) * DM;
            float ss = 0.f;
#pragma unroll
            for (int i = 0; i < 4; ++i) ss += (v[i][0] * v[i][0] + v[i][1] * v[i][1]) + (v[i][2] * v[i][2] + v[i][3] * v[i][3]);
#pragma unroll
            for (int o = 1; o < 64; o <<= 1) ss += __shfl_xor(ss, o);
#pragma unroll
            for (int i = 0; i < 4; ++i) { u32x2 w; w.x = cvt_pk_bf16(v[i][0], v[i][1]); w.y = cvt_pk_bf16(v[i][2], v[i][3]); ((u32x2*)dst)[lane + 64 * i] = w; }
            if (lane == 0) { const float rstd = rsqrtf(ss * (1.0f / 1024.0f) + EPS); if (isx) ((float*)(ws + WS_RSTD0))[r] = rstd; else ((float*)(ws + WS_RSTDM))[r - MROWS] = rstd; }
#pragma unroll
            for (int i = 0; i < 4; ++i) v[i] = vn[i];
        }
    }
    transpose_range(p, lds, 0, 576, blockIdx.x, G);
}
__device__ __forceinline__ void deferred_prep(const Params p, unsigned char* lds, int j, int nworkers) {
    transpose_range(p, lds, 576, 1984, j, nworkers);
}
__device__ __forceinline__ void fold_pool_weights_mfma(const Params& p) {
    bf16_t* wto = (bf16_t*)(p.ws + WS_WT_OUT);
    const int tid = threadIdx.x, w = tid >> 6, lane = tid & 63, fr = lane & 15, q = lane >> 4;
    for (int item = blockIdx.x; item < 256; item += gridDim.x) {
        const int gi = item >> 6, nb = item & 63;
        f32x4 acc = (f32x4){0.f, 0.f, 0.f, 0.f};
        const float* wp = p.w_pool + (size_t)(gi * 128 + 16 * w + fr) * 128;
        const float* ps = p.pool_scale + gi * 128;
        const bf16_t* arow = wto + (size_t)(16 * nb + fr) * 1024 + 512 + gi * 128;
#pragma unroll
        for (int ks = 0; ks < 4; ++ks) {
            const int d0 = 32 * ks + 8 * q;
            const f32x4 w0 = *(const f32x4*)(wp + d0), w1 = *(const f32x4*)(wp + d0 + 4), s0 = *(const f32x4*)(ps + d0), s1 = *(const f32x4*)(ps + d0 + 4);
            const bf16x8 cfr = mk8u(cvt_pk_bf16(w0[0] * s0[0], w0[1] * s0[1]), cvt_pk_bf16(w0[2] * s0[2], w0[3] * s0[3]), cvt_pk_bf16(w1[0] * s1[0], w1[1] * s1[1]), cvt_pk_bf16(w1[2] * s1[2], w1[3] * s1[3]));
            const bf16x8 nfr = *(const bf16x8*)(arow + d0);
            acc = mfma16(cfr, nfr, acc);
        }
        asm volatile("s_waitcnt vmcnt(0)" ::: "memory");
        __syncthreads();
        u32x2 o; o.x = cvt_pk_bf16(acc[0], acc[1]); o.y = cvt_pk_bf16(acc[2], acc[3]);
        *(u32x2*)(wto + (size_t)(16 * nb + fr) * 1024 + 512 + gi * 128 + 16 * w + 4 * q) = o;
        __syncthreads();
    }
}

__device__ __forceinline__ void phase_passA(const bf16_t* __restrict__ KH, const float* __restrict__ LF, const bf16_t* __restrict__ VH, bf16_t* __restrict__ LT, float* __restrict__ DEC, unsigned char* lds) {
    const int tid = threadIdx.x, ch = tid & 127, seg = tid >> 7, G = gridDim.x;
    float* segtot = (float*)lds;
    unsigned char* KdT = lds + 2048;
    unsigned char* VTl = lds + 2048 + 18432;
    const int w = tid >> 6, lane = tid & 63, fr = lane & 15, q = lane >> 4;
    float lf[16], kk[16]; unsigned vr[16];
    int unit = blockIdx.x;
    if (unit < 1024) { const int b = unit >> 8, c = (unit >> 2) & 63, h = unit & 3; const size_t g0 = (size_t)(b * SEQ + c * 64 + seg * 16) * 512 + h * 128 + ch;
#pragma unroll
        for (int i = 0; i < 16; ++i) { lf[i] = LF[g0 + (size_t)i * 512]; vr[i] = VH[g0 + (size_t)i * 512]; } }
    for (; unit < 1024; unit += G) {
        const int b = unit >> 8, c = (unit >> 2) & 63, h = unit & 3, bh = b * 4 + h;
#pragma unroll
        for (int i = 0; i < 16; ++i) kk[i] = 1.0f - __expf(lf[i]);
#pragma unroll
        for (int i = 1; i < 16; ++i) lf[i] += lf[i - 1];
        segtot[seg * 128 + ch] = lf[15];
        __syncthreads();
        float after = 0.f;
#pragma unroll
        for (int s2 = 1; s2 < 4; ++s2) if (s2 > seg) after += segtot[s2 * 128 + ch];
        const float tot = after + lf[15];
        if (seg == 0) DEC[(size_t)(bh * 64 + c) * 128 + ch] = __expf(tot);
        unsigned kd[8], vp[8];
#pragma unroll
        for (int i = 0; i < 8; ++i) {
            kd[i] = cvt_pk_bf16(kk[2 * i] * __expf(tot - lf[2 * i]), kk[2 * i + 1] * __expf(tot - lf[2 * i + 1]));
            vp[i] = vr[2 * i] | (vr[2 * i + 1] << 16);
        }
        { u32x4* d = (u32x4*)(KdT + ch * 144 + seg * 32); d[0] = (u32x4){kd[0], kd[1], kd[2], kd[3]}; d[1] = (u32x4){kd[4], kd[5], kd[6], kd[7]}; }
        { u32x4* d = (u32x4*)(VTl + ch * 144 + seg * 32); d[0] = (u32x4){vp[0], vp[1], vp[2], vp[3]}; d[1] = (u32x4){vp[4], vp[5], vp[6], vp[7]}; }
        __syncthreads();
        {
            const int un = unit + G;
            if (un < 1024) { const int b2 = un >> 8, c2 = (un >> 2) & 63, h2 = un & 3; const size_t g0 = (size_t)(b2 * SEQ + c2 * 64 + seg * 16) * 512 + h2 * 128 + ch;
#pragma unroll
                for (int i = 0; i < 16; ++i) { lf[i] = LF[g0 + (size_t)i * 512]; vr[i] = VH[g0 + (size_t)i * 512]; } }
        }
        bf16x8 a[2];
#pragma unroll
        for (int ks = 0; ks < 2; ++ks) a[ks] = *(const bf16x8*)(KdT + (16 * w + fr) * 144 + (32 * ks + 8 * q) * 2);
        bf16_t* ltp = LT + (size_t)(bh * 64 + c) * 16384;
#pragma unroll
        for (int vb = 0; vb < 8; ++vb) {
            f32x4 acc = (f32x4){0.f, 0.f, 0.f, 0.f};
#pragma unroll
            for (int ks = 0; ks < 2; ++ks) { const bf16x8 bfr = *(const bf16x8*)(VTl + (16 * vb + fr) * 144 + (32 * ks + 8 * q) * 2); acc = mfma16(a[ks], bfr, acc); }
            u32x2 pk; pk.x = cvt_pk_bf16(acc[0], acc[1]); pk.y = cvt_pk_bf16(acc[2], acc[3]);
            *(u32x2*)(ltp + (size_t)(16 * vb + fr) * 128 + 16 * w + 4 * q) = pk;
        }
        __syncthreads();
    }
}

template <int W>
__device__ __forceinline__ void pool_body(const bf16_t* __restrict__ PH, bf16_t* __restrict__ MIXED, int r0, int s0, int c0) {
    unsigned v[31 + W];
#pragma unroll
    for (int j = 1; j < W; ++j) v[W - 1 - j] = (s0 - j >= 0) ? *(const unsigned*)(PH + (size_t)(r0 - j) * 512 + c0) : 0u;
#pragma unroll
    for (int tt = 0; tt < 32; ++tt) v[W - 1 + tt] = *(const unsigned*)(PH + (size_t)(r0 + tt) * 512 + c0);
    float sx = 0.f, sy = 0.f;
#pragma unroll
    for (int j = 1; j < W; ++j) { sx += bflo(v[W - 1 - j]); sy += bfhi(v[W - 1 - j]); }
#pragma unroll
    for (int tt = 0; tt < 32; ++tt) {
        const int s = s0 + tt;
        const float px = bflo(v[W - 1 + tt]), py = bfhi(v[W - 1 + tt]);
        sx += px; sy += py;
        const int cnt = (s + 1) < W ? (s + 1) : W;
        const float inv = __builtin_amdgcn_rcpf((float)cnt);
        *(unsigned*)(MIXED + (size_t)(r0 + tt) * 1024 + 512 + c0) = cvt_pk_bf16(sx * inv - px, sy * inv - py);
        sx -= bflo(v[tt]); sy -= bfhi(v[tt]);
    }
}
__device__ __forceinline__ void pool_tile(const bf16_t* __restrict__ PH, bf16_t* __restrict__ MIXED, int tile) {
    const int tid = threadIdx.x, cp = tid & 255, th = tid >> 8, c0 = 2 * cp, gi = c0 >> 7;
    const int r0 = tile * 64 + th * 32, s0 = r0 & (SEQ - 1);
    if (gi == 0) pool_body<2>(PH, MIXED, r0, s0, c0);
    else if (gi == 1) pool_body<4>(PH, MIXED, r0, s0, c0);
    else if (gi == 2) pool_body<8>(PH, MIXED, r0, s0, c0);
    else pool_body<16>(PH, MIXED, r0, s0, c0);
}

__device__ __forceinline__ void phase_scan(const bf16_t* LT, const float* __restrict__ DEC, bf16_t* ST) {
    for (int e2 = blockIdx.x * NTHREADS + threadIdx.x; e2 < 131072; e2 += gridDim.x * NTHREADS) {
        const int bh = e2 >> 13, v = (e2 >> 6) & 127, kp = e2 & 63;
        float sx = 0.f, sy = 0.f;
        const size_t base = (size_t)bh * 64 * 16384 + (size_t)v * 128 + 2 * kp;
        const float* dp = DEC + (size_t)bh * 64 * 128 + 2 * kp;
        for (int c0 = 0; c0 < 64; c0 += 32) {
            unsigned l[32]; f32x2 d[32];
#pragma unroll
            for (int j = 0; j < 32; ++j) { l[j] = *(const unsigned*)(LT + base + (size_t)(c0 + j) * 16384); d[j] = *(const f32x2*)(dp + (c0 + j) * 128); }
#pragma unroll
            for (int j = 0; j < 32; ++j) {
                *(unsigned*)(ST + base + (size_t)(c0 + j) * 16384) = cvt_pk_bf16(sx, sy);
                sx = d[j][0] * sx + bflo(l[j]); sy = d[j][1] * sy + bfhi(l[j]);
            }
        }
    }
}

__device__ __forceinline__ void phase_passC(const bf16_t* __restrict__ QH, const bf16_t* __restrict__ KH, const float* __restrict__ LF, const bf16_t* __restrict__ VH, const bf16_t* __restrict__ GH,
                                const bf16_t* __restrict__ ST, const float* __restrict__ hg, bf16_t* __restrict__ MIXED, unsigned char* lds) {
    const int tid = threadIdx.x, ch = tid & 127, seg = tid >> 7, G = gridDim.x;
    float lf[16], kk[16]; unsigned qr[16], vr[16];
    int unit = blockIdx.x;
    if (unit < 1024) { const int b = unit >> 8, c = (unit >> 2) & 63, h = unit & 3; const size_t g0 = (size_t)(b * SEQ + c * 64 + seg * 16) * 512 + h * 128 + ch;
#pragma unroll
        for (int i = 0; i < 16; ++i) { lf[i] = LF[g0 + (size_t)i * 512]; vr[i] = VH[g0 + (size_t)i * 512]; qr[i] = QH[g0 + (size_t)i * 512]; } }
  for (; unit < 1024; unit += G) {
    const int b = unit >> 8, c = (unit >> 2) & 63, h = unit & 3;
    const int row0 = b * SEQ + c * 64, bh = b * 4 + h;
    float* segtot = (float*)lds;
    float* rmsp = (float*)(lds + 2048);
    bf16_t* QC = (bf16_t*)(lds + 4096);
    bf16_t* QT = (bf16_t*)(lds + 21504);
    constexpr int KT0 = 38912;
    unsigned char* VTl = lds + 82432;
    const int w = tid >> 6, lane = tid & 63, fr = lane & 15, q = lane >> 4;
    const int i = w & 3, vh = w >> 2;
    const size_t row = (size_t)(row0 + 16 * i + fr);
    u32x2 gt[4]; f32x4 gg[4]; bf16x8 stf[4][4];
    {
        const bf16_t* stp = ST + (size_t)(bh * 64 + c) * 16384;
#pragma unroll
        for (int vbl = 0; vbl < 4; ++vbl) { const int v0 = 16 * (vh * 4 + vbl) + 4 * q; gt[vbl] = *(const u32x2*)(GH + row * 512 + h * 128 + v0); gg[vbl] = *(const f32x4*)(hg + h * 128 + v0);
#pragma unroll
            for (int ks = 0; ks < 4; ++ks) stf[ks][vbl] = *(const bf16x8*)(stp + (size_t)(16 * (vh * 4 + vbl) + fr) * 128 + 32 * ks + 8 * q); }
    }
#pragma unroll
    for (int i2 = 0; i2 < 16; ++i2) kk[i2] = 1.0f - __expf(lf[i2]);
#pragma unroll
    for (int i2 = 1; i2 < 16; ++i2) lf[i2] += lf[i2 - 1];
    segtot[seg * 128 + ch] = lf[15];
    {
        unsigned vp[8];
#pragma unroll
        for (int i2 = 0; i2 < 8; ++i2) vp[i2] = vr[2 * i2] | (vr[2 * i2 + 1] << 16);
        u32x4* d = (u32x4*)(VTl + ch * 144 + seg * 32); d[0] = (u32x4){vp[0], vp[1], vp[2], vp[3]}; d[1] = (u32x4){vp[4], vp[5], vp[6], vp[7]};
    }
    __syncthreads();
    const float t0 = segtot[ch], t1 = segtot[128 + ch], t2 = segtot[256 + ch];
    const float P = (seg > 0 ? t0 : 0.f) + (seg > 1 ? t1 : 0.f) + (seg > 2 ? t2 : 0.f);
    {
        const float eP = __expf(P);
#pragma unroll
        for (int i2 = 0; i2 < 16; ++i2) {
            const float qv = bflo(qr[i2]);
            const float el = __expf(lf[i2]);
            QT[(seg * 16 + i2) * 136 + ch] = f2bf(qv * el);
            QC[(seg * 16 + i2) * 136 + ch] = f2bf(qv * el * eP);
        }
        float E = 0.f;
#pragma unroll
        for (int i2 = 0; i2 < 4; ++i2) {
            if (i2 >= seg) {
                bf16_t* KT = (bf16_t*)(lds + KT0 + 4352 * ((i2 * (i2 + 1)) / 2));
#pragma unroll
                for (int j = 0; j < 16; ++j) KT[(seg * 16 + j) * 136 + ch] = f2bf(kk[j] * __expf(E - lf[j]));
                E += (i2 == 0 ? t0 : (i2 == 1 ? t1 : t2));
            }
        }
    }
    __syncthreads();
    {
        const int un = unit + G;
        if (un < 1024) { const int b2 = un >> 8, c2 = (un >> 2) & 63, h2 = un & 3; const size_t g2 = (size_t)(b2 * SEQ + c2 * 64 + seg * 16) * 512 + h2 * 128 + ch;
#pragma unroll
            for (int i2 = 0; i2 < 16; ++i2) { lf[i2] = LF[g2 + (size_t)i2 * 512]; vr[i2] = VH[g2 + (size_t)i2 * 512]; qr[i2] = QH[g2 + (size_t)i2 * 512]; } }
    }
    f32x4 sT[4];
#pragma unroll
    for (int j = 0; j < 4; ++j) sT[j] = (f32x4){0.f, 0.f, 0.f, 0.f};
    {
        bf16x8 qfr[4];
#pragma unroll
        for (int ks = 0; ks < 4; ++ks) qfr[ks] = *(const bf16x8*)((const unsigned char*)QT + (16 * i + fr) * 272 + (32 * ks + 8 * q) * 2);
        const unsigned char* KT = lds + KT0 + 4352 * ((i * (i + 1)) / 2);
#pragma unroll
        for (int j = 0; j < 4; ++j) if (j <= i) {
#pragma unroll
            for (int ks = 0; ks < 4; ++ks) { const bf16x8 a = *(const bf16x8*)(KT + (16 * j + fr) * 272 + (32 * ks + 8 * q) * 2); sT[j] = mfma16(a, qfr[ks], sT[j]); }
            if (j == i) {
#pragma unroll
                for (int rg = 0; rg < 4; ++rg) if (4 * q + rg > fr) sT[j][rg] = 0.f;
            }
        }
    }
    f32x4 oacc[4];
#pragma unroll
    for (int vbl = 0; vbl < 4; ++vbl) oacc[vbl] = (f32x4){0.f, 0.f, 0.f, 0.f};
#pragma unroll
    for (int m = 0; m < 2; ++m) if (2 * m <= i) {
        const bf16x8 bfrag = mk8u(cvt_pk_bf16(sT[2 * m][0], sT[2 * m][1]), cvt_pk_bf16(sT[2 * m][2], sT[2 * m][3]), cvt_pk_bf16(sT[2 * m + 1][0], sT[2 * m + 1][1]), cvt_pk_bf16(sT[2 * m + 1][2], sT[2 * m + 1][3]));
#pragma unroll
        for (int vbl = 0; vbl < 4; ++vbl) {
            const unsigned char* base = VTl + (16 * (vh * 4 + vbl) + fr) * 144 + (32 * m + 4 * q) * 2;
            const bf16x8 a = mk8(*(const u32x2*)base, *(const u32x2*)(base + 32));
            oacc[vbl] = mfma16(a, bfrag, oacc[vbl]);
        }
    }
    {
#pragma unroll
        for (int ks = 0; ks < 4; ++ks) {
            const bf16x8 bfr = *(const bf16x8*)((const unsigned char*)QC + (16 * i + fr) * 272 + (32 * ks + 8 * q) * 2);
#pragma unroll
            for (int vbl = 0; vbl < 4; ++vbl) oacc[vbl] = mfma16(stf[ks][vbl], bfr, oacc[vbl]);
        }
    }
    float ss = 0.f;
#pragma unroll
    for (int vbl = 0; vbl < 4; ++vbl) ss += (oacc[vbl][0] * oacc[vbl][0] + oacc[vbl][1] * oacc[vbl][1]) + (oacc[vbl][2] * oacc[vbl][2] + oacc[vbl][3] * oacc[vbl][3]);
    ss += __shfl_xor(ss, 16); ss += __shfl_xor(ss, 32);
    if (q == 0) rmsp[vh * 64 + 16 * i + fr] = ss;
    __syncthreads();
    const float rstd = rsqrtf((rmsp[16 * i + fr] + rmsp[64 + 16 * i + fr]) * (1.0f / 128.0f) + EPS);
#pragma unroll
    for (int vbl = 0; vbl < 4; ++vbl) {
        const int v0 = 16 * (vh * 4 + vbl) + 4 * q;
        u32x2 o;
        o.x = cvt_pk_bf16(oacc[vbl][0] * rstd * gg[vbl][0] * bflo(gt[vbl].x), oacc[vbl][1] * rstd * gg[vbl][1] * bfhi(gt[vbl].x));
        o.y = cvt_pk_bf16(oacc[vbl][2] * rstd * gg[vbl][2] * bflo(gt[vbl].y), oacc[vbl][3] * rstd * gg[vbl][3] * bfhi(gt[vbl].y));
        *(u32x2*)(MIXED + row * 1024 + h * 128 + v0) = o;
    }
    __syncthreads();
  }
}

__device__ __forceinline__ void attn_unit(const bf16_t* __restrict__ XQ, const bf16_t* __restrict__ KX, const bf16_t* __restrict__ VT, bf16_t* __restrict__ ATT, int unit, unsigned char* lds) {
    const int tid = threadIdx.x, w = tid >> 6, lane = tid & 63, r = lane & 31, hh = lane >> 5;
    const int b = unit >> 6, st = (unit >> 2) & 15, h = unit & 3;
    const int row0 = b * SEQ + st * 256;
    const bf16_t* qp = XQ + (size_t)(row0 + 32 * w + r) * 1024 + h * 256 + 8 * hh;
    {
        const bf16_t* kp = KX + (size_t)(b * 256) * 1024 + h * 256;
        u32x4 kv[16];
#pragma unroll
        for (int it = 0; it < 16; ++it) { const int idx = tid + 512 * it, m = idx >> 5, cc = idx & 31; kv[it] = *(const u32x4*)(kp + (size_t)m * 1024 + cc * 8); }
#pragma unroll
        for (int it = 0; it < 16; ++it) { const int idx = tid + 512 * it, m = idx >> 5, cc = idx & 31; *(u32x4*)(lds + m * 528 + cc * 16) = kv[it]; }
    }
    __syncthreads();
    f32x16 sacc[8];
#pragma unroll
    for (int mb = 0; mb < 8; ++mb)
#pragma unroll
        for (int e = 0; e < 16; ++e) sacc[mb][e] = 0.f;
    {
        bf16x8 qf[4], qn[4];
#pragma unroll
        for (int k4 = 0; k4 < 4; ++k4) qf[k4] = *(const bf16x8*)(qp + 16 * k4);
#pragma unroll
        for (int kg = 0; kg < 4; ++kg) {
            if (kg < 3) {
#pragma unroll
                for (int k4 = 0; k4 < 4; ++k4) qn[k4] = *(const bf16x8*)(qp + 16 * (4 * (kg + 1) + k4)); }
#pragma unroll
            for (int k4 = 0; k4 < 4; ++k4)
#pragma unroll
                for (int mb = 0; mb < 8; ++mb) { const bf16x8 a = *(const bf16x8*)(lds + (32 * mb + r) * 528 + (16 * (4 * kg + k4) + 8 * hh) * 2); sacc[mb] = mfma32(a, qf[k4], sacc[mb]); }
#pragma unroll
            for (int k4 = 0; k4 < 4; ++k4) qf[k4] = qn[k4];
        }
    }
    float mx = -3.0e38f;
#pragma unroll
    for (int mb = 0; mb < 8; ++mb)
#pragma unroll
        for (int e = 0; e < 16; ++e) mx = fmaxf(mx, sacc[mb][e]);
    mx = fmaxf(mx, __shfl_xor(mx, 32));
    float sum = 0.f;
    bf16x8 pf[8][2];
#pragma unroll
    for (int mb = 0; mb < 8; ++mb) {
        float pv[16];
#pragma unroll
        for (int e = 0; e < 16; ++e) { pv[e] = __expf(sacc[mb][e] - mx); sum += pv[e]; }
#pragma unroll
        for (int s = 0; s < 2; ++s) pf[mb][s] = mk8u(cvt_pk_bf16(pv[8 * s + 0], pv[8 * s + 1]), cvt_pk_bf16(pv[8 * s + 2], pv[8 * s + 3]), cvt_pk_bf16(pv[8 * s + 4], pv[8 * s + 5]), cvt_pk_bf16(pv[8 * s + 6], pv[8 * s + 7]));
    }
    sum += __shfl_xor(sum, 32);
    const float inv = 1.0f / sum;
    __syncthreads();
    {
        const bf16_t* vp = VT + (size_t)(h * 256) * 1024 + b * 256;
        u32x4 vv[16];
#pragma unroll
        for (int it = 0; it < 16; ++it) { const int idx = tid + 512 * it, e = idx >> 5, cc = idx & 31; vv[it] = *(const u32x4*)(vp + (size_t)e * 1024 + cc * 8); }
#pragma unroll
        for (int it = 0; it < 16; ++it) { const int idx = tid + 512 * it, e = idx >> 5, cc = idx & 31;
            u32x2* d = (u32x2*)(lds + e * 520 + cc * 16); d[0] = (u32x2){vv[it].x, vv[it].y}; d[1] = (u32x2){vv[it].z, vv[it].w}; }
    }
    __syncthreads();
    bf16_t* op = ATT + (size_t)(row0 + 32 * w + r) * 1024 + h * 256 + 4 * hh;
#pragma unroll
    for (int half = 0; half < 2; ++half) {
        f32x16 oacc[4];
#pragma unroll
        for (int d = 0; d < 4; ++d)
#pragma unroll
            for (int e = 0; e < 16; ++e) oacc[d][e] = 0.f;
#pragma unroll
        for (int mb = 0; mb < 8; ++mb)
#pragma unroll
            for (int s = 0; s < 2; ++s)
#pragma unroll
                for (int d = 0; d < 4; ++d) {
                    const unsigned char* base = lds + (32 * (half * 4 + d) + r) * 520 + (32 * mb + 16 * s + 4 * hh) * 2;
                    const bf16x8 a = mk8(*(const u32x2*)base, *(const u32x2*)(base + 16));
                    oacc[d] = mfma32(a, pf[mb][s], oacc[d]);
                }
#pragma unroll
        for (int d = 0; d < 4; ++d)
#pragma unroll
            for (int g = 0; g < 4; ++g) {
                u32x2 o; o.x = cvt_pk_bf16(oacc[d][4 * g] * inv, oacc[d][4 * g + 1] * inv); o.y = cvt_pk_bf16(oacc[d][4 * g + 2] * inv, oacc[d][4 * g + 3] * inv);
                *(u32x2*)(op + 32 * (half * 4 + d) + 8 * g) = o;
            }
    }
    __syncthreads();
}

__device__ __forceinline__ void phase_final(const bf16_t* __restrict__ xb, const float* __restrict__ ssq, float* __restrict__ out, const float* __restrict__ g) {
    const int tid = threadIdx.x, sub = tid >> 7, l = tid & 127;
    const f32x4 g0 = *(const f32x4*)(g + 8 * l), g1 = *(const f32x4*)(g + 8 * l + 4);
    for (int r = blockIdx.x * 4 + sub; r < MROWS; r += gridDim.x * 4) {
        const u32x4 v = *(const u32x4*)(xb + (size_t)r * DM + 8 * l);
        const f32x4* pp = (const f32x4*)(ssq + (size_t)r * 16); const f32x4 a = pp[0], b = pp[1], c = pp[2], d = pp[3];
        const float t = ((a[0] + a[1]) + (a[2] + a[3])) + ((b[0] + b[1]) + (b[2] + b[3])) + ((c[0] + c[1]) + (c[2] + c[3])) + ((d[0] + d[1]) + (d[2] + d[3]));
        const float rstd = rsqrtf(t * (1.0f / 1024.0f) + EPS);
        const f32x4 o0 = (f32x4){bflo(v.x), bfhi(v.x), bflo(v.y), bfhi(v.y)} * rstd * g0, o1 = (f32x4){bflo(v.z), bfhi(v.z), bflo(v.w), bfhi(v.w)} * rstd * g1;
        *(f32x4*)(out + (size_t)r * DM + 8 * l) = o0; *(f32x4*)(out + (size_t)r * DM + 8 * l + 4) = o1;
    }
}

#define XB_TMO      128
#define XB_XCNT(j)  (256  + 64 * (j))
#define XB_XSUB(j)  (1280 + 64 * (j))
#define XB_XGEN(j)  (2304 + 64 * (j))
#define XB_TOP      3328
#define XB_TOPGEN   3392
#define XCD_BAR_WORDS 3456
#define XB_SPIN_CAP (1u << 22)
__device__ __forceinline__ unsigned xb_ld(unsigned* p)              { return __hip_atomic_load(p, __ATOMIC_RELAXED, __HIP_MEMORY_SCOPE_AGENT); }
__device__ __forceinline__ unsigned xb_add(unsigned* p, unsigned v) { return __hip_atomic_fetch_add(p, v, __ATOMIC_RELAXED, __HIP_MEMORY_SCOPE_AGENT); }
__device__ __forceinline__ unsigned xb_xcc_id() { return (unsigned)__builtin_amdgcn_s_getreg((3 << 11) | 20) & 0xFu; }
#define XB_SPIN(cond, bar) do { unsigned _sp = 0; while (cond) { __builtin_amdgcn_s_sleep(1); \
    if ((++_sp & 255u) == 0u) { if (xb_ld(&(bar)[XB_TMO])) break; if (_sp > XB_SPIN_CAP) { atomicAdd(&(bar)[XB_TMO], 1u); break; } } } } while (0)
struct XcdBarrier { unsigned* bar; unsigned x; volatile LAS unsigned* st; };
__device__ __forceinline__ XcdBarrier xcd_barrier_post(unsigned* bar, volatile LAS unsigned* st) {
    XcdBarrier b; b.bar = bar; b.x = xb_xcc_id(); b.st = st;
    if (threadIdx.x == 0) (void)xb_add(&bar[XB_XCNT(b.x)], 1u);
    return b;
}
__device__ __forceinline__ void xcd_barrier_complete(unsigned* bar, unsigned x, unsigned& nloc, unsigned& nx) {
    const unsigned G = gridDim.x * gridDim.y * gridDim.z;
    unsigned sum, cnt, mine, sp = 0u;
    for (;;) {
        sum = 0u; cnt = 0u; mine = 0u;
#pragma unroll
        for (unsigned j = 0; j < 16; ++j) { const unsigned c = xb_ld(&bar[XB_XCNT(j)]); sum += c; cnt += (c > 0u) ? 1u : 0u; mine = (j == x) ? c : mine; }
        if (sum == G) break;
        __builtin_amdgcn_s_sleep(1);
        if ((++sp & 255u) == 0u) { if (xb_ld(&bar[XB_TMO])) break; if (sp > XB_SPIN_CAP) { atomicAdd(&bar[XB_TMO], 1u); break; } }
    }
    nloc = mine > 0u ? mine : 1u; nx = cnt > 0u ? cnt : 1u;
}
__device__ __forceinline__ void xcd_barrier(const XcdBarrier& b) {
    asm volatile("s_waitcnt vmcnt(0)" ::: "memory");
    __syncthreads();
    if (threadIdx.x == 0) {
        unsigned* bar = b.bar;
        __builtin_amdgcn_s_waitcnt(0);
        unsigned nloc = b.st[0], nx = b.st[1];
        if (nloc == 0u) { xcd_barrier_complete(bar, b.x, nloc, nx); b.st[0] = nloc; b.st[1] = nx; }
        const unsigned old = xb_add(&bar[XB_XSUB(b.x)], 1u);
        const unsigned gen = old / nloc;
        if (old + 1u == (gen + 1u) * nloc) {
            __builtin_amdgcn_fence(__ATOMIC_RELEASE, "agent");
            asm volatile("s_waitcnt vmcnt(0)" ::: "memory");
            const unsigned og = xb_add(&bar[XB_TOP], 1u);
            const unsigned tg = og / nx;
            if (og + 1u == (tg + 1u) * nx) xb_add(&bar[XB_TOPGEN], 1u);
            else XB_SPIN(xb_ld(&bar[XB_TOPGEN]) == tg, bar);
            __builtin_amdgcn_fence(__ATOMIC_ACQUIRE, "agent");
            asm volatile("s_waitcnt vmcnt(0)" ::: "memory");
        } else {
            XB_SPIN(xb_ld(&bar[XB_TOPGEN]) == gen, bar);
            __builtin_amdgcn_fence(__ATOMIC_ACQUIRE, "agent");
            asm volatile("s_waitcnt vmcnt(0)" ::: "memory");
        }
    }
    __syncthreads();
}

constexpr int N_PHASES = 12;
__global__ void __launch_bounds__(NTHREADS, 2) mega(Params p) {
    extern __shared__ __attribute__((aligned(16))) unsigned char lds[];
    LAS unsigned char* ldsl = (LAS unsigned char*)lds;
    unsigned char* ws = p.ws;
    const int G = gridDim.x, bid = blockIdx.x;
    const int lo = p.ph_lo, hi = p.ph_hi;

#ifndef DEFER_PREP
#define DEFER_PREP 0
#endif
#ifndef FUSE_FINAL
#define FUSE_FINAL 0
#endif
#ifndef DBG_LAST
#define DBG_LAST -1
#endif
#ifndef PHASE_MASK
#define PHASE_MASK 0xfff
#endif
#define IN(k) (((PHASE_MASK >> (k)) & 1) && lo <= (k) && (k) < hi)
    if (threadIdx.x == 0) { ((volatile LAS unsigned*)(ldsl + LDS_MAIN))[0] = 0u; ((volatile LAS unsigned*)(ldsl + LDS_MAIN))[1] = 0u; }
    __syncthreads();
    XcdBarrier xbar; xbar.bar = (unsigned*)(ws + WS_BAR); xbar.x = 0; xbar.st = nullptr;
    if (hi - lo > 1) xbar = xcd_barrier_post((unsigned*)(ws + WS_BAR), (volatile LAS unsigned*)(ldsl + LDS_MAIN));
    if (lo > hi) cg::this_grid().sync();
#define SEAM(k) do { if (IN(k) && IN((k) + 1)) { xcd_barrier(xbar); } } while (0)
    bf16_t* XB = (bf16_t*)(ws + WS_XB); bf16_t* LT = (bf16_t*)(ws + WS_ST);
    bf16_t* QH = (bf16_t*)(ws + WS_QH); bf16_t* KH = (bf16_t*)(ws + WS_KH); bf16_t* VH = (bf16_t*)(ws + WS_VH); bf16_t* GH = (bf16_t*)(ws + WS_GH); bf16_t* PH = (bf16_t*)(ws + WS_PH);
    float* LF = (float*)(ws + WS_LF); bf16_t* ST = (bf16_t*)(ws + WS_ST); bf16_t* MIXED = (bf16_t*)(ws + WS_MIXED);
    float* X1 = (float*)(ws + WS_X1); bf16_t* XQ = (bf16_t*)(ws + WS_XQ); bf16_t* ATT = (bf16_t*)(ws + WS_ATT); bf16_t* U = (bf16_t*)(ws + WS_U);
    float* SSQ = (float*)(ws + WS_SSQ); float* DEC = (float*)(ws + WS_DEC);
    bf16_t* MEMB = (bf16_t*)(ws + WS_MEMB); bf16_t* KX = (bf16_t*)(ws + WS_KX); bf16_t* VT = (bf16_t*)(ws + WS_VT);

    const bool fuse_final = FUSE_FINAL && (G == 256) && IN(10) && (hi - lo > 1);
    if (IN(0)) { phase_prep(p, lds);
#if !DEFER_PREP
        deferred_prep(p, lds, bid, G);
#endif
    }
    SEAM(0);
    if (IN(1)) {
        const pg8::Epi E{0, ws, p.x, p.out, p.lb_logits, p.final_norm_g};
        { pg8::Gemm g{XB, (const bf16_t*)(ws + WS_WT_IN), MROWS, NIN, DM}; pg8::StaticOrder S; S.init(MROWS, NIN, G, bid); pg8::gemm_phase(ldsl, g, S, E); }
        const pg8::Epi E1{1, ws, p.x, p.out, p.lb_logits, p.final_norm_g};
        { pg8::Gemm g{MEMB, (const bf16_t*)(ws + WS_WT_K), MEMROWS, 1024, DM}; pg8::StaticOrder S; S.init(MEMROWS, 1024, G, (bid + 128) % G); pg8::gemm_phase(ldsl, g, S, E1); }
        const pg8::Epi E2{2, ws, p.x, p.out, p.lb_logits, p.final_norm_g};
        { pg8::Gemm g{(const bf16_t*)(ws + WS_WT_V), MEMB, 1024, MEMROWS, DM}; pg8::StaticOrder S; S.init(1024, MEMROWS, G, (bid + 112) % G); pg8::gemm_phase(ldsl, g, S, E2); }
#if DEFER_PREP
        if (G == 256) { if (bid >= 160) deferred_prep(p, lds, bid - 160, 96); }
        else deferred_prep(p, lds, bid, G);
#endif
    }
    SEAM(1);
    if (IN(2)) {
#ifndef DBG_NO_PASSA
        phase_passA(KH, LF, VH, LT, DEC, lds);
#endif
#ifndef DBG_NO_POOL
        for (int t = bid; t < 256; t += G) pool_tile(PH, MIXED, t);
#endif
        fold_pool_weights_mfma(p);
    }
    SEAM(2);
    if (IN(3)) { phase_scan(LT, DEC, ST); }
    SEAM(3);
    if (IN(4)) { phase_passC(QH, KH, LF, VH, GH, ST, p.hgrn_norm_g, MIXED, lds); }
    SEAM(4);
    if (IN(5)) {
        const pg8::Epi E{6, ws, p.x, p.out, p.lb_logits, p.final_norm_g};
        pg8::Gemm g{MIXED, (const bf16_t*)(ws + WS_WT_OUT), MROWS, DM, DM}; pg8::StaticOrder S; S.init(MROWS, DM, G, bid); pg8::gemm_phase(ldsl, g, S, E);
    }
    SEAM(5);
    const bool fuse_attn = (G == 256) && IN(6) && IN(7);
    if (IN(6)) {
        const pg8::Epi E{4, ws, p.x, p.out, p.lb_logits, p.final_norm_g};
        pg8::Gemm g{XB, (const bf16_t*)(ws + WS_WT_Q), MROWS, DM, DM}; pg8::StaticOrder S; S.init(MROWS, DM, G, bid); pg8::gemm_phase(ldsl, g, S, E);
        if (fuse_attn) {
            pg8::Unit u; S.next(0, u);
            asm volatile("s_waitcnt vmcnt(0)" ::: "memory"); __syncthreads();
            attn_unit(XQ, KX, VT, ATT, u.pm * 4 + u.pn, lds);
        }
    }
    if (!fuse_attn) {
        SEAM(6);
        if (IN(7)) { for (int u = bid; u < 256; u += G) attn_unit(XQ, KX, VT, ATT, u, lds); }
    }
    SEAM(7);
    if (IN(8)) {
        const pg8::Epi E{6, ws, p.x, p.out, p.lb_logits, p.final_norm_g};
        pg8::Gemm g{ATT, (const bf16_t*)(ws + WS_WT_O), MROWS, DM, DM}; pg8::StaticOrder S; S.init(MROWS, DM, G, bid); pg8::gemm_phase(ldsl, g, S, E);
    }
    SEAM(8);
    if (IN(9)) {
        const pg8::Epi E{5, ws, p.x, p.out, p.lb_logits, p.final_norm_g};
        pg8::Gemm g{XB, (const bf16_t*)(ws + WS_WT_FF1), MROWS, DFF, DM}; pg8::StaticOrder S; S.init(MROWS, DFF, G, bid); pg8::gemm_phase(ldsl, g, S, E);
    }
    SEAM(9);
    if (IN(10)) {
        const pg8::Epi E{fuse_final ? 8 : 7, ws, p.x, p.out, p.lb_logits, p.final_norm_g};
        pg8::Gemm g{U, (const bf16_t*)(ws + WS_WT_FF2), MROWS, DM, DFF}; pg8::StaticOrder S; S.init(MROWS, DM, G, bid); pg8::gemm_phase(ldsl, g, S, E);
    }
    if (!fuse_final) {
        SEAM(10);
        if (IN(11)) { phase_final(XB, SSQ, p.out, p.final_norm_g); }
    }
#if DBG_LAST >= 0
    cg::this_grid().sync();
    {
        const unsigned* w32 = (const unsigned*)ws;
        for (size_t i = (size_t)bid * NTHREADS + threadIdx.x; i < (size_t)MROWS * DM; i += (size_t)G * NTHREADS) {
            float a = 0.f;
            for (int j = 0; j < 4; ++j) { const unsigned v = w32[i + (size_t)j * MROWS * DM]; a += (float)(v & 0xffffu) + (float)(v >> 16); }
            p.out[i] = a;
        }
    }
#endif
#undef IN
#undef SEAM
}

extern "C" void kernel_launch(void* const* d_in, const int* in_sizes, int n_in, void* d_out, int out_size, void* d_ws, size_t ws_size, hipStream_t stream) {
    static int grid = 0;
    if (grid == 0) {
        if (n_in != 19 || in_sizes[0] != MROWS * DM || out_size != MROWS * DM || ws_size < WS_END) { fprintf(stderr, "kernel_launch: unexpected shapes (n_in %d, ws %zu)\n", n_in, ws_size); grid = -1; return; }
        int dev = 0, cus = 0, per_cu = 0;
        hipGetDevice(&dev); hipDeviceGetAttribute(&cus, hipDeviceAttributeMultiprocessorCount, dev);
        if (hipFuncSetAttribute((const void*)mega, hipFuncAttributeMaxDynamicSharedMemorySize, LDS_BYTES) != hipSuccess) { fprintf(stderr, "kernel_launch: hipFuncSetAttribute failed\n"); grid = -1; return; }
        if (hipOccupancyMaxActiveBlocksPerMultiprocessor(&per_cu, (const void*)mega, NTHREADS, LDS_BYTES) != hipSuccess || per_cu < 1) { fprintf(stderr, "kernel_launch: occupancy query says %d\n", per_cu); per_cu = 1; }
        (void)hipGetLastError();
        grid = cus * 1;
        if (grid > cus * per_cu) grid = cus * per_cu;
    }
    if (grid < 0) return;
    if (hipMemsetAsync((char*)d_ws + WS_BAR, 0, 32768, stream) != hipSuccess) { fprintf(stderr, "kernel_launch: memset of barrier words failed\n"); return; }
    Params p{};
    const float** f = (const float**)&p;
    for (int i = 0; i < 19; ++i) f[i] = (const float*)d_in[i];
    p.out = (float*)d_out; p.ws = (unsigned char*)d_ws;
#if N_LAUNCH_MODE == 1
    p.ph_lo = 0; p.ph_hi = (DBG_LAST >= 0) ? DBG_LAST + 1 : N_PHASES;
    void* args[] = {&p};
    hipError_t e = hipLaunchCooperativeKernel((const void*)mega, dim3(grid), dim3(NTHREADS), args, LDS_BYTES, stream);
    if (e != hipSuccess) fprintf(stderr, "kernel_launch: cooperative launch failed: %s (grid %d)\n", hipGetErrorString(e), grid);
#else
    for (int k = 0; k < N_PHASES; ++k) { p.ph_lo = k; p.ph_hi = k + 1; hipLaunchKernelGGL(mega, dim3(grid), dim3(NTHREADS), LDS_BYTES, stream, p); }
#endif
}
```

```cpp
#include <hip/hip_runtime.h>
#include <hip/hip_cooperative_groups.h>
#include <cstdio>
namespace cg = cooperative_groups;

#ifndef N_LAUNCH_MODE
#define N_LAUNCH_MODE 1
#endif

typedef unsigned short bf16_t;
typedef short bf16x8 __attribute__((ext_vector_type(8)));
typedef float f32x2 __attribute__((ext_vector_type(2)));
typedef float f32x4 __attribute__((ext_vector_type(4)));
typedef float f32x16 __attribute__((ext_vector_type(16)));
typedef unsigned u32x2 __attribute__((ext_vector_type(2)));
typedef unsigned u32x4 __attribute__((ext_vector_type(4)));
#define LAS __attribute__((address_space(3)))

constexpr int MROWS = 16384, DM = 1024, SEQ = 4096, NIN = 2560, DFF = 4096, MEMROWS = 1024;
constexpr float EPS = 1e-6f;
constexpr int NTHREADS = 512;
constexpr int LDS_MAIN = 135168;
constexpr int LDS_BYTES = LDS_MAIN + 16;

constexpr size_t MiB = 1u << 20;
constexpr size_t WS_WT_IN = 0, WS_WT_K = 5 * MiB, WS_WT_V = 7 * MiB, WS_WT_OUT = 9 * MiB, WS_WT_Q = 11 * MiB, WS_WT_O = 13 * MiB,
                 WS_WT_FF1 = 15 * MiB, WS_WT_FF2 = 23 * MiB, WS_MEMB = 31 * MiB, WS_KX = 33 * MiB, WS_VT = 35 * MiB, WS_SSQ = 37 * MiB,
                 WS_BAR = 39 * MiB, WS_CNT = 39 * MiB + 16384, WS_RSTD0 = 38 * MiB, WS_RSTDM = 38 * MiB + 65536, WS_DEC = 38 * MiB + 131072,
                 WS_XB = 40 * MiB  , WS_QH = 72 * MiB, WS_KH = 88 * MiB, WS_VH = 104 * MiB, WS_GH = 120 * MiB, WS_PH = 136 * MiB,
                 WS_LF = 152 * MiB, WS_ST = 184 * MiB, WS_MIXED = 216 * MiB,
                 WS_X1 = 72 * MiB, WS_XQ = 136 * MiB, WS_ATT = 168 * MiB, WS_U = 72 * MiB, WS_END = 256 * MiB;

typedef __bf16 bf16x2n __attribute__((ext_vector_type(2)));
__device__ __forceinline__ unsigned cvt_pk_bf16(float lo, float hi) { f32x2 v = {lo, hi}; return __builtin_bit_cast(unsigned, __builtin_convertvector(v, bf16x2n)); }
__device__ __forceinline__ bf16_t f2bf(float f) { return (bf16_t)(cvt_pk_bf16(f, 0.f) & 0xffffu); }
__device__ __forceinline__ float bf2f(bf16_t b) { return __uint_as_float(((unsigned)b) << 16); }
__device__ __forceinline__ float bflo(unsigned u) { return __uint_as_float(u << 16); }
__device__ __forceinline__ float bfhi(unsigned u) { return __uint_as_float(u & 0xffff0000u); }
__device__ __forceinline__ f32x4 mfma16(bf16x8 a, bf16x8 b, f32x4 c) { return __builtin_amdgcn_mfma_f32_16x16x32_bf16(a, b, c, 0, 0, 0); }
__device__ __forceinline__ f32x16 mfma32(bf16x8 a, bf16x8 b, f32x16 c) { return __builtin_amdgcn_mfma_f32_32x32x16_bf16(a, b, c, 0, 0, 0); }
__device__ __forceinline__ bf16x8 mk8(u32x2 lo, u32x2 hi) { u32x4 t; t.x = lo.x; t.y = lo.y; t.z = hi.x; t.w = hi.y; return __builtin_bit_cast(bf16x8, t); }
__device__ __forceinline__ bf16x8 mk8u(unsigned a, unsigned b, unsigned c, unsigned d) { u32x4 t; t.x = a; t.y = b; t.z = c; t.w = d; return __builtin_bit_cast(bf16x8, t); }
__device__ __forceinline__ float sigmoidf_(float z) { return __builtin_amdgcn_rcpf(1.0f + __expf(-z)); }

namespace pg8 {
constexpr int BM = 256, BK = 64, HALF = 128, HTB = HALF * BK * 2, STAGE_BYTES = 8 * HTB, NXCD = 8, WGM = 8;
__device__ __forceinline__ int lds_byte(int r, int c) { const int st = (r >> 4) * 2 + (c >> 5), rr = r & 15, cc = c & 31, ob = rr * 64 + cc * 2; return st * 1024 + (ob ^ (((ob >> 9) & 1) << 5)); }
__device__ __forceinline__ void stage_rc(int b, int& R, int& C) { const int st = b / 1024, sb = b % 1024, swz = sb ^ (((sb >> 9) & 1) << 5); R = (st >> 1) * 16 + swz / 64; C = (st & 1) * 32 + (swz % 64) / 2; }
__device__ __forceinline__ int perm32(int rho) { const int n = rho >> 4, i = rho & 15; return 8 * (i >> 2) + 4 * n + (i & 3); }
struct Unit { int pm, pn; };
struct Gemm { const bf16_t* A; const bf16_t* Bt; int M, N, K; };
struct StaticOrder {
    int nM, nN, nwg, G, c;
    __device__ __forceinline__ void init(int M, int N, int G_, int c_) { nM = M / BM; nN = N / BM; nwg = nM * nN; G = G_; c = c_; }
    __device__ __forceinline__ bool next(int i, Unit& u) const {
        const long L = (long)i * G + c; if (L >= nwg) return false;
        int wgid = (int)L; { const int q = nwg / NXCD, r = nwg % NXCD, xcd = wgid % NXCD, off = wgid / NXCD; wgid = (xcd < r ? xcd * (q + 1) : r * (q + 1) + (xcd - r) * q) + off; }
        const int nig = WGM * nN, gid = wgid / nig, fm = gid * WGM, gsz = (nM - fm) < WGM ? (nM - fm) : WGM;
        u.pm = fm + ((wgid % nig) % gsz); u.pn = (wgid % nig) / gsz; return true;
    }
};

struct Epi {
    static constexpr bool PERM = true;
    int mode;
    unsigned char* ws; const float* x; float* out; const float* lbl; const float* gfin;
    __device__ __forceinline__ void store8(bf16_t* p, const f32x4& v0, const f32x4& v1) const {
        u32x4 w; w.x = cvt_pk_bf16(v0[0], v0[1]); w.y = cvt_pk_bf16(v0[2], v0[3]); w.z = cvt_pk_bf16(v1[0], v1[1]); w.w = cvt_pk_bf16(v1[2], v1[3]); *(u32x4*)p = w; }
    __device__ __forceinline__ void fused(f32x4 (&acc)[2][2][4][2], const Unit& u, int wr, int wc, int fr, int fq) const {
        const int row0 = u.pm * BM + wr * 64 + fr;
        const int col0 = u.pn * BM + wc * 32 + 8 * fq;
        const bf16_t* xb = (const bf16_t*)(ws + WS_XB);
        unsigned* sq = (unsigned*)(ws + WS_SSQ);
        unsigned* cnt = (unsigned*)(ws + WS_CNT) + 64 * u.pm;
        u32x4 bc[2], bn[2];
        { const size_t o = (size_t)row0 * DM + col0; bc[0] = *(const u32x4*)(xb + o); bc[1] = *(const u32x4*)(xb + o + HALF); }
#pragma unroll
        for (int gidx = 0; gidx < 8; ++gidx) { const int ai = gidx >> 2, m = gidx & 3; const int row = row0 + ai * HALF + m * 16;
            if (gidx < 7) { const int g2 = gidx + 1; const size_t o2 = (size_t)(row0 + (g2 >> 2) * HALF + (g2 & 3) * 16) * DM + col0; bn[0] = *(const u32x4*)(xb + o2); bn[1] = *(const u32x4*)(xb + o2 + HALF); }
            float ss = 0.f;
#pragma unroll
            for (int bj = 0; bj < 2; ++bj) { const u32x4 bb = bc[bj];
                const f32x4 v0 = acc[ai][bj][m][0] + (f32x4){bflo(bb.x), bfhi(bb.x), bflo(bb.y), bfhi(bb.y)}, v1 = acc[ai][bj][m][1] + (f32x4){bflo(bb.z), bfhi(bb.z), bflo(bb.w), bfhi(bb.w)};
                acc[ai][bj][m][0] = v0; acc[ai][bj][m][1] = v1;
                ss += (v0[0] * v0[0] + v0[1] * v0[1]) + (v0[2] * v0[2] + v0[3] * v0[3]) + (v1[0] * v1[0] + v1[1] * v1[1]) + (v1[2] * v1[2] + v1[3] * v1[3]); }
            ss += __shfl_xor(ss, 16); ss += __shfl_xor(ss, 32);
            if (fq == 0) __hip_atomic_store(sq + (size_t)row * 16 + u.pn * 4 + wc, __float_as_uint(ss), __ATOMIC_RELAXED, __HIP_MEMORY_SCOPE_AGENT);
            bc[0] = bn[0]; bc[1] = bn[1]; }
        asm volatile("s_waitcnt vmcnt(0)" ::: "memory");
        if ((threadIdx.x & 63) == 0) __hip_atomic_fetch_add(cnt, 1u, __ATOMIC_RELAXED, __HIP_MEMORY_SCOPE_AGENT);
        f32x4 gv[2][2];
#pragma unroll
        for (int bj = 0; bj < 2; ++bj) { gv[bj][0] = *(const f32x4*)(gfin + col0 + bj * HALF); gv[bj][1] = *(const f32x4*)(gfin + col0 + bj * HALF + 4); }
        { unsigned spins = 0; while ((unsigned)__builtin_amdgcn_readfirstlane(__hip_atomic_load(cnt, __ATOMIC_RELAXED, __HIP_MEMORY_SCOPE_AGENT)) < 32u) { __builtin_amdgcn_s_sleep(1); if (++spins > (1u << 22)) break; } }
        __builtin_amdgcn_fence(__ATOMIC_ACQUIRE, "agent");
        asm volatile("s_waitcnt vmcnt(0)" ::: "memory");
        f32x4 pv[8];
#pragma unroll
        for (int gidx = 0; gidx < 8; ++gidx) pv[gidx] = *(const f32x4*)((const float*)sq + (size_t)(row0 + (gidx >> 2) * HALF + (gidx & 3) * 16) * 16 + 4 * fq);
#pragma unroll
        for (int gidx = 0; gidx < 8; ++gidx) { const int ai = gidx >> 2, m = gidx & 3; const int row = row0 + ai * HALF + m * 16;
            float t = (pv[gidx][0] + pv[gidx][1]) + (pv[gidx][2] + pv[gidx][3]); t += __shfl_xor(t, 16); t += __shfl_xor(t, 32);
            const float rstd = rsqrtf(t * (1.0f / 1024.0f) + EPS);
            const size_t o = (size_t)row * DM + col0;
#pragma unroll
            for (int bj = 0; bj < 2; ++bj) { *(f32x4*)(out + o + bj * HALF) = acc[ai][bj][m][0] * rstd * gv[bj][0]; *(f32x4*)(out + o + bj * HALF + 4) = acc[ai][bj][m][1] * rstd * gv[bj][1]; } }
    }
    template <class Sched>
    __device__ __forceinline__ bool prefill(LAS unsigned char* lds, const Sched& S) const {
        if (!(mode == 0 || mode == 1 || mode == 4 || mode == 5) || S.nwg > 4 * S.G) return false;
        const int tid = threadIdx.x, rr = tid & 255;
#pragma unroll
        for (int k = 0; k < 2; ++k) { const int ui = (tid >> 8) + 2 * k; Unit u;
            if (S.next(ui, u)) { const int row = u.pm * BM + rr; float r;
                if (mode == 4 || mode == 5) { const f32x4* pp = (const f32x4*)((const float*)(ws + WS_SSQ) + (size_t)row * 16); const f32x4 a = pp[0], b = pp[1], c = pp[2], d = pp[3];
                    const float t = ((a[0] + a[1]) + (a[2] + a[3])) + ((b[0] + b[1]) + (b[2] + b[3])) + ((c[0] + c[1]) + (c[2] + c[3])) + ((d[0] + d[1]) + (d[2] + d[3]));
                    r = rsqrtf(t * (1.0f / 1024.0f) + EPS) * (mode == 4 ? 0.0625f : 1.0f); }
                else r = ((const float*)(ws + (mode == 0 ? WS_RSTD0 : WS_RSTDM)))[row];
                *(LAS float*)(lds + STAGE_BYTES + (ui * 256 + rr) * 4) = r; } }
        return true;
    }
    __device__ __forceinline__ void operator()(const f32x4 (&acc)[2][2][4][2], const Unit& u, int ui, bool tab, LAS unsigned char* lds, int wr, int wc, int fr, int fq) const {
        const int row0 = u.pm * BM + wr * 64 + fr;
        const int colL = wc * 32 + 8 * fq;
        if (mode == 3 || mode == 6 || mode == 7) {
            const int col0 = u.pn * BM + colL;
            bf16_t* xb = (bf16_t*)(ws + WS_XB);
            float* ssq = (float*)(ws + WS_SSQ);
            f32x4 rc[4], rn[4];
            u32x4 bc[2], bn[2];
            if (mode == 3) { const size_t o = (size_t)row0 * DM + col0; rc[0] = *(const f32x4*)(x + o); rc[1] = *(const f32x4*)(x + o + 4); rc[2] = *(const f32x4*)(x + o + HALF); rc[3] = *(const f32x4*)(x + o + HALF + 4); }
            else { const size_t o = (size_t)row0 * DM + col0; bc[0] = *(const u32x4*)(xb + o); bc[1] = *(const u32x4*)(xb + o + HALF); }
#pragma unroll
            for (int gidx = 0; gidx < 8; ++gidx) { const int ai = gidx >> 2, m = gidx & 3; const int row = row0 + ai * HALF + m * 16;
                if (gidx < 7) { const int g2 = gidx + 1; const size_t o2 = (size_t)(row0 + (g2 >> 2) * HALF + (g2 & 3) * 16) * DM + col0;
                    if (mode == 3) { rn[0] = *(const f32x4*)(x + o2); rn[1] = *(const f32x4*)(x + o2 + 4); rn[2] = *(const f32x4*)(x + o2 + HALF); rn[3] = *(const f32x4*)(x + o2 + HALF + 4); }
                    else { bn[0] = *(const u32x4*)(xb + o2); bn[1] = *(const u32x4*)(xb + o2 + HALF); } }
                if (mode != 3) {
#pragma unroll
                    for (int bj = 0; bj < 2; ++bj) { rc[2 * bj] = (f32x4){bflo(bc[bj].x), bfhi(bc[bj].x), bflo(bc[bj].y), bfhi(bc[bj].y)}; rc[2 * bj + 1] = (f32x4){bflo(bc[bj].z), bfhi(bc[bj].z), bflo(bc[bj].w), bfhi(bc[bj].w)}; } }
                float ss = 0.f;
#pragma unroll
                for (int bj = 0; bj < 2; ++bj) { const size_t o = (size_t)row * DM + col0 + bj * HALF;
                    const f32x4 v0 = acc[ai][bj][m][0] + rc[2 * bj], v1 = acc[ai][bj][m][1] + rc[2 * bj + 1];
                    store8(xb + o, v0, v1);
                    ss += (v0[0] * v0[0] + v0[1] * v0[1]) + (v0[2] * v0[2] + v0[3] * v0[3]) + (v1[0] * v1[0] + v1[1] * v1[1]) + (v1[2] * v1[2] + v1[3] * v1[3]); }
                ss += __shfl_xor(ss, 16); ss += __shfl_xor(ss, 32);
                if (fq == 0) ssq[(size_t)row * 16 + u.pn * 4 + wc] = ss;
#pragma unroll
                for (int k = 0; k < 4; ++k) rc[k] = rn[k];
                bc[0] = bn[0]; bc[1] = bn[1]; }
            return;
        }
        if (mode == 2) {
            const int col0 = u.pn * BM + colL;
            const float* rs = (const float*)(ws + WS_RSTDM); bf16_t* ob = (bf16_t*)(ws + WS_VT); const int ldo = 1024;
            f32x4 c0[2], c1[2];
#pragma unroll
            for (int bj = 0; bj < 2; ++bj) { c0[bj] = *(const f32x4*)(rs + col0 + bj * HALF); c1[bj] = *(const f32x4*)(rs + col0 + bj * HALF + 4); }
#pragma unroll
            for (int ai = 0; ai < 2; ++ai)
#pragma unroll
                for (int m = 0; m < 4; ++m) { const int row = row0 + ai * HALF + m * 16;
#pragma unroll
                    for (int bj = 0; bj < 2; ++bj) store8(ob + (size_t)row * ldo + col0 + bj * HALF, acc[ai][bj][m][0] * c0[bj], acc[ai][bj][m][1] * c1[bj]); }
            return;
        }
        float rsc[8];
        if (tab) {
#pragma unroll
            for (int gidx = 0; gidx < 8; ++gidx) rsc[gidx] = *(const LAS float*)(lds + STAGE_BYTES + (ui * 256 + wr * 64 + fr + (gidx >> 2) * HALF + (gidx & 3) * 16) * 4);
        } else if (mode == 4 || mode == 5) {
            asm volatile("" ::: "memory");
            const float* sq = (const float*)(ws + WS_SSQ);
            f32x4 pv[8];
#pragma unroll
            for (int gidx = 0; gidx < 8; ++gidx) pv[gidx] = *(const f32x4*)(sq + (size_t)(row0 + (gidx >> 2) * HALF + (gidx & 3) * 16) * 16 + 4 * fq);
            const float cs = mode == 4 ? 0.0625f : 1.0f;
#pragma unroll
            for (int gidx = 0; gidx < 8; ++gidx) { float t = (pv[gidx][0] + pv[gidx][1]) + (pv[gidx][2] + pv[gidx][3]); t += __shfl_xor(t, 16); t += __shfl_xor(t, 32); rsc[gidx] = rsqrtf(t * (1.0f / 1024.0f) + EPS) * cs; }
        } else {
            asm volatile("" ::: "memory");
            const float* rs = (const float*)(ws + (mode == 0 ? WS_RSTD0 : WS_RSTDM));
#pragma unroll
            for (int gidx = 0; gidx < 8; ++gidx) rsc[gidx] = rs[row0 + (gidx >> 2) * HALF + (gidx & 3) * 16];
        }
        if (mode == 0) {
            float* lf = (float*)(ws + WS_LF);
            const int sub = u.pn >> 1; const int cb = (u.pn & 1) * 256 + colL;
            if (sub == 1) {
                float oml[2][8];
#pragma unroll
                for (int bj = 0; bj < 2; ++bj)
#pragma unroll
                    for (int j = 0; j < 8; ++j) { const int c = cb + bj * HALF + j; const float l0 = lbl[c], l1 = lbl[512 + c]; const float lb = 1.0f / (1.0f + __expf(l1 - l0)); oml[bj][j] = 1.0f - lb; }
#pragma unroll
                for (int ai = 0; ai < 2; ++ai)
#pragma unroll
                    for (int m = 0; m < 4; ++m) { const int row = row0 + ai * HALF + m * 16; const float r = rsc[ai * 4 + m];
#pragma unroll
                        for (int bj = 0; bj < 2; ++bj) { f32x4 lf0, lf1;
#pragma unroll
                            for (int j = 0; j < 4; ++j) {
                                const float za = acc[ai][bj][m][0][j] * r, zb = acc[ai][bj][m][1][j] * r;
                                const float ka = oml[bj][j] * (1.0f - sigmoidf_(za)), kb = oml[bj][4 + j] * (1.0f - sigmoidf_(zb));
                                lf0[j] = __logf(1.0f - ka); lf1[j] = __logf(1.0f - kb); }
                            const size_t o = (size_t)row * 512 + cb + bj * HALF;
                            *(f32x4*)(lf + o) = lf0; *(f32x4*)(lf + o + 4) = lf1; } }
            } else {
                bf16_t* dst = (bf16_t*)(ws + (sub == 0 ? WS_QH : (sub == 2 ? WS_VH : (sub == 3 ? WS_GH : WS_PH))));
                const bool act = (sub == 0) || (sub == 3);
#pragma unroll
                for (int ai = 0; ai < 2; ++ai)
#pragma unroll
                    for (int m = 0; m < 4; ++m) { const int row = row0 + ai * HALF + m * 16; const float r = rsc[ai * 4 + m];
#pragma unroll
                        for (int bj = 0; bj < 2; ++bj) { f32x4 v0 = acc[ai][bj][m][0] * r, v1 = acc[ai][bj][m][1] * r;
                            if (act) {
#pragma unroll
                                for (int j = 0; j < 4; ++j) { v0[j] = v0[j] * sigmoidf_(v0[j]); v1[j] = v1[j] * sigmoidf_(v1[j]); } }
                            store8(dst + (size_t)row * 512 + cb + bj * HALF, v0, v1); } }
            }
        } else {
            const int col0 = u.pn * BM + colL;
            bf16_t* ob = (bf16_t*)(ws + (mode == 1 ? WS_KX : (mode == 4 ? WS_XQ : WS_U))); const int ldo = mode == 5 ? DFF : 1024;
#pragma unroll
            for (int ai = 0; ai < 2; ++ai)
#pragma unroll
                for (int m = 0; m < 4; ++m) { const int row = row0 + ai * HALF + m * 16; const float r = rsc[ai * 4 + m];
#pragma unroll
                    for (int bj = 0; bj < 2; ++bj) { f32x4 v0 = acc[ai][bj][m][0] * r, v1 = acc[ai][bj][m][1] * r;
                        if (mode == 5) {
#pragma unroll
                            for (int j = 0; j < 4; ++j) { const float a = fmaxf(v0[j], 0.f), b = fmaxf(v1[j], 0.f); v0[j] = a * a; v1[j] = b * b; } }
                        store8(ob + (size_t)row * ldo + col0 + bj * HALF, v0, v1); } }
        }
    }
};

template <class EpiT, class Sched>
__device__ __forceinline__ void gemm_phase(LAS unsigned char* lds, const Gemm g, const Sched S, const EpiT E) {
    const int tid = threadIdx.x, wid = __builtin_amdgcn_readfirstlane(tid >> 6), lane = tid & 63, wr = wid >> 2, wc = wid & 3, fr = lane & 15, fq = lane >> 4;
    const int K = g.K, nt = K / BK;
    unsigned voffA[2], voffB[2];
#pragma unroll
    for (int i = 0; i < 2; ++i) { int R, C; stage_rc(tid * 16 + i * 8192, R, C); const int Rb = EpiT::PERM ? ((R & ~31) + perm32(R & 31)) : R;
        voffA[i] = (unsigned)(R * K + C) * 2u; voffB[i] = (unsigned)(Rb * K + C) * 2u; }
    const size_t kstep = (size_t)(BK * 2);
    const size_t hstep = (size_t)HALF * K * 2;
    const size_t tstep = 2 * hstep;
    const unsigned ldsw = (unsigned)wid * 1024u;
    const int aoff = lds_byte(wr * 64 + fr, fq * 8), boff = lds_byte(wc * 32 + fr, fq * 8);
#define PG8_SA(b, h) (((b) * 2 + (h)) * HTB)
#define PG8_SB(b, h) ((4 + (b) * 2 + (h)) * HTB)
#define PG8_STAGE(bufoff, gbase, voff) do { _Pragma("unroll") for (int _i = 0; _i < 2; ++_i) \
        __builtin_amdgcn_global_load_lds((const unsigned*)((const char*)(gbase) + (voff)[_i]), (LAS unsigned*)(lds + (bufoff) + ldsw + _i * 8192), 16, 0, 0); } while (0)
#define PG8_LDA(dst, b, h) do { _Pragma("unroll") for (int m = 0; m < 4; ++m) _Pragma("unroll") for (int k = 0; k < 2; ++k) dst[m][k] = *(const LAS bf16x8*)(lds + PG8_SA(b, h) + aoff + m * 2048 + k * 1024); } while (0)
#define PG8_LDB(dst, b, h) do { _Pragma("unroll") for (int n = 0; n < 2; ++n) _Pragma("unroll") for (int k = 0; k < 2; ++k) dst[n][k] = *(const LAS bf16x8*)(lds + PG8_SB(b, h) + boff + n * 2048 + k * 1024); } while (0)
#define PG8_MMA(ai, bj, At, Bt) do { __builtin_amdgcn_s_setprio(1); _Pragma("unroll") for (int m = 0; m < 4; ++m) _Pragma("unroll") for (int n = 0; n < 2; ++n) _Pragma("unroll") for (int k = 0; k < 2; ++k) \
        acc[ai][bj][m][n] = __builtin_amdgcn_mfma_f32_16x16x32_bf16(Bt[n][k], At[m][k], acc[ai][bj][m][n], 0, 0, 0); __builtin_amdgcn_s_setprio(0); } while (0)
#define PG8_WAIT_V(n) asm volatile("s_waitcnt vmcnt(" #n ")" ::: "memory")
#define PG8_WAIT_L(n) asm volatile("s_waitcnt lgkmcnt(" #n ")" ::: "memory")
#define PG8_BAR __builtin_amdgcn_s_barrier()
#define PG8_SCHED __builtin_amdgcn_sched_barrier(0)
    Unit cur, nxt; int ui = 0;
    if (!S.next(0, cur)) return;
    const bool tab = E.prefill(lds, S);
    if (tab) __syncthreads();
    f32x4 acc[2][2][4][2];
#pragma unroll
    for (int a = 0; a < 2; ++a)
#pragma unroll
        for (int b = 0; b < 2; ++b)
#pragma unroll
            for (int m = 0; m < 4; ++m)
#pragma unroll
                for (int n = 0; n < 2; ++n) acc[a][b][m][n] = (f32x4){0.f, 0.f, 0.f, 0.f};
    bf16x8 At[4][2], B0[2][2], B1[2][2];
    const char* cA = (const char*)g.A + (size_t)cur.pm * tstep; const char* cB = (const char*)g.Bt + (size_t)cur.pn * tstep;
    PG8_STAGE(PG8_SB(0, 0), cB, voffB); PG8_STAGE(PG8_SA(0, 0), cA, voffA); PG8_STAGE(PG8_SB(0, 1), cB + hstep, voffB); PG8_STAGE(PG8_SA(0, 1), cA + hstep, voffA);
    if (wr == 1) PG8_BAR;
    PG8_WAIT_V(4); PG8_BAR;
    PG8_STAGE(PG8_SB(1, 0), cB + kstep, voffB); PG8_STAGE(PG8_SA(1, 0), cA + kstep, voffA); PG8_STAGE(PG8_SB(1, 1), cB + hstep + kstep, voffB);
    PG8_WAIT_V(6); PG8_BAR;
    for (;;) {
        const bool has_next = S.next(ui + 1, nxt);
        const char* nA = has_next ? (const char*)g.A + (size_t)nxt.pm * tstep : cA; const char* nB = has_next ? (const char*)g.Bt + (size_t)nxt.pn * tstep : cB;
        for (int t = 0; t < nt; t += 2) {
            const bool last = (t == nt - 2);
            const char* a1 = cA + (size_t)(t + 1) * kstep;
            const char* a2 = last ? nA : cA + (size_t)(t + 2) * kstep; const char* b2 = last ? nB : cB + (size_t)(t + 2) * kstep;
            const char* a3 = a2 + kstep; const char* b3 = b2 + kstep;
            PG8_LDB(B0, 0, 0); PG8_SCHED; PG8_LDA(At, 0, 0); PG8_STAGE(PG8_SA(1, 1), a1 + hstep, voffA);
            PG8_WAIT_L(8); PG8_BAR; PG8_WAIT_L(0); PG8_MMA(0, 0, At, B0); PG8_BAR; PG8_SCHED;
            PG8_LDB(B1, 0, 1); PG8_STAGE(PG8_SB(0, 0), b2, voffB);
            PG8_BAR; PG8_WAIT_L(0); PG8_MMA(0, 1, At, B1); PG8_BAR;
            PG8_LDA(At, 0, 1); PG8_STAGE(PG8_SA(0, 0), a2, voffA);
            PG8_BAR; PG8_WAIT_L(0); PG8_MMA(1, 0, At, B0); PG8_BAR; PG8_SCHED;
            PG8_STAGE(PG8_SB(0, 1), b2 + hstep, voffB);
            PG8_WAIT_V(6); PG8_BAR; PG8_MMA(1, 1, At, B1); PG8_BAR;
            PG8_LDB(B0, 1, 0); PG8_SCHED; PG8_LDA(At, 1, 0); PG8_STAGE(PG8_SA(0, 1), a2 + hstep, voffA);
            PG8_WAIT_L(8); PG8_BAR; PG8_WAIT_L(0); PG8_MMA(0, 0, At, B0); PG8_BAR; PG8_SCHED;
            PG8_LDB(B1, 1, 1); PG8_STAGE(PG8_SB(1, 0), b3, voffB);
            PG8_BAR; PG8_WAIT_L(0); PG8_MMA(0, 1, At, B1); PG8_BAR;
            PG8_LDA(At, 1, 1); PG8_STAGE(PG8_SA(1, 0), a3, voffA);
            PG8_BAR; PG8_WAIT_L(0); PG8_MMA(1, 0, At, B0); PG8_BAR; PG8_SCHED;
            PG8_STAGE(PG8_SB(1, 1), b3 + hstep, voffB);
            PG8_WAIT_V(6); PG8_BAR; PG8_MMA(1, 1, At, B1); PG8_BAR;
        }
        if (E.mode != 8) E(acc, cur, ui, tab, lds, wr, wc, fr, fq);
        if (E.mode == 0) __builtin_amdgcn_s_waitcnt(0x0F70);
        if (!has_next) break;
#pragma unroll
        for (int a = 0; a < 2; ++a)
#pragma unroll
            for (int b = 0; b < 2; ++b)
#pragma unroll
                for (int m = 0; m < 4; ++m)
#pragma unroll
                    for (int n = 0; n < 2; ++n) acc[a][b][m][n] = (f32x4){0.f, 0.f, 0.f, 0.f};
        cur = nxt; cA = nA; cB = nB; ++ui;
    }
    PG8_WAIT_V(0);
    if (wr == 0) PG8_BAR;
    PG8_BAR;
    if (E.mode == 8) E.fused(acc, cur, wr, wc, fr, fq);
#undef PG8_SA
#undef PG8_SB
#undef PG8_STAGE
#undef PG8_LDA
#undef PG8_LDB
#undef PG8_MMA
#undef PG8_WAIT_V
#undef PG8_WAIT_L
#undef PG8_BAR
#undef PG8_SCHED
}
}

struct Params {
    const float *x, *mem, *norm_mix_g, *w_in, *lb_logits, *hgrn_norm_g, *w_pool, *pool_scale, *w_out, *norm_x_g, *norm_mem_g, *w_xq, *w_xk, *w_xv, *w_xo, *norm_ffn_g, *w_ff1, *w_ff2, *final_norm_g;
    float* out; unsigned char* ws;
    int ph_lo, ph_hi;
};

struct TD { const float* W; const float* g; bf16_t* out; int N, ldo, kt, nt; };
__device__ __forceinline__ TD tile_desc(const Params& p, int t) {
    unsigned char* ws = p.ws; TD d;
    if (t < 320)       { d.W = p.w_in;  d.g = p.norm_mix_g; d.out = (bf16_t*)(ws + WS_WT_IN);  d.N = NIN;  d.ldo = 1024; d.kt = t / 40; d.nt = t % 40; }
    else if (t < 448)  { const int u = t - 320;  d.W = p.w_xk;  d.g = p.norm_mem_g; d.out = (bf16_t*)(ws + WS_WT_K);   d.N = 1024; d.ldo = 1024; d.kt = u / 16; d.nt = u % 16; }
    else if (t < 576)  { const int u = t - 448;  d.W = p.w_xv;  d.g = p.norm_mem_g; d.out = (bf16_t*)(ws + WS_WT_V);   d.N = 1024; d.ldo = 1024; d.kt = u / 16; d.nt = u % 16; }
    else if (t < 704)  { const int u = t - 576;  d.W = p.w_xq;  d.g = p.norm_x_g;   d.out = (bf16_t*)(ws + WS_WT_Q);   d.N = 1024; d.ldo = 1024; d.kt = u / 16; d.nt = u % 16; }
    else if (t < 832)  { const int u = t - 704;  d.W = p.w_xo;  d.g = nullptr;      d.out = (bf16_t*)(ws + WS_WT_O);   d.N = 1024; d.ldo = 1024; d.kt = u / 16; d.nt = u % 16; }
    else if (t < 960)  { const int u = t - 832;  d.W = p.w_out; d.g = nullptr;      d.out = (bf16_t*)(ws + WS_WT_OUT); d.N = 1024; d.ldo = 1024; d.kt = u / 16; d.nt = u % 16; }
    else if (t < 1472) { const int u = t - 960;  d.W = p.w_ff1; d.g = p.norm_ffn_g; d.out = (bf16_t*)(ws + WS_WT_FF1); d.N = DFF;  d.ldo = 1024; d.kt = u / 64; d.nt = u % 64; }
    else               { const int u = t - 1472; d.W = p.w_ff2; d.g = nullptr;      d.out = (bf16_t*)(ws + WS_WT_FF2); d.N = 1024; d.ldo = 4096; d.kt = u / 16; d.nt = u % 16; }
    return d;
}
__device__ __forceinline__ void tile_load(const TD& d, f32x4 (&v)[4], float (&sc)[4]) {
    const int tid = threadIdx.x, r = tid >> 4, c4 = tid & 15;
#pragma unroll
    for (int i = 0; i < 4; ++i) { const int k = 128 * d.kt + r + 32 * i; v[i] = __builtin_nontemporal_load((const f32x4*)(d.W + (size_t)k * d.N + 64 * d.nt + 4 * c4)); sc[i] = d.g ? d.g[k] : 1.0f; }
}
__device__ __forceinline__ void transpose_range(const Params& p, unsigned char* lds, int t_begin, int t_end, int first, int stride) {
    bf16_t* T0 = (bf16_t*)lds;
    bf16_t* T1 = (bf16_t*)(lds + 17408);
    const int tid = threadIdx.x, r = tid >> 4, c4 = tid & 15, n = tid >> 3, ks = tid & 7;
    int ta = t_begin + first;
    if (ta >= t_end) return;
    int tb = ta + stride; bool hb = tb < t_end;
    TD da = tile_desc(p, ta), db = da; f32x4 va[4], vb[4]; float sa[4], sb[4];
    tile_load(da, va, sa);
    if (hb) { db = tile_desc(p, tb); tile_load(db, vb, sb); }
    for (;;) {
#pragma unroll
        for (int i = 0; i < 4; ++i) { const int kl = r + 32 * i;
            T0[(4 * c4 + 0) * 136 + kl] = f2bf(va[i][0] * sa[i]); T0[(4 * c4 + 1) * 136 + kl] = f2bf(va[i][1] * sa[i]);
            T0[(4 * c4 + 2) * 136 + kl] = f2bf(va[i][2] * sa[i]); T0[(4 * c4 + 3) * 136 + kl] = f2bf(va[i][3] * sa[i]); }
        if (hb) {
#pragma unroll
            for (int i = 0; i < 4; ++i) { const int kl = r + 32 * i;
                T1[(4 * c4 + 0) * 136 + kl] = f2bf(vb[i][0] * sb[i]); T1[(4 * c4 + 1) * 136 + kl] = f2bf(vb[i][1] * sb[i]);
                T1[(4 * c4 + 2) * 136 + kl] = f2bf(vb[i][2] * sb[i]); T1[(4 * c4 + 3) * 136 + kl] = f2bf(vb[i][3] * sb[i]); } }
        __syncthreads();
        const int tna = ta + 2 * stride, tnb = tna + stride; const bool hna = tna < t_end, hnb = tnb < t_end;
        const TD ca = da, cb = db; const bool chb = hb;
        if (hna) { da = tile_desc(p, tna); tile_load(da, va, sa); }
        if (hnb) { db = tile_desc(p, tnb); tile_load(db, vb, sb); }
        { const u32x4* src = (const u32x4*)(T0 + n * 136 + 16 * ks); const u32x4 a = src[0], b = src[1];
          u32x4* dst = (u32x4*)(ca.out + (size_t)(64 * ca.nt + n) * ca.ldo + 128 * ca.kt + 16 * ks); dst[0] = a; dst[1] = b; }
        if (chb) { const u32x4* src = (const u32x4*)(T1 + n * 136 + 16 * ks); const u32x4 a = src[0], b = src[1];
          u32x4* dst = (u32x4*)(cb.out + (size_t)(64 * cb.nt + n) * cb.ldo + 128 * cb.kt + 16 * ks); dst[0] = a; dst[1] = b; }
        __syncthreads();
        if (!hna) break;
        ta = tna; hb = hnb;
    }
}
__device__ __forceinline__ void phase_prep(const Params p, unsigned char* lds) {
    unsigned char* ws = p.ws;
    const int G = gridDim.x;
    {
        const int lane = threadIdx.x & 63, gw = blockIdx.x * (NTHREADS / 64) + (threadIdx.x >> 6), nw = G * (NTHREADS / 64);
        int r = gw;
        f32x4 v[4], vn[4];
        if (r < MROWS + MEMROWS) { const float* src = r < MROWS ? p.x + (size_t)r * DM : p.mem + (size_t)(r - MROWS) * DM;
#pragma unroll
            for (int i = 0; i < 4; ++i) v[i] = __builtin_nontemporal_load((const f32x4*)src + lane + 64 * i); }
        for (; r < MROWS + MEMROWS; r += nw) {
            const int rn = r + nw;
            if (rn < MROWS + MEMROWS) { const float* src = rn < MROWS ? p.x + (size_t)rn * DM : p.mem + (size_t)(rn - MROWS) * DM;
#pragma unroll
                for (int i = 0; i < 4; ++i) vn[i] = __builtin_nontemporal_load((const f32x4*)src + lane + 64 * i); }
            const bool isx = r < MROWS;
            bf16_t* dst = isx ? (bf16_t*)(ws + WS_XB) + (size_t)r * DM : (bf16_t*)(ws + WS_MEMB) + (size_t)(r - MROWS) * DM;
            float ss = 0.f;
#pragma unroll
            for (int i = 0; i < 4; ++i) ss += (v[i][0] * v[i][0] + v[i][1] * v[i][1]) + (v[i][2] * v[i][2] + v[i][3] * v[i][3]);
#pragma unroll
            for (int o = 1; o < 64; o <<= 1) ss += __shfl_xor(ss, o);
#pragma unroll
            for (int i = 0; i < 4; ++i) { u32x2 w; w.x = cvt_pk_bf16(v[i][0], v[i][1]); w.y = cvt_pk_bf16(v[i][2], v[i][3]); ((u32x2*)dst)[lane + 64 * i] = w; }
            if (lane == 0) { const float rstd = rsqrtf(ss * (1.0f / 1024.0f) + EPS); if (isx) ((float*)(ws + WS_RSTD0))[r] = rstd; else ((float*)(ws + WS_RSTDM))[r - MROWS] = rstd; }
#pragma unroll
            for (int i = 0; i < 4; ++i) v[i] = vn[i];
        }
    }
    transpose_range(p, lds, 0, 576, blockIdx.x, G);
}
__device__ __forceinline__ void deferred_prep(const Params p, unsigned char* lds, int j, int nworkers) {
    transpose_range(p, lds, 576, 1984, j, nworkers);
}
__device__ __forceinline__ void fold_pool_weights_mfma(const Params& p) {
    bf16_t* wto = (bf16_t*)(p.ws + WS_WT_OUT);
    const int tid = threadIdx.x, w = tid >> 6, lane = tid & 63, fr = lane & 15, q = lane >> 4;
    for (int item = blockIdx.x; item < 256; item += gridDim.x) {
        const int gi = item >> 6, nb = item & 63;
        f32x4 acc = (f32x4){0.f, 0.f, 0.f, 0.f};
        const float* wp = p.w_pool + (size_t)(gi * 128 + 16 * w + fr) * 128;
        const float* ps = p.pool_scale + gi * 128;
        const bf16_t* arow = wto + (size_t)(16 * nb + fr) * 1024 + 512 + gi * 128;
#pragma unroll
        for (int ks = 0; ks < 4; ++ks) {
            const int d0 = 32 * ks + 8 * q;
            const f32x4 w0 = *(const f32x4*)(wp + d0), w1 = *(const f32x4*)(wp + d0 + 4), s0 = *(const f32x4*)(ps + d0), s1 = *(const f32x4*)(ps + d0 + 4);
            const bf16x8 cfr = mk8u(cvt_pk_bf16(w0[0] * s0[0], w0[1] * s0[1]), cvt_pk_bf16(w0[2] * s0[2], w0[3] * s0[3]), cvt_pk_bf16(w1[0] * s1[0], w1[1] * s1[1]), cvt_pk_bf16(w1[2] * s1[2], w1[3] * s1[3]));
            const bf16x8 nfr = *(const bf16x8*)(arow + d0);
            acc = mfma16(cfr, nfr, acc);
        }
        asm volatile("s_waitcnt vmcnt(0)" ::: "memory");
        __syncthreads();
        u32x2 o; o.x = cvt_pk_bf16(acc[0], acc[1]); o.y = cvt_pk_bf16(acc[2], acc[3]);
        *(u32x2*)(wto + (size_t)(16 * nb + fr) * 1024 + 512 + gi * 128 + 16 * w + 4 * q) = o;
        __syncthreads();
    }
}

__device__ __forceinline__ void phase_passA(const bf16_t* __restrict__ KH, const float* __restrict__ LF, const bf16_t* __restrict__ VH, bf16_t* __restrict__ LT, float* __restrict__ DEC, unsigned char* lds) {
    const int tid = threadIdx.x, ch = tid & 127, seg = tid >> 7, G = gridDim.x;
    float* segtot = (float*)lds;
    unsigned char* KdT = lds + 2048;
    unsigned char* VTl = lds + 2048 + 18432;
    const int w = tid >> 6, lane = tid & 63, fr = lane & 15, q = lane >> 4;
    float lf[16], kk[16]; unsigned vr[16];
    int unit = blockIdx.x;
    if (unit < 1024) { const int b = unit >> 8, c = (unit >> 2) & 63, h = unit & 3; const size_t g0 = (size_t)(b * SEQ + c * 64 + seg * 16) * 512 + h * 128 + ch;
#pragma unroll
        for (int i = 0; i < 16; ++i) { lf[i] = LF[g0 + (size_t)i * 512]; vr[i] = VH[g0 + (size_t)i * 512]; } }
    for (; unit < 1024; unit += G) {
        const int b = unit >> 8, c = (unit >> 2) & 63, h = unit & 3, bh = b * 4 + h;
#pragma unroll
        for (int i = 0; i < 16; ++i) kk[i] = 1.0f - __expf(lf[i]);
#pragma unroll
        for (int i = 1; i < 16; ++i) lf[i] += lf[i - 1];
        segtot[seg * 128 + ch] = lf[15];
        __syncthreads();
        float after = 0.f;
#pragma unroll
        for (int s2 = 1; s2 < 4; ++s2) if (s2 > seg) after += segtot[s2 * 128 + ch];
        const float tot = after + lf[15];
        if (seg == 0) DEC[(size_t)(bh * 64 + c) * 128 + ch] = __expf(tot);
        unsigned kd[8], vp[8];
#pragma unroll
        for (int i = 0; i < 8; ++i) {
            kd[i] = cvt_pk_bf16(kk[2 * i] * __expf(tot - lf[2 * i]), kk[2 * i + 1] * __expf(tot - lf[2 * i + 1]));
            vp[i] = vr[2 * i] | (vr[2 * i + 1] << 16);
        }
        { u32x4* d = (u32x4*)(KdT + ch * 144 + seg * 32); d[0] = (u32x4){kd[0], kd[1], kd[2], kd[3]}; d[1] = (u32x4){kd[4], kd[5], kd[6], kd[7]}; }
        { u32x4* d = (u32x4*)(VTl + ch * 144 + seg * 32); d[0] = (u32x4){vp[0], vp[1], vp[2], vp[3]}; d[1] = (u32x4){vp[4], vp[5], vp[6], vp[7]}; }
        __syncthreads();
        {
            const int un = unit + G;
            if (un < 1024) { const int b2 = un >> 8, c2 = (un >> 2) & 63, h2 = un & 3; const size_t g0 = (size_t)(b2 * SEQ + c2 * 64 + seg * 16) * 512 + h2 * 128 + ch;
#pragma unroll
                for (int i = 0; i < 16; ++i) { lf[i] = LF[g0 + (size_t)i * 512]; vr[i] = VH[g0 + (size_t)i * 512]; } }
        }
        bf16x8 a[2];
#pragma unroll
        for (int ks = 0; ks < 2; ++ks) a[ks] = *(const bf16x8*)(KdT + (16 * w + fr) * 144 + (32 * ks + 8 * q) * 2);
        bf16_t* ltp = LT + (size_t)(bh * 64 + c) * 16384;
#pragma unroll
        for (int vb = 0; vb < 8; ++vb) {
            f32x4 acc = (f32x4){0.f, 0.f, 0.f, 0.f};
#pragma unroll
            for (int ks = 0; ks < 2; ++ks) { const bf16x8 bfr = *(const bf16x8*)(VTl + (16 * vb + fr) * 144 + (32 * ks + 8 * q) * 2); acc = mfma16(a[ks], bfr, acc); }
            u32x2 pk; pk.x = cvt_pk_bf16(acc[0], acc[1]); pk.y = cvt_pk_bf16(acc[2], acc[3]);
            *(u32x2*)(ltp + (size_t)(16 * vb + fr) * 128 + 16 * w + 4 * q) = pk;
        }
        __syncthreads();
    }
}

template <int W>
__device__ __forceinline__ void pool_body(const bf16_t* __restrict__ PH, bf16_t* __restrict__ MIXED, int r0, int s0, int c0) {
    unsigned v[31 + W];
#pragma unroll
    for (int j = 1; j < W; ++j) v[W - 1 - j] = (s0 - j >= 0) ? *(const unsigned*)(PH + (size_t)(r0 - j) * 512 + c0) : 0u;
#pragma unroll
    for (int tt = 0; tt < 32; ++tt) v[W - 1 + tt] = *(const unsigned*)(PH + (size_t)(r0 + tt) * 512 + c0);
    float sx = 0.f, sy = 0.f;
#pragma unroll
    for (int j = 1; j < W; ++j) { sx += bflo(v[W - 1 - j]); sy += bfhi(v[W - 1 - j]); }
#pragma unroll
    for (int tt = 0; tt < 32; ++tt) {
        const int s = s0 + tt;
        const float px = bflo(v[W - 1 + tt]), py = bfhi(v[W - 1 + tt]);
        sx += px; sy += py;
        const int cnt = (s + 1) < W ? (s + 1) : W;
        const float inv = __builtin_amdgcn_rcpf((float)cnt);
        *(unsigned*)(MIXED + (size_t)(r0 + tt) * 1024 + 512 + c0) = cvt_pk_bf16(sx * inv - px, sy * inv - py);
        sx -= bflo(v[tt]); sy -= bfhi(v[tt]);
    }
}
__device__ __forceinline__ void pool_tile(const bf16_t* __restrict__ PH, bf16_t* __restrict__ MIXED, int tile) {
    const int tid = threadIdx.x, cp = tid & 255, th = tid >> 8, c0 = 2 * cp, gi = c0 >> 7;
    const int r0 = tile * 64 + th * 32, s0 = r0 & (SEQ - 1);
    if (gi == 0) pool_body<2>(PH, MIXED, r0, s0, c0);
    else if (gi == 1) pool_body<4>(PH, MIXED, r0, s0, c0);
    else if (gi == 2) pool_body<8>(PH, MIXED, r0, s0, c0);
    else pool_body<16>(PH, MIXED, r0, s0, c0);
}

__device__ __forceinline__ void phase_scan(const bf16_t* LT, const float* __restrict__ DEC, bf16_t* ST) {
    for (int e2 = blockIdx.x * NTHREADS + threadIdx.x; e2 < 131072; e2 += gridDim.x * NTHREADS) {
        const int bh = e2 >> 13, v = (e2 >> 6) & 127, kp = e2 & 63;
        float sx = 0.f, sy = 0.f;
        const size_t base = (size_t)bh * 64 * 16384 + (size_t)v * 128 + 2 * kp;
        const float* dp = DEC + (size_t)bh * 64 * 128 + 2 * kp;
        for (int c0 = 0; c0 < 64; c0 += 32) {
            unsigned l[32]; f32x2 d[32];
#pragma unroll
            for (int j = 0; j < 32; ++j) { l[j] = *(const unsigned*)(LT + base + (size_t)(c0 + j) * 16384); d[j] = *(const f32x2*)(dp + (c0 + j) * 128); }
#pragma unroll
            for (int j = 0; j < 32; ++j) {
                *(unsigned*)(ST + base + (size_t)(c0 + j) * 16384) = cvt_pk_bf16(sx, sy);
                sx = d[j][0] * sx + bflo(l[j]); sy = d[j][1] * sy + bfhi(l[j]);
            }
        }
    }
}

__device__ __forceinline__ void phase_passC(const bf16_t* __restrict__ QH, const bf16_t* __restrict__ KH, const float* __restrict__ LF, const bf16_t* __restrict__ VH, const bf16_t* __restrict__ GH,
                                const bf16_t* __restrict__ ST, const float* __restrict__ hg, bf16_t* __restrict__ MIXED, unsigned char* lds) {
    const int tid = threadIdx.x, ch = tid & 127, seg = tid >> 7, G = gridDim.x;
    float lf[16], kk[16]; unsigned qr[16], vr[16];
    int unit = blockIdx.x;
    if (unit < 1024) { const int b = unit >> 8, c = (unit >> 2) & 63, h = unit & 3; const size_t g0 = (size_t)(b * SEQ + c * 64 + seg * 16) * 512 + h * 128 + ch;
#pragma unroll
        for (int i = 0; i < 16; ++i) { lf[i] = LF[g0 + (size_t)i * 512]; vr[i] = VH[g0 + (size_t)i * 512]; qr[i] = QH[g0 + (size_t)i * 512]; } }
  for (; unit < 1024; unit += G) {
    const int b = unit >> 8, c = (unit >> 2) & 63, h = unit & 3;
    const int row0 = b * SEQ + c * 64, bh = b * 4 + h;
    float* segtot = (float*)lds;
    float* rmsp = (float*)(lds + 2048);
    bf16_t* QC = (bf16_t*)(lds + 4096);
    bf16_t* QT = (bf16_t*)(lds + 21504);
    constexpr int KT0 = 38912;
    unsigned char* VTl = lds + 82432;
    const int w = tid >> 6, lane = tid & 63, fr = lane & 15, q = lane >> 4;
    const int i = w & 3, vh = w >> 2;
    const size_t row = (size_t)(row0 + 16 * i + fr);
    u32x2 gt[4]; f32x4 gg[4]; bf16x8 stf[4][4];
    {
        const bf16_t* stp = ST + (size_t)(bh * 64 + c) * 16384;
#pragma unroll
        for (int vbl = 0; vbl < 4; ++vbl) { const int v0 = 16 * (vh * 4 + vbl) + 4 * q; gt[vbl] = *(const u32x2*)(GH + row * 512 + h * 128 + v0); gg[vbl] = *(const f32x4*)(hg + h * 128 + v0);
#pragma unroll
            for (int ks = 0; ks < 4; ++ks) stf[ks][vbl] = *(const bf16x8*)(stp + (size_t)(16 * (vh * 4 + vbl) + fr) * 128 + 32 * ks + 8 * q); }
    }
#pragma unroll
    for (int i2 = 0; i2 < 16; ++i2) kk[i2] = 1.0f - __expf(lf[i2]);
#pragma unroll
    for (int i2 = 1; i2 < 16; ++i2) lf[i2] += lf[i2 - 1];
    segtot[seg * 128 + ch] = lf[15];
    {
        unsigned vp[8];
#pragma unroll
        for (int i2 = 0; i2 < 8; ++i2) vp[i2] = vr[2 * i2] | (vr[2 * i2 + 1] << 16);
        u32x4* d = (u32x4*)(VTl + ch * 144 + seg * 32); d[0] = (u32x4){vp[0], vp[1], vp[2], vp[3]}; d[1] = (u32x4){vp[4], vp[5], vp[6], vp[7]};
    }
    __syncthreads();
    const float t0 = segtot[ch], t1 = segtot[128 + ch], t2 = segtot[256 + ch];
    const float P = (seg > 0 ? t0 : 0.f) + (seg > 1 ? t1 : 0.f) + (seg > 2 ? t2 : 0.f);
    {
        const float eP = __expf(P);
#pragma unroll
        for (int i2 = 0; i2 < 16; ++i2) {
            const float qv = bflo(qr[i2]);
            const float el = __expf(lf[i2]);
            QT[(seg * 16 + i2) * 136 + ch] = f2bf(qv * el);
            QC[(seg * 16 + i2) * 136 + ch] = f2bf(qv * el * eP);
        }
        float E = 0.f;
#pragma unroll
        for (int i2 = 0; i2 < 4; ++i2) {
            if (i2 >= seg) {
                bf16_t* KT = (bf16_t*)(lds + KT0 + 4352 * ((i2 * (i2 + 1)) / 2));
#pragma unroll
                for (int j = 0; j < 16; ++j) KT[(seg * 16 + j) * 136 + ch] = f2bf(kk[j] * __expf(E - lf[j]));
                E += (i2 == 0 ? t0 : (i2 == 1 ? t1 : t2));
            }
        }
    }
    __syncthreads();
    {
        const int un = unit + G;
        if (un < 1024) { const int b2 = un >> 8, c2 = (un >> 2) & 63, h2 = un & 3; const size_t g2 = (size_t)(b2 * SEQ + c2 * 64 + seg * 16) * 512 + h2 * 128 + ch;
#pragma unroll
            for (int i2 = 0; i2 < 16; ++i2) { lf[i2] = LF[g2 + (size_t)i2 * 512]; vr[i2] = VH[g2 + (size_t)i2 * 512]; qr[i2] = QH[g2 + (size_t)i2 * 512]; } }
    }
    f32x4 sT[4];
#pragma unroll
    for (int j = 0; j < 4; ++j) sT[j] = (f32x4){0.f, 0.f, 0.f, 0.f};
    {
        bf16x8 qfr[4];
#pragma unroll
        for (int ks = 0; ks < 4; ++ks) qfr[ks] = *(const bf16x8*)((const unsigned char*)QT + (16 * i + fr) * 272 + (32 * ks + 8 * q) * 2);
        const unsigned char* KT = lds + KT0 + 4352 * ((i * (i + 1)) / 2);
#pragma unroll
        for (int j = 0; j < 4; ++j) if (j <= i) {
#pragma unroll
            for (int ks = 0; ks < 4; ++ks) { const bf16x8 a = *(const bf16x8*)(KT + (16 * j + fr) * 272 + (32 * ks + 8 * q) * 2); sT[j] = mfma16(a, qfr[ks], sT[j]); }
            if (j == i) {
#pragma unroll
                for (int rg = 0; rg < 4; ++rg) if (4 * q + rg > fr) sT[j][rg] = 0.f;
            }
        }
    }
    f32x4 oacc[4];
#pragma unroll
    for (int vbl = 0; vbl < 4; ++vbl) oacc[vbl] = (f32x4){0.f, 0.f, 0.f, 0.f};
#pragma unroll
    for (int m = 0; m < 2; ++m) if (2 * m <= i) {
        const bf16x8 bfrag = mk8u(cvt_pk_bf16(sT[2 * m][0], sT[2 * m][1]), cvt_pk_bf16(sT[2 * m][2], sT[2 * m][3]), cvt_pk_bf16(sT[2 * m + 1][0], sT[2 * m + 1][1]), cvt_pk_bf16(sT[2 * m + 1][2], sT[2 * m + 1][3]));
#pragma unroll
        for (int vbl = 0; vbl < 4; ++vbl) {
            const unsigned char* base = VTl + (16 * (vh * 4 + vbl) + fr) * 144 + (32 * m + 4 * q) * 2;
            const bf16x8 a = mk8(*(const u32x2*)base, *(const u32x2*)(base + 32));
            oacc[vbl] = mfma16(a, bfrag, oacc[vbl]);
        }
    }
    {
#pragma unroll
        for (int ks = 0; ks < 4; ++ks) {
            const bf16x8 bfr = *(const bf16x8*)((const unsigned char*)QC + (16 * i + fr) * 272 + (32 * ks + 8 * q) * 2);
#pragma unroll
            for (int vbl = 0; vbl < 4; ++vbl) oacc[vbl] = mfma16(stf[ks][vbl], bfr, oacc[vbl]);
        }
    }
    float ss = 0.f;
#pragma unroll
    for (int vbl = 0; vbl < 4; ++vbl) ss += (oacc[vbl][0] * oacc[vbl][0] + oacc[vbl][1] * oacc[vbl][1]) + (oacc[vbl][2] * oacc[vbl][2] + oacc[vbl][3] * oacc[vbl][3]);
    ss += __shfl_xor(ss, 16); ss += __shfl_xor(ss, 32);
    if (q == 0) rmsp[vh * 64 + 16 * i + fr] = ss;
    __syncthreads();
    const float rstd = rsqrtf((rmsp[16 * i + fr] + rmsp[64 + 16 * i + fr]) * (1.0f / 128.0f) + EPS);
#pragma unroll
    for (int vbl = 0; vbl < 4; ++vbl) {
        const int v0 = 16 * (vh * 4 + vbl) + 4 * q;
        u32x2 o;
        o.x = cvt_pk_bf16(oacc[vbl][0] * rstd * gg[vbl][0] * bflo(gt[vbl].x), oacc[vbl][1] * rstd * gg[vbl][1] * bfhi(gt[vbl].x));
        o.y = cvt_pk_bf16(oacc[vbl][2] * rstd * gg[vbl][2] * bflo(gt[vbl].y), oacc[vbl][3] * rstd * gg[vbl][3] * bfhi(gt[vbl].y));
        *(u32x2*)(MIXED + row * 1024 + h * 128 + v0) = o;
    }
    __syncthreads();
  }
}

__device__ __forceinline__ void attn_unit(const bf16_t* __restrict__ XQ, const bf16_t* __restrict__ KX, const bf16_t* __restrict__ VT, bf16_t* __restrict__ ATT, int unit, unsigned char* lds) {
    const int tid = threadIdx.x, w = tid >> 6, lane = tid & 63, r = lane & 31, hh = lane >> 5;
    const int b = unit >> 6, st = (unit >> 2) & 15, h = unit & 3;
    const int row0 = b * SEQ + st * 256;
    const bf16_t* qp = XQ + (size_t)(row0 + 32 * w + r) * 1024 + h * 256 + 8 * hh;
    {
        const bf16_t* kp = KX + (size_t)(b * 256) * 1024 + h * 256;
        u32x4 kv[16];
#pragma unroll
        for (int it = 0; it < 16; ++it) { const int idx = tid + 512 * it, m = idx >> 5, cc = idx & 31; kv[it] = *(const u32x4*)(kp + (size_t)m * 1024 + cc * 8); }
#pragma unroll
        for (int it = 0; it < 16; ++it) { const int idx = tid + 512 * it, m = idx >> 5, cc = idx & 31; *(u32x4*)(lds + m * 528 + cc * 16) = kv[it]; }
    }
    __syncthreads();
    f32x16 sacc[8];
#pragma unroll
    for (int mb = 0; mb < 8; ++mb)
#pragma unroll
        for (int e = 0; e < 16; ++e) sacc[mb][e] = 0.f;
    {
        bf16x8 qf[4], qn[4];
#pragma unroll
        for (int k4 = 0; k4 < 4; ++k4) qf[k4] = *(const bf16x8*)(qp + 16 * k4);
#pragma unroll
        for (int kg = 0; kg < 4; ++kg) {
            if (kg < 3) {
#pragma unroll
                for (int k4 = 0; k4 < 4; ++k4) qn[k4] = *(const bf16x8*)(qp + 16 * (4 * (kg + 1) + k4)); }
#pragma unroll
            for (int k4 = 0; k4 < 4; ++k4)
#pragma unroll
                for (int mb = 0; mb < 8; ++mb) { const bf16x8 a = *(const bf16x8*)(lds + (32 * mb + r) * 528 + (16 * (4 * kg + k4) + 8 * hh) * 2); sacc[mb] = mfma32(a, qf[k4], sacc[mb]); }
#pragma unroll
            for (int k4 = 0; k4 < 4; ++k4) qf[k4] = qn[k4];
        }
    }
    float mx = -3.0e38f;
#pragma unroll
    for (int mb = 0; mb < 8; ++mb)
#pragma unroll
        for (int e = 0; e < 16; ++e) mx = fmaxf(mx, sacc[mb][e]);
    mx = fmaxf(mx, __shfl_xor(mx, 32));
    float sum = 0.f;
    bf16x8 pf[8][2];
#pragma unroll
    for (int mb = 0; mb < 8; ++mb) {
        float pv[16];
#pragma unroll
        for (int e = 0; e < 16; ++e) { pv[e] = __expf(sacc[mb][e] - mx); sum += pv[e]; }
#pragma unroll
        for (int s = 0; s < 2; ++s) pf[mb][s] = mk8u(cvt_pk_bf16(pv[8 * s + 0], pv[8 * s + 1]), cvt_pk_bf16(pv[8 * s + 2], pv[8 * s + 3]), cvt_pk_bf16(pv[8 * s + 4], pv[8 * s + 5]), cvt_pk_bf16(pv[8 * s + 6], pv[8 * s + 7]));
    }
    sum += __shfl_xor(sum, 32);
    const float inv = 1.0f / sum;
    __syncthreads();
    {
        const bf16_t* vp = VT + (size_t)(h * 256) * 1024 + b * 256;
        u32x4 vv[16];
#pragma unroll
        for (int it = 0; it < 16; ++it) { const int idx = tid + 512 * it, e = idx >> 5, cc = idx & 31; vv[it] = *(const u32x4*)(vp + (size_t)e * 1024 + cc * 8); }
#pragma unroll
        for (int it = 0; it < 16; ++it) { const int idx = tid + 512 * it, e = idx >> 5, cc = idx & 31;
            u32x2* d = (u32x2*)(lds + e * 520 + cc * 16); d[0] = (u32x2){vv[it].x, vv[it].y}; d[1] = (u32x2){vv[it].z, vv[it].w}; }
    }
    __syncthreads();
    bf16_t* op = ATT + (size_t)(row0 + 32 * w + r) * 1024 + h * 256 + 4 * hh;
#pragma unroll
    for (int half = 0; half < 2; ++half) {
        f32x16 oacc[4];
#pragma unroll
        for (int d = 0; d < 4; ++d)
#pragma unroll
            for (int e = 0; e < 16; ++e) oacc[d][e] = 0.f;
#pragma unroll
        for (int mb = 0; mb < 8; ++mb)
#pragma unroll
            for (int s = 0; s < 2; ++s)
#pragma unroll
                for (int d = 0; d < 4; ++d) {
                    const unsigned char* base = lds + (32 * (half * 4 + d) + r) * 520 + (32 * mb + 16 * s + 4 * hh) * 2;
                    const bf16x8 a = mk8(*(const u32x2*)base, *(const u32x2*)(base + 16));
                    oacc[d] = mfma32(a, pf[mb][s], oacc[d]);
                }
#pragma unroll
        for (int d = 0; d < 4; ++d)
#pragma unroll
            for (int g = 0; g < 4; ++g) {
                u32x2 o; o.x = cvt_pk_bf16(oacc[d][4 * g] * inv, oacc[d][4 * g + 1] * inv); o.y = cvt_pk_bf16(oacc[d][4 * g + 2] * inv, oacc[d][4 * g + 3] * inv);
                *(u32x2*)(op + 32 * (half * 4 + d) + 8 * g) = o;
            }
    }
    __syncthreads();
}

__device__ __forceinline__ void phase_final(const bf16_t* __restrict__ xb, const float* __restrict__ ssq, float* __restrict__ out, const float* __restrict__ g) {
    const int tid = threadIdx.x, sub = tid >> 7, l = tid & 127;
    const f32x4 g0 = *(const f32x4*)(g + 8 * l), g1 = *(const f32x4*)(g + 8 * l + 4);
    for (int r = blockIdx.x * 4 + sub; r < MROWS; r += gridDim.x * 4) {
        const u32x4 v = *(const u32x4*)(xb + (size_t)r * DM + 8 * l);
        const f32x4* pp = (const f32x4*)(ssq + (size_t)r * 16); const f32x4 a = pp[0], b = pp[1], c = pp[2], d = pp[3];
        const float t = ((a[0] + a[1]) + (a[2] + a[3])) + ((b[0] + b[1]) + (b[2] + b[3])) + ((c[0] + c[1]) + (c[2] + c[3])) + ((d[0] + d[1]) + (d[2] + d[3]));
        const float rstd = rsqrtf(t * (1.0f / 1024.0f) + EPS);
        const f32x4 o0 = (f32x4){bflo(v.x), bfhi(v.x), bflo(v.y), bfhi(v.y)} * rstd * g0, o1 = (f32x4){bflo(v.z), bfhi(v.z), bflo(v.w), bfhi(v.w)} * rstd * g1;
        *(f32x4*)(out + (size_t)r * DM + 8 * l) = o0; *(f32x4*)(out + (size_t)r * DM + 8 * l + 4) = o1;
    }
}

#define XB_TMO      128
#define XB_XCNT(j)  (256  + 64 * (j))
#define XB_XSUB(j)  (1280 + 64 * (j))
#define XB_XGEN(j)  (2304 + 64 * (j))
#define XB_TOP      3328
#define XB_TOPGEN   3392
#define XCD_BAR_WORDS 3456
#define XB_SPIN_CAP (1u << 22)
__device__ __forceinline__ unsigned xb_ld(unsigned* p)              { return __hip_atomic_load(p, __ATOMIC_RELAXED, __HIP_MEMORY_SCOPE_AGENT); }
__device__ __forceinline__ unsigned xb_add(unsigned* p, unsigned v) { return __hip_atomic_fetch_add(p, v, __ATOMIC_RELAXED, __HIP_MEMORY_SCOPE_AGENT); }
__device__ __forceinline__ unsigned xb_xcc_id() { return (unsigned)__builtin_amdgcn_s_getreg((3 << 11) | 20) & 0xFu; }
#define XB_SPIN(cond, bar) do { unsigned _sp = 0; while (cond) { __builtin_amdgcn_s_sleep(1); \
    if ((++_sp & 255u) == 0u) { if (xb_ld(&(bar)[XB_TMO])) break; if (_sp > XB_SPIN_CAP) { atomicAdd(&(bar)[XB_TMO], 1u); break; } } } } while (0)
struct XcdBarrier { unsigned* bar; unsigned x; volatile LAS unsigned* st; };
__device__ __forceinline__ XcdBarrier xcd_barrier_post(unsigned* bar, volatile LAS unsigned* st) {
    XcdBarrier b; b.bar = bar; b.x = xb_xcc_id(); b.st = st;
    if (threadIdx.x == 0) (void)xb_add(&bar[XB_XCNT(b.x)], 1u);
    return b;
}
__device__ __forceinline__ void xcd_barrier_complete(unsigned* bar, unsigned x, unsigned& nloc, unsigned& nx) {
    const unsigned G = gridDim.x * gridDim.y * gridDim.z;
    unsigned sum, cnt, mine, sp = 0u;
    for (;;) {
        sum = 0u; cnt = 0u; mine = 0u;
#pragma unroll
        for (unsigned j = 0; j < 16; ++j) { const unsigned c = xb_ld(&bar[XB_XCNT(j)]); sum += c; cnt += (c > 0u) ? 1u : 0u; mine = (j == x) ? c : mine; }
        if (sum == G) break;
        __builtin_amdgcn_s_sleep(1);
        if ((++sp & 255u) == 0u) { if (xb_ld(&bar[XB_TMO])) break; if (sp > XB_SPIN_CAP) { atomicAdd(&bar[XB_TMO], 1u); break; } }
    }
    nloc = mine > 0u ? mine : 1u; nx = cnt > 0u ? cnt : 1u;
}
__device__ __forceinline__ void xcd_barrier(const XcdBarrier& b) {
    asm volatile("s_waitcnt vmcnt(0)" ::: "memory");
    __syncthreads();
    if (threadIdx.x == 0) {
        unsigned* bar = b.bar;
        __builtin_amdgcn_s_waitcnt(0);
        unsigned nloc = b.st[0], nx = b.st[1];
        if (nloc == 0u) { xcd_barrier_complete(bar, b.x, nloc, nx); b.st[0] = nloc; b.st[1] = nx; }
        const unsigned old = xb_add(&bar[XB_XSUB(b.x)], 1u);
        const unsigned gen = old / nloc;
        if (old + 1u == (gen + 1u) * nloc) {
            __builtin_amdgcn_fence(__ATOMIC_RELEASE, "agent");
            asm volatile("s_waitcnt vmcnt(0)" ::: "memory");
            const unsigned og = xb_add(&bar[XB_TOP], 1u);
            const unsigned tg = og / nx;
            if (og + 1u == (tg + 1u) * nx) xb_add(&bar[XB_TOPGEN], 1u);
            else XB_SPIN(xb_ld(&bar[XB_TOPGEN]) == tg, bar);
            __builtin_amdgcn_fence(__ATOMIC_ACQUIRE, "agent");
            asm volatile("s_waitcnt vmcnt(0)" ::: "memory");
        } else {
            XB_SPIN(xb_ld(&bar[XB_TOPGEN]) == gen, bar);
            __builtin_amdgcn_fence(__ATOMIC_ACQUIRE, "agent");
            asm volatile("s_waitcnt vmcnt(0)" ::: "memory");
        }
    }
    __syncthreads();
}

constexpr int N_PHASES = 12;
__global__ void __launch_bounds__(NTHREADS, 2) mega(Params p) {
    extern __shared__ __attribute__((aligned(16))) unsigned char lds[];
    LAS unsigned char* ldsl = (LAS unsigned char*)lds;
    unsigned char* ws = p.ws;
    const int G = gridDim.x, bid = blockIdx.x;
    const int lo = p.ph_lo, hi = p.ph_hi;

#ifndef DEFER_PREP
#define DEFER_PREP 0
#endif
#ifndef FUSE_FINAL
#define FUSE_FINAL 0
#endif
#ifndef DBG_LAST
#define DBG_LAST -1
#endif
#ifndef PHASE_MASK
#define PHASE_MASK 0xfff
#endif
#define IN(k) (((PHASE_MASK >> (k)) & 1) && lo <= (k) && (k) < hi)
    if (threadIdx.x == 0) { ((volatile LAS unsigned*)(ldsl + LDS_MAIN))[0] = 0u; ((volatile LAS unsigned*)(ldsl + LDS_MAIN))[1] = 0u; }
    __syncthreads();
    XcdBarrier xbar; xbar.bar = (unsigned*)(ws + WS_BAR); xbar.x = 0; xbar.st = nullptr;
    if (hi - lo > 1) xbar = xcd_barrier_post((unsigned*)(ws + WS_BAR), (volatile LAS unsigned*)(ldsl + LDS_MAIN));
    if (lo > hi) cg::this_grid().sync();
#define SEAM(k) do { if (IN(k) && IN((k) + 1)) { xcd_barrier(xbar); } } while (0)
    bf16_t* XB = (bf16_t*)(ws + WS_XB); bf16_t* LT = (bf16_t*)(ws + WS_ST);
    bf16_t* QH = (bf16_t*)(ws + WS_QH); bf16_t* KH = (bf16_t*)(ws + WS_KH); bf16_t* VH = (bf16_t*)(ws + WS_VH); bf16_t* GH = (bf16_t*)(ws + WS_GH); bf16_t* PH = (bf16_t*)(ws + WS_PH);
    float* LF = (float*)(ws + WS_LF); bf16_t* ST = (bf16_t*)(ws + WS_ST); bf16_t* MIXED = (bf16_t*)(ws + WS_MIXED);
    float* X1 = (float*)(ws + WS_X1); bf16_t* XQ = (bf16_t*)(ws + WS_XQ); bf16_t* ATT = (bf16_t*)(ws + WS_ATT); bf16_t* U = (bf16_t*)(ws + WS_U);
    float* SSQ = (float*)(ws + WS_SSQ); float* DEC = (float*)(ws + WS_DEC);
    bf16_t* MEMB = (bf16_t*)(ws + WS_MEMB); bf16_t* KX = (bf16_t*)(ws + WS_KX); bf16_t* VT = (bf16_t*)(ws + WS_VT);

    const bool fuse_final = FUSE_FINAL && (G == 256) && IN(10) && (hi - lo > 1);
    if (IN(0)) { phase_prep(p, lds);
#if !DEFER_PREP
        deferred_prep(p, lds, bid, G);
#endif
    }
    SEAM(0);
    if (IN(1)) {
        const pg8::Epi E{0, ws, p.x, p.out, p.lb_logits, p.final_norm_g};
        { pg8::Gemm g{XB, (const bf16_t*)(ws + WS_WT_IN), MROWS, NIN, DM}; pg8::StaticOrder S; S.init(MROWS, NIN, G, bid); pg8::gemm_phase(ldsl, g, S, E); }
        const pg8::Epi E1{1, ws, p.x, p.out, p.lb_logits, p.final_norm_g};
        { pg8::Gemm g{MEMB, (const bf16_t*)(ws + WS_WT_K), MEMROWS, 1024, DM}; pg8::StaticOrder S; S.init(MEMROWS, 1024, G, (bid + 128) % G); pg8::gemm_phase(ldsl, g, S, E1); }
        const pg8::Epi E2{2, ws, p.x, p.out, p.lb_logits, p.final_norm_g};
        { pg8::Gemm g{(const bf16_t*)(ws + WS_WT_V), MEMB, 1024, MEMROWS, DM}; pg8::StaticOrder S; S.init(1024, MEMROWS, G, (bid + 112) % G); pg8::gemm_phase(ldsl, g, S, E2); }
#if DEFER_PREP
        if (G == 256) { if (bid >= 160) deferred_prep(p, lds, bid - 160, 96); }
        else deferred_prep(p, lds, bid, G);
#endif
    }
    SEAM(1);
    if (IN(2)) {
#ifndef DBG_NO_PASSA
        phase_passA(KH, LF, VH, LT, DEC, lds);
#endif
#ifndef DBG_NO_POOL
        for (int t = bid; t < 256; t += G) pool_tile(PH, MIXED, t);
#endif
        fold_pool_weights_mfma(p);
    }
    SEAM(2);
    if (IN(3)) { phase_scan(LT, DEC, ST); }
    SEAM(3);
    if (IN(4)) { phase_passC(QH, KH, LF, VH, GH, ST, p.hgrn_norm_g, MIXED, lds); }
    SEAM(4);
    if (IN(5)) {
        const pg8::Epi E{6, ws, p.x, p.out, p.lb_logits, p.final_norm_g};
        pg8::Gemm g{MIXED, (const bf16_t*)(ws + WS_WT_OUT), MROWS, DM, DM}; pg8::StaticOrder S; S.init(MROWS, DM, G, bid); pg8::gemm_phase(ldsl, g, S, E);
    }
    SEAM(5);
    const bool fuse_attn = (G == 256) && IN(6) && IN(7);
    if (IN(6)) {
        const pg8::Epi E{4, ws, p.x, p.out, p.lb_logits, p.final_norm_g};
        pg8::Gemm g{XB, (const bf16_t*)(ws + WS_WT_Q), MROWS, DM, DM}; pg8::StaticOrder S; S.init(MROWS, DM, G, bid); pg8::gemm_phase(ldsl, g, S, E);
        if (fuse_attn) {
            pg8::Unit u; S.next(0, u);
            asm volatile("s_waitcnt vmcnt(0)" ::: "memory"); __syncthreads();
            attn_unit(XQ, KX, VT, ATT, u.pm * 4 + u.pn, lds);
        }
    }
    if (!fuse_attn) {
        SEAM(6);
        if (IN(7)) { for (int u = bid; u < 256; u += G) attn_unit(XQ, KX, VT, ATT, u, lds); }
    }
    SEAM(7);
    if (IN(8)) {
        const pg8::Epi E{6, ws, p.x, p.out, p.lb_logits, p.final_norm_g};
        pg8::Gemm g{ATT, (const bf16_t*)(ws + WS_WT_O), MROWS, DM, DM}; pg8::StaticOrder S; S.init(MROWS, DM, G, bid); pg8::gemm_phase(ldsl, g, S, E);
    }
    SEAM(8);
    if (IN(9)) {
        const pg8::Epi E{5, ws, p.x, p.out, p.lb_logits, p.final_norm_g};
        pg8::Gemm g{XB, (const bf16_t*)(ws + WS_WT_FF1), MROWS, DFF, DM}; pg8::StaticOrder S; S.init(MROWS, DFF, G, bid); pg8::gemm_phase(ldsl, g, S, E);
    }
    SEAM(9);
    if (IN(10)) {
        const pg8::Epi E{fuse_final ? 8 : 7, ws, p.x, p.out, p.lb_logits, p.final_norm_g};
        pg8::Gemm g{U, (const bf16_t*)(ws + WS_WT_FF2), MROWS, DM, DFF}; pg8::StaticOrder S; S.init(MROWS, DM, G, bid); pg8::gemm_phase(ldsl, g, S, E);
    }
    if (!fuse_final) {
        SEAM(10);
        if (IN(11)) { phase_final(XB, SSQ, p.out, p.final_norm_g); }
    }
#if DBG_LAST >= 0
    cg::this_grid().sync();
    {
        const unsigned* w32 = (const unsigned*)ws;
        for (size_t i = (size_t)bid * NTHREADS + threadIdx.x; i < (size_t)MROWS * DM; i += (size_t)G * NTHREADS) {
            float a = 0.f;
            for (int j = 0; j < 4; ++j) { const unsigned v = w32[i + (size_t)j * MROWS * DM]; a += (float)(v & 0xffffu) + (float)(v >> 16); }
            p.out[i] = a;
        }
    }
#endif
#undef IN
#undef SEAM
}

extern "C" void kernel_launch(void* const* d_in, const int* in_sizes, int n_in, void* d_out, int out_size, void* d_ws, size_t ws_size, hipStream_t stream) {
    static int grid = 0;
    if (grid == 0) {
        if (n_in != 19 || in_sizes[0] != MROWS * DM || out_size != MROWS * DM || ws_size < WS_END) { fprintf(stderr, "kernel_launch: unexpected shapes (n_in %d, ws %zu)\n", n_in, ws_size); grid = -1; return; }
        int dev = 0, cus = 0, per_cu = 0;
        hipGetDevice(&dev); hipDeviceGetAttribute(&cus, hipDeviceAttributeMultiprocessorCount, dev);
        if (hipFuncSetAttribute((const void*)mega, hipFuncAttributeMaxDynamicSharedMemorySize, LDS_BYTES) != hipSuccess) { fprintf(stderr, "kernel_launch: hipFuncSetAttribute failed\n"); grid = -1; return; }
        if (hipOccupancyMaxActiveBlocksPerMultiprocessor(&per_cu, (const void*)mega, NTHREADS, LDS_BYTES) != hipSuccess || per_cu < 1) { fprintf(stderr, "kernel_launch: occupancy query says %d\n", per_cu); per_cu = 1; }
        (void)hipGetLastError();
        grid = cus * 1;
        if (grid > cus * per_cu) grid = cus * per_cu;
    }
    if (grid < 0) return;
    if (hipMemsetAsync((char*)d_ws + WS_BAR, 0, 32768, stream) != hipSuccess) { fprintf(stderr, "kernel_launch: memset of barrier words failed\n"); return; }
    Params p{};
    const float** f = (const float**)&p;
    for (int i = 0; i < 19; ++i) f[i] = (const float*)d_in[i];
    p.out = (float*)d_out; p.ws = (unsigned char*)d_ws;
#if N_LAUNCH_MODE == 1
    p.ph_lo = 0; p.ph_hi = (DBG_LAST >= 0) ? DBG_LAST + 1 : N_PHASES;
    void* args[] = {&p};
    hipError_t e = hipLaunchCooperativeKernel((const void*)mega, dim3(grid), dim3(NTHREADS), args, LDS_BYTES, stream);
    if (e != hipSuccess) fprintf(stderr, "kernel_launch: cooperative launch failed: %s (grid %d)\n", hipGetErrorString(e), grid);
#else
    for (int k = 0; k < N_PHASES; ++k) { p.ph_lo = k; p.ph_hi = k + 1; hipLaunchKernelGGL(mega, dim3(grid), dim3(NTHREADS), LDS_BYTES, stream, p); }
#endif
}
```

```cpp
#include <hip/hip_runtime.h>
#include <hip/hip_cooperative_groups.h>
#include <cstdio>
namespace cg = cooperative_groups;

#ifndef N_LAUNCH_MODE
#define N_LAUNCH_MODE 1
#endif

typedef unsigned short bf16_t;
typedef short bf16x8 __attribute__((ext_vector_type(8)));
typedef float f32x2 __attribute__((ext_vector_type(2)));
typedef float f32x4 __attribute__((ext_vector_type(4)));
typedef float f32x16 __attribute__((ext_vector_type(16)));
typedef unsigned u32x2 __attribute__((ext_vector_type(2)));
typedef unsigned u32x4 __attribute__((ext_vector_type(4)));
#define LAS __attribute__((address_space(3)))

constexpr int MROWS = 16384, DM = 1024, SEQ = 4096, NIN = 2560, DFF = 4096, MEMROWS = 1024;
constexpr float EPS = 1e-6f;
constexpr int NTHREADS = 512;
constexpr int LDS_MAIN = 135168;
constexpr int LDS_BYTES = LDS_MAIN + 16;

constexpr size_t MiB = 1u << 20;
constexpr size_t WS_WT_IN = 0, WS_WT_K = 5 * MiB, WS_WT_V = 7 * MiB, WS_WT_OUT = 9 * MiB, WS_WT_Q = 11 * MiB, WS_WT_O = 13 * MiB,
                 WS_WT_FF1 = 15 * MiB, WS_WT_FF2 = 23 * MiB, WS_MEMB = 31 * MiB, WS_KX = 33 * MiB, WS_VT = 35 * MiB, WS_SSQ = 37 * MiB,
                 WS_BAR = 39 * MiB, WS_CNT = 39 * MiB + 16384, WS_RSTD0 = 38 * MiB, WS_RSTDM = 38 * MiB + 65536, WS_DEC = 38 * MiB + 131072,
                 WS_XB = 40 * MiB  , WS_QH = 72 * MiB, WS_KH = 88 * MiB, WS_VH = 104 * MiB, WS_GH = 120 * MiB, WS_PH = 136 * MiB,
                 WS_LF = 152 * MiB, WS_ST = 184 * MiB, WS_MIXED = 216 * MiB,
                 WS_X1 = 72 * MiB, WS_XQ = 136 * MiB, WS_ATT = 168 * MiB, WS_U = 72 * MiB, WS_END = 256 * MiB;

typedef __bf16 bf16x2n __attribute__((ext_vector_type(2)));
__device__ __forceinline__ unsigned cvt_pk_bf16(float lo, float hi) { f32x2 v = {lo, hi}; return __builtin_bit_cast(unsigned, __builtin_convertvector(v, bf16x2n)); }
__device__ __forceinline__ bf16_t f2bf(float f) { return (bf16_t)(cvt_pk_bf16(f, 0.f) & 0xffffu); }
__device__ __forceinline__ float bf2f(bf16_t b) { return __uint_as_float(((unsigned)b) << 16); }
__device__ __forceinline__ float bflo(unsigned u) { return __uint_as_float(u << 16); }
__device__ __forceinline__ float bfhi(unsigned u) { return __uint_as_float(u & 0xffff0000u); }
__device__ __forceinline__ f32x4 mfma16(bf16x8 a, bf16x8 b, f32x4 c) { return __builtin_amdgcn_mfma_f32_16x16x32_bf16(a, b, c, 0, 0, 0); }
__device__ __forceinline__ f32x16 mfma32(bf16x8 a, bf16x8 b, f32x16 c) { return __builtin_amdgcn_mfma_f32_32x32x16_bf16(a, b, c, 0, 0, 0); }
__device__ __forceinline__ bf16x8 mk8(u32x2 lo, u32x2 hi) { u32x4 t; t.x = lo.x; t.y = lo.y; t.z = hi.x; t.w = hi.y; return __builtin_bit_cast(bf16x8, t); }
__device__ __forceinline__ bf16x8 mk8u(unsigned a, unsigned b, unsigned c, unsigned d) { u32x4 t; t.x = a; t.y = b; t.z = c; t.w = d; return __builtin_bit_cast(bf16x8, t); }
__device__ __forceinline__ float sigmoidf_(float z) { return __builtin_amdgcn_rcpf(1.0f + __expf(-z)); }

namespace pg8 {
constexpr int BM = 256, BK = 64, HALF = 128, HTB = HALF * BK * 2, STAGE_BYTES = 8 * HTB, NXCD = 8, WGM = 8;
__device__ __forceinline__ int lds_byte(int r, int c) { const int st = (r >> 4) * 2 + (c >> 5), rr = r & 15, cc = c & 31, ob = rr * 64 + cc * 2; return st * 1024 + (ob ^ (((ob >> 9) & 1) << 5)); }
__device__ __forceinline__ void stage_rc(int b, int& R, int& C) { const int st = b / 1024, sb = b % 1024, swz = sb ^ (((sb >> 9) & 1) << 5); R = (st >> 1) * 16 + swz / 64; C = (st & 1) * 32 + (swz % 64) / 2; }
__device__ __forceinline__ int perm32(int rho) { const int n = rho >> 4, i = rho & 15; return 8 * (i >> 2) + 4 * n + (i & 3); }
struct Unit { int pm, pn; };
struct Gemm { const bf16_t* A; const bf16_t* Bt; int M, N, K; };
struct StaticOrder {
    int nM, nN, nwg, G, c;
    __device__ __forceinline__ void init(int M, int N, int G_, int c_) { nM = M / BM; nN = N / BM; nwg = nM * nN; G = G_; c = c_; }
    __device__ __forceinline__ bool next(int i, Unit& u) const {
        const long L = (long)i * G + c; if (L >= nwg) return false;
        int wgid = (int)L; { const int q = nwg / NXCD, r = nwg % NXCD, xcd = wgid % NXCD, off = wgid / NXCD; wgid = (xcd < r ? xcd * (q + 1) : r * (q + 1) + (xcd - r) * q) + off; }
        const int nig = WGM * nN, gid = wgid / nig, fm = gid * WGM, gsz = (nM - fm) < WGM ? (nM - fm) : WGM;
        u.pm = fm + ((wgid % nig) % gsz); u.pn = (wgid % nig) / gsz; return true;
    }
};

struct Epi {
    static constexpr bool PERM = true;
    int mode;
    unsigned char* ws; const float* x; float* out; const float* lbl; const float* gfin; int pnoff;
    __device__ __forceinline__ void store8(bf16_t* p, const f32x4& v0, const f32x4& v1) const {
        u32x4 w; w.x = cvt_pk_bf16(v0[0], v0[1]); w.y = cvt_pk_bf16(v0[2], v0[3]); w.z = cvt_pk_bf16(v1[0], v1[1]); w.w = cvt_pk_bf16(v1[2], v1[3]); *(u32x4*)p = w; }
    __device__ __forceinline__ void fused(f32x4 (&acc)[2][2][4][2], const Unit& u, int wr, int wc, int fr, int fq) const {
        const int row0 = u.pm * BM + wr * 64 + fr;
        const int col0 = u.pn * BM + wc * 32 + 8 * fq;
        const bf16_t* xb = (const bf16_t*)(ws + WS_XB);
        unsigned* sq = (unsigned*)(ws + WS_SSQ);
        unsigned* cnt = (unsigned*)(ws + WS_CNT) + 64 * u.pm;
        u32x4 bc[2], bn[2];
        { const size_t o = (size_t)row0 * DM + col0; bc[0] = *(const u32x4*)(xb + o); bc[1] = *(const u32x4*)(xb + o + HALF); }
#pragma unroll
        for (int gidx = 0; gidx < 8; ++gidx) { const int ai = gidx >> 2, m = gidx & 3; const int row = row0 + ai * HALF + m * 16;
            if (gidx < 7) { const int g2 = gidx + 1; const size_t o2 = (size_t)(row0 + (g2 >> 2) * HALF + (g2 & 3) * 16) * DM + col0; bn[0] = *(const u32x4*)(xb + o2); bn[1] = *(const u32x4*)(xb + o2 + HALF); }
            float ss = 0.f;
#pragma unroll
            for (int bj = 0; bj < 2; ++bj) { const u32x4 bb = bc[bj];
                const f32x4 v0 = acc[ai][bj][m][0] + (f32x4){bflo(bb.x), bfhi(bb.x), bflo(bb.y), bfhi(bb.y)}, v1 = acc[ai][bj][m][1] + (f32x4){bflo(bb.z), bfhi(bb.z), bflo(bb.w), bfhi(bb.w)};
                acc[ai][bj][m][0] = v0; acc[ai][bj][m][1] = v1;
                ss += (v0[0] * v0[0] + v0[1] * v0[1]) + (v0[2] * v0[2] + v0[3] * v0[3]) + (v1[0] * v1[0] + v1[1] * v1[1]) + (v1[2] * v1[2] + v1[3] * v1[3]); }
            ss += __shfl_xor(ss, 16); ss += __shfl_xor(ss, 32);
            if (fq == 0) __hip_atomic_store(sq + (size_t)row * 16 + u.pn * 4 + wc, __float_as_uint(ss), __ATOMIC_RELAXED, __HIP_MEMORY_SCOPE_AGENT);
            bc[0] = bn[0]; bc[1] = bn[1]; }
        asm volatile("s_waitcnt vmcnt(0)" ::: "memory");
        if ((threadIdx.x & 63) == 0) __hip_atomic_fetch_add(cnt, 1u, __ATOMIC_RELAXED, __HIP_MEMORY_SCOPE_AGENT);
        f32x4 gv[2][2];
#pragma unroll
        for (int bj = 0; bj < 2; ++bj) { gv[bj][0] = *(const f32x4*)(gfin + col0 + bj * HALF); gv[bj][1] = *(const f32x4*)(gfin + col0 + bj * HALF + 4); }
        { unsigned spins = 0; while ((unsigned)__builtin_amdgcn_readfirstlane(__hip_atomic_load(cnt, __ATOMIC_RELAXED, __HIP_MEMORY_SCOPE_AGENT)) < 32u) { __builtin_amdgcn_s_sleep(1); if (++spins > (1u << 22)) break; } }
        __builtin_amdgcn_fence(__ATOMIC_ACQUIRE, "agent");
        asm volatile("s_waitcnt vmcnt(0)" ::: "memory");
        f32x4 pv[8];
#pragma unroll
        for (int gidx = 0; gidx < 8; ++gidx) pv[gidx] = *(const f32x4*)((const float*)sq + (size_t)(row0 + (gidx >> 2) * HALF + (gidx & 3) * 16) * 16 + 4 * fq);
#pragma unroll
        for (int gidx = 0; gidx < 8; ++gidx) { const int ai = gidx >> 2, m = gidx & 3; const int row = row0 + ai * HALF + m * 16;
            float t = (pv[gidx][0] + pv[gidx][1]) + (pv[gidx][2] + pv[gidx][3]); t += __shfl_xor(t, 16); t += __shfl_xor(t, 32);
            const float rstd = rsqrtf(t * (1.0f / 1024.0f) + EPS);
            const size_t o = (size_t)row * DM + col0;
#pragma unroll
            for (int bj = 0; bj < 2; ++bj) { *(f32x4*)(out + o + bj * HALF) = acc[ai][bj][m][0] * rstd * gv[bj][0]; *(f32x4*)(out + o + bj * HALF + 4) = acc[ai][bj][m][1] * rstd * gv[bj][1]; } }
    }
    template <class Sched>
    __device__ __forceinline__ bool prefill(LAS unsigned char* lds, const Sched& S) const {
        if (!(mode == 0 || mode == 1 || mode == 4 || mode == 5) || S.nwg > 4 * S.G) return false;
        const int tid = threadIdx.x, rr = tid & 255;
#pragma unroll
        for (int k = 0; k < 2; ++k) { const int ui = (tid >> 8) + 2 * k; Unit u;
            if (S.next(ui, u)) { const int row = u.pm * BM + rr; float r;
                if (mode == 4 || mode == 5) { const f32x4* pp = (const f32x4*)((const float*)(ws + WS_SSQ) + (size_t)row * 16); const f32x4 a = pp[0], b = pp[1], c = pp[2], d = pp[3];
                    const float t = ((a[0] + a[1]) + (a[2] + a[3])) + ((b[0] + b[1]) + (b[2] + b[3])) + ((c[0] + c[1]) + (c[2] + c[3])) + ((d[0] + d[1]) + (d[2] + d[3]));
                    r = rsqrtf(t * (1.0f / 1024.0f) + EPS) * (mode == 4 ? 0.0625f : 1.0f); }
                else r = ((const float*)(ws + (mode == 0 ? WS_RSTD0 : WS_RSTDM)))[row];
                *(LAS float*)(lds + STAGE_BYTES + (ui * 256 + rr) * 4) = r; } }
        return true;
    }
    __device__ __forceinline__ void operator()(const f32x4 (&acc)[2][2][4][2], const Unit& u, int ui, bool tab, LAS unsigned char* lds, int wr, int wc, int fr, int fq) const {
        const int row0 = u.pm * BM + wr * 64 + fr;
        const int colL = wc * 32 + 8 * fq;
        if (mode == 3 || mode == 6 || mode == 7) {
            const int col0 = u.pn * BM + colL;
            bf16_t* xb = (bf16_t*)(ws + WS_XB);
            float* ssq = (float*)(ws + WS_SSQ);
            f32x4 rc[4], rn[4];
            u32x4 bc[2], bn[2];
            if (mode == 3) { const size_t o = (size_t)row0 * DM + col0; rc[0] = *(const f32x4*)(x + o); rc[1] = *(const f32x4*)(x + o + 4); rc[2] = *(const f32x4*)(x + o + HALF); rc[3] = *(const f32x4*)(x + o + HALF + 4); }
            else { const size_t o = (size_t)row0 * DM + col0; bc[0] = *(const u32x4*)(xb + o); bc[1] = *(const u32x4*)(xb + o + HALF); }
#pragma unroll
            for (int gidx = 0; gidx < 8; ++gidx) { const int ai = gidx >> 2, m = gidx & 3; const int row = row0 + ai * HALF + m * 16;
                if (gidx < 7) { const int g2 = gidx + 1; const size_t o2 = (size_t)(row0 + (g2 >> 2) * HALF + (g2 & 3) * 16) * DM + col0;
                    if (mode == 3) { rn[0] = *(const f32x4*)(x + o2); rn[1] = *(const f32x4*)(x + o2 + 4); rn[2] = *(const f32x4*)(x + o2 + HALF); rn[3] = *(const f32x4*)(x + o2 + HALF + 4); }
                    else { bn[0] = *(const u32x4*)(xb + o2); bn[1] = *(const u32x4*)(xb + o2 + HALF); } }
                if (mode != 3) {
#pragma unroll
                    for (int bj = 0; bj < 2; ++bj) { rc[2 * bj] = (f32x4){bflo(bc[bj].x), bfhi(bc[bj].x), bflo(bc[bj].y), bfhi(bc[bj].y)}; rc[2 * bj + 1] = (f32x4){bflo(bc[bj].z), bfhi(bc[bj].z), bflo(bc[bj].w), bfhi(bc[bj].w)}; } }
                float ss = 0.f;
#pragma unroll
                for (int bj = 0; bj < 2; ++bj) { const size_t o = (size_t)row * DM + col0 + bj * HALF;
                    const f32x4 v0 = acc[ai][bj][m][0] + rc[2 * bj], v1 = acc[ai][bj][m][1] + rc[2 * bj + 1];
                    store8(xb + o, v0, v1);
                    ss += (v0[0] * v0[0] + v0[1] * v0[1]) + (v0[2] * v0[2] + v0[3] * v0[3]) + (v1[0] * v1[0] + v1[1] * v1[1]) + (v1[2] * v1[2] + v1[3] * v1[3]); }
                ss += __shfl_xor(ss, 16); ss += __shfl_xor(ss, 32);
                if (fq == 0) ssq[(size_t)row * 16 + u.pn * 4 + wc] = ss;
#pragma unroll
                for (int k = 0; k < 4; ++k) rc[k] = rn[k];
                bc[0] = bn[0]; bc[1] = bn[1]; }
            return;
        }
        if (mode == 2) {
            const int col0 = u.pn * BM + colL;
            const float* rs = (const float*)(ws + WS_RSTDM); bf16_t* ob = (bf16_t*)(ws + WS_VT); const int ldo = 1024;
            f32x4 c0[2], c1[2];
#pragma unroll
            for (int bj = 0; bj < 2; ++bj) { c0[bj] = *(const f32x4*)(rs + col0 + bj * HALF); c1[bj] = *(const f32x4*)(rs + col0 + bj * HALF + 4); }
#pragma unroll
            for (int ai = 0; ai < 2; ++ai)
#pragma unroll
                for (int m = 0; m < 4; ++m) { const int row = row0 + ai * HALF + m * 16;
#pragma unroll
                    for (int bj = 0; bj < 2; ++bj) store8(ob + (size_t)row * ldo + col0 + bj * HALF, acc[ai][bj][m][0] * c0[bj], acc[ai][bj][m][1] * c1[bj]); }
            return;
        }
        float rsc[8];
        if (tab) {
#pragma unroll
            for (int gidx = 0; gidx < 8; ++gidx) rsc[gidx] = *(const LAS float*)(lds + STAGE_BYTES + (ui * 256 + wr * 64 + fr + (gidx >> 2) * HALF + (gidx & 3) * 16) * 4);
        } else if (mode == 4 || mode == 5) {
            asm volatile("" ::: "memory");
            const float* sq = (const float*)(ws + WS_SSQ);
            f32x4 pv[8];
#pragma unroll
            for (int gidx = 0; gidx < 8; ++gidx) pv[gidx] = *(const f32x4*)(sq + (size_t)(row0 + (gidx >> 2) * HALF + (gidx & 3) * 16) * 16 + 4 * fq);
            const float cs = mode == 4 ? 0.0625f : 1.0f;
#pragma unroll
            for (int gidx = 0; gidx < 8; ++gidx) { float t = (pv[gidx][0] + pv[gidx][1]) + (pv[gidx][2] + pv[gidx][3]); t += __shfl_xor(t, 16); t += __shfl_xor(t, 32); rsc[gidx] = rsqrtf(t * (1.0f / 1024.0f) + EPS) * cs; }
        } else {
            asm volatile("" ::: "memory");
            const float* rs = (const float*)(ws + (mode == 0 ? WS_RSTD0 : WS_RSTDM));
#pragma unroll
            for (int gidx = 0; gidx < 8; ++gidx) rsc[gidx] = rs[row0 + (gidx >> 2) * HALF + (gidx & 3) * 16];
        }
        if (mode == 0) {
            float* lf = (float*)(ws + WS_LF);
            const int pnn = u.pn + pnoff; const int sub = pnn >> 1; const int cb = (pnn & 1) * 256 + colL;
            if (sub == 1) {
                float oml[2][8];
#pragma unroll
                for (int bj = 0; bj < 2; ++bj)
#pragma unroll
                    for (int j = 0; j < 8; ++j) { const int c = cb + bj * HALF + j; const float l0 = lbl[c], l1 = lbl[512 + c]; const float lb = 1.0f / (1.0f + __expf(l1 - l0)); oml[bj][j] = 1.0f - lb; }
#pragma unroll
                for (int ai = 0; ai < 2; ++ai)
#pragma unroll
                    for (int m = 0; m < 4; ++m) { const int row = row0 + ai * HALF + m * 16; const float r = rsc[ai * 4 + m];
#pragma unroll
                        for (int bj = 0; bj < 2; ++bj) { f32x4 lf0, lf1;
#pragma unroll
                            for (int j = 0; j < 4; ++j) {
                                const float za = acc[ai][bj][m][0][j] * r, zb = acc[ai][bj][m][1][j] * r;
                                const float ka = oml[bj][j] * (1.0f - sigmoidf_(za)), kb = oml[bj][4 + j] * (1.0f - sigmoidf_(zb));
                                lf0[j] = __logf(1.0f - ka); lf1[j] = __logf(1.0f - kb); }
                            const size_t o = (size_t)row * 512 + cb + bj * HALF;
                            *(f32x4*)(lf + o) = lf0; *(f32x4*)(lf + o + 4) = lf1; } }
            } else {
                bf16_t* dst = (bf16_t*)(ws + (sub == 0 ? WS_QH : (sub == 2 ? WS_VH : (sub == 3 ? WS_GH : WS_PH))));
                const bool act = (sub == 0) || (sub == 3);
#pragma unroll
                for (int ai = 0; ai < 2; ++ai)
#pragma unroll
                    for (int m = 0; m < 4; ++m) { const int row = row0 + ai * HALF + m * 16; const float r = rsc[ai * 4 + m];
#pragma unroll
                        for (int bj = 0; bj < 2; ++bj) { f32x4 v0 = acc[ai][bj][m][0] * r, v1 = acc[ai][bj][m][1] * r;
                            if (act) {
#pragma unroll
                                for (int j = 0; j < 4; ++j) { v0[j] = v0[j] * sigmoidf_(v0[j]); v1[j] = v1[j] * sigmoidf_(v1[j]); } }
                            store8(dst + (size_t)row * 512 + cb + bj * HALF, v0, v1); } }
            }
        } else {
            const int col0 = u.pn * BM + colL;
            bf16_t* ob = (bf16_t*)(ws + (mode == 1 ? WS_KX : (mode == 4 ? WS_XQ : WS_U))); const int ldo = mode == 5 ? DFF : 1024;
#pragma unroll
            for (int ai = 0; ai < 2; ++ai)
#pragma unroll
                for (int m = 0; m < 4; ++m) { const int row = row0 + ai * HALF + m * 16; const float r = rsc[ai * 4 + m];
#pragma unroll
                    for (int bj = 0; bj < 2; ++bj) { f32x4 v0 = acc[ai][bj][m][0] * r, v1 = acc[ai][bj][m][1] * r;
                        if (mode == 5) {
#pragma unroll
                            for (int j = 0; j < 4; ++j) { const float a = fmaxf(v0[j], 0.f), b = fmaxf(v1[j], 0.f); v0[j] = a * a; v1[j] = b * b; } }
                        store8(ob + (size_t)row * ldo + col0 + bj * HALF, v0, v1); } }
        }
    }
};

template <class EpiT, class Sched>
__device__ __forceinline__ void gemm_phase(LAS unsigned char* lds, const Gemm g, const Sched S, const EpiT E) {
    const int tid = threadIdx.x, wid = __builtin_amdgcn_readfirstlane(tid >> 6), lane = tid & 63, wr = wid >> 2, wc = wid & 3, fr = lane & 15, fq = lane >> 4;
    const int K = g.K, nt = K / BK;
    unsigned voffA[2], voffB[2];
#pragma unroll
    for (int i = 0; i < 2; ++i) { int R, C; stage_rc(tid * 16 + i * 8192, R, C); const int Rb = EpiT::PERM ? ((R & ~31) + perm32(R & 31)) : R;
        voffA[i] = (unsigned)(R * K + C) * 2u; voffB[i] = (unsigned)(Rb * K + C) * 2u; }
    const size_t kstep = (size_t)(BK * 2);
    const size_t hstep = (size_t)HALF * K * 2;
    const size_t tstep = 2 * hstep;
    const unsigned ldsw = (unsigned)wid * 1024u;
    const int aoff = lds_byte(wr * 64 + fr, fq * 8), boff = lds_byte(wc * 32 + fr, fq * 8);
#define PG8_SA(b, h) (((b) * 2 + (h)) * HTB)
#define PG8_SB(b, h) ((4 + (b) * 2 + (h)) * HTB)
#define PG8_STAGE(bufoff, gbase, voff) do { _Pragma("unroll") for (int _i = 0; _i < 2; ++_i) \
        __builtin_amdgcn_global_load_lds((const unsigned*)((const char*)(gbase) + (voff)[_i]), (LAS unsigned*)(lds + (bufoff) + ldsw + _i * 8192), 16, 0, 0); } while (0)
#define PG8_LDA(dst, b, h) do { _Pragma("unroll") for (int m = 0; m < 4; ++m) _Pragma("unroll") for (int k = 0; k < 2; ++k) dst[m][k] = *(const LAS bf16x8*)(lds + PG8_SA(b, h) + aoff + m * 2048 + k * 1024); } while (0)
#define PG8_LDB(dst, b, h) do { _Pragma("unroll") for (int n = 0; n < 2; ++n) _Pragma("unroll") for (int k = 0; k < 2; ++k) dst[n][k] = *(const LAS bf16x8*)(lds + PG8_SB(b, h) + boff + n * 2048 + k * 1024); } while (0)
#define PG8_MMA(ai, bj, At, Bt) do { __builtin_amdgcn_s_setprio(1); _Pragma("unroll") for (int m = 0; m < 4; ++m) _Pragma("unroll") for (int n = 0; n < 2; ++n) _Pragma("unroll") for (int k = 0; k < 2; ++k) \
        acc[ai][bj][m][n] = __builtin_amdgcn_mfma_f32_16x16x32_bf16(Bt[n][k], At[m][k], acc[ai][bj][m][n], 0, 0, 0); __builtin_amdgcn_s_setprio(0); } while (0)
#define PG8_WAIT_V(n) asm volatile("s_waitcnt vmcnt(" #n ")" ::: "memory")
#define PG8_WAIT_L(n) asm volatile("s_waitcnt lgkmcnt(" #n ")" ::: "memory")
#define PG8_BAR __builtin_amdgcn_s_barrier()
#define PG8_SCHED __builtin_amdgcn_sched_barrier(0)
    Unit cur, nxt; int ui = 0;
    if (!S.next(0, cur)) return;
    const bool tab = E.prefill(lds, S);
    if (tab) __syncthreads();
    f32x4 acc[2][2][4][2];
#pragma unroll
    for (int a = 0; a < 2; ++a)
#pragma unroll
        for (int b = 0; b < 2; ++b)
#pragma unroll
            for (int m = 0; m < 4; ++m)
#pragma unroll
                for (int n = 0; n < 2; ++n) acc[a][b][m][n] = (f32x4){0.f, 0.f, 0.f, 0.f};
    bf16x8 At[4][2], B0[2][2], B1[2][2];
    const char* cA = (const char*)g.A + (size_t)cur.pm * tstep; const char* cB = (const char*)g.Bt + (size_t)cur.pn * tstep;
    PG8_STAGE(PG8_SB(0, 0), cB, voffB); PG8_STAGE(PG8_SA(0, 0), cA, voffA); PG8_STAGE(PG8_SB(0, 1), cB + hstep, voffB); PG8_STAGE(PG8_SA(0, 1), cA + hstep, voffA);
    if (wr == 1) PG8_BAR;
    PG8_WAIT_V(4); PG8_BAR;
    PG8_STAGE(PG8_SB(1, 0), cB + kstep, voffB); PG8_STAGE(PG8_SA(1, 0), cA + kstep, voffA); PG8_STAGE(PG8_SB(1, 1), cB + hstep + kstep, voffB);
    PG8_WAIT_V(6); PG8_BAR;
    for (;;) {
        const bool has_next = S.next(ui + 1, nxt);
        const char* nA = has_next ? (const char*)g.A + (size_t)nxt.pm * tstep : cA; const char* nB = has_next ? (const char*)g.Bt + (size_t)nxt.pn * tstep : cB;
        for (int t = 0; t < nt; t += 2) {
            const bool last = (t == nt - 2);
            const char* a1 = cA + (size_t)(t + 1) * kstep;
            const char* a2 = last ? nA : cA + (size_t)(t + 2) * kstep; const char* b2 = last ? nB : cB + (size_t)(t + 2) * kstep;
            const char* a3 = a2 + kstep; const char* b3 = b2 + kstep;
            PG8_LDB(B0, 0, 0); PG8_SCHED; PG8_LDA(At, 0, 0); PG8_STAGE(PG8_SA(1, 1), a1 + hstep, voffA);
            PG8_WAIT_L(8); PG8_BAR; PG8_WAIT_L(0); PG8_MMA(0, 0, At, B0); PG8_BAR; PG8_SCHED;
            PG8_LDB(B1, 0, 1); PG8_STAGE(PG8_SB(0, 0), b2, voffB);
            PG8_BAR; PG8_WAIT_L(0); PG8_MMA(0, 1, At, B1); PG8_BAR;
            PG8_LDA(At, 0, 1); PG8_STAGE(PG8_SA(0, 0), a2, voffA);
            PG8_BAR; PG8_WAIT_L(0); PG8_MMA(1, 0, At, B0); PG8_BAR; PG8_SCHED;
            PG8_STAGE(PG8_SB(0, 1), b2 + hstep, voffB);
            PG8_WAIT_V(6); PG8_BAR; PG8_MMA(1, 1, At, B1); PG8_BAR;
            PG8_LDB(B0, 1, 0); PG8_SCHED; PG8_LDA(At, 1, 0); PG8_STAGE(PG8_SA(0, 1), a2 + hstep, voffA);
            PG8_WAIT_L(8); PG8_BAR; PG8_WAIT_L(0); PG8_MMA(0, 0, At, B0); PG8_BAR; PG8_SCHED;
            PG8_LDB(B1, 1, 1); PG8_STAGE(PG8_SB(1, 0), b3, voffB);
            PG8_BAR; PG8_WAIT_L(0); PG8_MMA(0, 1, At, B1); PG8_BAR;
            PG8_LDA(At, 1, 1); PG8_STAGE(PG8_SA(1, 0), a3, voffA);
            PG8_BAR; PG8_WAIT_L(0); PG8_MMA(1, 0, At, B0); PG8_BAR; PG8_SCHED;
            PG8_STAGE(PG8_SB(1, 1), b3 + hstep, voffB);
            PG8_WAIT_V(6); PG8_BAR; PG8_MMA(1, 1, At, B1); PG8_BAR;
        }
        if (E.mode != 8) E(acc, cur, ui, tab, lds, wr, wc, fr, fq);
        if (E.mode == 0) __builtin_amdgcn_s_waitcnt(0x0F70);
        if (!has_next) break;
#pragma unroll
        for (int a = 0; a < 2; ++a)
#pragma unroll
            for (int b = 0; b < 2; ++b)
#pragma unroll
                for (int m = 0; m < 4; ++m)
#pragma unroll
                    for (int n = 0; n < 2; ++n) acc[a][b][m][n] = (f32x4){0.f, 0.f, 0.f, 0.f};
        cur = nxt; cA = nA; cB = nB; ++ui;
    }
    PG8_WAIT_V(0);
    if (wr == 0) PG8_BAR;
    PG8_BAR;
    if (E.mode == 8) E.fused(acc, cur, wr, wc, fr, fq);
#undef PG8_SA
#undef PG8_SB
#undef PG8_STAGE
#undef PG8_LDA
#undef PG8_LDB
#undef PG8_MMA
#undef PG8_WAIT_V
#undef PG8_WAIT_L
#undef PG8_BAR
#undef PG8_SCHED
}
}

struct Params {
    const float *x, *mem, *norm_mix_g, *w_in, *lb_logits, *hgrn_norm_g, *w_pool, *pool_scale, *w_out, *norm_x_g, *norm_mem_g, *w_xq, *w_xk, *w_xv, *w_xo, *norm_ffn_g, *w_ff1, *w_ff2, *final_norm_g;
    float* out; unsigned char* ws;
    int ph_lo, ph_hi;
};

struct TD { const float* W; const float* g; bf16_t* out; int N, ldo, kt, nt; };
__device__ __forceinline__ TD tile_desc(const Params& p, int t) {
    unsigned char* ws = p.ws; TD d;
    if (t < 320)       { d.W = p.w_in;  d.g = p.norm_mix_g; d.out = (bf16_t*)(ws + WS_WT_IN);  d.N = NIN;  d.ldo = 1024; d.kt = t / 40; d.nt = t % 40; }
    else if (t < 448)  { const int u = t - 320;  d.W = p.w_xk;  d.g = p.norm_mem_g; d.out = (bf16_t*)(ws + WS_WT_K);   d.N = 1024; d.ldo = 1024; d.kt = u / 16; d.nt = u % 16; }
    else if (t < 576)  { const int u = t - 448;  d.W = p.w_xv;  d.g = p.norm_mem_g; d.out = (bf16_t*)(ws + WS_WT_V);   d.N = 1024; d.ldo = 1024; d.kt = u / 16; d.nt = u % 16; }
    else if (t < 704)  { const int u = t - 576;  d.W = p.w_xq;  d.g = p.norm_x_g;   d.out = (bf16_t*)(ws + WS_WT_Q);   d.N = 1024; d.ldo = 1024; d.kt = u / 16; d.nt = u % 16; }
    else if (t < 832)  { const int u = t - 704;  d.W = p.w_xo;  d.g = nullptr;      d.out = (bf16_t*)(ws + WS_WT_O);   d.N = 1024; d.ldo = 1024; d.kt = u / 16; d.nt = u % 16; }
    else if (t < 960)  { const int u = t - 832;  d.W = p.w_out; d.g = nullptr;      d.out = (bf16_t*)(ws + WS_WT_OUT); d.N = 1024; d.ldo = 1024; d.kt = u / 16; d.nt = u % 16; }
    else if (t < 1472) { const int u = t - 960;  d.W = p.w_ff1; d.g = p.norm_ffn_g; d.out = (bf16_t*)(ws + WS_WT_FF1); d.N = DFF;  d.ldo = 1024; d.kt = u / 64; d.nt = u % 64; }
    else               { const int u = t - 1472; d.W = p.w_ff2; d.g = nullptr;      d.out = (bf16_t*)(ws + WS_WT_FF2); d.N = 1024; d.ldo = 4096; d.kt = u / 16; d.nt = u % 16; }
    return d;
}
__device__ __forceinline__ void tile_load(const TD& d, f32x4 (&v)[4], float (&sc)[4]) {
    const int tid = threadIdx.x, r = tid >> 4, c4 = tid & 15;
#pragma unroll
    for (int i = 0; i < 4; ++i) { const int k = 128 * d.kt + r + 32 * i; v[i] = __builtin_nontemporal_load((const f32x4*)(d.W + (size_t)k * d.N + 64 * d.nt + 4 * c4)); sc[i] = d.g ? d.g[k] : 1.0f; }
}
__device__ __forceinline__ void transpose_range(const Params& p, unsigned char* lds, int t_begin, int t_end, int first, int stride) {
    bf16_t* T0 = (bf16_t*)lds;
    bf16_t* T1 = (bf16_t*)(lds + 17408);
    const int tid = threadIdx.x, r = tid >> 4, c4 = tid & 15, n = tid >> 3, ks = tid & 7;
    int ta = t_begin + first;
    if (ta >= t_end) return;
    int tb = ta + stride; bool hb = tb < t_end;
    TD da = tile_desc(p, ta), db = da; f32x4 va[4], vb[4]; float sa[4], sb[4];
    tile_load(da, va, sa);
    if (hb) { db = tile_desc(p, tb); tile_load(db, vb, sb); }
    for (;;) {
#pragma unroll
        for (int i = 0; i < 4; ++i) { const int kl = r + 32 * i;
            T0[(4 * c4 + 0) * 136 + kl] = f2bf(va[i][0] * sa[i]); T0[(4 * c4 + 1) * 136 + kl] = f2bf(va[i][1] * sa[i]);
            T0[(4 * c4 + 2) * 136 + kl] = f2bf(va[i][2] * sa[i]); T0[(4 * c4 + 3) * 136 + kl] = f2bf(va[i][3] * sa[i]); }
        if (hb) {
#pragma unroll
            for (int i = 0; i < 4; ++i) { const int kl = r + 32 * i;
                T1[(4 * c4 + 0) * 136 + kl] = f2bf(vb[i][0] * sb[i]); T1[(4 * c4 + 1) * 136 + kl] = f2bf(vb[i][1] * sb[i]);
                T1[(4 * c4 + 2) * 136 + kl] = f2bf(vb[i][2] * sb[i]); T1[(4 * c4 + 3) * 136 + kl] = f2bf(vb[i][3] * sb[i]); } }
        __syncthreads();
        const int tna = ta + 2 * stride, tnb = tna + stride; const bool hna = tna < t_end, hnb = tnb < t_end;
        const TD ca = da, cb = db; const bool chb = hb;
        if (hna) { da = tile_desc(p, tna); tile_load(da, va, sa); }
        if (hnb) { db = tile_desc(p, tnb); tile_load(db, vb, sb); }
        { const u32x4* src = (const u32x4*)(T0 + n * 136 + 16 * ks); const u32x4 a = src[0], b = src[1];
          u32x4* dst = (u32x4*)(ca.out + (size_t)(64 * ca.nt + n) * ca.ldo + 128 * ca.kt + 16 * ks); dst[0] = a; dst[1] = b; }
        if (chb) { const u32x4* src = (const u32x4*)(T1 + n * 136 + 16 * ks); const u32x4 a = src[0], b = src[1];
          u32x4* dst = (u32x4*)(cb.out + (size_t)(64 * cb.nt + n) * cb.ldo + 128 * cb.kt + 16 * ks); dst[0] = a; dst[1] = b; }
        __syncthreads();
        if (!hna) break;
        ta = tna; hb = hnb;
    }
}
__device__ __forceinline__ void phase_prep(const Params p, unsigned char* lds) {
    unsigned char* ws = p.ws;
    const int G = gridDim.x;
    {
        const int lane = threadIdx.x & 63, gw = blockIdx.x * (NTHREADS / 64) + (threadIdx.x >> 6), nw = G * (NTHREADS / 64);
        int r = gw;
        f32x4 v[4], vn[4];
        if (r < MROWS + MEMROWS) { const float* src = r < MROWS ? p.x + (size_t)r * DM : p.mem + (size_t)(r - MROWS) * DM;
#pragma unroll
            for (int i = 0; i < 4; ++i) v[i] = __builtin_nontemporal_load((const f32x4*)src + lane + 64 * i); }
        for (; r < MROWS + MEMROWS; r += nw) {
            const int rn = r + nw;
            if (rn < MROWS + MEMROWS) { const float* src = rn < MROWS ? p.x + (size_t)rn * DM : p.mem + (size_t)(rn - MROWS) * DM;
#pragma unroll
                for (int i = 0; i < 4; ++i) vn[i] = __builtin_nontemporal_load((const f32x4*)src + lane + 64 * i); }
            const bool isx = r < MROWS;
            bf16_t* dst = isx ? (bf16_t*)(ws + WS_XB) + (size_t)r * DM : (bf16_t*)(ws + WS_MEMB) + (size_t)(r - MROWS) * DM;
            float ss = 0.f;
#pragma unroll
            for (int i = 0; i < 4; ++i) ss += (v[i][0] * v[i][0] + v[i][1] * v[i][1]) + (v[i][2] * v[i][2] + v[i][3] * v[i][3]);
#pragma unroll
            for (int o = 1; o < 64; o <<= 1) ss += __shfl_xor(ss, o);
#pragma unroll
            for (int i = 0; i < 4; ++i) { u32x2 w; w.x = cvt_pk_bf16(v[i][0], v[i][1]); w.y = cvt_pk_bf16(v[i][2], v[i][3]); ((u32x2*)dst)[lane + 64 * i] = w; }
            if (lane == 0) { const float rstd = rsqrtf(ss * (1.0f / 1024.0f) + EPS); if (isx) ((float*)(ws + WS_RSTD0))[r] = rstd; else ((float*)(ws + WS_RSTDM))[r - MROWS] = rstd; }
#pragma unroll
            for (int i = 0; i < 4; ++i) v[i] = vn[i];
        }
    }
    transpose_range(p, lds, 0, 576, blockIdx.x, G);
}
__device__ __forceinline__ void deferred_prep(const Params p, unsigned char* lds, int j, int nworkers) {
    transpose_range(p, lds, 576, 1984, j, nworkers);
}
__device__ __forceinline__ void fold_pool_weights_mfma(const Params& p) {
    bf16_t* wto = (bf16_t*)(p.ws + WS_WT_OUT);
    const int tid = threadIdx.x, w = tid >> 6, lane = tid & 63, fr = lane & 15, q = lane >> 4;
    for (int item = blockIdx.x; item < 256; item += gridDim.x) {
        const int gi = item >> 6, nb = item & 63;
        f32x4 acc = (f32x4){0.f, 0.f, 0.f, 0.f};
        const float* wp = p.w_pool + (size_t)(gi * 128 + 16 * w + fr) * 128;
        const float* ps = p.pool_scale + gi * 128;
        const bf16_t* arow = wto + (size_t)(16 * nb + fr) * 1024 + 512 + gi * 128;
#pragma unroll
        for (int ks = 0; ks < 4; ++ks) {
            const int d0 = 32 * ks + 8 * q;
            const f32x4 w0 = *(const f32x4*)(wp + d0), w1 = *(const f32x4*)(wp + d0 + 4), s0 = *(const f32x4*)(ps + d0), s1 = *(const f32x4*)(ps + d0 + 4);
            const bf16x8 cfr = mk8u(cvt_pk_bf16(w0[0] * s0[0], w0[1] * s0[1]), cvt_pk_bf16(w0[2] * s0[2], w0[3] * s0[3]), cvt_pk_bf16(w1[0] * s1[0], w1[1] * s1[1]), cvt_pk_bf16(w1[2] * s1[2], w1[3] * s1[3]));
            const bf16x8 nfr = *(const bf16x8*)(arow + d0);
            acc = mfma16(cfr, nfr, acc);
        }
        asm volatile("s_waitcnt vmcnt(0)" ::: "memory");
        __syncthreads();
        u32x2 o; o.x = cvt_pk_bf16(acc[0], acc[1]); o.y = cvt_pk_bf16(acc[2], acc[3]);
        *(u32x2*)(wto + (size_t)(16 * nb + fr) * 1024 + 512 + gi * 128 + 16 * w + 4 * q) = o;
        __syncthreads();
    }
}

__device__ __forceinline__ void phase_passA(const bf16_t* __restrict__ KH, const float* __restrict__ LF, const bf16_t* __restrict__ VH, bf16_t* __restrict__ LT, float* __restrict__ DEC, unsigned char* lds, int first, int stride, int ubeg, int uend) {
    const int tid = threadIdx.x, ch = tid & 127, seg = tid >> 7;
    float* segtot = (float*)lds;
    unsigned char* KdT = lds + 2048;
    unsigned char* VTl = lds + 2048 + 18432;
    const int w = tid >> 6, lane = tid & 63, fr = lane & 15, q = lane >> 4;
    float lf[16], kk[16]; unsigned vr[16];
    int unit = ubeg + first;
    if (unit < uend) { const int b = unit >> 8, c = (unit >> 2) & 63, h = unit & 3; const size_t g0 = (size_t)(b * SEQ + c * 64 + seg * 16) * 512 + h * 128 + ch;
#pragma unroll
        for (int i = 0; i < 16; ++i) { lf[i] = LF[g0 + (size_t)i * 512]; vr[i] = VH[g0 + (size_t)i * 512]; } }
    for (; unit < uend; unit += stride) {
        const int b = unit >> 8, c = (unit >> 2) & 63, h = unit & 3, bh = b * 4 + h;
#pragma unroll
        for (int i = 0; i < 16; ++i) kk[i] = 1.0f - __expf(lf[i]);
#pragma unroll
        for (int i = 1; i < 16; ++i) lf[i] += lf[i - 1];
        segtot[seg * 128 + ch] = lf[15];
        __syncthreads();
        float after = 0.f;
#pragma unroll
        for (int s2 = 1; s2 < 4; ++s2) if (s2 > seg) after += segtot[s2 * 128 + ch];
        const float tot = after + lf[15];
        if (seg == 0) DEC[(size_t)(bh * 64 + c) * 128 + ch] = __expf(tot);
        unsigned kd[8], vp[8];
#pragma unroll
        for (int i = 0; i < 8; ++i) {
            kd[i] = cvt_pk_bf16(kk[2 * i] * __expf(tot - lf[2 * i]), kk[2 * i + 1] * __expf(tot - lf[2 * i + 1]));
            vp[i] = vr[2 * i] | (vr[2 * i + 1] << 16);
        }
        { u32x4* d = (u32x4*)(KdT + ch * 144 + seg * 32); d[0] = (u32x4){kd[0], kd[1], kd[2], kd[3]}; d[1] = (u32x4){kd[4], kd[5], kd[6], kd[7]}; }
        { u32x4* d = (u32x4*)(VTl + ch * 144 + seg * 32); d[0] = (u32x4){vp[0], vp[1], vp[2], vp[3]}; d[1] = (u32x4){vp[4], vp[5], vp[6], vp[7]}; }
        __syncthreads();
        {
            const int un = unit + stride;
            if (un < uend) { const int b2 = un >> 8, c2 = (un >> 2) & 63, h2 = un & 3; const size_t g0 = (size_t)(b2 * SEQ + c2 * 64 + seg * 16) * 512 + h2 * 128 + ch;
#pragma unroll
                for (int i = 0; i < 16; ++i) { lf[i] = LF[g0 + (size_t)i * 512]; vr[i] = VH[g0 + (size_t)i * 512]; } }
        }
        bf16x8 a[2];
#pragma unroll
        for (int ks = 0; ks < 2; ++ks) a[ks] = *(const bf16x8*)(KdT + (16 * w + fr) * 144 + (32 * ks + 8 * q) * 2);
        bf16_t* ltp = LT + (size_t)(bh * 64 + c) * 16384;
#pragma unroll
        for (int vb = 0; vb < 8; ++vb) {
            f32x4 acc = (f32x4){0.f, 0.f, 0.f, 0.f};
#pragma unroll
            for (int ks = 0; ks < 2; ++ks) { const bf16x8 bfr = *(const bf16x8*)(VTl + (16 * vb + fr) * 144 + (32 * ks + 8 * q) * 2); acc = mfma16(a[ks], bfr, acc); }
            u32x2 pk; pk.x = cvt_pk_bf16(acc[0], acc[1]); pk.y = cvt_pk_bf16(acc[2], acc[3]);
            *(u32x2*)(ltp + (size_t)(16 * vb + fr) * 128 + 16 * w + 4 * q) = pk;
        }
        __syncthreads();
    }
}

template <int W>
__device__ __forceinline__ void pool_body(const bf16_t* __restrict__ PH, bf16_t* __restrict__ MIXED, int r0, int s0, int c0) {
    unsigned v[31 + W];
#pragma unroll
    for (int j = 1; j < W; ++j) v[W - 1 - j] = (s0 - j >= 0) ? *(const unsigned*)(PH + (size_t)(r0 - j) * 512 + c0) : 0u;
#pragma unroll
    for (int tt = 0; tt < 32; ++tt) v[W - 1 + tt] = *(const unsigned*)(PH + (size_t)(r0 + tt) * 512 + c0);
    float sx = 0.f, sy = 0.f;
#pragma unroll
    for (int j = 1; j < W; ++j) { sx += bflo(v[W - 1 - j]); sy += bfhi(v[W - 1 - j]); }
#pragma unroll
    for (int tt = 0; tt < 32; ++tt) {
        const int s = s0 + tt;
        const float px = bflo(v[W - 1 + tt]), py = bfhi(v[W - 1 + tt]);
        sx += px; sy += py;
        const int cnt = (s + 1) < W ? (s + 1) : W;
        const float inv = __builtin_amdgcn_rcpf((float)cnt);
        *(unsigned*)(MIXED + (size_t)(r0 + tt) * 1024 + 512 + c0) = cvt_pk_bf16(sx * inv - px, sy * inv - py);
        sx -= bflo(v[tt]); sy -= bfhi(v[tt]);
    }
}
__device__ __forceinline__ void pool_tile(const bf16_t* __restrict__ PH, bf16_t* __restrict__ MIXED, int tile) {
    const int tid = threadIdx.x, cp = tid & 255, th = tid >> 8, c0 = 2 * cp, gi = c0 >> 7;
    const int r0 = tile * 64 + th * 32, s0 = r0 & (SEQ - 1);
    if (gi == 0) pool_body<2>(PH, MIXED, r0, s0, c0);
    else if (gi == 1) pool_body<4>(PH, MIXED, r0, s0, c0);
    else if (gi == 2) pool_body<8>(PH, MIXED, r0, s0, c0);
    else pool_body<16>(PH, MIXED, r0, s0, c0);
}

__device__ __forceinline__ void phase_scan(const bf16_t* LT, const float* __restrict__ DEC, bf16_t* ST) {
    for (int e2 = blockIdx.x * NTHREADS + threadIdx.x; e2 < 131072; e2 += gridDim.x * NTHREADS) {
        const int bh = e2 >> 13, v = (e2 >> 6) & 127, kp = e2 & 63;
        float sx = 0.f, sy = 0.f;
        const size_t base = (size_t)bh * 64 * 16384 + (size_t)v * 128 + 2 * kp;
        const float* dp = DEC + (size_t)bh * 64 * 128 + 2 * kp;
        for (int c0 = 0; c0 < 64; c0 += 32) {
            unsigned l[32]; f32x2 d[32];
#pragma unroll
            for (int j = 0; j < 32; ++j) { l[j] = *(const unsigned*)(LT + base + (size_t)(c0 + j) * 16384); d[j] = *(const f32x2*)(dp + (c0 + j) * 128); }
#pragma unroll
            for (int j = 0; j < 32; ++j) {
                *(unsigned*)(ST + base + (size_t)(c0 + j) * 16384) = cvt_pk_bf16(sx, sy);
                sx = d[j][0] * sx + bflo(l[j]); sy = d[j][1] * sy + bfhi(l[j]);
            }
        }
    }
}

__device__ __forceinline__ void phase_passC(const bf16_t* __restrict__ QH, const bf16_t* __restrict__ KH, const float* __restrict__ LF, const bf16_t* __restrict__ VH, const bf16_t* __restrict__ GH,
                                const bf16_t* __restrict__ ST, const float* __restrict__ hg, bf16_t* __restrict__ MIXED, unsigned char* lds) {
    const int tid = threadIdx.x, ch = tid & 127, seg = tid >> 7, G = gridDim.x;
    float lf[16], kk[16]; unsigned qr[16], vr[16];
    int unit = blockIdx.x;
    if (unit < 1024) { const int b = unit >> 8, c = (unit >> 2) & 63, h = unit & 3; const size_t g0 = (size_t)(b * SEQ + c * 64 + seg * 16) * 512 + h * 128 + ch;
#pragma unroll
        for (int i = 0; i < 16; ++i) { lf[i] = LF[g0 + (size_t)i * 512]; vr[i] = VH[g0 + (size_t)i * 512]; qr[i] = QH[g0 + (size_t)i * 512]; } }
  for (; unit < 1024; unit += G) {
    const int b = unit >> 8, c = (unit >> 2) & 63, h = unit & 3;
    const int row0 = b * SEQ + c * 64, bh = b * 4 + h;
    float* segtot = (float*)lds;
    float* rmsp = (float*)(lds + 2048);
    bf16_t* QC = (bf16_t*)(lds + 4096);
    bf16_t* QT = (bf16_t*)(lds + 21504);
    constexpr int KT0 = 38912;
    unsigned char* VTl = lds + 82432;
    const int w = tid >> 6, lane = tid & 63, fr = lane & 15, q = lane >> 4;
    const int i = w & 3, vh = w >> 2;
    const size_t row = (size_t)(row0 + 16 * i + fr);
    u32x2 gt[4]; f32x4 gg[4]; bf16x8 stf[4][4];
    {
        const bf16_t* stp = ST + (size_t)(bh * 64 + c) * 16384;
#pragma unroll
        for (int vbl = 0; vbl < 4; ++vbl) { const int v0 = 16 * (vh * 4 + vbl) + 4 * q; gt[vbl] = *(const u32x2*)(GH + row * 512 + h * 128 + v0); gg[vbl] = *(const f32x4*)(hg + h * 128 + v0);
#pragma unroll
            for (int ks = 0; ks < 4; ++ks) stf[ks][vbl] = *(const bf16x8*)(stp + (size_t)(16 * (vh * 4 + vbl) + fr) * 128 + 32 * ks + 8 * q); }
    }
#pragma unroll
    for (int i2 = 0; i2 < 16; ++i2) kk[i2] = 1.0f - __expf(lf[i2]);
#pragma unroll
    for (int i2 = 1; i2 < 16; ++i2) lf[i2] += lf[i2 - 1];
    segtot[seg * 128 + ch] = lf[15];
    {
        unsigned vp[8];
#pragma unroll
        for (int i2 = 0; i2 < 8; ++i2) vp[i2] = vr[2 * i2] | (vr[2 * i2 + 1] << 16);
        u32x4* d = (u32x4*)(VTl + ch * 144 + seg * 32); d[0] = (u32x4){vp[0], vp[1], vp[2], vp[3]}; d[1] = (u32x4){vp[4], vp[5], vp[6], vp[7]};
    }
    __syncthreads();
    const float t0 = segtot[ch], t1 = segtot[128 + ch], t2 = segtot[256 + ch];
    const float P = (seg > 0 ? t0 : 0.f) + (seg > 1 ? t1 : 0.f) + (seg > 2 ? t2 : 0.f);
    {
        const float eP = __expf(P);
#pragma unroll
        for (int i2 = 0; i2 < 16; ++i2) {
            const float qv = bflo(qr[i2]);
            const float el = __expf(lf[i2]);
            QT[(seg * 16 + i2) * 136 + ch] = f2bf(qv * el);
            QC[(seg * 16 + i2) * 136 + ch] = f2bf(qv * el * eP);
        }
        float E = 0.f;
#pragma unroll
        for (int i2 = 0; i2 < 4; ++i2) {
            if (i2 >= seg) {
                bf16_t* KT = (bf16_t*)(lds + KT0 + 4352 * ((i2 * (i2 + 1)) / 2));
#pragma unroll
                for (int j = 0; j < 16; ++j) KT[(seg * 16 + j) * 136 + ch] = f2bf(kk[j] * __expf(E - lf[j]));
                E += (i2 == 0 ? t0 : (i2 == 1 ? t1 : t2));
            }
        }
    }
    __syncthreads();
    {
        const int un = unit + G;
        if (un < 1024) { const int b2 = un >> 8, c2 = (un >> 2) & 63, h2 = un & 3; const size_t g2 = (size_t)(b2 * SEQ + c2 * 64 + seg * 16) * 512 + h2 * 128 + ch;
#pragma unroll
            for (int i2 = 0; i2 < 16; ++i2) { lf[i2] = LF[g2 + (size_t)i2 * 512]; vr[i2] = VH[g2 + (size_t)i2 * 512]; qr[i2] = QH[g2 + (size_t)i2 * 512]; } }
    }
    f32x4 sT[4];
#pragma unroll
    for (int j = 0; j < 4; ++j) sT[j] = (f32x4){0.f, 0.f, 0.f, 0.f};
    {
        bf16x8 qfr[4];
#pragma unroll
        for (int ks = 0; ks < 4; ++ks) qfr[ks] = *(const bf16x8*)((const unsigned char*)QT + (16 * i + fr) * 272 + (32 * ks + 8 * q) * 2);
        const unsigned char* KT = lds + KT0 + 4352 * ((i * (i + 1)) / 2);
#pragma unroll
        for (int j = 0; j < 4; ++j) if (j <= i) {
#pragma unroll
            for (int ks = 0; ks < 4; ++ks) { const bf16x8 a = *(const bf16x8*)(KT + (16 * j + fr) * 272 + (32 * ks + 8 * q) * 2); sT[j] = mfma16(a, qfr[ks], sT[j]); }
            if (j == i) {
#pragma unroll
                for (int rg = 0; rg < 4; ++rg) if (4 * q + rg > fr) sT[j][rg] = 0.f;
            }
        }
    }
    f32x4 oacc[4];
#pragma unroll
    for (int vbl = 0; vbl < 4; ++vbl) oacc[vbl] = (f32x4){0.f, 0.f, 0.f, 0.f};
#pragma unroll
    for (int m = 0; m < 2; ++m) if (2 * m <= i) {
        const bf16x8 bfrag = mk8u(cvt_pk_bf16(sT[2 * m][0], sT[2 * m][1]), cvt_pk_bf16(sT[2 * m][2], sT[2 * m][3]), cvt_pk_bf16(sT[2 * m + 1][0], sT[2 * m + 1][1]), cvt_pk_bf16(sT[2 * m + 1][2], sT[2 * m + 1][3]));
#pragma unroll
        for (int vbl = 0; vbl < 4; ++vbl) {
            const unsigned char* base = VTl + (16 * (vh * 4 + vbl) + fr) * 144 + (32 * m + 4 * q) * 2;
            const bf16x8 a = mk8(*(const u32x2*)base, *(const u32x2*)(base + 32));
            oacc[vbl] = mfma16(a, bfrag, oacc[vbl]);
        }
    }
    {
#pragma unroll
        for (int ks = 0; ks < 4; ++ks) {
            const bf16x8 bfr = *(const bf16x8*)((const unsigned char*)QC + (16 * i + fr) * 272 + (32 * ks + 8 * q) * 2);
#pragma unroll
            for (int vbl = 0; vbl < 4; ++vbl) oacc[vbl] = mfma16(stf[ks][vbl], bfr, oacc[vbl]);
        }
    }
    float ss = 0.f;
#pragma unroll
    for (int vbl = 0; vbl < 4; ++vbl) ss += (oacc[vbl][0] * oacc[vbl][0] + oacc[vbl][1] * oacc[vbl][1]) + (oacc[vbl][2] * oacc[vbl][2] + oacc[vbl][3] * oacc[vbl][3]);
    ss += __shfl_xor(ss, 16); ss += __shfl_xor(ss, 32);
    if (q == 0) rmsp[vh * 64 + 16 * i + fr] = ss;
    __syncthreads();
    const float rstd = rsqrtf((rmsp[16 * i + fr] + rmsp[64 + 16 * i + fr]) * (1.0f / 128.0f) + EPS);
#pragma unroll
    for (int vbl = 0; vbl < 4; ++vbl) {
        const int v0 = 16 * (vh * 4 + vbl) + 4 * q;
        u32x2 o;
        o.x = cvt_pk_bf16(oacc[vbl][0] * rstd * gg[vbl][0] * bflo(gt[vbl].x), oacc[vbl][1] * rstd * gg[vbl][1] * bfhi(gt[vbl].x));
        o.y = cvt_pk_bf16(oacc[vbl][2] * rstd * gg[vbl][2] * bflo(gt[vbl].y), oacc[vbl][3] * rstd * gg[vbl][3] * bfhi(gt[vbl].y));
        *(u32x2*)(MIXED + row * 1024 + h * 128 + v0) = o;
    }
    __syncthreads();
  }
}

__device__ __forceinline__ void attn_unit(const bf16_t* __restrict__ XQ, const bf16_t* __restrict__ KX, const bf16_t* __restrict__ VT, bf16_t* __restrict__ ATT, int unit, unsigned char* lds) {
    const int tid = threadIdx.x, w = tid >> 6, lane = tid & 63, r = lane & 31, hh = lane >> 5;
    const int b = unit >> 6, st = (unit >> 2) & 15, h = unit & 3;
    const int row0 = b * SEQ + st * 256;
    const bf16_t* qp = XQ + (size_t)(row0 + 32 * w + r) * 1024 + h * 256 + 8 * hh;
    {
        const bf16_t* kp = KX + (size_t)(b * 256) * 1024 + h * 256;
        u32x4 kv[16];
#pragma unroll
        for (int it = 0; it < 16; ++it) { const int idx = tid + 512 * it, m = idx >> 5, cc = idx & 31; kv[it] = *(const u32x4*)(kp + (size_t)m * 1024 + cc * 8); }
#pragma unroll
        for (int it = 0; it < 16; ++it) { const int idx = tid + 512 * it, m = idx >> 5, cc = idx & 31; *(u32x4*)(lds + m * 528 + cc * 16) = kv[it]; }
    }
    __syncthreads();
    f32x16 sacc[8];
#pragma unroll
    for (int mb = 0; mb < 8; ++mb)
#pragma unroll
        for (int e = 0; e < 16; ++e) sacc[mb][e] = 0.f;
    {
        bf16x8 qf[4], qn[4];
#pragma unroll
        for (int k4 = 0; k4 < 4; ++k4) qf[k4] = *(const bf16x8*)(qp + 16 * k4);
#pragma unroll
        for (int kg = 0; kg < 4; ++kg) {
            if (kg < 3) {
#pragma unroll
                for (int k4 = 0; k4 < 4; ++k4) qn[k4] = *(const bf16x8*)(qp + 16 * (4 * (kg + 1) + k4)); }
#pragma unroll
            for (int k4 = 0; k4 < 4; ++k4)
#pragma unroll
                for (int mb = 0; mb < 8; ++mb) { const bf16x8 a = *(const bf16x8*)(lds + (32 * mb + r) * 528 + (16 * (4 * kg + k4) + 8 * hh) * 2); sacc[mb] = mfma32(a, qf[k4], sacc[mb]); }
#pragma unroll
            for (int k4 = 0; k4 < 4; ++k4) qf[k4] = qn[k4];
        }
    }
    float mx = -3.0e38f;
#pragma unroll
    for (int mb = 0; mb < 8; ++mb)
#pragma unroll
        for (int e = 0; e < 16; ++e) mx = fmaxf(mx, sacc[mb][e]);
    mx = fmaxf(mx, __shfl_xor(mx, 32));
    float sum = 0.f;
    bf16x8 pf[8][2];
#pragma unroll
    for (int mb = 0; mb < 8; ++mb) {
        float pv[16];
#pragma unroll
        for (int e = 0; e < 16; ++e) { pv[e] = __expf(sacc[mb][e] - mx); sum += pv[e]; }
#pragma unroll
        for (int s = 0; s < 2; ++s) pf[mb][s] = mk8u(cvt_pk_bf16(pv[8 * s + 0], pv[8 * s + 1]), cvt_pk_bf16(pv[8 * s + 2], pv[8 * s + 3]), cvt_pk_bf16(pv[8 * s + 4], pv[8 * s + 5]), cvt_pk_bf16(pv[8 * s + 6], pv[8 * s + 7]));
    }
    sum += __shfl_xor(sum, 32);
    const float inv = 1.0f / sum;
    __syncthreads();
    {
        const bf16_t* vp = VT + (size_t)(h * 256) * 1024 + b * 256;
        u32x4 vv[16];
#pragma unroll
        for (int it = 0; it < 16; ++it) { const int idx = tid + 512 * it, e = idx >> 5, cc = idx & 31; vv[it] = *(const u32x4*)(vp + (size_t)e * 1024 + cc * 8); }
#pragma unroll
        for (int it = 0; it < 16; ++it) { const int idx = tid + 512 * it, e = idx >> 5, cc = idx & 31;
            u32x2* d = (u32x2*)(lds + e * 520 + cc * 16); d[0] = (u32x2){vv[it].x, vv[it].y}; d[1] = (u32x2){vv[it].z, vv[it].w}; }
    }
    __syncthreads();
    bf16_t* op = ATT + (size_t)(row0 + 32 * w + r) * 1024 + h * 256 + 4 * hh;
#pragma unroll
    for (int half = 0; half < 2; ++half) {
        f32x16 oacc[4];
#pragma unroll
        for (int d = 0; d < 4; ++d)
#pragma unroll
            for (int e = 0; e < 16; ++e) oacc[d][e] = 0.f;
#pragma unroll
        for (int mb = 0; mb < 8; ++mb)
#pragma unroll
            for (int s = 0; s < 2; ++s)
#pragma unroll
                for (int d = 0; d < 4; ++d) {
                    const unsigned char* base = lds + (32 * (half * 4 + d) + r) * 520 + (32 * mb + 16 * s + 4 * hh) * 2;
                    const bf16x8 a = mk8(*(const u32x2*)base, *(const u32x2*)(base + 16));
                    oacc[d] = mfma32(a, pf[mb][s], oacc[d]);
                }
#pragma unroll
        for (int d = 0; d < 4; ++d)
#pragma unroll
            for (int g = 0; g < 4; ++g) {
                u32x2 o; o.x = cvt_pk_bf16(oacc[d][4 * g] * inv, oacc[d][4 * g + 1] * inv); o.y = cvt_pk_bf16(oacc[d][4 * g + 2] * inv, oacc[d][4 * g + 3] * inv);
                *(u32x2*)(op + 32 * (half * 4 + d) + 8 * g) = o;
            }
    }
    __syncthreads();
}

__device__ __forceinline__ void phase_final(const bf16_t* __restrict__ xb, const float* __restrict__ ssq, float* __restrict__ out, const float* __restrict__ g) {
    const int tid = threadIdx.x, sub = tid >> 7, l = tid & 127;
    const f32x4 g0 = *(const f32x4*)(g + 8 * l), g1 = *(const f32x4*)(g + 8 * l + 4);
    for (int r = blockIdx.x * 4 + sub; r < MROWS; r += gridDim.x * 4) {
        const u32x4 v = *(const u32x4*)(xb + (size_t)r * DM + 8 * l);
        const f32x4* pp = (const f32x4*)(ssq + (size_t)r * 16); const f32x4 a = pp[0], b = pp[1], c = pp[2], d = pp[3];
        const float t = ((a[0] + a[1]) + (a[2] + a[3])) + ((b[0] + b[1]) + (b[2] + b[3])) + ((c[0] + c[1]) + (c[2] + c[3])) + ((d[0] + d[1]) + (d[2] + d[3]));
        const float rstd = rsqrtf(t * (1.0f / 1024.0f) + EPS);
        const f32x4 o0 = (f32x4){bflo(v.x), bfhi(v.x), bflo(v.y), bfhi(v.y)} * rstd * g0, o1 = (f32x4){bflo(v.z), bfhi(v.z), bflo(v.w), bfhi(v.w)} * rstd * g1;
        *(f32x4*)(out + (size_t)r * DM + 8 * l) = o0; *(f32x4*)(out + (size_t)r * DM + 8 * l + 4) = o1;
    }
}

#define XB_TMO      128
#define XB_XCNT(j)  (256  + 64 * (j))
#define XB_XSUB(j)  (1280 + 64 * (j))
#define XB_XGEN(j)  (2304 + 64 * (j))
#define XB_TOP      3328
#define XB_TOPGEN   3392
#define XCD_BAR_WORDS 3456
#define XB_SPIN_CAP (1u << 22)
__device__ __forceinline__ unsigned xb_ld(unsigned* p)              { return __hip_atomic_load(p, __ATOMIC_RELAXED, __HIP_MEMORY_SCOPE_AGENT); }
__device__ __forceinline__ unsigned xb_add(unsigned* p, unsigned v) { return __hip_atomic_fetch_add(p, v, __ATOMIC_RELAXED, __HIP_MEMORY_SCOPE_AGENT); }
__device__ __forceinline__ unsigned xb_xcc_id() { return (unsigned)__builtin_amdgcn_s_getreg((3 << 11) | 20) & 0xFu; }
#define XB_SPIN(cond, bar) do { unsigned _sp = 0; while (cond) { __builtin_amdgcn_s_sleep(1); \
    if ((++_sp & 255u) == 0u) { if (xb_ld(&(bar)[XB_TMO])) break; if (_sp > XB_SPIN_CAP) { atomicAdd(&(bar)[XB_TMO], 1u); break; } } } } while (0)
struct XcdBarrier { unsigned* bar; unsigned x; volatile LAS unsigned* st; };
__device__ __forceinline__ XcdBarrier xcd_barrier_post(unsigned* bar, volatile LAS unsigned* st) {
    XcdBarrier b; b.bar = bar; b.x = xb_xcc_id(); b.st = st;
    if (threadIdx.x == 0) (void)xb_add(&bar[XB_XCNT(b.x)], 1u);
    return b;
}
__device__ __forceinline__ void xcd_barrier_complete(unsigned* bar, unsigned x, unsigned& nloc, unsigned& nx) {
    const unsigned G = gridDim.x * gridDim.y * gridDim.z;
    unsigned sum, cnt, mine, sp = 0u;
    for (;;) {
        sum = 0u; cnt = 0u; mine = 0u;
#pragma unroll
        for (unsigned j = 0; j < 16; ++j) { const unsigned c = xb_ld(&bar[XB_XCNT(j)]); sum += c; cnt += (c > 0u) ? 1u : 0u; mine = (j == x) ? c : mine; }
        if (sum == G) break;
        __builtin_amdgcn_s_sleep(1);
        if ((++sp & 255u) == 0u) { if (xb_ld(&bar[XB_TMO])) break; if (sp > XB_SPIN_CAP) { atomicAdd(&bar[XB_TMO], 1u); break; } }
    }
    nloc = mine > 0u ? mine : 1u; nx = cnt > 0u ? cnt : 1u;
}
__device__ __forceinline__ void xcd_barrier(const XcdBarrier& b) {
    asm volatile("s_waitcnt vmcnt(0)" ::: "memory");
    __syncthreads();
    if (threadIdx.x == 0) {
        unsigned* bar = b.bar;
        __builtin_amdgcn_s_waitcnt(0);
        unsigned nloc = b.st[0], nx = b.st[1];
        if (nloc == 0u) { xcd_barrier_complete(bar, b.x, nloc, nx); b.st[0] = nloc; b.st[1] = nx; }
        const unsigned old = xb_add(&bar[XB_XSUB(b.x)], 1u);
        const unsigned gen = old / nloc;
        if (old + 1u == (gen + 1u) * nloc) {
            __builtin_amdgcn_fence(__ATOMIC_RELEASE, "agent");
            asm volatile("s_waitcnt vmcnt(0)" ::: "memory");
            const unsigned og = xb_add(&bar[XB_TOP], 1u);
            const unsigned tg = og / nx;
            if (og + 1u == (tg + 1u) * nx) xb_add(&bar[XB_TOPGEN], 1u);
            else XB_SPIN(xb_ld(&bar[XB_TOPGEN]) == tg, bar);
            __builtin_amdgcn_fence(__ATOMIC_ACQUIRE, "agent");
            asm volatile("s_waitcnt vmcnt(0)" ::: "memory");
        } else {
            XB_SPIN(xb_ld(&bar[XB_TOPGEN]) == gen, bar);
            __builtin_amdgcn_fence(__ATOMIC_ACQUIRE, "agent");
            asm volatile("s_waitcnt vmcnt(0)" ::: "memory");
        }
    }
    __syncthreads();
}

constexpr int N_PHASES = 12;
__global__ void __launch_bounds__(NTHREADS, 2) mega(Params p) {
    extern __shared__ __attribute__((aligned(16))) unsigned char lds[];
    LAS unsigned char* ldsl = (LAS unsigned char*)lds;
    unsigned char* ws = p.ws;
    const int G = gridDim.x, bid = blockIdx.x;
    const int lo = p.ph_lo, hi = p.ph_hi;

#ifndef DEFER_PREP
#define DEFER_PREP 0
#endif
#ifndef FUSE_FINAL
#define FUSE_FINAL 0
#endif
#ifndef DBG_LAST
#define DBG_LAST -1
#endif
#ifndef PHASE_MASK
#define PHASE_MASK 0xfff
#endif
#define IN(k) (((PHASE_MASK >> (k)) & 1) && lo <= (k) && (k) < hi)
    if (threadIdx.x == 0) { ((volatile LAS unsigned*)(ldsl + LDS_MAIN))[0] = 0u; ((volatile LAS unsigned*)(ldsl + LDS_MAIN))[1] = 0u; }
    __syncthreads();
    XcdBarrier xbar; xbar.bar = (unsigned*)(ws + WS_BAR); xbar.x = 0; xbar.st = nullptr;
    if (hi - lo > 1) xbar = xcd_barrier_post((unsigned*)(ws + WS_BAR), (volatile LAS unsigned*)(ldsl + LDS_MAIN));
    if (lo > hi) cg::this_grid().sync();
#define SEAM(k) do { if (IN(k) && IN((k) + 1)) { xcd_barrier(xbar); } } while (0)
    bf16_t* XB = (bf16_t*)(ws + WS_XB); bf16_t* LT = (bf16_t*)(ws + WS_ST);
    bf16_t* QH = (bf16_t*)(ws + WS_QH); bf16_t* KH = (bf16_t*)(ws + WS_KH); bf16_t* VH = (bf16_t*)(ws + WS_VH); bf16_t* GH = (bf16_t*)(ws + WS_GH); bf16_t* PH = (bf16_t*)(ws + WS_PH);
    float* LF = (float*)(ws + WS_LF); bf16_t* ST = (bf16_t*)(ws + WS_ST); bf16_t* MIXED = (bf16_t*)(ws + WS_MIXED);
    float* X1 = (float*)(ws + WS_X1); bf16_t* XQ = (bf16_t*)(ws + WS_XQ); bf16_t* ATT = (bf16_t*)(ws + WS_ATT); bf16_t* U = (bf16_t*)(ws + WS_U);
    float* SSQ = (float*)(ws + WS_SSQ); float* DEC = (float*)(ws + WS_DEC);
    bf16_t* MEMB = (bf16_t*)(ws + WS_MEMB); bf16_t* KX = (bf16_t*)(ws + WS_KX); bf16_t* VT = (bf16_t*)(ws + WS_VT);

    const bool fuse_final = FUSE_FINAL && (G == 256) && IN(10) && (hi - lo > 1);
    if (IN(0)) { phase_prep(p, lds);
#if !DEFER_PREP
        deferred_prep(p, lds, bid, G);
#endif
    }
    SEAM(0);
    const bf16_t* WTIN = (const bf16_t*)(ws + WS_WT_IN);
    if (IN(1)) {
        const pg8::Epi E{0, ws, p.x, p.out, p.lb_logits, p.final_norm_g, 2};
        pg8::Gemm g{XB, WTIN + (size_t)512 * DM, MROWS, 1024, DM}; pg8::StaticOrder S; S.init(MROWS, 1024, G, bid); pg8::gemm_phase(ldsl, g, S, E);
    }
    SEAM(1);
    if (IN(2)) {
        { const pg8::Epi E{0, ws, p.x, p.out, p.lb_logits, p.final_norm_g, 6};
          pg8::Gemm g{XB, WTIN + (size_t)1536 * DM, MROWS, 1024, DM}; pg8::StaticOrder S; S.init(MROWS, 1024, G, bid); pg8::gemm_phase(ldsl, g, S, E); }
        { const pg8::Epi E{0, ws, p.x, p.out, p.lb_logits, p.final_norm_g, 0};
          pg8::Gemm g{XB, WTIN, MROWS, 512, DM}; pg8::StaticOrder S; S.init(MROWS, 512, G, bid); pg8::gemm_phase(ldsl, g, S, E); }
        const pg8::Epi E1{1, ws, p.x, p.out, p.lb_logits, p.final_norm_g, 0};
        { pg8::Gemm g{MEMB, (const bf16_t*)(ws + WS_WT_K), MEMROWS, 1024, DM}; pg8::StaticOrder S; S.init(MEMROWS, 1024, G, (bid + 128) % G); pg8::gemm_phase(ldsl, g, S, E1); }
        const pg8::Epi E2{2, ws, p.x, p.out, p.lb_logits, p.final_norm_g, 0};
        { pg8::Gemm g{(const bf16_t*)(ws + WS_WT_V), MEMB, 1024, MEMROWS, DM}; pg8::StaticOrder S; S.init(1024, MEMROWS, G, (bid + 112) % G); pg8::gemm_phase(ldsl, g, S, E2); }
        if (G == 256) {
            if (bid >= 160) phase_passA(KH, LF, VH, LT, DEC, lds, bid - 160, 96, 0, 512);
            phase_passA(KH, LF, VH, LT, DEC, lds, bid, G, 512, 1024);
        } else phase_passA(KH, LF, VH, LT, DEC, lds, bid, G, 0, 1024);
    }
    SEAM(2);
    if (IN(3)) {
        phase_scan(LT, DEC, ST);
        for (int t = bid; t < 256; t += G) pool_tile(PH, MIXED, t);
        fold_pool_weights_mfma(p);
    }
    SEAM(3);
    if (IN(4)) { phase_passC(QH, KH, LF, VH, GH, ST, p.hgrn_norm_g, MIXED, lds); }
    SEAM(4);
    if (IN(5)) {
        const pg8::Epi E{6, ws, p.x, p.out, p.lb_logits, p.final_norm_g, 0};
        pg8::Gemm g{MIXED, (const bf16_t*)(ws + WS_WT_OUT), MROWS, DM, DM}; pg8::StaticOrder S; S.init(MROWS, DM, G, bid); pg8::gemm_phase(ldsl, g, S, E);
    }
    SEAM(5);
    const bool fuse_attn = (G == 256) && IN(6) && IN(7);
    if (IN(6)) {
        const pg8::Epi E{4, ws, p.x, p.out, p.lb_logits, p.final_norm_g, 0};
        pg8::Gemm g{XB, (const bf16_t*)(ws + WS_WT_Q), MROWS, DM, DM}; pg8::StaticOrder S; S.init(MROWS, DM, G, bid); pg8::gemm_phase(ldsl, g, S, E);
        if (fuse_attn) {
            pg8::Unit u; S.next(0, u);
            asm volatile("s_waitcnt vmcnt(0)" ::: "memory"); __syncthreads();
            attn_unit(XQ, KX, VT, ATT, u.pm * 4 + u.pn, lds);
        }
    }
    if (!fuse_attn) {
        SEAM(6);
        if (IN(7)) { for (int u = bid; u < 256; u += G) attn_unit(XQ, KX, VT, ATT, u, lds); }
    }
    SEAM(7);
    if (IN(8)) {
        const pg8::Epi E{6, ws, p.x, p.out, p.lb_logits, p.final_norm_g, 0};
        pg8::Gemm g{ATT, (const bf16_t*)(ws + WS_WT_O), MROWS, DM, DM}; pg8::StaticOrder S; S.init(MROWS, DM, G, bid); pg8::gemm_phase(ldsl, g, S, E);
    }
    SEAM(8);
    if (IN(9)) {
        const pg8::Epi E{5, ws, p.x, p.out, p.lb_logits, p.final_norm_g, 0};
        pg8::Gemm g{XB, (const bf16_t*)(ws + WS_WT_FF1), MROWS, DFF, DM}; pg8::StaticOrder S; S.init(MROWS, DFF, G, bid); pg8::gemm_phase(ldsl, g, S, E);
    }
    SEAM(9);
    if (IN(10)) {
        const pg8::Epi E{fuse_final ? 8 : 7, ws, p.x, p.out, p.lb_logits, p.final_norm_g, 0};
        pg8::Gemm g{U, (const bf16_t*)(ws + WS_WT_FF2), MROWS, DM, DFF}; pg8::StaticOrder S; S.init(MROWS, DM, G, bid); pg8::gemm_phase(ldsl, g, S, E);
    }
    if (!fuse_final) {
        SEAM(10);
        if (IN(11)) { phase_final(XB, SSQ, p.out, p.final_norm_g); }
    }
#if DBG_LAST >= 0
    cg::this_grid().sync();
    {
        const unsigned* w32 = (const unsigned*)ws;
        for (size_t i = (size_t)bid * NTHREADS + threadIdx.x; i < (size_t)MROWS * DM; i += (size_t)G * NTHREADS) {
            float a = 0.f;
            for (int j = 0; j < 4; ++j) { const unsigned v = w32[i + (size_t)j * MROWS * DM]; a += (float)(v & 0xffffu) + (float)(v >> 16); }
            p.out[i] = a;
        }
    }
#endif
#undef IN
#undef SEAM
}

extern "C" void kernel_launch(void* const* d_in, const int* in_sizes, int n_in, void* d_out, int out_size, void* d_ws, size_t ws_size, hipStream_t stream) {
    static int grid = 0;
    if (grid == 0) {
        if (n_in != 19 || in_sizes[0] != MROWS * DM || out_size != MROWS * DM || ws_size < WS_END) { fprintf(stderr, "kernel_launch: unexpected shapes (n_in %d, ws %zu)\n", n_in, ws_size); grid = -1; return; }
        int dev = 0, cus = 0, per_cu = 0;
        hipGetDevice(&dev); hipDeviceGetAttribute(&cus, hipDeviceAttributeMultiprocessorCount, dev);
        if (hipFuncSetAttribute((const void*)mega, hipFuncAttributeMaxDynamicSharedMemorySize, LDS_BYTES) != hipSuccess) { fprintf(stderr, "kernel_launch: hipFuncSetAttribute failed\n"); grid = -1; return; }
        if (hipOccupancyMaxActiveBlocksPerMultiprocessor(&per_cu, (const void*)mega, NTHREADS, LDS_BYTES) != hipSuccess || per_cu < 1) { fprintf(stderr, "kernel_launch: occupancy query says %d\n", per_cu); per_cu = 1; }
        (void)hipGetLastError();
        grid = cus * 1;
        if (grid > cus * per_cu) grid = cus * per_cu;
    }
    if (grid < 0) return;
    if (hipMemsetAsync((char*)d_ws + WS_BAR, 0, 32768, stream) != hipSuccess) { fprintf(stderr, "kernel_launch: memset of barrier words failed\n"); return; }
    Params p{};
    const float** f = (const float**)&p;
    for (int i = 0; i < 19; ++i) f[i] = (const float*)d_in[i];
    p.out = (float*)d_out; p.ws = (unsigned char*)d_ws;
#if N_LAUNCH_MODE == 1
    p.ph_lo = 0; p.ph_hi = (DBG_LAST >= 0) ? DBG_LAST + 1 : N_PHASES;
    void* args[] = {&p};
    hipError_t e = hipLaunchCooperativeKernel((const void*)mega, dim3(grid), dim3(NTHREADS), args, LDS_BYTES, stream);
    if (e != hipSuccess) fprintf(stderr, "kernel_launch: cooperative launch failed: %s (grid %d)\n", hipGetErrorString(e), grid);
#else
    for (int k = 0; k < N_PHASES; ++k) { p.ph_lo = k; p.ph_hi = k + 1; hipLaunchKernelGGL(mega, dim3(grid), dim3(NTHREADS), LDS_BYTES, stream, p); }
#endif
}
```

```cpp
#include <hip/hip_runtime.h>
#include <hip/hip_cooperative_groups.h>
#include <cstdio>
namespace cg = cooperative_groups;

#ifndef N_LAUNCH_MODE
#define N_LAUNCH_MODE 1
#endif

typedef unsigned short bf16_t;
typedef short bf16x8 __attribute__((ext_vector_type(8)));
typedef float f32x2 __attribute__((ext_vector_type(2)));
typedef float f32x4 __attribute__((ext_vector_type(4)));
typedef float f32x16 __attribute__((ext_vector_type(16)));
typedef unsigned u32x2 __attribute__((ext_vector_type(2)));
typedef unsigned u32x4 __attribute__((ext_vector_type(4)));
#define LAS __attribute__((address_space(3)))

constexpr int MROWS = 16384, DM = 1024, SEQ = 4096, NIN = 2560, DFF = 4096, MEMROWS = 1024;
constexpr float EPS = 1e-6f;
constexpr int NTHREADS = 512;
constexpr int LDS_MAIN = 135168;
constexpr int LDS_BYTES = LDS_MAIN + 16;

constexpr size_t MiB = 1u << 20;
constexpr size_t WS_WT_IN = 0, WS_WT_K = 5 * MiB, WS_WT_V = 7 * MiB, WS_WT_OUT = 9 * MiB, WS_WT_Q = 11 * MiB, WS_WT_O = 13 * MiB,
                 WS_WT_FF1 = 15 * MiB, WS_WT_FF2 = 23 * MiB, WS_MEMB = 31 * MiB, WS_KX = 33 * MiB, WS_VT = 35 * MiB, WS_SSQ = 37 * MiB,
                 WS_BAR = 39 * MiB, WS_CNT = 39 * MiB + 16384, WS_RSTD0 = 38 * MiB, WS_RSTDM = 38 * MiB + 65536, WS_DEC = 38 * MiB + 131072,
                 WS_XB = 40 * MiB  , WS_QH = 72 * MiB, WS_KH = 88 * MiB, WS_VH = 104 * MiB, WS_GH = 120 * MiB, WS_PH = 136 * MiB,
                 WS_LF = 152 * MiB, WS_ST = 184 * MiB, WS_MIXED = 216 * MiB,
                 WS_X1 = 72 * MiB, WS_XQ = 136 * MiB, WS_ATT = 168 * MiB, WS_U = 72 * MiB, WS_END = 256 * MiB;

typedef __bf16 bf16x2n __attribute__((ext_vector_type(2)));
__device__ __forceinline__ unsigned cvt_pk_bf16(float lo, float hi) { f32x2 v = {lo, hi}; return __builtin_bit_cast(unsigned, __builtin_convertvector(v, bf16x2n)); }
__device__ __forceinline__ bf16_t f2bf(float f) { return (bf16_t)(cvt_pk_bf16(f, 0.f) & 0xffffu); }
__device__ __forceinline__ float bf2f(bf16_t b) { return __uint_as_float(((unsigned)b) << 16); }
__device__ __forceinline__ float bflo(unsigned u) { return __uint_as_float(u << 16); }
__device__ __forceinline__ float bfhi(unsigned u) { return __uint_as_float(u & 0xffff0000u); }
__device__ __forceinline__ f32x4 mfma16(bf16x8 a, bf16x8 b, f32x4 c) { return __builtin_amdgcn_mfma_f32_16x16x32_bf16(a, b, c, 0, 0, 0); }
__device__ __forceinline__ f32x16 mfma32(bf16x8 a, bf16x8 b, f32x16 c) { return __builtin_amdgcn_mfma_f32_32x32x16_bf16(a, b, c, 0, 0, 0); }
__device__ __forceinline__ bf16x8 mk8(u32x2 lo, u32x2 hi) { u32x4 t; t.x = lo.x; t.y = lo.y; t.z = hi.x; t.w = hi.y; return __builtin_bit_cast(bf16x8, t); }
__device__ __forceinline__ bf16x8 mk8u(unsigned a, unsigned b, unsigned c, unsigned d) { u32x4 t; t.x = a; t.y = b; t.z = c; t.w = d; return __builtin_bit_cast(bf16x8, t); }
__device__ __forceinline__ float sigmoidf_(float z) { return __builtin_amdgcn_rcpf(1.0f + __expf(-z)); }

namespace pg8 {
constexpr int BM = 256, BK = 64, HALF = 128, HTB = HALF * BK * 2, STAGE_BYTES = 8 * HTB, NXCD = 8, WGM = 8;
__device__ __forceinline__ int lds_byte(int r, int c) { const int st = (r >> 4) * 2 + (c >> 5), rr = r & 15, cc = c & 31, ob = rr * 64 + cc * 2; return st * 1024 + (ob ^ (((ob >> 9) & 1) << 5)); }
__device__ __forceinline__ void stage_rc(int b, int& R, int& C) { const int st = b / 1024, sb = b % 1024, swz = sb ^ (((sb >> 9) & 1) << 5); R = (st >> 1) * 16 + swz / 64; C = (st & 1) * 32 + (swz % 64) / 2; }
__device__ __forceinline__ int perm32(int rho) { const int n = rho >> 4, i = rho & 15; return 8 * (i >> 2) + 4 * n + (i & 3); }
struct Unit { int pm, pn; };
struct Gemm { const bf16_t* A; const bf16_t* Bt; int M, N, K; };
struct StaticOrder {
    int nM, nN, nwg, G, c;
    __device__ __forceinline__ void init(int M, int N, int G_, int c_) { nM = M / BM; nN = N / BM; nwg = nM * nN; G = G_; c = c_; }
    __device__ __forceinline__ bool next(int i, Unit& u) const {
        const long L = (long)i * G + c; if (L >= nwg) return false;
        int wgid = (int)L; { const int q = nwg / NXCD, r = nwg % NXCD, xcd = wgid % NXCD, off = wgid / NXCD; wgid = (xcd < r ? xcd * (q + 1) : r * (q + 1) + (xcd - r) * q) + off; }
        const int nig = WGM * nN, gid = wgid / nig, fm = gid * WGM, gsz = (nM - fm) < WGM ? (nM - fm) : WGM;
        u.pm = fm + ((wgid % nig) % gsz); u.pn = (wgid % nig) / gsz; return true;
    }
};

struct Epi {
    static constexpr bool PERM = true;
    int mode;
    unsigned char* ws; const float* x; float* out; const float* lbl; const float* gfin; int pnoff;
    __device__ __forceinline__ void store8(bf16_t* p, const f32x4& v0, const f32x4& v1) const {
        u32x4 w; w.x = cvt_pk_bf16(v0[0], v0[1]); w.y = cvt_pk_bf16(v0[2], v0[3]); w.z = cvt_pk_bf16(v1[0], v1[1]); w.w = cvt_pk_bf16(v1[2], v1[3]); *(u32x4*)p = w; }
    __device__ __forceinline__ void fused(f32x4 (&acc)[2][2][4][2], const Unit& u, int wr, int wc, int fr, int fq) const {
        const int row0 = u.pm * BM + wr * 64 + fr;
        const int col0 = u.pn * BM + wc * 32 + 8 * fq;
        const bf16_t* xb = (const bf16_t*)(ws + WS_XB);
        unsigned* sq = (unsigned*)(ws + WS_SSQ);
        unsigned* cnt = (unsigned*)(ws + WS_CNT) + 64 * u.pm;
        u32x4 bc[2], bn[2];
        { const size_t o = (size_t)row0 * DM + col0; bc[0] = *(const u32x4*)(xb + o); bc[1] = *(const u32x4*)(xb + o + HALF); }
#pragma unroll
        for (int gidx = 0; gidx < 8; ++gidx) { const int ai = gidx >> 2, m = gidx & 3; const int row = row0 + ai * HALF + m * 16;
            if (gidx < 7) { const int g2 = gidx + 1; const size_t o2 = (size_t)(row0 + (g2 >> 2) * HALF + (g2 & 3) * 16) * DM + col0; bn[0] = *(const u32x4*)(xb + o2); bn[1] = *(const u32x4*)(xb + o2 + HALF); }
            float ss = 0.f;
#pragma unroll
            for (int bj = 0; bj < 2; ++bj) { const u32x4 bb = bc[bj];
                const f32x4 v0 = acc[ai][bj][m][0] + (f32x4){bflo(bb.x), bfhi(bb.x), bflo(bb.y), bfhi(bb.y)}, v1 = acc[ai][bj][m][1] + (f32x4){bflo(bb.z), bfhi(bb.z), bflo(bb.w), bfhi(bb.w)};
                acc[ai][bj][m][0] = v0; acc[ai][bj][m][1] = v1;
                ss += (v0[0] * v0[0] + v0[1] * v0[1]) + (v0[2] * v0[2] + v0[3] * v0[3]) + (v1[0] * v1[0] + v1[1] * v1[1]) + (v1[2] * v1[2] + v1[3] * v1[3]); }
            ss += __shfl_xor(ss, 16); ss += __shfl_xor(ss, 32);
            if (fq == 0) __hip_atomic_store(sq + (size_t)row * 16 + u.pn * 4 + wc, __float_as_uint(ss), __ATOMIC_RELAXED, __HIP_MEMORY_SCOPE_AGENT);
            bc[0] = bn[0]; bc[1] = bn[1]; }
        asm volatile("s_waitcnt vmcnt(0)" ::: "memory");
        if ((threadIdx.x & 63) == 0) __hip_atomic_fetch_add(cnt, 1u, __ATOMIC_RELAXED, __HIP_MEMORY_SCOPE_AGENT);
        f32x4 gv[2][2];
#pragma unroll
        for (int bj = 0; bj < 2; ++bj) { gv[bj][0] = *(const f32x4*)(gfin + col0 + bj * HALF); gv[bj][1] = *(const f32x4*)(gfin + col0 + bj * HALF + 4); }
        { unsigned spins = 0; while ((unsigned)__builtin_amdgcn_readfirstlane(__hip_atomic_load(cnt, __ATOMIC_RELAXED, __HIP_MEMORY_SCOPE_AGENT)) < 32u) { __builtin_amdgcn_s_sleep(1); if (++spins > (1u << 22)) break; } }
        __builtin_amdgcn_fence(__ATOMIC_ACQUIRE, "agent");
        asm volatile("s_waitcnt vmcnt(0)" ::: "memory");
        f32x4 pv[8];
#pragma unroll
        for (int gidx = 0; gidx < 8; ++gidx) pv[gidx] = *(const f32x4*)((const float*)sq + (size_t)(row0 + (gidx >> 2) * HALF + (gidx & 3) * 16) * 16 + 4 * fq);
#pragma unroll
        for (int gidx = 0; gidx < 8; ++gidx) { const int ai = gidx >> 2, m = gidx & 3; const int row = row0 + ai * HALF + m * 16;
            float t = (pv[gidx][0] + pv[gidx][1]) + (pv[gidx][2] + pv[gidx][3]); t += __shfl_xor(t, 16); t += __shfl_xor(t, 32);
            const float rstd = rsqrtf(t * (1.0f / 1024.0f) + EPS);
            const size_t o = (size_t)row * DM + col0;
#pragma unroll
            for (int bj = 0; bj < 2; ++bj) { *(f32x4*)(out + o + bj * HALF) = acc[ai][bj][m][0] * rstd * gv[bj][0]; *(f32x4*)(out + o + bj * HALF + 4) = acc[ai][bj][m][1] * rstd * gv[bj][1]; } }
    }
    template <class Sched>
    __device__ __forceinline__ bool prefill(LAS unsigned char* lds, const Sched& S) const {
        if (!(mode == 0 || mode == 1 || mode == 4 || mode == 5) || S.nwg > 4 * S.G) return false;
        const int tid = threadIdx.x, rr = tid & 255;
#pragma unroll
        for (int k = 0; k < 2; ++k) { const int ui = (tid >> 8) + 2 * k; Unit u;
            if (S.next(ui, u)) { const int row = u.pm * BM + rr; float r;
                if (mode == 4 || mode == 5) { const f32x4* pp = (const f32x4*)((const float*)(ws + WS_SSQ) + (size_t)row * 16); const f32x4 a = pp[0], b = pp[1], c = pp[2], d = pp[3];
                    const float t = ((a[0] + a[1]) + (a[2] + a[3])) + ((b[0] + b[1]) + (b[2] + b[3])) + ((c[0] + c[1]) + (c[2] + c[3])) + ((d[0] + d[1]) + (d[2] + d[3]));
                    r = rsqrtf(t * (1.0f / 1024.0f) + EPS) * (mode == 4 ? 0.0625f : 1.0f); }
                else r = ((const float*)(ws + (mode == 0 ? WS_RSTD0 : WS_RSTDM)))[row];
                *(LAS float*)(lds + STAGE_BYTES + (ui * 256 + rr) * 4) = r; } }
        return true;
    }
    __device__ __forceinline__ void operator()(const f32x4 (&acc)[2][2][4][2], const Unit& u, int ui, bool tab, LAS unsigned char* lds, int wr, int wc, int fr, int fq) const {
        const int row0 = u.pm * BM + wr * 64 + fr;
        const int colL = wc * 32 + 8 * fq;
        if (mode == 3 || mode == 6 || mode == 7) {
            const int col0 = u.pn * BM + colL;
            bf16_t* xb = (bf16_t*)(ws + WS_XB);
            float* ssq = (float*)(ws + WS_SSQ);
            f32x4 rc[4], rn[4];
            u32x4 bc[2], bn[2];
            if (mode == 3) { const size_t o = (size_t)row0 * DM + col0; rc[0] = *(const f32x4*)(x + o); rc[1] = *(const f32x4*)(x + o + 4); rc[2] = *(const f32x4*)(x + o + HALF); rc[3] = *(const f32x4*)(x + o + HALF + 4); }
            else { const size_t o = (size_t)row0 * DM + col0; bc[0] = *(const u32x4*)(xb + o); bc[1] = *(const u32x4*)(xb + o + HALF); }
#pragma unroll
            for (int gidx = 0; gidx < 8; ++gidx) { const int ai = gidx >> 2, m = gidx & 3; const int row = row0 + ai * HALF + m * 16;
                if (gidx < 7) { const int g2 = gidx + 1; const size_t o2 = (size_t)(row0 + (g2 >> 2) * HALF + (g2 & 3) * 16) * DM + col0;
                    if (mode == 3) { rn[0] = *(const f32x4*)(x + o2); rn[1] = *(const f32x4*)(x + o2 + 4); rn[2] = *(const f32x4*)(x + o2 + HALF); rn[3] = *(const f32x4*)(x + o2 + HALF + 4); }
                    else { bn[0] = *(const u32x4*)(xb + o2); bn[1] = *(const u32x4*)(xb + o2 + HALF); } }
                if (mode != 3) {
#pragma unroll
                    for (int bj = 0; bj < 2; ++bj) { rc[2 * bj] = (f32x4){bflo(bc[bj].x), bfhi(bc[bj].x), bflo(bc[bj].y), bfhi(bc[bj].y)}; rc[2 * bj + 1] = (f32x4){bflo(bc[bj].z), bfhi(bc[bj].z), bflo(bc[bj].w), bfhi(bc[bj].w)}; } }
                float ss = 0.f;
#pragma unroll
                for (int bj = 0; bj < 2; ++bj) { const size_t o = (size_t)row * DM + col0 + bj * HALF;
                    const f32x4 v0 = acc[ai][bj][m][0] + rc[2 * bj], v1 = acc[ai][bj][m][1] + rc[2 * bj + 1];
                    store8(xb + o, v0, v1);
                    ss += (v0[0] * v0[0] + v0[1] * v0[1]) + (v0[2] * v0[2] + v0[3] * v0[3]) + (v1[0] * v1[0] + v1[1] * v1[1]) + (v1[2] * v1[2] + v1[3] * v1[3]); }
                ss += __shfl_xor(ss, 16); ss += __shfl_xor(ss, 32);
                if (fq == 0) ssq[(size_t)row * 16 + u.pn * 4 + wc] = ss;
#pragma unroll
                for (int k = 0; k < 4; ++k) rc[k] = rn[k];
                bc[0] = bn[0]; bc[1] = bn[1]; }
            return;
        }
        if (mode == 2) {
            const int col0 = u.pn * BM + colL;
            const float* rs = (const float*)(ws + WS_RSTDM); bf16_t* ob = (bf16_t*)(ws + WS_VT); const int ldo = 1024;
            f32x4 c0[2], c1[2];
#pragma unroll
            for (int bj = 0; bj < 2; ++bj) { c0[bj] = *(const f32x4*)(rs + col0 + bj * HALF); c1[bj] = *(const f32x4*)(rs + col0 + bj * HALF + 4); }
#pragma unroll
            for (int ai = 0; ai < 2; ++ai)
#pragma unroll
                for (int m = 0; m < 4; ++m) { const int row = row0 + ai * HALF + m * 16;
#pragma unroll
                    for (int bj = 0; bj < 2; ++bj) store8(ob + (size_t)row * ldo + col0 + bj * HALF, acc[ai][bj][m][0] * c0[bj], acc[ai][bj][m][1] * c1[bj]); }
            return;
        }
        float rsc[8];
        if (tab) {
#pragma unroll
            for (int gidx = 0; gidx < 8; ++gidx) rsc[gidx] = *(const LAS float*)(lds + STAGE_BYTES + (ui * 256 + wr * 64 + fr + (gidx >> 2) * HALF + (gidx & 3) * 16) * 4);
        } else if (mode == 4 || mode == 5) {
            asm volatile("" ::: "memory");
            const float* sq = (const float*)(ws + WS_SSQ);
            f32x4 pv[8];
#pragma unroll
            for (int gidx = 0; gidx < 8; ++gidx) pv[gidx] = *(const f32x4*)(sq + (size_t)(row0 + (gidx >> 2) * HALF + (gidx & 3) * 16) * 16 + 4 * fq);
            const float cs = mode == 4 ? 0.0625f : 1.0f;
#pragma unroll
            for (int gidx = 0; gidx < 8; ++gidx) { float t = (pv[gidx][0] + pv[gidx][1]) + (pv[gidx][2] + pv[gidx][3]); t += __shfl_xor(t, 16); t += __shfl_xor(t, 32); rsc[gidx] = rsqrtf(t * (1.0f / 1024.0f) + EPS) * cs; }
        } else {
            asm volatile("" ::: "memory");
            const float* rs = (const float*)(ws + (mode == 0 ? WS_RSTD0 : WS_RSTDM));
#pragma unroll
            for (int gidx = 0; gidx < 8; ++gidx) rsc[gidx] = rs[row0 + (gidx >> 2) * HALF + (gidx & 3) * 16];
        }
        if (mode == 0) {
            float* lf = (float*)(ws + WS_LF);
            const int pnn = u.pn + pnoff; const int sub = pnn >> 1; const int cb = (pnn & 1) * 256 + colL;
            if (sub == 1) {
                float oml[2][8];
#pragma unroll
                for (int bj = 0; bj < 2; ++bj)
#pragma unroll
                    for (int j = 0; j < 8; ++j) { const int c = cb + bj * HALF + j; const float l0 = lbl[c], l1 = lbl[512 + c]; const float lb = 1.0f / (1.0f + __expf(l1 - l0)); oml[bj][j] = 1.0f - lb; }
#pragma unroll
                for (int ai = 0; ai < 2; ++ai)
#pragma unroll
                    for (int m = 0; m < 4; ++m) { const int row = row0 + ai * HALF + m * 16; const float r = rsc[ai * 4 + m];
#pragma unroll
                        for (int bj = 0; bj < 2; ++bj) { f32x4 lf0, lf1;
#pragma unroll
                            for (int j = 0; j < 4; ++j) {
                                const float za = acc[ai][bj][m][0][j] * r, zb = acc[ai][bj][m][1][j] * r;
                                const float ka = oml[bj][j] * (1.0f - sigmoidf_(za)), kb = oml[bj][4 + j] * (1.0f - sigmoidf_(zb));
                                lf0[j] = __logf(1.0f - ka); lf1[j] = __logf(1.0f - kb); }
                            const size_t o = (size_t)row * 512 + cb + bj * HALF;
                            *(f32x4*)(lf + o) = lf0; *(f32x4*)(lf + o + 4) = lf1; } }
            } else {
                bf16_t* dst = (bf16_t*)(ws + (sub == 0 ? WS_QH : (sub == 2 ? WS_VH : (sub == 3 ? WS_GH : WS_PH))));
                const bool act = (sub == 0) || (sub == 3);
#pragma unroll
                for (int ai = 0; ai < 2; ++ai)
#pragma unroll
                    for (int m = 0; m < 4; ++m) { const int row = row0 + ai * HALF + m * 16; const float r = rsc[ai * 4 + m];
#pragma unroll
                        for (int bj = 0; bj < 2; ++bj) { f32x4 v0 = acc[ai][bj][m][0] * r, v1 = acc[ai][bj][m][1] * r;
                            if (act) {
#pragma unroll
                                for (int j = 0; j < 4; ++j) { v0[j] = v0[j] * sigmoidf_(v0[j]); v1[j] = v1[j] * sigmoidf_(v1[j]); } }
                            store8(dst + (size_t)row * 512 + cb + bj * HALF, v0, v1); } }
            }
        } else {
            const int col0 = u.pn * BM + colL;
            bf16_t* ob = (bf16_t*)(ws + (mode == 1 ? WS_KX : (mode == 4 ? WS_XQ : WS_U))); const int ldo = mode == 5 ? DFF : 1024;
#pragma unroll
            for (int ai = 0; ai < 2; ++ai)
#pragma unroll
                for (int m = 0; m < 4; ++m) { const int row = row0 + ai * HALF + m * 16; const float r = rsc[ai * 4 + m];
#pragma unroll
                    for (int bj = 0; bj < 2; ++bj) { f32x4 v0 = acc[ai][bj][m][0] * r, v1 = acc[ai][bj][m][1] * r;
                        if (mode == 5) {
#pragma unroll
                            for (int j = 0; j < 4; ++j) { const float a = fmaxf(v0[j], 0.f), b = fmaxf(v1[j], 0.f); v0[j] = a * a; v1[j] = b * b; } }
                        store8(ob + (size_t)row * ldo + col0 + bj * HALF, v0, v1); } }
        }
    }
};

template <class EpiT, class Sched>
__device__ __forceinline__ void gemm_phase(LAS unsigned char* lds, const Gemm g, const Sched S, const EpiT E) {
    const int tid = threadIdx.x, wid = __builtin_amdgcn_readfirstlane(tid >> 6), lane = tid & 63, wr = wid >> 2, wc = wid & 3, fr = lane & 15, fq = lane >> 4;
    const int K = g.K, nt = K / BK;
    unsigned voffA[2], voffB[2];
#pragma unroll
    for (int i = 0; i < 2; ++i) { int R, C; stage_rc(tid * 16 + i * 8192, R, C); const int Rb = EpiT::PERM ? ((R & ~31) + perm32(R & 31)) : R;
        voffA[i] = (unsigned)(R * K + C) * 2u; voffB[i] = (unsigned)(Rb * K + C) * 2u; }
    const size_t kstep = (size_t)(BK * 2);
    const size_t hstep = (size_t)HALF * K * 2;
    const size_t tstep = 2 * hstep;
    const unsigned ldsw = (unsigned)wid * 1024u;
    const int aoff = lds_byte(wr * 64 + fr, fq * 8), boff = lds_byte(wc * 32 + fr, fq * 8);
#define PG8_SA(b, h) (((b) * 2 + (h)) * HTB)
#define PG8_SB(b, h) ((4 + (b) * 2 + (h)) * HTB)
#define PG8_STAGE(bufoff, gbase, voff) do { _Pragma("unroll") for (int _i = 0; _i < 2; ++_i) \
        __builtin_amdgcn_global_load_lds((const unsigned*)((const char*)(gbase) + (voff)[_i]), (LAS unsigned*)(lds + (bufoff) + ldsw + _i * 8192), 16, 0, 0); } while (0)
#define PG8_LDA(dst, b, h) do { _Pragma("unroll") for (int m = 0; m < 4; ++m) _Pragma("unroll") for (int k = 0; k < 2; ++k) dst[m][k] = *(const LAS bf16x8*)(lds + PG8_SA(b, h) + aoff + m * 2048 + k * 1024); } while (0)
#define PG8_LDB(dst, b, h) do { _Pragma("unroll") for (int n = 0; n < 2; ++n) _Pragma("unroll") for (int k = 0; k < 2; ++k) dst[n][k] = *(const LAS bf16x8*)(lds + PG8_SB(b, h) + boff + n * 2048 + k * 1024); } while (0)
#define PG8_MMA(ai, bj, At, Bt) do { __builtin_amdgcn_s_setprio(1); _Pragma("unroll") for (int m = 0; m < 4; ++m) _Pragma("unroll") for (int n = 0; n < 2; ++n) _Pragma("unroll") for (int k = 0; k < 2; ++k) \
        acc[ai][bj][m][n] = __builtin_amdgcn_mfma_f32_16x16x32_bf16(Bt[n][k], At[m][k], acc[ai][bj][m][n], 0, 0, 0); __builtin_amdgcn_s_setprio(0); } while (0)
#define PG8_WAIT_V(n) asm volatile("s_waitcnt vmcnt(" #n ")" ::: "memory")
#define PG8_WAIT_L(n) asm volatile("s_waitcnt lgkmcnt(" #n ")" ::: "memory")
#define PG8_BAR __builtin_amdgcn_s_barrier()
#define PG8_SCHED __builtin_amdgcn_sched_barrier(0)
    Unit cur, nxt; int ui = 0;
    if (!S.next(0, cur)) return;
    const bool tab = E.prefill(lds, S);
    if (tab) __syncthreads();
    f32x4 acc[2][2][4][2];
#pragma unroll
    for (int a = 0; a < 2; ++a)
#pragma unroll
        for (int b = 0; b < 2; ++b)
#pragma unroll
            for (int m = 0; m < 4; ++m)
#pragma unroll
                for (int n = 0; n < 2; ++n) acc[a][b][m][n] = (f32x4){0.f, 0.f, 0.f, 0.f};
    bf16x8 At[4][2], B0[2][2], B1[2][2];
    const char* cA = (const char*)g.A + (size_t)cur.pm * tstep; const char* cB = (const char*)g.Bt + (size_t)cur.pn * tstep;
    PG8_STAGE(PG8_SB(0, 0), cB, voffB); PG8_STAGE(PG8_SA(0, 0), cA, voffA); PG8_STAGE(PG8_SB(0, 1), cB + hstep, voffB); PG8_STAGE(PG8_SA(0, 1), cA + hstep, voffA);
    if (wr == 1) PG8_BAR;
    PG8_WAIT_V(4); PG8_BAR;
    PG8_STAGE(PG8_SB(1, 0), cB + kstep, voffB); PG8_STAGE(PG8_SA(1, 0), cA + kstep, voffA); PG8_STAGE(PG8_SB(1, 1), cB + hstep + kstep, voffB);
    PG8_WAIT_V(6); PG8_BAR;
    for (;;) {
        const bool has_next = S.next(ui + 1, nxt);
        const char* nA = has_next ? (const char*)g.A + (size_t)nxt.pm * tstep : cA; const char* nB = has_next ? (const char*)g.Bt + (size_t)nxt.pn * tstep : cB;
        for (int t = 0; t < nt; t += 2) {
            const bool last = (t == nt - 2);
            const char* a1 = cA + (size_t)(t + 1) * kstep;
            const char* a2 = last ? nA : cA + (size_t)(t + 2) * kstep; const char* b2 = last ? nB : cB + (size_t)(t + 2) * kstep;
            const char* a3 = a2 + kstep; const char* b3 = b2 + kstep;
            PG8_LDB(B0, 0, 0); PG8_SCHED; PG8_LDA(At, 0, 0); PG8_STAGE(PG8_SA(1, 1), a1 + hstep, voffA);
            PG8_WAIT_L(8); PG8_BAR; PG8_WAIT_L(0); PG8_MMA(0, 0, At, B0); PG8_BAR; PG8_SCHED;
            PG8_LDB(B1, 0, 1); PG8_STAGE(PG8_SB(0, 0), b2, voffB);
            PG8_BAR; PG8_WAIT_L(0); PG8_MMA(0, 1, At, B1); PG8_BAR;
            PG8_LDA(At, 0, 1); PG8_STAGE(PG8_SA(0, 0), a2, voffA);
            PG8_BAR; PG8_WAIT_L(0); PG8_MMA(1, 0, At, B0); PG8_BAR; PG8_SCHED;
            PG8_STAGE(PG8_SB(0, 1), b2 + hstep, voffB);
            PG8_WAIT_V(6); PG8_BAR; PG8_MMA(1, 1, At, B1); PG8_BAR;
            PG8_LDB(B0, 1, 0); PG8_SCHED; PG8_LDA(At, 1, 0); PG8_STAGE(PG8_SA(0, 1), a2 + hstep, voffA);
            PG8_WAIT_L(8); PG8_BAR; PG8_WAIT_L(0); PG8_MMA(0, 0, At, B0); PG8_BAR; PG8_SCHED;
            PG8_LDB(B1, 1, 1); PG8_STAGE(PG8_SB(1, 0), b3, voffB);
            PG8_BAR; PG8_WAIT_L(0); PG8_MMA(0, 1, At, B1); PG8_BAR;
            PG8_LDA(At, 1, 1); PG8_STAGE(PG8_SA(1, 0), a3, voffA);
            PG8_BAR; PG8_WAIT_L(0); PG8_MMA(1, 0, At, B0); PG8_BAR; PG8_SCHED;
            PG8_STAGE(PG8_SB(1, 1), b3 + hstep, voffB);
            PG8_WAIT_V(6); PG8_BAR; PG8_MMA(1, 1, At, B1); PG8_BAR;
        }
        if (E.mode != 8) E(acc, cur, ui, tab, lds, wr, wc, fr, fq);
        if (E.mode == 0) __builtin_amdgcn_s_waitcnt(0x0F70);
        if (!has_next) break;
#pragma unroll
        for (int a = 0; a < 2; ++a)
#pragma unroll
            for (int b = 0; b < 2; ++b)
#pragma unroll
                for (int m = 0; m < 4; ++m)
#pragma unroll
                    for (int n = 0; n < 2; ++n) acc[a][b][m][n] = (f32x4){0.f, 0.f, 0.f, 0.f};
        cur = nxt; cA = nA; cB = nB; ++ui;
    }
    PG8_WAIT_V(0);
    if (wr == 0) PG8_BAR;
    PG8_BAR;
    if (E.mode == 8) E.fused(acc, cur, wr, wc, fr, fq);
#undef PG8_SA
#undef PG8_SB
#undef PG8_STAGE
#undef PG8_LDA
#undef PG8_LDB
#undef PG8_MMA
#undef PG8_WAIT_V
#undef PG8_WAIT_L
#undef PG8_BAR
#undef PG8_SCHED
}
}

struct Params {
    const float *x, *mem, *norm_mix_g, *w_in, *lb_logits, *hgrn_norm_g, *w_pool, *pool_scale, *w_out, *norm_x_g, *norm_mem_g, *w_xq, *w_xk, *w_xv, *w_xo, *norm_ffn_g, *w_ff1, *w_ff2, *final_norm_g;
    float* out; unsigned char* ws;
    int ph_lo, ph_hi;
};

struct TD { const float* W; const float* g; bf16_t* out; int N, ldo, kt, nt; };
__device__ __forceinline__ TD tile_desc(const Params& p, int t) {
    unsigned char* ws = p.ws; TD d;
    if (t < 320)       { d.W = p.w_in;  d.g = p.norm_mix_g; d.out = (bf16_t*)(ws + WS_WT_IN);  d.N = NIN;  d.ldo = 1024; d.kt = t / 40; d.nt = t % 40; }
    else if (t < 448)  { const int u = t - 320;  d.W = p.w_xk;  d.g = p.norm_mem_g; d.out = (bf16_t*)(ws + WS_WT_K);   d.N = 1024; d.ldo = 1024; d.kt = u / 16; d.nt = u % 16; }
    else if (t < 576)  { const int u = t - 448;  d.W = p.w_xv;  d.g = p.norm_mem_g; d.out = (bf16_t*)(ws + WS_WT_V);   d.N = 1024; d.ldo = 1024; d.kt = u / 16; d.nt = u % 16; }
    else if (t < 704)  { const int u = t - 576;  d.W = p.w_xq;  d.g = p.norm_x_g;   d.out = (bf16_t*)(ws + WS_WT_Q);   d.N = 1024; d.ldo = 1024; d.kt = u / 16; d.nt = u % 16; }
    else if (t < 832)  { const int u = t - 704;  d.W = p.w_xo;  d.g = nullptr;      d.out = (bf16_t*)(ws + WS_WT_O);   d.N = 1024; d.ldo = 1024; d.kt = u / 16; d.nt = u % 16; }
    else if (t < 960)  { const int u = t - 832;  d.W = p.w_out; d.g = nullptr;      d.out = (bf16_t*)(ws + WS_WT_OUT); d.N = 1024; d.ldo = 1024; d.kt = u / 16; d.nt = u % 16; }
    else if (t < 1472) { const int u = t - 960;  d.W = p.w_ff1; d.g = p.norm_ffn_g; d.out = (bf16_t*)(ws + WS_WT_FF1); d.N = DFF;  d.ldo = 1024; d.kt = u / 64; d.nt = u % 64; }
    else if (t < 1984) { const int u = t - 1472; d.W = p.w_ff2; d.g = nullptr;      d.out = (bf16_t*)(ws + WS_WT_FF2); d.N = 1024; d.ldo = 4096; d.kt = u / 16; d.nt = u % 16; }
    else if (t < 2112) { const int u = t - 1984; d.W = p.w_in;  d.g = p.norm_mix_g; d.out = (bf16_t*)(ws + WS_WT_IN);  d.N = NIN;  d.ldo = 1024; d.kt = u / 16; d.nt = 8 + u % 16; }
    else               { const int u = t - 2112, j = u % 24; d.W = p.w_in; d.g = p.norm_mix_g; d.out = (bf16_t*)(ws + WS_WT_IN); d.N = NIN; d.ldo = 1024; d.kt = u / 24; d.nt = j < 8 ? j : 16 + j; }
    return d;
}
__device__ __forceinline__ void tile_load(const TD& d, f32x4 (&v)[4], float (&sc)[4]) {
    const int tid = threadIdx.x, r = tid >> 4, c4 = tid & 15;
#pragma unroll
    for (int i = 0; i < 4; ++i) { const int k = 128 * d.kt + r + 32 * i; v[i] = __builtin_nontemporal_load((const f32x4*)(d.W + (size_t)k * d.N + 64 * d.nt + 4 * c4)); sc[i] = d.g ? d.g[k] : 1.0f; }
}
__device__ __forceinline__ void transpose_range(const Params& p, unsigned char* lds, int t_begin, int t_end, int first, int stride) {
    bf16_t* T0 = (bf16_t*)lds;
    bf16_t* T1 = (bf16_t*)(lds + 17408);
    const int tid = threadIdx.x, r = tid >> 4, c4 = tid & 15, n = tid >> 3, ks = tid & 7;
    int ta = t_begin + first;
    if (ta >= t_end) return;
    int tb = ta + stride; bool hb = tb < t_end;
    TD da = tile_desc(p, ta), db = da; f32x4 va[4], vb[4]; float sa[4], sb[4];
    tile_load(da, va, sa);
    if (hb) { db = tile_desc(p, tb); tile_load(db, vb, sb); }
    for (;;) {
#pragma unroll
        for (int i = 0; i < 4; ++i) { const int kl = r + 32 * i;
            T0[(4 * c4 + 0) * 136 + kl] = f2bf(va[i][0] * sa[i]); T0[(4 * c4 + 1) * 136 + kl] = f2bf(va[i][1] * sa[i]);
            T0[(4 * c4 + 2) * 136 + kl] = f2bf(va[i][2] * sa[i]); T0[(4 * c4 + 3) * 136 + kl] = f2bf(va[i][3] * sa[i]); }
        if (hb) {
#pragma unroll
            for (int i = 0; i < 4; ++i) { const int kl = r + 32 * i;
                T1[(4 * c4 + 0) * 136 + kl] = f2bf(vb[i][0] * sb[i]); T1[(4 * c4 + 1) * 136 + kl] = f2bf(vb[i][1] * sb[i]);
                T1[(4 * c4 + 2) * 136 + kl] = f2bf(vb[i][2] * sb[i]); T1[(4 * c4 + 3) * 136 + kl] = f2bf(vb[i][3] * sb[i]); } }
        __syncthreads();
        const int tna = ta + 2 * stride, tnb = tna + stride; const bool hna = tna < t_end, hnb = tnb < t_end;
        const TD ca = da, cb = db; const bool chb = hb;
        if (hna) { da = tile_desc(p, tna); tile_load(da, va, sa); }
        if (hnb) { db = tile_desc(p, tnb); tile_load(db, vb, sb); }
        { const u32x4* src = (const u32x4*)(T0 + n * 136 + 16 * ks); const u32x4 a = src[0], b = src[1];
          u32x4* dst = (u32x4*)(ca.out + (size_t)(64 * ca.nt + n) * ca.ldo + 128 * ca.kt + 16 * ks); dst[0] = a; dst[1] = b; }
        if (chb) { const u32x4* src = (const u32x4*)(T1 + n * 136 + 16 * ks); const u32x4 a = src[0], b = src[1];
          u32x4* dst = (u32x4*)(cb.out + (size_t)(64 * cb.nt + n) * cb.ldo + 128 * cb.kt + 16 * ks); dst[0] = a; dst[1] = b; }
        __syncthreads();
        if (!hna) break;
        ta = tna; hb = hnb;
    }
}
__device__ __forceinline__ void phase_prep(const Params p, unsigned char* lds, bool shadow) {
    unsigned char* ws = p.ws;
    const int G = gridDim.x;
    {
        const int lane = threadIdx.x & 63, gw = blockIdx.x * (NTHREADS / 64) + (threadIdx.x >> 6), nw = G * (NTHREADS / 64);
        int r = gw;
        f32x4 v[4], vn[4];
        if (r < MROWS + MEMROWS) { const float* src = r < MROWS ? p.x + (size_t)r * DM : p.mem + (size_t)(r - MROWS) * DM;
#pragma unroll
            for (int i = 0; i < 4; ++i) v[i] = __builtin_nontemporal_load((const f32x4*)src + lane + 64 * i); }
        for (; r < MROWS + MEMROWS; r += nw) {
            const int rn = r + nw;
            if (rn < MROWS + MEMROWS) { const float* src = rn < MROWS ? p.x + (size_t)rn * DM : p.mem + (size_t)(rn - MROWS) * DM;
#pragma unroll
                for (int i = 0; i < 4; ++i) vn[i] = __builtin_nontemporal_load((const f32x4*)src + lane + 64 * i); }
            const bool isx = r < MROWS;
            bf16_t* dst = isx ? (bf16_t*)(ws + WS_XB) + (size_t)r * DM : (bf16_t*)(ws + WS_MEMB) + (size_t)(r - MROWS) * DM;
            float ss = 0.f;
#pragma unroll
            for (int i = 0; i < 4; ++i) ss += (v[i][0] * v[i][0] + v[i][1] * v[i][1]) + (v[i][2] * v[i][2] + v[i][3] * v[i][3]);
#pragma unroll
            for (int o = 1; o < 64; o <<= 1) ss += __shfl_xor(ss, o);
#pragma unroll
            for (int i = 0; i < 4; ++i) { u32x2 w; w.x = cvt_pk_bf16(v[i][0], v[i][1]); w.y = cvt_pk_bf16(v[i][2], v[i][3]); ((u32x2*)dst)[lane + 64 * i] = w; }
            if (lane == 0) { const float rstd = rsqrtf(ss * (1.0f / 1024.0f) + EPS); if (isx) ((float*)(ws + WS_RSTD0))[r] = rstd; else ((float*)(ws + WS_RSTDM))[r - MROWS] = rstd; }
#pragma unroll
            for (int i = 0; i < 4; ++i) v[i] = vn[i];
        }
    }
    if (shadow) transpose_range(p, lds, 1984, 2112, blockIdx.x, G);
    else transpose_range(p, lds, 0, 576, blockIdx.x, G);
}
__device__ __forceinline__ void deferred_prep(const Params p, unsigned char* lds, int j, int nworkers) {
    transpose_range(p, lds, 576, 1984, j, nworkers);
}
__device__ __forceinline__ void fold_pool_weights_mfma(const Params& p) {
    bf16_t* wto = (bf16_t*)(p.ws + WS_WT_OUT);
    const int tid = threadIdx.x, w = tid >> 6, lane = tid & 63, fr = lane & 15, q = lane >> 4;
    for (int item = blockIdx.x; item < 256; item += gridDim.x) {
        const int gi = item >> 6, nb = item & 63;
        f32x4 acc = (f32x4){0.f, 0.f, 0.f, 0.f};
        const float* wp = p.w_pool + (size_t)(gi * 128 + 16 * w + fr) * 128;
        const float* ps = p.pool_scale + gi * 128;
        const bf16_t* arow = wto + (size_t)(16 * nb + fr) * 1024 + 512 + gi * 128;
#pragma unroll
        for (int ks = 0; ks < 4; ++ks) {
            const int d0 = 32 * ks + 8 * q;
            const f32x4 w0 = *(const f32x4*)(wp + d0), w1 = *(const f32x4*)(wp + d0 + 4), s0 = *(const f32x4*)(ps + d0), s1 = *(const f32x4*)(ps + d0 + 4);
            const bf16x8 cfr = mk8u(cvt_pk_bf16(w0[0] * s0[0], w0[1] * s0[1]), cvt_pk_bf16(w0[2] * s0[2], w0[3] * s0[3]), cvt_pk_bf16(w1[0] * s1[0], w1[1] * s1[1]), cvt_pk_bf16(w1[2] * s1[2], w1[3] * s1[3]));
            const bf16x8 nfr = *(const bf16x8*)(arow + d0);
            acc = mfma16(cfr, nfr, acc);
        }
        asm volatile("s_waitcnt vmcnt(0)" ::: "memory");
        __syncthreads();
        u32x2 o; o.x = cvt_pk_bf16(acc[0], acc[1]); o.y = cvt_pk_bf16(acc[2], acc[3]);
        *(u32x2*)(wto + (size_t)(16 * nb + fr) * 1024 + 512 + gi * 128 + 16 * w + 4 * q) = o;
        __syncthreads();
    }
}

__device__ __forceinline__ void phase_passA(const bf16_t* __restrict__ KH, const float* __restrict__ LF, const bf16_t* __restrict__ VH, bf16_t* __restrict__ LT, float* __restrict__ DEC, unsigned char* lds, int first, int stride, int ubeg, int uend) {
    const int tid = threadIdx.x, ch = tid & 127, seg = tid >> 7;
    float* segtot = (float*)lds;
    unsigned char* KdT = lds + 2048;
    unsigned char* VTl = lds + 2048 + 18432;
    const int w = tid >> 6, lane = tid & 63, fr = lane & 15, q = lane >> 4;
    float lf[16], kk[16]; unsigned vr[16];
    int unit = ubeg + first;
    if (unit < uend) { const int b = unit >> 8, c = (unit >> 2) & 63, h = unit & 3; const size_t g0 = (size_t)(b * SEQ + c * 64 + seg * 16) * 512 + h * 128 + ch;
#pragma unroll
        for (int i = 0; i < 16; ++i) { lf[i] = LF[g0 + (size_t)i * 512]; vr[i] = VH[g0 + (size_t)i * 512]; } }
    for (; unit < uend; unit += stride) {
        const int b = unit >> 8, c = (unit >> 2) & 63, h = unit & 3, bh = b * 4 + h;
#pragma unroll
        for (int i = 0; i < 16; ++i) kk[i] = 1.0f - __expf(lf[i]);
#pragma unroll
        for (int i = 1; i < 16; ++i) lf[i] += lf[i - 1];
        segtot[seg * 128 + ch] = lf[15];
        __syncthreads();
        float after = 0.f;
#pragma unroll
        for (int s2 = 1; s2 < 4; ++s2) if (s2 > seg) after += segtot[s2 * 128 + ch];
        const float tot = after + lf[15];
        if (seg == 0) DEC[(size_t)(bh * 64 + c) * 128 + ch] = __expf(tot);
        unsigned kd[8], vp[8];
#pragma unroll
        for (int i = 0; i < 8; ++i) {
            kd[i] = cvt_pk_bf16(kk[2 * i] * __expf(tot - lf[2 * i]), kk[2 * i + 1] * __expf(tot - lf[2 * i + 1]));
            vp[i] = vr[2 * i] | (vr[2 * i + 1] << 16);
        }
        { u32x4* d = (u32x4*)(KdT + ch * 144 + seg * 32); d[0] = (u32x4){kd[0], kd[1], kd[2], kd[3]}; d[1] = (u32x4){kd[4], kd[5], kd[6], kd[7]}; }
        { u32x4* d = (u32x4*)(VTl + ch * 144 + seg * 32); d[0] = (u32x4){vp[0], vp[1], vp[2], vp[3]}; d[1] = (u32x4){vp[4], vp[5], vp[6], vp[7]}; }
        __syncthreads();
        {
            const int un = unit + stride;
            if (un < uend) { const int b2 = un >> 8, c2 = (un >> 2) & 63, h2 = un & 3; const size_t g0 = (size_t)(b2 * SEQ + c2 * 64 + seg * 16) * 512 + h2 * 128 + ch;
#pragma unroll
                for (int i = 0; i < 16; ++i) { lf[i] = LF[g0 + (size_t)i * 512]; vr[i] = VH[g0 + (size_t)i * 512]; } }
        }
        bf16x8 a[2];
#pragma unroll
        for (int ks = 0; ks < 2; ++ks) a[ks] = *(const bf16x8*)(KdT + (16 * w + fr) * 144 + (32 * ks + 8 * q) * 2);
        bf16_t* ltp = LT + (size_t)(bh * 64 + c) * 16384;
#pragma unroll
        for (int vb = 0; vb < 8; ++vb) {
            f32x4 acc = (f32x4){0.f, 0.f, 0.f, 0.f};
#pragma unroll
            for (int ks = 0; ks < 2; ++ks) { const bf16x8 bfr = *(const bf16x8*)(VTl + (16 * vb + fr) * 144 + (32 * ks + 8 * q) * 2); acc = mfma16(a[ks], bfr, acc); }
            u32x2 pk; pk.x = cvt_pk_bf16(acc[0], acc[1]); pk.y = cvt_pk_bf16(acc[2], acc[3]);
            *(u32x2*)(ltp + (size_t)(16 * vb + fr) * 128 + 16 * w + 4 * q) = pk;
        }
        __syncthreads();
    }
}

template <int W>
__device__ __forceinline__ void pool_body(const bf16_t* __restrict__ PH, bf16_t* __restrict__ MIXED, int r0, int s0, int c0) {
    unsigned v[31 + W];
#pragma unroll
    for (int j = 1; j < W; ++j) v[W - 1 - j] = (s0 - j >= 0) ? *(const unsigned*)(PH + (size_t)(r0 - j) * 512 + c0) : 0u;
#pragma unroll
    for (int tt = 0; tt < 32; ++tt) v[W - 1 + tt] = *(const unsigned*)(PH + (size_t)(r0 + tt) * 512 + c0);
    float sx = 0.f, sy = 0.f;
#pragma unroll
    for (int j = 1; j < W; ++j) { sx += bflo(v[W - 1 - j]); sy += bfhi(v[W - 1 - j]); }
#pragma unroll
    for (int tt = 0; tt < 32; ++tt) {
        const int s = s0 + tt;
        const float px = bflo(v[W - 1 + tt]), py = bfhi(v[W - 1 + tt]);
        sx += px; sy += py;
        const int cnt = (s + 1) < W ? (s + 1) : W;
        const float inv = __builtin_amdgcn_rcpf((float)cnt);
        *(unsigned*)(MIXED + (size_t)(r0 + tt) * 1024 + 512 + c0) = cvt_pk_bf16(sx * inv - px, sy * inv - py);
        sx -= bflo(v[tt]); sy -= bfhi(v[tt]);
    }
}
__device__ __forceinline__ void pool_tile(const bf16_t* __restrict__ PH, bf16_t* __restrict__ MIXED, int tile) {
    const int tid = threadIdx.x, cp = tid & 255, th = tid >> 8, c0 = 2 * cp, gi = c0 >> 7;
    const int r0 = tile * 64 + th * 32, s0 = r0 & (SEQ - 1);
    if (gi == 0) pool_body<2>(PH, MIXED, r0, s0, c0);
    else if (gi == 1) pool_body<4>(PH, MIXED, r0, s0, c0);
    else if (gi == 2) pool_body<8>(PH, MIXED, r0, s0, c0);
    else pool_body<16>(PH, MIXED, r0, s0, c0);
}

__device__ __forceinline__ void phase_scan(const bf16_t* LT, const float* __restrict__ DEC, bf16_t* ST) {
    for (int e2 = blockIdx.x * NTHREADS + threadIdx.x; e2 < 131072; e2 += gridDim.x * NTHREADS) {
        const int bh = e2 >> 13, v = (e2 >> 6) & 127, kp = e2 & 63;
        float sx = 0.f, sy = 0.f;
        const size_t base = (size_t)bh * 64 * 16384 + (size_t)v * 128 + 2 * kp;
        const float* dp = DEC + (size_t)bh * 64 * 128 + 2 * kp;
        for (int c0 = 0; c0 < 64; c0 += 32) {
            unsigned l[32]; f32x2 d[32];
#pragma unroll
            for (int j = 0; j < 32; ++j) { l[j] = *(const unsigned*)(LT + base + (size_t)(c0 + j) * 16384); d[j] = *(const f32x2*)(dp + (c0 + j) * 128); }
#pragma unroll
            for (int j = 0; j < 32; ++j) {
                *(unsigned*)(ST + base + (size_t)(c0 + j) * 16384) = cvt_pk_bf16(sx, sy);
                sx = d[j][0] * sx + bflo(l[j]); sy = d[j][1] * sy + bfhi(l[j]);
            }
        }
    }
}

__device__ __forceinline__ void phase_passC(const bf16_t* __restrict__ QH, const bf16_t* __restrict__ KH, const float* __restrict__ LF, const bf16_t* __restrict__ VH, const bf16_t* __restrict__ GH,
                                const bf16_t* __restrict__ ST, const float* __restrict__ hg, bf16_t* __restrict__ MIXED, unsigned char* lds) {
    const int tid = threadIdx.x, ch = tid & 127, seg = tid >> 7, G = gridDim.x;
    float lf[16], kk[16]; unsigned qr[16], vr[16];
    int unit = blockIdx.x;
    if (unit < 1024) { const int b = unit >> 8, c = (unit >> 2) & 63, h = unit & 3; const size_t g0 = (size_t)(b * SEQ + c * 64 + seg * 16) * 512 + h * 128 + ch;
#pragma unroll
        for (int i = 0; i < 16; ++i) { lf[i] = LF[g0 + (size_t)i * 512]; vr[i] = VH[g0 + (size_t)i * 512]; qr[i] = QH[g0 + (size_t)i * 512]; } }
  for (; unit < 1024; unit += G) {
    const int b = unit >> 8, c = (unit >> 2) & 63, h = unit & 3;
    const int row0 = b * SEQ + c * 64, bh = b * 4 + h;
    float* segtot = (float*)lds;
    float* rmsp = (float*)(lds + 2048);
    bf16_t* QC = (bf16_t*)(lds + 4096);
    bf16_t* QT = (bf16_t*)(lds + 21504);
    constexpr int KT0 = 38912;
    unsigned char* VTl = lds + 82432;
    const int w = tid >> 6, lane = tid & 63, fr = lane & 15, q = lane >> 4;
    const int i = w & 3, vh = w >> 2;
    const size_t row = (size_t)(row0 + 16 * i + fr);
    u32x2 gt[4]; f32x4 gg[4]; bf16x8 stf[4][4];
    {
        const bf16_t* stp = ST + (size_t)(bh * 64 + c) * 16384;
#pragma unroll
        for (int vbl = 0; vbl < 4; ++vbl) { const int v0 = 16 * (vh * 4 + vbl) + 4 * q; gt[vbl] = *(const u32x2*)(GH + row * 512 + h * 128 + v0); gg[vbl] = *(const f32x4*)(hg + h * 128 + v0);
#pragma unroll
            for (int ks = 0; ks < 4; ++ks) stf[ks][vbl] = *(const bf16x8*)(stp + (size_t)(16 * (vh * 4 + vbl) + fr) * 128 + 32 * ks + 8 * q); }
    }
#pragma unroll
    for (int i2 = 0; i2 < 16; ++i2) kk[i2] = 1.0f - __expf(lf[i2]);
#pragma unroll
    for (int i2 = 1; i2 < 16; ++i2) lf[i2] += lf[i2 - 1];
    segtot[seg * 128 + ch] = lf[15];
    {
        unsigned vp[8];
#pragma unroll
        for (int i2 = 0; i2 < 8; ++i2) vp[i2] = vr[2 * i2] | (vr[2 * i2 + 1] << 16);
        u32x4* d = (u32x4*)(VTl + ch * 144 + seg * 32); d[0] = (u32x4){vp[0], vp[1], vp[2], vp[3]}; d[1] = (u32x4){vp[4], vp[5], vp[6], vp[7]};
    }
    __syncthreads();
    const float t0 = segtot[ch], t1 = segtot[128 + ch], t2 = segtot[256 + ch];
    const float P = (seg > 0 ? t0 : 0.f) + (seg > 1 ? t1 : 0.f) + (seg > 2 ? t2 : 0.f);
    {
        const float eP = __expf(P);
#pragma unroll
        for (int i2 = 0; i2 < 16; ++i2) {
            const float qv = bflo(qr[i2]);
            const float el = __expf(lf[i2]);
            QT[(seg * 16 + i2) * 136 + ch] = f2bf(qv * el);
            QC[(seg * 16 + i2) * 136 + ch] = f2bf(qv * el * eP);
        }
        float E = 0.f;
#pragma unroll
        for (int i2 = 0; i2 < 4; ++i2) {
            if (i2 >= seg) {
                bf16_t* KT = (bf16_t*)(lds + KT0 + 4352 * ((i2 * (i2 + 1)) / 2));
#pragma unroll
                for (int j = 0; j < 16; ++j) KT[(seg * 16 + j) * 136 + ch] = f2bf(kk[j] * __expf(E - lf[j]));
                E += (i2 == 0 ? t0 : (i2 == 1 ? t1 : t2));
            }
        }
    }
    __syncthreads();
    {
        const int un = unit + G;
        if (un < 1024) { const int b2 = un >> 8, c2 = (un >> 2) & 63, h2 = un & 3; const size_t g2 = (size_t)(b2 * SEQ + c2 * 64 + seg * 16) * 512 + h2 * 128 + ch;
#pragma unroll
            for (int i2 = 0; i2 < 16; ++i2) { lf[i2] = LF[g2 + (size_t)i2 * 512]; vr[i2] = VH[g2 + (size_t)i2 * 512]; qr[i2] = QH[g2 + (size_t)i2 * 512]; } }
    }
    f32x4 sT[4];
#pragma unroll
    for (int j = 0; j < 4; ++j) sT[j] = (f32x4){0.f, 0.f, 0.f, 0.f};
    {
        bf16x8 qfr[4];
#pragma unroll
        for (int ks = 0; ks < 4; ++ks) qfr[ks] = *(const bf16x8*)((const unsigned char*)QT + (16 * i + fr) * 272 + (32 * ks + 8 * q) * 2);
        const unsigned char* KT = lds + KT0 + 4352 * ((i * (i + 1)) / 2);
#pragma unroll
        for (int j = 0; j < 4; ++j) if (j <= i) {
#pragma unroll
            for (int ks = 0; ks < 4; ++ks) { const bf16x8 a = *(const bf16x8*)(KT + (16 * j + fr) * 272 + (32 * ks + 8 * q) * 2); sT[j] = mfma16(a, qfr[ks], sT[j]); }
            if (j == i) {
#pragma unroll
                for (int rg = 0; rg < 4; ++rg) if (4 * q + rg > fr) sT[j][rg] = 0.f;
            }
        }
    }
    f32x4 oacc[4];
#pragma unroll
    for (int vbl = 0; vbl < 4; ++vbl) oacc[vbl] = (f32x4){0.f, 0.f, 0.f, 0.f};
#pragma unroll
    for (int m = 0; m < 2; ++m) if (2 * m <= i) {
        const bf16x8 bfrag = mk8u(cvt_pk_bf16(sT[2 * m][0], sT[2 * m][1]), cvt_pk_bf16(sT[2 * m][2], sT[2 * m][3]), cvt_pk_bf16(sT[2 * m + 1][0], sT[2 * m + 1][1]), cvt_pk_bf16(sT[2 * m + 1][2], sT[2 * m + 1][3]));
#pragma unroll
        for (int vbl = 0; vbl < 4; ++vbl) {
            const unsigned char* base = VTl + (16 * (vh * 4 + vbl) + fr) * 144 + (32 * m + 4 * q) * 2;
            const bf16x8 a = mk8(*(const u32x2*)base, *(const u32x2*)(base + 32));
            oacc[vbl] = mfma16(a, bfrag, oacc[vbl]);
        }
    }
    {
#pragma unroll
        for (int ks = 0; ks < 4; ++ks) {
            const bf16x8 bfr = *(const bf16x8*)((const unsigned char*)QC + (16 * i + fr) * 272 + (32 * ks + 8 * q) * 2);
#pragma unroll
            for (int vbl = 0; vbl < 4; ++vbl) oacc[vbl] = mfma16(stf[ks][vbl], bfr, oacc[vbl]);
        }
    }
    float ss = 0.f;
#pragma unroll
    for (int vbl = 0; vbl < 4; ++vbl) ss += (oacc[vbl][0] * oacc[vbl][0] + oacc[vbl][1] * oacc[vbl][1]) + (oacc[vbl][2] * oacc[vbl][2] + oacc[vbl][3] * oacc[vbl][3]);
    ss += __shfl_xor(ss, 16); ss += __shfl_xor(ss, 32);
    if (q == 0) rmsp[vh * 64 + 16 * i + fr] = ss;
    __syncthreads();
    const float rstd = rsqrtf((rmsp[16 * i + fr] + rmsp[64 + 16 * i + fr]) * (1.0f / 128.0f) + EPS);
#pragma unroll
    for (int vbl = 0; vbl < 4; ++vbl) {
        const int v0 = 16 * (vh * 4 + vbl) + 4 * q;
        u32x2 o;
        o.x = cvt_pk_bf16(oacc[vbl][0] * rstd * gg[vbl][0] * bflo(gt[vbl].x), oacc[vbl][1] * rstd * gg[vbl][1] * bfhi(gt[vbl].x));
        o.y = cvt_pk_bf16(oacc[vbl][2] * rstd * gg[vbl][2] * bflo(gt[vbl].y), oacc[vbl][3] * rstd * gg[vbl][3] * bfhi(gt[vbl].y));
        *(u32x2*)(MIXED + row * 1024 + h * 128 + v0) = o;
    }
    __syncthreads();
  }
}

__device__ __forceinline__ void attn_unit(const bf16_t* __restrict__ XQ, const bf16_t* __restrict__ KX, const bf16_t* __restrict__ VT, bf16_t* __restrict__ ATT, int unit, unsigned char* lds) {
    const int tid = threadIdx.x, w = tid >> 6, lane = tid & 63, r = lane & 31, hh = lane >> 5;
    const int b = unit >> 6, st = (unit >> 2) & 15, h = unit & 3;
    const int row0 = b * SEQ + st * 256;
    const bf16_t* qp = XQ + (size_t)(row0 + 32 * w + r) * 1024 + h * 256 + 8 * hh;
    {
        const bf16_t* kp = KX + (size_t)(b * 256) * 1024 + h * 256;
        u32x4 kv[16];
#pragma unroll
        for (int it = 0; it < 16; ++it) { const int idx = tid + 512 * it, m = idx >> 5, cc = idx & 31; kv[it] = *(const u32x4*)(kp + (size_t)m * 1024 + cc * 8); }
#pragma unroll
        for (int it = 0; it < 16; ++it) { const int idx = tid + 512 * it, m = idx >> 5, cc = idx & 31; *(u32x4*)(lds + m * 528 + cc * 16) = kv[it]; }
    }
    __syncthreads();
    f32x16 sacc[8];
#pragma unroll
    for (int mb = 0; mb < 8; ++mb)
#pragma unroll
        for (int e = 0; e < 16; ++e) sacc[mb][e] = 0.f;
    {
        bf16x8 qf[4], qn[4];
#pragma unroll
        for (int k4 = 0; k4 < 4; ++k4) qf[k4] = *(const bf16x8*)(qp + 16 * k4);
#pragma unroll
        for (int kg = 0; kg < 4; ++kg) {
            if (kg < 3) {
#pragma unroll
                for (int k4 = 0; k4 < 4; ++k4) qn[k4] = *(const bf16x8*)(qp + 16 * (4 * (kg + 1) + k4)); }
#pragma unroll
            for (int k4 = 0; k4 < 4; ++k4)
#pragma unroll
                for (int mb = 0; mb < 8; ++mb) { const bf16x8 a = *(const bf16x8*)(lds + (32 * mb + r) * 528 + (16 * (4 * kg + k4) + 8 * hh) * 2); sacc[mb] = mfma32(a, qf[k4], sacc[mb]); }
#pragma unroll
            for (int k4 = 0; k4 < 4; ++k4) qf[k4] = qn[k4];
        }
    }
    float mx = -3.0e38f;
#pragma unroll
    for (int mb = 0; mb < 8; ++mb)
#pragma unroll
        for (int e = 0; e < 16; ++e) mx = fmaxf(mx, sacc[mb][e]);
    mx = fmaxf(mx, __shfl_xor(mx, 32));
    float sum = 0.f;
    bf16x8 pf[8][2];
#pragma unroll
    for (int mb = 0; mb < 8; ++mb) {
        float pv[16];
#pragma unroll
        for (int e = 0; e < 16; ++e) { pv[e] = __expf(sacc[mb][e] - mx); sum += pv[e]; }
#pragma unroll
        for (int s = 0; s < 2; ++s) pf[mb][s] = mk8u(cvt_pk_bf16(pv[8 * s + 0], pv[8 * s + 1]), cvt_pk_bf16(pv[8 * s + 2], pv[8 * s + 3]), cvt_pk_bf16(pv[8 * s + 4], pv[8 * s + 5]), cvt_pk_bf16(pv[8 * s + 6], pv[8 * s + 7]));
    }
    sum += __shfl_xor(sum, 32);
    const float inv = 1.0f / sum;
    __syncthreads();
    {
        const bf16_t* vp = VT + (size_t)(h * 256) * 1024 + b * 256;
        u32x4 vv[16];
#pragma unroll
        for (int it = 0; it < 16; ++it) { const int idx = tid + 512 * it, e = idx >> 5, cc = idx & 31; vv[it] = *(const u32x4*)(vp + (size_t)e * 1024 + cc * 8); }
#pragma unroll
        for (int it = 0; it < 16; ++it) { const int idx = tid + 512 * it, e = idx >> 5, cc = idx & 31;
            u32x2* d = (u32x2*)(lds + e * 520 + cc * 16); d[0] = (u32x2){vv[it].x, vv[it].y}; d[1] = (u32x2){vv[it].z, vv[it].w}; }
    }
    __syncthreads();
    bf16_t* op = ATT + (size_t)(row0 + 32 * w + r) * 1024 + h * 256 + 8 * hh;
#pragma unroll
    for (int half = 0; half < 2; ++half) {
        f32x16 oacc[4];
#pragma unroll
        for (int d = 0; d < 4; ++d)
#pragma unroll
            for (int e = 0; e < 16; ++e) oacc[d][e] = 0.f;
#pragma unroll
        for (int mb = 0; mb < 8; ++mb)
#pragma unroll
            for (int s = 0; s < 2; ++s)
#pragma unroll
                for (int d = 0; d < 4; ++d) {
                    const unsigned char* base = lds + (32 * (half * 4 + d) + r) * 520 + (32 * mb + 16 * s + 4 * hh) * 2;
                    const bf16x8 a = mk8(*(const u32x2*)base, *(const u32x2*)(base + 16));
                    oacc[d] = mfma32(a, pf[mb][s], oacc[d]);
                }
#pragma unroll
        for (int d = 0; d < 4; ++d)
#pragma unroll
            for (int pp = 0; pp < 2; ++pp) {
                unsigned ax = cvt_pk_bf16(oacc[d][8 * pp] * inv, oacc[d][8 * pp + 1] * inv), ay = cvt_pk_bf16(oacc[d][8 * pp + 2] * inv, oacc[d][8 * pp + 3] * inv);
                unsigned bx = cvt_pk_bf16(oacc[d][8 * pp + 4] * inv, oacc[d][8 * pp + 5] * inv), by = cvt_pk_bf16(oacc[d][8 * pp + 6] * inv, oacc[d][8 * pp + 7] * inv);
                { auto t = __builtin_amdgcn_permlane32_swap(ax, bx, false, false); ax = t[0]; bx = t[1]; }
                { auto t = __builtin_amdgcn_permlane32_swap(ay, by, false, false); ay = t[0]; by = t[1]; }
                u32x4 o; o.x = ax; o.y = ay; o.z = bx; o.w = by;
                *(u32x4*)(op + 32 * (half * 4 + d) + 16 * pp) = o;
            }
    }
    __syncthreads();
}

__device__ __forceinline__ void phase_final(const bf16_t* __restrict__ xb, const float* __restrict__ ssq, float* __restrict__ out, const float* __restrict__ g) {
    const int tid = threadIdx.x, sub = tid >> 7, l = tid & 127;
    const f32x4 g0 = *(const f32x4*)(g + 8 * l), g1 = *(const f32x4*)(g + 8 * l + 4);
    for (int r = blockIdx.x * 4 + sub; r < MROWS; r += gridDim.x * 4) {
        const u32x4 v = *(const u32x4*)(xb + (size_t)r * DM + 8 * l);
        const f32x4* pp = (const f32x4*)(ssq + (size_t)r * 16); const f32x4 a = pp[0], b = pp[1], c = pp[2], d = pp[3];
        const float t = ((a[0] + a[1]) + (a[2] + a[3])) + ((b[0] + b[1]) + (b[2] + b[3])) + ((c[0] + c[1]) + (c[2] + c[3])) + ((d[0] + d[1]) + (d[2] + d[3]));
        const float rstd = rsqrtf(t * (1.0f / 1024.0f) + EPS);
        const f32x4 o0 = (f32x4){bflo(v.x), bfhi(v.x), bflo(v.y), bfhi(v.y)} * rstd * g0, o1 = (f32x4){bflo(v.z), bfhi(v.z), bflo(v.w), bfhi(v.w)} * rstd * g1;
        *(f32x4*)(out + (size_t)r * DM + 8 * l) = o0; *(f32x4*)(out + (size_t)r * DM + 8 * l + 4) = o1;
    }
}

#define XB_TMO      128
#define XB_XCNT(j)  (256  + 64 * (j))
#define XB_XSUB(j)  (1280 + 64 * (j))
#define XB_XGEN(j)  (2304 + 64 * (j))
#define XB_TOP      3328
#define XB_TOPGEN   3392
#define XCD_BAR_WORDS 3456
#define XB_SPIN_CAP (1u << 22)
__device__ __forceinline__ unsigned xb_ld(unsigned* p)              { return __hip_atomic_load(p, __ATOMIC_RELAXED, __HIP_MEMORY_SCOPE_AGENT); }
__device__ __forceinline__ unsigned xb_add(unsigned* p, unsigned v) { return __hip_atomic_fetch_add(p, v, __ATOMIC_RELAXED, __HIP_MEMORY_SCOPE_AGENT); }
__device__ __forceinline__ unsigned xb_xcc_id() { return (unsigned)__builtin_amdgcn_s_getreg((3 << 11) | 20) & 0xFu; }
#define XB_SPIN(cond, bar) do { unsigned _sp = 0; while (cond) { __builtin_amdgcn_s_sleep(1); \
    if ((++_sp & 255u) == 0u) { if (xb_ld(&(bar)[XB_TMO])) break; if (_sp > XB_SPIN_CAP) { atomicAdd(&(bar)[XB_TMO], 1u); break; } } } } while (0)
struct XcdBarrier { unsigned* bar; unsigned x; volatile LAS unsigned* st; };
__device__ __forceinline__ XcdBarrier xcd_barrier_post(unsigned* bar, volatile LAS unsigned* st) {
    XcdBarrier b; b.bar = bar; b.x = xb_xcc_id(); b.st = st;
    if (threadIdx.x == 0) (void)xb_add(&bar[XB_XCNT(b.x)], 1u);
    return b;
}
__device__ __forceinline__ void xcd_barrier_complete(unsigned* bar, unsigned x, unsigned& nloc, unsigned& nx) {
    const unsigned G = gridDim.x * gridDim.y * gridDim.z;
    unsigned sum, cnt, mine, sp = 0u;
    for (;;) {
        sum = 0u; cnt = 0u; mine = 0u;
#pragma unroll
        for (unsigned j = 0; j < 16; ++j) { const unsigned c = xb_ld(&bar[XB_XCNT(j)]); sum += c; cnt += (c > 0u) ? 1u : 0u; mine = (j == x) ? c : mine; }
        if (sum == G) break;
        __builtin_amdgcn_s_sleep(1);
        if ((++sp & 255u) == 0u) { if (xb_ld(&bar[XB_TMO])) break; if (sp > XB_SPIN_CAP) { atomicAdd(&bar[XB_TMO], 1u); break; } }
    }
    nloc = mine > 0u ? mine : 1u; nx = cnt > 0u ? cnt : 1u;
}
__device__ __forceinline__ void xcd_barrier(const XcdBarrier& b) {
    asm volatile("s_waitcnt vmcnt(0)" ::: "memory");
    __syncthreads();
    if (threadIdx.x == 0) {
        unsigned* bar = b.bar;
        __builtin_amdgcn_s_waitcnt(0);
        unsigned nloc = b.st[0], nx = b.st[1];
        if (nloc == 0u) { xcd_barrier_complete(bar, b.x, nloc, nx); b.st[0] = nloc; b.st[1] = nx; }
        const unsigned old = xb_add(&bar[XB_XSUB(b.x)], 1u);
        const unsigned gen = old / nloc;
        if (old + 1u == (gen + 1u) * nloc) {
            __builtin_amdgcn_fence(__ATOMIC_RELEASE, "agent");
            asm volatile("s_waitcnt vmcnt(0)" ::: "memory");
            const unsigned og = xb_add(&bar[XB_TOP], 1u);
            const unsigned tg = og / nx;
            if (og + 1u == (tg + 1u) * nx) xb_add(&bar[XB_TOPGEN], 1u);
            else XB_SPIN(xb_ld(&bar[XB_TOPGEN]) == tg, bar);
            __builtin_amdgcn_fence(__ATOMIC_ACQUIRE, "agent");
            asm volatile("s_waitcnt vmcnt(0)" ::: "memory");
        } else {
            XB_SPIN(xb_ld(&bar[XB_TOPGEN]) == gen, bar);
            __builtin_amdgcn_fence(__ATOMIC_ACQUIRE, "agent");
            asm volatile("s_waitcnt vmcnt(0)" ::: "memory");
        }
    }
    __syncthreads();
}

__device__ __forceinline__ unsigned xcd_arrive(const XcdBarrier& b) {
    asm volatile("s_waitcnt vmcnt(0)" ::: "memory");
    __syncthreads();
    unsigned gen = 0u;
    if (threadIdx.x == 0) {
        unsigned* bar = b.bar;
        __builtin_amdgcn_s_waitcnt(0);
        unsigned nloc = b.st[0], nx = b.st[1];
        if (nloc == 0u) { xcd_barrier_complete(bar, b.x, nloc, nx); b.st[0] = nloc; b.st[1] = nx; }
        const unsigned old = xb_add(&bar[XB_XSUB(b.x)], 1u);
        gen = old / nloc;
        if (old + 1u == (gen + 1u) * nloc) {
            __builtin_amdgcn_fence(__ATOMIC_RELEASE, "agent");
            asm volatile("s_waitcnt vmcnt(0)" ::: "memory");
            const unsigned og = xb_add(&bar[XB_TOP], 1u);
            const unsigned tg = og / nx;
            if (og + 1u == (tg + 1u) * nx) xb_add(&bar[XB_TOPGEN], 1u);
        }
    }
    return gen;
}
__device__ __forceinline__ void xcd_wait(const XcdBarrier& b, unsigned gen) {
    if (threadIdx.x == 0) {
        unsigned* bar = b.bar;
        XB_SPIN(xb_ld(&bar[XB_TOPGEN]) == gen, bar);
        __builtin_amdgcn_fence(__ATOMIC_ACQUIRE, "agent");
        asm volatile("s_waitcnt vmcnt(0)" ::: "memory");
    }
    __syncthreads();
}
__device__ __forceinline__ void shadow_work(const Params& p, unsigned char* lds, int k, int bid, int G) {
    const int lo = bid, hi2 = (bid + 128) % G;
    if (k == 0)      { transpose_range(p, lds, 2112, 2304, lo, G);  transpose_range(p, lds, 320, 576, (bid + 64) % G, G); }
    else if (k == 1) { transpose_range(p, lds, 832, 960, lo, G);    transpose_range(p, lds, 960, 1088, hi2, G); }
    else if (k == 2) { transpose_range(p, lds, 576, 704, lo, G);    transpose_range(p, lds, 1088, 1216, hi2, G); }
    else if (k == 3) { transpose_range(p, lds, 704, 832, lo, G);    transpose_range(p, lds, 1216, 1344, hi2, G); }
    else if (k == 4) { transpose_range(p, lds, 1344, 1472, lo, G);  transpose_range(p, lds, 1472, 1600, hi2, G); }
    else if (k == 5) { transpose_range(p, lds, 1600, 1856, lo, G); }
    else if (k == 7) { transpose_range(p, lds, 1856, 1984, lo, G); }
}

constexpr int N_PHASES = 12;
__global__ void __launch_bounds__(NTHREADS, 2) mega(Params p) {
    extern __shared__ __attribute__((aligned(16))) unsigned char lds[];
    LAS unsigned char* ldsl = (LAS unsigned char*)lds;
    unsigned char* ws = p.ws;
    const int G = gridDim.x, bid = blockIdx.x;
    const int lo = p.ph_lo, hi = p.ph_hi;

#ifndef DEFER_PREP
#define DEFER_PREP 0
#endif
#ifndef FUSE_FINAL
#define FUSE_FINAL 0
#endif
#ifndef DBG_LAST
#define DBG_LAST -1
#endif
#ifndef PHASE_MASK
#define PHASE_MASK 0xfff
#endif
#define IN(k) (((PHASE_MASK >> (k)) & 1) && lo <= (k) && (k) < hi)
    if (threadIdx.x == 0) { ((volatile LAS unsigned*)(ldsl + LDS_MAIN))[0] = 0u; ((volatile LAS unsigned*)(ldsl + LDS_MAIN))[1] = 0u; }
    __syncthreads();
    XcdBarrier xbar; xbar.bar = (unsigned*)(ws + WS_BAR); xbar.x = 0; xbar.st = nullptr;
    if (hi - lo > 1) xbar = xcd_barrier_post((unsigned*)(ws + WS_BAR), (volatile LAS unsigned*)(ldsl + LDS_MAIN));
    if (lo > hi) cg::this_grid().sync();
    const bool shadow = (G == 256) && (hi - lo == N_PHASES);
#define SEAM(k) do { if (IN(k) && IN((k) + 1)) { const unsigned g_ = xcd_arrive(xbar); if (shadow) shadow_work(p, lds, (k), bid, G); xcd_wait(xbar, g_); } } while (0)
    bf16_t* XB = (bf16_t*)(ws + WS_XB); bf16_t* LT = (bf16_t*)(ws + WS_ST);
    bf16_t* QH = (bf16_t*)(ws + WS_QH); bf16_t* KH = (bf16_t*)(ws + WS_KH); bf16_t* VH = (bf16_t*)(ws + WS_VH); bf16_t* GH = (bf16_t*)(ws + WS_GH); bf16_t* PH = (bf16_t*)(ws + WS_PH);
    float* LF = (float*)(ws + WS_LF); bf16_t* ST = (bf16_t*)(ws + WS_ST); bf16_t* MIXED = (bf16_t*)(ws + WS_MIXED);
    float* X1 = (float*)(ws + WS_X1); bf16_t* XQ = (bf16_t*)(ws + WS_XQ); bf16_t* ATT = (bf16_t*)(ws + WS_ATT); bf16_t* U = (bf16_t*)(ws + WS_U);
    float* SSQ = (float*)(ws + WS_SSQ); float* DEC = (float*)(ws + WS_DEC);
    bf16_t* MEMB = (bf16_t*)(ws + WS_MEMB); bf16_t* KX = (bf16_t*)(ws + WS_KX); bf16_t* VT = (bf16_t*)(ws + WS_VT);

    const bool fuse_final = FUSE_FINAL && (G == 256) && IN(10) && (hi - lo > 1);
    if (IN(0)) { phase_prep(p, lds, shadow);
#if !DEFER_PREP
        if (!shadow) deferred_prep(p, lds, bid, G);
#endif
    }
    SEAM(0);
    const bf16_t* WTIN = (const bf16_t*)(ws + WS_WT_IN);
    if (IN(1)) {
        const pg8::Epi E{0, ws, p.x, p.out, p.lb_logits, p.final_norm_g, 2};
        pg8::Gemm g{XB, WTIN + (size_t)512 * DM, MROWS, 1024, DM}; pg8::StaticOrder S; S.init(MROWS, 1024, G, bid); pg8::gemm_phase(ldsl, g, S, E);
    }
    SEAM(1);
    if (IN(2)) {
        { const pg8::Epi E{0, ws, p.x, p.out, p.lb_logits, p.final_norm_g, 6};
          pg8::Gemm g{XB, WTIN + (size_t)1536 * DM, MROWS, 1024, DM}; pg8::StaticOrder S; S.init(MROWS, 1024, G, bid); pg8::gemm_phase(ldsl, g, S, E); }
        { const pg8::Epi E{0, ws, p.x, p.out, p.lb_logits, p.final_norm_g, 0};
          pg8::Gemm g{XB, WTIN, MROWS, 512, DM}; pg8::StaticOrder S; S.init(MROWS, 512, G, bid); pg8::gemm_phase(ldsl, g, S, E); }
        const pg8::Epi E1{1, ws, p.x, p.out, p.lb_logits, p.final_norm_g, 0};
        { pg8::Gemm g{MEMB, (const bf16_t*)(ws + WS_WT_K), MEMROWS, 1024, DM}; pg8::StaticOrder S; S.init(MEMROWS, 1024, G, (bid + 128) % G); pg8::gemm_phase(ldsl, g, S, E1); }
        const pg8::Epi E2{2, ws, p.x, p.out, p.lb_logits, p.final_norm_g, 0};
        { pg8::Gemm g{(const bf16_t*)(ws + WS_WT_V), MEMB, 1024, MEMROWS, DM}; pg8::StaticOrder S; S.init(1024, MEMROWS, G, (bid + 112) % G); pg8::gemm_phase(ldsl, g, S, E2); }
        if (G == 256) {
            if (bid >= 160) phase_passA(KH, LF, VH, LT, DEC, lds, bid - 160, 96, 0, 512);
            phase_passA(KH, LF, VH, LT, DEC, lds, bid, G, 512, 1024);
        } else phase_passA(KH, LF, VH, LT, DEC, lds, bid, G, 0, 1024);
    }
    SEAM(2);
    if (IN(3)) {
        phase_scan(LT, DEC, ST);
        for (int t = bid; t < 256; t += G) pool_tile(PH, MIXED, t);
        fold_pool_weights_mfma(p);
    }
    SEAM(3);
    if (IN(4)) { phase_passC(QH, KH, LF, VH, GH, ST, p.hgrn_norm_g, MIXED, lds); }
    SEAM(4);
    if (IN(5)) {
        const pg8::Epi E{6, ws, p.x, p.out, p.lb_logits, p.final_norm_g, 0};
        pg8::Gemm g{MIXED, (const bf16_t*)(ws + WS_WT_OUT), MROWS, DM, DM}; pg8::StaticOrder S; S.init(MROWS, DM, G, bid); pg8::gemm_phase(ldsl, g, S, E);
    }
    SEAM(5);
    const bool fuse_attn = (G == 256) && IN(6) && IN(7);
    if (IN(6)) {
        const pg8::Epi E{4, ws, p.x, p.out, p.lb_logits, p.final_norm_g, 0};
        pg8::Gemm g{XB, (const bf16_t*)(ws + WS_WT_Q), MROWS, DM, DM}; pg8::StaticOrder S; S.init(MROWS, DM, G, bid); pg8::gemm_phase(ldsl, g, S, E);
        if (fuse_attn) {
            pg8::Unit u; S.next(0, u);
            asm volatile("s_waitcnt vmcnt(0)" ::: "memory"); __syncthreads();
            attn_unit(XQ, KX, VT, ATT, u.pm * 4 + u.pn, lds);
        }
    }
    if (!fuse_attn) {
        SEAM(6);
        if (IN(7)) { for (int u = bid; u < 256; u += G) attn_unit(XQ, KX, VT, ATT, u, lds); }
    }
    SEAM(7);
    if (IN(8)) {
        const pg8::Epi E{6, ws, p.x, p.out, p.lb_logits, p.final_norm_g, 0};
        pg8::Gemm g{ATT, (const bf16_t*)(ws + WS_WT_O), MROWS, DM, DM}; pg8::StaticOrder S; S.init(MROWS, DM, G, bid); pg8::gemm_phase(ldsl, g, S, E);
    }
    SEAM(8);
    if (IN(9)) {
        const pg8::Epi E{5, ws, p.x, p.out, p.lb_logits, p.final_norm_g, 0};
        pg8::Gemm g{XB, (const bf16_t*)(ws + WS_WT_FF1), MROWS, DFF, DM}; pg8::StaticOrder S; S.init(MROWS, DFF, G, bid); pg8::gemm_phase(ldsl, g, S, E);
    }
    SEAM(9);
    if (IN(10)) {
        const pg8::Epi E{fuse_final ? 8 : 7, ws, p.x, p.out, p.lb_logits, p.final_norm_g, 0};
        pg8::Gemm g{U, (const bf16_t*)(ws + WS_WT_FF2), MROWS, DM, DFF}; pg8::StaticOrder S; S.init(MROWS, DM, G, bid); pg8::gemm_phase(ldsl, g, S, E);
    }
    if (!fuse_final) {
        SEAM(10);
        if (IN(11)) { phase_final(XB, SSQ, p.out, p.final_norm_g); }
    }
#if DBG_LAST >= 0
    cg::this_grid().sync();
    {
        const unsigned* w32 = (const unsigned*)ws;
        for (size_t i = (size_t)bid * NTHREADS + threadIdx.x; i < (size_t)MROWS * DM; i += (size_t)G * NTHREADS) {
            float a = 0.f;
            for (int j = 0; j < 4; ++j) { const unsigned v = w32[i + (size_t)j * MROWS * DM]; a += (float)(v & 0xffffu) + (float)(v >> 16); }
            p.out[i] = a;
        }
    }
#endif
#undef IN
#undef SEAM
}

extern "C" void kernel_launch(void* const* d_in, const int* in_sizes, int n_in, void* d_out, int out_size, void* d_ws, size_t ws_size, hipStream_t stream) {
    static int grid = 0;
    if (grid == 0) {
        if (n_in != 19 || in_sizes[0] != MROWS * DM || out_size != MROWS * DM || ws_size < WS_END) { fprintf(stderr, "kernel_launch: unexpected shapes (n_in %d, ws %zu)\n", n_in, ws_size); grid = -1; return; }
        int dev = 0, cus = 0, per_cu = 0;
        hipGetDevice(&dev); hipDeviceGetAttribute(&cus, hipDeviceAttributeMultiprocessorCount, dev);
        if (hipFuncSetAttribute((const void*)mega, hipFuncAttributeMaxDynamicSharedMemorySize, LDS_BYTES) != hipSuccess) { fprintf(stderr, "kernel_launch: hipFuncSetAttribute failed\n"); grid = -1; return; }
        if (hipOccupancyMaxActiveBlocksPerMultiprocessor(&per_cu, (const void*)mega, NTHREADS, LDS_BYTES) != hipSuccess || per_cu < 1) { fprintf(stderr, "kernel_launch: occupancy query says %d\n", per_cu); per_cu = 1; }
        (void)hipGetLastError();
        grid = cus * 1;
        if (grid > cus * per_cu) grid = cus * per_cu;
    }
    if (grid < 0) return;
    if (hipMemsetAsync((char*)d_ws + WS_BAR, 0, 32768, stream) != hipSuccess) { fprintf(stderr, "kernel_launch: memset of barrier words failed\n"); return; }
    Params p{};
    const float** f = (const float**)&p;
    for (int i = 0; i < 19; ++i) f[i] = (const float*)d_in[i];
    p.out = (float*)d_out; p.ws = (unsigned char*)d_ws;
#if N_LAUNCH_MODE == 1
    p.ph_lo = 0; p.ph_hi = (DBG_LAST >= 0) ? DBG_LAST + 1 : N_PHASES;
    void* args[] = {&p};
    hipError_t e = hipLaunchCooperativeKernel((const void*)mega, dim3(grid), dim3(NTHREADS), args, LDS_BYTES, stream);
    if (e != hipSuccess) fprintf(stderr, "kernel_launch: cooperative launch failed: %s (grid %d)\n", hipGetErrorString(e), grid);
#else
    for (int k = 0; k < N_PHASES; ++k) { p.ph_lo = k; p.ph_hi = k + 1; hipLaunchKernelGGL(mega, dim3(grid), dim3(NTHREADS), LDS_BYTES, stream, p); }
#endif
}
```

```cpp
#include <hip/hip_runtime.h>
#include <hip/hip_cooperative_groups.h>
#include <cstdio>
namespace cg = cooperative_groups;

#ifndef N_LAUNCH_MODE
#define N_LAUNCH_MODE 1
#endif

typedef unsigned short bf16_t;
typedef short bf16x8 __attribute__((ext_vector_type(8)));
typedef float f32x2 __attribute__((ext_vector_type(2)));
typedef float f32x4 __attribute__((ext_vector_type(4)));
typedef float f32x16 __attribute__((ext_vector_type(16)));
typedef unsigned u32x2 __attribute__((ext_vector_type(2)));
typedef unsigned u32x4 __attribute__((ext_vector_type(4)));
#define LAS __attribute__((address_space(3)))

constexpr int MROWS = 16384, DM = 1024, SEQ = 4096, NIN = 2560, DFF = 4096, MEMROWS = 1024;
constexpr float EPS = 1e-6f;
constexpr int NTHREADS = 512;
constexpr int LDS_MAIN = 135168;
constexpr int LDS_BYTES = LDS_MAIN + 16;

constexpr size_t MiB = 1u << 20;
constexpr size_t WS_WT_IN = 0, WS_WT_K = 5 * MiB, WS_WT_V = 7 * MiB, WS_WT_OUT = 9 * MiB, WS_WT_Q = 11 * MiB, WS_WT_O = 13 * MiB,
                 WS_WT_FF1 = 15 * MiB, WS_WT_FF2 = 23 * MiB, WS_MEMB = 31 * MiB, WS_KX = 33 * MiB, WS_VT = 35 * MiB, WS_SSQ = 37 * MiB,
                 WS_BAR = 39 * MiB, WS_CNT = 39 * MiB + 16384, WS_RSTD0 = 38 * MiB, WS_RSTDM = 38 * MiB + 65536, WS_DEC = 38 * MiB + 131072,
                 WS_XB = 40 * MiB  , WS_QH = 72 * MiB, WS_KH = 88 * MiB, WS_VH = 104 * MiB, WS_GH = 120 * MiB, WS_PH = 136 * MiB,
                 WS_LF = 152 * MiB, WS_ST = 184 * MiB, WS_MIXED = 216 * MiB,
                 WS_X1 = 72 * MiB, WS_XQ = 136 * MiB, WS_ATT = 168 * MiB, WS_U = 72 * MiB, WS_END = 256 * MiB;

typedef __bf16 bf16x2n __attribute__((ext_vector_type(2)));
__device__ __forceinline__ unsigned cvt_pk_bf16(float lo, float hi) { f32x2 v = {lo, hi}; return __builtin_bit_cast(unsigned, __builtin_convertvector(v, bf16x2n)); }
__device__ __forceinline__ bf16_t f2bf(float f) { return (bf16_t)(cvt_pk_bf16(f, 0.f) & 0xffffu); }
__device__ __forceinline__ float bf2f(bf16_t b) { return __uint_as_float(((unsigned)b) << 16); }
__device__ __forceinline__ float bflo(unsigned u) { return __uint_as_float(u << 16); }
__device__ __forceinline__ float bfhi(unsigned u) { return __uint_as_float(u & 0xffff0000u); }
__device__ __forceinline__ f32x4 mfma16(bf16x8 a, bf16x8 b, f32x4 c) { return __builtin_amdgcn_mfma_f32_16x16x32_bf16(a, b, c, 0, 0, 0); }
__device__ __forceinline__ f32x16 mfma32(bf16x8 a, bf16x8 b, f32x16 c) { return __builtin_amdgcn_mfma_f32_32x32x16_bf16(a, b, c, 0, 0, 0); }
__device__ __forceinline__ bf16x8 mk8(u32x2 lo, u32x2 hi) { u32x4 t; t.x = lo.x; t.y = lo.y; t.z = hi.x; t.w = hi.y; return __builtin_bit_cast(bf16x8, t); }
__device__ __forceinline__ bf16x8 mk8u(unsigned a, unsigned b, unsigned c, unsigned d) { u32x4 t; t.x = a; t.y = b; t.z = c; t.w = d; return __builtin_bit_cast(bf16x8, t); }
__device__ __forceinline__ float sigmoidf_(float z) { return __builtin_amdgcn_rcpf(1.0f + __expf(-z)); }

namespace pg8 {
constexpr int BM = 256, BK = 64, HALF = 128, HTB = HALF * BK * 2, STAGE_BYTES = 8 * HTB, NXCD = 8, WGM = 8;
__device__ __forceinline__ int lds_byte(int r, int c) { const int st = (r >> 4) * 2 + (c >> 5), rr = r & 15, cc = c & 31, ob = rr * 64 + cc * 2; return st * 1024 + (ob ^ (((ob >> 9) & 1) << 5)); }
__device__ __forceinline__ void stage_rc(int b, int& R, int& C) { const int st = b / 1024, sb = b % 1024, swz = sb ^ (((sb >> 9) & 1) << 5); R = (st >> 1) * 16 + swz / 64; C = (st & 1) * 32 + (swz % 64) / 2; }
__device__ __forceinline__ int perm32(int rho) { const int n = rho >> 4, i = rho & 15; return 8 * (i >> 2) + 4 * n + (i & 3); }
struct Unit { int pm, pn; };
struct Gemm { const bf16_t* A; const bf16_t* Bt; int M, N, K; };
struct StaticOrder {
    int nM, nN, nwg, G, c;
    __device__ __forceinline__ void init(int M, int N, int G_, int c_) { nM = M / BM; nN = N / BM; nwg = nM * nN; G = G_; c = c_; }
    __device__ __forceinline__ bool next(int i, Unit& u) const {
        const long L = (long)i * G + c; if (L >= nwg) return false;
        int wgid = (int)L; { const int q = nwg / NXCD, r = nwg % NXCD, xcd = wgid % NXCD, off = wgid / NXCD; wgid = (xcd < r ? xcd * (q + 1) : r * (q + 1) + (xcd - r) * q) + off; }
        const int nig = WGM * nN, gid = wgid / nig, fm = gid * WGM, gsz = (nM - fm) < WGM ? (nM - fm) : WGM;
        u.pm = fm + ((wgid % nig) % gsz); u.pn = (wgid % nig) / gsz; return true;
    }
};

struct Epi {
    static constexpr bool PERM = true;
    int mode;
    unsigned char* ws; const float* x; float* out; const float* lbl; const float* gfin; int pnoff;
    __device__ __forceinline__ void store8(bf16_t* p, const f32x4& v0, const f32x4& v1) const {
        u32x4 w; w.x = cvt_pk_bf16(v0[0], v0[1]); w.y = cvt_pk_bf16(v0[2], v0[3]); w.z = cvt_pk_bf16(v1[0], v1[1]); w.w = cvt_pk_bf16(v1[2], v1[3]); *(u32x4*)p = w; }
    __device__ __forceinline__ void fused(f32x4 (&acc)[2][2][4][2], const Unit& u, int wr, int wc, int fr, int fq) const {
        const int row0 = u.pm * BM + wr * 64 + fr;
        const int col0 = u.pn * BM + wc * 32 + 8 * fq;
        const bf16_t* xb = (const bf16_t*)(ws + WS_XB);
        unsigned* sq = (unsigned*)(ws + WS_SSQ);
        unsigned* cnt = (unsigned*)(ws + WS_CNT) + 64 * u.pm;
        u32x4 bc[2], bn[2];
        { const size_t o = (size_t)row0 * DM + col0; bc[0] = *(const u32x4*)(xb + o); bc[1] = *(const u32x4*)(xb + o + HALF); }
#pragma unroll
        for (int gidx = 0; gidx < 8; ++gidx) { const int ai = gidx >> 2, m = gidx & 3; const int row = row0 + ai * HALF + m * 16;
            if (gidx < 7) { const int g2 = gidx + 1; const size_t o2 = (size_t)(row0 + (g2 >> 2) * HALF + (g2 & 3) * 16) * DM + col0; bn[0] = *(const u32x4*)(xb + o2); bn[1] = *(const u32x4*)(xb + o2 + HALF); }
            float ss = 0.f;
#pragma unroll
            for (int bj = 0; bj < 2; ++bj) { const u32x4 bb = bc[bj];
                const f32x4 v0 = acc[ai][bj][m][0] + (f32x4){bflo(bb.x), bfhi(bb.x), bflo(bb.y), bfhi(bb.y)}, v1 = acc[ai][bj][m][1] + (f32x4){bflo(bb.z), bfhi(bb.z), bflo(bb.w), bfhi(bb.w)};
                acc[ai][bj][m][0] = v0; acc[ai][bj][m][1] = v1;
                ss += (v0[0] * v0[0] + v0[1] * v0[1]) + (v0[2] * v0[2] + v0[3] * v0[3]) + (v1[0] * v1[0] + v1[1] * v1[1]) + (v1[2] * v1[2] + v1[3] * v1[3]); }
            ss += __shfl_xor(ss, 16); ss += __shfl_xor(ss, 32);
            if (fq == 0) __hip_atomic_store(sq + (size_t)row * 16 + u.pn * 4 + wc, __float_as_uint(ss), __ATOMIC_RELAXED, __HIP_MEMORY_SCOPE_AGENT);
            bc[0] = bn[0]; bc[1] = bn[1]; }
        asm volatile("s_waitcnt vmcnt(0)" ::: "memory");
        if ((threadIdx.x & 63) == 0) __hip_atomic_fetch_add(cnt, 1u, __ATOMIC_RELAXED, __HIP_MEMORY_SCOPE_AGENT);
        f32x4 gv[2][2];
#pragma unroll
        for (int bj = 0; bj < 2; ++bj) { gv[bj][0] = *(const f32x4*)(gfin + col0 + bj * HALF); gv[bj][1] = *(const f32x4*)(gfin + col0 + bj * HALF + 4); }
        { unsigned spins = 0; while ((unsigned)__builtin_amdgcn_readfirstlane(__hip_atomic_load(cnt, __ATOMIC_RELAXED, __HIP_MEMORY_SCOPE_AGENT)) < 32u) { __builtin_amdgcn_s_sleep(1); if (++spins > (1u << 22)) break; } }
        __builtin_amdgcn_fence(__ATOMIC_ACQUIRE, "agent");
        asm volatile("s_waitcnt vmcnt(0)" ::: "memory");
        f32x4 pv[8];
#pragma unroll
        for (int gidx = 0; gidx < 8; ++gidx) pv[gidx] = *(const f32x4*)((const float*)sq + (size_t)(row0 + (gidx >> 2) * HALF + (gidx & 3) * 16) * 16 + 4 * fq);
#pragma unroll
        for (int gidx = 0; gidx < 8; ++gidx) { const int ai = gidx >> 2, m = gidx & 3; const int row = row0 + ai * HALF + m * 16;
            float t = (pv[gidx][0] + pv[gidx][1]) + (pv[gidx][2] + pv[gidx][3]); t += __shfl_xor(t, 16); t += __shfl_xor(t, 32);
            const float rstd = rsqrtf(t * (1.0f / 1024.0f) + EPS);
            const size_t o = (size_t)row * DM + col0;
#pragma unroll
            for (int bj = 0; bj < 2; ++bj) { *(f32x4*)(out + o + bj * HALF) = acc[ai][bj][m][0] * rstd * gv[bj][0]; *(f32x4*)(out + o + bj * HALF + 4) = acc[ai][bj][m][1] * rstd * gv[bj][1]; } }
    }
    template <class Sched>
    __device__ __forceinline__ bool prefill(LAS unsigned char* lds, const Sched& S) const {
        if (!(mode == 0 || mode == 1 || mode == 4 || mode == 5) || S.nwg > 4 * S.G) return false;
        const int tid = threadIdx.x, rr = tid & 255;
#pragma unroll
        for (int k = 0; k < 2; ++k) { const int ui = (tid >> 8) + 2 * k; Unit u;
            if (S.next(ui, u)) { const int row = u.pm * BM + rr; float r;
                if (mode == 4 || mode == 5) { const f32x4* pp = (const f32x4*)((const float*)(ws + WS_SSQ) + (size_t)row * 16); const f32x4 a = pp[0], b = pp[1], c = pp[2], d = pp[3];
                    const float t = ((a[0] + a[1]) + (a[2] + a[3])) + ((b[0] + b[1]) + (b[2] + b[3])) + ((c[0] + c[1]) + (c[2] + c[3])) + ((d[0] + d[1]) + (d[2] + d[3]));
                    r = rsqrtf(t * (1.0f / 1024.0f) + EPS) * (mode == 4 ? 0.0625f : 1.0f); }
                else r = ((const float*)(ws + (mode == 0 ? WS_RSTD0 : WS_RSTDM)))[row];
                *(LAS float*)(lds + STAGE_BYTES + (ui * 256 + rr) * 4) = r; } }
        return true;
    }
    __device__ __forceinline__ void operator()(const f32x4 (&acc)[2][2][4][2], const Unit& u, int ui, bool tab, LAS unsigned char* lds, int wr, int wc, int fr, int fq) const {
        const int row0 = u.pm * BM + wr * 64 + fr;
        const int colL = wc * 32 + 8 * fq;
        if (mode == 3 || mode == 6 || mode == 7) {
            const int col0 = u.pn * BM + colL;
            bf16_t* xb = (bf16_t*)(ws + WS_XB);
            float* ssq = (float*)(ws + WS_SSQ);
            f32x4 rc[4], rn[4];
            u32x4 bc[2], bn[2];
            if (mode == 3) { const size_t o = (size_t)row0 * DM + col0; rc[0] = *(const f32x4*)(x + o); rc[1] = *(const f32x4*)(x + o + 4); rc[2] = *(const f32x4*)(x + o + HALF); rc[3] = *(const f32x4*)(x + o + HALF + 4); }
            else { const size_t o = (size_t)row0 * DM + col0; bc[0] = *(const u32x4*)(xb + o); bc[1] = *(const u32x4*)(xb + o + HALF); }
#pragma unroll
            for (int gidx = 0; gidx < 8; ++gidx) { const int ai = gidx >> 2, m = gidx & 3; const int row = row0 + ai * HALF + m * 16;
                if (gidx < 7) { const int g2 = gidx + 1; const size_t o2 = (size_t)(row0 + (g2 >> 2) * HALF + (g2 & 3) * 16) * DM + col0;
                    if (mode == 3) { rn[0] = *(const f32x4*)(x + o2); rn[1] = *(const f32x4*)(x + o2 + 4); rn[2] = *(const f32x4*)(x + o2 + HALF); rn[3] = *(const f32x4*)(x + o2 + HALF + 4); }
                    else { bn[0] = *(const u32x4*)(xb + o2); bn[1] = *(const u32x4*)(xb + o2 + HALF); } }
                if (mode != 3) {
#pragma unroll
                    for (int bj = 0; bj < 2; ++bj) { rc[2 * bj] = (f32x4){bflo(bc[bj].x), bfhi(bc[bj].x), bflo(bc[bj].y), bfhi(bc[bj].y)}; rc[2 * bj + 1] = (f32x4){bflo(bc[bj].z), bfhi(bc[bj].z), bflo(bc[bj].w), bfhi(bc[bj].w)}; } }
                float ss = 0.f;
#pragma unroll
                for (int bj = 0; bj < 2; ++bj) { const size_t o = (size_t)row * DM + col0 + bj * HALF;
                    const f32x4 v0 = acc[ai][bj][m][0] + rc[2 * bj], v1 = acc[ai][bj][m][1] + rc[2 * bj + 1];
                    store8(xb + o, v0, v1);
                    ss += (v0[0] * v0[0] + v0[1] * v0[1]) + (v0[2] * v0[2] + v0[3] * v0[3]) + (v1[0] * v1[0] + v1[1] * v1[1]) + (v1[2] * v1[2] + v1[3] * v1[3]); }
                ss += __shfl_xor(ss, 16); ss += __shfl_xor(ss, 32);
                if (fq == 0) ssq[(size_t)row * 16 + u.pn * 4 + wc] = ss;
#pragma unroll
                for (int k = 0; k < 4; ++k) rc[k] = rn[k];
                bc[0] = bn[0]; bc[1] = bn[1]; }
            return;
        }
        if (mode == 2) {
            const int col0 = u.pn * BM + colL;
            const float* rs = (const float*)(ws + WS_RSTDM); bf16_t* ob = (bf16_t*)(ws + WS_VT); const int ldo = 1024;
            f32x4 c0[2], c1[2];
#pragma unroll
            for (int bj = 0; bj < 2; ++bj) { c0[bj] = *(const f32x4*)(rs + col0 + bj * HALF); c1[bj] = *(const f32x4*)(rs + col0 + bj * HALF + 4); }
#pragma unroll
            for (int ai = 0; ai < 2; ++ai)
#pragma unroll
                for (int m = 0; m < 4; ++m) { const int row = row0 + ai * HALF + m * 16;
#pragma unroll
                    for (int bj = 0; bj < 2; ++bj) store8(ob + (size_t)row * ldo + col0 + bj * HALF, acc[ai][bj][m][0] * c0[bj], acc[ai][bj][m][1] * c1[bj]); }
            return;
        }
        float rsc[8];
        if (tab) {
#pragma unroll
            for (int gidx = 0; gidx < 8; ++gidx) rsc[gidx] = *(const LAS float*)(lds + STAGE_BYTES + (ui * 256 + wr * 64 + fr + (gidx >> 2) * HALF + (gidx & 3) * 16) * 4);
        } else if (mode == 4 || mode == 5) {
            asm volatile("" ::: "memory");
            const float* sq = (const float*)(ws + WS_SSQ);
            f32x4 pv[8];
#pragma unroll
            for (int gidx = 0; gidx < 8; ++gidx) pv[gidx] = *(const f32x4*)(sq + (size_t)(row0 + (gidx >> 2) * HALF + (gidx & 3) * 16) * 16 + 4 * fq);
            const float cs = mode == 4 ? 0.0625f : 1.0f;
#pragma unroll
            for (int gidx = 0; gidx < 8; ++gidx) { float t = (pv[gidx][0] + pv[gidx][1]) + (pv[gidx][2] + pv[gidx][3]); t += __shfl_xor(t, 16); t += __shfl_xor(t, 32); rsc[gidx] = rsqrtf(t * (1.0f / 1024.0f) + EPS) * cs; }
        } else {
            asm volatile("" ::: "memory");
            const float* rs = (const float*)(ws + (mode == 0 ? WS_RSTD0 : WS_RSTDM));
#pragma unroll
            for (int gidx = 0; gidx < 8; ++gidx) rsc[gidx] = rs[row0 + (gidx >> 2) * HALF + (gidx & 3) * 16];
        }
        if (mode == 0) {
            float* lf = (float*)(ws + WS_LF);
            const int pnn = u.pn + pnoff; const int sub = pnn >> 1; const int cb = (pnn & 1) * 256 + colL;
            if (sub == 1) {
                float oml[2][8];
#pragma unroll
                for (int bj = 0; bj < 2; ++bj)
#pragma unroll
                    for (int j = 0; j < 8; ++j) { const int c = cb + bj * HALF + j; const float l0 = lbl[c], l1 = lbl[512 + c]; const float lb = 1.0f / (1.0f + __expf(l1 - l0)); oml[bj][j] = 1.0f - lb; }
#pragma unroll
                for (int ai = 0; ai < 2; ++ai)
#pragma unroll
                    for (int m = 0; m < 4; ++m) { const int row = row0 + ai * HALF + m * 16; const float r = rsc[ai * 4 + m];
#pragma unroll
                        for (int bj = 0; bj < 2; ++bj) { f32x4 lf0, lf1;
#pragma unroll
                            for (int j = 0; j < 4; ++j) {
                                const float za = acc[ai][bj][m][0][j] * r, zb = acc[ai][bj][m][1][j] * r;
                                const float ka = oml[bj][j] * (1.0f - sigmoidf_(za)), kb = oml[bj][4 + j] * (1.0f - sigmoidf_(zb));
                                lf0[j] = __logf(1.0f - ka); lf1[j] = __logf(1.0f - kb); }
                            const size_t o = (size_t)row * 512 + cb + bj * HALF;
                            *(f32x4*)(lf + o) = lf0; *(f32x4*)(lf + o + 4) = lf1; } }
            } else {
                bf16_t* dst = (bf16_t*)(ws + (sub == 0 ? WS_QH : (sub == 2 ? WS_VH : (sub == 3 ? WS_GH : WS_PH))));
                const bool act = (sub == 0) || (sub == 3);
#pragma unroll
                for (int ai = 0; ai < 2; ++ai)
#pragma unroll
                    for (int m = 0; m < 4; ++m) { const int row = row0 + ai * HALF + m * 16; const float r = rsc[ai * 4 + m];
#pragma unroll
                        for (int bj = 0; bj < 2; ++bj) { f32x4 v0 = acc[ai][bj][m][0] * r, v1 = acc[ai][bj][m][1] * r;
                            if (act) {
#pragma unroll
                                for (int j = 0; j < 4; ++j) { v0[j] = v0[j] * sigmoidf_(v0[j]); v1[j] = v1[j] * sigmoidf_(v1[j]); } }
                            store8(dst + (size_t)row * 512 + cb + bj * HALF, v0, v1); } }
            }
        } else {
            const int col0 = u.pn * BM + colL;
            bf16_t* ob = (bf16_t*)(ws + (mode == 1 ? WS_KX : (mode == 4 ? WS_XQ : WS_U))); const int ldo = mode == 5 ? DFF : 1024;
#pragma unroll
            for (int ai = 0; ai < 2; ++ai)
#pragma unroll
                for (int m = 0; m < 4; ++m) { const int row = row0 + ai * HALF + m * 16; const float r = rsc[ai * 4 + m];
#pragma unroll
                    for (int bj = 0; bj < 2; ++bj) { f32x4 v0 = acc[ai][bj][m][0] * r, v1 = acc[ai][bj][m][1] * r;
                        if (mode == 5) {
#pragma unroll
                            for (int j = 0; j < 4; ++j) { const float a = fmaxf(v0[j], 0.f), b = fmaxf(v1[j], 0.f); v0[j] = a * a; v1[j] = b * b; } }
                        store8(ob + (size_t)row * ldo + col0 + bj * HALF, v0, v1); } }
        }
    }
};

template <class EpiT, class Sched>
__device__ __forceinline__ void gemm_phase(LAS unsigned char* lds, const Gemm g, const Sched S, const EpiT E) {
    const int tid = threadIdx.x, wid = __builtin_amdgcn_readfirstlane(tid >> 6), lane = tid & 63, wr = wid >> 2, wc = wid & 3, fr = lane & 15, fq = lane >> 4;
    const int K = g.K, nt = K / BK;
    unsigned voffA[2], voffB[2];
#pragma unroll
    for (int i = 0; i < 2; ++i) { int R, C; stage_rc(tid * 16 + i * 8192, R, C); const int Rb = EpiT::PERM ? ((R & ~31) + perm32(R & 31)) : R;
        voffA[i] = (unsigned)(R * K + C) * 2u; voffB[i] = (unsigned)(Rb * K + C) * 2u; }
    const size_t kstep = (size_t)(BK * 2);
    const size_t hstep = (size_t)HALF * K * 2;
    const size_t tstep = 2 * hstep;
    const unsigned ldsw = (unsigned)wid * 1024u;
    const int aoff = lds_byte(wr * 64 + fr, fq * 8), boff = lds_byte(wc * 32 + fr, fq * 8);
#define PG8_SA(b, h) (((b) * 2 + (h)) * HTB)
#define PG8_SB(b, h) ((4 + (b) * 2 + (h)) * HTB)
#define PG8_STAGE(bufoff, gbase, voff) do { _Pragma("unroll") for (int _i = 0; _i < 2; ++_i) \
        __builtin_amdgcn_global_load_lds((const unsigned*)((const char*)(gbase) + (voff)[_i]), (LAS unsigned*)(lds + (bufoff) + ldsw + _i * 8192), 16, 0, 0); } while (0)
#define PG8_LDA(dst, b, h) do { _Pragma("unroll") for (int m = 0; m < 4; ++m) _Pragma("unroll") for (int k = 0; k < 2; ++k) dst[m][k] = *(const LAS bf16x8*)(lds + PG8_SA(b, h) + aoff + m * 2048 + k * 1024); } while (0)
#define PG8_LDB(dst, b, h) do { _Pragma("unroll") for (int n = 0; n < 2; ++n) _Pragma("unroll") for (int k = 0; k < 2; ++k) dst[n][k] = *(const LAS bf16x8*)(lds + PG8_SB(b, h) + boff + n * 2048 + k * 1024); } while (0)
#define PG8_MMA(ai, bj, At, Bt) do { __builtin_amdgcn_s_setprio(1); _Pragma("unroll") for (int m = 0; m < 4; ++m) _Pragma("unroll") for (int n = 0; n < 2; ++n) _Pragma("unroll") for (int k = 0; k < 2; ++k) \
        acc[ai][bj][m][n] = __builtin_amdgcn_mfma_f32_16x16x32_bf16(Bt[n][k], At[m][k], acc[ai][bj][m][n], 0, 0, 0); __builtin_amdgcn_s_setprio(0); } while (0)
#define PG8_WAIT_V(n) asm volatile("s_waitcnt vmcnt(" #n ")" ::: "memory")
#define PG8_WAIT_L(n) asm volatile("s_waitcnt lgkmcnt(" #n ")" ::: "memory")
#define PG8_BAR __builtin_amdgcn_s_barrier()
#define PG8_SCHED __builtin_amdgcn_sched_barrier(0)
    Unit cur, nxt; int ui = 0;
    if (!S.next(0, cur)) return;
    const bool tab = E.prefill(lds, S);
    if (tab) __syncthreads();
    f32x4 acc[2][2][4][2];
#pragma unroll
    for (int a = 0; a < 2; ++a)
#pragma unroll
        for (int b = 0; b < 2; ++b)
#pragma unroll
            for (int m = 0; m < 4; ++m)
#pragma unroll
                for (int n = 0; n < 2; ++n) acc[a][b][m][n] = (f32x4){0.f, 0.f, 0.f, 0.f};
    bf16x8 At[4][2], B0[2][2], B1[2][2];
    const char* cA = (const char*)g.A + (size_t)cur.pm * tstep; const char* cB = (const char*)g.Bt + (size_t)cur.pn * tstep;
    PG8_STAGE(PG8_SB(0, 0), cB, voffB); PG8_STAGE(PG8_SA(0, 0), cA, voffA); PG8_STAGE(PG8_SB(0, 1), cB + hstep, voffB); PG8_STAGE(PG8_SA(0, 1), cA + hstep, voffA);
    if (wr == 1) PG8_BAR;
    PG8_WAIT_V(4); PG8_BAR;
    PG8_STAGE(PG8_SB(1, 0), cB + kstep, voffB); PG8_STAGE(PG8_SA(1, 0), cA + kstep, voffA); PG8_STAGE(PG8_SB(1, 1), cB + hstep + kstep, voffB);
    PG8_WAIT_V(6); PG8_BAR;
    for (;;) {
        const bool has_next = S.next(ui + 1, nxt);
        const char* nA = has_next ? (const char*)g.A + (size_t)nxt.pm * tstep : cA; const char* nB = has_next ? (const char*)g.Bt + (size_t)nxt.pn * tstep : cB;
        for (int t = 0; t < nt; t += 2) {
            const bool last = (t == nt - 2);
            const char* a1 = cA + (size_t)(t + 1) * kstep;
            const char* a2 = last ? nA : cA + (size_t)(t + 2) * kstep; const char* b2 = last ? nB : cB + (size_t)(t + 2) * kstep;
            const char* a3 = a2 + kstep; const char* b3 = b2 + kstep;
            PG8_LDB(B0, 0, 0); PG8_SCHED; PG8_LDA(At, 0, 0); PG8_STAGE(PG8_SA(1, 1), a1 + hstep, voffA);
            PG8_WAIT_L(8); PG8_BAR; PG8_WAIT_L(0); PG8_MMA(0, 0, At, B0); PG8_BAR; PG8_SCHED;
            PG8_LDB(B1, 0, 1); PG8_STAGE(PG8_SB(0, 0), b2, voffB);
            PG8_BAR; PG8_WAIT_L(0); PG8_MMA(0, 1, At, B1); PG8_BAR;
            PG8_LDA(At, 0, 1); PG8_STAGE(PG8_SA(0, 0), a2, voffA);
            PG8_BAR; PG8_WAIT_L(0); PG8_MMA(1, 0, At, B0); PG8_BAR; PG8_SCHED;
            PG8_STAGE(PG8_SB(0, 1), b2 + hstep, voffB);
            PG8_WAIT_V(6); PG8_BAR; PG8_MMA(1, 1, At, B1); PG8_BAR;
            PG8_LDB(B0, 1, 0); PG8_SCHED; PG8_LDA(At, 1, 0); PG8_STAGE(PG8_SA(0, 1), a2 + hstep, voffA);
            PG8_WAIT_L(8); PG8_BAR; PG8_WAIT_L(0); PG8_MMA(0, 0, At, B0); PG8_BAR; PG8_SCHED;
            PG8_LDB(B1, 1, 1); PG8_STAGE(PG8_SB(1, 0), b3, voffB);
            PG8_BAR; PG8_WAIT_L(0); PG8_MMA(0, 1, At, B1); PG8_BAR;
            PG8_LDA(At, 1, 1); PG8_STAGE(PG8_SA(1, 0), a3, voffA);
            PG8_BAR; PG8_WAIT_L(0); PG8_MMA(1, 0, At, B0); PG8_BAR; PG8_SCHED;
            PG8_STAGE(PG8_SB(1, 1), b3 + hstep, voffB);
            PG8_WAIT_V(6); PG8_BAR; PG8_MMA(1, 1, At, B1); PG8_BAR;
        }
        if (E.mode != 8) E(acc, cur, ui, tab, lds, wr, wc, fr, fq);
        if (E.mode == 0) __builtin_amdgcn_s_waitcnt(0x0F70);
        if (!has_next) break;
#pragma unroll
        for (int a = 0; a < 2; ++a)
#pragma unroll
            for (int b = 0; b < 2; ++b)
#pragma unroll
                for (int m = 0; m < 4; ++m)
#pragma unroll
                    for (int n = 0; n < 2; ++n) acc[a][b][m][n] = (f32x4){0.f, 0.f, 0.f, 0.f};
        cur = nxt; cA = nA; cB = nB; ++ui;
    }
    PG8_WAIT_V(0);
    if (wr == 0) PG8_BAR;
    PG8_BAR;
    if (E.mode == 8) E.fused(acc, cur, wr, wc, fr, fq);
#undef PG8_SA
#undef PG8_SB
#undef PG8_STAGE
#undef PG8_LDA
#undef PG8_LDB
#undef PG8_MMA
#undef PG8_WAIT_V
#undef PG8_WAIT_L
#undef PG8_BAR
#undef PG8_SCHED
}
}

struct Params {
    const float *x, *mem, *norm_mix_g, *w_in, *lb_logits, *hgrn_norm_g, *w_pool, *pool_scale, *w_out, *norm_x_g, *norm_mem_g, *w_xq, *w_xk, *w_xv, *w_xo, *norm_ffn_g, *w_ff1, *w_ff2, *final_norm_g;
    float* out; unsigned char* ws;
    int ph_lo, ph_hi;
};

struct TD { const float* W; const float* g; bf16_t* out; int N, ldo, kt, nt; };
__device__ __forceinline__ TD tile_desc(const Params& p, int t) {
    unsigned char* ws = p.ws; TD d;
    if (t < 320)       { d.W = p.w_in;  d.g = p.norm_mix_g; d.out = (bf16_t*)(ws + WS_WT_IN);  d.N = NIN;  d.ldo = 1024; d.kt = t / 40; d.nt = t % 40; }
    else if (t < 448)  { const int u = t - 320;  d.W = p.w_xk;  d.g = p.norm_mem_g; d.out = (bf16_t*)(ws + WS_WT_K);   d.N = 1024; d.ldo = 1024; d.kt = u / 16; d.nt = u % 16; }
    else if (t < 576)  { const int u = t - 448;  d.W = p.w_xv;  d.g = p.norm_mem_g; d.out = (bf16_t*)(ws + WS_WT_V);   d.N = 1024; d.ldo = 1024; d.kt = u / 16; d.nt = u % 16; }
    else if (t < 704)  { const int u = t - 576;  d.W = p.w_xq;  d.g = p.norm_x_g;   d.out = (bf16_t*)(ws + WS_WT_Q);   d.N = 1024; d.ldo = 1024; d.kt = u / 16; d.nt = u % 16; }
    else if (t < 832)  { const int u = t - 704;  d.W = p.w_xo;  d.g = nullptr;      d.out = (bf16_t*)(ws + WS_WT_O);   d.N = 1024; d.ldo = 1024; d.kt = u / 16; d.nt = u % 16; }
    else if (t < 960)  { const int u = t - 832;  d.W = p.w_out; d.g = nullptr;      d.out = (bf16_t*)(ws + WS_WT_OUT); d.N = 1024; d.ldo = 1024; d.kt = u / 16; d.nt = u % 16; }
    else if (t < 1472) { const int u = t - 960;  d.W = p.w_ff1; d.g = p.norm_ffn_g; d.out = (bf16_t*)(ws + WS_WT_FF1); d.N = DFF;  d.ldo = 1024; d.kt = u / 64; d.nt = u % 64; }
    else if (t < 1984) { const int u = t - 1472; d.W = p.w_ff2; d.g = nullptr;      d.out = (bf16_t*)(ws + WS_WT_FF2); d.N = 1024; d.ldo = 4096; d.kt = u / 16; d.nt = u % 16; }
    else if (t < 2112) { const int u = t - 1984; d.W = p.w_in;  d.g = p.norm_mix_g; d.out = (bf16_t*)(ws + WS_WT_IN);  d.N = NIN;  d.ldo = 1024; d.kt = u / 16; d.nt = 8 + u % 16; }
    else               { const int u = t - 2112, j = u % 24; d.W = p.w_in; d.g = p.norm_mix_g; d.out = (bf16_t*)(ws + WS_WT_IN); d.N = NIN; d.ldo = 1024; d.kt = u / 24; d.nt = j < 8 ? j : 16 + j; }
    return d;
}
__device__ __forceinline__ void tile_load(const TD& d, f32x4 (&v)[4], float (&sc)[4]) {
    const int tid = threadIdx.x, r = tid >> 4, c4 = tid & 15;
#pragma unroll
    for (int i = 0; i < 4; ++i) { const int k = 128 * d.kt + r + 32 * i; v[i] = __builtin_nontemporal_load((const f32x4*)(d.W + (size_t)k * d.N + 64 * d.nt + 4 * c4)); sc[i] = d.g ? d.g[k] : 1.0f; }
}
__device__ __forceinline__ void transpose_range(const Params& p, unsigned char* lds, int t_begin, int t_end, int first, int stride) {
    bf16_t* T0 = (bf16_t*)lds;
    bf16_t* T1 = (bf16_t*)(lds + 17408);
    const int tid = threadIdx.x, r = tid >> 4, c4 = tid & 15, n = tid >> 3, ks = tid & 7;
    int ta = t_begin + first;
    if (ta >= t_end) return;
    int tb = ta + stride; bool hb = tb < t_end;
    TD da = tile_desc(p, ta), db = da; f32x4 va[4], vb[4]; float sa[4], sb[4];
    tile_load(da, va, sa);
    if (hb) { db = tile_desc(p, tb); tile_load(db, vb, sb); }
    for (;;) {
#pragma unroll
        for (int i = 0; i < 4; ++i) { const int kl = r + 32 * i;
            T0[(4 * c4 + 0) * 136 + kl] = f2bf(va[i][0] * sa[i]); T0[(4 * c4 + 1) * 136 + kl] = f2bf(va[i][1] * sa[i]);
            T0[(4 * c4 + 2) * 136 + kl] = f2bf(va[i][2] * sa[i]); T0[(4 * c4 + 3) * 136 + kl] = f2bf(va[i][3] * sa[i]); }
        if (hb) {
#pragma unroll
            for (int i = 0; i < 4; ++i) { const int kl = r + 32 * i;
                T1[(4 * c4 + 0) * 136 + kl] = f2bf(vb[i][0] * sb[i]); T1[(4 * c4 + 1) * 136 + kl] = f2bf(vb[i][1] * sb[i]);
                T1[(4 * c4 + 2) * 136 + kl] = f2bf(vb[i][2] * sb[i]); T1[(4 * c4 + 3) * 136 + kl] = f2bf(vb[i][3] * sb[i]); } }
        __syncthreads();
        const int tna = ta + 2 * stride, tnb = tna + stride; const bool hna = tna < t_end, hnb = tnb < t_end;
        const TD ca = da, cb = db; const bool chb = hb;
        if (hna) { da = tile_desc(p, tna); tile_load(da, va, sa); }
        if (hnb) { db = tile_desc(p, tnb); tile_load(db, vb, sb); }
        { const u32x4* src = (const u32x4*)(T0 + n * 136 + 16 * ks); const u32x4 a = src[0], b = src[1];
          u32x4* dst = (u32x4*)(ca.out + (size_t)(64 * ca.nt + n) * ca.ldo + 128 * ca.kt + 16 * ks); dst[0] = a; dst[1] = b; }
        if (chb) { const u32x4* src = (const u32x4*)(T1 + n * 136 + 16 * ks); const u32x4 a = src[0], b = src[1];
          u32x4* dst = (u32x4*)(cb.out + (size_t)(64 * cb.nt + n) * cb.ldo + 128 * cb.kt + 16 * ks); dst[0] = a; dst[1] = b; }
        __syncthreads();
        if (!hna) break;
        ta = tna; hb = hnb;
    }
}
__device__ __forceinline__ void phase_prep(const Params p, unsigned char* lds, bool shadow) {
    unsigned char* ws = p.ws;
    const int G = gridDim.x;
    {
        const int lane = threadIdx.x & 63, gw = blockIdx.x * (NTHREADS / 64) + (threadIdx.x >> 6), nw = G * (NTHREADS / 64);
        int r = gw;
        f32x4 v[4], vn[4];
        if (r < MROWS + MEMROWS) { const float* src = r < MROWS ? p.x + (size_t)r * DM : p.mem + (size_t)(r - MROWS) * DM;
#pragma unroll
            for (int i = 0; i < 4; ++i) v[i] = __builtin_nontemporal_load((const f32x4*)src + lane + 64 * i); }
        for (; r < MROWS + MEMROWS; r += nw) {
            const int rn = r + nw;
            if (rn < MROWS + MEMROWS) { const float* src = rn < MROWS ? p.x + (size_t)rn * DM : p.mem + (size_t)(rn - MROWS) * DM;
#pragma unroll
                for (int i = 0; i < 4; ++i) vn[i] = __builtin_nontemporal_load((const f32x4*)src + lane + 64 * i); }
            const bool isx = r < MROWS;
            bf16_t* dst = isx ? (bf16_t*)(ws + WS_XB) + (size_t)r * DM : (bf16_t*)(ws + WS_MEMB) + (size_t)(r - MROWS) * DM;
            float ss = 0.f;
#pragma unroll
            for (int i = 0; i < 4; ++i) ss += (v[i][0] * v[i][0] + v[i][1] * v[i][1]) + (v[i][2] * v[i][2] + v[i][3] * v[i][3]);
#pragma unroll
            for (int o = 1; o < 64; o <<= 1) ss += __shfl_xor(ss, o);
#pragma unroll
            for (int i = 0; i < 4; ++i) { u32x2 w; w.x = cvt_pk_bf16(v[i][0], v[i][1]); w.y = cvt_pk_bf16(v[i][2], v[i][3]); ((u32x2*)dst)[lane + 64 * i] = w; }
            if (lane == 0) { const float rstd = rsqrtf(ss * (1.0f / 1024.0f) + EPS); if (isx) ((float*)(ws + WS_RSTD0))[r] = rstd; else ((float*)(ws + WS_RSTDM))[r - MROWS] = rstd; }
#pragma unroll
            for (int i = 0; i < 4; ++i) v[i] = vn[i];
        }
    }
    if (shadow) transpose_range(p, lds, 1984, 2112, blockIdx.x, G);
    else transpose_range(p, lds, 0, 576, blockIdx.x, G);
}
__device__ __forceinline__ void deferred_prep(const Params p, unsigned char* lds, int j, int nworkers) {
    transpose_range(p, lds, 576, 1984, j, nworkers);
}
__device__ __forceinline__ void fold_pool_weights_mfma(const Params& p) {
    bf16_t* wto = (bf16_t*)(p.ws + WS_WT_OUT);
    const int tid = threadIdx.x, w = tid >> 6, lane = tid & 63, fr = lane & 15, q = lane >> 4;
    for (int item = blockIdx.x; item < 256; item += gridDim.x) {
        const int gi = item >> 6, nb = item & 63;
        f32x4 acc = (f32x4){0.f, 0.f, 0.f, 0.f};
        const float* wp = p.w_pool + (size_t)(gi * 128 + 16 * w + fr) * 128;
        const float* ps = p.pool_scale + gi * 128;
        const bf16_t* arow = wto + (size_t)(16 * nb + fr) * 1024 + 512 + gi * 128;
#pragma unroll
        for (int ks = 0; ks < 4; ++ks) {
            const int d0 = 32 * ks + 8 * q;
            const f32x4 w0 = *(const f32x4*)(wp + d0), w1 = *(const f32x4*)(wp + d0 + 4), s0 = *(const f32x4*)(ps + d0), s1 = *(const f32x4*)(ps + d0 + 4);
            const bf16x8 cfr = mk8u(cvt_pk_bf16(w0[0] * s0[0], w0[1] * s0[1]), cvt_pk_bf16(w0[2] * s0[2], w0[3] * s0[3]), cvt_pk_bf16(w1[0] * s1[0], w1[1] * s1[1]), cvt_pk_bf16(w1[2] * s1[2], w1[3] * s1[3]));
            const bf16x8 nfr = *(const bf16x8*)(arow + d0);
            acc = mfma16(cfr, nfr, acc);
        }
        asm volatile("s_waitcnt vmcnt(0)" ::: "memory");
        __syncthreads();
        u32x2 o; o.x = cvt_pk_bf16(acc[0], acc[1]); o.y = cvt_pk_bf16(acc[2], acc[3]);
        *(u32x2*)(wto + (size_t)(16 * nb + fr) * 1024 + 512 + gi * 128 + 16 * w + 4 * q) = o;
        __syncthreads();
    }
}

__device__ __forceinline__ void phase_passA(const bf16_t* __restrict__ KH, const float* __restrict__ LF, const bf16_t* __restrict__ VH, bf16_t* __restrict__ LT, float* __restrict__ DEC, unsigned char* lds, int first, int stride, int ubeg, int uend) {
    const int tid = threadIdx.x, ch = tid & 127, seg = tid >> 7;
    float* segtot = (float*)lds;
    unsigned char* KdT = lds + 2048;
    unsigned char* VTl = lds + 2048 + 18432;
    const int w = tid >> 6, lane = tid & 63, fr = lane & 15, q = lane >> 4;
    float lf[16], kk[16]; unsigned vr[16];
    int unit = ubeg + first;
    if (unit < uend) { const int b = unit >> 8, c = (unit >> 2) & 63, h = unit & 3; const size_t g0 = (size_t)(b * SEQ + c * 64 + seg * 16) * 512 + h * 128 + ch;
#pragma unroll
        for (int i = 0; i < 16; ++i) { lf[i] = LF[g0 + (size_t)i * 512]; vr[i] = VH[g0 + (size_t)i * 512]; } }
    for (; unit < uend; unit += stride) {
        const int b = unit >> 8, c = (unit >> 2) & 63, h = unit & 3, bh = b * 4 + h;
#pragma unroll
        for (int i = 0; i < 16; ++i) kk[i] = 1.0f - __expf(lf[i]);
#pragma unroll
        for (int i = 1; i < 16; ++i) lf[i] += lf[i - 1];
        segtot[seg * 128 + ch] = lf[15];
        __syncthreads();
        float after = 0.f;
#pragma unroll
        for (int s2 = 1; s2 < 4; ++s2) if (s2 > seg) after += segtot[s2 * 128 + ch];
        const float tot = after + lf[15];
        if (seg == 0) DEC[(size_t)(bh * 64 + c) * 128 + ch] = __expf(tot);
        unsigned kd[8], vp[8];
#pragma unroll
        for (int i = 0; i < 8; ++i) {
            kd[i] = cvt_pk_bf16(kk[2 * i] * __expf(tot - lf[2 * i]), kk[2 * i + 1] * __expf(tot - lf[2 * i + 1]));
            vp[i] = vr[2 * i] | (vr[2 * i + 1] << 16);
        }
        { u32x4* d = (u32x4*)(KdT + ch * 144 + seg * 32); d[0] = (u32x4){kd[0], kd[1], kd[2], kd[3]}; d[1] = (u32x4){kd[4], kd[5], kd[6], kd[7]}; }
        { u32x4* d = (u32x4*)(VTl + ch * 144 + seg * 32); d[0] = (u32x4){vp[0], vp[1], vp[2], vp[3]}; d[1] = (u32x4){vp[4], vp[5], vp[6], vp[7]}; }
        __syncthreads();
        {
            const int un = unit + stride;
            if (un < uend) { const int b2 = un >> 8, c2 = (un >> 2) & 63, h2 = un & 3; const size_t g0 = (size_t)(b2 * SEQ + c2 * 64 + seg * 16) * 512 + h2 * 128 + ch;
#pragma unroll
                for (int i = 0; i < 16; ++i) { lf[i] = LF[g0 + (size_t)i * 512]; vr[i] = VH[g0 + (size_t)i * 512]; } }
        }
        bf16x8 a[2];
#pragma unroll
        for (int ks = 0; ks < 2; ++ks) a[ks] = *(const bf16x8*)(KdT + (16 * w + fr) * 144 + (32 * ks + 8 * q) * 2);
        bf16_t* ltp = LT + (size_t)(bh * 64 + c) * 16384;
#pragma unroll
        for (int vb = 0; vb < 8; ++vb) {
            f32x4 acc = (f32x4){0.f, 0.f, 0.f, 0.f};
#pragma unroll
            for (int ks = 0; ks < 2; ++ks) { const bf16x8 bfr = *(const bf16x8*)(VTl + (16 * vb + fr) * 144 + (32 * ks + 8 * q) * 2); acc = mfma16(a[ks], bfr, acc); }
            u32x2 pk; pk.x = cvt_pk_bf16(acc[0], acc[1]); pk.y = cvt_pk_bf16(acc[2], acc[3]);
            *(u32x2*)(ltp + (size_t)(16 * vb + fr) * 128 + 16 * w + 4 * q) = pk;
        }
        __syncthreads();
    }
}

template <int W>
__device__ __forceinline__ void pool_body(const bf16_t* __restrict__ PH, bf16_t* __restrict__ MIXED, int r0, int s0, int c0) {
    unsigned v[31 + W];
#pragma unroll
    for (int j = 1; j < W; ++j) v[W - 1 - j] = (s0 - j >= 0) ? *(const unsigned*)(PH + (size_t)(r0 - j) * 512 + c0) : 0u;
#pragma unroll
    for (int tt = 0; tt < 32; ++tt) v[W - 1 + tt] = *(const unsigned*)(PH + (size_t)(r0 + tt) * 512 + c0);
    float sx = 0.f, sy = 0.f;
#pragma unroll
    for (int j = 1; j < W; ++j) { sx += bflo(v[W - 1 - j]); sy += bfhi(v[W - 1 - j]); }
#pragma unroll
    for (int tt = 0; tt < 32; ++tt) {
        const int s = s0 + tt;
        const float px = bflo(v[W - 1 + tt]), py = bfhi(v[W - 1 + tt]);
        sx += px; sy += py;
        const int cnt = (s + 1) < W ? (s + 1) : W;
        const float inv = __builtin_amdgcn_rcpf((float)cnt);
        *(unsigned*)(MIXED + (size_t)(r0 + tt) * 1024 + 512 + c0) = cvt_pk_bf16(sx * inv - px, sy * inv - py);
        sx -= bflo(v[tt]); sy -= bfhi(v[tt]);
    }
}
__device__ __forceinline__ void pool_tile(const bf16_t* __restrict__ PH, bf16_t* __restrict__ MIXED, int tile) {
    const int tid = threadIdx.x, cp = tid & 255, th = tid >> 8, c0 = 2 * cp, gi = c0 >> 7;
    const int r0 = tile * 64 + th * 32, s0 = r0 & (SEQ - 1);
    if (gi == 0) pool_body<2>(PH, MIXED, r0, s0, c0);
    else if (gi == 1) pool_body<4>(PH, MIXED, r0, s0, c0);
    else if (gi == 2) pool_body<8>(PH, MIXED, r0, s0, c0);
    else pool_body<16>(PH, MIXED, r0, s0, c0);
}

__device__ __forceinline__ void phase_scan(const bf16_t* LT, const float* __restrict__ DEC, bf16_t* ST) {
    for (int e2 = blockIdx.x * NTHREADS + threadIdx.x; e2 < 131072; e2 += gridDim.x * NTHREADS) {
        const int bh = e2 >> 13, v = (e2 >> 6) & 127, kp = e2 & 63;
        float sx = 0.f, sy = 0.f;
        const size_t base = (size_t)bh * 64 * 16384 + (size_t)v * 128 + 2 * kp;
        const float* dp = DEC + (size_t)bh * 64 * 128 + 2 * kp;
        for (int c0 = 0; c0 < 64; c0 += 32) {
            unsigned l[32]; f32x2 d[32];
#pragma unroll
            for (int j = 0; j < 32; ++j) { l[j] = *(const unsigned*)(LT + base + (size_t)(c0 + j) * 16384); d[j] = *(const f32x2*)(dp + (c0 + j) * 128); }
#pragma unroll
            for (int j = 0; j < 32; ++j) {
                *(unsigned*)(ST + base + (size_t)(c0 + j) * 16384) = cvt_pk_bf16(sx, sy);
                sx = d[j][0] * sx + bflo(l[j]); sy = d[j][1] * sy + bfhi(l[j]);
            }
        }
    }
}

__device__ __forceinline__ void phase_passC(const bf16_t* __restrict__ QH, const bf16_t* __restrict__ KH, const float* __restrict__ LF, const bf16_t* __restrict__ VH, const bf16_t* __restrict__ GH,
                                const bf16_t* __restrict__ ST, const float* __restrict__ hg, bf16_t* __restrict__ MIXED, unsigned char* lds) {
    const int tid = threadIdx.x, ch = tid & 127, seg = tid >> 7, G = gridDim.x;
    float lf[16], kk[16]; unsigned qr[16], vr[16];
    int unit = blockIdx.x;
    if (unit < 1024) { const int b = unit >> 8, c = (unit >> 2) & 63, h = unit & 3; const size_t g0 = (size_t)(b * SEQ + c * 64 + seg * 16) * 512 + h * 128 + ch;
#pragma unroll
        for (int i = 0; i < 16; ++i) { lf[i] = LF[g0 + (size_t)i * 512]; vr[i] = VH[g0 + (size_t)i * 512]; qr[i] = QH[g0 + (size_t)i * 512]; } }
  for (; unit < 1024; unit += G) {
    const int b = unit >> 8, c = (unit >> 2) & 63, h = unit & 3;
    const int row0 = b * SEQ + c * 64, bh = b * 4 + h;
    float* segtot = (float*)lds;
    float* rmsp = (float*)(lds + 2048);
    bf16_t* QC = (bf16_t*)(lds + 4096);
    bf16_t* QT = (bf16_t*)(lds + 21504);
    constexpr int KT0 = 38912;
    unsigned char* VTl = lds + 82432;
    const int w = tid >> 6, lane = tid & 63, fr = lane & 15, q = lane >> 4;
    const int i = w & 3, vh = w >> 2;
    const size_t row = (size_t)(row0 + 16 * i + fr);
    u32x2 gt[4]; f32x4 gg[4]; bf16x8 stf[4][4];
    {
        const bf16_t* stp = ST + (size_t)(bh * 64 + c) * 16384;
#pragma unroll
        for (int vbl = 0; vbl < 4; ++vbl) { const int v0 = 16 * (vh * 4 + vbl) + 4 * q; gt[vbl] = *(const u32x2*)(GH + row * 512 + h * 128 + v0); gg[vbl] = *(const f32x4*)(hg + h * 128 + v0);
#pragma unroll
            for (int ks = 0; ks < 4; ++ks) stf[ks][vbl] = *(const bf16x8*)(stp + (size_t)(16 * (vh * 4 + vbl) + fr) * 128 + 32 * ks + 8 * q); }
    }
#pragma unroll
    for (int i2 = 0; i2 < 16; ++i2) kk[i2] = 1.0f - __expf(lf[i2]);
#pragma unroll
    for (int i2 = 1; i2 < 16; ++i2) lf[i2] += lf[i2 - 1];
    segtot[seg * 128 + ch] = lf[15];
    {
        unsigned vp[8];
#pragma unroll
        for (int i2 = 0; i2 < 8; ++i2) vp[i2] = vr[2 * i2] | (vr[2 * i2 + 1] << 16);
        u32x4* d = (u32x4*)(VTl + ch * 144 + seg * 32); d[0] = (u32x4){vp[0], vp[1], vp[2], vp[3]}; d[1] = (u32x4){vp[4], vp[5], vp[6], vp[7]};
    }
    __syncthreads();
    const float t0 = segtot[ch], t1 = segtot[128 + ch], t2 = segtot[256 + ch];
    const float P = (seg > 0 ? t0 : 0.f) + (seg > 1 ? t1 : 0.f) + (seg > 2 ? t2 : 0.f);
    {
        const float eP = __expf(P);
#pragma unroll
        for (int i2 = 0; i2 < 16; ++i2) {
            const float qv = bflo(qr[i2]);
            const float el = __expf(lf[i2]);
            QT[(seg * 16 + i2) * 136 + ch] = f2bf(qv * el);
            QC[(seg * 16 + i2) * 136 + ch] = f2bf(qv * el * eP);
        }
        float E = 0.f;
#pragma unroll
        for (int i2 = 0; i2 < 4; ++i2) {
            if (i2 >= seg) {
                bf16_t* KT = (bf16_t*)(lds + KT0 + 4352 * ((i2 * (i2 + 1)) / 2));
#pragma unroll
                for (int j = 0; j < 16; ++j) KT[(seg * 16 + j) * 136 + ch] = f2bf(kk[j] * __expf(E - lf[j]));
                E += (i2 == 0 ? t0 : (i2 == 1 ? t1 : t2));
            }
        }
    }
    __syncthreads();
    {
        const int un = unit + G;
        if (un < 1024) { const int b2 = un >> 8, c2 = (un >> 2) & 63, h2 = un & 3; const size_t g2 = (size_t)(b2 * SEQ + c2 * 64 + seg * 16) * 512 + h2 * 128 + ch;
#pragma unroll
            for (int i2 = 0; i2 < 16; ++i2) { lf[i2] = LF[g2 + (size_t)i2 * 512]; vr[i2] = VH[g2 + (size_t)i2 * 512]; qr[i2] = QH[g2 + (size_t)i2 * 512]; } }
    }
    f32x4 sT[4];
#pragma unroll
    for (int j = 0; j < 4; ++j) sT[j] = (f32x4){0.f, 0.f, 0.f, 0.f};
    {
        bf16x8 qfr[4];
#pragma unroll
        for (int ks = 0; ks < 4; ++ks) qfr[ks] = *(const bf16x8*)((const unsigned char*)QT + (16 * i + fr) * 272 + (32 * ks + 8 * q) * 2);
        const unsigned char* KT = lds + KT0 + 4352 * ((i * (i + 1)) / 2);
#pragma unroll
        for (int j = 0; j < 4; ++j) if (j <= i) {
#pragma unroll
            for (int ks = 0; ks < 4; ++ks) { const bf16x8 a = *(const bf16x8*)(KT + (16 * j + fr) * 272 + (32 * ks + 8 * q) * 2); sT[j] = mfma16(a, qfr[ks], sT[j]); }
            if (j == i) {
#pragma unroll
                for (int rg = 0; rg < 4; ++rg) if (4 * q + rg > fr) sT[j][rg] = 0.f;
            }
        }
    }
    f32x4 oacc[4];
#pragma unroll
    for (int vbl = 0; vbl < 4; ++vbl) oacc[vbl] = (f32x4){0.f, 0.f, 0.f, 0.f};
#pragma unroll
    for (int m = 0; m < 2; ++m) if (2 * m <= i) {
        const bf16x8 bfrag = mk8u(cvt_pk_bf16(sT[2 * m][0], sT[2 * m][1]), cvt_pk_bf16(sT[2 * m][2], sT[2 * m][3]), cvt_pk_bf16(sT[2 * m + 1][0], sT[2 * m + 1][1]), cvt_pk_bf16(sT[2 * m + 1][2], sT[2 * m + 1][3]));
#pragma unroll
        for (int vbl = 0; vbl < 4; ++vbl) {
            const unsigned char* base = VTl + (16 * (vh * 4 + vbl) + fr) * 144 + (32 * m + 4 * q) * 2;
            const bf16x8 a = mk8(*(const u32x2*)base, *(const u32x2*)(base + 32));
            oacc[vbl] = mfma16(a, bfrag, oacc[vbl]);
        }
    }
    {
#pragma unroll
        for (int ks = 0; ks < 4; ++ks) {
            const bf16x8 bfr = *(const bf16x8*)((const unsigned char*)QC + (16 * i + fr) * 272 + (32 * ks + 8 * q) * 2);
#pragma unroll
            for (int vbl = 0; vbl < 4; ++vbl) oacc[vbl] = mfma16(stf[ks][vbl], bfr, oacc[vbl]);
        }
    }
    float ss = 0.f;
#pragma unroll
    for (int vbl = 0; vbl < 4; ++vbl) ss += (oacc[vbl][0] * oacc[vbl][0] + oacc[vbl][1] * oacc[vbl][1]) + (oacc[vbl][2] * oacc[vbl][2] + oacc[vbl][3] * oacc[vbl][3]);
    ss += __shfl_xor(ss, 16); ss += __shfl_xor(ss, 32);
    if (q == 0) rmsp[vh * 64 + 16 * i + fr] = ss;
    __syncthreads();
    const float rstd = rsqrtf((rmsp[16 * i + fr] + rmsp[64 + 16 * i + fr]) * (1.0f / 128.0f) + EPS);
#pragma unroll
    for (int vbl = 0; vbl < 4; ++vbl) {
        const int v0 = 16 * (vh * 4 + vbl) + 4 * q;
        u32x2 o;
        o.x = cvt_pk_bf16(oacc[vbl][0] * rstd * gg[vbl][0] * bflo(gt[vbl].x), oacc[vbl][1] * rstd * gg[vbl][1] * bfhi(gt[vbl].x));
        o.y = cvt_pk_bf16(oacc[vbl][2] * rstd * gg[vbl][2] * bflo(gt[vbl].y), oacc[vbl][3] * rstd * gg[vbl][3] * bfhi(gt[vbl].y));
        *(u32x2*)(MIXED + row * 1024 + h * 128 + v0) = o;
    }
    __syncthreads();
  }
}

__device__ __forceinline__ void attn_unit(const bf16_t* __restrict__ XQ, const bf16_t* __restrict__ KX, const bf16_t* __restrict__ VT, bf16_t* __restrict__ ATT, int unit, unsigned char* lds) {
    const int tid = threadIdx.x, w = tid >> 6, lane = tid & 63, r = lane & 31, hh = lane >> 5;
    const int b = unit >> 6, st = (unit >> 2) & 15, h = unit & 3;
    const int row0 = b * SEQ + st * 256;
    const bf16_t* qp = XQ + (size_t)(row0 + 32 * w + r) * 1024 + h * 256 + 8 * hh;
    {
        const bf16_t* kp = KX + (size_t)(b * 256) * 1024 + h * 256;
        u32x4 kv[16];
#pragma unroll
        for (int it = 0; it < 16; ++it) { const int idx = tid + 512 * it, m = idx >> 5, cc = idx & 31; kv[it] = *(const u32x4*)(kp + (size_t)m * 1024 + cc * 8); }
#pragma unroll
        for (int it = 0; it < 16; ++it) { const int idx = tid + 512 * it, m = idx >> 5, cc = idx & 31; *(u32x4*)(lds + m * 528 + cc * 16) = kv[it]; }
    }
    __syncthreads();
    f32x16 sacc[8];
#pragma unroll
    for (int mb = 0; mb < 8; ++mb)
#pragma unroll
        for (int e = 0; e < 16; ++e) sacc[mb][e] = 0.f;
    {
        bf16x8 qf[4], qn[4];
#pragma unroll
        for (int k4 = 0; k4 < 4; ++k4) qf[k4] = *(const bf16x8*)(qp + 16 * k4);
#pragma unroll
        for (int kg = 0; kg < 4; ++kg) {
            if (kg < 3) {
#pragma unroll
                for (int k4 = 0; k4 < 4; ++k4) qn[k4] = *(const bf16x8*)(qp + 16 * (4 * (kg + 1) + k4)); }
#pragma unroll
            for (int k4 = 0; k4 < 4; ++k4)
#pragma unroll
                for (int mb = 0; mb < 8; ++mb) { const bf16x8 a = *(const bf16x8*)(lds + (32 * mb + r) * 528 + (16 * (4 * kg + k4) + 8 * hh) * 2); sacc[mb] = mfma32(a, qf[k4], sacc[mb]); }
#pragma unroll
            for (int k4 = 0; k4 < 4; ++k4) qf[k4] = qn[k4];
        }
    }
    float mx = -3.0e38f;
#pragma unroll
    for (int mb = 0; mb < 8; ++mb)
#pragma unroll
        for (int e = 0; e < 16; ++e) mx = fmaxf(mx, sacc[mb][e]);
    mx = fmaxf(mx, __shfl_xor(mx, 32));
    float sum = 0.f;
    bf16x8 pf[8][2];
#pragma unroll
    for (int mb = 0; mb < 8; ++mb) {
        float pv[16];
#pragma unroll
        for (int e = 0; e < 16; ++e) { pv[e] = __expf(sacc[mb][e] - mx); sum += pv[e]; }
#pragma unroll
        for (int s = 0; s < 2; ++s) pf[mb][s] = mk8u(cvt_pk_bf16(pv[8 * s + 0], pv[8 * s + 1]), cvt_pk_bf16(pv[8 * s + 2], pv[8 * s + 3]), cvt_pk_bf16(pv[8 * s + 4], pv[8 * s + 5]), cvt_pk_bf16(pv[8 * s + 6], pv[8 * s + 7]));
    }
    sum += __shfl_xor(sum, 32);
    const float inv = 1.0f / sum;
    __syncthreads();
    {
        const bf16_t* vp = VT + (size_t)(h * 256) * 1024 + b * 256;
        u32x4 vv[16];
#pragma unroll
        for (int it = 0; it < 16; ++it) { const int idx = tid + 512 * it, e = idx >> 5, cc = idx & 31; vv[it] = *(const u32x4*)(vp + (size_t)e * 1024 + cc * 8); }
#pragma unroll
        for (int it = 0; it < 16; ++it) { const int idx = tid + 512 * it, e = idx >> 5, cc = idx & 31;
            u32x2* d = (u32x2*)(lds + e * 520 + cc * 16); d[0] = (u32x2){vv[it].x, vv[it].y}; d[1] = (u32x2){vv[it].z, vv[it].w}; }
    }
    __syncthreads();
    bf16_t* op = ATT + (size_t)(row0 + 32 * w + r) * 1024 + h * 256 + 8 * hh;
#pragma unroll
    for (int half = 0; half < 2; ++half) {
        f32x16 oacc[4];
#pragma unroll
        for (int d = 0; d < 4; ++d)
#pragma unroll
            for (int e = 0; e < 16; ++e) oacc[d][e] = 0.f;
#pragma unroll
        for (int mb = 0; mb < 8; ++mb)
#pragma unroll
            for (int s = 0; s < 2; ++s)
#pragma unroll
                for (int d = 0; d < 4; ++d) {
                    const unsigned char* base = lds + (32 * (half * 4 + d) + r) * 520 + (32 * mb + 16 * s + 4 * hh) * 2;
                    const bf16x8 a = mk8(*(const u32x2*)base, *(const u32x2*)(base + 16));
                    oacc[d] = mfma32(a, pf[mb][s], oacc[d]);
                }
#pragma unroll
        for (int d = 0; d < 4; ++d)
#pragma unroll
            for (int pp = 0; pp < 2; ++pp) {
                unsigned ax = cvt_pk_bf16(oacc[d][8 * pp] * inv, oacc[d][8 * pp + 1] * inv), ay = cvt_pk_bf16(oacc[d][8 * pp + 2] * inv, oacc[d][8 * pp + 3] * inv);
                unsigned bx = cvt_pk_bf16(oacc[d][8 * pp + 4] * inv, oacc[d][8 * pp + 5] * inv), by = cvt_pk_bf16(oacc[d][8 * pp + 6] * inv, oacc[d][8 * pp + 7] * inv);
                { auto t = __builtin_amdgcn_permlane32_swap(ax, bx, false, false); ax = t[0]; bx = t[1]; }
                { auto t = __builtin_amdgcn_permlane32_swap(ay, by, false, false); ay = t[0]; by = t[1]; }
                u32x4 o; o.x = ax; o.y = ay; o.z = bx; o.w = by;
                *(u32x4*)(op + 32 * (half * 4 + d) + 16 * pp) = o;
            }
    }
    __syncthreads();
}

__device__ __forceinline__ void phase_final(const bf16_t* __restrict__ xb, const float* __restrict__ ssq, float* __restrict__ out, const float* __restrict__ g) {
    const int tid = threadIdx.x, sub = tid >> 7, l = tid & 127;
    const f32x4 g0 = *(const f32x4*)(g + 8 * l), g1 = *(const f32x4*)(g + 8 * l + 4);
    for (int r = blockIdx.x * 4 + sub; r < MROWS; r += gridDim.x * 4) {
        const u32x4 v = *(const u32x4*)(xb + (size_t)r * DM + 8 * l);
        const f32x4* pp = (const f32x4*)(ssq + (size_t)r * 16); const f32x4 a = pp[0], b = pp[1], c = pp[2], d = pp[3];
        const float t = ((a[0] + a[1]) + (a[2] + a[3])) + ((b[0] + b[1]) + (b[2] + b[3])) + ((c[0] + c[1]) + (c[2] + c[3])) + ((d[0] + d[1]) + (d[2] + d[3]));
        const float rstd = rsqrtf(t * (1.0f / 1024.0f) + EPS);
        const f32x4 o0 = (f32x4){bflo(v.x), bfhi(v.x), bflo(v.y), bfhi(v.y)} * rstd * g0, o1 = (f32x4){bflo(v.z), bfhi(v.z), bflo(v.w), bfhi(v.w)} * rstd * g1;
        *(f32x4*)(out + (size_t)r * DM + 8 * l) = o0; *(f32x4*)(out + (size_t)r * DM + 8 * l + 4) = o1;
    }
}

#define XB_TMO      128
#define XB_XCNT(j)  (256  + 64 * (j))
#define XB_XSUB(j)  (1280 + 64 * (j))
#define XB_XGEN(j)  (2304 + 64 * (j))
#define XB_TOP      3328
#define XB_TOPGEN   3392
#define XCD_BAR_WORDS 3456
#define XB_SPIN_CAP (1u << 22)
__device__ __forceinline__ unsigned xb_ld(unsigned* p)              { return __hip_atomic_load(p, __ATOMIC_RELAXED, __HIP_MEMORY_SCOPE_AGENT); }
__device__ __forceinline__ unsigned xb_add(unsigned* p, unsigned v) { return __hip_atomic_fetch_add(p, v, __ATOMIC_RELAXED, __HIP_MEMORY_SCOPE_AGENT); }
__device__ __forceinline__ unsigned xb_xcc_id() { return (unsigned)__builtin_amdgcn_s_getreg((3 << 11) | 20) & 0xFu; }
#define XB_SPIN(cond, bar) do { unsigned _sp = 0; while (cond) { __builtin_amdgcn_s_sleep(1); \
    if ((++_sp & 255u) == 0u) { if (xb_ld(&(bar)[XB_TMO])) break; if (_sp > XB_SPIN_CAP) { atomicAdd(&(bar)[XB_TMO], 1u); break; } } } } while (0)
struct XcdBarrier { unsigned* bar; unsigned x; volatile LAS unsigned* st; };
__device__ __forceinline__ XcdBarrier xcd_barrier_post(unsigned* bar, volatile LAS unsigned* st) {
    XcdBarrier b; b.bar = bar; b.x = xb_xcc_id(); b.st = st;
    if (threadIdx.x == 0) (void)xb_add(&bar[XB_XCNT(b.x)], 1u);
    return b;
}
__device__ __forceinline__ void xcd_barrier_complete(unsigned* bar, unsigned x, unsigned& nloc, unsigned& nx) {
    const unsigned G = gridDim.x * gridDim.y * gridDim.z;
    unsigned sum, cnt, mine, sp = 0u;
    for (;;) {
        sum = 0u; cnt = 0u; mine = 0u;
#pragma unroll
        for (unsigned j = 0; j < 16; ++j) { const unsigned c = xb_ld(&bar[XB_XCNT(j)]); sum += c; cnt += (c > 0u) ? 1u : 0u; mine = (j == x) ? c : mine; }
        if (sum == G) break;
        __builtin_amdgcn_s_sleep(1);
        if ((++sp & 255u) == 0u) { if (xb_ld(&bar[XB_TMO])) break; if (sp > XB_SPIN_CAP) { atomicAdd(&bar[XB_TMO], 1u); break; } }
    }
    nloc = mine > 0u ? mine : 1u; nx = cnt > 0u ? cnt : 1u;
}
__device__ __forceinline__ void xcd_barrier(const XcdBarrier& b) {
    asm volatile("s_waitcnt vmcnt(0)" ::: "memory");
    __syncthreads();
    if (threadIdx.x == 0) {
        unsigned* bar = b.bar;
        __builtin_amdgcn_s_waitcnt(0);
        unsigned nloc = b.st[0], nx = b.st[1];
        if (nloc == 0u) { xcd_barrier_complete(bar, b.x, nloc, nx); b.st[0] = nloc; b.st[1] = nx; }
        const unsigned old = xb_add(&bar[XB_XSUB(b.x)], 1u);
        const unsigned gen = old / nloc;
        if (old + 1u == (gen + 1u) * nloc) {
            __builtin_amdgcn_fence(__ATOMIC_RELEASE, "agent");
            asm volatile("s_waitcnt vmcnt(0)" ::: "memory");
            const unsigned og = xb_add(&bar[XB_TOP], 1u);
            const unsigned tg = og / nx;
            if (og + 1u == (tg + 1u) * nx) xb_add(&bar[XB_TOPGEN], 1u);
            else XB_SPIN(xb_ld(&bar[XB_TOPGEN]) == tg, bar);
            __builtin_amdgcn_fence(__ATOMIC_ACQUIRE, "agent");
            asm volatile("s_waitcnt vmcnt(0)" ::: "memory");
        } else {
            XB_SPIN(xb_ld(&bar[XB_TOPGEN]) == gen, bar);
            __builtin_amdgcn_fence(__ATOMIC_ACQUIRE, "agent");
            asm volatile("s_waitcnt vmcnt(0)" ::: "memory");
        }
    }
    __syncthreads();
}

__device__ __forceinline__ unsigned xcd_arrive(const XcdBarrier& b) {
    asm volatile("s_waitcnt vmcnt(0)" ::: "memory");
    __syncthreads();
    unsigned gen = 0u;
    if (threadIdx.x == 0) {
        unsigned* bar = b.bar;
        __builtin_amdgcn_s_waitcnt(0);
        unsigned nloc = b.st[0], nx = b.st[1];
        if (nloc == 0u) { xcd_barrier_complete(bar, b.x, nloc, nx); b.st[0] = nloc; b.st[1] = nx; }
        const unsigned old = xb_add(&bar[XB_XSUB(b.x)], 1u);
        gen = old / nloc;
        if (old + 1u == (gen + 1u) * nloc) {
            __builtin_amdgcn_fence(__ATOMIC_RELEASE, "agent");
            asm volatile("s_waitcnt vmcnt(0)" ::: "memory");
            const unsigned og = xb_add(&bar[XB_TOP], 1u);
            const unsigned tg = og / nx;
            if (og + 1u == (tg + 1u) * nx) xb_add(&bar[XB_TOPGEN], 1u);
        }
    }
    return gen;
}
__device__ __forceinline__ void xcd_wait(const XcdBarrier& b, unsigned gen) {
    if (threadIdx.x == 0) {
        unsigned* bar = b.bar;
        XB_SPIN(xb_ld(&bar[XB_TOPGEN]) == gen, bar);
        __builtin_amdgcn_fence(__ATOMIC_ACQUIRE, "agent");
        asm volatile("s_waitcnt vmcnt(0)" ::: "memory");
    }
    __syncthreads();
}
__device__ __forceinline__ void shadow_work(const Params& p, unsigned char* lds, int k, int bid, int G) {
    const int lo = bid, hi2 = (bid + 128) % G;
    if (k == 0)      { transpose_range(p, lds, 2112, 2304, lo, G);  transpose_range(p, lds, 320, 576, (bid + 64) % G, G); }
    else if (k == 1) { transpose_range(p, lds, 832, 960, lo, G);    transpose_range(p, lds, 960, 1088, hi2, G); }
    else if (k == 2) { transpose_range(p, lds, 576, 704, lo, G);    transpose_range(p, lds, 1088, 1216, hi2, G); }
    else if (k == 3) { for (int t = bid; t < 256; t += G) pool_tile((const bf16_t*)(p.ws + WS_PH), (bf16_t*)(p.ws + WS_MIXED), t); }
    else if (k == 4) { transpose_range(p, lds, 704, 832, lo, G);    transpose_range(p, lds, 1216, 1344, hi2, G); }
    else if (k == 5) { transpose_range(p, lds, 1344, 1472, lo, G);  transpose_range(p, lds, 1472, 1600, hi2, G); }
    else if (k == 7) { transpose_range(p, lds, 1600, 1856, lo, G); }
    else if (k == 8) { transpose_range(p, lds, 1856, 1984, lo, G); }
}

constexpr int N_PHASES = 12;
__global__ void __launch_bounds__(NTHREADS, 2) mega(Params p) {
    extern __shared__ __attribute__((aligned(16))) unsigned char lds[];
    LAS unsigned char* ldsl = (LAS unsigned char*)lds;
    unsigned char* ws = p.ws;
    const int G = gridDim.x, bid = blockIdx.x;
    const int lo = p.ph_lo, hi = p.ph_hi;

#ifndef DEFER_PREP
#define DEFER_PREP 0
#endif
#ifndef FUSE_FINAL
#define FUSE_FINAL 0
#endif
#ifndef DBG_LAST
#define DBG_LAST -1
#endif
#ifndef PHASE_MASK
#define PHASE_MASK 0xfff
#endif
#define IN(k) (((PHASE_MASK >> (k)) & 1) && lo <= (k) && (k) < hi)
    if (threadIdx.x == 0) { ((volatile LAS unsigned*)(ldsl + LDS_MAIN))[0] = 0u; ((volatile LAS unsigned*)(ldsl + LDS_MAIN))[1] = 0u; }
    __syncthreads();
    XcdBarrier xbar; xbar.bar = (unsigned*)(ws + WS_BAR); xbar.x = 0; xbar.st = nullptr;
    if (hi - lo > 1) xbar = xcd_barrier_post((unsigned*)(ws + WS_BAR), (volatile LAS unsigned*)(ldsl + LDS_MAIN));
    if (lo > hi) cg::this_grid().sync();
    const bool shadow = (G == 256) && (hi - lo == N_PHASES);
#define SEAM(k) do { if (IN(k) && IN((k) + 1)) { const unsigned g_ = xcd_arrive(xbar); if (shadow) shadow_work(p, lds, (k), bid, G); xcd_wait(xbar, g_); } } while (0)
    bf16_t* XB = (bf16_t*)(ws + WS_XB); bf16_t* LT = (bf16_t*)(ws + WS_ST);
    bf16_t* QH = (bf16_t*)(ws + WS_QH); bf16_t* KH = (bf16_t*)(ws + WS_KH); bf16_t* VH = (bf16_t*)(ws + WS_VH); bf16_t* GH = (bf16_t*)(ws + WS_GH); bf16_t* PH = (bf16_t*)(ws + WS_PH);
    float* LF = (float*)(ws + WS_LF); bf16_t* ST = (bf16_t*)(ws + WS_ST); bf16_t* MIXED = (bf16_t*)(ws + WS_MIXED);
    float* X1 = (float*)(ws + WS_X1); bf16_t* XQ = (bf16_t*)(ws + WS_XQ); bf16_t* ATT = (bf16_t*)(ws + WS_ATT); bf16_t* U = (bf16_t*)(ws + WS_U);
    float* SSQ = (float*)(ws + WS_SSQ); float* DEC = (float*)(ws + WS_DEC);
    bf16_t* MEMB = (bf16_t*)(ws + WS_MEMB); bf16_t* KX = (bf16_t*)(ws + WS_KX); bf16_t* VT = (bf16_t*)(ws + WS_VT);

    const bool fuse_final = FUSE_FINAL && (G == 256) && IN(10) && (hi - lo > 1);
    if (IN(0)) { phase_prep(p, lds, shadow);
#if !DEFER_PREP
        if (!shadow) deferred_prep(p, lds, bid, G);
#endif
    }
    SEAM(0);
    const bf16_t* WTIN = (const bf16_t*)(ws + WS_WT_IN);
    if (IN(1)) {
        const pg8::Epi E{0, ws, p.x, p.out, p.lb_logits, p.final_norm_g, 2};
        pg8::Gemm g{XB, WTIN + (size_t)512 * DM, MROWS, 1024, DM}; pg8::StaticOrder S; S.init(MROWS, 1024, G, bid); pg8::gemm_phase(ldsl, g, S, E);
    }
    SEAM(1);
    if (IN(2)) {
        { const pg8::Epi E{0, ws, p.x, p.out, p.lb_logits, p.final_norm_g, 6};
          pg8::Gemm g{XB, WTIN + (size_t)1536 * DM, MROWS, 1024, DM}; pg8::StaticOrder S; S.init(MROWS, 1024, G, bid); pg8::gemm_phase(ldsl, g, S, E); }
        { const pg8::Epi E{0, ws, p.x, p.out, p.lb_logits, p.final_norm_g, 0};
          pg8::Gemm g{XB, WTIN, MROWS, 512, DM}; pg8::StaticOrder S; S.init(MROWS, 512, G, bid); pg8::gemm_phase(ldsl, g, S, E); }
        const pg8::Epi E1{1, ws, p.x, p.out, p.lb_logits, p.final_norm_g, 0};
        { pg8::Gemm g{MEMB, (const bf16_t*)(ws + WS_WT_K), MEMROWS, 1024, DM}; pg8::StaticOrder S; S.init(MEMROWS, 1024, G, (bid + 128) % G); pg8::gemm_phase(ldsl, g, S, E1); }
        const pg8::Epi E2{2, ws, p.x, p.out, p.lb_logits, p.final_norm_g, 0};
        { pg8::Gemm g{(const bf16_t*)(ws + WS_WT_V), MEMB, 1024, MEMROWS, DM}; pg8::StaticOrder S; S.init(1024, MEMROWS, G, (bid + 112) % G); pg8::gemm_phase(ldsl, g, S, E2); }
        if (G == 256) {
            if (bid >= 160) phase_passA(KH, LF, VH, LT, DEC, lds, bid - 160, 96, 0, 512);
            phase_passA(KH, LF, VH, LT, DEC, lds, bid, G, 512, 1024);
        } else phase_passA(KH, LF, VH, LT, DEC, lds, bid, G, 0, 1024);
    }
    SEAM(2);
    if (IN(3)) {
        phase_scan(LT, DEC, ST);
        if (!shadow) { for (int t = bid; t < 256; t += G) pool_tile(PH, MIXED, t); }
        fold_pool_weights_mfma(p);
    }
    SEAM(3);
    if (IN(4)) { phase_passC(QH, KH, LF, VH, GH, ST, p.hgrn_norm_g, MIXED, lds); }
    SEAM(4);
    if (IN(5)) {
        const pg8::Epi E{6, ws, p.x, p.out, p.lb_logits, p.final_norm_g, 0};
        pg8::Gemm g{MIXED, (const bf16_t*)(ws + WS_WT_OUT), MROWS, DM, DM}; pg8::StaticOrder S; S.init(MROWS, DM, G, bid); pg8::gemm_phase(ldsl, g, S, E);
    }
    SEAM(5);
    const bool fuse_attn = (G == 256) && IN(6) && IN(7);
    if (IN(6)) {
        const pg8::Epi E{4, ws, p.x, p.out, p.lb_logits, p.final_norm_g, 0};
        pg8::Gemm g{XB, (const bf16_t*)(ws + WS_WT_Q), MROWS, DM, DM}; pg8::StaticOrder S; S.init(MROWS, DM, G, bid); pg8::gemm_phase(ldsl, g, S, E);
        if (fuse_attn) {
            pg8::Unit u; S.next(0, u);
            asm volatile("s_waitcnt vmcnt(0)" ::: "memory"); __syncthreads();
            attn_unit(XQ, KX, VT, ATT, u.pm * 4 + u.pn, lds);
        }
    }
    if (!fuse_attn) {
        SEAM(6);
        if (IN(7)) { for (int u = bid; u < 256; u += G) attn_unit(XQ, KX, VT, ATT, u, lds); }
    }
    SEAM(7);
    if (IN(8)) {
        const pg8::Epi E{6, ws, p.x, p.out, p.lb_logits, p.final_norm_g, 0};
        pg8::Gemm g{ATT, (const bf16_t*)(ws + WS_WT_O), MROWS, DM, DM}; pg8::StaticOrder S; S.init(MROWS, DM, G, bid); pg8::gemm_phase(ldsl, g, S, E);
    }
    SEAM(8);
    if (IN(9)) {
        const pg8::Epi E{5, ws, p.x, p.out, p.lb_logits, p.final_norm_g, 0};
        pg8::Gemm g{XB, (const bf16_t*)(ws + WS_WT_FF1), MROWS, DFF, DM}; pg8::StaticOrder S; S.init(MROWS, DFF, G, bid); pg8::gemm_phase(ldsl, g, S, E);
    }
    SEAM(9);
    if (IN(10)) {
        const pg8::Epi E{fuse_final ? 8 : 7, ws, p.x, p.out, p.lb_logits, p.final_norm_g, 0};
        pg8::Gemm g{U, (const bf16_t*)(ws + WS_WT_FF2), MROWS, DM, DFF}; pg8::StaticOrder S; S.init(MROWS, DM, G, bid); pg8::gemm_phase(ldsl, g, S, E);
    }
    if (!fuse_final) {
        SEAM(10);
        if (IN(11)) { phase_final(XB, SSQ, p.out, p.final_norm_g); }
    }
#if DBG_LAST >= 0
    cg::this_grid().sync();
    {
        const unsigned* w32 = (const unsigned*)ws;
        for (size_t i = (size_t)bid * NTHREADS + threadIdx.x; i < (size_t)MROWS * DM; i += (size_t)G * NTHREADS) {
            float a = 0.f;
            for (int j = 0; j < 4; ++j) { const unsigned v = w32[i + (size_t)j * MROWS * DM]; a += (float)(v & 0xffffu) + (float)(v >> 16); }
            p.out[i] = a;
        }
    }
#endif
#undef IN
#undef SEAM
}

extern "C" void kernel_launch(void* const* d_in, const int* in_sizes, int n_in, void* d_out, int out_size, void* d_ws, size_t ws_size, hipStream_t stream) {
    static int grid = 0;
    if (grid == 0) {
        if (n_in != 19 || in_sizes[0] != MROWS * DM || out_size != MROWS * DM || ws_size < WS_END) { fprintf(stderr, "kernel_launch: unexpected shapes (n_in %d, ws %zu)\n", n_in, ws_size); grid = -1; return; }
        int dev = 0, cus = 0, per_cu = 0;
        hipGetDevice(&dev); hipDeviceGetAttribute(&cus, hipDeviceAttributeMultiprocessorCount, dev);
        if (hipFuncSetAttribute((const void*)mega, hipFuncAttributeMaxDynamicSharedMemorySize, LDS_BYTES) != hipSuccess) { fprintf(stderr, "kernel_launch: hipFuncSetAttribute failed\n"); grid = -1; return; }
        if (hipOccupancyMaxActiveBlocksPerMultiprocessor(&per_cu, (const void*)mega, NTHREADS, LDS_BYTES) != hipSuccess || per_cu < 1) { fprintf(stderr, "kernel_launch: occupancy query says %d\n", per_cu); per_cu = 1; }
        (void)hipGetLastError();
        grid = cus * 1;
        if (grid > cus * per_cu) grid = cus * per_cu;
    }
    if (grid < 0) return;
    if (hipMemsetAsync((char*)d_ws + WS_BAR, 0, 32768, stream) != hipSuccess) { fprintf(stderr, "kernel_launch: memset of barrier words failed\n"); return; }
    Params p{};
    const float** f = (const float**)&p;
    for (int i = 0; i < 19; ++i) f[i] = (const float*)d_in[i];
    p.out = (float*)d_out; p.ws = (unsigned char*)d_ws;
#if N_LAUNCH_MODE == 1
    p.ph_lo = 0; p.ph_hi = (DBG_LAST >= 0) ? DBG_LAST + 1 : N_PHASES;
    void* args[] = {&p};
    hipError_t e = hipLaunchCooperativeKernel((const void*)mega, dim3(grid), dim3(NTHREADS), args, LDS_BYTES, stream);
    if (e != hipSuccess) fprintf(stderr, "kernel_launch: cooperative launch failed: %s (grid %d)\n", hipGetErrorString(e), grid);
#else
    for (int k = 0; k < N_PHASES; ++k) { p.ph_lo = k; p.ph_hi = k + 1; hipLaunchKernelGGL(mega, dim3(grid), dim3(NTHREADS), LDS_BYTES, stream, p); }
#endif
}
```

```cpp
#include <hip/hip_runtime.h>
#include <hip/hip_cooperative_groups.h>
#include <cstdio>
namespace cg = cooperative_groups;

#ifndef N_LAUNCH_MODE
#define N_LAUNCH_MODE 1
#endif

typedef unsigned short bf16_t;
typedef short bf16x8 __attribute__((ext_vector_type(8)));
typedef float f32x2 __attribute__((ext_vector_type(2)));
typedef float f32x4 __attribute__((ext_vector_type(4)));
typedef float f32x16 __attribute__((ext_vector_type(16)));
typedef unsigned u32x2 __attribute__((ext_vector_type(2)));
typedef unsigned u32x4 __attribute__((ext_vector_type(4)));
#define LAS __attribute__((address_space(3)))

constexpr int MROWS = 16384, DM = 1024, SEQ = 4096, NIN = 2560, DFF = 4096, MEMROWS = 1024;
constexpr float EPS = 1e-6f;
constexpr int NTHREADS = 512;
constexpr int LDS_MAIN = 135168;
constexpr int LDS_BYTES = LDS_MAIN + 16;

constexpr size_t MiB = 1u << 20;
constexpr size_t WS_WT_IN = 0, WS_WT_K = 5 * MiB, WS_WT_V = 7 * MiB, WS_WT_OUT = 9 * MiB, WS_WT_Q = 11 * MiB, WS_WT_O = 13 * MiB,
                 WS_WT_FF1 = 15 * MiB, WS_WT_FF2 = 23 * MiB, WS_MEMB = 31 * MiB, WS_KX = 33 * MiB, WS_VT = 35 * MiB, WS_SSQ = 37 * MiB,
                 WS_BAR = 39 * MiB, WS_CNT = 39 * MiB + 16384, WS_RSTD0 = 38 * MiB, WS_RSTDM = 38 * MiB + 65536, WS_DEC = 38 * MiB + 131072,
                 WS_XB = 40 * MiB  , WS_QH = 72 * MiB, WS_KH = 88 * MiB, WS_VH = 104 * MiB, WS_GH = 120 * MiB, WS_PH = 136 * MiB,
                 WS_LF = 152 * MiB, WS_ST = 184 * MiB, WS_MIXED = 216 * MiB,
                 WS_X1 = 72 * MiB, WS_XQ = 136 * MiB, WS_ATT = 168 * MiB, WS_U = 72 * MiB, WS_END = 256 * MiB;

typedef __bf16 bf16x2n __attribute__((ext_vector_type(2)));
__device__ __forceinline__ unsigned cvt_pk_bf16(float lo, float hi) { f32x2 v = {lo, hi}; return __builtin_bit_cast(unsigned, __builtin_convertvector(v, bf16x2n)); }
__device__ __forceinline__ bf16_t f2bf(float f) { return (bf16_t)(cvt_pk_bf16(f, 0.f) & 0xffffu); }
__device__ __forceinline__ float bf2f(bf16_t b) { return __uint_as_float(((unsigned)b) << 16); }
__device__ __forceinline__ float bflo(unsigned u) { return __uint_as_float(u << 16); }
__device__ __forceinline__ float bfhi(unsigned u) { return __uint_as_float(u & 0xffff0000u); }
__device__ __forceinline__ f32x4 mfma16(bf16x8 a, bf16x8 b, f32x4 c) { return __builtin_amdgcn_mfma_f32_16x16x32_bf16(a, b, c, 0, 0, 0); }
__device__ __forceinline__ f32x16 mfma32(bf16x8 a, bf16x8 b, f32x16 c) { return __builtin_amdgcn_mfma_f32_32x32x16_bf16(a, b, c, 0, 0, 0); }
__device__ __forceinline__ bf16x8 mk8(u32x2 lo, u32x2 hi) { u32x4 t; t.x = lo.x; t.y = lo.y; t.z = hi.x; t.w = hi.y; return __builtin_bit_cast(bf16x8, t); }
__device__ __forceinline__ bf16x8 mk8u(unsigned a, unsigned b, unsigned c, unsigned d) { u32x4 t; t.x = a; t.y = b; t.z = c; t.w = d; return __builtin_bit_cast(bf16x8, t); }
__device__ __forceinline__ float sigmoidf_(float z) { return __builtin_amdgcn_rcpf(1.0f + __expf(-z)); }

namespace pg8 {
constexpr int BM = 256, BK = 64, HALF = 128, HTB = HALF * BK * 2, STAGE_BYTES = 8 * HTB, NXCD = 8, WGM = 8;
__device__ __forceinline__ int lds_byte(int r, int c) { const int st = (r >> 4) * 2 + (c >> 5), rr = r & 15, cc = c & 31, ob = rr * 64 + cc * 2; return st * 1024 + (ob ^ (((ob >> 9) & 1) << 5)); }
__device__ __forceinline__ void stage_rc(int b, int& R, int& C) { const int st = b / 1024, sb = b % 1024, swz = sb ^ (((sb >> 9) & 1) << 5); R = (st >> 1) * 16 + swz / 64; C = (st & 1) * 32 + (swz % 64) / 2; }
__device__ __forceinline__ int perm32(int rho) { const int n = rho >> 4, i = rho & 15; return 8 * (i >> 2) + 4 * n + (i & 3); }
struct Unit { int pm, pn; };
struct Gemm { const bf16_t* A; const bf16_t* Bt; int M, N, K; };
struct StaticOrder {
    int nM, nN, nwg, G, c;
    __device__ __forceinline__ void init(int M, int N, int G_, int c_) { nM = M / BM; nN = N / BM; nwg = nM * nN; G = G_; c = c_; }
    __device__ __forceinline__ bool next(int i, Unit& u) const {
        const long L = (long)i * G + c; if (L >= nwg) return false;
        int wgid = (int)L; { const int q = nwg / NXCD, r = nwg % NXCD, xcd = wgid % NXCD, off = wgid / NXCD; wgid = (xcd < r ? xcd * (q + 1) : r * (q + 1) + (xcd - r) * q) + off; }
        const int nig = WGM * nN, gid = wgid / nig, fm = gid * WGM, gsz = (nM - fm) < WGM ? (nM - fm) : WGM;
        u.pm = fm + ((wgid % nig) % gsz); u.pn = (wgid % nig) / gsz; return true;
    }
};

struct Epi {
    static constexpr bool PERM = true;
    int mode;
    unsigned char* ws; const float* x; float* out; const float* lbl; const float* gfin; int pnoff;
    __device__ __forceinline__ void store8(bf16_t* p, const f32x4& v0, const f32x4& v1) const {
        u32x4 w; w.x = cvt_pk_bf16(v0[0], v0[1]); w.y = cvt_pk_bf16(v0[2], v0[3]); w.z = cvt_pk_bf16(v1[0], v1[1]); w.w = cvt_pk_bf16(v1[2], v1[3]); *(u32x4*)p = w; }
    __device__ __forceinline__ void fused(f32x4 (&acc)[2][2][4][2], const Unit& u, int wr, int wc, int fr, int fq) const {
        const int row0 = u.pm * BM + wr * 64 + fr;
        const int col0 = u.pn * BM + wc * 32 + 8 * fq;
        const bf16_t* xb = (const bf16_t*)(ws + WS_XB);
        unsigned* sq = (unsigned*)(ws + WS_SSQ);
        unsigned* cnt = (unsigned*)(ws + WS_CNT) + 64 * u.pm;
        u32x4 bc[2], bn[2];
        { const size_t o = (size_t)row0 * DM + col0; bc[0] = *(const u32x4*)(xb + o); bc[1] = *(const u32x4*)(xb + o + HALF); }
#pragma unroll
        for (int gidx = 0; gidx < 8; ++gidx) { const int ai = gidx >> 2, m = gidx & 3; const int row = row0 + ai * HALF + m * 16;
            if (gidx < 7) { const int g2 = gidx + 1; const size_t o2 = (size_t)(row0 + (g2 >> 2) * HALF + (g2 & 3) * 16) * DM + col0; bn[0] = *(const u32x4*)(xb + o2); bn[1] = *(const u32x4*)(xb + o2 + HALF); }
            float ss = 0.f;
#pragma unroll
            for (int bj = 0; bj < 2; ++bj) { const u32x4 bb = bc[bj];
                const f32x4 v0 = acc[ai][bj][m][0] + (f32x4){bflo(bb.x), bfhi(bb.x), bflo(bb.y), bfhi(bb.y)}, v1 = acc[ai][bj][m][1] + (f32x4){bflo(bb.z), bfhi(bb.z), bflo(bb.w), bfhi(bb.w)};
                acc[ai][bj][m][0] = v0; acc[ai][bj][m][1] = v1;
                ss += (v0[0] * v0[0] + v0[1] * v0[1]) + (v0[2] * v0[2] + v0[3] * v0[3]) + (v1[0] * v1[0] + v1[1] * v1[1]) + (v1[2] * v1[2] + v1[3] * v1[3]); }
            ss += __shfl_xor(ss, 16); ss += __shfl_xor(ss, 32);
            if (fq == 0) __hip_atomic_store(sq + (size_t)row * 16 + u.pn * 4 + wc, __float_as_uint(ss), __ATOMIC_RELAXED, __HIP_MEMORY_SCOPE_AGENT);
            bc[0] = bn[0]; bc[1] = bn[1]; }
        asm volatile("s_waitcnt vmcnt(0)" ::: "memory");
        if ((threadIdx.x & 63) == 0) __hip_atomic_fetch_add(cnt, 1u, __ATOMIC_RELAXED, __HIP_MEMORY_SCOPE_AGENT);
        f32x4 gv[2][2];
#pragma unroll
        for (int bj = 0; bj < 2; ++bj) { gv[bj][0] = *(const f32x4*)(gfin + col0 + bj * HALF); gv[bj][1] = *(const f32x4*)(gfin + col0 + bj * HALF + 4); }
        { unsigned spins = 0; while ((unsigned)__builtin_amdgcn_readfirstlane(__hip_atomic_load(cnt, __ATOMIC_RELAXED, __HIP_MEMORY_SCOPE_AGENT)) < 32u) { __builtin_amdgcn_s_sleep(1); if (++spins > (1u << 22)) break; } }
        __builtin_amdgcn_fence(__ATOMIC_ACQUIRE, "agent");
        asm volatile("s_waitcnt vmcnt(0)" ::: "memory");
        f32x4 pv[8];
#pragma unroll
        for (int gidx = 0; gidx < 8; ++gidx) pv[gidx] = *(const f32x4*)((const float*)sq + (size_t)(row0 + (gidx >> 2) * HALF + (gidx & 3) * 16) * 16 + 4 * fq);
#pragma unroll
        for (int gidx = 0; gidx < 8; ++gidx) { const int ai = gidx >> 2, m = gidx & 3; const int row = row0 + ai * HALF + m * 16;
            float t = (pv[gidx][0] + pv[gidx][1]) + (pv[gidx][2] + pv[gidx][3]); t += __shfl_xor(t, 16); t += __shfl_xor(t, 32);
            const float rstd = rsqrtf(t * (1.0f / 1024.0f) + EPS);
            const size_t o = (size_t)row * DM + col0;
#pragma unroll
            for (int bj = 0; bj < 2; ++bj) { *(f32x4*)(out + o + bj * HALF) = acc[ai][bj][m][0] * rstd * gv[bj][0]; *(f32x4*)(out + o + bj * HALF + 4) = acc[ai][bj][m][1] * rstd * gv[bj][1]; } }
    }
    template <class Sched>
    __device__ __forceinline__ bool prefill(LAS unsigned char* lds, const Sched& S) const {
        if (!(mode == 0 || mode == 1 || mode == 4 || mode == 5) || S.nwg > 4 * S.G) return false;
        const int tid = threadIdx.x, rr = tid & 255;
#pragma unroll
        for (int k = 0; k < 2; ++k) { const int ui = (tid >> 8) + 2 * k; Unit u;
            if (S.next(ui, u)) { const int row = u.pm * BM + rr; float r;
                if (mode == 4 || mode == 5) { const f32x4* pp = (const f32x4*)((const float*)(ws + WS_SSQ) + (size_t)row * 16); const f32x4 a = pp[0], b = pp[1], c = pp[2], d = pp[3];
                    const float t = ((a[0] + a[1]) + (a[2] + a[3])) + ((b[0] + b[1]) + (b[2] + b[3])) + ((c[0] + c[1]) + (c[2] + c[3])) + ((d[0] + d[1]) + (d[2] + d[3]));
                    r = rsqrtf(t * (1.0f / 1024.0f) + EPS) * (mode == 4 ? 0.0625f : 1.0f); }
                else r = ((const float*)(ws + (mode == 0 ? WS_RSTD0 : WS_RSTDM)))[row];
                *(LAS float*)(lds + STAGE_BYTES + (ui * 256 + rr) * 4) = r; } }
        return true;
    }
    __device__ __forceinline__ void operator()(const f32x4 (&acc)[2][2][4][2], const Unit& u, int ui, bool tab, LAS unsigned char* lds, int wr, int wc, int fr, int fq) const {
        const int row0 = u.pm * BM + wr * 64 + fr;
        const int colL = wc * 32 + 8 * fq;
        if (mode == 3 || mode == 6 || mode == 7) {
            const int col0 = u.pn * BM + colL;
            bf16_t* xb = (bf16_t*)(ws + WS_XB);
            float* ssq = (float*)(ws + WS_SSQ);
            f32x4 rc[4], rn[4];
            u32x4 bc[2], bn[2];
            if (mode == 3) { const size_t o = (size_t)row0 * DM + col0; rc[0] = *(const f32x4*)(x + o); rc[1] = *(const f32x4*)(x + o + 4); rc[2] = *(const f32x4*)(x + o + HALF); rc[3] = *(const f32x4*)(x + o + HALF + 4); }
            else { const size_t o = (size_t)row0 * DM + col0; bc[0] = *(const u32x4*)(xb + o); bc[1] = *(const u32x4*)(xb + o + HALF); }
#pragma unroll
            for (int gidx = 0; gidx < 8; ++gidx) { const int ai = gidx >> 2, m = gidx & 3; const int row = row0 + ai * HALF + m * 16;
                if (gidx < 7) { const int g2 = gidx + 1; const size_t o2 = (size_t)(row0 + (g2 >> 2) * HALF + (g2 & 3) * 16) * DM + col0;
                    if (mode == 3) { rn[0] = *(const f32x4*)(x + o2); rn[1] = *(const f32x4*)(x + o2 + 4); rn[2] = *(const f32x4*)(x + o2 + HALF); rn[3] = *(const f32x4*)(x + o2 + HALF + 4); }
                    else { bn[0] = *(const u32x4*)(xb + o2); bn[1] = *(const u32x4*)(xb + o2 + HALF); } }
                if (mode != 3) {
#pragma unroll
                    for (int bj = 0; bj < 2; ++bj) { rc[2 * bj] = (f32x4){bflo(bc[bj].x), bfhi(bc[bj].x), bflo(bc[bj].y), bfhi(bc[bj].y)}; rc[2 * bj + 1] = (f32x4){bflo(bc[bj].z), bfhi(bc[bj].z), bflo(bc[bj].w), bfhi(bc[bj].w)}; } }
                float ss = 0.f;
#pragma unroll
                for (int bj = 0; bj < 2; ++bj) { const size_t o = (size_t)row * DM + col0 + bj * HALF;
                    const f32x4 v0 = acc[ai][bj][m][0] + rc[2 * bj], v1 = acc[ai][bj][m][1] + rc[2 * bj + 1];
                    store8(xb + o, v0, v1);
                    ss += (v0[0] * v0[0] + v0[1] * v0[1]) + (v0[2] * v0[2] + v0[3] * v0[3]) + (v1[0] * v1[0] + v1[1] * v1[1]) + (v1[2] * v1[2] + v1[3] * v1[3]); }
                ss += __shfl_xor(ss, 16); ss += __shfl_xor(ss, 32);
                if (fq == 0) ssq[(size_t)row * 16 + u.pn * 4 + wc] = ss;
#pragma unroll
                for (int k = 0; k < 4; ++k) rc[k] = rn[k];
                bc[0] = bn[0]; bc[1] = bn[1]; }
            return;
        }
        if (mode == 2) {
            const int col0 = u.pn * BM + colL;
            const float* rs = (const float*)(ws + WS_RSTDM); bf16_t* ob = (bf16_t*)(ws + WS_VT); const int ldo = 1024;
            f32x4 c0[2], c1[2];
#pragma unroll
            for (int bj = 0; bj < 2; ++bj) { c0[bj] = *(const f32x4*)(rs + col0 + bj * HALF); c1[bj] = *(const f32x4*)(rs + col0 + bj * HALF + 4); }
#pragma unroll
            for (int ai = 0; ai < 2; ++ai)
#pragma unroll
                for (int m = 0; m < 4; ++m) { const int row = row0 + ai * HALF + m * 16;
#pragma unroll
                    for (int bj = 0; bj < 2; ++bj) store8(ob + (size_t)row * ldo + col0 + bj * HALF, acc[ai][bj][m][0] * c0[bj], acc[ai][bj][m][1] * c1[bj]); }
            return;
        }
        float rsc[8];
        if (tab) {
#pragma unroll
            for (int gidx = 0; gidx < 8; ++gidx) rsc[gidx] = *(const LAS float*)(lds + STAGE_BYTES + (ui * 256 + wr * 64 + fr + (gidx >> 2) * HALF + (gidx & 3) * 16) * 4);
        } else if (mode == 4 || mode == 5) {
            asm volatile("" ::: "memory");
            const float* sq = (const float*)(ws + WS_SSQ);
            f32x4 pv[8];
#pragma unroll
            for (int gidx = 0; gidx < 8; ++gidx) pv[gidx] = *(const f32x4*)(sq + (size_t)(row0 + (gidx >> 2) * HALF + (gidx & 3) * 16) * 16 + 4 * fq);
            const float cs = mode == 4 ? 0.0625f : 1.0f;
#pragma unroll
            for (int gidx = 0; gidx < 8; ++gidx) { float t = (pv[gidx][0] + pv[gidx][1]) + (pv[gidx][2] + pv[gidx][3]); t += __shfl_xor(t, 16); t += __shfl_xor(t, 32); rsc[gidx] = rsqrtf(t * (1.0f / 1024.0f) + EPS) * cs; }
        } else {
            asm volatile("" ::: "memory");
            const float* rs = (const float*)(ws + (mode == 0 ? WS_RSTD0 : WS_RSTDM));
#pragma unroll
            for (int gidx = 0; gidx < 8; ++gidx) rsc[gidx] = rs[row0 + (gidx >> 2) * HALF + (gidx & 3) * 16];
        }
        if (mode == 0) {
            float* lf = (float*)(ws + WS_LF);
            const int pnn = u.pn + pnoff; const int sub = pnn >> 1; const int cb = (pnn & 1) * 256 + colL;
            if (sub == 1) {
                float oml[2][8];
#pragma unroll
                for (int bj = 0; bj < 2; ++bj)
#pragma unroll
                    for (int j = 0; j < 8; ++j) { const int c = cb + bj * HALF + j; const float l0 = lbl[c], l1 = lbl[512 + c]; const float lb = 1.0f / (1.0f + __expf(l1 - l0)); oml[bj][j] = 1.0f - lb; }
#pragma unroll
                for (int ai = 0; ai < 2; ++ai)
#pragma unroll
                    for (int m = 0; m < 4; ++m) { const int row = row0 + ai * HALF + m * 16; const float r = rsc[ai * 4 + m];
#pragma unroll
                        for (int bj = 0; bj < 2; ++bj) { f32x4 lf0, lf1;
#pragma unroll
                            for (int j = 0; j < 4; ++j) {
                                const float za = acc[ai][bj][m][0][j] * r, zb = acc[ai][bj][m][1][j] * r;
                                const float ka = oml[bj][j] * (1.0f - sigmoidf_(za)), kb = oml[bj][4 + j] * (1.0f - sigmoidf_(zb));
                                lf0[j] = __logf(1.0f - ka); lf1[j] = __logf(1.0f - kb); }
                            const size_t o = (size_t)row * 512 + cb + bj * HALF;
                            *(f32x4*)(lf + o) = lf0; *(f32x4*)(lf + o + 4) = lf1; } }
            } else {
                bf16_t* dst = (bf16_t*)(ws + (sub == 0 ? WS_QH : (sub == 2 ? WS_VH : (sub == 3 ? WS_GH : WS_PH))));
                const bool act = (sub == 0) || (sub == 3);
#pragma unroll
                for (int ai = 0; ai < 2; ++ai)
#pragma unroll
                    for (int m = 0; m < 4; ++m) { const int row = row0 + ai * HALF + m * 16; const float r = rsc[ai * 4 + m];
#pragma unroll
                        for (int bj = 0; bj < 2; ++bj) { f32x4 v0 = acc[ai][bj][m][0] * r, v1 = acc[ai][bj][m][1] * r;
                            if (act) {
#pragma unroll
                                for (int j = 0; j < 4; ++j) { v0[j] = v0[j] * sigmoidf_(v0[j]); v1[j] = v1[j] * sigmoidf_(v1[j]); } }
                            store8(dst + (size_t)row * 512 + cb + bj * HALF, v0, v1); } }
            }
        } else {
            const int col0 = u.pn * BM + colL;
            bf16_t* ob = (bf16_t*)(ws + (mode == 1 ? WS_KX : (mode == 4 ? WS_XQ : WS_U))); const int ldo = mode == 5 ? DFF : 1024;
#pragma unroll
            for (int ai = 0; ai < 2; ++ai)
#pragma unroll
                for (int m = 0; m < 4; ++m) { const int row = row0 + ai * HALF + m * 16; const float r = rsc[ai * 4 + m];
#pragma unroll
                    for (int bj = 0; bj < 2; ++bj) { f32x4 v0 = acc[ai][bj][m][0] * r, v1 = acc[ai][bj][m][1] * r;
                        if (mode == 5) {
#pragma unroll
                            for (int j = 0; j < 4; ++j) { const float a = fmaxf(v0[j], 0.f), b = fmaxf(v1[j], 0.f); v0[j] = a * a; v1[j] = b * b; } }
                        if (mode == 5) {
                            u32x4 w; w.x = cvt_pk_bf16(v0[0], v0[1]); w.y = cvt_pk_bf16(v0[2], v0[3]); w.z = cvt_pk_bf16(v1[0], v1[1]); w.w = cvt_pk_bf16(v1[2], v1[3]);
                            __builtin_amdgcn_raw_buffer_store_b128(w, __builtin_amdgcn_make_buffer_rsrc((void*)ob, 0, 0x7fffffff, 0x00020000), (int)(((size_t)row * ldo + col0 + bj * HALF) * 2), 0, 16); }
                        else store8(ob + (size_t)row * ldo + col0 + bj * HALF, v0, v1); } }
        }
    }
};

template <class EpiT, class Sched>
__device__ __forceinline__ void gemm_phase(LAS unsigned char* lds, const Gemm g, const Sched S, const EpiT E) {
    const int tid = threadIdx.x, wid = __builtin_amdgcn_readfirstlane(tid >> 6), lane = tid & 63, wr = wid >> 2, wc = wid & 3, fr = lane & 15, fq = lane >> 4;
    const int K = g.K, nt = K / BK;
    unsigned voffA[2], voffB[2];
#pragma unroll
    for (int i = 0; i < 2; ++i) { int R, C; stage_rc(tid * 16 + i * 8192, R, C); const int Rb = EpiT::PERM ? ((R & ~31) + perm32(R & 31)) : R;
        voffA[i] = (unsigned)(R * K + C) * 2u; voffB[i] = (unsigned)(Rb * K + C) * 2u; }
    const size_t kstep = (size_t)(BK * 2);
    const size_t hstep = (size_t)HALF * K * 2;
    const size_t tstep = 2 * hstep;
    const unsigned ldsw = (unsigned)wid * 1024u;
    const int aoff = lds_byte(wr * 64 + fr, fq * 8), boff = lds_byte(wc * 32 + fr, fq * 8);
#define PG8_SA(b, h) (((b) * 2 + (h)) * HTB)
#define PG8_SB(b, h) ((4 + (b) * 2 + (h)) * HTB)
#define PG8_STAGE(bufoff, gbase, voff) do { _Pragma("unroll") for (int _i = 0; _i < 2; ++_i) \
        __builtin_amdgcn_global_load_lds((const unsigned*)((const char*)(gbase) + (voff)[_i]), (LAS unsigned*)(lds + (bufoff) + ldsw + _i * 8192), 16, 0, 0); } while (0)
#define PG8_LDA(dst, b, h) do { _Pragma("unroll") for (int m = 0; m < 4; ++m) _Pragma("unroll") for (int k = 0; k < 2; ++k) dst[m][k] = *(const LAS bf16x8*)(lds + PG8_SA(b, h) + aoff + m * 2048 + k * 1024); } while (0)
#define PG8_LDB(dst, b, h) do { _Pragma("unroll") for (int n = 0; n < 2; ++n) _Pragma("unroll") for (int k = 0; k < 2; ++k) dst[n][k] = *(const LAS bf16x8*)(lds + PG8_SB(b, h) + boff + n * 2048 + k * 1024); } while (0)
#define PG8_MMA(ai, bj, At, Bt) do { __builtin_amdgcn_s_setprio(1); _Pragma("unroll") for (int m = 0; m < 4; ++m) _Pragma("unroll") for (int n = 0; n < 2; ++n) _Pragma("unroll") for (int k = 0; k < 2; ++k) \
        acc[ai][bj][m][n] = __builtin_amdgcn_mfma_f32_16x16x32_bf16(Bt[n][k], At[m][k], acc[ai][bj][m][n], 0, 0, 0); __builtin_amdgcn_s_setprio(0); } while (0)
#define PG8_WAIT_V(n) asm volatile("s_waitcnt vmcnt(" #n ")" ::: "memory")
#define PG8_WAIT_L(n) asm volatile("s_waitcnt lgkmcnt(" #n ")" ::: "memory")
#define PG8_BAR __builtin_amdgcn_s_barrier()
#define PG8_SCHED __builtin_amdgcn_sched_barrier(0)
    Unit cur, nxt; int ui = 0;
    if (!S.next(0, cur)) return;
    const bool tab = E.prefill(lds, S);
    if (tab) __syncthreads();
    f32x4 acc[2][2][4][2];
#pragma unroll
    for (int a = 0; a < 2; ++a)
#pragma unroll
        for (int b = 0; b < 2; ++b)
#pragma unroll
            for (int m = 0; m < 4; ++m)
#pragma unroll
                for (int n = 0; n < 2; ++n) acc[a][b][m][n] = (f32x4){0.f, 0.f, 0.f, 0.f};
    bf16x8 At[4][2], B0[2][2], B1[2][2];
    const char* cA = (const char*)g.A + (size_t)cur.pm * tstep; const char* cB = (const char*)g.Bt + (size_t)cur.pn * tstep;
    PG8_STAGE(PG8_SB(0, 0), cB, voffB); PG8_STAGE(PG8_SA(0, 0), cA, voffA); PG8_STAGE(PG8_SB(0, 1), cB + hstep, voffB); PG8_STAGE(PG8_SA(0, 1), cA + hstep, voffA);
    if (wr == 1) PG8_BAR;
    PG8_WAIT_V(4); PG8_BAR;
    PG8_STAGE(PG8_SB(1, 0), cB + kstep, voffB); PG8_STAGE(PG8_SA(1, 0), cA + kstep, voffA); PG8_STAGE(PG8_SB(1, 1), cB + hstep + kstep, voffB);
    PG8_WAIT_V(6); PG8_BAR;
    for (;;) {
        const bool has_next = S.next(ui + 1, nxt);
        const char* nA = has_next ? (const char*)g.A + (size_t)nxt.pm * tstep : cA; const char* nB = has_next ? (const char*)g.Bt + (size_t)nxt.pn * tstep : cB;
        for (int t = 0; t < nt; t += 2) {
            const bool last = (t == nt - 2);
            const char* a1 = cA + (size_t)(t + 1) * kstep;
            const char* a2 = last ? nA : cA + (size_t)(t + 2) * kstep; const char* b2 = last ? nB : cB + (size_t)(t + 2) * kstep;
            const char* a3 = a2 + kstep; const char* b3 = b2 + kstep;
            PG8_LDB(B0, 0, 0); PG8_SCHED; PG8_LDA(At, 0, 0); PG8_STAGE(PG8_SA(1, 1), a1 + hstep, voffA);
            PG8_WAIT_L(8); PG8_BAR; PG8_WAIT_L(0); PG8_MMA(0, 0, At, B0); PG8_BAR; PG8_SCHED;
            PG8_LDB(B1, 0, 1); PG8_STAGE(PG8_SB(0, 0), b2, voffB);
            PG8_BAR; PG8_WAIT_L(0); PG8_MMA(0, 1, At, B1); PG8_BAR;
            PG8_LDA(At, 0, 1); PG8_STAGE(PG8_SA(0, 0), a2, voffA);
            PG8_BAR; PG8_WAIT_L(0); PG8_MMA(1, 0, At, B0); PG8_BAR; PG8_SCHED;
            PG8_STAGE(PG8_SB(0, 1), b2 + hstep, voffB);
            PG8_WAIT_V(6); PG8_BAR; PG8_MMA(1, 1, At, B1); PG8_BAR;
            PG8_LDB(B0, 1, 0); PG8_SCHED; PG8_LDA(At, 1, 0); PG8_STAGE(PG8_SA(0, 1), a2 + hstep, voffA);
            PG8_WAIT_L(8); PG8_BAR; PG8_WAIT_L(0); PG8_MMA(0, 0, At, B0); PG8_BAR; PG8_SCHED;
            PG8_LDB(B1, 1, 1); PG8_STAGE(PG8_SB(1, 0), b3, voffB);
            PG8_BAR; PG8_WAIT_L(0); PG8_MMA(0, 1, At, B1); PG8_BAR;
            PG8_LDA(At, 1, 1); PG8_STAGE(PG8_SA(1, 0), a3, voffA);
            PG8_BAR; PG8_WAIT_L(0); PG8_MMA(1, 0, At, B0); PG8_BAR; PG8_SCHED;
            PG8_STAGE(PG8_SB(1, 1), b3 + hstep, voffB);
            PG8_WAIT_V(6); PG8_BAR; PG8_MMA(1, 1, At, B1); PG8_BAR;
        }
        if (E.mode != 8) E(acc, cur, ui, tab, lds, wr, wc, fr, fq);
        if (E.mode == 0) __builtin_amdgcn_s_waitcnt(0x0F70);
        if (!has_next) break;
#pragma unroll
        for (int a = 0; a < 2; ++a)
#pragma unroll
            for (int b = 0; b < 2; ++b)
#pragma unroll
                for (int m = 0; m < 4; ++m)
#pragma unroll
                    for (int n = 0; n < 2; ++n) acc[a][b][m][n] = (f32x4){0.f, 0.f, 0.f, 0.f};
        cur = nxt; cA = nA; cB = nB; ++ui;
    }
    PG8_WAIT_V(0);
    if (wr == 0) PG8_BAR;
    PG8_BAR;
    if (E.mode == 8) E.fused(acc, cur, wr, wc, fr, fq);
#undef PG8_SA
#undef PG8_SB
#undef PG8_STAGE
#undef PG8_LDA
#undef PG8_LDB
#undef PG8_MMA
#undef PG8_WAIT_V
#undef PG8_WAIT_L
#undef PG8_BAR
#undef PG8_SCHED
}
}

struct Params {
    const float *x, *mem, *norm_mix_g, *w_in, *lb_logits, *hgrn_norm_g, *w_pool, *pool_scale, *w_out, *norm_x_g, *norm_mem_g, *w_xq, *w_xk, *w_xv, *w_xo, *norm_ffn_g, *w_ff1, *w_ff2, *final_norm_g;
    float* out; unsigned char* ws;
    int ph_lo, ph_hi;
};

struct TD { const float* W; const float* g; bf16_t* out; int N, ldo, kt, nt; };
__device__ __forceinline__ TD tile_desc(const Params& p, int t) {
    unsigned char* ws = p.ws; TD d;
    if (t < 320)       { d.W = p.w_in;  d.g = p.norm_mix_g; d.out = (bf16_t*)(ws + WS_WT_IN);  d.N = NIN;  d.ldo = 1024; d.kt = t / 40; d.nt = t % 40; }
    else if (t < 448)  { const int u = t - 320;  d.W = p.w_xk;  d.g = p.norm_mem_g; d.out = (bf16_t*)(ws + WS_WT_K);   d.N = 1024; d.ldo = 1024; d.kt = u / 16; d.nt = u % 16; }
    else if (t < 576)  { const int u = t - 448;  d.W = p.w_xv;  d.g = p.norm_mem_g; d.out = (bf16_t*)(ws + WS_WT_V);   d.N = 1024; d.ldo = 1024; d.kt = u / 16; d.nt = u % 16; }
    else if (t < 704)  { const int u = t - 576;  d.W = p.w_xq;  d.g = p.norm_x_g;   d.out = (bf16_t*)(ws + WS_WT_Q);   d.N = 1024; d.ldo = 1024; d.kt = u / 16; d.nt = u % 16; }
    else if (t < 832)  { const int u = t - 704;  d.W = p.w_xo;  d.g = nullptr;      d.out = (bf16_t*)(ws + WS_WT_O);   d.N = 1024; d.ldo = 1024; d.kt = u / 16; d.nt = u % 16; }
    else if (t < 960)  { const int u = t - 832;  d.W = p.w_out; d.g = nullptr;      d.out = (bf16_t*)(ws + WS_WT_OUT); d.N = 1024; d.ldo = 1024; d.kt = u / 16; d.nt = u % 16; }
    else if (t < 1472) { const int u = t - 960;  d.W = p.w_ff1; d.g = p.norm_ffn_g; d.out = (bf16_t*)(ws + WS_WT_FF1); d.N = DFF;  d.ldo = 1024; d.kt = u / 64; d.nt = u % 64; }
    else if (t < 1984) { const int u = t - 1472; d.W = p.w_ff2; d.g = nullptr;      d.out = (bf16_t*)(ws + WS_WT_FF2); d.N = 1024; d.ldo = 4096; d.kt = u / 16; d.nt = u % 16; }
    else if (t < 2112) { const int u = t - 1984; d.W = p.w_in;  d.g = p.norm_mix_g; d.out = (bf16_t*)(ws + WS_WT_IN);  d.N = NIN;  d.ldo = 1024; d.kt = u / 16; d.nt = 8 + u % 16; }
    else               { const int u = t - 2112, j = u % 24; d.W = p.w_in; d.g = p.norm_mix_g; d.out = (bf16_t*)(ws + WS_WT_IN); d.N = NIN; d.ldo = 1024; d.kt = u / 24; d.nt = j < 8 ? j : 16 + j; }
    return d;
}
__device__ __forceinline__ void tile_load(const TD& d, f32x4 (&v)[4], float (&sc)[4]) {
    const int tid = threadIdx.x, r = tid >> 4, c4 = tid & 15;
#pragma unroll
    for (int i = 0; i < 4; ++i) { const int k = 128 * d.kt + r + 32 * i; v[i] = __builtin_nontemporal_load((const f32x4*)(d.W + (size_t)k * d.N + 64 * d.nt + 4 * c4)); sc[i] = d.g ? d.g[k] : 1.0f; }
}
__device__ __forceinline__ void transpose_range(const Params& p, unsigned char* lds, int t_begin, int t_end, int first, int stride) {
    bf16_t* T0 = (bf16_t*)lds;
    bf16_t* T1 = (bf16_t*)(lds + 17408);
    const int tid = threadIdx.x, r = tid >> 4, c4 = tid & 15, n = tid >> 3, ks = tid & 7;
    int ta = t_begin + first;
    if (ta >= t_end) return;
    int tb = ta + stride; bool hb = tb < t_end;
    TD da = tile_desc(p, ta), db = da; f32x4 va[4], vb[4]; float sa[4], sb[4];
    tile_load(da, va, sa);
    if (hb) { db = tile_desc(p, tb); tile_load(db, vb, sb); }
    for (;;) {
#pragma unroll
        for (int i = 0; i < 4; ++i) { const int kl = r + 32 * i;
            T0[(4 * c4 + 0) * 136 + kl] = f2bf(va[i][0] * sa[i]); T0[(4 * c4 + 1) * 136 + kl] = f2bf(va[i][1] * sa[i]);
            T0[(4 * c4 + 2) * 136 + kl] = f2bf(va[i][2] * sa[i]); T0[(4 * c4 + 3) * 136 + kl] = f2bf(va[i][3] * sa[i]); }
        if (hb) {
#pragma unroll
            for (int i = 0; i < 4; ++i) { const int kl = r + 32 * i;
                T1[(4 * c4 + 0) * 136 + kl] = f2bf(vb[i][0] * sb[i]); T1[(4 * c4 + 1) * 136 + kl] = f2bf(vb[i][1] * sb[i]);
                T1[(4 * c4 + 2) * 136 + kl] = f2bf(vb[i][2] * sb[i]); T1[(4 * c4 + 3) * 136 + kl] = f2bf(vb[i][3] * sb[i]); } }
        __syncthreads();
        const int tna = ta + 2 * stride, tnb = tna + stride; const bool hna = tna < t_end, hnb = tnb < t_end;
        const TD ca = da, cb = db; const bool chb = hb;
        if (hna) { da = tile_desc(p, tna); tile_load(da, va, sa); }
        if (hnb) { db = tile_desc(p, tnb); tile_load(db, vb, sb); }
        { const u32x4* src = (const u32x4*)(T0 + n * 136 + 16 * ks); const u32x4 a = src[0], b = src[1];
          u32x4* dst = (u32x4*)(ca.out + (size_t)(64 * ca.nt + n) * ca.ldo + 128 * ca.kt + 16 * ks); dst[0] = a; dst[1] = b; }
        if (chb) { const u32x4* src = (const u32x4*)(T1 + n * 136 + 16 * ks); const u32x4 a = src[0], b = src[1];
          u32x4* dst = (u32x4*)(cb.out + (size_t)(64 * cb.nt + n) * cb.ldo + 128 * cb.kt + 16 * ks); dst[0] = a; dst[1] = b; }
        __syncthreads();
        if (!hna) break;
        ta = tna; hb = hnb;
    }
}
__device__ __forceinline__ void phase_prep(const Params p, unsigned char* lds, bool shadow) {
    unsigned char* ws = p.ws;
    const int G = gridDim.x;
    {
        const int lane = threadIdx.x & 63, gw = blockIdx.x * (NTHREADS / 64) + (threadIdx.x >> 6), nw = G * (NTHREADS / 64);
        int r = gw;
        f32x4 v[4], vn[4];
        if (r < MROWS + MEMROWS) { const float* src = r < MROWS ? p.x + (size_t)r * DM : p.mem + (size_t)(r - MROWS) * DM;
#pragma unroll
            for (int i = 0; i < 4; ++i) v[i] = __builtin_nontemporal_load((const f32x4*)src + lane + 64 * i); }
        for (; r < MROWS + MEMROWS; r += nw) {
            const int rn = r + nw;
            if (rn < MROWS + MEMROWS) { const float* src = rn < MROWS ? p.x + (size_t)rn * DM : p.mem + (size_t)(rn - MROWS) * DM;
#pragma unroll
                for (int i = 0; i < 4; ++i) vn[i] = __builtin_nontemporal_load((const f32x4*)src + lane + 64 * i); }
            const bool isx = r < MROWS;
            bf16_t* dst = isx ? (bf16_t*)(ws + WS_XB) + (size_t)r * DM : (bf16_t*)(ws + WS_MEMB) + (size_t)(r - MROWS) * DM;
            float ss = 0.f;
#pragma unroll
            for (int i = 0; i < 4; ++i) ss += (v[i][0] * v[i][0] + v[i][1] * v[i][1]) + (v[i][2] * v[i][2] + v[i][3] * v[i][3]);
#pragma unroll
            for (int o = 1; o < 64; o <<= 1) ss += __shfl_xor(ss, o);
#pragma unroll
            for (int i = 0; i < 4; ++i) { u32x2 w; w.x = cvt_pk_bf16(v[i][0], v[i][1]); w.y = cvt_pk_bf16(v[i][2], v[i][3]); ((u32x2*)dst)[lane + 64 * i] = w; }
            if (lane == 0) { const float rstd = rsqrtf(ss * (1.0f / 1024.0f) + EPS); if (isx) ((float*)(ws + WS_RSTD0))[r] = rstd; else ((float*)(ws + WS_RSTDM))[r - MROWS] = rstd; }
#pragma unroll
            for (int i = 0; i < 4; ++i) v[i] = vn[i];
        }
    }
    if (shadow) transpose_range(p, lds, 1984, 2112, blockIdx.x, G);
    else transpose_range(p, lds, 0, 576, blockIdx.x, G);
}
__device__ __forceinline__ void deferred_prep(const Params p, unsigned char* lds, int j, int nworkers) {
    transpose_range(p, lds, 576, 1984, j, nworkers);
}
__device__ __forceinline__ void fold_pool_weights_mfma(const Params& p) {
    bf16_t* wto = (bf16_t*)(p.ws + WS_WT_OUT);
    const int tid = threadIdx.x, w = tid >> 6, lane = tid & 63, fr = lane & 15, q = lane >> 4;
    for (int item = blockIdx.x; item < 256; item += gridDim.x) {
        const int gi = item >> 6, nb = item & 63;
        f32x4 acc = (f32x4){0.f, 0.f, 0.f, 0.f};
        const float* wp = p.w_pool + (size_t)(gi * 128 + 16 * w + fr) * 128;
        const float* ps = p.pool_scale + gi * 128;
        const bf16_t* arow = wto + (size_t)(16 * nb + fr) * 1024 + 512 + gi * 128;
#pragma unroll
        for (int ks = 0; ks < 4; ++ks) {
            const int d0 = 32 * ks + 8 * q;
            const f32x4 w0 = *(const f32x4*)(wp + d0), w1 = *(const f32x4*)(wp + d0 + 4), s0 = *(const f32x4*)(ps + d0), s1 = *(const f32x4*)(ps + d0 + 4);
            const bf16x8 cfr = mk8u(cvt_pk_bf16(w0[0] * s0[0], w0[1] * s0[1]), cvt_pk_bf16(w0[2] * s0[2], w0[3] * s0[3]), cvt_pk_bf16(w1[0] * s1[0], w1[1] * s1[1]), cvt_pk_bf16(w1[2] * s1[2], w1[3] * s1[3]));
            const bf16x8 nfr = *(const bf16x8*)(arow + d0);
            acc = mfma16(cfr, nfr, acc);
        }
        asm volatile("s_waitcnt vmcnt(0)" ::: "memory");
        __syncthreads();
        u32x2 o; o.x = cvt_pk_bf16(acc[0], acc[1]); o.y = cvt_pk_bf16(acc[2], acc[3]);
        *(u32x2*)(wto + (size_t)(16 * nb + fr) * 1024 + 512 + gi * 128 + 16 * w + 4 * q) = o;
        __syncthreads();
    }
}

__device__ __forceinline__ void phase_passA(const bf16_t* __restrict__ KH, const float* __restrict__ LF, const bf16_t* __restrict__ VH, bf16_t* __restrict__ LT, float* __restrict__ DEC, unsigned char* lds, int first, int stride, int ubeg, int uend) {
    const int tid = threadIdx.x, ch = tid & 127, seg = tid >> 7;
    float* segtot = (float*)lds;
    unsigned char* KdT = lds + 2048;
    unsigned char* VTl = lds + 2048 + 18432;
    const int w = tid >> 6, lane = tid & 63, fr = lane & 15, q = lane >> 4;
    float lf[16], kk[16]; unsigned vr[16];
    int unit = ubeg + first;
    if (unit < uend) { const int b = unit >> 8, c = (unit >> 2) & 63, h = unit & 3; const size_t g0 = (size_t)(b * SEQ + c * 64 + seg * 16) * 512 + h * 128 + ch;
#pragma unroll
        for (int i = 0; i < 16; ++i) { lf[i] = LF[g0 + (size_t)i * 512]; vr[i] = VH[g0 + (size_t)i * 512]; } }
    for (; unit < uend; unit += stride) {
        const int b = unit >> 8, c = (unit >> 2) & 63, h = unit & 3, bh = b * 4 + h;
#pragma unroll
        for (int i = 0; i < 16; ++i) kk[i] = 1.0f - __expf(lf[i]);
#pragma unroll
        for (int i = 1; i < 16; ++i) lf[i] += lf[i - 1];
        segtot[seg * 128 + ch] = lf[15];
        __syncthreads();
        float after = 0.f;
#pragma unroll
        for (int s2 = 1; s2 < 4; ++s2) if (s2 > seg) after += segtot[s2 * 128 + ch];
        const float tot = after + lf[15];
        if (seg == 0) DEC[(size_t)(bh * 64 + c) * 128 + ch] = __expf(tot);
        unsigned kd[8], vp[8];
#pragma unroll
        for (int i = 0; i < 8; ++i) {
            kd[i] = cvt_pk_bf16(kk[2 * i] * __expf(tot - lf[2 * i]), kk[2 * i + 1] * __expf(tot - lf[2 * i + 1]));
            vp[i] = vr[2 * i] | (vr[2 * i + 1] << 16);
        }
        { u32x4* d = (u32x4*)(KdT + ch * 144 + seg * 32); d[0] = (u32x4){kd[0], kd[1], kd[2], kd[3]}; d[1] = (u32x4){kd[4], kd[5], kd[6], kd[7]}; }
        { u32x4* d = (u32x4*)(VTl + ch * 144 + seg * 32); d[0] = (u32x4){vp[0], vp[1], vp[2], vp[3]}; d[1] = (u32x4){vp[4], vp[5], vp[6], vp[7]}; }
        __syncthreads();
        {
            const int un = unit + stride;
            if (un < uend) { const int b2 = un >> 8, c2 = (un >> 2) & 63, h2 = un & 3; const size_t g0 = (size_t)(b2 * SEQ + c2 * 64 + seg * 16) * 512 + h2 * 128 + ch;
#pragma unroll
                for (int i = 0; i < 16; ++i) { lf[i] = LF[g0 + (size_t)i * 512]; vr[i] = VH[g0 + (size_t)i * 512]; } }
        }
        bf16x8 a[2];
#pragma unroll
        for (int ks = 0; ks < 2; ++ks) a[ks] = *(const bf16x8*)(KdT + (16 * w + fr) * 144 + (32 * ks + 8 * q) * 2);
        bf16_t* ltp = LT + (size_t)(bh * 64 + c) * 16384;
#pragma unroll
        for (int vb = 0; vb < 8; ++vb) {
            f32x4 acc = (f32x4){0.f, 0.f, 0.f, 0.f};
#pragma unroll
            for (int ks = 0; ks < 2; ++ks) { const bf16x8 bfr = *(const bf16x8*)(VTl + (16 * vb + fr) * 144 + (32 * ks + 8 * q) * 2); acc = mfma16(a[ks], bfr, acc); }
            u32x2 pk; pk.x = cvt_pk_bf16(acc[0], acc[1]); pk.y = cvt_pk_bf16(acc[2], acc[3]);
            *(u32x2*)(ltp + (size_t)(16 * vb + fr) * 128 + 16 * w + 4 * q) = pk;
        }
        __syncthreads();
    }
}

template <int W>
__device__ __forceinline__ void pool_body(const bf16_t* __restrict__ PH, bf16_t* __restrict__ MIXED, int r0, int s0, int c0) {
    unsigned v[31 + W];
#pragma unroll
    for (int j = 1; j < W; ++j) v[W - 1 - j] = (s0 - j >= 0) ? *(const unsigned*)(PH + (size_t)(r0 - j) * 512 + c0) : 0u;
#pragma unroll
    for (int tt = 0; tt < 32; ++tt) v[W - 1 + tt] = *(const unsigned*)(PH + (size_t)(r0 + tt) * 512 + c0);
    float sx = 0.f, sy = 0.f;
#pragma unroll
    for (int j = 1; j < W; ++j) { sx += bflo(v[W - 1 - j]); sy += bfhi(v[W - 1 - j]); }
#pragma unroll
    for (int tt = 0; tt < 32; ++tt) {
        const int s = s0 + tt;
        const float px = bflo(v[W - 1 + tt]), py = bfhi(v[W - 1 + tt]);
        sx += px; sy += py;
        const int cnt = (s + 1) < W ? (s + 1) : W;
        const float inv = __builtin_amdgcn_rcpf((float)cnt);
        *(unsigned*)(MIXED + (size_t)(r0 + tt) * 1024 + 512 + c0) = cvt_pk_bf16(sx * inv - px, sy * inv - py);
        sx -= bflo(v[tt]); sy -= bfhi(v[tt]);
    }
}
__device__ __forceinline__ void pool_tile(const bf16_t* __restrict__ PH, bf16_t* __restrict__ MIXED, int tile) {
    const int tid = threadIdx.x, cp = tid & 255, th = tid >> 8, c0 = 2 * cp, gi = c0 >> 7;
    const int r0 = tile * 64 + th * 32, s0 = r0 & (SEQ - 1);
    if (gi == 0) pool_body<2>(PH, MIXED, r0, s0, c0);
    else if (gi == 1) pool_body<4>(PH, MIXED, r0, s0, c0);
    else if (gi == 2) pool_body<8>(PH, MIXED, r0, s0, c0);
    else pool_body<16>(PH, MIXED, r0, s0, c0);
}

__device__ __forceinline__ void phase_scan(const bf16_t* LT, const float* __restrict__ DEC, bf16_t* ST) {
    for (int e2 = blockIdx.x * NTHREADS + threadIdx.x; e2 < 131072; e2 += gridDim.x * NTHREADS) {
        const int bh = e2 >> 13, v = (e2 >> 6) & 127, kp = e2 & 63;
        float sx = 0.f, sy = 0.f;
        const size_t base = (size_t)bh * 64 * 16384 + (size_t)v * 128 + 2 * kp;
        const float* dp = DEC + (size_t)bh * 64 * 128 + 2 * kp;
        for (int c0 = 0; c0 < 64; c0 += 32) {
            unsigned l[32]; f32x2 d[32];
#pragma unroll
            for (int j = 0; j < 32; ++j) { l[j] = *(const unsigned*)(LT + base + (size_t)(c0 + j) * 16384); d[j] = *(const f32x2*)(dp + (c0 + j) * 128); }
#pragma unroll
            for (int j = 0; j < 32; ++j) {
                *(unsigned*)(ST + base + (size_t)(c0 + j) * 16384) = cvt_pk_bf16(sx, sy);
                sx = d[j][0] * sx + bflo(l[j]); sy = d[j][1] * sy + bfhi(l[j]);
            }
        }
    }
}

__device__ __forceinline__ void phase_passC(const bf16_t* __restrict__ QH, const bf16_t* __restrict__ KH, const float* __restrict__ LF, const bf16_t* __restrict__ VH, const bf16_t* __restrict__ GH,
                                const bf16_t* __restrict__ ST, const float* __restrict__ hg, bf16_t* __restrict__ MIXED, unsigned char* lds) {
    const int tid = threadIdx.x, ch = tid & 127, seg = tid >> 7, G = gridDim.x;
    float lf[16], kk[16]; unsigned qr[16], vr[16];
    int unit = blockIdx.x;
    if (unit < 1024) { const int b = unit >> 8, c = (unit >> 2) & 63, h = unit & 3; const size_t g0 = (size_t)(b * SEQ + c * 64 + seg * 16) * 512 + h * 128 + ch;
#pragma unroll
        for (int i = 0; i < 16; ++i) { lf[i] = LF[g0 + (size_t)i * 512]; vr[i] = VH[g0 + (size_t)i * 512]; qr[i] = QH[g0 + (size_t)i * 512]; } }
  for (; unit < 1024; unit += G) {
    const int b = unit >> 8, c = (unit >> 2) & 63, h = unit & 3;
    const int row0 = b * SEQ + c * 64, bh = b * 4 + h;
    float* segtot = (float*)lds;
    float* rmsp = (float*)(lds + 2048);
    bf16_t* QC = (bf16_t*)(lds + 4096);
    bf16_t* QT = (bf16_t*)(lds + 21504);
    constexpr int KT0 = 38912;
    unsigned char* VTl = lds + 82432;
    const int w = tid >> 6, lane = tid & 63, fr = lane & 15, q = lane >> 4;
    const int i = w & 3, vh = w >> 2;
    const size_t row = (size_t)(row0 + 16 * i + fr);
    u32x2 gt[4]; f32x4 gg[4]; bf16x8 stf[4][4];
    {
        const bf16_t* stp = ST + (size_t)(bh * 64 + c) * 16384;
#pragma unroll
        for (int vbl = 0; vbl < 4; ++vbl) { const int v0 = 16 * (vh * 4 + vbl) + 4 * q; gt[vbl] = *(const u32x2*)(GH + row * 512 + h * 128 + v0); gg[vbl] = *(const f32x4*)(hg + h * 128 + v0);
#pragma unroll
            for (int ks = 0; ks < 4; ++ks) stf[ks][vbl] = *(const bf16x8*)(stp + (size_t)(16 * (vh * 4 + vbl) + fr) * 128 + 32 * ks + 8 * q); }
    }
#pragma unroll
    for (int i2 = 0; i2 < 16; ++i2) kk[i2] = 1.0f - __expf(lf[i2]);
#pragma unroll
    for (int i2 = 1; i2 < 16; ++i2) lf[i2] += lf[i2 - 1];
    segtot[seg * 128 + ch] = lf[15];
    {
        unsigned vp[8];
#pragma unroll
        for (int i2 = 0; i2 < 8; ++i2) vp[i2] = vr[2 * i2] | (vr[2 * i2 + 1] << 16);
        u32x4* d = (u32x4*)(VTl + ch * 144 + seg * 32); d[0] = (u32x4){vp[0], vp[1], vp[2], vp[3]}; d[1] = (u32x4){vp[4], vp[5], vp[6], vp[7]};
    }
    __syncthreads();
    const float t0 = segtot[ch], t1 = segtot[128 + ch], t2 = segtot[256 + ch];
    const float P = (seg > 0 ? t0 : 0.f) + (seg > 1 ? t1 : 0.f) + (seg > 2 ? t2 : 0.f);
    {
        const float eP = __expf(P);
#pragma unroll
        for (int i2 = 0; i2 < 16; ++i2) {
            const float qv = bflo(qr[i2]);
            const float el = __expf(lf[i2]);
            QT[(seg * 16 + i2) * 136 + ch] = f2bf(qv * el);
            QC[(seg * 16 + i2) * 136 + ch] = f2bf(qv * el * eP);
        }
        float E = 0.f;
#pragma unroll
        for (int i2 = 0; i2 < 4; ++i2) {
            if (i2 >= seg) {
                bf16_t* KT = (bf16_t*)(lds + KT0 + 4352 * ((i2 * (i2 + 1)) / 2));
#pragma unroll
                for (int j = 0; j < 16; ++j) KT[(seg * 16 + j) * 136 + ch] = f2bf(kk[j] * __expf(E - lf[j]));
                E += (i2 == 0 ? t0 : (i2 == 1 ? t1 : t2));
            }
        }
    }
    __syncthreads();
    {
        const int un = unit + G;
        if (un < 1024) { const int b2 = un >> 8, c2 = (un >> 2) & 63, h2 = un & 3; const size_t g2 = (size_t)(b2 * SEQ + c2 * 64 + seg * 16) * 512 + h2 * 128 + ch;
#pragma unroll
            for (int i2 = 0; i2 < 16; ++i2) { lf[i2] = LF[g2 + (size_t)i2 * 512]; vr[i2] = VH[g2 + (size_t)i2 * 512]; qr[i2] = QH[g2 + (size_t)i2 * 512]; } }
    }
    f32x4 sT[4];
#pragma unroll
    for (int j = 0; j < 4; ++j) sT[j] = (f32x4){0.f, 0.f, 0.f, 0.f};
    {
        bf16x8 qfr[4];
#pragma unroll
        for (int ks = 0; ks < 4; ++ks) qfr[ks] = *(const bf16x8*)((const unsigned char*)QT + (16 * i + fr) * 272 + (32 * ks + 8 * q) * 2);
        const unsigned char* KT = lds + KT0 + 4352 * ((i * (i + 1)) / 2);
#pragma unroll
        for (int j = 0; j < 4; ++j) if (j <= i) {
#pragma unroll
            for (int ks = 0; ks < 4; ++ks) { const bf16x8 a = *(const bf16x8*)(KT + (16 * j + fr) * 272 + (32 * ks + 8 * q) * 2); sT[j] = mfma16(a, qfr[ks], sT[j]); }
            if (j == i) {
#pragma unroll
                for (int rg = 0; rg < 4; ++rg) if (4 * q + rg > fr) sT[j][rg] = 0.f;
            }
        }
    }
    f32x4 oacc[4];
#pragma unroll
    for (int vbl = 0; vbl < 4; ++vbl) oacc[vbl] = (f32x4){0.f, 0.f, 0.f, 0.f};
#pragma unroll
    for (int m = 0; m < 2; ++m) if (2 * m <= i) {
        const bf16x8 bfrag = mk8u(cvt_pk_bf16(sT[2 * m][0], sT[2 * m][1]), cvt_pk_bf16(sT[2 * m][2], sT[2 * m][3]), cvt_pk_bf16(sT[2 * m + 1][0], sT[2 * m + 1][1]), cvt_pk_bf16(sT[2 * m + 1][2], sT[2 * m + 1][3]));
#pragma unroll
        for (int vbl = 0; vbl < 4; ++vbl) {
            const unsigned char* base = VTl + (16 * (vh * 4 + vbl) + fr) * 144 + (32 * m + 4 * q) * 2;
            const bf16x8 a = mk8(*(const u32x2*)base, *(const u32x2*)(base + 32));
            oacc[vbl] = mfma16(a, bfrag, oacc[vbl]);
        }
    }
    {
#pragma unroll
        for (int ks = 0; ks < 4; ++ks) {
            const bf16x8 bfr = *(const bf16x8*)((const unsigned char*)QC + (16 * i + fr) * 272 + (32 * ks + 8 * q) * 2);
#pragma unroll
            for (int vbl = 0; vbl < 4; ++vbl) oacc[vbl] = mfma16(stf[ks][vbl], bfr, oacc[vbl]);
        }
    }
    float ss = 0.f;
#pragma unroll
    for (int vbl = 0; vbl < 4; ++vbl) ss += (oacc[vbl][0] * oacc[vbl][0] + oacc[vbl][1] * oacc[vbl][1]) + (oacc[vbl][2] * oacc[vbl][2] + oacc[vbl][3] * oacc[vbl][3]);
    ss += __shfl_xor(ss, 16); ss += __shfl_xor(ss, 32);
    if (q == 0) rmsp[vh * 64 + 16 * i + fr] = ss;
    __syncthreads();
    const float rstd = rsqrtf((rmsp[16 * i + fr] + rmsp[64 + 16 * i + fr]) * (1.0f / 128.0f) + EPS);
#pragma unroll
    for (int vbl = 0; vbl < 4; ++vbl) {
        const int v0 = 16 * (vh * 4 + vbl) + 4 * q;
        u32x2 o;
        o.x = cvt_pk_bf16(oacc[vbl][0] * rstd * gg[vbl][0] * bflo(gt[vbl].x), oacc[vbl][1] * rstd * gg[vbl][1] * bfhi(gt[vbl].x));
        o.y = cvt_pk_bf16(oacc[vbl][2] * rstd * gg[vbl][2] * bflo(gt[vbl].y), oacc[vbl][3] * rstd * gg[vbl][3] * bfhi(gt[vbl].y));
        *(u32x2*)(MIXED + row * 1024 + h * 128 + v0) = o;
    }
    __syncthreads();
  }
}

__device__ __forceinline__ void attn_unit(const bf16_t* __restrict__ XQ, const bf16_t* __restrict__ KX, const bf16_t* __restrict__ VT, bf16_t* __restrict__ ATT, int unit, unsigned char* lds) {
    const int tid = threadIdx.x, w = tid >> 6, lane = tid & 63, r = lane & 31, hh = lane >> 5;
    const int b = unit >> 6, st = (unit >> 2) & 15, h = unit & 3;
    const int row0 = b * SEQ + st * 256;
    const bf16_t* qp = XQ + (size_t)(row0 + 32 * w + r) * 1024 + h * 256 + 8 * hh;
    {
        const bf16_t* kp = KX + (size_t)(b * 256) * 1024 + h * 256;
        u32x4 kv[16];
#pragma unroll
        for (int it = 0; it < 16; ++it) { const int idx = tid + 512 * it, m = idx >> 5, cc = idx & 31; kv[it] = *(const u32x4*)(kp + (size_t)m * 1024 + cc * 8); }
#pragma unroll
        for (int it = 0; it < 16; ++it) { const int idx = tid + 512 * it, m = idx >> 5, cc = idx & 31; *(u32x4*)(lds + m * 528 + cc * 16) = kv[it]; }
    }
    __syncthreads();
    f32x16 sacc[8];
#pragma unroll
    for (int mb = 0; mb < 8; ++mb)
#pragma unroll
        for (int e = 0; e < 16; ++e) sacc[mb][e] = 0.f;
    {
        bf16x8 qf[4], qn[4];
#pragma unroll
        for (int k4 = 0; k4 < 4; ++k4) qf[k4] = *(const bf16x8*)(qp + 16 * k4);
#pragma unroll
        for (int kg = 0; kg < 4; ++kg) {
            if (kg < 3) {
#pragma unroll
                for (int k4 = 0; k4 < 4; ++k4) qn[k4] = *(const bf16x8*)(qp + 16 * (4 * (kg + 1) + k4)); }
#pragma unroll
            for (int k4 = 0; k4 < 4; ++k4)
#pragma unroll
                for (int mb = 0; mb < 8; ++mb) { const bf16x8 a = *(const bf16x8*)(lds + (32 * mb + r) * 528 + (16 * (4 * kg + k4) + 8 * hh) * 2); sacc[mb] = mfma32(a, qf[k4], sacc[mb]); }
#pragma unroll
            for (int k4 = 0; k4 < 4; ++k4) qf[k4] = qn[k4];
        }
    }
    float mx = -3.0e38f;
#pragma unroll
    for (int mb = 0; mb < 8; ++mb)
#pragma unroll
        for (int e = 0; e < 16; ++e) mx = fmaxf(mx, sacc[mb][e]);
    mx = fmaxf(mx, __shfl_xor(mx, 32));
    float sum = 0.f;
    bf16x8 pf[8][2];
#pragma unroll
    for (int mb = 0; mb < 8; ++mb) {
        float pv[16];
#pragma unroll
        for (int e = 0; e < 16; ++e) { pv[e] = __expf(sacc[mb][e] - mx); sum += pv[e]; }
#pragma unroll
        for (int s = 0; s < 2; ++s) pf[mb][s] = mk8u(cvt_pk_bf16(pv[8 * s + 0], pv[8 * s + 1]), cvt_pk_bf16(pv[8 * s + 2], pv[8 * s + 3]), cvt_pk_bf16(pv[8 * s + 4], pv[8 * s + 5]), cvt_pk_bf16(pv[8 * s + 6], pv[8 * s + 7]));
    }
    sum += __shfl_xor(sum, 32);
    const float inv = 1.0f / sum;
    __syncthreads();
    {
        const bf16_t* vp = VT + (size_t)(h * 256) * 1024 + b * 256;
        u32x4 vv[16];
#pragma unroll
        for (int it = 0; it < 16; ++it) { const int idx = tid + 512 * it, e = idx >> 5, cc = idx & 31; vv[it] = *(const u32x4*)(vp + (size_t)e * 1024 + cc * 8); }
#pragma unroll
        for (int it = 0; it < 16; ++it) { const int idx = tid + 512 * it, e = idx >> 5, cc = idx & 31;
            u32x2* d = (u32x2*)(lds + e * 520 + cc * 16); d[0] = (u32x2){vv[it].x, vv[it].y}; d[1] = (u32x2){vv[it].z, vv[it].w}; }
    }
    __syncthreads();
    bf16_t* op = ATT + (size_t)(row0 + 32 * w + r) * 1024 + h * 256 + 8 * hh;
#pragma unroll
    for (int half = 0; half < 2; ++half) {
        f32x16 oacc[4];
#pragma unroll
        for (int d = 0; d < 4; ++d)
#pragma unroll
            for (int e = 0; e < 16; ++e) oacc[d][e] = 0.f;
#pragma unroll
        for (int mb = 0; mb < 8; ++mb)
#pragma unroll
            for (int s = 0; s < 2; ++s)
#pragma unroll
                for (int d = 0; d < 4; ++d) {
                    const unsigned char* base = lds + (32 * (half * 4 + d) + r) * 520 + (32 * mb + 16 * s + 4 * hh) * 2;
                    const bf16x8 a = mk8(*(const u32x2*)base, *(const u32x2*)(base + 16));
                    oacc[d] = mfma32(a, pf[mb][s], oacc[d]);
                }
#pragma unroll
        for (int d = 0; d < 4; ++d)
#pragma unroll
            for (int pp = 0; pp < 2; ++pp) {
                unsigned ax = cvt_pk_bf16(oacc[d][8 * pp] * inv, oacc[d][8 * pp + 1] * inv), ay = cvt_pk_bf16(oacc[d][8 * pp + 2] * inv, oacc[d][8 * pp + 3] * inv);
                unsigned bx = cvt_pk_bf16(oacc[d][8 * pp + 4] * inv, oacc[d][8 * pp + 5] * inv), by = cvt_pk_bf16(oacc[d][8 * pp + 6] * inv, oacc[d][8 * pp + 7] * inv);
                { auto t = __builtin_amdgcn_permlane32_swap(ax, bx, false, false); ax = t[0]; bx = t[1]; }
                { auto t = __builtin_amdgcn_permlane32_swap(ay, by, false, false); ay = t[0]; by = t[1]; }
                u32x4 o; o.x = ax; o.y = ay; o.z = bx; o.w = by;
                *(u32x4*)(op + 32 * (half * 4 + d) + 16 * pp) = o;
            }
    }
    __syncthreads();
}

__device__ __forceinline__ void phase_final(const bf16_t* __restrict__ xb, const float* __restrict__ ssq, float* __restrict__ out, const float* __restrict__ g) {
    const int tid = threadIdx.x, sub = tid >> 7, l = tid & 127;
    const f32x4 g0 = *(const f32x4*)(g + 8 * l), g1 = *(const f32x4*)(g + 8 * l + 4);
    for (int r = blockIdx.x * 4 + sub; r < MROWS; r += gridDim.x * 4) {
        const u32x4 v = *(const u32x4*)(xb + (size_t)r * DM + 8 * l);
        const f32x4* pp = (const f32x4*)(ssq + (size_t)r * 16); const f32x4 a = pp[0], b = pp[1], c = pp[2], d = pp[3];
        const float t = ((a[0] + a[1]) + (a[2] + a[3])) + ((b[0] + b[1]) + (b[2] + b[3])) + ((c[0] + c[1]) + (c[2] + c[3])) + ((d[0] + d[1]) + (d[2] + d[3]));
        const float rstd = rsqrtf(t * (1.0f / 1024.0f) + EPS);
        const f32x4 o0 = (f32x4){bflo(v.x), bfhi(v.x), bflo(v.y), bfhi(v.y)} * rstd * g0, o1 = (f32x4){bflo(v.z), bfhi(v.z), bflo(v.w), bfhi(v.w)} * rstd * g1;
        *(f32x4*)(out + (size_t)r * DM + 8 * l) = o0; *(f32x4*)(out + (size_t)r * DM + 8 * l + 4) = o1;
    }
}

#define XB_TMO      128
#define XB_XCNT(j)  (256  + 64 * (j))
#define XB_XSUB(j)  (1280 + 64 * (j))
#define XB_XGEN(j)  (2304 + 64 * (j))
#define XB_TOP      3328
#define XB_TOPGEN   3392
#define XCD_BAR_WORDS 3456
#define XB_SPIN_CAP (1u << 22)
__device__ __forceinline__ unsigned xb_ld(unsigned* p)              { return __hip_atomic_load(p, __ATOMIC_RELAXED, __HIP_MEMORY_SCOPE_AGENT); }
__device__ __forceinline__ unsigned xb_add(unsigned* p, unsigned v) { return __hip_atomic_fetch_add(p, v, __ATOMIC_RELAXED, __HIP_MEMORY_SCOPE_AGENT); }
__device__ __forceinline__ unsigned xb_xcc_id() { return (unsigned)__builtin_amdgcn_s_getreg((3 << 11) | 20) & 0xFu; }
#define XB_SPIN(cond, bar) do { unsigned _sp = 0; while (cond) { __builtin_amdgcn_s_sleep(1); \
    if ((++_sp & 255u) == 0u) { if (xb_ld(&(bar)[XB_TMO])) break; if (_sp > XB_SPIN_CAP) { atomicAdd(&(bar)[XB_TMO], 1u); break; } } } } while (0)
struct XcdBarrier { unsigned* bar; unsigned x; volatile LAS unsigned* st; };
__device__ __forceinline__ XcdBarrier xcd_barrier_post(unsigned* bar, volatile LAS unsigned* st) {
    XcdBarrier b; b.bar = bar; b.x = xb_xcc_id(); b.st = st;
    if (threadIdx.x == 0) (void)xb_add(&bar[XB_XCNT(b.x)], 1u);
    return b;
}
__device__ __forceinline__ void xcd_barrier_complete(unsigned* bar, unsigned x, unsigned& nloc, unsigned& nx) {
    const unsigned G = gridDim.x * gridDim.y * gridDim.z;
    unsigned sum, cnt, mine, sp = 0u;
    for (;;) {
        sum = 0u; cnt = 0u; mine = 0u;
#pragma unroll
        for (unsigned j = 0; j < 16; ++j) { const unsigned c = xb_ld(&bar[XB_XCNT(j)]); sum += c; cnt += (c > 0u) ? 1u : 0u; mine = (j == x) ? c : mine; }
        if (sum == G) break;
        __builtin_amdgcn_s_sleep(1);
        if ((++sp & 255u) == 0u) { if (xb_ld(&bar[XB_TMO])) break; if (sp > XB_SPIN_CAP) { atomicAdd(&bar[XB_TMO], 1u); break; } }
    }
    nloc = mine > 0u ? mine : 1u; nx = cnt > 0u ? cnt : 1u;
}
__device__ __forceinline__ void xcd_barrier(const XcdBarrier& b) {
    asm volatile("s_waitcnt vmcnt(0)" ::: "memory");
    __syncthreads();
    if (threadIdx.x == 0) {
        unsigned* bar = b.bar;
        __builtin_amdgcn_s_waitcnt(0);
        unsigned nloc = b.st[0], nx = b.st[1];
        if (nloc == 0u) { xcd_barrier_complete(bar, b.x, nloc, nx); b.st[0] = nloc; b.st[1] = nx; }
        const unsigned old = xb_add(&bar[XB_XSUB(b.x)], 1u);
        const unsigned gen = old / nloc;
        if (old + 1u == (gen + 1u) * nloc) {
            __builtin_amdgcn_fence(__ATOMIC_RELEASE, "agent");
            asm volatile("s_waitcnt vmcnt(0)" ::: "memory");
            const unsigned og = xb_add(&bar[XB_TOP], 1u);
            const unsigned tg = og / nx;
            if (og + 1u == (tg + 1u) * nx) xb_add(&bar[XB_TOPGEN], 1u);
            else XB_SPIN(xb_ld(&bar[XB_TOPGEN]) == tg, bar);
            __builtin_amdgcn_fence(__ATOMIC_ACQUIRE, "agent");
            asm volatile("s_waitcnt vmcnt(0)" ::: "memory");
        } else {
            XB_SPIN(xb_ld(&bar[XB_TOPGEN]) == gen, bar);
            __builtin_amdgcn_fence(__ATOMIC_ACQUIRE, "agent");
            asm volatile("s_waitcnt vmcnt(0)" ::: "memory");
        }
    }
    __syncthreads();
}

__device__ __forceinline__ unsigned xcd_arrive(const XcdBarrier& b) {
    asm volatile("s_waitcnt vmcnt(0)" ::: "memory");
    __syncthreads();
    unsigned gen = 0u;
    if (threadIdx.x == 0) {
        unsigned* bar = b.bar;
        __builtin_amdgcn_s_waitcnt(0);
        unsigned nloc = b.st[0], nx = b.st[1];
        if (nloc == 0u) { xcd_barrier_complete(bar, b.x, nloc, nx); b.st[0] = nloc; b.st[1] = nx; }
        const unsigned old = xb_add(&bar[XB_XSUB(b.x)], 1u);
        gen = old / nloc;
        if (old + 1u == (gen + 1u) * nloc) {
            __builtin_amdgcn_fence(__ATOMIC_RELEASE, "agent");
            asm volatile("s_waitcnt vmcnt(0)" ::: "memory");
            const unsigned og = xb_add(&bar[XB_TOP], 1u);
            const unsigned tg = og / nx;
            if (og + 1u == (tg + 1u) * nx) xb_add(&bar[XB_TOPGEN], 1u);
        }
    }
    return gen;
}
__device__ __forceinline__ void xcd_wait(const XcdBarrier& b, unsigned gen) {
    if (threadIdx.x == 0) {
        unsigned* bar = b.bar;
        XB_SPIN(xb_ld(&bar[XB_TOPGEN]) == gen, bar);
        __builtin_amdgcn_fence(__ATOMIC_ACQUIRE, "agent");
        asm volatile("s_waitcnt vmcnt(0)" ::: "memory");
    }
    __syncthreads();
}
__device__ __forceinline__ void shadow_work(const Params& p, unsigned char* lds, int k, int bid, int G) {
    const int lo = bid, hi2 = (bid + 128) % G;
    if (k == 0)      { transpose_range(p, lds, 2112, 2304, lo, G);  transpose_range(p, lds, 320, 576, (bid + 64) % G, G); }
    else if (k == 1) { transpose_range(p, lds, 832, 960, lo, G);    transpose_range(p, lds, 960, 1088, hi2, G); }
    else if (k == 2) { transpose_range(p, lds, 576, 704, lo, G);    transpose_range(p, lds, 1088, 1216, hi2, G); }
    else if (k == 3) { for (int t = bid; t < 256; t += G) pool_tile((const bf16_t*)(p.ws + WS_PH), (bf16_t*)(p.ws + WS_MIXED), t); }
    else if (k == 4) { transpose_range(p, lds, 704, 832, lo, G);    transpose_range(p, lds, 1216, 1344, hi2, G); }
    else if (k == 5) { transpose_range(p, lds, 1344, 1472, lo, G);  transpose_range(p, lds, 1472, 1600, hi2, G); }
    else if (k == 7) { transpose_range(p, lds, 1600, 1856, lo, G); }
    else if (k == 8) { transpose_range(p, lds, 1856, 1984, lo, G); }
}

constexpr int N_PHASES = 12;
__global__ void __launch_bounds__(NTHREADS, 2) mega(Params p) {
    extern __shared__ __attribute__((aligned(16))) unsigned char lds[];
    LAS unsigned char* ldsl = (LAS unsigned char*)lds;
    unsigned char* ws = p.ws;
    const int G = gridDim.x, bid = blockIdx.x;
    const int lo = p.ph_lo, hi = p.ph_hi;

#ifndef DEFER_PREP
#define DEFER_PREP 0
#endif
#ifndef FUSE_FINAL
#define FUSE_FINAL 0
#endif
#ifndef DBG_LAST
#define DBG_LAST -1
#endif
#ifndef PHASE_MASK
#define PHASE_MASK 0xfff
#endif
#define IN(k) (((PHASE_MASK >> (k)) & 1) && lo <= (k) && (k) < hi)
    if (threadIdx.x == 0) { ((volatile LAS unsigned*)(ldsl + LDS_MAIN))[0] = 0u; ((volatile LAS unsigned*)(ldsl + LDS_MAIN))[1] = 0u; }
    __syncthreads();
    XcdBarrier xbar; xbar.bar = (unsigned*)(ws + WS_BAR); xbar.x = 0; xbar.st = nullptr;
    if (hi - lo > 1) xbar = xcd_barrier_post((unsigned*)(ws + WS_BAR), (volatile LAS unsigned*)(ldsl + LDS_MAIN));
    if (lo > hi) cg::this_grid().sync();
    const bool shadow = (G == 256) && (hi - lo == N_PHASES);
#define SEAM(k) do { if (IN(k) && IN((k) + 1)) { const unsigned g_ = xcd_arrive(xbar); if (shadow) shadow_work(p, lds, (k), bid, G); xcd_wait(xbar, g_); } } while (0)
    bf16_t* XB = (bf16_t*)(ws + WS_XB); bf16_t* LT = (bf16_t*)(ws + WS_ST);
    bf16_t* QH = (bf16_t*)(ws + WS_QH); bf16_t* KH = (bf16_t*)(ws + WS_KH); bf16_t* VH = (bf16_t*)(ws + WS_VH); bf16_t* GH = (bf16_t*)(ws + WS_GH); bf16_t* PH = (bf16_t*)(ws + WS_PH);
    float* LF = (float*)(ws + WS_LF); bf16_t* ST = (bf16_t*)(ws + WS_ST); bf16_t* MIXED = (bf16_t*)(ws + WS_MIXED);
    float* X1 = (float*)(ws + WS_X1); bf16_t* XQ = (bf16_t*)(ws + WS_XQ); bf16_t* ATT = (bf16_t*)(ws + WS_ATT); bf16_t* U = (bf16_t*)(ws + WS_U);
    float* SSQ = (float*)(ws + WS_SSQ); float* DEC = (float*)(ws + WS_DEC);
    bf16_t* MEMB = (bf16_t*)(ws + WS_MEMB); bf16_t* KX = (bf16_t*)(ws + WS_KX); bf16_t* VT = (bf16_t*)(ws + WS_VT);

    const bool fuse_final = FUSE_FINAL && (G == 256) && IN(10) && (hi - lo > 1);
    if (IN(0)) { phase_prep(p, lds, shadow);
#if !DEFER_PREP
        if (!shadow) deferred_prep(p, lds, bid, G);
#endif
    }
    SEAM(0);
    const bf16_t* WTIN = (const bf16_t*)(ws + WS_WT_IN);
    if (IN(1)) {
        const pg8::Epi E{0, ws, p.x, p.out, p.lb_logits, p.final_norm_g, 2};
        pg8::Gemm g{XB, WTIN + (size_t)512 * DM, MROWS, 1024, DM}; pg8::StaticOrder S; S.init(MROWS, 1024, G, bid); pg8::gemm_phase(ldsl, g, S, E);
    }
    SEAM(1);
    if (IN(2)) {
        { const pg8::Epi E{0, ws, p.x, p.out, p.lb_logits, p.final_norm_g, 6};
          pg8::Gemm g{XB, WTIN + (size_t)1536 * DM, MROWS, 1024, DM}; pg8::StaticOrder S; S.init(MROWS, 1024, G, bid); pg8::gemm_phase(ldsl, g, S, E); }
        { const pg8::Epi E{0, ws, p.x, p.out, p.lb_logits, p.final_norm_g, 0};
          pg8::Gemm g{XB, WTIN, MROWS, 512, DM}; pg8::StaticOrder S; S.init(MROWS, 512, G, bid); pg8::gemm_phase(ldsl, g, S, E); }
        const pg8::Epi E1{1, ws, p.x, p.out, p.lb_logits, p.final_norm_g, 0};
        { pg8::Gemm g{MEMB, (const bf16_t*)(ws + WS_WT_K), MEMROWS, 1024, DM}; pg8::StaticOrder S; S.init(MEMROWS, 1024, G, (bid + 128) % G); pg8::gemm_phase(ldsl, g, S, E1); }
        const pg8::Epi E2{2, ws, p.x, p.out, p.lb_logits, p.final_norm_g, 0};
        { pg8::Gemm g{(const bf16_t*)(ws + WS_WT_V), MEMB, 1024, MEMROWS, DM}; pg8::StaticOrder S; S.init(1024, MEMROWS, G, (bid + 112) % G); pg8::gemm_phase(ldsl, g, S, E2); }
        if (G == 256) {
            if (bid >= 160) phase_passA(KH, LF, VH, LT, DEC, lds, bid - 160, 96, 0, 512);
            phase_passA(KH, LF, VH, LT, DEC, lds, bid, G, 512, 1024);
        } else phase_passA(KH, LF, VH, LT, DEC, lds, bid, G, 0, 1024);
    }
    SEAM(2);
    if (IN(3)) {
        phase_scan(LT, DEC, ST);
        if (!shadow) { for (int t = bid; t < 256; t += G) pool_tile(PH, MIXED, t); }
        fold_pool_weights_mfma(p);
    }
    SEAM(3);
    if (IN(4)) { phase_passC(QH, KH, LF, VH, GH, ST, p.hgrn_norm_g, MIXED, lds); }
    SEAM(4);
    if (IN(5)) {
        const pg8::Epi E{6, ws, p.x, p.out, p.lb_logits, p.final_norm_g, 0};
        pg8::Gemm g{MIXED, (const bf16_t*)(ws + WS_WT_OUT), MROWS, DM, DM}; pg8::StaticOrder S; S.init(MROWS, DM, G, bid); pg8::gemm_phase(ldsl, g, S, E);
    }
    SEAM(5);
    const bool fuse_attn = (G == 256) && IN(6) && IN(7);
    if (IN(6)) {
        const pg8::Epi E{4, ws, p.x, p.out, p.lb_logits, p.final_norm_g, 0};
        pg8::Gemm g{XB, (const bf16_t*)(ws + WS_WT_Q), MROWS, DM, DM}; pg8::StaticOrder S; S.init(MROWS, DM, G, bid); pg8::gemm_phase(ldsl, g, S, E);
        if (fuse_attn) {
            pg8::Unit u; S.next(0, u);
            asm volatile("s_waitcnt vmcnt(0)" ::: "memory"); __syncthreads();
            attn_unit(XQ, KX, VT, ATT, u.pm * 4 + u.pn, lds);
        }
    }
    if (!fuse_attn) {
        SEAM(6);
        if (IN(7)) { for (int u = bid; u < 256; u += G) attn_unit(XQ, KX, VT, ATT, u, lds); }
    }
    SEAM(7);
    if (IN(8)) {
        const pg8::Epi E{6, ws, p.x, p.out, p.lb_logits, p.final_norm_g, 0};
        pg8::Gemm g{ATT, (const bf16_t*)(ws + WS_WT_O), MROWS, DM, DM}; pg8::StaticOrder S; S.init(MROWS, DM, G, bid); pg8::gemm_phase(ldsl, g, S, E);
    }
    SEAM(8);
    if (IN(9)) {
        const pg8::Epi E{5, ws, p.x, p.out, p.lb_logits, p.final_norm_g, 0};
        pg8::Gemm g{XB, (const bf16_t*)(ws + WS_WT_FF1), MROWS, DFF, DM}; pg8::StaticOrder S; S.init(MROWS, DFF, G, bid); pg8::gemm_phase(ldsl, g, S, E);
    }
    SEAM(9);
    if (IN(10)) {
        const pg8::Epi E{fuse_final ? 8 : 7, ws, p.x, p.out, p.lb_logits, p.final_norm_g, 0};
        pg8::Gemm g{U, (const bf16_t*)(ws + WS_WT_FF2), MROWS, DM, DFF}; pg8::StaticOrder S; S.init(MROWS, DM, G, bid); pg8::gemm_phase(ldsl, g, S, E);
    }
    if (!fuse_final) {
        SEAM(10);
        if (IN(11)) { phase_final(XB, SSQ, p.out, p.final_norm_g); }
    }
#if DBG_LAST >= 0
    cg::this_grid().sync();
    {
        const unsigned* w32 = (const unsigned*)ws;
        for (size_t i = (size_t)bid * NTHREADS + threadIdx.x; i < (size_t)MROWS * DM; i += (size_t)G * NTHREADS) {
            float a = 0.f;
            for (int j = 0; j < 4; ++j) { const unsigned v = w32[i + (size_t)j * MROWS * DM]; a += (float)(v & 0xffffu) + (float)(v >> 16); }
            p.out[i] = a;
        }
    }
#endif
#undef IN
#undef SEAM
}

extern "C" void kernel_launch(void* const* d_in, const int* in_sizes, int n_in, void* d_out, int out_size, void* d_ws, size_t ws_size, hipStream_t stream) {
    static int grid = 0;
    if (grid == 0) {
        if (n_in != 19 || in_sizes[0] != MROWS * DM || out_size != MROWS * DM || ws_size < WS_END) { fprintf(stderr, "kernel_launch: unexpected shapes (n_in %d, ws %zu)\n", n_in, ws_size); grid = -1; return; }
        int dev = 0, cus = 0, per_cu = 0;
        hipGetDevice(&dev); hipDeviceGetAttribute(&cus, hipDeviceAttributeMultiprocessorCount, dev);
        if (hipFuncSetAttribute((const void*)mega, hipFuncAttributeMaxDynamicSharedMemorySize, LDS_BYTES) != hipSuccess) { fprintf(stderr, "kernel_launch: hipFuncSetAttribute failed\n"); grid = -1; return; }
        if (hipOccupancyMaxActiveBlocksPerMultiprocessor(&per_cu, (const void*)mega, NTHREADS, LDS_BYTES) != hipSuccess || per_cu < 1) { fprintf(stderr, "kernel_launch: occupancy query says %d\n", per_cu); per_cu = 1; }
        (void)hipGetLastError();
        grid = cus * 1;
        if (grid > cus * per_cu) grid = cus * per_cu;
    }
    if (grid < 0) return;
    if (hipMemsetAsync((char*)d_ws + WS_BAR, 0, 32768, stream) != hipSuccess) { fprintf(stderr, "kernel_launch: memset of barrier words failed\n"); return; }
    Params p{};
    const float** f = (const float**)&p;
    for (int i = 0; i < 19; ++i) f[i] = (const float*)d_in[i];
    p.out = (float*)d_out; p.ws = (unsigned char*)d_ws;
#if N_LAUNCH_MODE == 1
    p.ph_lo = 0; p.ph_hi = (DBG_LAST >= 0) ? DBG_LAST + 1 : N_PHASES;
    void* args[] = {&p};
    hipError_t e = hipLaunchCooperativeKernel((const void*)mega, dim3(grid), dim3(NTHREADS), args, LDS_BYTES, stream);
    if (e != hipSuccess) fprintf(stderr, "kernel_launch: cooperative launch failed: %s (grid %d)\n", hipGetErrorString(e), grid);
#else
    for (int k = 0; k < N_PHASES; ++k) { p.ph_lo = k; p.ph_hi = k + 1; hipLaunchKernelGGL(mega, dim3(grid), dim3(NTHREADS), LDS_BYTES, stream, p); }
#endif
}
```

```cpp
#include <hip/hip_runtime.h>
#include <hip/hip_cooperative_groups.h>
#include <cstdio>
namespace cg = cooperative_groups;

#ifndef N_LAUNCH_MODE
#define N_LAUNCH_MODE 1
#endif

typedef unsigned short bf16_t;
typedef short bf16x8 __attribute__((ext_vector_type(8)));
typedef float f32x2 __attribute__((ext_vector_type(2)));
typedef float f32x4 __attribute__((ext_vector_type(4)));
typedef float f32x16 __attribute__((ext_vector_type(16)));
typedef unsigned u32x2 __attribute__((ext_vector_type(2)));
typedef unsigned u32x4 __attribute__((ext_vector_type(4)));
#define LAS __attribute__((address_space(3)))

constexpr int MROWS = 16384, DM = 1024, SEQ = 4096, NIN = 2560, DFF = 4096, MEMROWS = 1024;
constexpr float EPS = 1e-6f;
constexpr int NTHREADS = 512;
constexpr int LDS_MAIN = 135168;
constexpr int LDS_BYTES = LDS_MAIN + 16;

constexpr size_t MiB = 1u << 20;
constexpr size_t WS_WT_IN = 0, WS_WT_K = 5 * MiB, WS_WT_V = 7 * MiB, WS_WT_OUT = 9 * MiB, WS_WT_Q = 11 * MiB, WS_WT_O = 13 * MiB,
                 WS_WT_FF1 = 15 * MiB, WS_WT_FF2 = 23 * MiB, WS_MEMB = 31 * MiB, WS_KX = 33 * MiB, WS_VT = 35 * MiB, WS_SSQ = 37 * MiB,
                 WS_BAR = 39 * MiB, WS_CNT = 39 * MiB + 16384, WS_RSTD0 = 38 * MiB, WS_RSTDM = 38 * MiB + 65536, WS_DEC = 38 * MiB + 131072,
                 WS_XB = 40 * MiB  , WS_QH = 72 * MiB, WS_KH = 88 * MiB, WS_VH = 104 * MiB, WS_GH = 120 * MiB, WS_PH = 136 * MiB,
                 WS_LF = 152 * MiB, WS_ST = 184 * MiB, WS_MIXED = 216 * MiB,
                 WS_X1 = 72 * MiB, WS_XQ = 136 * MiB, WS_ATT = 168 * MiB, WS_U = 72 * MiB, WS_END = 256 * MiB;

typedef __bf16 bf16x2n __attribute__((ext_vector_type(2)));
__device__ __forceinline__ unsigned cvt_pk_bf16(float lo, float hi) { f32x2 v = {lo, hi}; return __builtin_bit_cast(unsigned, __builtin_convertvector(v, bf16x2n)); }
__device__ __forceinline__ bf16_t f2bf(float f) { return (bf16_t)(cvt_pk_bf16(f, 0.f) & 0xffffu); }
__device__ __forceinline__ float bf2f(bf16_t b) { return __uint_as_float(((unsigned)b) << 16); }
__device__ __forceinline__ float bflo(unsigned u) { return __uint_as_float(u << 16); }
__device__ __forceinline__ float bfhi(unsigned u) { return __uint_as_float(u & 0xffff0000u); }
__device__ __forceinline__ f32x4 mfma16(bf16x8 a, bf16x8 b, f32x4 c) { return __builtin_amdgcn_mfma_f32_16x16x32_bf16(a, b, c, 0, 0, 0); }
__device__ __forceinline__ f32x16 mfma32(bf16x8 a, bf16x8 b, f32x16 c) { return __builtin_amdgcn_mfma_f32_32x32x16_bf16(a, b, c, 0, 0, 0); }
__device__ __forceinline__ bf16x8 mk8(u32x2 lo, u32x2 hi) { u32x4 t; t.x = lo.x; t.y = lo.y; t.z = hi.x; t.w = hi.y; return __builtin_bit_cast(bf16x8, t); }
__device__ __forceinline__ bf16x8 mk8u(unsigned a, unsigned b, unsigned c, unsigned d) { u32x4 t; t.x = a; t.y = b; t.z = c; t.w = d; return __builtin_bit_cast(bf16x8, t); }
__device__ __forceinline__ float sigmoidf_(float z) { return __builtin_amdgcn_rcpf(1.0f + __expf(-z)); }

namespace pg8 {
constexpr int BM = 256, BK = 64, HALF = 128, HTB = HALF * BK * 2, STAGE_BYTES = 8 * HTB, NXCD = 8, WGM = 8;
__device__ __forceinline__ int lds_byte(int r, int c) { const int st = (r >> 4) * 2 + (c >> 5), rr = r & 15, cc = c & 31, ob = rr * 64 + cc * 2; return st * 1024 + (ob ^ (((ob >> 9) & 1) << 5)); }
__device__ __forceinline__ void stage_rc(int b, int& R, int& C) { const int st = b / 1024, sb = b % 1024, swz = sb ^ (((sb >> 9) & 1) << 5); R = (st >> 1) * 16 + swz / 64; C = (st & 1) * 32 + (swz % 64) / 2; }
__device__ __forceinline__ int perm32(int rho) { const int n = rho >> 4, i = rho & 15; return 8 * (i >> 2) + 4 * n + (i & 3); }
struct Unit { int pm, pn; };
struct Gemm { const bf16_t* A; const bf16_t* Bt; int M, N, K; };
struct StaticOrder {
    int nM, nN, nwg, G, c;
    __device__ __forceinline__ void init(int M, int N, int G_, int c_) { nM = M / BM; nN = N / BM; nwg = nM * nN; G = G_; c = c_; }
    __device__ __forceinline__ bool next(int i, Unit& u) const {
        const long L = (long)i * G + c; if (L >= nwg) return false;
        int wgid = (int)L; { const int q = nwg / NXCD, r = nwg % NXCD, xcd = wgid % NXCD, off = wgid / NXCD; wgid = (xcd < r ? xcd * (q + 1) : r * (q + 1) + (xcd - r) * q) + off; }
        const int nig = WGM * nN, gid = wgid / nig, fm = gid * WGM, gsz = (nM - fm) < WGM ? (nM - fm) : WGM;
        u.pm = fm + ((wgid % nig) % gsz); u.pn = (wgid % nig) / gsz; return true;
    }
};

struct Epi {
    static constexpr bool PERM = true;
    int mode;
    unsigned char* ws; const float* x; float* out; const float* lbl; const float* gfin; int pnoff;
    __device__ __forceinline__ void store8(bf16_t* p, const f32x4& v0, const f32x4& v1) const {
        u32x4 w; w.x = cvt_pk_bf16(v0[0], v0[1]); w.y = cvt_pk_bf16(v0[2], v0[3]); w.z = cvt_pk_bf16(v1[0], v1[1]); w.w = cvt_pk_bf16(v1[2], v1[3]); *(u32x4*)p = w; }
    __device__ __forceinline__ void fused(f32x4 (&acc)[2][2][4][2], const Unit& u, int wr, int wc, int fr, int fq) const {
        const int row0 = u.pm * BM + wr * 64 + fr;
        const int col0 = u.pn * BM + wc * 32 + 8 * fq;
        const bf16_t* xb = (const bf16_t*)(ws + WS_XB);
        unsigned* sq = (unsigned*)(ws + WS_SSQ);
        unsigned* cnt = (unsigned*)(ws + WS_CNT) + 64 * u.pm;
        u32x4 bc[2], bn[2];
        { const size_t o = (size_t)row0 * DM + col0; bc[0] = *(const u32x4*)(xb + o); bc[1] = *(const u32x4*)(xb + o + HALF); }
#pragma unroll
        for (int gidx = 0; gidx < 8; ++gidx) { const int ai = gidx >> 2, m = gidx & 3; const int row = row0 + ai * HALF + m * 16;
            if (gidx < 7) { const int g2 = gidx + 1; const size_t o2 = (size_t)(row0 + (g2 >> 2) * HALF + (g2 & 3) * 16) * DM + col0; bn[0] = *(const u32x4*)(xb + o2); bn[1] = *(const u32x4*)(xb + o2 + HALF); }
            float ss = 0.f;
#pragma unroll
            for (int bj = 0; bj < 2; ++bj) { const u32x4 bb = bc[bj];
                const f32x4 v0 = acc[ai][bj][m][0] + (f32x4){bflo(bb.x), bfhi(bb.x), bflo(bb.y), bfhi(bb.y)}, v1 = acc[ai][bj][m][1] + (f32x4){bflo(bb.z), bfhi(bb.z), bflo(bb.w), bfhi(bb.w)};
                acc[ai][bj][m][0] = v0; acc[ai][bj][m][1] = v1;
                ss += (v0[0] * v0[0] + v0[1] * v0[1]) + (v0[2] * v0[2] + v0[3] * v0[3]) + (v1[0] * v1[0] + v1[1] * v1[1]) + (v1[2] * v1[2] + v1[3] * v1[3]); }
            ss += __shfl_xor(ss, 16); ss += __shfl_xor(ss, 32);
            if (fq == 0) __hip_atomic_store(sq + (size_t)row * 16 + u.pn * 4 + wc, __float_as_uint(ss), __ATOMIC_RELAXED, __HIP_MEMORY_SCOPE_AGENT);
            bc[0] = bn[0]; bc[1] = bn[1]; }
        asm volatile("s_waitcnt vmcnt(0)" ::: "memory");
        if ((threadIdx.x & 63) == 0) __hip_atomic_fetch_add(cnt, 1u, __ATOMIC_RELAXED, __HIP_MEMORY_SCOPE_AGENT);
        f32x4 gv[2][2];
#pragma unroll
        for (int bj = 0; bj < 2; ++bj) { gv[bj][0] = *(const f32x4*)(gfin + col0 + bj * HALF); gv[bj][1] = *(const f32x4*)(gfin + col0 + bj * HALF + 4); }
        { unsigned spins = 0; while ((unsigned)__builtin_amdgcn_readfirstlane(__hip_atomic_load(cnt, __ATOMIC_RELAXED, __HIP_MEMORY_SCOPE_AGENT)) < 32u) { __builtin_amdgcn_s_sleep(1); if (++spins > (1u << 22)) break; } }
        __builtin_amdgcn_fence(__ATOMIC_ACQUIRE, "agent");
        asm volatile("s_waitcnt vmcnt(0)" ::: "memory");
        f32x4 pv[8];
#pragma unroll
        for (int gidx = 0; gidx < 8; ++gidx) pv[gidx] = *(const f32x4*)((const float*)sq + (size_t)(row0 + (gidx >> 2) * HALF + (gidx & 3) * 16) * 16 + 4 * fq);
#pragma unroll
        for (int gidx = 0; gidx < 8; ++gidx) { const int ai = gidx >> 2, m = gidx & 3; const int row = row0 + ai * HALF + m * 16;
            float t = (pv[gidx][0] + pv[gidx][1]) + (pv[gidx][2] + pv[gidx][3]); t += __shfl_xor(t, 16); t += __shfl_xor(t, 32);
            const float rstd = rsqrtf(t * (1.0f / 1024.0f) + EPS);
            const size_t o = (size_t)row * DM + col0;
#pragma unroll
            for (int bj = 0; bj < 2; ++bj) { *(f32x4*)(out + o + bj * HALF) = acc[ai][bj][m][0] * rstd * gv[bj][0]; *(f32x4*)(out + o + bj * HALF + 4) = acc[ai][bj][m][1] * rstd * gv[bj][1]; } }
    }
    template <class Sched>
    __device__ __forceinline__ bool prefill(LAS unsigned char* lds, const Sched& S) const {
        if (!(mode == 0 || mode == 1 || mode == 4 || mode == 5) || S.nwg > 4 * S.G) return false;
        const int tid = threadIdx.x, rr = tid & 255;
#pragma unroll
        for (int k = 0; k < 2; ++k) { const int ui = (tid >> 8) + 2 * k; Unit u;
            if (S.next(ui, u)) { const int row = u.pm * BM + rr; float r;
                if (mode == 4 || mode == 5) { const f32x4* pp = (const f32x4*)((const float*)(ws + WS_SSQ) + (size_t)row * 16); const f32x4 a = pp[0], b = pp[1], c = pp[2], d = pp[3];
                    const float t = ((a[0] + a[1]) + (a[2] + a[3])) + ((b[0] + b[1]) + (b[2] + b[3])) + ((c[0] + c[1]) + (c[2] + c[3])) + ((d[0] + d[1]) + (d[2] + d[3]));
                    r = rsqrtf(t * (1.0f / 1024.0f) + EPS) * (mode == 4 ? 0.0625f : 1.0f); }
                else r = ((const float*)(ws + (mode == 0 ? WS_RSTD0 : WS_RSTDM)))[row];
                *(LAS float*)(lds + STAGE_BYTES + (ui * 256 + rr) * 4) = r; } }
        return true;
    }
    __device__ __forceinline__ void operator()(const f32x4 (&acc)[2][2][4][2], const Unit& u, int ui, bool tab, LAS unsigned char* lds, int wr, int wc, int fr, int fq) const {
        const int row0 = u.pm * BM + wr * 64 + fr;
        const int colL = wc * 32 + 8 * fq;
        if (mode == 3 || mode == 6 || mode == 7) {
            const int col0 = u.pn * BM + colL;
            bf16_t* xb = (bf16_t*)(ws + WS_XB);
            float* ssq = (float*)(ws + WS_SSQ);
            f32x4 rc[4], rn[4];
            u32x4 bc[2], bn[2];
            if (mode == 3) { const size_t o = (size_t)row0 * DM + col0; rc[0] = *(const f32x4*)(x + o); rc[1] = *(const f32x4*)(x + o + 4); rc[2] = *(const f32x4*)(x + o + HALF); rc[3] = *(const f32x4*)(x + o + HALF + 4); }
            else { const size_t o = (size_t)row0 * DM + col0; bc[0] = *(const u32x4*)(xb + o); bc[1] = *(const u32x4*)(xb + o + HALF); }
#pragma unroll
            for (int gidx = 0; gidx < 8; ++gidx) { const int ai = gidx >> 2, m = gidx & 3; const int row = row0 + ai * HALF + m * 16;
                if (gidx < 7) { const int g2 = gidx + 1; const size_t o2 = (size_t)(row0 + (g2 >> 2) * HALF + (g2 & 3) * 16) * DM + col0;
                    if (mode == 3) { rn[0] = *(const f32x4*)(x + o2); rn[1] = *(const f32x4*)(x + o2 + 4); rn[2] = *(const f32x4*)(x + o2 + HALF); rn[3] = *(const f32x4*)(x + o2 + HALF + 4); }
                    else { bn[0] = *(const u32x4*)(xb + o2); bn[1] = *(const u32x4*)(xb + o2 + HALF); } }
                if (mode != 3) {
#pragma unroll
                    for (int bj = 0; bj < 2; ++bj) { rc[2 * bj] = (f32x4){bflo(bc[bj].x), bfhi(bc[bj].x), bflo(bc[bj].y), bfhi(bc[bj].y)}; rc[2 * bj + 1] = (f32x4){bflo(bc[bj].z), bfhi(bc[bj].z), bflo(bc[bj].w), bfhi(bc[bj].w)}; } }
                float ss = 0.f;
#pragma unroll
                for (int bj = 0; bj < 2; ++bj) { const size_t o = (size_t)row * DM + col0 + bj * HALF;
                    const f32x4 v0 = acc[ai][bj][m][0] + rc[2 * bj], v1 = acc[ai][bj][m][1] + rc[2 * bj + 1];
                    store8(xb + o, v0, v1);
                    ss += (v0[0] * v0[0] + v0[1] * v0[1]) + (v0[2] * v0[2] + v0[3] * v0[3]) + (v1[0] * v1[0] + v1[1] * v1[1]) + (v1[2] * v1[2] + v1[3] * v1[3]); }
                ss += __shfl_xor(ss, 16); ss += __shfl_xor(ss, 32);
                if (fq == 0) ssq[(size_t)row * 16 + u.pn * 4 + wc] = ss;
#pragma unroll
                for (int k = 0; k < 4; ++k) rc[k] = rn[k];
                bc[0] = bn[0]; bc[1] = bn[1]; }
            return;
        }
        if (mode == 2) {
            const int col0 = u.pn * BM + colL;
            const float* rs = (const float*)(ws + WS_RSTDM); bf16_t* ob = (bf16_t*)(ws + WS_VT); const int ldo = 1024;
            f32x4 c0[2], c1[2];
#pragma unroll
            for (int bj = 0; bj < 2; ++bj) { c0[bj] = *(const f32x4*)(rs + col0 + bj * HALF); c1[bj] = *(const f32x4*)(rs + col0 + bj * HALF + 4); }
#pragma unroll
            for (int ai = 0; ai < 2; ++ai)
#pragma unroll
                for (int m = 0; m < 4; ++m) { const int row = row0 + ai * HALF + m * 16;
#pragma unroll
                    for (int bj = 0; bj < 2; ++bj) store8(ob + (size_t)row * ldo + col0 + bj * HALF, acc[ai][bj][m][0] * c0[bj], acc[ai][bj][m][1] * c1[bj]); }
            return;
        }
        float rsc[8];
        if (tab) {
#pragma unroll
            for (int gidx = 0; gidx < 8; ++gidx) rsc[gidx] = *(const LAS float*)(lds + STAGE_BYTES + (ui * 256 + wr * 64 + fr + (gidx >> 2) * HALF + (gidx & 3) * 16) * 4);
        } else if (mode == 4 || mode == 5) {
            asm volatile("" ::: "memory");
            const float* sq = (const float*)(ws + WS_SSQ);
            f32x4 pv[8];
#pragma unroll
            for (int gidx = 0; gidx < 8; ++gidx) pv[gidx] = *(const f32x4*)(sq + (size_t)(row0 + (gidx >> 2) * HALF + (gidx & 3) * 16) * 16 + 4 * fq);
            const float cs = mode == 4 ? 0.0625f : 1.0f;
#pragma unroll
            for (int gidx = 0; gidx < 8; ++gidx) { float t = (pv[gidx][0] + pv[gidx][1]) + (pv[gidx][2] + pv[gidx][3]); t += __shfl_xor(t, 16); t += __shfl_xor(t, 32); rsc[gidx] = rsqrtf(t * (1.0f / 1024.0f) + EPS) * cs; }
        } else {
            asm volatile("" ::: "memory");
            const float* rs = (const float*)(ws + (mode == 0 ? WS_RSTD0 : WS_RSTDM));
#pragma unroll
            for (int gidx = 0; gidx < 8; ++gidx) rsc[gidx] = rs[row0 + (gidx >> 2) * HALF + (gidx & 3) * 16];
        }
        if (mode == 0) {
            float* lf = (float*)(ws + WS_LF);
            const int pnn = u.pn + pnoff; const int sub = pnn >> 1; const int cb = (pnn & 1) * 256 + colL;
            if (sub == 1) {
                float oml[2][8];
#pragma unroll
                for (int bj = 0; bj < 2; ++bj)
#pragma unroll
                    for (int j = 0; j < 8; ++j) { const int c = cb + bj * HALF + j; const float l0 = lbl[c], l1 = lbl[512 + c]; const float lb = 1.0f / (1.0f + __expf(l1 - l0)); oml[bj][j] = 1.0f - lb; }
#pragma unroll
                for (int ai = 0; ai < 2; ++ai)
#pragma unroll
                    for (int m = 0; m < 4; ++m) { const int row = row0 + ai * HALF + m * 16; const float r = rsc[ai * 4 + m];
#pragma unroll
                        for (int bj = 0; bj < 2; ++bj) { f32x4 lf0, lf1;
#pragma unroll
                            for (int j = 0; j < 4; ++j) {
                                const float za = acc[ai][bj][m][0][j] * r, zb = acc[ai][bj][m][1][j] * r;
                                const float ka = oml[bj][j] * (1.0f - sigmoidf_(za)), kb = oml[bj][4 + j] * (1.0f - sigmoidf_(zb));
                                lf0[j] = __logf(1.0f - ka); lf1[j] = __logf(1.0f - kb); }
                            const size_t o = (size_t)row * 512 + cb + bj * HALF;
                            *(f32x4*)(lf + o) = lf0; *(f32x4*)(lf + o + 4) = lf1; } }
            } else {
                bf16_t* dst = (bf16_t*)(ws + (sub == 0 ? WS_QH : (sub == 2 ? WS_VH : (sub == 3 ? WS_GH : WS_PH))));
                const bool act = (sub == 0) || (sub == 3);
#pragma unroll
                for (int ai = 0; ai < 2; ++ai)
#pragma unroll
                    for (int m = 0; m < 4; ++m) { const int row = row0 + ai * HALF + m * 16; const float r = rsc[ai * 4 + m];
#pragma unroll
                        for (int bj = 0; bj < 2; ++bj) { f32x4 v0 = acc[ai][bj][m][0] * r, v1 = acc[ai][bj][m][1] * r;
                            if (act) {
#pragma unroll
                                for (int j = 0; j < 4; ++j) { v0[j] = v0[j] * sigmoidf_(v0[j]); v1[j] = v1[j] * sigmoidf_(v1[j]); } }
                            store8(dst + (size_t)row * 512 + cb + bj * HALF, v0, v1); } }
            }
        } else {
            const int col0 = u.pn * BM + colL;
            bf16_t* ob = (bf16_t*)(ws + (mode == 1 ? WS_KX : (mode == 4 ? WS_XQ : WS_U))); const int ldo = mode == 5 ? DFF : 1024;
#pragma unroll
            for (int ai = 0; ai < 2; ++ai)
#pragma unroll
                for (int m = 0; m < 4; ++m) { const int row = row0 + ai * HALF + m * 16; const float r = rsc[ai * 4 + m];
#pragma unroll
                    for (int bj = 0; bj < 2; ++bj) { f32x4 v0 = acc[ai][bj][m][0] * r, v1 = acc[ai][bj][m][1] * r;
                        if (mode == 5) {
#pragma unroll
                            for (int j = 0; j < 4; ++j) { const float a = fmaxf(v0[j], 0.f), b = fmaxf(v1[j], 0.f); v0[j] = a * a; v1[j] = b * b; } }
                        if (mode == 5) {
                            u32x4 w; w.x = cvt_pk_bf16(v0[0], v0[1]); w.y = cvt_pk_bf16(v0[2], v0[3]); w.z = cvt_pk_bf16(v1[0], v1[1]); w.w = cvt_pk_bf16(v1[2], v1[3]);
                            __builtin_amdgcn_raw_buffer_store_b128(w, __builtin_amdgcn_make_buffer_rsrc((void*)ob, 0, 0x7fffffff, 0x00020000), (int)(((size_t)row * ldo + col0 + bj * HALF) * 2), 0, 16); }
                        else store8(ob + (size_t)row * ldo + col0 + bj * HALF, v0, v1); } }
        }
    }
};

template <class EpiT, class Sched>
__device__ __forceinline__ void gemm_phase(LAS unsigned char* lds, const Gemm g, const Sched S, const EpiT E) {
    const int tid = threadIdx.x, wid = __builtin_amdgcn_readfirstlane(tid >> 6), lane = tid & 63, wr = wid >> 2, wc = wid & 3, fr = lane & 15, fq = lane >> 4;
    const int K = g.K, nt = K / BK;
    unsigned voffA[2], voffB[2];
#pragma unroll
    for (int i = 0; i < 2; ++i) { int R, C; stage_rc(tid * 16 + i * 8192, R, C); const int Rb = EpiT::PERM ? ((R & ~31) + perm32(R & 31)) : R;
        voffA[i] = (unsigned)(R * K + C) * 2u; voffB[i] = (unsigned)(Rb * K + C) * 2u; }
    const size_t kstep = (size_t)(BK * 2);
    const size_t hstep = (size_t)HALF * K * 2;
    const size_t tstep = 2 * hstep;
    const unsigned ldsw = (unsigned)wid * 1024u;
    const int aoff = lds_byte(wr * 64 + fr, fq * 8), boff = lds_byte(wc * 32 + fr, fq * 8);
#define PG8_SA(b, h) (((b) * 2 + (h)) * HTB)
#define PG8_SB(b, h) ((4 + (b) * 2 + (h)) * HTB)
#define PG8_STAGE(bufoff, gbase, voff) do { _Pragma("unroll") for (int _i = 0; _i < 2; ++_i) \
        __builtin_amdgcn_global_load_lds((const unsigned*)((const char*)(gbase) + (voff)[_i]), (LAS unsigned*)(lds + (bufoff) + ldsw + _i * 8192), 16, 0, 0); } while (0)
#define PG8_LDA(dst, b, h) do { _Pragma("unroll") for (int m = 0; m < 4; ++m) _Pragma("unroll") for (int k = 0; k < 2; ++k) dst[m][k] = *(const LAS bf16x8*)(lds + PG8_SA(b, h) + aoff + m * 2048 + k * 1024); } while (0)
#define PG8_LDB(dst, b, h) do { _Pragma("unroll") for (int n = 0; n < 2; ++n) _Pragma("unroll") for (int k = 0; k < 2; ++k) dst[n][k] = *(const LAS bf16x8*)(lds + PG8_SB(b, h) + boff + n * 2048 + k * 1024); } while (0)
#define PG8_MMA(ai, bj, At, Bt) do { __builtin_amdgcn_s_setprio(1); _Pragma("unroll") for (int m = 0; m < 4; ++m) _Pragma("unroll") for (int n = 0; n < 2; ++n) _Pragma("unroll") for (int k = 0; k < 2; ++k) \
        acc[ai][bj][m][n] = __builtin_amdgcn_mfma_f32_16x16x32_bf16(Bt[n][k], At[m][k], acc[ai][bj][m][n], 0, 0, 0); __builtin_amdgcn_s_setprio(0); } while (0)
#define PG8_WAIT_V(n) asm volatile("s_waitcnt vmcnt(" #n ")" ::: "memory")
#define PG8_WAIT_L(n) asm volatile("s_waitcnt lgkmcnt(" #n ")" ::: "memory")
#define PG8_BAR __builtin_amdgcn_s_barrier()
#define PG8_SCHED __builtin_amdgcn_sched_barrier(0)
    Unit cur, nxt; int ui = 0;
    if (!S.next(0, cur)) return;
    const bool tab = E.prefill(lds, S);
    if (tab) __syncthreads();
    f32x4 acc[2][2][4][2];
#pragma unroll
    for (int a = 0; a < 2; ++a)
#pragma unroll
        for (int b = 0; b < 2; ++b)
#pragma unroll
            for (int m = 0; m < 4; ++m)
#pragma unroll
                for (int n = 0; n < 2; ++n) acc[a][b][m][n] = (f32x4){0.f, 0.f, 0.f, 0.f};
    bf16x8 At[4][2], B0[2][2], B1[2][2];
    const char* cA = (const char*)g.A + (size_t)cur.pm * tstep; const char* cB = (const char*)g.Bt + (size_t)cur.pn * tstep;
    PG8_STAGE(PG8_SB(0, 0), cB, voffB); PG8_STAGE(PG8_SA(0, 0), cA, voffA); PG8_STAGE(PG8_SB(0, 1), cB + hstep, voffB); PG8_STAGE(PG8_SA(0, 1), cA + hstep, voffA);
    if (wr == 1) PG8_BAR;
    PG8_WAIT_V(4); PG8_BAR;
    PG8_STAGE(PG8_SB(1, 0), cB + kstep, voffB); PG8_STAGE(PG8_SA(1, 0), cA + kstep, voffA); PG8_STAGE(PG8_SB(1, 1), cB + hstep + kstep, voffB);
    PG8_WAIT_V(6); PG8_BAR;
    for (;;) {
        const bool has_next = S.next(ui + 1, nxt);
        const char* nA = has_next ? (const char*)g.A + (size_t)nxt.pm * tstep : cA; const char* nB = has_next ? (const char*)g.Bt + (size_t)nxt.pn * tstep : cB;
        for (int t = 0; t < nt; t += 2) {
            const bool last = (t == nt - 2);
            const char* a1 = cA + (size_t)(t + 1) * kstep;
            const char* a2 = last ? nA : cA + (size_t)(t + 2) * kstep; const char* b2 = last ? nB : cB + (size_t)(t + 2) * kstep;
            const char* a3 = a2 + kstep; const char* b3 = b2 + kstep;
            PG8_LDB(B0, 0, 0); PG8_SCHED; PG8_LDA(At, 0, 0); PG8_STAGE(PG8_SA(1, 1), a1 + hstep, voffA);
            PG8_WAIT_L(8); PG8_BAR; PG8_WAIT_L(0); PG8_MMA(0, 0, At, B0); PG8_BAR; PG8_SCHED;
            PG8_LDB(B1, 0, 1); PG8_STAGE(PG8_SB(0, 0), b2, voffB);
            PG8_BAR; PG8_WAIT_L(0); PG8_MMA(0, 1, At, B1); PG8_BAR;
            PG8_LDA(At, 0, 1); PG8_STAGE(PG8_SA(0, 0), a2, voffA);
            PG8_BAR; PG8_WAIT_L(0); PG8_MMA(1, 0, At, B0); PG8_BAR; PG8_SCHED;
            PG8_STAGE(PG8_SB(0, 1), b2 + hstep, voffB);
            PG8_WAIT_V(6); PG8_BAR; PG8_MMA(1, 1, At, B1); PG8_BAR;
            PG8_LDB(B0, 1, 0); PG8_SCHED; PG8_LDA(At, 1, 0); PG8_STAGE(PG8_SA(0, 1), a2 + hstep, voffA);
            PG8_WAIT_L(8); PG8_BAR; PG8_WAIT_L(0); PG8_MMA(0, 0, At, B0); PG8_BAR; PG8_SCHED;
            PG8_LDB(B1, 1, 1); PG8_STAGE(PG8_SB(1, 0), b3, voffB);
            PG8_BAR; PG8_WAIT_L(0); PG8_MMA(0, 1, At, B1); PG8_BAR;
            PG8_LDA(At, 1, 1); PG8_STAGE(PG8_SA(1, 0), a3, voffA);
            PG8_BAR; PG8_WAIT_L(0); PG8_MMA(1, 0, At, B0); PG8_BAR; PG8_SCHED;
            PG8_STAGE(PG8_SB(1, 1), b3 + hstep, voffB);
            PG8_WAIT_V(6); PG8_BAR; PG8_MMA(1, 1, At, B1); PG8_BAR;
        }
        if (E.mode != 8) E(acc, cur, ui, tab, lds, wr, wc, fr, fq);
        if (E.mode == 0) __builtin_amdgcn_s_waitcnt(0x0F70);
        if (!has_next) break;
#pragma unroll
        for (int a = 0; a < 2; ++a)
#pragma unroll
            for (int b = 0; b < 2; ++b)
#pragma unroll
                for (int m = 0; m < 4; ++m)
#pragma unroll
                    for (int n = 0; n < 2; ++n) acc[a][b][m][n] = (f32x4){0.f, 0.f, 0.f, 0.f};
        cur = nxt; cA = nA; cB = nB; ++ui;
    }
    PG8_WAIT_V(0);
    if (wr == 0) PG8_BAR;
    PG8_BAR;
    if (E.mode == 8) E.fused(acc, cur, wr, wc, fr, fq);
#undef PG8_SA
#undef PG8_SB
#undef PG8_STAGE
#undef PG8_LDA
#undef PG8_LDB
#undef PG8_MMA
#undef PG8_WAIT_V
#undef PG8_WAIT_L
#undef PG8_BAR
#undef PG8_SCHED
}
}

struct Params {
    const float *x, *mem, *norm_mix_g, *w_in, *lb_logits, *hgrn_norm_g, *w_pool, *pool_scale, *w_out, *norm_x_g, *norm_mem_g, *w_xq, *w_xk, *w_xv, *w_xo, *norm_ffn_g, *w_ff1, *w_ff2, *final_norm_g;
    float* out; unsigned char* ws;
    int ph_lo, ph_hi;
};

struct TD { const float* W; const float* g; bf16_t* out; int N, ldo, kt, nt; };
__device__ __forceinline__ TD tile_desc(const Params& p, int t) {
    unsigned char* ws = p.ws; TD d;
    if (t < 320)       { d.W = p.w_in;  d.g = p.norm_mix_g; d.out = (bf16_t*)(ws + WS_WT_IN);  d.N = NIN;  d.ldo = 1024; d.kt = t / 40; d.nt = t % 40; }
    else if (t < 448)  { const int u = t - 320;  d.W = p.w_xk;  d.g = p.norm_mem_g; d.out = (bf16_t*)(ws + WS_WT_K);   d.N = 1024; d.ldo = 1024; d.kt = u / 16; d.nt = u % 16; }
    else if (t < 576)  { const int u = t - 448;  d.W = p.w_xv;  d.g = p.norm_mem_g; d.out = (bf16_t*)(ws + WS_WT_V);   d.N = 1024; d.ldo = 1024; d.kt = u / 16; d.nt = u % 16; }
    else if (t < 704)  { const int u = t - 576;  d.W = p.w_xq;  d.g = p.norm_x_g;   d.out = (bf16_t*)(ws + WS_WT_Q);   d.N = 1024; d.ldo = 1024; d.kt = u / 16; d.nt = u % 16; }
    else if (t < 832)  { const int u = t - 704;  d.W = p.w_xo;  d.g = nullptr;      d.out = (bf16_t*)(ws + WS_WT_O);   d.N = 1024; d.ldo = 1024; d.kt = u / 16; d.nt = u % 16; }
    else if (t < 960)  { const int u = t - 832;  d.W = p.w_out; d.g = nullptr;      d.out = (bf16_t*)(ws + WS_WT_OUT); d.N = 1024; d.ldo = 1024; d.kt = u / 16; d.nt = u % 16; }
    else if (t < 1472) { const int u = t - 960;  d.W = p.w_ff1; d.g = p.norm_ffn_g; d.out = (bf16_t*)(ws + WS_WT_FF1); d.N = DFF;  d.ldo = 1024; d.kt = u / 64; d.nt = u % 64; }
    else if (t < 1984) { const int u = t - 1472; d.W = p.w_ff2; d.g = nullptr;      d.out = (bf16_t*)(ws + WS_WT_FF2); d.N = 1024; d.ldo = 4096; d.kt = u / 16; d.nt = u % 16; }
    else if (t < 2112) { const int u = t - 1984; d.W = p.w_in;  d.g = p.norm_mix_g; d.out = (bf16_t*)(ws + WS_WT_IN);  d.N = NIN;  d.ldo = 1024; d.kt = u / 16; d.nt = 8 + u % 16; }
    else               { const int u = t - 2112, j = u % 24; d.W = p.w_in; d.g = p.norm_mix_g; d.out = (bf16_t*)(ws + WS_WT_IN); d.N = NIN; d.ldo = 1024; d.kt = u / 24; d.nt = j < 8 ? j : 16 + j; }
    return d;
}
__device__ __forceinline__ void tile_load(const TD& d, f32x4 (&v)[4], float (&sc)[4]) {
    const int tid = threadIdx.x, r = tid >> 4, c4 = tid & 15;
#pragma unroll
    for (int i = 0; i < 4; ++i) { const int k = 128 * d.kt + r + 32 * i; v[i] = __builtin_nontemporal_load((const f32x4*)(d.W + (size_t)k * d.N + 64 * d.nt + 4 * c4)); sc[i] = d.g ? d.g[k] : 1.0f; }
}
__device__ __forceinline__ void transpose_range(const Params& p, unsigned char* lds, int t_begin, int t_end, int first, int stride) {
    bf16_t* T0 = (bf16_t*)lds;
    bf16_t* T1 = (bf16_t*)(lds + 17408);
    const int tid = threadIdx.x, r = tid >> 4, c4 = tid & 15, n = tid >> 3, ks = tid & 7;
    int ta = t_begin + first;
    if (ta >= t_end) return;
    int tb = ta + stride; bool hb = tb < t_end;
    TD da = tile_desc(p, ta), db = da; f32x4 va[4], vb[4]; float sa[4], sb[4];
    tile_load(da, va, sa);
    if (hb) { db = tile_desc(p, tb); tile_load(db, vb, sb); }
    for (;;) {
#pragma unroll
        for (int i = 0; i < 4; ++i) { const int kl = r + 32 * i;
            T0[(4 * c4 + 0) * 136 + kl] = f2bf(va[i][0] * sa[i]); T0[(4 * c4 + 1) * 136 + kl] = f2bf(va[i][1] * sa[i]);
            T0[(4 * c4 + 2) * 136 + kl] = f2bf(va[i][2] * sa[i]); T0[(4 * c4 + 3) * 136 + kl] = f2bf(va[i][3] * sa[i]); }
        if (hb) {
#pragma unroll
            for (int i = 0; i < 4; ++i) { const int kl = r + 32 * i;
                T1[(4 * c4 + 0) * 136 + kl] = f2bf(vb[i][0] * sb[i]); T1[(4 * c4 + 1) * 136 + kl] = f2bf(vb[i][1] * sb[i]);
                T1[(4 * c4 + 2) * 136 + kl] = f2bf(vb[i][2] * sb[i]); T1[(4 * c4 + 3) * 136 + kl] = f2bf(vb[i][3] * sb[i]); } }
        __syncthreads();
        const int tna = ta + 2 * stride, tnb = tna + stride; const bool hna = tna < t_end, hnb = tnb < t_end;
        const TD ca = da, cb = db; const bool chb = hb;
        if (hna) { da = tile_desc(p, tna); tile_load(da, va, sa); }
        if (hnb) { db = tile_desc(p, tnb); tile_load(db, vb, sb); }
        { const u32x4* src = (const u32x4*)(T0 + n * 136 + 16 * ks); const u32x4 a = src[0], b = src[1];
          u32x4* dst = (u32x4*)(ca.out + (size_t)(64 * ca.nt + n) * ca.ldo + 128 * ca.kt + 16 * ks); dst[0] = a; dst[1] = b; }
        if (chb) { const u32x4* src = (const u32x4*)(T1 + n * 136 + 16 * ks); const u32x4 a = src[0], b = src[1];
          u32x4* dst = (u32x4*)(cb.out + (size_t)(64 * cb.nt + n) * cb.ldo + 128 * cb.kt + 16 * ks); dst[0] = a; dst[1] = b; }
        __syncthreads();
        if (!hna) break;
        ta = tna; hb = hnb;
    }
}
__device__ __forceinline__ void phase_prep(const Params p, unsigned char* lds, bool shadow) {
    unsigned char* ws = p.ws;
    const int G = gridDim.x;
    {
        const int lane = threadIdx.x & 63, gw = blockIdx.x * (NTHREADS / 64) + (threadIdx.x >> 6), nw = G * (NTHREADS / 64);
        int r = gw;
        f32x4 v[4], vn[4];
        if (r < MROWS + MEMROWS) { const float* src = r < MROWS ? p.x + (size_t)r * DM : p.mem + (size_t)(r - MROWS) * DM;
#pragma unroll
            for (int i = 0; i < 4; ++i) v[i] = __builtin_nontemporal_load((const f32x4*)src + lane + 64 * i); }
        for (; r < MROWS + MEMROWS; r += nw) {
            const int rn = r + nw;
            if (rn < MROWS + MEMROWS) { const float* src = rn < MROWS ? p.x + (size_t)rn * DM : p.mem + (size_t)(rn - MROWS) * DM;
#pragma unroll
                for (int i = 0; i < 4; ++i) vn[i] = __builtin_nontemporal_load((const f32x4*)src + lane + 64 * i); }
            const bool isx = r < MROWS;
            bf16_t* dst = isx ? (bf16_t*)(ws + WS_XB) + (size_t)r * DM : (bf16_t*)(ws + WS_MEMB) + (size_t)(r - MROWS) * DM;
            float ss = 0.f;
#pragma unroll
            for (int i = 0; i < 4; ++i) ss += (v[i][0] * v[i][0] + v[i][1] * v[i][1]) + (v[i][2] * v[i][2] + v[i][3] * v[i][3]);
#pragma unroll
            for (int o = 1; o < 64; o <<= 1) ss += __shfl_xor(ss, o);
#pragma unroll
            for (int i = 0; i < 4; ++i) { u32x2 w; w.x = cvt_pk_bf16(v[i][0], v[i][1]); w.y = cvt_pk_bf16(v[i][2], v[i][3]); ((u32x2*)dst)[lane + 64 * i] = w; }
            if (lane == 0) { const float rstd = rsqrtf(ss * (1.0f / 1024.0f) + EPS); if (isx) ((float*)(ws + WS_RSTD0))[r] = rstd; else ((float*)(ws + WS_RSTDM))[r - MROWS] = rstd; }
#pragma unroll
            for (int i = 0; i < 4; ++i) v[i] = vn[i];
        }
    }
    if (shadow) transpose_range(p, lds, 1984, 2112, blockIdx.x, G);
    else transpose_range(p, lds, 0, 576, blockIdx.x, G);
}
__device__ __forceinline__ void deferred_prep(const Params p, unsigned char* lds, int j, int nworkers) {
    transpose_range(p, lds, 576, 1984, j, nworkers);
}
__device__ __forceinline__ void fold_pool_weights_mfma(const Params& p) {
    bf16_t* wto = (bf16_t*)(p.ws + WS_WT_OUT);
    const int tid = threadIdx.x, w = tid >> 6, lane = tid & 63, fr = lane & 15, q = lane >> 4;
    for (int item = blockIdx.x; item < 256; item += gridDim.x) {
        const int gi = item >> 6, nb = item & 63;
        f32x4 acc = (f32x4){0.f, 0.f, 0.f, 0.f};
        const float* wp = p.w_pool + (size_t)(gi * 128 + 16 * w + fr) * 128;
        const float* ps = p.pool_scale + gi * 128;
        const bf16_t* arow = wto + (size_t)(16 * nb + fr) * 1024 + 512 + gi * 128;
#pragma unroll
        for (int ks = 0; ks < 4; ++ks) {
            const int d0 = 32 * ks + 8 * q;
            const f32x4 w0 = *(const f32x4*)(wp + d0), w1 = *(const f32x4*)(wp + d0 + 4), s0 = *(const f32x4*)(ps + d0), s1 = *(const f32x4*)(ps + d0 + 4);
            const bf16x8 cfr = mk8u(cvt_pk_bf16(w0[0] * s0[0], w0[1] * s0[1]), cvt_pk_bf16(w0[2] * s0[2], w0[3] * s0[3]), cvt_pk_bf16(w1[0] * s1[0], w1[1] * s1[1]), cvt_pk_bf16(w1[2] * s1[2], w1[3] * s1[3]));
            const bf16x8 nfr = *(const bf16x8*)(arow + d0);
            acc = mfma16(cfr, nfr, acc);
        }
        asm volatile("s_waitcnt vmcnt(0)" ::: "memory");
        __syncthreads();
        u32x2 o; o.x = cvt_pk_bf16(acc[0], acc[1]); o.y = cvt_pk_bf16(acc[2], acc[3]);
        *(u32x2*)(wto + (size_t)(16 * nb + fr) * 1024 + 512 + gi * 128 + 16 * w + 4 * q) = o;
        __syncthreads();
    }
}

__device__ __forceinline__ void phase_passA(const bf16_t* __restrict__ KH, const float* __restrict__ LF, const bf16_t* __restrict__ VH, bf16_t* __restrict__ LT, float* __restrict__ DEC, unsigned char* lds, int first, int stride, int ubeg, int uend) {
    const int tid = threadIdx.x, ch = tid & 127, seg = tid >> 7;
    float* segtot = (float*)lds;
    unsigned char* KdT = lds + 2048;
    unsigned char* VTl = lds + 2048 + 18432;
    const int w = tid >> 6, lane = tid & 63, fr = lane & 15, q = lane >> 4;
    float lf[16], kk[16]; unsigned vr[16];
    int unit = ubeg + first;
    if (unit < uend) { const int b = unit >> 8, c = (unit >> 2) & 63, h = unit & 3; const size_t g0 = (size_t)(b * SEQ + c * 64 + seg * 16) * 512 + h * 128 + ch;
#pragma unroll
        for (int i = 0; i < 16; ++i) { lf[i] = LF[g0 + (size_t)i * 512]; vr[i] = VH[g0 + (size_t)i * 512]; } }
    for (; unit < uend; unit += stride) {
        const int b = unit >> 8, c = (unit >> 2) & 63, h = unit & 3, bh = b * 4 + h;
#pragma unroll
        for (int i = 0; i < 16; ++i) kk[i] = 1.0f - __expf(lf[i]);
#pragma unroll
        for (int i = 1; i < 16; ++i) lf[i] += lf[i - 1];
        segtot[seg * 128 + ch] = lf[15];
        __syncthreads();
        float after = 0.f;
#pragma unroll
        for (int s2 = 1; s2 < 4; ++s2) if (s2 > seg) after += segtot[s2 * 128 + ch];
        const float tot = after + lf[15];
        if (seg == 0) DEC[(size_t)(bh * 64 + c) * 128 + ch] = __expf(tot);
        unsigned kd[8], vp[8];
#pragma unroll
        for (int i = 0; i < 8; ++i) {
            kd[i] = cvt_pk_bf16(kk[2 * i] * __expf(tot - lf[2 * i]), kk[2 * i + 1] * __expf(tot - lf[2 * i + 1]));
            vp[i] = vr[2 * i] | (vr[2 * i + 1] << 16);
        }
        { u32x4* d = (u32x4*)(KdT + ch * 144 + seg * 32); d[0] = (u32x4){kd[0], kd[1], kd[2], kd[3]}; d[1] = (u32x4){kd[4], kd[5], kd[6], kd[7]}; }
        { u32x4* d = (u32x4*)(VTl + ch * 144 + seg * 32); d[0] = (u32x4){vp[0], vp[1], vp[2], vp[3]}; d[1] = (u32x4){vp[4], vp[5], vp[6], vp[7]}; }
        __syncthreads();
        {
            const int un = unit + stride;
            if (un < uend) { const int b2 = un >> 8, c2 = (un >> 2) & 63, h2 = un & 3; const size_t g0 = (size_t)(b2 * SEQ + c2 * 64 + seg * 16) * 512 + h2 * 128 + ch;
#pragma unroll
                for (int i = 0; i < 16; ++i) { lf[i] = LF[g0 + (size_t)i * 512]; vr[i] = VH[g0 + (size_t)i * 512]; } }
        }
        bf16x8 a[2];
#pragma unroll
        for (int ks = 0; ks < 2; ++ks) a[ks] = *(const bf16x8*)(KdT + (16 * w + fr) * 144 + (32 * ks + 8 * q) * 2);
        bf16_t* ltp = LT + (size_t)(bh * 64 + c) * 16384;
#pragma unroll
        for (int vb = 0; vb < 8; ++vb) {
            f32x4 acc = (f32x4){0.f, 0.f, 0.f, 0.f};
#pragma unroll
            for (int ks = 0; ks < 2; ++ks) { const bf16x8 bfr = *(const bf16x8*)(VTl + (16 * vb + fr) * 144 + (32 * ks + 8 * q) * 2); acc = mfma16(a[ks], bfr, acc); }
            u32x2 pk; pk.x = cvt_pk_bf16(acc[0], acc[1]); pk.y = cvt_pk_bf16(acc[2], acc[3]);
            *(u32x2*)(ltp + (size_t)(16 * vb + fr) * 128 + 16 * w + 4 * q) = pk;
        }
        __syncthreads();
    }
}

template <int W>
__device__ __forceinline__ void pool_body(const bf16_t* __restrict__ PH, bf16_t* __restrict__ MIXED, int r0, int s0, int c0) {
    unsigned v[31 + W];
#pragma unroll
    for (int j = 1; j < W; ++j) v[W - 1 - j] = (s0 - j >= 0) ? *(const unsigned*)(PH + (size_t)(r0 - j) * 512 + c0) : 0u;
#pragma unroll
    for (int tt = 0; tt < 32; ++tt) v[W - 1 + tt] = *(const unsigned*)(PH + (size_t)(r0 + tt) * 512 + c0);
    float sx = 0.f, sy = 0.f;
#pragma unroll
    for (int j = 1; j < W; ++j) { sx += bflo(v[W - 1 - j]); sy += bfhi(v[W - 1 - j]); }
#pragma unroll
    for (int tt = 0; tt < 32; ++tt) {
        const int s = s0 + tt;
        const float px = bflo(v[W - 1 + tt]), py = bfhi(v[W - 1 + tt]);
        sx += px; sy += py;
        const int cnt = (s + 1) < W ? (s + 1) : W;
        const float inv = __builtin_amdgcn_rcpf((float)cnt);
        *(unsigned*)(MIXED + (size_t)(r0 + tt) * 1024 + 512 + c0) = cvt_pk_bf16(sx * inv - px, sy * inv - py);
        sx -= bflo(v[tt]); sy -= bfhi(v[tt]);
    }
}
__device__ __forceinline__ void pool_tile(const bf16_t* __restrict__ PH, bf16_t* __restrict__ MIXED, int tile) {
    const int tid = threadIdx.x, cp = tid & 255, th = tid >> 8, c0 = 2 * cp, gi = c0 >> 7;
    const int r0 = tile * 64 + th * 32, s0 = r0 & (SEQ - 1);
    if (gi == 0) pool_body<2>(PH, MIXED, r0, s0, c0);
    else if (gi == 1) pool_body<4>(PH, MIXED, r0, s0, c0);
    else if (gi == 2) pool_body<8>(PH, MIXED, r0, s0, c0);
    else pool_body<16>(PH, MIXED, r0, s0, c0);
}

__device__ __forceinline__ void phase_scan(const bf16_t* LT, const float* __restrict__ DEC, bf16_t* ST) {
    for (int e2 = blockIdx.x * NTHREADS + threadIdx.x; e2 < 131072; e2 += gridDim.x * NTHREADS) {
        const int bh = e2 >> 13, v = (e2 >> 6) & 127, kp = e2 & 63;
        float sx = 0.f, sy = 0.f;
        const size_t base = (size_t)bh * 64 * 16384 + (size_t)v * 128 + 2 * kp;
        const float* dp = DEC + (size_t)bh * 64 * 128 + 2 * kp;
        for (int c0 = 0; c0 < 64; c0 += 32) {
            unsigned l[32]; f32x2 d[32];
#pragma unroll
            for (int j = 0; j < 32; ++j) { l[j] = *(const unsigned*)(LT + base + (size_t)(c0 + j) * 16384); d[j] = *(const f32x2*)(dp + (c0 + j) * 128); }
#pragma unroll
            for (int j = 0; j < 32; ++j) {
                *(unsigned*)(ST + base + (size_t)(c0 + j) * 16384) = cvt_pk_bf16(sx, sy);
                sx = d[j][0] * sx + bflo(l[j]); sy = d[j][1] * sy + bfhi(l[j]);
            }
        }
    }
}

__device__ __forceinline__ void phase_passC(const bf16_t* __restrict__ QH, const bf16_t* __restrict__ KH, const float* __restrict__ LF, const bf16_t* __restrict__ VH, const bf16_t* __restrict__ GH,
                                const bf16_t* __restrict__ ST, const float* __restrict__ hg, bf16_t* __restrict__ MIXED, unsigned char* lds) {
    const int tid = threadIdx.x, ch = tid & 127, seg = tid >> 7, G = gridDim.x;
    float lf[16], kk[16]; unsigned qr[16], vr[16];
    int unit = blockIdx.x;
    if (unit < 1024) { const int b = unit >> 8, c = (unit >> 2) & 63, h = unit & 3; const size_t g0 = (size_t)(b * SEQ + c * 64 + seg * 16) * 512 + h * 128 + ch;
#pragma unroll
        for (int i = 0; i < 16; ++i) { lf[i] = LF[g0 + (size_t)i * 512]; vr[i] = VH[g0 + (size_t)i * 512]; qr[i] = QH[g0 + (size_t)i * 512]; } }
  for (; unit < 1024; unit += G) {
    const int b = unit >> 8, c = (unit >> 2) & 63, h = unit & 3;
    const int row0 = b * SEQ + c * 64, bh = b * 4 + h;
    float* segtot = (float*)lds;
    float* rmsp = (float*)(lds + 2048);
    bf16_t* QC = (bf16_t*)(lds + 4096);
    bf16_t* QT = (bf16_t*)(lds + 21504);
    constexpr int KT0 = 38912;
    unsigned char* VTl = lds + 82432;
    const int w = tid >> 6, lane = tid & 63, fr = lane & 15, q = lane >> 4;
    const int i = w & 3, vh = w >> 2;
    const size_t row = (size_t)(row0 + 16 * i + fr);
    u32x2 gt[4]; f32x4 gg[4]; bf16x8 stf[4][4];
    {
        const bf16_t* stp = ST + (size_t)(bh * 64 + c) * 16384;
#pragma unroll
        for (int vbl = 0; vbl < 4; ++vbl) { const int v0 = 16 * (vh * 4 + vbl) + 4 * q; gt[vbl] = *(const u32x2*)(GH + row * 512 + h * 128 + v0); gg[vbl] = *(const f32x4*)(hg + h * 128 + v0);
#pragma unroll
            for (int ks = 0; ks < 4; ++ks) stf[ks][vbl] = *(const bf16x8*)(stp + (size_t)(16 * (vh * 4 + vbl) + fr) * 128 + 32 * ks + 8 * q); }
    }
#pragma unroll
    for (int i2 = 0; i2 < 16; ++i2) kk[i2] = 1.0f - __expf(lf[i2]);
#pragma unroll
    for (int i2 = 1; i2 < 16; ++i2) lf[i2] += lf[i2 - 1];
    segtot[seg * 128 + ch] = lf[15];
    {
        unsigned vp[8];
#pragma unroll
        for (int i2 = 0; i2 < 8; ++i2) vp[i2] = vr[2 * i2] | (vr[2 * i2 + 1] << 16);
        u32x4* d = (u32x4*)(VTl + ch * 144 + seg * 32); d[0] = (u32x4){vp[0], vp[1], vp[2], vp[3]}; d[1] = (u32x4){vp[4], vp[5], vp[6], vp[7]};
    }
    __syncthreads();
    const float t0 = segtot[ch], t1 = segtot[128 + ch], t2 = segtot[256 + ch];
    const float P = (seg > 0 ? t0 : 0.f) + (seg > 1 ? t1 : 0.f) + (seg > 2 ? t2 : 0.f);
    {
        const float eP = __expf(P);
#pragma unroll
        for (int i2 = 0; i2 < 16; ++i2) {
            const float qv = bflo(qr[i2]);
            const float el = __expf(lf[i2]);
            QT[(seg * 16 + i2) * 136 + ch] = f2bf(qv * el);
            QC[(seg * 16 + i2) * 136 + ch] = f2bf(qv * el * eP);
        }
        float E = 0.f;
#pragma unroll
        for (int i2 = 0; i2 < 4; ++i2) {
            if (i2 >= seg) {
                bf16_t* KT = (bf16_t*)(lds + KT0 + 4352 * ((i2 * (i2 + 1)) / 2));
#pragma unroll
                for (int j = 0; j < 16; ++j) KT[(seg * 16 + j) * 136 + ch] = f2bf(kk[j] * __expf(E - lf[j]));
                E += (i2 == 0 ? t0 : (i2 == 1 ? t1 : t2));
            }
        }
    }
    __syncthreads();
    {
        const int un = unit + G;
        if (un < 1024) { const int b2 = un >> 8, c2 = (un >> 2) & 63, h2 = un & 3; const size_t g2 = (size_t)(b2 * SEQ + c2 * 64 + seg * 16) * 512 + h2 * 128 + ch;
#pragma unroll
            for (int i2 = 0; i2 < 16; ++i2) { lf[i2] = LF[g2 + (size_t)i2 * 512]; vr[i2] = VH[g2 + (size_t)i2 * 512]; qr[i2] = QH[g2 + (size_t)i2 * 512]; } }
    }
    f32x4 sT[4];
#pragma unroll
    for (int j = 0; j < 4; ++j) sT[j] = (f32x4){0.f, 0.f, 0.f, 0.f};
    {
        bf16x8 qfr[4];
#pragma unroll
        for (int ks = 0; ks < 4; ++ks) qfr[ks] = *(const bf16x8*)((const unsigned char*)QT + (16 * i + fr) * 272 + (32 * ks + 8 * q) * 2);
        const unsigned char* KT = lds + KT0 + 4352 * ((i * (i + 1)) / 2);
#pragma unroll
        for (int j = 0; j < 4; ++j) if (j <= i) {
#pragma unroll
            for (int ks = 0; ks < 4; ++ks) { const bf16x8 a = *(const bf16x8*)(KT + (16 * j + fr) * 272 + (32 * ks + 8 * q) * 2); sT[j] = mfma16(a, qfr[ks], sT[j]); }
            if (j == i) {
#pragma unroll
                for (int rg = 0; rg < 4; ++rg) if (4 * q + rg > fr) sT[j][rg] = 0.f;
            }
        }
    }
    f32x4 oacc[4];
#pragma unroll
    for (int vbl = 0; vbl < 4; ++vbl) oacc[vbl] = (f32x4){0.f, 0.f, 0.f, 0.f};
#pragma unroll
    for (int m = 0; m < 2; ++m) if (2 * m <= i) {
        const bf16x8 bfrag = mk8u(cvt_pk_bf16(sT[2 * m][0], sT[2 * m][1]), cvt_pk_bf16(sT[2 * m][2], sT[2 * m][3]), cvt_pk_bf16(sT[2 * m + 1][0], sT[2 * m + 1][1]), cvt_pk_bf16(sT[2 * m + 1][2], sT[2 * m + 1][3]));
#pragma unroll
        for (int vbl = 0; vbl < 4; ++vbl) {
            const unsigned char* base = VTl + (16 * (vh * 4 + vbl) + fr) * 144 + (32 * m + 4 * q) * 2;
            const bf16x8 a = mk8(*(const u32x2*)base, *(const u32x2*)(base + 32));
            oacc[vbl] = mfma16(a, bfrag, oacc[vbl]);
        }
    }
    {
#pragma unroll
        for (int ks = 0; ks < 4; ++ks) {
            const bf16x8 bfr = *(const bf16x8*)((const unsigned char*)QC + (16 * i + fr) * 272 + (32 * ks + 8 * q) * 2);
#pragma unroll
            for (int vbl = 0; vbl < 4; ++vbl) oacc[vbl] = mfma16(stf[ks][vbl], bfr, oacc[vbl]);
        }
    }
    float ss = 0.f;
#pragma unroll
    for (int vbl = 0; vbl < 4; ++vbl) ss += (oacc[vbl][0] * oacc[vbl][0] + oacc[vbl][1] * oacc[vbl][1]) + (oacc[vbl][2] * oacc[vbl][2] + oacc[vbl][3] * oacc[vbl][3]);
    ss += __shfl_xor(ss, 16); ss += __shfl_xor(ss, 32);
    if (q == 0) rmsp[vh * 64 + 16 * i + fr] = ss;
    __syncthreads();
    const float rstd = rsqrtf((rmsp[16 * i + fr] + rmsp[64 + 16 * i + fr]) * (1.0f / 128.0f) + EPS);
#pragma unroll
    for (int vbl = 0; vbl < 4; ++vbl) {
        const int v0 = 16 * (vh * 4 + vbl) + 4 * q;
        u32x2 o;
        o.x = cvt_pk_bf16(oacc[vbl][0] * rstd * gg[vbl][0] * bflo(gt[vbl].x), oacc[vbl][1] * rstd * gg[vbl][1] * bfhi(gt[vbl].x));
        o.y = cvt_pk_bf16(oacc[vbl][2] * rstd * gg[vbl][2] * bflo(gt[vbl].y), oacc[vbl][3] * rstd * gg[vbl][3] * bfhi(gt[vbl].y));
        *(u32x2*)(MIXED + row * 1024 + h * 128 + v0) = o;
    }
    __syncthreads();
  }
}

__device__ __forceinline__ void attn_unit(const bf16_t* __restrict__ XQ, const bf16_t* __restrict__ KX, const bf16_t* __restrict__ VT, bf16_t* __restrict__ ATT, int unit, unsigned char* lds) {
    const int tid = threadIdx.x, w = tid >> 6, lane = tid & 63, r = lane & 31, hh = lane >> 5;
    const int b = unit >> 6, st = (unit >> 2) & 15, h = unit & 3;
    const int row0 = b * SEQ + st * 256;
    const bf16_t* qp = XQ + (size_t)(row0 + 32 * w + r) * 1024 + h * 256 + 8 * hh;
    {
        const bf16_t* kp = KX + (size_t)(b * 256) * 1024 + h * 256;
        u32x4 kv[16];
#pragma unroll
        for (int it = 0; it < 16; ++it) { const int idx = tid + 512 * it, m = idx >> 5, cc = idx & 31; kv[it] = *(const u32x4*)(kp + (size_t)m * 1024 + cc * 8); }
#pragma unroll
        for (int it = 0; it < 16; ++it) { const int idx = tid + 512 * it, m = idx >> 5, cc = idx & 31; *(u32x4*)(lds + m * 528 + cc * 16) = kv[it]; }
    }
    __syncthreads();
    f32x16 sacc[8];
#pragma unroll
    for (int mb = 0; mb < 8; ++mb)
#pragma unroll
        for (int e = 0; e < 16; ++e) sacc[mb][e] = 0.f;
    {
        bf16x8 qf[4], qn[4];
#pragma unroll
        for (int k4 = 0; k4 < 4; ++k4) qf[k4] = *(const bf16x8*)(qp + 16 * k4);
#pragma unroll
        for (int kg = 0; kg < 4; ++kg) {
            if (kg < 3) {
#pragma unroll
                for (int k4 = 0; k4 < 4; ++k4) qn[k4] = *(const bf16x8*)(qp + 16 * (4 * (kg + 1) + k4)); }
#pragma unroll
            for (int k4 = 0; k4 < 4; ++k4)
#pragma unroll
                for (int mb = 0; mb < 8; ++mb) { const bf16x8 a = *(const bf16x8*)(lds + (32 * mb + r) * 528 + (16 * (4 * kg + k4) + 8 * hh) * 2); sacc[mb] = mfma32(a, qf[k4], sacc[mb]); }
#pragma unroll
            for (int k4 = 0; k4 < 4; ++k4) qf[k4] = qn[k4];
        }
    }
    float mx = -3.0e38f;
#pragma unroll
    for (int mb = 0; mb < 8; ++mb)
#pragma unroll
        for (int e = 0; e < 16; ++e) mx = fmaxf(mx, sacc[mb][e]);
    mx = fmaxf(mx, __shfl_xor(mx, 32));
    float sum = 0.f;
    bf16x8 pf[8][2];
#pragma unroll
    for (int mb = 0; mb < 8; ++mb) {
        float pv[16];
#pragma unroll
        for (int e = 0; e < 16; ++e) { pv[e] = __expf(sacc[mb][e] - mx); sum += pv[e]; }
#pragma unroll
        for (int s = 0; s < 2; ++s) pf[mb][s] = mk8u(cvt_pk_bf16(pv[8 * s + 0], pv[8 * s + 1]), cvt_pk_bf16(pv[8 * s + 2], pv[8 * s + 3]), cvt_pk_bf16(pv[8 * s + 4], pv[8 * s + 5]), cvt_pk_bf16(pv[8 * s + 6], pv[8 * s + 7]));
    }
    sum += __shfl_xor(sum, 32);
    const float inv = 1.0f / sum;
    __syncthreads();
    {
        const bf16_t* vp = VT + (size_t)(h * 256) * 1024 + b * 256;
        u32x4 vv[16];
#pragma unroll
        for (int it = 0; it < 16; ++it) { const int idx = tid + 512 * it, e = idx >> 5, cc = idx & 31; vv[it] = *(const u32x4*)(vp + (size_t)e * 1024 + cc * 8); }
#pragma unroll
        for (int it = 0; it < 16; ++it) { const int idx = tid + 512 * it, e = idx >> 5, cc = idx & 31;
            u32x2* d = (u32x2*)(lds + e * 520 + cc * 16); d[0] = (u32x2){vv[it].x, vv[it].y}; d[1] = (u32x2){vv[it].z, vv[it].w}; }
    }
    __syncthreads();
    bf16_t* op = ATT + (size_t)(row0 + 32 * w + r) * 1024 + h * 256 + 8 * hh;
#pragma unroll
    for (int half = 0; half < 2; ++half) {
        f32x16 oacc[4];
#pragma unroll
        for (int d = 0; d < 4; ++d)
#pragma unroll
            for (int e = 0; e < 16; ++e) oacc[d][e] = 0.f;
#pragma unroll
        for (int mb = 0; mb < 8; ++mb)
#pragma unroll
            for (int s = 0; s < 2; ++s)
#pragma unroll
                for (int d = 0; d < 4; ++d) {
                    const unsigned char* base = lds + (32 * (half * 4 + d) + r) * 520 + (32 * mb + 16 * s + 4 * hh) * 2;
                    const bf16x8 a = mk8(*(const u32x2*)base, *(const u32x2*)(base + 16));
                    oacc[d] = mfma32(a, pf[mb][s], oacc[d]);
                }
#pragma unroll
        for (int d = 0; d < 4; ++d)
#pragma unroll
            for (int pp = 0; pp < 2; ++pp) {
                unsigned ax = cvt_pk_bf16(oacc[d][8 * pp] * inv, oacc[d][8 * pp + 1] * inv), ay = cvt_pk_bf16(oacc[d][8 * pp + 2] * inv, oacc[d][8 * pp + 3] * inv);
                unsigned bx = cvt_pk_bf16(oacc[d][8 * pp + 4] * inv, oacc[d][8 * pp + 5] * inv), by = cvt_pk_bf16(oacc[d][8 * pp + 6] * inv, oacc[d][8 * pp + 7] * inv);
                { auto t = __builtin_amdgcn_permlane32_swap(ax, bx, false, false); ax = t[0]; bx = t[1]; }
                { auto t = __builtin_amdgcn_permlane32_swap(ay, by, false, false); ay = t[0]; by = t[1]; }
                u32x4 o; o.x = ax; o.y = ay; o.z = bx; o.w = by;
                *(u32x4*)(op + 32 * (half * 4 + d) + 16 * pp) = o;
            }
    }
    __syncthreads();
}

__device__ __forceinline__ void phase_final(const bf16_t* __restrict__ xb, const float* __restrict__ ssq, float* __restrict__ out, const float* __restrict__ g) {
    const int tid = threadIdx.x, sub = tid >> 7, l = tid & 127;
    const f32x4 g0 = *(const f32x4*)(g + 8 * l), g1 = *(const f32x4*)(g + 8 * l + 4);
    for (int r = blockIdx.x * 4 + sub; r < MROWS; r += gridDim.x * 4) {
        const u32x4 v = *(const u32x4*)(xb + (size_t)r * DM + 8 * l);
        const f32x4* pp = (const f32x4*)(ssq + (size_t)r * 16); const f32x4 a = pp[0], b = pp[1], c = pp[2], d = pp[3];
        const float t = ((a[0] + a[1]) + (a[2] + a[3])) + ((b[0] + b[1]) + (b[2] + b[3])) + ((c[0] + c[1]) + (c[2] + c[3])) + ((d[0] + d[1]) + (d[2] + d[3]));
        const float rstd = rsqrtf(t * (1.0f / 1024.0f) + EPS);
        const f32x4 o0 = (f32x4){bflo(v.x), bfhi(v.x), bflo(v.y), bfhi(v.y)} * rstd * g0, o1 = (f32x4){bflo(v.z), bfhi(v.z), bflo(v.w), bfhi(v.w)} * rstd * g1;
        *(f32x4*)(out + (size_t)r * DM + 8 * l) = o0; *(f32x4*)(out + (size_t)r * DM + 8 * l + 4) = o1;
    }
}

#define XB_TMO      128
#define XB_XCNT(j)  (256  + 64 * (j))
#define XB_XSUB(j)  (1280 + 64 * (j))
#define XB_XGEN(j)  (2304 + 64 * (j))
#define XB_TOP      3328
#define XB_TOPGEN   3392
#define XCD_BAR_WORDS 3456
#define XB_SPIN_CAP (1u << 22)
__device__ __forceinline__ unsigned xb_ld(unsigned* p)              { return __hip_atomic_load(p, __ATOMIC_RELAXED, __HIP_MEMORY_SCOPE_AGENT); }
__device__ __forceinline__ unsigned xb_add(unsigned* p, unsigned v) { return __hip_atomic_fetch_add(p, v, __ATOMIC_RELAXED, __HIP_MEMORY_SCOPE_AGENT); }
__device__ __forceinline__ unsigned xb_xcc_id() { return (unsigned)__builtin_amdgcn_s_getreg((3 << 11) | 20) & 0xFu; }
#define XB_SPIN(cond, bar) do { unsigned _sp = 0; while (cond) { __builtin_amdgcn_s_sleep(1); \
    if ((++_sp & 255u) == 0u) { if (xb_ld(&(bar)[XB_TMO])) break; if (_sp > XB_SPIN_CAP) { atomicAdd(&(bar)[XB_TMO], 1u); break; } } } } while (0)
struct XcdBarrier { unsigned* bar; unsigned x; volatile LAS unsigned* st; };
__device__ __forceinline__ XcdBarrier xcd_barrier_post(unsigned* bar, volatile LAS unsigned* st) {
    XcdBarrier b; b.bar = bar; b.x = xb_xcc_id(); b.st = st;
    if (threadIdx.x == 0) (void)xb_add(&bar[XB_XCNT(b.x)], 1u);
    return b;
}
__device__ __forceinline__ void xcd_barrier_complete(unsigned* bar, unsigned x, unsigned& nloc, unsigned& nx) {
    const unsigned G = gridDim.x * gridDim.y * gridDim.z;
    unsigned sum, cnt, mine, sp = 0u;
    for (;;) {
        sum = 0u; cnt = 0u; mine = 0u;
#pragma unroll
        for (unsigned j = 0; j < 16; ++j) { const unsigned c = xb_ld(&bar[XB_XCNT(j)]); sum += c; cnt += (c > 0u) ? 1u : 0u; mine = (j == x) ? c : mine; }
        if (sum == G) break;
        __builtin_amdgcn_s_sleep(1);
        if ((++sp & 255u) == 0u) { if (xb_ld(&bar[XB_TMO])) break; if (sp > XB_SPIN_CAP) { atomicAdd(&bar[XB_TMO], 1u); break; } }
    }
    nloc = mine > 0u ? mine : 1u; nx = cnt > 0u ? cnt : 1u;
}
__device__ __forceinline__ void xcd_barrier(const XcdBarrier& b) {
    asm volatile("s_waitcnt vmcnt(0)" ::: "memory");
    __syncthreads();
    if (threadIdx.x == 0) {
        unsigned* bar = b.bar;
        __builtin_amdgcn_s_waitcnt(0);
        unsigned nloc = b.st[0], nx = b.st[1];
        if (nloc == 0u) { xcd_barrier_complete(bar, b.x, nloc, nx); b.st[0] = nloc; b.st[1] = nx; }
        const unsigned old = xb_add(&bar[XB_XSUB(b.x)], 1u);
        const unsigned gen = old / nloc;
        if (old + 1u == (gen + 1u) * nloc) {
            __builtin_amdgcn_fence(__ATOMIC_RELEASE, "agent");
            asm volatile("s_waitcnt vmcnt(0)" ::: "memory");
            const unsigned og = xb_add(&bar[XB_TOP], 1u);
            const unsigned tg = og / nx;
            if (og + 1u == (tg + 1u) * nx) xb_add(&bar[XB_TOPGEN], 1u);
            else XB_SPIN(xb_ld(&bar[XB_TOPGEN]) == tg, bar);
            __builtin_amdgcn_fence(__ATOMIC_ACQUIRE, "agent");
            asm volatile("s_waitcnt vmcnt(0)" ::: "memory");
        } else {
            XB_SPIN(xb_ld(&bar[XB_TOPGEN]) == gen, bar);
            __builtin_amdgcn_fence(__ATOMIC_ACQUIRE, "agent");
            asm volatile("s_waitcnt vmcnt(0)" ::: "memory");
        }
    }
    __syncthreads();
}

__device__ __forceinline__ unsigned xcd_arrive(const XcdBarrier& b) {
    asm volatile("s_waitcnt vmcnt(0)" ::: "memory");
    __syncthreads();
    unsigned gen = 0u;
    if (threadIdx.x == 0) {
        unsigned* bar = b.bar;
        __builtin_amdgcn_s_waitcnt(0);
        unsigned nloc = b.st[0], nx = b.st[1];
        if (nloc == 0u) { xcd_barrier_complete(bar, b.x, nloc, nx); b.st[0] = nloc; b.st[1] = nx; }
        const unsigned old = xb_add(&bar[XB_XSUB(b.x)], 1u);
        gen = old / nloc;
        if (old + 1u == (gen + 1u) * nloc) {
            __builtin_amdgcn_fence(__ATOMIC_RELEASE, "agent");
            asm volatile("s_waitcnt vmcnt(0)" ::: "memory");
            (void)xb_add(&bar[XB_TOP], 1u);
        }
    }
    return gen;
}
__device__ __forceinline__ void xcd_wait(const XcdBarrier& b, unsigned gen) {
    if (threadIdx.x == 0) {
        unsigned* bar = b.bar;
        const unsigned want = (gen + 1u) * b.st[1];
        XB_SPIN(xb_ld(&bar[XB_TOP]) < want, bar);
        __builtin_amdgcn_fence(__ATOMIC_ACQUIRE, "agent");
        asm volatile("s_waitcnt vmcnt(0)" ::: "memory");
    }
    __syncthreads();
}
__device__ __forceinline__ void shadow_work(const Params& p, unsigned char* lds, int k, int bid, int G) {
    const int lo = bid, hi2 = (bid + 128) % G;
    if (k == 0)      { transpose_range(p, lds, 2112, 2304, lo, G);  transpose_range(p, lds, 320, 576, (bid + 64) % G, G); }
    else if (k == 1) { transpose_range(p, lds, 832, 960, lo, G);    transpose_range(p, lds, 960, 1088, hi2, G); }
    else if (k == 2) { transpose_range(p, lds, 576, 704, lo, G);    transpose_range(p, lds, 1088, 1216, hi2, G); }
    else if (k == 3) { for (int t = bid; t < 256; t += G) pool_tile((const bf16_t*)(p.ws + WS_PH), (bf16_t*)(p.ws + WS_MIXED), t); }
    else if (k == 4) { transpose_range(p, lds, 704, 832, lo, G);    transpose_range(p, lds, 1216, 1344, hi2, G); }
    else if (k == 5) { transpose_range(p, lds, 1344, 1472, lo, G);  transpose_range(p, lds, 1472, 1600, hi2, G); }
    else if (k == 7) { transpose_range(p, lds, 1600, 1856, lo, G); }
    else if (k == 8) { transpose_range(p, lds, 1856, 1984, lo, G); }
}

constexpr int N_PHASES = 12;
__global__ void __launch_bounds__(NTHREADS, 2) mega(Params p) {
    extern __shared__ __attribute__((aligned(16))) unsigned char lds[];
    LAS unsigned char* ldsl = (LAS unsigned char*)lds;
    unsigned char* ws = p.ws;
    const int G = gridDim.x, bid = blockIdx.x;
    const int lo = p.ph_lo, hi = p.ph_hi;

#ifndef DEFER_PREP
#define DEFER_PREP 0
#endif
#ifndef FUSE_FINAL
#define FUSE_FINAL 0
#endif
#ifndef DBG_LAST
#define DBG_LAST -1
#endif
#ifndef PHASE_MASK
#define PHASE_MASK 0xfff
#endif
#define IN(k) (((PHASE_MASK >> (k)) & 1) && lo <= (k) && (k) < hi)
    if (threadIdx.x == 0) { ((volatile LAS unsigned*)(ldsl + LDS_MAIN))[0] = 0u; ((volatile LAS unsigned*)(ldsl + LDS_MAIN))[1] = 0u; }
    __syncthreads();
    XcdBarrier xbar; xbar.bar = (unsigned*)(ws + WS_BAR); xbar.x = 0; xbar.st = nullptr;
    if (hi - lo > 1) xbar = xcd_barrier_post((unsigned*)(ws + WS_BAR), (volatile LAS unsigned*)(ldsl + LDS_MAIN));
    if (lo > hi) cg::this_grid().sync();
    const bool shadow = (G == 256) && (hi - lo == N_PHASES);
#define SEAM(k) do { if (IN(k) && IN((k) + 1)) { const unsigned g_ = xcd_arrive(xbar); if (shadow) shadow_work(p, lds, (k), bid, G); xcd_wait(xbar, g_); } } while (0)
    bf16_t* XB = (bf16_t*)(ws + WS_XB); bf16_t* LT = (bf16_t*)(ws + WS_ST);
    bf16_t* QH = (bf16_t*)(ws + WS_QH); bf16_t* KH = (bf16_t*)(ws + WS_KH); bf16_t* VH = (bf16_t*)(ws + WS_VH); bf16_t* GH = (bf16_t*)(ws + WS_GH); bf16_t* PH = (bf16_t*)(ws + WS_PH);
    float* LF = (float*)(ws + WS_LF); bf16_t* ST = (bf16_t*)(ws + WS_ST); bf16_t* MIXED = (bf16_t*)(ws + WS_MIXED);
    float* X1 = (float*)(ws + WS_X1); bf16_t* XQ = (bf16_t*)(ws + WS_XQ); bf16_t* ATT = (bf16_t*)(ws + WS_ATT); bf16_t* U = (bf16_t*)(ws + WS_U);
    float* SSQ = (float*)(ws + WS_SSQ); float* DEC = (float*)(ws + WS_DEC);
    bf16_t* MEMB = (bf16_t*)(ws + WS_MEMB); bf16_t* KX = (bf16_t*)(ws + WS_KX); bf16_t* VT = (bf16_t*)(ws + WS_VT);

    const bool fuse_final = FUSE_FINAL && (G == 256) && IN(10) && (hi - lo > 1);
    if (IN(0)) { phase_prep(p, lds, shadow);
#if !DEFER_PREP
        if (!shadow) deferred_prep(p, lds, bid, G);
#endif
    }
    SEAM(0);
    const bf16_t* WTIN = (const bf16_t*)(ws + WS_WT_IN);
    if (IN(1)) {
        const pg8::Epi E{0, ws, p.x, p.out, p.lb_logits, p.final_norm_g, 2};
        pg8::Gemm g{XB, WTIN + (size_t)512 * DM, MROWS, 1024, DM}; pg8::StaticOrder S; S.init(MROWS, 1024, G, bid); pg8::gemm_phase(ldsl, g, S, E);
    }
    SEAM(1);
    if (IN(2)) {
        { const pg8::Epi E{0, ws, p.x, p.out, p.lb_logits, p.final_norm_g, 6};
          pg8::Gemm g{XB, WTIN + (size_t)1536 * DM, MROWS, 1024, DM}; pg8::StaticOrder S; S.init(MROWS, 1024, G, bid); pg8::gemm_phase(ldsl, g, S, E); }
        { const pg8::Epi E{0, ws, p.x, p.out, p.lb_logits, p.final_norm_g, 0};
          pg8::Gemm g{XB, WTIN, MROWS, 512, DM}; pg8::StaticOrder S; S.init(MROWS, 512, G, bid); pg8::gemm_phase(ldsl, g, S, E); }
        const pg8::Epi E1{1, ws, p.x, p.out, p.lb_logits, p.final_norm_g, 0};
        { pg8::Gemm g{MEMB, (const bf16_t*)(ws + WS_WT_K), MEMROWS, 1024, DM}; pg8::StaticOrder S; S.init(MEMROWS, 1024, G, (bid + 128) % G); pg8::gemm_phase(ldsl, g, S, E1); }
        const pg8::Epi E2{2, ws, p.x, p.out, p.lb_logits, p.final_norm_g, 0};
        { pg8::Gemm g{(const bf16_t*)(ws + WS_WT_V), MEMB, 1024, MEMROWS, DM}; pg8::StaticOrder S; S.init(1024, MEMROWS, G, (bid + 112) % G); pg8::gemm_phase(ldsl, g, S, E2); }
        if (G == 256) {
            if (bid >= 160) phase_passA(KH, LF, VH, LT, DEC, lds, bid - 160, 96, 0, 512);
            phase_passA(KH, LF, VH, LT, DEC, lds, bid, G, 512, 1024);
        } else phase_passA(KH, LF, VH, LT, DEC, lds, bid, G, 0, 1024);
    }
    SEAM(2);
    if (IN(3)) {
        phase_scan(LT, DEC, ST);
        if (!shadow) { for (int t = bid; t < 256; t += G) pool_tile(PH, MIXED, t); }
        fold_pool_weights_mfma(p);
    }
    SEAM(3);
    if (IN(4)) { phase_passC(QH, KH, LF, VH, GH, ST, p.hgrn_norm_g, MIXED, lds); }
    SEAM(4);
    if (IN(5)) {
        const pg8::Epi E{6, ws, p.x, p.out, p.lb_logits, p.final_norm_g, 0};
        pg8::Gemm g{MIXED, (const bf16_t*)(ws + WS_WT_OUT), MROWS, DM, DM}; pg8::StaticOrder S; S.init(MROWS, DM, G, bid); pg8::gemm_phase(ldsl, g, S, E);
    }
    SEAM(5);
    const bool fuse_attn = (G == 256) && IN(6) && IN(7);
    if (IN(6)) {
        const pg8::Epi E{4, ws, p.x, p.out, p.lb_logits, p.final_norm_g, 0};
        pg8::Gemm g{XB, (const bf16_t*)(ws + WS_WT_Q), MROWS, DM, DM}; pg8::StaticOrder S; S.init(MROWS, DM, G, bid); pg8::gemm_phase(ldsl, g, S, E);
        if (fuse_attn) {
            pg8::Unit u; S.next(0, u);
            asm volatile("s_waitcnt vmcnt(0)" ::: "memory"); __syncthreads();
            attn_unit(XQ, KX, VT, ATT, u.pm * 4 + u.pn, lds);
        }
    }
    if (!fuse_attn) {
        SEAM(6);
        if (IN(7)) { for (int u = bid; u < 256; u += G) attn_unit(XQ, KX, VT, ATT, u, lds); }
    }
    SEAM(7);
    if (IN(8)) {
        const pg8::Epi E{6, ws, p.x, p.out, p.lb_logits, p.final_norm_g, 0};
        pg8::Gemm g{ATT, (const bf16_t*)(ws + WS_WT_O), MROWS, DM, DM}; pg8::StaticOrder S; S.init(MROWS, DM, G, bid); pg8::gemm_phase(ldsl, g, S, E);
    }
    SEAM(8);
    if (IN(9)) {
        const pg8::Epi E{5, ws, p.x, p.out, p.lb_logits, p.final_norm_g, 0};
        pg8::Gemm g{XB, (const bf16_t*)(ws + WS_WT_FF1), MROWS, DFF, DM}; pg8::StaticOrder S; S.init(MROWS, DFF, G, bid); pg8::gemm_phase(ldsl, g, S, E);
    }
    SEAM(9);
    if (IN(10)) {
        const pg8::Epi E{fuse_final ? 8 : 7, ws, p.x, p.out, p.lb_logits, p.final_norm_g, 0};
        pg8::Gemm g{U, (const bf16_t*)(ws + WS_WT_FF2), MROWS, DM, DFF}; pg8::StaticOrder S; S.init(MROWS, DM, G, bid); pg8::gemm_phase(ldsl, g, S, E);
    }
    if (!fuse_final) {
        SEAM(10);
        if (IN(11)) { phase_final(XB, SSQ, p.out, p.final_norm_g); }
    }
#if DBG_LAST >= 0
    cg::this_grid().sync();
    {
        const unsigned* w32 = (const unsigned*)ws;
        for (size_t i = (size_t)bid * NTHREADS + threadIdx.x; i < (size_t)MROWS * DM; i += (size_t)G * NTHREADS) {
            float a = 0.f;
            for (int j = 0; j < 4; ++j) { const unsigned v = w32[i + (size_t)j * MROWS * DM]; a += (float)(v & 0xffffu) + (float)(v >> 16); }
            p.out[i] = a;
        }
    }
#endif
#undef IN
#undef SEAM
}

extern "C" void kernel_launch(void* const* d_in, const int* in_sizes, int n_in, void* d_out, int out_size, void* d_ws, size_t ws_size, hipStream_t stream) {
    static int grid = 0;
    if (grid == 0) {
        if (n_in != 19 || in_sizes[0] != MROWS * DM || out_size != MROWS * DM || ws_size < WS_END) { fprintf(stderr, "kernel_launch: unexpected shapes (n_in %d, ws %zu)\n", n_in, ws_size); grid = -1; return; }
        int dev = 0, cus = 0, per_cu = 0;
        hipGetDevice(&dev); hipDeviceGetAttribute(&cus, hipDeviceAttributeMultiprocessorCount, dev);
        if (hipFuncSetAttribute((const void*)mega, hipFuncAttributeMaxDynamicSharedMemorySize, LDS_BYTES) != hipSuccess) { fprintf(stderr, "kernel_launch: hipFuncSetAttribute failed\n"); grid = -1; return; }
        if (hipOccupancyMaxActiveBlocksPerMultiprocessor(&per_cu, (const void*)mega, NTHREADS, LDS_BYTES) != hipSuccess || per_cu < 1) { fprintf(stderr, "kernel_launch: occupancy query says %d\n", per_cu); per_cu = 1; }
        (void)hipGetLastError();
        grid = cus * 1;
        if (grid > cus * per_cu) grid = cus * per_cu;
    }
    if (grid < 0) return;
    if (hipMemsetAsync((char*)d_ws + WS_BAR, 0, 32768, stream) != hipSuccess) { fprintf(stderr, "kernel_launch: memset of barrier words failed\n"); return; }
    Params p{};
    const float** f = (const float**)&p;
    for (int i = 0; i < 19; ++i) f[i] = (const float*)d_in[i];
    p.out = (float*)d_out; p.ws = (unsigned char*)d_ws;
#if N_LAUNCH_MODE == 1
    p.ph_lo = 0; p.ph_hi = (DBG_LAST >= 0) ? DBG_LAST + 1 : N_PHASES;
    void* args[] = {&p};
    hipError_t e = hipLaunchCooperativeKernel((const void*)mega, dim3(grid), dim3(NTHREADS), args, LDS_BYTES, stream);
    if (e != hipSuccess) fprintf(stderr, "kernel_launch: cooperative launch failed: %s (grid %d)\n", hipGetErrorString(e), grid);
#else
    for (int k = 0; k < N_PHASES; ++k) { p.ph_lo = k; p.ph_hi = k + 1; hipLaunchKernelGGL(mega, dim3(grid), dim3(NTHREADS), LDS_BYTES, stream, p); }
#endif
}
```

```cpp
#include <hip/hip_runtime.h>
#include <hip/hip_cooperative_groups.h>
#include <cstdio>
namespace cg = cooperative_groups;

#ifndef N_LAUNCH_MODE
#define N_LAUNCH_MODE 1
#endif

typedef unsigned short bf16_t;
typedef short bf16x8 __attribute__((ext_vector_type(8)));
typedef float f32x2 __attribute__((ext_vector_type(2)));
typedef float f32x4 __attribute__((ext_vector_type(4)));
typedef float f32x16 __attribute__((ext_vector_type(16)));
typedef unsigned u32x2 __attribute__((ext_vector_type(2)));
typedef unsigned u32x4 __attribute__((ext_vector_type(4)));
#define LAS __attribute__((address_space(3)))

constexpr int MROWS = 16384, DM = 1024, SEQ = 4096, NIN = 2560, DFF = 4096, MEMROWS = 1024;
constexpr float EPS = 1e-6f;
constexpr int NTHREADS = 512;
constexpr int LDS_MAIN = 135168;
constexpr int LDS_BYTES = LDS_MAIN + 16;

constexpr size_t MiB = 1u << 20;
constexpr size_t WS_WT_IN = 0, WS_WT_K = 5 * MiB, WS_WT_V = 7 * MiB, WS_WT_OUT = 9 * MiB, WS_WT_Q = 11 * MiB, WS_WT_O = 13 * MiB,
                 WS_WT_FF1 = 15 * MiB, WS_WT_FF2 = 23 * MiB, WS_MEMB = 31 * MiB, WS_KX = 33 * MiB, WS_VT = 35 * MiB, WS_SSQ = 37 * MiB,
                 WS_BAR = 39 * MiB, WS_CNT = 39 * MiB + 16384, WS_RSTD0 = 38 * MiB, WS_RSTDM = 38 * MiB + 65536, WS_DEC = 38 * MiB + 131072,
                 WS_XB = 40 * MiB  , WS_QH = 72 * MiB, WS_KH = 88 * MiB, WS_VH = 104 * MiB, WS_GH = 120 * MiB, WS_PH = 136 * MiB,
                 WS_LF = 152 * MiB, WS_ST = 184 * MiB, WS_MIXED = 216 * MiB,
                 WS_X1 = 72 * MiB, WS_XQ = 136 * MiB, WS_ATT = 168 * MiB, WS_U = 72 * MiB, WS_END = 256 * MiB;

typedef __bf16 bf16x2n __attribute__((ext_vector_type(2)));
__device__ __forceinline__ unsigned cvt_pk_bf16(float lo, float hi) { f32x2 v = {lo, hi}; return __builtin_bit_cast(unsigned, __builtin_convertvector(v, bf16x2n)); }
__device__ __forceinline__ bf16_t f2bf(float f) { return (bf16_t)(cvt_pk_bf16(f, 0.f) & 0xffffu); }
__device__ __forceinline__ float bf2f(bf16_t b) { return __uint_as_float(((unsigned)b) << 16); }
__device__ __forceinline__ float bflo(unsigned u) { return __uint_as_float(u << 16); }
__device__ __forceinline__ float bfhi(unsigned u) { return __uint_as_float(u & 0xffff0000u); }
__device__ __forceinline__ f32x4 mfma16(bf16x8 a, bf16x8 b, f32x4 c) { return __builtin_amdgcn_mfma_f32_16x16x32_bf16(a, b, c, 0, 0, 0); }
__device__ __forceinline__ f32x16 mfma32(bf16x8 a, bf16x8 b, f32x16 c) { return __builtin_amdgcn_mfma_f32_32x32x16_bf16(a, b, c, 0, 0, 0); }
__device__ __forceinline__ bf16x8 mk8(u32x2 lo, u32x2 hi) { u32x4 t; t.x = lo.x; t.y = lo.y; t.z = hi.x; t.w = hi.y; return __builtin_bit_cast(bf16x8, t); }
__device__ __forceinline__ bf16x8 mk8u(unsigned a, unsigned b, unsigned c, unsigned d) { u32x4 t; t.x = a; t.y = b; t.z = c; t.w = d; return __builtin_bit_cast(bf16x8, t); }
__device__ __forceinline__ float sigmoidf_(float z) { return __builtin_amdgcn_rcpf(1.0f + __expf(-z)); }

namespace pg8 {
constexpr int BM = 256, BK = 64, HALF = 128, HTB = HALF * BK * 2, STAGE_BYTES = 8 * HTB, NXCD = 8, WGM = 8;
__device__ __forceinline__ int lds_byte(int r, int c) { const int st = (r >> 4) * 2 + (c >> 5), rr = r & 15, cc = c & 31, ob = rr * 64 + cc * 2; return st * 1024 + (ob ^ (((ob >> 9) & 1) << 5)); }
__device__ __forceinline__ void stage_rc(int b, int& R, int& C) { const int st = b / 1024, sb = b % 1024, swz = sb ^ (((sb >> 9) & 1) << 5); R = (st >> 1) * 16 + swz / 64; C = (st & 1) * 32 + (swz % 64) / 2; }
__device__ __forceinline__ int perm32(int rho) { const int n = rho >> 4, i = rho & 15; return 8 * (i >> 2) + 4 * n + (i & 3); }
struct Unit { int pm, pn; };
struct Gemm { const bf16_t* A; const bf16_t* Bt; int M, N, K; };
struct StaticOrder {
    int nM, nN, nwg, G, c;
    __device__ __forceinline__ void init(int M, int N, int G_, int c_) { nM = M / BM; nN = N / BM; nwg = nM * nN; G = G_; c = c_; }
    __device__ __forceinline__ bool next(int i, Unit& u) const {
        const long L = (long)i * G + c; if (L >= nwg) return false;
        int wgid = (int)L; { const int q = nwg / NXCD, r = nwg % NXCD, xcd = wgid % NXCD, off = wgid / NXCD; wgid = (xcd < r ? xcd * (q + 1) : r * (q + 1) + (xcd - r) * q) + off; }
        const int nig = WGM * nN, gid = wgid / nig, fm = gid * WGM, gsz = (nM - fm) < WGM ? (nM - fm) : WGM;
        u.pm = fm + ((wgid % nig) % gsz); u.pn = (wgid % nig) / gsz; return true;
    }
};

struct Epi {
    static constexpr bool PERM = true;
    int mode;
    unsigned char* ws; const float* x; float* out; const float* lbl; const float* gfin; int pnoff;
    __device__ __forceinline__ void store8(bf16_t* p, const f32x4& v0, const f32x4& v1) const {
        u32x4 w; w.x = cvt_pk_bf16(v0[0], v0[1]); w.y = cvt_pk_bf16(v0[2], v0[3]); w.z = cvt_pk_bf16(v1[0], v1[1]); w.w = cvt_pk_bf16(v1[2], v1[3]); *(u32x4*)p = w; }
    __device__ __forceinline__ void fused(f32x4 (&acc)[2][2][4][2], const Unit& u, int wr, int wc, int fr, int fq) const {
        const int row0 = u.pm * BM + wr * 64 + fr;
        const int col0 = u.pn * BM + wc * 32 + 8 * fq;
        const bf16_t* xb = (const bf16_t*)(ws + WS_XB);
        unsigned* sq = (unsigned*)(ws + WS_SSQ);
        unsigned* cnt = (unsigned*)(ws + WS_CNT) + 64 * u.pm;
        u32x4 bc[2], bn[2];
        { const size_t o = (size_t)row0 * DM + col0; bc[0] = *(const u32x4*)(xb + o); bc[1] = *(const u32x4*)(xb + o + HALF); }
#pragma unroll
        for (int gidx = 0; gidx < 8; ++gidx) { const int ai = gidx >> 2, m = gidx & 3; const int row = row0 + ai * HALF + m * 16;
            if (gidx < 7) { const int g2 = gidx + 1; const size_t o2 = (size_t)(row0 + (g2 >> 2) * HALF + (g2 & 3) * 16) * DM + col0; bn[0] = *(const u32x4*)(xb + o2); bn[1] = *(const u32x4*)(xb + o2 + HALF); }
            float ss = 0.f;
#pragma unroll
            for (int bj = 0; bj < 2; ++bj) { const u32x4 bb = bc[bj];
                const f32x4 v0 = acc[ai][bj][m][0] + (f32x4){bflo(bb.x), bfhi(bb.x), bflo(bb.y), bfhi(bb.y)}, v1 = acc[ai][bj][m][1] + (f32x4){bflo(bb.z), bfhi(bb.z), bflo(bb.w), bfhi(bb.w)};
                acc[ai][bj][m][0] = v0; acc[ai][bj][m][1] = v1;
                ss += (v0[0] * v0[0] + v0[1] * v0[1]) + (v0[2] * v0[2] + v0[3] * v0[3]) + (v1[0] * v1[0] + v1[1] * v1[1]) + (v1[2] * v1[2] + v1[3] * v1[3]); }
            ss += __shfl_xor(ss, 16); ss += __shfl_xor(ss, 32);
            if (fq == 0) __hip_atomic_store(sq + (size_t)row * 16 + u.pn * 4 + wc, __float_as_uint(ss), __ATOMIC_RELAXED, __HIP_MEMORY_SCOPE_AGENT);
            bc[0] = bn[0]; bc[1] = bn[1]; }
        asm volatile("s_waitcnt vmcnt(0)" ::: "memory");
        if ((threadIdx.x & 63) == 0) __hip_atomic_fetch_add(cnt, 1u, __ATOMIC_RELAXED, __HIP_MEMORY_SCOPE_AGENT);
        f32x4 gv[2][2];
#pragma unroll
        for (int bj = 0; bj < 2; ++bj) { gv[bj][0] = *(const f32x4*)(gfin + col0 + bj * HALF); gv[bj][1] = *(const f32x4*)(gfin + col0 + bj * HALF + 4); }
        { unsigned spins = 0; while ((unsigned)__builtin_amdgcn_readfirstlane(__hip_atomic_load(cnt, __ATOMIC_RELAXED, __HIP_MEMORY_SCOPE_AGENT)) < 32u) { __builtin_amdgcn_s_sleep(1); if (++spins > (1u << 22)) break; } }
        __builtin_amdgcn_fence(__ATOMIC_ACQUIRE, "agent");
        asm volatile("s_waitcnt vmcnt(0)" ::: "memory");
        f32x4 pv[8];
#pragma unroll
        for (int gidx = 0; gidx < 8; ++gidx) pv[gidx] = *(const f32x4*)((const float*)sq + (size_t)(row0 + (gidx >> 2) * HALF + (gidx & 3) * 16) * 16 + 4 * fq);
#pragma unroll
        for (int gidx = 0; gidx < 8; ++gidx) { const int ai = gidx >> 2, m = gidx & 3; const int row = row0 + ai * HALF + m * 16;
            float t = (pv[gidx][0] + pv[gidx][1]) + (pv[gidx][2] + pv[gidx][3]); t += __shfl_xor(t, 16); t += __shfl_xor(t, 32);
            const float rstd = rsqrtf(t * (1.0f / 1024.0f) + EPS);
            const size_t o = (size_t)row * DM + col0;
#pragma unroll
            for (int bj = 0; bj < 2; ++bj) { *(f32x4*)(out + o + bj * HALF) = acc[ai][bj][m][0] * rstd * gv[bj][0]; *(f32x4*)(out + o + bj * HALF + 4) = acc[ai][bj][m][1] * rstd * gv[bj][1]; } }
    }
    template <class Sched>
    __device__ __forceinline__ bool prefill(LAS unsigned char* lds, const Sched& S) const {
        if (!(mode == 0 || mode == 1 || mode == 4 || mode == 5) || S.nwg > 4 * S.G) return false;
        const int tid = threadIdx.x, rr = tid & 255;
#pragma unroll
        for (int k = 0; k < 2; ++k) { const int ui = (tid >> 8) + 2 * k; Unit u;
            if (S.next(ui, u)) { const int row = u.pm * BM + rr; float r;
                if (mode == 4 || mode == 5) { const f32x4* pp = (const f32x4*)((const float*)(ws + WS_SSQ) + (size_t)row * 16); const f32x4 a = pp[0], b = pp[1], c = pp[2], d = pp[3];
                    const float t = ((a[0] + a[1]) + (a[2] + a[3])) + ((b[0] + b[1]) + (b[2] + b[3])) + ((c[0] + c[1]) + (c[2] + c[3])) + ((d[0] + d[1]) + (d[2] + d[3]));
                    r = rsqrtf(t * (1.0f / 1024.0f) + EPS) * (mode == 4 ? 0.0625f : 1.0f); }
                else r = ((const float*)(ws + (mode == 0 ? WS_RSTD0 : WS_RSTDM)))[row];
                *(LAS float*)(lds + STAGE_BYTES + (ui * 256 + rr) * 4) = r; } }
        return true;
    }
    __device__ __forceinline__ void operator()(const f32x4 (&acc)[2][2][4][2], const Unit& u, int ui, bool tab, LAS unsigned char* lds, int wr, int wc, int fr, int fq) const {
        const int row0 = u.pm * BM + wr * 64 + fr;
        const int colL = wc * 32 + 8 * fq;
        if (mode == 3 || mode == 6 || mode == 7) {
            const int col0 = u.pn * BM + colL;
            bf16_t* xb = (bf16_t*)(ws + WS_XB);
            float* ssq = (float*)(ws + WS_SSQ);
            f32x4 rc[4], rn[4];
            u32x4 bc[2], bn[2];
            if (mode == 3) { const size_t o = (size_t)row0 * DM + col0; rc[0] = *(const f32x4*)(x + o); rc[1] = *(const f32x4*)(x + o + 4); rc[2] = *(const f32x4*)(x + o + HALF); rc[3] = *(const f32x4*)(x + o + HALF + 4); }
            else { const size_t o = (size_t)row0 * DM + col0; bc[0] = *(const u32x4*)(xb + o); bc[1] = *(const u32x4*)(xb + o + HALF); }
#pragma unroll
            for (int gidx = 0; gidx < 8; ++gidx) { const int ai = gidx >> 2, m = gidx & 3; const int row = row0 + ai * HALF + m * 16;
                if (gidx < 7) { const int g2 = gidx + 1; const size_t o2 = (size_t)(row0 + (g2 >> 2) * HALF + (g2 & 3) * 16) * DM + col0;
                    if (mode == 3) { rn[0] = *(const f32x4*)(x + o2); rn[1] = *(const f32x4*)(x + o2 + 4); rn[2] = *(const f32x4*)(x + o2 + HALF); rn[3] = *(const f32x4*)(x + o2 + HALF + 4); }
                    else { bn[0] = *(const u32x4*)(xb + o2); bn[1] = *(const u32x4*)(xb + o2 + HALF); } }
                if (mode != 3) {
#pragma unroll
                    for (int bj = 0; bj < 2; ++bj) { rc[2 * bj] = (f32x4){bflo(bc[bj].x), bfhi(bc[bj].x), bflo(bc[bj].y), bfhi(bc[bj].y)}; rc[2 * bj + 1] = (f32x4){bflo(bc[bj].z), bfhi(bc[bj].z), bflo(bc[bj].w), bfhi(bc[bj].w)}; } }
                float ss = 0.f;
#pragma unroll
                for (int bj = 0; bj < 2; ++bj) { const size_t o = (size_t)row * DM + col0 + bj * HALF;
                    const f32x4 v0 = acc[ai][bj][m][0] + rc[2 * bj], v1 = acc[ai][bj][m][1] + rc[2 * bj + 1];
                    store8(xb + o, v0, v1);
                    ss += (v0[0] * v0[0] + v0[1] * v0[1]) + (v0[2] * v0[2] + v0[3] * v0[3]) + (v1[0] * v1[0] + v1[1] * v1[1]) + (v1[2] * v1[2] + v1[3] * v1[3]); }
                ss += __shfl_xor(ss, 16); ss += __shfl_xor(ss, 32);
                if (fq == 0) ssq[(size_t)row * 16 + u.pn * 4 + wc] = ss;
#pragma unroll
                for (int k = 0; k < 4; ++k) rc[k] = rn[k];
                bc[0] = bn[0]; bc[1] = bn[1]; }
            return;
        }
        if (mode == 2) {
            const int col0 = u.pn * BM + colL;
            const float* rs = (const float*)(ws + WS_RSTDM); bf16_t* ob = (bf16_t*)(ws + WS_VT); const int ldo = 1024;
            f32x4 c0[2], c1[2];
#pragma unroll
            for (int bj = 0; bj < 2; ++bj) { c0[bj] = *(const f32x4*)(rs + col0 + bj * HALF); c1[bj] = *(const f32x4*)(rs + col0 + bj * HALF + 4); }
#pragma unroll
            for (int ai = 0; ai < 2; ++ai)
#pragma unroll
                for (int m = 0; m < 4; ++m) { const int row = row0 + ai * HALF + m * 16;
#pragma unroll
                    for (int bj = 0; bj < 2; ++bj) store8(ob + (size_t)row * ldo + col0 + bj * HALF, acc[ai][bj][m][0] * c0[bj], acc[ai][bj][m][1] * c1[bj]); }
            return;
        }
        float rsc[8];
        if (tab) {
#pragma unroll
            for (int gidx = 0; gidx < 8; ++gidx) rsc[gidx] = *(const LAS float*)(lds + STAGE_BYTES + (ui * 256 + wr * 64 + fr + (gidx >> 2) * HALF + (gidx & 3) * 16) * 4);
        } else if (mode == 4 || mode == 5) {
            asm volatile("" ::: "memory");
            const float* sq = (const float*)(ws + WS_SSQ);
            f32x4 pv[8];
#pragma unroll
            for (int gidx = 0; gidx < 8; ++gidx) pv[gidx] = *(const f32x4*)(sq + (size_t)(row0 + (gidx >> 2) * HALF + (gidx & 3) * 16) * 16 + 4 * fq);
            const float cs = mode == 4 ? 0.0625f : 1.0f;
#pragma unroll
            for (int gidx = 0; gidx < 8; ++gidx) { float t = (pv[gidx][0] + pv[gidx][1]) + (pv[gidx][2] + pv[gidx][3]); t += __shfl_xor(t, 16); t += __shfl_xor(t, 32); rsc[gidx] = rsqrtf(t * (1.0f / 1024.0f) + EPS) * cs; }
        } else {
            asm volatile("" ::: "memory");
            const float* rs = (const float*)(ws + (mode == 0 ? WS_RSTD0 : WS_RSTDM));
#pragma unroll
            for (int gidx = 0; gidx < 8; ++gidx) rsc[gidx] = rs[row0 + (gidx >> 2) * HALF + (gidx & 3) * 16];
        }
        if (mode == 0) {
            float* lf = (float*)(ws + WS_LF);
            const int pnn = u.pn + pnoff; const int sub = pnn >> 1; const int cb = (pnn & 1) * 256 + colL;
            if (sub == 1) {
                float oml[2][8];
#pragma unroll
                for (int bj = 0; bj < 2; ++bj)
#pragma unroll
                    for (int j = 0; j < 8; ++j) { const int c = cb + bj * HALF + j; const float l0 = lbl[c], l1 = lbl[512 + c]; const float lb = 1.0f / (1.0f + __expf(l1 - l0)); oml[bj][j] = 1.0f - lb; }
#pragma unroll
                for (int ai = 0; ai < 2; ++ai)
#pragma unroll
                    for (int m = 0; m < 4; ++m) { const int row = row0 + ai * HALF + m * 16; const float r = rsc[ai * 4 + m];
#pragma unroll
                        for (int bj = 0; bj < 2; ++bj) { f32x4 lf0, lf1;
#pragma unroll
                            for (int j = 0; j < 4; ++j) {
                                const float za = acc[ai][bj][m][0][j] * r, zb = acc[ai][bj][m][1][j] * r;
                                const float ka = oml[bj][j] * (1.0f - sigmoidf_(za)), kb = oml[bj][4 + j] * (1.0f - sigmoidf_(zb));
                                lf0[j] = __logf(1.0f - ka); lf1[j] = __logf(1.0f - kb); }
                            const size_t o = (size_t)row * 512 + cb + bj * HALF;
                            *(f32x4*)(lf + o) = lf0; *(f32x4*)(lf + o + 4) = lf1; } }
            } else {
                bf16_t* dst = (bf16_t*)(ws + (sub == 0 ? WS_QH : (sub == 2 ? WS_VH : (sub == 3 ? WS_GH : WS_PH))));
                const bool act = (sub == 0) || (sub == 3);
#pragma unroll
                for (int ai = 0; ai < 2; ++ai)
#pragma unroll
                    for (int m = 0; m < 4; ++m) { const int row = row0 + ai * HALF + m * 16; const float r = rsc[ai * 4 + m];
#pragma unroll
                        for (int bj = 0; bj < 2; ++bj) { f32x4 v0 = acc[ai][bj][m][0] * r, v1 = acc[ai][bj][m][1] * r;
                            if (act) {
#pragma unroll
                                for (int j = 0; j < 4; ++j) { v0[j] = v0[j] * sigmoidf_(v0[j]); v1[j] = v1[j] * sigmoidf_(v1[j]); } }
                            store8(dst + (size_t)row * 512 + cb + bj * HALF, v0, v1); } }
            }
        } else {
            const int col0 = u.pn * BM + colL;
            bf16_t* ob = (bf16_t*)(ws + (mode == 1 ? WS_KX : (mode == 4 ? WS_XQ : WS_U))); const int ldo = mode == 5 ? DFF : 1024;
#pragma unroll
            for (int ai = 0; ai < 2; ++ai)
#pragma unroll
                for (int m = 0; m < 4; ++m) { const int row = row0 + ai * HALF + m * 16; const float r = rsc[ai * 4 + m];
#pragma unroll
                    for (int bj = 0; bj < 2; ++bj) { f32x4 v0 = acc[ai][bj][m][0] * r, v1 = acc[ai][bj][m][1] * r;
                        if (mode == 5) {
#pragma unroll
                            for (int j = 0; j < 4; ++j) { const float a = fmaxf(v0[j], 0.f), b = fmaxf(v1[j], 0.f); v0[j] = a * a; v1[j] = b * b; } }
                        if (mode == 5) {
                            u32x4 w; w.x = cvt_pk_bf16(v0[0], v0[1]); w.y = cvt_pk_bf16(v0[2], v0[3]); w.z = cvt_pk_bf16(v1[0], v1[1]); w.w = cvt_pk_bf16(v1[2], v1[3]);
                            __builtin_amdgcn_raw_buffer_store_b128(w, __builtin_amdgcn_make_buffer_rsrc((void*)ob, 0, 0x7fffffff, 0x00020000), (int)(((size_t)row * ldo + col0 + bj * HALF) * 2), 0, 16); }
                        else store8(ob + (size_t)row * ldo + col0 + bj * HALF, v0, v1); } }
        }
    }
};

template <class EpiT, class Sched>
__device__ __forceinline__ void gemm_phase(LAS unsigned char* lds, const Gemm g, const Sched S, const EpiT E) {
    const int tid = threadIdx.x, wid = __builtin_amdgcn_readfirstlane(tid >> 6), lane = tid & 63, wr = wid >> 2, wc = wid & 3, fr = lane & 15, fq = lane >> 4;
    const int K = g.K, nt = K / BK;
    unsigned voffA[2], voffB[2];
#pragma unroll
    for (int i = 0; i < 2; ++i) { int R, C; stage_rc(tid * 16 + i * 8192, R, C); const int Rb = EpiT::PERM ? ((R & ~31) + perm32(R & 31)) : R;
        voffA[i] = (unsigned)(R * K + C) * 2u; voffB[i] = (unsigned)(Rb * K + C) * 2u; }
    const size_t kstep = (size_t)(BK * 2);
    const size_t hstep = (size_t)HALF * K * 2;
    const size_t tstep = 2 * hstep;
    const unsigned ldsw = (unsigned)wid * 1024u;
    const int aoff = lds_byte(wr * 64 + fr, fq * 8), boff = lds_byte(wc * 32 + fr, fq * 8);
#define PG8_SA(b, h) (((b) * 2 + (h)) * HTB)
#define PG8_SB(b, h) ((4 + (b) * 2 + (h)) * HTB)
#define PG8_STAGE(bufoff, gbase, voff) do { _Pragma("unroll") for (int _i = 0; _i < 2; ++_i) \
        __builtin_amdgcn_global_load_lds((const unsigned*)((const char*)(gbase) + (voff)[_i]), (LAS unsigned*)(lds + (bufoff) + ldsw + _i * 8192), 16, 0, 0); } while (0)
#define PG8_LDA(dst, b, h) do { _Pragma("unroll") for (int m = 0; m < 4; ++m) _Pragma("unroll") for (int k = 0; k < 2; ++k) dst[m][k] = *(const LAS bf16x8*)(lds + PG8_SA(b, h) + aoff + m * 2048 + k * 1024); } while (0)
#define PG8_LDB(dst, b, h) do { _Pragma("unroll") for (int n = 0; n < 2; ++n) _Pragma("unroll") for (int k = 0; k < 2; ++k) dst[n][k] = *(const LAS bf16x8*)(lds + PG8_SB(b, h) + boff + n * 2048 + k * 1024); } while (0)
#define PG8_MMA(ai, bj, At, Bt) do { __builtin_amdgcn_s_setprio(1); _Pragma("unroll") for (int m = 0; m < 4; ++m) _Pragma("unroll") for (int n = 0; n < 2; ++n) _Pragma("unroll") for (int k = 0; k < 2; ++k) \
        acc[ai][bj][m][n] = __builtin_amdgcn_mfma_f32_16x16x32_bf16(Bt[n][k], At[m][k], acc[ai][bj][m][n], 0, 0, 0); __builtin_amdgcn_s_setprio(0); } while (0)
#define PG8_WAIT_V(n) asm volatile("s_waitcnt vmcnt(" #n ")" ::: "memory")
#define PG8_WAIT_L(n) asm volatile("s_waitcnt lgkmcnt(" #n ")" ::: "memory")
#define PG8_BAR __builtin_amdgcn_s_barrier()
#define PG8_SCHED __builtin_amdgcn_sched_barrier(0)
    Unit cur, nxt; int ui = 0;
    if (!S.next(0, cur)) return;
    const bool tab = E.prefill(lds, S);
    if (tab) __syncthreads();
    f32x4 acc[2][2][4][2];
#pragma unroll
    for (int a = 0; a < 2; ++a)
#pragma unroll
        for (int b = 0; b < 2; ++b)
#pragma unroll
            for (int m = 0; m < 4; ++m)
#pragma unroll
                for (int n = 0; n < 2; ++n) acc[a][b][m][n] = (f32x4){0.f, 0.f, 0.f, 0.f};
    bf16x8 At[4][2], B0[2][2], B1[2][2];
    const char* cA = (const char*)g.A + (size_t)cur.pm * tstep; const char* cB = (const char*)g.Bt + (size_t)cur.pn * tstep;
    PG8_STAGE(PG8_SB(0, 0), cB, voffB); PG8_STAGE(PG8_SA(0, 0), cA, voffA); PG8_STAGE(PG8_SB(0, 1), cB + hstep, voffB); PG8_STAGE(PG8_SA(0, 1), cA + hstep, voffA);
    if (wr == 1) PG8_BAR;
    PG8_WAIT_V(4); PG8_BAR;
    PG8_STAGE(PG8_SB(1, 0), cB + kstep, voffB); PG8_STAGE(PG8_SA(1, 0), cA + kstep, voffA); PG8_STAGE(PG8_SB(1, 1), cB + hstep + kstep, voffB);
    PG8_WAIT_V(6); PG8_BAR;
    for (;;) {
        const bool has_next = S.next(ui + 1, nxt);
        const char* nA = has_next ? (const char*)g.A + (size_t)nxt.pm * tstep : cA; const char* nB = has_next ? (const char*)g.Bt + (size_t)nxt.pn * tstep : cB;
        for (int t = 0; t < nt; t += 2) {
            const bool last = (t == nt - 2);
            const char* a1 = cA + (size_t)(t + 1) * kstep;
            const char* a2 = last ? nA : cA + (size_t)(t + 2) * kstep; const char* b2 = last ? nB : cB + (size_t)(t + 2) * kstep;
            const char* a3 = a2 + kstep; const char* b3 = b2 + kstep;
            PG8_LDB(B0, 0, 0); PG8_SCHED; PG8_LDA(At, 0, 0); PG8_STAGE(PG8_SA(1, 1), a1 + hstep, voffA);
            PG8_WAIT_L(8); PG8_BAR; PG8_WAIT_L(0); PG8_MMA(0, 0, At, B0); PG8_BAR; PG8_SCHED;
            PG8_LDB(B1, 0, 1); PG8_STAGE(PG8_SB(0, 0), b2, voffB);
            PG8_BAR; PG8_WAIT_L(0); PG8_MMA(0, 1, At, B1); PG8_BAR;
            PG8_LDA(At, 0, 1); PG8_STAGE(PG8_SA(0, 0), a2, voffA);
            PG8_BAR; PG8_WAIT_L(0); PG8_MMA(1, 0, At, B0); PG8_BAR; PG8_SCHED;
            PG8_STAGE(PG8_SB(0, 1), b2 + hstep, voffB);
            PG8_WAIT_V(6); PG8_BAR; PG8_MMA(1, 1, At, B1); PG8_BAR;
            PG8_LDB(B0, 1, 0); PG8_SCHED; PG8_LDA(At, 1, 0); PG8_STAGE(PG8_SA(0, 1), a2 + hstep, voffA);
            PG8_WAIT_L(8); PG8_BAR; PG8_WAIT_L(0); PG8_MMA(0, 0, At, B0); PG8_BAR; PG8_SCHED;
            PG8_LDB(B1, 1, 1); PG8_STAGE(PG8_SB(1, 0), b3, voffB);
            PG8_BAR; PG8_WAIT_L(0); PG8_MMA(0, 1, At, B1); PG8_BAR;
            PG8_LDA(At, 1, 1); PG8_STAGE(PG8_SA(1, 0), a3, voffA);
            PG8_BAR; PG8_WAIT_L(0); PG8_MMA(1, 0, At, B0); PG8_BAR; PG8_SCHED;
            PG8_STAGE(PG8_SB(1, 1), b3 + hstep, voffB);
            PG8_WAIT_V(6); PG8_BAR; PG8_MMA(1, 1, At, B1); PG8_BAR;
        }
        if (E.mode != 8) E(acc, cur, ui, tab, lds, wr, wc, fr, fq);
        if (E.mode == 0) __builtin_amdgcn_s_waitcnt(0x0F70);
        if (!has_next) break;
#pragma unroll
        for (int a = 0; a < 2; ++a)
#pragma unroll
            for (int b = 0; b < 2; ++b)
#pragma unroll
                for (int m = 0; m < 4; ++m)
#pragma unroll
                    for (int n = 0; n < 2; ++n) acc[a][b][m][n] = (f32x4){0.f, 0.f, 0.f, 0.f};
        cur = nxt; cA = nA; cB = nB; ++ui;
    }
    PG8_WAIT_V(0);
    if (wr == 0) PG8_BAR;
    PG8_BAR;
    if (E.mode == 8) E.fused(acc, cur, wr, wc, fr, fq);
#undef PG8_SA
#undef PG8_SB
#undef PG8_STAGE
#undef PG8_LDA
#undef PG8_LDB
#undef PG8_MMA
#undef PG8_WAIT_V
#undef PG8_WAIT_L
#undef PG8_BAR
#undef PG8_SCHED
}
}

struct Params {
    const float *x, *mem, *norm_mix_g, *w_in, *lb_logits, *hgrn_norm_g, *w_pool, *pool_scale, *w_out, *norm_x_g, *norm_mem_g, *w_xq, *w_xk, *w_xv, *w_xo, *norm_ffn_g, *w_ff1, *w_ff2, *final_norm_g;
    float* out; unsigned char* ws;
    int ph_lo, ph_hi;
};

struct TD { const float* W; const float* g; bf16_t* out; int N, ldo, kt, nt; };
__device__ __forceinline__ TD tile_desc(const Params& p, int t) {
    unsigned char* ws = p.ws; TD d;
    if (t < 320)       { d.W = p.w_in;  d.g = p.norm_mix_g; d.out = (bf16_t*)(ws + WS_WT_IN);  d.N = NIN;  d.ldo = 1024; d.kt = t / 40; d.nt = t % 40; }
    else if (t < 448)  { const int u = t - 320;  d.W = p.w_xk;  d.g = p.norm_mem_g; d.out = (bf16_t*)(ws + WS_WT_K);   d.N = 1024; d.ldo = 1024; d.kt = u / 16; d.nt = u % 16; }
    else if (t < 576)  { const int u = t - 448;  d.W = p.w_xv;  d.g = p.norm_mem_g; d.out = (bf16_t*)(ws + WS_WT_V);   d.N = 1024; d.ldo = 1024; d.kt = u / 16; d.nt = u % 16; }
    else if (t < 704)  { const int u = t - 576;  d.W = p.w_xq;  d.g = p.norm_x_g;   d.out = (bf16_t*)(ws + WS_WT_Q);   d.N = 1024; d.ldo = 1024; d.kt = u / 16; d.nt = u % 16; }
    else if (t < 832)  { const int u = t - 704;  d.W = p.w_xo;  d.g = nullptr;      d.out = (bf16_t*)(ws + WS_WT_O);   d.N = 1024; d.ldo = 1024; d.kt = u / 16; d.nt = u % 16; }
    else if (t < 960)  { const int u = t - 832;  d.W = p.w_out; d.g = nullptr;      d.out = (bf16_t*)(ws + WS_WT_OUT); d.N = 1024; d.ldo = 1024; d.kt = u / 16; d.nt = u % 16; }
    else if (t < 1472) { const int u = t - 960;  d.W = p.w_ff1; d.g = p.norm_ffn_g; d.out = (bf16_t*)(ws + WS_WT_FF1); d.N = DFF;  d.ldo = 1024; d.kt = u / 64; d.nt = u % 64; }
    else if (t < 1984) { const int u = t - 1472; d.W = p.w_ff2; d.g = nullptr;      d.out = (bf16_t*)(ws + WS_WT_FF2); d.N = 1024; d.ldo = 4096; d.kt = u / 16; d.nt = u % 16; }
    else if (t < 2112) { const int u = t - 1984; d.W = p.w_in;  d.g = p.norm_mix_g; d.out = (bf16_t*)(ws + WS_WT_IN);  d.N = NIN;  d.ldo = 1024; d.kt = u / 16; d.nt = 8 + u % 16; }
    else               { const int u = t - 2112, j = u % 24; d.W = p.w_in; d.g = p.norm_mix_g; d.out = (bf16_t*)(ws + WS_WT_IN); d.N = NIN; d.ldo = 1024; d.kt = u / 24; d.nt = j < 8 ? j : 16 + j; }
    return d;
}
__device__ __forceinline__ void tile_load(const TD& d, f32x4 (&v)[4], float (&sc)[4]) {
    const int tid = threadIdx.x, r = tid >> 4, c4 = tid & 15;
#pragma unroll
    for (int i = 0; i < 4; ++i) { const int k = 128 * d.kt + r + 32 * i; v[i] = __builtin_nontemporal_load((const f32x4*)(d.W + (size_t)k * d.N + 64 * d.nt + 4 * c4)); sc[i] = d.g ? d.g[k] : 1.0f; }
}
__device__ __forceinline__ void transpose_range(const Params& p, unsigned char* lds, int t_begin, int t_end, int first, int stride) {
    bf16_t* T0 = (bf16_t*)lds;
    bf16_t* T1 = (bf16_t*)(lds + 17408);
    const int tid = threadIdx.x, r = tid >> 4, c4 = tid & 15, n = tid >> 3, ks = tid & 7;
    int ta = t_begin + first;
    if (ta >= t_end) return;
    int tb = ta + stride; bool hb = tb < t_end;
    TD da = tile_desc(p, ta), db = da; f32x4 va[4], vb[4]; float sa[4], sb[4];
    tile_load(da, va, sa);
    if (hb) { db = tile_desc(p, tb); tile_load(db, vb, sb); }
    for (;;) {
#pragma unroll
        for (int i = 0; i < 4; ++i) { const int kl = r + 32 * i;
            T0[(4 * c4 + 0) * 136 + kl] = f2bf(va[i][0] * sa[i]); T0[(4 * c4 + 1) * 136 + kl] = f2bf(va[i][1] * sa[i]);
            T0[(4 * c4 + 2) * 136 + kl] = f2bf(va[i][2] * sa[i]); T0[(4 * c4 + 3) * 136 + kl] = f2bf(va[i][3] * sa[i]); }
        if (hb) {
#pragma unroll
            for (int i = 0; i < 4; ++i) { const int kl = r + 32 * i;
                T1[(4 * c4 + 0) * 136 + kl] = f2bf(vb[i][0] * sb[i]); T1[(4 * c4 + 1) * 136 + kl] = f2bf(vb[i][1] * sb[i]);
                T1[(4 * c4 + 2) * 136 + kl] = f2bf(vb[i][2] * sb[i]); T1[(4 * c4 + 3) * 136 + kl] = f2bf(vb[i][3] * sb[i]); } }
        __syncthreads();
        const int tna = ta + 2 * stride, tnb = tna + stride; const bool hna = tna < t_end, hnb = tnb < t_end;
        const TD ca = da, cb = db; const bool chb = hb;
        if (hna) { da = tile_desc(p, tna); tile_load(da, va, sa); }
        if (hnb) { db = tile_desc(p, tnb); tile_load(db, vb, sb); }
        { const u32x4* src = (const u32x4*)(T0 + n * 136 + 16 * ks); const u32x4 a = src[0], b = src[1];
          u32x4* dst = (u32x4*)(ca.out + (size_t)(64 * ca.nt + n) * ca.ldo + 128 * ca.kt + 16 * ks); dst[0] = a; dst[1] = b; }
        if (chb) { const u32x4* src = (const u32x4*)(T1 + n * 136 + 16 * ks); const u32x4 a = src[0], b = src[1];
          u32x4* dst = (u32x4*)(cb.out + (size_t)(64 * cb.nt + n) * cb.ldo + 128 * cb.kt + 16 * ks); dst[0] = a; dst[1] = b; }
        __syncthreads();
        if (!hna) break;
        ta = tna; hb = hnb;
    }
}
__device__ __forceinline__ void phase_prep(const Params p, unsigned char* lds, bool shadow) {
    unsigned char* ws = p.ws;
    const int G = gridDim.x;
    {
        const int lane = threadIdx.x & 63, gw = blockIdx.x * (NTHREADS / 64) + (threadIdx.x >> 6), nw = G * (NTHREADS / 64);
        int r = gw;
        f32x4 v[4], vn[4];
        if (r < MROWS + MEMROWS) { const float* src = r < MROWS ? p.x + (size_t)r * DM : p.mem + (size_t)(r - MROWS) * DM;
#pragma unroll
            for (int i = 0; i < 4; ++i) v[i] = __builtin_nontemporal_load((const f32x4*)src + lane + 64 * i); }
        for (; r < MROWS + MEMROWS; r += nw) {
            const int rn = r + nw;
            if (rn < MROWS + MEMROWS) { const float* src = rn < MROWS ? p.x + (size_t)rn * DM : p.mem + (size_t)(rn - MROWS) * DM;
#pragma unroll
                for (int i = 0; i < 4; ++i) vn[i] = __builtin_nontemporal_load((const f32x4*)src + lane + 64 * i); }
            const bool isx = r < MROWS;
            bf16_t* dst = isx ? (bf16_t*)(ws + WS_XB) + (size_t)r * DM : (bf16_t*)(ws + WS_MEMB) + (size_t)(r - MROWS) * DM;
            float ss = 0.f;
#pragma unroll
            for (int i = 0; i < 4; ++i) ss += (v[i][0] * v[i][0] + v[i][1] * v[i][1]) + (v[i][2] * v[i][2] + v[i][3] * v[i][3]);
#pragma unroll
            for (int o = 1; o < 64; o <<= 1) ss += __shfl_xor(ss, o);
#pragma unroll
            for (int i = 0; i < 4; ++i) { u32x2 w; w.x = cvt_pk_bf16(v[i][0], v[i][1]); w.y = cvt_pk_bf16(v[i][2], v[i][3]); ((u32x2*)dst)[lane + 64 * i] = w; }
            if (lane == 0) { const float rstd = rsqrtf(ss * (1.0f / 1024.0f) + EPS); if (isx) ((float*)(ws + WS_RSTD0))[r] = rstd; else ((float*)(ws + WS_RSTDM))[r - MROWS] = rstd; }
#pragma unroll
            for (int i = 0; i < 4; ++i) v[i] = vn[i];
        }
    }
    if (shadow) transpose_range(p, lds, 1984, 2112, blockIdx.x, G);
    else transpose_range(p, lds, 0, 576, blockIdx.x, G);
}
__device__ __forceinline__ void deferred_prep(const Params p, unsigned char* lds, int j, int nworkers) {
    transpose_range(p, lds, 576, 1984, j, nworkers);
}
__device__ __forceinline__ void fold_pool_weights_mfma(const Params& p) {
    bf16_t* wto = (bf16_t*)(p.ws + WS_WT_OUT);
    const int tid = threadIdx.x, w = tid >> 6, lane = tid & 63, fr = lane & 15, q = lane >> 4;
    for (int item = blockIdx.x; item < 256; item += gridDim.x) {
        const int gi = item >> 6, nb = item & 63;
        f32x4 acc = (f32x4){0.f, 0.f, 0.f, 0.f};
        const float* wp = p.w_pool + (size_t)(gi * 128 + 16 * w + fr) * 128;
        const float* ps = p.pool_scale + gi * 128;
        const bf16_t* arow = wto + (size_t)(16 * nb + fr) * 1024 + 512 + gi * 128;
#pragma unroll
        for (int ks = 0; ks < 4; ++ks) {
            const int d0 = 32 * ks + 8 * q;
            const f32x4 w0 = *(const f32x4*)(wp + d0), w1 = *(const f32x4*)(wp + d0 + 4), s0 = *(const f32x4*)(ps + d0), s1 = *(const f32x4*)(ps + d0 + 4);
            const bf16x8 cfr = mk8u(cvt_pk_bf16(w0[0] * s0[0], w0[1] * s0[1]), cvt_pk_bf16(w0[2] * s0[2], w0[3] * s0[3]), cvt_pk_bf16(w1[0] * s1[0], w1[1] * s1[1]), cvt_pk_bf16(w1[2] * s1[2], w1[3] * s1[3]));
            const bf16x8 nfr = *(const bf16x8*)(arow + d0);
            acc = mfma16(cfr, nfr, acc);
        }
        asm volatile("s_waitcnt vmcnt(0)" ::: "memory");
        __syncthreads();
        u32x2 o; o.x = cvt_pk_bf16(acc[0], acc[1]); o.y = cvt_pk_bf16(acc[2], acc[3]);
        *(u32x2*)(wto + (size_t)(16 * nb + fr) * 1024 + 512 + gi * 128 + 16 * w + 4 * q) = o;
        __syncthreads();
    }
}

__device__ __forceinline__ void phase_passA(const bf16_t* __restrict__ KH, const float* __restrict__ LF, const bf16_t* __restrict__ VH, bf16_t* __restrict__ LT, float* __restrict__ DEC, unsigned char* lds, int first, int stride, int ubeg, int uend) {
    const int tid = threadIdx.x, ch = tid & 127, seg = tid >> 7;
    float* segtot = (float*)lds;
    unsigned char* KdT = lds + 2048;
    unsigned char* VTl = lds + 2048 + 18432;
    const int w = tid >> 6, lane = tid & 63, fr = lane & 15, q = lane >> 4;
    float lf[16], kk[16]; unsigned vr[16];
    int unit = ubeg + first;
    if (unit < uend) { const int b = unit >> 8, c = (unit >> 2) & 63, h = unit & 3; const size_t g0 = (size_t)(b * SEQ + c * 64 + seg * 16) * 512 + h * 128 + ch;
#pragma unroll
        for (int i = 0; i < 16; ++i) { lf[i] = LF[g0 + (size_t)i * 512]; vr[i] = VH[g0 + (size_t)i * 512]; } }
    for (; unit < uend; unit += stride) {
        const int b = unit >> 8, c = (unit >> 2) & 63, h = unit & 3, bh = b * 4 + h;
#pragma unroll
        for (int i = 0; i < 16; ++i) kk[i] = 1.0f - __expf(lf[i]);
#pragma unroll
        for (int i = 1; i < 16; ++i) lf[i] += lf[i - 1];
        segtot[seg * 128 + ch] = lf[15];
        __syncthreads();
        float after = 0.f;
#pragma unroll
        for (int s2 = 1; s2 < 4; ++s2) if (s2 > seg) after += segtot[s2 * 128 + ch];
        const float tot = after + lf[15];
        if (seg == 0) DEC[(size_t)(bh * 64 + c) * 128 + ch] = __expf(tot);
        unsigned kd[8], vp[8];
#pragma unroll
        for (int i = 0; i < 8; ++i) {
            kd[i] = cvt_pk_bf16(kk[2 * i] * __expf(tot - lf[2 * i]), kk[2 * i + 1] * __expf(tot - lf[2 * i + 1]));
            vp[i] = vr[2 * i] | (vr[2 * i + 1] << 16);
        }
        { u32x4* d = (u32x4*)(KdT + ch * 144 + seg * 32); d[0] = (u32x4){kd[0], kd[1], kd[2], kd[3]}; d[1] = (u32x4){kd[4], kd[5], kd[6], kd[7]}; }
        { u32x4* d = (u32x4*)(VTl + ch * 144 + seg * 32); d[0] = (u32x4){vp[0], vp[1], vp[2], vp[3]}; d[1] = (u32x4){vp[4], vp[5], vp[6], vp[7]}; }
        __syncthreads();
        {
            const int un = unit + stride;
            if (un < uend) { const int b2 = un >> 8, c2 = (un >> 2) & 63, h2 = un & 3; const size_t g0 = (size_t)(b2 * SEQ + c2 * 64 + seg * 16) * 512 + h2 * 128 + ch;
#pragma unroll
                for (int i = 0; i < 16; ++i) { lf[i] = LF[g0 + (size_t)i * 512]; vr[i] = VH[g0 + (size_t)i * 512]; } }
        }
        bf16x8 a[2];
#pragma unroll
        for (int ks = 0; ks < 2; ++ks) a[ks] = *(const bf16x8*)(KdT + (16 * w + fr) * 144 + (32 * ks + 8 * q) * 2);
        bf16_t* ltp = LT + (size_t)(bh * 64 + c) * 16384;
#pragma unroll
        for (int vb = 0; vb < 8; ++vb) {
            f32x4 acc = (f32x4){0.f, 0.f, 0.f, 0.f};
#pragma unroll
            for (int ks = 0; ks < 2; ++ks) { const bf16x8 bfr = *(const bf16x8*)(VTl + (16 * vb + fr) * 144 + (32 * ks + 8 * q) * 2); acc = mfma16(a[ks], bfr, acc); }
            u32x2 pk; pk.x = cvt_pk_bf16(acc[0], acc[1]); pk.y = cvt_pk_bf16(acc[2], acc[3]);
            *(u32x2*)(ltp + (size_t)(16 * vb + fr) * 128 + 16 * w + 4 * q) = pk;
        }
        __syncthreads();
    }
}

template <int W>
__device__ __forceinline__ void pool_body(const bf16_t* __restrict__ PH, bf16_t* __restrict__ MIXED, int r0, int s0, int c0) {
    unsigned v[31 + W];
#pragma unroll
    for (int j = 1; j < W; ++j) v[W - 1 - j] = (s0 - j >= 0) ? *(const unsigned*)(PH + (size_t)(r0 - j) * 512 + c0) : 0u;
#pragma unroll
    for (int tt = 0; tt < 32; ++tt) v[W - 1 + tt] = *(const unsigned*)(PH + (size_t)(r0 + tt) * 512 + c0);
    float sx = 0.f, sy = 0.f;
#pragma unroll
    for (int j = 1; j < W; ++j) { sx += bflo(v[W - 1 - j]); sy += bfhi(v[W - 1 - j]); }
#pragma unroll
    for (int tt = 0; tt < 32; ++tt) {
        const int s = s0 + tt;
        const float px = bflo(v[W - 1 + tt]), py = bfhi(v[W - 1 + tt]);
        sx += px; sy += py;
        const int cnt = (s + 1) < W ? (s + 1) : W;
        const float inv = __builtin_amdgcn_rcpf((float)cnt);
        *(unsigned*)(MIXED + (size_t)(r0 + tt) * 1024 + 512 + c0) = cvt_pk_bf16(sx * inv - px, sy * inv - py);
        sx -= bflo(v[tt]); sy -= bfhi(v[tt]);
    }
}
__device__ __forceinline__ void pool_tile(const bf16_t* __restrict__ PH, bf16_t* __restrict__ MIXED, int tile) {
    const int tid = threadIdx.x, cp = tid & 255, th = tid >> 8, c0 = 2 * cp, gi = c0 >> 7;
    const int r0 = tile * 64 + th * 32, s0 = r0 & (SEQ - 1);
    if (gi == 0) pool_body<2>(PH, MIXED, r0, s0, c0);
    else if (gi == 1) pool_body<4>(PH, MIXED, r0, s0, c0);
    else if (gi == 2) pool_body<8>(PH, MIXED, r0, s0, c0);
    else pool_body<16>(PH, MIXED, r0, s0, c0);
}

__device__ __forceinline__ void phase_scan(const bf16_t* LT, const float* __restrict__ DEC, bf16_t* ST, unsigned char* lds) {
    float* decl = (float*)lds;
    for (int e0 = blockIdx.x * NTHREADS; e0 < 131072; e0 += gridDim.x * NTHREADS) {
        const int e2 = e0 + threadIdx.x;
        const int bh = e2 >> 13, v = (e2 >> 6) & 127, kp = e2 & 63;
        const size_t base = (size_t)bh * 64 * 16384 + (size_t)v * 128 + 2 * kp;
        {
            const float* dp = DEC + (size_t)bh * 64 * 128;
            float dv[16];
#pragma unroll
            for (int i = 0; i < 16; ++i) dv[i] = dp[threadIdx.x + NTHREADS * i];
#pragma unroll
            for (int i = 0; i < 16; ++i) decl[threadIdx.x + NTHREADS * i] = dv[i];
        }
        __syncthreads();
        float sx = 0.f, sy = 0.f;
        for (int c0 = 0; c0 < 64; c0 += 32) {
            unsigned l[32];
#pragma unroll
            for (int j = 0; j < 32; ++j) l[j] = *(const unsigned*)(LT + base + (size_t)(c0 + j) * 16384);
#pragma unroll
            for (int j = 0; j < 32; ++j) {
                const f32x2 d = *(const f32x2*)(decl + (c0 + j) * 128 + 2 * kp);
                *(unsigned*)(ST + base + (size_t)(c0 + j) * 16384) = cvt_pk_bf16(sx, sy);
                sx = d[0] * sx + bflo(l[j]); sy = d[1] * sy + bfhi(l[j]);
            }
        }
        __syncthreads();
    }
}

__device__ __forceinline__ void phase_passC(const bf16_t* __restrict__ QH, const bf16_t* __restrict__ KH, const float* __restrict__ LF, const bf16_t* __restrict__ VH, const bf16_t* __restrict__ GH,
                                const bf16_t* __restrict__ ST, const float* __restrict__ hg, bf16_t* __restrict__ MIXED, unsigned char* lds) {
    const int tid = threadIdx.x, ch = tid & 127, seg = tid >> 7, G = gridDim.x;
    float lf[16], kk[16]; unsigned qr[16], vr[16];
    int unit = blockIdx.x;
    if (unit < 1024) { const int b = unit >> 8, c = (unit >> 2) & 63, h = unit & 3; const size_t g0 = (size_t)(b * SEQ + c * 64 + seg * 16) * 512 + h * 128 + ch;
#pragma unroll
        for (int i = 0; i < 16; ++i) { lf[i] = LF[g0 + (size_t)i * 512]; vr[i] = VH[g0 + (size_t)i * 512]; qr[i] = QH[g0 + (size_t)i * 512]; } }
  for (; unit < 1024; unit += G) {
    const int b = unit >> 8, c = (unit >> 2) & 63, h = unit & 3;
    const int row0 = b * SEQ + c * 64, bh = b * 4 + h;
    float* segtot = (float*)lds;
    float* rmsp = (float*)(lds + 2048);
    bf16_t* QC = (bf16_t*)(lds + 4096);
    bf16_t* QT = (bf16_t*)(lds + 21504);
    constexpr int KT0 = 38912;
    unsigned char* VTl = lds + 82432;
    const int w = tid >> 6, lane = tid & 63, fr = lane & 15, q = lane >> 4;
    const int i = w & 3, vh = w >> 2;
    const size_t row = (size_t)(row0 + 16 * i + fr);
    u32x2 gt[4]; f32x4 gg[4]; bf16x8 stf[4][4];
    {
        const bf16_t* stp = ST + (size_t)(bh * 64 + c) * 16384;
#pragma unroll
        for (int vbl = 0; vbl < 4; ++vbl) { const int v0 = 16 * (vh * 4 + vbl) + 4 * q; gt[vbl] = *(const u32x2*)(GH + row * 512 + h * 128 + v0); gg[vbl] = *(const f32x4*)(hg + h * 128 + v0);
#pragma unroll
            for (int ks = 0; ks < 4; ++ks) stf[ks][vbl] = *(const bf16x8*)(stp + (size_t)(16 * (vh * 4 + vbl) + fr) * 128 + 32 * ks + 8 * q); }
    }
#pragma unroll
    for (int i2 = 0; i2 < 16; ++i2) kk[i2] = 1.0f - __expf(lf[i2]);
#pragma unroll
    for (int i2 = 1; i2 < 16; ++i2) lf[i2] += lf[i2 - 1];
    segtot[seg * 128 + ch] = lf[15];
    {
        unsigned vp[8];
#pragma unroll
        for (int i2 = 0; i2 < 8; ++i2) vp[i2] = vr[2 * i2] | (vr[2 * i2 + 1] << 16);
        u32x4* d = (u32x4*)(VTl + ch * 144 + seg * 32); d[0] = (u32x4){vp[0], vp[1], vp[2], vp[3]}; d[1] = (u32x4){vp[4], vp[5], vp[6], vp[7]};
    }
    __syncthreads();
    const float t0 = segtot[ch], t1 = segtot[128 + ch], t2 = segtot[256 + ch];
    const float P = (seg > 0 ? t0 : 0.f) + (seg > 1 ? t1 : 0.f) + (seg > 2 ? t2 : 0.f);
    {
        const float eP = __expf(P);
#pragma unroll
        for (int i2 = 0; i2 < 16; ++i2) {
            const float qv = bflo(qr[i2]);
            const float el = __expf(lf[i2]);
            QT[(seg * 16 + i2) * 136 + ch] = f2bf(qv * el);
            QC[(seg * 16 + i2) * 136 + ch] = f2bf(qv * el * eP);
        }
        float E = 0.f;
#pragma unroll
        for (int i2 = 0; i2 < 4; ++i2) {
            if (i2 >= seg) {
                bf16_t* KT = (bf16_t*)(lds + KT0 + 4352 * ((i2 * (i2 + 1)) / 2));
#pragma unroll
                for (int j = 0; j < 16; ++j) KT[(seg * 16 + j) * 136 + ch] = f2bf(kk[j] * __expf(E - lf[j]));
                E += (i2 == 0 ? t0 : (i2 == 1 ? t1 : t2));
            }
        }
    }
    __syncthreads();
    {
        const int un = unit + G;
        if (un < 1024) { const int b2 = un >> 8, c2 = (un >> 2) & 63, h2 = un & 3; const size_t g2 = (size_t)(b2 * SEQ + c2 * 64 + seg * 16) * 512 + h2 * 128 + ch;
#pragma unroll
            for (int i2 = 0; i2 < 16; ++i2) { lf[i2] = LF[g2 + (size_t)i2 * 512]; vr[i2] = VH[g2 + (size_t)i2 * 512]; qr[i2] = QH[g2 + (size_t)i2 * 512]; } }
    }
    f32x4 sT[4];
#pragma unroll
    for (int j = 0; j < 4; ++j) sT[j] = (f32x4){0.f, 0.f, 0.f, 0.f};
    {
        bf16x8 qfr[4];
#pragma unroll
        for (int ks = 0; ks < 4; ++ks) qfr[ks] = *(const bf16x8*)((const unsigned char*)QT + (16 * i + fr) * 272 + (32 * ks + 8 * q) * 2);
        const unsigned char* KT = lds + KT0 + 4352 * ((i * (i + 1)) / 2);
#pragma unroll
        for (int j = 0; j < 4; ++j) if (j <= i) {
#pragma unroll
            for (int ks = 0; ks < 4; ++ks) { const bf16x8 a = *(const bf16x8*)(KT + (16 * j + fr) * 272 + (32 * ks + 8 * q) * 2); sT[j] = mfma16(a, qfr[ks], sT[j]); }
            if (j == i) {
#pragma unroll
                for (int rg = 0; rg < 4; ++rg) if (4 * q + rg > fr) sT[j][rg] = 0.f;
            }
        }
    }
    f32x4 oacc[4];
#pragma unroll
    for (int vbl = 0; vbl < 4; ++vbl) oacc[vbl] = (f32x4){0.f, 0.f, 0.f, 0.f};
#pragma unroll
    for (int m = 0; m < 2; ++m) if (2 * m <= i) {
        const bf16x8 bfrag = mk8u(cvt_pk_bf16(sT[2 * m][0], sT[2 * m][1]), cvt_pk_bf16(sT[2 * m][2], sT[2 * m][3]), cvt_pk_bf16(sT[2 * m + 1][0], sT[2 * m + 1][1]), cvt_pk_bf16(sT[2 * m + 1][2], sT[2 * m + 1][3]));
#pragma unroll
        for (int vbl = 0; vbl < 4; ++vbl) {
            const unsigned char* base = VTl + (16 * (vh * 4 + vbl) + fr) * 144 + (32 * m + 4 * q) * 2;
            const bf16x8 a = mk8(*(const u32x2*)base, *(const u32x2*)(base + 32));
            oacc[vbl] = mfma16(a, bfrag, oacc[vbl]);
        }
    }
    {
#pragma unroll
        for (int ks = 0; ks < 4; ++ks) {
            const bf16x8 bfr = *(const bf16x8*)((const unsigned char*)QC + (16 * i + fr) * 272 + (32 * ks + 8 * q) * 2);
#pragma unroll
            for (int vbl = 0; vbl < 4; ++vbl) oacc[vbl] = mfma16(stf[ks][vbl], bfr, oacc[vbl]);
        }
    }
    float ss = 0.f;
#pragma unroll
    for (int vbl = 0; vbl < 4; ++vbl) ss += (oacc[vbl][0] * oacc[vbl][0] + oacc[vbl][1] * oacc[vbl][1]) + (oacc[vbl][2] * oacc[vbl][2] + oacc[vbl][3] * oacc[vbl][3]);
    ss += __shfl_xor(ss, 16); ss += __shfl_xor(ss, 32);
    if (q == 0) rmsp[vh * 64 + 16 * i + fr] = ss;
    __syncthreads();
    const float rstd = rsqrtf((rmsp[16 * i + fr] + rmsp[64 + 16 * i + fr]) * (1.0f / 128.0f) + EPS);
#pragma unroll
    for (int vbl = 0; vbl < 4; ++vbl) {
        const int v0 = 16 * (vh * 4 + vbl) + 4 * q;
        u32x2 o;
        o.x = cvt_pk_bf16(oacc[vbl][0] * rstd * gg[vbl][0] * bflo(gt[vbl].x), oacc[vbl][1] * rstd * gg[vbl][1] * bfhi(gt[vbl].x));
        o.y = cvt_pk_bf16(oacc[vbl][2] * rstd * gg[vbl][2] * bflo(gt[vbl].y), oacc[vbl][3] * rstd * gg[vbl][3] * bfhi(gt[vbl].y));
        *(u32x2*)(MIXED + row * 1024 + h * 128 + v0) = o;
    }
    __syncthreads();
  }
}

__device__ __forceinline__ void attn_unit(const bf16_t* __restrict__ XQ, const bf16_t* __restrict__ KX, const bf16_t* __restrict__ VT, bf16_t* __restrict__ ATT, int unit, unsigned char* lds) {
    const int tid = threadIdx.x, w = tid >> 6, lane = tid & 63, r = lane & 31, hh = lane >> 5;
    const int b = unit >> 6, st = (unit >> 2) & 15, h = unit & 3;
    const int row0 = b * SEQ + st * 256;
    const bf16_t* qp = XQ + (size_t)(row0 + 32 * w + r) * 1024 + h * 256 + 8 * hh;
    {
        const bf16_t* kp = KX + (size_t)(b * 256) * 1024 + h * 256;
        u32x4 kv[16];
#pragma unroll
        for (int it = 0; it < 16; ++it) { const int idx = tid + 512 * it, m = idx >> 5, cc = idx & 31; kv[it] = *(const u32x4*)(kp + (size_t)m * 1024 + cc * 8); }
#pragma unroll
        for (int it = 0; it < 16; ++it) { const int idx = tid + 512 * it, m = idx >> 5, cc = idx & 31; *(u32x4*)(lds + m * 528 + cc * 16) = kv[it]; }
    }
    __syncthreads();
    f32x16 sacc[8];
#pragma unroll
    for (int mb = 0; mb < 8; ++mb)
#pragma unroll
        for (int e = 0; e < 16; ++e) sacc[mb][e] = 0.f;
    {
        bf16x8 qf[4], qn[4];
#pragma unroll
        for (int k4 = 0; k4 < 4; ++k4) qf[k4] = *(const bf16x8*)(qp + 16 * k4);
#pragma unroll
        for (int kg = 0; kg < 4; ++kg) {
            if (kg < 3) {
#pragma unroll
                for (int k4 = 0; k4 < 4; ++k4) qn[k4] = *(const bf16x8*)(qp + 16 * (4 * (kg + 1) + k4)); }
#pragma unroll
            for (int k4 = 0; k4 < 4; ++k4)
#pragma unroll
                for (int mb = 0; mb < 8; ++mb) { const bf16x8 a = *(const bf16x8*)(lds + (32 * mb + r) * 528 + (16 * (4 * kg + k4) + 8 * hh) * 2); sacc[mb] = mfma32(a, qf[k4], sacc[mb]); }
#pragma unroll
            for (int k4 = 0; k4 < 4; ++k4) qf[k4] = qn[k4];
        }
    }
    float mx = -3.0e38f;
#pragma unroll
    for (int mb = 0; mb < 8; ++mb)
#pragma unroll
        for (int e = 0; e < 16; ++e) mx = fmaxf(mx, sacc[mb][e]);
    mx = fmaxf(mx, __shfl_xor(mx, 32));
    float sum = 0.f;
    bf16x8 pf[8][2];
#pragma unroll
    for (int mb = 0; mb < 8; ++mb) {
        float pv[16];
#pragma unroll
        for (int e = 0; e < 16; ++e) { pv[e] = __expf(sacc[mb][e] - mx); sum += pv[e]; }
#pragma unroll
        for (int s = 0; s < 2; ++s) pf[mb][s] = mk8u(cvt_pk_bf16(pv[8 * s + 0], pv[8 * s + 1]), cvt_pk_bf16(pv[8 * s + 2], pv[8 * s + 3]), cvt_pk_bf16(pv[8 * s + 4], pv[8 * s + 5]), cvt_pk_bf16(pv[8 * s + 6], pv[8 * s + 7]));
    }
    sum += __shfl_xor(sum, 32);
    const float inv = 1.0f / sum;
    __syncthreads();
    {
        const bf16_t* vp = VT + (size_t)(h * 256) * 1024 + b * 256;
        u32x4 vv[16];
#pragma unroll
        for (int it = 0; it < 16; ++it) { const int idx = tid + 512 * it, e = idx >> 5, cc = idx & 31; vv[it] = *(const u32x4*)(vp + (size_t)e * 1024 + cc * 8); }
#pragma unroll
        for (int it = 0; it < 16; ++it) { const int idx = tid + 512 * it, e = idx >> 5, cc = idx & 31;
            u32x2* d = (u32x2*)(lds + e * 520 + cc * 16); d[0] = (u32x2){vv[it].x, vv[it].y}; d[1] = (u32x2){vv[it].z, vv[it].w}; }
    }
    __syncthreads();
    bf16_t* op = ATT + (size_t)(row0 + 32 * w + r) * 1024 + h * 256 + 8 * hh;
#pragma unroll
    for (int half = 0; half < 2; ++half) {
        f32x16 oacc[4];
#pragma unroll
        for (int d = 0; d < 4; ++d)
#pragma unroll
            for (int e = 0; e < 16; ++e) oacc[d][e] = 0.f;
#pragma unroll
        for (int mb = 0; mb < 8; ++mb)
#pragma unroll
            for (int s = 0; s < 2; ++s)
#pragma unroll
                for (int d = 0; d < 4; ++d) {
                    const unsigned char* base = lds + (32 * (half * 4 + d) + r) * 520 + (32 * mb + 16 * s + 4 * hh) * 2;
                    const bf16x8 a = mk8(*(const u32x2*)base, *(const u32x2*)(base + 16));
                    oacc[d] = mfma32(a, pf[mb][s], oacc[d]);
                }
#pragma unroll
        for (int d = 0; d < 4; ++d)
#pragma unroll
            for (int pp = 0; pp < 2; ++pp) {
                unsigned ax = cvt_pk_bf16(oacc[d][8 * pp] * inv, oacc[d][8 * pp + 1] * inv), ay = cvt_pk_bf16(oacc[d][8 * pp + 2] * inv, oacc[d][8 * pp + 3] * inv);
                unsigned bx = cvt_pk_bf16(oacc[d][8 * pp + 4] * inv, oacc[d][8 * pp + 5] * inv), by = cvt_pk_bf16(oacc[d][8 * pp + 6] * inv, oacc[d][8 * pp + 7] * inv);
                { auto t = __builtin_amdgcn_permlane32_swap(ax, bx, false, false); ax = t[0]; bx = t[1]; }
                { auto t = __builtin_amdgcn_permlane32_swap(ay, by, false, false); ay = t[0]; by = t[1]; }
                u32x4 o; o.x = ax; o.y = ay; o.z = bx; o.w = by;
                *(u32x4*)(op + 32 * (half * 4 + d) + 16 * pp) = o;
            }
    }
    __syncthreads();
}

__device__ __forceinline__ void phase_final(const bf16_t* __restrict__ xb, const float* __restrict__ ssq, float* __restrict__ out, const float* __restrict__ g) {
    const int tid = threadIdx.x, sub = tid >> 7, l = tid & 127;
    const f32x4 g0 = *(const f32x4*)(g + 8 * l), g1 = *(const f32x4*)(g + 8 * l + 4);
    for (int r = blockIdx.x * 4 + sub; r < MROWS; r += gridDim.x * 4) {
        const u32x4 v = *(const u32x4*)(xb + (size_t)r * DM + 8 * l);
        const f32x4* pp = (const f32x4*)(ssq + (size_t)r * 16); const f32x4 a = pp[0], b = pp[1], c = pp[2], d = pp[3];
        const float t = ((a[0] + a[1]) + (a[2] + a[3])) + ((b[0] + b[1]) + (b[2] + b[3])) + ((c[0] + c[1]) + (c[2] + c[3])) + ((d[0] + d[1]) + (d[2] + d[3]));
        const float rstd = rsqrtf(t * (1.0f / 1024.0f) + EPS);
        const f32x4 o0 = (f32x4){bflo(v.x), bfhi(v.x), bflo(v.y), bfhi(v.y)} * rstd * g0, o1 = (f32x4){bflo(v.z), bfhi(v.z), bflo(v.w), bfhi(v.w)} * rstd * g1;
        *(f32x4*)(out + (size_t)r * DM + 8 * l) = o0; *(f32x4*)(out + (size_t)r * DM + 8 * l + 4) = o1;
    }
}

#define XB_TMO      128
#define XB_XCNT(j)  (256  + 64 * (j))
#define XB_XSUB(j)  (1280 + 64 * (j))
#define XB_XGEN(j)  (2304 + 64 * (j))
#define XB_TOP      3328
#define XB_TOPGEN   3392
#define XCD_BAR_WORDS 3456
#define XB_SPIN_CAP (1u << 22)
__device__ __forceinline__ unsigned xb_ld(unsigned* p)              { return __hip_atomic_load(p, __ATOMIC_RELAXED, __HIP_MEMORY_SCOPE_AGENT); }
__device__ __forceinline__ unsigned xb_add(unsigned* p, unsigned v) { return __hip_atomic_fetch_add(p, v, __ATOMIC_RELAXED, __HIP_MEMORY_SCOPE_AGENT); }
__device__ __forceinline__ unsigned xb_xcc_id() { return (unsigned)__builtin_amdgcn_s_getreg((3 << 11) | 20) & 0xFu; }
#define XB_SPIN(cond, bar) do { unsigned _sp = 0; while (cond) { __builtin_amdgcn_s_sleep(1); \
    if ((++_sp & 255u) == 0u) { if (xb_ld(&(bar)[XB_TMO])) break; if (_sp > XB_SPIN_CAP) { atomicAdd(&(bar)[XB_TMO], 1u); break; } } } } while (0)
struct XcdBarrier { unsigned* bar; unsigned x; volatile LAS unsigned* st; };
__device__ __forceinline__ XcdBarrier xcd_barrier_post(unsigned* bar, volatile LAS unsigned* st) {
    XcdBarrier b; b.bar = bar; b.x = xb_xcc_id(); b.st = st;
    if (threadIdx.x == 0) (void)xb_add(&bar[XB_XCNT(b.x)], 1u);
    return b;
}
__device__ __forceinline__ void xcd_barrier_complete(unsigned* bar, unsigned x, unsigned& nloc, unsigned& nx) {
    const unsigned G = gridDim.x * gridDim.y * gridDim.z;
    unsigned sum, cnt, mine, sp = 0u;
    for (;;) {
        sum = 0u; cnt = 0u; mine = 0u;
#pragma unroll
        for (unsigned j = 0; j < 16; ++j) { const unsigned c = xb_ld(&bar[XB_XCNT(j)]); sum += c; cnt += (c > 0u) ? 1u : 0u; mine = (j == x) ? c : mine; }
        if (sum == G) break;
        __builtin_amdgcn_s_sleep(1);
        if ((++sp & 255u) == 0u) { if (xb_ld(&bar[XB_TMO])) break; if (sp > XB_SPIN_CAP) { atomicAdd(&bar[XB_TMO], 1u); break; } }
    }
    nloc = mine > 0u ? mine : 1u; nx = cnt > 0u ? cnt : 1u;
}
__device__ __forceinline__ void xcd_barrier(const XcdBarrier& b) {
    asm volatile("s_waitcnt vmcnt(0)" ::: "memory");
    __syncthreads();
    if (threadIdx.x == 0) {
        unsigned* bar = b.bar;
        __builtin_amdgcn_s_waitcnt(0);
        unsigned nloc = b.st[0], nx = b.st[1];
        if (nloc == 0u) { xcd_barrier_complete(bar, b.x, nloc, nx); b.st[0] = nloc; b.st[1] = nx; }
        const unsigned old = xb_add(&bar[XB_XSUB(b.x)], 1u);
        const unsigned gen = old / nloc;
        if (old + 1u == (gen + 1u) * nloc) {
            __builtin_amdgcn_fence(__ATOMIC_RELEASE, "agent");
            asm volatile("s_waitcnt vmcnt(0)" ::: "memory");
            const unsigned og = xb_add(&bar[XB_TOP], 1u);
            const unsigned tg = og / nx;
            if (og + 1u == (tg + 1u) * nx) xb_add(&bar[XB_TOPGEN], 1u);
            else XB_SPIN(xb_ld(&bar[XB_TOPGEN]) == tg, bar);
            __builtin_amdgcn_fence(__ATOMIC_ACQUIRE, "agent");
            asm volatile("s_waitcnt vmcnt(0)" ::: "memory");
        } else {
            XB_SPIN(xb_ld(&bar[XB_TOPGEN]) == gen, bar);
            __builtin_amdgcn_fence(__ATOMIC_ACQUIRE, "agent");
            asm volatile("s_waitcnt vmcnt(0)" ::: "memory");
        }
    }
    __syncthreads();
}

__device__ __forceinline__ unsigned xcd_arrive(const XcdBarrier& b) {
    asm volatile("s_waitcnt vmcnt(0)" ::: "memory");
    __syncthreads();
    unsigned gen = 0u;
    if (threadIdx.x == 0) {
        unsigned* bar = b.bar;
        __builtin_amdgcn_s_waitcnt(0);
        unsigned nloc = b.st[0], nx = b.st[1];
        if (nloc == 0u) { xcd_barrier_complete(bar, b.x, nloc, nx); b.st[0] = nloc; b.st[1] = nx; }
        const unsigned old = xb_add(&bar[XB_XSUB(b.x)], 1u);
        gen = old / nloc;
        if (old + 1u == (gen + 1u) * nloc) {
            __builtin_amdgcn_fence(__ATOMIC_RELEASE, "agent");
            asm volatile("s_waitcnt vmcnt(0)" ::: "memory");
            (void)xb_add(&bar[XB_TOP], 1u);
        }
    }
    return gen;
}
__device__ __forceinline__ void xcd_wait(const XcdBarrier& b, unsigned gen) {
    if (threadIdx.x == 0) {
        unsigned* bar = b.bar;
        const unsigned want = (gen + 1u) * b.st[1];
        XB_SPIN(xb_ld(&bar[XB_TOP]) < want, bar);
        __builtin_amdgcn_fence(__ATOMIC_ACQUIRE, "agent");
        asm volatile("s_waitcnt vmcnt(0)" ::: "memory");
    }
    __syncthreads();
}
__device__ __forceinline__ void shadow_work(const Params& p, unsigned char* lds, int k, int bid, int G) {
    const int lo = bid, hi2 = (bid + 128) % G;
    if (k == 0)      { transpose_range(p, lds, 2112, 2304, lo, G);  transpose_range(p, lds, 320, 576, (bid + 64) % G, G); }
    else if (k == 1) { transpose_range(p, lds, 832, 960, lo, G);    transpose_range(p, lds, 960, 1088, hi2, G); }
    else if (k == 2) { transpose_range(p, lds, 576, 704, lo, G);    transpose_range(p, lds, 1088, 1216, hi2, G); }
    else if (k == 3) { for (int t = bid; t < 256; t += G) pool_tile((const bf16_t*)(p.ws + WS_PH), (bf16_t*)(p.ws + WS_MIXED), t); }
    else if (k == 4) { transpose_range(p, lds, 704, 832, lo, G);    transpose_range(p, lds, 1216, 1344, hi2, G); }
    else if (k == 5) { transpose_range(p, lds, 1344, 1472, lo, G);  transpose_range(p, lds, 1472, 1600, hi2, G); }
    else if (k == 7) { transpose_range(p, lds, 1600, 1856, lo, G); }
    else if (k == 8) { transpose_range(p, lds, 1856, 1984, lo, G); }
}

constexpr int N_PHASES = 12;
__global__ void __launch_bounds__(NTHREADS, 2) mega(Params p) {
    extern __shared__ __attribute__((aligned(16))) unsigned char lds[];
    LAS unsigned char* ldsl = (LAS unsigned char*)lds;
    unsigned char* ws = p.ws;
    const int G = gridDim.x, bid = blockIdx.x;
    const int lo = p.ph_lo, hi = p.ph_hi;

#ifndef DEFER_PREP
#define DEFER_PREP 0
#endif
#ifndef FUSE_FINAL
#define FUSE_FINAL 0
#endif
#ifndef DBG_LAST
#define DBG_LAST -1
#endif
#ifndef PHASE_MASK
#define PHASE_MASK 0xfff
#endif
#define IN(k) (((PHASE_MASK >> (k)) & 1) && lo <= (k) && (k) < hi)
    if (threadIdx.x == 0) { ((volatile LAS unsigned*)(ldsl + LDS_MAIN))[0] = 0u; ((volatile LAS unsigned*)(ldsl + LDS_MAIN))[1] = 0u; }
    __syncthreads();
    XcdBarrier xbar; xbar.bar = (unsigned*)(ws + WS_BAR); xbar.x = 0; xbar.st = nullptr;
    if (hi - lo > 1) xbar = xcd_barrier_post((unsigned*)(ws + WS_BAR), (volatile LAS unsigned*)(ldsl + LDS_MAIN));
    if (lo > hi) cg::this_grid().sync();
    const bool shadow = (G == 256) && (hi - lo == N_PHASES);
#define SEAM(k) do { if (IN(k) && IN((k) + 1)) { const unsigned g_ = xcd_arrive(xbar); if (shadow) shadow_work(p, lds, (k), bid, G); xcd_wait(xbar, g_); } } while (0)
    bf16_t* XB = (bf16_t*)(ws + WS_XB); bf16_t* LT = (bf16_t*)(ws + WS_ST);
    bf16_t* QH = (bf16_t*)(ws + WS_QH); bf16_t* KH = (bf16_t*)(ws + WS_KH); bf16_t* VH = (bf16_t*)(ws + WS_VH); bf16_t* GH = (bf16_t*)(ws + WS_GH); bf16_t* PH = (bf16_t*)(ws + WS_PH);
    float* LF = (float*)(ws + WS_LF); bf16_t* ST = (bf16_t*)(ws + WS_ST); bf16_t* MIXED = (bf16_t*)(ws + WS_MIXED);
    float* X1 = (float*)(ws + WS_X1); bf16_t* XQ = (bf16_t*)(ws + WS_XQ); bf16_t* ATT = (bf16_t*)(ws + WS_ATT); bf16_t* U = (bf16_t*)(ws + WS_U);
    float* SSQ = (float*)(ws + WS_SSQ); float* DEC = (float*)(ws + WS_DEC);
    bf16_t* MEMB = (bf16_t*)(ws + WS_MEMB); bf16_t* KX = (bf16_t*)(ws + WS_KX); bf16_t* VT = (bf16_t*)(ws + WS_VT);

    const bool fuse_final = FUSE_FINAL && (G == 256) && IN(10) && (hi - lo > 1);
    if (IN(0)) { phase_prep(p, lds, shadow);
#if !DEFER_PREP
        if (!shadow) deferred_prep(p, lds, bid, G);
#endif
    }
    SEAM(0);
    const bf16_t* WTIN = (const bf16_t*)(ws + WS_WT_IN);
    if (IN(1)) {
        const pg8::Epi E{0, ws, p.x, p.out, p.lb_logits, p.final_norm_g, 2};
        pg8::Gemm g{XB, WTIN + (size_t)512 * DM, MROWS, 1024, DM}; pg8::StaticOrder S; S.init(MROWS, 1024, G, bid); pg8::gemm_phase(ldsl, g, S, E);
    }
    SEAM(1);
    if (IN(2)) {
        { const pg8::Epi E{0, ws, p.x, p.out, p.lb_logits, p.final_norm_g, 6};
          pg8::Gemm g{XB, WTIN + (size_t)1536 * DM, MROWS, 1024, DM}; pg8::StaticOrder S; S.init(MROWS, 1024, G, bid); pg8::gemm_phase(ldsl, g, S, E); }
        { const pg8::Epi E{0, ws, p.x, p.out, p.lb_logits, p.final_norm_g, 0};
          pg8::Gemm g{XB, WTIN, MROWS, 512, DM}; pg8::StaticOrder S; S.init(MROWS, 512, G, bid); pg8::gemm_phase(ldsl, g, S, E); }
        const pg8::Epi E1{1, ws, p.x, p.out, p.lb_logits, p.final_norm_g, 0};
        { pg8::Gemm g{MEMB, (const bf16_t*)(ws + WS_WT_K), MEMROWS, 1024, DM}; pg8::StaticOrder S; S.init(MEMROWS, 1024, G, (bid + 128) % G); pg8::gemm_phase(ldsl, g, S, E1); }
        const pg8::Epi E2{2, ws, p.x, p.out, p.lb_logits, p.final_norm_g, 0};
        { pg8::Gemm g{(const bf16_t*)(ws + WS_WT_V), MEMB, 1024, MEMROWS, DM}; pg8::StaticOrder S; S.init(1024, MEMROWS, G, (bid + 112) % G); pg8::gemm_phase(ldsl, g, S, E2); }
        if (G == 256) {
            if (bid >= 160) phase_passA(KH, LF, VH, LT, DEC, lds, bid - 160, 96, 0, 512);
            phase_passA(KH, LF, VH, LT, DEC, lds, bid, G, 512, 1024);
        } else phase_passA(KH, LF, VH, LT, DEC, lds, bid, G, 0, 1024);
    }
    SEAM(2);
    if (IN(3)) {
        phase_scan(LT, DEC, ST, lds);
        if (!shadow) { for (int t = bid; t < 256; t += G) pool_tile(PH, MIXED, t); }
        fold_pool_weights_mfma(p);
    }
    SEAM(3);
    if (IN(4)) { phase_passC(QH, KH, LF, VH, GH, ST, p.hgrn_norm_g, MIXED, lds); }
    SEAM(4);
    if (IN(5)) {
        const pg8::Epi E{6, ws, p.x, p.out, p.lb_logits, p.final_norm_g, 0};
        pg8::Gemm g{MIXED, (const bf16_t*)(ws + WS_WT_OUT), MROWS, DM, DM}; pg8::StaticOrder S; S.init(MROWS, DM, G, bid); pg8::gemm_phase(ldsl, g, S, E);
    }
    SEAM(5);
    const bool fuse_attn = (G == 256) && IN(6) && IN(7);
    if (IN(6)) {
        const pg8::Epi E{4, ws, p.x, p.out, p.lb_logits, p.final_norm_g, 0};
        pg8::Gemm g{XB, (const bf16_t*)(ws + WS_WT_Q), MROWS, DM, DM}; pg8::StaticOrder S; S.init(MROWS, DM, G, bid); pg8::gemm_phase(ldsl, g, S, E);
        if (fuse_attn) {
            pg8::Unit u; S.next(0, u);
            asm volatile("s_waitcnt vmcnt(0)" ::: "memory"); __syncthreads();
            attn_unit(XQ, KX, VT, ATT, u.pm * 4 + u.pn, lds);
        }
    }
    if (!fuse_attn) {
        SEAM(6);
        if (IN(7)) { for (int u = bid; u < 256; u += G) attn_unit(XQ, KX, VT, ATT, u, lds); }
    }
    SEAM(7);
    if (IN(8)) {
        const pg8::Epi E{6, ws, p.x, p.out, p.lb_logits, p.final_norm_g, 0};
        pg8::Gemm g{ATT, (const bf16_t*)(ws + WS_WT_O), MROWS, DM, DM}; pg8::StaticOrder S; S.init(MROWS, DM, G, bid); pg8::gemm_phase(ldsl, g, S, E);
    }
    SEAM(8);
    if (IN(9)) {
        const pg8::Epi E{5, ws, p.x, p.out, p.lb_logits, p.final_norm_g, 0};
        pg8::Gemm g{XB, (const bf16_t*)(ws + WS_WT_FF1), MROWS, DFF, DM}; pg8::StaticOrder S; S.init(MROWS, DFF, G, bid); pg8::gemm_phase(ldsl, g, S, E);
    }
    SEAM(9);
    if (IN(10)) {
        const pg8::Epi E{fuse_final ? 8 : 7, ws, p.x, p.out, p.lb_logits, p.final_norm_g, 0};
        pg8::Gemm g{U, (const bf16_t*)(ws + WS_WT_FF2), MROWS, DM, DFF}; pg8::StaticOrder S; S.init(MROWS, DM, G, bid); pg8::gemm_phase(ldsl, g, S, E);
    }
    if (!fuse_final) {
        SEAM(10);
        if (IN(11)) { phase_final(XB, SSQ, p.out, p.final_norm_g); }
    }
#if DBG_LAST >= 0
    cg::this_grid().sync();
    {
        const unsigned* w32 = (const unsigned*)ws;
        for (size_t i = (size_t)bid * NTHREADS + threadIdx.x; i < (size_t)MROWS * DM; i += (size_t)G * NTHREADS) {
            float a = 0.f;
            for (int j = 0; j < 4; ++j) { const unsigned v = w32[i + (size_t)j * MROWS * DM]; a += (float)(v & 0xffffu) + (float)(v >> 16); }
            p.out[i] = a;
        }
    }
#endif
#undef IN
#undef SEAM
}

extern "C" void kernel_launch(void* const* d_in, const int* in_sizes, int n_in, void* d_out, int out_size, void* d_ws, size_t ws_size, hipStream_t stream) {
    static int grid = 0;
    if (grid == 0) {
        if (n_in != 19 || in_sizes[0] != MROWS * DM || out_size != MROWS * DM || ws_size < WS_END) { fprintf(stderr, "kernel_launch: unexpected shapes (n_in %d, ws %zu)\n", n_in, ws_size); grid = -1; return; }
        int dev = 0, cus = 0, per_cu = 0;
        hipGetDevice(&dev); hipDeviceGetAttribute(&cus, hipDeviceAttributeMultiprocessorCount, dev);
        if (hipFuncSetAttribute((const void*)mega, hipFuncAttributeMaxDynamicSharedMemorySize, LDS_BYTES) != hipSuccess) { fprintf(stderr, "kernel_launch: hipFuncSetAttribute failed\n"); grid = -1; return; }
        if (hipOccupancyMaxActiveBlocksPerMultiprocessor(&per_cu, (const void*)mega, NTHREADS, LDS_BYTES) != hipSuccess || per_cu < 1) { fprintf(stderr, "kernel_launch: occupancy query says %d\n", per_cu); per_cu = 1; }
        (void)hipGetLastError();
        grid = cus * 1;
        if (grid > cus * per_cu) grid = cus * per_cu;
    }
    if (grid < 0) return;
    if (hipMemsetAsync((char*)d_ws + WS_BAR, 0, 32768, stream) != hipSuccess) { fprintf(stderr, "kernel_launch: memset of barrier words failed\n"); return; }
    Params p{};
    const float** f = (const float**)&p;
    for (int i = 0; i < 19; ++i) f[i] = (const float*)d_in[i];
    p.out = (float*)d_out; p.ws = (unsigned char*)d_ws;
#if N_LAUNCH_MODE == 1
    p.ph_lo = 0; p.ph_hi = (DBG_LAST >= 0) ? DBG_LAST + 1 : N_PHASES;
    void* args[] = {&p};
    hipError_t e = hipLaunchCooperativeKernel((const void*)mega, dim3(grid), dim3(NTHREADS), args, LDS_BYTES, stream);
    if (e != hipSuccess) fprintf(stderr, "kernel_launch: cooperative launch failed: %s (grid %d)\n", hipGetErrorString(e), grid);
#else
    for (int k = 0; k < N_PHASES; ++k) { p.ph_lo = k; p.ph_hi = k + 1; hipLaunchKernelGGL(mega, dim3(grid), dim3(NTHREADS), LDS_BYTES, stream, p); }
#endif
}
```

```cpp
#include <hip/hip_runtime.h>
#include <hip/hip_cooperative_groups.h>
#include <cstdio>
namespace cg = cooperative_groups;

#ifndef N_LAUNCH_MODE
#define N_LAUNCH_MODE 1
#endif

typedef unsigned short bf16_t;
typedef short bf16x8 __attribute__((ext_vector_type(8)));
typedef float f32x2 __attribute__((ext_vector_type(2)));
typedef float f32x4 __attribute__((ext_vector_type(4)));
typedef float f32x16 __attribute__((ext_vector_type(16)));
typedef unsigned u32x2 __attribute__((ext_vector_type(2)));
typedef unsigned u32x4 __attribute__((ext_vector_type(4)));
#define LAS __attribute__((address_space(3)))

constexpr int MROWS = 16384, DM = 1024, SEQ = 4096, NIN = 2560, DFF = 4096, MEMROWS = 1024;
constexpr float EPS = 1e-6f;
constexpr int NTHREADS = 512;
constexpr int LDS_MAIN = 136192;
constexpr int LDS_BYTES = LDS_MAIN + 16;

constexpr size_t MiB = 1u << 20;
constexpr size_t WS_WT_IN = 0, WS_WT_K = 5 * MiB, WS_WT_V = 7 * MiB, WS_WT_OUT = 9 * MiB, WS_WT_Q = 11 * MiB, WS_WT_O = 13 * MiB,
                 WS_WT_FF1 = 15 * MiB, WS_WT_FF2 = 23 * MiB, WS_MEMB = 31 * MiB, WS_KX = 33 * MiB, WS_VT = 35 * MiB, WS_SSQ = 37 * MiB,
                 WS_BAR = 39 * MiB, WS_CNT = 39 * MiB + 16384, WS_RSTD0 = 38 * MiB, WS_RSTDM = 38 * MiB + 65536, WS_DEC = 38 * MiB + 131072,
                 WS_XB = 40 * MiB  , WS_QH = 72 * MiB, WS_KH = 88 * MiB, WS_VH = 104 * MiB, WS_GH = 120 * MiB, WS_PH = 136 * MiB,
                 WS_LF = 152 * MiB, WS_ST = 184 * MiB, WS_MIXED = 216 * MiB,
                 WS_X1 = 72 * MiB, WS_XQ = 136 * MiB, WS_ATT = 168 * MiB, WS_U = 72 * MiB, WS_END = 256 * MiB;

typedef __bf16 bf16x2n __attribute__((ext_vector_type(2)));
__device__ __forceinline__ unsigned cvt_pk_bf16(float lo, float hi) { f32x2 v = {lo, hi}; return __builtin_bit_cast(unsigned, __builtin_convertvector(v, bf16x2n)); }
__device__ __forceinline__ bf16_t f2bf(float f) { return (bf16_t)(cvt_pk_bf16(f, 0.f) & 0xffffu); }
__device__ __forceinline__ float bf2f(bf16_t b) { return __uint_as_float(((unsigned)b) << 16); }
__device__ __forceinline__ float bflo(unsigned u) { return __uint_as_float(u << 16); }
__device__ __forceinline__ float bfhi(unsigned u) { return __uint_as_float(u & 0xffff0000u); }
__device__ __forceinline__ f32x4 mfma16(bf16x8 a, bf16x8 b, f32x4 c) { return __builtin_amdgcn_mfma_f32_16x16x32_bf16(a, b, c, 0, 0, 0); }
__device__ __forceinline__ f32x16 mfma32(bf16x8 a, bf16x8 b, f32x16 c) { return __builtin_amdgcn_mfma_f32_32x32x16_bf16(a, b, c, 0, 0, 0); }
__device__ __forceinline__ bf16x8 mk8(u32x2 lo, u32x2 hi) { u32x4 t; t.x = lo.x; t.y = lo.y; t.z = hi.x; t.w = hi.y; return __builtin_bit_cast(bf16x8, t); }
__device__ __forceinline__ bf16x8 mk8u(unsigned a, unsigned b, unsigned c, unsigned d) { u32x4 t; t.x = a; t.y = b; t.z = c; t.w = d; return __builtin_bit_cast(bf16x8, t); }
__device__ __forceinline__ float sigmoidf_(float z) { return __builtin_amdgcn_rcpf(1.0f + __expf(-z)); }

namespace pg8 {
constexpr int BM = 256, BK = 64, HALF = 128, HTB = HALF * BK * 2, STAGE_BYTES = 8 * HTB, NXCD = 8, WGM = 8;
__device__ __forceinline__ int lds_byte(int r, int c) { const int st = (r >> 4) * 2 + (c >> 5), rr = r & 15, cc = c & 31, ob = rr * 64 + cc * 2; return st * 1024 + (ob ^ (((ob >> 9) & 1) << 5)); }
__device__ __forceinline__ void stage_rc(int b, int& R, int& C) { const int st = b / 1024, sb = b % 1024, swz = sb ^ (((sb >> 9) & 1) << 5); R = (st >> 1) * 16 + swz / 64; C = (st & 1) * 32 + (swz % 64) / 2; }
__device__ __forceinline__ int perm32(int rho) { const int n = rho >> 4, i = rho & 15; return 8 * (i >> 2) + 4 * n + (i & 3); }
struct Unit { int pm, pn; };
struct Gemm { const bf16_t* A; const bf16_t* Bt; int M, N, K; };
struct StaticOrder {
    int nM, nN, nwg, G, c;
    __device__ __forceinline__ void init(int M, int N, int G_, int c_) { nM = M / BM; nN = N / BM; nwg = nM * nN; G = G_; c = c_; }
    __device__ __forceinline__ bool next(int i, Unit& u) const {
        const long L = (long)i * G + c; if (L >= nwg) return false;
        int wgid = (int)L; { const int q = nwg / NXCD, r = nwg % NXCD, xcd = wgid % NXCD, off = wgid / NXCD; wgid = (xcd < r ? xcd * (q + 1) : r * (q + 1) + (xcd - r) * q) + off; }
        const int nig = WGM * nN, gid = wgid / nig, fm = gid * WGM, gsz = (nM - fm) < WGM ? (nM - fm) : WGM;
        u.pm = fm + ((wgid % nig) % gsz); u.pn = (wgid % nig) / gsz; return true;
    }
};

struct Epi {
    static constexpr bool PERM = true;
    int mode;
    unsigned char* ws; const float* x; float* out; const float* lbl; const float* gfin; int pnoff;
    __device__ __forceinline__ void store8(bf16_t* p, const f32x4& v0, const f32x4& v1) const {
        u32x4 w; w.x = cvt_pk_bf16(v0[0], v0[1]); w.y = cvt_pk_bf16(v0[2], v0[3]); w.z = cvt_pk_bf16(v1[0], v1[1]); w.w = cvt_pk_bf16(v1[2], v1[3]); *(u32x4*)p = w; }
    __device__ __forceinline__ void fused(f32x4 (&acc)[2][2][4][2], const Unit& u, int wr, int wc, int fr, int fq) const {
        const int row0 = u.pm * BM + wr * 64 + fr;
        const int col0 = u.pn * BM + wc * 32 + 8 * fq;
        const bf16_t* xb = (const bf16_t*)(ws + WS_XB);
        unsigned* sq = (unsigned*)(ws + WS_SSQ);
        unsigned* cnt = (unsigned*)(ws + WS_CNT) + 64 * u.pm;
        u32x4 bc[2], bn[2];
        { const size_t o = (size_t)row0 * DM + col0; bc[0] = *(const u32x4*)(xb + o); bc[1] = *(const u32x4*)(xb + o + HALF); }
#pragma unroll
        for (int gidx = 0; gidx < 8; ++gidx) { const int ai = gidx >> 2, m = gidx & 3; const int row = row0 + ai * HALF + m * 16;
            if (gidx < 7) { const int g2 = gidx + 1; const size_t o2 = (size_t)(row0 + (g2 >> 2) * HALF + (g2 & 3) * 16) * DM + col0; bn[0] = *(const u32x4*)(xb + o2); bn[1] = *(const u32x4*)(xb + o2 + HALF); }
            float ss = 0.f;
#pragma unroll
            for (int bj = 0; bj < 2; ++bj) { const u32x4 bb = bc[bj];
                const f32x4 v0 = acc[ai][bj][m][0] + (f32x4){bflo(bb.x), bfhi(bb.x), bflo(bb.y), bfhi(bb.y)}, v1 = acc[ai][bj][m][1] + (f32x4){bflo(bb.z), bfhi(bb.z), bflo(bb.w), bfhi(bb.w)};
                acc[ai][bj][m][0] = v0; acc[ai][bj][m][1] = v1;
                ss += (v0[0] * v0[0] + v0[1] * v0[1]) + (v0[2] * v0[2] + v0[3] * v0[3]) + (v1[0] * v1[0] + v1[1] * v1[1]) + (v1[2] * v1[2] + v1[3] * v1[3]); }
            ss += __shfl_xor(ss, 16); ss += __shfl_xor(ss, 32);
            if (fq == 0) __hip_atomic_store(sq + (size_t)row * 16 + u.pn * 4 + wc, __float_as_uint(ss), __ATOMIC_RELAXED, __HIP_MEMORY_SCOPE_AGENT);
            bc[0] = bn[0]; bc[1] = bn[1]; }
        asm volatile("s_waitcnt vmcnt(0)" ::: "memory");
        if ((threadIdx.x & 63) == 0) __hip_atomic_fetch_add(cnt, 1u, __ATOMIC_RELAXED, __HIP_MEMORY_SCOPE_AGENT);
        f32x4 gv[2][2];
#pragma unroll
        for (int bj = 0; bj < 2; ++bj) { gv[bj][0] = *(const f32x4*)(gfin + col0 + bj * HALF); gv[bj][1] = *(const f32x4*)(gfin + col0 + bj * HALF + 4); }
        { unsigned spins = 0; while ((unsigned)__builtin_amdgcn_readfirstlane(__hip_atomic_load(cnt, __ATOMIC_RELAXED, __HIP_MEMORY_SCOPE_AGENT)) < 32u) { __builtin_amdgcn_s_sleep(1); if (++spins > (1u << 22)) break; } }
        __builtin_amdgcn_fence(__ATOMIC_ACQUIRE, "agent");
        asm volatile("s_waitcnt vmcnt(0)" ::: "memory");
        f32x4 pv[8];
#pragma unroll
        for (int gidx = 0; gidx < 8; ++gidx) pv[gidx] = *(const f32x4*)((const float*)sq + (size_t)(row0 + (gidx >> 2) * HALF + (gidx & 3) * 16) * 16 + 4 * fq);
#pragma unroll
        for (int gidx = 0; gidx < 8; ++gidx) { const int ai = gidx >> 2, m = gidx & 3; const int row = row0 + ai * HALF + m * 16;
            float t = (pv[gidx][0] + pv[gidx][1]) + (pv[gidx][2] + pv[gidx][3]); t += __shfl_xor(t, 16); t += __shfl_xor(t, 32);
            const float rstd = rsqrtf(t * (1.0f / 1024.0f) + EPS);
            const size_t o = (size_t)row * DM + col0;
#pragma unroll
            for (int bj = 0; bj < 2; ++bj) { *(f32x4*)(out + o + bj * HALF) = acc[ai][bj][m][0] * rstd * gv[bj][0]; *(f32x4*)(out + o + bj * HALF + 4) = acc[ai][bj][m][1] * rstd * gv[bj][1]; } }
    }
    template <class Sched>
    __device__ __forceinline__ bool prefill(LAS unsigned char* lds, const Sched& S) const {
        if (!(mode == 0 || mode == 1 || mode == 4 || mode == 5) || S.nwg > 4 * S.G) return false;
        const int tid = threadIdx.x, rr = tid & 255;
#pragma unroll
        for (int k = 0; k < 2; ++k) { const int ui = (tid >> 8) + 2 * k; Unit u;
            if (S.next(ui, u)) { const int row = u.pm * BM + rr; float r;
                if (mode == 4 || mode == 5) { const f32x4* pp = (const f32x4*)((const float*)(ws + WS_SSQ) + (size_t)row * 16); const f32x4 a = pp[0], b = pp[1], c = pp[2], d = pp[3];
                    const float t = ((a[0] + a[1]) + (a[2] + a[3])) + ((b[0] + b[1]) + (b[2] + b[3])) + ((c[0] + c[1]) + (c[2] + c[3])) + ((d[0] + d[1]) + (d[2] + d[3]));
                    r = rsqrtf(t * (1.0f / 1024.0f) + EPS) * (mode == 4 ? 0.0625f : 1.0f); }
                else r = ((const float*)(ws + (mode == 0 ? WS_RSTD0 : WS_RSTDM)))[row];
                *(LAS float*)(lds + STAGE_BYTES + (ui * 256 + rr) * 4) = r; } }
        return true;
    }
    __device__ __forceinline__ void operator()(const f32x4 (&acc)[2][2][4][2], const Unit& u, int ui, bool tab, LAS unsigned char* lds, int wr, int wc, int fr, int fq) const {
        const int row0 = u.pm * BM + wr * 64 + fr;
        const int colL = wc * 32 + 8 * fq;
        if (mode == 3 || mode == 6 || mode == 7) {
            const int col0 = u.pn * BM + colL;
            bf16_t* xb = (bf16_t*)(ws + WS_XB);
            float* ssq = (float*)(ws + WS_SSQ);
            f32x4 rc[4], rn[4];
            u32x4 bc[2], bn[2];
            if (mode == 3) { const size_t o = (size_t)row0 * DM + col0; rc[0] = *(const f32x4*)(x + o); rc[1] = *(const f32x4*)(x + o + 4); rc[2] = *(const f32x4*)(x + o + HALF); rc[3] = *(const f32x4*)(x + o + HALF + 4); }
            else { const size_t o = (size_t)row0 * DM + col0; bc[0] = *(const u32x4*)(xb + o); bc[1] = *(const u32x4*)(xb + o + HALF); }
#pragma unroll
            for (int gidx = 0; gidx < 8; ++gidx) { const int ai = gidx >> 2, m = gidx & 3; const int row = row0 + ai * HALF + m * 16;
                if (gidx < 7) { const int g2 = gidx + 1; const size_t o2 = (size_t)(row0 + (g2 >> 2) * HALF + (g2 & 3) * 16) * DM + col0;
                    if (mode == 3) { rn[0] = *(const f32x4*)(x + o2); rn[1] = *(const f32x4*)(x + o2 + 4); rn[2] = *(const f32x4*)(x + o2 + HALF); rn[3] = *(const f32x4*)(x + o2 + HALF + 4); }
                    else { bn[0] = *(const u32x4*)(xb + o2); bn[1] = *(const u32x4*)(xb + o2 + HALF); } }
                if (mode != 3) {
#pragma unroll
                    for (int bj = 0; bj < 2; ++bj) { rc[2 * bj] = (f32x4){bflo(bc[bj].x), bfhi(bc[bj].x), bflo(bc[bj].y), bfhi(bc[bj].y)}; rc[2 * bj + 1] = (f32x4){bflo(bc[bj].z), bfhi(bc[bj].z), bflo(bc[bj].w), bfhi(bc[bj].w)}; } }
                float ss = 0.f;
#pragma unroll
                for (int bj = 0; bj < 2; ++bj) { const size_t o = (size_t)row * DM + col0 + bj * HALF;
                    const f32x4 v0 = acc[ai][bj][m][0] + rc[2 * bj], v1 = acc[ai][bj][m][1] + rc[2 * bj + 1];
                    store8(xb + o, v0, v1);
                    ss += (v0[0] * v0[0] + v0[1] * v0[1]) + (v0[2] * v0[2] + v0[3] * v0[3]) + (v1[0] * v1[0] + v1[1] * v1[1]) + (v1[2] * v1[2] + v1[3] * v1[3]); }
                ss += __shfl_xor(ss, 16); ss += __shfl_xor(ss, 32);
                if (fq == 0) ssq[(size_t)row * 16 + u.pn * 4 + wc] = ss;
#pragma unroll
                for (int k = 0; k < 4; ++k) rc[k] = rn[k];
                bc[0] = bn[0]; bc[1] = bn[1]; }
            return;
        }
        if (mode == 2) {
            const int col0 = u.pn * BM + colL;
            const float* rs = (const float*)(ws + WS_RSTDM); bf16_t* ob = (bf16_t*)(ws + WS_VT); const int ldo = 1024;
            f32x4 c0[2], c1[2];
#pragma unroll
            for (int bj = 0; bj < 2; ++bj) { c0[bj] = *(const f32x4*)(rs + col0 + bj * HALF); c1[bj] = *(const f32x4*)(rs + col0 + bj * HALF + 4); }
#pragma unroll
            for (int ai = 0; ai < 2; ++ai)
#pragma unroll
                for (int m = 0; m < 4; ++m) { const int row = row0 + ai * HALF + m * 16;
#pragma unroll
                    for (int bj = 0; bj < 2; ++bj) store8(ob + (size_t)row * ldo + col0 + bj * HALF, acc[ai][bj][m][0] * c0[bj], acc[ai][bj][m][1] * c1[bj]); }
            return;
        }
        float rsc[8];
        if (tab) {
#pragma unroll
            for (int gidx = 0; gidx < 8; ++gidx) rsc[gidx] = *(const LAS float*)(lds + STAGE_BYTES + (ui * 256 + wr * 64 + fr + (gidx >> 2) * HALF + (gidx & 3) * 16) * 4);
        } else if (mode == 4 || mode == 5) {
            asm volatile("" ::: "memory");
            const float* sq = (const float*)(ws + WS_SSQ);
            f32x4 pv[8];
#pragma unroll
            for (int gidx = 0; gidx < 8; ++gidx) pv[gidx] = *(const f32x4*)(sq + (size_t)(row0 + (gidx >> 2) * HALF + (gidx & 3) * 16) * 16 + 4 * fq);
            const float cs = mode == 4 ? 0.0625f : 1.0f;
#pragma unroll
            for (int gidx = 0; gidx < 8; ++gidx) { float t = (pv[gidx][0] + pv[gidx][1]) + (pv[gidx][2] + pv[gidx][3]); t += __shfl_xor(t, 16); t += __shfl_xor(t, 32); rsc[gidx] = rsqrtf(t * (1.0f / 1024.0f) + EPS) * cs; }
        } else {
            asm volatile("" ::: "memory");
            const float* rs = (const float*)(ws + (mode == 0 ? WS_RSTD0 : WS_RSTDM));
#pragma unroll
            for (int gidx = 0; gidx < 8; ++gidx) rsc[gidx] = rs[row0 + (gidx >> 2) * HALF + (gidx & 3) * 16];
        }
        if (mode == 0) {
            float* lf = (float*)(ws + WS_LF);
            const int pnn = u.pn + pnoff; const int sub = pnn >> 1; const int cb = (pnn & 1) * 256 + colL;
            if (sub == 1) {
                float oml[2][8];
#pragma unroll
                for (int bj = 0; bj < 2; ++bj)
#pragma unroll
                    for (int j = 0; j < 8; ++j) { const int c = cb + bj * HALF + j; const float l0 = lbl[c], l1 = lbl[512 + c]; const float lb = 1.0f / (1.0f + __expf(l1 - l0)); oml[bj][j] = 1.0f - lb; }
#pragma unroll
                for (int ai = 0; ai < 2; ++ai)
#pragma unroll
                    for (int m = 0; m < 4; ++m) { const int row = row0 + ai * HALF + m * 16; const float r = rsc[ai * 4 + m];
#pragma unroll
                        for (int bj = 0; bj < 2; ++bj) { f32x4 lf0, lf1;
#pragma unroll
                            for (int j = 0; j < 4; ++j) {
                                const float za = acc[ai][bj][m][0][j] * r, zb = acc[ai][bj][m][1][j] * r;
                                const float ka = oml[bj][j] * (1.0f - sigmoidf_(za)), kb = oml[bj][4 + j] * (1.0f - sigmoidf_(zb));
                                lf0[j] = __logf(1.0f - ka); lf1[j] = __logf(1.0f - kb); }
                            const size_t o = (size_t)row * 512 + cb + bj * HALF;
                            *(f32x4*)(lf + o) = lf0; *(f32x4*)(lf + o + 4) = lf1; } }
            } else {
                bf16_t* dst = (bf16_t*)(ws + (sub == 0 ? WS_QH : (sub == 2 ? WS_VH : (sub == 3 ? WS_GH : WS_PH))));
                const bool act = (sub == 0) || (sub == 3);
#pragma unroll
                for (int ai = 0; ai < 2; ++ai)
#pragma unroll
                    for (int m = 0; m < 4; ++m) { const int row = row0 + ai * HALF + m * 16; const float r = rsc[ai * 4 + m];
#pragma unroll
                        for (int bj = 0; bj < 2; ++bj) { f32x4 v0 = acc[ai][bj][m][0] * r, v1 = acc[ai][bj][m][1] * r;
                            if (act) {
#pragma unroll
                                for (int j = 0; j < 4; ++j) { v0[j] = v0[j] * sigmoidf_(v0[j]); v1[j] = v1[j] * sigmoidf_(v1[j]); } }
                            store8(dst + (size_t)row * 512 + cb + bj * HALF, v0, v1); } }
            }
        } else {
            const int col0 = u.pn * BM + colL;
            bf16_t* ob = (bf16_t*)(ws + (mode == 1 ? WS_KX : (mode == 4 ? WS_XQ : WS_U))); const int ldo = mode == 5 ? DFF : 1024;
#pragma unroll
            for (int ai = 0; ai < 2; ++ai)
#pragma unroll
                for (int m = 0; m < 4; ++m) { const int row = row0 + ai * HALF + m * 16; const float r = rsc[ai * 4 + m];
#pragma unroll
                    for (int bj = 0; bj < 2; ++bj) { f32x4 v0 = acc[ai][bj][m][0] * r, v1 = acc[ai][bj][m][1] * r;
                        if (mode == 5) {
#pragma unroll
                            for (int j = 0; j < 4; ++j) { const float a = fmaxf(v0[j], 0.f), b = fmaxf(v1[j], 0.f); v0[j] = a * a; v1[j] = b * b; } }
                        if (mode == 5) {
                            u32x4 w; w.x = cvt_pk_bf16(v0[0], v0[1]); w.y = cvt_pk_bf16(v0[2], v0[3]); w.z = cvt_pk_bf16(v1[0], v1[1]); w.w = cvt_pk_bf16(v1[2], v1[3]);
                            __builtin_amdgcn_raw_buffer_store_b128(w, __builtin_amdgcn_make_buffer_rsrc((void*)ob, 0, 0x7fffffff, 0x00020000), (int)(((size_t)row * ldo + col0 + bj * HALF) * 2), 0, 16); }
                        else store8(ob + (size_t)row * ldo + col0 + bj * HALF, v0, v1); } }
        }
    }
};

template <class EpiT, class Sched>
__device__ __forceinline__ void gemm_phase(LAS unsigned char* lds, const Gemm g, const Sched S, const EpiT E) {
    const int tid = threadIdx.x, wid = __builtin_amdgcn_readfirstlane(tid >> 6), lane = tid & 63, wr = wid >> 2, wc = wid & 3, fr = lane & 15, fq = lane >> 4;
    const int K = g.K, nt = K / BK;
    unsigned voffA[2], voffB[2];
#pragma unroll
    for (int i = 0; i < 2; ++i) { int R, C; stage_rc(tid * 16 + i * 8192, R, C); const int Rb = EpiT::PERM ? ((R & ~31) + perm32(R & 31)) : R;
        voffA[i] = (unsigned)(R * K + C) * 2u; voffB[i] = (unsigned)(Rb * K + C) * 2u; }
    const size_t kstep = (size_t)(BK * 2);
    const size_t hstep = (size_t)HALF * K * 2;
    const size_t tstep = 2 * hstep;
    const unsigned ldsw = (unsigned)wid * 1024u;
    const int aoff = lds_byte(wr * 64 + fr, fq * 8), boff = lds_byte(wc * 32 + fr, fq * 8);
#define PG8_SA(b, h) (((b) * 2 + (h)) * HTB)
#define PG8_SB(b, h) ((4 + (b) * 2 + (h)) * HTB)
#define PG8_STAGE(bufoff, gbase, voff) do { _Pragma("unroll") for (int _i = 0; _i < 2; ++_i) \
        __builtin_amdgcn_global_load_lds((const unsigned*)((const char*)(gbase) + (voff)[_i]), (LAS unsigned*)(lds + (bufoff) + ldsw + _i * 8192), 16, 0, 0); } while (0)
#define PG8_LDA(dst, b, h) do { _Pragma("unroll") for (int m = 0; m < 4; ++m) _Pragma("unroll") for (int k = 0; k < 2; ++k) dst[m][k] = *(const LAS bf16x8*)(lds + PG8_SA(b, h) + aoff + m * 2048 + k * 1024); } while (0)
#define PG8_LDB(dst, b, h) do { _Pragma("unroll") for (int n = 0; n < 2; ++n) _Pragma("unroll") for (int k = 0; k < 2; ++k) dst[n][k] = *(const LAS bf16x8*)(lds + PG8_SB(b, h) + boff + n * 2048 + k * 1024); } while (0)
#define PG8_MMA(ai, bj, At, Bt) do { __builtin_amdgcn_s_setprio(1); _Pragma("unroll") for (int m = 0; m < 4; ++m) _Pragma("unroll") for (int n = 0; n < 2; ++n) _Pragma("unroll") for (int k = 0; k < 2; ++k) \
        acc[ai][bj][m][n] = __builtin_amdgcn_mfma_f32_16x16x32_bf16(Bt[n][k], At[m][k], acc[ai][bj][m][n], 0, 0, 0); __builtin_amdgcn_s_setprio(0); } while (0)
#define PG8_WAIT_V(n) asm volatile("s_waitcnt vmcnt(" #n ")" ::: "memory")
#define PG8_WAIT_L(n) asm volatile("s_waitcnt lgkmcnt(" #n ")" ::: "memory")
#define PG8_BAR __builtin_amdgcn_s_barrier()
#define PG8_SCHED __builtin_amdgcn_sched_barrier(0)
    Unit cur, nxt; int ui = 0;
    if (!S.next(0, cur)) return;
    const bool tab = E.prefill(lds, S);
    if (tab) __syncthreads();
    f32x4 acc[2][2][4][2];
#pragma unroll
    for (int a = 0; a < 2; ++a)
#pragma unroll
        for (int b = 0; b < 2; ++b)
#pragma unroll
            for (int m = 0; m < 4; ++m)
#pragma unroll
                for (int n = 0; n < 2; ++n) acc[a][b][m][n] = (f32x4){0.f, 0.f, 0.f, 0.f};
    bf16x8 At[4][2], B0[2][2], B1[2][2];
    const char* cA = (const char*)g.A + (size_t)cur.pm * tstep; const char* cB = (const char*)g.Bt + (size_t)cur.pn * tstep;
    PG8_STAGE(PG8_SB(0, 0), cB, voffB); PG8_STAGE(PG8_SA(0, 0), cA, voffA); PG8_STAGE(PG8_SB(0, 1), cB + hstep, voffB); PG8_STAGE(PG8_SA(0, 1), cA + hstep, voffA);
    if (wr == 1) PG8_BAR;
    PG8_WAIT_V(4); PG8_BAR;
    PG8_STAGE(PG8_SB(1, 0), cB + kstep, voffB); PG8_STAGE(PG8_SA(1, 0), cA + kstep, voffA); PG8_STAGE(PG8_SB(1, 1), cB + hstep + kstep, voffB);
    PG8_WAIT_V(6); PG8_BAR;
    for (;;) {
        const bool has_next = S.next(ui + 1, nxt);
        const char* nA = has_next ? (const char*)g.A + (size_t)nxt.pm * tstep : cA; const char* nB = has_next ? (const char*)g.Bt + (size_t)nxt.pn * tstep : cB;
        for (int t = 0; t < nt; t += 2) {
            const bool last = (t == nt - 2);
            const char* a1 = cA + (size_t)(t + 1) * kstep;
            const char* a2 = last ? nA : cA + (size_t)(t + 2) * kstep; const char* b2 = last ? nB : cB + (size_t)(t + 2) * kstep;
            const char* a3 = a2 + kstep; const char* b3 = b2 + kstep;
            PG8_LDB(B0, 0, 0); PG8_SCHED; PG8_LDA(At, 0, 0); PG8_STAGE(PG8_SA(1, 1), a1 + hstep, voffA);
            PG8_WAIT_L(8); PG8_BAR; PG8_WAIT_L(0); PG8_MMA(0, 0, At, B0); PG8_BAR; PG8_SCHED;
            PG8_LDB(B1, 0, 1); PG8_STAGE(PG8_SB(0, 0), b2, voffB);
            PG8_BAR; PG8_WAIT_L(0); PG8_MMA(0, 1, At, B1); PG8_BAR;
            PG8_LDA(At, 0, 1); PG8_STAGE(PG8_SA(0, 0), a2, voffA);
            PG8_BAR; PG8_WAIT_L(0); PG8_MMA(1, 0, At, B0); PG8_BAR; PG8_SCHED;
            PG8_STAGE(PG8_SB(0, 1), b2 + hstep, voffB);
            PG8_WAIT_V(6); PG8_BAR; PG8_MMA(1, 1, At, B1); PG8_BAR;
            PG8_LDB(B0, 1, 0); PG8_SCHED; PG8_LDA(At, 1, 0); PG8_STAGE(PG8_SA(0, 1), a2 + hstep, voffA);
            PG8_WAIT_L(8); PG8_BAR; PG8_WAIT_L(0); PG8_MMA(0, 0, At, B0); PG8_BAR; PG8_SCHED;
            PG8_LDB(B1, 1, 1); PG8_STAGE(PG8_SB(1, 0), b3, voffB);
            PG8_BAR; PG8_WAIT_L(0); PG8_MMA(0, 1, At, B1); PG8_BAR;
            PG8_LDA(At, 1, 1); PG8_STAGE(PG8_SA(1, 0), a3, voffA);
            PG8_BAR; PG8_WAIT_L(0); PG8_MMA(1, 0, At, B0); PG8_BAR; PG8_SCHED;
            PG8_STAGE(PG8_SB(1, 1), b3 + hstep, voffB);
            PG8_WAIT_V(6); PG8_BAR; PG8_MMA(1, 1, At, B1); PG8_BAR;
        }
        if (E.mode != 8) E(acc, cur, ui, tab, lds, wr, wc, fr, fq);
        if (E.mode == 0) __builtin_amdgcn_s_waitcnt(0x0F70);
        if (!has_next) break;
#pragma unroll
        for (int a = 0; a < 2; ++a)
#pragma unroll
            for (int b = 0; b < 2; ++b)
#pragma unroll
                for (int m = 0; m < 4; ++m)
#pragma unroll
                    for (int n = 0; n < 2; ++n) acc[a][b][m][n] = (f32x4){0.f, 0.f, 0.f, 0.f};
        cur = nxt; cA = nA; cB = nB; ++ui;
    }
    PG8_WAIT_V(0);
    if (wr == 0) PG8_BAR;
    PG8_BAR;
    if (E.mode == 8) E.fused(acc, cur, wr, wc, fr, fq);
#undef PG8_SA
#undef PG8_SB
#undef PG8_STAGE
#undef PG8_LDA
#undef PG8_LDB
#undef PG8_MMA
#undef PG8_WAIT_V
#undef PG8_WAIT_L
#undef PG8_BAR
#undef PG8_SCHED
}
}

struct Params {
    const float *x, *mem, *norm_mix_g, *w_in, *lb_logits, *hgrn_norm_g, *w_pool, *pool_scale, *w_out, *norm_x_g, *norm_mem_g, *w_xq, *w_xk, *w_xv, *w_xo, *norm_ffn_g, *w_ff1, *w_ff2, *final_norm_g;
    float* out; unsigned char* ws;
    int ph_lo, ph_hi;
};

struct TD { const float* W; const float* g; bf16_t* out; int N, ldo, kt, nt; };
__device__ __forceinline__ TD tile_desc(const Params& p, int t) {
    unsigned char* ws = p.ws; TD d;
    if (t < 320)       { d.W = p.w_in;  d.g = p.norm_mix_g; d.out = (bf16_t*)(ws + WS_WT_IN);  d.N = NIN;  d.ldo = 1024; d.kt = t / 40; d.nt = t % 40; }
    else if (t < 448)  { const int u = t - 320;  d.W = p.w_xk;  d.g = p.norm_mem_g; d.out = (bf16_t*)(ws + WS_WT_K);   d.N = 1024; d.ldo = 1024; d.kt = u / 16; d.nt = u % 16; }
    else if (t < 576)  { const int u = t - 448;  d.W = p.w_xv;  d.g = p.norm_mem_g; d.out = (bf16_t*)(ws + WS_WT_V);   d.N = 1024; d.ldo = 1024; d.kt = u / 16; d.nt = u % 16; }
    else if (t < 704)  { const int u = t - 576;  d.W = p.w_xq;  d.g = p.norm_x_g;   d.out = (bf16_t*)(ws + WS_WT_Q);   d.N = 1024; d.ldo = 1024; d.kt = u / 16; d.nt = u % 16; }
    else if (t < 832)  { const int u = t - 704;  d.W = p.w_xo;  d.g = nullptr;      d.out = (bf16_t*)(ws + WS_WT_O);   d.N = 1024; d.ldo = 1024; d.kt = u / 16; d.nt = u % 16; }
    else if (t < 960)  { const int u = t - 832;  d.W = p.w_out; d.g = nullptr;      d.out = (bf16_t*)(ws + WS_WT_OUT); d.N = 1024; d.ldo = 1024; d.kt = u / 16; d.nt = u % 16; }
    else if (t < 1472) { const int u = t - 960;  d.W = p.w_ff1; d.g = p.norm_ffn_g; d.out = (bf16_t*)(ws + WS_WT_FF1); d.N = DFF;  d.ldo = 1024; d.kt = u / 64; d.nt = u % 64; }
    else if (t < 1984) { const int u = t - 1472; d.W = p.w_ff2; d.g = nullptr;      d.out = (bf16_t*)(ws + WS_WT_FF2); d.N = 1024; d.ldo = 4096; d.kt = u / 16; d.nt = u % 16; }
    else if (t < 2112) { const int u = t - 1984; d.W = p.w_in;  d.g = p.norm_mix_g; d.out = (bf16_t*)(ws + WS_WT_IN);  d.N = NIN;  d.ldo = 1024; d.kt = u / 16; d.nt = 8 + u % 16; }
    else               { const int u = t - 2112, j = u % 24; d.W = p.w_in; d.g = p.norm_mix_g; d.out = (bf16_t*)(ws + WS_WT_IN); d.N = NIN; d.ldo = 1024; d.kt = u / 24; d.nt = j < 8 ? j : 16 + j; }
    return d;
}
__device__ __forceinline__ void tile_load(const TD& d, f32x4 (&v)[4], float (&sc)[4]) {
    const int tid = threadIdx.x, r = tid >> 4, c4 = tid & 15;
#pragma unroll
    for (int i = 0; i < 4; ++i) { const int k = 128 * d.kt + r + 32 * i; v[i] = __builtin_nontemporal_load((const f32x4*)(d.W + (size_t)k * d.N + 64 * d.nt + 4 * c4)); sc[i] = d.g ? d.g[k] : 1.0f; }
}
__device__ __forceinline__ void transpose_range(const Params& p, unsigned char* lds, int t_begin, int t_end, int first, int stride) {
    bf16_t* T0 = (bf16_t*)lds;
    bf16_t* T1 = (bf16_t*)(lds + 17408);
    const int tid = threadIdx.x, r = tid >> 4, c4 = tid & 15, n = tid >> 3, ks = tid & 7;
    int ta = t_begin + first;
    if (ta >= t_end) return;
    int tb = ta + stride; bool hb = tb < t_end;
    TD da = tile_desc(p, ta), db = da; f32x4 va[4], vb[4]; float sa[4], sb[4];
    tile_load(da, va, sa);
    if (hb) { db = tile_desc(p, tb); tile_load(db, vb, sb); }
    for (;;) {
#pragma unroll
        for (int i = 0; i < 4; ++i) { const int kl = r + 32 * i;
            T0[(4 * c4 + 0) * 136 + kl] = f2bf(va[i][0] * sa[i]); T0[(4 * c4 + 1) * 136 + kl] = f2bf(va[i][1] * sa[i]);
            T0[(4 * c4 + 2) * 136 + kl] = f2bf(va[i][2] * sa[i]); T0[(4 * c4 + 3) * 136 + kl] = f2bf(va[i][3] * sa[i]); }
        if (hb) {
#pragma unroll
            for (int i = 0; i < 4; ++i) { const int kl = r + 32 * i;
                T1[(4 * c4 + 0) * 136 + kl] = f2bf(vb[i][0] * sb[i]); T1[(4 * c4 + 1) * 136 + kl] = f2bf(vb[i][1] * sb[i]);
                T1[(4 * c4 + 2) * 136 + kl] = f2bf(vb[i][2] * sb[i]); T1[(4 * c4 + 3) * 136 + kl] = f2bf(vb[i][3] * sb[i]); } }
        __syncthreads();
        const int tna = ta + 2 * stride, tnb = tna + stride; const bool hna = tna < t_end, hnb = tnb < t_end;
        const TD ca = da, cb = db; const bool chb = hb;
        if (hna) { da = tile_desc(p, tna); tile_load(da, va, sa); }
        if (hnb) { db = tile_desc(p, tnb); tile_load(db, vb, sb); }
        { const u32x4* src = (const u32x4*)(T0 + n * 136 + 16 * ks); const u32x4 a = src[0], b = src[1];
          u32x4* dst = (u32x4*)(ca.out + (size_t)(64 * ca.nt + n) * ca.ldo + 128 * ca.kt + 16 * ks); dst[0] = a; dst[1] = b; }
        if (chb) { const u32x4* src = (const u32x4*)(T1 + n * 136 + 16 * ks); const u32x4 a = src[0], b = src[1];
          u32x4* dst = (u32x4*)(cb.out + (size_t)(64 * cb.nt + n) * cb.ldo + 128 * cb.kt + 16 * ks); dst[0] = a; dst[1] = b; }
        __syncthreads();
        if (!hna) break;
        ta = tna; hb = hnb;
    }
}
__device__ __forceinline__ void phase_prep(const Params p, unsigned char* lds, bool shadow) {
    unsigned char* ws = p.ws;
    const int G = gridDim.x;
    {
        const int lane = threadIdx.x & 63, gw = blockIdx.x * (NTHREADS / 64) + (threadIdx.x >> 6), nw = G * (NTHREADS / 64);
        int r = gw;
        f32x4 v[4], vn[4];
        if (r < MROWS + MEMROWS) { const float* src = r < MROWS ? p.x + (size_t)r * DM : p.mem + (size_t)(r - MROWS) * DM;
#pragma unroll
            for (int i = 0; i < 4; ++i) v[i] = __builtin_nontemporal_load((const f32x4*)src + lane + 64 * i); }
        for (; r < MROWS + MEMROWS; r += nw) {
            const int rn = r + nw;
            if (rn < MROWS + MEMROWS) { const float* src = rn < MROWS ? p.x + (size_t)rn * DM : p.mem + (size_t)(rn - MROWS) * DM;
#pragma unroll
                for (int i = 0; i < 4; ++i) vn[i] = __builtin_nontemporal_load((const f32x4*)src + lane + 64 * i); }
            const bool isx = r < MROWS;
            bf16_t* dst = isx ? (bf16_t*)(ws + WS_XB) + (size_t)r * DM : (bf16_t*)(ws + WS_MEMB) + (size_t)(r - MROWS) * DM;
            float ss = 0.f;
#pragma unroll
            for (int i = 0; i < 4; ++i) ss += (v[i][0] * v[i][0] + v[i][1] * v[i][1]) + (v[i][2] * v[i][2] + v[i][3] * v[i][3]);
#pragma unroll
            for (int o = 1; o < 64; o <<= 1) ss += __shfl_xor(ss, o);
#pragma unroll
            for (int i = 0; i < 4; ++i) { u32x2 w; w.x = cvt_pk_bf16(v[i][0], v[i][1]); w.y = cvt_pk_bf16(v[i][2], v[i][3]); ((u32x2*)dst)[lane + 64 * i] = w; }
            if (lane == 0) { const float rstd = rsqrtf(ss * (1.0f / 1024.0f) + EPS); if (isx) ((float*)(ws + WS_RSTD0))[r] = rstd; else ((float*)(ws + WS_RSTDM))[r - MROWS] = rstd; }
#pragma unroll
            for (int i = 0; i < 4; ++i) v[i] = vn[i];
        }
    }
    if (shadow) transpose_range(p, lds, 1984, 2112, blockIdx.x, G);
    else transpose_range(p, lds, 0, 576, blockIdx.x, G);
}
__device__ __forceinline__ void deferred_prep(const Params p, unsigned char* lds, int j, int nworkers) {
    transpose_range(p, lds, 576, 1984, j, nworkers);
}
__device__ __forceinline__ void fold_pool_weights_mfma(const Params& p) {
    bf16_t* wto = (bf16_t*)(p.ws + WS_WT_OUT);
    const int tid = threadIdx.x, w = tid >> 6, lane = tid & 63, fr = lane & 15, q = lane >> 4;
    for (int item = blockIdx.x; item < 256; item += gridDim.x) {
        const int gi = item >> 6, nb = item & 63;
        f32x4 acc = (f32x4){0.f, 0.f, 0.f, 0.f};
        const float* wp = p.w_pool + (size_t)(gi * 128 + 16 * w + fr) * 128;
        const float* ps = p.pool_scale + gi * 128;
        const bf16_t* arow = wto + (size_t)(16 * nb + fr) * 1024 + 512 + gi * 128;
#pragma unroll
        for (int ks = 0; ks < 4; ++ks) {
            const int d0 = 32 * ks + 8 * q;
            const f32x4 w0 = *(const f32x4*)(wp + d0), w1 = *(const f32x4*)(wp + d0 + 4), s0 = *(const f32x4*)(ps + d0), s1 = *(const f32x4*)(ps + d0 + 4);
            const bf16x8 cfr = mk8u(cvt_pk_bf16(w0[0] * s0[0], w0[1] * s0[1]), cvt_pk_bf16(w0[2] * s0[2], w0[3] * s0[3]), cvt_pk_bf16(w1[0] * s1[0], w1[1] * s1[1]), cvt_pk_bf16(w1[2] * s1[2], w1[3] * s1[3]));
            const bf16x8 nfr = *(const bf16x8*)(arow + d0);
            acc = mfma16(cfr, nfr, acc);
        }
        asm volatile("s_waitcnt vmcnt(0)" ::: "memory");
        __syncthreads();
        u32x2 o; o.x = cvt_pk_bf16(acc[0], acc[1]); o.y = cvt_pk_bf16(acc[2], acc[3]);
        *(u32x2*)(wto + (size_t)(16 * nb + fr) * 1024 + 512 + gi * 128 + 16 * w + 4 * q) = o;
        __syncthreads();
    }
}

__device__ __forceinline__ void phase_passA(const bf16_t* __restrict__ KH, const float* __restrict__ LF, const bf16_t* __restrict__ VH, bf16_t* __restrict__ LT, float* __restrict__ DEC, unsigned char* lds, int first, int stride, int ubeg, int uend) {
    const int tid = threadIdx.x, ch = tid & 127, seg = tid >> 7;
    float* segtot = (float*)lds;
    unsigned char* KdT = lds + 2048;
    unsigned char* VTl = lds + 2048 + 18432;
    const int w = tid >> 6, lane = tid & 63, fr = lane & 15, q = lane >> 4;
    float lf[16], kk[16]; unsigned vr[16];
    int unit = ubeg + first;
    if (unit < uend) { const int b = unit >> 8, c = (unit >> 2) & 63, h = unit & 3; const size_t g0 = (size_t)(b * SEQ + c * 64 + seg * 16) * 512 + h * 128 + ch;
#pragma unroll
        for (int i = 0; i < 16; ++i) { lf[i] = LF[g0 + (size_t)i * 512]; vr[i] = VH[g0 + (size_t)i * 512]; } }
    for (; unit < uend; unit += stride) {
        const int b = unit >> 8, c = (unit >> 2) & 63, h = unit & 3, bh = b * 4 + h;
#pragma unroll
        for (int i = 0; i < 16; ++i) kk[i] = 1.0f - __expf(lf[i]);
#pragma unroll
        for (int i = 1; i < 16; ++i) lf[i] += lf[i - 1];
        segtot[seg * 128 + ch] = lf[15];
        __syncthreads();
        float after = 0.f;
#pragma unroll
        for (int s2 = 1; s2 < 4; ++s2) if (s2 > seg) after += segtot[s2 * 128 + ch];
        const float tot = after + lf[15];
        if (seg == 0) DEC[(size_t)(bh * 64 + c) * 128 + ch] = __expf(tot);
        unsigned kd[8], vp[8];
#pragma unroll
        for (int i = 0; i < 8; ++i) {
            kd[i] = cvt_pk_bf16(kk[2 * i] * __expf(tot - lf[2 * i]), kk[2 * i + 1] * __expf(tot - lf[2 * i + 1]));
            vp[i] = vr[2 * i] | (vr[2 * i + 1] << 16);
        }
        { u32x4* d = (u32x4*)(KdT + ch * 144 + seg * 32); d[0] = (u32x4){kd[0], kd[1], kd[2], kd[3]}; d[1] = (u32x4){kd[4], kd[5], kd[6], kd[7]}; }
        { u32x4* d = (u32x4*)(VTl + ch * 144 + seg * 32); d[0] = (u32x4){vp[0], vp[1], vp[2], vp[3]}; d[1] = (u32x4){vp[4], vp[5], vp[6], vp[7]}; }
        __syncthreads();
        {
            const int un = unit + stride;
            if (un < uend) { const int b2 = un >> 8, c2 = (un >> 2) & 63, h2 = un & 3; const size_t g0 = (size_t)(b2 * SEQ + c2 * 64 + seg * 16) * 512 + h2 * 128 + ch;
#pragma unroll
                for (int i = 0; i < 16; ++i) { lf[i] = LF[g0 + (size_t)i * 512]; vr[i] = VH[g0 + (size_t)i * 512]; } }
        }
        bf16x8 a[2];
#pragma unroll
        for (int ks = 0; ks < 2; ++ks) a[ks] = *(const bf16x8*)(KdT + (16 * w + fr) * 144 + (32 * ks + 8 * q) * 2);
        bf16_t* ltp = LT + (size_t)(bh * 64 + c) * 16384;
#pragma unroll
        for (int vb = 0; vb < 8; ++vb) {
            f32x4 acc = (f32x4){0.f, 0.f, 0.f, 0.f};
#pragma unroll
            for (int ks = 0; ks < 2; ++ks) { const bf16x8 bfr = *(const bf16x8*)(VTl + (16 * vb + fr) * 144 + (32 * ks + 8 * q) * 2); acc = mfma16(a[ks], bfr, acc); }
            u32x2 pk; pk.x = cvt_pk_bf16(acc[0], acc[1]); pk.y = cvt_pk_bf16(acc[2], acc[3]);
            *(u32x2*)(ltp + (size_t)(16 * vb + fr) * 128 + 16 * w + 4 * q) = pk;
        }
        __syncthreads();
    }
}

template <int W>
__device__ __forceinline__ void pool_body(const bf16_t* __restrict__ PH, bf16_t* __restrict__ MIXED, int r0, int s0, int c0) {
    unsigned v[31 + W];
#pragma unroll
    for (int j = 1; j < W; ++j) v[W - 1 - j] = (s0 - j >= 0) ? *(const unsigned*)(PH + (size_t)(r0 - j) * 512 + c0) : 0u;
#pragma unroll
    for (int tt = 0; tt < 32; ++tt) v[W - 1 + tt] = *(const unsigned*)(PH + (size_t)(r0 + tt) * 512 + c0);
    float sx = 0.f, sy = 0.f;
#pragma unroll
    for (int j = 1; j < W; ++j) { sx += bflo(v[W - 1 - j]); sy += bfhi(v[W - 1 - j]); }
#pragma unroll
    for (int tt = 0; tt < 32; ++tt) {
        const int s = s0 + tt;
        const float px = bflo(v[W - 1 + tt]), py = bfhi(v[W - 1 + tt]);
        sx += px; sy += py;
        const int cnt = (s + 1) < W ? (s + 1) : W;
        const float inv = __builtin_amdgcn_rcpf((float)cnt);
        *(unsigned*)(MIXED + (size_t)(r0 + tt) * 1024 + 512 + c0) = cvt_pk_bf16(sx * inv - px, sy * inv - py);
        sx -= bflo(v[tt]); sy -= bfhi(v[tt]);
    }
}
__device__ __forceinline__ void pool_tile(const bf16_t* __restrict__ PH, bf16_t* __restrict__ MIXED, int tile) {
    const int tid = threadIdx.x, cp = tid & 255, th = tid >> 8, c0 = 2 * cp, gi = c0 >> 7;
    const int r0 = tile * 64 + th * 32, s0 = r0 & (SEQ - 1);
    if (gi == 0) pool_body<2>(PH, MIXED, r0, s0, c0);
    else if (gi == 1) pool_body<4>(PH, MIXED, r0, s0, c0);
    else if (gi == 2) pool_body<8>(PH, MIXED, r0, s0, c0);
    else pool_body<16>(PH, MIXED, r0, s0, c0);
}

__device__ __forceinline__ void phase_scan(const bf16_t* LT, const float* __restrict__ DEC, bf16_t* ST, unsigned char* lds) {
    float* decl = (float*)lds;
    for (int e0 = blockIdx.x * NTHREADS; e0 < 131072; e0 += gridDim.x * NTHREADS) {
        const int e2 = e0 + threadIdx.x;
        const int bh = e2 >> 13, v = (e2 >> 6) & 127, kp = e2 & 63;
        const size_t base = (size_t)bh * 64 * 16384 + (size_t)v * 128 + 2 * kp;
        {
            const float* dp = DEC + (size_t)bh * 64 * 128;
            float dv[16];
#pragma unroll
            for (int i = 0; i < 16; ++i) dv[i] = dp[threadIdx.x + NTHREADS * i];
#pragma unroll
            for (int i = 0; i < 16; ++i) decl[threadIdx.x + NTHREADS * i] = dv[i];
        }
        __syncthreads();
        float sx = 0.f, sy = 0.f;
        for (int c0 = 0; c0 < 64; c0 += 32) {
            unsigned l[32];
#pragma unroll
            for (int j = 0; j < 32; ++j) l[j] = *(const unsigned*)(LT + base + (size_t)(c0 + j) * 16384);
#pragma unroll
            for (int j = 0; j < 32; ++j) {
                const f32x2 d = *(const f32x2*)(decl + (c0 + j) * 128 + 2 * kp);
                *(unsigned*)(ST + base + (size_t)(c0 + j) * 16384) = cvt_pk_bf16(sx, sy);
                sx = d[0] * sx + bflo(l[j]); sy = d[1] * sy + bfhi(l[j]);
            }
        }
        __syncthreads();
    }
}

__device__ __forceinline__ void phase_passC(const bf16_t* __restrict__ QH, const bf16_t* __restrict__ KH, const float* __restrict__ LF, const bf16_t* __restrict__ VH, const bf16_t* __restrict__ GH,
                                const bf16_t* __restrict__ ST, const float* __restrict__ hg, bf16_t* __restrict__ MIXED, unsigned char* lds) {
    const int tid = threadIdx.x, ch = tid & 127, seg = tid >> 7, G = gridDim.x;
    float lf[16], kk[16]; unsigned qr[16], vr[16];
    int unit = blockIdx.x;
    if (unit < 1024) { const int b = unit >> 8, c = (unit >> 2) & 63, h = unit & 3; const size_t g0 = (size_t)(b * SEQ + c * 64 + seg * 16) * 512 + h * 128 + ch;
#pragma unroll
        for (int i = 0; i < 16; ++i) { lf[i] = LF[g0 + (size_t)i * 512]; vr[i] = VH[g0 + (size_t)i * 512]; qr[i] = QH[g0 + (size_t)i * 512]; } }
  for (; unit < 1024; unit += G) {
    const int b = unit >> 8, c = (unit >> 2) & 63, h = unit & 3;
    const int row0 = b * SEQ + c * 64, bh = b * 4 + h;
    float* segtot = (float*)lds;
    float* rmsp = (float*)(lds + 2048);
    bf16_t* QC = (bf16_t*)(lds + 4096);
    bf16_t* QT = (bf16_t*)(lds + 21504);
    constexpr int KT0 = 38912;
    unsigned char* VTl = lds + 82432;
    const int w = tid >> 6, lane = tid & 63, fr = lane & 15, q = lane >> 4;
    const int i = w & 3, vh = w >> 2;
    const size_t row = (size_t)(row0 + 16 * i + fr);
    u32x2 gt[4]; f32x4 gg[4]; u32x4 stg[4];
    unsigned char* STL = lds + 100864;
    {
        const bf16_t* stp = ST + (size_t)(bh * 64 + c) * 16384;
#pragma unroll
        for (int vbl = 0; vbl < 4; ++vbl) { const int v0 = 16 * (vh * 4 + vbl) + 4 * q; gt[vbl] = *(const u32x2*)(GH + row * 512 + h * 128 + v0); gg[vbl] = *(const f32x4*)(hg + h * 128 + v0); }
#pragma unroll
        for (int i2 = 0; i2 < 4; ++i2) stg[i2] = *(const u32x4*)(stp + (size_t)tid * 32 + 8 * i2);
    }
#pragma unroll
    for (int i2 = 0; i2 < 16; ++i2) kk[i2] = 1.0f - __expf(lf[i2]);
#pragma unroll
    for (int i2 = 1; i2 < 16; ++i2) lf[i2] += lf[i2 - 1];
    segtot[seg * 128 + ch] = lf[15];
    {
        unsigned vp[8];
#pragma unroll
        for (int i2 = 0; i2 < 8; ++i2) vp[i2] = vr[2 * i2] | (vr[2 * i2 + 1] << 16);
        u32x4* d = (u32x4*)(VTl + ch * 144 + seg * 32); d[0] = (u32x4){vp[0], vp[1], vp[2], vp[3]}; d[1] = (u32x4){vp[4], vp[5], vp[6], vp[7]};
    }
    __syncthreads();
    const float t0 = segtot[ch], t1 = segtot[128 + ch], t2 = segtot[256 + ch];
    const float P = (seg > 0 ? t0 : 0.f) + (seg > 1 ? t1 : 0.f) + (seg > 2 ? t2 : 0.f);
    {
        const float eP = __expf(P);
#pragma unroll
        for (int i2 = 0; i2 < 16; ++i2) {
            const float qv = bflo(qr[i2]);
            const float el = __expf(lf[i2]);
            QT[(seg * 16 + i2) * 136 + ch] = f2bf(qv * el);
            QC[(seg * 16 + i2) * 136 + ch] = f2bf(qv * el * eP);
        }
        float E = 0.f;
#pragma unroll
        for (int i2 = 0; i2 < 4; ++i2) {
            if (i2 >= seg) {
                bf16_t* KT = (bf16_t*)(lds + KT0 + 4352 * ((i2 * (i2 + 1)) / 2));
#pragma unroll
                for (int j = 0; j < 16; ++j) KT[(seg * 16 + j) * 136 + ch] = f2bf(kk[j] * __expf(E - lf[j]));
                E += (i2 == 0 ? t0 : (i2 == 1 ? t1 : t2));
            }
        }
    }
#pragma unroll
    for (int i2 = 0; i2 < 4; ++i2) *(u32x4*)(STL + (tid >> 2) * 272 + (tid & 3) * 64 + 16 * i2) = stg[i2];
    __syncthreads();
    {
        const int un = unit + G;
        if (un < 1024) { const int b2 = un >> 8, c2 = (un >> 2) & 63, h2 = un & 3; const size_t g2 = (size_t)(b2 * SEQ + c2 * 64 + seg * 16) * 512 + h2 * 128 + ch;
#pragma unroll
            for (int i2 = 0; i2 < 16; ++i2) { lf[i2] = LF[g2 + (size_t)i2 * 512]; vr[i2] = VH[g2 + (size_t)i2 * 512]; qr[i2] = QH[g2 + (size_t)i2 * 512]; } }
    }
    f32x4 sT[4];
#pragma unroll
    for (int j = 0; j < 4; ++j) sT[j] = (f32x4){0.f, 0.f, 0.f, 0.f};
    {
        bf16x8 qfr[4];
#pragma unroll
        for (int ks = 0; ks < 4; ++ks) qfr[ks] = *(const bf16x8*)((const unsigned char*)QT + (16 * i + fr) * 272 + (32 * ks + 8 * q) * 2);
        const unsigned char* KT = lds + KT0 + 4352 * ((i * (i + 1)) / 2);
#pragma unroll
        for (int j = 0; j < 4; ++j) if (j <= i) {
#pragma unroll
            for (int ks = 0; ks < 4; ++ks) { const bf16x8 a = *(const bf16x8*)(KT + (16 * j + fr) * 272 + (32 * ks + 8 * q) * 2); sT[j] = mfma16(a, qfr[ks], sT[j]); }
            if (j == i) {
#pragma unroll
                for (int rg = 0; rg < 4; ++rg) if (4 * q + rg > fr) sT[j][rg] = 0.f;
            }
        }
    }
    f32x4 oacc[4];
#pragma unroll
    for (int vbl = 0; vbl < 4; ++vbl) oacc[vbl] = (f32x4){0.f, 0.f, 0.f, 0.f};
#pragma unroll
    for (int m = 0; m < 2; ++m) if (2 * m <= i) {
        const bf16x8 bfrag = mk8u(cvt_pk_bf16(sT[2 * m][0], sT[2 * m][1]), cvt_pk_bf16(sT[2 * m][2], sT[2 * m][3]), cvt_pk_bf16(sT[2 * m + 1][0], sT[2 * m + 1][1]), cvt_pk_bf16(sT[2 * m + 1][2], sT[2 * m + 1][3]));
#pragma unroll
        for (int vbl = 0; vbl < 4; ++vbl) {
            const unsigned char* base = VTl + (16 * (vh * 4 + vbl) + fr) * 144 + (32 * m + 4 * q) * 2;
            const bf16x8 a = mk8(*(const u32x2*)base, *(const u32x2*)(base + 32));
            oacc[vbl] = mfma16(a, bfrag, oacc[vbl]);
        }
    }
    {
#pragma unroll
        for (int ks = 0; ks < 4; ++ks) {
            const bf16x8 bfr = *(const bf16x8*)((const unsigned char*)QC + (16 * i + fr) * 272 + (32 * ks + 8 * q) * 2);
#pragma unroll
            for (int vbl = 0; vbl < 4; ++vbl) { const bf16x8 a = *(const bf16x8*)(STL + (16 * (vh * 4 + vbl) + fr) * 272 + (32 * ks + 8 * q) * 2); oacc[vbl] = mfma16(a, bfr, oacc[vbl]); }
        }
    }
    float ss = 0.f;
#pragma unroll
    for (int vbl = 0; vbl < 4; ++vbl) ss += (oacc[vbl][0] * oacc[vbl][0] + oacc[vbl][1] * oacc[vbl][1]) + (oacc[vbl][2] * oacc[vbl][2] + oacc[vbl][3] * oacc[vbl][3]);
    ss += __shfl_xor(ss, 16); ss += __shfl_xor(ss, 32);
    if (q == 0) rmsp[vh * 64 + 16 * i + fr] = ss;
    __syncthreads();
    const float rstd = rsqrtf((rmsp[16 * i + fr] + rmsp[64 + 16 * i + fr]) * (1.0f / 128.0f) + EPS);
#pragma unroll
    for (int vbl = 0; vbl < 4; ++vbl) {
        const int v0 = 16 * (vh * 4 + vbl) + 4 * q;
        u32x2 o;
        o.x = cvt_pk_bf16(oacc[vbl][0] * rstd * gg[vbl][0] * bflo(gt[vbl].x), oacc[vbl][1] * rstd * gg[vbl][1] * bfhi(gt[vbl].x));
        o.y = cvt_pk_bf16(oacc[vbl][2] * rstd * gg[vbl][2] * bflo(gt[vbl].y), oacc[vbl][3] * rstd * gg[vbl][3] * bfhi(gt[vbl].y));
        *(u32x2*)(MIXED + row * 1024 + h * 128 + v0) = o;
    }
    __syncthreads();
  }
}

__device__ __forceinline__ void attn_unit(const bf16_t* __restrict__ XQ, const bf16_t* __restrict__ KX, const bf16_t* __restrict__ VT, bf16_t* __restrict__ ATT, int unit, unsigned char* lds) {
    const int tid = threadIdx.x, w = tid >> 6, lane = tid & 63, r = lane & 31, hh = lane >> 5;
    const int b = unit >> 6, st = (unit >> 2) & 15, h = unit & 3;
    const int row0 = b * SEQ + st * 256;
    const bf16_t* qp = XQ + (size_t)(row0 + 32 * w + r) * 1024 + h * 256 + 8 * hh;
    {
        const bf16_t* kp = KX + (size_t)(b * 256) * 1024 + h * 256;
        u32x4 kv[16];
#pragma unroll
        for (int it = 0; it < 16; ++it) { const int idx = tid + 512 * it, m = idx >> 5, cc = idx & 31; kv[it] = *(const u32x4*)(kp + (size_t)m * 1024 + cc * 8); }
#pragma unroll
        for (int it = 0; it < 16; ++it) { const int idx = tid + 512 * it, m = idx >> 5, cc = idx & 31; *(u32x4*)(lds + m * 528 + cc * 16) = kv[it]; }
    }
    __syncthreads();
    f32x16 sacc[8];
#pragma unroll
    for (int mb = 0; mb < 8; ++mb)
#pragma unroll
        for (int e = 0; e < 16; ++e) sacc[mb][e] = 0.f;
    {
        bf16x8 qf[4], qn[4];
#pragma unroll
        for (int k4 = 0; k4 < 4; ++k4) qf[k4] = *(const bf16x8*)(qp + 16 * k4);
#pragma unroll
        for (int kg = 0; kg < 4; ++kg) {
            if (kg < 3) {
#pragma unroll
                for (int k4 = 0; k4 < 4; ++k4) qn[k4] = *(const bf16x8*)(qp + 16 * (4 * (kg + 1) + k4)); }
#pragma unroll
            for (int k4 = 0; k4 < 4; ++k4)
#pragma unroll
                for (int mb = 0; mb < 8; ++mb) { const bf16x8 a = *(const bf16x8*)(lds + (32 * mb + r) * 528 + (16 * (4 * kg + k4) + 8 * hh) * 2); sacc[mb] = mfma32(a, qf[k4], sacc[mb]); }
#pragma unroll
            for (int k4 = 0; k4 < 4; ++k4) qf[k4] = qn[k4];
        }
    }
    float mx = -3.0e38f;
#pragma unroll
    for (int mb = 0; mb < 8; ++mb)
#pragma unroll
        for (int e = 0; e < 16; ++e) mx = fmaxf(mx, sacc[mb][e]);
    mx = fmaxf(mx, __shfl_xor(mx, 32));
    float sum = 0.f;
    bf16x8 pf[8][2];
#pragma unroll
    for (int mb = 0; mb < 8; ++mb) {
        float pv[16];
#pragma unroll
        for (int e = 0; e < 16; ++e) { pv[e] = __expf(sacc[mb][e] - mx); sum += pv[e]; }
#pragma unroll
        for (int s = 0; s < 2; ++s) pf[mb][s] = mk8u(cvt_pk_bf16(pv[8 * s + 0], pv[8 * s + 1]), cvt_pk_bf16(pv[8 * s + 2], pv[8 * s + 3]), cvt_pk_bf16(pv[8 * s + 4], pv[8 * s + 5]), cvt_pk_bf16(pv[8 * s + 6], pv[8 * s + 7]));
    }
    sum += __shfl_xor(sum, 32);
    const float inv = 1.0f / sum;
    __syncthreads();
    {
        const bf16_t* vp = VT + (size_t)(h * 256) * 1024 + b * 256;
        u32x4 vv[16];
#pragma unroll
        for (int it = 0; it < 16; ++it) { const int idx = tid + 512 * it, e = idx >> 5, cc = idx & 31; vv[it] = *(const u32x4*)(vp + (size_t)e * 1024 + cc * 8); }
#pragma unroll
        for (int it = 0; it < 16; ++it) { const int idx = tid + 512 * it, e = idx >> 5, cc = idx & 31;
            u32x2* d = (u32x2*)(lds + e * 520 + cc * 16); d[0] = (u32x2){vv[it].x, vv[it].y}; d[1] = (u32x2){vv[it].z, vv[it].w}; }
    }
    __syncthreads();
    bf16_t* op = ATT + (size_t)(row0 + 32 * w + r) * 1024 + h * 256 + 8 * hh;
#pragma unroll
    for (int half = 0; half < 2; ++half) {
        f32x16 oacc[4];
#pragma unroll
        for (int d = 0; d < 4; ++d)
#pragma unroll
            for (int e = 0; e < 16; ++e) oacc[d][e] = 0.f;
#pragma unroll
        for (int mb = 0; mb < 8; ++mb)
#pragma unroll
            for (int s = 0; s < 2; ++s)
#pragma unroll
                for (int d = 0; d < 4; ++d) {
                    const unsigned char* base = lds + (32 * (half * 4 + d) + r) * 520 + (32 * mb + 16 * s + 4 * hh) * 2;
                    const bf16x8 a = mk8(*(const u32x2*)base, *(const u32x2*)(base + 16));
                    oacc[d] = mfma32(a, pf[mb][s], oacc[d]);
                }
#pragma unroll
        for (int d = 0; d < 4; ++d)
#pragma unroll
            for (int pp = 0; pp < 2; ++pp) {
                unsigned ax = cvt_pk_bf16(oacc[d][8 * pp] * inv, oacc[d][8 * pp + 1] * inv), ay = cvt_pk_bf16(oacc[d][8 * pp + 2] * inv, oacc[d][8 * pp + 3] * inv);
                unsigned bx = cvt_pk_bf16(oacc[d][8 * pp + 4] * inv, oacc[d][8 * pp + 5] * inv), by = cvt_pk_bf16(oacc[d][8 * pp + 6] * inv, oacc[d][8 * pp + 7] * inv);
                { auto t = __builtin_amdgcn_permlane32_swap(ax, bx, false, false); ax = t[0]; bx = t[1]; }
                { auto t = __builtin_amdgcn_permlane32_swap(ay, by, false, false); ay = t[0]; by = t[1]; }
                u32x4 o; o.x = ax; o.y = ay; o.z = bx; o.w = by;
                *(u32x4*)(op + 32 * (half * 4 + d) + 16 * pp) = o;
            }
    }
    __syncthreads();
}

__device__ __forceinline__ void phase_final(const bf16_t* __restrict__ xb, const float* __restrict__ ssq, float* __restrict__ out, const float* __restrict__ g) {
    const int tid = threadIdx.x, sub = tid >> 7, l = tid & 127;
    const f32x4 g0 = *(const f32x4*)(g + 8 * l), g1 = *(const f32x4*)(g + 8 * l + 4);
    for (int r = blockIdx.x * 4 + sub; r < MROWS; r += gridDim.x * 4) {
        const u32x4 v = *(const u32x4*)(xb + (size_t)r * DM + 8 * l);
        const f32x4* pp = (const f32x4*)(ssq + (size_t)r * 16); const f32x4 a = pp[0], b = pp[1], c = pp[2], d = pp[3];
        const float t = ((a[0] + a[1]) + (a[2] + a[3])) + ((b[0] + b[1]) + (b[2] + b[3])) + ((c[0] + c[1]) + (c[2] + c[3])) + ((d[0] + d[1]) + (d[2] + d[3]));
        const float rstd = rsqrtf(t * (1.0f / 1024.0f) + EPS);
        const f32x4 o0 = (f32x4){bflo(v.x), bfhi(v.x), bflo(v.y), bfhi(v.y)} * rstd * g0, o1 = (f32x4){bflo(v.z), bfhi(v.z), bflo(v.w), bfhi(v.w)} * rstd * g1;
        *(f32x4*)(out + (size_t)r * DM + 8 * l) = o0; *(f32x4*)(out + (size_t)r * DM + 8 * l + 4) = o1;
    }
}

#define XB_TMO      128
#define XB_XCNT(j)  (256  + 64 * (j))
#define XB_XSUB(j)  (1280 + 64 * (j))
#define XB_XGEN(j)  (2304 + 64 * (j))
#define XB_TOP      3328
#define XB_TOPGEN   3392
#define XCD_BAR_WORDS 3456
#define XB_SPIN_CAP (1u << 22)
__device__ __forceinline__ unsigned xb_ld(unsigned* p)              { return __hip_atomic_load(p, __ATOMIC_RELAXED, __HIP_MEMORY_SCOPE_AGENT); }
__device__ __forceinline__ unsigned xb_add(unsigned* p, unsigned v) { return __hip_atomic_fetch_add(p, v, __ATOMIC_RELAXED, __HIP_MEMORY_SCOPE_AGENT); }
__device__ __forceinline__ unsigned xb_xcc_id() { return (unsigned)__builtin_amdgcn_s_getreg((3 << 11) | 20) & 0xFu; }
#define XB_SPIN(cond, bar) do { unsigned _sp = 0; while (cond) { __builtin_amdgcn_s_sleep(1); \
    if ((++_sp & 255u) == 0u) { if (xb_ld(&(bar)[XB_TMO])) break; if (_sp > XB_SPIN_CAP) { atomicAdd(&(bar)[XB_TMO], 1u); break; } } } } while (0)
struct XcdBarrier { unsigned* bar; unsigned x; volatile LAS unsigned* st; };
__device__ __forceinline__ XcdBarrier xcd_barrier_post(unsigned* bar, volatile LAS unsigned* st) {
    XcdBarrier b; b.bar = bar; b.x = xb_xcc_id(); b.st = st;
    if (threadIdx.x == 0) (void)xb_add(&bar[XB_XCNT(b.x)], 1u);
    return b;
}
__device__ __forceinline__ void xcd_barrier_complete(unsigned* bar, unsigned x, unsigned& nloc, unsigned& nx) {
    const unsigned G = gridDim.x * gridDim.y * gridDim.z;
    unsigned sum, cnt, mine, sp = 0u;
    for (;;) {
        sum = 0u; cnt = 0u; mine = 0u;
#pragma unroll
        for (unsigned j = 0; j < 16; ++j) { const unsigned c = xb_ld(&bar[XB_XCNT(j)]); sum += c; cnt += (c > 0u) ? 1u : 0u; mine = (j == x) ? c : mine; }
        if (sum == G) break;
        __builtin_amdgcn_s_sleep(1);
        if ((++sp & 255u) == 0u) { if (xb_ld(&bar[XB_TMO])) break; if (sp > XB_SPIN_CAP) { atomicAdd(&bar[XB_TMO], 1u); break; } }
    }
    nloc = mine > 0u ? mine : 1u; nx = cnt > 0u ? cnt : 1u;
}
__device__ __forceinline__ void xcd_barrier(const XcdBarrier& b) {
    asm volatile("s_waitcnt vmcnt(0)" ::: "memory");
    __syncthreads();
    if (threadIdx.x == 0) {
        unsigned* bar = b.bar;
        __builtin_amdgcn_s_waitcnt(0);
        unsigned nloc = b.st[0], nx = b.st[1];
        if (nloc == 0u) { xcd_barrier_complete(bar, b.x, nloc, nx); b.st[0] = nloc; b.st[1] = nx; }
        const unsigned old = xb_add(&bar[XB_XSUB(b.x)], 1u);
        const unsigned gen = old / nloc;
        if (old + 1u == (gen + 1u) * nloc) {
            __builtin_amdgcn_fence(__ATOMIC_RELEASE, "agent");
            asm volatile("s_waitcnt vmcnt(0)" ::: "memory");
            const unsigned og = xb_add(&bar[XB_TOP], 1u);
            const unsigned tg = og / nx;
            if (og + 1u == (tg + 1u) * nx) xb_add(&bar[XB_TOPGEN], 1u);
            else XB_SPIN(xb_ld(&bar[XB_TOPGEN]) == tg, bar);
            __builtin_amdgcn_fence(__ATOMIC_ACQUIRE, "agent");
            asm volatile("s_waitcnt vmcnt(0)" ::: "memory");
        } else {
            XB_SPIN(xb_ld(&bar[XB_TOPGEN]) == gen, bar);
            __builtin_amdgcn_fence(__ATOMIC_ACQUIRE, "agent");
            asm volatile("s_waitcnt vmcnt(0)" ::: "memory");
        }
    }
    __syncthreads();
}

__device__ __forceinline__ unsigned xcd_arrive(const XcdBarrier& b) {
    asm volatile("s_waitcnt vmcnt(0)" ::: "memory");
    __syncthreads();
    unsigned gen = 0u;
    if (threadIdx.x == 0) {
        unsigned* bar = b.bar;
        __builtin_amdgcn_s_waitcnt(0);
        unsigned nloc = b.st[0], nx = b.st[1];
        if (nloc == 0u) { xcd_barrier_complete(bar, b.x, nloc, nx); b.st[0] = nloc; b.st[1] = nx; }
        const unsigned old = xb_add(&bar[XB_XSUB(b.x)], 1u);
        gen = old / nloc;
        if (old + 1u == (gen + 1u) * nloc) {
            __builtin_amdgcn_fence(__ATOMIC_RELEASE, "agent");
            asm volatile("s_waitcnt vmcnt(0)" ::: "memory");
            (void)xb_add(&bar[XB_TOP], 1u);
        }
    }
    return gen;
}
__device__ __forceinline__ void xcd_wait(const XcdBarrier& b, unsigned gen) {
    if (threadIdx.x == 0) {
        unsigned* bar = b.bar;
        const unsigned want = (gen + 1u) * b.st[1];
        XB_SPIN(xb_ld(&bar[XB_TOP]) < want, bar);
        __builtin_amdgcn_fence(__ATOMIC_ACQUIRE, "agent");
        asm volatile("s_waitcnt vmcnt(0)" ::: "memory");
    }
    __syncthreads();
}
__device__ __forceinline__ void shadow_work(const Params& p, unsigned char* lds, int k, int bid, int G) {
    const int lo = bid, hi2 = (bid + 128) % G;
    if (k == 0)      { transpose_range(p, lds, 2112, 2304, lo, G);  transpose_range(p, lds, 320, 576, (bid + 64) % G, G); }
    else if (k == 1) { transpose_range(p, lds, 832, 960, lo, G);    transpose_range(p, lds, 960, 1088, hi2, G); }
    else if (k == 2) { transpose_range(p, lds, 576, 704, lo, G);    transpose_range(p, lds, 1088, 1216, hi2, G); }
    else if (k == 3) { for (int t = bid; t < 256; t += G) pool_tile((const bf16_t*)(p.ws + WS_PH), (bf16_t*)(p.ws + WS_MIXED), t); }
    else if (k == 4) { transpose_range(p, lds, 704, 832, lo, G);    transpose_range(p, lds, 1216, 1344, hi2, G); }
    else if (k == 5) { transpose_range(p, lds, 1344, 1472, lo, G);  transpose_range(p, lds, 1472, 1600, hi2, G); }
    else if (k == 7) { transpose_range(p, lds, 1600, 1856, lo, G); }
    else if (k == 8) { transpose_range(p, lds, 1856, 1984, lo, G); }
}

constexpr int N_PHASES = 12;
__global__ void __launch_bounds__(NTHREADS, 2) mega(Params p) {
    extern __shared__ __attribute__((aligned(16))) unsigned char lds[];
    LAS unsigned char* ldsl = (LAS unsigned char*)lds;
    unsigned char* ws = p.ws;
    const int G = gridDim.x, bid = blockIdx.x;
    const int lo = p.ph_lo, hi = p.ph_hi;

#ifndef DEFER_PREP
#define DEFER_PREP 0
#endif
#ifndef FUSE_FINAL
#define FUSE_FINAL 0
#endif
#ifndef DBG_LAST
#define DBG_LAST -1
#endif
#ifndef PHASE_MASK
#define PHASE_MASK 0xfff
#endif
#define IN(k) (((PHASE_MASK >> (k)) & 1) && lo <= (k) && (k) < hi)
    if (threadIdx.x == 0) { ((volatile LAS unsigned*)(ldsl + LDS_MAIN))[0] = 0u; ((volatile LAS unsigned*)(ldsl + LDS_MAIN))[1] = 0u; }
    __syncthreads();
    XcdBarrier xbar; xbar.bar = (unsigned*)(ws + WS_BAR); xbar.x = 0; xbar.st = nullptr;
    if (hi - lo > 1) xbar = xcd_barrier_post((unsigned*)(ws + WS_BAR), (volatile LAS unsigned*)(ldsl + LDS_MAIN));
    if (lo > hi) cg::this_grid().sync();
    const bool shadow = (G == 256) && (hi - lo == N_PHASES);
#define SEAM(k) do { if (IN(k) && IN((k) + 1)) { const unsigned g_ = xcd_arrive(xbar); if (shadow) shadow_work(p, lds, (k), bid, G); xcd_wait(xbar, g_); } } while (0)
    bf16_t* XB = (bf16_t*)(ws + WS_XB); bf16_t* LT = (bf16_t*)(ws + WS_ST);
    bf16_t* QH = (bf16_t*)(ws + WS_QH); bf16_t* KH = (bf16_t*)(ws + WS_KH); bf16_t* VH = (bf16_t*)(ws + WS_VH); bf16_t* GH = (bf16_t*)(ws + WS_GH); bf16_t* PH = (bf16_t*)(ws + WS_PH);
    float* LF = (float*)(ws + WS_LF); bf16_t* ST = (bf16_t*)(ws + WS_ST); bf16_t* MIXED = (bf16_t*)(ws + WS_MIXED);
    float* X1 = (float*)(ws + WS_X1); bf16_t* XQ = (bf16_t*)(ws + WS_XQ); bf16_t* ATT = (bf16_t*)(ws + WS_ATT); bf16_t* U = (bf16_t*)(ws + WS_U);
    float* SSQ = (float*)(ws + WS_SSQ); float* DEC = (float*)(ws + WS_DEC);
    bf16_t* MEMB = (bf16_t*)(ws + WS_MEMB); bf16_t* KX = (bf16_t*)(ws + WS_KX); bf16_t* VT = (bf16_t*)(ws + WS_VT);

    const bool fuse_final = FUSE_FINAL && (G == 256) && IN(10) && (hi - lo > 1);
    if (IN(0)) { phase_prep(p, lds, shadow);
#if !DEFER_PREP
        if (!shadow) deferred_prep(p, lds, bid, G);
#endif
    }
    SEAM(0);
    const bf16_t* WTIN = (const bf16_t*)(ws + WS_WT_IN);
    if (IN(1)) {
        const pg8::Epi E{0, ws, p.x, p.out, p.lb_logits, p.final_norm_g, 2};
        pg8::Gemm g{XB, WTIN + (size_t)512 * DM, MROWS, 1024, DM}; pg8::StaticOrder S; S.init(MROWS, 1024, G, bid); pg8::gemm_phase(ldsl, g, S, E);
    }
    SEAM(1);
    if (IN(2)) {
        { const pg8::Epi E{0, ws, p.x, p.out, p.lb_logits, p.final_norm_g, 6};
          pg8::Gemm g{XB, WTIN + (size_t)1536 * DM, MROWS, 1024, DM}; pg8::StaticOrder S; S.init(MROWS, 1024, G, bid); pg8::gemm_phase(ldsl, g, S, E); }
        { const pg8::Epi E{0, ws, p.x, p.out, p.lb_logits, p.final_norm_g, 0};
          pg8::Gemm g{XB, WTIN, MROWS, 512, DM}; pg8::StaticOrder S; S.init(MROWS, 512, G, bid); pg8::gemm_phase(ldsl, g, S, E); }
        const pg8::Epi E1{1, ws, p.x, p.out, p.lb_logits, p.final_norm_g, 0};
        { pg8::Gemm g{MEMB, (const bf16_t*)(ws + WS_WT_K), MEMROWS, 1024, DM}; pg8::StaticOrder S; S.init(MEMROWS, 1024, G, (bid + 128) % G); pg8::gemm_phase(ldsl, g, S, E1); }
        const pg8::Epi E2{2, ws, p.x, p.out, p.lb_logits, p.final_norm_g, 0};
        { pg8::Gemm g{(const bf16_t*)(ws + WS_WT_V), MEMB, 1024, MEMROWS, DM}; pg8::StaticOrder S; S.init(1024, MEMROWS, G, (bid + 112) % G); pg8::gemm_phase(ldsl, g, S, E2); }
        if (G == 256) {
            if (bid >= 160) phase_passA(KH, LF, VH, LT, DEC, lds, bid - 160, 96, 0, 512);
            phase_passA(KH, LF, VH, LT, DEC, lds, bid, G, 512, 1024);
        } else phase_passA(KH, LF, VH, LT, DEC, lds, bid, G, 0, 1024);
    }
    SEAM(2);
    if (IN(3)) {
        phase_scan(LT, DEC, ST, lds);
        if (!shadow) { for (int t = bid; t < 256; t += G) pool_tile(PH, MIXED, t); }
        fold_pool_weights_mfma(p);
    }
    SEAM(3);
    if (IN(4)) { phase_passC(QH, KH, LF, VH, GH, ST, p.hgrn_norm_g, MIXED, lds); }
    SEAM(4);
    if (IN(5)) {
        const pg8::Epi E{6, ws, p.x, p.out, p.lb_logits, p.final_norm_g, 0};
        pg8::Gemm g{MIXED, (const bf16_t*)(ws + WS_WT_OUT), MROWS, DM, DM}; pg8::StaticOrder S; S.init(MROWS, DM, G, bid); pg8::gemm_phase(ldsl, g, S, E);
    }
    SEAM(5);
    const bool fuse_attn = (G == 256) && IN(6) && IN(7);
    if (IN(6)) {
        const pg8::Epi E{4, ws, p.x, p.out, p.lb_logits, p.final_norm_g, 0};
        pg8::Gemm g{XB, (const bf16_t*)(ws + WS_WT_Q), MROWS, DM, DM}; pg8::StaticOrder S; S.init(MROWS, DM, G, bid); pg8::gemm_phase(ldsl, g, S, E);
        if (fuse_attn) {
            pg8::Unit u; S.next(0, u);
            asm volatile("s_waitcnt vmcnt(0)" ::: "memory"); __syncthreads();
            attn_unit(XQ, KX, VT, ATT, u.pm * 4 + u.pn, lds);
        }
    }
    if (!fuse_attn) {
        SEAM(6);
        if (IN(7)) { for (int u = bid; u < 256; u += G) attn_unit(XQ, KX, VT, ATT, u, lds); }
    }
    SEAM(7);
    if (IN(8)) {
        const pg8::Epi E{6, ws, p.x, p.out, p.lb_logits, p.final_norm_g, 0};
        pg8::Gemm g{ATT, (const bf16_t*)(ws + WS_WT_O), MROWS, DM, DM}; pg8::StaticOrder S; S.init(MROWS, DM, G, bid); pg8::gemm_phase(ldsl, g, S, E);
    }
    SEAM(8);
    if (IN(9)) {
        const pg8::Epi E{5, ws, p.x, p.out, p.lb_logits, p.final_norm_g, 0};
        pg8::Gemm g{XB, (const bf16_t*)(ws + WS_WT_FF1), MROWS, DFF, DM}; pg8::StaticOrder S; S.init(MROWS, DFF, G, bid); pg8::gemm_phase(ldsl, g, S, E);
    }
    SEAM(9);
    if (IN(10)) {
        const pg8::Epi E{fuse_final ? 8 : 7, ws, p.x, p.out, p.lb_logits, p.final_norm_g, 0};
        pg8::Gemm g{U, (const bf16_t*)(ws + WS_WT_FF2), MROWS, DM, DFF}; pg8::StaticOrder S; S.init(MROWS, DM, G, bid); pg8::gemm_phase(ldsl, g, S, E);
    }
    if (!fuse_final) {
        SEAM(10);
        if (IN(11)) { phase_final(XB, SSQ, p.out, p.final_norm_g); }
    }
#if DBG_LAST >= 0
    cg::this_grid().sync();
    {
        const unsigned* w32 = (const unsigned*)ws;
        for (size_t i = (size_t)bid * NTHREADS + threadIdx.x; i < (size_t)MROWS * DM; i += (size_t)G * NTHREADS) {
            float a = 0.f;
            for (int j = 0; j < 4; ++j) { const unsigned v = w32[i + (size_t)j * MROWS * DM]; a += (float)(v & 0xffffu) + (float)(v >> 16); }
            p.out[i] = a;
        }
    }
#endif
#undef IN
#undef SEAM
}

extern "C" void kernel_launch(void* const* d_in, const int* in_sizes, int n_in, void* d_out, int out_size, void* d_ws, size_t ws_size, hipStream_t stream) {
    static int grid = 0;
    if (grid == 0) {
        if (n_in != 19 || in_sizes[0] != MROWS * DM || out_size != MROWS * DM || ws_size < WS_END) { fprintf(stderr, "kernel_launch: unexpected shapes (n_in %d, ws %zu)\n", n_in, ws_size); grid = -1; return; }
        int dev = 0, cus = 0, per_cu = 0;
        hipGetDevice(&dev); hipDeviceGetAttribute(&cus, hipDeviceAttributeMultiprocessorCount, dev);
        if (hipFuncSetAttribute((const void*)mega, hipFuncAttributeMaxDynamicSharedMemorySize, LDS_BYTES) != hipSuccess) { fprintf(stderr, "kernel_launch: hipFuncSetAttribute failed\n"); grid = -1; return; }
        if (hipOccupancyMaxActiveBlocksPerMultiprocessor(&per_cu, (const void*)mega, NTHREADS, LDS_BYTES) != hipSuccess || per_cu < 1) { fprintf(stderr, "kernel_launch: occupancy query says %d\n", per_cu); per_cu = 1; }
        (void)hipGetLastError();
        grid = cus * 1;
        if (grid > cus * per_cu) grid = cus * per_cu;
    }
    if (grid < 0) return;
    if (hipMemsetAsync((char*)d_ws + WS_BAR, 0, 32768, stream) != hipSuccess) { fprintf(stderr, "kernel_launch: memset of barrier words failed\n"); return; }
    Params p{};
    const float** f = (const float**)&p;
    for (int i = 0; i < 19; ++i) f[i] = (const float*)d_in[i];
    p.out = (float*)d_out; p.ws = (unsigned char*)d_ws;
#if N_LAUNCH_MODE == 1
    p.ph_lo = 0; p.ph_hi = (DBG_LAST >= 0) ? DBG_LAST + 1 : N_PHASES;
    void* args[] = {&p};
    hipError_t e = hipLaunchCooperativeKernel((const void*)mega, dim3(grid), dim3(NTHREADS), args, LDS_BYTES, stream);
    if (e != hipSuccess) fprintf(stderr, "kernel_launch: cooperative launch failed: %s (grid %d)\n", hipGetErrorString(e), grid);
#else
    for (int k = 0; k < N_PHASES; ++k) { p.ph_lo = k; p.ph_hi = k + 1; hipLaunchKernelGGL(mega, dim3(grid), dim3(NTHREADS), LDS_BYTES, stream, p); }
#endif
}
```
